# Optimizing an MI355X kernel written in HIP

```python
import jax, jax.numpy as jnp
from jax import lax
import numpy as np

D_MODEL = 1024
BATCH = 8
SEQ = 8192
DEPTH = 1

EPS = 1e-6
RWKV_HEADS = 8
RWKV_HEAD_DIM = 64
D_RWKV = RWKV_HEADS * RWKV_HEAD_DIM
DECAY_LORA = 64
AAA_LORA = 64
GATE_LORA = 128
LN_X_EPS = 64e-5
MLA_HEADS = 8
QK_NOPE_DIM = 64
QK_ROPE_DIM = 32
QK_HEAD_DIM = QK_NOPE_DIM + QK_ROPE_DIM
V_HEAD_DIM = 64
D_MLA = MLA_HEADS * V_HEAD_DIM
Q_LORA = 256
KV_LORA = 128
ROPE_THETA = 10000.0
Q_BLOCK = 128
RWKV_COLS = 3 * D_RWKV + DECAY_LORA + AAA_LORA + GATE_LORA
MLA_COLS = Q_LORA + KV_LORA + QK_ROPE_DIM
N_BRANCHES = 2
D_IN = RWKV_COLS + MLA_COLS + N_BRANCHES * D_MODEL
D_BRANCH = 512
N_GROUPS = 4
EXPERTS_PER_GROUP = 8
N_EXPERTS = N_GROUPS * EXPERTS_PER_GROUP
TOP_K = 2
D_EXPERT = 256

kernel_name = "hybrid_rwkv7_mla_hmoe_adaln_block"


def rmsnorm(x, g):
    xf = x.astype(jnp.float32)
    y = xf * lax.rsqrt(jnp.mean(xf * xf, axis=-1, keepdims=True) + EPS)
    return (y * g.astype(jnp.float32)).astype(x.dtype)


def modulate(h, shift, scale):
    return h * (1 + scale[:, None, :]) + shift[:, None, :]


def token_shift(z):
    return jnp.pad(z, ((0, 0), (1, 0), (0, 0)))[:, :-1]


def rope(x, cos, sin):
    x1, x2 = jnp.split(x, 2, axis=-1)
    return jnp.concatenate([x1 * cos - x2 * sin, x2 * cos + x1 * sin], axis=-1)


def rwkv7_scan(r, w, k, v, kk, b):
    bsz, _, nh, n = r.shape
    xs = tuple(jnp.moveaxis(t.astype(jnp.float32), 1, 0) for t in (r, w, k, v, kk, b))

    def step(state, inp):
        r_t, w_t, k_t, v_t, kk_t, b_t = inp
        sa = jnp.einsum('bhij,bhj->bhi', state, -kk_t)
        state = (state * w_t[:, :, None, :]
                 + sa[..., None] * b_t[:, :, None, :]
                 + v_t[..., None] * k_t[:, :, None, :])
        y = jnp.einsum('bhij,bhj->bhi', state, r_t)
        return state, y

    state0 = jnp.zeros((bsz, nh, n, n), jnp.float32)
    _, ys = lax.scan(step, state0, xs)
    return jnp.moveaxis(ys, 0, 1)


def rwkv7_branch(z, mu, w0, w_decay_up, a0, w_a_up, w_g_up, k_k, k_a, r_k, ln_w, ln_b):
    bsz, s, _ = z.shape
    z = z + (token_shift(z) - z) * mu
    zr, zk, zv, zw, za, zg = jnp.split(
        z, [D_RWKV, 2 * D_RWKV, 3 * D_RWKV, 3 * D_RWKV + DECAY_LORA,
            3 * D_RWKV + DECAY_LORA + AAA_LORA], axis=-1)
    w_log = -jax.nn.softplus(-(w0 + jnp.tanh(zw) @ w_decay_up)) - 0.5
    decay = jnp.exp(-jnp.exp(w_log.astype(jnp.float32)))
    a = jax.nn.sigmoid(a0 + za @ w_a_up)
    g = jax.nn.sigmoid(zg) @ w_g_up

    heads = lambda t: t.reshape(bsz, s, RWKV_HEADS, RWKV_HEAD_DIM)
    kk = heads(zk * k_k).astype(jnp.float32)
    kk = kk / jnp.maximum(jnp.sqrt(jnp.sum(kk * kk, axis=-1, keepdims=True)), 1e-12)
    k = zk * (1 + (a - 1) * k_a)
    r_h, k_h, v_h, a_h = heads(zr), heads(k), heads(zv), heads(a)

    y = rwkv7_scan(r_h, heads(decay), k_h, v_h, kk, kk * a_h)
    mean = jnp.mean(y, axis=-1, keepdims=True)
    var = jnp.mean(jnp.square(y - mean), axis=-1, keepdims=True)
    y = ((y - mean) * lax.rsqrt(var + LN_X_EPS)).reshape(bsz, s, D_RWKV)
    y = (y * ln_w.astype(jnp.float32) + ln_b.astype(jnp.float32)).astype(z.dtype)
    bonus = jnp.sum(r_h * k_h * r_k, axis=-1, keepdims=True) * v_h
    return (y + bonus.reshape(bsz, s, D_RWKV)) * g


def causal_attention(q, k, v):
    bsz, s, nh, dv = v.shape
    q = q.transpose(0, 2, 1, 3)
    k = k.transpose(0, 2, 1, 3)
    v = v.transpose(0, 2, 1, 3)
    scale = QK_HEAD_DIM ** -0.5
    kpos = jnp.arange(s)

    def block(i):
        start = i * Q_BLOCK
        qb = lax.dynamic_slice_in_dim(q, start, Q_BLOCK, axis=2)
        sc = jnp.einsum('bhqd,bhkd->bhqk', qb, k).astype(jnp.float32) * scale
        qpos = start + jnp.arange(Q_BLOCK)
        sc = jnp.where(kpos[None, :] <= qpos[:, None], sc, -jnp.inf)
        p = jax.nn.softmax(sc, axis=-1).astype(v.dtype)
        return jnp.einsum('bhqk,bhkd->bhqd', p, v)

    o = lax.map(block, jnp.arange(s // Q_BLOCK))
    return o.transpose(1, 0, 3, 2, 4).reshape(bsz, s, nh, dv)


def mla_branch(z, cos, sin, g_q_a, w_uq, g_kv_a, w_ukv, q_norm, k_norm):
    bsz, s, _ = z.shape
    zq, zkv, zpe = jnp.split(z, [Q_LORA, Q_LORA + KV_LORA], axis=-1)
    q = (rmsnorm(zq, g_q_a) @ w_uq).reshape(bsz, s, MLA_HEADS, QK_HEAD_DIM)
    kv = (rmsnorm(zkv, g_kv_a) @ w_ukv).reshape(bsz, s, MLA_HEADS, QK_NOPE_DIM + V_HEAD_DIM)
    k_nope, v = jnp.split(kv, [QK_NOPE_DIM], axis=-1)
    k_pe = jnp.broadcast_to(zpe[:, :, None, :], (bsz, s, MLA_HEADS, QK_ROPE_DIM))
    k = jnp.concatenate([k_nope, k_pe], axis=-1)
    q = rmsnorm(q, q_norm)
    k = rmsnorm(k, k_norm)
    q = jnp.concatenate([q[..., :QK_NOPE_DIM], rope(q[..., QK_NOPE_DIM:], cos, sin)], axis=-1)
    k = jnp.concatenate([k[..., :QK_NOPE_DIM], rope(k[..., QK_NOPE_DIM:], cos, sin)], axis=-1)
    o = causal_attention(q, k, v)
    return o.reshape(bsz, s, D_MLA)


def hier_moe(h, w_rg, b_rg, w_re, b_re, w_e_gate, w_e_up, w_e_down):
    bsz, s, d = h.shape
    t = h.reshape(-1, d)
    g_logits = (t @ w_rg).astype(jnp.float32) + b_rg.astype(jnp.float32)
    p_group = jax.nn.softmax(g_logits, axis=-1)
    g_idx = jnp.argmax(g_logits, axis=-1)
    p_g = jnp.take_along_axis(p_group, g_idx[:, None], axis=-1)
    e_logits = ((t @ w_re).astype(jnp.float32) + b_re.astype(jnp.float32)).reshape(
        -1, N_GROUPS, EXPERTS_PER_GROUP)
    e_in_group = jnp.take_along_axis(e_logits, g_idx[:, None, None], axis=1)[:, 0]
    p_e = jax.nn.softmax(e_in_group, axis=-1)
    top_w, top_i = lax.top_k(p_e, TOP_K)
    top_w = top_w / jnp.sum(top_w, axis=-1, keepdims=True) * p_g
    expert_id = g_idx[:, None] * EXPERTS_PER_GROUP + top_i
    combine = jnp.sum(jax.nn.one_hot(expert_id, N_EXPERTS, dtype=jnp.float32)
                      * top_w[..., None], axis=1).astype(t.dtype)
    out = jnp.zeros_like(t)
    for e in range(N_EXPERTS):
        hid = jax.nn.silu(t @ w_e_gate[e]) * (t @ w_e_up[e])
        out = out + combine[:, e:e + 1] * (hid @ w_e_down[e])
    return out.reshape(bsz, s, d)


def setup_inputs(seed: int = 0) -> dict:
    key = jax.random.key(seed)
    ks = iter(jax.random.split(key, 40))
    L = DEPTH
    nrm = lambda shape, scale: jax.random.normal(next(ks), shape, jnp.float32) * scale
    gain = lambda shape: 1.0 + nrm(shape, 0.02)
    x = nrm((BATCH, SEQ, D_MODEL), 1.0)
    c = nrm((BATCH, D_MODEL), 1.0)
    offset = jax.random.randint(next(ks), (BATCH, 1), 0, 4096, dtype=jnp.int32)
    positions = (offset + jnp.arange(SEQ, dtype=jnp.int32)[None, :]).astype(jnp.int32)
    return {
        'x': x,
        'c': c,
        'positions': positions,
        'w_ada': nrm((L, D_MODEL, 6 * D_MODEL), D_MODEL ** -0.5),
        'b_ada': nrm((L, 6 * D_MODEL), 0.01),
        'g_norm_mix': gain((L, D_MODEL)),
        'w_in': nrm((L, D_MODEL, D_IN), D_MODEL ** -0.5),
        'mu_shift': jax.random.uniform(next(ks), (L, RWKV_COLS), jnp.float32),
        'w0': -2.0 + nrm((L, D_RWKV), 0.5),
        'w_decay_up': nrm((L, DECAY_LORA, D_RWKV), 0.5 * DECAY_LORA ** -0.5),
        'a0': nrm((L, D_RWKV), 0.1),
        'w_a_up': nrm((L, AAA_LORA, D_RWKV), AAA_LORA ** -0.5),
        'w_g_up': nrm((L, GATE_LORA, D_RWKV), GATE_LORA ** -0.5),
        'k_k': 0.85 + nrm((L, D_RWKV), 0.05),
        'k_a': 1.0 + nrm((L, D_RWKV), 0.05),
        'r_k': nrm((L, RWKV_HEADS, RWKV_HEAD_DIM), 0.1),
        'ln_x_w': gain((L, D_RWKV)),
        'ln_x_b': nrm((L, D_RWKV), 0.01),
        'g_q_a': gain((L, Q_LORA)),
        'w_uq': nrm((L, Q_LORA, MLA_HEADS * QK_HEAD_DIM), Q_LORA ** -0.5),
        'g_kv_a': gain((L, KV_LORA)),
        'w_ukv': nrm((L, KV_LORA, MLA_HEADS * (QK_NOPE_DIM + V_HEAD_DIM)), KV_LORA ** -0.5),
        'q_norm': gain((L, QK_HEAD_DIM)),
        'k_norm': gain((L, QK_HEAD_DIM)),
        'w_branch': nrm((L, N_BRANCHES, D_BRANCH, D_MODEL), D_BRANCH ** -0.5),
        'w_out': nrm((L, D_MODEL, D_MODEL), D_MODEL ** -0.5),
        'g_norm_ffn': gain((L, D_MODEL)),
        'w_router_group': nrm((L, D_MODEL, N_GROUPS), D_MODEL ** -0.5),
        'b_router_group': nrm((L, N_GROUPS), 0.01),
        'w_router_expert': nrm((L, D_MODEL, N_EXPERTS), D_MODEL ** -0.5),
        'b_router_expert': nrm((L, N_EXPERTS), 0.01),
        'w_e_gate': nrm((L, N_EXPERTS, D_MODEL, D_EXPERT), D_MODEL ** -0.5),
        'w_e_up': nrm((L, N_EXPERTS, D_MODEL, D_EXPERT), D_MODEL ** -0.5),
        'w_e_down': nrm((L, N_EXPERTS, D_EXPERT, D_MODEL), D_EXPERT ** -0.5),
    }


def reference(x, c, positions, w_ada, b_ada, g_norm_mix, w_in, mu_shift, w0, w_decay_up,
              a0, w_a_up, w_g_up, k_k, k_a, r_k, ln_x_w, ln_x_b, g_q_a, w_uq, g_kv_a,
              w_ukv, q_norm, k_norm, w_branch, w_out, g_norm_ffn, w_router_group,
              b_router_group, w_router_expert, b_router_expert, w_e_gate, w_e_up, w_e_down):
    freqs = ROPE_THETA ** (-(jnp.arange(0, QK_ROPE_DIM, 2, dtype=jnp.float32) / QK_ROPE_DIM))
    ang = positions.astype(jnp.float32)[..., None] * freqs
    cos = jnp.cos(ang)[:, :, None, :].astype(x.dtype)
    sin = jnp.sin(ang)[:, :, None, :].astype(x.dtype)
    for l in range(DEPTH):
        mod = jax.nn.silu(c) @ w_ada[l] + b_ada[l]
        sh_m, sc_m, gt_m, sh_f, sc_f, gt_f = jnp.split(mod, 6, axis=-1)

        h = modulate(rmsnorm(x, g_norm_mix[l]), sh_m, sc_m)
        z = h @ w_in[l]
        z_rwkv, z_mla, z_gates = jnp.split(z, [RWKV_COLS, RWKV_COLS + MLA_COLS], axis=-1)
        y_rwkv = rwkv7_branch(z_rwkv, mu_shift[l], w0[l], w_decay_up[l], a0[l], w_a_up[l],
                              w_g_up[l], k_k[l], k_a[l], r_k[l], ln_x_w[l], ln_x_b[l])
        y_mla = mla_branch(z_mla, cos, sin, g_q_a[l], w_uq[l], g_kv_a[l], w_ukv[l],
                           q_norm[l], k_norm[l])
        gate_rwkv, gate_mla = jnp.split(jax.nn.sigmoid(z_gates), N_BRANCHES, axis=-1)
        merged = gate_rwkv * (y_rwkv @ w_branch[l, 0]) + gate_mla * (y_mla @ w_branch[l, 1])
        x = x + gt_m[:, None, :] * (merged @ w_out[l])

        h2 = modulate(rmsnorm(x, g_norm_ffn[l]), sh_f, sc_f)
        x = x + gt_f[:, None, :] * hier_moe(h2, w_router_group[l], b_router_group[l],
                                            w_router_expert[l], b_router_expert[l],
                                            w_e_gate[l], w_e_up[l], w_e_down[l])
    return x
```

```cpp
#include <hip/hip_runtime.h>
#include <cstdio>
#include <cstdint>

#ifndef N_LAUNCH_MODE
#define N_LAUNCH_MODE 0
#endif
#ifndef ENG_GEMM
#define ENG_GEMM 0
#endif
#ifndef ENG_ATTN
#define ENG_ATTN 0
#endif

#define GAS __attribute__((address_space(1)))
#define LAS __attribute__((address_space(3)))
typedef unsigned short bf16;
typedef float f32x4 __attribute__((ext_vector_type(4)));
typedef float f32x2 __attribute__((ext_vector_type(2)));
typedef unsigned u32x4 __attribute__((ext_vector_type(4)));
typedef unsigned u32x2 __attribute__((ext_vector_type(2)));
typedef short bf16x8 __attribute__((ext_vector_type(8)));

constexpr int BATCH = 8, SEQ = 8192, DM = 1024, NTOK = BATCH * SEQ;
constexpr int D_RWKV = 512, RWKV_COLS = 1792, MLA_COLS = 416, D_IN = 4256, N_IN_PAD = 4352;
constexpr int NH = 8, QKD = 96, NOPE = 64, ROPE = 32, VD = 64;
constexpr int NEXP = 32, DEXP = 256;
constexpr int MPAD = 139264;
constexpr float EPS = 1e-6f, LN_X_EPS = 64e-5f;
constexpr float QSCALE = 0.10206207261596577f * 1.4426950408889634f;

constexpr size_t MiB = 1u << 20;
constexpr size_t WS_CTL = 0, CTL_ZERO_BYTES = 1 * MiB;
constexpr size_t WS_MOD = 1 * MiB;
constexpr size_t WS_ROUTE = 2 * MiB;
constexpr size_t WS_CS = 4 * MiB;
constexpr size_t WS_WIN = 16 * MiB;
constexpr size_t WS_WBLK = 25 * MiB;
constexpr size_t WS_WG = WS_WBLK + 256 * 1024;
constexpr size_t WS_WUQ = WS_WG + 128 * 1024;
constexpr size_t WS_WUKV = WS_WUQ + 384 * 1024;
constexpr size_t WS_WB = 26 * MiB;
constexpr size_t WS_WO = 28 * MiB;
constexpr size_t WS_WGU = 30 * MiB;
constexpr size_t WS_WDN = 62 * MiB;
constexpr size_t WS_SG = 80 * MiB;
constexpr size_t WS_H2 = 80 * MiB;
constexpr size_t WS_ZR = 336 * MiB;
constexpr size_t WS_VC = 336 * MiB;
constexpr size_t WS_KC = 400 * MiB;
constexpr size_t WS_Y = 496 * MiB;
constexpr size_t WS_XG = 336 * MiB;
constexpr size_t WS_ZM = 560 * MiB;
constexpr size_t WS_YM = 560 * MiB;
constexpr size_t WS_H = 624 * MiB;
constexpr size_t WS_LW = 624 * MiB;
constexpr size_t WS_A = 688 * MiB;
constexpr size_t WS_MG = 624 * MiB;
constexpr size_t WS_HID = 608 * MiB;
constexpr size_t WS_R = 752 * MiB;
constexpr size_t WS_V = 816 * MiB;
constexpr size_t WS_ZK = 880 * MiB;
constexpr size_t WS_TWA = 944 * MiB;
constexpr size_t WS_SGL = 960 * MiB;
constexpr size_t WS_QA = 976 * MiB;
constexpr size_t WS_KVA = 1008 * MiB;
constexpr size_t WS_KK = 944 * MiB;
constexpr size_t WS_YS = 752 * MiB;
constexpr size_t WS_END = 1024 * MiB;
constexpr size_t DO_G = 0;
constexpr size_t DO_Q = 64 * MiB;
constexpr size_t DO_KN = 160 * MiB;

constexpr int CW_CNT = 64;
constexpr int CW_BAR = 4096;

constexpr int NWAVES = 8, NTHR = 512;
constexpr int LDS_BYTES = 155648;
constexpr int LDS_MISC = 151552;

__device__ __forceinline__ float bf2f(unsigned short h) { return __builtin_bit_cast(float, (unsigned)h << 16); }
__device__ __forceinline__ unsigned f2bf(float f) { unsigned u = __builtin_bit_cast(unsigned, f); return (u + 0x7fffu + ((u >> 16) & 1u)) >> 16; }
__device__ __forceinline__ unsigned pk2(float lo, float hi) { return f2bf(lo) | (f2bf(hi) << 16); }
__device__ __forceinline__ float lo2f(unsigned w) { return __builtin_bit_cast(float, w << 16); }
__device__ __forceinline__ float hi2f(unsigned w) { return __builtin_bit_cast(float, w & 0xffff0000u); }
__device__ __forceinline__ float wave_sum(float v) {
#pragma unroll
    for (int o = 1; o < 64; o <<= 1) v += __shfl_xor(v, o);
    return v;
}
__device__ __forceinline__ float sum8(float v) { v += __shfl_xor(v, 1); v += __shfl_xor(v, 2); v += __shfl_xor(v, 4); return v; }
__device__ __forceinline__ float sigmoidf_(float x) { return 1.f / (1.f + __expf(-x)); }
__device__ __forceinline__ float siluf_(float x) { return x / (1.f + __expf(-x)); }
__device__ __forceinline__ void unpack8(const u32x4 w, float (&v)[8]) {
    v[0] = lo2f(w.x); v[1] = hi2f(w.x); v[2] = lo2f(w.y); v[3] = hi2f(w.y); v[4] = lo2f(w.z); v[5] = hi2f(w.z); v[6] = lo2f(w.w); v[7] = hi2f(w.w);
}
__device__ __forceinline__ u32x4 pack8(const float (&v)[8]) { u32x4 w; w.x = pk2(v[0], v[1]); w.y = pk2(v[2], v[3]); w.z = pk2(v[4], v[5]); w.w = pk2(v[6], v[7]); return w; }

#define XB_TMO      128
#define XB_XCNT(j)  (256  + 64 * (j))
#define XB_XSUB(j)  (1280 + 64 * (j))
#define XB_XGEN(j)  (2304 + 64 * (j))
#define XB_TOP      3328
#define XB_TOPGEN   3392
#define XCD_BAR_WORDS 3456
#define XB_SPIN_CAP (1u << 22)
__device__ __forceinline__ unsigned xb_ld(unsigned* p)              { return __hip_atomic_load(p, __ATOMIC_RELAXED, __HIP_MEMORY_SCOPE_AGENT); }
__device__ __forceinline__ unsigned xb_add(unsigned* p, unsigned v) { return __hip_atomic_fetch_add(p, v, __ATOMIC_RELAXED, __HIP_MEMORY_SCOPE_AGENT); }
__device__ __forceinline__ unsigned xb_xcc_id() { return (unsigned)__builtin_amdgcn_s_getreg((3 << 11) | 20) & 0xFu; }
#define XB_SPIN(cond, bar) do { unsigned _sp = 0; while (cond) { __builtin_amdgcn_s_sleep(1); \
    if ((++_sp & 255u) == 0u) { if (xb_ld(&(bar)[XB_TMO])) break; if (_sp > XB_SPIN_CAP) { atomicAdd(&(bar)[XB_TMO], 1u); break; } } } } while (0)
struct XcdBarrier { unsigned* bar; unsigned x; volatile LAS unsigned* st; };
__device__ __forceinline__ XcdBarrier xcd_barrier_post(unsigned* bar, volatile LAS unsigned* st) {
    XcdBarrier b; b.bar = bar; b.x = xb_xcc_id(); b.st = st;
    if (threadIdx.x == 0) (void)xb_add(&bar[XB_XCNT(b.x)], 1u);
    return b;
}
__device__ __forceinline__ void xcd_barrier_complete(unsigned* bar, unsigned x, unsigned& nloc, unsigned& nx) {
    const unsigned G = gridDim.x * gridDim.y * gridDim.z;
    unsigned sum, cnt, mine, sp = 0u;
    for (;;) {
        sum = 0u; cnt = 0u; mine = 0u;
#pragma unroll
        for (unsigned j = 0; j < 16; ++j) { const unsigned c = xb_ld(&bar[XB_XCNT(j)]); sum += c; cnt += (c > 0u) ? 1u : 0u; mine = (j == x) ? c : mine; }
        if (sum == G) break;
        __builtin_amdgcn_s_sleep(1);
        if ((++sp & 255u) == 0u) { if (xb_ld(&bar[XB_TMO])) break; if (sp > XB_SPIN_CAP) { atomicAdd(&bar[XB_TMO], 1u); break; } }
    }
    nloc = mine > 0u ? mine : 1u; nx = cnt > 0u ? cnt : 1u;
}
__device__ __forceinline__ void xcd_barrier(const XcdBarrier& b) {
    asm volatile("s_waitcnt vmcnt(0)" ::: "memory");
    __syncthreads();
    if (threadIdx.x == 0) {
        unsigned* bar = b.bar;
        __builtin_amdgcn_s_waitcnt(0);
        unsigned nloc = b.st[0], nx = b.st[1];
        if (nloc == 0u) { xcd_barrier_complete(bar, b.x, nloc, nx); b.st[0] = nloc; b.st[1] = nx; }
        const unsigned old = xb_add(&bar[XB_XSUB(b.x)], 1u);
        const unsigned gen = old / nloc;
        if (old + 1u == (gen + 1u) * nloc) {
            __builtin_amdgcn_fence(__ATOMIC_RELEASE, "agent");
            asm volatile("s_waitcnt vmcnt(0)" ::: "memory");
            const unsigned og = xb_add(&bar[XB_TOP], 1u);
            const unsigned tg = og / nx;
            if (og + 1u == (tg + 1u) * nx) xb_add(&bar[XB_TOPGEN], 1u);
            else XB_SPIN(xb_ld(&bar[XB_TOPGEN]) == tg, bar);
            __builtin_amdgcn_fence(__ATOMIC_ACQUIRE, "agent");
            xb_add(&bar[XB_XGEN(b.x)], 1u);
            asm volatile("s_waitcnt vmcnt(0)" ::: "memory");
        } else {
            XB_SPIN(xb_ld(&bar[XB_XGEN(b.x)]) == gen, bar);
            __builtin_amdgcn_fence(__ATOMIC_ACQUIRE, "agent");
            asm volatile("s_waitcnt vmcnt(0)" ::: "memory");
        }
    }
    __syncthreads();
}

struct Args {
    const float* in[34]; float* out; unsigned char* ws; int ph_lo, ph_hi;
};
struct Frame {
    LAS unsigned char* lds;
    int tid, lane, wave, vcu, G, gw, NGW;
    unsigned char* ws; unsigned char* dob;
};
enum { I_X = 0, I_C, I_POS, I_WADA, I_BADA, I_GMIX, I_WIN, I_MU, I_W0, I_WDEC, I_A0, I_WAUP, I_WGUP, I_KK, I_KA, I_RK, I_LNW, I_LNB, I_GQA, I_WUQ, I_GKVA, I_WUKV,
       I_QN, I_KN, I_WBR, I_WOUT, I_GFFN, I_WRG, I_BRG, I_WRE, I_BRE, I_WEG, I_WEU, I_WED };

struct Unit { int pm, pn; };
struct Gemm { const bf16* A; const bf16* Bt; int M, N, K; };
constexpr int NXCD = 8, WGM = 8;
struct StaticOrder {
    int nM, nN, nwg, G, c;
    __device__ void init(int M, int N, int G_, int c_) { nM = M / 256; nN = N / 256; nwg = nM * nN; G = G_; c = c_; }
    __device__ bool next(int i, Unit& u) const {
        const long L = (long)i * G + c; if (L >= nwg) return false;
        int wgid = (int)L; { const int q = nwg / NXCD, r = nwg % NXCD, xcd = wgid % NXCD, off = wgid / NXCD; wgid = (xcd < r ? xcd * (q + 1) : r * (q + 1) + (xcd - r) * q) + off; }
        const int nig = WGM * nN, gid = wgid / nig, fm = gid * WGM, gsz = (nM - fm) < WGM ? (nM - fm) : WGM;
        u.pm = fm + ((wgid % nig) % gsz); u.pn = (wgid % nig) / gsz; return true;
    }
};
struct TableOrder {
    const LAS int* texp; int ntiles, nN, G, c;
    __device__ bool next(int i, Unit& u) const {
        const long L = (long)i * G + c; if (L >= (long)ntiles * nN) return false;
        const int t = (int)(L / nN), j = (int)(L % nN); u.pm = t; u.pn = texp[t] * nN + j; return true;
    }
};

template <class Epi, class Sched>
__device__ __forceinline__ void gemm_phase_naive(LAS unsigned char* lds, const Gemm g, const Sched& S, const Epi& E) {
    const int tid = threadIdx.x, ty = tid >> 5, tx = tid & 31;
    LAS bf16* As = (LAS bf16*)lds; LAS bf16* Bs = (LAS bf16*)(lds + 128 * 40 * 2);
    Unit u;
    for (int i = 0; S.next(i, u); ++i) {
        for (int half = 0; half < 2; ++half) {
            float acc[8][8];
#pragma unroll
            for (int r = 0; r < 8; ++r)
#pragma unroll
                for (int c = 0; c < 8; ++c) acc[r][c] = 0.f;
            const bf16* Ab = g.A + ((size_t)u.pm * 256 + half * 128) * g.K; const bf16* Bb = g.Bt + (size_t)u.pn * 256 * g.K;
            for (int k0 = 0; k0 < g.K; k0 += 32) {
                __syncthreads();
                { const int r = tid >> 2, c8 = (tid & 3) * 8; *(LAS u32x4*)(As + r * 40 + c8) = *(const u32x4*)(Ab + (size_t)r * g.K + k0 + c8); }
#pragma unroll
                for (int j = 0; j < 2; ++j) { const int ch = tid + j * 512, r = ch >> 2, c8 = (ch & 3) * 8; *(LAS u32x4*)(Bs + r * 40 + c8) = *(const u32x4*)(Bb + (size_t)r * g.K + k0 + c8); }
                __syncthreads();
#pragma unroll 2
                for (int k = 0; k < 32; k += 2) {
                    float b0[8], b1[8];
#pragma unroll
                    for (int c = 0; c < 8; ++c) { const unsigned w = *(const LAS unsigned*)(Bs + (tx * 8 + c) * 40 + k); b0[c] = lo2f(w); b1[c] = hi2f(w); }
#pragma unroll
                    for (int r = 0; r < 8; ++r) { const unsigned w = *(const LAS unsigned*)(As + (ty * 8 + r) * 40 + k); const float a0 = lo2f(w), a1 = hi2f(w);
#pragma unroll
                        for (int c = 0; c < 8; ++c) acc[r][c] = fmaf(a1, b1[c], fmaf(a0, b0[c], acc[r][c])); }
                }
            }
#pragma unroll
            for (int r = 0; r < 8; ++r) E.store8(u, half * 128 + ty * 8 + r, tx * 8, acc[r]);
        }
    }
    __syncthreads();
}

struct EpiZ { bf16 *ZR, *SG, *ZM;
    __device__ __forceinline__ void store8(const Unit& u, int r, int c, const float (&v)[8]) const {
        const size_t row = (size_t)u.pm * 256 + r;
        if (u.pn < 7) { *(u32x4*)(ZR + row * 1792 + u.pn * 256 + c) = pack8(v); }
        else if (u.pn < 15) { float s[8];
#pragma unroll
            for (int i = 0; i < 8; ++i) s[i] = sigmoidf_(v[i]);
            *(u32x4*)(SG + row * 2048 + (u.pn - 7) * 256 + c) = pack8(s); }
        else { *(u32x4*)(ZM + row * 512 + (u.pn - 15) * 256 + c) = pack8(v); }
    } };
struct EpiLora { bf16 *LW, *A; const float *w0, *a0;
    __device__ __forceinline__ void store8(const Unit& u, int r, int c, const float (&v)[8]) const {
        const size_t row = (size_t)u.pm * 256 + r; const int col = u.pn * 256 + c; float o[8];
        if (col < 512) {
#pragma unroll
            for (int i = 0; i < 8; ++i) { const float x = -(w0[col + i] + v[i]); const float sp = (x > 20.f) ? x : log1pf(__expf(x)); o[i] = -__expf(-sp - 0.5f); }
            *(u32x4*)(LW + row * 512 + col) = pack8(o);
        } else {
#pragma unroll
            for (int i = 0; i < 8; ++i) o[i] = sigmoidf_(a0[col - 512 + i] + v[i]);
            *(u32x4*)(A + row * 512 + col - 512) = pack8(o);
        }
    } };
struct EpiPlain { bf16* O0; bf16* O1; int split, ld0, ld1;
    __device__ __forceinline__ void store8(const Unit& u, int r, int c, const float (&v)[8]) const {
        const size_t row = (size_t)u.pm * 256 + r; int col = u.pn * 256 + c;
        if (col < split) *(u32x4*)(O0 + row * ld0 + col) = pack8(v); else *(u32x4*)(O1 + row * ld1 + col - split) = pack8(v);
    } };
template <bool ACCUM> struct EpiBranch { bf16* MG; const bf16* SG; int goff;
    __device__ __forceinline__ void store8(const Unit& u, int r, int c, const float (&v)[8]) const {
        const size_t row = (size_t)u.pm * 256 + r; const int col = u.pn * 256 + c; float gt[8], o[8];
        unpack8(*(const u32x4*)(SG + row * 2048 + goff + col), gt);
        if (ACCUM) { float p[8]; unpack8(*(const u32x4*)(MG + row * 1024 + col), p);
#pragma unroll
            for (int i = 0; i < 8; ++i) o[i] = p[i] + gt[i] * v[i]; }
        else {
#pragma unroll
            for (int i = 0; i < 8; ++i) o[i] = gt[i] * v[i]; }
        *(u32x4*)(MG + row * 1024 + col) = pack8(o);
    } };
struct EpiOut { float* X1; const float* x; const float* mod;
    __device__ __forceinline__ void store8(const Unit& u, int r, int c, const float (&v)[8]) const {
        const size_t row = (size_t)u.pm * 256 + r; const int col = u.pn * 256 + c; const int b = (int)(row / SEQ);
        const float* gt = mod + b * 6144 + 2048 + col; const float* xr = x + row * 1024 + col; float* o = X1 + row * 1024 + col;
        const f32x4 g0 = *(const f32x4*)gt, g1 = *(const f32x4*)(gt + 4), x0 = *(const f32x4*)xr, x1 = *(const f32x4*)(xr + 4);
        *(f32x4*)o = (f32x4){x0.x + g0.x * v[0], x0.y + g0.y * v[1], x0.z + g0.z * v[2], x0.w + g0.w * v[3]};
        *(f32x4*)(o + 4) = (f32x4){x1.x + g1.x * v[4], x1.y + g1.y * v[5], x1.z + g1.z * v[6], x1.w + g1.w * v[7]};
    } };
struct EpiGateUp { bf16* HID;
    __device__ __forceinline__ void store8(const Unit& u, int r, int c, const float (&v)[8]) const {
        const size_t row = (size_t)u.pm * 256 + r; const int col = ((u.pn & 1) * 256 + c) >> 1;
        u32x2 w; w.x = pk2(siluf_(v[0]) * v[4], siluf_(v[1]) * v[5]); w.y = pk2(siluf_(v[2]) * v[6], siluf_(v[3]) * v[7]);
        *(u32x2*)(HID + row * 256 + col) = w;
    } };
struct EpiDown { bf16* YS;
    __device__ __forceinline__ void store8(const Unit& u, int r, int c, const float (&v)[8]) const {
        const size_t row = (size_t)u.pm * 256 + r; *(u32x4*)(YS + row * 1024 + (u.pn & 3) * 256 + c) = pack8(v);
    } };

template <class Epi, class Sched>
__device__ __forceinline__ void gemm_phase_any(LAS unsigned char* lds, const Gemm g, const Sched& S, const Epi& E) {
    gemm_phase_naive<Epi, Sched>(lds, g, S, E);
}

template <class RowMap>
__device__ __forceinline__ void transpose_item(const float* W, int ldw, bf16* WT, int ldt, int koff, int k0, int n0, const RowMap& rm, LAS float* scr, int lane) {
#pragma unroll 8
    for (int i = 0; i < 32; ++i) { const int kk = 2 * i + (lane >> 5); scr[kk * 33 + (lane & 31)] = W[(size_t)(k0 + kk) * ldw + n0 + (lane & 31)]; }
    asm volatile("s_waitcnt lgkmcnt(0)" ::: "memory");
    const int c = lane & 7;
#pragma unroll
    for (int j = 0; j < 4; ++j) { const int n = (lane >> 3) + 8 * j; const LAS float* s = scr + (8 * c) * 33 + n;
        u32x4 o; o.x = pk2(s[0 * 33], s[1 * 33]); o.y = pk2(s[2 * 33], s[3 * 33]); o.z = pk2(s[4 * 33], s[5 * 33]); o.w = pk2(s[6 * 33], s[7 * 33]);
        *(u32x4*)(WT + (size_t)rm(n0 + n) * ldt + koff + k0 + 8 * c) = o; }
    asm volatile("s_waitcnt lgkmcnt(0)" ::: "memory");
}
struct RmId { int off; __device__ int operator()(int n) const { return off + n; } };
struct RmWin { __device__ int operator()(int n) const { return n < 1792 ? n : (n < 2208 ? 3840 + (n - 1792) : 1792 + (n - 2208)); } };
struct RmUkv { __device__ int operator()(int n) const { const int h = n >> 7, j = n & 127; return j < 64 ? h * 64 + j : 512 + h * 64 + (j - 64); } };
struct RmGU { int off; __device__ int operator()(int j) const { return off + 8 * (j >> 2) + (j & 3); } };

__device__ __forceinline__ void p0_prologue(const Frame& F, const Args& a) {
    LAS float* scr = (LAS float*)(F.lds + F.wave * 16384);
    const int lane = F.lane;
    bf16* Win = (bf16*)(F.ws + WS_WIN); bf16* Wblk = (bf16*)(F.ws + WS_WBLK); bf16* Wg = (bf16*)(F.ws + WS_WG); bf16* Wuq = (bf16*)(F.ws + WS_WUQ);
    bf16* Wukv = (bf16*)(F.ws + WS_WUKV); bf16* Wb = (bf16*)(F.ws + WS_WB); bf16* Wo = (bf16*)(F.ws + WS_WO); bf16* Wgu = (bf16*)(F.ws + WS_WGU); bf16* Wdn = (bf16*)(F.ws + WS_WDN);
    constexpr int I_IN = 16 * 133, I_DEC = 1 * 16, I_AUP = 16, I_GUP = 2 * 16, I_UQ = 4 * 24, I_UKV = 2 * 32, I_BR = 2 * 8 * 32, I_O = 16 * 32;
    constexpr int I_EG = 32 * 16 * 8, I_EU = I_EG, I_ED = 32 * 4 * 32;
    constexpr int NITEMS = I_IN + I_DEC + I_AUP + I_GUP + I_UQ + I_UKV + I_BR + I_O + I_EG + I_EU + I_ED;
    for (int it = F.gw; it < NITEMS; it += F.NGW) {
        int r = it;
        if (r < I_IN) { const int kb = r / 133, nb = r % 133; transpose_item(a.in[I_WIN], D_IN, Win, 1024, 0, 64 * kb, 32 * nb, RmWin{}, scr, lane); continue; } r -= I_IN;
        if (r < I_DEC) { transpose_item(a.in[I_WDEC], 512, Wblk, 128, 0, 0, 32 * r, RmId{0}, scr, lane); continue; } r -= I_DEC;
        if (r < I_AUP) { transpose_item(a.in[I_WAUP], 512, Wblk, 128, 64, 0, 32 * r, RmId{512}, scr, lane); continue; } r -= I_AUP;
        if (r < I_GUP) { const int kb = r / 16, nb = r % 16; transpose_item(a.in[I_WGUP], 512, Wg, 128, 0, 64 * kb, 32 * nb, RmId{0}, scr, lane); continue; } r -= I_GUP;
        if (r < I_UQ) { const int kb = r / 24, nb = r % 24; transpose_item(a.in[I_WUQ], 768, Wuq, 256, 0, 64 * kb, 32 * nb, RmId{0}, scr, lane); continue; } r -= I_UQ;
        if (r < I_UKV) { const int kb = r / 32, nb = r % 32; transpose_item(a.in[I_WUKV], 1024, Wukv, 128, 0, 64 * kb, 32 * nb, RmUkv{}, scr, lane); continue; } r -= I_UKV;
        if (r < I_BR) { const int br = r / 256, q = r % 256, kb = q / 32, nb = q % 32; transpose_item(a.in[I_WBR] + (size_t)br * 512 * 1024, 1024, Wb + (size_t)br * 1024 * 512, 512, 0, 64 * kb, 32 * nb, RmId{0}, scr, lane); continue; } r -= I_BR;
        if (r < I_O) { const int kb = r / 32, nb = r % 32; transpose_item(a.in[I_WOUT], 1024, Wo, 1024, 0, 64 * kb, 32 * nb, RmId{0}, scr, lane); continue; } r -= I_O;
        if (r < I_EG) { const int e = r / 128, q = r % 128, kb = q / 8, nb = q % 8; transpose_item(a.in[I_WEG] + (size_t)e * 1024 * 256, 256, Wgu + (size_t)e * 512 * 1024, 1024, 0, 64 * kb, 32 * nb, RmGU{0}, scr, lane); continue; } r -= I_EG;
        if (r < I_EU) { const int e = r / 128, q = r % 128, kb = q / 8, nb = q % 8; transpose_item(a.in[I_WEU] + (size_t)e * 1024 * 256, 256, Wgu + (size_t)e * 512 * 1024, 1024, 0, 64 * kb, 32 * nb, RmGU{4}, scr, lane); continue; } r -= I_EU;
        { const int e = r / 128, q = r % 128, kb = q / 32, nb = q % 32; transpose_item(a.in[I_WED] + (size_t)e * 256 * 1024, 1024, Wdn + (size_t)e * 1024 * 256, 256, 0, 64 * kb, 32 * nb, RmId{0}, scr, lane); }
    }
    for (int i = F.gw * 64 + lane; i < 96 * 128; i += F.NGW * 64) *(u32x4*)(Win + (size_t)4256 * 1024 + (size_t)i * 8) = (u32x4){0u, 0u, 0u, 0u};
    for (int i = F.gw * 64 + lane; i < 1024 * 8; i += F.NGW * 64) { const int row = i >> 3, c8 = (i & 7) * 8; *(u32x4*)(Wblk + row * 128 + (row < 512 ? 64 : 0) + c8) = (u32x4){0u, 0u, 0u, 0u}; }
    { const int* pos = (const int*)a.in[I_POS]; float* cs = (float*)(F.ws + WS_CS);
      for (int i = F.gw * 64 + lane; i < NTOK * 16; i += F.NGW * 64) { const int t = i >> 4, j = i & 15;
          const float fr = exp2f(-(float)j * (13.287712379549449f / 16.0f));
          const float ang = (float)pos[t] * fr; cs[t * 32 + j] = cosf(ang); cs[t * 32 + 16 + j] = sinf(ang); } }
    { float* mod = (float*)(F.ws + WS_MOD); const float* c = a.in[I_C]; const float* wa = a.in[I_WADA]; const float* ba = a.in[I_BADA];
      LAS float* red = (LAS float*)(F.lds + 8 * 16384);
      for (int nb = F.vcu; nb < 96; nb += F.G) {
          float acc[8];
#pragma unroll
          for (int b = 0; b < 8; ++b) acc[b] = 0.f;
          const int n = nb * 64 + lane;
          for (int k = F.wave * 128; k < F.wave * 128 + 128; ++k) { const float w = wa[(size_t)k * 6144 + n];
#pragma unroll
              for (int b = 0; b < 8; ++b) acc[b] = fmaf(siluf_(c[b * 1024 + k]), w, acc[b]); }
#pragma unroll
          for (int b = 0; b < 8; ++b) red[(F.wave * 8 + b) * 64 + lane] = acc[b];
          __syncthreads();
          { const int b = F.wave; float s = ba[n];
#pragma unroll
            for (int w = 0; w < 8; ++w) s += red[(w * 8 + b) * 64 + lane];
            mod[b * 6144 + n] = s; }
          __syncthreads();
      } }
}

__device__ __forceinline__ void p_normmod(const Frame& F, const float* x, const float* g, const float* mod, int sh_off, int sc_off, bf16* H) {
    for (int m = F.gw; m < NTOK; m += F.NGW) {
        const int b = m / SEQ; const f32x4* xr = (const f32x4*)(x + (size_t)m * 1024) + F.lane;
        f32x4 v[4]; float s = 0.f;
#pragma unroll
        for (int j = 0; j < 4; ++j) { v[j] = xr[64 * j]; s += (v[j].x * v[j].x + v[j].y * v[j].y) + (v[j].z * v[j].z + v[j].w * v[j].w); }
        const float rstd = 1.0f / sqrtf(wave_sum(s) * (1.f / 1024.f) + EPS);
        u32x2* o = (u32x2*)(H + (size_t)m * 1024) + F.lane;
#pragma unroll
        for (int j = 0; j < 4; ++j) { const int col = 4 * F.lane + 256 * j;
            const f32x4 gg = *(const f32x4*)(g + col), sc = *(const f32x4*)(mod + b * 6144 + sc_off + col), sh = *(const f32x4*)(mod + b * 6144 + sh_off + col);
            const f32x4 y = v[j] * rstd * gg * (sc + 1.0f) + sh; u32x2 w; w.x = pk2(y.x, y.y); w.y = pk2(y.z, y.w); o[64 * j] = w; }
    }
}

__device__ __forceinline__ void p_prep_a(const Frame& F, const Args& a) {
    const bf16* ZR = (const bf16*)(F.ws + WS_ZR); const bf16* ZM = (const bf16*)(F.ws + WS_ZM);
    bf16* R = (bf16*)(F.ws + WS_R); bf16* V = (bf16*)(F.ws + WS_V); bf16* ZK = (bf16*)(F.ws + WS_ZK);
    bf16* TWA = (bf16*)(F.ws + WS_TWA); bf16* SGL = (bf16*)(F.ws + WS_SGL); bf16* QA = (bf16*)(F.ws + WS_QA); bf16* KVA = (bf16*)(F.ws + WS_KVA);
    const float* mu = a.in[I_MU]; const float* gqa = a.in[I_GQA]; const float* gkva = a.in[I_GKVA];
    const int lane = F.lane;
    for (int m = F.gw; m < NTOK; m += F.NGW) {
        const bool first = (m % SEQ) == 0;
        const u32x2* zc = (const u32x2*)(ZR + (size_t)m * 1792) + lane; const u32x2* zp = (const u32x2*)(ZR + (size_t)(first ? m : m - 1) * 1792) + lane;
#pragma unroll
        for (int ch = 0; ch < 7; ++ch) {
            const u32x2 c = zc[64 * ch]; u32x2 p = zp[64 * ch]; if (first) { p.x = 0u; p.y = 0u; }
            const f32x4 mm = *(const f32x4*)(mu + 256 * ch + 4 * lane);
            float z[4] = {lo2f(c.x), hi2f(c.x), lo2f(c.y), hi2f(c.y)}; const float q[4] = {lo2f(p.x), hi2f(p.x), lo2f(p.y), hi2f(p.y)};
            z[0] += (q[0] - z[0]) * mm.x; z[1] += (q[1] - z[1]) * mm.y; z[2] += (q[2] - z[2]) * mm.z; z[3] += (q[3] - z[3]) * mm.w;
            if (ch < 6) { bf16* dst = (ch < 2) ? R : (ch < 4 ? ZK : V); u32x2 w; w.x = pk2(z[0], z[1]); w.y = pk2(z[2], z[3]);
                *((u32x2*)(dst + (size_t)m * 512 + 256 * (ch & 1)) + lane) = w; }
            else {
                if (lane < 16) { u32x2 w; w.x = pk2(tanhf(z[0]), tanhf(z[1])); w.y = pk2(tanhf(z[2]), tanhf(z[3])); *((u32x2*)(TWA + (size_t)m * 128) + lane) = w; }
                else if (lane < 32) { u32x2 w; w.x = pk2(z[0], z[1]); w.y = pk2(z[2], z[3]); *((u32x2*)(TWA + (size_t)m * 128) + lane) = w; }
                else { u32x2 w; w.x = pk2(sigmoidf_(z[0]), sigmoidf_(z[1])); w.y = pk2(sigmoidf_(z[2]), sigmoidf_(z[3])); *((u32x2*)(SGL + (size_t)m * 128) + (lane - 32)) = w; }
            }
        }
        { const u32x2 c = *((const u32x2*)(ZM + (size_t)m * 512) + lane); const float z[4] = {lo2f(c.x), hi2f(c.x), lo2f(c.y), hi2f(c.y)};
          const float rstd = 1.0f / sqrtf(wave_sum((z[0] * z[0] + z[1] * z[1]) + (z[2] * z[2] + z[3] * z[3])) * (1.f / 256.f) + EPS);
          const f32x4 gg = *(const f32x4*)(gqa + 4 * lane); u32x2 w; w.x = pk2(z[0] * rstd * gg.x, z[1] * rstd * gg.y); w.y = pk2(z[2] * rstd * gg.z, z[3] * rstd * gg.w);
          *((u32x2*)(QA + (size_t)m * 256) + lane) = w; }
        { u32x2 c = (u32x2){0u, 0u}; if (lane < 32) c = *((const u32x2*)(ZM + (size_t)m * 512 + 256) + lane); const float z[4] = {lo2f(c.x), hi2f(c.x), lo2f(c.y), hi2f(c.y)};
          const float rstd = 1.0f / sqrtf(wave_sum((z[0] * z[0] + z[1] * z[1]) + (z[2] * z[2] + z[3] * z[3])) * (1.f / 128.f) + EPS);
          if (lane < 32) { const f32x4 gg = *(const f32x4*)(gkva + 4 * lane); u32x2 w; w.x = pk2(z[0] * rstd * gg.x, z[1] * rstd * gg.y); w.y = pk2(z[2] * rstd * gg.z, z[3] * rstd * gg.w);
              *((u32x2*)(KVA + (size_t)m * 128) + lane) = w; } }
    }
}

__device__ __forceinline__ void p_prep_c(const Frame& F, const Args& a) {
    bf16* ZK = (bf16*)(F.ws + WS_ZK); bf16* A = (bf16*)(F.ws + WS_A); bf16* KK = (bf16*)(F.ws + WS_KK);
    bf16* Q = (bf16*)(F.dob + DO_Q); const bf16* KN = (const bf16*)(F.dob + DO_KN); const bf16* ZM = (const bf16*)(F.ws + WS_ZM); bf16* KC = (bf16*)(F.ws + WS_KC);
    const float* cs = (const float*)(F.ws + WS_CS);
    const float* k_k = a.in[I_KK]; const float* k_a = a.in[I_KA]; const float* qn = a.in[I_QN]; const float* kn = a.in[I_KN];
    const int lane = F.lane, hd = lane >> 3, j = lane & 7;
    for (int m = F.gw; m < NTOK; m += F.NGW) {
        { float zk[8], av[8], ko[8], kr[8], bo[8]; unpack8(*((const u32x4*)(ZK + (size_t)m * 512) + lane), zk); unpack8(*((const u32x4*)(A + (size_t)m * 512) + lane), av);
          float ss = 0.f;
#pragma unroll
          for (int i = 0; i < 8; ++i) { const int col = 8 * lane + i; ko[i] = zk[i] * (1.f + (av[i] - 1.f) * k_a[col]); kr[i] = zk[i] * k_k[col]; ss += kr[i] * kr[i]; }
          const float inv = 1.0f / fmaxf(sqrtf(sum8(ss)), 1e-12f);
#pragma unroll
          for (int i = 0; i < 8; ++i) { kr[i] *= inv; bo[i] = kr[i] * av[i]; }
          *((u32x4*)(ZK + (size_t)m * 512) + lane) = pack8(ko); *((u32x4*)(KK + (size_t)m * 512) + lane) = pack8(kr); *((u32x4*)(A + (size_t)m * 512) + lane) = pack8(bo); }
        const f32x2 cc = *(const f32x2*)(cs + (size_t)m * 32 + 2 * j), sn = *(const f32x2*)(cs + (size_t)m * 32 + 16 + 2 * j);
        { bf16* qp = Q + (size_t)m * 768 + hd * 96; float v[8]; unpack8(*(const u32x4*)(qp + 8 * j), v);
          const unsigned w1 = *(const unsigned*)(qp + 64 + 2 * j), w2 = *(const unsigned*)(qp + 80 + 2 * j); float x1[2] = {lo2f(w1), hi2f(w1)}, x2[2] = {lo2f(w2), hi2f(w2)};
          float ss = (x1[0] * x1[0] + x1[1] * x1[1]) + (x2[0] * x2[0] + x2[1] * x2[1]);
#pragma unroll
          for (int i = 0; i < 8; ++i) ss += v[i] * v[i];
          const float rstd = 1.0f / sqrtf(sum8(ss) * (1.f / 96.f) + EPS);
#pragma unroll
          for (int i = 0; i < 8; ++i) v[i] = v[i] * rstd * qn[8 * j + i] * QSCALE;
          x1[0] *= rstd * qn[64 + 2 * j]; x1[1] *= rstd * qn[65 + 2 * j]; x2[0] *= rstd * qn[80 + 2 * j]; x2[1] *= rstd * qn[81 + 2 * j];
          const float o1a = (x1[0] * cc.x - x2[0] * sn.x) * QSCALE, o1b = (x1[1] * cc.y - x2[1] * sn.y) * QSCALE, o2a = (x2[0] * cc.x + x1[0] * sn.x) * QSCALE, o2b = (x2[1] * cc.y + x1[1] * sn.y) * QSCALE;
          *(u32x4*)(qp + 8 * j) = pack8(v); *(unsigned*)(qp + 64 + 2 * j) = pk2(o1a, o1b); *(unsigned*)(qp + 80 + 2 * j) = pk2(o2a, o2b); }
        { float v[8]; unpack8(*(const u32x4*)(KN + (size_t)m * 512 + hd * 64 + 8 * j), v);
          const unsigned w1 = *(const unsigned*)(ZM + (size_t)m * 512 + 384 + 2 * j), w2 = *(const unsigned*)(ZM + (size_t)m * 512 + 400 + 2 * j); float x1[2] = {lo2f(w1), hi2f(w1)}, x2[2] = {lo2f(w2), hi2f(w2)};
          float ss = (x1[0] * x1[0] + x1[1] * x1[1]) + (x2[0] * x2[0] + x2[1] * x2[1]);
#pragma unroll
          for (int i = 0; i < 8; ++i) ss += v[i] * v[i];
          const float rstd = 1.0f / sqrtf(sum8(ss) * (1.f / 96.f) + EPS);
#pragma unroll
          for (int i = 0; i < 8; ++i) v[i] = v[i] * rstd * kn[8 * j + i];
          x1[0] *= rstd * kn[64 + 2 * j]; x1[1] *= rstd * kn[65 + 2 * j]; x2[0] *= rstd * kn[80 + 2 * j]; x2[1] *= rstd * kn[81 + 2 * j];
          bf16* kp = KC + (size_t)m * 768 + hd * 96;
          *(u32x4*)(kp + 8 * j) = pack8(v); *(unsigned*)(kp + 64 + 2 * j) = pk2(x1[0] * cc.x - x2[0] * sn.x, x1[1] * cc.y - x2[1] * sn.y);
          *(unsigned*)(kp + 80 + 2 * j) = pk2(x2[0] * cc.x + x1[0] * sn.x, x2[1] * cc.y + x1[1] * sn.y); }
    }
}

constexpr int SC_T = 32;
constexpr int SC_BUF = 5 * SC_T * 64 * 4 + SC_T * 16 * 4 + SC_T * 16 * 4;
template <int CTRL> __device__ __forceinline__ float dpp_add(float x) { return x + __builtin_bit_cast(float, __builtin_amdgcn_update_dpp(0, __builtin_bit_cast(int, x), CTRL, 0xf, 0xf, false)); }
__device__ __forceinline__ float allsum16(float x) { x = dpp_add<0xB1>(x); x = dpp_add<0x4E>(x); x = dpp_add<0x141>(x); x = dpp_add<0x140>(x); return x; }
__device__ __forceinline__ void p_scan(const Frame& F) {
    const bf16* R = (const bf16*)(F.ws + WS_R); const bf16* K = (const bf16*)(F.ws + WS_ZK); const bf16* V = (const bf16*)(F.ws + WS_V);
    const bf16* KK = (const bf16*)(F.ws + WS_KK); const bf16* B = (const bf16*)(F.ws + WS_A); const bf16* LW = (const bf16*)(F.ws + WS_LW); bf16* Y = (bf16*)(F.ws + WS_Y);
    const int lane = F.lane, wave = F.wave, tid = F.tid;
    for (int item = F.vcu; item < 256; item += F.G) {
        const int bh = item >> 2, qt = item & 3, b = bh >> 3, h = bh & 7;
        const size_t row0 = (size_t)b * SEQ; const int colh = h * 64;
        float S0 = 0.f, S1 = 0.f, S2 = 0.f, S3 = 0.f;
        const int NCH = SEQ / SC_T;
        __syncthreads();
        for (int c = 0; c <= NCH + 1; ++c) {
            LAS unsigned char* bs = F.lds + (c & 1) * SC_BUF;
            LAS unsigned char* bc = F.lds + ((c + 1) & 1) * SC_BUF;
            if (wave >= 4) {
                const int lt = tid - 256;
                if (c >= 2 && lt < 64) { const int st = lt >> 1, hf = lt & 1; const LAS float* yy = (const LAS float*)(bs + 5 * SC_T * 256 + SC_T * 64) + st * 16 + hf * 8;
                    float v[8];
#pragma unroll
                    for (int i = 0; i < 8; ++i) v[i] = yy[i];
                    *(u32x4*)(Y + (row0 + (size_t)(c - 2) * SC_T + st) * 512 + colh + qt * 16 + hf * 8) = pack8(v); }
                if (c < NCH) {
                    const int st = lt >> 3, j8 = (lt & 7) * 8; const size_t g = (row0 + (size_t)c * SC_T + st) * 512 + colh + j8;
                    float v[8]; LAS float* dst = (LAS float*)bs + st * 64 + j8;
                    unpack8(*(const u32x4*)(LW + g), v);
#pragma unroll
                    for (int i = 0; i < 8; ++i) dst[i] = __expf(v[i]);
                    unpack8(*(const u32x4*)(KK + g), v);
#pragma unroll
                    for (int i = 0; i < 8; ++i) dst[SC_T * 64 + i] = -v[i];
                    unpack8(*(const u32x4*)(B + g), v);
#pragma unroll
                    for (int i = 0; i < 8; ++i) dst[2 * SC_T * 64 + i] = v[i];
                    unpack8(*(const u32x4*)(K + g), v);
#pragma unroll
                    for (int i = 0; i < 8; ++i) dst[3 * SC_T * 64 + i] = v[i];
                    unpack8(*(const u32x4*)(R + g), v);
#pragma unroll
                    for (int i = 0; i < 8; ++i) dst[4 * SC_T * 64 + i] = v[i];
                    if (lt < 64) { const int s2 = lt >> 1, hf = lt & 1; unpack8(*(const u32x4*)(V + (row0 + (size_t)c * SC_T + s2) * 512 + colh + qt * 16 + hf * 8), v);
                        LAS float* dv = (LAS float*)(bs + 5 * SC_T * 256) + s2 * 16 + hf * 8;
#pragma unroll
                        for (int i = 0; i < 8; ++i) dv[i] = v[i]; }
                }
            } else if (c >= 1 && c <= NCH) {
                const int rg = lane >> 4, jl = lane & 15;
                const LAS float* base = (const LAS float*)bc + 4 * jl;
                const LAS float* vb = (const LAS float*)(bc + 5 * SC_T * 256) + wave * 4 + rg;
                LAS float* yb = (LAS float*)(bc + 5 * SC_T * 256 + SC_T * 64) + wave * 4 + rg;
#pragma unroll 4
                for (int st = 0; st < SC_T; ++st) {
                    const f32x4 w = *(const LAS f32x4*)(base + st * 64), nk = *(const LAS f32x4*)(base + SC_T * 64 + st * 64), bb = *(const LAS f32x4*)(base + 2 * SC_T * 64 + st * 64),
                                kv = *(const LAS f32x4*)(base + 3 * SC_T * 64 + st * 64), rr = *(const LAS f32x4*)(base + 4 * SC_T * 64 + st * 64);
                    const float v = vb[st * 16];
                    float sa = (S0 * nk.x + S1 * nk.y) + (S2 * nk.z + S3 * nk.w);
                    sa = allsum16(sa);
                    S0 = fmaf(S0, w.x, fmaf(sa, bb.x, v * kv.x)); S1 = fmaf(S1, w.y, fmaf(sa, bb.y, v * kv.y));
                    S2 = fmaf(S2, w.z, fmaf(sa, bb.z, v * kv.z)); S3 = fmaf(S3, w.w, fmaf(sa, bb.w, v * kv.w));
                    float y = (S0 * rr.x + S1 * rr.y) + (S2 * rr.z + S3 * rr.w);
                    y = allsum16(y);
                    if (jl == 0) yb[st * 16] = y;
                }
            }
            __syncthreads();
        }
    }
}

__device__ __forceinline__ void p_attn_naive(const Frame& F) {
    const bf16* Q = (const bf16*)(F.dob + DO_Q); const bf16* KC = (const bf16*)(F.ws + WS_KC); const bf16* VC = (const bf16*)(F.ws + WS_VC); bf16* YM = (bf16*)(F.ws + WS_YM);
    LAS float* Ks = (LAS float*)F.lds; LAS float* Vs = (LAS float*)(F.lds + 32 * 96 * 4);
    const int tid = F.tid;
    for (int unit = F.vcu; unit < 64 * 16; unit += F.G) {
        const int bh = unit >> 4, qb = 15 - (unit & 15), b = bh >> 3, h = bh & 7; const size_t row0 = (size_t)b * SEQ; const int t = qb * 512 + tid;
        unsigned qp[48];
        { const u32x4* qg = (const u32x4*)(Q + (row0 + t) * 768 + h * 96);
#pragma unroll
          for (int i = 0; i < 12; ++i) { const u32x4 w = qg[i]; qp[4 * i] = w.x; qp[4 * i + 1] = w.y; qp[4 * i + 2] = w.z; qp[4 * i + 3] = w.w; } }
        float o[64];
#pragma unroll
        for (int i = 0; i < 64; ++i) o[i] = 0.f;
        float mx = -INFINITY, l = 0.f;
        const int nkt = (qb + 1) * 16;
        for (int kt = 0; kt < nkt; ++kt) {
            __syncthreads();
            if (tid < 384) { const int r = tid / 12, c8 = (tid % 12) * 8; float v[8]; unpack8(*(const u32x4*)(KC + (row0 + kt * 32 + r) * 768 + h * 96 + c8), v);
#pragma unroll
                for (int i = 0; i < 8; ++i) Ks[r * 96 + c8 + i] = v[i]; }
            if (tid < 256) { const int r = tid >> 3, c8 = (tid & 7) * 8; float v[8]; unpack8(*(const u32x4*)(VC + (row0 + kt * 32 + r) * 512 + h * 64 + c8), v);
#pragma unroll
                for (int i = 0; i < 8; ++i) Vs[r * 64 + c8 + i] = v[i]; }
            __syncthreads();
            for (int kk = 0; kk < 32; ++kk) {
                const int kv = kt * 32 + kk;
                float s = 0.f; const LAS f32x4* kr = (const LAS f32x4*)(Ks + kk * 96);
#pragma unroll
                for (int i = 0; i < 24; ++i) { const f32x4 k4 = kr[i]; s += lo2f(qp[2 * i]) * k4.x + hi2f(qp[2 * i]) * k4.y + lo2f(qp[2 * i + 1]) * k4.z + hi2f(qp[2 * i + 1]) * k4.w; }
                if (kv <= t) {
                    const float mn = fmaxf(mx, s), f = exp2f(mx - mn), p = exp2f(s - mn); mx = mn; l = l * f + p;
                    const LAS f32x4* vr = (const LAS f32x4*)(Vs + kk * 64);
#pragma unroll
                    for (int i = 0; i < 16; ++i) { const f32x4 v4 = vr[i]; o[4 * i] = o[4 * i] * f + p * v4.x; o[4 * i + 1] = o[4 * i + 1] * f + p * v4.y; o[4 * i + 2] = o[4 * i + 2] * f + p * v4.z; o[4 * i + 3] = o[4 * i + 3] * f + p * v4.w; }
                }
            }
        }
        const float il = 1.f / l; u32x4* og = (u32x4*)(YM + (row0 + t) * 512 + h * 64);
#pragma unroll
        for (int i = 0; i < 8; ++i) { u32x4 w; w.x = pk2(o[8 * i] * il, o[8 * i + 1] * il); w.y = pk2(o[8 * i + 2] * il, o[8 * i + 3] * il); w.z = pk2(o[8 * i + 4] * il, o[8 * i + 5] * il); w.w = pk2(o[8 * i + 6] * il, o[8 * i + 7] * il); og[i] = w; }
    }
    __syncthreads();
}

__device__ __forceinline__ void p_post_scan(const Frame& F, const Args& a) {
    bf16* Y = (bf16*)(F.ws + WS_Y); const bf16* R = (const bf16*)(F.ws + WS_R); const bf16* K = (const bf16*)(F.ws + WS_ZK); const bf16* V = (const bf16*)(F.ws + WS_V); const bf16* G = (const bf16*)(F.dob + DO_G);
    const float* lnw = a.in[I_LNW]; const float* lnb = a.in[I_LNB]; const float* rk = a.in[I_RK];
    const int lane = F.lane;
    for (int m = F.gw; m < NTOK; m += F.NGW) {
        float y[8], r[8], k[8], v[8], g[8], o[8];
        unpack8(*((const u32x4*)(Y + (size_t)m * 512) + lane), y); unpack8(*((const u32x4*)(R + (size_t)m * 512) + lane), r); unpack8(*((const u32x4*)(K + (size_t)m * 512) + lane), k);
        unpack8(*((const u32x4*)(V + (size_t)m * 512) + lane), v); unpack8(*((const u32x4*)(G + (size_t)m * 512) + lane), g);
        float s = 0.f, d = 0.f;
#pragma unroll
        for (int i = 0; i < 8; ++i) { s += y[i]; d += r[i] * k[i] * rk[8 * lane + i]; }
        const float mean = sum8(s) * (1.f / 64.f); d = sum8(d); float q = 0.f;
#pragma unroll
        for (int i = 0; i < 8; ++i) { y[i] -= mean; q += y[i] * y[i]; }
        const float rstd = 1.0f / sqrtf(sum8(q) * (1.f / 64.f) + LN_X_EPS);
#pragma unroll
        for (int i = 0; i < 8; ++i) o[i] = (y[i] * rstd * lnw[8 * lane + i] + lnb[8 * lane + i] + d * v[i]) * g[i];
        *((u32x4*)(Y + (size_t)m * 512) + lane) = pack8(o);
    }
}

__device__ __forceinline__ void p_ffn_route(const Frame& F, const Args& a) {
    const float* X1 = (const float*)F.dob; bf16* H2 = (bf16*)(F.ws + WS_H2); const float* mod = (const float*)(F.ws + WS_MOD); const float* g = a.in[I_GFFN];
    unsigned* cnt = (unsigned*)(F.ws + WS_CTL) + CW_CNT; int* route = (int*)(F.ws + WS_ROUTE);
    LAS float* wr = (LAS float*)F.lds;
    __syncthreads();
    for (int i = F.tid; i < 1024 * 4; i += NTHR) { const int k = i >> 2, o = i & 3; wr[o * 1024 + k] = a.in[I_WRG][i]; }
    for (int i = F.tid; i < 1024 * 32; i += NTHR) { const int k = i >> 5, o = i & 31; wr[(4 + o) * 1024 + k] = a.in[I_WRE][i]; }
    __syncthreads();
    const float* brg = a.in[I_BRG]; const float* bre = a.in[I_BRE];
    const int lane = F.lane;
    for (int m = F.gw; m < NTOK; m += F.NGW) {
        const int b = m / SEQ; const f32x4* xr = (const f32x4*)(X1 + (size_t)m * 1024) + lane;
        f32x4 v[4]; float s = 0.f;
#pragma unroll
        for (int j = 0; j < 4; ++j) { v[j] = xr[64 * j]; s += (v[j].x * v[j].x + v[j].y * v[j].y) + (v[j].z * v[j].z + v[j].w * v[j].w); }
        const float rstd = 1.0f / sqrtf(wave_sum(s) * (1.f / 1024.f) + EPS);
        u32x2* o = (u32x2*)(H2 + (size_t)m * 1024) + lane;
#pragma unroll
        for (int j = 0; j < 4; ++j) { const int col = 4 * lane + 256 * j;
            const f32x4 gg = *(const f32x4*)(g + col), sc = *(const f32x4*)(mod + b * 6144 + 4096 + col), sh = *(const f32x4*)(mod + b * 6144 + 3072 + col);
            v[j] = v[j] * rstd * gg * (sc + 1.0f) + sh; u32x2 w; w.x = pk2(v[j].x, v[j].y); w.y = pk2(v[j].z, v[j].w); o[64 * j] = w; }
        float lgq[4];
#pragma unroll
        for (int oo = 0; oo < 4; ++oo) { float p = 0.f;
#pragma unroll
            for (int j = 0; j < 4; ++j) { const f32x4 w4 = *(const LAS f32x4*)(wr + oo * 1024 + 4 * lane + 256 * j); p += (v[j].x * w4.x + v[j].y * w4.y) + (v[j].z * w4.z + v[j].w * w4.w); }
            lgq[oo] = wave_sum(p) + brg[oo]; }
        int gi = 0; float gm = lgq[0];
#pragma unroll
        for (int i = 1; i < 4; ++i) { if (lgq[i] > gm) { gm = lgq[i]; gi = i; } }
        float gs = 0.f;
#pragma unroll
        for (int i = 0; i < 4; ++i) gs += __expf(lgq[i] - gm);
        const float pg = 1.f / gs;
        gi = __builtin_amdgcn_readfirstlane(gi);
        float el[8];
        { const LAS float* wg = wr + (4 + gi * 8) * 1024 + 4 * lane;
#pragma unroll
          for (int i = 0; i < 8; ++i) { float p = 0.f;
#pragma unroll
              for (int j = 0; j < 4; ++j) { const f32x4 w4 = *(const LAS f32x4*)(wg + i * 1024 + 256 * j); p += (v[j].x * w4.x + v[j].y * w4.y) + (v[j].z * w4.z + v[j].w * w4.w); }
              el[i] = wave_sum(p) + bre[gi * 8 + i]; } }
        int i0 = 0; float m0 = el[0];
#pragma unroll
        for (int i = 1; i < 8; ++i) if (el[i] > m0) { m0 = el[i]; i0 = i; }
        int i1 = -1; float m1 = -INFINITY;
#pragma unroll
        for (int i = 0; i < 8; ++i) if (i != i0 && el[i] > m1) { m1 = el[i]; i1 = i; }
        const float e1 = __expf(m1 - m0), w0 = pg / (1.f + e1), w1 = pg * e1 / (1.f + e1);
        if (lane == 0) { const int x0 = gi * 8 + i0, x1 = gi * 8 + i1;
            const unsigned p0 = __hip_atomic_fetch_add(cnt + x0, 1u, __ATOMIC_RELAXED, __HIP_MEMORY_SCOPE_AGENT), p1 = __hip_atomic_fetch_add(cnt + x1, 1u, __ATOMIC_RELAXED, __HIP_MEMORY_SCOPE_AGENT);
            int* rt = route + (size_t)m * 8; rt[0] = x0; rt[1] = x1; rt[2] = (int)p0; rt[3] = (int)p1; rt[4] = __builtin_bit_cast(int, w0); rt[5] = __builtin_bit_cast(int, w1); }
    }
    __syncthreads();
}
__device__ __forceinline__ int moe_tables(const Frame& F, LAS int* offs, LAS int* texp) {
    const unsigned* cnt = (const unsigned*)(F.ws + WS_CTL) + CW_CNT;
    __syncthreads();
    if (F.tid == 0) { int o = 0; for (int e = 0; e < 32; ++e) { offs[e] = o; const int c = (int)__hip_atomic_load(cnt + e, __ATOMIC_RELAXED, __HIP_MEMORY_SCOPE_AGENT); const int nt = (c + 255) >> 8; for (int t = 0; t < nt; ++t) texp[(o >> 8) + t] = e; o += nt << 8; } offs[32] = o; }
    __syncthreads();
    return offs[32] >> 8;
}
__device__ __forceinline__ void p_gather(const Frame& F) {
    LAS int* offs = (LAS int*)(F.lds + 1024); LAS int* texp = (LAS int*)(F.lds + 2048);
    moe_tables(F, offs, texp);
    const bf16* H2 = (const bf16*)(F.ws + WS_H2); bf16* XG = (bf16*)(F.ws + WS_XG); const int* route = (const int*)(F.ws + WS_ROUTE);
    const unsigned* cnt = (const unsigned*)(F.ws + WS_CTL) + CW_CNT; const int lane = F.lane;
    for (int m = F.gw; m < NTOK; m += F.NGW) {
        const int* rt = route + (size_t)m * 8; const int d0 = offs[rt[0]] + rt[2], d1 = offs[rt[1]] + rt[3];
        const u32x4* src = (const u32x4*)(H2 + (size_t)m * 1024) + lane; const u32x4 a0 = src[0], a1 = src[64];
        u32x4* p0 = (u32x4*)(XG + (size_t)d0 * 1024) + lane; u32x4* p1 = (u32x4*)(XG + (size_t)d1 * 1024) + lane;
        p0[0] = a0; p0[64] = a1; p1[0] = a0; p1[64] = a1;
    }
    for (int i = F.gw; i < 32 * 256; i += F.NGW) { const int e = i >> 8, r = i & 255; const int c = (int)cnt[e]; const int pad = ((c + 255) & ~255) - c;
        if (r < pad) { u32x4* p = (u32x4*)(XG + (size_t)(offs[e] + c + r) * 1024) + lane; p[0] = (u32x4){0u, 0u, 0u, 0u}; p[64] = (u32x4){0u, 0u, 0u, 0u}; } }
    __syncthreads();
}
__device__ __forceinline__ void p_combine(const Frame& F) {
    LAS int* offs = (LAS int*)(F.lds + 1024); LAS int* texp = (LAS int*)(F.lds + 2048);
    moe_tables(F, offs, texp);
    float* out = (float*)F.dob; const bf16* YS = (const bf16*)(F.ws + WS_YS); const int* route = (const int*)(F.ws + WS_ROUTE); const float* mod = (const float*)(F.ws + WS_MOD);
    const int lane = F.lane;
    for (int m = F.gw; m < NTOK; m += F.NGW) {
        const int b = m / SEQ; const int* rt = route + (size_t)m * 8; const int d0 = offs[rt[0]] + rt[2], d1 = offs[rt[1]] + rt[3];
        const float w0 = __builtin_bit_cast(float, rt[4]), w1 = __builtin_bit_cast(float, rt[5]);
#pragma unroll
        for (int j = 0; j < 2; ++j) { const int col = 8 * lane + 512 * j; float y0[8], y1[8];
            unpack8(*(const u32x4*)(YS + (size_t)d0 * 1024 + col), y0); unpack8(*(const u32x4*)(YS + (size_t)d1 * 1024 + col), y1);
            float* o = out + (size_t)m * 1024 + col; const float* gt = mod + b * 6144 + 5120 + col;
            f32x4 x0 = *(const f32x4*)o, x1 = *(const f32x4*)(o + 4); const f32x4 g0 = *(const f32x4*)gt, g1 = *(const f32x4*)(gt + 4);
            x0.x += g0.x * (w0 * y0[0] + w1 * y1[0]); x0.y += g0.y * (w0 * y0[1] + w1 * y1[1]); x0.z += g0.z * (w0 * y0[2] + w1 * y1[2]); x0.w += g0.w * (w0 * y0[3] + w1 * y1[3]);
            x1.x += g1.x * (w0 * y0[4] + w1 * y1[4]); x1.y += g1.y * (w0 * y0[5] + w1 * y1[5]); x1.z += g1.z * (w0 * y0[6] + w1 * y1[6]); x1.w += g1.w * (w0 * y0[7] + w1 * y1[7]);
            *(f32x4*)o = x0; *(f32x4*)(o + 4) = x1; }
    }
}

constexpr int NPHASE = 16;
template <int LO, int HI>
__global__ void __launch_bounds__(NTHR, 2) fwd(Args args) {
    extern __shared__ __attribute__((aligned(16))) unsigned char lds_raw[];
    Frame F;
    F.lds = (LAS unsigned char*)lds_raw;
    F.tid = threadIdx.x; F.lane = F.tid & 63; F.wave = __builtin_amdgcn_readfirstlane(F.tid >> 6);
    F.G = gridDim.x; { const int bx = blockIdx.x; F.vcu = (F.G % 8 == 0) ? (bx % 8) * (F.G / 8) + bx / 8 : bx; }
    F.gw = F.vcu * NWAVES + F.wave; F.NGW = F.G * NWAVES;
    F.ws = args.ws; F.dob = (unsigned char*)args.out;
    volatile LAS unsigned* MISC = (volatile LAS unsigned*)(F.lds + LDS_MISC);
    if (F.tid < 64) MISC[F.tid] = 0u;
    __syncthreads();
    XcdBarrier bar; bar.bar = (unsigned*)(F.ws + WS_CTL) + CW_BAR; bar.x = 0; bar.st = MISC + 8;
#if N_LAUNCH_MODE == 1
    bar = xcd_barrier_post((unsigned*)(F.ws + WS_CTL) + CW_BAR, MISC + 8);
#define GRID_BAR() xcd_barrier(bar)
#else
#define GRID_BAR() do { } while (0)
#endif
#define IN(k) (LO <= (k) && (k) < HI)
#define SEAM(k) do { if constexpr (IN(k) && IN((k) + 1)) GRID_BAR(); } while (0)
    const float* mod = (const float*)(F.ws + WS_MOD);

    if constexpr (IN(0)) { p0_prologue(F, args); } SEAM(0);
    if constexpr (IN(1)) { p_normmod(F, args.in[I_X], args.in[I_GMIX], mod, 0, 1024, (bf16*)(F.ws + WS_H)); } SEAM(1);
    if constexpr (IN(2)) { Gemm g{(const bf16*)(F.ws + WS_H), (const bf16*)(F.ws + WS_WIN), NTOK, N_IN_PAD, 1024}; StaticOrder S; S.init(NTOK, N_IN_PAD, F.G, (int)blockIdx.x);
        EpiZ E{(bf16*)(F.ws + WS_ZR), (bf16*)(F.ws + WS_SG), (bf16*)(F.ws + WS_ZM)}; gemm_phase_any(F.lds, g, S, E); } SEAM(2);
    if constexpr (IN(3)) { p_prep_a(F, args); } SEAM(3);
    if constexpr (IN(4)) {
        { Gemm g{(const bf16*)(F.ws + WS_TWA), (const bf16*)(F.ws + WS_WBLK), NTOK, 1024, 128}; StaticOrder S; S.init(NTOK, 1024, F.G, (int)blockIdx.x);
          EpiLora E{(bf16*)(F.ws + WS_LW), (bf16*)(F.ws + WS_A), args.in[I_W0], args.in[I_A0]}; gemm_phase_any(F.lds, g, S, E); }
        { Gemm g{(const bf16*)(F.ws + WS_SGL), (const bf16*)(F.ws + WS_WG), NTOK, 512, 128}; StaticOrder S; S.init(NTOK, 512, F.G, (int)blockIdx.x);
          EpiPlain E{(bf16*)(F.dob + DO_G), nullptr, 1 << 30, 512, 0}; gemm_phase_any(F.lds, g, S, E); }
        { Gemm g{(const bf16*)(F.ws + WS_QA), (const bf16*)(F.ws + WS_WUQ), NTOK, 768, 256}; StaticOrder S; S.init(NTOK, 768, F.G, (int)blockIdx.x);
          EpiPlain E{(bf16*)(F.dob + DO_Q), nullptr, 1 << 30, 768, 0}; gemm_phase_any(F.lds, g, S, E); }
        { Gemm g{(const bf16*)(F.ws + WS_KVA), (const bf16*)(F.ws + WS_WUKV), NTOK, 1024, 128}; StaticOrder S; S.init(NTOK, 1024, F.G, (int)blockIdx.x);
          EpiPlain E{(bf16*)(F.dob + DO_KN), (bf16*)(F.ws + WS_VC), 512, 512, 512}; gemm_phase_any(F.lds, g, S, E); }
    } SEAM(4);
    if constexpr (IN(5)) { p_prep_c(F, args); } SEAM(5);
    if constexpr (IN(6)) { p_scan(F); } SEAM(6);
    if constexpr (IN(7)) { p_attn_naive(F); } SEAM(7);
    if constexpr (IN(8)) { p_post_scan(F, args); } SEAM(8);
    if constexpr (IN(9)) {
        { Gemm g{(const bf16*)(F.ws + WS_Y), (const bf16*)(F.ws + WS_WB), NTOK, 1024, 512}; StaticOrder S; S.init(NTOK, 1024, F.G, (int)blockIdx.x);
          EpiBranch<false> E{(bf16*)(F.ws + WS_MG), (const bf16*)(F.ws + WS_SG), 0}; gemm_phase_any(F.lds, g, S, E); }
        { Gemm g{(const bf16*)(F.ws + WS_YM), (const bf16*)(F.ws + WS_WB) + (size_t)1024 * 512, NTOK, 1024, 512}; StaticOrder S; S.init(NTOK, 1024, F.G, (int)blockIdx.x);
          EpiBranch<true> E{(bf16*)(F.ws + WS_MG), (const bf16*)(F.ws + WS_SG), 1024}; gemm_phase_any(F.lds, g, S, E); }
    } SEAM(9);
    if constexpr (IN(10)) { Gemm g{(const bf16*)(F.ws + WS_MG), (const bf16*)(F.ws + WS_WO), NTOK, 1024, 1024}; StaticOrder S; S.init(NTOK, 1024, F.G, (int)blockIdx.x);
        EpiOut E{(float*)F.dob, args.in[I_X], mod}; gemm_phase_any(F.lds, g, S, E); } SEAM(10);
    if constexpr (IN(11)) { p_ffn_route(F, args); } SEAM(11);
    if constexpr (IN(12)) { p_gather(F); } SEAM(12);
    if constexpr (IN(13)) { LAS int* offs = (LAS int*)(F.lds + LDS_MISC + 1024); LAS int* texp = (LAS int*)(F.lds + LDS_MISC + 1024 + 256); const int nt = moe_tables(F, offs, texp);
        Gemm g{(const bf16*)(F.ws + WS_XG), (const bf16*)(F.ws + WS_WGU), MPAD, 512, 1024}; TableOrder S{texp, nt, 2, F.G, (int)blockIdx.x};
        EpiGateUp E{(bf16*)(F.ws + WS_HID)}; gemm_phase_any(F.lds, g, S, E); } SEAM(13);
    if constexpr (IN(14)) { LAS int* offs = (LAS int*)(F.lds + LDS_MISC + 1024); LAS int* texp = (LAS int*)(F.lds + LDS_MISC + 1024 + 256); const int nt = moe_tables(F, offs, texp);
        Gemm g{(const bf16*)(F.ws + WS_HID), (const bf16*)(F.ws + WS_WDN), MPAD, 1024, 256}; TableOrder S{texp, nt, 4, F.G, (int)blockIdx.x};
        EpiDown E{(bf16*)(F.ws + WS_YS)}; gemm_phase_any(F.lds, g, S, E); } SEAM(14);
    if constexpr (IN(15)) { p_combine(F); }
}

#if N_LAUNCH_MODE == 1
static bool set_attrs() { return hipFuncSetAttribute((const void*)fwd<0, NPHASE>, hipFuncAttributeMaxDynamicSharedMemorySize, LDS_BYTES) == hipSuccess; }
#else
template <int P> static bool set_attr_all() { if constexpr (P < NPHASE) { return hipFuncSetAttribute((const void*)fwd<P, P + 1>, hipFuncAttributeMaxDynamicSharedMemorySize, LDS_BYTES) == hipSuccess && set_attr_all<P + 1>(); } else return true; }
static bool set_attrs() { return set_attr_all<0>(); }
template <int P> static void launch_all(int grid, hipStream_t stream, const Args& a) { if constexpr (P < NPHASE) { hipLaunchKernelGGL((fwd<P, P + 1>), dim3(grid), dim3(NTHR), LDS_BYTES, stream, a); launch_all<P + 1>(grid, stream, a); } }
#endif
extern "C" void kernel_launch(void* const* d_in, const int* in_sizes, int n_in, void* d_out, int out_size, void* d_ws, size_t ws_size, hipStream_t stream) {
    static int grid = 0;
    if (grid == 0) {
        if (n_in != 34 || out_size != NTOK * DM || ws_size < WS_END) { fprintf(stderr, "kernel_launch: unexpected shapes (n_in %d out %d ws %zu)\n", n_in, out_size, ws_size); grid = -1; return; }
        int dev = 0, cus = 0;
        if (hipGetDevice(&dev) != hipSuccess || hipDeviceGetAttribute(&cus, hipDeviceAttributeMultiprocessorCount, dev) != hipSuccess) { grid = -1; return; }
        if (!set_attrs()) { fprintf(stderr, "kernel_launch: hipFuncSetAttribute failed\n"); grid = -1; return; }
        grid = cus;
    }
    if (grid < 0) return;
    (void)hipMemsetAsync((char*)d_ws + WS_CTL, 0, CTL_ZERO_BYTES, stream);
    Args a{};
    for (int i = 0; i < 34; ++i) a.in[i] = (const float*)d_in[i];
    a.out = (float*)d_out; a.ws = (unsigned char*)d_ws;
    a.ph_lo = 0; a.ph_hi = NPHASE;
#if N_LAUNCH_MODE == 1
    hipLaunchKernelGGL((fwd<0, NPHASE>), dim3(grid), dim3(NTHR), LDS_BYTES, stream, a);
#else
    launch_all<0>(grid, stream, a);
#endif
}
```

```cpp
#include <hip/hip_runtime.h>
#include <cstdio>
#include <cstdint>

#ifndef N_LAUNCH_MODE
#define N_LAUNCH_MODE 1
#endif
#ifndef ENG_GEMM
#define ENG_GEMM 1
#endif
#ifndef ENG_ATTN
#define ENG_ATTN 1
#endif

#define GAS __attribute__((address_space(1)))
#define LAS __attribute__((address_space(3)))
typedef unsigned short bf16;
typedef float f32x4 __attribute__((ext_vector_type(4)));
typedef float f32x2 __attribute__((ext_vector_type(2)));
typedef unsigned u32x4 __attribute__((ext_vector_type(4)));
typedef unsigned u32x2 __attribute__((ext_vector_type(2)));
typedef short bf16x8 __attribute__((ext_vector_type(8)));

constexpr int BATCH = 8, SEQ = 8192, DM = 1024, NTOK = BATCH * SEQ;
constexpr int D_RWKV = 512, RWKV_COLS = 1792, MLA_COLS = 416, D_IN = 4256, N_IN_PAD = 4352;
constexpr int NH = 8, QKD = 96, NOPE = 64, ROPE = 32, VD = 64;
constexpr int NEXP = 32, DEXP = 256;
constexpr int MPAD = 139264;
constexpr float EPS = 1e-6f, LN_X_EPS = 64e-5f;
constexpr float QSCALE = 0.10206207261596577f * 1.4426950408889634f;

constexpr size_t MiB = 1u << 20;
constexpr size_t WS_CTL = 0, CTL_ZERO_BYTES = 1 * MiB;
constexpr size_t WS_MOD = 1 * MiB;
constexpr size_t WS_ROUTE = 2 * MiB;
constexpr size_t WS_CS = 4 * MiB;
constexpr size_t WS_WIN = 16 * MiB;
constexpr size_t WS_WBLK = 25 * MiB;
constexpr size_t WS_WG = WS_WBLK + 256 * 1024;
constexpr size_t WS_WUQ = WS_WG + 128 * 1024;
constexpr size_t WS_WUKV = WS_WUQ + 384 * 1024;
constexpr size_t WS_WB = 26 * MiB;
constexpr size_t WS_WO = 28 * MiB;
constexpr size_t WS_WGU = 30 * MiB;
constexpr size_t WS_WDN = 62 * MiB;
constexpr size_t WS_SG = 80 * MiB;
constexpr size_t WS_H2 = 80 * MiB;
constexpr size_t WS_ZR = 336 * MiB;
constexpr size_t WS_VC = 336 * MiB;
constexpr size_t WS_KC = 400 * MiB;
constexpr size_t WS_Y = 496 * MiB;
constexpr size_t WS_XG = 336 * MiB;
constexpr size_t WS_ZM = 560 * MiB;
constexpr size_t WS_YM = 560 * MiB;
constexpr size_t WS_H = 624 * MiB;
constexpr size_t WS_LW = 624 * MiB;
constexpr size_t WS_A = 688 * MiB;
constexpr size_t WS_MG = 624 * MiB;
constexpr size_t WS_HID = 608 * MiB;
constexpr size_t WS_R = 752 * MiB;
constexpr size_t WS_V = 816 * MiB;
constexpr size_t WS_ZK = 880 * MiB;
constexpr size_t WS_TWA = 944 * MiB;
constexpr size_t WS_SGL = 960 * MiB;
constexpr size_t WS_QA = 976 * MiB;
constexpr size_t WS_KVA = 1008 * MiB;
constexpr size_t WS_KK = 944 * MiB;
constexpr size_t WS_YS = 752 * MiB;
constexpr size_t WS_END = 1024 * MiB;
constexpr size_t DO_G = 0;
constexpr size_t DO_Q = 64 * MiB;
constexpr size_t DO_KN = 160 * MiB;

constexpr int CW_CNT = 64;
constexpr int CW_BAR = 4096;

constexpr int NWAVES = 8, NTHR = 512;
constexpr int LDS_BYTES = 155648;
constexpr int LDS_MISC = 151552;

__device__ __forceinline__ int lane_id_fresh() { int l; asm volatile("v_mbcnt_lo_u32_b32 %0, -1, 0\n\tv_mbcnt_hi_u32_b32 %0, -1, %0" : "=v"(l)); return l; }
__device__ __forceinline__ float bf2f(unsigned short h) { return __builtin_bit_cast(float, (unsigned)h << 16); }
__device__ __forceinline__ unsigned f2bf(float f) { unsigned u = __builtin_bit_cast(unsigned, f); return (u + 0x7fffu + ((u >> 16) & 1u)) >> 16; }
__device__ __forceinline__ unsigned pk2(float lo, float hi) { return f2bf(lo) | (f2bf(hi) << 16); }
__device__ __forceinline__ float lo2f(unsigned w) { return __builtin_bit_cast(float, w << 16); }
__device__ __forceinline__ float hi2f(unsigned w) { return __builtin_bit_cast(float, w & 0xffff0000u); }
__device__ __forceinline__ float wave_sum(float v) {
#pragma unroll
    for (int o = 1; o < 64; o <<= 1) v += __shfl_xor(v, o);
    return v;
}
__device__ __forceinline__ float sum8(float v) { v += __shfl_xor(v, 1); v += __shfl_xor(v, 2); v += __shfl_xor(v, 4); return v; }
__device__ __forceinline__ float sigmoidf_(float x) { return 1.f / (1.f + __expf(-x)); }
__device__ __forceinline__ float siluf_(float x) { return x / (1.f + __expf(-x)); }
__device__ __forceinline__ void unpack8(const u32x4 w, float (&v)[8]) {
    v[0] = lo2f(w.x); v[1] = hi2f(w.x); v[2] = lo2f(w.y); v[3] = hi2f(w.y); v[4] = lo2f(w.z); v[5] = hi2f(w.z); v[6] = lo2f(w.w); v[7] = hi2f(w.w);
}
__device__ __forceinline__ u32x4 pack8(const float (&v)[8]) { u32x4 w; w.x = pk2(v[0], v[1]); w.y = pk2(v[2], v[3]); w.z = pk2(v[4], v[5]); w.w = pk2(v[6], v[7]); return w; }

#define XB_TMO      128
#define XB_XCNT(j)  (256  + 64 * (j))
#define XB_XSUB(j)  (1280 + 64 * (j))
#define XB_XGEN(j)  (2304 + 64 * (j))
#define XB_TOP      3328
#define XB_TOPGEN   3392
#define XCD_BAR_WORDS 3456
#define XB_SPIN_CAP (1u << 19)
__device__ __forceinline__ unsigned xb_ld(unsigned* p)              { return __hip_atomic_load(p, __ATOMIC_RELAXED, __HIP_MEMORY_SCOPE_AGENT); }
__device__ __forceinline__ unsigned xb_add(unsigned* p, unsigned v) { return __hip_atomic_fetch_add(p, v, __ATOMIC_RELAXED, __HIP_MEMORY_SCOPE_AGENT); }
__device__ __forceinline__ unsigned xb_xcc_id() { return (unsigned)__builtin_amdgcn_s_getreg((3 << 11) | 20) & 0xFu; }
#define XB_SPIN(cond, bar) do { unsigned _sp = 0; while (cond) { __builtin_amdgcn_s_sleep(1); \
    if ((++_sp & 255u) == 0u) { if (xb_ld(&(bar)[XB_TMO])) break; if (_sp > XB_SPIN_CAP) { atomicAdd(&(bar)[XB_TMO], 1u); break; } } } } while (0)
struct XcdBarrier { unsigned* bar; unsigned x; volatile LAS unsigned* st; };
__device__ __forceinline__ XcdBarrier xcd_barrier_post(unsigned* bar, volatile LAS unsigned* st) {
    XcdBarrier b; b.bar = bar; b.x = xb_xcc_id(); b.st = st;
    if (threadIdx.x == 0) (void)xb_add(&bar[XB_XCNT(b.x)], 1u);
    return b;
}
__device__ __forceinline__ void xcd_barrier_complete(unsigned* bar, unsigned x, unsigned& nloc, unsigned& nx) {
    const unsigned G = gridDim.x * gridDim.y * gridDim.z;
    unsigned sum, cnt, mine, sp = 0u;
    for (;;) {
        sum = 0u; cnt = 0u; mine = 0u;
#pragma unroll
        for (unsigned j = 0; j < 16; ++j) { const unsigned c = xb_ld(&bar[XB_XCNT(j)]); sum += c; cnt += (c > 0u) ? 1u : 0u; mine = (j == x) ? c : mine; }
        if (sum == G) break;
        __builtin_amdgcn_s_sleep(1);
        if ((++sp & 255u) == 0u) { if (xb_ld(&bar[XB_TMO])) break; if (sp > XB_SPIN_CAP) { atomicAdd(&bar[XB_TMO], 1u); break; } }
    }
    nloc = mine > 0u ? mine : 1u; nx = cnt > 0u ? cnt : 1u;
}
__device__ __forceinline__ void xcd_barrier(const XcdBarrier& b) {
    asm volatile("s_waitcnt vmcnt(0)" ::: "memory");
    __syncthreads();
    if (threadIdx.x == 0) {
        unsigned* bar = b.bar;
        __builtin_amdgcn_s_waitcnt(0);
        unsigned nloc = b.st[0], nx = b.st[1];
        if (nloc == 0u) { xcd_barrier_complete(bar, b.x, nloc, nx); b.st[0] = nloc; b.st[1] = nx; }
        const unsigned old = xb_add(&bar[XB_XSUB(b.x)], 1u);
        const unsigned gen = old / nloc;
        if (old + 1u == (gen + 1u) * nloc) {
            __builtin_amdgcn_fence(__ATOMIC_RELEASE, "agent");
            asm volatile("s_waitcnt vmcnt(0)" ::: "memory");
            const unsigned og = xb_add(&bar[XB_TOP], 1u);
            const unsigned tg = og / nx;
            if (og + 1u == (tg + 1u) * nx) xb_add(&bar[XB_TOPGEN], 1u);
            else XB_SPIN(xb_ld(&bar[XB_TOPGEN]) == tg, bar);
            __builtin_amdgcn_fence(__ATOMIC_ACQUIRE, "agent");
            xb_add(&bar[XB_XGEN(b.x)], 1u);
            asm volatile("s_waitcnt vmcnt(0)" ::: "memory");
        } else {
            XB_SPIN(xb_ld(&bar[XB_XGEN(b.x)]) == gen, bar);
            __builtin_amdgcn_fence(__ATOMIC_ACQUIRE, "agent");
            asm volatile("s_waitcnt vmcnt(0)" ::: "memory");
        }
    }
    __syncthreads();
}

struct Args {
    const float* in[34]; float* out; unsigned char* ws; int ph_lo, ph_hi;
};
typedef const __attribute__((address_space(4))) Args* ArgsP;
struct Frame {
    LAS unsigned char* lds;
    int wave, vcu, G, gw, NGW;
    unsigned char* ws; unsigned char* dob;
};
enum { I_X = 0, I_C, I_POS, I_WADA, I_BADA, I_GMIX, I_WIN, I_MU, I_W0, I_WDEC, I_A0, I_WAUP, I_WGUP, I_KK, I_KA, I_RK, I_LNW, I_LNB, I_GQA, I_WUQ, I_GKVA, I_WUKV,
       I_QN, I_KN, I_WBR, I_WOUT, I_GFFN, I_WRG, I_BRG, I_WRE, I_BRE, I_WEG, I_WEU, I_WED };

struct Unit { int pm, pn; };
struct Gemm { const bf16* A; const bf16* Bt; int M, N, K; };
constexpr int NXCD = 8, WGM = 8;
struct StaticOrder {
    int nM, nN, nwg, G, c;
    __device__ void init(int M, int N, int G_, int c_) { nM = M / 256; nN = N / 256; nwg = nM * nN; G = G_; c = c_; }
    __device__ bool next(int i, Unit& u) const {
        const long L = (long)i * G + c; if (L >= nwg) return false;
        int wgid = (int)L; { const int q = nwg / NXCD, r = nwg % NXCD, xcd = wgid % NXCD, off = wgid / NXCD; wgid = (xcd < r ? xcd * (q + 1) : r * (q + 1) + (xcd - r) * q) + off; }
        const int nig = WGM * nN, gid = wgid / nig, fm = gid * WGM, gsz = (nM - fm) < WGM ? (nM - fm) : WGM;
        u.pm = fm + ((wgid % nig) % gsz); u.pn = (wgid % nig) / gsz; return true;
    }
    __device__ __forceinline__ void a_ready(const Unit&) const {}
    __device__ __forceinline__ void done(const Unit&) const {}
};
struct TableOrder {
    const LAS int* texp; int ntiles, nN, G, c;
    __device__ bool next(int i, Unit& u) const {
        const long L = (long)i * G + c; if (L >= (long)ntiles * nN) return false;
        const int t = (int)(L / nN), j = (int)(L % nN); u.pm = t; u.pn = texp[t] * nN + j; return true;
    }
    __device__ __forceinline__ void a_ready(const Unit&) const {}
    __device__ __forceinline__ void done(const Unit&) const {}
};

template <class Epi, class Sched>
__device__ __forceinline__ void gemm_phase_naive(LAS unsigned char* lds, const Gemm g, const Sched& S, const Epi& E) {
    const int tid = (int)__builtin_amdgcn_readfirstlane((int)threadIdx.x >> 6) * 64 + lane_id_fresh(), ty = tid >> 5, tx = tid & 31;
    LAS bf16* As = (LAS bf16*)lds; LAS bf16* Bs = (LAS bf16*)(lds + 128 * 40 * 2);
    Unit u;
    for (int i = 0; S.next(i, u); ++i) {
        for (int half = 0; half < 2; ++half) {
            float acc[8][8];
#pragma unroll
            for (int r = 0; r < 8; ++r)
#pragma unroll
                for (int c = 0; c < 8; ++c) acc[r][c] = 0.f;
            const bf16* Ab = g.A + ((size_t)u.pm * 256 + half * 128) * g.K; const bf16* Bb = g.Bt + (size_t)u.pn * 256 * g.K;
            for (int k0 = 0; k0 < g.K; k0 += 32) {
                __syncthreads();
                { const int r = tid >> 2, c8 = (tid & 3) * 8; *(LAS u32x4*)(As + r * 40 + c8) = *(const u32x4*)(Ab + (size_t)r * g.K + k0 + c8); }
#pragma unroll
                for (int j = 0; j < 2; ++j) { const int ch = tid + j * 512, r = ch >> 2, c8 = (ch & 3) * 8; *(LAS u32x4*)(Bs + r * 40 + c8) = *(const u32x4*)(Bb + (size_t)r * g.K + k0 + c8); }
                __syncthreads();
#pragma unroll 2
                for (int k = 0; k < 32; k += 2) {
                    float b0[8], b1[8];
#pragma unroll
                    for (int c = 0; c < 8; ++c) { const unsigned w = *(const LAS unsigned*)(Bs + (tx * 8 + c) * 40 + k); b0[c] = lo2f(w); b1[c] = hi2f(w); }
#pragma unroll
                    for (int r = 0; r < 8; ++r) { const unsigned w = *(const LAS unsigned*)(As + (ty * 8 + r) * 40 + k); const float a0 = lo2f(w), a1 = hi2f(w);
#pragma unroll
                        for (int c = 0; c < 8; ++c) acc[r][c] = fmaf(a1, b1[c], fmaf(a0, b0[c], acc[r][c])); }
                }
            }
#pragma unroll
            for (int r = 0; r < 8; ++r) E.store8(u, half * 128 + ty * 8 + r, tx * 8, acc[r]);
        }
    }
    __syncthreads();
}

struct EpiZ { bf16 *ZR, *SG, *ZM;
    __device__ __forceinline__ void store8(const Unit& u, int r, int c, const float (&v)[8]) const {
        const size_t row = (size_t)u.pm * 256 + r;
        if (u.pn < 7) { *(u32x4*)(ZR + row * 1792 + u.pn * 256 + c) = pack8(v); }
        else if (u.pn < 15) { float s[8];
#pragma unroll
            for (int i = 0; i < 8; ++i) s[i] = sigmoidf_(v[i]);
            *(u32x4*)(SG + row * 2048 + (u.pn - 7) * 256 + c) = pack8(s); }
        else { *(u32x4*)(ZM + row * 512 + (u.pn - 15) * 256 + c) = pack8(v); }
    } };
struct EpiLora { bf16 *LW, *A; const float *w0, *a0;
    __device__ __forceinline__ void store8(const Unit& u, int r, int c, const float (&v)[8]) const {
        const size_t row = (size_t)u.pm * 256 + r; const int col = u.pn * 256 + c; float o[8];
        const bool isw = col < 512; const float* bp = isw ? (w0 + col) : (a0 + col - 512);
        const f32x4 b0 = *(const f32x4*)bp, b1 = *(const f32x4*)(bp + 4); const float bb[8] = {b0.x, b0.y, b0.z, b0.w, b1.x, b1.y, b1.z, b1.w};
#pragma unroll
        for (int i = 0; i < 8; ++i) { const float e = __expf(fminf(-(bb[i] + v[i]), 80.f)); const float s = 1.0f / (1.0f + e); o[i] = isw ? -0.60653065971263342f * s : s; }
        bf16* dst = isw ? (LW + row * 512 + col) : (A + row * 512 + col - 512);
        *(u32x4*)dst = pack8(o);
    } };
struct EpiPlain { bf16* O0; bf16* O1; int split, ld0, ld1;
    __device__ __forceinline__ void store8(const Unit& u, int r, int c, const float (&v)[8]) const {
        const size_t row = (size_t)u.pm * 256 + r; int col = u.pn * 256 + c;
        if (col < split) *(u32x4*)(O0 + row * ld0 + col) = pack8(v); else *(u32x4*)(O1 + row * ld1 + col - split) = pack8(v);
    } };
template <bool ACCUM> struct EpiBranch { bf16* MG; const bf16* SG; int goff;
    __device__ __forceinline__ void store8(const Unit& u, int r, int c, const float (&v)[8]) const {
        const size_t row = (size_t)u.pm * 256 + r; const int col = u.pn * 256 + c; float gt[8], o[8];
        unpack8(*(const u32x4*)(SG + row * 2048 + goff + col), gt);
        if (ACCUM) { float p[8]; unpack8(*(const u32x4*)(MG + row * 1024 + col), p);
#pragma unroll
            for (int i = 0; i < 8; ++i) o[i] = p[i] + gt[i] * v[i]; }
        else {
#pragma unroll
            for (int i = 0; i < 8; ++i) o[i] = gt[i] * v[i]; }
        *(u32x4*)(MG + row * 1024 + col) = pack8(o);
    } };
struct EpiOut { float* X1; const float* x; const float* mod;
    __device__ __forceinline__ void store8(const Unit& u, int r, int c, const float (&v)[8]) const {
        const size_t row = (size_t)u.pm * 256 + r; const int col = u.pn * 256 + c; const int b = (int)(row / SEQ);
        const float* gt = mod + b * 6144 + 2048 + col; const float* xr = x + row * 1024 + col; float* o = X1 + row * 1024 + col;
        const f32x4 g0 = *(const f32x4*)gt, g1 = *(const f32x4*)(gt + 4), x0 = *(const f32x4*)xr, x1 = *(const f32x4*)(xr + 4);
        *(f32x4*)o = (f32x4){x0.x + g0.x * v[0], x0.y + g0.y * v[1], x0.z + g0.z * v[2], x0.w + g0.w * v[3]};
        *(f32x4*)(o + 4) = (f32x4){x1.x + g1.x * v[4], x1.y + g1.y * v[5], x1.z + g1.z * v[6], x1.w + g1.w * v[7]};
    } };
struct EpiGateUp { bf16* HID;
    __device__ __forceinline__ void store8(const Unit& u, int r, int c, const float (&v)[8]) const {
        const size_t row = (size_t)u.pm * 256 + r; const int col = ((u.pn & 1) * 256 + c) >> 1;
        u32x2 w; w.x = pk2(siluf_(v[0]) * v[4], siluf_(v[1]) * v[5]); w.y = pk2(siluf_(v[2]) * v[6], siluf_(v[3]) * v[7]);
        *(u32x2*)(HID + row * 256 + col) = w;
    } };
struct EpiDown { bf16* YS;
    __device__ __forceinline__ void store8(const Unit& u, int r, int c, const float (&v)[8]) const {
        const size_t row = (size_t)u.pm * 256 + r; *(u32x4*)(YS + row * 1024 + (u.pn & 3) * 256 + c) = pack8(v);
    } };


namespace pg8 {
#define PG8_LAS __attribute__((address_space(3)))
typedef ::bf16x8 bf16x8; typedef ::f32x4 f32x4;
using ::Unit; using ::Gemm;
constexpr int BM = 256, BK = 64, HALF = 128, HTB = HALF * BK * 2  , STAGE_BYTES = 8 * HTB;

__device__ __forceinline__ int lds_byte(int r, int c) { const int st = (r >> 4) * 2 + (c >> 5), rr = r & 15, cc = c & 31, ob = rr * 64 + cc * 2; return st * 1024 + (ob ^ (((ob >> 9) & 1) << 5)); }
__device__ __forceinline__ void stage_rc(int b, int& R, int& C) { const int st = b / 1024, sb = b % 1024, swz = sb ^ (((sb >> 9) & 1) << 5); R = (st >> 1) * 16 + swz / 64; C = (st & 1) * 32 + (swz % 64) / 2; }
__device__ __forceinline__ int perm32(int rho) { const int n = rho >> 4, i = rho & 15; return 8 * (i >> 2) + 4 * n + (i & 3); }
template <class Epi, class Sched, bool ALIGN_EPI = false, bool SP2 = false>
__device__ __forceinline__ void gemm_phase(PG8_LAS unsigned char* lds, const Gemm g, const Sched& S, const Epi& E, const int wave_in) {
    const int lane = lane_id_fresh(), wid = wave_in, tid = wid * 64 + lane,
              wr = wid >> 2, wc = wid & 3, fr = lane & 15, fq = lane >> 4;
    const int K = g.K, nt = K / BK;
    unsigned voffA[2], voffB[2];
#pragma unroll
    for (int i = 0; i < 2; ++i) { int R, C; stage_rc(tid * 16 + i * 8192, R, C); const int Rb = Epi::PERM ? ((R & ~31) + perm32(R & 31)) : R;
        voffA[i] = (unsigned)(R * K + C) * 2u; voffB[i] = (unsigned)(Rb * K + C) * 2u; }
    const size_t kstep = (size_t)(BK * 2);
    const size_t hstep = (size_t)HALF * K * 2;
    const size_t tstep = 2 * hstep;
    const unsigned ldsw = (unsigned)wid * 1024u;
    const int aoff = lds_byte(wr * 64 + fr, fq * 8), boff = lds_byte(wc * 32 + fr, fq * 8);
#define PG8_SA(b, h) (((b) * 2 + (h)) * HTB)
#define PG8_SB(b, h) ((4 + (b) * 2 + (h)) * HTB)
#define PG8_STAGE(bufoff, gbase, voff) do { _Pragma("unroll") for (int _i = 0; _i < 2; ++_i) \
        __builtin_amdgcn_global_load_lds((const unsigned*)((const char*)(gbase) + (voff)[_i]), (PG8_LAS unsigned*)(lds + (bufoff) + ldsw + _i * 8192), 16, 0, 0); } while (0)
#define PG8_LDA(dst, b, h) do { _Pragma("unroll") for (int m = 0; m < 4; ++m) _Pragma("unroll") for (int k = 0; k < 2; ++k) dst[m][k] = *(const PG8_LAS bf16x8*)(lds + PG8_SA(b, h) + aoff + m * 2048 + k * 1024); } while (0)
#define PG8_LDB(dst, b, h) do { _Pragma("unroll") for (int n = 0; n < 2; ++n) _Pragma("unroll") for (int k = 0; k < 2; ++k) dst[n][k] = *(const PG8_LAS bf16x8*)(lds + PG8_SB(b, h) + boff + n * 2048 + k * 1024); } while (0)
#define PG8_MMA(ai, bj, At, Bt) do { __builtin_amdgcn_s_setprio(1); _Pragma("unroll") for (int m = 0; m < 4; ++m) _Pragma("unroll") for (int n = 0; n < 2; ++n) _Pragma("unroll") for (int k = 0; k < 2; ++k) \
        acc[ai][bj][m][n] = __builtin_amdgcn_mfma_f32_16x16x32_bf16(Bt[n][k], At[m][k], acc[ai][bj][m][n], 0, 0, 0); __builtin_amdgcn_s_setprio(0); } while (0)
#define PG8_WAIT_V(n) asm volatile("s_waitcnt vmcnt(" #n ")" ::: "memory")
#define PG8_WAIT_L(n) asm volatile("s_waitcnt lgkmcnt(" #n ")" ::: "memory")
#define PG8_BAR __builtin_amdgcn_s_barrier()
#define PG8_SCHED __builtin_amdgcn_sched_barrier(0)
    Unit cur, nxt; int ui = 0;
    if (!S.next(0, cur)) return;
    f32x4 acc[2][2][4][2];
#pragma unroll
    for (int a = 0; a < 2; ++a)
#pragma unroll
        for (int b = 0; b < 2; ++b)
#pragma unroll
            for (int m = 0; m < 4; ++m)
#pragma unroll
                for (int n = 0; n < 2; ++n) acc[a][b][m][n] = (f32x4){0.f, 0.f, 0.f, 0.f};
    bf16x8 At[4][2], B0[2][2], B1[2][2];
    const char* cA = (const char*)g.A + (size_t)cur.pm * tstep; const char* cB = (const char*)g.Bt + (size_t)cur.pn * tstep;
    S.a_ready(cur);
    if constexpr (SP2) {
        PG8_STAGE(PG8_SB(0, 0), cB, voffB); PG8_STAGE(PG8_SB(0, 1), cB + hstep, voffB); PG8_STAGE(PG8_SA(0, 0), cA, voffA); PG8_STAGE(PG8_SA(0, 1), cA + hstep, voffA);
        if (wr == 1) PG8_BAR;
        PG8_WAIT_V(2); PG8_BAR;
        PG8_STAGE(PG8_SB(1, 0), cB + kstep, voffB); PG8_STAGE(PG8_SA(1, 0), cA + kstep, voffA); PG8_STAGE(PG8_SB(1, 1), cB + hstep + kstep, voffB);
        PG8_WAIT_V(6); PG8_BAR;
    } else {
        PG8_STAGE(PG8_SB(0, 0), cB, voffB); PG8_STAGE(PG8_SA(0, 0), cA, voffA); PG8_STAGE(PG8_SB(0, 1), cB + hstep, voffB); PG8_STAGE(PG8_SA(0, 1), cA + hstep, voffA);
        if (wr == 1) PG8_BAR;
        PG8_WAIT_V(4); PG8_BAR;
        PG8_STAGE(PG8_SB(1, 0), cB + kstep, voffB); PG8_STAGE(PG8_SA(1, 0), cA + kstep, voffA); PG8_STAGE(PG8_SB(1, 1), cB + hstep + kstep, voffB);
        PG8_WAIT_V(6); PG8_BAR;
    }
    for (;;) {
        const bool has_next = S.next(ui + 1, nxt);
        const char* nA = has_next ? (const char*)g.A + (size_t)nxt.pm * tstep : cA; const char* nB = has_next ? (const char*)g.Bt + (size_t)nxt.pn * tstep : cB;
        for (int t = 0; t < nt; t += 2) {
            const bool last = (t == nt - 2);
            const char* a1 = cA + (size_t)(t + 1) * kstep;
            const char* a2 = last ? nA : cA + (size_t)(t + 2) * kstep; const char* b2 = last ? nB : cB + (size_t)(t + 2) * kstep;
            const char* a3 = a2 + kstep; const char* b3 = b2 + kstep;
            if (last && has_next) S.a_ready(nxt);
            if constexpr (SP2) {
            PG8_LDB(B0, 0, 0); PG8_LDB(B1, 0, 1); PG8_SCHED; PG8_LDA(At, 0, 0); PG8_STAGE(PG8_SA(1, 1), a1 + hstep, voffA);
            PG8_WAIT_V(8); PG8_WAIT_L(0); PG8_BAR; PG8_MMA(0, 0, At, B0); PG8_MMA(0, 1, At, B1); PG8_BAR; PG8_SCHED;
            PG8_LDA(At, 0, 1); PG8_STAGE(PG8_SB(0, 0), b2, voffB); PG8_STAGE(PG8_SB(0, 1), b2 + hstep, voffB); PG8_STAGE(PG8_SA(0, 0), a2, voffA);
            PG8_WAIT_V(8); PG8_WAIT_L(0); PG8_BAR; PG8_MMA(1, 0, At, B0); PG8_MMA(1, 1, At, B1); PG8_BAR; PG8_SCHED;
            PG8_LDB(B0, 1, 0); PG8_LDB(B1, 1, 1); PG8_SCHED; PG8_LDA(At, 1, 0); PG8_STAGE(PG8_SA(0, 1), a2 + hstep, voffA);
            PG8_WAIT_V(8); PG8_WAIT_L(0); PG8_BAR; PG8_MMA(0, 0, At, B0); PG8_MMA(0, 1, At, B1); PG8_BAR; PG8_SCHED;
            PG8_LDA(At, 1, 1); PG8_STAGE(PG8_SB(1, 0), b3, voffB); PG8_STAGE(PG8_SB(1, 1), b3 + hstep, voffB); PG8_STAGE(PG8_SA(1, 0), a3, voffA);
            PG8_WAIT_V(8); PG8_WAIT_L(0); PG8_BAR; PG8_MMA(1, 0, At, B0); PG8_MMA(1, 1, At, B1); PG8_BAR; PG8_SCHED;
            } else {
            PG8_LDB(B0, 0, 0); PG8_SCHED; PG8_LDA(At, 0, 0); PG8_STAGE(PG8_SA(1, 1), a1 + hstep, voffA);
            PG8_WAIT_L(8); PG8_BAR; PG8_WAIT_L(0); PG8_MMA(0, 0, At, B0); PG8_BAR; PG8_SCHED;
            PG8_LDB(B1, 0, 1); PG8_STAGE(PG8_SB(0, 0), b2, voffB);
            PG8_BAR; PG8_WAIT_L(0); PG8_MMA(0, 1, At, B1); PG8_BAR;
            PG8_LDA(At, 0, 1); PG8_STAGE(PG8_SA(0, 0), a2, voffA);
            PG8_BAR; PG8_WAIT_L(0); PG8_MMA(1, 0, At, B0); PG8_BAR; PG8_SCHED;
            PG8_STAGE(PG8_SB(0, 1), b2 + hstep, voffB);
            PG8_WAIT_V(6); PG8_BAR; PG8_MMA(1, 1, At, B1); PG8_BAR;
            PG8_LDB(B0, 1, 0); PG8_SCHED; PG8_LDA(At, 1, 0); PG8_STAGE(PG8_SA(0, 1), a2 + hstep, voffA);
            PG8_WAIT_L(8); PG8_BAR; PG8_WAIT_L(0); PG8_MMA(0, 0, At, B0); PG8_BAR; PG8_SCHED;
            PG8_LDB(B1, 1, 1); PG8_STAGE(PG8_SB(1, 0), b3, voffB);
            PG8_BAR; PG8_WAIT_L(0); PG8_MMA(0, 1, At, B1); PG8_BAR;
            PG8_LDA(At, 1, 1); PG8_STAGE(PG8_SA(1, 0), a3, voffA);
            PG8_BAR; PG8_WAIT_L(0); PG8_MMA(1, 0, At, B0); PG8_BAR; PG8_SCHED;
            PG8_STAGE(PG8_SB(1, 1), b3 + hstep, voffB);
            PG8_WAIT_V(6); PG8_BAR; PG8_MMA(1, 1, At, B1); PG8_BAR;
            }
        }
        if constexpr (ALIGN_EPI) { if (wr == 0) PG8_BAR; }
        if constexpr (!Epi::AFTER_DRAIN) { E(acc, cur, wr, wc, fr, fq); S.done(cur); }
        if (!has_next) break;
#pragma unroll
        for (int a = 0; a < 2; ++a)
#pragma unroll
            for (int b = 0; b < 2; ++b)
#pragma unroll
                for (int m = 0; m < 4; ++m)
#pragma unroll
                    for (int n = 0; n < 2; ++n) acc[a][b][m][n] = (f32x4){0.f, 0.f, 0.f, 0.f};
        cur = nxt; cA = nA; cB = nB; ++ui;
        if constexpr (ALIGN_EPI) { if (wr == 1) PG8_BAR; }
    }
    PG8_WAIT_V(0);
    if constexpr (!ALIGN_EPI) { if (wr == 0) PG8_BAR; }
    PG8_BAR;
    if constexpr (Epi::AFTER_DRAIN) { E.fused(acc, cur, wr, wc, fr, fq, lds, wid, lane); S.done(cur); }
#undef PG8_SA
#undef PG8_SB
#undef PG8_STAGE
#undef PG8_LDA
#undef PG8_LDB
#undef PG8_MMA
#undef PG8_WAIT_V
#undef PG8_WAIT_L
#undef PG8_BAR
#undef PG8_SCHED
}

template <class F> struct EpiAdapt {
    static constexpr bool PERM = true, AFTER_DRAIN = false; F f;
    __device__ __forceinline__ void operator()(const f32x4 (&acc)[2][2][4][2], const Unit& u, int wr, int wc, int fr, int fq) const {
        asm volatile("" : "+v"(fr), "+v"(fq));
#pragma unroll
        for (int ai = 0; ai < 2; ++ai)
#pragma unroll
            for (int m = 0; m < 4; ++m) { const int row = ai * HALF + wr * 64 + m * 16 + fr;
#pragma unroll
                for (int bj = 0; bj < 2; ++bj) { const f32x4 v0 = acc[ai][bj][m][0], v1 = acc[ai][bj][m][1];
                    const float v[8] = {v0[0], v0[1], v0[2], v0[3], v1[0], v1[1], v1[2], v1[3]};
                    f.store8(u, row, bj * HALF + wc * 32 + 8 * fq, v); } }
    }
};
}

template <class Epi, class Sched>
__device__ __forceinline__ void gemm_phase_any(LAS unsigned char* lds, const Gemm g, const Sched& S, const Epi& E, const int wave_in) {
#if ENG_GEMM == 1
    pg8::EpiAdapt<Epi> EA{E};
    pg8::gemm_phase<pg8::EpiAdapt<Epi>, Sched, true, true>(lds, g, S, EA, wave_in);
#else
    gemm_phase_naive<Epi, Sched>(lds, g, S, E);
#endif
}

template <class RowMap>
__device__ __forceinline__ void transpose_item(const float* W, int ldw, bf16* WT, int ldt, int koff, int k0, int n0, const RowMap& rm, LAS float* scr, int lane) {
#pragma unroll 8
    for (int i = 0; i < 32; ++i) { const int kk = 2 * i + (lane >> 5); scr[kk * 33 + (lane & 31)] = W[(size_t)(k0 + kk) * ldw + n0 + (lane & 31)]; }
    asm volatile("s_waitcnt lgkmcnt(0)" ::: "memory");
    const int c = lane & 7;
#pragma unroll
    for (int j = 0; j < 4; ++j) { const int n = (lane >> 3) + 8 * j; const LAS float* s = scr + (8 * c) * 33 + n;
        u32x4 o; o.x = pk2(s[0 * 33], s[1 * 33]); o.y = pk2(s[2 * 33], s[3 * 33]); o.z = pk2(s[4 * 33], s[5 * 33]); o.w = pk2(s[6 * 33], s[7 * 33]);
        *(u32x4*)(WT + (size_t)rm(n0 + n) * ldt + koff + k0 + 8 * c) = o; }
    asm volatile("s_waitcnt lgkmcnt(0)" ::: "memory");
}
struct RmId { int off; __device__ int operator()(int n) const { return off + n; } };
struct RmWin { __device__ int operator()(int n) const { return n < 1792 ? n : (n < 2208 ? 3840 + (n - 1792) : 1792 + (n - 2208)); } };
struct RmUkv { __device__ int operator()(int n) const { const int h = n >> 7, j = n & 127; return j < 64 ? h * 64 + j : 512 + h * 64 + (j - 64); } };
struct RmGU { int off; __device__ int operator()(int j) const { return off + 8 * (j >> 2) + (j & 3); } };

__device__ __forceinline__ void p0_prologue(const Frame& F, ArgsP a) {
    const int lane_f = lane_id_fresh(), tid_f = F.wave * 64 + lane_f;
    LAS float* scr = (LAS float*)(F.lds + F.wave * 16384);
    const int lane = lane_f;
    bf16* Win = (bf16*)(F.ws + WS_WIN); bf16* Wblk = (bf16*)(F.ws + WS_WBLK); bf16* Wg = (bf16*)(F.ws + WS_WG); bf16* Wuq = (bf16*)(F.ws + WS_WUQ);
    bf16* Wukv = (bf16*)(F.ws + WS_WUKV); bf16* Wb = (bf16*)(F.ws + WS_WB); bf16* Wo = (bf16*)(F.ws + WS_WO); bf16* Wgu = (bf16*)(F.ws + WS_WGU); bf16* Wdn = (bf16*)(F.ws + WS_WDN);
    constexpr int I_IN = 16 * 133, I_DEC = 1 * 16, I_AUP = 16, I_GUP = 2 * 16, I_UQ = 4 * 24, I_UKV = 2 * 32, I_BR = 2 * 8 * 32, I_O = 16 * 32;
    constexpr int I_EG = 32 * 16 * 8, I_EU = I_EG, I_ED = 32 * 4 * 32;
    constexpr int NITEMS = I_IN + I_DEC + I_AUP + I_GUP + I_UQ + I_UKV + I_BR + I_O + I_EG + I_EU + I_ED;
    for (int it = F.gw; it < NITEMS; it += F.NGW) {
        int r = it;
        if (r < I_IN) { const int kb = r / 133, nb = r % 133; transpose_item(a->in[I_WIN], D_IN, Win, 1024, 0, 64 * kb, 32 * nb, RmWin{}, scr, lane); continue; } r -= I_IN;
        if (r < I_DEC) { transpose_item(a->in[I_WDEC], 512, Wblk, 128, 0, 0, 32 * r, RmId{0}, scr, lane); continue; } r -= I_DEC;
        if (r < I_AUP) { transpose_item(a->in[I_WAUP], 512, Wblk, 128, 64, 0, 32 * r, RmId{512}, scr, lane); continue; } r -= I_AUP;
        if (r < I_GUP) { const int kb = r / 16, nb = r % 16; transpose_item(a->in[I_WGUP], 512, Wg, 128, 0, 64 * kb, 32 * nb, RmId{0}, scr, lane); continue; } r -= I_GUP;
        if (r < I_UQ) { const int kb = r / 24, nb = r % 24; transpose_item(a->in[I_WUQ], 768, Wuq, 256, 0, 64 * kb, 32 * nb, RmId{0}, scr, lane); continue; } r -= I_UQ;
        if (r < I_UKV) { const int kb = r / 32, nb = r % 32; transpose_item(a->in[I_WUKV], 1024, Wukv, 128, 0, 64 * kb, 32 * nb, RmUkv{}, scr, lane); continue; } r -= I_UKV;
        if (r < I_BR) { const int br = r / 256, q = r % 256, kb = q / 32, nb = q % 32; transpose_item(a->in[I_WBR] + (size_t)br * 512 * 1024, 1024, Wb + (size_t)br * 1024 * 512, 512, 0, 64 * kb, 32 * nb, RmId{0}, scr, lane); continue; } r -= I_BR;
        if (r < I_O) { const int kb = r / 32, nb = r % 32; transpose_item(a->in[I_WOUT], 1024, Wo, 1024, 0, 64 * kb, 32 * nb, RmId{0}, scr, lane); continue; } r -= I_O;
        if (r < I_EG) { const int e = r / 128, q = r % 128, kb = q / 8, nb = q % 8; transpose_item(a->in[I_WEG] + (size_t)e * 1024 * 256, 256, Wgu + (size_t)e * 512 * 1024, 1024, 0, 64 * kb, 32 * nb, RmGU{0}, scr, lane); continue; } r -= I_EG;
        if (r < I_EU) { const int e = r / 128, q = r % 128, kb = q / 8, nb = q % 8; transpose_item(a->in[I_WEU] + (size_t)e * 1024 * 256, 256, Wgu + (size_t)e * 512 * 1024, 1024, 0, 64 * kb, 32 * nb, RmGU{4}, scr, lane); continue; } r -= I_EU;
        { const int e = r / 128, q = r % 128, kb = q / 32, nb = q % 32; transpose_item(a->in[I_WED] + (size_t)e * 256 * 1024, 1024, Wdn + (size_t)e * 1024 * 256, 256, 0, 64 * kb, 32 * nb, RmId{0}, scr, lane); }
    }
    for (int i = F.gw * 64 + lane; i < 96 * 128; i += F.NGW * 64) *(u32x4*)(Win + (size_t)4256 * 1024 + (size_t)i * 8) = (u32x4){0u, 0u, 0u, 0u};
    for (int i = F.gw * 64 + lane; i < 1024 * 8; i += F.NGW * 64) { const int row = i >> 3, c8 = (i & 7) * 8; *(u32x4*)(Wblk + row * 128 + (row < 512 ? 64 : 0) + c8) = (u32x4){0u, 0u, 0u, 0u}; }
    { const int* pos = (const int*)a->in[I_POS]; float* cs = (float*)(F.ws + WS_CS);
      for (int i = F.gw * 64 + lane; i < NTOK * 16; i += F.NGW * 64) { const int t = i >> 4, j = i & 15;
          const float fr = exp2f(-(float)j * (13.287712379549449f / 16.0f));
          const float ang = (float)pos[t] * fr; cs[t * 32 + j] = cosf(ang); cs[t * 32 + 16 + j] = sinf(ang); } }
    { float* mod = (float*)(F.ws + WS_MOD); const float* c = a->in[I_C]; const float* wa = a->in[I_WADA]; const float* ba = a->in[I_BADA];
      LAS float* red = (LAS float*)(F.lds + 8 * 16384);
      for (int nb = F.vcu; nb < 96; nb += F.G) {
          float acc[8];
#pragma unroll
          for (int b = 0; b < 8; ++b) acc[b] = 0.f;
          const int n = nb * 64 + lane;
          for (int k = F.wave * 128; k < F.wave * 128 + 128; ++k) { const float w = wa[(size_t)k * 6144 + n];
#pragma unroll
              for (int b = 0; b < 8; ++b) acc[b] = fmaf(siluf_(c[b * 1024 + k]), w, acc[b]); }
#pragma unroll
          for (int b = 0; b < 8; ++b) red[(F.wave * 8 + b) * 64 + lane] = acc[b];
          __syncthreads();
          { const int b = F.wave; float s = ba[n];
#pragma unroll
            for (int w = 0; w < 8; ++w) s += red[(w * 8 + b) * 64 + lane];
            mod[b * 6144 + n] = s; }
          __syncthreads();
      } }
}

__device__ __forceinline__ void p_normmod(const Frame& F, const float* x, const float* g, const float* mod, int sh_off, int sc_off, bf16* H) {
    const int lane_f = lane_id_fresh(), tid_f = F.wave * 64 + lane_f;
    for (int m = F.gw; m < NTOK; m += F.NGW) {
        const int b = m / SEQ; const f32x4* xr = (const f32x4*)(x + (size_t)m * 1024) + lane_f;
        f32x4 v[4]; float s = 0.f;
#pragma unroll
        for (int j = 0; j < 4; ++j) { v[j] = xr[64 * j]; s += (v[j].x * v[j].x + v[j].y * v[j].y) + (v[j].z * v[j].z + v[j].w * v[j].w); }
        const float rstd = 1.0f / sqrtf(wave_sum(s) * (1.f / 1024.f) + EPS);
        u32x2* o = (u32x2*)(H + (size_t)m * 1024) + lane_f;
#pragma unroll
        for (int j = 0; j < 4; ++j) { const int col = 4 * lane_f + 256 * j;
            const f32x4 gg = *(const f32x4*)(g + col), sc = *(const f32x4*)(mod + b * 6144 + sc_off + col), sh = *(const f32x4*)(mod + b * 6144 + sh_off + col);
            const f32x4 y = v[j] * rstd * gg * (sc + 1.0f) + sh; u32x2 w; w.x = pk2(y.x, y.y); w.y = pk2(y.z, y.w); o[64 * j] = w; }
    }
}

__device__ __forceinline__ void p_prep_a(const Frame& F, ArgsP a) {
    const int lane_f = lane_id_fresh(), tid_f = F.wave * 64 + lane_f;
    const bf16* ZR = (const bf16*)(F.ws + WS_ZR); const bf16* ZM = (const bf16*)(F.ws + WS_ZM);
    bf16* R = (bf16*)(F.ws + WS_R); bf16* V = (bf16*)(F.ws + WS_V); bf16* ZK = (bf16*)(F.ws + WS_ZK);
    bf16* TWA = (bf16*)(F.ws + WS_TWA); bf16* SGL = (bf16*)(F.ws + WS_SGL); bf16* QA = (bf16*)(F.ws + WS_QA); bf16* KVA = (bf16*)(F.ws + WS_KVA);
    const float* mu = a->in[I_MU]; const float* gqa = a->in[I_GQA]; const float* gkva = a->in[I_GKVA];
    const int lane = lane_f;
    for (int m = F.gw; m < NTOK; m += F.NGW) {
        const bool first = (m % SEQ) == 0;
        const u32x2* zc = (const u32x2*)(ZR + (size_t)m * 1792) + lane; const u32x2* zp = (const u32x2*)(ZR + (size_t)(first ? m : m - 1) * 1792) + lane;
#pragma unroll
        for (int ch = 0; ch < 7; ++ch) {
            const u32x2 c = zc[64 * ch]; u32x2 p = zp[64 * ch]; if (first) { p.x = 0u; p.y = 0u; }
            const f32x4 mm = *(const f32x4*)(mu + 256 * ch + 4 * lane);
            float z[4] = {lo2f(c.x), hi2f(c.x), lo2f(c.y), hi2f(c.y)}; const float q[4] = {lo2f(p.x), hi2f(p.x), lo2f(p.y), hi2f(p.y)};
            z[0] += (q[0] - z[0]) * mm.x; z[1] += (q[1] - z[1]) * mm.y; z[2] += (q[2] - z[2]) * mm.z; z[3] += (q[3] - z[3]) * mm.w;
            if (ch < 6) { bf16* dst = (ch < 2) ? R : (ch < 4 ? ZK : V); u32x2 w; w.x = pk2(z[0], z[1]); w.y = pk2(z[2], z[3]);
                *((u32x2*)(dst + (size_t)m * 512 + 256 * (ch & 1)) + lane) = w; }
            else {
                if (lane < 16) { u32x2 w; w.x = pk2(tanhf(z[0]), tanhf(z[1])); w.y = pk2(tanhf(z[2]), tanhf(z[3])); *((u32x2*)(TWA + (size_t)m * 128) + lane) = w; }
                else if (lane < 32) { u32x2 w; w.x = pk2(z[0], z[1]); w.y = pk2(z[2], z[3]); *((u32x2*)(TWA + (size_t)m * 128) + lane) = w; }
                else { u32x2 w; w.x = pk2(sigmoidf_(z[0]), sigmoidf_(z[1])); w.y = pk2(sigmoidf_(z[2]), sigmoidf_(z[3])); *((u32x2*)(SGL + (size_t)m * 128) + (lane - 32)) = w; }
            }
        }
        { const u32x2 c = *((const u32x2*)(ZM + (size_t)m * 512) + lane); const float z[4] = {lo2f(c.x), hi2f(c.x), lo2f(c.y), hi2f(c.y)};
          const float rstd = 1.0f / sqrtf(wave_sum((z[0] * z[0] + z[1] * z[1]) + (z[2] * z[2] + z[3] * z[3])) * (1.f / 256.f) + EPS);
          const f32x4 gg = *(const f32x4*)(gqa + 4 * lane); u32x2 w; w.x = pk2(z[0] * rstd * gg.x, z[1] * rstd * gg.y); w.y = pk2(z[2] * rstd * gg.z, z[3] * rstd * gg.w);
          *((u32x2*)(QA + (size_t)m * 256) + lane) = w; }
        { u32x2 c = (u32x2){0u, 0u}; if (lane < 32) c = *((const u32x2*)(ZM + (size_t)m * 512 + 256) + lane); const float z[4] = {lo2f(c.x), hi2f(c.x), lo2f(c.y), hi2f(c.y)};
          const float rstd = 1.0f / sqrtf(wave_sum((z[0] * z[0] + z[1] * z[1]) + (z[2] * z[2] + z[3] * z[3])) * (1.f / 128.f) + EPS);
          if (lane < 32) { const f32x4 gg = *(const f32x4*)(gkva + 4 * lane); u32x2 w; w.x = pk2(z[0] * rstd * gg.x, z[1] * rstd * gg.y); w.y = pk2(z[2] * rstd * gg.z, z[3] * rstd * gg.w);
              *((u32x2*)(KVA + (size_t)m * 128) + lane) = w; } }
    }
}

__device__ __forceinline__ void p_prep_c(const Frame& F, ArgsP a) {
    const int lane_f = lane_id_fresh(), tid_f = F.wave * 64 + lane_f;
    bf16* ZK = (bf16*)(F.ws + WS_ZK); bf16* A = (bf16*)(F.ws + WS_A); bf16* KK = (bf16*)(F.ws + WS_KK);
    bf16* Q = (bf16*)(F.dob + DO_Q); const bf16* KN = (const bf16*)(F.dob + DO_KN); const bf16* ZM = (const bf16*)(F.ws + WS_ZM); bf16* KC = (bf16*)(F.ws + WS_KC);
    const float* cs = (const float*)(F.ws + WS_CS);
    const float* k_k = a->in[I_KK]; const float* k_a = a->in[I_KA]; const float* qn = a->in[I_QN]; const float* kn = a->in[I_KN];
    const int lane = lane_f, hd = lane >> 3, j = lane & 7;
    for (int m = F.gw; m < NTOK; m += F.NGW) {
        { float zk[8], av[8], ko[8], kr[8], bo[8]; unpack8(*((const u32x4*)(ZK + (size_t)m * 512) + lane), zk); unpack8(*((const u32x4*)(A + (size_t)m * 512) + lane), av);
          float ss = 0.f;
#pragma unroll
          for (int i = 0; i < 8; ++i) { const int col = 8 * lane + i; ko[i] = zk[i] * (1.f + (av[i] - 1.f) * k_a[col]); kr[i] = zk[i] * k_k[col]; ss += kr[i] * kr[i]; }
          const float inv = 1.0f / fmaxf(sqrtf(sum8(ss)), 1e-12f);
#pragma unroll
          for (int i = 0; i < 8; ++i) { kr[i] *= inv; bo[i] = kr[i] * av[i]; }
          *((u32x4*)(ZK + (size_t)m * 512) + lane) = pack8(ko); *((u32x4*)(KK + (size_t)m * 512) + lane) = pack8(kr); *((u32x4*)(A + (size_t)m * 512) + lane) = pack8(bo); }
        const f32x2 cc = *(const f32x2*)(cs + (size_t)m * 32 + 2 * j), sn = *(const f32x2*)(cs + (size_t)m * 32 + 16 + 2 * j);
        { bf16* qp = Q + (size_t)m * 768 + hd * 96; float v[8]; unpack8(*(const u32x4*)(qp + 8 * j), v);
          const unsigned w1 = *(const unsigned*)(qp + 64 + 2 * j), w2 = *(const unsigned*)(qp + 80 + 2 * j); float x1[2] = {lo2f(w1), hi2f(w1)}, x2[2] = {lo2f(w2), hi2f(w2)};
          float ss = (x1[0] * x1[0] + x1[1] * x1[1]) + (x2[0] * x2[0] + x2[1] * x2[1]);
#pragma unroll
          for (int i = 0; i < 8; ++i) ss += v[i] * v[i];
          const float rstd = 1.0f / sqrtf(sum8(ss) * (1.f / 96.f) + EPS);
#pragma unroll
          for (int i = 0; i < 8; ++i) v[i] = v[i] * rstd * qn[8 * j + i] * QSCALE;
          x1[0] *= rstd * qn[64 + 2 * j]; x1[1] *= rstd * qn[65 + 2 * j]; x2[0] *= rstd * qn[80 + 2 * j]; x2[1] *= rstd * qn[81 + 2 * j];
          const float o1a = (x1[0] * cc.x - x2[0] * sn.x) * QSCALE, o1b = (x1[1] * cc.y - x2[1] * sn.y) * QSCALE, o2a = (x2[0] * cc.x + x1[0] * sn.x) * QSCALE, o2b = (x2[1] * cc.y + x1[1] * sn.y) * QSCALE;
          *(u32x4*)(qp + 8 * j) = pack8(v); *(unsigned*)(qp + 64 + 2 * j) = pk2(o1a, o1b); *(unsigned*)(qp + 80 + 2 * j) = pk2(o2a, o2b); }
        { float v[8]; unpack8(*(const u32x4*)(KN + (size_t)m * 512 + hd * 64 + 8 * j), v);
          const unsigned w1 = *(const unsigned*)(ZM + (size_t)m * 512 + 384 + 2 * j), w2 = *(const unsigned*)(ZM + (size_t)m * 512 + 400 + 2 * j); float x1[2] = {lo2f(w1), hi2f(w1)}, x2[2] = {lo2f(w2), hi2f(w2)};
          float ss = (x1[0] * x1[0] + x1[1] * x1[1]) + (x2[0] * x2[0] + x2[1] * x2[1]);
#pragma unroll
          for (int i = 0; i < 8; ++i) ss += v[i] * v[i];
          const float rstd = 1.0f / sqrtf(sum8(ss) * (1.f / 96.f) + EPS);
#pragma unroll
          for (int i = 0; i < 8; ++i) v[i] = v[i] * rstd * kn[8 * j + i];
          x1[0] *= rstd * kn[64 + 2 * j]; x1[1] *= rstd * kn[65 + 2 * j]; x2[0] *= rstd * kn[80 + 2 * j]; x2[1] *= rstd * kn[81 + 2 * j];
          bf16* kp = KC + (size_t)m * 768 + hd * 96;
          *(u32x4*)(kp + 8 * j) = pack8(v); *(unsigned*)(kp + 64 + 2 * j) = pk2(x1[0] * cc.x - x2[0] * sn.x, x1[1] * cc.y - x2[1] * sn.y);
          *(unsigned*)(kp + 80 + 2 * j) = pk2(x2[0] * cc.x + x1[0] * sn.x, x2[1] * cc.y + x1[1] * sn.y); }
    }
}

constexpr int SC_T = 32;
constexpr int SC_BUF = 5 * SC_T * 64 * 4 + SC_T * 16 * 4 + SC_T * 16 * 4;
template <int CTRL> __device__ __forceinline__ float dpp_add(float x) { return x + __builtin_bit_cast(float, __builtin_amdgcn_update_dpp(0, __builtin_bit_cast(int, x), CTRL, 0xf, 0xf, false)); }
__device__ __forceinline__ float allsum16(float x) { x = dpp_add<0xB1>(x); x = dpp_add<0x4E>(x); x = dpp_add<0x141>(x); x = dpp_add<0x140>(x); return x; }
__device__ __forceinline__ void p_scan(const Frame& F) {
    const int lane_f = lane_id_fresh(), tid_f = F.wave * 64 + lane_f;
    const bf16* R = (const bf16*)(F.ws + WS_R); const bf16* K = (const bf16*)(F.ws + WS_ZK); const bf16* V = (const bf16*)(F.ws + WS_V);
    const bf16* KK = (const bf16*)(F.ws + WS_KK); const bf16* B = (const bf16*)(F.ws + WS_A); const bf16* LW = (const bf16*)(F.ws + WS_LW); bf16* Y = (bf16*)(F.ws + WS_Y);
    const int lane = lane_f, wave = F.wave, tid = tid_f;
    for (int item = F.vcu; item < 256; item += F.G) {
        const int bh = item >> 2, qt = item & 3, b = bh >> 3, h = bh & 7;
        const size_t row0 = (size_t)b * SEQ; const int colh = h * 64;
        float S0 = 0.f, S1 = 0.f, S2 = 0.f, S3 = 0.f;
        const int NCH = SEQ / SC_T;
        __syncthreads();
        for (int c = 0; c <= NCH + 1; ++c) {
            LAS unsigned char* bs = F.lds + (c & 1) * SC_BUF;
            LAS unsigned char* bc = F.lds + ((c + 1) & 1) * SC_BUF;
            if (wave >= 4) {
                const int lt = tid - 256;
                if (c >= 2 && lt < 64) { const int st = lt >> 1, hf = lt & 1; const LAS float* yy = (const LAS float*)(bs + 5 * SC_T * 256 + SC_T * 64) + st * 16 + hf * 8;
                    float v[8];
#pragma unroll
                    for (int i = 0; i < 8; ++i) v[i] = yy[i];
                    *(u32x4*)(Y + (row0 + (size_t)(c - 2) * SC_T + st) * 512 + colh + qt * 16 + hf * 8) = pack8(v); }
                if (c < NCH) {
                    const int st = lt >> 3, j8 = (lt & 7) * 8; const size_t g = (row0 + (size_t)c * SC_T + st) * 512 + colh + j8;
                    float v[8]; LAS float* dst = (LAS float*)bs + st * 64 + j8;
                    unpack8(*(const u32x4*)(LW + g), v);
#pragma unroll
                    for (int i = 0; i < 8; ++i) dst[i] = __expf(v[i]);
                    unpack8(*(const u32x4*)(KK + g), v);
#pragma unroll
                    for (int i = 0; i < 8; ++i) dst[SC_T * 64 + i] = -v[i];
                    unpack8(*(const u32x4*)(B + g), v);
#pragma unroll
                    for (int i = 0; i < 8; ++i) dst[2 * SC_T * 64 + i] = v[i];
                    unpack8(*(const u32x4*)(K + g), v);
#pragma unroll
                    for (int i = 0; i < 8; ++i) dst[3 * SC_T * 64 + i] = v[i];
                    unpack8(*(const u32x4*)(R + g), v);
#pragma unroll
                    for (int i = 0; i < 8; ++i) dst[4 * SC_T * 64 + i] = v[i];
                    if (lt < 64) { const int s2 = lt >> 1, hf = lt & 1; unpack8(*(const u32x4*)(V + (row0 + (size_t)c * SC_T + s2) * 512 + colh + qt * 16 + hf * 8), v);
                        LAS float* dv = (LAS float*)(bs + 5 * SC_T * 256) + s2 * 16 + hf * 8;
#pragma unroll
                        for (int i = 0; i < 8; ++i) dv[i] = v[i]; }
                }
            } else if (c >= 1 && c <= NCH) {
                const int rg = lane >> 4, jl = lane & 15;
                const LAS float* base = (const LAS float*)bc + 4 * jl;
                const LAS float* vb = (const LAS float*)(bc + 5 * SC_T * 256) + wave * 4 + rg;
                LAS float* yb = (LAS float*)(bc + 5 * SC_T * 256 + SC_T * 64) + wave * 4 + rg;
#pragma unroll 4
                for (int st = 0; st < SC_T; ++st) {
                    const f32x4 w = *(const LAS f32x4*)(base + st * 64), nk = *(const LAS f32x4*)(base + SC_T * 64 + st * 64), bb = *(const LAS f32x4*)(base + 2 * SC_T * 64 + st * 64),
                                kv = *(const LAS f32x4*)(base + 3 * SC_T * 64 + st * 64), rr = *(const LAS f32x4*)(base + 4 * SC_T * 64 + st * 64);
                    const float v = vb[st * 16];
                    float sa = (S0 * nk.x + S1 * nk.y) + (S2 * nk.z + S3 * nk.w);
                    sa = allsum16(sa);
                    S0 = fmaf(S0, w.x, fmaf(sa, bb.x, v * kv.x)); S1 = fmaf(S1, w.y, fmaf(sa, bb.y, v * kv.y));
                    S2 = fmaf(S2, w.z, fmaf(sa, bb.z, v * kv.z)); S3 = fmaf(S3, w.w, fmaf(sa, bb.w, v * kv.w));
                    float y = (S0 * rr.x + S1 * rr.y) + (S2 * rr.z + S3 * rr.w);
                    y = allsum16(y);
                    if (jl == 0) yb[st * 16] = y;
                }
            }
            __syncthreads();
        }
    }
}

__device__ __forceinline__ void p_attn_naive(const Frame& F) {
    const int lane_f = lane_id_fresh(), tid_f = F.wave * 64 + lane_f;
    const bf16* Q = (const bf16*)(F.dob + DO_Q); const bf16* KC = (const bf16*)(F.ws + WS_KC); const bf16* VC = (const bf16*)(F.ws + WS_VC); bf16* YM = (bf16*)(F.ws + WS_YM);
    LAS float* Ks = (LAS float*)F.lds; LAS float* Vs = (LAS float*)(F.lds + 32 * 96 * 4);
    const int tid = tid_f;
    for (int unit = F.vcu; unit < 64 * 16; unit += F.G) {
        const int bh = unit >> 4, qb = 15 - (unit & 15), b = bh >> 3, h = bh & 7; const size_t row0 = (size_t)b * SEQ; const int t = qb * 512 + tid;
        unsigned qp[48];
        { const u32x4* qg = (const u32x4*)(Q + (row0 + t) * 768 + h * 96);
#pragma unroll
          for (int i = 0; i < 12; ++i) { const u32x4 w = qg[i]; qp[4 * i] = w.x; qp[4 * i + 1] = w.y; qp[4 * i + 2] = w.z; qp[4 * i + 3] = w.w; } }
        float o[64];
#pragma unroll
        for (int i = 0; i < 64; ++i) o[i] = 0.f;
        float mx = -INFINITY, l = 0.f;
        const int nkt = (qb + 1) * 16;
        for (int kt = 0; kt < nkt; ++kt) {
            __syncthreads();
            if (tid < 384) { const int r = tid / 12, c8 = (tid % 12) * 8; float v[8]; unpack8(*(const u32x4*)(KC + (row0 + kt * 32 + r) * 768 + h * 96 + c8), v);
#pragma unroll
                for (int i = 0; i < 8; ++i) Ks[r * 96 + c8 + i] = v[i]; }
            if (tid < 256) { const int r = tid >> 3, c8 = (tid & 7) * 8; float v[8]; unpack8(*(const u32x4*)(VC + (row0 + kt * 32 + r) * 512 + h * 64 + c8), v);
#pragma unroll
                for (int i = 0; i < 8; ++i) Vs[r * 64 + c8 + i] = v[i]; }
            __syncthreads();
            for (int kk = 0; kk < 32; ++kk) {
                const int kv = kt * 32 + kk;
                float s = 0.f; const LAS f32x4* kr = (const LAS f32x4*)(Ks + kk * 96);
#pragma unroll
                for (int i = 0; i < 24; ++i) { const f32x4 k4 = kr[i]; s += lo2f(qp[2 * i]) * k4.x + hi2f(qp[2 * i]) * k4.y + lo2f(qp[2 * i + 1]) * k4.z + hi2f(qp[2 * i + 1]) * k4.w; }
                if (kv <= t) {
                    const float mn = fmaxf(mx, s), f = exp2f(mx - mn), p = exp2f(s - mn); mx = mn; l = l * f + p;
                    const LAS f32x4* vr = (const LAS f32x4*)(Vs + kk * 64);
#pragma unroll
                    for (int i = 0; i < 16; ++i) { const f32x4 v4 = vr[i]; o[4 * i] = o[4 * i] * f + p * v4.x; o[4 * i + 1] = o[4 * i + 1] * f + p * v4.y; o[4 * i + 2] = o[4 * i + 2] * f + p * v4.z; o[4 * i + 3] = o[4 * i + 3] * f + p * v4.w; }
                }
            }
        }
        const float il = 1.f / l; u32x4* og = (u32x4*)(YM + (row0 + t) * 512 + h * 64);
#pragma unroll
        for (int i = 0; i < 8; ++i) { u32x4 w; w.x = pk2(o[8 * i] * il, o[8 * i + 1] * il); w.y = pk2(o[8 * i + 2] * il, o[8 * i + 3] * il); w.z = pk2(o[8 * i + 4] * il, o[8 * i + 5] * il); w.w = pk2(o[8 * i + 6] * il, o[8 * i + 7] * il); og[i] = w; }
    }
    __syncthreads();
}

typedef float f32x16 __attribute__((ext_vector_type(16)));
typedef short s16x4 __attribute__((ext_vector_type(4)));
__device__ __forceinline__ int crow(int r, int hi) { return (r & 3) + 8 * (r >> 2) + 4 * hi; }
__device__ __forceinline__ float xhalf_max(float x) { auto rr = __builtin_amdgcn_permlane32_swap(__float_as_uint(x), __float_as_uint(x), false, false); return fmaxf(__uint_as_float(rr[0]), __uint_as_float(rr[1])); }
__device__ __forceinline__ float xhalf_sum(float x) { auto rr = __builtin_amdgcn_permlane32_swap(__float_as_uint(x), __float_as_uint(x), false, false); return __uint_as_float(rr[0]) + __uint_as_float(rr[1]); }
__device__ __forceinline__ bf16x8 packp(const f32x16& p, int s2) {
    u32x4 w; w.x = pk2(p[8 * s2 + 0], p[8 * s2 + 1]); w.y = pk2(p[8 * s2 + 2], p[8 * s2 + 3]); w.z = pk2(p[8 * s2 + 4], p[8 * s2 + 5]); w.w = pk2(p[8 * s2 + 6], p[8 * s2 + 7]);
    return __builtin_bit_cast(bf16x8, w);
}
__device__ __forceinline__ void p_attn_mfma(const Frame& F) {
    const int lane_f = lane_id_fresh(), tid_f = F.wave * 64 + lane_f;
    const bf16* Q = (const bf16*)(F.dob + DO_Q); const bf16* KC = (const bf16*)(F.ws + WS_KC); const bf16* VC = (const bf16*)(F.ws + WS_VC); bf16* YM = (bf16*)(F.ws + WS_YM);
    constexpr int KST = 208, VST = 192, KBYTES = 64 * KST, BUF = KBYTES + 64 * VST;
    const int tid = tid_f, lane = lane_f, wave = F.wave, r = lane & 31, hi = lane >> 5;
    const int kr0 = tid / 12, kp0 = tid % 12, kr1 = (tid + 512) / 12, kp1 = (tid + 512) % 12, vr = tid >> 3, vp = tid & 7;
    const int g4 = lane >> 4, li = lane & 15;
    const int vtr = (4 * (g4 >> 1) + (li >> 2)) * VST + (16 * (g4 & 1) + 4 * (li & 3)) * 2;
    const int kfr = r * KST + hi * 16;
    LAS unsigned char* lds = F.lds;
    for (int item = F.vcu; item < 1024; item += F.G) {
        const int bh = item >> 4, sidx = item & 15, b = bh >> 3, h = bh & 7; const size_t row0 = (size_t)b * SEQ;
        const bf16* Kg = KC + row0 * 768 + h * 96; const bf16* Vg = VC + row0 * 512 + h * 64;
        for (int uu = 0; uu < 2; ++uu) {
            const int qb = uu == 0 ? 31 - sidx : sidx, q0 = qb * 256, NT = (q0 + 256) / 64;
            const int qw = q0 + wave * 32;
            bf16x8 qf[6];
            { const bf16* qp = Q + (row0 + qw + r) * 768 + h * 96 + hi * 8;
#pragma unroll
              for (int s = 0; s < 6; ++s) qf[s] = *(const bf16x8*)(qp + 16 * s); }
            f32x16 o0 = {}, o1 = {}; float m = -INFINITY, l = 0.f;
            __syncthreads();
            { const u32x4 a0 = *(const u32x4*)(Kg + (size_t)kr0 * 768 + kp0 * 8); u32x4 a1 = {}; if (tid < 256) a1 = *(const u32x4*)(Kg + (size_t)kr1 * 768 + kp1 * 8);
              const u32x4 a2 = *(const u32x4*)(Vg + (size_t)vr * 512 + vp * 8);
              *(LAS u32x4*)(lds + kr0 * KST + kp0 * 16) = a0; if (tid < 256) *(LAS u32x4*)(lds + kr1 * KST + kp1 * 16) = a1; *(LAS u32x4*)(lds + KBYTES + vr * VST + vp * 16) = a2; }
            __syncthreads();
            for (int t = 0; t < NT; ++t) {
                LAS unsigned char* kb = lds + (t & 1) * BUF; LAS unsigned char* vb = kb + KBYTES;
                u32x4 a0 = {}, a1 = {}, a2 = {};
                const bool more = (t + 1 < NT);
                if (more) { const bf16* kg = Kg + (size_t)(t + 1) * 64 * 768; const bf16* vg = Vg + (size_t)(t + 1) * 64 * 512;
                    a0 = *(const u32x4*)(kg + (size_t)kr0 * 768 + kp0 * 8); if (tid < 256) a1 = *(const u32x4*)(kg + (size_t)kr1 * 768 + kp1 * 8); a2 = *(const u32x4*)(vg + (size_t)vr * 512 + vp * 8); }
                if (64 * t <= qw + 31) {
                    f32x16 p0 = {}, p1 = {};
#pragma unroll
                    for (int s = 0; s < 6; ++s) { const bf16x8 k0 = *(const LAS bf16x8*)(kb + kfr + s * 32), k1 = *(const LAS bf16x8*)(kb + kfr + 32 * KST + s * 32);
                        p0 = __builtin_amdgcn_mfma_f32_32x32x16_bf16(k0, qf[s], p0, 0, 0, 0); p1 = __builtin_amdgcn_mfma_f32_32x32x16_bf16(k1, qf[s], p1, 0, 0, 0); }
                    if (64 * t + 63 > qw) {
                        const int qrel = qw + r - 64 * t;
#pragma unroll
                        for (int rg = 0; rg < 16; ++rg) { const int kv = crow(rg, hi); if (kv > qrel) p0[rg] = -INFINITY; if (kv + 32 > qrel) p1[rg] = -INFINITY; }
                    }
                    float mx = fmaxf(p0[0], p1[0]);
#pragma unroll
                    for (int rg = 1; rg < 16; ++rg) mx = fmaxf(mx, fmaxf(p0[rg], p1[rg]));
                    mx = xhalf_max(mx);
                    const float mn = fmaxf(m, mx), f = __builtin_amdgcn_exp2f(m - mn); m = mn;
                    float rs = 0.f;
#pragma unroll
                    for (int rg = 0; rg < 16; ++rg) { p0[rg] = __builtin_amdgcn_exp2f(p0[rg] - mn); p1[rg] = __builtin_amdgcn_exp2f(p1[rg] - mn); rs += p0[rg] + p1[rg]; }
                    l = l * f + rs;
#pragma unroll
                    for (int rg = 0; rg < 16; ++rg) { o0[rg] *= f; o1[rg] *= f; }
#pragma unroll
                    for (int hh = 0; hh < 2; ++hh)
#pragma unroll
                        for (int s2 = 0; s2 < 2; ++s2) { const bf16x8 pf = packp(hh == 0 ? p0 : p1, s2);
#pragma unroll
                            for (int db = 0; db < 2; ++db) { LAS unsigned char* vp_ = vb + vtr + (32 * hh + 16 * s2) * VST + db * 64;
                                const s16x4 lo = __builtin_bit_cast(s16x4, __builtin_amdgcn_ds_read_tr16_b64_v4i16((LAS s16x4*)vp_));
                                const s16x4 hi4 = __builtin_bit_cast(s16x4, __builtin_amdgcn_ds_read_tr16_b64_v4i16((LAS s16x4*)(vp_ + 8 * VST)));
                                const bf16x8 vf = (bf16x8){lo[0], lo[1], lo[2], lo[3], hi4[0], hi4[1], hi4[2], hi4[3]};
                                if (db == 0) o0 = __builtin_amdgcn_mfma_f32_32x32x16_bf16(vf, pf, o0, 0, 0, 0); else o1 = __builtin_amdgcn_mfma_f32_32x32x16_bf16(vf, pf, o1, 0, 0, 0); } }
                }
                if (more) { LAS unsigned char* nb = lds + ((t + 1) & 1) * BUF;
                    *(LAS u32x4*)(nb + kr0 * KST + kp0 * 16) = a0; if (tid < 256) *(LAS u32x4*)(nb + kr1 * KST + kp1 * 16) = a1; *(LAS u32x4*)(nb + KBYTES + vr * VST + vp * 16) = a2; }
                __syncthreads();
            }
            const float il = 1.0f / xhalf_sum(l);
            bf16* op = YM + (row0 + qw + r) * 512 + h * 64 + 4 * hi;
#pragma unroll
            for (int gq = 0; gq < 4; ++gq) { u32x2 w0, w1;
                w0.x = pk2(o0[4 * gq] * il, o0[4 * gq + 1] * il); w0.y = pk2(o0[4 * gq + 2] * il, o0[4 * gq + 3] * il);
                w1.x = pk2(o1[4 * gq] * il, o1[4 * gq + 1] * il); w1.y = pk2(o1[4 * gq + 2] * il, o1[4 * gq + 3] * il);
                *(u32x2*)(op + 8 * gq) = w0; *(u32x2*)(op + 32 + 8 * gq) = w1; }
        }
    }
    __syncthreads();
}

__device__ __forceinline__ void p_post_scan(const Frame& F, ArgsP a) {
    const int lane_f = lane_id_fresh(), tid_f = F.wave * 64 + lane_f;
    bf16* Y = (bf16*)(F.ws + WS_Y); const bf16* R = (const bf16*)(F.ws + WS_R); const bf16* K = (const bf16*)(F.ws + WS_ZK); const bf16* V = (const bf16*)(F.ws + WS_V); const bf16* G = (const bf16*)(F.dob + DO_G);
    const float* lnw = a->in[I_LNW]; const float* lnb = a->in[I_LNB]; const float* rk = a->in[I_RK];
    const int lane = lane_f;
    for (int m = F.gw; m < NTOK; m += F.NGW) {
        float y[8], r[8], k[8], v[8], g[8], o[8];
        unpack8(*((const u32x4*)(Y + (size_t)m * 512) + lane), y); unpack8(*((const u32x4*)(R + (size_t)m * 512) + lane), r); unpack8(*((const u32x4*)(K + (size_t)m * 512) + lane), k);
        unpack8(*((const u32x4*)(V + (size_t)m * 512) + lane), v); unpack8(*((const u32x4*)(G + (size_t)m * 512) + lane), g);
        float s = 0.f, d = 0.f;
#pragma unroll
        for (int i = 0; i < 8; ++i) { s += y[i]; d += r[i] * k[i] * rk[8 * lane + i]; }
        const float mean = sum8(s) * (1.f / 64.f); d = sum8(d); float q = 0.f;
#pragma unroll
        for (int i = 0; i < 8; ++i) { y[i] -= mean; q += y[i] * y[i]; }
        const float rstd = 1.0f / sqrtf(sum8(q) * (1.f / 64.f) + LN_X_EPS);
#pragma unroll
        for (int i = 0; i < 8; ++i) o[i] = (y[i] * rstd * lnw[8 * lane + i] + lnb[8 * lane + i] + d * v[i]) * g[i];
        *((u32x4*)(Y + (size_t)m * 512) + lane) = pack8(o);
    }
}

__device__ __forceinline__ void p_ffn_route(const Frame& F, ArgsP a) {
    const int lane_f = lane_id_fresh(), tid_f = F.wave * 64 + lane_f;
    const float* X1 = (const float*)F.dob; bf16* H2 = (bf16*)(F.ws + WS_H2); const float* mod = (const float*)(F.ws + WS_MOD); const float* g = a->in[I_GFFN];
    unsigned* cnt = (unsigned*)(F.ws + WS_CTL) + CW_CNT; int* route = (int*)(F.ws + WS_ROUTE);
    LAS float* wr = (LAS float*)F.lds;
    __syncthreads();
    for (int i = tid_f; i < 1024 * 4; i += NTHR) { const int k = i >> 2, o = i & 3; wr[o * 1024 + k] = a->in[I_WRG][i]; }
    for (int i = tid_f; i < 1024 * 32; i += NTHR) { const int k = i >> 5, o = i & 31; wr[(4 + o) * 1024 + k] = a->in[I_WRE][i]; }
    __syncthreads();
    const float* brg = a->in[I_BRG]; const float* bre = a->in[I_BRE];
    const int lane = lane_f;
    for (int m = F.gw; m < NTOK; m += F.NGW) {
        const int b = m / SEQ; const f32x4* xr = (const f32x4*)(X1 + (size_t)m * 1024) + lane;
        f32x4 v[4]; float s = 0.f;
#pragma unroll
        for (int j = 0; j < 4; ++j) { v[j] = xr[64 * j]; s += (v[j].x * v[j].x + v[j].y * v[j].y) + (v[j].z * v[j].z + v[j].w * v[j].w); }
        const float rstd = 1.0f / sqrtf(wave_sum(s) * (1.f / 1024.f) + EPS);
        u32x2* o = (u32x2*)(H2 + (size_t)m * 1024) + lane;
#pragma unroll
        for (int j = 0; j < 4; ++j) { const int col = 4 * lane + 256 * j;
            const f32x4 gg = *(const f32x4*)(g + col), sc = *(const f32x4*)(mod + b * 6144 + 4096 + col), sh = *(const f32x4*)(mod + b * 6144 + 3072 + col);
            v[j] = v[j] * rstd * gg * (sc + 1.0f) + sh; u32x2 w; w.x = pk2(v[j].x, v[j].y); w.y = pk2(v[j].z, v[j].w); o[64 * j] = w; }
        float lgq[4];
#pragma unroll
        for (int oo = 0; oo < 4; ++oo) { float p = 0.f;
#pragma unroll
            for (int j = 0; j < 4; ++j) { const f32x4 w4 = *(const LAS f32x4*)(wr + oo * 1024 + 4 * lane + 256 * j); p += (v[j].x * w4.x + v[j].y * w4.y) + (v[j].z * w4.z + v[j].w * w4.w); }
            lgq[oo] = wave_sum(p) + brg[oo]; }
        int gi = 0; float gm = lgq[0];
#pragma unroll
        for (int i = 1; i < 4; ++i) { if (lgq[i] > gm) { gm = lgq[i]; gi = i; } }
        float gs = 0.f;
#pragma unroll
        for (int i = 0; i < 4; ++i) gs += __expf(lgq[i] - gm);
        const float pg = 1.f / gs;
        gi = __builtin_amdgcn_readfirstlane(gi);
        float el[8];
        { const LAS float* wg = wr + (4 + gi * 8) * 1024 + 4 * lane;
#pragma unroll
          for (int i = 0; i < 8; ++i) { float p = 0.f;
#pragma unroll
              for (int j = 0; j < 4; ++j) { const f32x4 w4 = *(const LAS f32x4*)(wg + i * 1024 + 256 * j); p += (v[j].x * w4.x + v[j].y * w4.y) + (v[j].z * w4.z + v[j].w * w4.w); }
              el[i] = wave_sum(p) + bre[gi * 8 + i]; } }
        int i0 = 0; float m0 = el[0];
#pragma unroll
        for (int i = 1; i < 8; ++i) if (el[i] > m0) { m0 = el[i]; i0 = i; }
        int i1 = -1; float m1 = -INFINITY;
#pragma unroll
        for (int i = 0; i < 8; ++i) if (i != i0 && el[i] > m1) { m1 = el[i]; i1 = i; }
        const float e1 = __expf(m1 - m0), w0 = pg / (1.f + e1), w1 = pg * e1 / (1.f + e1);
        if (lane == 0) { const int x0 = gi * 8 + i0, x1 = gi * 8 + i1;
            const unsigned p0 = __hip_atomic_fetch_add(cnt + x0, 1u, __ATOMIC_RELAXED, __HIP_MEMORY_SCOPE_AGENT), p1 = __hip_atomic_fetch_add(cnt + x1, 1u, __ATOMIC_RELAXED, __HIP_MEMORY_SCOPE_AGENT);
            int* rt = route + (size_t)m * 8; rt[0] = x0; rt[1] = x1; rt[2] = (int)p0; rt[3] = (int)p1; rt[4] = __builtin_bit_cast(int, w0); rt[5] = __builtin_bit_cast(int, w1); }
    }
    __syncthreads();
}
__device__ __forceinline__ int moe_tables(const Frame& F, LAS int* offs, LAS int* texp) {
    const int lane_f = lane_id_fresh(), tid_f = F.wave * 64 + lane_f;
    const unsigned* cnt = (const unsigned*)(F.ws + WS_CTL) + CW_CNT;
    __syncthreads();
    if (tid_f == 0) { int o = 0; for (int e = 0; e < 32; ++e) { offs[e] = o; const int c = (int)__hip_atomic_load(cnt + e, __ATOMIC_RELAXED, __HIP_MEMORY_SCOPE_AGENT); const int nt = (c + 255) >> 8; for (int t = 0; t < nt; ++t) texp[(o >> 8) + t] = e; o += nt << 8; } offs[32] = o; }
    __syncthreads();
    return offs[32] >> 8;
}
__device__ __forceinline__ void p_gather(const Frame& F) {
    const int lane_f = lane_id_fresh(), tid_f = F.wave * 64 + lane_f;
    LAS int* offs = (LAS int*)(F.lds + 1024); LAS int* texp = (LAS int*)(F.lds + 2048);
    moe_tables(F, offs, texp);
    const bf16* H2 = (const bf16*)(F.ws + WS_H2); bf16* XG = (bf16*)(F.ws + WS_XG); const int* route = (const int*)(F.ws + WS_ROUTE);
    const unsigned* cnt = (const unsigned*)(F.ws + WS_CTL) + CW_CNT; const int lane = lane_f;
    for (int m = F.gw; m < NTOK; m += F.NGW) {
        const int* rt = route + (size_t)m * 8; const int d0 = offs[rt[0]] + rt[2], d1 = offs[rt[1]] + rt[3];
        const u32x4* src = (const u32x4*)(H2 + (size_t)m * 1024) + lane; const u32x4 a0 = src[0], a1 = src[64];
        u32x4* p0 = (u32x4*)(XG + (size_t)d0 * 1024) + lane; u32x4* p1 = (u32x4*)(XG + (size_t)d1 * 1024) + lane;
        p0[0] = a0; p0[64] = a1; p1[0] = a0; p1[64] = a1;
    }
    for (int i = F.gw; i < 32 * 256; i += F.NGW) { const int e = i >> 8, r = i & 255; const int c = (int)cnt[e]; const int pad = ((c + 255) & ~255) - c;
        if (r < pad) { u32x4* p = (u32x4*)(XG + (size_t)(offs[e] + c + r) * 1024) + lane; p[0] = (u32x4){0u, 0u, 0u, 0u}; p[64] = (u32x4){0u, 0u, 0u, 0u}; } }
    __syncthreads();
}
__device__ __forceinline__ void p_combine(const Frame& F) {
    const int lane_f = lane_id_fresh(), tid_f = F.wave * 64 + lane_f;
    LAS int* offs = (LAS int*)(F.lds + 1024); LAS int* texp = (LAS int*)(F.lds + 2048);
    moe_tables(F, offs, texp);
    float* out = (float*)F.dob; const bf16* YS = (const bf16*)(F.ws + WS_YS); const int* route = (const int*)(F.ws + WS_ROUTE); const float* mod = (const float*)(F.ws + WS_MOD);
    const int lane = lane_f;
    for (int m = F.gw; m < NTOK; m += F.NGW) {
        const int b = m / SEQ; const int* rt = route + (size_t)m * 8; const int d0 = offs[rt[0]] + rt[2], d1 = offs[rt[1]] + rt[3];
        const float w0 = __builtin_bit_cast(float, rt[4]), w1 = __builtin_bit_cast(float, rt[5]);
#pragma unroll
        for (int j = 0; j < 2; ++j) { const int col = 8 * lane + 512 * j; float y0[8], y1[8];
            unpack8(*(const u32x4*)(YS + (size_t)d0 * 1024 + col), y0); unpack8(*(const u32x4*)(YS + (size_t)d1 * 1024 + col), y1);
            float* o = out + (size_t)m * 1024 + col; const float* gt = mod + b * 6144 + 5120 + col;
            f32x4 x0 = *(const f32x4*)o, x1 = *(const f32x4*)(o + 4); const f32x4 g0 = *(const f32x4*)gt, g1 = *(const f32x4*)(gt + 4);
            x0.x += g0.x * (w0 * y0[0] + w1 * y1[0]); x0.y += g0.y * (w0 * y0[1] + w1 * y1[1]); x0.z += g0.z * (w0 * y0[2] + w1 * y1[2]); x0.w += g0.w * (w0 * y0[3] + w1 * y1[3]);
            x1.x += g1.x * (w0 * y0[4] + w1 * y1[4]); x1.y += g1.y * (w0 * y0[5] + w1 * y1[5]); x1.z += g1.z * (w0 * y0[6] + w1 * y1[6]); x1.w += g1.w * (w0 * y0[7] + w1 * y1[7]);
            *(f32x4*)o = x0; *(f32x4*)(o + 4) = x1; }
    }
}

constexpr int NPHASE = 16;
template <int LO, int HI>
__global__ void __launch_bounds__(NTHR, 2) fwd(Args args) {
    extern __shared__ __attribute__((aligned(16))) unsigned char lds_raw[];
    Frame F;
    F.lds = (LAS unsigned char*)lds_raw;
    F.wave = __builtin_amdgcn_readfirstlane((int)threadIdx.x >> 6);
    F.G = gridDim.x; { const int bx = blockIdx.x; F.vcu = (F.G % 8 == 0) ? (bx % 8) * (F.G / 8) + bx / 8 : bx; }
    F.gw = F.vcu * NWAVES + F.wave; F.NGW = F.G * NWAVES;
    F.ws = args.ws; F.dob = (unsigned char*)args.out;
    ArgsP AP = (ArgsP)__builtin_amdgcn_kernarg_segment_ptr();
    volatile LAS unsigned* MISC = (volatile LAS unsigned*)(F.lds + LDS_MISC);
    if (threadIdx.x < 64) MISC[threadIdx.x] = 0u;
    __syncthreads();
    XcdBarrier bar; bar.bar = (unsigned*)(F.ws + WS_CTL) + CW_BAR; bar.x = 0; bar.st = MISC + 8;
#if N_LAUNCH_MODE == 1
    bar = xcd_barrier_post((unsigned*)(F.ws + WS_CTL) + CW_BAR, MISC + 8);
#define GRID_BAR() xcd_barrier(bar)
#else
#define GRID_BAR() do { } while (0)
#endif
#define IN(k) (LO <= (k) && (k) < HI)
#define SEAM(k) do { if constexpr (IN(k) && IN((k) + 1)) GRID_BAR(); } while (0)
    const float* mod = (const float*)(F.ws + WS_MOD);

    if constexpr (IN(0)) { asm volatile("" : "+s"(AP)); p0_prologue(F, AP); } SEAM(0);
    if constexpr (IN(1)) { asm volatile("" : "+s"(AP)); p_normmod(F, AP->in[I_X], AP->in[I_GMIX], mod, 0, 1024, (bf16*)(F.ws + WS_H)); } SEAM(1);
    if constexpr (IN(2)) { asm volatile("" : "+s"(AP)); Gemm g{(const bf16*)(F.ws + WS_H), (const bf16*)(F.ws + WS_WIN), NTOK, N_IN_PAD, 1024}; StaticOrder S; S.init(NTOK, N_IN_PAD, F.G, (int)blockIdx.x);
        EpiZ E{(bf16*)(F.ws + WS_ZR), (bf16*)(F.ws + WS_SG), (bf16*)(F.ws + WS_ZM)}; gemm_phase_any(F.lds, g, S, E, F.wave); } SEAM(2);
    if constexpr (IN(3)) { asm volatile("" : "+s"(AP)); p_prep_a(F, AP); } SEAM(3);
    if constexpr (IN(4)) { asm volatile("" : "+s"(AP));
        { Gemm g{(const bf16*)(F.ws + WS_TWA), (const bf16*)(F.ws + WS_WBLK), NTOK, 1024, 128}; StaticOrder S; S.init(NTOK, 1024, F.G, (int)blockIdx.x);
          EpiLora E{(bf16*)(F.ws + WS_LW), (bf16*)(F.ws + WS_A), AP->in[I_W0], AP->in[I_A0]}; gemm_phase_any(F.lds, g, S, E, F.wave); }
        { Gemm g{(const bf16*)(F.ws + WS_SGL), (const bf16*)(F.ws + WS_WG), NTOK, 512, 128}; StaticOrder S; S.init(NTOK, 512, F.G, (int)blockIdx.x);
          EpiPlain E{(bf16*)(F.dob + DO_G), nullptr, 1 << 30, 512, 0}; gemm_phase_any(F.lds, g, S, E, F.wave); }
        { Gemm g{(const bf16*)(F.ws + WS_QA), (const bf16*)(F.ws + WS_WUQ), NTOK, 768, 256}; StaticOrder S; S.init(NTOK, 768, F.G, (int)blockIdx.x);
          EpiPlain E{(bf16*)(F.dob + DO_Q), nullptr, 1 << 30, 768, 0}; gemm_phase_any(F.lds, g, S, E, F.wave); }
        { Gemm g{(const bf16*)(F.ws + WS_KVA), (const bf16*)(F.ws + WS_WUKV), NTOK, 1024, 128}; StaticOrder S; S.init(NTOK, 1024, F.G, (int)blockIdx.x);
          EpiPlain E{(bf16*)(F.dob + DO_KN), (bf16*)(F.ws + WS_VC), 512, 512, 512}; gemm_phase_any(F.lds, g, S, E, F.wave); }
    } SEAM(4);
    if constexpr (IN(5)) { asm volatile("" : "+s"(AP)); p_prep_c(F, AP); } SEAM(5);
    if constexpr (IN(6)) { asm volatile("" : "+s"(AP)); p_scan(F); } SEAM(6);
#if ENG_ATTN == 1
    if constexpr (IN(7)) { asm volatile("" : "+s"(AP)); p_attn_mfma(F); } SEAM(7);
#else
    if constexpr (IN(7)) { asm volatile("" : "+s"(AP)); p_attn_naive(F); } SEAM(7);
#endif
    if constexpr (IN(8)) { asm volatile("" : "+s"(AP)); p_post_scan(F, AP); } SEAM(8);
    if constexpr (IN(9)) { asm volatile("" : "+s"(AP));
        { Gemm g{(const bf16*)(F.ws + WS_Y), (const bf16*)(F.ws + WS_WB), NTOK, 1024, 512}; StaticOrder S; S.init(NTOK, 1024, F.G, (int)blockIdx.x);
          EpiBranch<false> E{(bf16*)(F.ws + WS_MG), (const bf16*)(F.ws + WS_SG), 0}; gemm_phase_any(F.lds, g, S, E, F.wave); }
        { Gemm g{(const bf16*)(F.ws + WS_YM), (const bf16*)(F.ws + WS_WB) + (size_t)1024 * 512, NTOK, 1024, 512}; StaticOrder S; S.init(NTOK, 1024, F.G, (int)blockIdx.x);
          EpiBranch<true> E{(bf16*)(F.ws + WS_MG), (const bf16*)(F.ws + WS_SG), 1024}; gemm_phase_any(F.lds, g, S, E, F.wave); }
    } SEAM(9);
    if constexpr (IN(10)) { asm volatile("" : "+s"(AP)); Gemm g{(const bf16*)(F.ws + WS_MG), (const bf16*)(F.ws + WS_WO), NTOK, 1024, 1024}; StaticOrder S; S.init(NTOK, 1024, F.G, (int)blockIdx.x);
        EpiOut E{(float*)F.dob, AP->in[I_X], mod}; gemm_phase_any(F.lds, g, S, E, F.wave); } SEAM(10);
    if constexpr (IN(11)) { asm volatile("" : "+s"(AP)); p_ffn_route(F, AP); } SEAM(11);
    if constexpr (IN(12)) { asm volatile("" : "+s"(AP)); p_gather(F); } SEAM(12);
    if constexpr (IN(13)) { asm volatile("" : "+s"(AP)); LAS int* offs = (LAS int*)(F.lds + LDS_MISC + 1024); LAS int* texp = (LAS int*)(F.lds + LDS_MISC + 1024 + 256); const int nt = moe_tables(F, offs, texp);
        Gemm g{(const bf16*)(F.ws + WS_XG), (const bf16*)(F.ws + WS_WGU), MPAD, 512, 1024}; TableOrder S{texp, nt, 2, F.G, (int)blockIdx.x};
        EpiGateUp E{(bf16*)(F.ws + WS_HID)}; gemm_phase_any(F.lds, g, S, E, F.wave); } SEAM(13);
    if constexpr (IN(14)) { asm volatile("" : "+s"(AP)); LAS int* offs = (LAS int*)(F.lds + LDS_MISC + 1024); LAS int* texp = (LAS int*)(F.lds + LDS_MISC + 1024 + 256); const int nt = moe_tables(F, offs, texp);
        Gemm g{(const bf16*)(F.ws + WS_HID), (const bf16*)(F.ws + WS_WDN), MPAD, 1024, 256}; TableOrder S{texp, nt, 4, F.G, (int)blockIdx.x};
        EpiDown E{(bf16*)(F.ws + WS_YS)}; gemm_phase_any(F.lds, g, S, E, F.wave); } SEAM(14);
    if constexpr (IN(15)) { asm volatile("" : "+s"(AP)); p_combine(F); }
}

#if N_LAUNCH_MODE == 1
static bool set_attrs() { return hipFuncSetAttribute((const void*)fwd<0, NPHASE>, hipFuncAttributeMaxDynamicSharedMemorySize, LDS_BYTES) == hipSuccess; }
#else
template <int P> static bool set_attr_all() { if constexpr (P < NPHASE) { return hipFuncSetAttribute((const void*)fwd<P, P + 1>, hipFuncAttributeMaxDynamicSharedMemorySize, LDS_BYTES) == hipSuccess && set_attr_all<P + 1>(); } else return true; }
static bool set_attrs() { return set_attr_all<0>(); }
template <int P> static void launch_all(int grid, hipStream_t stream, const Args& a) { if constexpr (P < NPHASE) { hipLaunchKernelGGL((fwd<P, P + 1>), dim3(grid), dim3(NTHR), LDS_BYTES, stream, a); launch_all<P + 1>(grid, stream, a); } }
#endif
extern "C" void kernel_launch(void* const* d_in, const int* in_sizes, int n_in, void* d_out, int out_size, void* d_ws, size_t ws_size, hipStream_t stream) {
    static int grid = 0;
    if (grid == 0) {
        if (n_in != 34 || out_size != NTOK * DM || ws_size < WS_END) { fprintf(stderr, "kernel_launch: unexpected shapes (n_in %d out %d ws %zu)\n", n_in, out_size, ws_size); grid = -1; return; }
        int dev = 0, cus = 0;
        if (hipGetDevice(&dev) != hipSuccess || hipDeviceGetAttribute(&cus, hipDeviceAttributeMultiprocessorCount, dev) != hipSuccess) { grid = -1; return; }
        if (!set_attrs()) { fprintf(stderr, "kernel_launch: hipFuncSetAttribute failed\n"); grid = -1; return; }
        grid = cus;
    }
    if (grid < 0) return;
    (void)hipMemsetAsync((char*)d_ws + WS_CTL, 0, CTL_ZERO_BYTES, stream);
    Args a{};
    for (int i = 0; i < 34; ++i) a.in[i] = (const float*)d_in[i];
    a.out = (float*)d_out; a.ws = (unsigned char*)d_ws;
    a.ph_lo = 0; a.ph_hi = NPHASE;
#if N_LAUNCH_MODE == 1
    hipLaunchKernelGGL((fwd<0, NPHASE>), dim3(grid), dim3(NTHR), LDS_BYTES, stream, a);
#else
    launch_all<0>(grid, stream, a);
#endif
}
```

```cpp
#include <hip/hip_runtime.h>
#include <cstdio>
#include <cstdint>

#ifndef N_LAUNCH_MODE
#define N_LAUNCH_MODE 1
#endif
#ifndef ENG_GEMM
#define ENG_GEMM 1
#endif
#ifndef ENG_ATTN
#define ENG_ATTN 1
#endif

#define GAS __attribute__((address_space(1)))
#define LAS __attribute__((address_space(3)))
typedef unsigned short bf16;
typedef float f32x4 __attribute__((ext_vector_type(4)));
typedef float f32x2 __attribute__((ext_vector_type(2)));
typedef unsigned u32x4 __attribute__((ext_vector_type(4)));
typedef unsigned u32x2 __attribute__((ext_vector_type(2)));
typedef short bf16x8 __attribute__((ext_vector_type(8)));

constexpr int BATCH = 8, SEQ = 8192, DM = 1024, NTOK = BATCH * SEQ;
constexpr int D_RWKV = 512, RWKV_COLS = 1792, MLA_COLS = 416, D_IN = 4256, N_IN_PAD = 4352;
constexpr int NH = 8, QKD = 96, NOPE = 64, ROPE = 32, VD = 64;
constexpr int NEXP = 32, DEXP = 256;
constexpr int MPAD = 139264;
constexpr float EPS = 1e-6f, LN_X_EPS = 64e-5f;
constexpr float QSCALE = 0.10206207261596577f * 1.4426950408889634f;

constexpr size_t MiB = 1u << 20;
constexpr size_t WS_CTL = 0, CTL_ZERO_BYTES = 1 * MiB;
constexpr size_t WS_MOD = 1 * MiB;
constexpr size_t WS_ROUTE = 2 * MiB;
constexpr size_t WS_CS = 4 * MiB;
constexpr size_t WS_WIN = 16 * MiB;
constexpr size_t WS_WBLK = 25 * MiB;
constexpr size_t WS_WG = WS_WBLK + 256 * 1024;
constexpr size_t WS_WUQ = WS_WG + 128 * 1024;
constexpr size_t WS_WUKV = WS_WUQ + 384 * 1024;
constexpr size_t WS_WB = 26 * MiB;
constexpr size_t WS_WO = 28 * MiB;
constexpr size_t WS_WGU = 30 * MiB;
constexpr size_t WS_WDN = 62 * MiB;
constexpr size_t WS_SG = 80 * MiB;
constexpr size_t WS_H2 = 80 * MiB;
constexpr size_t WS_ZR = 336 * MiB;
constexpr size_t WS_VC = 752 * MiB;
constexpr size_t WS_KC = 816 * MiB;
constexpr size_t WS_Y = 912 * MiB;
constexpr size_t WS_XG = 336 * MiB;
constexpr size_t WS_ZM = 560 * MiB;
constexpr size_t WS_YM = 560 * MiB;
constexpr size_t WS_H = 624 * MiB;
constexpr size_t WS_LW = 624 * MiB;
constexpr size_t WS_A = 688 * MiB;
constexpr size_t WS_MG = 624 * MiB;
constexpr size_t WS_HID = 608 * MiB;
constexpr size_t WS_R = 752 * MiB;
constexpr size_t WS_V = 816 * MiB;
constexpr size_t WS_ZK = 880 * MiB;
constexpr size_t WS_TWA = 944 * MiB;
constexpr size_t WS_SGL = 960 * MiB;
constexpr size_t WS_QA = 976 * MiB;
constexpr size_t WS_KVA = 1008 * MiB;
constexpr size_t WS_KK = 944 * MiB;
constexpr size_t WS_YS = 752 * MiB;
constexpr size_t WS_END = 1024 * MiB;
constexpr size_t DO_G = 0;
constexpr size_t DO_Q = 64 * MiB;
constexpr size_t DO_KN = 160 * MiB;

constexpr int CW_CNT = 64;
constexpr int CW_BAR = 4096;

constexpr int NWAVES = 8, NTHR = 512;
constexpr int LDS_BYTES = 155648;
constexpr int LDS_MISC = 151552;

__device__ __forceinline__ int lane_id_fresh() { int l; asm volatile("v_mbcnt_lo_u32_b32 %0, -1, 0\n\tv_mbcnt_hi_u32_b32 %0, -1, %0" : "=v"(l)); return l; }
__device__ __forceinline__ float bf2f(unsigned short h) { return __builtin_bit_cast(float, (unsigned)h << 16); }
__device__ __forceinline__ unsigned f2bf(float f) { unsigned u = __builtin_bit_cast(unsigned, f); return (u + 0x7fffu + ((u >> 16) & 1u)) >> 16; }
__device__ __forceinline__ unsigned pk2(float lo, float hi) { return f2bf(lo) | (f2bf(hi) << 16); }
__device__ __forceinline__ float lo2f(unsigned w) { return __builtin_bit_cast(float, w << 16); }
__device__ __forceinline__ float hi2f(unsigned w) { return __builtin_bit_cast(float, w & 0xffff0000u); }
__device__ __forceinline__ float wave_sum(float v) {
#pragma unroll
    for (int o = 1; o < 64; o <<= 1) v += __shfl_xor(v, o);
    return v;
}
__device__ __forceinline__ float sum8(float v) { v += __shfl_xor(v, 1); v += __shfl_xor(v, 2); v += __shfl_xor(v, 4); return v; }
__device__ __forceinline__ float sigmoidf_(float x) { return 1.f / (1.f + __expf(-x)); }
__device__ __forceinline__ float siluf_(float x) { return x / (1.f + __expf(-x)); }
__device__ __forceinline__ void unpack8(const u32x4 w, float (&v)[8]) {
    v[0] = lo2f(w.x); v[1] = hi2f(w.x); v[2] = lo2f(w.y); v[3] = hi2f(w.y); v[4] = lo2f(w.z); v[5] = hi2f(w.z); v[6] = lo2f(w.w); v[7] = hi2f(w.w);
}
__device__ __forceinline__ u32x4 pack8(const float (&v)[8]) { u32x4 w; w.x = pk2(v[0], v[1]); w.y = pk2(v[2], v[3]); w.z = pk2(v[4], v[5]); w.w = pk2(v[6], v[7]); return w; }

#define XB_TMO      128
#define XB_XCNT(j)  (256  + 64 * (j))
#define XB_XSUB(j)  (1280 + 64 * (j))
#define XB_XGEN(j)  (2304 + 64 * (j))
#define XB_TOP      3328
#define XB_TOPGEN   3392
#define XCD_BAR_WORDS 3456
#define XB_SPIN_CAP (1u << 19)
__device__ __forceinline__ unsigned xb_ld(unsigned* p)              { return __hip_atomic_load(p, __ATOMIC_RELAXED, __HIP_MEMORY_SCOPE_AGENT); }
__device__ __forceinline__ unsigned xb_add(unsigned* p, unsigned v) { return __hip_atomic_fetch_add(p, v, __ATOMIC_RELAXED, __HIP_MEMORY_SCOPE_AGENT); }
__device__ __forceinline__ unsigned xb_xcc_id() { return (unsigned)__builtin_amdgcn_s_getreg((3 << 11) | 20) & 0xFu; }
#define XB_SPIN(cond, bar) do { unsigned _sp = 0; while (cond) { __builtin_amdgcn_s_sleep(1); \
    if ((++_sp & 255u) == 0u) { if (xb_ld(&(bar)[XB_TMO])) break; if (_sp > XB_SPIN_CAP) { atomicAdd(&(bar)[XB_TMO], 1u); break; } } } } while (0)
struct XcdBarrier { unsigned* bar; unsigned x; volatile LAS unsigned* st; };
__device__ __forceinline__ XcdBarrier xcd_barrier_post(unsigned* bar, volatile LAS unsigned* st) {
    XcdBarrier b; b.bar = bar; b.x = xb_xcc_id(); b.st = st;
    if (threadIdx.x == 0) (void)xb_add(&bar[XB_XCNT(b.x)], 1u);
    return b;
}
__device__ __forceinline__ void xcd_barrier_complete(unsigned* bar, unsigned x, unsigned& nloc, unsigned& nx) {
    const unsigned G = gridDim.x * gridDim.y * gridDim.z;
    unsigned sum, cnt, mine, sp = 0u;
    for (;;) {
        sum = 0u; cnt = 0u; mine = 0u;
#pragma unroll
        for (unsigned j = 0; j < 16; ++j) { const unsigned c = xb_ld(&bar[XB_XCNT(j)]); sum += c; cnt += (c > 0u) ? 1u : 0u; mine = (j == x) ? c : mine; }
        if (sum == G) break;
        __builtin_amdgcn_s_sleep(1);
        if ((++sp & 255u) == 0u) { if (xb_ld(&bar[XB_TMO])) break; if (sp > XB_SPIN_CAP) { atomicAdd(&bar[XB_TMO], 1u); break; } }
    }
    nloc = mine > 0u ? mine : 1u; nx = cnt > 0u ? cnt : 1u;
}
__device__ __forceinline__ void xcd_barrier(const XcdBarrier& b) {
    asm volatile("s_waitcnt vmcnt(0)" ::: "memory");
    __syncthreads();
    if (threadIdx.x == 0) {
        unsigned* bar = b.bar;
        __builtin_amdgcn_s_waitcnt(0);
        unsigned nloc = b.st[0], nx = b.st[1];
        if (nloc == 0u) { xcd_barrier_complete(bar, b.x, nloc, nx); b.st[0] = nloc; b.st[1] = nx; }
        const unsigned old = xb_add(&bar[XB_XSUB(b.x)], 1u);
        const unsigned gen = old / nloc;
        if (old + 1u == (gen + 1u) * nloc) {
            __builtin_amdgcn_fence(__ATOMIC_RELEASE, "agent");
            asm volatile("s_waitcnt vmcnt(0)" ::: "memory");
            const unsigned og = xb_add(&bar[XB_TOP], 1u);
            const unsigned tg = og / nx;
            if (og + 1u == (tg + 1u) * nx) xb_add(&bar[XB_TOPGEN], 1u);
            else XB_SPIN(xb_ld(&bar[XB_TOPGEN]) == tg, bar);
            __builtin_amdgcn_fence(__ATOMIC_ACQUIRE, "agent");
            xb_add(&bar[XB_XGEN(b.x)], 1u);
            asm volatile("s_waitcnt vmcnt(0)" ::: "memory");
        } else {
            XB_SPIN(xb_ld(&bar[XB_XGEN(b.x)]) == gen, bar);
            __builtin_amdgcn_fence(__ATOMIC_ACQUIRE, "agent");
            asm volatile("s_waitcnt vmcnt(0)" ::: "memory");
        }
    }
    __syncthreads();
}

struct Args {
    const float* in[34]; float* out; unsigned char* ws; int ph_lo, ph_hi;
};
typedef const __attribute__((address_space(4))) Args* ArgsP;
struct Frame {
    LAS unsigned char* lds;
    int wave, vcu, G, gw, NGW;
    unsigned char* ws; unsigned char* dob;
};
enum { I_X = 0, I_C, I_POS, I_WADA, I_BADA, I_GMIX, I_WIN, I_MU, I_W0, I_WDEC, I_A0, I_WAUP, I_WGUP, I_KK, I_KA, I_RK, I_LNW, I_LNB, I_GQA, I_WUQ, I_GKVA, I_WUKV,
       I_QN, I_KN, I_WBR, I_WOUT, I_GFFN, I_WRG, I_BRG, I_WRE, I_BRE, I_WEG, I_WEU, I_WED };

struct Unit { int pm, pn; };
struct Gemm { const bf16* A; const bf16* Bt; int M, N, K; };
constexpr int NXCD = 8, WGM = 8;
struct StaticOrder {
    int nM, nN, nwg, G, c;
    __device__ void init(int M, int N, int G_, int c_) { nM = M / 256; nN = N / 256; nwg = nM * nN; G = G_; c = c_; }
    __device__ bool next(int i, Unit& u) const {
        const long L = (long)i * G + c; if (L >= nwg) return false;
        int wgid = (int)L; { const int q = nwg / NXCD, r = nwg % NXCD, xcd = wgid % NXCD, off = wgid / NXCD; wgid = (xcd < r ? xcd * (q + 1) : r * (q + 1) + (xcd - r) * q) + off; }
        const int nig = WGM * nN, gid = wgid / nig, fm = gid * WGM, gsz = (nM - fm) < WGM ? (nM - fm) : WGM;
        u.pm = fm + ((wgid % nig) % gsz); u.pn = (wgid % nig) / gsz; return true;
    }
    __device__ __forceinline__ void a_ready(const Unit&) const {}
    __device__ __forceinline__ void done(const Unit&) const {}
};
struct TableOrder {
    const LAS int* texp; int ntiles, nN, G, c;
    __device__ bool next(int i, Unit& u) const {
        const long L = (long)i * G + c; if (L >= (long)ntiles * nN) return false;
        const int t = (int)(L / nN), j = (int)(L % nN); u.pm = t; u.pn = texp[t] * nN + j; return true;
    }
    __device__ __forceinline__ void a_ready(const Unit&) const {}
    __device__ __forceinline__ void done(const Unit&) const {}
};

template <class Epi, class Sched>
__device__ __forceinline__ void gemm_phase_naive(LAS unsigned char* lds, const Gemm g, const Sched& S, const Epi& E) {
    const int tid = (int)__builtin_amdgcn_readfirstlane((int)threadIdx.x >> 6) * 64 + lane_id_fresh(), ty = tid >> 5, tx = tid & 31;
    LAS bf16* As = (LAS bf16*)lds; LAS bf16* Bs = (LAS bf16*)(lds + 128 * 40 * 2);
    Unit u;
    for (int i = 0; S.next(i, u); ++i) {
        for (int half = 0; half < 2; ++half) {
            float acc[8][8];
#pragma unroll
            for (int r = 0; r < 8; ++r)
#pragma unroll
                for (int c = 0; c < 8; ++c) acc[r][c] = 0.f;
            const bf16* Ab = g.A + ((size_t)u.pm * 256 + half * 128) * g.K; const bf16* Bb = g.Bt + (size_t)u.pn * 256 * g.K;
            for (int k0 = 0; k0 < g.K; k0 += 32) {
                __syncthreads();
                { const int r = tid >> 2, c8 = (tid & 3) * 8; *(LAS u32x4*)(As + r * 40 + c8) = *(const u32x4*)(Ab + (size_t)r * g.K + k0 + c8); }
#pragma unroll
                for (int j = 0; j < 2; ++j) { const int ch = tid + j * 512, r = ch >> 2, c8 = (ch & 3) * 8; *(LAS u32x4*)(Bs + r * 40 + c8) = *(const u32x4*)(Bb + (size_t)r * g.K + k0 + c8); }
                __syncthreads();
#pragma unroll 2
                for (int k = 0; k < 32; k += 2) {
                    float b0[8], b1[8];
#pragma unroll
                    for (int c = 0; c < 8; ++c) { const unsigned w = *(const LAS unsigned*)(Bs + (tx * 8 + c) * 40 + k); b0[c] = lo2f(w); b1[c] = hi2f(w); }
#pragma unroll
                    for (int r = 0; r < 8; ++r) { const unsigned w = *(const LAS unsigned*)(As + (ty * 8 + r) * 40 + k); const float a0 = lo2f(w), a1 = hi2f(w);
#pragma unroll
                        for (int c = 0; c < 8; ++c) acc[r][c] = fmaf(a1, b1[c], fmaf(a0, b0[c], acc[r][c])); }
                }
            }
#pragma unroll
            for (int r = 0; r < 8; ++r) E.store8(u, half * 128 + ty * 8 + r, tx * 8, acc[r]);
        }
    }
    __syncthreads();
}

struct EpiZ { bf16 *ZR, *SG, *ZM;
    __device__ __forceinline__ void store8(const Unit& u, int r, int c, const float (&v)[8]) const {
        const size_t row = (size_t)u.pm * 256 + r;
        if (u.pn < 7) { *(u32x4*)(ZR + row * 1792 + u.pn * 256 + c) = pack8(v); }
        else if (u.pn < 15) { float s[8];
#pragma unroll
            for (int i = 0; i < 8; ++i) s[i] = sigmoidf_(v[i]);
            *(u32x4*)(SG + row * 2048 + (u.pn - 7) * 256 + c) = pack8(s); }
        else { *(u32x4*)(ZM + row * 512 + (u.pn - 15) * 256 + c) = pack8(v); }
    } };
struct EpiLora { bf16 *LW, *A; const float *w0, *a0;
    __device__ __forceinline__ void store8(const Unit& u, int r, int c, const float (&v)[8]) const {
        const size_t row = (size_t)u.pm * 256 + r; const int col = u.pn * 256 + c; float o[8];
        const bool isw = col < 512; const float* bp = isw ? (w0 + col) : (a0 + col - 512);
        const f32x4 b0 = *(const f32x4*)bp, b1 = *(const f32x4*)(bp + 4); const float bb[8] = {b0.x, b0.y, b0.z, b0.w, b1.x, b1.y, b1.z, b1.w};
#pragma unroll
        for (int i = 0; i < 8; ++i) { const float e = __expf(fminf(-(bb[i] + v[i]), 80.f)); const float s = 1.0f / (1.0f + e); o[i] = isw ? -0.60653065971263342f * s : s; }
        bf16* dst = isw ? (LW + row * 512 + col) : (A + row * 512 + col - 512);
        *(u32x4*)dst = pack8(o);
    } };
struct EpiPlain { bf16* O0; bf16* O1; int split, ld0, ld1;
    __device__ __forceinline__ void store8(const Unit& u, int r, int c, const float (&v)[8]) const {
        const size_t row = (size_t)u.pm * 256 + r; int col = u.pn * 256 + c;
        if (col < split) *(u32x4*)(O0 + row * ld0 + col) = pack8(v); else *(u32x4*)(O1 + row * ld1 + col - split) = pack8(v);
    } };
template <bool ACCUM> struct EpiBranch { bf16* MG; const bf16* SG; int goff;
    __device__ __forceinline__ void store8(const Unit& u, int r, int c, const float (&v)[8]) const {
        const size_t row = (size_t)u.pm * 256 + r; const int col = u.pn * 256 + c; float gt[8], o[8];
        unpack8(*(const u32x4*)(SG + row * 2048 + goff + col), gt);
        if (ACCUM) { float p[8]; unpack8(*(const u32x4*)(MG + row * 1024 + col), p);
#pragma unroll
            for (int i = 0; i < 8; ++i) o[i] = p[i] + gt[i] * v[i]; }
        else {
#pragma unroll
            for (int i = 0; i < 8; ++i) o[i] = gt[i] * v[i]; }
        *(u32x4*)(MG + row * 1024 + col) = pack8(o);
    } };
struct EpiOut { float* X1; const float* x; const float* mod;
    __device__ __forceinline__ void store8(const Unit& u, int r, int c, const float (&v)[8]) const {
        const size_t row = (size_t)u.pm * 256 + r; const int col = u.pn * 256 + c; const int b = (int)(row / SEQ);
        const float* gt = mod + b * 6144 + 2048 + col; const float* xr = x + row * 1024 + col; float* o = X1 + row * 1024 + col;
        const f32x4 g0 = *(const f32x4*)gt, g1 = *(const f32x4*)(gt + 4), x0 = *(const f32x4*)xr, x1 = *(const f32x4*)(xr + 4);
        *(f32x4*)o = (f32x4){x0.x + g0.x * v[0], x0.y + g0.y * v[1], x0.z + g0.z * v[2], x0.w + g0.w * v[3]};
        *(f32x4*)(o + 4) = (f32x4){x1.x + g1.x * v[4], x1.y + g1.y * v[5], x1.z + g1.z * v[6], x1.w + g1.w * v[7]};
    } };
struct EpiGateUp { bf16* HID;
    __device__ __forceinline__ void store8(const Unit& u, int r, int c, const float (&v)[8]) const {
        const size_t row = (size_t)u.pm * 256 + r; const int col = ((u.pn & 1) * 256 + c) >> 1;
        u32x2 w; w.x = pk2(siluf_(v[0]) * v[4], siluf_(v[1]) * v[5]); w.y = pk2(siluf_(v[2]) * v[6], siluf_(v[3]) * v[7]);
        *(u32x2*)(HID + row * 256 + col) = w;
    } };
struct EpiDown { bf16* YS;
    __device__ __forceinline__ void store8(const Unit& u, int r, int c, const float (&v)[8]) const {
        const size_t row = (size_t)u.pm * 256 + r; *(u32x4*)(YS + row * 1024 + (u.pn & 3) * 256 + c) = pack8(v);
    } };


namespace pg8 {
#define PG8_LAS __attribute__((address_space(3)))
typedef ::bf16x8 bf16x8; typedef ::f32x4 f32x4;
using ::Unit; using ::Gemm;
constexpr int BM = 256, BK = 64, HALF = 128, HTB = HALF * BK * 2  , STAGE_BYTES = 8 * HTB;

__device__ __forceinline__ int lds_byte(int r, int c) { const int st = (r >> 4) * 2 + (c >> 5), rr = r & 15, cc = c & 31, ob = rr * 64 + cc * 2; return st * 1024 + (ob ^ (((ob >> 9) & 1) << 5)); }
__device__ __forceinline__ void stage_rc(int b, int& R, int& C) { const int st = b / 1024, sb = b % 1024, swz = sb ^ (((sb >> 9) & 1) << 5); R = (st >> 1) * 16 + swz / 64; C = (st & 1) * 32 + (swz % 64) / 2; }
__device__ __forceinline__ int perm32(int rho) { const int n = rho >> 4, i = rho & 15; return 8 * (i >> 2) + 4 * n + (i & 3); }
template <class Epi, class Sched, bool ALIGN_EPI = false, bool SP2 = false>
__device__ __forceinline__ void gemm_phase(PG8_LAS unsigned char* lds, const Gemm g, const Sched& S, const Epi& E, const int wave_in) {
    const int lane = lane_id_fresh(), wid = wave_in, tid = wid * 64 + lane,
              wr = wid >> 2, wc = wid & 3, fr = lane & 15, fq = lane >> 4;
    const int K = g.K, nt = K / BK;
    unsigned voffA[2], voffB[2];
#pragma unroll
    for (int i = 0; i < 2; ++i) { int R, C; stage_rc(tid * 16 + i * 8192, R, C); const int Rb = Epi::PERM ? ((R & ~31) + perm32(R & 31)) : R;
        voffA[i] = (unsigned)(R * K + C) * 2u; voffB[i] = (unsigned)(Rb * K + C) * 2u; }
    const size_t kstep = (size_t)(BK * 2);
    const size_t hstep = (size_t)HALF * K * 2;
    const size_t tstep = 2 * hstep;
    const unsigned ldsw = (unsigned)wid * 1024u;
    const int aoff = lds_byte(wr * 64 + fr, fq * 8), boff = lds_byte(wc * 32 + fr, fq * 8);
#define PG8_SA(b, h) (((b) * 2 + (h)) * HTB)
#define PG8_SB(b, h) ((4 + (b) * 2 + (h)) * HTB)
#define PG8_STAGE(bufoff, gbase, voff) do { _Pragma("unroll") for (int _i = 0; _i < 2; ++_i) \
        __builtin_amdgcn_global_load_lds((const unsigned*)((const char*)(gbase) + (voff)[_i]), (PG8_LAS unsigned*)(lds + (bufoff) + ldsw + _i * 8192), 16, 0, 0); } while (0)
#define PG8_LDA(dst, b, h) do { _Pragma("unroll") for (int m = 0; m < 4; ++m) _Pragma("unroll") for (int k = 0; k < 2; ++k) dst[m][k] = *(const PG8_LAS bf16x8*)(lds + PG8_SA(b, h) + aoff + m * 2048 + k * 1024); } while (0)
#define PG8_LDB(dst, b, h) do { _Pragma("unroll") for (int n = 0; n < 2; ++n) _Pragma("unroll") for (int k = 0; k < 2; ++k) dst[n][k] = *(const PG8_LAS bf16x8*)(lds + PG8_SB(b, h) + boff + n * 2048 + k * 1024); } while (0)
#define PG8_MMA(ai, bj, At, Bt) do { __builtin_amdgcn_s_setprio(1); _Pragma("unroll") for (int m = 0; m < 4; ++m) _Pragma("unroll") for (int n = 0; n < 2; ++n) _Pragma("unroll") for (int k = 0; k < 2; ++k) \
        acc[ai][bj][m][n] = __builtin_amdgcn_mfma_f32_16x16x32_bf16(Bt[n][k], At[m][k], acc[ai][bj][m][n], 0, 0, 0); __builtin_amdgcn_s_setprio(0); } while (0)
#define PG8_WAIT_V(n) asm volatile("s_waitcnt vmcnt(" #n ")" ::: "memory")
#define PG8_WAIT_L(n) asm volatile("s_waitcnt lgkmcnt(" #n ")" ::: "memory")
#define PG8_BAR __builtin_amdgcn_s_barrier()
#define PG8_SCHED __builtin_amdgcn_sched_barrier(0)
    Unit cur, nxt; int ui = 0;
    if (!S.next(0, cur)) return;
    f32x4 acc[2][2][4][2];
#pragma unroll
    for (int a = 0; a < 2; ++a)
#pragma unroll
        for (int b = 0; b < 2; ++b)
#pragma unroll
            for (int m = 0; m < 4; ++m)
#pragma unroll
                for (int n = 0; n < 2; ++n) acc[a][b][m][n] = (f32x4){0.f, 0.f, 0.f, 0.f};
    bf16x8 At[4][2], B0[2][2], B1[2][2];
    const char* cA = (const char*)g.A + (size_t)cur.pm * tstep; const char* cB = (const char*)g.Bt + (size_t)cur.pn * tstep;
    S.a_ready(cur);
    if constexpr (SP2) {
        PG8_STAGE(PG8_SB(0, 0), cB, voffB); PG8_STAGE(PG8_SB(0, 1), cB + hstep, voffB); PG8_STAGE(PG8_SA(0, 0), cA, voffA); PG8_STAGE(PG8_SA(0, 1), cA + hstep, voffA);
        if (wr == 1) PG8_BAR;
        PG8_WAIT_V(2); PG8_BAR;
        PG8_STAGE(PG8_SB(1, 0), cB + kstep, voffB); PG8_STAGE(PG8_SA(1, 0), cA + kstep, voffA); PG8_STAGE(PG8_SB(1, 1), cB + hstep + kstep, voffB);
        PG8_WAIT_V(6); PG8_BAR;
    } else {
        PG8_STAGE(PG8_SB(0, 0), cB, voffB); PG8_STAGE(PG8_SA(0, 0), cA, voffA); PG8_STAGE(PG8_SB(0, 1), cB + hstep, voffB); PG8_STAGE(PG8_SA(0, 1), cA + hstep, voffA);
        if (wr == 1) PG8_BAR;
        PG8_WAIT_V(4); PG8_BAR;
        PG8_STAGE(PG8_SB(1, 0), cB + kstep, voffB); PG8_STAGE(PG8_SA(1, 0), cA + kstep, voffA); PG8_STAGE(PG8_SB(1, 1), cB + hstep + kstep, voffB);
        PG8_WAIT_V(6); PG8_BAR;
    }
    for (;;) {
        const bool has_next = S.next(ui + 1, nxt);
        const char* nA = has_next ? (const char*)g.A + (size_t)nxt.pm * tstep : cA; const char* nB = has_next ? (const char*)g.Bt + (size_t)nxt.pn * tstep : cB;
        for (int t = 0; t < nt; t += 2) {
            const bool last = (t == nt - 2);
            const char* a1 = cA + (size_t)(t + 1) * kstep;
            const char* a2 = last ? nA : cA + (size_t)(t + 2) * kstep; const char* b2 = last ? nB : cB + (size_t)(t + 2) * kstep;
            const char* a3 = a2 + kstep; const char* b3 = b2 + kstep;
            if (last && has_next) S.a_ready(nxt);
            if constexpr (SP2) {
            PG8_LDB(B0, 0, 0); PG8_LDB(B1, 0, 1); PG8_SCHED; PG8_LDA(At, 0, 0); PG8_STAGE(PG8_SA(1, 1), a1 + hstep, voffA);
            PG8_WAIT_V(8); PG8_WAIT_L(0); PG8_BAR; PG8_MMA(0, 0, At, B0); PG8_MMA(0, 1, At, B1); PG8_BAR; PG8_SCHED;
            PG8_LDA(At, 0, 1); PG8_STAGE(PG8_SB(0, 0), b2, voffB); PG8_STAGE(PG8_SB(0, 1), b2 + hstep, voffB); PG8_STAGE(PG8_SA(0, 0), a2, voffA);
            PG8_WAIT_V(8); PG8_WAIT_L(0); PG8_BAR; PG8_MMA(1, 0, At, B0); PG8_MMA(1, 1, At, B1); PG8_BAR; PG8_SCHED;
            PG8_LDB(B0, 1, 0); PG8_LDB(B1, 1, 1); PG8_SCHED; PG8_LDA(At, 1, 0); PG8_STAGE(PG8_SA(0, 1), a2 + hstep, voffA);
            PG8_WAIT_V(8); PG8_WAIT_L(0); PG8_BAR; PG8_MMA(0, 0, At, B0); PG8_MMA(0, 1, At, B1); PG8_BAR; PG8_SCHED;
            PG8_LDA(At, 1, 1); PG8_STAGE(PG8_SB(1, 0), b3, voffB); PG8_STAGE(PG8_SB(1, 1), b3 + hstep, voffB); PG8_STAGE(PG8_SA(1, 0), a3, voffA);
            PG8_WAIT_V(8); PG8_WAIT_L(0); PG8_BAR; PG8_MMA(1, 0, At, B0); PG8_MMA(1, 1, At, B1); PG8_BAR; PG8_SCHED;
            } else {
            PG8_LDB(B0, 0, 0); PG8_SCHED; PG8_LDA(At, 0, 0); PG8_STAGE(PG8_SA(1, 1), a1 + hstep, voffA);
            PG8_WAIT_L(8); PG8_BAR; PG8_WAIT_L(0); PG8_MMA(0, 0, At, B0); PG8_BAR; PG8_SCHED;
            PG8_LDB(B1, 0, 1); PG8_STAGE(PG8_SB(0, 0), b2, voffB);
            PG8_BAR; PG8_WAIT_L(0); PG8_MMA(0, 1, At, B1); PG8_BAR;
            PG8_LDA(At, 0, 1); PG8_STAGE(PG8_SA(0, 0), a2, voffA);
            PG8_BAR; PG8_WAIT_L(0); PG8_MMA(1, 0, At, B0); PG8_BAR; PG8_SCHED;
            PG8_STAGE(PG8_SB(0, 1), b2 + hstep, voffB);
            PG8_WAIT_V(6); PG8_BAR; PG8_MMA(1, 1, At, B1); PG8_BAR;
            PG8_LDB(B0, 1, 0); PG8_SCHED; PG8_LDA(At, 1, 0); PG8_STAGE(PG8_SA(0, 1), a2 + hstep, voffA);
            PG8_WAIT_L(8); PG8_BAR; PG8_WAIT_L(0); PG8_MMA(0, 0, At, B0); PG8_BAR; PG8_SCHED;
            PG8_LDB(B1, 1, 1); PG8_STAGE(PG8_SB(1, 0), b3, voffB);
            PG8_BAR; PG8_WAIT_L(0); PG8_MMA(0, 1, At, B1); PG8_BAR;
            PG8_LDA(At, 1, 1); PG8_STAGE(PG8_SA(1, 0), a3, voffA);
            PG8_BAR; PG8_WAIT_L(0); PG8_MMA(1, 0, At, B0); PG8_BAR; PG8_SCHED;
            PG8_STAGE(PG8_SB(1, 1), b3 + hstep, voffB);
            PG8_WAIT_V(6); PG8_BAR; PG8_MMA(1, 1, At, B1); PG8_BAR;
            }
        }
        if constexpr (ALIGN_EPI) { if (wr == 0) PG8_BAR; }
        if constexpr (!Epi::AFTER_DRAIN) { E(acc, cur, wr, wc, fr, fq); S.done(cur); }
        if (!has_next) break;
#pragma unroll
        for (int a = 0; a < 2; ++a)
#pragma unroll
            for (int b = 0; b < 2; ++b)
#pragma unroll
                for (int m = 0; m < 4; ++m)
#pragma unroll
                    for (int n = 0; n < 2; ++n) acc[a][b][m][n] = (f32x4){0.f, 0.f, 0.f, 0.f};
        cur = nxt; cA = nA; cB = nB; ++ui;
        if constexpr (ALIGN_EPI) { if (wr == 1) PG8_BAR; }
    }
    PG8_WAIT_V(0);
    if constexpr (!ALIGN_EPI) { if (wr == 0) PG8_BAR; }
    PG8_BAR;
    if constexpr (Epi::AFTER_DRAIN) { E.fused(acc, cur, wr, wc, fr, fq, lds, wid, lane); S.done(cur); }
#undef PG8_SA
#undef PG8_SB
#undef PG8_STAGE
#undef PG8_LDA
#undef PG8_LDB
#undef PG8_MMA
#undef PG8_WAIT_V
#undef PG8_WAIT_L
#undef PG8_BAR
#undef PG8_SCHED
}

template <class F> struct EpiAdapt {
    static constexpr bool PERM = true, AFTER_DRAIN = false; F f;
    __device__ __forceinline__ void operator()(const f32x4 (&acc)[2][2][4][2], const Unit& u, int wr, int wc, int fr, int fq) const {
        asm volatile("" : "+v"(fr), "+v"(fq));
#pragma unroll
        for (int ai = 0; ai < 2; ++ai)
#pragma unroll
            for (int m = 0; m < 4; ++m) { const int row = ai * HALF + wr * 64 + m * 16 + fr;
#pragma unroll
                for (int bj = 0; bj < 2; ++bj) { const f32x4 v0 = acc[ai][bj][m][0], v1 = acc[ai][bj][m][1];
                    const float v[8] = {v0[0], v0[1], v0[2], v0[3], v1[0], v1[1], v1[2], v1[3]};
                    f.store8(u, row, bj * HALF + wc * 32 + 8 * fq, v); } }
    }
};
}

template <class Epi, class Sched>
__device__ __forceinline__ void gemm_phase_any(LAS unsigned char* lds, const Gemm g, const Sched& S, const Epi& E, const int wave_in) {
#if ENG_GEMM == 1
    pg8::EpiAdapt<Epi> EA{E};
    pg8::gemm_phase<pg8::EpiAdapt<Epi>, Sched, true, true>(lds, g, S, EA, wave_in);
#else
    gemm_phase_naive<Epi, Sched>(lds, g, S, E);
#endif
}

template <class RowMap>
__device__ __forceinline__ void transpose_item(const float* W, int ldw, bf16* WT, int ldt, int koff, int k0, int n0, const RowMap& rm, LAS float* scr, int lane) {
#pragma unroll 8
    for (int i = 0; i < 32; ++i) { const int kk = 2 * i + (lane >> 5); scr[kk * 33 + (lane & 31)] = W[(size_t)(k0 + kk) * ldw + n0 + (lane & 31)]; }
    asm volatile("s_waitcnt lgkmcnt(0)" ::: "memory");
    const int c = lane & 7;
#pragma unroll
    for (int j = 0; j < 4; ++j) { const int n = (lane >> 3) + 8 * j; const LAS float* s = scr + (8 * c) * 33 + n;
        u32x4 o; o.x = pk2(s[0 * 33], s[1 * 33]); o.y = pk2(s[2 * 33], s[3 * 33]); o.z = pk2(s[4 * 33], s[5 * 33]); o.w = pk2(s[6 * 33], s[7 * 33]);
        *(u32x4*)(WT + (size_t)rm(n0 + n) * ldt + koff + k0 + 8 * c) = o; }
    asm volatile("s_waitcnt lgkmcnt(0)" ::: "memory");
}
struct RmId { int off; __device__ int operator()(int n) const { return off + n; } };
struct RmWin { __device__ int operator()(int n) const { return n < 1792 ? n : (n < 2208 ? 3840 + (n - 1792) : 1792 + (n - 2208)); } };
struct RmUkv { __device__ int operator()(int n) const { const int h = n >> 7, j = n & 127; return j < 64 ? h * 64 + j : 512 + h * 64 + (j - 64); } };
struct RmGU { int off; __device__ int operator()(int j) const { return off + 8 * (j >> 2) + (j & 3); } };

__device__ __forceinline__ void p0_prologue(const Frame& F, ArgsP a) {
    const int lane_f = lane_id_fresh(), tid_f = F.wave * 64 + lane_f;
    LAS float* scr = (LAS float*)(F.lds + F.wave * 16384);
    const int lane = lane_f;
    bf16* Win = (bf16*)(F.ws + WS_WIN); bf16* Wblk = (bf16*)(F.ws + WS_WBLK); bf16* Wg = (bf16*)(F.ws + WS_WG); bf16* Wuq = (bf16*)(F.ws + WS_WUQ);
    bf16* Wukv = (bf16*)(F.ws + WS_WUKV); bf16* Wb = (bf16*)(F.ws + WS_WB); bf16* Wo = (bf16*)(F.ws + WS_WO); bf16* Wgu = (bf16*)(F.ws + WS_WGU); bf16* Wdn = (bf16*)(F.ws + WS_WDN);
    constexpr int I_IN = 16 * 133, I_DEC = 1 * 16, I_AUP = 16, I_GUP = 2 * 16, I_UQ = 4 * 24, I_UKV = 2 * 32, I_BR = 2 * 8 * 32, I_O = 16 * 32;
    constexpr int I_EG = 32 * 16 * 8, I_EU = I_EG, I_ED = 32 * 4 * 32;
    constexpr int NITEMS = I_IN + I_DEC + I_AUP + I_GUP + I_UQ + I_UKV + I_BR + I_O + I_EG + I_EU + I_ED;
    for (int it = F.gw; it < NITEMS; it += F.NGW) {
        int r = it;
        if (r < I_IN) { const int kb = r / 133, nb = r % 133; transpose_item(a->in[I_WIN], D_IN, Win, 1024, 0, 64 * kb, 32 * nb, RmWin{}, scr, lane); continue; } r -= I_IN;
        if (r < I_DEC) { transpose_item(a->in[I_WDEC], 512, Wblk, 128, 0, 0, 32 * r, RmId{0}, scr, lane); continue; } r -= I_DEC;
        if (r < I_AUP) { transpose_item(a->in[I_WAUP], 512, Wblk, 128, 64, 0, 32 * r, RmId{512}, scr, lane); continue; } r -= I_AUP;
        if (r < I_GUP) { const int kb = r / 16, nb = r % 16; transpose_item(a->in[I_WGUP], 512, Wg, 128, 0, 64 * kb, 32 * nb, RmId{0}, scr, lane); continue; } r -= I_GUP;
        if (r < I_UQ) { const int kb = r / 24, nb = r % 24; transpose_item(a->in[I_WUQ], 768, Wuq, 256, 0, 64 * kb, 32 * nb, RmId{0}, scr, lane); continue; } r -= I_UQ;
        if (r < I_UKV) { const int kb = r / 32, nb = r % 32; transpose_item(a->in[I_WUKV], 1024, Wukv, 128, 0, 64 * kb, 32 * nb, RmUkv{}, scr, lane); continue; } r -= I_UKV;
        if (r < I_BR) { const int br = r / 256, q = r % 256, kb = q / 32, nb = q % 32; transpose_item(a->in[I_WBR] + (size_t)br * 512 * 1024, 1024, Wb + (size_t)br * 1024 * 512, 512, 0, 64 * kb, 32 * nb, RmId{0}, scr, lane); continue; } r -= I_BR;
        if (r < I_O) { const int kb = r / 32, nb = r % 32; transpose_item(a->in[I_WOUT], 1024, Wo, 1024, 0, 64 * kb, 32 * nb, RmId{0}, scr, lane); continue; } r -= I_O;
        if (r < I_EG) { const int e = r / 128, q = r % 128, kb = q / 8, nb = q % 8; transpose_item(a->in[I_WEG] + (size_t)e * 1024 * 256, 256, Wgu + (size_t)e * 512 * 1024, 1024, 0, 64 * kb, 32 * nb, RmGU{0}, scr, lane); continue; } r -= I_EG;
        if (r < I_EU) { const int e = r / 128, q = r % 128, kb = q / 8, nb = q % 8; transpose_item(a->in[I_WEU] + (size_t)e * 1024 * 256, 256, Wgu + (size_t)e * 512 * 1024, 1024, 0, 64 * kb, 32 * nb, RmGU{4}, scr, lane); continue; } r -= I_EU;
        { const int e = r / 128, q = r % 128, kb = q / 32, nb = q % 32; transpose_item(a->in[I_WED] + (size_t)e * 256 * 1024, 1024, Wdn + (size_t)e * 1024 * 256, 256, 0, 64 * kb, 32 * nb, RmId{0}, scr, lane); }
    }
    for (int i = F.gw * 64 + lane; i < 96 * 128; i += F.NGW * 64) *(u32x4*)(Win + (size_t)4256 * 1024 + (size_t)i * 8) = (u32x4){0u, 0u, 0u, 0u};
    for (int i = F.gw * 64 + lane; i < 1024 * 8; i += F.NGW * 64) { const int row = i >> 3, c8 = (i & 7) * 8; *(u32x4*)(Wblk + row * 128 + (row < 512 ? 64 : 0) + c8) = (u32x4){0u, 0u, 0u, 0u}; }
    { const int* pos = (const int*)a->in[I_POS]; float* cs = (float*)(F.ws + WS_CS);
      for (int i = F.gw * 64 + lane; i < NTOK * 16; i += F.NGW * 64) { const int t = i >> 4, j = i & 15;
          const float fr = exp2f(-(float)j * (13.287712379549449f / 16.0f));
          const float ang = (float)pos[t] * fr; cs[t * 32 + j] = cosf(ang); cs[t * 32 + 16 + j] = sinf(ang); } }
    { float* mod = (float*)(F.ws + WS_MOD); const float* c = a->in[I_C]; const float* wa = a->in[I_WADA]; const float* ba = a->in[I_BADA];
      LAS float* red = (LAS float*)(F.lds + 8 * 16384);
      for (int nb = F.vcu; nb < 96; nb += F.G) {
          float acc[8];
#pragma unroll
          for (int b = 0; b < 8; ++b) acc[b] = 0.f;
          const int n = nb * 64 + lane;
          for (int k = F.wave * 128; k < F.wave * 128 + 128; ++k) { const float w = wa[(size_t)k * 6144 + n];
#pragma unroll
              for (int b = 0; b < 8; ++b) acc[b] = fmaf(siluf_(c[b * 1024 + k]), w, acc[b]); }
#pragma unroll
          for (int b = 0; b < 8; ++b) red[(F.wave * 8 + b) * 64 + lane] = acc[b];
          __syncthreads();
          { const int b = F.wave; float s = ba[n];
#pragma unroll
            for (int w = 0; w < 8; ++w) s += red[(w * 8 + b) * 64 + lane];
            mod[b * 6144 + n] = s; }
          __syncthreads();
      } }
}

__device__ __forceinline__ void p_normmod(const Frame& F, const float* x, const float* g, const float* mod, int sh_off, int sc_off, bf16* H) {
    const int lane_f = lane_id_fresh(), tid_f = F.wave * 64 + lane_f;
    for (int m = F.gw; m < NTOK; m += F.NGW) {
        const int b = m / SEQ; const f32x4* xr = (const f32x4*)(x + (size_t)m * 1024) + lane_f;
        f32x4 v[4]; float s = 0.f;
#pragma unroll
        for (int j = 0; j < 4; ++j) { v[j] = xr[64 * j]; s += (v[j].x * v[j].x + v[j].y * v[j].y) + (v[j].z * v[j].z + v[j].w * v[j].w); }
        const float rstd = 1.0f / sqrtf(wave_sum(s) * (1.f / 1024.f) + EPS);
        u32x2* o = (u32x2*)(H + (size_t)m * 1024) + lane_f;
#pragma unroll
        for (int j = 0; j < 4; ++j) { const int col = 4 * lane_f + 256 * j;
            const f32x4 gg = *(const f32x4*)(g + col), sc = *(const f32x4*)(mod + b * 6144 + sc_off + col), sh = *(const f32x4*)(mod + b * 6144 + sh_off + col);
            const f32x4 y = v[j] * rstd * gg * (sc + 1.0f) + sh; u32x2 w; w.x = pk2(y.x, y.y); w.y = pk2(y.z, y.w); o[64 * j] = w; }
    }
}

__device__ __forceinline__ void p_prep_a(const Frame& F, ArgsP a) {
    const int lane_f = lane_id_fresh();
    const bf16* ZR = (const bf16*)(F.ws + WS_ZR); const bf16* ZM = (const bf16*)(F.ws + WS_ZM);
    bf16* TWA = (bf16*)(F.ws + WS_TWA); bf16* SGL = (bf16*)(F.ws + WS_SGL); bf16* QA = (bf16*)(F.ws + WS_QA); bf16* KVA = (bf16*)(F.ws + WS_KVA);
    const float* mu = a->in[I_MU]; const float* gqa = a->in[I_GQA]; const float* gkva = a->in[I_GKVA];
    const int lane = lane_f;
    const f32x4 mm = *(const f32x4*)(mu + 1536 + 4 * lane), gq = *(const f32x4*)(gqa + 4 * lane), gk = *(const f32x4*)(gkva + 4 * (lane & 31));
    for (int m = F.gw; m < NTOK; m += F.NGW) {
        const bool first = (m % SEQ) == 0;
        { const u32x2 c = *((const u32x2*)(ZR + (size_t)m * 1792 + 1536) + lane); u32x2 p = *((const u32x2*)(ZR + (size_t)(first ? m : m - 1) * 1792 + 1536) + lane); if (first) { p.x = 0u; p.y = 0u; }
          float z[4] = {lo2f(c.x), hi2f(c.x), lo2f(c.y), hi2f(c.y)}; const float q[4] = {lo2f(p.x), hi2f(p.x), lo2f(p.y), hi2f(p.y)};
          z[0] += (q[0] - z[0]) * mm.x; z[1] += (q[1] - z[1]) * mm.y; z[2] += (q[2] - z[2]) * mm.z; z[3] += (q[3] - z[3]) * mm.w;
          if (lane < 16) { u32x2 w; w.x = pk2(tanhf(z[0]), tanhf(z[1])); w.y = pk2(tanhf(z[2]), tanhf(z[3])); *((u32x2*)(TWA + (size_t)m * 128) + lane) = w; }
          else if (lane < 32) { u32x2 w; w.x = pk2(z[0], z[1]); w.y = pk2(z[2], z[3]); *((u32x2*)(TWA + (size_t)m * 128) + lane) = w; }
          else { u32x2 w; w.x = pk2(sigmoidf_(z[0]), sigmoidf_(z[1])); w.y = pk2(sigmoidf_(z[2]), sigmoidf_(z[3])); *((u32x2*)(SGL + (size_t)m * 128) + (lane - 32)) = w; } }
        { const u32x2 c = *((const u32x2*)(ZM + (size_t)m * 512) + lane); const float z[4] = {lo2f(c.x), hi2f(c.x), lo2f(c.y), hi2f(c.y)};
          u32x2 c2 = (u32x2){0u, 0u}; if (lane < 32) c2 = *((const u32x2*)(ZM + (size_t)m * 512 + 256) + lane); const float y[4] = {lo2f(c2.x), hi2f(c2.x), lo2f(c2.y), hi2f(c2.y)};
          const float rstd = 1.0f / sqrtf(wave_sum((z[0] * z[0] + z[1] * z[1]) + (z[2] * z[2] + z[3] * z[3])) * (1.f / 256.f) + EPS);
          const float rstd2 = 1.0f / sqrtf(wave_sum((y[0] * y[0] + y[1] * y[1]) + (y[2] * y[2] + y[3] * y[3])) * (1.f / 128.f) + EPS);
          u32x2 w; w.x = pk2(z[0] * rstd * gq.x, z[1] * rstd * gq.y); w.y = pk2(z[2] * rstd * gq.z, z[3] * rstd * gq.w);
          *((u32x2*)(QA + (size_t)m * 256) + lane) = w;
          if (lane < 32) { u32x2 w2; w2.x = pk2(y[0] * rstd2 * gk.x, y[1] * rstd2 * gk.y); w2.y = pk2(y[2] * rstd2 * gk.z, y[3] * rstd2 * gk.w);
              *((u32x2*)(KVA + (size_t)m * 128) + lane) = w2; } }
    }
}

__device__ __forceinline__ void p_prep_c(const Frame& F, ArgsP a) {
    const int lane_f = lane_id_fresh(), tid_f = F.wave * 64 + lane_f;
    bf16* Q = (bf16*)(F.dob + DO_Q); const bf16* KN = (const bf16*)(F.dob + DO_KN); const bf16* ZM = (const bf16*)(F.ws + WS_ZM); bf16* KC = (bf16*)(F.ws + WS_KC);
    const float* cs = (const float*)(F.ws + WS_CS);
    const float* qn = a->in[I_QN]; const float* kn = a->in[I_KN];
    const int lane = lane_f, hd = lane >> 3, j = lane & 7;
    for (int m = F.gw; m < NTOK; m += F.NGW) {
        const f32x2 cc = *(const f32x2*)(cs + (size_t)m * 32 + 2 * j), sn = *(const f32x2*)(cs + (size_t)m * 32 + 16 + 2 * j);
        { bf16* qp = Q + (size_t)m * 768 + hd * 96; float v[8]; unpack8(*(const u32x4*)(qp + 8 * j), v);
          const unsigned w1 = *(const unsigned*)(qp + 64 + 2 * j), w2 = *(const unsigned*)(qp + 80 + 2 * j); float x1[2] = {lo2f(w1), hi2f(w1)}, x2[2] = {lo2f(w2), hi2f(w2)};
          float ss = (x1[0] * x1[0] + x1[1] * x1[1]) + (x2[0] * x2[0] + x2[1] * x2[1]);
#pragma unroll
          for (int i = 0; i < 8; ++i) ss += v[i] * v[i];
          const float rstd = 1.0f / sqrtf(sum8(ss) * (1.f / 96.f) + EPS);
#pragma unroll
          for (int i = 0; i < 8; ++i) v[i] = v[i] * rstd * qn[8 * j + i] * QSCALE;
          x1[0] *= rstd * qn[64 + 2 * j]; x1[1] *= rstd * qn[65 + 2 * j]; x2[0] *= rstd * qn[80 + 2 * j]; x2[1] *= rstd * qn[81 + 2 * j];
          const float o1a = (x1[0] * cc.x - x2[0] * sn.x) * QSCALE, o1b = (x1[1] * cc.y - x2[1] * sn.y) * QSCALE, o2a = (x2[0] * cc.x + x1[0] * sn.x) * QSCALE, o2b = (x2[1] * cc.y + x1[1] * sn.y) * QSCALE;
          *(u32x4*)(qp + 8 * j) = pack8(v); *(unsigned*)(qp + 64 + 2 * j) = pk2(o1a, o1b); *(unsigned*)(qp + 80 + 2 * j) = pk2(o2a, o2b); }
        { float v[8]; unpack8(*(const u32x4*)(KN + (size_t)m * 512 + hd * 64 + 8 * j), v);
          const unsigned w1 = *(const unsigned*)(ZM + (size_t)m * 512 + 384 + 2 * j), w2 = *(const unsigned*)(ZM + (size_t)m * 512 + 400 + 2 * j); float x1[2] = {lo2f(w1), hi2f(w1)}, x2[2] = {lo2f(w2), hi2f(w2)};
          float ss = (x1[0] * x1[0] + x1[1] * x1[1]) + (x2[0] * x2[0] + x2[1] * x2[1]);
#pragma unroll
          for (int i = 0; i < 8; ++i) ss += v[i] * v[i];
          const float rstd = 1.0f / sqrtf(sum8(ss) * (1.f / 96.f) + EPS);
#pragma unroll
          for (int i = 0; i < 8; ++i) v[i] = v[i] * rstd * kn[8 * j + i];
          x1[0] *= rstd * kn[64 + 2 * j]; x1[1] *= rstd * kn[65 + 2 * j]; x2[0] *= rstd * kn[80 + 2 * j]; x2[1] *= rstd * kn[81 + 2 * j];
          bf16* kp = KC + (size_t)m * 768 + hd * 96;
          *(u32x4*)(kp + 8 * j) = pack8(v); *(unsigned*)(kp + 64 + 2 * j) = pk2(x1[0] * cc.x - x2[0] * sn.x, x1[1] * cc.y - x2[1] * sn.y);
          *(unsigned*)(kp + 80 + 2 * j) = pk2(x2[0] * cc.x + x1[0] * sn.x, x2[1] * cc.y + x1[1] * sn.y); }
    }
}

constexpr int SC_T = 32;
constexpr int SC_BUF = 5 * SC_T * 64 * 4 + SC_T * 16 * 4 + SC_T * 16 * 4;
template <int CTRL> __device__ __forceinline__ float dpp_add(float x) { return x + __builtin_bit_cast(float, __builtin_amdgcn_update_dpp(0, __builtin_bit_cast(int, x), CTRL, 0xf, 0xf, false)); }
__device__ __forceinline__ float allsum16(float x) { x = dpp_add<0xB1>(x); x = dpp_add<0x4E>(x); x = dpp_add<0x141>(x); x = dpp_add<0x140>(x); return x; }
#define LDS_BAR() do { asm volatile("s_waitcnt lgkmcnt(0)" ::: "memory"); __builtin_amdgcn_s_barrier(); asm volatile("" ::: "memory"); } while (0)
struct ScanRaw { u32x2 rc[2], rp[2], kc[2], kp[2], av[2], lw[2]; u32x4 vc, vp; };
__device__ __forceinline__ void scan_issue(ScanRaw& R, const bf16* ZR, const bf16* A, const bf16* LW, size_t row0, int t0, int st2, int col, int s2, int cv, bool dov) {
#pragma unroll
    for (int u = 0; u < 2; ++u) { const int tt = t0 + st2 + 16 * u; const size_t g = row0 + tt; const size_t gp = row0 + (tt > 0 ? tt - 1 : 0);
        R.rc[u] = *(const u32x2*)(ZR + g * 1792 + col); R.rp[u] = *(const u32x2*)(ZR + gp * 1792 + col);
        R.kc[u] = *(const u32x2*)(ZR + g * 1792 + 512 + col); R.kp[u] = *(const u32x2*)(ZR + gp * 1792 + 512 + col);
        R.av[u] = *(const u32x2*)(A + g * 512 + col); R.lw[u] = *(const u32x2*)(LW + g * 512 + col); }
    { const int tv = t0 + (dov ? s2 : 0); const size_t gv = row0 + tv; const size_t gvp = row0 + (tv > 0 ? tv - 1 : 0); R.vc = *(const u32x4*)(ZR + gv * 1792 + 1024 + cv); R.vp = *(const u32x4*)(ZR + gvp * 1792 + 1024 + cv); }
}
__device__ __forceinline__ void p_scan(const Frame& F, ArgsP a) {
    const int lane_f = lane_id_fresh(), tid_f = F.wave * 64 + lane_f;
    const bf16* ZR = (const bf16*)(F.ws + WS_ZR); const bf16* A = (const bf16*)(F.ws + WS_A); const bf16* LW = (const bf16*)(F.ws + WS_LW); bf16* Y = (bf16*)(F.ws + WS_Y);
    const float* mu = a->in[I_MU]; const float* k_k = a->in[I_KK]; const float* k_a = a->in[I_KA];
    const int lane = lane_f, wave = F.wave, tid = tid_f;
    for (int item = F.vcu; item < 256; item += F.G) {
        const int bh = item >> 2, qt = item & 3, b = bh >> 3, h = bh & 7;
        const size_t row0 = (size_t)b * SEQ; const int colh = h * 64;
        const int NCH = SEQ / SC_T;
        __syncthreads();
        if (wave >= 4) {
            const int lt = tid - 256, st2 = lt >> 4, j4 = (lt & 15) * 4, col = colh + j4, s2 = lt >> 1, hf = lt & 1, cv = colh + qt * 16 + hf * 8; const bool dov = lt < 64;
            f32x4 mur = *(const f32x4*)(mu + col), muk = *(const f32x4*)(mu + 512 + col), kkc = *(const f32x4*)(k_k + col), kac = *(const f32x4*)(k_a + col);
            f32x4 m0 = *(const f32x4*)(mu + 1024 + cv), m1 = *(const f32x4*)(mu + 1024 + cv + 4);
            asm volatile("" : "+v"(mur), "+v"(muk), "+v"(kkc), "+v"(kac), "+v"(m0), "+v"(m1));
            ScanRaw R0, R1;
            scan_issue(R0, ZR, A, LW, row0, 0, st2, col, s2, cv, dov);
#define SCAN_BUILD(RR, c_) do { LAS unsigned char* bs = F.lds + ((c_) & 1) * SC_BUF; \
                _Pragma("unroll") for (int u = 0; u < 2; ++u) { const int st = st2 + 16 * u; const bool t0_ = ((c_) * SC_T + st) == 0; \
                    const f32x4 rc = {lo2f(RR.rc[u].x), hi2f(RR.rc[u].x), lo2f(RR.rc[u].y), hi2f(RR.rc[u].y)}; f32x4 rp = {lo2f(RR.rp[u].x), hi2f(RR.rp[u].x), lo2f(RR.rp[u].y), hi2f(RR.rp[u].y)}; \
                    const f32x4 kc = {lo2f(RR.kc[u].x), hi2f(RR.kc[u].x), lo2f(RR.kc[u].y), hi2f(RR.kc[u].y)}; f32x4 kp = {lo2f(RR.kp[u].x), hi2f(RR.kp[u].x), lo2f(RR.kp[u].y), hi2f(RR.kp[u].y)}; \
                    const f32x4 av = {lo2f(RR.av[u].x), hi2f(RR.av[u].x), lo2f(RR.av[u].y), hi2f(RR.av[u].y)}; const f32x4 lw = {lo2f(RR.lw[u].x), hi2f(RR.lw[u].x), lo2f(RR.lw[u].y), hi2f(RR.lw[u].y)}; \
                    if (t0_) { rp = (f32x4){0.f, 0.f, 0.f, 0.f}; kp = rp; } \
                    const f32x4 r = rc + (rp - rc) * mur, zk = kc + (kp - kc) * muk, kq = zk * ((av - 1.0f) * kac + 1.0f), kr = zk * kkc; \
                    const float ss = allsum16((kr.x * kr.x + kr.y * kr.y) + (kr.z * kr.z + kr.w * kr.w)); const float inv = 1.0f / fmaxf(sqrtf(ss), 1e-12f); \
                    const f32x4 kk = kr * inv; const f32x4 wv = {__expf(lw.x), __expf(lw.y), __expf(lw.z), __expf(lw.w)}; \
                    LAS float* dst = (LAS float*)bs + st * 64 + j4; \
                    *(LAS f32x4*)dst = wv; *(LAS f32x4*)(dst + SC_T * 64) = -kk; *(LAS f32x4*)(dst + 2 * SC_T * 64) = kk * av; *(LAS f32x4*)(dst + 3 * SC_T * 64) = kq; *(LAS f32x4*)(dst + 4 * SC_T * 64) = r; } \
                if (dov) { float vc[8], vp[8]; unpack8(RR.vc, vc); unpack8(RR.vp, vp); if ((c_) * SC_T + s2 == 0) { _Pragma("unroll") for (int i = 0; i < 8; ++i) vp[i] = 0.f; } \
                    LAS float* dv = (LAS float*)(bs + 5 * SC_T * 256) + s2 * 16 + hf * 8; \
                    *(LAS f32x4*)dv = (f32x4){vc[0] + (vp[0] - vc[0]) * m0.x, vc[1] + (vp[1] - vc[1]) * m0.y, vc[2] + (vp[2] - vc[2]) * m0.z, vc[3] + (vp[3] - vc[3]) * m0.w}; \
                    *(LAS f32x4*)(dv + 4) = (f32x4){vc[4] + (vp[4] - vc[4]) * m1.x, vc[5] + (vp[5] - vc[5]) * m1.y, vc[6] + (vp[6] - vc[6]) * m1.z, vc[7] + (vp[7] - vc[7]) * m1.w}; } } while (0)
#define SCAN_FLUSH(c_) do { if ((c_) >= 2 && dov) { LAS unsigned char* bs = F.lds + ((c_) & 1) * SC_BUF; const LAS float* yy = (const LAS float*)(bs + 5 * SC_T * 256 + SC_T * 64) + s2 * 16 + hf * 8; \
                const f32x4 y0 = *(const LAS f32x4*)yy, y1 = *(const LAS f32x4*)(yy + 4); const float v[8] = {y0.x, y0.y, y0.z, y0.w, y1.x, y1.y, y1.z, y1.w}; \
                *(u32x4*)(Y + (row0 + (size_t)((c_) - 2) * SC_T + s2) * 512 + cv) = pack8(v); } } while (0)
            for (int c = 0; c <= NCH + 1; c += 2) {
                SCAN_FLUSH(c);
                scan_issue(R1, ZR, A, LW, row0, (c + 1 < NCH ? c + 1 : NCH - 1) * SC_T, st2, col, s2, cv, dov);
                if (c < NCH) SCAN_BUILD(R0, c);
                LDS_BAR();
                SCAN_FLUSH(c + 1);
                scan_issue(R0, ZR, A, LW, row0, (c + 2 < NCH ? c + 2 : NCH - 1) * SC_T, st2, col, s2, cv, dov);
                if (c + 1 < NCH) SCAN_BUILD(R1, c + 1);
                LDS_BAR();
            }
#undef SCAN_BUILD
#undef SCAN_FLUSH
        } else {
            const int rg = lane >> 4, jl = lane & 15;
            f32x2 Sa = {0.f, 0.f}, Sb = {0.f, 0.f};
            for (int c = 0; c <= NCH + 1; c += 2) {
#pragma unroll
                for (int half = 0; half < 2; ++half) {
                    const int cc = c + half;
                    if (cc >= 1 && cc <= NCH) {
                        LAS unsigned char* bc = F.lds + ((cc + 1) & 1) * SC_BUF;
                        const LAS float* base = (const LAS float*)bc + 4 * jl;
                        const LAS float* vb = (const LAS float*)(bc + 5 * SC_T * 256) + wave * 4 + rg;
                        LAS float* yb = (LAS float*)(bc + 5 * SC_T * 256 + SC_T * 64) + wave * 4 + rg;
                        f32x4 w[2][2], nk[2][2], bb[2][2], kv[2][2], rr[2][2]; float vv1[2][2];
#define SC_LOAD(slot, g_) do { _Pragma("unroll") for (int q = 0; q < 2; ++q) { const int st_ = (g_) * 2 + q; \
                            w[slot][q] = *(const LAS f32x4*)(base + st_ * 64); nk[slot][q] = *(const LAS f32x4*)(base + SC_T * 64 + st_ * 64); bb[slot][q] = *(const LAS f32x4*)(base + 2 * SC_T * 64 + st_ * 64); \
                            kv[slot][q] = *(const LAS f32x4*)(base + 3 * SC_T * 64 + st_ * 64); rr[slot][q] = *(const LAS f32x4*)(base + 4 * SC_T * 64 + st_ * 64); vv1[slot][q] = vb[st_ * 16]; } } while (0)
                        SC_LOAD(0, 0);
#pragma unroll
                        for (int g = 0; g < SC_T / 2; ++g) {
                            const int sl = g & 1;
                            if (g + 1 < SC_T / 2) { if (sl == 0) SC_LOAD(1, g + 1); else SC_LOAD(0, g + 1); }
                            float yo[2];
#pragma unroll
                            for (int q = 0; q < 2; ++q) {
                                const f32x4 w_ = w[sl][q], nk_ = nk[sl][q], bb_ = bb[sl][q], kv_ = kv[sl][q], rr_ = rr[sl][q]; const float v = vv1[sl][q];
                                const f32x2 t0 = Sa * (f32x2){nk_.x, nk_.y} + Sb * (f32x2){nk_.z, nk_.w};
                                const float sa = allsum16(t0.x + t0.y);
                                const f32x2 vv = {v, v}, ss = {sa, sa};
                                Sa = Sa * (f32x2){w_.x, w_.y} + (ss * (f32x2){bb_.x, bb_.y} + vv * (f32x2){kv_.x, kv_.y});
                                Sb = Sb * (f32x2){w_.z, w_.w} + (ss * (f32x2){bb_.z, bb_.w} + vv * (f32x2){kv_.z, kv_.w});
                                const f32x2 t1 = Sa * (f32x2){rr_.x, rr_.y} + Sb * (f32x2){rr_.z, rr_.w};
                                yo[q] = allsum16(t1.x + t1.y);
                            }
                            if (jl == 0) { yb[(g * 2) * 16] = yo[0]; yb[(g * 2 + 1) * 16] = yo[1]; }
                        }
#undef SC_LOAD
                    }
                    LDS_BAR();
                }
            }
        }
    }
}

__device__ __forceinline__ void p_attn_naive(const Frame& F) {
    const int lane_f = lane_id_fresh(), tid_f = F.wave * 64 + lane_f;
    const bf16* Q = (const bf16*)(F.dob + DO_Q); const bf16* KC = (const bf16*)(F.ws + WS_KC); const bf16* VC = (const bf16*)(F.ws + WS_VC); bf16* YM = (bf16*)(F.ws + WS_YM);
    LAS float* Ks = (LAS float*)F.lds; LAS float* Vs = (LAS float*)(F.lds + 32 * 96 * 4);
    const int tid = tid_f;
    for (int unit = F.vcu; unit < 64 * 16; unit += F.G) {
        const int bh = unit >> 4, qb = 15 - (unit & 15), b = bh >> 3, h = bh & 7; const size_t row0 = (size_t)b * SEQ; const int t = qb * 512 + tid;
        unsigned qp[48];
        { const u32x4* qg = (const u32x4*)(Q + (row0 + t) * 768 + h * 96);
#pragma unroll
          for (int i = 0; i < 12; ++i) { const u32x4 w = qg[i]; qp[4 * i] = w.x; qp[4 * i + 1] = w.y; qp[4 * i + 2] = w.z; qp[4 * i + 3] = w.w; } }
        float o[64];
#pragma unroll
        for (int i = 0; i < 64; ++i) o[i] = 0.f;
        float mx = -INFINITY, l = 0.f;
        const int nkt = (qb + 1) * 16;
        for (int kt = 0; kt < nkt; ++kt) {
            __syncthreads();
            if (tid < 384) { const int r = tid / 12, c8 = (tid % 12) * 8; float v[8]; unpack8(*(const u32x4*)(KC + (row0 + kt * 32 + r) * 768 + h * 96 + c8), v);
#pragma unroll
                for (int i = 0; i < 8; ++i) Ks[r * 96 + c8 + i] = v[i]; }
            if (tid < 256) { const int r = tid >> 3, c8 = (tid & 7) * 8; float v[8]; unpack8(*(const u32x4*)(VC + (row0 + kt * 32 + r) * 512 + h * 64 + c8), v);
#pragma unroll
                for (int i = 0; i < 8; ++i) Vs[r * 64 + c8 + i] = v[i]; }
            __syncthreads();
            for (int kk = 0; kk < 32; ++kk) {
                const int kv = kt * 32 + kk;
                float s = 0.f; const LAS f32x4* kr = (const LAS f32x4*)(Ks + kk * 96);
#pragma unroll
                for (int i = 0; i < 24; ++i) { const f32x4 k4 = kr[i]; s += lo2f(qp[2 * i]) * k4.x + hi2f(qp[2 * i]) * k4.y + lo2f(qp[2 * i + 1]) * k4.z + hi2f(qp[2 * i + 1]) * k4.w; }
                if (kv <= t) {
                    const float mn = fmaxf(mx, s), f = exp2f(mx - mn), p = exp2f(s - mn); mx = mn; l = l * f + p;
                    const LAS f32x4* vr = (const LAS f32x4*)(Vs + kk * 64);
#pragma unroll
                    for (int i = 0; i < 16; ++i) { const f32x4 v4 = vr[i]; o[4 * i] = o[4 * i] * f + p * v4.x; o[4 * i + 1] = o[4 * i + 1] * f + p * v4.y; o[4 * i + 2] = o[4 * i + 2] * f + p * v4.z; o[4 * i + 3] = o[4 * i + 3] * f + p * v4.w; }
                }
            }
        }
        const float il = 1.f / l; u32x4* og = (u32x4*)(YM + (row0 + t) * 512 + h * 64);
#pragma unroll
        for (int i = 0; i < 8; ++i) { u32x4 w; w.x = pk2(o[8 * i] * il, o[8 * i + 1] * il); w.y = pk2(o[8 * i + 2] * il, o[8 * i + 3] * il); w.z = pk2(o[8 * i + 4] * il, o[8 * i + 5] * il); w.w = pk2(o[8 * i + 6] * il, o[8 * i + 7] * il); og[i] = w; }
    }
    __syncthreads();
}

typedef float f32x16 __attribute__((ext_vector_type(16)));
typedef short s16x4 __attribute__((ext_vector_type(4)));
__device__ __forceinline__ int crow(int r, int hi) { return (r & 3) + 8 * (r >> 2) + 4 * hi; }
__device__ __forceinline__ float xhalf_max(float x) { auto rr = __builtin_amdgcn_permlane32_swap(__float_as_uint(x), __float_as_uint(x), false, false); return fmaxf(__uint_as_float(rr[0]), __uint_as_float(rr[1])); }
__device__ __forceinline__ float xhalf_sum(float x) { auto rr = __builtin_amdgcn_permlane32_swap(__float_as_uint(x), __float_as_uint(x), false, false); return __uint_as_float(rr[0]) + __uint_as_float(rr[1]); }
__device__ __forceinline__ bf16x8 packp(const f32x16& p, int s2) {
    u32x4 w; w.x = pk2(p[8 * s2 + 0], p[8 * s2 + 1]); w.y = pk2(p[8 * s2 + 2], p[8 * s2 + 3]); w.z = pk2(p[8 * s2 + 4], p[8 * s2 + 5]); w.w = pk2(p[8 * s2 + 6], p[8 * s2 + 7]);
    return __builtin_bit_cast(bf16x8, w);
}
__device__ __forceinline__ void p_attn_mfma(const Frame& F) {
    const int lane_f = lane_id_fresh(), tid_f = F.wave * 64 + lane_f;
    const bf16* Q = (const bf16*)(F.dob + DO_Q); const bf16* KC = (const bf16*)(F.ws + WS_KC); const bf16* VC = (const bf16*)(F.ws + WS_VC); bf16* YM = (bf16*)(F.ws + WS_YM);
    constexpr int KST = 208, VST = 192, KBYTES = 64 * KST, BUF = KBYTES + 64 * VST;
    const int tid = tid_f, lane = lane_f, wave = F.wave, r = lane & 31, hi = lane >> 5;
    const int kr0 = tid / 12, kp0 = tid % 12, kr1 = (tid + 512) / 12, kp1 = (tid + 512) % 12, vr = tid >> 3, vp = tid & 7;
    const int g4 = lane >> 4, li = lane & 15;
    const int vtr = (4 * (g4 >> 1) + (li >> 2)) * VST + (16 * (g4 & 1) + 4 * (li & 3)) * 2;
    const int kfr = r * KST + hi * 16;
    LAS unsigned char* lds = F.lds;
    for (int item = F.vcu; item < 1024; item += F.G) {
        const int bh = item >> 4, sidx = item & 15, b = bh >> 3, h = bh & 7; const size_t row0 = (size_t)b * SEQ;
        const bf16* Kg = KC + row0 * 768 + h * 96; const bf16* Vg = VC + row0 * 512 + h * 64;
        for (int uu = 0; uu < 2; ++uu) {
            const int qb = uu == 0 ? 31 - sidx : sidx, q0 = qb * 256, NT = (q0 + 256) / 64;
            const int qw = q0 + wave * 32;
            bf16x8 qf[6];
            { const bf16* qp = Q + (row0 + qw + r) * 768 + h * 96 + hi * 8;
#pragma unroll
              for (int s = 0; s < 6; ++s) qf[s] = *(const bf16x8*)(qp + 16 * s);
              asm volatile("" : "+v"(qf[0]), "+v"(qf[1]), "+v"(qf[2]), "+v"(qf[3]), "+v"(qf[4]), "+v"(qf[5])); }
            f32x16 o0 = {}, o1 = {}; float m = -INFINITY, l = 0.f;
            __syncthreads();
            { const u32x4 a0 = *(const u32x4*)(Kg + (size_t)kr0 * 768 + kp0 * 8); u32x4 a1 = {}; if (tid < 256) a1 = *(const u32x4*)(Kg + (size_t)kr1 * 768 + kp1 * 8);
              const u32x4 a2 = *(const u32x4*)(Vg + (size_t)vr * 512 + vp * 8);
              *(LAS u32x4*)(lds + kr0 * KST + kp0 * 16) = a0; if (tid < 256) *(LAS u32x4*)(lds + kr1 * KST + kp1 * 16) = a1; *(LAS u32x4*)(lds + KBYTES + vr * VST + vp * 16) = a2; }
            __syncthreads();
            for (int t = 0; t < NT; ++t) {
                LAS unsigned char* kb = lds + (t & 1) * BUF; LAS unsigned char* vb = kb + KBYTES;
                u32x4 a0 = {}, a1 = {}, a2 = {};
                const bool more = (t + 1 < NT);
                if (more) { const bf16* kg = Kg + (size_t)(t + 1) * 64 * 768; const bf16* vg = Vg + (size_t)(t + 1) * 64 * 512;
                    a0 = *(const u32x4*)(kg + (size_t)kr0 * 768 + kp0 * 8); if (tid < 256) a1 = *(const u32x4*)(kg + (size_t)kr1 * 768 + kp1 * 8); a2 = *(const u32x4*)(vg + (size_t)vr * 512 + vp * 8); }
                if (64 * t <= qw + 31) {
                    f32x16 p0 = {}, p1 = {};
#pragma unroll
                    for (int s = 0; s < 6; ++s) { const bf16x8 k0 = *(const LAS bf16x8*)(kb + kfr + s * 32), k1 = *(const LAS bf16x8*)(kb + kfr + 32 * KST + s * 32);
                        p0 = __builtin_amdgcn_mfma_f32_32x32x16_bf16(k0, qf[s], p0, 0, 0, 0); p1 = __builtin_amdgcn_mfma_f32_32x32x16_bf16(k1, qf[s], p1, 0, 0, 0); }
                    if (64 * t + 63 > qw) {
                        const int qrel = qw + r - 64 * t;
#pragma unroll
                        for (int rg = 0; rg < 16; ++rg) { const int kv = crow(rg, hi); if (kv > qrel) p0[rg] = -INFINITY; if (kv + 32 > qrel) p1[rg] = -INFINITY; }
                    }
                    float mx = fmaxf(p0[0], p1[0]);
#pragma unroll
                    for (int rg = 1; rg < 16; ++rg) mx = fmaxf(mx, fmaxf(p0[rg], p1[rg]));
                    mx = xhalf_max(mx);
                    const float mn = fmaxf(m, mx), f = __builtin_amdgcn_exp2f(m - mn); m = mn;
                    float rs = 0.f;
#pragma unroll
                    for (int rg = 0; rg < 16; ++rg) { p0[rg] = __builtin_amdgcn_exp2f(p0[rg] - mn); p1[rg] = __builtin_amdgcn_exp2f(p1[rg] - mn); rs += p0[rg] + p1[rg]; }
                    l = l * f + rs;
#pragma unroll
                    for (int rg = 0; rg < 16; ++rg) { o0[rg] *= f; o1[rg] *= f; }
#pragma unroll
                    for (int hh = 0; hh < 2; ++hh)
#pragma unroll
                        for (int s2 = 0; s2 < 2; ++s2) { const bf16x8 pf = packp(hh == 0 ? p0 : p1, s2);
#pragma unroll
                            for (int db = 0; db < 2; ++db) { LAS unsigned char* vp_ = vb + vtr + (32 * hh + 16 * s2) * VST + db * 64;
                                const s16x4 lo = __builtin_bit_cast(s16x4, __builtin_amdgcn_ds_read_tr16_b64_v4i16((LAS s16x4*)vp_));
                                const s16x4 hi4 = __builtin_bit_cast(s16x4, __builtin_amdgcn_ds_read_tr16_b64_v4i16((LAS s16x4*)(vp_ + 8 * VST)));
                                const bf16x8 vf = (bf16x8){lo[0], lo[1], lo[2], lo[3], hi4[0], hi4[1], hi4[2], hi4[3]};
                                if (db == 0) o0 = __builtin_amdgcn_mfma_f32_32x32x16_bf16(vf, pf, o0, 0, 0, 0); else o1 = __builtin_amdgcn_mfma_f32_32x32x16_bf16(vf, pf, o1, 0, 0, 0); } }
                }
                if (more) { LAS unsigned char* nb = lds + ((t + 1) & 1) * BUF;
                    *(LAS u32x4*)(nb + kr0 * KST + kp0 * 16) = a0; if (tid < 256) *(LAS u32x4*)(nb + kr1 * KST + kp1 * 16) = a1; *(LAS u32x4*)(nb + KBYTES + vr * VST + vp * 16) = a2; }
                __syncthreads();
            }
            const float il = 1.0f / xhalf_sum(l);
            bf16* op = YM + (row0 + qw + r) * 512 + h * 64 + 4 * hi;
#pragma unroll
            for (int gq = 0; gq < 4; ++gq) { u32x2 w0, w1;
                w0.x = pk2(o0[4 * gq] * il, o0[4 * gq + 1] * il); w0.y = pk2(o0[4 * gq + 2] * il, o0[4 * gq + 3] * il);
                w1.x = pk2(o1[4 * gq] * il, o1[4 * gq + 1] * il); w1.y = pk2(o1[4 * gq + 2] * il, o1[4 * gq + 3] * il);
                *(u32x2*)(op + 8 * gq) = w0; *(u32x2*)(op + 32 + 8 * gq) = w1; }
        }
    }
    __syncthreads();
}

__device__ __forceinline__ void p_post_scan(const Frame& F, ArgsP a) {
    const int lane_f = lane_id_fresh();
    bf16* Y = (bf16*)(F.ws + WS_Y); const bf16* ZR = (const bf16*)(F.ws + WS_ZR); const bf16* A = (const bf16*)(F.ws + WS_A); const bf16* G = (const bf16*)(F.dob + DO_G);
    const float* lnw = a->in[I_LNW]; const float* lnb = a->in[I_LNB]; const float* rk = a->in[I_RK]; const float* mu = a->in[I_MU]; const float* k_a = a->in[I_KA];
    const int lane = lane_f;
    for (int m = F.gw; m < NTOK; m += F.NGW) {
        const bool first = (m % SEQ) == 0; const size_t mp = first ? m : m - 1;
        float y[8], r[8], k[8], v[8], g[8], o[8], t[8], av[8];
        unpack8(*((const u32x4*)(Y + (size_t)m * 512) + lane), y); unpack8(*((const u32x4*)(G + (size_t)m * 512) + lane), g); unpack8(*((const u32x4*)(A + (size_t)m * 512) + lane), av);
        unpack8(*((const u32x4*)(ZR + (size_t)m * 1792) + lane), r); unpack8(*((const u32x4*)(ZR + mp * 1792) + lane), t);
#pragma unroll
        for (int i = 0; i < 8; ++i) r[i] += ((first ? 0.f : t[i]) - r[i]) * mu[8 * lane + i];
        unpack8(*((const u32x4*)(ZR + (size_t)m * 1792 + 512) + lane), k); unpack8(*((const u32x4*)(ZR + mp * 1792 + 512) + lane), t);
#pragma unroll
        for (int i = 0; i < 8; ++i) { const float zk = k[i] + ((first ? 0.f : t[i]) - k[i]) * mu[512 + 8 * lane + i]; k[i] = zk * (1.f + (av[i] - 1.f) * k_a[8 * lane + i]); }
        unpack8(*((const u32x4*)(ZR + (size_t)m * 1792 + 1024) + lane), v); unpack8(*((const u32x4*)(ZR + mp * 1792 + 1024) + lane), t);
#pragma unroll
        for (int i = 0; i < 8; ++i) v[i] += ((first ? 0.f : t[i]) - v[i]) * mu[1024 + 8 * lane + i];
        float s = 0.f, d = 0.f;
#pragma unroll
        for (int i = 0; i < 8; ++i) { s += y[i]; d += r[i] * k[i] * rk[8 * lane + i]; }
        const float mean = sum8(s) * (1.f / 64.f); d = sum8(d); float q = 0.f;
#pragma unroll
        for (int i = 0; i < 8; ++i) { y[i] -= mean; q += y[i] * y[i]; }
        const float rstd = 1.0f / sqrtf(sum8(q) * (1.f / 64.f) + LN_X_EPS);
#pragma unroll
        for (int i = 0; i < 8; ++i) o[i] = (y[i] * rstd * lnw[8 * lane + i] + lnb[8 * lane + i] + d * v[i]) * g[i];
        *((u32x4*)(Y + (size_t)m * 512) + lane) = pack8(o);
    }
}

__device__ __forceinline__ void p_ffn_route(const Frame& F, ArgsP a) {
    const int lane_f = lane_id_fresh(), tid_f = F.wave * 64 + lane_f;
    const float* X1 = (const float*)F.dob; bf16* H2 = (bf16*)(F.ws + WS_H2); const float* mod = (const float*)(F.ws + WS_MOD); const float* g = a->in[I_GFFN];
    unsigned* cnt = (unsigned*)(F.ws + WS_CTL) + CW_CNT; int* route = (int*)(F.ws + WS_ROUTE);
    LAS float* wr = (LAS float*)F.lds;
    __syncthreads();
    for (int i = tid_f; i < 1024 * 4; i += NTHR) { const int k = i >> 2, o = i & 3; wr[o * 1024 + k] = a->in[I_WRG][i]; }
    for (int i = tid_f; i < 1024 * 32; i += NTHR) { const int k = i >> 5, o = i & 31; wr[(4 + o) * 1024 + k] = a->in[I_WRE][i]; }
    __syncthreads();
    const float* brg = a->in[I_BRG]; const float* bre = a->in[I_BRE];
    const int lane = lane_f;
    for (int m = F.gw; m < NTOK; m += F.NGW) {
        const int b = m / SEQ; const f32x4* xr = (const f32x4*)(X1 + (size_t)m * 1024) + lane;
        f32x4 v[4]; float s = 0.f;
#pragma unroll
        for (int j = 0; j < 4; ++j) { v[j] = xr[64 * j]; s += (v[j].x * v[j].x + v[j].y * v[j].y) + (v[j].z * v[j].z + v[j].w * v[j].w); }
        const float rstd = 1.0f / sqrtf(wave_sum(s) * (1.f / 1024.f) + EPS);
        u32x2* o = (u32x2*)(H2 + (size_t)m * 1024) + lane;
#pragma unroll
        for (int j = 0; j < 4; ++j) { const int col = 4 * lane + 256 * j;
            const f32x4 gg = *(const f32x4*)(g + col), sc = *(const f32x4*)(mod + b * 6144 + 4096 + col), sh = *(const f32x4*)(mod + b * 6144 + 3072 + col);
            v[j] = v[j] * rstd * gg * (sc + 1.0f) + sh; u32x2 w; w.x = pk2(v[j].x, v[j].y); w.y = pk2(v[j].z, v[j].w); o[64 * j] = w; }
        float lgq[4];
#pragma unroll
        for (int oo = 0; oo < 4; ++oo) { float p = 0.f;
#pragma unroll
            for (int j = 0; j < 4; ++j) { const f32x4 w4 = *(const LAS f32x4*)(wr + oo * 1024 + 4 * lane + 256 * j); p += (v[j].x * w4.x + v[j].y * w4.y) + (v[j].z * w4.z + v[j].w * w4.w); }
            lgq[oo] = wave_sum(p) + brg[oo]; }
        int gi = 0; float gm = lgq[0];
#pragma unroll
        for (int i = 1; i < 4; ++i) { if (lgq[i] > gm) { gm = lgq[i]; gi = i; } }
        float gs = 0.f;
#pragma unroll
        for (int i = 0; i < 4; ++i) gs += __expf(lgq[i] - gm);
        const float pg = 1.f / gs;
        gi = __builtin_amdgcn_readfirstlane(gi);
        float el[8];
        { const LAS float* wg = wr + (4 + gi * 8) * 1024 + 4 * lane;
#pragma unroll
          for (int i = 0; i < 8; ++i) { float p = 0.f;
#pragma unroll
              for (int j = 0; j < 4; ++j) { const f32x4 w4 = *(const LAS f32x4*)(wg + i * 1024 + 256 * j); p += (v[j].x * w4.x + v[j].y * w4.y) + (v[j].z * w4.z + v[j].w * w4.w); }
              el[i] = wave_sum(p) + bre[gi * 8 + i]; } }
        int i0 = 0; float m0 = el[0];
#pragma unroll
        for (int i = 1; i < 8; ++i) if (el[i] > m0) { m0 = el[i]; i0 = i; }
        int i1 = -1; float m1 = -INFINITY;
#pragma unroll
        for (int i = 0; i < 8; ++i) if (i != i0 && el[i] > m1) { m1 = el[i]; i1 = i; }
        const float e1 = __expf(m1 - m0), w0 = pg / (1.f + e1), w1 = pg * e1 / (1.f + e1);
        if (lane == 0) { const int x0 = gi * 8 + i0, x1 = gi * 8 + i1;
            const unsigned p0 = __hip_atomic_fetch_add(cnt + x0, 1u, __ATOMIC_RELAXED, __HIP_MEMORY_SCOPE_AGENT), p1 = __hip_atomic_fetch_add(cnt + x1, 1u, __ATOMIC_RELAXED, __HIP_MEMORY_SCOPE_AGENT);
            int* rt = route + (size_t)m * 8; rt[0] = x0; rt[1] = x1; rt[2] = (int)p0; rt[3] = (int)p1; rt[4] = __builtin_bit_cast(int, w0); rt[5] = __builtin_bit_cast(int, w1); }
    }
    __syncthreads();
}
__device__ __forceinline__ int moe_tables(const Frame& F, LAS int* offs, LAS int* texp) {
    const int lane_f = lane_id_fresh(), tid_f = F.wave * 64 + lane_f;
    const unsigned* cnt = (const unsigned*)(F.ws + WS_CTL) + CW_CNT;
    __syncthreads();
    if (tid_f == 0) { int o = 0; for (int e = 0; e < 32; ++e) { offs[e] = o; const int c = (int)__hip_atomic_load(cnt + e, __ATOMIC_RELAXED, __HIP_MEMORY_SCOPE_AGENT); const int nt = (c + 255) >> 8; for (int t = 0; t < nt; ++t) texp[(o >> 8) + t] = e; o += nt << 8; } offs[32] = o; }
    __syncthreads();
    return offs[32] >> 8;
}
__device__ __forceinline__ void p_gather(const Frame& F) {
    const int lane_f = lane_id_fresh(), tid_f = F.wave * 64 + lane_f;
    LAS int* offs = (LAS int*)(F.lds + 1024); LAS int* texp = (LAS int*)(F.lds + 2048);
    moe_tables(F, offs, texp);
    const bf16* H2 = (const bf16*)(F.ws + WS_H2); bf16* XG = (bf16*)(F.ws + WS_XG); const int* route = (const int*)(F.ws + WS_ROUTE);
    const unsigned* cnt = (const unsigned*)(F.ws + WS_CTL) + CW_CNT; const int lane = lane_f;
    for (int m = F.gw; m < NTOK; m += F.NGW) {
        const int* rt = route + (size_t)m * 8; const int d0 = offs[rt[0]] + rt[2], d1 = offs[rt[1]] + rt[3];
        const u32x4* src = (const u32x4*)(H2 + (size_t)m * 1024) + lane; const u32x4 a0 = src[0], a1 = src[64];
        u32x4* p0 = (u32x4*)(XG + (size_t)d0 * 1024) + lane; u32x4* p1 = (u32x4*)(XG + (size_t)d1 * 1024) + lane;
        p0[0] = a0; p0[64] = a1; p1[0] = a0; p1[64] = a1;
    }
    for (int i = F.gw; i < 32 * 256; i += F.NGW) { const int e = i >> 8, r = i & 255; const int c = (int)cnt[e]; const int pad = ((c + 255) & ~255) - c;
        if (r < pad) { u32x4* p = (u32x4*)(XG + (size_t)(offs[e] + c + r) * 1024) + lane; p[0] = (u32x4){0u, 0u, 0u, 0u}; p[64] = (u32x4){0u, 0u, 0u, 0u}; } }
    __syncthreads();
}
__device__ __forceinline__ void p_combine(const Frame& F) {
    const int lane_f = lane_id_fresh(), tid_f = F.wave * 64 + lane_f;
    LAS int* offs = (LAS int*)(F.lds + 1024); LAS int* texp = (LAS int*)(F.lds + 2048);
    moe_tables(F, offs, texp);
    float* out = (float*)F.dob; const bf16* YS = (const bf16*)(F.ws + WS_YS); const int* route = (const int*)(F.ws + WS_ROUTE); const float* mod = (const float*)(F.ws + WS_MOD);
    const int lane = lane_f;
    for (int m = F.gw; m < NTOK; m += F.NGW) {
        const int b = m / SEQ; const int* rt = route + (size_t)m * 8; const int d0 = offs[rt[0]] + rt[2], d1 = offs[rt[1]] + rt[3];
        const float w0 = __builtin_bit_cast(float, rt[4]), w1 = __builtin_bit_cast(float, rt[5]);
#pragma unroll
        for (int j = 0; j < 2; ++j) { const int col = 8 * lane + 512 * j; float y0[8], y1[8];
            unpack8(*(const u32x4*)(YS + (size_t)d0 * 1024 + col), y0); unpack8(*(const u32x4*)(YS + (size_t)d1 * 1024 + col), y1);
            float* o = out + (size_t)m * 1024 + col; const float* gt = mod + b * 6144 + 5120 + col;
            f32x4 x0 = *(const f32x4*)o, x1 = *(const f32x4*)(o + 4); const f32x4 g0 = *(const f32x4*)gt, g1 = *(const f32x4*)(gt + 4);
            x0.x += g0.x * (w0 * y0[0] + w1 * y1[0]); x0.y += g0.y * (w0 * y0[1] + w1 * y1[1]); x0.z += g0.z * (w0 * y0[2] + w1 * y1[2]); x0.w += g0.w * (w0 * y0[3] + w1 * y1[3]);
            x1.x += g1.x * (w0 * y0[4] + w1 * y1[4]); x1.y += g1.y * (w0 * y0[5] + w1 * y1[5]); x1.z += g1.z * (w0 * y0[6] + w1 * y1[6]); x1.w += g1.w * (w0 * y0[7] + w1 * y1[7]);
            *(f32x4*)o = x0; *(f32x4*)(o + 4) = x1; }
    }
}

constexpr int NPHASE = 16;
template <int LO, int HI>
__global__ void __launch_bounds__(NTHR, 2) fwd(Args args) {
    extern __shared__ __attribute__((aligned(16))) unsigned char lds_raw[];
    Frame F;
    F.lds = (LAS unsigned char*)lds_raw;
    F.wave = __builtin_amdgcn_readfirstlane((int)threadIdx.x >> 6);
    F.G = gridDim.x; { const int bx = blockIdx.x; F.vcu = (F.G % 8 == 0) ? (bx % 8) * (F.G / 8) + bx / 8 : bx; }
    F.gw = F.vcu * NWAVES + F.wave; F.NGW = F.G * NWAVES;
    F.ws = args.ws; F.dob = (unsigned char*)args.out;
    ArgsP AP = (ArgsP)__builtin_amdgcn_kernarg_segment_ptr();
    volatile LAS unsigned* MISC = (volatile LAS unsigned*)(F.lds + LDS_MISC);
    if (threadIdx.x < 64) MISC[threadIdx.x] = 0u;
    __syncthreads();
    XcdBarrier bar; bar.bar = (unsigned*)(F.ws + WS_CTL) + CW_BAR; bar.x = 0; bar.st = MISC + 8;
#if N_LAUNCH_MODE == 1
    bar = xcd_barrier_post((unsigned*)(F.ws + WS_CTL) + CW_BAR, MISC + 8);
#define GRID_BAR() xcd_barrier(bar)
#else
#define GRID_BAR() do { } while (0)
#endif
#ifndef PROBE_REPEAT
#define PROBE_REPEAT -1
#endif
#define IN(k) (LO <= (k) && (k) < HI)
#define SEAM(k) do { if constexpr (IN(k) && IN((k) + 1)) GRID_BAR(); } while (0)
    const float* mod = (const float*)(F.ws + WS_MOD);

#define PH(k, ...) do { if constexpr (IN(k)) { asm volatile("" : "+s"(AP)); { __VA_ARGS__ } if constexpr (PROBE_REPEAT == (k)) { GRID_BAR(); asm volatile("" : "+s"(AP)); { __VA_ARGS__ } } } } while (0)
    PH(0, p0_prologue(F, AP);); SEAM(0);
    PH(1, p_normmod(F, AP->in[I_X], AP->in[I_GMIX], mod, 0, 1024, (bf16*)(F.ws + WS_H));); SEAM(1);
    PH(2, Gemm g{(const bf16*)(F.ws + WS_H), (const bf16*)(F.ws + WS_WIN), NTOK, N_IN_PAD, 1024}; StaticOrder S; S.init(NTOK, N_IN_PAD, F.G, (int)blockIdx.x);
        EpiZ E{(bf16*)(F.ws + WS_ZR), (bf16*)(F.ws + WS_SG), (bf16*)(F.ws + WS_ZM)}; gemm_phase_any(F.lds, g, S, E, F.wave);); SEAM(2);
    PH(3, p_prep_a(F, AP);); SEAM(3);
    PH(4,
        { Gemm g{(const bf16*)(F.ws + WS_TWA), (const bf16*)(F.ws + WS_WBLK), NTOK, 1024, 128}; StaticOrder S; S.init(NTOK, 1024, F.G, (int)blockIdx.x);
          EpiLora E{(bf16*)(F.ws + WS_LW), (bf16*)(F.ws + WS_A), AP->in[I_W0], AP->in[I_A0]}; gemm_phase_any(F.lds, g, S, E, F.wave); }
        { Gemm g{(const bf16*)(F.ws + WS_SGL), (const bf16*)(F.ws + WS_WG), NTOK, 512, 128}; StaticOrder S; S.init(NTOK, 512, F.G, (int)blockIdx.x);
          EpiPlain E{(bf16*)(F.dob + DO_G), nullptr, 1 << 30, 512, 0}; gemm_phase_any(F.lds, g, S, E, F.wave); }
        { Gemm g{(const bf16*)(F.ws + WS_QA), (const bf16*)(F.ws + WS_WUQ), NTOK, 768, 256}; StaticOrder S; S.init(NTOK, 768, F.G, (int)blockIdx.x);
          EpiPlain E{(bf16*)(F.dob + DO_Q), nullptr, 1 << 30, 768, 0}; gemm_phase_any(F.lds, g, S, E, F.wave); }
        { Gemm g{(const bf16*)(F.ws + WS_KVA), (const bf16*)(F.ws + WS_WUKV), NTOK, 1024, 128}; StaticOrder S; S.init(NTOK, 1024, F.G, (int)blockIdx.x);
          EpiPlain E{(bf16*)(F.dob + DO_KN), (bf16*)(F.ws + WS_VC), 512, 512, 512}; gemm_phase_any(F.lds, g, S, E, F.wave); }
    ); SEAM(4);
    PH(5, p_prep_c(F, AP);); SEAM(5);
    PH(6, p_scan(F, AP);); SEAM(6);
#if ENG_ATTN == 1
    PH(7, p_attn_mfma(F);); SEAM(7);
#else
    PH(7, p_attn_naive(F);); SEAM(7);
#endif
    PH(8, p_post_scan(F, AP);); SEAM(8);
    PH(9,
        { Gemm g{(const bf16*)(F.ws + WS_Y), (const bf16*)(F.ws + WS_WB), NTOK, 1024, 512}; StaticOrder S; S.init(NTOK, 1024, F.G, (int)blockIdx.x);
          EpiBranch<false> E{(bf16*)(F.ws + WS_MG), (const bf16*)(F.ws + WS_SG), 0}; gemm_phase_any(F.lds, g, S, E, F.wave); }
        { Gemm g{(const bf16*)(F.ws + WS_YM), (const bf16*)(F.ws + WS_WB) + (size_t)1024 * 512, NTOK, 1024, 512}; StaticOrder S; S.init(NTOK, 1024, F.G, (int)blockIdx.x);
          EpiBranch<true> E{(bf16*)(F.ws + WS_MG), (const bf16*)(F.ws + WS_SG), 1024}; gemm_phase_any(F.lds, g, S, E, F.wave); }
    ); SEAM(9);
    PH(10, Gemm g{(const bf16*)(F.ws + WS_MG), (const bf16*)(F.ws + WS_WO), NTOK, 1024, 1024}; StaticOrder S; S.init(NTOK, 1024, F.G, (int)blockIdx.x);
        EpiOut E{(float*)F.dob, AP->in[I_X], mod}; gemm_phase_any(F.lds, g, S, E, F.wave);); SEAM(10);
    PH(11, p_ffn_route(F, AP);); SEAM(11);
    PH(12, p_gather(F);); SEAM(12);
    PH(13, LAS int* offs = (LAS int*)(F.lds + LDS_MISC + 1024); LAS int* texp = (LAS int*)(F.lds + LDS_MISC + 1024 + 256); const int nt = moe_tables(F, offs, texp);
        Gemm g{(const bf16*)(F.ws + WS_XG), (const bf16*)(F.ws + WS_WGU), MPAD, 512, 1024}; TableOrder S{texp, nt, 2, F.G, (int)blockIdx.x};
        EpiGateUp E{(bf16*)(F.ws + WS_HID)}; gemm_phase_any(F.lds, g, S, E, F.wave);); SEAM(13);
    PH(14, LAS int* offs = (LAS int*)(F.lds + LDS_MISC + 1024); LAS int* texp = (LAS int*)(F.lds + LDS_MISC + 1024 + 256); const int nt = moe_tables(F, offs, texp);
        Gemm g{(const bf16*)(F.ws + WS_HID), (const bf16*)(F.ws + WS_WDN), MPAD, 1024, 256}; TableOrder S{texp, nt, 4, F.G, (int)blockIdx.x};
        EpiDown E{(bf16*)(F.ws + WS_YS)}; gemm_phase_any(F.lds, g, S, E, F.wave);); SEAM(14);
    PH(15, p_combine(F););
}

#if N_LAUNCH_MODE == 1
static bool set_attrs() { return hipFuncSetAttribute((const void*)fwd<0, NPHASE>, hipFuncAttributeMaxDynamicSharedMemorySize, LDS_BYTES) == hipSuccess; }
#else
template <int P> static bool set_attr_all() { if constexpr (P < NPHASE) { return hipFuncSetAttribute((const void*)fwd<P, P + 1>, hipFuncAttributeMaxDynamicSharedMemorySize, LDS_BYTES) == hipSuccess && set_attr_all<P + 1>(); } else return true; }
static bool set_attrs() { return set_attr_all<0>(); }
template <int P> static void launch_all(int grid, hipStream_t stream, const Args& a) { if constexpr (P < NPHASE) { hipLaunchKernelGGL((fwd<P, P + 1>), dim3(grid), dim3(NTHR), LDS_BYTES, stream, a); launch_all<P + 1>(grid, stream, a); } }
#endif
extern "C" void kernel_launch(void* const* d_in, const int* in_sizes, int n_in, void* d_out, int out_size, void* d_ws, size_t ws_size, hipStream_t stream) {
    static int grid = 0;
    if (grid == 0) {
        if (n_in != 34 || out_size != NTOK * DM || ws_size < WS_END) { fprintf(stderr, "kernel_launch: unexpected shapes (n_in %d out %d ws %zu)\n", n_in, out_size, ws_size); grid = -1; return; }
        int dev = 0, cus = 0;
        if (hipGetDevice(&dev) != hipSuccess || hipDeviceGetAttribute(&cus, hipDeviceAttributeMultiprocessorCount, dev) != hipSuccess) { grid = -1; return; }
        if (!set_attrs()) { fprintf(stderr, "kernel_launch: hipFuncSetAttribute failed\n"); grid = -1; return; }
        grid = cus;
    }
    if (grid < 0) return;
    (void)hipMemsetAsync((char*)d_ws + WS_CTL, 0, CTL_ZERO_BYTES, stream);
    Args a{};
    for (int i = 0; i < 34; ++i) a.in[i] = (const float*)d_in[i];
    a.out = (float*)d_out; a.ws = (unsigned char*)d_ws;
    a.ph_lo = 0; a.ph_hi = NPHASE;
#if N_LAUNCH_MODE == 1
    hipLaunchKernelGGL((fwd<0, NPHASE>), dim3(grid), dim3(NTHR), LDS_BYTES, stream, a);
#else
    launch_all<0>(grid, stream, a);
#endif
}
```

```cpp
#include <hip/hip_runtime.h>
#include <cstdio>
#include <cstdint>

#ifndef N_LAUNCH_MODE
#define N_LAUNCH_MODE 1
#endif
#ifndef ENG_GEMM
#define ENG_GEMM 1
#endif
#ifndef ENG_ATTN
#define ENG_ATTN 1
#endif

#define GAS __attribute__((address_space(1)))
#define LAS __attribute__((address_space(3)))
typedef unsigned short bf16;
typedef float f32x4 __attribute__((ext_vector_type(4)));
typedef float f32x2 __attribute__((ext_vector_type(2)));
typedef unsigned u32x4 __attribute__((ext_vector_type(4)));
typedef unsigned u32x2 __attribute__((ext_vector_type(2)));
typedef short bf16x8 __attribute__((ext_vector_type(8)));

constexpr int BATCH = 8, SEQ = 8192, DM = 1024, NTOK = BATCH * SEQ;
constexpr int D_RWKV = 512, RWKV_COLS = 1792, MLA_COLS = 416, D_IN = 4256, N_IN_PAD = 4352;
constexpr int NH = 8, QKD = 96, NOPE = 64, ROPE = 32, VD = 64;
constexpr int NEXP = 32, DEXP = 256;
constexpr int MPAD = 139264;
constexpr float EPS = 1e-6f, LN_X_EPS = 64e-5f;
constexpr float QSCALE = 0.10206207261596577f * 1.4426950408889634f;

constexpr size_t MiB = 1u << 20;
constexpr size_t WS_CTL = 0, CTL_ZERO_BYTES = 1 * MiB;
constexpr size_t WS_MOD = 1 * MiB;
constexpr size_t WS_ROUTE = 2 * MiB;
constexpr size_t WS_CS = 4 * MiB;
constexpr size_t WS_ENT = 12 * MiB;
constexpr size_t WS_WIN = 16 * MiB;
constexpr size_t WS_WBLK = 25 * MiB;
constexpr size_t WS_WG = WS_WBLK + 256 * 1024;
constexpr size_t WS_WUQ = WS_WG + 128 * 1024;
constexpr size_t WS_WUKV = WS_WUQ + 384 * 1024;
constexpr size_t WS_WB = 26 * MiB;
constexpr size_t WS_WO = 28 * MiB;
constexpr size_t WS_WGU = 30 * MiB;
constexpr size_t WS_WDN = 62 * MiB;
constexpr size_t WS_SG = 80 * MiB;
constexpr size_t WS_H2 = 80 * MiB;
constexpr size_t WS_ZR = 336 * MiB;
constexpr size_t WS_VC = 752 * MiB;
constexpr size_t WS_KC = 816 * MiB;
constexpr size_t WS_Y = 912 * MiB;
constexpr size_t WS_XG = 336 * MiB;
constexpr size_t WS_ZM = 560 * MiB;
constexpr size_t WS_YM = 560 * MiB;
constexpr size_t WS_H = 624 * MiB;
constexpr size_t WS_LW = 624 * MiB;
constexpr size_t WS_A = 688 * MiB;
constexpr size_t WS_MG = 624 * MiB;
constexpr size_t WS_HID = 608 * MiB;
constexpr size_t WS_R = 752 * MiB;
constexpr size_t WS_V = 816 * MiB;
constexpr size_t WS_ZK = 880 * MiB;
constexpr size_t WS_TWA = 944 * MiB;
constexpr size_t WS_SGL = 960 * MiB;
constexpr size_t WS_QA = 976 * MiB;
constexpr size_t WS_KVA = 1008 * MiB;
constexpr size_t WS_KK = 944 * MiB;
constexpr size_t WS_YS = 752 * MiB;
constexpr size_t WS_END = 1024 * MiB;
constexpr size_t DO_G = 0;
constexpr size_t DO_Q = 64 * MiB;
constexpr size_t DO_KN = 160 * MiB;

constexpr int CW_CNT = 64;
constexpr int CW_BAR = 4096;

constexpr int NWAVES = 8, NTHR = 512;
constexpr int LDS_BYTES = 155648;
constexpr int LDS_MISC = 151552;

__device__ __forceinline__ int lane_id_fresh() { int l; asm volatile("v_mbcnt_lo_u32_b32 %0, -1, 0\n\tv_mbcnt_hi_u32_b32 %0, -1, %0" : "=v"(l)); return l; }
__device__ __forceinline__ float bf2f(unsigned short h) { return __builtin_bit_cast(float, (unsigned)h << 16); }
__device__ __forceinline__ unsigned f2bf(float f) { unsigned u = __builtin_bit_cast(unsigned, f); return (u + 0x7fffu + ((u >> 16) & 1u)) >> 16; }
__device__ __forceinline__ unsigned pk2(float lo, float hi) { return f2bf(lo) | (f2bf(hi) << 16); }
__device__ __forceinline__ float lo2f(unsigned w) { return __builtin_bit_cast(float, w << 16); }
__device__ __forceinline__ float hi2f(unsigned w) { return __builtin_bit_cast(float, w & 0xffff0000u); }
template <int CTRL> __device__ __forceinline__ float dpp_add(float x) { return x + __builtin_bit_cast(float, __builtin_amdgcn_update_dpp(0, __builtin_bit_cast(int, x), CTRL, 0xf, 0xf, false)); }
__device__ __forceinline__ float allsum16(float x) { x = dpp_add<0xB1>(x); x = dpp_add<0x4E>(x); x = dpp_add<0x141>(x); x = dpp_add<0x140>(x); return x; }
__device__ __forceinline__ float sum8(float x) { x = dpp_add<0xB1>(x); x = dpp_add<0x4E>(x); x = dpp_add<0x141>(x); return x; }
__device__ __forceinline__ float wave_sum(float v) {
    v = allsum16(v);
    { auto r = __builtin_amdgcn_permlane16_swap(__float_as_uint(v), __float_as_uint(v), false, false); v = __uint_as_float(r[0]) + __uint_as_float(r[1]); }
    { auto r = __builtin_amdgcn_permlane32_swap(__float_as_uint(v), __float_as_uint(v), false, false); v = __uint_as_float(r[0]) + __uint_as_float(r[1]); }
    return v;
}
__device__ __forceinline__ float sigmoidf_(float x) { return 1.f / (1.f + __expf(-x)); }
__device__ __forceinline__ float siluf_(float x) { return x / (1.f + __expf(-x)); }
__device__ __forceinline__ void unpack8(const u32x4 w, float (&v)[8]) {
    v[0] = lo2f(w.x); v[1] = hi2f(w.x); v[2] = lo2f(w.y); v[3] = hi2f(w.y); v[4] = lo2f(w.z); v[5] = hi2f(w.z); v[6] = lo2f(w.w); v[7] = hi2f(w.w);
}
__device__ __forceinline__ u32x4 pack8(const float (&v)[8]) { u32x4 w; w.x = pk2(v[0], v[1]); w.y = pk2(v[2], v[3]); w.z = pk2(v[4], v[5]); w.w = pk2(v[6], v[7]); return w; }

#define XB_TMO      128
#define XB_XCNT(j)  (256  + 64 * (j))
#define XB_XSUB(j)  (1280 + 64 * (j))
#define XB_XGEN(j)  (2304 + 64 * (j))
#define XB_TOP      3328
#define XB_TOPGEN   3392
#define XCD_BAR_WORDS 3456
#define XB_SPIN_CAP (1u << 19)
__device__ __forceinline__ unsigned xb_ld(unsigned* p)              { return __hip_atomic_load(p, __ATOMIC_RELAXED, __HIP_MEMORY_SCOPE_AGENT); }
__device__ __forceinline__ unsigned xb_add(unsigned* p, unsigned v) { return __hip_atomic_fetch_add(p, v, __ATOMIC_RELAXED, __HIP_MEMORY_SCOPE_AGENT); }
__device__ __forceinline__ unsigned xb_xcc_id() { return (unsigned)__builtin_amdgcn_s_getreg((3 << 11) | 20) & 0xFu; }
#define XB_SPIN(cond, bar) do { unsigned _sp = 0; while (cond) { __builtin_amdgcn_s_sleep(1); \
    if ((++_sp & 255u) == 0u) { if (xb_ld(&(bar)[XB_TMO])) break; if (_sp > XB_SPIN_CAP) { atomicAdd(&(bar)[XB_TMO], 1u); break; } } } } while (0)
struct XcdBarrier { unsigned* bar; unsigned x; volatile LAS unsigned* st; };
__device__ __forceinline__ XcdBarrier xcd_barrier_post(unsigned* bar, volatile LAS unsigned* st) {
    XcdBarrier b; b.bar = bar; b.x = xb_xcc_id(); b.st = st;
    if (threadIdx.x == 0) (void)xb_add(&bar[XB_XCNT(b.x)], 1u);
    return b;
}
__device__ __forceinline__ void xcd_barrier_complete(unsigned* bar, unsigned x, unsigned& nloc, unsigned& nx) {
    const unsigned G = gridDim.x * gridDim.y * gridDim.z;
    unsigned sum, cnt, mine, sp = 0u;
    for (;;) {
        sum = 0u; cnt = 0u; mine = 0u;
#pragma unroll
        for (unsigned j = 0; j < 16; ++j) { const unsigned c = xb_ld(&bar[XB_XCNT(j)]); sum += c; cnt += (c > 0u) ? 1u : 0u; mine = (j == x) ? c : mine; }
        if (sum == G) break;
        __builtin_amdgcn_s_sleep(1);
        if ((++sp & 255u) == 0u) { if (xb_ld(&bar[XB_TMO])) break; if (sp > XB_SPIN_CAP) { atomicAdd(&bar[XB_TMO], 1u); break; } }
    }
    nloc = mine > 0u ? mine : 1u; nx = cnt > 0u ? cnt : 1u;
}
__device__ __forceinline__ void xcd_barrier(const XcdBarrier& b) {
    asm volatile("s_waitcnt vmcnt(0)" ::: "memory");
    __syncthreads();
    if (threadIdx.x == 0) {
        unsigned* bar = b.bar;
        __builtin_amdgcn_s_waitcnt(0);
        unsigned nloc = b.st[0], nx = b.st[1];
        if (nloc == 0u) { xcd_barrier_complete(bar, b.x, nloc, nx); b.st[0] = nloc; b.st[1] = nx; }
        const unsigned old = xb_add(&bar[XB_XSUB(b.x)], 1u);
        const unsigned gen = old / nloc;
        if (old + 1u == (gen + 1u) * nloc) {
            __builtin_amdgcn_fence(__ATOMIC_RELEASE, "agent");
            asm volatile("s_waitcnt vmcnt(0)" ::: "memory");
            const unsigned og = xb_add(&bar[XB_TOP], 1u);
            const unsigned tg = og / nx;
            if (og + 1u == (tg + 1u) * nx) xb_add(&bar[XB_TOPGEN], 1u);
            else XB_SPIN(xb_ld(&bar[XB_TOPGEN]) == tg, bar);
            __builtin_amdgcn_fence(__ATOMIC_ACQUIRE, "agent");
            xb_add(&bar[XB_XGEN(b.x)], 1u);
            asm volatile("s_waitcnt vmcnt(0)" ::: "memory");
        } else {
            XB_SPIN(xb_ld(&bar[XB_XGEN(b.x)]) == gen, bar);
            __builtin_amdgcn_fence(__ATOMIC_ACQUIRE, "agent");
            asm volatile("s_waitcnt vmcnt(0)" ::: "memory");
        }
    }
    __syncthreads();
}

struct Args {
    const float* in[34]; float* out; unsigned char* ws; int ph_lo, ph_hi;
};
typedef const __attribute__((address_space(4))) Args* ArgsP;
struct Frame {
    LAS unsigned char* lds;
    int wave, vcu, G, gw, NGW;
    unsigned char* ws; unsigned char* dob;
};
enum { I_X = 0, I_C, I_POS, I_WADA, I_BADA, I_GMIX, I_WIN, I_MU, I_W0, I_WDEC, I_A0, I_WAUP, I_WGUP, I_KK, I_KA, I_RK, I_LNW, I_LNB, I_GQA, I_WUQ, I_GKVA, I_WUKV,
       I_QN, I_KN, I_WBR, I_WOUT, I_GFFN, I_WRG, I_BRG, I_WRE, I_BRE, I_WEG, I_WEU, I_WED };

struct Unit { int pm, pn; };
struct Gemm { const bf16* A; const bf16* Bt; int M, N, K; };
constexpr int NXCD = 8, WGM = 8;
struct StaticOrder {
    int nM, nN, nwg, G, c;
    __device__ void init(int M, int N, int G_, int c_) { nM = M / 256; nN = N / 256; nwg = nM * nN; G = G_; c = c_; }
    __device__ bool next(int i, Unit& u) const {
        const long L = (long)i * G + c; if (L >= nwg) return false;
        int wgid = (int)L; { const int q = nwg / NXCD, r = nwg % NXCD, xcd = wgid % NXCD, off = wgid / NXCD; wgid = (xcd < r ? xcd * (q + 1) : r * (q + 1) + (xcd - r) * q) + off; }
        const int nig = WGM * nN, gid = wgid / nig, fm = gid * WGM, gsz = (nM - fm) < WGM ? (nM - fm) : WGM;
        u.pm = fm + ((wgid % nig) % gsz); u.pn = (wgid % nig) / gsz; return true;
    }
    __device__ __forceinline__ void a_ready(const Unit&) const {}
    __device__ __forceinline__ void done(const Unit&) const {}
};
struct TableOrder {
    const LAS int* texp; int ntiles, nN, G, c;
    __device__ bool next(int i, Unit& u) const {
        const long L = (long)i * G + c; if (L >= (long)ntiles * nN) return false;
        const int t = (int)(L / nN), j = (int)(L % nN); u.pm = t; u.pn = texp[t] * nN + j; return true;
    }
    __device__ __forceinline__ void a_ready(const Unit&) const {}
    __device__ __forceinline__ void done(const Unit&) const {}
};

template <class Epi, class Sched>
__device__ __forceinline__ void gemm_phase_naive(LAS unsigned char* lds, const Gemm g, const Sched& S, const Epi& E) {
    const int tid = (int)__builtin_amdgcn_readfirstlane((int)threadIdx.x >> 6) * 64 + lane_id_fresh(), ty = tid >> 5, tx = tid & 31;
    LAS bf16* As = (LAS bf16*)lds; LAS bf16* Bs = (LAS bf16*)(lds + 128 * 40 * 2);
    Unit u;
    for (int i = 0; S.next(i, u); ++i) {
        for (int half = 0; half < 2; ++half) {
            float acc[8][8];
#pragma unroll
            for (int r = 0; r < 8; ++r)
#pragma unroll
                for (int c = 0; c < 8; ++c) acc[r][c] = 0.f;
            const bf16* Ab = g.A + ((size_t)u.pm * 256 + half * 128) * g.K; const bf16* Bb = g.Bt + (size_t)u.pn * 256 * g.K;
            for (int k0 = 0; k0 < g.K; k0 += 32) {
                __syncthreads();
                { const int r = tid >> 2, c8 = (tid & 3) * 8; *(LAS u32x4*)(As + r * 40 + c8) = *(const u32x4*)(Ab + (size_t)r * g.K + k0 + c8); }
#pragma unroll
                for (int j = 0; j < 2; ++j) { const int ch = tid + j * 512, r = ch >> 2, c8 = (ch & 3) * 8; *(LAS u32x4*)(Bs + r * 40 + c8) = *(const u32x4*)(Bb + (size_t)r * g.K + k0 + c8); }
                __syncthreads();
#pragma unroll 2
                for (int k = 0; k < 32; k += 2) {
                    float b0[8], b1[8];
#pragma unroll
                    for (int c = 0; c < 8; ++c) { const unsigned w = *(const LAS unsigned*)(Bs + (tx * 8 + c) * 40 + k); b0[c] = lo2f(w); b1[c] = hi2f(w); }
#pragma unroll
                    for (int r = 0; r < 8; ++r) { const unsigned w = *(const LAS unsigned*)(As + (ty * 8 + r) * 40 + k); const float a0 = lo2f(w), a1 = hi2f(w);
#pragma unroll
                        for (int c = 0; c < 8; ++c) acc[r][c] = fmaf(a1, b1[c], fmaf(a0, b0[c], acc[r][c])); }
                }
            }
#pragma unroll
            for (int r = 0; r < 8; ++r) E.store8(u, half * 128 + ty * 8 + r, tx * 8, acc[r]);
        }
    }
    __syncthreads();
}

struct EpiZ { bf16 *ZR, *SG, *ZM;
    __device__ __forceinline__ void store8(const Unit& u, int r, int c, const float (&v)[8]) const {
        const size_t row = (size_t)u.pm * 256 + r;
        if (u.pn < 7) { *(u32x4*)(ZR + row * 1792 + u.pn * 256 + c) = pack8(v); }
        else if (u.pn < 15) { float s[8];
#pragma unroll
            for (int i = 0; i < 8; ++i) s[i] = sigmoidf_(v[i]);
            *(u32x4*)(SG + row * 2048 + (u.pn - 7) * 256 + c) = pack8(s); }
        else { *(u32x4*)(ZM + row * 512 + (u.pn - 15) * 256 + c) = pack8(v); }
    } };
struct EpiLora { bf16 *LW, *A; const float *w0, *a0;
    __device__ __forceinline__ void store8(const Unit& u, int r, int c, const float (&v)[8]) const {
        const size_t row = (size_t)u.pm * 256 + r; const int col = u.pn * 256 + c; float o[8];
        const bool isw = col < 512; const float* bp = isw ? (w0 + col) : (a0 + col - 512);
        const f32x4 b0 = *(const f32x4*)bp, b1 = *(const f32x4*)(bp + 4); const float bb[8] = {b0.x, b0.y, b0.z, b0.w, b1.x, b1.y, b1.z, b1.w};
#pragma unroll
        for (int i = 0; i < 8; ++i) { const float e = __expf(fminf(-(bb[i] + v[i]), 80.f)); const float s = 1.0f / (1.0f + e); o[i] = isw ? -0.60653065971263342f * s : s; }
        bf16* dst = isw ? (LW + row * 512 + col) : (A + row * 512 + col - 512);
        *(u32x4*)dst = pack8(o);
    } };
struct EpiPlain { bf16* O0; bf16* O1; int split, ld0, ld1;
    __device__ __forceinline__ void store8(const Unit& u, int r, int c, const float (&v)[8]) const {
        const size_t row = (size_t)u.pm * 256 + r; int col = u.pn * 256 + c;
        if (col < split) *(u32x4*)(O0 + row * ld0 + col) = pack8(v); else *(u32x4*)(O1 + row * ld1 + col - split) = pack8(v);
    } };
template <bool ACCUM> struct EpiBranch { bf16* MG; const bf16* SG; int goff;
    __device__ __forceinline__ void store8(const Unit& u, int r, int c, const float (&v)[8]) const {
        const size_t row = (size_t)u.pm * 256 + r; const int col = u.pn * 256 + c; float gt[8], o[8];
        unpack8(*(const u32x4*)(SG + row * 2048 + goff + col), gt);
        if (ACCUM) { float p[8]; unpack8(*(const u32x4*)(MG + row * 1024 + col), p);
#pragma unroll
            for (int i = 0; i < 8; ++i) o[i] = p[i] + gt[i] * v[i]; }
        else {
#pragma unroll
            for (int i = 0; i < 8; ++i) o[i] = gt[i] * v[i]; }
        *(u32x4*)(MG + row * 1024 + col) = pack8(o);
    } };
struct EpiOut { float* X1; const float* x; const float* mod;
    __device__ __forceinline__ void store8(const Unit& u, int r, int c, const float (&v)[8]) const {
        const size_t row = (size_t)u.pm * 256 + r; const int col = u.pn * 256 + c; const int b = (int)(row / SEQ);
        const float* gt = mod + b * 6144 + 2048 + col; const float* xr = x + row * 1024 + col; float* o = X1 + row * 1024 + col;
        const f32x4 g0 = *(const f32x4*)gt, g1 = *(const f32x4*)(gt + 4), x0 = *(const f32x4*)xr, x1 = *(const f32x4*)(xr + 4);
        *(f32x4*)o = (f32x4){x0.x + g0.x * v[0], x0.y + g0.y * v[1], x0.z + g0.z * v[2], x0.w + g0.w * v[3]};
        *(f32x4*)(o + 4) = (f32x4){x1.x + g1.x * v[4], x1.y + g1.y * v[5], x1.z + g1.z * v[6], x1.w + g1.w * v[7]};
    } };
struct EpiGateUp { bf16* HID;
    __device__ __forceinline__ void store8(const Unit& u, int r, int c, const float (&v)[8]) const {
        const size_t row = (size_t)u.pm * 256 + r; const int col = ((u.pn & 1) * 256 + c) >> 1;
        u32x2 w; w.x = pk2(siluf_(v[0]) * v[4], siluf_(v[1]) * v[5]); w.y = pk2(siluf_(v[2]) * v[6], siluf_(v[3]) * v[7]);
        *(u32x2*)(HID + row * 256 + col) = w;
    } };
struct EpiDownAtomic { float* out; const int* ent; const float* mod;
    __device__ __forceinline__ void store8(const Unit& u, int r, int c, const float (&v)[8]) const {
        const int e0 = ent[2 * (u.pm * 256 + r)]; if (e0 < 0) return; const float w = __builtin_bit_cast(float, ent[2 * (u.pm * 256 + r) + 1]);
        const int col = (u.pn & 3) * 256 + c, b = e0 / SEQ; const float* gt = mod + b * 6144 + 5120 + col; float* o = out + (size_t)e0 * 1024 + col;
        const f32x4 g0 = *(const f32x4*)gt, g1 = *(const f32x4*)(gt + 4);
        unsafeAtomicAdd(o + 0, g0.x * w * v[0]); unsafeAtomicAdd(o + 1, g0.y * w * v[1]); unsafeAtomicAdd(o + 2, g0.z * w * v[2]); unsafeAtomicAdd(o + 3, g0.w * w * v[3]);
        unsafeAtomicAdd(o + 4, g1.x * w * v[4]); unsafeAtomicAdd(o + 5, g1.y * w * v[5]); unsafeAtomicAdd(o + 6, g1.z * w * v[6]); unsafeAtomicAdd(o + 7, g1.w * w * v[7]);
    } };
struct EpiDown { bf16* YS;
    __device__ __forceinline__ void store8(const Unit& u, int r, int c, const float (&v)[8]) const {
        const size_t row = (size_t)u.pm * 256 + r; *(u32x4*)(YS + row * 1024 + (u.pn & 3) * 256 + c) = pack8(v);
    } };


namespace pg8 {
#define PG8_LAS __attribute__((address_space(3)))
typedef ::bf16x8 bf16x8; typedef ::f32x4 f32x4;
using ::Unit; using ::Gemm;
constexpr int BM = 256, BK = 64, HALF = 128, HTB = HALF * BK * 2  , STAGE_BYTES = 8 * HTB;

__device__ __forceinline__ int lds_byte(int r, int c) { const int st = (r >> 4) * 2 + (c >> 5), rr = r & 15, cc = c & 31, ob = rr * 64 + cc * 2; return st * 1024 + (ob ^ (((ob >> 9) & 1) << 5)); }
__device__ __forceinline__ void stage_rc(int b, int& R, int& C) { const int st = b / 1024, sb = b % 1024, swz = sb ^ (((sb >> 9) & 1) << 5); R = (st >> 1) * 16 + swz / 64; C = (st & 1) * 32 + (swz % 64) / 2; }
__device__ __forceinline__ int perm32(int rho) { const int n = rho >> 4, i = rho & 15; return 8 * (i >> 2) + 4 * n + (i & 3); }
template <class Epi, class Sched, bool ALIGN_EPI = false, bool SP2 = false>
__device__ __forceinline__ void gemm_phase(PG8_LAS unsigned char* lds, const Gemm g, const Sched& S, const Epi& E, const int wave_in) {
    const int lane = lane_id_fresh(), wid = wave_in, tid = wid * 64 + lane,
              wr = wid >> 2, wc = wid & 3, fr = lane & 15, fq = lane >> 4;
    const int K = g.K, nt = K / BK;
    unsigned voffA[2], voffB[2];
#pragma unroll
    for (int i = 0; i < 2; ++i) { int R, C; stage_rc(tid * 16 + i * 8192, R, C); const int Rb = Epi::PERM ? ((R & ~31) + perm32(R & 31)) : R;
        voffA[i] = (unsigned)(R * K + C) * 2u; voffB[i] = (unsigned)(Rb * K + C) * 2u; }
    const size_t kstep = (size_t)(BK * 2);
    const size_t hstep = (size_t)HALF * K * 2;
    const size_t tstep = 2 * hstep;
    const unsigned ldsw = (unsigned)wid * 1024u;
    const int aoff = lds_byte(wr * 64 + fr, fq * 8), boff = lds_byte(wc * 32 + fr, fq * 8);
#define PG8_SA(b, h) (((b) * 2 + (h)) * HTB)
#define PG8_SB(b, h) ((4 + (b) * 2 + (h)) * HTB)
#define PG8_STAGE(bufoff, gbase, voff) do { _Pragma("unroll") for (int _i = 0; _i < 2; ++_i) \
        __builtin_amdgcn_global_load_lds((const unsigned*)((const char*)(gbase) + (voff)[_i]), (PG8_LAS unsigned*)(lds + (bufoff) + ldsw + _i * 8192), 16, 0, 0); } while (0)
#define PG8_LDA(dst, b, h) do { _Pragma("unroll") for (int m = 0; m < 4; ++m) _Pragma("unroll") for (int k = 0; k < 2; ++k) dst[m][k] = *(const PG8_LAS bf16x8*)(lds + PG8_SA(b, h) + aoff + m * 2048 + k * 1024); } while (0)
#define PG8_LDB(dst, b, h) do { _Pragma("unroll") for (int n = 0; n < 2; ++n) _Pragma("unroll") for (int k = 0; k < 2; ++k) dst[n][k] = *(const PG8_LAS bf16x8*)(lds + PG8_SB(b, h) + boff + n * 2048 + k * 1024); } while (0)
#define PG8_MMA(ai, bj, At, Bt) do { __builtin_amdgcn_s_setprio(1); _Pragma("unroll") for (int m = 0; m < 4; ++m) _Pragma("unroll") for (int n = 0; n < 2; ++n) _Pragma("unroll") for (int k = 0; k < 2; ++k) \
        acc[ai][bj][m][n] = __builtin_amdgcn_mfma_f32_16x16x32_bf16(Bt[n][k], At[m][k], acc[ai][bj][m][n], 0, 0, 0); __builtin_amdgcn_s_setprio(0); } while (0)
#define PG8_WAIT_V(n) asm volatile("s_waitcnt vmcnt(" #n ")" ::: "memory")
#define PG8_WAIT_L(n) asm volatile("s_waitcnt lgkmcnt(" #n ")" ::: "memory")
#define PG8_BAR __builtin_amdgcn_s_barrier()
#define PG8_SCHED __builtin_amdgcn_sched_barrier(0)
    Unit cur, nxt; int ui = 0;
    if (!S.next(0, cur)) return;
    f32x4 acc[2][2][4][2];
#pragma unroll
    for (int a = 0; a < 2; ++a)
#pragma unroll
        for (int b = 0; b < 2; ++b)
#pragma unroll
            for (int m = 0; m < 4; ++m)
#pragma unroll
                for (int n = 0; n < 2; ++n) acc[a][b][m][n] = (f32x4){0.f, 0.f, 0.f, 0.f};
    bf16x8 At[4][2], B0[2][2], B1[2][2];
    const char* cA = (const char*)g.A + (size_t)cur.pm * tstep; const char* cB = (const char*)g.Bt + (size_t)cur.pn * tstep;
    S.a_ready(cur);
    if constexpr (SP2) {
        PG8_STAGE(PG8_SB(0, 0), cB, voffB); PG8_STAGE(PG8_SB(0, 1), cB + hstep, voffB); PG8_STAGE(PG8_SA(0, 0), cA, voffA); PG8_STAGE(PG8_SA(0, 1), cA + hstep, voffA);
        if (wr == 1) PG8_BAR;
        PG8_WAIT_V(2); PG8_BAR;
        PG8_STAGE(PG8_SB(1, 0), cB + kstep, voffB); PG8_STAGE(PG8_SA(1, 0), cA + kstep, voffA); PG8_STAGE(PG8_SB(1, 1), cB + hstep + kstep, voffB);
        PG8_WAIT_V(6); PG8_BAR;
    } else {
        PG8_STAGE(PG8_SB(0, 0), cB, voffB); PG8_STAGE(PG8_SA(0, 0), cA, voffA); PG8_STAGE(PG8_SB(0, 1), cB + hstep, voffB); PG8_STAGE(PG8_SA(0, 1), cA + hstep, voffA);
        if (wr == 1) PG8_BAR;
        PG8_WAIT_V(4); PG8_BAR;
        PG8_STAGE(PG8_SB(1, 0), cB + kstep, voffB); PG8_STAGE(PG8_SA(1, 0), cA + kstep, voffA); PG8_STAGE(PG8_SB(1, 1), cB + hstep + kstep, voffB);
        PG8_WAIT_V(6); PG8_BAR;
    }
    for (;;) {
        const bool has_next = S.next(ui + 1, nxt);
        const char* nA = has_next ? (const char*)g.A + (size_t)nxt.pm * tstep : cA; const char* nB = has_next ? (const char*)g.Bt + (size_t)nxt.pn * tstep : cB;
        for (int t = 0; t < nt; t += 2) {
            const bool last = (t == nt - 2);
            const char* a1 = cA + (size_t)(t + 1) * kstep;
            const char* a2 = last ? nA : cA + (size_t)(t + 2) * kstep; const char* b2 = last ? nB : cB + (size_t)(t + 2) * kstep;
            const char* a3 = a2 + kstep; const char* b3 = b2 + kstep;
            if (last && has_next) S.a_ready(nxt);
            if constexpr (SP2) {
            PG8_LDB(B0, 0, 0); PG8_LDB(B1, 0, 1); PG8_SCHED; PG8_LDA(At, 0, 0); PG8_STAGE(PG8_SA(1, 1), a1 + hstep, voffA);
            PG8_WAIT_V(8); PG8_WAIT_L(0); PG8_BAR; PG8_MMA(0, 0, At, B0); PG8_MMA(0, 1, At, B1); PG8_BAR; PG8_SCHED;
            PG8_LDA(At, 0, 1); PG8_STAGE(PG8_SB(0, 0), b2, voffB); PG8_STAGE(PG8_SB(0, 1), b2 + hstep, voffB); PG8_STAGE(PG8_SA(0, 0), a2, voffA);
            PG8_WAIT_V(8); PG8_WAIT_L(0); PG8_BAR; PG8_MMA(1, 0, At, B0); PG8_MMA(1, 1, At, B1); PG8_BAR; PG8_SCHED;
            PG8_LDB(B0, 1, 0); PG8_LDB(B1, 1, 1); PG8_SCHED; PG8_LDA(At, 1, 0); PG8_STAGE(PG8_SA(0, 1), a2 + hstep, voffA);
            PG8_WAIT_V(8); PG8_WAIT_L(0); PG8_BAR; PG8_MMA(0, 0, At, B0); PG8_MMA(0, 1, At, B1); PG8_BAR; PG8_SCHED;
            PG8_LDA(At, 1, 1); PG8_STAGE(PG8_SB(1, 0), b3, voffB); PG8_STAGE(PG8_SB(1, 1), b3 + hstep, voffB); PG8_STAGE(PG8_SA(1, 0), a3, voffA);
            PG8_WAIT_V(8); PG8_WAIT_L(0); PG8_BAR; PG8_MMA(1, 0, At, B0); PG8_MMA(1, 1, At, B1); PG8_BAR; PG8_SCHED;
            } else {
            PG8_LDB(B0, 0, 0); PG8_SCHED; PG8_LDA(At, 0, 0); PG8_STAGE(PG8_SA(1, 1), a1 + hstep, voffA);
            PG8_WAIT_L(8); PG8_BAR; PG8_WAIT_L(0); PG8_MMA(0, 0, At, B0); PG8_BAR; PG8_SCHED;
            PG8_LDB(B1, 0, 1); PG8_STAGE(PG8_SB(0, 0), b2, voffB);
            PG8_BAR; PG8_WAIT_L(0); PG8_MMA(0, 1, At, B1); PG8_BAR;
            PG8_LDA(At, 0, 1); PG8_STAGE(PG8_SA(0, 0), a2, voffA);
            PG8_BAR; PG8_WAIT_L(0); PG8_MMA(1, 0, At, B0); PG8_BAR; PG8_SCHED;
            PG8_STAGE(PG8_SB(0, 1), b2 + hstep, voffB);
            PG8_WAIT_V(6); PG8_BAR; PG8_MMA(1, 1, At, B1); PG8_BAR;
            PG8_LDB(B0, 1, 0); PG8_SCHED; PG8_LDA(At, 1, 0); PG8_STAGE(PG8_SA(0, 1), a2 + hstep, voffA);
            PG8_WAIT_L(8); PG8_BAR; PG8_WAIT_L(0); PG8_MMA(0, 0, At, B0); PG8_BAR; PG8_SCHED;
            PG8_LDB(B1, 1, 1); PG8_STAGE(PG8_SB(1, 0), b3, voffB);
            PG8_BAR; PG8_WAIT_L(0); PG8_MMA(0, 1, At, B1); PG8_BAR;
            PG8_LDA(At, 1, 1); PG8_STAGE(PG8_SA(1, 0), a3, voffA);
            PG8_BAR; PG8_WAIT_L(0); PG8_MMA(1, 0, At, B0); PG8_BAR; PG8_SCHED;
            PG8_STAGE(PG8_SB(1, 1), b3 + hstep, voffB);
            PG8_WAIT_V(6); PG8_BAR; PG8_MMA(1, 1, At, B1); PG8_BAR;
            }
        }
        if constexpr (ALIGN_EPI) { if (wr == 0) PG8_BAR; }
        if constexpr (!Epi::AFTER_DRAIN) { E(acc, cur, wr, wc, fr, fq); S.done(cur); }
        if (!has_next) break;
#pragma unroll
        for (int a = 0; a < 2; ++a)
#pragma unroll
            for (int b = 0; b < 2; ++b)
#pragma unroll
                for (int m = 0; m < 4; ++m)
#pragma unroll
                    for (int n = 0; n < 2; ++n) acc[a][b][m][n] = (f32x4){0.f, 0.f, 0.f, 0.f};
        cur = nxt; cA = nA; cB = nB; ++ui;
        if constexpr (ALIGN_EPI) { if (wr == 1) PG8_BAR; }
    }
    PG8_WAIT_V(0);
    if constexpr (!ALIGN_EPI) { if (wr == 0) PG8_BAR; }
    PG8_BAR;
    if constexpr (Epi::AFTER_DRAIN) { E.fused(acc, cur, wr, wc, fr, fq, lds, wid, lane); S.done(cur); }
#undef PG8_SA
#undef PG8_SB
#undef PG8_STAGE
#undef PG8_LDA
#undef PG8_LDB
#undef PG8_MMA
#undef PG8_WAIT_V
#undef PG8_WAIT_L
#undef PG8_BAR
#undef PG8_SCHED
}

template <class F> struct EpiAdapt {
    static constexpr bool PERM = true, AFTER_DRAIN = false; F f;
    __device__ __forceinline__ void operator()(const f32x4 (&acc)[2][2][4][2], const Unit& u, int wr, int wc, int fr, int fq) const {
        asm volatile("" : "+v"(fr), "+v"(fq));
#pragma unroll
        for (int ai = 0; ai < 2; ++ai)
#pragma unroll
            for (int m = 0; m < 4; ++m) { const int row = ai * HALF + wr * 64 + m * 16 + fr;
#pragma unroll
                for (int bj = 0; bj < 2; ++bj) { const f32x4 v0 = acc[ai][bj][m][0], v1 = acc[ai][bj][m][1];
                    const float v[8] = {v0[0], v0[1], v0[2], v0[3], v1[0], v1[1], v1[2], v1[3]};
                    f.store8(u, row, bj * HALF + wc * 32 + 8 * fq, v); } }
    }
};
}

template <class Epi, class Sched>
__device__ __forceinline__ void gemm_phase_any(LAS unsigned char* lds, const Gemm g, const Sched& S, const Epi& E, const int wave_in) {
#if ENG_GEMM == 1
    pg8::EpiAdapt<Epi> EA{E};
    pg8::gemm_phase<pg8::EpiAdapt<Epi>, Sched, true, true>(lds, g, S, EA, wave_in);
#else
    gemm_phase_naive<Epi, Sched>(lds, g, S, E);
#endif
}

template <class RowMap>
__device__ __forceinline__ void transpose_item(const float* W, int ldw, bf16* WT, int ldt, int koff, int k0, int n0, const RowMap& rm, LAS float* scr, int lane) {
#pragma unroll 8
    for (int i = 0; i < 32; ++i) { const int kk = 2 * i + (lane >> 5); scr[kk * 33 + (lane & 31)] = W[(size_t)(k0 + kk) * ldw + n0 + (lane & 31)]; }
    asm volatile("s_waitcnt lgkmcnt(0)" ::: "memory");
    const int c = lane & 7;
#pragma unroll
    for (int j = 0; j < 4; ++j) { const int n = (lane >> 3) + 8 * j; const LAS float* s = scr + (8 * c) * 33 + n;
        u32x4 o; o.x = pk2(s[0 * 33], s[1 * 33]); o.y = pk2(s[2 * 33], s[3 * 33]); o.z = pk2(s[4 * 33], s[5 * 33]); o.w = pk2(s[6 * 33], s[7 * 33]);
        *(u32x4*)(WT + (size_t)rm(n0 + n) * ldt + koff + k0 + 8 * c) = o; }
    asm volatile("s_waitcnt lgkmcnt(0)" ::: "memory");
}
struct RmId { int off; __device__ int operator()(int n) const { return off + n; } };
struct RmWin { __device__ int operator()(int n) const { return n < 1792 ? n : (n < 2208 ? 3840 + (n - 1792) : 1792 + (n - 2208)); } };
struct RmUkv { __device__ int operator()(int n) const { const int h = n >> 7, j = n & 127; return j < 64 ? h * 64 + j : 512 + h * 64 + (j - 64); } };
struct RmGU { int off; __device__ int operator()(int j) const { return off + 8 * (j >> 2) + (j & 3); } };

__device__ __forceinline__ void p0_prologue(const Frame& F, ArgsP a) {
    const int lane_f = lane_id_fresh(), tid_f = F.wave * 64 + lane_f;
    LAS float* scr = (LAS float*)(F.lds + F.wave * 16384);
    const int lane = lane_f;
    bf16* Win = (bf16*)(F.ws + WS_WIN); bf16* Wblk = (bf16*)(F.ws + WS_WBLK); bf16* Wg = (bf16*)(F.ws + WS_WG); bf16* Wuq = (bf16*)(F.ws + WS_WUQ);
    bf16* Wukv = (bf16*)(F.ws + WS_WUKV); bf16* Wb = (bf16*)(F.ws + WS_WB); bf16* Wo = (bf16*)(F.ws + WS_WO); bf16* Wgu = (bf16*)(F.ws + WS_WGU); bf16* Wdn = (bf16*)(F.ws + WS_WDN);
    constexpr int I_IN = 16 * 133, I_DEC = 1 * 16, I_AUP = 16, I_GUP = 2 * 16, I_UQ = 4 * 24, I_UKV = 2 * 32, I_BR = 2 * 8 * 32, I_O = 16 * 32;
    constexpr int I_EG = 32 * 16 * 8, I_EU = I_EG, I_ED = 32 * 4 * 32;
    constexpr int NITEMS = I_IN + I_DEC + I_AUP + I_GUP + I_UQ + I_UKV + I_BR + I_O + I_EG + I_EU + I_ED;
    for (int it = F.gw; it < NITEMS; it += F.NGW) {
        int r = it;
        if (r < I_IN) { const int kb = r / 133, nb = r % 133; transpose_item(a->in[I_WIN], D_IN, Win, 1024, 0, 64 * kb, 32 * nb, RmWin{}, scr, lane); continue; } r -= I_IN;
        if (r < I_DEC) { transpose_item(a->in[I_WDEC], 512, Wblk, 128, 0, 0, 32 * r, RmId{0}, scr, lane); continue; } r -= I_DEC;
        if (r < I_AUP) { transpose_item(a->in[I_WAUP], 512, Wblk, 128, 64, 0, 32 * r, RmId{512}, scr, lane); continue; } r -= I_AUP;
        if (r < I_GUP) { const int kb = r / 16, nb = r % 16; transpose_item(a->in[I_WGUP], 512, Wg, 128, 0, 64 * kb, 32 * nb, RmId{0}, scr, lane); continue; } r -= I_GUP;
        if (r < I_UQ) { const int kb = r / 24, nb = r % 24; transpose_item(a->in[I_WUQ], 768, Wuq, 256, 0, 64 * kb, 32 * nb, RmId{0}, scr, lane); continue; } r -= I_UQ;
        if (r < I_UKV) { const int kb = r / 32, nb = r % 32; transpose_item(a->in[I_WUKV], 1024, Wukv, 128, 0, 64 * kb, 32 * nb, RmUkv{}, scr, lane); continue; } r -= I_UKV;
        if (r < I_BR) { const int br = r / 256, q = r % 256, kb = q / 32, nb = q % 32; transpose_item(a->in[I_WBR] + (size_t)br * 512 * 1024, 1024, Wb + (size_t)br * 1024 * 512, 512, 0, 64 * kb, 32 * nb, RmId{0}, scr, lane); continue; } r -= I_BR;
        if (r < I_O) { const int kb = r / 32, nb = r % 32; transpose_item(a->in[I_WOUT], 1024, Wo, 1024, 0, 64 * kb, 32 * nb, RmId{0}, scr, lane); continue; } r -= I_O;
        if (r < I_EG) { const int e = r / 128, q = r % 128, kb = q / 8, nb = q % 8; transpose_item(a->in[I_WEG] + (size_t)e * 1024 * 256, 256, Wgu + (size_t)e * 512 * 1024, 1024, 0, 64 * kb, 32 * nb, RmGU{0}, scr, lane); continue; } r -= I_EG;
        if (r < I_EU) { const int e = r / 128, q = r % 128, kb = q / 8, nb = q % 8; transpose_item(a->in[I_WEU] + (size_t)e * 1024 * 256, 256, Wgu + (size_t)e * 512 * 1024, 1024, 0, 64 * kb, 32 * nb, RmGU{4}, scr, lane); continue; } r -= I_EU;
        { const int e = r / 128, q = r % 128, kb = q / 32, nb = q % 32; transpose_item(a->in[I_WED] + (size_t)e * 256 * 1024, 1024, Wdn + (size_t)e * 1024 * 256, 256, 0, 64 * kb, 32 * nb, RmId{0}, scr, lane); }
    }
    for (int i = F.gw * 64 + lane; i < 96 * 128; i += F.NGW * 64) *(u32x4*)(Win + (size_t)4256 * 1024 + (size_t)i * 8) = (u32x4){0u, 0u, 0u, 0u};
    for (int i = F.gw * 64 + lane; i < 1024 * 8; i += F.NGW * 64) { const int row = i >> 3, c8 = (i & 7) * 8; *(u32x4*)(Wblk + row * 128 + (row < 512 ? 64 : 0) + c8) = (u32x4){0u, 0u, 0u, 0u}; }
    { const int* pos = (const int*)a->in[I_POS]; float* cs = (float*)(F.ws + WS_CS);
      for (int i = F.gw * 64 + lane; i < NTOK * 16; i += F.NGW * 64) { const int t = i >> 4, j = i & 15;
          const float fr = exp2f(-(float)j * (13.287712379549449f / 16.0f));
          const float ang = (float)pos[t] * fr; cs[t * 32 + j] = cosf(ang); cs[t * 32 + 16 + j] = sinf(ang); } }
    { float* mod = (float*)(F.ws + WS_MOD); const float* c = a->in[I_C]; const float* wa = a->in[I_WADA]; const float* ba = a->in[I_BADA];
      LAS float* red = (LAS float*)(F.lds + 8 * 16384);
      for (int nb = F.vcu; nb < 96; nb += F.G) {
          float acc[8];
#pragma unroll
          for (int b = 0; b < 8; ++b) acc[b] = 0.f;
          const int n = nb * 64 + lane;
          for (int k = F.wave * 128; k < F.wave * 128 + 128; ++k) { const float w = wa[(size_t)k * 6144 + n];
#pragma unroll
              for (int b = 0; b < 8; ++b) acc[b] = fmaf(siluf_(c[b * 1024 + k]), w, acc[b]); }
#pragma unroll
          for (int b = 0; b < 8; ++b) red[(F.wave * 8 + b) * 64 + lane] = acc[b];
          __syncthreads();
          { const int b = F.wave; float s = ba[n];
#pragma unroll
            for (int w = 0; w < 8; ++w) s += red[(w * 8 + b) * 64 + lane];
            mod[b * 6144 + n] = s; }
          __syncthreads();
      } }
}

__device__ __forceinline__ void p_normmod(const Frame& F, const float* x, const float* g, const float* mod, int sh_off, int sc_off, bf16* H) {
    const int lane_f = lane_id_fresh(), tid_f = F.wave * 64 + lane_f;
    for (int m = F.gw; m < NTOK; m += F.NGW) {
        const int b = m / SEQ; const f32x4* xr = (const f32x4*)(x + (size_t)m * 1024) + lane_f;
        f32x4 v[4]; float s = 0.f;
#pragma unroll
        for (int j = 0; j < 4; ++j) { v[j] = xr[64 * j]; s += (v[j].x * v[j].x + v[j].y * v[j].y) + (v[j].z * v[j].z + v[j].w * v[j].w); }
        const float rstd = 1.0f / sqrtf(wave_sum(s) * (1.f / 1024.f) + EPS);
        u32x2* o = (u32x2*)(H + (size_t)m * 1024) + lane_f;
#pragma unroll
        for (int j = 0; j < 4; ++j) { const int col = 4 * lane_f + 256 * j;
            const f32x4 gg = *(const f32x4*)(g + col), sc = *(const f32x4*)(mod + b * 6144 + sc_off + col), sh = *(const f32x4*)(mod + b * 6144 + sh_off + col);
            const f32x4 y = v[j] * rstd * gg * (sc + 1.0f) + sh; u32x2 w; w.x = pk2(y.x, y.y); w.y = pk2(y.z, y.w); o[64 * j] = w; }
    }
}

__device__ __forceinline__ void p_prep_a(const Frame& F, ArgsP a) {
    const int lane_f = lane_id_fresh();
    const bf16* ZR = (const bf16*)(F.ws + WS_ZR); const bf16* ZM = (const bf16*)(F.ws + WS_ZM);
    bf16* TWA = (bf16*)(F.ws + WS_TWA); bf16* SGL = (bf16*)(F.ws + WS_SGL); bf16* QA = (bf16*)(F.ws + WS_QA); bf16* KVA = (bf16*)(F.ws + WS_KVA);
    const float* mu = a->in[I_MU]; const float* gqa = a->in[I_GQA]; const float* gkva = a->in[I_GKVA];
    const int lane = lane_f;
    const f32x4 mm = *(const f32x4*)(mu + 1536 + 4 * lane), gq = *(const f32x4*)(gqa + 4 * lane), gk = *(const f32x4*)(gkva + 4 * (lane & 31));
    for (int m = F.gw; m < NTOK; m += F.NGW) {
        const bool first = (m % SEQ) == 0;
        { const u32x2 c = *((const u32x2*)(ZR + (size_t)m * 1792 + 1536) + lane); u32x2 p = *((const u32x2*)(ZR + (size_t)(first ? m : m - 1) * 1792 + 1536) + lane); if (first) { p.x = 0u; p.y = 0u; }
          float z[4] = {lo2f(c.x), hi2f(c.x), lo2f(c.y), hi2f(c.y)}; const float q[4] = {lo2f(p.x), hi2f(p.x), lo2f(p.y), hi2f(p.y)};
          z[0] += (q[0] - z[0]) * mm.x; z[1] += (q[1] - z[1]) * mm.y; z[2] += (q[2] - z[2]) * mm.z; z[3] += (q[3] - z[3]) * mm.w;
          if (lane < 16) { u32x2 w; w.x = pk2(tanhf(z[0]), tanhf(z[1])); w.y = pk2(tanhf(z[2]), tanhf(z[3])); *((u32x2*)(TWA + (size_t)m * 128) + lane) = w; }
          else if (lane < 32) { u32x2 w; w.x = pk2(z[0], z[1]); w.y = pk2(z[2], z[3]); *((u32x2*)(TWA + (size_t)m * 128) + lane) = w; }
          else { u32x2 w; w.x = pk2(sigmoidf_(z[0]), sigmoidf_(z[1])); w.y = pk2(sigmoidf_(z[2]), sigmoidf_(z[3])); *((u32x2*)(SGL + (size_t)m * 128) + (lane - 32)) = w; } }
        { const u32x2 c = *((const u32x2*)(ZM + (size_t)m * 512) + lane); const float z[4] = {lo2f(c.x), hi2f(c.x), lo2f(c.y), hi2f(c.y)};
          u32x2 c2 = (u32x2){0u, 0u}; if (lane < 32) c2 = *((const u32x2*)(ZM + (size_t)m * 512 + 256) + lane); const float y[4] = {lo2f(c2.x), hi2f(c2.x), lo2f(c2.y), hi2f(c2.y)};
          const float rstd = 1.0f / sqrtf(wave_sum((z[0] * z[0] + z[1] * z[1]) + (z[2] * z[2] + z[3] * z[3])) * (1.f / 256.f) + EPS);
          const float rstd2 = 1.0f / sqrtf(wave_sum((y[0] * y[0] + y[1] * y[1]) + (y[2] * y[2] + y[3] * y[3])) * (1.f / 128.f) + EPS);
          u32x2 w; w.x = pk2(z[0] * rstd * gq.x, z[1] * rstd * gq.y); w.y = pk2(z[2] * rstd * gq.z, z[3] * rstd * gq.w);
          *((u32x2*)(QA + (size_t)m * 256) + lane) = w;
          if (lane < 32) { u32x2 w2; w2.x = pk2(y[0] * rstd2 * gk.x, y[1] * rstd2 * gk.y); w2.y = pk2(y[2] * rstd2 * gk.z, y[3] * rstd2 * gk.w);
              *((u32x2*)(KVA + (size_t)m * 128) + lane) = w2; } }
    }
}

__device__ __forceinline__ void p_prep_c(const Frame& F, ArgsP a) {
    const int lane_f = lane_id_fresh(), tid_f = F.wave * 64 + lane_f;
    bf16* Q = (bf16*)(F.dob + DO_Q); const bf16* KN = (const bf16*)(F.dob + DO_KN); const bf16* ZM = (const bf16*)(F.ws + WS_ZM); bf16* KC = (bf16*)(F.ws + WS_KC);
    const float* cs = (const float*)(F.ws + WS_CS);
    const float* qn = a->in[I_QN]; const float* kn = a->in[I_KN];
    const int lane = lane_f, hd = lane >> 3, j = lane & 7;
    for (int m = F.gw; m < NTOK; m += F.NGW) {
        const f32x2 cc = *(const f32x2*)(cs + (size_t)m * 32 + 2 * j), sn = *(const f32x2*)(cs + (size_t)m * 32 + 16 + 2 * j);
        { bf16* qp = Q + (size_t)m * 768 + hd * 96; float v[8]; unpack8(*(const u32x4*)(qp + 8 * j), v);
          const unsigned w1 = *(const unsigned*)(qp + 64 + 2 * j), w2 = *(const unsigned*)(qp + 80 + 2 * j); float x1[2] = {lo2f(w1), hi2f(w1)}, x2[2] = {lo2f(w2), hi2f(w2)};
          float ss = (x1[0] * x1[0] + x1[1] * x1[1]) + (x2[0] * x2[0] + x2[1] * x2[1]);
#pragma unroll
          for (int i = 0; i < 8; ++i) ss += v[i] * v[i];
          const float rstd = 1.0f / sqrtf(sum8(ss) * (1.f / 96.f) + EPS);
#pragma unroll
          for (int i = 0; i < 8; ++i) v[i] = v[i] * rstd * qn[8 * j + i] * QSCALE;
          x1[0] *= rstd * qn[64 + 2 * j]; x1[1] *= rstd * qn[65 + 2 * j]; x2[0] *= rstd * qn[80 + 2 * j]; x2[1] *= rstd * qn[81 + 2 * j];
          const float o1a = (x1[0] * cc.x - x2[0] * sn.x) * QSCALE, o1b = (x1[1] * cc.y - x2[1] * sn.y) * QSCALE, o2a = (x2[0] * cc.x + x1[0] * sn.x) * QSCALE, o2b = (x2[1] * cc.y + x1[1] * sn.y) * QSCALE;
          *(u32x4*)(qp + 8 * j) = pack8(v); *(unsigned*)(qp + 64 + 2 * j) = pk2(o1a, o1b); *(unsigned*)(qp + 80 + 2 * j) = pk2(o2a, o2b); }
        { float v[8]; unpack8(*(const u32x4*)(KN + (size_t)m * 512 + hd * 64 + 8 * j), v);
          const unsigned w1 = *(const unsigned*)(ZM + (size_t)m * 512 + 384 + 2 * j), w2 = *(const unsigned*)(ZM + (size_t)m * 512 + 400 + 2 * j); float x1[2] = {lo2f(w1), hi2f(w1)}, x2[2] = {lo2f(w2), hi2f(w2)};
          float ss = (x1[0] * x1[0] + x1[1] * x1[1]) + (x2[0] * x2[0] + x2[1] * x2[1]);
#pragma unroll
          for (int i = 0; i < 8; ++i) ss += v[i] * v[i];
          const float rstd = 1.0f / sqrtf(sum8(ss) * (1.f / 96.f) + EPS);
#pragma unroll
          for (int i = 0; i < 8; ++i) v[i] = v[i] * rstd * kn[8 * j + i];
          x1[0] *= rstd * kn[64 + 2 * j]; x1[1] *= rstd * kn[65 + 2 * j]; x2[0] *= rstd * kn[80 + 2 * j]; x2[1] *= rstd * kn[81 + 2 * j];
          bf16* kp = KC + (size_t)m * 768 + hd * 96;
          *(u32x4*)(kp + 8 * j) = pack8(v); *(unsigned*)(kp + 64 + 2 * j) = pk2(x1[0] * cc.x - x2[0] * sn.x, x1[1] * cc.y - x2[1] * sn.y);
          *(unsigned*)(kp + 80 + 2 * j) = pk2(x2[0] * cc.x + x1[0] * sn.x, x2[1] * cc.y + x1[1] * sn.y); }
    }
}

constexpr int SC_T = 32;
constexpr int SC_BUF = 5 * SC_T * 64 * 4 + SC_T * 16 * 4 + SC_T * 16 * 4;
#define LDS_BAR() do { asm volatile("s_waitcnt lgkmcnt(0)" ::: "memory"); __builtin_amdgcn_s_barrier(); asm volatile("" ::: "memory"); } while (0)
struct ScanRaw { u32x2 rc[2], rp[2], kc[2], kp[2], av[2], lw[2]; u32x4 vc, vp; };
__device__ __forceinline__ void scan_issue(ScanRaw& R, const bf16* ZR, const bf16* A, const bf16* LW, size_t row0, int t0, int st2, int col, int s2, int cv, bool dov) {
#pragma unroll
    for (int u = 0; u < 2; ++u) { const int tt = t0 + st2 + 16 * u; const size_t g = row0 + tt; const size_t gp = row0 + (tt > 0 ? tt - 1 : 0);
        R.rc[u] = *(const u32x2*)(ZR + g * 1792 + col); R.rp[u] = *(const u32x2*)(ZR + gp * 1792 + col);
        R.kc[u] = *(const u32x2*)(ZR + g * 1792 + 512 + col); R.kp[u] = *(const u32x2*)(ZR + gp * 1792 + 512 + col);
        R.av[u] = *(const u32x2*)(A + g * 512 + col); R.lw[u] = *(const u32x2*)(LW + g * 512 + col); }
    { const int tv = t0 + (dov ? s2 : 0); const size_t gv = row0 + tv; const size_t gvp = row0 + (tv > 0 ? tv - 1 : 0); R.vc = *(const u32x4*)(ZR + gv * 1792 + 1024 + cv); R.vp = *(const u32x4*)(ZR + gvp * 1792 + 1024 + cv); }
}
__device__ __forceinline__ void p_scan(const Frame& F, ArgsP a) {
    const int lane_f = lane_id_fresh(), tid_f = F.wave * 64 + lane_f;
    const bf16* ZR = (const bf16*)(F.ws + WS_ZR); const bf16* A = (const bf16*)(F.ws + WS_A); const bf16* LW = (const bf16*)(F.ws + WS_LW); bf16* Y = (bf16*)(F.ws + WS_Y);
    const float* mu = a->in[I_MU]; const float* k_k = a->in[I_KK]; const float* k_a = a->in[I_KA];
    const int lane = lane_f, wave = F.wave, tid = tid_f;
    for (int item = F.vcu; item < 256; item += F.G) {
        const int bh = item >> 2, qt = item & 3, b = bh >> 3, h = bh & 7;
        const size_t row0 = (size_t)b * SEQ; const int colh = h * 64;
        const int NCH = SEQ / SC_T;
        __syncthreads();
        if (wave >= 4) {
            const int lt = tid - 256, st2 = lt >> 4, j4 = (lt & 15) * 4, col = colh + j4, s2 = lt >> 1, hf = lt & 1, cv = colh + qt * 16 + hf * 8; const bool dov = lt < 64;
            f32x4 mur = *(const f32x4*)(mu + col), muk = *(const f32x4*)(mu + 512 + col), kkc = *(const f32x4*)(k_k + col), kac = *(const f32x4*)(k_a + col);
            f32x4 m0 = *(const f32x4*)(mu + 1024 + cv), m1 = *(const f32x4*)(mu + 1024 + cv + 4);
            asm volatile("" : "+v"(mur), "+v"(muk), "+v"(kkc), "+v"(kac), "+v"(m0), "+v"(m1));
            ScanRaw R0, R1;
            scan_issue(R0, ZR, A, LW, row0, 0, st2, col, s2, cv, dov);
#define SCAN_BUILD(RR, c_) do { LAS unsigned char* bs = F.lds + ((c_) & 1) * SC_BUF; \
                _Pragma("unroll") for (int u = 0; u < 2; ++u) { const int st = st2 + 16 * u; const bool t0_ = ((c_) * SC_T + st) == 0; \
                    const f32x4 rc = {lo2f(RR.rc[u].x), hi2f(RR.rc[u].x), lo2f(RR.rc[u].y), hi2f(RR.rc[u].y)}; f32x4 rp = {lo2f(RR.rp[u].x), hi2f(RR.rp[u].x), lo2f(RR.rp[u].y), hi2f(RR.rp[u].y)}; \
                    const f32x4 kc = {lo2f(RR.kc[u].x), hi2f(RR.kc[u].x), lo2f(RR.kc[u].y), hi2f(RR.kc[u].y)}; f32x4 kp = {lo2f(RR.kp[u].x), hi2f(RR.kp[u].x), lo2f(RR.kp[u].y), hi2f(RR.kp[u].y)}; \
                    const f32x4 av = {lo2f(RR.av[u].x), hi2f(RR.av[u].x), lo2f(RR.av[u].y), hi2f(RR.av[u].y)}; const f32x4 lw = {lo2f(RR.lw[u].x), hi2f(RR.lw[u].x), lo2f(RR.lw[u].y), hi2f(RR.lw[u].y)}; \
                    if (t0_) { rp = (f32x4){0.f, 0.f, 0.f, 0.f}; kp = rp; } \
                    const f32x4 r = rc + (rp - rc) * mur, zk = kc + (kp - kc) * muk, kq = zk * ((av - 1.0f) * kac + 1.0f), kr = zk * kkc; \
                    const float ss = allsum16((kr.x * kr.x + kr.y * kr.y) + (kr.z * kr.z + kr.w * kr.w)); const float inv = 1.0f / fmaxf(sqrtf(ss), 1e-12f); \
                    const f32x4 kk = kr * inv; const f32x4 wv = {__expf(lw.x), __expf(lw.y), __expf(lw.z), __expf(lw.w)}; \
                    LAS float* dst = (LAS float*)bs + st * 64 + j4; \
                    *(LAS f32x4*)dst = wv; *(LAS f32x4*)(dst + SC_T * 64) = -kk; *(LAS f32x4*)(dst + 2 * SC_T * 64) = kk * av; *(LAS f32x4*)(dst + 3 * SC_T * 64) = kq; *(LAS f32x4*)(dst + 4 * SC_T * 64) = r; } \
                if (dov) { float vc[8], vp[8]; unpack8(RR.vc, vc); unpack8(RR.vp, vp); if ((c_) * SC_T + s2 == 0) { _Pragma("unroll") for (int i = 0; i < 8; ++i) vp[i] = 0.f; } \
                    LAS float* dv = (LAS float*)(bs + 5 * SC_T * 256) + s2 * 16 + hf * 8; \
                    *(LAS f32x4*)dv = (f32x4){vc[0] + (vp[0] - vc[0]) * m0.x, vc[1] + (vp[1] - vc[1]) * m0.y, vc[2] + (vp[2] - vc[2]) * m0.z, vc[3] + (vp[3] - vc[3]) * m0.w}; \
                    *(LAS f32x4*)(dv + 4) = (f32x4){vc[4] + (vp[4] - vc[4]) * m1.x, vc[5] + (vp[5] - vc[5]) * m1.y, vc[6] + (vp[6] - vc[6]) * m1.z, vc[7] + (vp[7] - vc[7]) * m1.w}; } } while (0)
#define SCAN_FLUSH(c_) do { if ((c_) >= 2 && dov) { LAS unsigned char* bs = F.lds + ((c_) & 1) * SC_BUF; const LAS float* yy = (const LAS float*)(bs + 5 * SC_T * 256 + SC_T * 64) + s2 * 16 + hf * 8; \
                const f32x4 y0 = *(const LAS f32x4*)yy, y1 = *(const LAS f32x4*)(yy + 4); const float v[8] = {y0.x, y0.y, y0.z, y0.w, y1.x, y1.y, y1.z, y1.w}; \
                *(u32x4*)(Y + (row0 + (size_t)((c_) - 2) * SC_T + s2) * 512 + cv) = pack8(v); } } while (0)
            for (int c = 0; c <= NCH + 1; c += 2) {
                SCAN_FLUSH(c);
                scan_issue(R1, ZR, A, LW, row0, (c + 1 < NCH ? c + 1 : NCH - 1) * SC_T, st2, col, s2, cv, dov);
                if (c < NCH) SCAN_BUILD(R0, c);
                LDS_BAR();
                SCAN_FLUSH(c + 1);
                scan_issue(R0, ZR, A, LW, row0, (c + 2 < NCH ? c + 2 : NCH - 1) * SC_T, st2, col, s2, cv, dov);
                if (c + 1 < NCH) SCAN_BUILD(R1, c + 1);
                LDS_BAR();
            }
#undef SCAN_BUILD
#undef SCAN_FLUSH
        } else {
            const int rg = lane >> 4, jl = lane & 15;
            f32x2 Sa = {0.f, 0.f}, Sb = {0.f, 0.f};
            for (int c = 0; c <= NCH + 1; c += 2) {
#pragma unroll
                for (int half = 0; half < 2; ++half) {
                    const int cc = c + half;
                    if (cc >= 1 && cc <= NCH) {
                        LAS unsigned char* bc = F.lds + ((cc + 1) & 1) * SC_BUF;
                        const LAS float* base = (const LAS float*)bc + 4 * jl;
                        const LAS float* vb = (const LAS float*)(bc + 5 * SC_T * 256) + wave * 4 + rg;
                        LAS float* yb = (LAS float*)(bc + 5 * SC_T * 256 + SC_T * 64) + wave * 4 + rg;
                        f32x4 w[2][2], nk[2][2], bb[2][2], kv[2][2], rr[2][2]; float vv1[2][2];
#define SC_LOAD(slot, g_) do { _Pragma("unroll") for (int q = 0; q < 2; ++q) { const int st_ = (g_) * 2 + q; \
                            w[slot][q] = *(const LAS f32x4*)(base + st_ * 64); nk[slot][q] = *(const LAS f32x4*)(base + SC_T * 64 + st_ * 64); bb[slot][q] = *(const LAS f32x4*)(base + 2 * SC_T * 64 + st_ * 64); \
                            kv[slot][q] = *(const LAS f32x4*)(base + 3 * SC_T * 64 + st_ * 64); rr[slot][q] = *(const LAS f32x4*)(base + 4 * SC_T * 64 + st_ * 64); vv1[slot][q] = vb[st_ * 16]; } } while (0)
                        SC_LOAD(0, 0);
#pragma unroll
                        for (int g = 0; g < SC_T / 2; ++g) {
                            const int sl = g & 1;
                            if (g + 1 < SC_T / 2) { if (sl == 0) SC_LOAD(1, g + 1); else SC_LOAD(0, g + 1); }
                            float yo[2];
#pragma unroll
                            for (int q = 0; q < 2; ++q) {
                                const f32x4 w_ = w[sl][q], nk_ = nk[sl][q], bb_ = bb[sl][q], kv_ = kv[sl][q], rr_ = rr[sl][q]; const float v = vv1[sl][q];
                                const f32x2 t0 = Sa * (f32x2){nk_.x, nk_.y} + Sb * (f32x2){nk_.z, nk_.w};
                                const float sa = allsum16(t0.x + t0.y);
                                const f32x2 vv = {v, v}, ss = {sa, sa};
                                Sa = Sa * (f32x2){w_.x, w_.y} + (ss * (f32x2){bb_.x, bb_.y} + vv * (f32x2){kv_.x, kv_.y});
                                Sb = Sb * (f32x2){w_.z, w_.w} + (ss * (f32x2){bb_.z, bb_.w} + vv * (f32x2){kv_.z, kv_.w});
                                const f32x2 t1 = Sa * (f32x2){rr_.x, rr_.y} + Sb * (f32x2){rr_.z, rr_.w};
                                yo[q] = allsum16(t1.x + t1.y);
                            }
                            if (jl == 0) { yb[(g * 2) * 16] = yo[0]; yb[(g * 2 + 1) * 16] = yo[1]; }
                        }
#undef SC_LOAD
                    }
                    LDS_BAR();
                }
            }
        }
    }
}

__device__ __forceinline__ void p_attn_naive(const Frame& F) {
    const int lane_f = lane_id_fresh(), tid_f = F.wave * 64 + lane_f;
    const bf16* Q = (const bf16*)(F.dob + DO_Q); const bf16* KC = (const bf16*)(F.ws + WS_KC); const bf16* VC = (const bf16*)(F.ws + WS_VC); bf16* YM = (bf16*)(F.ws + WS_YM);
    LAS float* Ks = (LAS float*)F.lds; LAS float* Vs = (LAS float*)(F.lds + 32 * 96 * 4);
    const int tid = tid_f;
    for (int unit = F.vcu; unit < 64 * 16; unit += F.G) {
        const int bh = unit >> 4, qb = 15 - (unit & 15), b = bh >> 3, h = bh & 7; const size_t row0 = (size_t)b * SEQ; const int t = qb * 512 + tid;
        unsigned qp[48];
        { const u32x4* qg = (const u32x4*)(Q + (row0 + t) * 768 + h * 96);
#pragma unroll
          for (int i = 0; i < 12; ++i) { const u32x4 w = qg[i]; qp[4 * i] = w.x; qp[4 * i + 1] = w.y; qp[4 * i + 2] = w.z; qp[4 * i + 3] = w.w; } }
        float o[64];
#pragma unroll
        for (int i = 0; i < 64; ++i) o[i] = 0.f;
        float mx = -INFINITY, l = 0.f;
        const int nkt = (qb + 1) * 16;
        for (int kt = 0; kt < nkt; ++kt) {
            __syncthreads();
            if (tid < 384) { const int r = tid / 12, c8 = (tid % 12) * 8; float v[8]; unpack8(*(const u32x4*)(KC + (row0 + kt * 32 + r) * 768 + h * 96 + c8), v);
#pragma unroll
                for (int i = 0; i < 8; ++i) Ks[r * 96 + c8 + i] = v[i]; }
            if (tid < 256) { const int r = tid >> 3, c8 = (tid & 7) * 8; float v[8]; unpack8(*(const u32x4*)(VC + (row0 + kt * 32 + r) * 512 + h * 64 + c8), v);
#pragma unroll
                for (int i = 0; i < 8; ++i) Vs[r * 64 + c8 + i] = v[i]; }
            __syncthreads();
            for (int kk = 0; kk < 32; ++kk) {
                const int kv = kt * 32 + kk;
                float s = 0.f; const LAS f32x4* kr = (const LAS f32x4*)(Ks + kk * 96);
#pragma unroll
                for (int i = 0; i < 24; ++i) { const f32x4 k4 = kr[i]; s += lo2f(qp[2 * i]) * k4.x + hi2f(qp[2 * i]) * k4.y + lo2f(qp[2 * i + 1]) * k4.z + hi2f(qp[2 * i + 1]) * k4.w; }
                if (kv <= t) {
                    const float mn = fmaxf(mx, s), f = exp2f(mx - mn), p = exp2f(s - mn); mx = mn; l = l * f + p;
                    const LAS f32x4* vr = (const LAS f32x4*)(Vs + kk * 64);
#pragma unroll
                    for (int i = 0; i < 16; ++i) { const f32x4 v4 = vr[i]; o[4 * i] = o[4 * i] * f + p * v4.x; o[4 * i + 1] = o[4 * i + 1] * f + p * v4.y; o[4 * i + 2] = o[4 * i + 2] * f + p * v4.z; o[4 * i + 3] = o[4 * i + 3] * f + p * v4.w; }
                }
            }
        }
        const float il = 1.f / l; u32x4* og = (u32x4*)(YM + (row0 + t) * 512 + h * 64);
#pragma unroll
        for (int i = 0; i < 8; ++i) { u32x4 w; w.x = pk2(o[8 * i] * il, o[8 * i + 1] * il); w.y = pk2(o[8 * i + 2] * il, o[8 * i + 3] * il); w.z = pk2(o[8 * i + 4] * il, o[8 * i + 5] * il); w.w = pk2(o[8 * i + 6] * il, o[8 * i + 7] * il); og[i] = w; }
    }
    __syncthreads();
}

typedef float f32x16 __attribute__((ext_vector_type(16)));
typedef short s16x4 __attribute__((ext_vector_type(4)));
__device__ __forceinline__ int crow(int r, int hi) { return (r & 3) + 8 * (r >> 2) + 4 * hi; }
__device__ __forceinline__ float xhalf_max(float x) { auto rr = __builtin_amdgcn_permlane32_swap(__float_as_uint(x), __float_as_uint(x), false, false); return fmaxf(__uint_as_float(rr[0]), __uint_as_float(rr[1])); }
__device__ __forceinline__ float xhalf_sum(float x) { auto rr = __builtin_amdgcn_permlane32_swap(__float_as_uint(x), __float_as_uint(x), false, false); return __uint_as_float(rr[0]) + __uint_as_float(rr[1]); }
__device__ __forceinline__ bf16x8 packp(const f32x16& p, int s2) {
    u32x4 w; w.x = pk2(p[8 * s2 + 0], p[8 * s2 + 1]); w.y = pk2(p[8 * s2 + 2], p[8 * s2 + 3]); w.z = pk2(p[8 * s2 + 4], p[8 * s2 + 5]); w.w = pk2(p[8 * s2 + 6], p[8 * s2 + 7]);
    return __builtin_bit_cast(bf16x8, w);
}
__device__ __forceinline__ void p_attn_mfma(const Frame& F) {
    const int lane_f = lane_id_fresh(), tid_f = F.wave * 64 + lane_f;
    const bf16* Q = (const bf16*)(F.dob + DO_Q); const bf16* KC = (const bf16*)(F.ws + WS_KC); const bf16* VC = (const bf16*)(F.ws + WS_VC); bf16* YM = (bf16*)(F.ws + WS_YM);
    constexpr int KST = 208, VST = 192, KBYTES = 64 * KST, BUF = KBYTES + 64 * VST;
    const int tid = tid_f, lane = lane_f, wave = F.wave, r = lane & 31, hi = lane >> 5;
    const int kr0 = tid / 12, kp0 = tid % 12, kr1 = (tid + 512) / 12, kp1 = (tid + 512) % 12, vr = tid >> 3, vp = tid & 7;
    const int g4 = lane >> 4, li = lane & 15;
    const int vtr = (4 * (g4 >> 1) + (li >> 2)) * VST + (16 * (g4 & 1) + 4 * (li & 3)) * 2;
    const int kfr = r * KST + hi * 16;
    LAS unsigned char* lds = F.lds;
    for (int item = F.vcu; item < 1024; item += F.G) {
        const int bh = item >> 4, sidx = item & 15, b = bh >> 3, h = bh & 7; const size_t row0 = (size_t)b * SEQ;
        const bf16* Kg = KC + row0 * 768 + h * 96; const bf16* Vg = VC + row0 * 512 + h * 64;
        for (int uu = 0; uu < 2; ++uu) {
            const int qb = uu == 0 ? 31 - sidx : sidx, q0 = qb * 256, NT = (q0 + 256) / 64;
            const int qw = q0 + wave * 32;
            bf16x8 qf[6];
            { const bf16* qp = Q + (row0 + qw + r) * 768 + h * 96 + hi * 8;
#pragma unroll
              for (int s = 0; s < 6; ++s) qf[s] = *(const bf16x8*)(qp + 16 * s);
              asm volatile("" : "+v"(qf[0]), "+v"(qf[1]), "+v"(qf[2]), "+v"(qf[3]), "+v"(qf[4]), "+v"(qf[5])); }
            f32x16 o0 = {}, o1 = {}; float m = -INFINITY, l = 0.f;
            __syncthreads();
            { const u32x4 a0 = *(const u32x4*)(Kg + (size_t)kr0 * 768 + kp0 * 8); u32x4 a1 = {}; if (tid < 256) a1 = *(const u32x4*)(Kg + (size_t)kr1 * 768 + kp1 * 8);
              const u32x4 a2 = *(const u32x4*)(Vg + (size_t)vr * 512 + vp * 8);
              *(LAS u32x4*)(lds + kr0 * KST + kp0 * 16) = a0; if (tid < 256) *(LAS u32x4*)(lds + kr1 * KST + kp1 * 16) = a1; *(LAS u32x4*)(lds + KBYTES + vr * VST + vp * 16) = a2; }
            __syncthreads();
            for (int t = 0; t < NT; ++t) {
                LAS unsigned char* kb = lds + (t & 1) * BUF; LAS unsigned char* vb = kb + KBYTES;
                u32x4 a0 = {}, a1 = {}, a2 = {};
                const bool more = (t + 1 < NT);
                if (more) { const bf16* kg = Kg + (size_t)(t + 1) * 64 * 768; const bf16* vg = Vg + (size_t)(t + 1) * 64 * 512;
                    a0 = *(const u32x4*)(kg + (size_t)kr0 * 768 + kp0 * 8); if (tid < 256) a1 = *(const u32x4*)(kg + (size_t)kr1 * 768 + kp1 * 8); a2 = *(const u32x4*)(vg + (size_t)vr * 512 + vp * 8); }
                if (64 * t <= qw + 31) {
                    f32x16 p0 = {}, p1 = {};
#pragma unroll
                    for (int s = 0; s < 6; ++s) { const bf16x8 k0 = *(const LAS bf16x8*)(kb + kfr + s * 32), k1 = *(const LAS bf16x8*)(kb + kfr + 32 * KST + s * 32);
                        p0 = __builtin_amdgcn_mfma_f32_32x32x16_bf16(k0, qf[s], p0, 0, 0, 0); p1 = __builtin_amdgcn_mfma_f32_32x32x16_bf16(k1, qf[s], p1, 0, 0, 0); }
                    if (64 * t + 63 > qw) {
                        const int qrel = qw + r - 64 * t;
#pragma unroll
                        for (int rg = 0; rg < 16; ++rg) { const int kv = crow(rg, hi); if (kv > qrel) p0[rg] = -INFINITY; if (kv + 32 > qrel) p1[rg] = -INFINITY; }
                    }
                    float mx = fmaxf(p0[0], p1[0]);
#pragma unroll
                    for (int rg = 1; rg < 16; ++rg) mx = fmaxf(mx, fmaxf(p0[rg], p1[rg]));
                    mx = xhalf_max(mx);
                    const float mn = fmaxf(m, mx), f = __builtin_amdgcn_exp2f(m - mn); m = mn;
                    float rs = 0.f;
#pragma unroll
                    for (int rg = 0; rg < 16; ++rg) { p0[rg] = __builtin_amdgcn_exp2f(p0[rg] - mn); p1[rg] = __builtin_amdgcn_exp2f(p1[rg] - mn); rs += p0[rg] + p1[rg]; }
                    l = l * f + rs;
#pragma unroll
                    for (int rg = 0; rg < 16; ++rg) { o0[rg] *= f; o1[rg] *= f; }
#pragma unroll
                    for (int hh = 0; hh < 2; ++hh)
#pragma unroll
                        for (int s2 = 0; s2 < 2; ++s2) { const bf16x8 pf = packp(hh == 0 ? p0 : p1, s2);
#pragma unroll
                            for (int db = 0; db < 2; ++db) { LAS unsigned char* vp_ = vb + vtr + (32 * hh + 16 * s2) * VST + db * 64;
                                const s16x4 lo = __builtin_bit_cast(s16x4, __builtin_amdgcn_ds_read_tr16_b64_v4i16((LAS s16x4*)vp_));
                                const s16x4 hi4 = __builtin_bit_cast(s16x4, __builtin_amdgcn_ds_read_tr16_b64_v4i16((LAS s16x4*)(vp_ + 8 * VST)));
                                const bf16x8 vf = (bf16x8){lo[0], lo[1], lo[2], lo[3], hi4[0], hi4[1], hi4[2], hi4[3]};
                                if (db == 0) o0 = __builtin_amdgcn_mfma_f32_32x32x16_bf16(vf, pf, o0, 0, 0, 0); else o1 = __builtin_amdgcn_mfma_f32_32x32x16_bf16(vf, pf, o1, 0, 0, 0); } }
                }
                if (more) { LAS unsigned char* nb = lds + ((t + 1) & 1) * BUF;
                    *(LAS u32x4*)(nb + kr0 * KST + kp0 * 16) = a0; if (tid < 256) *(LAS u32x4*)(nb + kr1 * KST + kp1 * 16) = a1; *(LAS u32x4*)(nb + KBYTES + vr * VST + vp * 16) = a2; }
                __syncthreads();
            }
            const float il = 1.0f / xhalf_sum(l);
            bf16* op = YM + (row0 + qw + r) * 512 + h * 64 + 4 * hi;
#pragma unroll
            for (int gq = 0; gq < 4; ++gq) { u32x2 w0, w1;
                w0.x = pk2(o0[4 * gq] * il, o0[4 * gq + 1] * il); w0.y = pk2(o0[4 * gq + 2] * il, o0[4 * gq + 3] * il);
                w1.x = pk2(o1[4 * gq] * il, o1[4 * gq + 1] * il); w1.y = pk2(o1[4 * gq + 2] * il, o1[4 * gq + 3] * il);
                *(u32x2*)(op + 8 * gq) = w0; *(u32x2*)(op + 32 + 8 * gq) = w1; }
        }
    }
    __syncthreads();
}

__device__ __forceinline__ void p_post_scan(const Frame& F, ArgsP a, bf16* YD) {
    const int lane_f = lane_id_fresh();
    bf16* Y = (bf16*)(F.ws + WS_Y); const bf16* ZR = (const bf16*)(F.ws + WS_ZR); const bf16* A = (const bf16*)(F.ws + WS_A); const bf16* G = (const bf16*)(F.dob + DO_G);
    const float* lnw = a->in[I_LNW]; const float* lnb = a->in[I_LNB]; const float* rk = a->in[I_RK]; const float* mu = a->in[I_MU]; const float* k_a = a->in[I_KA];
    const int lane = lane_f;
    for (int m = F.gw; m < NTOK; m += F.NGW) {
        const bool first = (m % SEQ) == 0; const size_t mp = first ? m : m - 1;
        float y[8], r[8], k[8], v[8], g[8], o[8], t[8], av[8];
        unpack8(*((const u32x4*)(Y + (size_t)m * 512) + lane), y); unpack8(*((const u32x4*)(G + (size_t)m * 512) + lane), g); unpack8(*((const u32x4*)(A + (size_t)m * 512) + lane), av);
        unpack8(*((const u32x4*)(ZR + (size_t)m * 1792) + lane), r); unpack8(*((const u32x4*)(ZR + mp * 1792) + lane), t);
#pragma unroll
        for (int i = 0; i < 8; ++i) r[i] += ((first ? 0.f : t[i]) - r[i]) * mu[8 * lane + i];
        unpack8(*((const u32x4*)(ZR + (size_t)m * 1792 + 512) + lane), k); unpack8(*((const u32x4*)(ZR + mp * 1792 + 512) + lane), t);
#pragma unroll
        for (int i = 0; i < 8; ++i) { const float zk = k[i] + ((first ? 0.f : t[i]) - k[i]) * mu[512 + 8 * lane + i]; k[i] = zk * (1.f + (av[i] - 1.f) * k_a[8 * lane + i]); }
        unpack8(*((const u32x4*)(ZR + (size_t)m * 1792 + 1024) + lane), v); unpack8(*((const u32x4*)(ZR + mp * 1792 + 1024) + lane), t);
#pragma unroll
        for (int i = 0; i < 8; ++i) v[i] += ((first ? 0.f : t[i]) - v[i]) * mu[1024 + 8 * lane + i];
        float s = 0.f, d = 0.f;
#pragma unroll
        for (int i = 0; i < 8; ++i) { s += y[i]; d += r[i] * k[i] * rk[8 * lane + i]; }
        const float mean = sum8(s) * (1.f / 64.f); d = sum8(d); float q = 0.f;
#pragma unroll
        for (int i = 0; i < 8; ++i) { y[i] -= mean; q += y[i] * y[i]; }
        const float rstd = 1.0f / sqrtf(sum8(q) * (1.f / 64.f) + LN_X_EPS);
#pragma unroll
        for (int i = 0; i < 8; ++i) o[i] = (y[i] * rstd * lnw[8 * lane + i] + lnb[8 * lane + i] + d * v[i]) * g[i];
        *((u32x4*)(YD + (size_t)m * 512) + lane) = pack8(o);
    }
}

__device__ __forceinline__ void p_ffn_route(const Frame& F, ArgsP a, unsigned* cnt, int* route) {
    const int lane_f = lane_id_fresh(), tid_f = F.wave * 64 + lane_f;
    const float* X1 = (const float*)F.dob; bf16* H2 = (bf16*)(F.ws + WS_H2); const float* mod = (const float*)(F.ws + WS_MOD); const float* g = a->in[I_GFFN];
    LAS float* wr = (LAS float*)F.lds;
    __syncthreads();
    for (int i = tid_f; i < 1024 * 4; i += NTHR) { const int k = i >> 2, o = i & 3; wr[o * 1024 + k] = a->in[I_WRG][i]; }
    for (int i = tid_f; i < 1024 * 32; i += NTHR) { const int k = i >> 5, o = i & 31; wr[(4 + o) * 1024 + k] = a->in[I_WRE][i]; }
    __syncthreads();
    const float* brg = a->in[I_BRG]; const float* bre = a->in[I_BRE];
    const int lane = lane_f;
    LAS unsigned* lcnt = (LAS unsigned*)(F.lds + LDS_MISC + 512);
    if (tid_f < 64) lcnt[tid_f] = 0u;
    __syncthreads();
    int my_e0 = 0, my_e1 = 0; float my_w0 = 0.f, my_w1 = 0.f; int kk_ = 0;
    for (int m = F.gw; m < NTOK; m += F.NGW, ++kk_) {
        const int b = m / SEQ; const f32x4* xr = (const f32x4*)(X1 + (size_t)m * 1024) + lane;
        f32x4 v[4]; float s = 0.f;
#pragma unroll
        for (int j = 0; j < 4; ++j) { v[j] = xr[64 * j]; s += (v[j].x * v[j].x + v[j].y * v[j].y) + (v[j].z * v[j].z + v[j].w * v[j].w); }
        const float rstd = 1.0f / sqrtf(wave_sum(s) * (1.f / 1024.f) + EPS);
        u32x2* o = (u32x2*)(H2 + (size_t)m * 1024) + lane;
#pragma unroll
        for (int j = 0; j < 4; ++j) { const int col = 4 * lane + 256 * j;
            const f32x4 gg = *(const f32x4*)(g + col), sc = *(const f32x4*)(mod + b * 6144 + 4096 + col), sh = *(const f32x4*)(mod + b * 6144 + 3072 + col);
            v[j] = v[j] * rstd * gg * (sc + 1.0f) + sh; u32x2 w; w.x = pk2(v[j].x, v[j].y); w.y = pk2(v[j].z, v[j].w); o[64 * j] = w; }
        float lgq[4];
#pragma unroll
        for (int oo = 0; oo < 4; ++oo) { float p = 0.f;
#pragma unroll
            for (int j = 0; j < 4; ++j) { const f32x4 w4 = *(const LAS f32x4*)(wr + oo * 1024 + 4 * lane + 256 * j); p += (v[j].x * w4.x + v[j].y * w4.y) + (v[j].z * w4.z + v[j].w * w4.w); }
            lgq[oo] = wave_sum(p) + brg[oo]; }
        int gi = 0; float gm = lgq[0];
#pragma unroll
        for (int i = 1; i < 4; ++i) { if (lgq[i] > gm) { gm = lgq[i]; gi = i; } }
        float gs = 0.f;
#pragma unroll
        for (int i = 0; i < 4; ++i) gs += __expf(lgq[i] - gm);
        const float pg = 1.f / gs;
        gi = __builtin_amdgcn_readfirstlane(gi);
        float el[8];
        { const LAS float* wg = wr + (4 + gi * 8) * 1024 + 4 * lane;
#pragma unroll
          for (int i = 0; i < 8; ++i) { float p = 0.f;
#pragma unroll
              for (int j = 0; j < 4; ++j) { const f32x4 w4 = *(const LAS f32x4*)(wg + i * 1024 + 256 * j); p += (v[j].x * w4.x + v[j].y * w4.y) + (v[j].z * w4.z + v[j].w * w4.w); }
              el[i] = wave_sum(p) + bre[gi * 8 + i]; } }
        int i0 = 0; float m0 = el[0];
#pragma unroll
        for (int i = 1; i < 8; ++i) if (el[i] > m0) { m0 = el[i]; i0 = i; }
        int i1 = -1; float m1 = -INFINITY;
#pragma unroll
        for (int i = 0; i < 8; ++i) if (i != i0 && el[i] > m1) { m1 = el[i]; i1 = i; }
        const float e1 = __expf(m1 - m0), w0 = pg / (1.f + e1), w1 = pg * e1 / (1.f + e1);
        if (lane == kk_) { my_e0 = gi * 8 + i0; my_e1 = gi * 8 + i1; my_w0 = w0; my_w1 = w1; }
    }
    unsigned lp0 = 0u, lp1 = 0u;
    if (lane < kk_) { lp0 = __hip_atomic_fetch_add(lcnt + my_e0, 1u, __ATOMIC_RELAXED, __HIP_MEMORY_SCOPE_WORKGROUP); lp1 = __hip_atomic_fetch_add(lcnt + my_e1, 1u, __ATOMIC_RELAXED, __HIP_MEMORY_SCOPE_WORKGROUP); }
    __syncthreads();
    if (tid_f < 32) lcnt[32 + tid_f] = __hip_atomic_fetch_add(cnt + tid_f, lcnt[tid_f], __ATOMIC_RELAXED, __HIP_MEMORY_SCOPE_AGENT);
    __syncthreads();
    if (lane < kk_) { const int m = F.gw + lane * F.NGW; int* rt = route + (size_t)m * 8;
        rt[0] = my_e0; rt[1] = my_e1; rt[2] = (int)(lcnt[32 + my_e0] + lp0); rt[3] = (int)(lcnt[32 + my_e1] + lp1); rt[4] = __builtin_bit_cast(int, my_w0); rt[5] = __builtin_bit_cast(int, my_w1); }
    __syncthreads();
}
__device__ __forceinline__ int moe_tables(const Frame& F, LAS int* offs, LAS int* texp) {
    const int lane_f = lane_id_fresh(), tid_f = F.wave * 64 + lane_f;
    const unsigned* cnt = (const unsigned*)(F.ws + WS_CTL) + CW_CNT;
    __syncthreads();
    if (tid_f == 0) { int o = 0; for (int e = 0; e < 32; ++e) { offs[e] = o; const int c = (int)__hip_atomic_load(cnt + e, __ATOMIC_RELAXED, __HIP_MEMORY_SCOPE_AGENT); const int nt = (c + 255) >> 8; for (int t = 0; t < nt; ++t) texp[(o >> 8) + t] = e; o += nt << 8; } offs[32] = o; }
    __syncthreads();
    return offs[32] >> 8;
}
__device__ __forceinline__ void p_gather(const Frame& F) {
    const int lane_f = lane_id_fresh(), tid_f = F.wave * 64 + lane_f;
    LAS int* offs = (LAS int*)(F.lds + 1024); LAS int* texp = (LAS int*)(F.lds + 2048);
    moe_tables(F, offs, texp);
    const bf16* H2 = (const bf16*)(F.ws + WS_H2); bf16* XG = (bf16*)(F.ws + WS_XG); const int* route = (const int*)(F.ws + WS_ROUTE); int* ent = (int*)(F.ws + WS_ENT);
    const unsigned* cnt = (const unsigned*)(F.ws + WS_CTL) + CW_CNT; const int lane = lane_f;
    for (int m = F.gw; m < NTOK; m += F.NGW) {
        const int* rt = route + (size_t)m * 8; const int d0 = offs[rt[0]] + rt[2], d1 = offs[rt[1]] + rt[3];
        const u32x4* src = (const u32x4*)(H2 + (size_t)m * 1024) + lane; const u32x4 a0 = src[0], a1 = src[64];
        u32x4* p0 = (u32x4*)(XG + (size_t)d0 * 1024) + lane; u32x4* p1 = (u32x4*)(XG + (size_t)d1 * 1024) + lane;
        p0[0] = a0; p0[64] = a1; p1[0] = a0; p1[64] = a1;
        if (lane == 0) { ent[2 * d0] = m; ent[2 * d0 + 1] = rt[4]; ent[2 * d1] = m; ent[2 * d1 + 1] = rt[5]; }
    }
    for (int i = F.gw; i < 32 * 256; i += F.NGW) { const int e = i >> 8, r = i & 255; const int c = (int)cnt[e]; const int pad = ((c + 255) & ~255) - c;
        if (r < pad) { u32x4* p = (u32x4*)(XG + (size_t)(offs[e] + c + r) * 1024) + lane; p[0] = (u32x4){0u, 0u, 0u, 0u}; p[64] = (u32x4){0u, 0u, 0u, 0u}; if (lane == 0) { ent[2 * (offs[e] + c + r)] = -1; ent[2 * (offs[e] + c + r) + 1] = 0; } } }
    __syncthreads();
}
__device__ __forceinline__ void p_combine(const Frame& F, float* dst) {
    const int lane_f = lane_id_fresh(), tid_f = F.wave * 64 + lane_f;
    LAS int* offs = (LAS int*)(F.lds + 1024); LAS int* texp = (LAS int*)(F.lds + 2048);
    moe_tables(F, offs, texp);
    float* out = (float*)F.dob; const bf16* YS = (const bf16*)(F.ws + WS_YS); const int* route = (const int*)(F.ws + WS_ROUTE); const float* mod = (const float*)(F.ws + WS_MOD);
    const int lane = lane_f;
    for (int m = F.gw; m < NTOK; m += F.NGW) {
        const int b = m / SEQ; const int* rt = route + (size_t)m * 8; const int d0 = offs[rt[0]] + rt[2], d1 = offs[rt[1]] + rt[3];
        const float w0 = __builtin_bit_cast(float, rt[4]), w1 = __builtin_bit_cast(float, rt[5]);
#pragma unroll
        for (int j = 0; j < 2; ++j) { const int col = 8 * lane + 512 * j; float y0[8], y1[8];
            unpack8(*(const u32x4*)(YS + (size_t)d0 * 1024 + col), y0); unpack8(*(const u32x4*)(YS + (size_t)d1 * 1024 + col), y1);
            float* o = out + (size_t)m * 1024 + col; const float* gt = mod + b * 6144 + 5120 + col;
            f32x4 x0 = *(const f32x4*)o, x1 = *(const f32x4*)(o + 4); const f32x4 g0 = *(const f32x4*)gt, g1 = *(const f32x4*)(gt + 4);
            x0.x += g0.x * (w0 * y0[0] + w1 * y1[0]); x0.y += g0.y * (w0 * y0[1] + w1 * y1[1]); x0.z += g0.z * (w0 * y0[2] + w1 * y1[2]); x0.w += g0.w * (w0 * y0[3] + w1 * y1[3]);
            x1.x += g1.x * (w0 * y0[4] + w1 * y1[4]); x1.y += g1.y * (w0 * y0[5] + w1 * y1[5]); x1.z += g1.z * (w0 * y0[6] + w1 * y1[6]); x1.w += g1.w * (w0 * y0[7] + w1 * y1[7]);
            float* od = dst + (size_t)m * 1024 + col; *(f32x4*)od = x0; *(f32x4*)(od + 4) = x1; }
    }
}

constexpr int NPHASE = 16;
template <int LO, int HI>
__global__ void __launch_bounds__(NTHR, 2) fwd(Args args) {
    extern __shared__ __attribute__((aligned(16))) unsigned char lds_raw[];
    Frame F;
    F.lds = (LAS unsigned char*)lds_raw;
    F.wave = __builtin_amdgcn_readfirstlane((int)threadIdx.x >> 6);
    F.G = gridDim.x; { const int bx = blockIdx.x; F.vcu = (F.G % 8 == 0) ? (bx % 8) * (F.G / 8) + bx / 8 : bx; }
    F.gw = F.vcu * NWAVES + F.wave; F.NGW = F.G * NWAVES;
    F.ws = args.ws; F.dob = (unsigned char*)args.out;
    ArgsP AP = (ArgsP)__builtin_amdgcn_kernarg_segment_ptr();
    volatile LAS unsigned* MISC = (volatile LAS unsigned*)(F.lds + LDS_MISC);
    if (threadIdx.x < 64) MISC[threadIdx.x] = 0u;
    __syncthreads();
    XcdBarrier bar; bar.bar = (unsigned*)(F.ws + WS_CTL) + CW_BAR; bar.x = 0; bar.st = MISC + 8;
#if N_LAUNCH_MODE == 1
    bar = xcd_barrier_post((unsigned*)(F.ws + WS_CTL) + CW_BAR, MISC + 8);
#define GRID_BAR() xcd_barrier(bar)
#else
#define GRID_BAR() do { } while (0)
#endif
#ifndef PROBE_REPEAT
#define PROBE_REPEAT -1
#endif
#define IN(k) (LO <= (k) && (k) < HI)
#define SEAM(k) do { if constexpr (IN(k) && IN((k) + 1)) GRID_BAR(); } while (0)
    const float* mod = (const float*)(F.ws + WS_MOD);

#define PH(k, ...) do { if constexpr (IN(k)) { asm volatile("" : "+s"(AP)); { __VA_ARGS__ } if constexpr (PROBE_REPEAT == (k)) { GRID_BAR(); asm volatile("" : "+s"(AP)); { __VA_ARGS__ } } } } while (0)
    PH(0, p0_prologue(F, AP);); SEAM(0);
    PH(1, p_normmod(F, AP->in[I_X], AP->in[I_GMIX], mod, 0, 1024, (bf16*)(F.ws + WS_H));); SEAM(1);
    PH(2, Gemm g{(const bf16*)(F.ws + WS_H), (const bf16*)(F.ws + WS_WIN), NTOK, N_IN_PAD, 1024}; StaticOrder S; S.init(NTOK, N_IN_PAD, F.G, (int)blockIdx.x);
        EpiZ E{(bf16*)(F.ws + WS_ZR), (bf16*)(F.ws + WS_SG), (bf16*)(F.ws + WS_ZM)}; gemm_phase_any(F.lds, g, S, E, F.wave);); SEAM(2);
    PH(3, p_prep_a(F, AP);); SEAM(3);
    PH(4,
        { Gemm g{(const bf16*)(F.ws + WS_TWA), (const bf16*)(F.ws + WS_WBLK), NTOK, 1024, 128}; StaticOrder S; S.init(NTOK, 1024, F.G, (int)blockIdx.x);
          EpiLora E{(bf16*)(F.ws + WS_LW), (bf16*)(F.ws + WS_A), AP->in[I_W0], AP->in[I_A0]}; gemm_phase_any(F.lds, g, S, E, F.wave); }
        { Gemm g{(const bf16*)(F.ws + WS_SGL), (const bf16*)(F.ws + WS_WG), NTOK, 512, 128}; StaticOrder S; S.init(NTOK, 512, F.G, (int)blockIdx.x);
          EpiPlain E{(bf16*)(F.dob + DO_G), nullptr, 1 << 30, 512, 0}; gemm_phase_any(F.lds, g, S, E, F.wave); }
        { Gemm g{(const bf16*)(F.ws + WS_QA), (const bf16*)(F.ws + WS_WUQ), NTOK, 768, 256}; StaticOrder S; S.init(NTOK, 768, F.G, (int)blockIdx.x);
          EpiPlain E{(bf16*)(F.dob + DO_Q), nullptr, 1 << 30, 768, 0}; gemm_phase_any(F.lds, g, S, E, F.wave); }
        { Gemm g{(const bf16*)(F.ws + WS_KVA), (const bf16*)(F.ws + WS_WUKV), NTOK, 1024, 128}; StaticOrder S; S.init(NTOK, 1024, F.G, (int)blockIdx.x);
          EpiPlain E{(bf16*)(F.dob + DO_KN), (bf16*)(F.ws + WS_VC), 512, 512, 512}; gemm_phase_any(F.lds, g, S, E, F.wave); }
    ); SEAM(4);
    PH(5, p_prep_c(F, AP);); SEAM(5);
    PH(6, p_scan(F, AP);); SEAM(6);
#if ENG_ATTN == 1
    PH(7, p_attn_mfma(F);); SEAM(7);
#else
    PH(7, p_attn_naive(F);); SEAM(7);
#endif
    if constexpr (PROBE_REPEAT == 8) { p_post_scan(F, AP, (bf16*)(F.ws + WS_KK)); GRID_BAR(); }
    if constexpr (IN(8)) { asm volatile("" : "+s"(AP)); p_post_scan(F, AP, (bf16*)(F.ws + WS_Y)); } SEAM(8);
    PH(9,
        { Gemm g{(const bf16*)(F.ws + WS_Y), (const bf16*)(F.ws + WS_WB), NTOK, 1024, 512}; StaticOrder S; S.init(NTOK, 1024, F.G, (int)blockIdx.x);
          EpiBranch<false> E{(bf16*)(F.ws + WS_MG), (const bf16*)(F.ws + WS_SG), 0}; gemm_phase_any(F.lds, g, S, E, F.wave); }
        { Gemm g{(const bf16*)(F.ws + WS_YM), (const bf16*)(F.ws + WS_WB) + (size_t)1024 * 512, NTOK, 1024, 512}; StaticOrder S; S.init(NTOK, 1024, F.G, (int)blockIdx.x);
          EpiBranch<true> E{(bf16*)(F.ws + WS_MG), (const bf16*)(F.ws + WS_SG), 1024}; gemm_phase_any(F.lds, g, S, E, F.wave); }
    ); SEAM(9);
    PH(10, Gemm g{(const bf16*)(F.ws + WS_MG), (const bf16*)(F.ws + WS_WO), NTOK, 1024, 1024}; StaticOrder S; S.init(NTOK, 1024, F.G, (int)blockIdx.x);
        EpiOut E{(float*)F.dob, AP->in[I_X], mod}; gemm_phase_any(F.lds, g, S, E, F.wave);); SEAM(10);
    if constexpr (PROBE_REPEAT == 11) { p_ffn_route(F, AP, (unsigned*)(F.ws + WS_CTL) + CW_CNT + 64, (int*)(F.ws + WS_CS)); GRID_BAR(); }
    if constexpr (IN(11)) { asm volatile("" : "+s"(AP)); p_ffn_route(F, AP, (unsigned*)(F.ws + WS_CTL) + CW_CNT, (int*)(F.ws + WS_ROUTE)); } SEAM(11);
    PH(12, p_gather(F);); SEAM(12);
    PH(13, LAS int* offs = (LAS int*)(F.lds + LDS_MISC + 1024); LAS int* texp = (LAS int*)(F.lds + LDS_MISC + 1024 + 256); const int nt = moe_tables(F, offs, texp);
        Gemm g{(const bf16*)(F.ws + WS_XG), (const bf16*)(F.ws + WS_WGU), MPAD, 512, 1024}; TableOrder S{texp, nt, 2, F.G, (int)blockIdx.x};
        EpiGateUp E{(bf16*)(F.ws + WS_HID)}; gemm_phase_any(F.lds, g, S, E, F.wave);); SEAM(13);
    PH(14, LAS int* offs = (LAS int*)(F.lds + LDS_MISC + 1024); LAS int* texp = (LAS int*)(F.lds + LDS_MISC + 1024 + 256); const int nt = moe_tables(F, offs, texp);
        Gemm g{(const bf16*)(F.ws + WS_HID), (const bf16*)(F.ws + WS_WDN), MPAD, 1024, 256}; TableOrder S{texp, nt, 4, F.G, (int)blockIdx.x};
        EpiDown E{(bf16*)(F.ws + WS_YS)}; gemm_phase_any(F.lds, g, S, E, F.wave);); SEAM(14);
    if constexpr (PROBE_REPEAT == 15) { p_combine(F, (float*)(F.ws + WS_SG)); GRID_BAR(); }
    if constexpr (IN(15)) { p_combine(F, (float*)F.dob); }
}

#if N_LAUNCH_MODE == 1
static bool set_attrs() { return hipFuncSetAttribute((const void*)fwd<0, NPHASE>, hipFuncAttributeMaxDynamicSharedMemorySize, LDS_BYTES) == hipSuccess; }
#else
template <int P> static bool set_attr_all() { if constexpr (P < NPHASE) { return hipFuncSetAttribute((const void*)fwd<P, P + 1>, hipFuncAttributeMaxDynamicSharedMemorySize, LDS_BYTES) == hipSuccess && set_attr_all<P + 1>(); } else return true; }
static bool set_attrs() { return set_attr_all<0>(); }
template <int P> static void launch_all(int grid, hipStream_t stream, const Args& a) { if constexpr (P < NPHASE) { hipLaunchKernelGGL((fwd<P, P + 1>), dim3(grid), dim3(NTHR), LDS_BYTES, stream, a); launch_all<P + 1>(grid, stream, a); } }
#endif
extern "C" void kernel_launch(void* const* d_in, const int* in_sizes, int n_in, void* d_out, int out_size, void* d_ws, size_t ws_size, hipStream_t stream) {
    static int grid = 0;
    if (grid == 0) {
        if (n_in != 34 || out_size != NTOK * DM || ws_size < WS_END) { fprintf(stderr, "kernel_launch: unexpected shapes (n_in %d out %d ws %zu)\n", n_in, out_size, ws_size); grid = -1; return; }
        int dev = 0, cus = 0;
        if (hipGetDevice(&dev) != hipSuccess || hipDeviceGetAttribute(&cus, hipDeviceAttributeMultiprocessorCount, dev) != hipSuccess) { grid = -1; return; }
        if (!set_attrs()) { fprintf(stderr, "kernel_launch: hipFuncSetAttribute failed\n"); grid = -1; return; }
        grid = cus;
    }
    if (grid < 0) return;
    (void)hipMemsetAsync((char*)d_ws + WS_CTL, 0, CTL_ZERO_BYTES, stream);
    Args a{};
    for (int i = 0; i < 34; ++i) a.in[i] = (const float*)d_in[i];
    a.out = (float*)d_out; a.ws = (unsigned char*)d_ws;
    a.ph_lo = 0; a.ph_hi = NPHASE;
#if N_LAUNCH_MODE == 1
    hipLaunchKernelGGL((fwd<0, NPHASE>), dim3(grid), dim3(NTHR), LDS_BYTES, stream, a);
#else
    launch_all<0>(grid, stream, a);
#endif
}
```

```cpp
#include <hip/hip_runtime.h>
#include <cstdio>
#include <cstdint>

#ifndef N_LAUNCH_MODE
#define N_LAUNCH_MODE 1
#endif
#ifndef ENG_GEMM
#define ENG_GEMM 1
#endif
#ifndef ENG_ATTN
#define ENG_ATTN 1
#endif

#define GAS __attribute__((address_space(1)))
#define LAS __attribute__((address_space(3)))
typedef unsigned short bf16;
typedef float f32x4 __attribute__((ext_vector_type(4)));
typedef float f32x2 __attribute__((ext_vector_type(2)));
typedef unsigned u32x4 __attribute__((ext_vector_type(4)));
typedef unsigned u32x2 __attribute__((ext_vector_type(2)));
typedef short bf16x8 __attribute__((ext_vector_type(8)));

constexpr int BATCH = 8, SEQ = 8192, DM = 1024, NTOK = BATCH * SEQ;
constexpr int D_RWKV = 512, RWKV_COLS = 1792, MLA_COLS = 416, D_IN = 4256, N_IN_PAD = 4352;
constexpr int NH = 8, QKD = 96, NOPE = 64, ROPE = 32, VD = 64;
constexpr int NEXP = 32, DEXP = 256;
constexpr int MPAD = 139264;
constexpr float EPS = 1e-6f, LN_X_EPS = 64e-5f;
constexpr float QSCALE = 0.10206207261596577f * 1.4426950408889634f;

constexpr size_t MiB = 1u << 20;
constexpr size_t WS_CTL = 0, CTL_ZERO_BYTES = 1 * MiB;
constexpr size_t WS_MOD = 1 * MiB;
constexpr size_t WS_ROUTE = 2 * MiB;
constexpr size_t WS_CS = 4 * MiB;
constexpr size_t WS_ENT = 12 * MiB;
constexpr size_t WS_WIN = 16 * MiB;
constexpr size_t WS_WBLK = 25 * MiB;
constexpr size_t WS_WG = WS_WBLK + 256 * 1024;
constexpr size_t WS_WUQ = WS_WG + 128 * 1024;
constexpr size_t WS_WUKV = WS_WUQ + 384 * 1024;
constexpr size_t WS_WB = 26 * MiB;
constexpr size_t WS_WO = 28 * MiB;
constexpr size_t WS_WGU = 30 * MiB;
constexpr size_t WS_WDN = 62 * MiB;
constexpr size_t WS_SG = 80 * MiB;
constexpr size_t WS_H2 = 80 * MiB;
constexpr size_t WS_ZR = 336 * MiB;
constexpr size_t WS_VC = 752 * MiB;
constexpr size_t WS_KC = 816 * MiB;
constexpr size_t WS_Y = 912 * MiB;
constexpr size_t WS_XG = 336 * MiB;
constexpr size_t WS_ZM = 560 * MiB;
constexpr size_t WS_YM = 560 * MiB;
constexpr size_t WS_H = 624 * MiB;
constexpr size_t WS_LW = 624 * MiB;
constexpr size_t WS_A = 688 * MiB;
constexpr size_t WS_MG = 624 * MiB;
constexpr size_t WS_HID = 608 * MiB;
constexpr size_t WS_R = 752 * MiB;
constexpr size_t WS_V = 816 * MiB;
constexpr size_t WS_ZK = 880 * MiB;
constexpr size_t WS_TWA = 944 * MiB;
constexpr size_t WS_SGL = 960 * MiB;
constexpr size_t WS_QA = 976 * MiB;
constexpr size_t WS_KVA = 1008 * MiB;
constexpr size_t WS_KK = 944 * MiB;
constexpr size_t WS_YS = 752 * MiB;
constexpr size_t WS_END = 1024 * MiB;
constexpr size_t DO_G = 0;
constexpr size_t DO_Q = 64 * MiB;
constexpr size_t DO_KN = 160 * MiB;

constexpr int CW_CNT = 64;
constexpr int CW_BAR = 4096;

constexpr int NWAVES = 8, NTHR = 512;
constexpr int LDS_BYTES = 155648;
constexpr int LDS_MISC = 151552;

__device__ __forceinline__ int lane_id_fresh() { int l; asm volatile("v_mbcnt_lo_u32_b32 %0, -1, 0\n\tv_mbcnt_hi_u32_b32 %0, -1, %0" : "=v"(l)); return l; }
__device__ __forceinline__ float bf2f(unsigned short h) { return __builtin_bit_cast(float, (unsigned)h << 16); }
__device__ __forceinline__ unsigned f2bf(float f) { unsigned u = __builtin_bit_cast(unsigned, f); return (u + 0x7fffu + ((u >> 16) & 1u)) >> 16; }
typedef __bf16 bf16x2_t __attribute__((ext_vector_type(2)));
__device__ __forceinline__ unsigned pk2(float lo, float hi) { const f32x2 v = {lo, hi}; return __builtin_bit_cast(unsigned, __builtin_convertvector(v, bf16x2_t)); }
__device__ __forceinline__ float lo2f(unsigned w) { return __builtin_bit_cast(float, w << 16); }
__device__ __forceinline__ float hi2f(unsigned w) { return __builtin_bit_cast(float, w & 0xffff0000u); }
template <int CTRL> __device__ __forceinline__ float dpp_add(float x) { return x + __builtin_bit_cast(float, __builtin_amdgcn_update_dpp(0, __builtin_bit_cast(int, x), CTRL, 0xf, 0xf, false)); }
__device__ __forceinline__ float allsum16(float x) { x = dpp_add<0xB1>(x); x = dpp_add<0x4E>(x); x = dpp_add<0x141>(x); x = dpp_add<0x140>(x); return x; }
__device__ __forceinline__ float sum8(float x) { x = dpp_add<0xB1>(x); x = dpp_add<0x4E>(x); x = dpp_add<0x141>(x); return x; }
__device__ __forceinline__ float wave_sum(float v) {
    v = allsum16(v);
    { auto r = __builtin_amdgcn_permlane16_swap(__float_as_uint(v), __float_as_uint(v), false, false); v = __uint_as_float(r[0]) + __uint_as_float(r[1]); }
    { auto r = __builtin_amdgcn_permlane32_swap(__float_as_uint(v), __float_as_uint(v), false, false); v = __uint_as_float(r[0]) + __uint_as_float(r[1]); }
    return v;
}
__device__ __forceinline__ float sigmoidf_(float x) { return __builtin_amdgcn_rcpf(1.f + __builtin_amdgcn_exp2f(-1.4426950408889634f * x)); }
__device__ __forceinline__ float siluf_(float x) { return x * __builtin_amdgcn_rcpf(1.f + __builtin_amdgcn_exp2f(-1.4426950408889634f * x)); }
__device__ __forceinline__ void unpack8(const u32x4 w, float (&v)[8]) {
    v[0] = lo2f(w.x); v[1] = hi2f(w.x); v[2] = lo2f(w.y); v[3] = hi2f(w.y); v[4] = lo2f(w.z); v[5] = hi2f(w.z); v[6] = lo2f(w.w); v[7] = hi2f(w.w);
}
__device__ __forceinline__ u32x4 pack8(const float (&v)[8]) { u32x4 w; w.x = pk2(v[0], v[1]); w.y = pk2(v[2], v[3]); w.z = pk2(v[4], v[5]); w.w = pk2(v[6], v[7]); return w; }

#define LDS_BAR() do { asm volatile("s_waitcnt lgkmcnt(0)" ::: "memory"); __builtin_amdgcn_s_barrier(); asm volatile("" ::: "memory"); } while (0)

#define XB_TMO      128
#define XB_XCNT(j)  (256  + 64 * (j))
#define XB_XSUB(j)  (1280 + 64 * (j))
#define XB_XGEN(j)  (2304 + 64 * (j))
#define XB_TOP      3328
#define XB_TOPGEN   3392
#define XCD_BAR_WORDS 3456
#define XB_SPIN_CAP (1u << 19)
__device__ __forceinline__ unsigned xb_ld(unsigned* p)              { return __hip_atomic_load(p, __ATOMIC_RELAXED, __HIP_MEMORY_SCOPE_AGENT); }
__device__ __forceinline__ unsigned xb_add(unsigned* p, unsigned v) { return __hip_atomic_fetch_add(p, v, __ATOMIC_RELAXED, __HIP_MEMORY_SCOPE_AGENT); }
__device__ __forceinline__ unsigned xb_xcc_id() { return (unsigned)__builtin_amdgcn_s_getreg((3 << 11) | 20) & 0xFu; }
#define XB_SPIN(cond, bar) do { unsigned _sp = 0; while (cond) { __builtin_amdgcn_s_sleep(1); \
    if ((++_sp & 255u) == 0u) { if (xb_ld(&(bar)[XB_TMO])) break; if (_sp > XB_SPIN_CAP) { atomicAdd(&(bar)[XB_TMO], 1u); break; } } } } while (0)
struct XcdBarrier { unsigned* bar; unsigned x; volatile LAS unsigned* st; };
__device__ __forceinline__ XcdBarrier xcd_barrier_post(unsigned* bar, volatile LAS unsigned* st) {
    XcdBarrier b; b.bar = bar; b.x = xb_xcc_id(); b.st = st;
    if (threadIdx.x == 0) (void)xb_add(&bar[XB_XCNT(b.x)], 1u);
    return b;
}
__device__ __forceinline__ void xcd_barrier_complete(unsigned* bar, unsigned x, unsigned& nloc, unsigned& nx) {
    const unsigned G = gridDim.x * gridDim.y * gridDim.z;
    unsigned sum, cnt, mine, sp = 0u;
    for (;;) {
        sum = 0u; cnt = 0u; mine = 0u;
#pragma unroll
        for (unsigned j = 0; j < 16; ++j) { const unsigned c = xb_ld(&bar[XB_XCNT(j)]); sum += c; cnt += (c > 0u) ? 1u : 0u; mine = (j == x) ? c : mine; }
        if (sum == G) break;
        __builtin_amdgcn_s_sleep(1);
        if ((++sp & 255u) == 0u) { if (xb_ld(&bar[XB_TMO])) break; if (sp > XB_SPIN_CAP) { atomicAdd(&bar[XB_TMO], 1u); break; } }
    }
    nloc = mine > 0u ? mine : 1u; nx = cnt > 0u ? cnt : 1u;
}
__device__ __forceinline__ void xcd_barrier(const XcdBarrier& b) {
    asm volatile("s_waitcnt vmcnt(0)" ::: "memory");
    __syncthreads();
    if (threadIdx.x == 0) {
        unsigned* bar = b.bar;
        __builtin_amdgcn_s_waitcnt(0);
        unsigned nloc = b.st[0], nx = b.st[1];
        if (nloc == 0u) { xcd_barrier_complete(bar, b.x, nloc, nx); b.st[0] = nloc; b.st[1] = nx; }
        const unsigned old = xb_add(&bar[XB_XSUB(b.x)], 1u);
        const unsigned gen = old / nloc;
        if (old + 1u == (gen + 1u) * nloc) {
            __builtin_amdgcn_fence(__ATOMIC_RELEASE, "agent");
            asm volatile("s_waitcnt vmcnt(0)" ::: "memory");
            const unsigned og = xb_add(&bar[XB_TOP], 1u);
            const unsigned tg = og / nx;
            if (og + 1u == (tg + 1u) * nx) xb_add(&bar[XB_TOPGEN], 1u);
            else XB_SPIN(xb_ld(&bar[XB_TOPGEN]) == tg, bar);
            __builtin_amdgcn_fence(__ATOMIC_ACQUIRE, "agent");
            xb_add(&bar[XB_XGEN(b.x)], 1u);
            asm volatile("s_waitcnt vmcnt(0)" ::: "memory");
        } else {
            XB_SPIN(xb_ld(&bar[XB_XGEN(b.x)]) == gen, bar);
            __builtin_amdgcn_fence(__ATOMIC_ACQUIRE, "agent");
            asm volatile("s_waitcnt vmcnt(0)" ::: "memory");
        }
    }
    __syncthreads();
}

struct Args {
    const float* in[34]; float* out; unsigned char* ws; int ph_lo, ph_hi;
};
typedef const __attribute__((address_space(4))) Args* ArgsP;
struct Frame {
    LAS unsigned char* lds;
    int wave, vcu, G, gw, NGW;
    unsigned char* ws; unsigned char* dob;
};
enum { I_X = 0, I_C, I_POS, I_WADA, I_BADA, I_GMIX, I_WIN, I_MU, I_W0, I_WDEC, I_A0, I_WAUP, I_WGUP, I_KK, I_KA, I_RK, I_LNW, I_LNB, I_GQA, I_WUQ, I_GKVA, I_WUKV,
       I_QN, I_KN, I_WBR, I_WOUT, I_GFFN, I_WRG, I_BRG, I_WRE, I_BRE, I_WEG, I_WEU, I_WED };

struct Unit { int pm, pn; };
struct Gemm { const bf16* A; const bf16* Bt; int M, N, K; };
constexpr int NXCD = 8, WGM = 8;
struct StaticOrder {
    int nM, nN, nwg, G, c;
    __device__ void init(int M, int N, int G_, int c_) { nM = M / 256; nN = N / 256; nwg = nM * nN; G = G_; c = c_; }
    __device__ bool next(int i, Unit& u) const {
        const long L = (long)i * G + c; if (L >= nwg) return false;
        int wgid = (int)L; { const int q = nwg / NXCD, r = nwg % NXCD, xcd = wgid % NXCD, off = wgid / NXCD; wgid = (xcd < r ? xcd * (q + 1) : r * (q + 1) + (xcd - r) * q) + off; }
        const int nig = WGM * nN, gid = wgid / nig, fm = gid * WGM, gsz = (nM - fm) < WGM ? (nM - fm) : WGM;
        u.pm = fm + ((wgid % nig) % gsz); u.pn = (wgid % nig) / gsz; return true;
    }
    __device__ __forceinline__ void a_ready(const Unit&) const {}
    __device__ __forceinline__ void done(const Unit&) const {}
};
struct TableOrder {
    const LAS int* texp; int ntiles, nN, G, c;
    __device__ bool next(int i, Unit& u) const {
        const long L = (long)i * G + c; if (L >= (long)ntiles * nN) return false;
        const int t = (int)(L / nN), j = (int)(L % nN); u.pm = t; u.pn = texp[t] * nN + j; return true;
    }
    __device__ __forceinline__ void a_ready(const Unit&) const {}
    __device__ __forceinline__ void done(const Unit&) const {}
};

template <class Epi, class Sched>
__device__ __forceinline__ void gemm_phase_naive(LAS unsigned char* lds, const Gemm g, const Sched& S, const Epi& E) {
    const int tid = (int)__builtin_amdgcn_readfirstlane((int)threadIdx.x >> 6) * 64 + lane_id_fresh(), ty = tid >> 5, tx = tid & 31;
    LAS bf16* As = (LAS bf16*)lds; LAS bf16* Bs = (LAS bf16*)(lds + 128 * 40 * 2);
    Unit u;
    for (int i = 0; S.next(i, u); ++i) {
        for (int half = 0; half < 2; ++half) {
            float acc[8][8];
#pragma unroll
            for (int r = 0; r < 8; ++r)
#pragma unroll
                for (int c = 0; c < 8; ++c) acc[r][c] = 0.f;
            const bf16* Ab = g.A + ((size_t)u.pm * 256 + half * 128) * g.K; const bf16* Bb = g.Bt + (size_t)u.pn * 256 * g.K;
            for (int k0 = 0; k0 < g.K; k0 += 32) {
                __syncthreads();
                { const int r = tid >> 2, c8 = (tid & 3) * 8; *(LAS u32x4*)(As + r * 40 + c8) = *(const u32x4*)(Ab + (size_t)r * g.K + k0 + c8); }
#pragma unroll
                for (int j = 0; j < 2; ++j) { const int ch = tid + j * 512, r = ch >> 2, c8 = (ch & 3) * 8; *(LAS u32x4*)(Bs + r * 40 + c8) = *(const u32x4*)(Bb + (size_t)r * g.K + k0 + c8); }
                __syncthreads();
#pragma unroll 2
                for (int k = 0; k < 32; k += 2) {
                    float b0[8], b1[8];
#pragma unroll
                    for (int c = 0; c < 8; ++c) { const unsigned w = *(const LAS unsigned*)(Bs + (tx * 8 + c) * 40 + k); b0[c] = lo2f(w); b1[c] = hi2f(w); }
#pragma unroll
                    for (int r = 0; r < 8; ++r) { const unsigned w = *(const LAS unsigned*)(As + (ty * 8 + r) * 40 + k); const float a0 = lo2f(w), a1 = hi2f(w);
#pragma unroll
                        for (int c = 0; c < 8; ++c) acc[r][c] = fmaf(a1, b1[c], fmaf(a0, b0[c], acc[r][c])); }
                }
            }
#pragma unroll
            for (int r = 0; r < 8; ++r) E.store8(u, half * 128 + ty * 8 + r, tx * 8, acc[r]);
        }
    }
    __syncthreads();
}

struct EpiZ { bf16 *ZR, *SG, *ZM;
    __device__ __forceinline__ void store8(const Unit& u, int r, int c, const float (&v)[8]) const {
        const size_t row = (size_t)u.pm * 256 + r;
        if (u.pn < 7) { *(u32x4*)(ZR + row * 1792 + u.pn * 256 + c) = pack8(v); }
        else if (u.pn < 15) { float s[8];
#pragma unroll
            for (int i = 0; i < 8; ++i) s[i] = sigmoidf_(v[i]);
            *(u32x4*)(SG + row * 2048 + (u.pn - 7) * 256 + c) = pack8(s); }
        else { *(u32x4*)(ZM + row * 512 + (u.pn - 15) * 256 + c) = pack8(v); }
    } };
struct EpiLora { bf16 *LW, *A; const float *w0, *a0;
    __device__ __forceinline__ void store8(const Unit& u, int r, int c, const float (&v)[8]) const {
        const size_t row = (size_t)u.pm * 256 + r; const int col = u.pn * 256 + c; float o[8];
        const bool isw = col < 512; const float* bp = isw ? (w0 + col) : (a0 + col - 512);
        const f32x4 b0 = *(const f32x4*)bp, b1 = *(const f32x4*)(bp + 4); const float bb[8] = {b0.x, b0.y, b0.z, b0.w, b1.x, b1.y, b1.z, b1.w};
#pragma unroll
        for (int i = 0; i < 8; ++i) { const float e = __builtin_amdgcn_exp2f(fminf(-1.4426950408889634f * (bb[i] + v[i]), 120.f)); const float s = __builtin_amdgcn_rcpf(1.0f + e); o[i] = isw ? -0.60653065971263342f * s : s; }
        bf16* dst = isw ? (LW + row * 512 + col) : (A + row * 512 + col - 512);
        *(u32x4*)dst = pack8(o);
    } };
struct EpiPlain { bf16* O0; bf16* O1; int split, ld0, ld1;
    __device__ __forceinline__ void store8(const Unit& u, int r, int c, const float (&v)[8]) const {
        const size_t row = (size_t)u.pm * 256 + r; int col = u.pn * 256 + c;
        if (col < split) *(u32x4*)(O0 + row * ld0 + col) = pack8(v); else *(u32x4*)(O1 + row * ld1 + col - split) = pack8(v);
    } };
template <bool ACCUM> struct EpiBranch { bf16* MG; const bf16* SG; int goff;
    __device__ __forceinline__ void store8(const Unit& u, int r, int c, const float (&v)[8]) const {
        const size_t row = (size_t)u.pm * 256 + r; const int col = u.pn * 256 + c; float gt[8], o[8];
        unpack8(*(const u32x4*)(SG + row * 2048 + goff + col), gt);
        if (ACCUM) { float p[8]; unpack8(*(const u32x4*)(MG + row * 1024 + col), p);
#pragma unroll
            for (int i = 0; i < 8; ++i) o[i] = p[i] + gt[i] * v[i]; }
        else {
#pragma unroll
            for (int i = 0; i < 8; ++i) o[i] = gt[i] * v[i]; }
        *(u32x4*)(MG + row * 1024 + col) = pack8(o);
    } };
struct EpiOut { float* X1; const float* x; const float* mod;
    __device__ __forceinline__ void store8(const Unit& u, int r, int c, const float (&v)[8]) const {
        const size_t row = (size_t)u.pm * 256 + r; const int col = u.pn * 256 + c; const int b = (int)(row / SEQ);
        const float* gt = mod + b * 6144 + 2048 + col; const float* xr = x + row * 1024 + col; float* o = X1 + row * 1024 + col;
        const f32x4 g0 = *(const f32x4*)gt, g1 = *(const f32x4*)(gt + 4), x0 = *(const f32x4*)xr, x1 = *(const f32x4*)(xr + 4);
        *(f32x4*)o = (f32x4){x0.x + g0.x * v[0], x0.y + g0.y * v[1], x0.z + g0.z * v[2], x0.w + g0.w * v[3]};
        *(f32x4*)(o + 4) = (f32x4){x1.x + g1.x * v[4], x1.y + g1.y * v[5], x1.z + g1.z * v[6], x1.w + g1.w * v[7]};
    } };
struct EpiGateUp { bf16* HID;
    __device__ __forceinline__ void store8(const Unit& u, int r, int c, const float (&v)[8]) const {
        const size_t row = (size_t)u.pm * 256 + r; const int col = ((u.pn & 1) * 256 + c) >> 1;
        u32x2 w; w.x = pk2(siluf_(v[0]) * v[4], siluf_(v[1]) * v[5]); w.y = pk2(siluf_(v[2]) * v[6], siluf_(v[3]) * v[7]);
        *(u32x2*)(HID + row * 256 + col) = w;
    } };
struct EpiDownAtomic { float* out; const int* ent; const float* mod;
    __device__ __forceinline__ void store8(const Unit& u, int r, int c, const float (&v)[8]) const {
        const int e0 = ent[2 * (u.pm * 256 + r)]; if (e0 < 0) return; const float w = __builtin_bit_cast(float, ent[2 * (u.pm * 256 + r) + 1]);
        const int col = (u.pn & 3) * 256 + c, b = e0 / SEQ; const float* gt = mod + b * 6144 + 5120 + col; float* o = out + (size_t)e0 * 1024 + col;
        const f32x4 g0 = *(const f32x4*)gt, g1 = *(const f32x4*)(gt + 4);
        unsafeAtomicAdd(o + 0, g0.x * w * v[0]); unsafeAtomicAdd(o + 1, g0.y * w * v[1]); unsafeAtomicAdd(o + 2, g0.z * w * v[2]); unsafeAtomicAdd(o + 3, g0.w * w * v[3]);
        unsafeAtomicAdd(o + 4, g1.x * w * v[4]); unsafeAtomicAdd(o + 5, g1.y * w * v[5]); unsafeAtomicAdd(o + 6, g1.z * w * v[6]); unsafeAtomicAdd(o + 7, g1.w * w * v[7]);
    } };
struct EpiDown { bf16* YS;
    __device__ __forceinline__ void store8(const Unit& u, int r, int c, const float (&v)[8]) const {
        const size_t row = (size_t)u.pm * 256 + r; *(u32x4*)(YS + row * 1024 + (u.pn & 3) * 256 + c) = pack8(v);
    } };


namespace pg8 {
#define PG8_LAS __attribute__((address_space(3)))
typedef ::bf16x8 bf16x8; typedef ::f32x4 f32x4;
using ::Unit; using ::Gemm;
constexpr int BM = 256, BK = 64, HALF = 128, HTB = HALF * BK * 2  , STAGE_BYTES = 8 * HTB;

__device__ __forceinline__ int lds_byte(int r, int c) { const int st = (r >> 4) * 2 + (c >> 5), rr = r & 15, cc = c & 31, ob = rr * 64 + cc * 2; return st * 1024 + (ob ^ (((ob >> 9) & 1) << 5)); }
__device__ __forceinline__ void stage_rc(int b, int& R, int& C) { const int st = b / 1024, sb = b % 1024, swz = sb ^ (((sb >> 9) & 1) << 5); R = (st >> 1) * 16 + swz / 64; C = (st & 1) * 32 + (swz % 64) / 2; }
__device__ __forceinline__ int perm32(int rho) { const int n = rho >> 4, i = rho & 15; return 8 * (i >> 2) + 4 * n + (i & 3); }
template <class Epi, class Sched, bool ALIGN_EPI = false, bool SP2 = false>
__device__ __forceinline__ void gemm_phase(PG8_LAS unsigned char* lds, const Gemm g, const Sched& S, const Epi& E, const int wave_in) {
    const int lane = lane_id_fresh(), wid = wave_in, tid = wid * 64 + lane,
              wr = wid >> 2, wc = wid & 3, fr = lane & 15, fq = lane >> 4;
    const int K = g.K, nt = K / BK;
    unsigned voffA[2], voffB[2];
#pragma unroll
    for (int i = 0; i < 2; ++i) { int R, C; stage_rc(tid * 16 + i * 8192, R, C); const int Rb = Epi::PERM ? ((R & ~31) + perm32(R & 31)) : R;
        voffA[i] = (unsigned)(R * K + C) * 2u; voffB[i] = (unsigned)(Rb * K + C) * 2u; }
    const size_t kstep = (size_t)(BK * 2);
    const size_t hstep = (size_t)HALF * K * 2;
    const size_t tstep = 2 * hstep;
    const unsigned ldsw = (unsigned)wid * 1024u;
    const int aoff = lds_byte(wr * 64 + fr, fq * 8), boff = lds_byte(wc * 32 + fr, fq * 8);
#define PG8_SA(b, h) (((b) * 2 + (h)) * HTB)
#define PG8_SB(b, h) ((4 + (b) * 2 + (h)) * HTB)
#define PG8_STAGE(bufoff, gbase, voff) do { _Pragma("unroll") for (int _i = 0; _i < 2; ++_i) \
        __builtin_amdgcn_global_load_lds((const unsigned*)((const char*)(gbase) + (voff)[_i]), (PG8_LAS unsigned*)(lds + (bufoff) + ldsw + _i * 8192), 16, 0, 0); } while (0)
#define PG8_LDA(dst, b, h) do { _Pragma("unroll") for (int m = 0; m < 4; ++m) _Pragma("unroll") for (int k = 0; k < 2; ++k) dst[m][k] = *(const PG8_LAS bf16x8*)(lds + PG8_SA(b, h) + aoff + m * 2048 + k * 1024); } while (0)
#define PG8_LDB(dst, b, h) do { _Pragma("unroll") for (int n = 0; n < 2; ++n) _Pragma("unroll") for (int k = 0; k < 2; ++k) dst[n][k] = *(const PG8_LAS bf16x8*)(lds + PG8_SB(b, h) + boff + n * 2048 + k * 1024); } while (0)
#define PG8_MMA(ai, bj, At, Bt) do { __builtin_amdgcn_s_setprio(1); _Pragma("unroll") for (int m = 0; m < 4; ++m) _Pragma("unroll") for (int n = 0; n < 2; ++n) _Pragma("unroll") for (int k = 0; k < 2; ++k) \
        acc[ai][bj][m][n] = __builtin_amdgcn_mfma_f32_16x16x32_bf16(Bt[n][k], At[m][k], acc[ai][bj][m][n], 0, 0, 0); __builtin_amdgcn_s_setprio(0); } while (0)
#define PG8_WAIT_V(n) asm volatile("s_waitcnt vmcnt(" #n ")" ::: "memory")
#define PG8_WAIT_L(n) asm volatile("s_waitcnt lgkmcnt(" #n ")" ::: "memory")
#define PG8_BAR __builtin_amdgcn_s_barrier()
#define PG8_SCHED __builtin_amdgcn_sched_barrier(0)
    Unit cur, nxt; int ui = 0;
    if (!S.next(0, cur)) return;
    f32x4 acc[2][2][4][2];
#pragma unroll
    for (int a = 0; a < 2; ++a)
#pragma unroll
        for (int b = 0; b < 2; ++b)
#pragma unroll
            for (int m = 0; m < 4; ++m)
#pragma unroll
                for (int n = 0; n < 2; ++n) acc[a][b][m][n] = (f32x4){0.f, 0.f, 0.f, 0.f};
    bf16x8 At[4][2], B0[2][2], B1[2][2];
    const char* cA = (const char*)g.A + (size_t)cur.pm * tstep; const char* cB = (const char*)g.Bt + (size_t)cur.pn * tstep;
    S.a_ready(cur);
    if constexpr (SP2) {
        PG8_STAGE(PG8_SB(0, 0), cB, voffB); PG8_STAGE(PG8_SB(0, 1), cB + hstep, voffB); PG8_STAGE(PG8_SA(0, 0), cA, voffA); PG8_STAGE(PG8_SA(0, 1), cA + hstep, voffA);
        if (wr == 1) PG8_BAR;
        PG8_WAIT_V(2); PG8_BAR;
        PG8_STAGE(PG8_SB(1, 0), cB + kstep, voffB); PG8_STAGE(PG8_SA(1, 0), cA + kstep, voffA); PG8_STAGE(PG8_SB(1, 1), cB + hstep + kstep, voffB);
        PG8_WAIT_V(6); PG8_BAR;
    } else {
        PG8_STAGE(PG8_SB(0, 0), cB, voffB); PG8_STAGE(PG8_SA(0, 0), cA, voffA); PG8_STAGE(PG8_SB(0, 1), cB + hstep, voffB); PG8_STAGE(PG8_SA(0, 1), cA + hstep, voffA);
        if (wr == 1) PG8_BAR;
        PG8_WAIT_V(4); PG8_BAR;
        PG8_STAGE(PG8_SB(1, 0), cB + kstep, voffB); PG8_STAGE(PG8_SA(1, 0), cA + kstep, voffA); PG8_STAGE(PG8_SB(1, 1), cB + hstep + kstep, voffB);
        PG8_WAIT_V(6); PG8_BAR;
    }
    for (;;) {
        const bool has_next = S.next(ui + 1, nxt);
        const char* nA = has_next ? (const char*)g.A + (size_t)nxt.pm * tstep : cA; const char* nB = has_next ? (const char*)g.Bt + (size_t)nxt.pn * tstep : cB;
        for (int t = 0; t < nt; t += 2) {
            const bool last = (t == nt - 2);
            const char* a1 = cA + (size_t)(t + 1) * kstep;
            const char* a2 = last ? nA : cA + (size_t)(t + 2) * kstep; const char* b2 = last ? nB : cB + (size_t)(t + 2) * kstep;
            const char* a3 = a2 + kstep; const char* b3 = b2 + kstep;
            if (last && has_next) S.a_ready(nxt);
            if constexpr (SP2) {
            PG8_LDB(B0, 0, 0); PG8_LDB(B1, 0, 1); PG8_SCHED; PG8_LDA(At, 0, 0); PG8_STAGE(PG8_SA(1, 1), a1 + hstep, voffA);
            PG8_WAIT_V(8); PG8_WAIT_L(0); PG8_BAR; PG8_MMA(0, 0, At, B0); PG8_MMA(0, 1, At, B1); PG8_BAR; PG8_SCHED;
            PG8_LDA(At, 0, 1); PG8_STAGE(PG8_SB(0, 0), b2, voffB); PG8_STAGE(PG8_SB(0, 1), b2 + hstep, voffB); PG8_STAGE(PG8_SA(0, 0), a2, voffA);
            PG8_WAIT_V(8); PG8_WAIT_L(0); PG8_BAR; PG8_MMA(1, 0, At, B0); PG8_MMA(1, 1, At, B1); PG8_BAR; PG8_SCHED;
            PG8_LDB(B0, 1, 0); PG8_LDB(B1, 1, 1); PG8_SCHED; PG8_LDA(At, 1, 0); PG8_STAGE(PG8_SA(0, 1), a2 + hstep, voffA);
            PG8_WAIT_V(8); PG8_WAIT_L(0); PG8_BAR; PG8_MMA(0, 0, At, B0); PG8_MMA(0, 1, At, B1); PG8_BAR; PG8_SCHED;
            PG8_LDA(At, 1, 1); PG8_STAGE(PG8_SB(1, 0), b3, voffB); PG8_STAGE(PG8_SB(1, 1), b3 + hstep, voffB); PG8_STAGE(PG8_SA(1, 0), a3, voffA);
            PG8_WAIT_V(8); PG8_WAIT_L(0); PG8_BAR; PG8_MMA(1, 0, At, B0); PG8_MMA(1, 1, At, B1); PG8_BAR; PG8_SCHED;
            } else {
            PG8_LDB(B0, 0, 0); PG8_SCHED; PG8_LDA(At, 0, 0); PG8_STAGE(PG8_SA(1, 1), a1 + hstep, voffA);
            PG8_WAIT_L(8); PG8_BAR; PG8_WAIT_L(0); PG8_MMA(0, 0, At, B0); PG8_BAR; PG8_SCHED;
            PG8_LDB(B1, 0, 1); PG8_STAGE(PG8_SB(0, 0), b2, voffB);
            PG8_BAR; PG8_WAIT_L(0); PG8_MMA(0, 1, At, B1); PG8_BAR;
            PG8_LDA(At, 0, 1); PG8_STAGE(PG8_SA(0, 0), a2, voffA);
            PG8_BAR; PG8_WAIT_L(0); PG8_MMA(1, 0, At, B0); PG8_BAR; PG8_SCHED;
            PG8_STAGE(PG8_SB(0, 1), b2 + hstep, voffB);
            PG8_WAIT_V(6); PG8_BAR; PG8_MMA(1, 1, At, B1); PG8_BAR;
            PG8_LDB(B0, 1, 0); PG8_SCHED; PG8_LDA(At, 1, 0); PG8_STAGE(PG8_SA(0, 1), a2 + hstep, voffA);
            PG8_WAIT_L(8); PG8_BAR; PG8_WAIT_L(0); PG8_MMA(0, 0, At, B0); PG8_BAR; PG8_SCHED;
            PG8_LDB(B1, 1, 1); PG8_STAGE(PG8_SB(1, 0), b3, voffB);
            PG8_BAR; PG8_WAIT_L(0); PG8_MMA(0, 1, At, B1); PG8_BAR;
            PG8_LDA(At, 1, 1); PG8_STAGE(PG8_SA(1, 0), a3, voffA);
            PG8_BAR; PG8_WAIT_L(0); PG8_MMA(1, 0, At, B0); PG8_BAR; PG8_SCHED;
            PG8_STAGE(PG8_SB(1, 1), b3 + hstep, voffB);
            PG8_WAIT_V(6); PG8_BAR; PG8_MMA(1, 1, At, B1); PG8_BAR;
            }
        }
        if constexpr (ALIGN_EPI) { if (wr == 0) PG8_BAR; }
        if constexpr (!Epi::AFTER_DRAIN) { E(acc, cur, wr, wc, fr, fq); S.done(cur); }
        if (!has_next) break;
#pragma unroll
        for (int a = 0; a < 2; ++a)
#pragma unroll
            for (int b = 0; b < 2; ++b)
#pragma unroll
                for (int m = 0; m < 4; ++m)
#pragma unroll
                    for (int n = 0; n < 2; ++n) acc[a][b][m][n] = (f32x4){0.f, 0.f, 0.f, 0.f};
        cur = nxt; cA = nA; cB = nB; ++ui;
        if constexpr (ALIGN_EPI) { if (wr == 1) PG8_BAR; }
    }
    PG8_WAIT_V(0);
    if constexpr (!ALIGN_EPI) { if (wr == 0) PG8_BAR; }
    PG8_BAR;
    if constexpr (Epi::AFTER_DRAIN) { E.fused(acc, cur, wr, wc, fr, fq, lds, wid, lane); S.done(cur); }
#undef PG8_SA
#undef PG8_SB
#undef PG8_STAGE
#undef PG8_LDA
#undef PG8_LDB
#undef PG8_MMA
#undef PG8_WAIT_V
#undef PG8_WAIT_L
#undef PG8_BAR
#undef PG8_SCHED
}

template <class F> struct EpiAdapt {
    static constexpr bool PERM = true, AFTER_DRAIN = false; F f;
    __device__ __forceinline__ void operator()(const f32x4 (&acc)[2][2][4][2], const Unit& u, int wr, int wc, int fr, int fq) const {
        asm volatile("" : "+v"(fr), "+v"(fq));
#pragma unroll
        for (int ai = 0; ai < 2; ++ai)
#pragma unroll
            for (int m = 0; m < 4; ++m) { const int row = ai * HALF + wr * 64 + m * 16 + fr;
#pragma unroll
                for (int bj = 0; bj < 2; ++bj) { const f32x4 v0 = acc[ai][bj][m][0], v1 = acc[ai][bj][m][1];
                    const float v[8] = {v0[0], v0[1], v0[2], v0[3], v1[0], v1[1], v1[2], v1[3]};
                    f.store8(u, row, bj * HALF + wc * 32 + 8 * fq, v); } }
    }
};
}

template <class Epi, class Sched>
__device__ __forceinline__ void gemm_phase_any(LAS unsigned char* lds, const Gemm g, const Sched& S, const Epi& E, const int wave_in) {
#if ENG_GEMM == 1
    pg8::EpiAdapt<Epi> EA{E};
    pg8::gemm_phase<pg8::EpiAdapt<Epi>, Sched, true, true>(lds, g, S, EA, wave_in);
#else
    gemm_phase_naive<Epi, Sched>(lds, g, S, E);
#endif
}

template <class RowMap>
__device__ __forceinline__ void transpose_item(const float* W, int ldw, bf16* WT, int ldt, int koff, int k0, int n0, const RowMap& rm, LAS float* scr, int lane) {
#pragma unroll 8
    for (int i = 0; i < 32; ++i) { const int kk = 2 * i + (lane >> 5); scr[kk * 33 + (lane & 31)] = W[(size_t)(k0 + kk) * ldw + n0 + (lane & 31)]; }
    asm volatile("s_waitcnt lgkmcnt(0)" ::: "memory");
    const int c = lane & 7;
#pragma unroll
    for (int j = 0; j < 4; ++j) { const int n = (lane >> 3) + 8 * j; const LAS float* s = scr + (8 * c) * 33 + n;
        u32x4 o; o.x = pk2(s[0 * 33], s[1 * 33]); o.y = pk2(s[2 * 33], s[3 * 33]); o.z = pk2(s[4 * 33], s[5 * 33]); o.w = pk2(s[6 * 33], s[7 * 33]);
        *(u32x4*)(WT + (size_t)rm(n0 + n) * ldt + koff + k0 + 8 * c) = o; }
    asm volatile("s_waitcnt lgkmcnt(0)" ::: "memory");
}
struct RmId { int off; __device__ int operator()(int n) const { return off + n; } };
struct RmWin { __device__ int operator()(int n) const { return n < 1792 ? n : (n < 2208 ? 3840 + (n - 1792) : 1792 + (n - 2208)); } };
struct RmUkv { __device__ int operator()(int n) const { const int h = n >> 7, j = n & 127; return j < 64 ? h * 64 + j : 512 + h * 64 + (j - 64); } };
struct RmGU { int off; __device__ int operator()(int j) const { return off + 8 * (j >> 2) + (j & 3); } };

__device__ __forceinline__ void p0_prologue(const Frame& F, ArgsP a) {
    const int lane_f = lane_id_fresh(), tid_f = F.wave * 64 + lane_f;
    LAS float* scr = (LAS float*)(F.lds + F.wave * 16384);
    const int lane = lane_f;
    bf16* Win = (bf16*)(F.ws + WS_WIN); bf16* Wblk = (bf16*)(F.ws + WS_WBLK); bf16* Wg = (bf16*)(F.ws + WS_WG); bf16* Wuq = (bf16*)(F.ws + WS_WUQ);
    bf16* Wukv = (bf16*)(F.ws + WS_WUKV); bf16* Wb = (bf16*)(F.ws + WS_WB); bf16* Wo = (bf16*)(F.ws + WS_WO); bf16* Wgu = (bf16*)(F.ws + WS_WGU); bf16* Wdn = (bf16*)(F.ws + WS_WDN);
    constexpr int I_IN = 16 * 133, I_DEC = 1 * 16, I_AUP = 16, I_GUP = 2 * 16, I_UQ = 4 * 24, I_UKV = 2 * 32, I_BR = 2 * 8 * 32, I_O = 16 * 32;
    constexpr int I_EG = 32 * 16 * 8, I_EU = I_EG, I_ED = 32 * 4 * 32;
    constexpr int NITEMS = I_IN + I_DEC + I_AUP + I_GUP + I_UQ + I_UKV + I_BR + I_O + I_EG + I_EU + I_ED;
    for (int it = F.gw; it < NITEMS; it += F.NGW) {
        int r = it;
        if (r < I_IN) { const int kb = r / 133, nb = r % 133; transpose_item(a->in[I_WIN], D_IN, Win, 1024, 0, 64 * kb, 32 * nb, RmWin{}, scr, lane); continue; } r -= I_IN;
        if (r < I_DEC) { transpose_item(a->in[I_WDEC], 512, Wblk, 128, 0, 0, 32 * r, RmId{0}, scr, lane); continue; } r -= I_DEC;
        if (r < I_AUP) { transpose_item(a->in[I_WAUP], 512, Wblk, 128, 64, 0, 32 * r, RmId{512}, scr, lane); continue; } r -= I_AUP;
        if (r < I_GUP) { const int kb = r / 16, nb = r % 16; transpose_item(a->in[I_WGUP], 512, Wg, 128, 0, 64 * kb, 32 * nb, RmId{0}, scr, lane); continue; } r -= I_GUP;
        if (r < I_UQ) { const int kb = r / 24, nb = r % 24; transpose_item(a->in[I_WUQ], 768, Wuq, 256, 0, 64 * kb, 32 * nb, RmId{0}, scr, lane); continue; } r -= I_UQ;
        if (r < I_UKV) { const int kb = r / 32, nb = r % 32; transpose_item(a->in[I_WUKV], 1024, Wukv, 128, 0, 64 * kb, 32 * nb, RmUkv{}, scr, lane); continue; } r -= I_UKV;
        if (r < I_BR) { const int br = r / 256, q = r % 256, kb = q / 32, nb = q % 32; transpose_item(a->in[I_WBR] + (size_t)br * 512 * 1024, 1024, Wb + (size_t)br * 1024 * 512, 512, 0, 64 * kb, 32 * nb, RmId{0}, scr, lane); continue; } r -= I_BR;
        if (r < I_O) { const int kb = r / 32, nb = r % 32; transpose_item(a->in[I_WOUT], 1024, Wo, 1024, 0, 64 * kb, 32 * nb, RmId{0}, scr, lane); continue; } r -= I_O;
        if (r < I_EG) { const int e = r / 128, q = r % 128, kb = q / 8, nb = q % 8; transpose_item(a->in[I_WEG] + (size_t)e * 1024 * 256, 256, Wgu + (size_t)e * 512 * 1024, 1024, 0, 64 * kb, 32 * nb, RmGU{0}, scr, lane); continue; } r -= I_EG;
        if (r < I_EU) { const int e = r / 128, q = r % 128, kb = q / 8, nb = q % 8; transpose_item(a->in[I_WEU] + (size_t)e * 1024 * 256, 256, Wgu + (size_t)e * 512 * 1024, 1024, 0, 64 * kb, 32 * nb, RmGU{4}, scr, lane); continue; } r -= I_EU;
        { const int e = r / 128, q = r % 128, kb = q / 32, nb = q % 32; transpose_item(a->in[I_WED] + (size_t)e * 256 * 1024, 1024, Wdn + (size_t)e * 1024 * 256, 256, 0, 64 * kb, 32 * nb, RmId{0}, scr, lane); }
    }
    for (int i = F.gw * 64 + lane; i < 96 * 128; i += F.NGW * 64) *(u32x4*)(Win + (size_t)4256 * 1024 + (size_t)i * 8) = (u32x4){0u, 0u, 0u, 0u};
    for (int i = F.gw * 64 + lane; i < 1024 * 8; i += F.NGW * 64) { const int row = i >> 3, c8 = (i & 7) * 8; *(u32x4*)(Wblk + row * 128 + (row < 512 ? 64 : 0) + c8) = (u32x4){0u, 0u, 0u, 0u}; }
    { const int* pos = (const int*)a->in[I_POS]; float* cs = (float*)(F.ws + WS_CS);
      for (int i = F.gw * 64 + lane; i < NTOK * 16; i += F.NGW * 64) { const int t = i >> 4, j = i & 15;
          const float fr = exp2f(-(float)j * (13.287712379549449f / 16.0f));
          const float ang = (float)pos[t] * fr; cs[t * 32 + j] = cosf(ang); cs[t * 32 + 16 + j] = sinf(ang); } }
    { float* mod = (float*)(F.ws + WS_MOD); const float* c = a->in[I_C]; const float* wa = a->in[I_WADA]; const float* ba = a->in[I_BADA];
      LAS float* red = (LAS float*)(F.lds + 8 * 16384);
      for (int nb = F.vcu; nb < 96; nb += F.G) {
          float acc[8];
#pragma unroll
          for (int b = 0; b < 8; ++b) acc[b] = 0.f;
          const int n = nb * 64 + lane;
          for (int k = F.wave * 128; k < F.wave * 128 + 128; ++k) { const float w = wa[(size_t)k * 6144 + n];
#pragma unroll
              for (int b = 0; b < 8; ++b) acc[b] = fmaf(siluf_(c[b * 1024 + k]), w, acc[b]); }
#pragma unroll
          for (int b = 0; b < 8; ++b) red[(F.wave * 8 + b) * 64 + lane] = acc[b];
          __syncthreads();
          { const int b = F.wave; float s = ba[n];
#pragma unroll
            for (int w = 0; w < 8; ++w) s += red[(w * 8 + b) * 64 + lane];
            mod[b * 6144 + n] = s; }
          __syncthreads();
      } }
}

__device__ __forceinline__ void p_normmod(const Frame& F, const float* x, const float* g, const float* mod, int sh_off, int sc_off, bf16* H) {
    const int lane_f = lane_id_fresh(), tid_f = F.wave * 64 + lane_f;
    for (int m = F.gw; m < NTOK; m += F.NGW) {
        const int b = m / SEQ; const f32x4* xr = (const f32x4*)(x + (size_t)m * 1024) + lane_f;
        f32x4 v[4]; float s = 0.f;
#pragma unroll
        for (int j = 0; j < 4; ++j) { v[j] = xr[64 * j]; s += (v[j].x * v[j].x + v[j].y * v[j].y) + (v[j].z * v[j].z + v[j].w * v[j].w); }
        const float rstd = 1.0f / sqrtf(wave_sum(s) * (1.f / 1024.f) + EPS);
        u32x2* o = (u32x2*)(H + (size_t)m * 1024) + lane_f;
#pragma unroll
        for (int j = 0; j < 4; ++j) { const int col = 4 * lane_f + 256 * j;
            const f32x4 gg = *(const f32x4*)(g + col), sc = *(const f32x4*)(mod + b * 6144 + sc_off + col), sh = *(const f32x4*)(mod + b * 6144 + sh_off + col);
            const f32x4 y = v[j] * rstd * gg * (sc + 1.0f) + sh; u32x2 w; w.x = pk2(y.x, y.y); w.y = pk2(y.z, y.w); o[64 * j] = w; }
    }
}

__device__ __forceinline__ void p_prep_a(const Frame& F, ArgsP a) {
    const int lane_f = lane_id_fresh();
    const bf16* ZR = (const bf16*)(F.ws + WS_ZR); const bf16* ZM = (const bf16*)(F.ws + WS_ZM);
    bf16* TWA = (bf16*)(F.ws + WS_TWA); bf16* SGL = (bf16*)(F.ws + WS_SGL); bf16* QA = (bf16*)(F.ws + WS_QA); bf16* KVA = (bf16*)(F.ws + WS_KVA);
    const float* mu = a->in[I_MU]; const float* gqa = a->in[I_GQA]; const float* gkva = a->in[I_GKVA];
    const int lane = lane_f;
    const f32x4 mm = *(const f32x4*)(mu + 1536 + 4 * lane), gq = *(const f32x4*)(gqa + 4 * lane), gk = *(const f32x4*)(gkva + 4 * (lane & 31));
    for (int m = F.gw; m < NTOK; m += F.NGW) {
        const bool first = (m % SEQ) == 0;
        { const u32x2 c = *((const u32x2*)(ZR + (size_t)m * 1792 + 1536) + lane); u32x2 p = *((const u32x2*)(ZR + (size_t)(first ? m : m - 1) * 1792 + 1536) + lane); if (first) { p.x = 0u; p.y = 0u; }
          float z[4] = {lo2f(c.x), hi2f(c.x), lo2f(c.y), hi2f(c.y)}; const float q[4] = {lo2f(p.x), hi2f(p.x), lo2f(p.y), hi2f(p.y)};
          z[0] += (q[0] - z[0]) * mm.x; z[1] += (q[1] - z[1]) * mm.y; z[2] += (q[2] - z[2]) * mm.z; z[3] += (q[3] - z[3]) * mm.w;
          if (lane < 16) { u32x2 w; w.x = pk2(tanhf(z[0]), tanhf(z[1])); w.y = pk2(tanhf(z[2]), tanhf(z[3])); *((u32x2*)(TWA + (size_t)m * 128) + lane) = w; }
          else if (lane < 32) { u32x2 w; w.x = pk2(z[0], z[1]); w.y = pk2(z[2], z[3]); *((u32x2*)(TWA + (size_t)m * 128) + lane) = w; }
          else { u32x2 w; w.x = pk2(sigmoidf_(z[0]), sigmoidf_(z[1])); w.y = pk2(sigmoidf_(z[2]), sigmoidf_(z[3])); *((u32x2*)(SGL + (size_t)m * 128) + (lane - 32)) = w; } }
        { const u32x2 c = *((const u32x2*)(ZM + (size_t)m * 512) + lane); const float z[4] = {lo2f(c.x), hi2f(c.x), lo2f(c.y), hi2f(c.y)};
          u32x2 c2 = (u32x2){0u, 0u}; if (lane < 32) c2 = *((const u32x2*)(ZM + (size_t)m * 512 + 256) + lane); const float y[4] = {lo2f(c2.x), hi2f(c2.x), lo2f(c2.y), hi2f(c2.y)};
          const float rstd = 1.0f / sqrtf(wave_sum((z[0] * z[0] + z[1] * z[1]) + (z[2] * z[2] + z[3] * z[3])) * (1.f / 256.f) + EPS);
          const float rstd2 = 1.0f / sqrtf(wave_sum((y[0] * y[0] + y[1] * y[1]) + (y[2] * y[2] + y[3] * y[3])) * (1.f / 128.f) + EPS);
          u32x2 w; w.x = pk2(z[0] * rstd * gq.x, z[1] * rstd * gq.y); w.y = pk2(z[2] * rstd * gq.z, z[3] * rstd * gq.w);
          *((u32x2*)(QA + (size_t)m * 256) + lane) = w;
          if (lane < 32) { u32x2 w2; w2.x = pk2(y[0] * rstd2 * gk.x, y[1] * rstd2 * gk.y); w2.y = pk2(y[2] * rstd2 * gk.z, y[3] * rstd2 * gk.w);
              *((u32x2*)(KVA + (size_t)m * 128) + lane) = w2; } }
    }
}

__device__ __forceinline__ void p_prep_c(const Frame& F, ArgsP a) {
    const int lane_f = lane_id_fresh(), tid_f = F.wave * 64 + lane_f;
    bf16* Q = (bf16*)(F.dob + DO_Q); const bf16* KN = (const bf16*)(F.dob + DO_KN); const bf16* ZM = (const bf16*)(F.ws + WS_ZM); bf16* KC = (bf16*)(F.ws + WS_KC);
    const float* cs = (const float*)(F.ws + WS_CS);
    const float* qn = a->in[I_QN]; const float* kn = a->in[I_KN];
    const int lane = lane_f, hd = lane >> 3, j = lane & 7;
    for (int m = F.gw; m < NTOK; m += F.NGW) {
        const f32x2 cc = *(const f32x2*)(cs + (size_t)m * 32 + 2 * j), sn = *(const f32x2*)(cs + (size_t)m * 32 + 16 + 2 * j);
        { bf16* qp = Q + (size_t)m * 768 + hd * 96; float v[8]; unpack8(*(const u32x4*)(qp + 8 * j), v);
          const unsigned w1 = *(const unsigned*)(qp + 64 + 2 * j), w2 = *(const unsigned*)(qp + 80 + 2 * j); float x1[2] = {lo2f(w1), hi2f(w1)}, x2[2] = {lo2f(w2), hi2f(w2)};
          float ss = (x1[0] * x1[0] + x1[1] * x1[1]) + (x2[0] * x2[0] + x2[1] * x2[1]);
#pragma unroll
          for (int i = 0; i < 8; ++i) ss += v[i] * v[i];
          const float rstd = 1.0f / sqrtf(sum8(ss) * (1.f / 96.f) + EPS);
#pragma unroll
          for (int i = 0; i < 8; ++i) v[i] = v[i] * rstd * qn[8 * j + i] * QSCALE;
          x1[0] *= rstd * qn[64 + 2 * j]; x1[1] *= rstd * qn[65 + 2 * j]; x2[0] *= rstd * qn[80 + 2 * j]; x2[1] *= rstd * qn[81 + 2 * j];
          const float o1a = (x1[0] * cc.x - x2[0] * sn.x) * QSCALE, o1b = (x1[1] * cc.y - x2[1] * sn.y) * QSCALE, o2a = (x2[0] * cc.x + x1[0] * sn.x) * QSCALE, o2b = (x2[1] * cc.y + x1[1] * sn.y) * QSCALE;
          *(u32x4*)(qp + 8 * j) = pack8(v); *(unsigned*)(qp + 64 + 2 * j) = pk2(o1a, o1b); *(unsigned*)(qp + 80 + 2 * j) = pk2(o2a, o2b); }
        { float v[8]; unpack8(*(const u32x4*)(KN + (size_t)m * 512 + hd * 64 + 8 * j), v);
          const unsigned w1 = *(const unsigned*)(ZM + (size_t)m * 512 + 384 + 2 * j), w2 = *(const unsigned*)(ZM + (size_t)m * 512 + 400 + 2 * j); float x1[2] = {lo2f(w1), hi2f(w1)}, x2[2] = {lo2f(w2), hi2f(w2)};
          float ss = (x1[0] * x1[0] + x1[1] * x1[1]) + (x2[0] * x2[0] + x2[1] * x2[1]);
#pragma unroll
          for (int i = 0; i < 8; ++i) ss += v[i] * v[i];
          const float rstd = 1.0f / sqrtf(sum8(ss) * (1.f / 96.f) + EPS);
#pragma unroll
          for (int i = 0; i < 8; ++i) v[i] = v[i] * rstd * kn[8 * j + i];
          x1[0] *= rstd * kn[64 + 2 * j]; x1[1] *= rstd * kn[65 + 2 * j]; x2[0] *= rstd * kn[80 + 2 * j]; x2[1] *= rstd * kn[81 + 2 * j];
          bf16* kp = KC + (size_t)m * 768 + hd * 96;
          *(u32x4*)(kp + 8 * j) = pack8(v); *(unsigned*)(kp + 64 + 2 * j) = pk2(x1[0] * cc.x - x2[0] * sn.x, x1[1] * cc.y - x2[1] * sn.y);
          *(unsigned*)(kp + 80 + 2 * j) = pk2(x2[0] * cc.x + x1[0] * sn.x, x2[1] * cc.y + x1[1] * sn.y); }
    }
}

constexpr int SC_T = 32;
constexpr int SC_BUF = 5 * SC_T * 64 * 4 + SC_T * 16 * 4 + SC_T * 16 * 4;
struct ScanRaw { u32x2 rc[2], rp[2], kc[2], kp[2], av[2], lw[2]; u32x4 vc, vp; };
__device__ __forceinline__ void scan_issue(ScanRaw& R, const bf16* ZR, const bf16* A, const bf16* LW, size_t row0, int t0, int st2, int col, int s2, int cv, bool dov) {
#pragma unroll
    for (int u = 0; u < 2; ++u) { const int tt = t0 + st2 + 16 * u; const size_t g = row0 + tt; const size_t gp = row0 + (tt > 0 ? tt - 1 : 0);
        R.rc[u] = *(const u32x2*)(ZR + g * 1792 + col); R.rp[u] = *(const u32x2*)(ZR + gp * 1792 + col);
        R.kc[u] = *(const u32x2*)(ZR + g * 1792 + 512 + col); R.kp[u] = *(const u32x2*)(ZR + gp * 1792 + 512 + col);
        R.av[u] = *(const u32x2*)(A + g * 512 + col); R.lw[u] = *(const u32x2*)(LW + g * 512 + col); }
    { const int tv = t0 + (dov ? s2 : 0); const size_t gv = row0 + tv; const size_t gvp = row0 + (tv > 0 ? tv - 1 : 0); R.vc = *(const u32x4*)(ZR + gv * 1792 + 1024 + cv); R.vp = *(const u32x4*)(ZR + gvp * 1792 + 1024 + cv); }
}
__device__ __forceinline__ void p_scan(const Frame& F, ArgsP a) {
    const int lane_f = lane_id_fresh(), tid_f = F.wave * 64 + lane_f;
    const bf16* ZR = (const bf16*)(F.ws + WS_ZR); const bf16* A = (const bf16*)(F.ws + WS_A); const bf16* LW = (const bf16*)(F.ws + WS_LW); bf16* Y = (bf16*)(F.ws + WS_Y);
    const float* mu = a->in[I_MU]; const float* k_k = a->in[I_KK]; const float* k_a = a->in[I_KA];
    const int lane = lane_f, wave = F.wave, tid = tid_f;
    for (int item = F.vcu; item < 256; item += F.G) {
        const int bh = item >> 2, qt = item & 3, b = bh >> 3, h = bh & 7;
        const size_t row0 = (size_t)b * SEQ; const int colh = h * 64;
        const int NCH = SEQ / SC_T;
        __syncthreads();
        if (wave >= 4) {
            const int lt = tid - 256, st2 = lt >> 4, j4 = (lt & 15) * 4, col = colh + j4, s2 = lt >> 1, hf = lt & 1, cv = colh + qt * 16 + hf * 8; const bool dov = lt < 64;
            f32x4 mur = *(const f32x4*)(mu + col), muk = *(const f32x4*)(mu + 512 + col), kkc = *(const f32x4*)(k_k + col), kac = *(const f32x4*)(k_a + col);
            f32x4 m0 = *(const f32x4*)(mu + 1024 + cv), m1 = *(const f32x4*)(mu + 1024 + cv + 4);
            asm volatile("" : "+v"(mur), "+v"(muk), "+v"(kkc), "+v"(kac), "+v"(m0), "+v"(m1));
            ScanRaw R0, R1;
            scan_issue(R0, ZR, A, LW, row0, 0, st2, col, s2, cv, dov);
#define SCAN_BUILD(RR, c_) do { LAS unsigned char* bs = F.lds + ((c_) & 1) * SC_BUF; \
                _Pragma("unroll") for (int u = 0; u < 2; ++u) { const int st = st2 + 16 * u; const bool t0_ = ((c_) * SC_T + st) == 0; \
                    const f32x4 rc = {lo2f(RR.rc[u].x), hi2f(RR.rc[u].x), lo2f(RR.rc[u].y), hi2f(RR.rc[u].y)}; f32x4 rp = {lo2f(RR.rp[u].x), hi2f(RR.rp[u].x), lo2f(RR.rp[u].y), hi2f(RR.rp[u].y)}; \
                    const f32x4 kc = {lo2f(RR.kc[u].x), hi2f(RR.kc[u].x), lo2f(RR.kc[u].y), hi2f(RR.kc[u].y)}; f32x4 kp = {lo2f(RR.kp[u].x), hi2f(RR.kp[u].x), lo2f(RR.kp[u].y), hi2f(RR.kp[u].y)}; \
                    const f32x4 av = {lo2f(RR.av[u].x), hi2f(RR.av[u].x), lo2f(RR.av[u].y), hi2f(RR.av[u].y)}; const f32x4 lw = {lo2f(RR.lw[u].x), hi2f(RR.lw[u].x), lo2f(RR.lw[u].y), hi2f(RR.lw[u].y)}; \
                    if (t0_) { rp = (f32x4){0.f, 0.f, 0.f, 0.f}; kp = rp; } \
                    const f32x4 r = rc + (rp - rc) * mur, zk = kc + (kp - kc) * muk, kq = zk * ((av - 1.0f) * kac + 1.0f), kr = zk * kkc; \
                    const float ss = allsum16((kr.x * kr.x + kr.y * kr.y) + (kr.z * kr.z + kr.w * kr.w)); const float inv = 1.0f / fmaxf(sqrtf(ss), 1e-12f); \
                    const f32x4 kk = kr * inv; const f32x4 wv = {__expf(lw.x), __expf(lw.y), __expf(lw.z), __expf(lw.w)}; \
                    LAS float* dst = (LAS float*)bs + st * 64 + j4; \
                    *(LAS f32x4*)dst = wv; *(LAS f32x4*)(dst + SC_T * 64) = -kk; *(LAS f32x4*)(dst + 2 * SC_T * 64) = kk * av; *(LAS f32x4*)(dst + 3 * SC_T * 64) = kq; *(LAS f32x4*)(dst + 4 * SC_T * 64) = r; } \
                if (dov) { float vc[8], vp[8]; unpack8(RR.vc, vc); unpack8(RR.vp, vp); if ((c_) * SC_T + s2 == 0) { _Pragma("unroll") for (int i = 0; i < 8; ++i) vp[i] = 0.f; } \
                    LAS float* dv = (LAS float*)(bs + 5 * SC_T * 256) + s2 * 16 + hf * 8; \
                    *(LAS f32x4*)dv = (f32x4){vc[0] + (vp[0] - vc[0]) * m0.x, vc[1] + (vp[1] - vc[1]) * m0.y, vc[2] + (vp[2] - vc[2]) * m0.z, vc[3] + (vp[3] - vc[3]) * m0.w}; \
                    *(LAS f32x4*)(dv + 4) = (f32x4){vc[4] + (vp[4] - vc[4]) * m1.x, vc[5] + (vp[5] - vc[5]) * m1.y, vc[6] + (vp[6] - vc[6]) * m1.z, vc[7] + (vp[7] - vc[7]) * m1.w}; } } while (0)
#define SCAN_FLUSH(c_) do { if ((c_) >= 2 && dov) { LAS unsigned char* bs = F.lds + ((c_) & 1) * SC_BUF; const LAS float* yy = (const LAS float*)(bs + 5 * SC_T * 256 + SC_T * 64) + s2 * 16 + hf * 8; \
                const f32x4 y0 = *(const LAS f32x4*)yy, y1 = *(const LAS f32x4*)(yy + 4); const float v[8] = {y0.x, y0.y, y0.z, y0.w, y1.x, y1.y, y1.z, y1.w}; \
                *(u32x4*)(Y + (row0 + (size_t)((c_) - 2) * SC_T + s2) * 512 + cv) = pack8(v); } } while (0)
            for (int c = 0; c <= NCH + 1; c += 2) {
                SCAN_FLUSH(c);
                scan_issue(R1, ZR, A, LW, row0, (c + 1 < NCH ? c + 1 : NCH - 1) * SC_T, st2, col, s2, cv, dov);
                if (c < NCH) SCAN_BUILD(R0, c);
                LDS_BAR();
                SCAN_FLUSH(c + 1);
                scan_issue(R0, ZR, A, LW, row0, (c + 2 < NCH ? c + 2 : NCH - 1) * SC_T, st2, col, s2, cv, dov);
                if (c + 1 < NCH) SCAN_BUILD(R1, c + 1);
                LDS_BAR();
            }
#undef SCAN_BUILD
#undef SCAN_FLUSH
        } else {
            const int rg = lane >> 4, jl = lane & 15;
            f32x2 Sa = {0.f, 0.f}, Sb = {0.f, 0.f};
            for (int c = 0; c <= NCH + 1; c += 2) {
#pragma unroll
                for (int half = 0; half < 2; ++half) {
                    const int cc = c + half;
                    if (cc >= 1 && cc <= NCH) {
                        LAS unsigned char* bc = F.lds + ((cc + 1) & 1) * SC_BUF;
                        const LAS float* base = (const LAS float*)bc + 4 * jl;
                        const LAS float* vb = (const LAS float*)(bc + 5 * SC_T * 256) + wave * 4 + rg;
                        LAS float* yb = (LAS float*)(bc + 5 * SC_T * 256 + SC_T * 64) + wave * 4 + rg;
                        f32x4 w[2][2], nk[2][2], bb[2][2], kv[2][2], rr[2][2]; float vv1[2][2];
#define SC_LOAD(slot, g_) do { _Pragma("unroll") for (int q = 0; q < 2; ++q) { const int st_ = (g_) * 2 + q; \
                            w[slot][q] = *(const LAS f32x4*)(base + st_ * 64); nk[slot][q] = *(const LAS f32x4*)(base + SC_T * 64 + st_ * 64); bb[slot][q] = *(const LAS f32x4*)(base + 2 * SC_T * 64 + st_ * 64); \
                            kv[slot][q] = *(const LAS f32x4*)(base + 3 * SC_T * 64 + st_ * 64); rr[slot][q] = *(const LAS f32x4*)(base + 4 * SC_T * 64 + st_ * 64); vv1[slot][q] = vb[st_ * 16]; } } while (0)
                        SC_LOAD(0, 0);
#pragma unroll
                        for (int g = 0; g < SC_T / 2; ++g) {
                            const int sl = g & 1;
                            if (g + 1 < SC_T / 2) { if (sl == 0) SC_LOAD(1, g + 1); else SC_LOAD(0, g + 1); }
                            float yo[2];
#pragma unroll
                            for (int q = 0; q < 2; ++q) {
                                const f32x4 w_ = w[sl][q], nk_ = nk[sl][q], bb_ = bb[sl][q], kv_ = kv[sl][q], rr_ = rr[sl][q]; const float v = vv1[sl][q];
                                const f32x2 t0 = Sa * (f32x2){nk_.x, nk_.y} + Sb * (f32x2){nk_.z, nk_.w};
                                const float sa = allsum16(t0.x + t0.y);
                                const f32x2 vv = {v, v}, ss = {sa, sa};
                                Sa = Sa * (f32x2){w_.x, w_.y} + (ss * (f32x2){bb_.x, bb_.y} + vv * (f32x2){kv_.x, kv_.y});
                                Sb = Sb * (f32x2){w_.z, w_.w} + (ss * (f32x2){bb_.z, bb_.w} + vv * (f32x2){kv_.z, kv_.w});
                                const f32x2 t1 = Sa * (f32x2){rr_.x, rr_.y} + Sb * (f32x2){rr_.z, rr_.w};
                                yo[q] = allsum16(t1.x + t1.y);
                            }
                            if (jl == 0) { yb[(g * 2) * 16] = yo[0]; yb[(g * 2 + 1) * 16] = yo[1]; }
                        }
#undef SC_LOAD
                    }
                    LDS_BAR();
                }
            }
        }
    }
}

__device__ __forceinline__ void p_attn_naive(const Frame& F) {
    const int lane_f = lane_id_fresh(), tid_f = F.wave * 64 + lane_f;
    const bf16* Q = (const bf16*)(F.dob + DO_Q); const bf16* KC = (const bf16*)(F.ws + WS_KC); const bf16* VC = (const bf16*)(F.ws + WS_VC); bf16* YM = (bf16*)(F.ws + WS_YM);
    LAS float* Ks = (LAS float*)F.lds; LAS float* Vs = (LAS float*)(F.lds + 32 * 96 * 4);
    const int tid = tid_f;
    for (int unit = F.vcu; unit < 64 * 16; unit += F.G) {
        const int bh = unit >> 4, qb = 15 - (unit & 15), b = bh >> 3, h = bh & 7; const size_t row0 = (size_t)b * SEQ; const int t = qb * 512 + tid;
        unsigned qp[48];
        { const u32x4* qg = (const u32x4*)(Q + (row0 + t) * 768 + h * 96);
#pragma unroll
          for (int i = 0; i < 12; ++i) { const u32x4 w = qg[i]; qp[4 * i] = w.x; qp[4 * i + 1] = w.y; qp[4 * i + 2] = w.z; qp[4 * i + 3] = w.w; } }
        float o[64];
#pragma unroll
        for (int i = 0; i < 64; ++i) o[i] = 0.f;
        float mx = -INFINITY, l = 0.f;
        const int nkt = (qb + 1) * 16;
        for (int kt = 0; kt < nkt; ++kt) {
            __syncthreads();
            if (tid < 384) { const int r = tid / 12, c8 = (tid % 12) * 8; float v[8]; unpack8(*(const u32x4*)(KC + (row0 + kt * 32 + r) * 768 + h * 96 + c8), v);
#pragma unroll
                for (int i = 0; i < 8; ++i) Ks[r * 96 + c8 + i] = v[i]; }
            if (tid < 256) { const int r = tid >> 3, c8 = (tid & 7) * 8; float v[8]; unpack8(*(const u32x4*)(VC + (row0 + kt * 32 + r) * 512 + h * 64 + c8), v);
#pragma unroll
                for (int i = 0; i < 8; ++i) Vs[r * 64 + c8 + i] = v[i]; }
            __syncthreads();
            for (int kk = 0; kk < 32; ++kk) {
                const int kv = kt * 32 + kk;
                float s = 0.f; const LAS f32x4* kr = (const LAS f32x4*)(Ks + kk * 96);
#pragma unroll
                for (int i = 0; i < 24; ++i) { const f32x4 k4 = kr[i]; s += lo2f(qp[2 * i]) * k4.x + hi2f(qp[2 * i]) * k4.y + lo2f(qp[2 * i + 1]) * k4.z + hi2f(qp[2 * i + 1]) * k4.w; }
                if (kv <= t) {
                    const float mn = fmaxf(mx, s), f = exp2f(mx - mn), p = exp2f(s - mn); mx = mn; l = l * f + p;
                    const LAS f32x4* vr = (const LAS f32x4*)(Vs + kk * 64);
#pragma unroll
                    for (int i = 0; i < 16; ++i) { const f32x4 v4 = vr[i]; o[4 * i] = o[4 * i] * f + p * v4.x; o[4 * i + 1] = o[4 * i + 1] * f + p * v4.y; o[4 * i + 2] = o[4 * i + 2] * f + p * v4.z; o[4 * i + 3] = o[4 * i + 3] * f + p * v4.w; }
                }
            }
        }
        const float il = 1.f / l; u32x4* og = (u32x4*)(YM + (row0 + t) * 512 + h * 64);
#pragma unroll
        for (int i = 0; i < 8; ++i) { u32x4 w; w.x = pk2(o[8 * i] * il, o[8 * i + 1] * il); w.y = pk2(o[8 * i + 2] * il, o[8 * i + 3] * il); w.z = pk2(o[8 * i + 4] * il, o[8 * i + 5] * il); w.w = pk2(o[8 * i + 6] * il, o[8 * i + 7] * il); og[i] = w; }
    }
    __syncthreads();
}

typedef float f32x16 __attribute__((ext_vector_type(16)));
typedef short s16x4 __attribute__((ext_vector_type(4)));
__device__ __forceinline__ int crow(int r, int hi) { return (r & 3) + 8 * (r >> 2) + 4 * hi; }
__device__ __forceinline__ float xhalf_max(float x) { auto rr = __builtin_amdgcn_permlane32_swap(__float_as_uint(x), __float_as_uint(x), false, false); return fmaxf(__uint_as_float(rr[0]), __uint_as_float(rr[1])); }
__device__ __forceinline__ float xhalf_sum(float x) { auto rr = __builtin_amdgcn_permlane32_swap(__float_as_uint(x), __float_as_uint(x), false, false); return __uint_as_float(rr[0]) + __uint_as_float(rr[1]); }
__device__ __forceinline__ bf16x8 packp(const f32x16& p, int s2) {
    u32x4 w; w.x = pk2(p[8 * s2 + 0], p[8 * s2 + 1]); w.y = pk2(p[8 * s2 + 2], p[8 * s2 + 3]); w.z = pk2(p[8 * s2 + 4], p[8 * s2 + 5]); w.w = pk2(p[8 * s2 + 6], p[8 * s2 + 7]);
    return __builtin_bit_cast(bf16x8, w);
}
__device__ __forceinline__ void p_attn_mfma(const Frame& F) {
    const int lane_f = lane_id_fresh(), tid_f = F.wave * 64 + lane_f;
    const bf16* Q = (const bf16*)(F.dob + DO_Q); const bf16* KC = (const bf16*)(F.ws + WS_KC); const bf16* VC = (const bf16*)(F.ws + WS_VC); bf16* YM = (bf16*)(F.ws + WS_YM);
    constexpr int KST = 208, VST = 192, KBYTES = 64 * KST, SUB = KBYTES + 64 * VST, BUF = 2 * SUB;
    const int tid = tid_f, lane = lane_f, wave = F.wave, r = lane & 31, hi = lane >> 5;
    int kg[3], kl[3], vg[2], vl[2];
#pragma unroll
    for (int i = 0; i < 3; ++i) { const int c = tid + 512 * i, row = c / 12, pc = c % 12; kg[i] = row * 768 + pc * 8; kl[i] = (row >> 6) * SUB + (row & 63) * KST + pc * 16; }
#pragma unroll
    for (int i = 0; i < 2; ++i) { const int c = tid + 512 * i, row = c >> 3, pc = c & 7; vg[i] = row * 512 + pc * 8; vl[i] = (row >> 6) * SUB + KBYTES + (row & 63) * VST + pc * 16; }
    const int g4 = lane >> 4, li = lane & 15;
    const int vtr = (4 * (g4 >> 1) + (li >> 2)) * VST + (16 * (g4 & 1) + 4 * (li & 3)) * 2;
    const int kfr = r * KST + hi * 16;
    LAS unsigned char* lds = F.lds;
    for (int item = F.vcu; item < 1024; item += F.G) {
        const int bh = item >> 4, sidx = item & 15, b = bh >> 3, h = bh & 7; const size_t row0 = (size_t)b * SEQ;
        const bf16* Kg = KC + row0 * 768 + h * 96; const bf16* Vg = VC + row0 * 512 + h * 64;
        for (int uu = 0; uu < 2; ++uu) {
            const int qb = uu == 0 ? 31 - sidx : sidx, q0 = qb * 256, NT = (q0 + 256) / 128;
            const int qw = q0 + wave * 32;
            bf16x8 qf[6];
            { const bf16* qp = Q + (row0 + qw + r) * 768 + h * 96 + hi * 8;
#pragma unroll
              for (int s = 0; s < 6; ++s) qf[s] = *(const bf16x8*)(qp + 16 * s); }
            f32x16 o0 = {}, o1 = {}; float m = -INFINITY, l = 0.f;
            u32x4 ak[3], av[2];
#pragma unroll
            for (int i = 0; i < 3; ++i) ak[i] = *(const u32x4*)(Kg + kg[i]);
#pragma unroll
            for (int i = 0; i < 2; ++i) av[i] = *(const u32x4*)(Vg + vg[i]);
            asm volatile("" : "+v"(qf[0]), "+v"(qf[1]), "+v"(qf[2]), "+v"(qf[3]), "+v"(qf[4]), "+v"(qf[5]));
            LDS_BAR();
#pragma unroll
            for (int i = 0; i < 3; ++i) *(LAS u32x4*)(lds + kl[i]) = ak[i];
#pragma unroll
            for (int i = 0; i < 2; ++i) *(LAS u32x4*)(lds + vl[i]) = av[i];
            LDS_BAR();
            for (int t = 0; t < NT; ++t) {
                LAS unsigned char* bb = lds + (t & 1) * BUF;
                { const int tn = (t + 1 < NT) ? t + 1 : t;
                  const bf16* kgp = Kg + (size_t)tn * 128 * 768; const bf16* vgp = Vg + (size_t)tn * 128 * 512;
#pragma unroll
                  for (int i = 0; i < 3; ++i) ak[i] = *(const u32x4*)(kgp + kg[i]);
#pragma unroll
                  for (int i = 0; i < 2; ++i) av[i] = *(const u32x4*)(vgp + vg[i]); }
#pragma unroll
                for (int sub = 0; sub < 2; ++sub) {
                    const int tt = 2 * t + sub;
                    if (64 * tt <= qw + 31) {
                        LAS unsigned char* kb = bb + sub * SUB; LAS unsigned char* vb = kb + KBYTES;
                        f32x16 p0 = {}, p1 = {};
#pragma unroll
                        for (int s = 0; s < 6; ++s) { const bf16x8 k0 = *(const LAS bf16x8*)(kb + kfr + s * 32), k1 = *(const LAS bf16x8*)(kb + kfr + 32 * KST + s * 32);
                            p0 = __builtin_amdgcn_mfma_f32_32x32x16_bf16(k0, qf[s], p0, 0, 0, 0); p1 = __builtin_amdgcn_mfma_f32_32x32x16_bf16(k1, qf[s], p1, 0, 0, 0); }
                        if (64 * tt + 63 > qw) {
                            const int qrel = qw + r - 64 * tt;
#pragma unroll
                            for (int rg = 0; rg < 16; ++rg) { const int kv = crow(rg, hi); if (kv > qrel) p0[rg] = -INFINITY; if (kv + 32 > qrel) p1[rg] = -INFINITY; }
                        }
                        float mx = fmaxf(p0[0], p1[0]);
#pragma unroll
                        for (int rg = 1; rg < 16; ++rg) mx = fmaxf(mx, fmaxf(p0[rg], p1[rg]));
                        mx = xhalf_max(mx);
                        if (!__all(mx <= m + 8.0f)) {
                            const float mn = fmaxf(m, mx), f = __builtin_amdgcn_exp2f(m - mn); m = mn; l *= f;
#pragma unroll
                            for (int rg = 0; rg < 16; ++rg) { o0[rg] *= f; o1[rg] *= f; }
                        }
                        float rs = 0.f;
#pragma unroll
                        for (int rg = 0; rg < 16; ++rg) { p0[rg] = __builtin_amdgcn_exp2f(p0[rg] - m); p1[rg] = __builtin_amdgcn_exp2f(p1[rg] - m); rs += p0[rg] + p1[rg]; }
                        l += rs;
#pragma unroll
                        for (int hh = 0; hh < 2; ++hh)
#pragma unroll
                            for (int s2 = 0; s2 < 2; ++s2) { const bf16x8 pf = packp(hh == 0 ? p0 : p1, s2);
#pragma unroll
                                for (int db = 0; db < 2; ++db) { LAS unsigned char* vp_ = vb + vtr + (32 * hh + 16 * s2) * VST + db * 64;
                                    const s16x4 lo = __builtin_bit_cast(s16x4, __builtin_amdgcn_ds_read_tr16_b64_v4i16((LAS s16x4*)vp_));
                                    const s16x4 hi4 = __builtin_bit_cast(s16x4, __builtin_amdgcn_ds_read_tr16_b64_v4i16((LAS s16x4*)(vp_ + 8 * VST)));
                                    const bf16x8 vf = (bf16x8){lo[0], lo[1], lo[2], lo[3], hi4[0], hi4[1], hi4[2], hi4[3]};
                                    if (db == 0) o0 = __builtin_amdgcn_mfma_f32_32x32x16_bf16(vf, pf, o0, 0, 0, 0); else o1 = __builtin_amdgcn_mfma_f32_32x32x16_bf16(vf, pf, o1, 0, 0, 0); } }
                    }
                }
                { LAS unsigned char* nb = lds + ((t + 1) & 1) * BUF;
#pragma unroll
                  for (int i = 0; i < 3; ++i) *(LAS u32x4*)(nb + kl[i]) = ak[i];
#pragma unroll
                  for (int i = 0; i < 2; ++i) *(LAS u32x4*)(nb + vl[i]) = av[i]; }
                LDS_BAR();
            }
            const float il = 1.0f / xhalf_sum(l);
            bf16* op = YM + (row0 + qw + r) * 512 + h * 64 + 4 * hi;
#pragma unroll
            for (int gq = 0; gq < 4; ++gq) { u32x2 w0, w1;
                w0.x = pk2(o0[4 * gq] * il, o0[4 * gq + 1] * il); w0.y = pk2(o0[4 * gq + 2] * il, o0[4 * gq + 3] * il);
                w1.x = pk2(o1[4 * gq] * il, o1[4 * gq + 1] * il); w1.y = pk2(o1[4 * gq + 2] * il, o1[4 * gq + 3] * il);
                *(u32x2*)(op + 8 * gq) = w0; *(u32x2*)(op + 32 + 8 * gq) = w1; }
        }
    }
    __syncthreads();
}

__device__ __forceinline__ void p_post_scan(const Frame& F, ArgsP a, bf16* YD) {
    const int lane_f = lane_id_fresh();
    bf16* Y = (bf16*)(F.ws + WS_Y); const bf16* ZR = (const bf16*)(F.ws + WS_ZR); const bf16* A = (const bf16*)(F.ws + WS_A); const bf16* G = (const bf16*)(F.dob + DO_G);
    const float* lnw = a->in[I_LNW]; const float* lnb = a->in[I_LNB]; const float* rk = a->in[I_RK]; const float* mu = a->in[I_MU]; const float* k_a = a->in[I_KA];
    const int lane = lane_f;
    for (int m = F.gw; m < NTOK; m += F.NGW) {
        const bool first = (m % SEQ) == 0; const size_t mp = first ? m : m - 1;
        float y[8], r[8], k[8], v[8], g[8], o[8], t[8], av[8];
        unpack8(*((const u32x4*)(Y + (size_t)m * 512) + lane), y); unpack8(*((const u32x4*)(G + (size_t)m * 512) + lane), g); unpack8(*((const u32x4*)(A + (size_t)m * 512) + lane), av);
        unpack8(*((const u32x4*)(ZR + (size_t)m * 1792) + lane), r); unpack8(*((const u32x4*)(ZR + mp * 1792) + lane), t);
#pragma unroll
        for (int i = 0; i < 8; ++i) r[i] += ((first ? 0.f : t[i]) - r[i]) * mu[8 * lane + i];
        unpack8(*((const u32x4*)(ZR + (size_t)m * 1792 + 512) + lane), k); unpack8(*((const u32x4*)(ZR + mp * 1792 + 512) + lane), t);
#pragma unroll
        for (int i = 0; i < 8; ++i) { const float zk = k[i] + ((first ? 0.f : t[i]) - k[i]) * mu[512 + 8 * lane + i]; k[i] = zk * (1.f + (av[i] - 1.f) * k_a[8 * lane + i]); }
        unpack8(*((const u32x4*)(ZR + (size_t)m * 1792 + 1024) + lane), v); unpack8(*((const u32x4*)(ZR + mp * 1792 + 1024) + lane), t);
#pragma unroll
        for (int i = 0; i < 8; ++i) v[i] += ((first ? 0.f : t[i]) - v[i]) * mu[1024 + 8 * lane + i];
        float s = 0.f, d = 0.f;
#pragma unroll
        for (int i = 0; i < 8; ++i) { s += y[i]; d += r[i] * k[i] * rk[8 * lane + i]; }
        const float mean = sum8(s) * (1.f / 64.f); d = sum8(d); float q = 0.f;
#pragma unroll
        for (int i = 0; i < 8; ++i) { y[i] -= mean; q += y[i] * y[i]; }
        const float rstd = 1.0f / sqrtf(sum8(q) * (1.f / 64.f) + LN_X_EPS);
#pragma unroll
        for (int i = 0; i < 8; ++i) o[i] = (y[i] * rstd * lnw[8 * lane + i] + lnb[8 * lane + i] + d * v[i]) * g[i];
        *((u32x4*)(YD + (size_t)m * 512) + lane) = pack8(o);
    }
}

__device__ __forceinline__ void p_ffn_route(const Frame& F, ArgsP a, unsigned* cnt, int* route) {
    const int lane_f = lane_id_fresh(), tid_f = F.wave * 64 + lane_f;
    const float* X1 = (const float*)F.dob; bf16* H2 = (bf16*)(F.ws + WS_H2); const float* mod = (const float*)(F.ws + WS_MOD); const float* g = a->in[I_GFFN];
    LAS float* wr = (LAS float*)F.lds;
    __syncthreads();
    for (int i = tid_f; i < 1024 * 4; i += NTHR) { const int k = i >> 2, o = i & 3; wr[o * 1024 + k] = a->in[I_WRG][i]; }
    for (int i = tid_f; i < 1024 * 32; i += NTHR) { const int k = i >> 5, o = i & 31; wr[(4 + o) * 1024 + k] = a->in[I_WRE][i]; }
    __syncthreads();
    const float* brg = a->in[I_BRG]; const float* bre = a->in[I_BRE];
    const int lane = lane_f;
    LAS unsigned* lcnt = (LAS unsigned*)(F.lds + LDS_MISC + 512);
    if (tid_f < 64) lcnt[tid_f] = 0u;
    __syncthreads();
    int my_e0 = 0, my_e1 = 0; float my_w0 = 0.f, my_w1 = 0.f; int kk_ = 0;
    for (int m = F.gw; m < NTOK; m += F.NGW, ++kk_) {
        const int b = m / SEQ; const f32x4* xr = (const f32x4*)(X1 + (size_t)m * 1024) + lane;
        f32x4 v[4]; float s = 0.f;
#pragma unroll
        for (int j = 0; j < 4; ++j) { v[j] = xr[64 * j]; s += (v[j].x * v[j].x + v[j].y * v[j].y) + (v[j].z * v[j].z + v[j].w * v[j].w); }
        const float rstd = 1.0f / sqrtf(wave_sum(s) * (1.f / 1024.f) + EPS);
        u32x2* o = (u32x2*)(H2 + (size_t)m * 1024) + lane;
#pragma unroll
        for (int j = 0; j < 4; ++j) { const int col = 4 * lane + 256 * j;
            const f32x4 gg = *(const f32x4*)(g + col), sc = *(const f32x4*)(mod + b * 6144 + 4096 + col), sh = *(const f32x4*)(mod + b * 6144 + 3072 + col);
            v[j] = v[j] * rstd * gg * (sc + 1.0f) + sh; u32x2 w; w.x = pk2(v[j].x, v[j].y); w.y = pk2(v[j].z, v[j].w); o[64 * j] = w; }
        float lgq[4];
#pragma unroll
        for (int oo = 0; oo < 4; ++oo) { float p = 0.f;
#pragma unroll
            for (int j = 0; j < 4; ++j) { const f32x4 w4 = *(const LAS f32x4*)(wr + oo * 1024 + 4 * lane + 256 * j); p += (v[j].x * w4.x + v[j].y * w4.y) + (v[j].z * w4.z + v[j].w * w4.w); }
            lgq[oo] = wave_sum(p) + brg[oo]; }
        int gi = 0; float gm = lgq[0];
#pragma unroll
        for (int i = 1; i < 4; ++i) { if (lgq[i] > gm) { gm = lgq[i]; gi = i; } }
        float gs = 0.f;
#pragma unroll
        for (int i = 0; i < 4; ++i) gs += __expf(lgq[i] - gm);
        const float pg = 1.f / gs;
        gi = __builtin_amdgcn_readfirstlane(gi);
        float el[8];
        { const LAS float* wg = wr + (4 + gi * 8) * 1024 + 4 * lane;
#pragma unroll
          for (int i = 0; i < 8; ++i) { float p = 0.f;
#pragma unroll
              for (int j = 0; j < 4; ++j) { const f32x4 w4 = *(const LAS f32x4*)(wg + i * 1024 + 256 * j); p += (v[j].x * w4.x + v[j].y * w4.y) + (v[j].z * w4.z + v[j].w * w4.w); }
              el[i] = wave_sum(p) + bre[gi * 8 + i]; } }
        int i0 = 0; float m0 = el[0];
#pragma unroll
        for (int i = 1; i < 8; ++i) if (el[i] > m0) { m0 = el[i]; i0 = i; }
        int i1 = -1; float m1 = -INFINITY;
#pragma unroll
        for (int i = 0; i < 8; ++i) if (i != i0 && el[i] > m1) { m1 = el[i]; i1 = i; }
        const float e1 = __expf(m1 - m0), w0 = pg / (1.f + e1), w1 = pg * e1 / (1.f + e1);
        if (lane == kk_) { my_e0 = gi * 8 + i0; my_e1 = gi * 8 + i1; my_w0 = w0; my_w1 = w1; }
    }
    unsigned lp0 = 0u, lp1 = 0u;
    if (lane < kk_) { lp0 = __hip_atomic_fetch_add(lcnt + my_e0, 1u, __ATOMIC_RELAXED, __HIP_MEMORY_SCOPE_WORKGROUP); lp1 = __hip_atomic_fetch_add(lcnt + my_e1, 1u, __ATOMIC_RELAXED, __HIP_MEMORY_SCOPE_WORKGROUP); }
    __syncthreads();
    if (tid_f < 32) lcnt[32 + tid_f] = __hip_atomic_fetch_add(cnt + tid_f, lcnt[tid_f], __ATOMIC_RELAXED, __HIP_MEMORY_SCOPE_AGENT);
    __syncthreads();
    if (lane < kk_) { const int m = F.gw + lane * F.NGW; int* rt = route + (size_t)m * 8;
        rt[0] = my_e0; rt[1] = my_e1; rt[2] = (int)(lcnt[32 + my_e0] + lp0); rt[3] = (int)(lcnt[32 + my_e1] + lp1); rt[4] = __builtin_bit_cast(int, my_w0); rt[5] = __builtin_bit_cast(int, my_w1); }
    __syncthreads();
}
__device__ __forceinline__ int moe_tables(const Frame& F, LAS int* offs, LAS int* texp) {
    const int lane_f = lane_id_fresh(), tid_f = F.wave * 64 + lane_f;
    const unsigned* cnt = (const unsigned*)(F.ws + WS_CTL) + CW_CNT;
    __syncthreads();
    if (tid_f == 0) { int o = 0; for (int e = 0; e < 32; ++e) { offs[e] = o; const int c = (int)__hip_atomic_load(cnt + e, __ATOMIC_RELAXED, __HIP_MEMORY_SCOPE_AGENT); const int nt = (c + 255) >> 8; for (int t = 0; t < nt; ++t) texp[(o >> 8) + t] = e; o += nt << 8; } offs[32] = o; }
    __syncthreads();
    return offs[32] >> 8;
}
__device__ __forceinline__ void p_gather(const Frame& F) {
    const int lane_f = lane_id_fresh(), tid_f = F.wave * 64 + lane_f;
    LAS int* offs = (LAS int*)(F.lds + 1024); LAS int* texp = (LAS int*)(F.lds + 2048);
    moe_tables(F, offs, texp);
    const bf16* H2 = (const bf16*)(F.ws + WS_H2); bf16* XG = (bf16*)(F.ws + WS_XG); const int* route = (const int*)(F.ws + WS_ROUTE); int* ent = (int*)(F.ws + WS_ENT);
    const unsigned* cnt = (const unsigned*)(F.ws + WS_CTL) + CW_CNT; const int lane = lane_f;
    for (int m = F.gw; m < NTOK; m += F.NGW) {
        const int* rt = route + (size_t)m * 8; const int d0 = offs[rt[0]] + rt[2], d1 = offs[rt[1]] + rt[3];
        const u32x4* src = (const u32x4*)(H2 + (size_t)m * 1024) + lane; const u32x4 a0 = src[0], a1 = src[64];
        u32x4* p0 = (u32x4*)(XG + (size_t)d0 * 1024) + lane; u32x4* p1 = (u32x4*)(XG + (size_t)d1 * 1024) + lane;
        p0[0] = a0; p0[64] = a1; p1[0] = a0; p1[64] = a1;
        if (lane == 0) { ent[2 * d0] = m; ent[2 * d0 + 1] = rt[4]; ent[2 * d1] = m; ent[2 * d1 + 1] = rt[5]; }
    }
    for (int i = F.gw; i < 32 * 256; i += F.NGW) { const int e = i >> 8, r = i & 255; const int c = (int)cnt[e]; const int pad = ((c + 255) & ~255) - c;
        if (r < pad) { u32x4* p = (u32x4*)(XG + (size_t)(offs[e] + c + r) * 1024) + lane; p[0] = (u32x4){0u, 0u, 0u, 0u}; p[64] = (u32x4){0u, 0u, 0u, 0u}; if (lane == 0) { ent[2 * (offs[e] + c + r)] = -1; ent[2 * (offs[e] + c + r) + 1] = 0; } } }
    __syncthreads();
}
__device__ __forceinline__ void p_combine(const Frame& F, float* dst) {
    const int lane_f = lane_id_fresh(), tid_f = F.wave * 64 + lane_f;
    LAS int* offs = (LAS int*)(F.lds + 1024); LAS int* texp = (LAS int*)(F.lds + 2048);
    moe_tables(F, offs, texp);
    float* out = (float*)F.dob; const bf16* YS = (const bf16*)(F.ws + WS_YS); const int* route = (const int*)(F.ws + WS_ROUTE); const float* mod = (const float*)(F.ws + WS_MOD);
    const int lane = lane_f;
    for (int m = F.gw; m < NTOK; m += F.NGW) {
        const int b = m / SEQ; const int* rt = route + (size_t)m * 8; const int d0 = offs[rt[0]] + rt[2], d1 = offs[rt[1]] + rt[3];
        const float w0 = __builtin_bit_cast(float, rt[4]), w1 = __builtin_bit_cast(float, rt[5]);
#pragma unroll
        for (int j = 0; j < 2; ++j) { const int col = 8 * lane + 512 * j; float y0[8], y1[8];
            unpack8(*(const u32x4*)(YS + (size_t)d0 * 1024 + col), y0); unpack8(*(const u32x4*)(YS + (size_t)d1 * 1024 + col), y1);
            float* o = out + (size_t)m * 1024 + col; const float* gt = mod + b * 6144 + 5120 + col;
            f32x4 x0 = *(const f32x4*)o, x1 = *(const f32x4*)(o + 4); const f32x4 g0 = *(const f32x4*)gt, g1 = *(const f32x4*)(gt + 4);
            x0.x += g0.x * (w0 * y0[0] + w1 * y1[0]); x0.y += g0.y * (w0 * y0[1] + w1 * y1[1]); x0.z += g0.z * (w0 * y0[2] + w1 * y1[2]); x0.w += g0.w * (w0 * y0[3] + w1 * y1[3]);
            x1.x += g1.x * (w0 * y0[4] + w1 * y1[4]); x1.y += g1.y * (w0 * y0[5] + w1 * y1[5]); x1.z += g1.z * (w0 * y0[6] + w1 * y1[6]); x1.w += g1.w * (w0 * y0[7] + w1 * y1[7]);
            float* od = dst + (size_t)m * 1024 + col; *(f32x4*)od = x0; *(f32x4*)(od + 4) = x1; }
    }
}

constexpr int NPHASE = 16;
template <int LO, int HI>
__global__ void __launch_bounds__(NTHR, 2) fwd(Args args) {
    extern __shared__ __attribute__((aligned(16))) unsigned char lds_raw[];
    Frame F;
    F.lds = (LAS unsigned char*)lds_raw;
    F.wave = __builtin_amdgcn_readfirstlane((int)threadIdx.x >> 6);
    F.G = gridDim.x; { const int bx = blockIdx.x; F.vcu = (F.G % 8 == 0) ? (bx % 8) * (F.G / 8) + bx / 8 : bx; }
    F.gw = F.vcu * NWAVES + F.wave; F.NGW = F.G * NWAVES;
    F.ws = args.ws; F.dob = (unsigned char*)args.out;
    ArgsP AP = (ArgsP)__builtin_amdgcn_kernarg_segment_ptr();
    volatile LAS unsigned* MISC = (volatile LAS unsigned*)(F.lds + LDS_MISC);
    if (threadIdx.x < 64) MISC[threadIdx.x] = 0u;
    __syncthreads();
    XcdBarrier bar; bar.bar = (unsigned*)(F.ws + WS_CTL) + CW_BAR; bar.x = 0; bar.st = MISC + 8;
#if N_LAUNCH_MODE == 1
    bar = xcd_barrier_post((unsigned*)(F.ws + WS_CTL) + CW_BAR, MISC + 8);
#define GRID_BAR() xcd_barrier(bar)
#else
#define GRID_BAR() do { } while (0)
#endif
#ifndef PROBE_REPEAT
#define PROBE_REPEAT -1
#endif
#define IN(k) (LO <= (k) && (k) < HI)
#define SEAM(k) do { if constexpr (IN(k) && IN((k) + 1)) GRID_BAR(); } while (0)
    const float* mod = (const float*)(F.ws + WS_MOD);

#define PH(k, ...) do { if constexpr (IN(k)) { asm volatile("" : "+s"(AP)); { __VA_ARGS__ } if constexpr (PROBE_REPEAT == (k)) { GRID_BAR(); asm volatile("" : "+s"(AP)); { __VA_ARGS__ } } } } while (0)
    PH(0, p0_prologue(F, AP);); SEAM(0);
    PH(1, p_normmod(F, AP->in[I_X], AP->in[I_GMIX], mod, 0, 1024, (bf16*)(F.ws + WS_H));); SEAM(1);
    PH(2, Gemm g{(const bf16*)(F.ws + WS_H), (const bf16*)(F.ws + WS_WIN), NTOK, N_IN_PAD, 1024}; StaticOrder S; S.init(NTOK, N_IN_PAD, F.G, (int)blockIdx.x);
        EpiZ E{(bf16*)(F.ws + WS_ZR), (bf16*)(F.ws + WS_SG), (bf16*)(F.ws + WS_ZM)}; gemm_phase_any(F.lds, g, S, E, F.wave);); SEAM(2);
    PH(3, p_prep_a(F, AP);); SEAM(3);
    PH(4,
        { Gemm g{(const bf16*)(F.ws + WS_TWA), (const bf16*)(F.ws + WS_WBLK), NTOK, 1024, 128}; StaticOrder S; S.init(NTOK, 1024, F.G, (int)blockIdx.x);
          EpiLora E{(bf16*)(F.ws + WS_LW), (bf16*)(F.ws + WS_A), AP->in[I_W0], AP->in[I_A0]}; gemm_phase_any(F.lds, g, S, E, F.wave); }
        { Gemm g{(const bf16*)(F.ws + WS_SGL), (const bf16*)(F.ws + WS_WG), NTOK, 512, 128}; StaticOrder S; S.init(NTOK, 512, F.G, (int)blockIdx.x);
          EpiPlain E{(bf16*)(F.dob + DO_G), nullptr, 1 << 30, 512, 0}; gemm_phase_any(F.lds, g, S, E, F.wave); }
        { Gemm g{(const bf16*)(F.ws + WS_QA), (const bf16*)(F.ws + WS_WUQ), NTOK, 768, 256}; StaticOrder S; S.init(NTOK, 768, F.G, (int)blockIdx.x);
          EpiPlain E{(bf16*)(F.dob + DO_Q), nullptr, 1 << 30, 768, 0}; gemm_phase_any(F.lds, g, S, E, F.wave); }
        { Gemm g{(const bf16*)(F.ws + WS_KVA), (const bf16*)(F.ws + WS_WUKV), NTOK, 1024, 128}; StaticOrder S; S.init(NTOK, 1024, F.G, (int)blockIdx.x);
          EpiPlain E{(bf16*)(F.dob + DO_KN), (bf16*)(F.ws + WS_VC), 512, 512, 512}; gemm_phase_any(F.lds, g, S, E, F.wave); }
    ); SEAM(4);
    PH(5, p_prep_c(F, AP);); SEAM(5);
    PH(6, p_scan(F, AP);); SEAM(6);
#if ENG_ATTN == 1
    PH(7, p_attn_mfma(F);); SEAM(7);
#else
    PH(7, p_attn_naive(F);); SEAM(7);
#endif
    if constexpr (PROBE_REPEAT == 8) { p_post_scan(F, AP, (bf16*)(F.ws + WS_KK)); GRID_BAR(); }
    if constexpr (IN(8)) { asm volatile("" : "+s"(AP)); p_post_scan(F, AP, (bf16*)(F.ws + WS_Y)); } SEAM(8);
    PH(9,
        { Gemm g{(const bf16*)(F.ws + WS_Y), (const bf16*)(F.ws + WS_WB), NTOK, 1024, 512}; StaticOrder S; S.init(NTOK, 1024, F.G, (int)blockIdx.x);
          EpiBranch<false> E{(bf16*)(F.ws + WS_MG), (const bf16*)(F.ws + WS_SG), 0}; gemm_phase_any(F.lds, g, S, E, F.wave); }
        { Gemm g{(const bf16*)(F.ws + WS_YM), (const bf16*)(F.ws + WS_WB) + (size_t)1024 * 512, NTOK, 1024, 512}; StaticOrder S; S.init(NTOK, 1024, F.G, (int)blockIdx.x);
          EpiBranch<true> E{(bf16*)(F.ws + WS_MG), (const bf16*)(F.ws + WS_SG), 1024}; gemm_phase_any(F.lds, g, S, E, F.wave); }
    ); SEAM(9);
    PH(10, Gemm g{(const bf16*)(F.ws + WS_MG), (const bf16*)(F.ws + WS_WO), NTOK, 1024, 1024}; StaticOrder S; S.init(NTOK, 1024, F.G, (int)blockIdx.x);
        EpiOut E{(float*)F.dob, AP->in[I_X], mod}; gemm_phase_any(F.lds, g, S, E, F.wave);); SEAM(10);
    if constexpr (PROBE_REPEAT == 11) { p_ffn_route(F, AP, (unsigned*)(F.ws + WS_CTL) + CW_CNT + 64, (int*)(F.ws + WS_CS)); GRID_BAR(); }
    if constexpr (IN(11)) { asm volatile("" : "+s"(AP)); p_ffn_route(F, AP, (unsigned*)(F.ws + WS_CTL) + CW_CNT, (int*)(F.ws + WS_ROUTE)); } SEAM(11);
    PH(12, p_gather(F);); SEAM(12);
    PH(13, LAS int* offs = (LAS int*)(F.lds + LDS_MISC + 1024); LAS int* texp = (LAS int*)(F.lds + LDS_MISC + 1024 + 256); const int nt = moe_tables(F, offs, texp);
        Gemm g{(const bf16*)(F.ws + WS_XG), (const bf16*)(F.ws + WS_WGU), MPAD, 512, 1024}; TableOrder S{texp, nt, 2, F.G, (int)blockIdx.x};
        EpiGateUp E{(bf16*)(F.ws + WS_HID)}; gemm_phase_any(F.lds, g, S, E, F.wave);); SEAM(13);
    PH(14, LAS int* offs = (LAS int*)(F.lds + LDS_MISC + 1024); LAS int* texp = (LAS int*)(F.lds + LDS_MISC + 1024 + 256); const int nt = moe_tables(F, offs, texp);
        Gemm g{(const bf16*)(F.ws + WS_HID), (const bf16*)(F.ws + WS_WDN), MPAD, 1024, 256}; TableOrder S{texp, nt, 4, F.G, (int)blockIdx.x};
        EpiDown E{(bf16*)(F.ws + WS_YS)}; gemm_phase_any(F.lds, g, S, E, F.wave);); SEAM(14);
    if constexpr (PROBE_REPEAT == 15) { p_combine(F, (float*)(F.ws + WS_SG)); GRID_BAR(); }
    if constexpr (IN(15)) { p_combine(F, (float*)F.dob); }
}

#if N_LAUNCH_MODE == 1
static bool set_attrs() { return hipFuncSetAttribute((const void*)fwd<0, NPHASE>, hipFuncAttributeMaxDynamicSharedMemorySize, LDS_BYTES) == hipSuccess; }
#else
template <int P> static bool set_attr_all() { if constexpr (P < NPHASE) { return hipFuncSetAttribute((const void*)fwd<P, P + 1>, hipFuncAttributeMaxDynamicSharedMemorySize, LDS_BYTES) == hipSuccess && set_attr_all<P + 1>(); } else return true; }
static bool set_attrs() { return set_attr_all<0>(); }
template <int P> static void launch_all(int grid, hipStream_t stream, const Args& a) { if constexpr (P < NPHASE) { hipLaunchKernelGGL((fwd<P, P + 1>), dim3(grid), dim3(NTHR), LDS_BYTES, stream, a); launch_all<P + 1>(grid, stream, a); } }
#endif
extern "C" void kernel_launch(void* const* d_in, const int* in_sizes, int n_in, void* d_out, int out_size, void* d_ws, size_t ws_size, hipStream_t stream) {
    static int grid = 0;
    if (grid == 0) {
        if (n_in != 34 || out_size != NTOK * DM || ws_size < WS_END) { fprintf(stderr, "kernel_launch: unexpected shapes (n_in %d out %d ws %zu)\n", n_in, out_size, ws_size); grid = -1; return; }
        int dev = 0, cus = 0;
        if (hipGetDevice(&dev) != hipSuccess || hipDeviceGetAttribute(&cus, hipDeviceAttributeMultiprocessorCount, dev) != hipSuccess) { grid = -1; return; }
        if (!set_attrs()) { fprintf(stderr, "kernel_launch: hipFuncSetAttribute failed\n"); grid = -1; return; }
        grid = cus;
    }
    if (grid < 0) return;
    (void)hipMemsetAsync((char*)d_ws + WS_CTL, 0, CTL_ZERO_BYTES, stream);
    Args a{};
    for (int i = 0; i < 34; ++i) a.in[i] = (const float*)d_in[i];
    a.out = (float*)d_out; a.ws = (unsigned char*)d_ws;
    a.ph_lo = 0; a.ph_hi = NPHASE;
#if N_LAUNCH_MODE == 1
    hipLaunchKernelGGL((fwd<0, NPHASE>), dim3(grid), dim3(NTHR), LDS_BYTES, stream, a);
#else
    launch_all<0>(grid, stream, a);
#endif
}
```

```cpp
#include <hip/hip_runtime.h>
#include <cstdio>
#include <cstdint>

#ifndef N_LAUNCH_MODE
#define N_LAUNCH_MODE 1
#endif
#ifndef ENG_GEMM
#define ENG_GEMM 1
#endif
#ifndef ENG_ATTN
#define ENG_ATTN 1
#endif

#define GAS __attribute__((address_space(1)))
#define LAS __attribute__((address_space(3)))
typedef unsigned short bf16;
typedef float f32x4 __attribute__((ext_vector_type(4)));
typedef float f32x2 __attribute__((ext_vector_type(2)));
typedef unsigned u32x4 __attribute__((ext_vector_type(4)));
typedef unsigned u32x2 __attribute__((ext_vector_type(2)));
typedef short bf16x8 __attribute__((ext_vector_type(8)));

constexpr int BATCH = 8, SEQ = 8192, DM = 1024, NTOK = BATCH * SEQ;
constexpr int D_RWKV = 512, RWKV_COLS = 1792, MLA_COLS = 416, D_IN = 4256, N_IN_PAD = 4352;
constexpr int NH = 8, QKD = 96, NOPE = 64, ROPE = 32, VD = 64;
constexpr int NEXP = 32, DEXP = 256;
constexpr int MPAD = 139264;
constexpr float EPS = 1e-6f, LN_X_EPS = 64e-5f;
constexpr float QSCALE = 0.10206207261596577f * 1.4426950408889634f;

constexpr size_t MiB = 1u << 20;
constexpr size_t WS_CTL = 0, CTL_ZERO_BYTES = 1 * MiB;
constexpr size_t WS_MOD = 1 * MiB;
constexpr size_t WS_ROUTE = 2 * MiB;
constexpr size_t WS_CS = 4 * MiB;
constexpr size_t WS_ENT = 12 * MiB;
constexpr size_t WS_WIN = 16 * MiB;
constexpr size_t WS_WBLK = 25 * MiB;
constexpr size_t WS_WG = WS_WBLK + 256 * 1024;
constexpr size_t WS_WUQ = WS_WG + 128 * 1024;
constexpr size_t WS_WUKV = WS_WUQ + 384 * 1024;
constexpr size_t WS_WB = 26 * MiB;
constexpr size_t WS_WO = 28 * MiB;
constexpr size_t WS_WGU = 30 * MiB;
constexpr size_t WS_WDN = 62 * MiB;
constexpr size_t WS_SG = 80 * MiB;
constexpr size_t WS_H2 = 80 * MiB;
constexpr size_t WS_ZR = 336 * MiB;
constexpr size_t WS_VC = 752 * MiB;
constexpr size_t WS_KC = 816 * MiB;
constexpr size_t WS_Y = 912 * MiB;
constexpr size_t WS_XG = 336 * MiB;
constexpr size_t WS_ZM = 560 * MiB;
constexpr size_t WS_YM = 560 * MiB;
constexpr size_t WS_H = 624 * MiB;
constexpr size_t WS_LW = 624 * MiB;
constexpr size_t WS_A = 688 * MiB;
constexpr size_t WS_MG = 624 * MiB;
constexpr size_t WS_HID = 608 * MiB;
constexpr size_t WS_R = 752 * MiB;
constexpr size_t WS_V = 816 * MiB;
constexpr size_t WS_ZK = 880 * MiB;
constexpr size_t WS_TWA = 944 * MiB;
constexpr size_t WS_SGL = 960 * MiB;
constexpr size_t WS_QA = 976 * MiB;
constexpr size_t WS_KVA = 1008 * MiB;
constexpr size_t WS_KK = 944 * MiB;
constexpr size_t WS_YS = 752 * MiB;
constexpr size_t WS_END = 1024 * MiB;
constexpr size_t DO_G = 0;
constexpr size_t DO_Q = 64 * MiB;
constexpr size_t DO_KN = 160 * MiB;

constexpr int CW_CNT = 64;
constexpr int CW_BAR = 4096;

constexpr int NWAVES = 8, NTHR = 512;
constexpr int LDS_BYTES = 155648;
constexpr int LDS_MISC = 151552;

__device__ __forceinline__ int lane_id_fresh() { int l; asm volatile("v_mbcnt_lo_u32_b32 %0, -1, 0\n\tv_mbcnt_hi_u32_b32 %0, -1, %0" : "=v"(l)); return l; }
__device__ __forceinline__ float bf2f(unsigned short h) { return __builtin_bit_cast(float, (unsigned)h << 16); }
__device__ __forceinline__ unsigned f2bf(float f) { unsigned u = __builtin_bit_cast(unsigned, f); return (u + 0x7fffu + ((u >> 16) & 1u)) >> 16; }
typedef __bf16 bf16x2_t __attribute__((ext_vector_type(2)));
__device__ __forceinline__ unsigned pk2(float lo, float hi) { const f32x2 v = {lo, hi}; return __builtin_bit_cast(unsigned, __builtin_convertvector(v, bf16x2_t)); }
__device__ __forceinline__ float lo2f(unsigned w) { return __builtin_bit_cast(float, w << 16); }
__device__ __forceinline__ float hi2f(unsigned w) { return __builtin_bit_cast(float, w & 0xffff0000u); }
template <int CTRL> __device__ __forceinline__ float dpp_add(float x) { return x + __builtin_bit_cast(float, __builtin_amdgcn_update_dpp(0, __builtin_bit_cast(int, x), CTRL, 0xf, 0xf, false)); }
__device__ __forceinline__ float allsum16(float x) { x = dpp_add<0xB1>(x); x = dpp_add<0x4E>(x); x = dpp_add<0x141>(x); x = dpp_add<0x140>(x); return x; }
__device__ __forceinline__ float allsum32(float x) { x = allsum16(x); auto r = __builtin_amdgcn_permlane16_swap(__float_as_uint(x), __float_as_uint(x), false, false); return __uint_as_float(r[0]) + __uint_as_float(r[1]); }
__device__ __forceinline__ float sum8(float x) { x = dpp_add<0xB1>(x); x = dpp_add<0x4E>(x); x = dpp_add<0x141>(x); return x; }
__device__ __forceinline__ float wave_sum(float v) {
    v = allsum16(v);
    { auto r = __builtin_amdgcn_permlane16_swap(__float_as_uint(v), __float_as_uint(v), false, false); v = __uint_as_float(r[0]) + __uint_as_float(r[1]); }
    { auto r = __builtin_amdgcn_permlane32_swap(__float_as_uint(v), __float_as_uint(v), false, false); v = __uint_as_float(r[0]) + __uint_as_float(r[1]); }
    return v;
}
__device__ __forceinline__ float sigmoidf_(float x) { return __builtin_amdgcn_rcpf(1.f + __builtin_amdgcn_exp2f(-1.4426950408889634f * x)); }
__device__ __forceinline__ float siluf_(float x) { return x * __builtin_amdgcn_rcpf(1.f + __builtin_amdgcn_exp2f(-1.4426950408889634f * x)); }
__device__ __forceinline__ void unpack8(const u32x4 w, float (&v)[8]) {
    v[0] = lo2f(w.x); v[1] = hi2f(w.x); v[2] = lo2f(w.y); v[3] = hi2f(w.y); v[4] = lo2f(w.z); v[5] = hi2f(w.z); v[6] = lo2f(w.w); v[7] = hi2f(w.w);
}
__device__ __forceinline__ u32x4 pack8(const float (&v)[8]) { u32x4 w; w.x = pk2(v[0], v[1]); w.y = pk2(v[2], v[3]); w.z = pk2(v[4], v[5]); w.w = pk2(v[6], v[7]); return w; }

#define LDS_BAR() do { asm volatile("s_waitcnt lgkmcnt(0)" ::: "memory"); __builtin_amdgcn_s_barrier(); asm volatile("" ::: "memory"); } while (0)

#define XB_TMO      128
#define XB_XCNT(j)  (256  + 64 * (j))
#define XB_XSUB(j)  (1280 + 64 * (j))
#define XB_XGEN(j)  (2304 + 64 * (j))
#define XB_TOP      3328
#define XB_TOPGEN   3392
#define XCD_BAR_WORDS 3456
#define XB_SPIN_CAP (1u << 19)
__device__ __forceinline__ unsigned xb_ld(unsigned* p)              { return __hip_atomic_load(p, __ATOMIC_RELAXED, __HIP_MEMORY_SCOPE_AGENT); }
__device__ __forceinline__ unsigned xb_add(unsigned* p, unsigned v) { return __hip_atomic_fetch_add(p, v, __ATOMIC_RELAXED, __HIP_MEMORY_SCOPE_AGENT); }
__device__ __forceinline__ unsigned xb_xcc_id() { return (unsigned)__builtin_amdgcn_s_getreg((3 << 11) | 20) & 0xFu; }
#define XB_SPIN(cond, bar) do { unsigned _sp = 0; while (cond) { __builtin_amdgcn_s_sleep(1); \
    if ((++_sp & 255u) == 0u) { if (xb_ld(&(bar)[XB_TMO])) break; if (_sp > XB_SPIN_CAP) { atomicAdd(&(bar)[XB_TMO], 1u); break; } } } } while (0)
struct XcdBarrier { unsigned* bar; unsigned x; volatile LAS unsigned* st; };
__device__ __forceinline__ XcdBarrier xcd_barrier_post(unsigned* bar, volatile LAS unsigned* st) {
    XcdBarrier b; b.bar = bar; b.x = xb_xcc_id(); b.st = st;
    if (threadIdx.x == 0) (void)xb_add(&bar[XB_XCNT(b.x)], 1u);
    return b;
}
__device__ __forceinline__ void xcd_barrier_complete(unsigned* bar, unsigned x, unsigned& nloc, unsigned& nx) {
    const unsigned G = gridDim.x * gridDim.y * gridDim.z;
    unsigned sum, cnt, mine, sp = 0u;
    for (;;) {
        sum = 0u; cnt = 0u; mine = 0u;
#pragma unroll
        for (unsigned j = 0; j < 16; ++j) { const unsigned c = xb_ld(&bar[XB_XCNT(j)]); sum += c; cnt += (c > 0u) ? 1u : 0u; mine = (j == x) ? c : mine; }
        if (sum == G) break;
        __builtin_amdgcn_s_sleep(1);
        if ((++sp & 255u) == 0u) { if (xb_ld(&bar[XB_TMO])) break; if (sp > XB_SPIN_CAP) { atomicAdd(&bar[XB_TMO], 1u); break; } }
    }
    nloc = mine > 0u ? mine : 1u; nx = cnt > 0u ? cnt : 1u;
}
__device__ __forceinline__ void xcd_barrier(const XcdBarrier& b) {
    asm volatile("s_waitcnt vmcnt(0)" ::: "memory");
    __syncthreads();
    if (threadIdx.x == 0) {
        unsigned* bar = b.bar;
        __builtin_amdgcn_s_waitcnt(0);
        unsigned nloc = b.st[0], nx = b.st[1];
        if (nloc == 0u) { xcd_barrier_complete(bar, b.x, nloc, nx); b.st[0] = nloc; b.st[1] = nx; }
        const unsigned old = xb_add(&bar[XB_XSUB(b.x)], 1u);
        const unsigned gen = old / nloc;
        if (old + 1u == (gen + 1u) * nloc) {
            __builtin_amdgcn_fence(__ATOMIC_RELEASE, "agent");
            asm volatile("s_waitcnt vmcnt(0)" ::: "memory");
            const unsigned og = xb_add(&bar[XB_TOP], 1u);
            const unsigned tg = og / nx;
            if (og + 1u == (tg + 1u) * nx) xb_add(&bar[XB_TOPGEN], 1u);
            else XB_SPIN(xb_ld(&bar[XB_TOPGEN]) == tg, bar);
            __builtin_amdgcn_fence(__ATOMIC_ACQUIRE, "agent");
            xb_add(&bar[XB_XGEN(b.x)], 1u);
            asm volatile("s_waitcnt vmcnt(0)" ::: "memory");
        } else {
            XB_SPIN(xb_ld(&bar[XB_XGEN(b.x)]) == gen, bar);
            __builtin_amdgcn_fence(__ATOMIC_ACQUIRE, "agent");
            asm volatile("s_waitcnt vmcnt(0)" ::: "memory");
        }
    }
    __syncthreads();
}

struct Args {
    const float* in[34]; float* out; unsigned char* ws; int ph_lo, ph_hi;
};
typedef const __attribute__((address_space(4))) Args* ArgsP;
struct Frame {
    LAS unsigned char* lds;
    int wave, vcu, G, gw, NGW;
    unsigned char* ws; unsigned char* dob;
};
enum { I_X = 0, I_C, I_POS, I_WADA, I_BADA, I_GMIX, I_WIN, I_MU, I_W0, I_WDEC, I_A0, I_WAUP, I_WGUP, I_KK, I_KA, I_RK, I_LNW, I_LNB, I_GQA, I_WUQ, I_GKVA, I_WUKV,
       I_QN, I_KN, I_WBR, I_WOUT, I_GFFN, I_WRG, I_BRG, I_WRE, I_BRE, I_WEG, I_WEU, I_WED };

struct Unit { int pm, pn; };
struct Gemm { const bf16* A; const bf16* Bt; int M, N, K; };
constexpr int NXCD = 8, WGM = 8;
struct StaticOrder {
    int nM, nN, nwg, G, c;
    __device__ void init(int M, int N, int G_, int c_) { nM = M / 256; nN = N / 256; nwg = nM * nN; G = G_; c = c_; }
    __device__ bool next(int i, Unit& u) const {
        const long L = (long)i * G + c; if (L >= nwg) return false;
        int wgid = (int)L; { const int q = nwg / NXCD, r = nwg % NXCD, xcd = wgid % NXCD, off = wgid / NXCD; wgid = (xcd < r ? xcd * (q + 1) : r * (q + 1) + (xcd - r) * q) + off; }
        const int nig = WGM * nN, gid = wgid / nig, fm = gid * WGM, gsz = (nM - fm) < WGM ? (nM - fm) : WGM;
        u.pm = fm + ((wgid % nig) % gsz); u.pn = (wgid % nig) / gsz; return true;
    }
    __device__ __forceinline__ void a_ready(const Unit&) const {}
    __device__ __forceinline__ void done(const Unit&) const {}
};
struct TableOrder {
    const LAS int* texp; int ntiles, nN, G, c;
    __device__ bool next(int i, Unit& u) const {
        const long L = (long)i * G + c; if (L >= (long)ntiles * nN) return false;
        const int t = (int)(L / nN), j = (int)(L % nN); u.pm = t; u.pn = texp[t] * nN + j; return true;
    }
    __device__ __forceinline__ void a_ready(const Unit&) const {}
    __device__ __forceinline__ void done(const Unit&) const {}
};

template <class Epi, class Sched>
__device__ __forceinline__ void gemm_phase_naive(LAS unsigned char* lds, const Gemm g, const Sched& S, const Epi& E) {
    const int tid = (int)__builtin_amdgcn_readfirstlane((int)threadIdx.x >> 6) * 64 + lane_id_fresh(), ty = tid >> 5, tx = tid & 31;
    LAS bf16* As = (LAS bf16*)lds; LAS bf16* Bs = (LAS bf16*)(lds + 128 * 40 * 2);
    Unit u;
    for (int i = 0; S.next(i, u); ++i) {
        for (int half = 0; half < 2; ++half) {
            float acc[8][8];
#pragma unroll
            for (int r = 0; r < 8; ++r)
#pragma unroll
                for (int c = 0; c < 8; ++c) acc[r][c] = 0.f;
            const bf16* Ab = g.A + ((size_t)u.pm * 256 + half * 128) * g.K; const bf16* Bb = g.Bt + (size_t)u.pn * 256 * g.K;
            for (int k0 = 0; k0 < g.K; k0 += 32) {
                __syncthreads();
                { const int r = tid >> 2, c8 = (tid & 3) * 8; *(LAS u32x4*)(As + r * 40 + c8) = *(const u32x4*)(Ab + (size_t)r * g.K + k0 + c8); }
#pragma unroll
                for (int j = 0; j < 2; ++j) { const int ch = tid + j * 512, r = ch >> 2, c8 = (ch & 3) * 8; *(LAS u32x4*)(Bs + r * 40 + c8) = *(const u32x4*)(Bb + (size_t)r * g.K + k0 + c8); }
                __syncthreads();
#pragma unroll 2
                for (int k = 0; k < 32; k += 2) {
                    float b0[8], b1[8];
#pragma unroll
                    for (int c = 0; c < 8; ++c) { const unsigned w = *(const LAS unsigned*)(Bs + (tx * 8 + c) * 40 + k); b0[c] = lo2f(w); b1[c] = hi2f(w); }
#pragma unroll
                    for (int r = 0; r < 8; ++r) { const unsigned w = *(const LAS unsigned*)(As + (ty * 8 + r) * 40 + k); const float a0 = lo2f(w), a1 = hi2f(w);
#pragma unroll
                        for (int c = 0; c < 8; ++c) acc[r][c] = fmaf(a1, b1[c], fmaf(a0, b0[c], acc[r][c])); }
                }
            }
#pragma unroll
            for (int r = 0; r < 8; ++r) E.store8(u, half * 128 + ty * 8 + r, tx * 8, acc[r]);
        }
    }
    __syncthreads();
}

struct EpiZ { bf16 *ZR, *SG, *ZM;
    __device__ __forceinline__ void store8(const Unit& u, int r, int c, const float (&v)[8]) const {
        const size_t row = (size_t)u.pm * 256 + r;
        if (u.pn < 7) { *(u32x4*)(ZR + row * 1792 + u.pn * 256 + c) = pack8(v); }
        else if (u.pn < 15) { float s[8];
#pragma unroll
            for (int i = 0; i < 8; ++i) s[i] = sigmoidf_(v[i]);
            *(u32x4*)(SG + row * 2048 + (u.pn - 7) * 256 + c) = pack8(s); }
        else { *(u32x4*)(ZM + row * 512 + (u.pn - 15) * 256 + c) = pack8(v); }
    } };
struct EpiLora { bf16 *LW, *A; const float *w0, *a0;
    __device__ __forceinline__ void store8(const Unit& u, int r, int c, const float (&v)[8]) const {
        const size_t row = (size_t)u.pm * 256 + r; const int col = u.pn * 256 + c; float o[8];
        const bool isw = col < 512; const float* bp = isw ? (w0 + col) : (a0 + col - 512);
        const f32x4 b0 = *(const f32x4*)bp, b1 = *(const f32x4*)(bp + 4); const float bb[8] = {b0.x, b0.y, b0.z, b0.w, b1.x, b1.y, b1.z, b1.w};
#pragma unroll
        for (int i = 0; i < 8; ++i) { const float e = __builtin_amdgcn_exp2f(fminf(-1.4426950408889634f * (bb[i] + v[i]), 120.f)); const float s = __builtin_amdgcn_rcpf(1.0f + e); o[i] = isw ? -0.60653065971263342f * s : s; }
        bf16* dst = isw ? (LW + row * 512 + col) : (A + row * 512 + col - 512);
        *(u32x4*)dst = pack8(o);
    } };
struct EpiPlain { bf16* O0; bf16* O1; int split, ld0, ld1;
    __device__ __forceinline__ void store8(const Unit& u, int r, int c, const float (&v)[8]) const {
        const size_t row = (size_t)u.pm * 256 + r; int col = u.pn * 256 + c;
        if (col < split) *(u32x4*)(O0 + row * ld0 + col) = pack8(v); else *(u32x4*)(O1 + row * ld1 + col - split) = pack8(v);
    } };
template <bool ACCUM> struct EpiBranch { bf16* MG; const bf16* SG; int goff;
    __device__ __forceinline__ void store8(const Unit& u, int r, int c, const float (&v)[8]) const {
        const size_t row = (size_t)u.pm * 256 + r; const int col = u.pn * 256 + c; float gt[8], o[8];
        unpack8(*(const u32x4*)(SG + row * 2048 + goff + col), gt);
        if (ACCUM) { float p[8]; unpack8(*(const u32x4*)(MG + row * 1024 + col), p);
#pragma unroll
            for (int i = 0; i < 8; ++i) o[i] = p[i] + gt[i] * v[i]; }
        else {
#pragma unroll
            for (int i = 0; i < 8; ++i) o[i] = gt[i] * v[i]; }
        *(u32x4*)(MG + row * 1024 + col) = pack8(o);
    } };
struct EpiOut { float* X1; const float* x; const float* mod;
    __device__ __forceinline__ void store8(const Unit& u, int r, int c, const float (&v)[8]) const {
        const size_t row = (size_t)u.pm * 256 + r; const int col = u.pn * 256 + c; const int b = (int)(row / SEQ);
        const float* gt = mod + b * 6144 + 2048 + col; const float* xr = x + row * 1024 + col; float* o = X1 + row * 1024 + col;
        const f32x4 g0 = *(const f32x4*)gt, g1 = *(const f32x4*)(gt + 4), x0 = *(const f32x4*)xr, x1 = *(const f32x4*)(xr + 4);
        *(f32x4*)o = (f32x4){x0.x + g0.x * v[0], x0.y + g0.y * v[1], x0.z + g0.z * v[2], x0.w + g0.w * v[3]};
        *(f32x4*)(o + 4) = (f32x4){x1.x + g1.x * v[4], x1.y + g1.y * v[5], x1.z + g1.z * v[6], x1.w + g1.w * v[7]};
    } };
struct EpiGateUp { bf16* HID;
    __device__ __forceinline__ void store8(const Unit& u, int r, int c, const float (&v)[8]) const {
        const size_t row = (size_t)u.pm * 256 + r; const int col = ((u.pn & 1) * 256 + c) >> 1;
        u32x2 w; w.x = pk2(siluf_(v[0]) * v[4], siluf_(v[1]) * v[5]); w.y = pk2(siluf_(v[2]) * v[6], siluf_(v[3]) * v[7]);
        *(u32x2*)(HID + row * 256 + col) = w;
    } };
struct EpiDownAtomic { float* out; const int* ent; const float* mod;
    __device__ __forceinline__ void store8(const Unit& u, int r, int c, const float (&v)[8]) const {
        const int e0 = ent[2 * (u.pm * 256 + r)]; if (e0 < 0) return; const float w = __builtin_bit_cast(float, ent[2 * (u.pm * 256 + r) + 1]);
        const int col = (u.pn & 3) * 256 + c, b = e0 / SEQ; const float* gt = mod + b * 6144 + 5120 + col; float* o = out + (size_t)e0 * 1024 + col;
        const f32x4 g0 = *(const f32x4*)gt, g1 = *(const f32x4*)(gt + 4);
        unsafeAtomicAdd(o + 0, g0.x * w * v[0]); unsafeAtomicAdd(o + 1, g0.y * w * v[1]); unsafeAtomicAdd(o + 2, g0.z * w * v[2]); unsafeAtomicAdd(o + 3, g0.w * w * v[3]);
        unsafeAtomicAdd(o + 4, g1.x * w * v[4]); unsafeAtomicAdd(o + 5, g1.y * w * v[5]); unsafeAtomicAdd(o + 6, g1.z * w * v[6]); unsafeAtomicAdd(o + 7, g1.w * w * v[7]);
    } };
struct EpiDown { bf16* YS;
    __device__ __forceinline__ void store8(const Unit& u, int r, int c, const float (&v)[8]) const {
        const size_t row = (size_t)u.pm * 256 + r; *(u32x4*)(YS + row * 1024 + (u.pn & 3) * 256 + c) = pack8(v);
    } };


namespace pg8 {
#define PG8_LAS __attribute__((address_space(3)))
typedef ::bf16x8 bf16x8; typedef ::f32x4 f32x4;
using ::Unit; using ::Gemm;
constexpr int BM = 256, BK = 64, HALF = 128, HTB = HALF * BK * 2  , STAGE_BYTES = 8 * HTB;

__device__ __forceinline__ int lds_byte(int r, int c) { const int st = (r >> 4) * 2 + (c >> 5), rr = r & 15, cc = c & 31, ob = rr * 64 + cc * 2; return st * 1024 + (ob ^ (((ob >> 9) & 1) << 5)); }
__device__ __forceinline__ void stage_rc(int b, int& R, int& C) { const int st = b / 1024, sb = b % 1024, swz = sb ^ (((sb >> 9) & 1) << 5); R = (st >> 1) * 16 + swz / 64; C = (st & 1) * 32 + (swz % 64) / 2; }
__device__ __forceinline__ int perm32(int rho) { const int n = rho >> 4, i = rho & 15; return 8 * (i >> 2) + 4 * n + (i & 3); }
template <class Epi, class Sched, bool ALIGN_EPI = false, bool SP2 = false>
__device__ __forceinline__ void gemm_phase(PG8_LAS unsigned char* lds, const Gemm g, const Sched& S, const Epi& E, const int wave_in) {
    const int lane = lane_id_fresh(), wid = wave_in, tid = wid * 64 + lane,
              wr = wid >> 2, wc = wid & 3, fr = lane & 15, fq = lane >> 4;
    const int K = g.K, nt = K / BK;
    unsigned voffA[2], voffB[2];
#pragma unroll
    for (int i = 0; i < 2; ++i) { int R, C; stage_rc(tid * 16 + i * 8192, R, C); const int Rb = Epi::PERM ? ((R & ~31) + perm32(R & 31)) : R;
        voffA[i] = (unsigned)(R * K + C) * 2u; voffB[i] = (unsigned)(Rb * K + C) * 2u; }
    const size_t kstep = (size_t)(BK * 2);
    const size_t hstep = (size_t)HALF * K * 2;
    const size_t tstep = 2 * hstep;
    const unsigned ldsw = (unsigned)wid * 1024u;
    const int aoff = lds_byte(wr * 64 + fr, fq * 8), boff = lds_byte(wc * 32 + fr, fq * 8);
#define PG8_SA(b, h) (((b) * 2 + (h)) * HTB)
#define PG8_SB(b, h) ((4 + (b) * 2 + (h)) * HTB)
#define PG8_STAGE(bufoff, gbase, voff) do { _Pragma("unroll") for (int _i = 0; _i < 2; ++_i) \
        __builtin_amdgcn_global_load_lds((const unsigned*)((const char*)(gbase) + (voff)[_i]), (PG8_LAS unsigned*)(lds + (bufoff) + ldsw + _i * 8192), 16, 0, 0); } while (0)
#define PG8_LDA(dst, b, h) do { _Pragma("unroll") for (int m = 0; m < 4; ++m) _Pragma("unroll") for (int k = 0; k < 2; ++k) dst[m][k] = *(const PG8_LAS bf16x8*)(lds + PG8_SA(b, h) + aoff + m * 2048 + k * 1024); } while (0)
#define PG8_LDB(dst, b, h) do { _Pragma("unroll") for (int n = 0; n < 2; ++n) _Pragma("unroll") for (int k = 0; k < 2; ++k) dst[n][k] = *(const PG8_LAS bf16x8*)(lds + PG8_SB(b, h) + boff + n * 2048 + k * 1024); } while (0)
#define PG8_MMA(ai, bj, At, Bt) do { __builtin_amdgcn_s_setprio(1); _Pragma("unroll") for (int m = 0; m < 4; ++m) _Pragma("unroll") for (int n = 0; n < 2; ++n) _Pragma("unroll") for (int k = 0; k < 2; ++k) \
        acc[ai][bj][m][n] = __builtin_amdgcn_mfma_f32_16x16x32_bf16(Bt[n][k], At[m][k], acc[ai][bj][m][n], 0, 0, 0); __builtin_amdgcn_s_setprio(0); } while (0)
#define PG8_WAIT_V(n) asm volatile("s_waitcnt vmcnt(" #n ")" ::: "memory")
#define PG8_WAIT_L(n) asm volatile("s_waitcnt lgkmcnt(" #n ")" ::: "memory")
#define PG8_BAR __builtin_amdgcn_s_barrier()
#define PG8_SCHED __builtin_amdgcn_sched_barrier(0)
    Unit cur, nxt; int ui = 0;
    if (!S.next(0, cur)) return;
    f32x4 acc[2][2][4][2];
#pragma unroll
    for (int a = 0; a < 2; ++a)
#pragma unroll
        for (int b = 0; b < 2; ++b)
#pragma unroll
            for (int m = 0; m < 4; ++m)
#pragma unroll
                for (int n = 0; n < 2; ++n) acc[a][b][m][n] = (f32x4){0.f, 0.f, 0.f, 0.f};
    bf16x8 At[4][2], B0[2][2], B1[2][2];
    const char* cA = (const char*)g.A + (size_t)cur.pm * tstep; const char* cB = (const char*)g.Bt + (size_t)cur.pn * tstep;
    S.a_ready(cur);
    if constexpr (SP2) {
        PG8_STAGE(PG8_SB(0, 0), cB, voffB); PG8_STAGE(PG8_SB(0, 1), cB + hstep, voffB); PG8_STAGE(PG8_SA(0, 0), cA, voffA); PG8_STAGE(PG8_SA(0, 1), cA + hstep, voffA);
        if (wr == 1) PG8_BAR;
        PG8_WAIT_V(2); PG8_BAR;
        PG8_STAGE(PG8_SB(1, 0), cB + kstep, voffB); PG8_STAGE(PG8_SA(1, 0), cA + kstep, voffA); PG8_STAGE(PG8_SB(1, 1), cB + hstep + kstep, voffB);
        PG8_WAIT_V(6); PG8_BAR;
    } else {
        PG8_STAGE(PG8_SB(0, 0), cB, voffB); PG8_STAGE(PG8_SA(0, 0), cA, voffA); PG8_STAGE(PG8_SB(0, 1), cB + hstep, voffB); PG8_STAGE(PG8_SA(0, 1), cA + hstep, voffA);
        if (wr == 1) PG8_BAR;
        PG8_WAIT_V(4); PG8_BAR;
        PG8_STAGE(PG8_SB(1, 0), cB + kstep, voffB); PG8_STAGE(PG8_SA(1, 0), cA + kstep, voffA); PG8_STAGE(PG8_SB(1, 1), cB + hstep + kstep, voffB);
        PG8_WAIT_V(6); PG8_BAR;
    }
    for (;;) {
        const bool has_next = S.next(ui + 1, nxt);
        const char* nA = has_next ? (const char*)g.A + (size_t)nxt.pm * tstep : cA; const char* nB = has_next ? (const char*)g.Bt + (size_t)nxt.pn * tstep : cB;
        for (int t = 0; t < nt; t += 2) {
            const bool last = (t == nt - 2);
            const char* a1 = cA + (size_t)(t + 1) * kstep;
            const char* a2 = last ? nA : cA + (size_t)(t + 2) * kstep; const char* b2 = last ? nB : cB + (size_t)(t + 2) * kstep;
            const char* a3 = a2 + kstep; const char* b3 = b2 + kstep;
            if (last && has_next) S.a_ready(nxt);
            if constexpr (SP2) {
            PG8_LDB(B0, 0, 0); PG8_LDB(B1, 0, 1); PG8_SCHED; PG8_LDA(At, 0, 0); PG8_STAGE(PG8_SA(1, 1), a1 + hstep, voffA);
            PG8_WAIT_V(8); PG8_WAIT_L(0); PG8_BAR; PG8_MMA(0, 0, At, B0); PG8_MMA(0, 1, At, B1); PG8_BAR; PG8_SCHED;
            PG8_LDA(At, 0, 1); PG8_STAGE(PG8_SB(0, 0), b2, voffB); PG8_STAGE(PG8_SB(0, 1), b2 + hstep, voffB); PG8_STAGE(PG8_SA(0, 0), a2, voffA);
            PG8_WAIT_V(8); PG8_WAIT_L(0); PG8_BAR; PG8_MMA(1, 0, At, B0); PG8_MMA(1, 1, At, B1); PG8_BAR; PG8_SCHED;
            PG8_LDB(B0, 1, 0); PG8_LDB(B1, 1, 1); PG8_SCHED; PG8_LDA(At, 1, 0); PG8_STAGE(PG8_SA(0, 1), a2 + hstep, voffA);
            PG8_WAIT_V(8); PG8_WAIT_L(0); PG8_BAR; PG8_MMA(0, 0, At, B0); PG8_MMA(0, 1, At, B1); PG8_BAR; PG8_SCHED;
            PG8_LDA(At, 1, 1); PG8_STAGE(PG8_SB(1, 0), b3, voffB); PG8_STAGE(PG8_SB(1, 1), b3 + hstep, voffB); PG8_STAGE(PG8_SA(1, 0), a3, voffA);
            PG8_WAIT_V(8); PG8_WAIT_L(0); PG8_BAR; PG8_MMA(1, 0, At, B0); PG8_MMA(1, 1, At, B1); PG8_BAR; PG8_SCHED;
            } else {
            PG8_LDB(B0, 0, 0); PG8_SCHED; PG8_LDA(At, 0, 0); PG8_STAGE(PG8_SA(1, 1), a1 + hstep, voffA);
            PG8_WAIT_L(8); PG8_BAR; PG8_WAIT_L(0); PG8_MMA(0, 0, At, B0); PG8_BAR; PG8_SCHED;
            PG8_LDB(B1, 0, 1); PG8_STAGE(PG8_SB(0, 0), b2, voffB);
            PG8_BAR; PG8_WAIT_L(0); PG8_MMA(0, 1, At, B1); PG8_BAR;
            PG8_LDA(At, 0, 1); PG8_STAGE(PG8_SA(0, 0), a2, voffA);
            PG8_BAR; PG8_WAIT_L(0); PG8_MMA(1, 0, At, B0); PG8_BAR; PG8_SCHED;
            PG8_STAGE(PG8_SB(0, 1), b2 + hstep, voffB);
            PG8_WAIT_V(6); PG8_BAR; PG8_MMA(1, 1, At, B1); PG8_BAR;
            PG8_LDB(B0, 1, 0); PG8_SCHED; PG8_LDA(At, 1, 0); PG8_STAGE(PG8_SA(0, 1), a2 + hstep, voffA);
            PG8_WAIT_L(8); PG8_BAR; PG8_WAIT_L(0); PG8_MMA(0, 0, At, B0); PG8_BAR; PG8_SCHED;
            PG8_LDB(B1, 1, 1); PG8_STAGE(PG8_SB(1, 0), b3, voffB);
            PG8_BAR; PG8_WAIT_L(0); PG8_MMA(0, 1, At, B1); PG8_BAR;
            PG8_LDA(At, 1, 1); PG8_STAGE(PG8_SA(1, 0), a3, voffA);
            PG8_BAR; PG8_WAIT_L(0); PG8_MMA(1, 0, At, B0); PG8_BAR; PG8_SCHED;
            PG8_STAGE(PG8_SB(1, 1), b3 + hstep, voffB);
            PG8_WAIT_V(6); PG8_BAR; PG8_MMA(1, 1, At, B1); PG8_BAR;
            }
        }
        if constexpr (ALIGN_EPI) { if (wr == 0) PG8_BAR; }
        if constexpr (!Epi::AFTER_DRAIN) { E(acc, cur, wr, wc, fr, fq); S.done(cur); }
        if (!has_next) break;
#pragma unroll
        for (int a = 0; a < 2; ++a)
#pragma unroll
            for (int b = 0; b < 2; ++b)
#pragma unroll
                for (int m = 0; m < 4; ++m)
#pragma unroll
                    for (int n = 0; n < 2; ++n) acc[a][b][m][n] = (f32x4){0.f, 0.f, 0.f, 0.f};
        cur = nxt; cA = nA; cB = nB; ++ui;
        if constexpr (ALIGN_EPI) { if (wr == 1) PG8_BAR; }
    }
    PG8_WAIT_V(0);
    if constexpr (!ALIGN_EPI) { if (wr == 0) PG8_BAR; }
    PG8_BAR;
    if constexpr (Epi::AFTER_DRAIN) { E.fused(acc, cur, wr, wc, fr, fq, lds, wid, lane); S.done(cur); }
#undef PG8_SA
#undef PG8_SB
#undef PG8_STAGE
#undef PG8_LDA
#undef PG8_LDB
#undef PG8_MMA
#undef PG8_WAIT_V
#undef PG8_WAIT_L
#undef PG8_BAR
#undef PG8_SCHED
}

template <class F> struct EpiAdapt {
    static constexpr bool PERM = true, AFTER_DRAIN = false; F f;
    __device__ __forceinline__ void operator()(const f32x4 (&acc)[2][2][4][2], const Unit& u, int wr, int wc, int fr, int fq) const {
        asm volatile("" : "+v"(fr), "+v"(fq));
#pragma unroll
        for (int ai = 0; ai < 2; ++ai)
#pragma unroll
            for (int m = 0; m < 4; ++m) { const int row = ai * HALF + wr * 64 + m * 16 + fr;
#pragma unroll
                for (int bj = 0; bj < 2; ++bj) { const f32x4 v0 = acc[ai][bj][m][0], v1 = acc[ai][bj][m][1];
                    const float v[8] = {v0[0], v0[1], v0[2], v0[3], v1[0], v1[1], v1[2], v1[3]};
                    f.store8(u, row, bj * HALF + wc * 32 + 8 * fq, v); } }
    }
};
}

template <class Epi, class Sched>
__device__ __forceinline__ void gemm_phase_any(LAS unsigned char* lds, const Gemm g, const Sched& S, const Epi& E, const int wave_in) {
#if ENG_GEMM == 1
    pg8::EpiAdapt<Epi> EA{E};
    pg8::gemm_phase<pg8::EpiAdapt<Epi>, Sched, true, true>(lds, g, S, EA, wave_in);
#else
    gemm_phase_naive<Epi, Sched>(lds, g, S, E);
#endif
}

template <class RowMap>
__device__ __forceinline__ void transpose_item(const float* W, int ldw, bf16* WT, int ldt, int koff, int k0, int n0, const RowMap& rm, LAS float* scr, int lane) {
#pragma unroll 8
    for (int i = 0; i < 32; ++i) { const int kk = 2 * i + (lane >> 5); scr[kk * 33 + (lane & 31)] = W[(size_t)(k0 + kk) * ldw + n0 + (lane & 31)]; }
    asm volatile("s_waitcnt lgkmcnt(0)" ::: "memory");
    const int c = lane & 7;
#pragma unroll
    for (int j = 0; j < 4; ++j) { const int n = (lane >> 3) + 8 * j; const LAS float* s = scr + (8 * c) * 33 + n;
        u32x4 o; o.x = pk2(s[0 * 33], s[1 * 33]); o.y = pk2(s[2 * 33], s[3 * 33]); o.z = pk2(s[4 * 33], s[5 * 33]); o.w = pk2(s[6 * 33], s[7 * 33]);
        *(u32x4*)(WT + (size_t)rm(n0 + n) * ldt + koff + k0 + 8 * c) = o; }
    asm volatile("s_waitcnt lgkmcnt(0)" ::: "memory");
}
struct RmId { int off; __device__ int operator()(int n) const { return off + n; } };
struct RmWin { __device__ int operator()(int n) const { return n < 1792 ? n : (n < 2208 ? 3840 + (n - 1792) : 1792 + (n - 2208)); } };
struct RmUkv { __device__ int operator()(int n) const { const int h = n >> 7, j = n & 127; return j < 64 ? h * 64 + j : 512 + h * 64 + (j - 64); } };
struct RmGU { int off; __device__ int operator()(int j) const { return off + 8 * (j >> 2) + (j & 3); } };

__device__ __forceinline__ void p0_prologue(const Frame& F, ArgsP a) {
    const int lane_f = lane_id_fresh(), tid_f = F.wave * 64 + lane_f;
    LAS float* scr = (LAS float*)(F.lds + F.wave * 16384);
    const int lane = lane_f;
    bf16* Win = (bf16*)(F.ws + WS_WIN); bf16* Wblk = (bf16*)(F.ws + WS_WBLK); bf16* Wg = (bf16*)(F.ws + WS_WG); bf16* Wuq = (bf16*)(F.ws + WS_WUQ);
    bf16* Wukv = (bf16*)(F.ws + WS_WUKV); bf16* Wb = (bf16*)(F.ws + WS_WB); bf16* Wo = (bf16*)(F.ws + WS_WO); bf16* Wgu = (bf16*)(F.ws + WS_WGU); bf16* Wdn = (bf16*)(F.ws + WS_WDN);
    constexpr int I_IN = 16 * 133, I_DEC = 1 * 16, I_AUP = 16, I_GUP = 2 * 16, I_UQ = 4 * 24, I_UKV = 2 * 32, I_BR = 2 * 8 * 32, I_O = 16 * 32;
    constexpr int I_EG = 32 * 16 * 8, I_EU = I_EG, I_ED = 32 * 4 * 32;
    constexpr int NITEMS = I_IN + I_DEC + I_AUP + I_GUP + I_UQ + I_UKV + I_BR + I_O + I_EG + I_EU + I_ED;
    for (int it = F.gw; it < NITEMS; it += F.NGW) {
        int r = it;
        if (r < I_IN) { const int kb = r / 133, nb = r % 133; transpose_item(a->in[I_WIN], D_IN, Win, 1024, 0, 64 * kb, 32 * nb, RmWin{}, scr, lane); continue; } r -= I_IN;
        if (r < I_DEC) { transpose_item(a->in[I_WDEC], 512, Wblk, 128, 0, 0, 32 * r, RmId{0}, scr, lane); continue; } r -= I_DEC;
        if (r < I_AUP) { transpose_item(a->in[I_WAUP], 512, Wblk, 128, 64, 0, 32 * r, RmId{512}, scr, lane); continue; } r -= I_AUP;
        if (r < I_GUP) { const int kb = r / 16, nb = r % 16; transpose_item(a->in[I_WGUP], 512, Wg, 128, 0, 64 * kb, 32 * nb, RmId{0}, scr, lane); continue; } r -= I_GUP;
        if (r < I_UQ) { const int kb = r / 24, nb = r % 24; transpose_item(a->in[I_WUQ], 768, Wuq, 256, 0, 64 * kb, 32 * nb, RmId{0}, scr, lane); continue; } r -= I_UQ;
        if (r < I_UKV) { const int kb = r / 32, nb = r % 32; transpose_item(a->in[I_WUKV], 1024, Wukv, 128, 0, 64 * kb, 32 * nb, RmUkv{}, scr, lane); continue; } r -= I_UKV;
        if (r < I_BR) { const int br = r / 256, q = r % 256, kb = q / 32, nb = q % 32; transpose_item(a->in[I_WBR] + (size_t)br * 512 * 1024, 1024, Wb + (size_t)br * 1024 * 512, 512, 0, 64 * kb, 32 * nb, RmId{0}, scr, lane); continue; } r -= I_BR;
        if (r < I_O) { const int kb = r / 32, nb = r % 32; transpose_item(a->in[I_WOUT], 1024, Wo, 1024, 0, 64 * kb, 32 * nb, RmId{0}, scr, lane); continue; } r -= I_O;
        if (r < I_EG) { const int e = r / 128, q = r % 128, kb = q / 8, nb = q % 8; transpose_item(a->in[I_WEG] + (size_t)e * 1024 * 256, 256, Wgu + (size_t)e * 512 * 1024, 1024, 0, 64 * kb, 32 * nb, RmGU{0}, scr, lane); continue; } r -= I_EG;
        if (r < I_EU) { const int e = r / 128, q = r % 128, kb = q / 8, nb = q % 8; transpose_item(a->in[I_WEU] + (size_t)e * 1024 * 256, 256, Wgu + (size_t)e * 512 * 1024, 1024, 0, 64 * kb, 32 * nb, RmGU{4}, scr, lane); continue; } r -= I_EU;
        { const int e = r / 128, q = r % 128, kb = q / 32, nb = q % 32; transpose_item(a->in[I_WED] + (size_t)e * 256 * 1024, 1024, Wdn + (size_t)e * 1024 * 256, 256, 0, 64 * kb, 32 * nb, RmId{0}, scr, lane); }
    }
    for (int i = F.gw * 64 + lane; i < 96 * 128; i += F.NGW * 64) *(u32x4*)(Win + (size_t)4256 * 1024 + (size_t)i * 8) = (u32x4){0u, 0u, 0u, 0u};
    for (int i = F.gw * 64 + lane; i < 1024 * 8; i += F.NGW * 64) { const int row = i >> 3, c8 = (i & 7) * 8; *(u32x4*)(Wblk + row * 128 + (row < 512 ? 64 : 0) + c8) = (u32x4){0u, 0u, 0u, 0u}; }
    { const int* pos = (const int*)a->in[I_POS]; float* cs = (float*)(F.ws + WS_CS);
      for (int i = F.gw * 64 + lane; i < NTOK * 16; i += F.NGW * 64) { const int t = i >> 4, j = i & 15;
          const float fr = exp2f(-(float)j * (13.287712379549449f / 16.0f));
          const float ang = (float)pos[t] * fr; cs[t * 32 + j] = cosf(ang); cs[t * 32 + 16 + j] = sinf(ang); } }
    { float* mod = (float*)(F.ws + WS_MOD); const float* c = a->in[I_C]; const float* wa = a->in[I_WADA]; const float* ba = a->in[I_BADA];
      LAS float* red = (LAS float*)(F.lds + 8 * 16384);
      for (int nb = F.vcu; nb < 96; nb += F.G) {
          float acc[8];
#pragma unroll
          for (int b = 0; b < 8; ++b) acc[b] = 0.f;
          const int n = nb * 64 + lane;
          for (int k = F.wave * 128; k < F.wave * 128 + 128; ++k) { const float w = wa[(size_t)k * 6144 + n];
#pragma unroll
              for (int b = 0; b < 8; ++b) acc[b] = fmaf(siluf_(c[b * 1024 + k]), w, acc[b]); }
#pragma unroll
          for (int b = 0; b < 8; ++b) red[(F.wave * 8 + b) * 64 + lane] = acc[b];
          __syncthreads();
          { const int b = F.wave; float s = ba[n];
#pragma unroll
            for (int w = 0; w < 8; ++w) s += red[(w * 8 + b) * 64 + lane];
            mod[b * 6144 + n] = s; }
          __syncthreads();
      } }
}

__device__ __forceinline__ void p_normmod(const Frame& F, const float* x, const float* g, const float* mod, int sh_off, int sc_off, bf16* H) {
    const int lane_f = lane_id_fresh(), tid_f = F.wave * 64 + lane_f;
    for (int m = F.gw; m < NTOK; m += F.NGW) {
        const int b = m / SEQ; const f32x4* xr = (const f32x4*)(x + (size_t)m * 1024) + lane_f;
        f32x4 v[4]; float s = 0.f;
#pragma unroll
        for (int j = 0; j < 4; ++j) { v[j] = xr[64 * j]; s += (v[j].x * v[j].x + v[j].y * v[j].y) + (v[j].z * v[j].z + v[j].w * v[j].w); }
        const float rstd = 1.0f / sqrtf(wave_sum(s) * (1.f / 1024.f) + EPS);
        u32x2* o = (u32x2*)(H + (size_t)m * 1024) + lane_f;
#pragma unroll
        for (int j = 0; j < 4; ++j) { const int col = 4 * lane_f + 256 * j;
            const f32x4 gg = *(const f32x4*)(g + col), sc = *(const f32x4*)(mod + b * 6144 + sc_off + col), sh = *(const f32x4*)(mod + b * 6144 + sh_off + col);
            const f32x4 y = v[j] * rstd * gg * (sc + 1.0f) + sh; u32x2 w; w.x = pk2(y.x, y.y); w.y = pk2(y.z, y.w); o[64 * j] = w; }
    }
}

__device__ __forceinline__ void p_prep_a(const Frame& F, ArgsP a) {
    const int lane_f = lane_id_fresh();
    const bf16* ZR = (const bf16*)(F.ws + WS_ZR); const bf16* ZM = (const bf16*)(F.ws + WS_ZM);
    bf16* TWA = (bf16*)(F.ws + WS_TWA); bf16* SGL = (bf16*)(F.ws + WS_SGL); bf16* QA = (bf16*)(F.ws + WS_QA); bf16* KVA = (bf16*)(F.ws + WS_KVA);
    const float* mu = a->in[I_MU]; const float* gqa = a->in[I_GQA]; const float* gkva = a->in[I_GKVA];
    const int lane = lane_f;
    const f32x4 mm = *(const f32x4*)(mu + 1536 + 4 * lane), gq = *(const f32x4*)(gqa + 4 * lane), gk = *(const f32x4*)(gkva + 4 * (lane & 31));
    for (int m = F.gw; m < NTOK; m += F.NGW) {
        const bool first = (m % SEQ) == 0;
        { const u32x2 c = *((const u32x2*)(ZR + (size_t)m * 1792 + 1536) + lane); u32x2 p = *((const u32x2*)(ZR + (size_t)(first ? m : m - 1) * 1792 + 1536) + lane); if (first) { p.x = 0u; p.y = 0u; }
          float z[4] = {lo2f(c.x), hi2f(c.x), lo2f(c.y), hi2f(c.y)}; const float q[4] = {lo2f(p.x), hi2f(p.x), lo2f(p.y), hi2f(p.y)};
          z[0] += (q[0] - z[0]) * mm.x; z[1] += (q[1] - z[1]) * mm.y; z[2] += (q[2] - z[2]) * mm.z; z[3] += (q[3] - z[3]) * mm.w;
          if (lane < 16) { u32x2 w; w.x = pk2(tanhf(z[0]), tanhf(z[1])); w.y = pk2(tanhf(z[2]), tanhf(z[3])); *((u32x2*)(TWA + (size_t)m * 128) + lane) = w; }
          else if (lane < 32) { u32x2 w; w.x = pk2(z[0], z[1]); w.y = pk2(z[2], z[3]); *((u32x2*)(TWA + (size_t)m * 128) + lane) = w; }
          else { u32x2 w; w.x = pk2(sigmoidf_(z[0]), sigmoidf_(z[1])); w.y = pk2(sigmoidf_(z[2]), sigmoidf_(z[3])); *((u32x2*)(SGL + (size_t)m * 128) + (lane - 32)) = w; } }
        { const u32x2 c = *((const u32x2*)(ZM + (size_t)m * 512) + lane); const float z[4] = {lo2f(c.x), hi2f(c.x), lo2f(c.y), hi2f(c.y)};
          u32x2 c2 = (u32x2){0u, 0u}; if (lane < 32) c2 = *((const u32x2*)(ZM + (size_t)m * 512 + 256) + lane); const float y[4] = {lo2f(c2.x), hi2f(c2.x), lo2f(c2.y), hi2f(c2.y)};
          const float rstd = 1.0f / sqrtf(wave_sum((z[0] * z[0] + z[1] * z[1]) + (z[2] * z[2] + z[3] * z[3])) * (1.f / 256.f) + EPS);
          const float rstd2 = 1.0f / sqrtf(wave_sum((y[0] * y[0] + y[1] * y[1]) + (y[2] * y[2] + y[3] * y[3])) * (1.f / 128.f) + EPS);
          u32x2 w; w.x = pk2(z[0] * rstd * gq.x, z[1] * rstd * gq.y); w.y = pk2(z[2] * rstd * gq.z, z[3] * rstd * gq.w);
          *((u32x2*)(QA + (size_t)m * 256) + lane) = w;
          if (lane < 32) { u32x2 w2; w2.x = pk2(y[0] * rstd2 * gk.x, y[1] * rstd2 * gk.y); w2.y = pk2(y[2] * rstd2 * gk.z, y[3] * rstd2 * gk.w);
              *((u32x2*)(KVA + (size_t)m * 128) + lane) = w2; } }
    }
}

__device__ __forceinline__ void p_prep_c(const Frame& F, ArgsP a) {
    const int lane_f = lane_id_fresh(), tid_f = F.wave * 64 + lane_f;
    bf16* Q = (bf16*)(F.dob + DO_Q); const bf16* KN = (const bf16*)(F.dob + DO_KN); const bf16* ZM = (const bf16*)(F.ws + WS_ZM); bf16* KC = (bf16*)(F.ws + WS_KC);
    const float* cs = (const float*)(F.ws + WS_CS);
    const float* qn = a->in[I_QN]; const float* kn = a->in[I_KN];
    const int lane = lane_f, hd = lane >> 3, j = lane & 7;
    for (int m = F.gw; m < NTOK; m += F.NGW) {
        const f32x2 cc = *(const f32x2*)(cs + (size_t)m * 32 + 2 * j), sn = *(const f32x2*)(cs + (size_t)m * 32 + 16 + 2 * j);
        { bf16* qp = Q + (size_t)m * 768 + hd * 96; float v[8]; unpack8(*(const u32x4*)(qp + 8 * j), v);
          const unsigned w1 = *(const unsigned*)(qp + 64 + 2 * j), w2 = *(const unsigned*)(qp + 80 + 2 * j); float x1[2] = {lo2f(w1), hi2f(w1)}, x2[2] = {lo2f(w2), hi2f(w2)};
          float ss = (x1[0] * x1[0] + x1[1] * x1[1]) + (x2[0] * x2[0] + x2[1] * x2[1]);
#pragma unroll
          for (int i = 0; i < 8; ++i) ss += v[i] * v[i];
          const float rstd = 1.0f / sqrtf(sum8(ss) * (1.f / 96.f) + EPS);
#pragma unroll
          for (int i = 0; i < 8; ++i) v[i] = v[i] * rstd * qn[8 * j + i] * QSCALE;
          x1[0] *= rstd * qn[64 + 2 * j]; x1[1] *= rstd * qn[65 + 2 * j]; x2[0] *= rstd * qn[80 + 2 * j]; x2[1] *= rstd * qn[81 + 2 * j];
          const float o1a = (x1[0] * cc.x - x2[0] * sn.x) * QSCALE, o1b = (x1[1] * cc.y - x2[1] * sn.y) * QSCALE, o2a = (x2[0] * cc.x + x1[0] * sn.x) * QSCALE, o2b = (x2[1] * cc.y + x1[1] * sn.y) * QSCALE;
          *(u32x4*)(qp + 8 * j) = pack8(v); *(unsigned*)(qp + 64 + 2 * j) = pk2(o1a, o1b); *(unsigned*)(qp + 80 + 2 * j) = pk2(o2a, o2b); }
        { float v[8]; unpack8(*(const u32x4*)(KN + (size_t)m * 512 + hd * 64 + 8 * j), v);
          const unsigned w1 = *(const unsigned*)(ZM + (size_t)m * 512 + 384 + 2 * j), w2 = *(const unsigned*)(ZM + (size_t)m * 512 + 400 + 2 * j); float x1[2] = {lo2f(w1), hi2f(w1)}, x2[2] = {lo2f(w2), hi2f(w2)};
          float ss = (x1[0] * x1[0] + x1[1] * x1[1]) + (x2[0] * x2[0] + x2[1] * x2[1]);
#pragma unroll
          for (int i = 0; i < 8; ++i) ss += v[i] * v[i];
          const float rstd = 1.0f / sqrtf(sum8(ss) * (1.f / 96.f) + EPS);
#pragma unroll
          for (int i = 0; i < 8; ++i) v[i] = v[i] * rstd * kn[8 * j + i];
          x1[0] *= rstd * kn[64 + 2 * j]; x1[1] *= rstd * kn[65 + 2 * j]; x2[0] *= rstd * kn[80 + 2 * j]; x2[1] *= rstd * kn[81 + 2 * j];
          bf16* kp = KC + (size_t)m * 768 + hd * 96;
          *(u32x4*)(kp + 8 * j) = pack8(v); *(unsigned*)(kp + 64 + 2 * j) = pk2(x1[0] * cc.x - x2[0] * sn.x, x1[1] * cc.y - x2[1] * sn.y);
          *(unsigned*)(kp + 80 + 2 * j) = pk2(x2[0] * cc.x + x1[0] * sn.x, x2[1] * cc.y + x1[1] * sn.y); }
    }
}

constexpr int SC_T = 32;
constexpr int SC_BUF = 5 * SC_T * 64 * 4 + SC_T * 16 * 4 + SC_T * 16 * 4;
struct ScanRaw { u32x2 rc[2], rp[2], kc[2], kp[2], av[2], lw[2]; u32x4 vc, vp; };
__device__ __forceinline__ void scan_issue(ScanRaw& R, const bf16* ZR, const bf16* A, const bf16* LW, size_t row0, int t0, int st2, int col, int s2, int cv, bool dov) {
#pragma unroll
    for (int u = 0; u < 2; ++u) { const int tt = t0 + st2 + 16 * u; const size_t g = row0 + tt; const size_t gp = row0 + (tt > 0 ? tt - 1 : 0);
        R.rc[u] = *(const u32x2*)(ZR + g * 1792 + col); R.rp[u] = *(const u32x2*)(ZR + gp * 1792 + col);
        R.kc[u] = *(const u32x2*)(ZR + g * 1792 + 512 + col); R.kp[u] = *(const u32x2*)(ZR + gp * 1792 + 512 + col);
        R.av[u] = *(const u32x2*)(A + g * 512 + col); R.lw[u] = *(const u32x2*)(LW + g * 512 + col); }
    { const int tv = t0 + (dov ? s2 : 0); const size_t gv = row0 + tv; const size_t gvp = row0 + (tv > 0 ? tv - 1 : 0); R.vc = *(const u32x4*)(ZR + gv * 1792 + 1024 + cv); R.vp = *(const u32x4*)(ZR + gvp * 1792 + 1024 + cv); }
}
__device__ __forceinline__ void p_scan(const Frame& F, ArgsP a) {
    const int lane_f = lane_id_fresh(), tid_f = F.wave * 64 + lane_f;
    const bf16* ZR = (const bf16*)(F.ws + WS_ZR); const bf16* A = (const bf16*)(F.ws + WS_A); const bf16* LW = (const bf16*)(F.ws + WS_LW); bf16* Y = (bf16*)(F.ws + WS_Y);
    const float* mu = a->in[I_MU]; const float* k_k = a->in[I_KK]; const float* k_a = a->in[I_KA];
    const int lane = lane_f, wave = F.wave, tid = tid_f;
    for (int item = F.vcu; item < 256; item += F.G) {
        const int bh = item >> 2, qt = item & 3, b = bh >> 3, h = bh & 7;
        const size_t row0 = (size_t)b * SEQ; const int colh = h * 64;
        const int NCH = SEQ / SC_T;
        __syncthreads();
        if (wave >= 4) {
            const int lt = tid - 256, st2 = lt >> 4, j4 = (lt & 15) * 4, col = colh + j4, s2 = lt >> 1, hf = lt & 1, cv = colh + qt * 16 + hf * 8; const bool dov = lt < 64;
            f32x4 mur = *(const f32x4*)(mu + col), muk = *(const f32x4*)(mu + 512 + col), kkc = *(const f32x4*)(k_k + col), kac = *(const f32x4*)(k_a + col);
            f32x4 m0 = *(const f32x4*)(mu + 1024 + cv), m1 = *(const f32x4*)(mu + 1024 + cv + 4);
            asm volatile("" : "+v"(mur), "+v"(muk), "+v"(kkc), "+v"(kac), "+v"(m0), "+v"(m1));
            ScanRaw R0, R1;
            scan_issue(R0, ZR, A, LW, row0, 0, st2, col, s2, cv, dov);
#define SCAN_BUILD(RR, c_) do { LAS unsigned char* bs = F.lds + ((c_) & 1) * SC_BUF; \
                _Pragma("unroll") for (int u = 0; u < 2; ++u) { const int st = st2 + 16 * u; const bool t0_ = ((c_) * SC_T + st) == 0; \
                    const f32x4 rc = {lo2f(RR.rc[u].x), hi2f(RR.rc[u].x), lo2f(RR.rc[u].y), hi2f(RR.rc[u].y)}; f32x4 rp = {lo2f(RR.rp[u].x), hi2f(RR.rp[u].x), lo2f(RR.rp[u].y), hi2f(RR.rp[u].y)}; \
                    const f32x4 kc = {lo2f(RR.kc[u].x), hi2f(RR.kc[u].x), lo2f(RR.kc[u].y), hi2f(RR.kc[u].y)}; f32x4 kp = {lo2f(RR.kp[u].x), hi2f(RR.kp[u].x), lo2f(RR.kp[u].y), hi2f(RR.kp[u].y)}; \
                    const f32x4 av = {lo2f(RR.av[u].x), hi2f(RR.av[u].x), lo2f(RR.av[u].y), hi2f(RR.av[u].y)}; const f32x4 lw = {lo2f(RR.lw[u].x), hi2f(RR.lw[u].x), lo2f(RR.lw[u].y), hi2f(RR.lw[u].y)}; \
                    if (t0_) { rp = (f32x4){0.f, 0.f, 0.f, 0.f}; kp = rp; } \
                    const f32x4 r = rc + (rp - rc) * mur, zk = kc + (kp - kc) * muk, kq = zk * ((av - 1.0f) * kac + 1.0f), kr = zk * kkc; \
                    const float ss = allsum16((kr.x * kr.x + kr.y * kr.y) + (kr.z * kr.z + kr.w * kr.w)); const float inv = 1.0f / fmaxf(sqrtf(ss), 1e-12f); \
                    const f32x4 kk = kr * inv; const f32x4 wv = {__expf(lw.x), __expf(lw.y), __expf(lw.z), __expf(lw.w)}; \
                    LAS float* dst = (LAS float*)bs + st * 64 + j4; \
                    *(LAS f32x4*)dst = wv; *(LAS f32x4*)(dst + SC_T * 64) = -kk; *(LAS f32x4*)(dst + 2 * SC_T * 64) = kk * av; *(LAS f32x4*)(dst + 3 * SC_T * 64) = kq; *(LAS f32x4*)(dst + 4 * SC_T * 64) = r; } \
                if (dov) { float vc[8], vp[8]; unpack8(RR.vc, vc); unpack8(RR.vp, vp); if ((c_) * SC_T + s2 == 0) { _Pragma("unroll") for (int i = 0; i < 8; ++i) vp[i] = 0.f; } \
                    LAS float* dv = (LAS float*)(bs + 5 * SC_T * 256) + s2 * 16 + hf * 8; \
                    *(LAS f32x4*)dv = (f32x4){vc[0] + (vp[0] - vc[0]) * m0.x, vc[1] + (vp[1] - vc[1]) * m0.y, vc[2] + (vp[2] - vc[2]) * m0.z, vc[3] + (vp[3] - vc[3]) * m0.w}; \
                    *(LAS f32x4*)(dv + 4) = (f32x4){vc[4] + (vp[4] - vc[4]) * m1.x, vc[5] + (vp[5] - vc[5]) * m1.y, vc[6] + (vp[6] - vc[6]) * m1.z, vc[7] + (vp[7] - vc[7]) * m1.w}; } } while (0)
#define SCAN_FLUSH(c_) do { if ((c_) >= 2 && dov) { LAS unsigned char* bs = F.lds + ((c_) & 1) * SC_BUF; const LAS float* yy = (const LAS float*)(bs + 5 * SC_T * 256 + SC_T * 64) + s2 * 16 + hf * 8; \
                const f32x4 y0 = *(const LAS f32x4*)yy, y1 = *(const LAS f32x4*)(yy + 4); const float v[8] = {y0.x, y0.y, y0.z, y0.w, y1.x, y1.y, y1.z, y1.w}; \
                *(u32x4*)(Y + (row0 + (size_t)((c_) - 2) * SC_T + s2) * 512 + cv) = pack8(v); } } while (0)
            for (int c = 0; c <= NCH + 1; c += 2) {
                SCAN_FLUSH(c);
                scan_issue(R1, ZR, A, LW, row0, (c + 1 < NCH ? c + 1 : NCH - 1) * SC_T, st2, col, s2, cv, dov);
                if (c < NCH) SCAN_BUILD(R0, c);
                LDS_BAR();
                SCAN_FLUSH(c + 1);
                scan_issue(R0, ZR, A, LW, row0, (c + 2 < NCH ? c + 2 : NCH - 1) * SC_T, st2, col, s2, cv, dov);
                if (c + 1 < NCH) SCAN_BUILD(R1, c + 1);
                LDS_BAR();
            }
#undef SCAN_BUILD
#undef SCAN_FLUSH
        } else {
            const int rg = lane >> 4, jl = lane & 15;
            f32x2 Sa = {0.f, 0.f}, Sb = {0.f, 0.f};
            for (int c = 0; c <= NCH + 1; c += 2) {
#pragma unroll
                for (int half = 0; half < 2; ++half) {
                    const int cc = c + half;
                    if (cc >= 1 && cc <= NCH) {
                        LAS unsigned char* bc = F.lds + ((cc + 1) & 1) * SC_BUF;
                        const LAS float* base = (const LAS float*)bc + 4 * jl;
                        const LAS float* vb = (const LAS float*)(bc + 5 * SC_T * 256) + wave * 4 + rg;
                        LAS float* yb = (LAS float*)(bc + 5 * SC_T * 256 + SC_T * 64) + wave * 4 + rg;
                        f32x4 w[2][2], nk[2][2], bb[2][2], kv[2][2], rr[2][2]; float vv1[2][2];
#define SC_LOAD(slot, g_) do { _Pragma("unroll") for (int q = 0; q < 2; ++q) { const int st_ = (g_) * 2 + q; \
                            w[slot][q] = *(const LAS f32x4*)(base + st_ * 64); nk[slot][q] = *(const LAS f32x4*)(base + SC_T * 64 + st_ * 64); bb[slot][q] = *(const LAS f32x4*)(base + 2 * SC_T * 64 + st_ * 64); \
                            kv[slot][q] = *(const LAS f32x4*)(base + 3 * SC_T * 64 + st_ * 64); rr[slot][q] = *(const LAS f32x4*)(base + 4 * SC_T * 64 + st_ * 64); vv1[slot][q] = vb[st_ * 16]; } } while (0)
                        SC_LOAD(0, 0);
#pragma unroll
                        for (int g = 0; g < SC_T / 2; ++g) {
                            const int sl = g & 1;
                            if (g + 1 < SC_T / 2) { if (sl == 0) SC_LOAD(1, g + 1); else SC_LOAD(0, g + 1); }
                            float yo[2];
#pragma unroll
                            for (int q = 0; q < 2; ++q) {
                                const f32x4 w_ = w[sl][q], nk_ = nk[sl][q], bb_ = bb[sl][q], kv_ = kv[sl][q], rr_ = rr[sl][q]; const float v = vv1[sl][q];
                                const f32x2 t0 = Sa * (f32x2){nk_.x, nk_.y} + Sb * (f32x2){nk_.z, nk_.w};
                                const float sa = allsum16(t0.x + t0.y);
                                const f32x2 vv = {v, v}, ss = {sa, sa};
                                Sa = Sa * (f32x2){w_.x, w_.y} + (ss * (f32x2){bb_.x, bb_.y} + vv * (f32x2){kv_.x, kv_.y});
                                Sb = Sb * (f32x2){w_.z, w_.w} + (ss * (f32x2){bb_.z, bb_.w} + vv * (f32x2){kv_.z, kv_.w});
                                const f32x2 t1 = Sa * (f32x2){rr_.x, rr_.y} + Sb * (f32x2){rr_.z, rr_.w};
                                yo[q] = allsum16(t1.x + t1.y);
                            }
                            if (jl == 0) { yb[(g * 2) * 16] = yo[0]; yb[(g * 2 + 1) * 16] = yo[1]; }
                        }
#undef SC_LOAD
                    }
                    LDS_BAR();
                }
            }
        }
    }
}

__device__ __forceinline__ void p_attn_naive(const Frame& F) {
    const int lane_f = lane_id_fresh(), tid_f = F.wave * 64 + lane_f;
    const bf16* Q = (const bf16*)(F.dob + DO_Q); const bf16* KC = (const bf16*)(F.ws + WS_KC); const bf16* VC = (const bf16*)(F.ws + WS_VC); bf16* YM = (bf16*)(F.ws + WS_YM);
    LAS float* Ks = (LAS float*)F.lds; LAS float* Vs = (LAS float*)(F.lds + 32 * 96 * 4);
    const int tid = tid_f;
    for (int unit = F.vcu; unit < 64 * 16; unit += F.G) {
        const int bh = unit >> 4, qb = 15 - (unit & 15), b = bh >> 3, h = bh & 7; const size_t row0 = (size_t)b * SEQ; const int t = qb * 512 + tid;
        unsigned qp[48];
        { const u32x4* qg = (const u32x4*)(Q + (row0 + t) * 768 + h * 96);
#pragma unroll
          for (int i = 0; i < 12; ++i) { const u32x4 w = qg[i]; qp[4 * i] = w.x; qp[4 * i + 1] = w.y; qp[4 * i + 2] = w.z; qp[4 * i + 3] = w.w; } }
        float o[64];
#pragma unroll
        for (int i = 0; i < 64; ++i) o[i] = 0.f;
        float mx = -INFINITY, l = 0.f;
        const int nkt = (qb + 1) * 16;
        for (int kt = 0; kt < nkt; ++kt) {
            __syncthreads();
            if (tid < 384) { const int r = tid / 12, c8 = (tid % 12) * 8; float v[8]; unpack8(*(const u32x4*)(KC + (row0 + kt * 32 + r) * 768 + h * 96 + c8), v);
#pragma unroll
                for (int i = 0; i < 8; ++i) Ks[r * 96 + c8 + i] = v[i]; }
            if (tid < 256) { const int r = tid >> 3, c8 = (tid & 7) * 8; float v[8]; unpack8(*(const u32x4*)(VC + (row0 + kt * 32 + r) * 512 + h * 64 + c8), v);
#pragma unroll
                for (int i = 0; i < 8; ++i) Vs[r * 64 + c8 + i] = v[i]; }
            __syncthreads();
            for (int kk = 0; kk < 32; ++kk) {
                const int kv = kt * 32 + kk;
                float s = 0.f; const LAS f32x4* kr = (const LAS f32x4*)(Ks + kk * 96);
#pragma unroll
                for (int i = 0; i < 24; ++i) { const f32x4 k4 = kr[i]; s += lo2f(qp[2 * i]) * k4.x + hi2f(qp[2 * i]) * k4.y + lo2f(qp[2 * i + 1]) * k4.z + hi2f(qp[2 * i + 1]) * k4.w; }
                if (kv <= t) {
                    const float mn = fmaxf(mx, s), f = exp2f(mx - mn), p = exp2f(s - mn); mx = mn; l = l * f + p;
                    const LAS f32x4* vr = (const LAS f32x4*)(Vs + kk * 64);
#pragma unroll
                    for (int i = 0; i < 16; ++i) { const f32x4 v4 = vr[i]; o[4 * i] = o[4 * i] * f + p * v4.x; o[4 * i + 1] = o[4 * i + 1] * f + p * v4.y; o[4 * i + 2] = o[4 * i + 2] * f + p * v4.z; o[4 * i + 3] = o[4 * i + 3] * f + p * v4.w; }
                }
            }
        }
        const float il = 1.f / l; u32x4* og = (u32x4*)(YM + (row0 + t) * 512 + h * 64);
#pragma unroll
        for (int i = 0; i < 8; ++i) { u32x4 w; w.x = pk2(o[8 * i] * il, o[8 * i + 1] * il); w.y = pk2(o[8 * i + 2] * il, o[8 * i + 3] * il); w.z = pk2(o[8 * i + 4] * il, o[8 * i + 5] * il); w.w = pk2(o[8 * i + 6] * il, o[8 * i + 7] * il); og[i] = w; }
    }
    __syncthreads();
}

typedef float f32x16 __attribute__((ext_vector_type(16)));
typedef short s16x4 __attribute__((ext_vector_type(4)));
__device__ __forceinline__ int crow(int r, int hi) { return (r & 3) + 8 * (r >> 2) + 4 * hi; }
__device__ __forceinline__ float xhalf_max(float x) { auto rr = __builtin_amdgcn_permlane32_swap(__float_as_uint(x), __float_as_uint(x), false, false); return fmaxf(__uint_as_float(rr[0]), __uint_as_float(rr[1])); }
__device__ __forceinline__ float xhalf_sum(float x) { auto rr = __builtin_amdgcn_permlane32_swap(__float_as_uint(x), __float_as_uint(x), false, false); return __uint_as_float(rr[0]) + __uint_as_float(rr[1]); }
__device__ __forceinline__ bf16x8 packp(const f32x16& p, int s2) {
    u32x4 w; w.x = pk2(p[8 * s2 + 0], p[8 * s2 + 1]); w.y = pk2(p[8 * s2 + 2], p[8 * s2 + 3]); w.z = pk2(p[8 * s2 + 4], p[8 * s2 + 5]); w.w = pk2(p[8 * s2 + 6], p[8 * s2 + 7]);
    return __builtin_bit_cast(bf16x8, w);
}
__device__ __forceinline__ void p_attn_mfma(const Frame& F) {
    const int lane_f = lane_id_fresh(), tid_f = F.wave * 64 + lane_f;
    const bf16* Q = (const bf16*)(F.dob + DO_Q); const bf16* KC = (const bf16*)(F.ws + WS_KC); const bf16* VC = (const bf16*)(F.ws + WS_VC); bf16* YM = (bf16*)(F.ws + WS_YM);
    constexpr int KST = 208, VST = 192, KBYTES = 64 * KST, SUB = KBYTES + 64 * VST, BUF = 2 * SUB;
    const int tid = tid_f, lane = lane_f, wave = F.wave, r = lane & 31, hi = lane >> 5;
    int kg[3], kl[3], vg[2], vl[2];
#pragma unroll
    for (int i = 0; i < 3; ++i) { const int c = tid + 512 * i, row = c / 12, pc = c % 12; kg[i] = row * 768 + pc * 8; kl[i] = (row >> 6) * SUB + (row & 63) * KST + pc * 16; }
#pragma unroll
    for (int i = 0; i < 2; ++i) { const int c = tid + 512 * i, row = c >> 3, pc = c & 7; vg[i] = row * 512 + pc * 8; vl[i] = (row >> 6) * SUB + KBYTES + (row & 63) * VST + pc * 16; }
    const int g4 = lane >> 4, li = lane & 15;
    const int vtr = (4 * (g4 >> 1) + (li >> 2)) * VST + (16 * (g4 & 1) + 4 * (li & 3)) * 2;
    const int kfr = r * KST + hi * 16;
    LAS unsigned char* lds = F.lds;
    for (int item = F.vcu; item < 1024; item += F.G) {
        const int bh = item >> 4, sidx = item & 15, b = bh >> 3, h = bh & 7; const size_t row0 = (size_t)b * SEQ;
        const bf16* Kg = KC + row0 * 768 + h * 96; const bf16* Vg = VC + row0 * 512 + h * 64;
        for (int uu = 0; uu < 2; ++uu) {
            const int qb = uu == 0 ? 31 - sidx : sidx, q0 = qb * 256, NT = (q0 + 256) / 128;
            const int qw = q0 + wave * 32;
            bf16x8 qf[6];
            { const bf16* qp = Q + (row0 + qw + r) * 768 + h * 96 + hi * 8;
#pragma unroll
              for (int s = 0; s < 6; ++s) qf[s] = *(const bf16x8*)(qp + 16 * s); }
            f32x16 o0 = {}, o1 = {}; float m = -INFINITY, l = 0.f;
            u32x4 ak[3], av[2];
#pragma unroll
            for (int i = 0; i < 3; ++i) ak[i] = *(const u32x4*)(Kg + kg[i]);
#pragma unroll
            for (int i = 0; i < 2; ++i) av[i] = *(const u32x4*)(Vg + vg[i]);
            asm volatile("" : "+v"(qf[0]), "+v"(qf[1]), "+v"(qf[2]), "+v"(qf[3]), "+v"(qf[4]), "+v"(qf[5]));
            LDS_BAR();
#pragma unroll
            for (int i = 0; i < 3; ++i) *(LAS u32x4*)(lds + kl[i]) = ak[i];
#pragma unroll
            for (int i = 0; i < 2; ++i) *(LAS u32x4*)(lds + vl[i]) = av[i];
            LDS_BAR();
            for (int t = 0; t < NT; ++t) {
                LAS unsigned char* bb = lds + (t & 1) * BUF;
                { const int tn = (t + 1 < NT) ? t + 1 : t;
                  const bf16* kgp = Kg + (size_t)tn * 128 * 768; const bf16* vgp = Vg + (size_t)tn * 128 * 512;
#pragma unroll
                  for (int i = 0; i < 3; ++i) ak[i] = *(const u32x4*)(kgp + kg[i]);
#pragma unroll
                  for (int i = 0; i < 2; ++i) av[i] = *(const u32x4*)(vgp + vg[i]); }
#pragma unroll
                for (int sub = 0; sub < 2; ++sub) {
                    const int tt = 2 * t + sub;
                    if (64 * tt <= qw + 31) {
                        LAS unsigned char* kb = bb + sub * SUB; LAS unsigned char* vb = kb + KBYTES;
                        f32x16 p0 = {}, p1 = {};
#pragma unroll
                        for (int s = 0; s < 6; ++s) { const bf16x8 k0 = *(const LAS bf16x8*)(kb + kfr + s * 32), k1 = *(const LAS bf16x8*)(kb + kfr + 32 * KST + s * 32);
                            p0 = __builtin_amdgcn_mfma_f32_32x32x16_bf16(k0, qf[s], p0, 0, 0, 0); p1 = __builtin_amdgcn_mfma_f32_32x32x16_bf16(k1, qf[s], p1, 0, 0, 0); }
                        if (64 * tt + 63 > qw) {
                            const int qrel = qw + r - 64 * tt;
#pragma unroll
                            for (int rg = 0; rg < 16; ++rg) { const int kv = crow(rg, hi); if (kv > qrel) p0[rg] = -INFINITY; if (kv + 32 > qrel) p1[rg] = -INFINITY; }
                        }
                        float mx = fmaxf(p0[0], p1[0]);
#pragma unroll
                        for (int rg = 1; rg < 16; ++rg) mx = fmaxf(mx, fmaxf(p0[rg], p1[rg]));
                        mx = xhalf_max(mx);
                        if (!__all(mx <= m + 8.0f)) {
                            const float mn = fmaxf(m, mx), f = __builtin_amdgcn_exp2f(m - mn); m = mn; l *= f;
#pragma unroll
                            for (int rg = 0; rg < 16; ++rg) { o0[rg] *= f; o1[rg] *= f; }
                        }
                        float rs = 0.f;
#pragma unroll
                        for (int rg = 0; rg < 16; ++rg) { p0[rg] = __builtin_amdgcn_exp2f(p0[rg] - m); p1[rg] = __builtin_amdgcn_exp2f(p1[rg] - m); rs += p0[rg] + p1[rg]; }
                        l += rs;
#pragma unroll
                        for (int hh = 0; hh < 2; ++hh)
#pragma unroll
                            for (int s2 = 0; s2 < 2; ++s2) { const bf16x8 pf = packp(hh == 0 ? p0 : p1, s2);
#pragma unroll
                                for (int db = 0; db < 2; ++db) { LAS unsigned char* vp_ = vb + vtr + (32 * hh + 16 * s2) * VST + db * 64;
                                    const s16x4 lo = __builtin_bit_cast(s16x4, __builtin_amdgcn_ds_read_tr16_b64_v4i16((LAS s16x4*)vp_));
                                    const s16x4 hi4 = __builtin_bit_cast(s16x4, __builtin_amdgcn_ds_read_tr16_b64_v4i16((LAS s16x4*)(vp_ + 8 * VST)));
                                    const bf16x8 vf = (bf16x8){lo[0], lo[1], lo[2], lo[3], hi4[0], hi4[1], hi4[2], hi4[3]};
                                    if (db == 0) o0 = __builtin_amdgcn_mfma_f32_32x32x16_bf16(vf, pf, o0, 0, 0, 0); else o1 = __builtin_amdgcn_mfma_f32_32x32x16_bf16(vf, pf, o1, 0, 0, 0); } }
                    }
                }
                { LAS unsigned char* nb = lds + ((t + 1) & 1) * BUF;
#pragma unroll
                  for (int i = 0; i < 3; ++i) *(LAS u32x4*)(nb + kl[i]) = ak[i];
#pragma unroll
                  for (int i = 0; i < 2; ++i) *(LAS u32x4*)(nb + vl[i]) = av[i]; }
                LDS_BAR();
            }
            const float il = 1.0f / xhalf_sum(l);
            bf16* op = YM + (row0 + qw + r) * 512 + h * 64 + 4 * hi;
#pragma unroll
            for (int gq = 0; gq < 4; ++gq) { u32x2 w0, w1;
                w0.x = pk2(o0[4 * gq] * il, o0[4 * gq + 1] * il); w0.y = pk2(o0[4 * gq + 2] * il, o0[4 * gq + 3] * il);
                w1.x = pk2(o1[4 * gq] * il, o1[4 * gq + 1] * il); w1.y = pk2(o1[4 * gq + 2] * il, o1[4 * gq + 3] * il);
                *(u32x2*)(op + 8 * gq) = w0; *(u32x2*)(op + 32 + 8 * gq) = w1; }
        }
    }
    __syncthreads();
}

constexpr int CS_RS = 144;
constexpr int CS_IMG = 16 * CS_RS;
constexpr int CS_WAVE = 8 * CS_IMG + 512;
enum { IM_A = 0, IM_R = 1, IM_B = 2, IM_K = 3, IM_BH = 4, IM_KH = 5, IM_V = 6, IM_G = 7 };
constexpr size_t DO_CSP = 64 * MiB, DO_CSG = 128 * MiB, DO_CSZ = 192 * MiB;
__device__ __forceinline__ int crow8(int q, int hi) { return (q & 3) + 8 * ((q >> 2) & 1) + 4 * hi; }
template <int N> __device__ __forceinline__ float dpp_shr0(float x) { return __builtin_bit_cast(float, __builtin_amdgcn_update_dpp(0, __builtin_bit_cast(int, x), 0x110 + N, 0xf, 0xf, true)); }
__device__ __forceinline__ float rowscan16(float x) { x += dpp_shr0<1>(x); x += dpp_shr0<2>(x); x += dpp_shr0<4>(x); x += dpp_shr0<8>(x); return x; }
__device__ __forceinline__ float xsum_16_32(float v) {
    { auto r = __builtin_amdgcn_permlane16_swap(__float_as_uint(v), __float_as_uint(v), false, false); v = __uint_as_float(r[0]) + __uint_as_float(r[1]); }
    { auto r = __builtin_amdgcn_permlane32_swap(__float_as_uint(v), __float_as_uint(v), false, false); v = __uint_as_float(r[0]) + __uint_as_float(r[1]); }
    return v;
}
__device__ __forceinline__ bf16x8 cs_rowfrag(const LAS unsigned char* rowp, int hi, int ks) {
    const LAS unsigned char* p = rowp + (16 * ks + 4 * hi) * 2; const u32x2 a = *(const LAS u32x2*)p, b = *(const LAS u32x2*)(p + 16);
    return __builtin_bit_cast(bf16x8, (u32x4){a.x, a.y, b.x, b.y});
}
__device__ __forceinline__ bf16x8 cs_trfrag(LAS unsigned char* img, int cb, int lane) {
    const int g4 = lane >> 4, li = lane & 15; LAS unsigned char* p = img + (4 * (g4 >> 1) + (li >> 2)) * CS_RS + (32 * cb + 16 * (g4 & 1) + 4 * (li & 3)) * 2;
    const s16x4 lo = __builtin_bit_cast(s16x4, __builtin_amdgcn_ds_read_tr16_b64_v4i16((LAS s16x4*)p));
    const s16x4 h4 = __builtin_bit_cast(s16x4, __builtin_amdgcn_ds_read_tr16_b64_v4i16((LAS s16x4*)(p + 8 * CS_RS)));
    return (bf16x8){lo[0], lo[1], lo[2], lo[3], h4[0], h4[1], h4[2], h4[3]};
}
__device__ __forceinline__ bf16x8 cs_zero8() { return (bf16x8){0, 0, 0, 0, 0, 0, 0, 0}; }
struct CsIn { const bf16 *ZR, *A, *LW, *G; const float *mu, *k_k, *k_a, *r_k; };
template <bool USE_V, bool WITH_Y>
__device__ __forceinline__ void cs_prep(const CsIn& in, size_t row0, int tok0, int h, LAS unsigned char* wl, int lane) {
    const int t = lane & 15, jq = lane >> 4, tok = tok0 + t; const bool first = tok == 0;
    const size_t g = row0 + tok, gp = row0 + (first ? 0 : tok - 1); const int c0 = h * 64 + 16 * jq;
    LAS float* gct = (LAS float*)(wl + 8 * CS_IMG); LAS float* btt = gct + 64;
    float inv;
    { float ss = 0.f;
#pragma unroll
      for (int hf = 0; hf < 2; ++hf) { float kc[8], kp[8]; unpack8(*(const u32x4*)(in.ZR + g * 1792 + 512 + c0 + 8 * hf), kc); unpack8(*(const u32x4*)(in.ZR + gp * 1792 + 512 + c0 + 8 * hf), kp);
          const f32x4 m0 = *(const f32x4*)(in.mu + 512 + c0 + 8 * hf), m1 = *(const f32x4*)(in.mu + 512 + c0 + 8 * hf + 4), q0 = *(const f32x4*)(in.k_k + c0 + 8 * hf), q1 = *(const f32x4*)(in.k_k + c0 + 8 * hf + 4);
          const float mm[8] = {m0.x, m0.y, m0.z, m0.w, m1.x, m1.y, m1.z, m1.w}, qq[8] = {q0.x, q0.y, q0.z, q0.w, q1.x, q1.y, q1.z, q1.w};
#pragma unroll
          for (int e = 0; e < 8; ++e) { const float zk = kc[e] + ((first ? 0.f : kp[e]) - kc[e]) * mm[e]; const float kr = zk * qq[e]; ss += kr * kr; } }
      inv = 1.0f / fmaxf(sqrtf(xsum_16_32(ss)), 1e-12f); }
    float btacc = 0.f;
#pragma unroll
    for (int hf = 0; hf < 2; ++hf) {
        const int cc = c0 + 8 * hf;
        float rc[8], rp[8], kc[8], kp[8], av[8], lw[8];
        unpack8(*(const u32x4*)(in.ZR + g * 1792 + cc), rc); unpack8(*(const u32x4*)(in.ZR + gp * 1792 + cc), rp);
        unpack8(*(const u32x4*)(in.ZR + g * 1792 + 512 + cc), kc); unpack8(*(const u32x4*)(in.ZR + gp * 1792 + 512 + cc), kp);
        unpack8(*(const u32x4*)(in.A + g * 512 + cc), av); unpack8(*(const u32x4*)(in.LW + g * 512 + cc), lw);
        float mr[8], mk[8], qk[8], qa[8], qr[8];
        { const f32x4 a0 = *(const f32x4*)(in.mu + cc), a1 = *(const f32x4*)(in.mu + cc + 4), b0 = *(const f32x4*)(in.mu + 512 + cc), b1 = *(const f32x4*)(in.mu + 512 + cc + 4);
          const f32x4 c0_ = *(const f32x4*)(in.k_k + cc), c1_ = *(const f32x4*)(in.k_k + cc + 4), d0 = *(const f32x4*)(in.k_a + cc), d1 = *(const f32x4*)(in.k_a + cc + 4);
          mr[0] = a0.x; mr[1] = a0.y; mr[2] = a0.z; mr[3] = a0.w; mr[4] = a1.x; mr[5] = a1.y; mr[6] = a1.z; mr[7] = a1.w;
          mk[0] = b0.x; mk[1] = b0.y; mk[2] = b0.z; mk[3] = b0.w; mk[4] = b1.x; mk[5] = b1.y; mk[6] = b1.z; mk[7] = b1.w;
          qk[0] = c0_.x; qk[1] = c0_.y; qk[2] = c0_.z; qk[3] = c0_.w; qk[4] = c1_.x; qk[5] = c1_.y; qk[6] = c1_.z; qk[7] = c1_.w;
          qa[0] = d0.x; qa[1] = d0.y; qa[2] = d0.z; qa[3] = d0.w; qa[4] = d1.x; qa[5] = d1.y; qa[6] = d1.z; qa[7] = d1.w; }
        if (WITH_Y) { const f32x4 e0 = *(const f32x4*)(in.r_k + cc), e1 = *(const f32x4*)(in.r_k + cc + 4); qr[0] = e0.x; qr[1] = e0.y; qr[2] = e0.z; qr[3] = e0.w; qr[4] = e1.x; qr[5] = e1.y; qr[6] = e1.z; qr[7] = e1.w; }
        float oA[8], oR[8], oB[8], oK[8], oBH[8], oKH[8];
#pragma unroll
        for (int e = 0; e < 8; ++e) {
            const float r = rc[e] + ((first ? 0.f : rp[e]) - rc[e]) * mr[e]; const float zk = kc[e] + ((first ? 0.f : kp[e]) - kc[e]) * mk[e];
            const float kq = zk * (1.f + (av[e] - 1.f) * qa[e]); const float kk = zk * qk[e] * inv; const float b = kk * av[e];
            const float Lg = rowscan16(lw[e]); const float eLg = __builtin_amdgcn_exp2f(1.4426950408889634f * Lg); const float enLg = __builtin_amdgcn_rcpf(eLg);
            const float eLgm = __builtin_bit_cast(float, __builtin_amdgcn_update_dpp(0x3f800000, __builtin_bit_cast(int, eLg), 0x111, 0xf, 0xf, false));
            const float eC = __builtin_bit_cast(float, __builtin_amdgcn_ds_bpermute(((lane & 48) | 15) << 2, __builtin_bit_cast(int, eLg)));
            oA[e] = -kk * eLgm; oR[e] = r * eLg; oB[e] = b * enLg; oK[e] = kq * enLg; oBH[e] = oB[e] * eC; oKH[e] = oK[e] * eC;
            if (WITH_Y) btacc += r * kq * qr[e];
            if (t == 15) gct[16 * jq + 8 * hf + e] = eC;
        }
        const int wo = t * CS_RS + (16 * jq + 8 * hf) * 2;
        *(LAS u32x4*)(wl + IM_A * CS_IMG + wo) = pack8(oA); *(LAS u32x4*)(wl + IM_R * CS_IMG + wo) = pack8(oR); *(LAS u32x4*)(wl + IM_B * CS_IMG + wo) = pack8(oB);
        *(LAS u32x4*)(wl + IM_K * CS_IMG + wo) = pack8(oK); *(LAS u32x4*)(wl + IM_BH * CS_IMG + wo) = pack8(oBH); *(LAS u32x4*)(wl + IM_KH * CS_IMG + wo) = pack8(oKH);
        if (USE_V) { float vc[8], vp[8], o[8]; unpack8(*(const u32x4*)(in.ZR + g * 1792 + 1024 + cc), vc); unpack8(*(const u32x4*)(in.ZR + gp * 1792 + 1024 + cc), vp);
            const f32x4 a0 = *(const f32x4*)(in.mu + 1024 + cc), a1 = *(const f32x4*)(in.mu + 1024 + cc + 4); const float mv[8] = {a0.x, a0.y, a0.z, a0.w, a1.x, a1.y, a1.z, a1.w};
#pragma unroll
            for (int e = 0; e < 8; ++e) o[e] = vc[e] + ((first ? 0.f : vp[e]) - vc[e]) * mv[e];
            *(LAS u32x4*)(wl + IM_V * CS_IMG + wo) = pack8(o); }
        if (WITH_Y) *(LAS u32x4*)(wl + IM_G * CS_IMG + wo) = *(const u32x4*)(in.G + g * 512 + cc);
    }
    if (WITH_Y) { btacc = xsum_16_32(btacc); if (lane < 16) btt[lane] = btacc; }
}
template <bool USE_V, bool WITH_Y>
__device__ __forceinline__ void cs_step(f32x16 (&Z)[2][2], f32x16 (&D)[2], LAS unsigned char* wl, int lane) {
    const int hi = lane >> 5, row = lane & 15; const bool up = (lane & 16) != 0;
    const LAS unsigned char* rpAR = wl + (up ? IM_R : IM_A) * CS_IMG + row * CS_RS; const LAS unsigned char* rpBK = wl + (up ? IM_K : IM_B) * CS_IMG + row * CS_RS;
    bf16x8 fAR[4];
#pragma unroll
    for (int ks = 0; ks < 4; ++ks) fAR[ks] = cs_rowfrag(rpAR, hi, ks);
    f32x16 F1 = {}, F2 = {};
#pragma unroll
    for (int ks = 0; ks < 4; ++ks) { const bf16x8 fBK = cs_rowfrag(rpBK, hi, ks);
        F1 = __builtin_amdgcn_mfma_f32_32x32x16_bf16(fBK, fAR[ks], F1, 0, 0, 0);
        F2 = __builtin_amdgcn_mfma_f32_32x32x16_bf16(fAR[ks], fBK, F2, 0, 0, 0); }
#pragma unroll
    for (int q = 0; q < 8; ++q) { const int s = crow8(q, hi); const bool k1 = up ? (s <= row) : (s < row);
        F1[q] = k1 ? F1[q] : 0.f; F1[8 + q] = k1 ? F1[8 + q] : 0.f; F2[q] = (!up && row < s) ? F2[q] : 0.f; }
    const bf16x8 f1lo = packp(F1, 0);
    const bf16x8 aL1 = up ? cs_zero8() : f1lo;
    const bf16x8 aMb = up ? f1lo : cs_zero8();
    const bf16x8 aLkMk = packp(F1, 1);
    const bf16x8 p2 = packp(F2, 0);
    const f32x16 z16 = {};
    const f32x16 Q1 = __builtin_amdgcn_mfma_f32_32x32x16_bf16(p2, aL1, z16, 0, 0, 0), Q2 = __builtin_amdgcn_mfma_f32_32x32x16_bf16(aL1, p2, z16, 0, 0, 0);
    const bf16x8 aL2 = packp(Q1, 0), p2b = packp(Q2, 0);
    const f32x16 R1 = __builtin_amdgcn_mfma_f32_32x32x16_bf16(p2b, aL2, z16, 0, 0, 0), R2 = __builtin_amdgcn_mfma_f32_32x32x16_bf16(aL2, p2b, z16, 0, 0, 0);
    const bf16x8 aL4 = packp(R1, 0), p2c = packp(R2, 0);
    const f32x16 S1 = __builtin_amdgcn_mfma_f32_32x32x16_bf16(p2c, aL4, z16, 0, 0, 0);
    const bf16x8 aL8 = packp(S1, 0);
    bf16x8 vf[2];
    if (USE_V) { vf[0] = cs_trfrag(wl + IM_V * CS_IMG, 0, lane); vf[1] = cs_trfrag(wl + IM_V * CS_IMG, 1, lane); }
#pragma unroll
    for (int nb = 0; nb < 2; ++nb) { f32x16 d = {};
#pragma unroll
        for (int jb = 0; jb < 2; ++jb)
#pragma unroll
            for (int k2 = 0; k2 < 2; ++k2) d = __builtin_amdgcn_mfma_f32_32x32x16_bf16(fAR[2 * jb + k2], packp(Z[jb][nb], k2), d, 0, 0, 0);
        if (USE_V) d = __builtin_amdgcn_mfma_f32_32x32x16_bf16(aLkMk, vf[nb], d, 0, 0, 0);
        D[nb] = d; }
#pragma unroll
    for (int nb = 0; nb < 2; ++nb) {
        D[nb] = __builtin_amdgcn_mfma_f32_32x32x16_bf16(aL8, packp(D[nb], 0), D[nb], 0, 0, 0);
        D[nb] = __builtin_amdgcn_mfma_f32_32x32x16_bf16(aL4, packp(D[nb], 0), D[nb], 0, 0, 0);
        D[nb] = __builtin_amdgcn_mfma_f32_32x32x16_bf16(aL2, packp(D[nb], 0), D[nb], 0, 0, 0);
        D[nb] = __builtin_amdgcn_mfma_f32_32x32x16_bf16(aL1, packp(D[nb], 0), D[nb], 0, 0, 0);
    }
    const bf16x8 u0 = packp(D[0], 0), u1 = packp(D[1], 0);
    if (WITH_Y) { D[0] = __builtin_amdgcn_mfma_f32_32x32x16_bf16(aMb, u0, D[0], 0, 0, 0); D[1] = __builtin_amdgcn_mfma_f32_32x32x16_bf16(aMb, u1, D[1], 0, 0, 0); }
    const LAS float* gct = (const LAS float*)(wl + 8 * CS_IMG);
#pragma unroll
    for (int jb = 0; jb < 2; ++jb) {
        const bf16x8 fb = cs_trfrag(wl + IM_BH * CS_IMG, jb, lane); bf16x8 fk = cs_zero8(); if (USE_V) fk = cs_trfrag(wl + IM_KH * CS_IMG, jb, lane);
        float gc[16];
#pragma unroll
        for (int g4 = 0; g4 < 4; ++g4) { const f32x4 x = *(const LAS f32x4*)(gct + 32 * jb + 8 * g4 + 4 * hi); gc[4 * g4] = x.x; gc[4 * g4 + 1] = x.y; gc[4 * g4 + 2] = x.z; gc[4 * g4 + 3] = x.w; }
#pragma unroll
        for (int nb = 0; nb < 2; ++nb) { f32x16 z = Z[jb][nb];
#pragma unroll
            for (int q = 0; q < 16; ++q) z[q] *= gc[q];
            z = __builtin_amdgcn_mfma_f32_32x32x16_bf16(fb, nb == 0 ? u0 : u1, z, 0, 0, 0);
            if (USE_V) z = __builtin_amdgcn_mfma_f32_32x32x16_bf16(fk, vf[nb], z, 0, 0, 0);
            Z[jb][nb] = z; }
    }
}
template <int PART>
__device__ __forceinline__ void p_cs_a_part(const Frame& F, ArgsP a) {
    const int lane = lane_id_fresh();
    LAS unsigned char* wl = F.lds + F.wave * CS_WAVE;
    CsIn in{(const bf16*)(F.ws + WS_ZR), (const bf16*)(F.ws + WS_A), (const bf16*)(F.ws + WS_LW), (const bf16*)(F.dob + DO_G), a->in[I_MU], a->in[I_KK], a->in[I_KA], a->in[I_RK]};
    bf16* Pm = (bf16*)(F.dob + DO_CSP); bf16* Gf = (bf16*)(F.dob + DO_CSG);
    const int hi = lane >> 5;
    for (int uc = F.gw; uc < 64 * 128; uc += F.NGW) {
        const int bh = uc >> 7, c = uc & 127, b = bh >> 3, h = bh & 7; const size_t row0 = (size_t)b * SEQ;
        f32x16 Z[2][2], D[2];
#pragma unroll
        for (int jb = 0; jb < 2; ++jb)
#pragma unroll
            for (int nb = 0; nb < 2; ++nb) { f32x16 z = {};
                if (PART == 0 && jb == nb) {
#pragma unroll
                    for (int q = 0; q < 16; ++q) z[q] = (crow(q, hi) == (lane & 31)) ? 1.f : 0.f; }
                Z[jb][nb] = z; }
        for (int sc = 0; sc < 4; ++sc) { int ln = lane; asm volatile("" : "+v"(ln));
            cs_prep<PART == 1, false>(in, row0, c * 64 + sc * 16, h, wl, ln); asm volatile("s_waitcnt lgkmcnt(0)" ::: "memory"); cs_step<PART == 1, false>(Z, D, wl, ln); asm volatile("s_waitcnt lgkmcnt(0)" ::: "memory"); }
        if (PART == 0) {
            LAS unsigned short* tb = (LAS unsigned short*)(wl + 4 * hi * CS_RS + (lane & 31) * 2);
#pragma unroll
            for (int jb = 0; jb < 2; ++jb)
#pragma unroll
                for (int nb = 0; nb < 2; ++nb)
#pragma unroll
                    for (int q = 0; q < 16; ++q) tb[((32 * jb + (q & 3) + 8 * (q >> 2)) * CS_RS + 64 * nb) / 2] = (unsigned short)f2bf(Z[jb][nb][q]);
            bf16* dst = Pm + (size_t)uc * 4096;
#pragma unroll
            for (int i = 0; i < 8; ++i) { const int ch = lane + 64 * i, rr = ch >> 3, c8 = (ch & 7) * 8; *(u32x4*)(dst + rr * 64 + c8) = *(const LAS u32x4*)(wl + rr * CS_RS + c8 * 2); }
        } else {
            bf16* dst = Gf + (size_t)uc * 4096;
#pragma unroll
            for (int jb = 0; jb < 2; ++jb)
#pragma unroll
                for (int nb = 0; nb < 2; ++nb) { u32x4 w0, w1; const f32x16& z = Z[jb][nb];
                    w0.x = pk2(z[0], z[1]); w0.y = pk2(z[2], z[3]); w0.z = pk2(z[4], z[5]); w0.w = pk2(z[6], z[7]); w1.x = pk2(z[8], z[9]); w1.y = pk2(z[10], z[11]); w1.z = pk2(z[12], z[13]); w1.w = pk2(z[14], z[15]);
                    u32x4* p = (u32x4*)(dst + ((jb * 2 + nb) * 64 + lane) * 16); p[0] = w0; p[1] = w1; }
        }
    }
}
struct CsB { u32x2 p[2][2][2][2]; u32x4 g[2][2]; };
__device__ __forceinline__ void csb_load(CsB& X, const bf16* Pm, const bf16* Gf, size_t uc, int nb, int lane) {
    const int hi = lane >> 5, r = lane & 31; const bf16* Pc = Pm + uc * 4096;
#pragma unroll
    for (int mb = 0; mb < 2; ++mb) {
#pragma unroll
        for (int jb = 0; jb < 2; ++jb)
#pragma unroll
            for (int k2 = 0; k2 < 2; ++k2) { const bf16* pr = Pc + (32 * mb + r) * 64 + 32 * jb + 16 * k2 + 4 * hi; X.p[mb][jb][k2][0] = *(const u32x2*)pr; X.p[mb][jb][k2][1] = *(const u32x2*)(pr + 8); }
        const u32x4* gp = (const u32x4*)(Gf + uc * 4096 + ((mb * 2 + nb) * 64 + lane) * 16); X.g[mb][0] = gp[0]; X.g[mb][1] = gp[1]; }
}
__device__ __forceinline__ void csb_step(f32x16 (&Z)[2], const CsB& X, bf16* Zf, size_t uc, int nb, int lane) {
#pragma unroll
    for (int jb = 0; jb < 2; ++jb) { u32x4 w0, w1; const f32x16& z = Z[jb];
        w0.x = pk2(z[0], z[1]); w0.y = pk2(z[2], z[3]); w0.z = pk2(z[4], z[5]); w0.w = pk2(z[6], z[7]); w1.x = pk2(z[8], z[9]); w1.y = pk2(z[10], z[11]); w1.z = pk2(z[12], z[13]); w1.w = pk2(z[14], z[15]);
        u32x4* p = (u32x4*)(Zf + uc * 4096 + ((jb * 2 + nb) * 64 + lane) * 16); p[0] = w0; p[1] = w1; }
    f32x16 N[2];
#pragma unroll
    for (int mb = 0; mb < 2; ++mb) { float g0[8], g1[8]; unpack8(X.g[mb][0], g0); unpack8(X.g[mb][1], g1);
#pragma unroll
        for (int q = 0; q < 8; ++q) { N[mb][q] = g0[q]; N[mb][8 + q] = g1[q]; } }
#pragma unroll
    for (int jb = 0; jb < 2; ++jb)
#pragma unroll
        for (int k2 = 0; k2 < 2; ++k2) { const bf16x8 zb = packp(Z[jb], k2);
#pragma unroll
            for (int mb = 0; mb < 2; ++mb) { const u32x2 x0 = X.p[mb][jb][k2][0], x1 = X.p[mb][jb][k2][1];
                N[mb] = __builtin_amdgcn_mfma_f32_32x32x16_bf16(__builtin_bit_cast(bf16x8, (u32x4){x0.x, x0.y, x1.x, x1.y}), zb, N[mb], 0, 0, 0); } }
    Z[0] = N[0]; Z[1] = N[1];
}
__device__ __forceinline__ void p_cs_b(const Frame& F) {
    const int lane = lane_id_fresh();
    const bf16* Pm = (const bf16*)(F.dob + DO_CSP); const bf16* Gf = (const bf16*)(F.dob + DO_CSG); bf16* Zf = (bf16*)(F.dob + DO_CSZ);
    for (int u16 = F.gw; u16 < 128 * 16; u16 += F.NGW) {
        if (u16 & 15) continue;
        const int u = u16 >> 4, bh = u >> 1, nb = u & 1; const size_t uc0 = (size_t)bh * 128;
        f32x16 Z[2] = {};
        CsB X0, X1;
        csb_load(X0, Pm, Gf, uc0, nb, lane);
        for (int c = 0; c < 128; c += 2) {
            csb_load(X1, Pm, Gf, uc0 + c + 1, nb, lane);
            csb_step(Z, X0, Zf, uc0 + c, nb, lane);
            csb_load(X0, Pm, Gf, uc0 + (c + 2 < 128 ? c + 2 : 127), nb, lane);
            csb_step(Z, X1, Zf, uc0 + c + 1, nb, lane);
        }
    }
}
__device__ __forceinline__ void p_cs_c(const Frame& F, ArgsP a) {
    const int lane = lane_id_fresh(), hi = lane >> 5;
    LAS unsigned char* wl = F.lds + F.wave * CS_WAVE;
    CsIn in{(const bf16*)(F.ws + WS_ZR), (const bf16*)(F.ws + WS_A), (const bf16*)(F.ws + WS_LW), (const bf16*)(F.dob + DO_G), a->in[I_MU], a->in[I_KK], a->in[I_KA], a->in[I_RK]};
    const bf16* Zf = (const bf16*)(F.dob + DO_CSZ); bf16* Y = (bf16*)(F.ws + WS_Y); const float* lnw = a->in[I_LNW]; const float* lnb = a->in[I_LNB];
    const LAS float* btt = (const LAS float*)(wl + 8 * CS_IMG) + 64;
    for (int uc = F.gw; uc < 64 * 128; uc += F.NGW) {
        const int bh = uc >> 7, c = uc & 127, b = bh >> 3, h = bh & 7; const size_t row0 = (size_t)b * SEQ;
        f32x16 Z[2][2], D[2];
#pragma unroll
        for (int jb = 0; jb < 2; ++jb)
#pragma unroll
            for (int nb = 0; nb < 2; ++nb) { const u32x4* p = (const u32x4*)(Zf + (size_t)uc * 4096 + ((jb * 2 + nb) * 64 + lane) * 16); float g0[8], g1[8]; unpack8(p[0], g0); unpack8(p[1], g1);
#pragma unroll
                for (int q = 0; q < 8; ++q) { Z[jb][nb][q] = g0[q]; Z[jb][nb][8 + q] = g1[q]; } }
        const float lw0 = lnw[h * 64 + (lane & 31)], lw1 = lnw[h * 64 + 32 + (lane & 31)], lb0 = lnb[h * 64 + (lane & 31)], lb1 = lnb[h * 64 + 32 + (lane & 31)];
        for (int sc = 0; sc < 4; ++sc) {
            const int tok0 = c * 64 + sc * 16;
            int ln = lane; asm volatile("" : "+v"(ln));
            cs_prep<true, true>(in, row0, tok0, h, wl, ln); asm volatile("s_waitcnt lgkmcnt(0)" ::: "memory");
            cs_step<true, true>(Z, D, wl, ln); asm volatile("s_waitcnt lgkmcnt(0)" ::: "memory");
            const bf16x8 v0 = cs_trfrag(wl + IM_V * CS_IMG, 0, lane), v1 = cs_trfrag(wl + IM_V * CS_IMG, 1, lane), g0 = cs_trfrag(wl + IM_G * CS_IMG, 0, lane), g1 = cs_trfrag(wl + IM_G * CS_IMG, 1, lane);
            const f32x4 bta = *(const LAS f32x4*)(btt + 4 * hi), btb = *(const LAS f32x4*)(btt + 8 + 4 * hi); const float bt[8] = {bta.x, bta.y, bta.z, bta.w, btb.x, btb.y, btb.z, btb.w};
#pragma unroll
            for (int q = 0; q < 8; ++q) {
                const float y0 = D[0][8 + q], y1 = D[1][8 + q];
                const float mean = allsum32(y0 + y1) * (1.f / 64.f); const float d0 = y0 - mean, d1 = y1 - mean;
                const float rstd = 1.0f / sqrtf(allsum32(d0 * d0 + d1 * d1) * (1.f / 64.f) + LN_X_EPS);
                const float o0 = (d0 * rstd * lw0 + lb0 + bt[q] * bf2f((unsigned short)v0[q])) * bf2f((unsigned short)g0[q]);
                const float o1 = (d1 * rstd * lw1 + lb1 + bt[q] * bf2f((unsigned short)v1[q])) * bf2f((unsigned short)g1[q]);
                bf16* yp = Y + (row0 + tok0 + crow8(q, hi)) * 512 + h * 64 + (lane & 31);
                yp[0] = (unsigned short)f2bf(o0); yp[32] = (unsigned short)f2bf(o1);
            }
            asm volatile("s_waitcnt lgkmcnt(0)" ::: "memory");
        }
    }
}

__device__ __forceinline__ void p_post_scan(const Frame& F, ArgsP a, bf16* YD) {
    const int lane_f = lane_id_fresh();
    bf16* Y = (bf16*)(F.ws + WS_Y); const bf16* ZR = (const bf16*)(F.ws + WS_ZR); const bf16* A = (const bf16*)(F.ws + WS_A); const bf16* G = (const bf16*)(F.dob + DO_G);
    const float* lnw = a->in[I_LNW]; const float* lnb = a->in[I_LNB]; const float* rk = a->in[I_RK]; const float* mu = a->in[I_MU]; const float* k_a = a->in[I_KA];
    const int lane = lane_f;
    for (int m = F.gw; m < NTOK; m += F.NGW) {
        const bool first = (m % SEQ) == 0; const size_t mp = first ? m : m - 1;
        float y[8], r[8], k[8], v[8], g[8], o[8], t[8], av[8];
        unpack8(*((const u32x4*)(Y + (size_t)m * 512) + lane), y); unpack8(*((const u32x4*)(G + (size_t)m * 512) + lane), g); unpack8(*((const u32x4*)(A + (size_t)m * 512) + lane), av);
        unpack8(*((const u32x4*)(ZR + (size_t)m * 1792) + lane), r); unpack8(*((const u32x4*)(ZR + mp * 1792) + lane), t);
#pragma unroll
        for (int i = 0; i < 8; ++i) r[i] += ((first ? 0.f : t[i]) - r[i]) * mu[8 * lane + i];
        unpack8(*((const u32x4*)(ZR + (size_t)m * 1792 + 512) + lane), k); unpack8(*((const u32x4*)(ZR + mp * 1792 + 512) + lane), t);
#pragma unroll
        for (int i = 0; i < 8; ++i) { const float zk = k[i] + ((first ? 0.f : t[i]) - k[i]) * mu[512 + 8 * lane + i]; k[i] = zk * (1.f + (av[i] - 1.f) * k_a[8 * lane + i]); }
        unpack8(*((const u32x4*)(ZR + (size_t)m * 1792 + 1024) + lane), v); unpack8(*((const u32x4*)(ZR + mp * 1792 + 1024) + lane), t);
#pragma unroll
        for (int i = 0; i < 8; ++i) v[i] += ((first ? 0.f : t[i]) - v[i]) * mu[1024 + 8 * lane + i];
        float s = 0.f, d = 0.f;
#pragma unroll
        for (int i = 0; i < 8; ++i) { s += y[i]; d += r[i] * k[i] * rk[8 * lane + i]; }
        const float mean = sum8(s) * (1.f / 64.f); d = sum8(d); float q = 0.f;
#pragma unroll
        for (int i = 0; i < 8; ++i) { y[i] -= mean; q += y[i] * y[i]; }
        const float rstd = 1.0f / sqrtf(sum8(q) * (1.f / 64.f) + LN_X_EPS);
#pragma unroll
        for (int i = 0; i < 8; ++i) o[i] = (y[i] * rstd * lnw[8 * lane + i] + lnb[8 * lane + i] + d * v[i]) * g[i];
        *((u32x4*)(YD + (size_t)m * 512) + lane) = pack8(o);
    }
}

__device__ __forceinline__ void p_ffn_route(const Frame& F, ArgsP a, unsigned* cnt, int* route) {
    const int lane_f = lane_id_fresh(), tid_f = F.wave * 64 + lane_f;
    const float* X1 = (const float*)F.dob; bf16* H2 = (bf16*)(F.ws + WS_H2); const float* mod = (const float*)(F.ws + WS_MOD); const float* g = a->in[I_GFFN];
    LAS float* wr = (LAS float*)F.lds;
    __syncthreads();
    for (int i = tid_f; i < 1024 * 4; i += NTHR) { const int k = i >> 2, o = i & 3; wr[o * 1024 + k] = a->in[I_WRG][i]; }
    for (int i = tid_f; i < 1024 * 32; i += NTHR) { const int k = i >> 5, o = i & 31; wr[(4 + o) * 1024 + k] = a->in[I_WRE][i]; }
    __syncthreads();
    const float* brg = a->in[I_BRG]; const float* bre = a->in[I_BRE];
    const int lane = lane_f;
    LAS unsigned* lcnt = (LAS unsigned*)(F.lds + LDS_MISC + 512);
    if (tid_f < 64) lcnt[tid_f] = 0u;
    __syncthreads();
    int my_e0 = 0, my_e1 = 0; float my_w0 = 0.f, my_w1 = 0.f; int kk_ = 0;
    for (int m = F.gw; m < NTOK; m += F.NGW, ++kk_) {
        const int b = m / SEQ; const f32x4* xr = (const f32x4*)(X1 + (size_t)m * 1024) + lane;
        f32x4 v[4]; float s = 0.f;
#pragma unroll
        for (int j = 0; j < 4; ++j) { v[j] = xr[64 * j]; s += (v[j].x * v[j].x + v[j].y * v[j].y) + (v[j].z * v[j].z + v[j].w * v[j].w); }
        const float rstd = 1.0f / sqrtf(wave_sum(s) * (1.f / 1024.f) + EPS);
        u32x2* o = (u32x2*)(H2 + (size_t)m * 1024) + lane;
#pragma unroll
        for (int j = 0; j < 4; ++j) { const int col = 4 * lane + 256 * j;
            const f32x4 gg = *(const f32x4*)(g + col), sc = *(const f32x4*)(mod + b * 6144 + 4096 + col), sh = *(const f32x4*)(mod + b * 6144 + 3072 + col);
            v[j] = v[j] * rstd * gg * (sc + 1.0f) + sh; u32x2 w; w.x = pk2(v[j].x, v[j].y); w.y = pk2(v[j].z, v[j].w); o[64 * j] = w; }
        float lgq[4];
#pragma unroll
        for (int oo = 0; oo < 4; ++oo) { float p = 0.f;
#pragma unroll
            for (int j = 0; j < 4; ++j) { const f32x4 w4 = *(const LAS f32x4*)(wr + oo * 1024 + 4 * lane + 256 * j); p += (v[j].x * w4.x + v[j].y * w4.y) + (v[j].z * w4.z + v[j].w * w4.w); }
            lgq[oo] = wave_sum(p) + brg[oo]; }
        int gi = 0; float gm = lgq[0];
#pragma unroll
        for (int i = 1; i < 4; ++i) { if (lgq[i] > gm) { gm = lgq[i]; gi = i; } }
        float gs = 0.f;
#pragma unroll
        for (int i = 0; i < 4; ++i) gs += __expf(lgq[i] - gm);
        const float pg = 1.f / gs;
        gi = __builtin_amdgcn_readfirstlane(gi);
        float el[8];
        { const LAS float* wg = wr + (4 + gi * 8) * 1024 + 4 * lane;
#pragma unroll
          for (int i = 0; i < 8; ++i) { float p = 0.f;
#pragma unroll
              for (int j = 0; j < 4; ++j) { const f32x4 w4 = *(const LAS f32x4*)(wg + i * 1024 + 256 * j); p += (v[j].x * w4.x + v[j].y * w4.y) + (v[j].z * w4.z + v[j].w * w4.w); }
              el[i] = wave_sum(p) + bre[gi * 8 + i]; } }
        int i0 = 0; float m0 = el[0];
#pragma unroll
        for (int i = 1; i < 8; ++i) if (el[i] > m0) { m0 = el[i]; i0 = i; }
        int i1 = -1; float m1 = -INFINITY;
#pragma unroll
        for (int i = 0; i < 8; ++i) if (i != i0 && el[i] > m1) { m1 = el[i]; i1 = i; }
        const float e1 = __expf(m1 - m0), w0 = pg / (1.f + e1), w1 = pg * e1 / (1.f + e1);
        if (lane == kk_) { my_e0 = gi * 8 + i0; my_e1 = gi * 8 + i1; my_w0 = w0; my_w1 = w1; }
    }
    unsigned lp0 = 0u, lp1 = 0u;
    if (lane < kk_) { lp0 = __hip_atomic_fetch_add(lcnt + my_e0, 1u, __ATOMIC_RELAXED, __HIP_MEMORY_SCOPE_WORKGROUP); lp1 = __hip_atomic_fetch_add(lcnt + my_e1, 1u, __ATOMIC_RELAXED, __HIP_MEMORY_SCOPE_WORKGROUP); }
    __syncthreads();
    if (tid_f < 32) lcnt[32 + tid_f] = __hip_atomic_fetch_add(cnt + tid_f, lcnt[tid_f], __ATOMIC_RELAXED, __HIP_MEMORY_SCOPE_AGENT);
    __syncthreads();
    if (lane < kk_) { const int m = F.gw + lane * F.NGW; int* rt = route + (size_t)m * 8;
        rt[0] = my_e0; rt[1] = my_e1; rt[2] = (int)(lcnt[32 + my_e0] + lp0); rt[3] = (int)(lcnt[32 + my_e1] + lp1); rt[4] = __builtin_bit_cast(int, my_w0); rt[5] = __builtin_bit_cast(int, my_w1); }
    __syncthreads();
}
__device__ __forceinline__ int moe_tables(const Frame& F, LAS int* offs, LAS int* texp) {
    const int lane_f = lane_id_fresh(), tid_f = F.wave * 64 + lane_f;
    const unsigned* cnt = (const unsigned*)(F.ws + WS_CTL) + CW_CNT;
    __syncthreads();
    if (tid_f == 0) { int o = 0; for (int e = 0; e < 32; ++e) { offs[e] = o; const int c = (int)__hip_atomic_load(cnt + e, __ATOMIC_RELAXED, __HIP_MEMORY_SCOPE_AGENT); const int nt = (c + 255) >> 8; for (int t = 0; t < nt; ++t) texp[(o >> 8) + t] = e; o += nt << 8; } offs[32] = o; }
    __syncthreads();
    return offs[32] >> 8;
}
__device__ __forceinline__ void p_gather(const Frame& F) {
    const int lane_f = lane_id_fresh(), tid_f = F.wave * 64 + lane_f;
    LAS int* offs = (LAS int*)(F.lds + 1024); LAS int* texp = (LAS int*)(F.lds + 2048);
    moe_tables(F, offs, texp);
    const bf16* H2 = (const bf16*)(F.ws + WS_H2); bf16* XG = (bf16*)(F.ws + WS_XG); const int* route = (const int*)(F.ws + WS_ROUTE); int* ent = (int*)(F.ws + WS_ENT);
    const unsigned* cnt = (const unsigned*)(F.ws + WS_CTL) + CW_CNT; const int lane = lane_f;
    for (int m = F.gw; m < NTOK; m += F.NGW) {
        const int* rt = route + (size_t)m * 8; const int d0 = offs[rt[0]] + rt[2], d1 = offs[rt[1]] + rt[3];
        const u32x4* src = (const u32x4*)(H2 + (size_t)m * 1024) + lane; const u32x4 a0 = src[0], a1 = src[64];
        u32x4* p0 = (u32x4*)(XG + (size_t)d0 * 1024) + lane; u32x4* p1 = (u32x4*)(XG + (size_t)d1 * 1024) + lane;
        p0[0] = a0; p0[64] = a1; p1[0] = a0; p1[64] = a1;
        if (lane == 0) { ent[2 * d0] = m; ent[2 * d0 + 1] = rt[4]; ent[2 * d1] = m; ent[2 * d1 + 1] = rt[5]; }
    }
    for (int i = F.gw; i < 32 * 256; i += F.NGW) { const int e = i >> 8, r = i & 255; const int c = (int)cnt[e]; const int pad = ((c + 255) & ~255) - c;
        if (r < pad) { u32x4* p = (u32x4*)(XG + (size_t)(offs[e] + c + r) * 1024) + lane; p[0] = (u32x4){0u, 0u, 0u, 0u}; p[64] = (u32x4){0u, 0u, 0u, 0u}; if (lane == 0) { ent[2 * (offs[e] + c + r)] = -1; ent[2 * (offs[e] + c + r) + 1] = 0; } } }
    __syncthreads();
}
__device__ __forceinline__ void p_combine(const Frame& F, float* dst) {
    const int lane_f = lane_id_fresh(), tid_f = F.wave * 64 + lane_f;
    LAS int* offs = (LAS int*)(F.lds + 1024); LAS int* texp = (LAS int*)(F.lds + 2048);
    moe_tables(F, offs, texp);
    float* out = (float*)F.dob; const bf16* YS = (const bf16*)(F.ws + WS_YS); const int* route = (const int*)(F.ws + WS_ROUTE); const float* mod = (const float*)(F.ws + WS_MOD);
    const int lane = lane_f;
    for (int m = F.gw; m < NTOK; m += F.NGW) {
        const int b = m / SEQ; const int* rt = route + (size_t)m * 8; const int d0 = offs[rt[0]] + rt[2], d1 = offs[rt[1]] + rt[3];
        const float w0 = __builtin_bit_cast(float, rt[4]), w1 = __builtin_bit_cast(float, rt[5]);
#pragma unroll
        for (int j = 0; j < 2; ++j) { const int col = 8 * lane + 512 * j; float y0[8], y1[8];
            unpack8(*(const u32x4*)(YS + (size_t)d0 * 1024 + col), y0); unpack8(*(const u32x4*)(YS + (size_t)d1 * 1024 + col), y1);
            float* o = out + (size_t)m * 1024 + col; const float* gt = mod + b * 6144 + 5120 + col;
            f32x4 x0 = *(const f32x4*)o, x1 = *(const f32x4*)(o + 4); const f32x4 g0 = *(const f32x4*)gt, g1 = *(const f32x4*)(gt + 4);
            x0.x += g0.x * (w0 * y0[0] + w1 * y1[0]); x0.y += g0.y * (w0 * y0[1] + w1 * y1[1]); x0.z += g0.z * (w0 * y0[2] + w1 * y1[2]); x0.w += g0.w * (w0 * y0[3] + w1 * y1[3]);
            x1.x += g1.x * (w0 * y0[4] + w1 * y1[4]); x1.y += g1.y * (w0 * y0[5] + w1 * y1[5]); x1.z += g1.z * (w0 * y0[6] + w1 * y1[6]); x1.w += g1.w * (w0 * y0[7] + w1 * y1[7]);
            float* od = dst + (size_t)m * 1024 + col; *(f32x4*)od = x0; *(f32x4*)(od + 4) = x1; }
    }
}

constexpr int NPHASE = 17;
template <int LO, int HI>
__global__ void __launch_bounds__(NTHR, 2) fwd(Args args) {
    extern __shared__ __attribute__((aligned(16))) unsigned char lds_raw[];
    Frame F;
    F.lds = (LAS unsigned char*)lds_raw;
    F.wave = __builtin_amdgcn_readfirstlane((int)threadIdx.x >> 6);
    F.G = gridDim.x; { const int bx = blockIdx.x; F.vcu = (F.G % 8 == 0) ? (bx % 8) * (F.G / 8) + bx / 8 : bx; }
    F.gw = F.vcu * NWAVES + F.wave; F.NGW = F.G * NWAVES;
    F.ws = args.ws; F.dob = (unsigned char*)args.out;
    ArgsP AP = (ArgsP)__builtin_amdgcn_kernarg_segment_ptr();
    volatile LAS unsigned* MISC = (volatile LAS unsigned*)(F.lds + LDS_MISC);
    if (threadIdx.x < 64) MISC[threadIdx.x] = 0u;
    __syncthreads();
    XcdBarrier bar; bar.bar = (unsigned*)(F.ws + WS_CTL) + CW_BAR; bar.x = 0; bar.st = MISC + 8;
#if N_LAUNCH_MODE == 1
    bar = xcd_barrier_post((unsigned*)(F.ws + WS_CTL) + CW_BAR, MISC + 8);
#define GRID_BAR() xcd_barrier(bar)
#else
#define GRID_BAR() do { } while (0)
#endif
#ifndef PROBE_REPEAT
#define PROBE_REPEAT -1
#endif
#define IN(k) (LO <= (k) && (k) < HI)
#define SEAM(k) do { if constexpr (IN(k) && IN((k) + 1)) GRID_BAR(); } while (0)
    const float* mod = (const float*)(F.ws + WS_MOD);

#define PH(k, ...) do { if constexpr (IN(k)) { asm volatile("" : "+s"(AP)); { __VA_ARGS__ } if constexpr (PROBE_REPEAT == (k)) { GRID_BAR(); asm volatile("" : "+s"(AP)); { __VA_ARGS__ } } } } while (0)
    PH(0, p0_prologue(F, AP);); SEAM(0);
    PH(1, p_normmod(F, AP->in[I_X], AP->in[I_GMIX], mod, 0, 1024, (bf16*)(F.ws + WS_H));); SEAM(1);
    PH(2, Gemm g{(const bf16*)(F.ws + WS_H), (const bf16*)(F.ws + WS_WIN), NTOK, N_IN_PAD, 1024}; StaticOrder S; S.init(NTOK, N_IN_PAD, F.G, (int)blockIdx.x);
        EpiZ E{(bf16*)(F.ws + WS_ZR), (bf16*)(F.ws + WS_SG), (bf16*)(F.ws + WS_ZM)}; gemm_phase_any(F.lds, g, S, E, F.wave);); SEAM(2);
    PH(3, p_prep_a(F, AP);); SEAM(3);
    PH(4,
        { Gemm g{(const bf16*)(F.ws + WS_TWA), (const bf16*)(F.ws + WS_WBLK), NTOK, 1024, 128}; StaticOrder S; S.init(NTOK, 1024, F.G, (int)blockIdx.x);
          EpiLora E{(bf16*)(F.ws + WS_LW), (bf16*)(F.ws + WS_A), AP->in[I_W0], AP->in[I_A0]}; gemm_phase_any(F.lds, g, S, E, F.wave); }
        { Gemm g{(const bf16*)(F.ws + WS_SGL), (const bf16*)(F.ws + WS_WG), NTOK, 512, 128}; StaticOrder S; S.init(NTOK, 512, F.G, (int)blockIdx.x);
          EpiPlain E{(bf16*)(F.dob + DO_G), nullptr, 1 << 30, 512, 0}; gemm_phase_any(F.lds, g, S, E, F.wave); }
        { Gemm g{(const bf16*)(F.ws + WS_QA), (const bf16*)(F.ws + WS_WUQ), NTOK, 768, 256}; StaticOrder S; S.init(NTOK, 768, F.G, (int)blockIdx.x);
          EpiPlain E{(bf16*)(F.dob + DO_Q), nullptr, 1 << 30, 768, 0}; gemm_phase_any(F.lds, g, S, E, F.wave); }
        { Gemm g{(const bf16*)(F.ws + WS_KVA), (const bf16*)(F.ws + WS_WUKV), NTOK, 1024, 128}; StaticOrder S; S.init(NTOK, 1024, F.G, (int)blockIdx.x);
          EpiPlain E{(bf16*)(F.dob + DO_KN), (bf16*)(F.ws + WS_VC), 512, 512, 512}; gemm_phase_any(F.lds, g, S, E, F.wave); }
    ); SEAM(4);
    PH(5, p_prep_c(F, AP);); SEAM(5);
#if ENG_ATTN == 1
    PH(6, p_attn_mfma(F);); SEAM(6);
#else
    PH(6, p_attn_naive(F);); SEAM(6);
#endif
    PH(7, p_cs_a_part<0>(F, AP); p_cs_a_part<1>(F, AP);); SEAM(7);
    PH(8, p_cs_b(F);); SEAM(8);
    PH(9, p_cs_c(F, AP);); SEAM(9);
    PH(10,
        { Gemm g{(const bf16*)(F.ws + WS_Y), (const bf16*)(F.ws + WS_WB), NTOK, 1024, 512}; StaticOrder S; S.init(NTOK, 1024, F.G, (int)blockIdx.x);
          EpiBranch<false> E{(bf16*)(F.ws + WS_MG), (const bf16*)(F.ws + WS_SG), 0}; gemm_phase_any(F.lds, g, S, E, F.wave); }
        { Gemm g{(const bf16*)(F.ws + WS_YM), (const bf16*)(F.ws + WS_WB) + (size_t)1024 * 512, NTOK, 1024, 512}; StaticOrder S; S.init(NTOK, 1024, F.G, (int)blockIdx.x);
          EpiBranch<true> E{(bf16*)(F.ws + WS_MG), (const bf16*)(F.ws + WS_SG), 1024}; gemm_phase_any(F.lds, g, S, E, F.wave); }
    ); SEAM(10);
    PH(11, Gemm g{(const bf16*)(F.ws + WS_MG), (const bf16*)(F.ws + WS_WO), NTOK, 1024, 1024}; StaticOrder S; S.init(NTOK, 1024, F.G, (int)blockIdx.x);
        EpiOut E{(float*)F.dob, AP->in[I_X], mod}; gemm_phase_any(F.lds, g, S, E, F.wave);); SEAM(11);
    if constexpr (PROBE_REPEAT == 12) { p_ffn_route(F, AP, (unsigned*)(F.ws + WS_CTL) + CW_CNT + 64, (int*)(F.ws + WS_CS)); GRID_BAR(); }
    if constexpr (IN(12)) { asm volatile("" : "+s"(AP)); p_ffn_route(F, AP, (unsigned*)(F.ws + WS_CTL) + CW_CNT, (int*)(F.ws + WS_ROUTE)); } SEAM(12);
    PH(13, p_gather(F);); SEAM(13);
    PH(14, LAS int* offs = (LAS int*)(F.lds + LDS_MISC + 1024); LAS int* texp = (LAS int*)(F.lds + LDS_MISC + 1024 + 256); const int nt = moe_tables(F, offs, texp);
        Gemm g{(const bf16*)(F.ws + WS_XG), (const bf16*)(F.ws + WS_WGU), MPAD, 512, 1024}; TableOrder S{texp, nt, 2, F.G, (int)blockIdx.x};
        EpiGateUp E{(bf16*)(F.ws + WS_HID)}; gemm_phase_any(F.lds, g, S, E, F.wave);); SEAM(14);
    PH(15, LAS int* offs = (LAS int*)(F.lds + LDS_MISC + 1024); LAS int* texp = (LAS int*)(F.lds + LDS_MISC + 1024 + 256); const int nt = moe_tables(F, offs, texp);
        Gemm g{(const bf16*)(F.ws + WS_HID), (const bf16*)(F.ws + WS_WDN), MPAD, 1024, 256}; TableOrder S{texp, nt, 4, F.G, (int)blockIdx.x};
        EpiDown E{(bf16*)(F.ws + WS_YS)}; gemm_phase_any(F.lds, g, S, E, F.wave);); SEAM(15);
    if constexpr (PROBE_REPEAT == 16) { p_combine(F, (float*)(F.ws + WS_SG)); GRID_BAR(); }
    if constexpr (IN(16)) { p_combine(F, (float*)F.dob); }
}

#if N_LAUNCH_MODE == 1
static bool set_attrs() { return hipFuncSetAttribute((const void*)fwd<0, NPHASE>, hipFuncAttributeMaxDynamicSharedMemorySize, LDS_BYTES) == hipSuccess; }
#else
template <int P> static bool set_attr_all() { if constexpr (P < NPHASE) { return hipFuncSetAttribute((const void*)fwd<P, P + 1>, hipFuncAttributeMaxDynamicSharedMemorySize, LDS_BYTES) == hipSuccess && set_attr_all<P + 1>(); } else return true; }
static bool set_attrs() { return set_attr_all<0>(); }
template <int P> static void launch_all(int grid, hipStream_t stream, const Args& a) { if constexpr (P < NPHASE) { hipLaunchKernelGGL((fwd<P, P + 1>), dim3(grid), dim3(NTHR), LDS_BYTES, stream, a); launch_all<P + 1>(grid, stream, a); } }
#endif
extern "C" void kernel_launch(void* const* d_in, const int* in_sizes, int n_in, void* d_out, int out_size, void* d_ws, size_t ws_size, hipStream_t stream) {
    static int grid = 0;
    if (grid == 0) {
        if (n_in != 34 || out_size != NTOK * DM || ws_size < WS_END) { fprintf(stderr, "kernel_launch: unexpected shapes (n_in %d out %d ws %zu)\n", n_in, out_size, ws_size); grid = -1; return; }
        int dev = 0, cus = 0;
        if (hipGetDevice(&dev) != hipSuccess || hipDeviceGetAttribute(&cus, hipDeviceAttributeMultiprocessorCount, dev) != hipSuccess) { grid = -1; return; }
        if (!set_attrs()) { fprintf(stderr, "kernel_launch: hipFuncSetAttribute failed\n"); grid = -1; return; }
        grid = cus;
    }
    if (grid < 0) return;
    (void)hipMemsetAsync((char*)d_ws + WS_CTL, 0, CTL_ZERO_BYTES, stream);
    Args a{};
    for (int i = 0; i < 34; ++i) a.in[i] = (const float*)d_in[i];
    a.out = (float*)d_out; a.ws = (unsigned char*)d_ws;
    a.ph_lo = 0; a.ph_hi = NPHASE;
#if N_LAUNCH_MODE == 1
    hipLaunchKernelGGL((fwd<0, NPHASE>), dim3(grid), dim3(NTHR), LDS_BYTES, stream, a);
#else
    launch_all<0>(grid, stream, a);
#endif
}
```

```cpp
#include <hip/hip_runtime.h>
#include <cstdio>
#include <cstdint>

#ifndef N_LAUNCH_MODE
#define N_LAUNCH_MODE 1
#endif
#ifndef ENG_GEMM
#define ENG_GEMM 1
#endif
#ifndef ENG_ATTN
#define ENG_ATTN 1
#endif

#define GAS __attribute__((address_space(1)))
#define LAS __attribute__((address_space(3)))
typedef unsigned short bf16;
typedef float f32x4 __attribute__((ext_vector_type(4)));
typedef float f32x2 __attribute__((ext_vector_type(2)));
typedef unsigned u32x4 __attribute__((ext_vector_type(4)));
typedef unsigned u32x2 __attribute__((ext_vector_type(2)));
typedef short bf16x8 __attribute__((ext_vector_type(8)));

constexpr int BATCH = 8, SEQ = 8192, DM = 1024, NTOK = BATCH * SEQ;
constexpr int D_RWKV = 512, RWKV_COLS = 1792, MLA_COLS = 416, D_IN = 4256, N_IN_PAD = 4352;
constexpr int NH = 8, QKD = 96, NOPE = 64, ROPE = 32, VD = 64;
constexpr int NEXP = 32, DEXP = 256;
constexpr int MPAD = 139264;
constexpr float EPS = 1e-6f, LN_X_EPS = 64e-5f;
constexpr float QSCALE = 0.10206207261596577f * 1.4426950408889634f;

constexpr size_t MiB = 1u << 20;
constexpr size_t WS_CTL = 0, CTL_ZERO_BYTES = 1 * MiB;
constexpr size_t WS_MOD = 1 * MiB;
constexpr size_t WS_ROUTE = 2 * MiB;
constexpr size_t WS_CS = 4 * MiB;
constexpr size_t WS_ENT = 12 * MiB;
constexpr size_t WS_WIN = 16 * MiB;
constexpr size_t WS_WBLK = 25 * MiB;
constexpr size_t WS_WG = WS_WBLK + 256 * 1024;
constexpr size_t WS_WUQ = WS_WG + 128 * 1024;
constexpr size_t WS_WUKV = WS_WUQ + 384 * 1024;
constexpr size_t WS_WB = 26 * MiB;
constexpr size_t WS_WO = 28 * MiB;
constexpr size_t WS_WGU = 30 * MiB;
constexpr size_t WS_WDN = 62 * MiB;
constexpr size_t WS_SG = 80 * MiB;
constexpr size_t WS_H2 = 80 * MiB;
constexpr size_t WS_ZR = 336 * MiB;
constexpr size_t WS_VC = 752 * MiB;
constexpr size_t WS_KC = 816 * MiB;
constexpr size_t WS_Y = 912 * MiB;
constexpr size_t WS_XG = 336 * MiB;
constexpr size_t WS_ZM = 560 * MiB;
constexpr size_t WS_YM = 560 * MiB;
constexpr size_t WS_H = 624 * MiB;
constexpr size_t WS_LW = 624 * MiB;
constexpr size_t WS_A = 688 * MiB;
constexpr size_t WS_MG = 624 * MiB;
constexpr size_t WS_HID = 608 * MiB;
constexpr size_t WS_R = 752 * MiB;
constexpr size_t WS_V = 816 * MiB;
constexpr size_t WS_ZK = 880 * MiB;
constexpr size_t WS_TWA = 944 * MiB;
constexpr size_t WS_SGL = 960 * MiB;
constexpr size_t WS_QA = 976 * MiB;
constexpr size_t WS_KVA = 1008 * MiB;
constexpr size_t WS_KK = 944 * MiB;
constexpr size_t WS_YS = 752 * MiB;
constexpr size_t WS_END = 1024 * MiB;
constexpr size_t DO_G = 0;
constexpr size_t DO_Q = 64 * MiB;
constexpr size_t DO_KN = 160 * MiB;

constexpr int CW_CNT = 64;
constexpr int CW_BAR = 4096;

constexpr int NWAVES = 8, NTHR = 512;
constexpr int LDS_BYTES = 155648;
constexpr int LDS_MISC = 151552;

__device__ __forceinline__ int lane_id_fresh() { int l; asm volatile("v_mbcnt_lo_u32_b32 %0, -1, 0\n\tv_mbcnt_hi_u32_b32 %0, -1, %0" : "=v"(l)); return l; }
__device__ __forceinline__ float bf2f(unsigned short h) { return __builtin_bit_cast(float, (unsigned)h << 16); }
__device__ __forceinline__ unsigned f2bf(float f) { unsigned u = __builtin_bit_cast(unsigned, f); return (u + 0x7fffu + ((u >> 16) & 1u)) >> 16; }
typedef __bf16 bf16x2_t __attribute__((ext_vector_type(2)));
__device__ __forceinline__ unsigned pk2(float lo, float hi) { const f32x2 v = {lo, hi}; return __builtin_bit_cast(unsigned, __builtin_convertvector(v, bf16x2_t)); }
__device__ __forceinline__ float lo2f(unsigned w) { return __builtin_bit_cast(float, w << 16); }
__device__ __forceinline__ float hi2f(unsigned w) { return __builtin_bit_cast(float, w & 0xffff0000u); }
template <int CTRL> __device__ __forceinline__ float dpp_add(float x) { return x + __builtin_bit_cast(float, __builtin_amdgcn_update_dpp(0, __builtin_bit_cast(int, x), CTRL, 0xf, 0xf, false)); }
__device__ __forceinline__ float allsum16(float x) { x = dpp_add<0xB1>(x); x = dpp_add<0x4E>(x); x = dpp_add<0x141>(x); x = dpp_add<0x140>(x); return x; }
__device__ __forceinline__ float allsum32(float x) { x = allsum16(x); auto r = __builtin_amdgcn_permlane16_swap(__float_as_uint(x), __float_as_uint(x), false, false); return __uint_as_float(r[0]) + __uint_as_float(r[1]); }
__device__ __forceinline__ float sum8(float x) { x = dpp_add<0xB1>(x); x = dpp_add<0x4E>(x); x = dpp_add<0x141>(x); return x; }
__device__ __forceinline__ float wave_sum(float v) {
    v = allsum16(v);
    { auto r = __builtin_amdgcn_permlane16_swap(__float_as_uint(v), __float_as_uint(v), false, false); v = __uint_as_float(r[0]) + __uint_as_float(r[1]); }
    { auto r = __builtin_amdgcn_permlane32_swap(__float_as_uint(v), __float_as_uint(v), false, false); v = __uint_as_float(r[0]) + __uint_as_float(r[1]); }
    return v;
}
__device__ __forceinline__ float sigmoidf_(float x) { return __builtin_amdgcn_rcpf(1.f + __builtin_amdgcn_exp2f(-1.4426950408889634f * x)); }
__device__ __forceinline__ float siluf_(float x) { return x * __builtin_amdgcn_rcpf(1.f + __builtin_amdgcn_exp2f(-1.4426950408889634f * x)); }
__device__ __forceinline__ void unpack8(const u32x4 w, float (&v)[8]) {
    v[0] = lo2f(w.x); v[1] = hi2f(w.x); v[2] = lo2f(w.y); v[3] = hi2f(w.y); v[4] = lo2f(w.z); v[5] = hi2f(w.z); v[6] = lo2f(w.w); v[7] = hi2f(w.w);
}
__device__ __forceinline__ u32x4 pack8(const float (&v)[8]) { u32x4 w; w.x = pk2(v[0], v[1]); w.y = pk2(v[2], v[3]); w.z = pk2(v[4], v[5]); w.w = pk2(v[6], v[7]); return w; }

#define LDS_BAR() do { asm volatile("s_waitcnt lgkmcnt(0)" ::: "memory"); __builtin_amdgcn_s_barrier(); asm volatile("" ::: "memory"); } while (0)

#define XB_TMO      128
#define XB_XCNT(j)  (256  + 64 * (j))
#define XB_XSUB(j)  (1280 + 64 * (j))
#define XB_XGEN(j)  (2304 + 64 * (j))
#define XB_TOP      3328
#define XB_TOPGEN   3392
#define XCD_BAR_WORDS 3456
#define XB_SPIN_CAP (1u << 19)
__device__ __forceinline__ unsigned xb_ld(unsigned* p)              { return __hip_atomic_load(p, __ATOMIC_RELAXED, __HIP_MEMORY_SCOPE_AGENT); }
__device__ __forceinline__ unsigned xb_add(unsigned* p, unsigned v) { return __hip_atomic_fetch_add(p, v, __ATOMIC_RELAXED, __HIP_MEMORY_SCOPE_AGENT); }
__device__ __forceinline__ unsigned xb_xcc_id() { return (unsigned)__builtin_amdgcn_s_getreg((3 << 11) | 20) & 0xFu; }
#define XB_SPIN(cond, bar) do { unsigned _sp = 0; while (cond) { __builtin_amdgcn_s_sleep(1); \
    if ((++_sp & 255u) == 0u) { if (xb_ld(&(bar)[XB_TMO])) break; if (_sp > XB_SPIN_CAP) { atomicAdd(&(bar)[XB_TMO], 1u); break; } } } } while (0)
struct XcdBarrier { unsigned* bar; unsigned x; volatile LAS unsigned* st; };
__device__ __forceinline__ XcdBarrier xcd_barrier_post(unsigned* bar, volatile LAS unsigned* st) {
    XcdBarrier b; b.bar = bar; b.x = xb_xcc_id(); b.st = st;
    if (threadIdx.x == 0) (void)xb_add(&bar[XB_XCNT(b.x)], 1u);
    return b;
}
__device__ __forceinline__ void xcd_barrier_complete(unsigned* bar, unsigned x, unsigned& nloc, unsigned& nx) {
    const unsigned G = gridDim.x * gridDim.y * gridDim.z;
    unsigned sum, cnt, mine, sp = 0u;
    for (;;) {
        sum = 0u; cnt = 0u; mine = 0u;
#pragma unroll
        for (unsigned j = 0; j < 16; ++j) { const unsigned c = xb_ld(&bar[XB_XCNT(j)]); sum += c; cnt += (c > 0u) ? 1u : 0u; mine = (j == x) ? c : mine; }
        if (sum == G) break;
        __builtin_amdgcn_s_sleep(1);
        if ((++sp & 255u) == 0u) { if (xb_ld(&bar[XB_TMO])) break; if (sp > XB_SPIN_CAP) { atomicAdd(&bar[XB_TMO], 1u); break; } }
    }
    nloc = mine > 0u ? mine : 1u; nx = cnt > 0u ? cnt : 1u;
}
__device__ __forceinline__ void xcd_barrier(const XcdBarrier& b) {
    asm volatile("s_waitcnt vmcnt(0)" ::: "memory");
    __syncthreads();
    if (threadIdx.x == 0) {
        unsigned* bar = b.bar;
        __builtin_amdgcn_s_waitcnt(0);
        unsigned nloc = b.st[0], nx = b.st[1];
        if (nloc == 0u) { xcd_barrier_complete(bar, b.x, nloc, nx); b.st[0] = nloc; b.st[1] = nx; }
        const unsigned old = xb_add(&bar[XB_XSUB(b.x)], 1u);
        const unsigned gen = old / nloc;
        if (old + 1u == (gen + 1u) * nloc) {
            __builtin_amdgcn_fence(__ATOMIC_RELEASE, "agent");
            asm volatile("s_waitcnt vmcnt(0)" ::: "memory");
            const unsigned og = xb_add(&bar[XB_TOP], 1u);
            const unsigned tg = og / nx;
            if (og + 1u == (tg + 1u) * nx) xb_add(&bar[XB_TOPGEN], 1u);
            else XB_SPIN(xb_ld(&bar[XB_TOPGEN]) == tg, bar);
            __builtin_amdgcn_fence(__ATOMIC_ACQUIRE, "agent");
            xb_add(&bar[XB_XGEN(b.x)], 1u);
            asm volatile("s_waitcnt vmcnt(0)" ::: "memory");
        } else {
            XB_SPIN(xb_ld(&bar[XB_XGEN(b.x)]) == gen, bar);
            __builtin_amdgcn_fence(__ATOMIC_ACQUIRE, "agent");
            asm volatile("s_waitcnt vmcnt(0)" ::: "memory");
        }
    }
    __syncthreads();
}

struct Args {
    const float* in[34]; float* out; unsigned char* ws; int ph_lo, ph_hi;
};
typedef const __attribute__((address_space(4))) Args* ArgsP;
struct Frame {
    LAS unsigned char* lds;
    int wave, vcu, G, gw, NGW;
    unsigned char* ws; unsigned char* dob;
};
enum { I_X = 0, I_C, I_POS, I_WADA, I_BADA, I_GMIX, I_WIN, I_MU, I_W0, I_WDEC, I_A0, I_WAUP, I_WGUP, I_KK, I_KA, I_RK, I_LNW, I_LNB, I_GQA, I_WUQ, I_GKVA, I_WUKV,
       I_QN, I_KN, I_WBR, I_WOUT, I_GFFN, I_WRG, I_BRG, I_WRE, I_BRE, I_WEG, I_WEU, I_WED };

struct Unit { int pm, pn; };
struct Gemm { const bf16* A; const bf16* Bt; int M, N, K; };
constexpr int NXCD = 8, WGM = 8;
struct StaticOrder {
    int nM, nN, nwg, G, c;
    __device__ void init(int M, int N, int G_, int c_) { nM = M / 256; nN = N / 256; nwg = nM * nN; G = G_; c = c_; }
    __device__ bool next(int i, Unit& u) const {
        const long L = (long)i * G + c; if (L >= nwg) return false;
        int wgid = (int)L; { const int q = nwg / NXCD, r = nwg % NXCD, xcd = wgid % NXCD, off = wgid / NXCD; wgid = (xcd < r ? xcd * (q + 1) : r * (q + 1) + (xcd - r) * q) + off; }
        const int nig = WGM * nN, gid = wgid / nig, fm = gid * WGM, gsz = (nM - fm) < WGM ? (nM - fm) : WGM;
        u.pm = fm + ((wgid % nig) % gsz); u.pn = (wgid % nig) / gsz; return true;
    }
    __device__ __forceinline__ void a_ready(const Unit&) const {}
    __device__ __forceinline__ void done(const Unit&) const {}
};
struct TableOrder {
    const LAS int* texp; int ntiles, nN, G, c;
    __device__ bool next(int i, Unit& u) const {
        const long L = (long)i * G + c; if (L >= (long)ntiles * nN) return false;
        const int t = (int)(L / nN), j = (int)(L % nN); u.pm = t; u.pn = texp[t] * nN + j; return true;
    }
    __device__ __forceinline__ void a_ready(const Unit&) const {}
    __device__ __forceinline__ void done(const Unit&) const {}
};

template <class Epi, class Sched>
__device__ __forceinline__ void gemm_phase_naive(LAS unsigned char* lds, const Gemm g, const Sched& S, const Epi& E) {
    const int tid = (int)__builtin_amdgcn_readfirstlane((int)threadIdx.x >> 6) * 64 + lane_id_fresh(), ty = tid >> 5, tx = tid & 31;
    LAS bf16* As = (LAS bf16*)lds; LAS bf16* Bs = (LAS bf16*)(lds + 128 * 40 * 2);
    Unit u;
    for (int i = 0; S.next(i, u); ++i) {
        for (int half = 0; half < 2; ++half) {
            float acc[8][8];
#pragma unroll
            for (int r = 0; r < 8; ++r)
#pragma unroll
                for (int c = 0; c < 8; ++c) acc[r][c] = 0.f;
            const bf16* Ab = g.A + ((size_t)u.pm * 256 + half * 128) * g.K; const bf16* Bb = g.Bt + (size_t)u.pn * 256 * g.K;
            for (int k0 = 0; k0 < g.K; k0 += 32) {
                __syncthreads();
                { const int r = tid >> 2, c8 = (tid & 3) * 8; *(LAS u32x4*)(As + r * 40 + c8) = *(const u32x4*)(Ab + (size_t)r * g.K + k0 + c8); }
#pragma unroll
                for (int j = 0; j < 2; ++j) { const int ch = tid + j * 512, r = ch >> 2, c8 = (ch & 3) * 8; *(LAS u32x4*)(Bs + r * 40 + c8) = *(const u32x4*)(Bb + (size_t)r * g.K + k0 + c8); }
                __syncthreads();
#pragma unroll 2
                for (int k = 0; k < 32; k += 2) {
                    float b0[8], b1[8];
#pragma unroll
                    for (int c = 0; c < 8; ++c) { const unsigned w = *(const LAS unsigned*)(Bs + (tx * 8 + c) * 40 + k); b0[c] = lo2f(w); b1[c] = hi2f(w); }
#pragma unroll
                    for (int r = 0; r < 8; ++r) { const unsigned w = *(const LAS unsigned*)(As + (ty * 8 + r) * 40 + k); const float a0 = lo2f(w), a1 = hi2f(w);
#pragma unroll
                        for (int c = 0; c < 8; ++c) acc[r][c] = fmaf(a1, b1[c], fmaf(a0, b0[c], acc[r][c])); }
                }
            }
#pragma unroll
            for (int r = 0; r < 8; ++r) E.store8(u, half * 128 + ty * 8 + r, tx * 8, acc[r]);
        }
    }
    __syncthreads();
}

struct EpiZ { bf16 *ZR, *SG, *ZM;
    __device__ __forceinline__ void store8(const Unit& u, int r, int c, const float (&v)[8]) const {
        const size_t row = (size_t)u.pm * 256 + r;
        if (u.pn < 7) { *(u32x4*)(ZR + row * 1792 + u.pn * 256 + c) = pack8(v); }
        else if (u.pn < 15) { float s[8];
#pragma unroll
            for (int i = 0; i < 8; ++i) s[i] = sigmoidf_(v[i]);
            *(u32x4*)(SG + row * 2048 + (u.pn - 7) * 256 + c) = pack8(s); }
        else { *(u32x4*)(ZM + row * 512 + (u.pn - 15) * 256 + c) = pack8(v); }
    } };
struct EpiLora { bf16 *LW, *A; const float *w0, *a0;
    __device__ __forceinline__ void store8(const Unit& u, int r, int c, const float (&v)[8]) const {
        const size_t row = (size_t)u.pm * 256 + r; const int col = u.pn * 256 + c; float o[8];
        const bool isw = col < 512; const float* bp = isw ? (w0 + col) : (a0 + col - 512);
        const f32x4 b0 = *(const f32x4*)bp, b1 = *(const f32x4*)(bp + 4); const float bb[8] = {b0.x, b0.y, b0.z, b0.w, b1.x, b1.y, b1.z, b1.w};
#pragma unroll
        for (int i = 0; i < 8; ++i) { const float e = __builtin_amdgcn_exp2f(fminf(-1.4426950408889634f * (bb[i] + v[i]), 120.f)); const float s = __builtin_amdgcn_rcpf(1.0f + e); o[i] = isw ? -0.60653065971263342f * s : s; }
        bf16* dst = isw ? (LW + row * 512 + col) : (A + row * 512 + col - 512);
        *(u32x4*)dst = pack8(o);
    } };
struct EpiPlain { bf16* O0; bf16* O1; int split, ld0, ld1;
    __device__ __forceinline__ void store8(const Unit& u, int r, int c, const float (&v)[8]) const {
        const size_t row = (size_t)u.pm * 256 + r; int col = u.pn * 256 + c;
        if (col < split) *(u32x4*)(O0 + row * ld0 + col) = pack8(v); else *(u32x4*)(O1 + row * ld1 + col - split) = pack8(v);
    } };
template <bool ACCUM> struct EpiBranch { bf16* MG; const bf16* SG; int goff;
    __device__ __forceinline__ void store8(const Unit& u, int r, int c, const float (&v)[8]) const {
        const size_t row = (size_t)u.pm * 256 + r; const int col = u.pn * 256 + c; float gt[8], o[8];
        unpack8(*(const u32x4*)(SG + row * 2048 + goff + col), gt);
        if (ACCUM) { float p[8]; unpack8(*(const u32x4*)(MG + row * 1024 + col), p);
#pragma unroll
            for (int i = 0; i < 8; ++i) o[i] = p[i] + gt[i] * v[i]; }
        else {
#pragma unroll
            for (int i = 0; i < 8; ++i) o[i] = gt[i] * v[i]; }
        *(u32x4*)(MG + row * 1024 + col) = pack8(o);
    } };
struct EpiOut { float* X1; const float* x; const float* mod;
    __device__ __forceinline__ void store8(const Unit& u, int r, int c, const float (&v)[8]) const {
        const size_t row = (size_t)u.pm * 256 + r; const int col = u.pn * 256 + c; const int b = (int)(row / SEQ);
        const float* gt = mod + b * 6144 + 2048 + col; const float* xr = x + row * 1024 + col; float* o = X1 + row * 1024 + col;
        const f32x4 g0 = *(const f32x4*)gt, g1 = *(const f32x4*)(gt + 4), x0 = *(const f32x4*)xr, x1 = *(const f32x4*)(xr + 4);
        *(f32x4*)o = (f32x4){x0.x + g0.x * v[0], x0.y + g0.y * v[1], x0.z + g0.z * v[2], x0.w + g0.w * v[3]};
        *(f32x4*)(o + 4) = (f32x4){x1.x + g1.x * v[4], x1.y + g1.y * v[5], x1.z + g1.z * v[6], x1.w + g1.w * v[7]};
    } };
struct EpiGateUp { bf16* HID;
    __device__ __forceinline__ void store8(const Unit& u, int r, int c, const float (&v)[8]) const {
        const size_t row = (size_t)u.pm * 256 + r; const int col = ((u.pn & 1) * 256 + c) >> 1;
        u32x2 w; w.x = pk2(siluf_(v[0]) * v[4], siluf_(v[1]) * v[5]); w.y = pk2(siluf_(v[2]) * v[6], siluf_(v[3]) * v[7]);
        *(u32x2*)(HID + row * 256 + col) = w;
    } };
struct EpiDownAtomic { float* out; const int* ent; const float* mod;
    __device__ __forceinline__ void store8(const Unit& u, int r, int c, const float (&v)[8]) const {
        const int e0 = ent[2 * (u.pm * 256 + r)]; if (e0 < 0) return; const float w = __builtin_bit_cast(float, ent[2 * (u.pm * 256 + r) + 1]);
        const int col = (u.pn & 3) * 256 + c, b = e0 / SEQ; const float* gt = mod + b * 6144 + 5120 + col; float* o = out + (size_t)e0 * 1024 + col;
        const f32x4 g0 = *(const f32x4*)gt, g1 = *(const f32x4*)(gt + 4);
        unsafeAtomicAdd(o + 0, g0.x * w * v[0]); unsafeAtomicAdd(o + 1, g0.y * w * v[1]); unsafeAtomicAdd(o + 2, g0.z * w * v[2]); unsafeAtomicAdd(o + 3, g0.w * w * v[3]);
        unsafeAtomicAdd(o + 4, g1.x * w * v[4]); unsafeAtomicAdd(o + 5, g1.y * w * v[5]); unsafeAtomicAdd(o + 6, g1.z * w * v[6]); unsafeAtomicAdd(o + 7, g1.w * w * v[7]);
    } };
struct EpiDown { bf16* YS;
    __device__ __forceinline__ void store8(const Unit& u, int r, int c, const float (&v)[8]) const {
        const size_t row = (size_t)u.pm * 256 + r; *(u32x4*)(YS + row * 1024 + (u.pn & 3) * 256 + c) = pack8(v);
    } };


namespace pg8 {
#define PG8_LAS __attribute__((address_space(3)))
typedef ::bf16x8 bf16x8; typedef ::f32x4 f32x4;
using ::Unit; using ::Gemm;
constexpr int BM = 256, BK = 64, HALF = 128, HTB = HALF * BK * 2  , STAGE_BYTES = 8 * HTB;

__device__ __forceinline__ int lds_byte(int r, int c) { const int st = (r >> 4) * 2 + (c >> 5), rr = r & 15, cc = c & 31, ob = rr * 64 + cc * 2; return st * 1024 + (ob ^ (((ob >> 9) & 1) << 5)); }
__device__ __forceinline__ void stage_rc(int b, int& R, int& C) { const int st = b / 1024, sb = b % 1024, swz = sb ^ (((sb >> 9) & 1) << 5); R = (st >> 1) * 16 + swz / 64; C = (st & 1) * 32 + (swz % 64) / 2; }
__device__ __forceinline__ int perm32(int rho) { const int n = rho >> 4, i = rho & 15; return 8 * (i >> 2) + 4 * n + (i & 3); }
template <class Epi, class Sched, bool ALIGN_EPI = false, bool SP2 = false>
__device__ __forceinline__ void gemm_phase(PG8_LAS unsigned char* lds, const Gemm g, const Sched& S, const Epi& E, const int wave_in) {
    const int lane = lane_id_fresh(), wid = wave_in, tid = wid * 64 + lane,
              wr = wid >> 2, wc = wid & 3, fr = lane & 15, fq = lane >> 4;
    const int K = g.K, nt = K / BK;
    unsigned voffA[2], voffB[2];
#pragma unroll
    for (int i = 0; i < 2; ++i) { int R, C; stage_rc(tid * 16 + i * 8192, R, C); const int Rb = Epi::PERM ? ((R & ~31) + perm32(R & 31)) : R;
        voffA[i] = (unsigned)(R * K + C) * 2u; voffB[i] = (unsigned)(Rb * K + C) * 2u; }
    const size_t kstep = (size_t)(BK * 2);
    const size_t hstep = (size_t)HALF * K * 2;
    const size_t tstep = 2 * hstep;
    const unsigned ldsw = (unsigned)wid * 1024u;
    const int aoff = lds_byte(wr * 64 + fr, fq * 8), boff = lds_byte(wc * 32 + fr, fq * 8);
#define PG8_SA(b, h) (((b) * 2 + (h)) * HTB)
#define PG8_SB(b, h) ((4 + (b) * 2 + (h)) * HTB)
#define PG8_STAGE(bufoff, gbase, voff) do { _Pragma("unroll") for (int _i = 0; _i < 2; ++_i) \
        __builtin_amdgcn_global_load_lds((const unsigned*)((const char*)(gbase) + (voff)[_i]), (PG8_LAS unsigned*)(lds + (bufoff) + ldsw + _i * 8192), 16, 0, 0); } while (0)
#define PG8_LDA(dst, b, h) do { _Pragma("unroll") for (int m = 0; m < 4; ++m) _Pragma("unroll") for (int k = 0; k < 2; ++k) dst[m][k] = *(const PG8_LAS bf16x8*)(lds + PG8_SA(b, h) + aoff + m * 2048 + k * 1024); } while (0)
#define PG8_LDB(dst, b, h) do { _Pragma("unroll") for (int n = 0; n < 2; ++n) _Pragma("unroll") for (int k = 0; k < 2; ++k) dst[n][k] = *(const PG8_LAS bf16x8*)(lds + PG8_SB(b, h) + boff + n * 2048 + k * 1024); } while (0)
#define PG8_MMA(ai, bj, At, Bt) do { __builtin_amdgcn_s_setprio(1); _Pragma("unroll") for (int m = 0; m < 4; ++m) _Pragma("unroll") for (int n = 0; n < 2; ++n) _Pragma("unroll") for (int k = 0; k < 2; ++k) \
        acc[ai][bj][m][n] = __builtin_amdgcn_mfma_f32_16x16x32_bf16(Bt[n][k], At[m][k], acc[ai][bj][m][n], 0, 0, 0); __builtin_amdgcn_s_setprio(0); } while (0)
#define PG8_WAIT_V(n) asm volatile("s_waitcnt vmcnt(" #n ")" ::: "memory")
#define PG8_WAIT_L(n) asm volatile("s_waitcnt lgkmcnt(" #n ")" ::: "memory")
#define PG8_BAR __builtin_amdgcn_s_barrier()
#define PG8_SCHED __builtin_amdgcn_sched_barrier(0)
    Unit cur, nxt; int ui = 0;
    if (!S.next(0, cur)) return;
    f32x4 acc[2][2][4][2];
#pragma unroll
    for (int a = 0; a < 2; ++a)
#pragma unroll
        for (int b = 0; b < 2; ++b)
#pragma unroll
            for (int m = 0; m < 4; ++m)
#pragma unroll
                for (int n = 0; n < 2; ++n) acc[a][b][m][n] = (f32x4){0.f, 0.f, 0.f, 0.f};
    bf16x8 At[4][2], B0[2][2], B1[2][2];
    const char* cA = (const char*)g.A + (size_t)cur.pm * tstep; const char* cB = (const char*)g.Bt + (size_t)cur.pn * tstep;
    S.a_ready(cur);
    if constexpr (SP2) {
        PG8_STAGE(PG8_SB(0, 0), cB, voffB); PG8_STAGE(PG8_SB(0, 1), cB + hstep, voffB); PG8_STAGE(PG8_SA(0, 0), cA, voffA); PG8_STAGE(PG8_SA(0, 1), cA + hstep, voffA);
        if (wr == 1) PG8_BAR;
        PG8_WAIT_V(2); PG8_BAR;
        PG8_STAGE(PG8_SB(1, 0), cB + kstep, voffB); PG8_STAGE(PG8_SA(1, 0), cA + kstep, voffA); PG8_STAGE(PG8_SB(1, 1), cB + hstep + kstep, voffB);
        PG8_WAIT_V(6); PG8_BAR;
    } else {
        PG8_STAGE(PG8_SB(0, 0), cB, voffB); PG8_STAGE(PG8_SA(0, 0), cA, voffA); PG8_STAGE(PG8_SB(0, 1), cB + hstep, voffB); PG8_STAGE(PG8_SA(0, 1), cA + hstep, voffA);
        if (wr == 1) PG8_BAR;
        PG8_WAIT_V(4); PG8_BAR;
        PG8_STAGE(PG8_SB(1, 0), cB + kstep, voffB); PG8_STAGE(PG8_SA(1, 0), cA + kstep, voffA); PG8_STAGE(PG8_SB(1, 1), cB + hstep + kstep, voffB);
        PG8_WAIT_V(6); PG8_BAR;
    }
    for (;;) {
        const bool has_next = S.next(ui + 1, nxt);
        const char* nA = has_next ? (const char*)g.A + (size_t)nxt.pm * tstep : cA; const char* nB = has_next ? (const char*)g.Bt + (size_t)nxt.pn * tstep : cB;
        for (int t = 0; t < nt; t += 2) {
            const bool last = (t == nt - 2);
            const char* a1 = cA + (size_t)(t + 1) * kstep;
            const char* a2 = last ? nA : cA + (size_t)(t + 2) * kstep; const char* b2 = last ? nB : cB + (size_t)(t + 2) * kstep;
            const char* a3 = a2 + kstep; const char* b3 = b2 + kstep;
            if (last && has_next) S.a_ready(nxt);
            if constexpr (SP2) {
            PG8_LDB(B0, 0, 0); PG8_LDB(B1, 0, 1); PG8_SCHED; PG8_LDA(At, 0, 0); PG8_STAGE(PG8_SA(1, 1), a1 + hstep, voffA);
            PG8_WAIT_V(8); PG8_WAIT_L(0); PG8_BAR; PG8_MMA(0, 0, At, B0); PG8_MMA(0, 1, At, B1); PG8_BAR; PG8_SCHED;
            PG8_LDA(At, 0, 1); PG8_STAGE(PG8_SB(0, 0), b2, voffB); PG8_STAGE(PG8_SB(0, 1), b2 + hstep, voffB); PG8_STAGE(PG8_SA(0, 0), a2, voffA);
            PG8_WAIT_V(8); PG8_WAIT_L(0); PG8_BAR; PG8_MMA(1, 0, At, B0); PG8_MMA(1, 1, At, B1); PG8_BAR; PG8_SCHED;
            PG8_LDB(B0, 1, 0); PG8_LDB(B1, 1, 1); PG8_SCHED; PG8_LDA(At, 1, 0); PG8_STAGE(PG8_SA(0, 1), a2 + hstep, voffA);
            PG8_WAIT_V(8); PG8_WAIT_L(0); PG8_BAR; PG8_MMA(0, 0, At, B0); PG8_MMA(0, 1, At, B1); PG8_BAR; PG8_SCHED;
            PG8_LDA(At, 1, 1); PG8_STAGE(PG8_SB(1, 0), b3, voffB); PG8_STAGE(PG8_SB(1, 1), b3 + hstep, voffB); PG8_STAGE(PG8_SA(1, 0), a3, voffA);
            PG8_WAIT_V(8); PG8_WAIT_L(0); PG8_BAR; PG8_MMA(1, 0, At, B0); PG8_MMA(1, 1, At, B1); PG8_BAR; PG8_SCHED;
            } else {
            PG8_LDB(B0, 0, 0); PG8_SCHED; PG8_LDA(At, 0, 0); PG8_STAGE(PG8_SA(1, 1), a1 + hstep, voffA);
            PG8_WAIT_L(8); PG8_BAR; PG8_WAIT_L(0); PG8_MMA(0, 0, At, B0); PG8_BAR; PG8_SCHED;
            PG8_LDB(B1, 0, 1); PG8_STAGE(PG8_SB(0, 0), b2, voffB);
            PG8_BAR; PG8_WAIT_L(0); PG8_MMA(0, 1, At, B1); PG8_BAR;
            PG8_LDA(At, 0, 1); PG8_STAGE(PG8_SA(0, 0), a2, voffA);
            PG8_BAR; PG8_WAIT_L(0); PG8_MMA(1, 0, At, B0); PG8_BAR; PG8_SCHED;
            PG8_STAGE(PG8_SB(0, 1), b2 + hstep, voffB);
            PG8_WAIT_V(6); PG8_BAR; PG8_MMA(1, 1, At, B1); PG8_BAR;
            PG8_LDB(B0, 1, 0); PG8_SCHED; PG8_LDA(At, 1, 0); PG8_STAGE(PG8_SA(0, 1), a2 + hstep, voffA);
            PG8_WAIT_L(8); PG8_BAR; PG8_WAIT_L(0); PG8_MMA(0, 0, At, B0); PG8_BAR; PG8_SCHED;
            PG8_LDB(B1, 1, 1); PG8_STAGE(PG8_SB(1, 0), b3, voffB);
            PG8_BAR; PG8_WAIT_L(0); PG8_MMA(0, 1, At, B1); PG8_BAR;
            PG8_LDA(At, 1, 1); PG8_STAGE(PG8_SA(1, 0), a3, voffA);
            PG8_BAR; PG8_WAIT_L(0); PG8_MMA(1, 0, At, B0); PG8_BAR; PG8_SCHED;
            PG8_STAGE(PG8_SB(1, 1), b3 + hstep, voffB);
            PG8_WAIT_V(6); PG8_BAR; PG8_MMA(1, 1, At, B1); PG8_BAR;
            }
        }
        if constexpr (ALIGN_EPI) { if (wr == 0) PG8_BAR; }
        if constexpr (!Epi::AFTER_DRAIN) { E(acc, cur, wr, wc, fr, fq); S.done(cur); }
        if (!has_next) break;
#pragma unroll
        for (int a = 0; a < 2; ++a)
#pragma unroll
            for (int b = 0; b < 2; ++b)
#pragma unroll
                for (int m = 0; m < 4; ++m)
#pragma unroll
                    for (int n = 0; n < 2; ++n) acc[a][b][m][n] = (f32x4){0.f, 0.f, 0.f, 0.f};
        cur = nxt; cA = nA; cB = nB; ++ui;
        if constexpr (ALIGN_EPI) { if (wr == 1) PG8_BAR; }
    }
    PG8_WAIT_V(0);
    if constexpr (!ALIGN_EPI) { if (wr == 0) PG8_BAR; }
    PG8_BAR;
    if constexpr (Epi::AFTER_DRAIN) { E.fused(acc, cur, wr, wc, fr, fq, lds, wid, lane); S.done(cur); }
#undef PG8_SA
#undef PG8_SB
#undef PG8_STAGE
#undef PG8_LDA
#undef PG8_LDB
#undef PG8_MMA
#undef PG8_WAIT_V
#undef PG8_WAIT_L
#undef PG8_BAR
#undef PG8_SCHED
}

template <class F> struct EpiAdapt {
    static constexpr bool PERM = true, AFTER_DRAIN = false; F f;
    __device__ __forceinline__ void operator()(const f32x4 (&acc)[2][2][4][2], const Unit& u, int wr, int wc, int fr, int fq) const {
        asm volatile("" : "+v"(fr), "+v"(fq));
#pragma unroll
        for (int ai = 0; ai < 2; ++ai)
#pragma unroll
            for (int m = 0; m < 4; ++m) { const int row = ai * HALF + wr * 64 + m * 16 + fr;
#pragma unroll
                for (int bj = 0; bj < 2; ++bj) { const f32x4 v0 = acc[ai][bj][m][0], v1 = acc[ai][bj][m][1];
                    const float v[8] = {v0[0], v0[1], v0[2], v0[3], v1[0], v1[1], v1[2], v1[3]};
                    f.store8(u, row, bj * HALF + wc * 32 + 8 * fq, v); } }
    }
};
}

template <class Epi, class Sched>
__device__ __forceinline__ void gemm_phase_any(LAS unsigned char* lds, const Gemm g, const Sched& S, const Epi& E, const int wave_in) {
#if ENG_GEMM == 1
    pg8::EpiAdapt<Epi> EA{E};
    pg8::gemm_phase<pg8::EpiAdapt<Epi>, Sched, true, true>(lds, g, S, EA, wave_in);
#else
    gemm_phase_naive<Epi, Sched>(lds, g, S, E);
#endif
}

template <class RowMap>
__device__ __forceinline__ void transpose_item(const float* W, int ldw, bf16* WT, int ldt, int koff, int k0, int n0, const RowMap& rm, LAS float* scr, int lane) {
#pragma unroll 8
    for (int i = 0; i < 32; ++i) { const int kk = 2 * i + (lane >> 5); scr[kk * 33 + (lane & 31)] = W[(size_t)(k0 + kk) * ldw + n0 + (lane & 31)]; }
    asm volatile("s_waitcnt lgkmcnt(0)" ::: "memory");
    const int c = lane & 7;
#pragma unroll
    for (int j = 0; j < 4; ++j) { const int n = (lane >> 3) + 8 * j; const LAS float* s = scr + (8 * c) * 33 + n;
        u32x4 o; o.x = pk2(s[0 * 33], s[1 * 33]); o.y = pk2(s[2 * 33], s[3 * 33]); o.z = pk2(s[4 * 33], s[5 * 33]); o.w = pk2(s[6 * 33], s[7 * 33]);
        *(u32x4*)(WT + (size_t)rm(n0 + n) * ldt + koff + k0 + 8 * c) = o; }
    asm volatile("s_waitcnt lgkmcnt(0)" ::: "memory");
}
struct RmId { int off; __device__ int operator()(int n) const { return off + n; } };
struct RmWin { __device__ int operator()(int n) const { return n < 1792 ? n : (n < 2208 ? 3840 + (n - 1792) : 1792 + (n - 2208)); } };
struct RmUkv { __device__ int operator()(int n) const { const int h = n >> 7, j = n & 127; return j < 64 ? h * 64 + j : 512 + h * 64 + (j - 64); } };
struct RmGU { int off; __device__ int operator()(int j) const { return off + 8 * (j >> 2) + (j & 3); } };

__device__ __forceinline__ void p0_prologue(const Frame& F, ArgsP a) {
    const int lane_f = lane_id_fresh(), tid_f = F.wave * 64 + lane_f;
    LAS float* scr = (LAS float*)(F.lds + F.wave * 16384);
    const int lane = lane_f;
    bf16* Win = (bf16*)(F.ws + WS_WIN); bf16* Wblk = (bf16*)(F.ws + WS_WBLK); bf16* Wg = (bf16*)(F.ws + WS_WG); bf16* Wuq = (bf16*)(F.ws + WS_WUQ);
    bf16* Wukv = (bf16*)(F.ws + WS_WUKV); bf16* Wb = (bf16*)(F.ws + WS_WB); bf16* Wo = (bf16*)(F.ws + WS_WO); bf16* Wgu = (bf16*)(F.ws + WS_WGU); bf16* Wdn = (bf16*)(F.ws + WS_WDN);
    constexpr int I_IN = 16 * 133, I_DEC = 1 * 16, I_AUP = 16, I_GUP = 2 * 16, I_UQ = 4 * 24, I_UKV = 2 * 32, I_BR = 2 * 8 * 32, I_O = 16 * 32;
    constexpr int I_EG = 32 * 16 * 8, I_EU = I_EG, I_ED = 32 * 4 * 32;
    constexpr int NITEMS = I_IN + I_DEC + I_AUP + I_GUP + I_UQ + I_UKV + I_BR + I_O + I_EG + I_EU + I_ED;
    for (int it = F.gw; it < NITEMS; it += F.NGW) {
        int r = it;
        if (r < I_IN) { const int kb = r / 133, nb = r % 133; transpose_item(a->in[I_WIN], D_IN, Win, 1024, 0, 64 * kb, 32 * nb, RmWin{}, scr, lane); continue; } r -= I_IN;
        if (r < I_DEC) { transpose_item(a->in[I_WDEC], 512, Wblk, 128, 0, 0, 32 * r, RmId{0}, scr, lane); continue; } r -= I_DEC;
        if (r < I_AUP) { transpose_item(a->in[I_WAUP], 512, Wblk, 128, 64, 0, 32 * r, RmId{512}, scr, lane); continue; } r -= I_AUP;
        if (r < I_GUP) { const int kb = r / 16, nb = r % 16; transpose_item(a->in[I_WGUP], 512, Wg, 128, 0, 64 * kb, 32 * nb, RmId{0}, scr, lane); continue; } r -= I_GUP;
        if (r < I_UQ) { const int kb = r / 24, nb = r % 24; transpose_item(a->in[I_WUQ], 768, Wuq, 256, 0, 64 * kb, 32 * nb, RmId{0}, scr, lane); continue; } r -= I_UQ;
        if (r < I_UKV) { const int kb = r / 32, nb = r % 32; transpose_item(a->in[I_WUKV], 1024, Wukv, 128, 0, 64 * kb, 32 * nb, RmUkv{}, scr, lane); continue; } r -= I_UKV;
        if (r < I_BR) { const int br = r / 256, q = r % 256, kb = q / 32, nb = q % 32; transpose_item(a->in[I_WBR] + (size_t)br * 512 * 1024, 1024, Wb + (size_t)br * 1024 * 512, 512, 0, 64 * kb, 32 * nb, RmId{0}, scr, lane); continue; } r -= I_BR;
        if (r < I_O) { const int kb = r / 32, nb = r % 32; transpose_item(a->in[I_WOUT], 1024, Wo, 1024, 0, 64 * kb, 32 * nb, RmId{0}, scr, lane); continue; } r -= I_O;
        if (r < I_EG) { const int e = r / 128, q = r % 128, kb = q / 8, nb = q % 8; transpose_item(a->in[I_WEG] + (size_t)e * 1024 * 256, 256, Wgu + (size_t)e * 512 * 1024, 1024, 0, 64 * kb, 32 * nb, RmGU{0}, scr, lane); continue; } r -= I_EG;
        if (r < I_EU) { const int e = r / 128, q = r % 128, kb = q / 8, nb = q % 8; transpose_item(a->in[I_WEU] + (size_t)e * 1024 * 256, 256, Wgu + (size_t)e * 512 * 1024, 1024, 0, 64 * kb, 32 * nb, RmGU{4}, scr, lane); continue; } r -= I_EU;
        { const int e = r / 128, q = r % 128, kb = q / 32, nb = q % 32; transpose_item(a->in[I_WED] + (size_t)e * 256 * 1024, 1024, Wdn + (size_t)e * 1024 * 256, 256, 0, 64 * kb, 32 * nb, RmId{0}, scr, lane); }
    }
    for (int i = F.gw * 64 + lane; i < 96 * 128; i += F.NGW * 64) *(u32x4*)(Win + (size_t)4256 * 1024 + (size_t)i * 8) = (u32x4){0u, 0u, 0u, 0u};
    for (int i = F.gw * 64 + lane; i < 1024 * 8; i += F.NGW * 64) { const int row = i >> 3, c8 = (i & 7) * 8; *(u32x4*)(Wblk + row * 128 + (row < 512 ? 64 : 0) + c8) = (u32x4){0u, 0u, 0u, 0u}; }
    { const int* pos = (const int*)a->in[I_POS]; float* cs = (float*)(F.ws + WS_CS);
      for (int i = F.gw * 64 + lane; i < NTOK * 16; i += F.NGW * 64) { const int t = i >> 4, j = i & 15;
          const float fr = exp2f(-(float)j * (13.287712379549449f / 16.0f));
          const float ang = (float)pos[t] * fr; cs[t * 32 + j] = cosf(ang); cs[t * 32 + 16 + j] = sinf(ang); } }
    { float* mod = (float*)(F.ws + WS_MOD); const float* c = a->in[I_C]; const float* wa = a->in[I_WADA]; const float* ba = a->in[I_BADA];
      LAS float* red = (LAS float*)(F.lds + 8 * 16384);
      for (int nb = F.vcu; nb < 96; nb += F.G) {
          float acc[8];
#pragma unroll
          for (int b = 0; b < 8; ++b) acc[b] = 0.f;
          const int n = nb * 64 + lane;
          for (int k = F.wave * 128; k < F.wave * 128 + 128; ++k) { const float w = wa[(size_t)k * 6144 + n];
#pragma unroll
              for (int b = 0; b < 8; ++b) acc[b] = fmaf(siluf_(c[b * 1024 + k]), w, acc[b]); }
#pragma unroll
          for (int b = 0; b < 8; ++b) red[(F.wave * 8 + b) * 64 + lane] = acc[b];
          __syncthreads();
          { const int b = F.wave; float s = ba[n];
#pragma unroll
            for (int w = 0; w < 8; ++w) s += red[(w * 8 + b) * 64 + lane];
            mod[b * 6144 + n] = s; }
          __syncthreads();
      } }
}

__device__ __forceinline__ void p_normmod(const Frame& F, const float* x, const float* g, const float* mod, int sh_off, int sc_off, bf16* H) {
    const int lane_f = lane_id_fresh(), tid_f = F.wave * 64 + lane_f;
    for (int m = F.gw; m < NTOK; m += F.NGW) {
        const int b = m / SEQ; const f32x4* xr = (const f32x4*)(x + (size_t)m * 1024) + lane_f;
        f32x4 v[4]; float s = 0.f;
#pragma unroll
        for (int j = 0; j < 4; ++j) { v[j] = xr[64 * j]; s += (v[j].x * v[j].x + v[j].y * v[j].y) + (v[j].z * v[j].z + v[j].w * v[j].w); }
        const float rstd = 1.0f / sqrtf(wave_sum(s) * (1.f / 1024.f) + EPS);
        u32x2* o = (u32x2*)(H + (size_t)m * 1024) + lane_f;
#pragma unroll
        for (int j = 0; j < 4; ++j) { const int col = 4 * lane_f + 256 * j;
            const f32x4 gg = *(const f32x4*)(g + col), sc = *(const f32x4*)(mod + b * 6144 + sc_off + col), sh = *(const f32x4*)(mod + b * 6144 + sh_off + col);
            const f32x4 y = v[j] * rstd * gg * (sc + 1.0f) + sh; u32x2 w; w.x = pk2(y.x, y.y); w.y = pk2(y.z, y.w); o[64 * j] = w; }
    }
}

__device__ __forceinline__ void p_prep_a(const Frame& F, ArgsP a) {
    const int lane_f = lane_id_fresh();
    const bf16* ZR = (const bf16*)(F.ws + WS_ZR); const bf16* ZM = (const bf16*)(F.ws + WS_ZM);
    bf16* TWA = (bf16*)(F.ws + WS_TWA); bf16* SGL = (bf16*)(F.ws + WS_SGL); bf16* QA = (bf16*)(F.ws + WS_QA); bf16* KVA = (bf16*)(F.ws + WS_KVA);
    const float* mu = a->in[I_MU]; const float* gqa = a->in[I_GQA]; const float* gkva = a->in[I_GKVA];
    const int lane = lane_f;
    const f32x4 mm = *(const f32x4*)(mu + 1536 + 4 * lane), gq = *(const f32x4*)(gqa + 4 * lane), gk = *(const f32x4*)(gkva + 4 * (lane & 31));
    for (int m = F.gw; m < NTOK; m += F.NGW) {
        const bool first = (m % SEQ) == 0;
        { const u32x2 c = *((const u32x2*)(ZR + (size_t)m * 1792 + 1536) + lane); u32x2 p = *((const u32x2*)(ZR + (size_t)(first ? m : m - 1) * 1792 + 1536) + lane); if (first) { p.x = 0u; p.y = 0u; }
          float z[4] = {lo2f(c.x), hi2f(c.x), lo2f(c.y), hi2f(c.y)}; const float q[4] = {lo2f(p.x), hi2f(p.x), lo2f(p.y), hi2f(p.y)};
          z[0] += (q[0] - z[0]) * mm.x; z[1] += (q[1] - z[1]) * mm.y; z[2] += (q[2] - z[2]) * mm.z; z[3] += (q[3] - z[3]) * mm.w;
          if (lane < 16) { u32x2 w; w.x = pk2(tanhf(z[0]), tanhf(z[1])); w.y = pk2(tanhf(z[2]), tanhf(z[3])); *((u32x2*)(TWA + (size_t)m * 128) + lane) = w; }
          else if (lane < 32) { u32x2 w; w.x = pk2(z[0], z[1]); w.y = pk2(z[2], z[3]); *((u32x2*)(TWA + (size_t)m * 128) + lane) = w; }
          else { u32x2 w; w.x = pk2(sigmoidf_(z[0]), sigmoidf_(z[1])); w.y = pk2(sigmoidf_(z[2]), sigmoidf_(z[3])); *((u32x2*)(SGL + (size_t)m * 128) + (lane - 32)) = w; } }
        { const u32x2 c = *((const u32x2*)(ZM + (size_t)m * 512) + lane); const float z[4] = {lo2f(c.x), hi2f(c.x), lo2f(c.y), hi2f(c.y)};
          u32x2 c2 = (u32x2){0u, 0u}; if (lane < 32) c2 = *((const u32x2*)(ZM + (size_t)m * 512 + 256) + lane); const float y[4] = {lo2f(c2.x), hi2f(c2.x), lo2f(c2.y), hi2f(c2.y)};
          const float rstd = 1.0f / sqrtf(wave_sum((z[0] * z[0] + z[1] * z[1]) + (z[2] * z[2] + z[3] * z[3])) * (1.f / 256.f) + EPS);
          const float rstd2 = 1.0f / sqrtf(wave_sum((y[0] * y[0] + y[1] * y[1]) + (y[2] * y[2] + y[3] * y[3])) * (1.f / 128.f) + EPS);
          u32x2 w; w.x = pk2(z[0] * rstd * gq.x, z[1] * rstd * gq.y); w.y = pk2(z[2] * rstd * gq.z, z[3] * rstd * gq.w);
          *((u32x2*)(QA + (size_t)m * 256) + lane) = w;
          if (lane < 32) { u32x2 w2; w2.x = pk2(y[0] * rstd2 * gk.x, y[1] * rstd2 * gk.y); w2.y = pk2(y[2] * rstd2 * gk.z, y[3] * rstd2 * gk.w);
              *((u32x2*)(KVA + (size_t)m * 128) + lane) = w2; } }
    }
}

__device__ __forceinline__ void p_prep_c(const Frame& F, ArgsP a) {
    const int lane_f = lane_id_fresh(), tid_f = F.wave * 64 + lane_f;
    bf16* Q = (bf16*)(F.dob + DO_Q); const bf16* KN = (const bf16*)(F.dob + DO_KN); const bf16* ZM = (const bf16*)(F.ws + WS_ZM); bf16* KC = (bf16*)(F.ws + WS_KC);
    const float* cs = (const float*)(F.ws + WS_CS);
    const float* qn = a->in[I_QN]; const float* kn = a->in[I_KN];
    const int lane = lane_f, hd = lane >> 3, j = lane & 7;
    for (int m = F.gw; m < NTOK; m += F.NGW) {
        const f32x2 cc = *(const f32x2*)(cs + (size_t)m * 32 + 2 * j), sn = *(const f32x2*)(cs + (size_t)m * 32 + 16 + 2 * j);
        { bf16* qp = Q + (size_t)m * 768 + hd * 96; float v[8]; unpack8(*(const u32x4*)(qp + 8 * j), v);
          const unsigned w1 = *(const unsigned*)(qp + 64 + 2 * j), w2 = *(const unsigned*)(qp + 80 + 2 * j); float x1[2] = {lo2f(w1), hi2f(w1)}, x2[2] = {lo2f(w2), hi2f(w2)};
          float ss = (x1[0] * x1[0] + x1[1] * x1[1]) + (x2[0] * x2[0] + x2[1] * x2[1]);
#pragma unroll
          for (int i = 0; i < 8; ++i) ss += v[i] * v[i];
          const float rstd = 1.0f / sqrtf(sum8(ss) * (1.f / 96.f) + EPS);
#pragma unroll
          for (int i = 0; i < 8; ++i) v[i] = v[i] * rstd * qn[8 * j + i] * QSCALE;
          x1[0] *= rstd * qn[64 + 2 * j]; x1[1] *= rstd * qn[65 + 2 * j]; x2[0] *= rstd * qn[80 + 2 * j]; x2[1] *= rstd * qn[81 + 2 * j];
          const float o1a = (x1[0] * cc.x - x2[0] * sn.x) * QSCALE, o1b = (x1[1] * cc.y - x2[1] * sn.y) * QSCALE, o2a = (x2[0] * cc.x + x1[0] * sn.x) * QSCALE, o2b = (x2[1] * cc.y + x1[1] * sn.y) * QSCALE;
          *(u32x4*)(qp + 8 * j) = pack8(v); *(unsigned*)(qp + 64 + 2 * j) = pk2(o1a, o1b); *(unsigned*)(qp + 80 + 2 * j) = pk2(o2a, o2b); }
        { float v[8]; unpack8(*(const u32x4*)(KN + (size_t)m * 512 + hd * 64 + 8 * j), v);
          const unsigned w1 = *(const unsigned*)(ZM + (size_t)m * 512 + 384 + 2 * j), w2 = *(const unsigned*)(ZM + (size_t)m * 512 + 400 + 2 * j); float x1[2] = {lo2f(w1), hi2f(w1)}, x2[2] = {lo2f(w2), hi2f(w2)};
          float ss = (x1[0] * x1[0] + x1[1] * x1[1]) + (x2[0] * x2[0] + x2[1] * x2[1]);
#pragma unroll
          for (int i = 0; i < 8; ++i) ss += v[i] * v[i];
          const float rstd = 1.0f / sqrtf(sum8(ss) * (1.f / 96.f) + EPS);
#pragma unroll
          for (int i = 0; i < 8; ++i) v[i] = v[i] * rstd * kn[8 * j + i];
          x1[0] *= rstd * kn[64 + 2 * j]; x1[1] *= rstd * kn[65 + 2 * j]; x2[0] *= rstd * kn[80 + 2 * j]; x2[1] *= rstd * kn[81 + 2 * j];
          bf16* kp = KC + (size_t)m * 768 + hd * 96;
          *(u32x4*)(kp + 8 * j) = pack8(v); *(unsigned*)(kp + 64 + 2 * j) = pk2(x1[0] * cc.x - x2[0] * sn.x, x1[1] * cc.y - x2[1] * sn.y);
          *(unsigned*)(kp + 80 + 2 * j) = pk2(x2[0] * cc.x + x1[0] * sn.x, x2[1] * cc.y + x1[1] * sn.y); }
    }
}

constexpr int SC_T = 32;
constexpr int SC_BUF = 5 * SC_T * 64 * 4 + SC_T * 16 * 4 + SC_T * 16 * 4;
struct ScanRaw { u32x2 rc[2], rp[2], kc[2], kp[2], av[2], lw[2]; u32x4 vc, vp; };
__device__ __forceinline__ void scan_issue(ScanRaw& R, const bf16* ZR, const bf16* A, const bf16* LW, size_t row0, int t0, int st2, int col, int s2, int cv, bool dov) {
#pragma unroll
    for (int u = 0; u < 2; ++u) { const int tt = t0 + st2 + 16 * u; const size_t g = row0 + tt; const size_t gp = row0 + (tt > 0 ? tt - 1 : 0);
        R.rc[u] = *(const u32x2*)(ZR + g * 1792 + col); R.rp[u] = *(const u32x2*)(ZR + gp * 1792 + col);
        R.kc[u] = *(const u32x2*)(ZR + g * 1792 + 512 + col); R.kp[u] = *(const u32x2*)(ZR + gp * 1792 + 512 + col);
        R.av[u] = *(const u32x2*)(A + g * 512 + col); R.lw[u] = *(const u32x2*)(LW + g * 512 + col); }
    { const int tv = t0 + (dov ? s2 : 0); const size_t gv = row0 + tv; const size_t gvp = row0 + (tv > 0 ? tv - 1 : 0); R.vc = *(const u32x4*)(ZR + gv * 1792 + 1024 + cv); R.vp = *(const u32x4*)(ZR + gvp * 1792 + 1024 + cv); }
}
__device__ __forceinline__ void p_scan(const Frame& F, ArgsP a) {
    const int lane_f = lane_id_fresh(), tid_f = F.wave * 64 + lane_f;
    const bf16* ZR = (const bf16*)(F.ws + WS_ZR); const bf16* A = (const bf16*)(F.ws + WS_A); const bf16* LW = (const bf16*)(F.ws + WS_LW); bf16* Y = (bf16*)(F.ws + WS_Y);
    const float* mu = a->in[I_MU]; const float* k_k = a->in[I_KK]; const float* k_a = a->in[I_KA];
    const int lane = lane_f, wave = F.wave, tid = tid_f;
    for (int item = F.vcu; item < 256; item += F.G) {
        const int bh = item >> 2, qt = item & 3, b = bh >> 3, h = bh & 7;
        const size_t row0 = (size_t)b * SEQ; const int colh = h * 64;
        const int NCH = SEQ / SC_T;
        __syncthreads();
        if (wave >= 4) {
            const int lt = tid - 256, st2 = lt >> 4, j4 = (lt & 15) * 4, col = colh + j4, s2 = lt >> 1, hf = lt & 1, cv = colh + qt * 16 + hf * 8; const bool dov = lt < 64;
            f32x4 mur = *(const f32x4*)(mu + col), muk = *(const f32x4*)(mu + 512 + col), kkc = *(const f32x4*)(k_k + col), kac = *(const f32x4*)(k_a + col);
            f32x4 m0 = *(const f32x4*)(mu + 1024 + cv), m1 = *(const f32x4*)(mu + 1024 + cv + 4);
            asm volatile("" : "+v"(mur), "+v"(muk), "+v"(kkc), "+v"(kac), "+v"(m0), "+v"(m1));
            ScanRaw R0, R1;
            scan_issue(R0, ZR, A, LW, row0, 0, st2, col, s2, cv, dov);
#define SCAN_BUILD(RR, c_) do { LAS unsigned char* bs = F.lds + ((c_) & 1) * SC_BUF; \
                _Pragma("unroll") for (int u = 0; u < 2; ++u) { const int st = st2 + 16 * u; const bool t0_ = ((c_) * SC_T + st) == 0; \
                    const f32x4 rc = {lo2f(RR.rc[u].x), hi2f(RR.rc[u].x), lo2f(RR.rc[u].y), hi2f(RR.rc[u].y)}; f32x4 rp = {lo2f(RR.rp[u].x), hi2f(RR.rp[u].x), lo2f(RR.rp[u].y), hi2f(RR.rp[u].y)}; \
                    const f32x4 kc = {lo2f(RR.kc[u].x), hi2f(RR.kc[u].x), lo2f(RR.kc[u].y), hi2f(RR.kc[u].y)}; f32x4 kp = {lo2f(RR.kp[u].x), hi2f(RR.kp[u].x), lo2f(RR.kp[u].y), hi2f(RR.kp[u].y)}; \
                    const f32x4 av = {lo2f(RR.av[u].x), hi2f(RR.av[u].x), lo2f(RR.av[u].y), hi2f(RR.av[u].y)}; const f32x4 lw = {lo2f(RR.lw[u].x), hi2f(RR.lw[u].x), lo2f(RR.lw[u].y), hi2f(RR.lw[u].y)}; \
                    if (t0_) { rp = (f32x4){0.f, 0.f, 0.f, 0.f}; kp = rp; } \
                    const f32x4 r = rc + (rp - rc) * mur, zk = kc + (kp - kc) * muk, kq = zk * ((av - 1.0f) * kac + 1.0f), kr = zk * kkc; \
                    const float ss = allsum16((kr.x * kr.x + kr.y * kr.y) + (kr.z * kr.z + kr.w * kr.w)); const float inv = 1.0f / fmaxf(sqrtf(ss), 1e-12f); \
                    const f32x4 kk = kr * inv; const f32x4 wv = {__expf(lw.x), __expf(lw.y), __expf(lw.z), __expf(lw.w)}; \
                    LAS float* dst = (LAS float*)bs + st * 64 + j4; \
                    *(LAS f32x4*)dst = wv; *(LAS f32x4*)(dst + SC_T * 64) = -kk; *(LAS f32x4*)(dst + 2 * SC_T * 64) = kk * av; *(LAS f32x4*)(dst + 3 * SC_T * 64) = kq; *(LAS f32x4*)(dst + 4 * SC_T * 64) = r; } \
                if (dov) { float vc[8], vp[8]; unpack8(RR.vc, vc); unpack8(RR.vp, vp); if ((c_) * SC_T + s2 == 0) { _Pragma("unroll") for (int i = 0; i < 8; ++i) vp[i] = 0.f; } \
                    LAS float* dv = (LAS float*)(bs + 5 * SC_T * 256) + s2 * 16 + hf * 8; \
                    *(LAS f32x4*)dv = (f32x4){vc[0] + (vp[0] - vc[0]) * m0.x, vc[1] + (vp[1] - vc[1]) * m0.y, vc[2] + (vp[2] - vc[2]) * m0.z, vc[3] + (vp[3] - vc[3]) * m0.w}; \
                    *(LAS f32x4*)(dv + 4) = (f32x4){vc[4] + (vp[4] - vc[4]) * m1.x, vc[5] + (vp[5] - vc[5]) * m1.y, vc[6] + (vp[6] - vc[6]) * m1.z, vc[7] + (vp[7] - vc[7]) * m1.w}; } } while (0)
#define SCAN_FLUSH(c_) do { if ((c_) >= 2 && dov) { LAS unsigned char* bs = F.lds + ((c_) & 1) * SC_BUF; const LAS float* yy = (const LAS float*)(bs + 5 * SC_T * 256 + SC_T * 64) + s2 * 16 + hf * 8; \
                const f32x4 y0 = *(const LAS f32x4*)yy, y1 = *(const LAS f32x4*)(yy + 4); const float v[8] = {y0.x, y0.y, y0.z, y0.w, y1.x, y1.y, y1.z, y1.w}; \
                *(u32x4*)(Y + (row0 + (size_t)((c_) - 2) * SC_T + s2) * 512 + cv) = pack8(v); } } while (0)
            for (int c = 0; c <= NCH + 1; c += 2) {
                SCAN_FLUSH(c);
                scan_issue(R1, ZR, A, LW, row0, (c + 1 < NCH ? c + 1 : NCH - 1) * SC_T, st2, col, s2, cv, dov);
                if (c < NCH) SCAN_BUILD(R0, c);
                LDS_BAR();
                SCAN_FLUSH(c + 1);
                scan_issue(R0, ZR, A, LW, row0, (c + 2 < NCH ? c + 2 : NCH - 1) * SC_T, st2, col, s2, cv, dov);
                if (c + 1 < NCH) SCAN_BUILD(R1, c + 1);
                LDS_BAR();
            }
#undef SCAN_BUILD
#undef SCAN_FLUSH
        } else {
            const int rg = lane >> 4, jl = lane & 15;
            f32x2 Sa = {0.f, 0.f}, Sb = {0.f, 0.f};
            for (int c = 0; c <= NCH + 1; c += 2) {
#pragma unroll
                for (int half = 0; half < 2; ++half) {
                    const int cc = c + half;
                    if (cc >= 1 && cc <= NCH) {
                        LAS unsigned char* bc = F.lds + ((cc + 1) & 1) * SC_BUF;
                        const LAS float* base = (const LAS float*)bc + 4 * jl;
                        const LAS float* vb = (const LAS float*)(bc + 5 * SC_T * 256) + wave * 4 + rg;
                        LAS float* yb = (LAS float*)(bc + 5 * SC_T * 256 + SC_T * 64) + wave * 4 + rg;
                        f32x4 w[2][2], nk[2][2], bb[2][2], kv[2][2], rr[2][2]; float vv1[2][2];
#define SC_LOAD(slot, g_) do { _Pragma("unroll") for (int q = 0; q < 2; ++q) { const int st_ = (g_) * 2 + q; \
                            w[slot][q] = *(const LAS f32x4*)(base + st_ * 64); nk[slot][q] = *(const LAS f32x4*)(base + SC_T * 64 + st_ * 64); bb[slot][q] = *(const LAS f32x4*)(base + 2 * SC_T * 64 + st_ * 64); \
                            kv[slot][q] = *(const LAS f32x4*)(base + 3 * SC_T * 64 + st_ * 64); rr[slot][q] = *(const LAS f32x4*)(base + 4 * SC_T * 64 + st_ * 64); vv1[slot][q] = vb[st_ * 16]; } } while (0)
                        SC_LOAD(0, 0);
#pragma unroll
                        for (int g = 0; g < SC_T / 2; ++g) {
                            const int sl = g & 1;
                            if (g + 1 < SC_T / 2) { if (sl == 0) SC_LOAD(1, g + 1); else SC_LOAD(0, g + 1); }
                            float yo[2];
#pragma unroll
                            for (int q = 0; q < 2; ++q) {
                                const f32x4 w_ = w[sl][q], nk_ = nk[sl][q], bb_ = bb[sl][q], kv_ = kv[sl][q], rr_ = rr[sl][q]; const float v = vv1[sl][q];
                                const f32x2 t0 = Sa * (f32x2){nk_.x, nk_.y} + Sb * (f32x2){nk_.z, nk_.w};
                                const float sa = allsum16(t0.x + t0.y);
                                const f32x2 vv = {v, v}, ss = {sa, sa};
                                Sa = Sa * (f32x2){w_.x, w_.y} + (ss * (f32x2){bb_.x, bb_.y} + vv * (f32x2){kv_.x, kv_.y});
                                Sb = Sb * (f32x2){w_.z, w_.w} + (ss * (f32x2){bb_.z, bb_.w} + vv * (f32x2){kv_.z, kv_.w});
                                const f32x2 t1 = Sa * (f32x2){rr_.x, rr_.y} + Sb * (f32x2){rr_.z, rr_.w};
                                yo[q] = allsum16(t1.x + t1.y);
                            }
                            if (jl == 0) { yb[(g * 2) * 16] = yo[0]; yb[(g * 2 + 1) * 16] = yo[1]; }
                        }
#undef SC_LOAD
                    }
                    LDS_BAR();
                }
            }
        }
    }
}

__device__ __forceinline__ void p_attn_naive(const Frame& F) {
    const int lane_f = lane_id_fresh(), tid_f = F.wave * 64 + lane_f;
    const bf16* Q = (const bf16*)(F.dob + DO_Q); const bf16* KC = (const bf16*)(F.ws + WS_KC); const bf16* VC = (const bf16*)(F.ws + WS_VC); bf16* YM = (bf16*)(F.ws + WS_YM);
    LAS float* Ks = (LAS float*)F.lds; LAS float* Vs = (LAS float*)(F.lds + 32 * 96 * 4);
    const int tid = tid_f;
    for (int unit = F.vcu; unit < 64 * 16; unit += F.G) {
        const int bh = unit >> 4, qb = 15 - (unit & 15), b = bh >> 3, h = bh & 7; const size_t row0 = (size_t)b * SEQ; const int t = qb * 512 + tid;
        unsigned qp[48];
        { const u32x4* qg = (const u32x4*)(Q + (row0 + t) * 768 + h * 96);
#pragma unroll
          for (int i = 0; i < 12; ++i) { const u32x4 w = qg[i]; qp[4 * i] = w.x; qp[4 * i + 1] = w.y; qp[4 * i + 2] = w.z; qp[4 * i + 3] = w.w; } }
        float o[64];
#pragma unroll
        for (int i = 0; i < 64; ++i) o[i] = 0.f;
        float mx = -INFINITY, l = 0.f;
        const int nkt = (qb + 1) * 16;
        for (int kt = 0; kt < nkt; ++kt) {
            __syncthreads();
            if (tid < 384) { const int r = tid / 12, c8 = (tid % 12) * 8; float v[8]; unpack8(*(const u32x4*)(KC + (row0 + kt * 32 + r) * 768 + h * 96 + c8), v);
#pragma unroll
                for (int i = 0; i < 8; ++i) Ks[r * 96 + c8 + i] = v[i]; }
            if (tid < 256) { const int r = tid >> 3, c8 = (tid & 7) * 8; float v[8]; unpack8(*(const u32x4*)(VC + (row0 + kt * 32 + r) * 512 + h * 64 + c8), v);
#pragma unroll
                for (int i = 0; i < 8; ++i) Vs[r * 64 + c8 + i] = v[i]; }
            __syncthreads();
            for (int kk = 0; kk < 32; ++kk) {
                const int kv = kt * 32 + kk;
                float s = 0.f; const LAS f32x4* kr = (const LAS f32x4*)(Ks + kk * 96);
#pragma unroll
                for (int i = 0; i < 24; ++i) { const f32x4 k4 = kr[i]; s += lo2f(qp[2 * i]) * k4.x + hi2f(qp[2 * i]) * k4.y + lo2f(qp[2 * i + 1]) * k4.z + hi2f(qp[2 * i + 1]) * k4.w; }
                if (kv <= t) {
                    const float mn = fmaxf(mx, s), f = exp2f(mx - mn), p = exp2f(s - mn); mx = mn; l = l * f + p;
                    const LAS f32x4* vr = (const LAS f32x4*)(Vs + kk * 64);
#pragma unroll
                    for (int i = 0; i < 16; ++i) { const f32x4 v4 = vr[i]; o[4 * i] = o[4 * i] * f + p * v4.x; o[4 * i + 1] = o[4 * i + 1] * f + p * v4.y; o[4 * i + 2] = o[4 * i + 2] * f + p * v4.z; o[4 * i + 3] = o[4 * i + 3] * f + p * v4.w; }
                }
            }
        }
        const float il = 1.f / l; u32x4* og = (u32x4*)(YM + (row0 + t) * 512 + h * 64);
#pragma unroll
        for (int i = 0; i < 8; ++i) { u32x4 w; w.x = pk2(o[8 * i] * il, o[8 * i + 1] * il); w.y = pk2(o[8 * i + 2] * il, o[8 * i + 3] * il); w.z = pk2(o[8 * i + 4] * il, o[8 * i + 5] * il); w.w = pk2(o[8 * i + 6] * il, o[8 * i + 7] * il); og[i] = w; }
    }
    __syncthreads();
}

typedef float f32x16 __attribute__((ext_vector_type(16)));
typedef short s16x4 __attribute__((ext_vector_type(4)));
__device__ __forceinline__ int crow(int r, int hi) { return (r & 3) + 8 * (r >> 2) + 4 * hi; }
__device__ __forceinline__ float xhalf_max(float x) { auto rr = __builtin_amdgcn_permlane32_swap(__float_as_uint(x), __float_as_uint(x), false, false); return fmaxf(__uint_as_float(rr[0]), __uint_as_float(rr[1])); }
__device__ __forceinline__ float xhalf_sum(float x) { auto rr = __builtin_amdgcn_permlane32_swap(__float_as_uint(x), __float_as_uint(x), false, false); return __uint_as_float(rr[0]) + __uint_as_float(rr[1]); }
__device__ __forceinline__ bf16x8 packp(const f32x16& p, int s2) {
    u32x4 w; w.x = pk2(p[8 * s2 + 0], p[8 * s2 + 1]); w.y = pk2(p[8 * s2 + 2], p[8 * s2 + 3]); w.z = pk2(p[8 * s2 + 4], p[8 * s2 + 5]); w.w = pk2(p[8 * s2 + 6], p[8 * s2 + 7]);
    return __builtin_bit_cast(bf16x8, w);
}
__device__ __forceinline__ void p_attn_mfma(const Frame& F) {
    const int lane_f = lane_id_fresh(), tid_f = F.wave * 64 + lane_f;
    const bf16* Q = (const bf16*)(F.dob + DO_Q); const bf16* KC = (const bf16*)(F.ws + WS_KC); const bf16* VC = (const bf16*)(F.ws + WS_VC); bf16* YM = (bf16*)(F.ws + WS_YM);
    constexpr int KST = 208, VST = 192, KBYTES = 64 * KST, SUB = KBYTES + 64 * VST, BUF = 2 * SUB;
    const int tid = tid_f, lane = lane_f, wave = F.wave, r = lane & 31, hi = lane >> 5;
    int kg[3], kl[3], vg[2], vl[2];
#pragma unroll
    for (int i = 0; i < 3; ++i) { const int c = tid + 512 * i, row = c / 12, pc = c % 12; kg[i] = row * 768 + pc * 8; kl[i] = (row >> 6) * SUB + (row & 63) * KST + pc * 16; }
#pragma unroll
    for (int i = 0; i < 2; ++i) { const int c = tid + 512 * i, row = c >> 3, pc = c & 7; vg[i] = row * 512 + pc * 8; vl[i] = (row >> 6) * SUB + KBYTES + (row & 63) * VST + pc * 16; }
    const int g4 = lane >> 4, li = lane & 15;
    const int vtr = (4 * (g4 >> 1) + (li >> 2)) * VST + (16 * (g4 & 1) + 4 * (li & 3)) * 2;
    const int kfr = r * KST + hi * 16;
    LAS unsigned char* lds = F.lds;
    for (int item = F.vcu; item < 1024; item += F.G) {
        const int bh = item >> 4, sidx = item & 15, b = bh >> 3, h = bh & 7; const size_t row0 = (size_t)b * SEQ;
        const bf16* Kg = KC + row0 * 768 + h * 96; const bf16* Vg = VC + row0 * 512 + h * 64;
        for (int uu = 0; uu < 2; ++uu) {
            const int qb = uu == 0 ? 31 - sidx : sidx, q0 = qb * 256, NT = (q0 + 256) / 128;
            const int qw = q0 + wave * 32;
            bf16x8 qf[6];
            { const bf16* qp = Q + (row0 + qw + r) * 768 + h * 96 + hi * 8;
#pragma unroll
              for (int s = 0; s < 6; ++s) qf[s] = *(const bf16x8*)(qp + 16 * s); }
            f32x16 o0 = {}, o1 = {}; float m = -INFINITY, l = 0.f;
            u32x4 ak[3], av[2];
#pragma unroll
            for (int i = 0; i < 3; ++i) ak[i] = *(const u32x4*)(Kg + kg[i]);
#pragma unroll
            for (int i = 0; i < 2; ++i) av[i] = *(const u32x4*)(Vg + vg[i]);
            asm volatile("" : "+v"(qf[0]), "+v"(qf[1]), "+v"(qf[2]), "+v"(qf[3]), "+v"(qf[4]), "+v"(qf[5]));
            LDS_BAR();
#pragma unroll
            for (int i = 0; i < 3; ++i) *(LAS u32x4*)(lds + kl[i]) = ak[i];
#pragma unroll
            for (int i = 0; i < 2; ++i) *(LAS u32x4*)(lds + vl[i]) = av[i];
            LDS_BAR();
            for (int t = 0; t < NT; ++t) {
                LAS unsigned char* bb = lds + (t & 1) * BUF;
                { const int tn = (t + 1 < NT) ? t + 1 : t;
                  const bf16* kgp = Kg + (size_t)tn * 128 * 768; const bf16* vgp = Vg + (size_t)tn * 128 * 512;
#pragma unroll
                  for (int i = 0; i < 3; ++i) ak[i] = *(const u32x4*)(kgp + kg[i]);
#pragma unroll
                  for (int i = 0; i < 2; ++i) av[i] = *(const u32x4*)(vgp + vg[i]); }
#pragma unroll
                for (int sub = 0; sub < 2; ++sub) {
                    const int tt = 2 * t + sub;
                    if (64 * tt <= qw + 31) {
                        LAS unsigned char* kb = bb + sub * SUB; LAS unsigned char* vb = kb + KBYTES;
                        f32x16 p0 = {}, p1 = {};
#pragma unroll
                        for (int s = 0; s < 6; ++s) { const bf16x8 k0 = *(const LAS bf16x8*)(kb + kfr + s * 32), k1 = *(const LAS bf16x8*)(kb + kfr + 32 * KST + s * 32);
                            p0 = __builtin_amdgcn_mfma_f32_32x32x16_bf16(k0, qf[s], p0, 0, 0, 0); p1 = __builtin_amdgcn_mfma_f32_32x32x16_bf16(k1, qf[s], p1, 0, 0, 0); }
                        if (64 * tt + 63 > qw) {
                            const int qrel = qw + r - 64 * tt;
#pragma unroll
                            for (int rg = 0; rg < 16; ++rg) { const int kv = crow(rg, hi); if (kv > qrel) p0[rg] = -INFINITY; if (kv + 32 > qrel) p1[rg] = -INFINITY; }
                        }
                        float mx = fmaxf(p0[0], p1[0]);
#pragma unroll
                        for (int rg = 1; rg < 16; ++rg) mx = fmaxf(mx, fmaxf(p0[rg], p1[rg]));
                        mx = xhalf_max(mx);
                        if (!__all(mx <= m + 8.0f)) {
                            const float mn = fmaxf(m, mx), f = __builtin_amdgcn_exp2f(m - mn); m = mn; l *= f;
#pragma unroll
                            for (int rg = 0; rg < 16; ++rg) { o0[rg] *= f; o1[rg] *= f; }
                        }
                        float rs = 0.f;
#pragma unroll
                        for (int rg = 0; rg < 16; ++rg) { p0[rg] = __builtin_amdgcn_exp2f(p0[rg] - m); p1[rg] = __builtin_amdgcn_exp2f(p1[rg] - m); rs += p0[rg] + p1[rg]; }
                        l += rs;
#pragma unroll
                        for (int hh = 0; hh < 2; ++hh)
#pragma unroll
                            for (int s2 = 0; s2 < 2; ++s2) { const bf16x8 pf = packp(hh == 0 ? p0 : p1, s2);
#pragma unroll
                                for (int db = 0; db < 2; ++db) { LAS unsigned char* vp_ = vb + vtr + (32 * hh + 16 * s2) * VST + db * 64;
                                    const s16x4 lo = __builtin_bit_cast(s16x4, __builtin_amdgcn_ds_read_tr16_b64_v4i16((LAS s16x4*)vp_));
                                    const s16x4 hi4 = __builtin_bit_cast(s16x4, __builtin_amdgcn_ds_read_tr16_b64_v4i16((LAS s16x4*)(vp_ + 8 * VST)));
                                    const bf16x8 vf = (bf16x8){lo[0], lo[1], lo[2], lo[3], hi4[0], hi4[1], hi4[2], hi4[3]};
                                    if (db == 0) o0 = __builtin_amdgcn_mfma_f32_32x32x16_bf16(vf, pf, o0, 0, 0, 0); else o1 = __builtin_amdgcn_mfma_f32_32x32x16_bf16(vf, pf, o1, 0, 0, 0); } }
                    }
                }
                { LAS unsigned char* nb = lds + ((t + 1) & 1) * BUF;
#pragma unroll
                  for (int i = 0; i < 3; ++i) *(LAS u32x4*)(nb + kl[i]) = ak[i];
#pragma unroll
                  for (int i = 0; i < 2; ++i) *(LAS u32x4*)(nb + vl[i]) = av[i]; }
                LDS_BAR();
            }
            const float il = 1.0f / xhalf_sum(l);
            bf16* op = YM + (row0 + qw + r) * 512 + h * 64 + 4 * hi;
#pragma unroll
            for (int gq = 0; gq < 4; ++gq) { u32x2 w0, w1;
                w0.x = pk2(o0[4 * gq] * il, o0[4 * gq + 1] * il); w0.y = pk2(o0[4 * gq + 2] * il, o0[4 * gq + 3] * il);
                w1.x = pk2(o1[4 * gq] * il, o1[4 * gq + 1] * il); w1.y = pk2(o1[4 * gq + 2] * il, o1[4 * gq + 3] * il);
                *(u32x2*)(op + 8 * gq) = w0; *(u32x2*)(op + 32 + 8 * gq) = w1; }
        }
    }
    __syncthreads();
}

constexpr int CS_CH = 256, CS_NCH = SEQ / CS_CH;
constexpr int CS_RS = 144;
constexpr int CS_IMG = 16 * CS_RS;
constexpr int CS_WAVE = 8 * CS_IMG + 512;
enum { IM_A = 0, IM_R = 1, IM_B = 2, IM_K = 3, IM_BH = 4, IM_KH = 5, IM_V = 6, IM_G = 7 };
constexpr size_t DO_CSP = 64 * MiB, DO_CSG = 128 * MiB, DO_CSZ = 192 * MiB;
__device__ __forceinline__ int crow8(int q, int hi) { return (q & 3) + 8 * ((q >> 2) & 1) + 4 * hi; }
template <int N> __device__ __forceinline__ float dpp_shr0(float x) { return __builtin_bit_cast(float, __builtin_amdgcn_update_dpp(0, __builtin_bit_cast(int, x), 0x110 + N, 0xf, 0xf, true)); }
__device__ __forceinline__ float rowscan16(float x) { x += dpp_shr0<1>(x); x += dpp_shr0<2>(x); x += dpp_shr0<4>(x); x += dpp_shr0<8>(x); return x; }
__device__ __forceinline__ float xsum_16_32(float v) {
    { auto r = __builtin_amdgcn_permlane16_swap(__float_as_uint(v), __float_as_uint(v), false, false); v = __uint_as_float(r[0]) + __uint_as_float(r[1]); }
    { auto r = __builtin_amdgcn_permlane32_swap(__float_as_uint(v), __float_as_uint(v), false, false); v = __uint_as_float(r[0]) + __uint_as_float(r[1]); }
    return v;
}
__device__ __forceinline__ bf16x8 cs_rowfrag(const LAS unsigned char* rowp, int hi, int ks) {
    const LAS unsigned char* p = rowp + (16 * ks + 4 * hi) * 2; const u32x2 a = *(const LAS u32x2*)p, b = *(const LAS u32x2*)(p + 16);
    return __builtin_bit_cast(bf16x8, (u32x4){a.x, a.y, b.x, b.y});
}
__device__ __forceinline__ bf16x8 cs_trfrag(LAS unsigned char* img, int cb, int lane) {
    const int g4 = lane >> 4, li = lane & 15; LAS unsigned char* p = img + (4 * (g4 >> 1) + (li >> 2)) * CS_RS + (32 * cb + 16 * (g4 & 1) + 4 * (li & 3)) * 2;
    const s16x4 lo = __builtin_bit_cast(s16x4, __builtin_amdgcn_ds_read_tr16_b64_v4i16((LAS s16x4*)p));
    const s16x4 h4 = __builtin_bit_cast(s16x4, __builtin_amdgcn_ds_read_tr16_b64_v4i16((LAS s16x4*)(p + 8 * CS_RS)));
    return (bf16x8){lo[0], lo[1], lo[2], lo[3], h4[0], h4[1], h4[2], h4[3]};
}
__device__ __forceinline__ bf16x8 cs_zero8() { return (bf16x8){0, 0, 0, 0, 0, 0, 0, 0}; }
struct CsIn { const bf16 *ZR, *A, *LW, *G; const float *mu, *k_k, *k_a, *r_k; };
template <bool USE_V, bool WITH_Y>
__device__ __forceinline__ void cs_prep(const CsIn& in, size_t row0, int tok0, int h, LAS unsigned char* wl, int lane) {
    const int t = lane & 15, jq = lane >> 4, tok = tok0 + t; const bool first = tok == 0;
    const size_t g = row0 + tok, gp = row0 + (first ? 0 : tok - 1); const int c0 = h * 64 + 16 * jq;
    LAS float* gct = (LAS float*)(wl + 8 * CS_IMG); LAS float* btt = gct + 64;
    u32x4 Lrc[2], Lrp[2], Lkc[2], Lkp[2], Lav[2], Llw[2], Lvc[2], Lvp[2];
#pragma unroll
    for (int hf = 0; hf < 2; ++hf) { const int cc = c0 + 8 * hf;
        Lkc[hf] = *(const u32x4*)(in.ZR + g * 1792 + 512 + cc); Lkp[hf] = *(const u32x4*)(in.ZR + gp * 1792 + 512 + cc);
        Lrc[hf] = *(const u32x4*)(in.ZR + g * 1792 + cc); Lrp[hf] = *(const u32x4*)(in.ZR + gp * 1792 + cc);
        Lav[hf] = *(const u32x4*)(in.A + g * 512 + cc); Llw[hf] = *(const u32x4*)(in.LW + g * 512 + cc);
        if (USE_V) { Lvc[hf] = *(const u32x4*)(in.ZR + g * 1792 + 1024 + cc); Lvp[hf] = *(const u32x4*)(in.ZR + gp * 1792 + 1024 + cc); }
    }
    float inv;
    { float ss = 0.f;
#pragma unroll
      for (int hf = 0; hf < 2; ++hf) { float kc[8], kp[8]; unpack8(Lkc[hf], kc); unpack8(Lkp[hf], kp);
          const f32x4 m0 = *(const f32x4*)(in.mu + 512 + c0 + 8 * hf), m1 = *(const f32x4*)(in.mu + 512 + c0 + 8 * hf + 4), q0 = *(const f32x4*)(in.k_k + c0 + 8 * hf), q1 = *(const f32x4*)(in.k_k + c0 + 8 * hf + 4);
          const float mm[8] = {m0.x, m0.y, m0.z, m0.w, m1.x, m1.y, m1.z, m1.w}, qq[8] = {q0.x, q0.y, q0.z, q0.w, q1.x, q1.y, q1.z, q1.w};
#pragma unroll
          for (int e = 0; e < 8; ++e) { const float zk = kc[e] + ((first ? 0.f : kp[e]) - kc[e]) * mm[e]; const float kr = zk * qq[e]; ss += kr * kr; } }
      inv = 1.0f / fmaxf(sqrtf(xsum_16_32(ss)), 1e-12f); }
    float btacc = 0.f;
#pragma unroll
    for (int hf = 0; hf < 2; ++hf) {
        const int cc = c0 + 8 * hf;
        u32x4 Lgg = {}; if (WITH_Y) Lgg = *(const u32x4*)(in.G + g * 512 + cc);
        float rc[8], rp[8], kc[8], kp[8], av[8], lw[8];
        unpack8(Lrc[hf], rc); unpack8(Lrp[hf], rp); unpack8(Lkc[hf], kc); unpack8(Lkp[hf], kp); unpack8(Lav[hf], av); unpack8(Llw[hf], lw);
        float mr[8], mk[8], qk[8], qa[8], qr[8];
        { const f32x4 a0 = *(const f32x4*)(in.mu + cc), a1 = *(const f32x4*)(in.mu + cc + 4), b0 = *(const f32x4*)(in.mu + 512 + cc), b1 = *(const f32x4*)(in.mu + 512 + cc + 4);
          const f32x4 c0_ = *(const f32x4*)(in.k_k + cc), c1_ = *(const f32x4*)(in.k_k + cc + 4), d0 = *(const f32x4*)(in.k_a + cc), d1 = *(const f32x4*)(in.k_a + cc + 4);
          mr[0] = a0.x; mr[1] = a0.y; mr[2] = a0.z; mr[3] = a0.w; mr[4] = a1.x; mr[5] = a1.y; mr[6] = a1.z; mr[7] = a1.w;
          mk[0] = b0.x; mk[1] = b0.y; mk[2] = b0.z; mk[3] = b0.w; mk[4] = b1.x; mk[5] = b1.y; mk[6] = b1.z; mk[7] = b1.w;
          qk[0] = c0_.x; qk[1] = c0_.y; qk[2] = c0_.z; qk[3] = c0_.w; qk[4] = c1_.x; qk[5] = c1_.y; qk[6] = c1_.z; qk[7] = c1_.w;
          qa[0] = d0.x; qa[1] = d0.y; qa[2] = d0.z; qa[3] = d0.w; qa[4] = d1.x; qa[5] = d1.y; qa[6] = d1.z; qa[7] = d1.w; }
        if (WITH_Y) { const f32x4 e0 = *(const f32x4*)(in.r_k + cc), e1 = *(const f32x4*)(in.r_k + cc + 4); qr[0] = e0.x; qr[1] = e0.y; qr[2] = e0.z; qr[3] = e0.w; qr[4] = e1.x; qr[5] = e1.y; qr[6] = e1.z; qr[7] = e1.w; }
        float oA[8], oR[8], oB[8], oK[8], oBH[8], oKH[8];
#pragma unroll
        for (int e = 0; e < 8; ++e) {
            const float r = rc[e] + ((first ? 0.f : rp[e]) - rc[e]) * mr[e]; const float zk = kc[e] + ((first ? 0.f : kp[e]) - kc[e]) * mk[e];
            const float kq = zk * (1.f + (av[e] - 1.f) * qa[e]); const float kk = zk * qk[e] * inv; const float b = kk * av[e];
            const float Lg = rowscan16(lw[e]); const float eLg = __builtin_amdgcn_exp2f(1.4426950408889634f * Lg); const float enLg = __builtin_amdgcn_rcpf(eLg);
            const float eLgm = __builtin_bit_cast(float, __builtin_amdgcn_update_dpp(0x3f800000, __builtin_bit_cast(int, eLg), 0x111, 0xf, 0xf, false));
            const float eC = __builtin_bit_cast(float, __builtin_amdgcn_ds_bpermute(((lane & 48) | 15) << 2, __builtin_bit_cast(int, eLg)));
            oA[e] = -kk * eLgm; oR[e] = r * eLg; oB[e] = b * enLg; oK[e] = kq * enLg; oBH[e] = oB[e] * eC; oKH[e] = oK[e] * eC;
            if (WITH_Y) btacc += r * kq * qr[e];
            if (t == 15) gct[16 * jq + 8 * hf + e] = eC;
        }
        const int wo = t * CS_RS + (16 * jq + 8 * hf) * 2;
        *(LAS u32x4*)(wl + IM_A * CS_IMG + wo) = pack8(oA); *(LAS u32x4*)(wl + IM_R * CS_IMG + wo) = pack8(oR); *(LAS u32x4*)(wl + IM_B * CS_IMG + wo) = pack8(oB);
        *(LAS u32x4*)(wl + IM_K * CS_IMG + wo) = pack8(oK); *(LAS u32x4*)(wl + IM_BH * CS_IMG + wo) = pack8(oBH); *(LAS u32x4*)(wl + IM_KH * CS_IMG + wo) = pack8(oKH);
        if (USE_V) { float vc[8], vp[8], o[8]; unpack8(Lvc[hf], vc); unpack8(Lvp[hf], vp);
            const f32x4 a0 = *(const f32x4*)(in.mu + 1024 + cc), a1 = *(const f32x4*)(in.mu + 1024 + cc + 4); const float mv[8] = {a0.x, a0.y, a0.z, a0.w, a1.x, a1.y, a1.z, a1.w};
#pragma unroll
            for (int e = 0; e < 8; ++e) o[e] = vc[e] + ((first ? 0.f : vp[e]) - vc[e]) * mv[e];
            *(LAS u32x4*)(wl + IM_V * CS_IMG + wo) = pack8(o); }
        if (WITH_Y) *(LAS u32x4*)(wl + IM_G * CS_IMG + wo) = Lgg;
    }
    if (WITH_Y) { btacc = xsum_16_32(btacc); if (lane < 16) btt[lane] = btacc; }
}
template <bool USE_V, bool WITH_Y>
__device__ __forceinline__ void cs_step(f32x16 (&Z)[2][2], f32x16 (&D)[2], LAS unsigned char* wl, int lane) {
    const int hi = lane >> 5, row = lane & 15; const bool up = (lane & 16) != 0;
    const LAS unsigned char* rpAR = wl + (up ? IM_R : IM_A) * CS_IMG + row * CS_RS; const LAS unsigned char* rpBK = wl + (up ? IM_K : IM_B) * CS_IMG + row * CS_RS;
    bf16x8 fAR[4];
#pragma unroll
    for (int ks = 0; ks < 4; ++ks) fAR[ks] = cs_rowfrag(rpAR, hi, ks);
    f32x16 F1 = {}, F2 = {};
#pragma unroll
    for (int ks = 0; ks < 4; ++ks) { const bf16x8 fBK = cs_rowfrag(rpBK, hi, ks);
        F1 = __builtin_amdgcn_mfma_f32_32x32x16_bf16(fBK, fAR[ks], F1, 0, 0, 0);
        F2 = __builtin_amdgcn_mfma_f32_32x32x16_bf16(fAR[ks], fBK, F2, 0, 0, 0); }
#pragma unroll
    for (int q = 0; q < 8; ++q) { const int s = crow8(q, hi); const bool k1 = up ? (s <= row) : (s < row);
        F1[q] = k1 ? F1[q] : 0.f; F1[8 + q] = k1 ? F1[8 + q] : 0.f; F2[q] = (!up && row < s) ? F2[q] : 0.f; }
    const bf16x8 f1lo = packp(F1, 0);
    const bf16x8 aL1 = up ? cs_zero8() : f1lo;
    const bf16x8 aMb = up ? f1lo : cs_zero8();
    const bf16x8 aLkMk = packp(F1, 1);
    const bf16x8 p2 = packp(F2, 0);
    const f32x16 z16 = {};
    const f32x16 Q1 = __builtin_amdgcn_mfma_f32_32x32x16_bf16(p2, aL1, z16, 0, 0, 0), Q2 = __builtin_amdgcn_mfma_f32_32x32x16_bf16(aL1, p2, z16, 0, 0, 0);
    const bf16x8 aL2 = packp(Q1, 0), p2b = packp(Q2, 0);
    const f32x16 R1 = __builtin_amdgcn_mfma_f32_32x32x16_bf16(p2b, aL2, z16, 0, 0, 0), R2 = __builtin_amdgcn_mfma_f32_32x32x16_bf16(aL2, p2b, z16, 0, 0, 0);
    const bf16x8 aL4 = packp(R1, 0), p2c = packp(R2, 0);
    const f32x16 S1 = __builtin_amdgcn_mfma_f32_32x32x16_bf16(p2c, aL4, z16, 0, 0, 0);
    const bf16x8 aL8 = packp(S1, 0);
    bf16x8 vf[2];
    if (USE_V) { vf[0] = cs_trfrag(wl + IM_V * CS_IMG, 0, lane); vf[1] = cs_trfrag(wl + IM_V * CS_IMG, 1, lane); }
#pragma unroll
    for (int nb = 0; nb < 2; ++nb) { f32x16 d = {};
#pragma unroll
        for (int jb = 0; jb < 2; ++jb)
#pragma unroll
            for (int k2 = 0; k2 < 2; ++k2) d = __builtin_amdgcn_mfma_f32_32x32x16_bf16(fAR[2 * jb + k2], packp(Z[jb][nb], k2), d, 0, 0, 0);
        if (USE_V) d = __builtin_amdgcn_mfma_f32_32x32x16_bf16(aLkMk, vf[nb], d, 0, 0, 0);
        D[nb] = d; }
#pragma unroll
    for (int nb = 0; nb < 2; ++nb) {
        D[nb] = __builtin_amdgcn_mfma_f32_32x32x16_bf16(aL8, packp(D[nb], 0), D[nb], 0, 0, 0);
        D[nb] = __builtin_amdgcn_mfma_f32_32x32x16_bf16(aL4, packp(D[nb], 0), D[nb], 0, 0, 0);
        D[nb] = __builtin_amdgcn_mfma_f32_32x32x16_bf16(aL2, packp(D[nb], 0), D[nb], 0, 0, 0);
        D[nb] = __builtin_amdgcn_mfma_f32_32x32x16_bf16(aL1, packp(D[nb], 0), D[nb], 0, 0, 0);
    }
    const bf16x8 u0 = packp(D[0], 0), u1 = packp(D[1], 0);
    if (WITH_Y) { D[0] = __builtin_amdgcn_mfma_f32_32x32x16_bf16(aMb, u0, D[0], 0, 0, 0); D[1] = __builtin_amdgcn_mfma_f32_32x32x16_bf16(aMb, u1, D[1], 0, 0, 0); }
    const LAS float* gct = (const LAS float*)(wl + 8 * CS_IMG);
#pragma unroll
    for (int jb = 0; jb < 2; ++jb) {
        const bf16x8 fb = cs_trfrag(wl + IM_BH * CS_IMG, jb, lane); bf16x8 fk = cs_zero8(); if (USE_V) fk = cs_trfrag(wl + IM_KH * CS_IMG, jb, lane);
        float gc[16];
#pragma unroll
        for (int g4 = 0; g4 < 4; ++g4) { const f32x4 x = *(const LAS f32x4*)(gct + 32 * jb + 8 * g4 + 4 * hi); gc[4 * g4] = x.x; gc[4 * g4 + 1] = x.y; gc[4 * g4 + 2] = x.z; gc[4 * g4 + 3] = x.w; }
#pragma unroll
        for (int nb = 0; nb < 2; ++nb) { f32x16 z = Z[jb][nb];
#pragma unroll
            for (int q = 0; q < 16; ++q) z[q] *= gc[q];
            z = __builtin_amdgcn_mfma_f32_32x32x16_bf16(fb, nb == 0 ? u0 : u1, z, 0, 0, 0);
            if (USE_V) z = __builtin_amdgcn_mfma_f32_32x32x16_bf16(fk, vf[nb], z, 0, 0, 0);
            Z[jb][nb] = z; }
    }
}
template <int PART>
__device__ __forceinline__ void p_cs_a_part(const Frame& F, ArgsP a) {
    const int lane = lane_id_fresh();
    LAS unsigned char* wl = F.lds + F.wave * CS_WAVE;
    CsIn in{(const bf16*)(F.ws + WS_ZR), (const bf16*)(F.ws + WS_A), (const bf16*)(F.ws + WS_LW), (const bf16*)(F.dob + DO_G), a->in[I_MU], a->in[I_KK], a->in[I_KA], a->in[I_RK]};
    bf16* Pm = (bf16*)(F.dob + DO_CSP); bf16* Gf = (bf16*)(F.dob + DO_CSG);
    const int hi = lane >> 5;
    for (int uc = F.gw; uc < 64 * CS_NCH; uc += F.NGW) {
        const int bh = uc / CS_NCH, c = uc % CS_NCH, b = bh >> 3, h = bh & 7; const size_t row0 = (size_t)b * SEQ;
        f32x16 Z[2][2], D[2];
#pragma unroll
        for (int jb = 0; jb < 2; ++jb)
#pragma unroll
            for (int nb = 0; nb < 2; ++nb) { f32x16 z = {};
                if (PART == 0 && jb == nb) {
#pragma unroll
                    for (int q = 0; q < 16; ++q) z[q] = (crow(q, hi) == (lane & 31)) ? 1.f : 0.f; }
                Z[jb][nb] = z; }
        for (int sc = 0; sc < CS_CH / 16; ++sc) { int ln = lane; asm volatile("" : "+v"(ln));
            cs_prep<PART == 1, false>(in, row0, c * CS_CH + sc * 16, h, wl, ln); asm volatile("s_waitcnt lgkmcnt(0)" ::: "memory"); cs_step<PART == 1, false>(Z, D, wl, ln); asm volatile("s_waitcnt lgkmcnt(0)" ::: "memory"); }
        int lo_ = lane; asm volatile("" : "+v"(lo_)); const int hi_o = lo_ >> 5;
        if (PART == 0) {
            LAS unsigned short* tb = (LAS unsigned short*)(wl + 4 * hi_o * CS_RS + (lo_ & 31) * 2);
#pragma unroll
            for (int jb = 0; jb < 2; ++jb)
#pragma unroll
                for (int nb = 0; nb < 2; ++nb)
#pragma unroll
                    for (int q = 0; q < 16; ++q) tb[((32 * jb + (q & 3) + 8 * (q >> 2)) * CS_RS + 64 * nb) / 2] = (unsigned short)f2bf(Z[jb][nb][q]);
            bf16* dst = Pm + (size_t)uc * 4096;
#pragma unroll
            for (int i = 0; i < 8; ++i) { const int ch = lo_ + 64 * i, rr = ch >> 3, c8 = (ch & 7) * 8; *(u32x4*)(dst + rr * 64 + c8) = *(const LAS u32x4*)(wl + rr * CS_RS + c8 * 2); }
        } else {
            bf16* dst = Gf + (size_t)uc * 4096;
#pragma unroll
            for (int jb = 0; jb < 2; ++jb)
#pragma unroll
                for (int nb = 0; nb < 2; ++nb) { u32x4 w0, w1; const f32x16& z = Z[jb][nb];
                    w0.x = pk2(z[0], z[1]); w0.y = pk2(z[2], z[3]); w0.z = pk2(z[4], z[5]); w0.w = pk2(z[6], z[7]); w1.x = pk2(z[8], z[9]); w1.y = pk2(z[10], z[11]); w1.z = pk2(z[12], z[13]); w1.w = pk2(z[14], z[15]);
                    u32x4* p = (u32x4*)(dst + ((jb * 2 + nb) * 64 + lo_) * 16); p[0] = w0; p[1] = w1; }
        }
    }
}
struct CsB { u32x2 p[2][2][2][2]; u32x4 g[2][2]; };
__device__ __forceinline__ void csb_load(CsB& X, const bf16* Pm, const bf16* Gf, size_t uc, int nb, int lane) {
    const int hi = lane >> 5, r = lane & 31; const bf16* Pc = Pm + uc * 4096;
#pragma unroll
    for (int mb = 0; mb < 2; ++mb) {
#pragma unroll
        for (int jb = 0; jb < 2; ++jb)
#pragma unroll
            for (int k2 = 0; k2 < 2; ++k2) { const bf16* pr = Pc + (32 * mb + r) * 64 + 32 * jb + 16 * k2 + 4 * hi; X.p[mb][jb][k2][0] = *(const u32x2*)pr; X.p[mb][jb][k2][1] = *(const u32x2*)(pr + 8); }
        const u32x4* gp = (const u32x4*)(Gf + uc * 4096 + ((mb * 2 + nb) * 64 + lane) * 16); X.g[mb][0] = gp[0]; X.g[mb][1] = gp[1]; }
}
__device__ __forceinline__ void csb_step(f32x16 (&Z)[2], const CsB& X, bf16* Zf, size_t uc, int nb, int lane) {
#pragma unroll
    for (int jb = 0; jb < 2; ++jb) { u32x4 w0, w1; const f32x16& z = Z[jb];
        w0.x = pk2(z[0], z[1]); w0.y = pk2(z[2], z[3]); w0.z = pk2(z[4], z[5]); w0.w = pk2(z[6], z[7]); w1.x = pk2(z[8], z[9]); w1.y = pk2(z[10], z[11]); w1.z = pk2(z[12], z[13]); w1.w = pk2(z[14], z[15]);
        u32x4* p = (u32x4*)(Zf + uc * 4096 + ((jb * 2 + nb) * 64 + lane) * 16); p[0] = w0; p[1] = w1; }
    f32x16 N[2];
#pragma unroll
    for (int mb = 0; mb < 2; ++mb) { float g0[8], g1[8]; unpack8(X.g[mb][0], g0); unpack8(X.g[mb][1], g1);
#pragma unroll
        for (int q = 0; q < 8; ++q) { N[mb][q] = g0[q]; N[mb][8 + q] = g1[q]; } }
#pragma unroll
    for (int jb = 0; jb < 2; ++jb)
#pragma unroll
        for (int k2 = 0; k2 < 2; ++k2) { const bf16x8 zb = packp(Z[jb], k2);
#pragma unroll
            for (int mb = 0; mb < 2; ++mb) { const u32x2 x0 = X.p[mb][jb][k2][0], x1 = X.p[mb][jb][k2][1];
                N[mb] = __builtin_amdgcn_mfma_f32_32x32x16_bf16(__builtin_bit_cast(bf16x8, (u32x4){x0.x, x0.y, x1.x, x1.y}), zb, N[mb], 0, 0, 0); } }
    Z[0] = N[0]; Z[1] = N[1];
}
__device__ __forceinline__ void p_cs_b(const Frame& F) {
    const int lane = lane_id_fresh();
    const bf16* Pm = (const bf16*)(F.dob + DO_CSP); const bf16* Gf = (const bf16*)(F.dob + DO_CSG); bf16* Zf = (bf16*)(F.dob + DO_CSZ);
    for (int u16 = F.gw; u16 < 128 * 16; u16 += F.NGW) {
        if (u16 & 15) continue;
        const int u = u16 >> 4, bh = u >> 1, nb = u & 1; const size_t uc0 = (size_t)bh * CS_NCH;
        f32x16 Z[2] = {};
        CsB X0, X1;
        csb_load(X0, Pm, Gf, uc0, nb, lane);
        for (int c = 0; c < CS_NCH; c += 2) {
            csb_load(X1, Pm, Gf, uc0 + c + 1, nb, lane);
            csb_step(Z, X0, Zf, uc0 + c, nb, lane);
            csb_load(X0, Pm, Gf, uc0 + (c + 2 < CS_NCH ? c + 2 : CS_NCH - 1), nb, lane);
            csb_step(Z, X1, Zf, uc0 + c + 1, nb, lane);
        }
    }
}
__device__ __forceinline__ void p_cs_c(const Frame& F, ArgsP a) {
    const int lane = lane_id_fresh(), hi = lane >> 5;
    LAS unsigned char* wl = F.lds + F.wave * CS_WAVE;
    CsIn in{(const bf16*)(F.ws + WS_ZR), (const bf16*)(F.ws + WS_A), (const bf16*)(F.ws + WS_LW), (const bf16*)(F.dob + DO_G), a->in[I_MU], a->in[I_KK], a->in[I_KA], a->in[I_RK]};
    const bf16* Zf = (const bf16*)(F.dob + DO_CSZ); bf16* Y = (bf16*)(F.ws + WS_Y); const float* lnw = a->in[I_LNW]; const float* lnb = a->in[I_LNB];
    const LAS float* btt = (const LAS float*)(wl + 8 * CS_IMG) + 64;
    for (int uc = F.gw; uc < 64 * CS_NCH; uc += F.NGW) {
        const int bh = uc / CS_NCH, c = uc % CS_NCH, b = bh >> 3, h = bh & 7; const size_t row0 = (size_t)b * SEQ;
        f32x16 Z[2][2], D[2];
        int lu = lane; asm volatile("" : "+v"(lu));
#pragma unroll
        for (int jb = 0; jb < 2; ++jb)
#pragma unroll
            for (int nb = 0; nb < 2; ++nb) { const u32x4* p = (const u32x4*)(Zf + (size_t)uc * 4096 + ((jb * 2 + nb) * 64 + lu) * 16); float g0[8], g1[8]; unpack8(p[0], g0); unpack8(p[1], g1);
#pragma unroll
                for (int q = 0; q < 8; ++q) { Z[jb][nb][q] = g0[q]; Z[jb][nb][8 + q] = g1[q]; } }
        const float lw0 = lnw[h * 64 + (lu & 31)], lw1 = lnw[h * 64 + 32 + (lu & 31)], lb0 = lnb[h * 64 + (lu & 31)], lb1 = lnb[h * 64 + 32 + (lu & 31)];
        for (int sc = 0; sc < CS_CH / 16; ++sc) {
            const int tok0 = c * CS_CH + sc * 16;
            int ln = lane; asm volatile("" : "+v"(ln));
            cs_prep<true, true>(in, row0, tok0, h, wl, ln); asm volatile("s_waitcnt lgkmcnt(0)" ::: "memory");
            cs_step<true, true>(Z, D, wl, ln); asm volatile("s_waitcnt lgkmcnt(0)" ::: "memory");
            const int hl = ln >> 5;
            const bf16x8 v0 = cs_trfrag(wl + IM_V * CS_IMG, 0, ln), v1 = cs_trfrag(wl + IM_V * CS_IMG, 1, ln), g0 = cs_trfrag(wl + IM_G * CS_IMG, 0, ln), g1 = cs_trfrag(wl + IM_G * CS_IMG, 1, ln);
            const f32x4 bta = *(const LAS f32x4*)(btt + 4 * hl), btb = *(const LAS f32x4*)(btt + 8 + 4 * hl); const float bt[8] = {bta.x, bta.y, bta.z, bta.w, btb.x, btb.y, btb.z, btb.w};
#pragma unroll
            for (int q = 0; q < 8; ++q) {
                const float y0 = D[0][8 + q], y1 = D[1][8 + q];
                const float mean = allsum32(y0 + y1) * (1.f / 64.f); const float d0 = y0 - mean, d1 = y1 - mean;
                const float rstd = 1.0f / sqrtf(allsum32(d0 * d0 + d1 * d1) * (1.f / 64.f) + LN_X_EPS);
                const float o0 = (d0 * rstd * lw0 + lb0 + bt[q] * bf2f((unsigned short)v0[q])) * bf2f((unsigned short)g0[q]);
                const float o1 = (d1 * rstd * lw1 + lb1 + bt[q] * bf2f((unsigned short)v1[q])) * bf2f((unsigned short)g1[q]);
                bf16* yp = Y + (row0 + tok0 + crow8(q, hl)) * 512 + h * 64 + (ln & 31);
                yp[0] = (unsigned short)f2bf(o0); yp[32] = (unsigned short)f2bf(o1);
            }
            asm volatile("s_waitcnt lgkmcnt(0)" ::: "memory");
        }
    }
}

__device__ __forceinline__ void p_post_scan(const Frame& F, ArgsP a, bf16* YD) {
    const int lane_f = lane_id_fresh();
    bf16* Y = (bf16*)(F.ws + WS_Y); const bf16* ZR = (const bf16*)(F.ws + WS_ZR); const bf16* A = (const bf16*)(F.ws + WS_A); const bf16* G = (const bf16*)(F.dob + DO_G);
    const float* lnw = a->in[I_LNW]; const float* lnb = a->in[I_LNB]; const float* rk = a->in[I_RK]; const float* mu = a->in[I_MU]; const float* k_a = a->in[I_KA];
    const int lane = lane_f;
    for (int m = F.gw; m < NTOK; m += F.NGW) {
        const bool first = (m % SEQ) == 0; const size_t mp = first ? m : m - 1;
        float y[8], r[8], k[8], v[8], g[8], o[8], t[8], av[8];
        unpack8(*((const u32x4*)(Y + (size_t)m * 512) + lane), y); unpack8(*((const u32x4*)(G + (size_t)m * 512) + lane), g); unpack8(*((const u32x4*)(A + (size_t)m * 512) + lane), av);
        unpack8(*((const u32x4*)(ZR + (size_t)m * 1792) + lane), r); unpack8(*((const u32x4*)(ZR + mp * 1792) + lane), t);
#pragma unroll
        for (int i = 0; i < 8; ++i) r[i] += ((first ? 0.f : t[i]) - r[i]) * mu[8 * lane + i];
        unpack8(*((const u32x4*)(ZR + (size_t)m * 1792 + 512) + lane), k); unpack8(*((const u32x4*)(ZR + mp * 1792 + 512) + lane), t);
#pragma unroll
        for (int i = 0; i < 8; ++i) { const float zk = k[i] + ((first ? 0.f : t[i]) - k[i]) * mu[512 + 8 * lane + i]; k[i] = zk * (1.f + (av[i] - 1.f) * k_a[8 * lane + i]); }
        unpack8(*((const u32x4*)(ZR + (size_t)m * 1792 + 1024) + lane), v); unpack8(*((const u32x4*)(ZR + mp * 1792 + 1024) + lane), t);
#pragma unroll
        for (int i = 0; i < 8; ++i) v[i] += ((first ? 0.f : t[i]) - v[i]) * mu[1024 + 8 * lane + i];
        float s = 0.f, d = 0.f;
#pragma unroll
        for (int i = 0; i < 8; ++i) { s += y[i]; d += r[i] * k[i] * rk[8 * lane + i]; }
        const float mean = sum8(s) * (1.f / 64.f); d = sum8(d); float q = 0.f;
#pragma unroll
        for (int i = 0; i < 8; ++i) { y[i] -= mean; q += y[i] * y[i]; }
        const float rstd = 1.0f / sqrtf(sum8(q) * (1.f / 64.f) + LN_X_EPS);
#pragma unroll
        for (int i = 0; i < 8; ++i) o[i] = (y[i] * rstd * lnw[8 * lane + i] + lnb[8 * lane + i] + d * v[i]) * g[i];
        *((u32x4*)(YD + (size_t)m * 512) + lane) = pack8(o);
    }
}

__device__ __forceinline__ void p_ffn_route(const Frame& F, ArgsP a, unsigned* cnt, int* route) {
    const int lane_f = lane_id_fresh(), tid_f = F.wave * 64 + lane_f;
    const float* X1 = (const float*)F.dob; bf16* H2 = (bf16*)(F.ws + WS_H2); const float* mod = (const float*)(F.ws + WS_MOD); const float* g = a->in[I_GFFN];
    LAS float* wr = (LAS float*)F.lds;
    __syncthreads();
    for (int i = tid_f; i < 1024 * 4; i += NTHR) { const int k = i >> 2, o = i & 3; wr[o * 1024 + k] = a->in[I_WRG][i]; }
    for (int i = tid_f; i < 1024 * 32; i += NTHR) { const int k = i >> 5, o = i & 31; wr[(4 + o) * 1024 + k] = a->in[I_WRE][i]; }
    __syncthreads();
    const float* brg = a->in[I_BRG]; const float* bre = a->in[I_BRE];
    const int lane = lane_f;
    LAS unsigned* lcnt = (LAS unsigned*)(F.lds + LDS_MISC + 512);
    if (tid_f < 64) lcnt[tid_f] = 0u;
    __syncthreads();
    int my_e0 = 0, my_e1 = 0; float my_w0 = 0.f, my_w1 = 0.f; int kk_ = 0;
    for (int m = F.gw; m < NTOK; m += F.NGW, ++kk_) {
        const int b = m / SEQ; const f32x4* xr = (const f32x4*)(X1 + (size_t)m * 1024) + lane;
        f32x4 v[4]; float s = 0.f;
#pragma unroll
        for (int j = 0; j < 4; ++j) { v[j] = xr[64 * j]; s += (v[j].x * v[j].x + v[j].y * v[j].y) + (v[j].z * v[j].z + v[j].w * v[j].w); }
        const float rstd = 1.0f / sqrtf(wave_sum(s) * (1.f / 1024.f) + EPS);
        u32x2* o = (u32x2*)(H2 + (size_t)m * 1024) + lane;
#pragma unroll
        for (int j = 0; j < 4; ++j) { const int col = 4 * lane + 256 * j;
            const f32x4 gg = *(const f32x4*)(g + col), sc = *(const f32x4*)(mod + b * 6144 + 4096 + col), sh = *(const f32x4*)(mod + b * 6144 + 3072 + col);
            v[j] = v[j] * rstd * gg * (sc + 1.0f) + sh; u32x2 w; w.x = pk2(v[j].x, v[j].y); w.y = pk2(v[j].z, v[j].w); o[64 * j] = w; }
        float lgq[4];
#pragma unroll
        for (int oo = 0; oo < 4; ++oo) { float p = 0.f;
#pragma unroll
            for (int j = 0; j < 4; ++j) { const f32x4 w4 = *(const LAS f32x4*)(wr + oo * 1024 + 4 * lane + 256 * j); p += (v[j].x * w4.x + v[j].y * w4.y) + (v[j].z * w4.z + v[j].w * w4.w); }
            lgq[oo] = wave_sum(p) + brg[oo]; }
        int gi = 0; float gm = lgq[0];
#pragma unroll
        for (int i = 1; i < 4; ++i) { if (lgq[i] > gm) { gm = lgq[i]; gi = i; } }
        float gs = 0.f;
#pragma unroll
        for (int i = 0; i < 4; ++i) gs += __expf(lgq[i] - gm);
        const float pg = 1.f / gs;
        gi = __builtin_amdgcn_readfirstlane(gi);
        float el[8];
        { const LAS float* wg = wr + (4 + gi * 8) * 1024 + 4 * lane;
#pragma unroll
          for (int i = 0; i < 8; ++i) { float p = 0.f;
#pragma unroll
              for (int j = 0; j < 4; ++j) { const f32x4 w4 = *(const LAS f32x4*)(wg + i * 1024 + 256 * j); p += (v[j].x * w4.x + v[j].y * w4.y) + (v[j].z * w4.z + v[j].w * w4.w); }
              el[i] = wave_sum(p) + bre[gi * 8 + i]; } }
        int i0 = 0; float m0 = el[0];
#pragma unroll
        for (int i = 1; i < 8; ++i) if (el[i] > m0) { m0 = el[i]; i0 = i; }
        int i1 = -1; float m1 = -INFINITY;
#pragma unroll
        for (int i = 0; i < 8; ++i) if (i != i0 && el[i] > m1) { m1 = el[i]; i1 = i; }
        const float e1 = __expf(m1 - m0), w0 = pg / (1.f + e1), w1 = pg * e1 / (1.f + e1);
        if (lane == kk_) { my_e0 = gi * 8 + i0; my_e1 = gi * 8 + i1; my_w0 = w0; my_w1 = w1; }
    }
    unsigned lp0 = 0u, lp1 = 0u;
    if (lane < kk_) { lp0 = __hip_atomic_fetch_add(lcnt + my_e0, 1u, __ATOMIC_RELAXED, __HIP_MEMORY_SCOPE_WORKGROUP); lp1 = __hip_atomic_fetch_add(lcnt + my_e1, 1u, __ATOMIC_RELAXED, __HIP_MEMORY_SCOPE_WORKGROUP); }
    __syncthreads();
    if (tid_f < 32) lcnt[32 + tid_f] = __hip_atomic_fetch_add(cnt + tid_f, lcnt[tid_f], __ATOMIC_RELAXED, __HIP_MEMORY_SCOPE_AGENT);
    __syncthreads();
    if (lane < kk_) { const int m = F.gw + lane * F.NGW; int* rt = route + (size_t)m * 8;
        rt[0] = my_e0; rt[1] = my_e1; rt[2] = (int)(lcnt[32 + my_e0] + lp0); rt[3] = (int)(lcnt[32 + my_e1] + lp1); rt[4] = __builtin_bit_cast(int, my_w0); rt[5] = __builtin_bit_cast(int, my_w1); }
    __syncthreads();
}
__device__ __forceinline__ int moe_tables(const Frame& F, LAS int* offs, LAS int* texp) {
    const int lane_f = lane_id_fresh(), tid_f = F.wave * 64 + lane_f;
    const unsigned* cnt = (const unsigned*)(F.ws + WS_CTL) + CW_CNT;
    __syncthreads();
    if (tid_f == 0) { int o = 0; for (int e = 0; e < 32; ++e) { offs[e] = o; const int c = (int)__hip_atomic_load(cnt + e, __ATOMIC_RELAXED, __HIP_MEMORY_SCOPE_AGENT); const int nt = (c + 255) >> 8; for (int t = 0; t < nt; ++t) texp[(o >> 8) + t] = e; o += nt << 8; } offs[32] = o; }
    __syncthreads();
    return offs[32] >> 8;
}
__device__ __forceinline__ void p_gather(const Frame& F) {
    const int lane_f = lane_id_fresh(), tid_f = F.wave * 64 + lane_f;
    LAS int* offs = (LAS int*)(F.lds + 1024); LAS int* texp = (LAS int*)(F.lds + 2048);
    moe_tables(F, offs, texp);
    const bf16* H2 = (const bf16*)(F.ws + WS_H2); bf16* XG = (bf16*)(F.ws + WS_XG); const int* route = (const int*)(F.ws + WS_ROUTE); int* ent = (int*)(F.ws + WS_ENT);
    const unsigned* cnt = (const unsigned*)(F.ws + WS_CTL) + CW_CNT; const int lane = lane_f;
    for (int m = F.gw; m < NTOK; m += F.NGW) {
        const int* rt = route + (size_t)m * 8; const int d0 = offs[rt[0]] + rt[2], d1 = offs[rt[1]] + rt[3];
        const u32x4* src = (const u32x4*)(H2 + (size_t)m * 1024) + lane; const u32x4 a0 = src[0], a1 = src[64];
        u32x4* p0 = (u32x4*)(XG + (size_t)d0 * 1024) + lane; u32x4* p1 = (u32x4*)(XG + (size_t)d1 * 1024) + lane;
        p0[0] = a0; p0[64] = a1; p1[0] = a0; p1[64] = a1;
        if (lane == 0) { ent[2 * d0] = m; ent[2 * d0 + 1] = rt[4]; ent[2 * d1] = m; ent[2 * d1 + 1] = rt[5]; }
    }
    for (int i = F.gw; i < 32 * 256; i += F.NGW) { const int e = i >> 8, r = i & 255; const int c = (int)cnt[e]; const int pad = ((c + 255) & ~255) - c;
        if (r < pad) { u32x4* p = (u32x4*)(XG + (size_t)(offs[e] + c + r) * 1024) + lane; p[0] = (u32x4){0u, 0u, 0u, 0u}; p[64] = (u32x4){0u, 0u, 0u, 0u}; if (lane == 0) { ent[2 * (offs[e] + c + r)] = -1; ent[2 * (offs[e] + c + r) + 1] = 0; } } }
    __syncthreads();
}
__device__ __forceinline__ void p_combine(const Frame& F, float* dst) {
    const int lane_f = lane_id_fresh(), tid_f = F.wave * 64 + lane_f;
    LAS int* offs = (LAS int*)(F.lds + 1024); LAS int* texp = (LAS int*)(F.lds + 2048);
    moe_tables(F, offs, texp);
    float* out = (float*)F.dob; const bf16* YS = (const bf16*)(F.ws + WS_YS); const int* route = (const int*)(F.ws + WS_ROUTE); const float* mod = (const float*)(F.ws + WS_MOD);
    const int lane = lane_f;
    for (int m = F.gw; m < NTOK; m += F.NGW) {
        const int b = m / SEQ; const int* rt = route + (size_t)m * 8; const int d0 = offs[rt[0]] + rt[2], d1 = offs[rt[1]] + rt[3];
        const float w0 = __builtin_bit_cast(float, rt[4]), w1 = __builtin_bit_cast(float, rt[5]);
#pragma unroll
        for (int j = 0; j < 2; ++j) { const int col = 8 * lane + 512 * j; float y0[8], y1[8];
            unpack8(*(const u32x4*)(YS + (size_t)d0 * 1024 + col), y0); unpack8(*(const u32x4*)(YS + (size_t)d1 * 1024 + col), y1);
            float* o = out + (size_t)m * 1024 + col; const float* gt = mod + b * 6144 + 5120 + col;
            f32x4 x0 = *(const f32x4*)o, x1 = *(const f32x4*)(o + 4); const f32x4 g0 = *(const f32x4*)gt, g1 = *(const f32x4*)(gt + 4);
            x0.x += g0.x * (w0 * y0[0] + w1 * y1[0]); x0.y += g0.y * (w0 * y0[1] + w1 * y1[1]); x0.z += g0.z * (w0 * y0[2] + w1 * y1[2]); x0.w += g0.w * (w0 * y0[3] + w1 * y1[3]);
            x1.x += g1.x * (w0 * y0[4] + w1 * y1[4]); x1.y += g1.y * (w0 * y0[5] + w1 * y1[5]); x1.z += g1.z * (w0 * y0[6] + w1 * y1[6]); x1.w += g1.w * (w0 * y0[7] + w1 * y1[7]);
            float* od = dst + (size_t)m * 1024 + col; *(f32x4*)od = x0; *(f32x4*)(od + 4) = x1; }
    }
}

constexpr int NPHASE = 17;
template <int LO, int HI>
__global__ void __launch_bounds__(NTHR, 2) fwd(Args args) {
    extern __shared__ __attribute__((aligned(16))) unsigned char lds_raw[];
    Frame F;
    F.lds = (LAS unsigned char*)lds_raw;
    F.wave = __builtin_amdgcn_readfirstlane((int)threadIdx.x >> 6);
    F.G = gridDim.x; { const int bx = blockIdx.x; F.vcu = (F.G % 8 == 0) ? (bx % 8) * (F.G / 8) + bx / 8 : bx; }
    F.gw = F.vcu * NWAVES + F.wave; F.NGW = F.G * NWAVES;
    F.ws = args.ws; F.dob = (unsigned char*)args.out;
    ArgsP AP = (ArgsP)__builtin_amdgcn_kernarg_segment_ptr();
    volatile LAS unsigned* MISC = (volatile LAS unsigned*)(F.lds + LDS_MISC);
    if (threadIdx.x < 64) MISC[threadIdx.x] = 0u;
    __syncthreads();
    XcdBarrier bar; bar.bar = (unsigned*)(F.ws + WS_CTL) + CW_BAR; bar.x = 0; bar.st = MISC + 8;
#if N_LAUNCH_MODE == 1
    bar = xcd_barrier_post((unsigned*)(F.ws + WS_CTL) + CW_BAR, MISC + 8);
#define GRID_BAR() xcd_barrier(bar)
#else
#define GRID_BAR() do { } while (0)
#endif
#ifndef PROBE_REPEAT
#define PROBE_REPEAT -1
#endif
#define IN(k) (LO <= (k) && (k) < HI)
#define SEAM(k) do { if constexpr (IN(k) && IN((k) + 1)) GRID_BAR(); } while (0)
    const float* mod = (const float*)(F.ws + WS_MOD);

#define PH(k, ...) do { if constexpr (IN(k)) { asm volatile("" : "+s"(AP)); { __VA_ARGS__ } if constexpr (PROBE_REPEAT == (k)) { GRID_BAR(); asm volatile("" : "+s"(AP)); { __VA_ARGS__ } } } } while (0)
    PH(0, p0_prologue(F, AP);); SEAM(0);
    PH(1, p_normmod(F, AP->in[I_X], AP->in[I_GMIX], mod, 0, 1024, (bf16*)(F.ws + WS_H));); SEAM(1);
    PH(2, Gemm g{(const bf16*)(F.ws + WS_H), (const bf16*)(F.ws + WS_WIN), NTOK, N_IN_PAD, 1024}; StaticOrder S; S.init(NTOK, N_IN_PAD, F.G, (int)blockIdx.x);
        EpiZ E{(bf16*)(F.ws + WS_ZR), (bf16*)(F.ws + WS_SG), (bf16*)(F.ws + WS_ZM)}; gemm_phase_any(F.lds, g, S, E, F.wave);); SEAM(2);
    PH(3, p_prep_a(F, AP);); SEAM(3);
    PH(4,
        { Gemm g{(const bf16*)(F.ws + WS_TWA), (const bf16*)(F.ws + WS_WBLK), NTOK, 1024, 128}; StaticOrder S; S.init(NTOK, 1024, F.G, (int)blockIdx.x);
          EpiLora E{(bf16*)(F.ws + WS_LW), (bf16*)(F.ws + WS_A), AP->in[I_W0], AP->in[I_A0]}; gemm_phase_any(F.lds, g, S, E, F.wave); }
        { Gemm g{(const bf16*)(F.ws + WS_SGL), (const bf16*)(F.ws + WS_WG), NTOK, 512, 128}; StaticOrder S; S.init(NTOK, 512, F.G, (int)blockIdx.x);
          EpiPlain E{(bf16*)(F.dob + DO_G), nullptr, 1 << 30, 512, 0}; gemm_phase_any(F.lds, g, S, E, F.wave); }
        { Gemm g{(const bf16*)(F.ws + WS_QA), (const bf16*)(F.ws + WS_WUQ), NTOK, 768, 256}; StaticOrder S; S.init(NTOK, 768, F.G, (int)blockIdx.x);
          EpiPlain E{(bf16*)(F.dob + DO_Q), nullptr, 1 << 30, 768, 0}; gemm_phase_any(F.lds, g, S, E, F.wave); }
        { Gemm g{(const bf16*)(F.ws + WS_KVA), (const bf16*)(F.ws + WS_WUKV), NTOK, 1024, 128}; StaticOrder S; S.init(NTOK, 1024, F.G, (int)blockIdx.x);
          EpiPlain E{(bf16*)(F.dob + DO_KN), (bf16*)(F.ws + WS_VC), 512, 512, 512}; gemm_phase_any(F.lds, g, S, E, F.wave); }
    ); SEAM(4);
    PH(5, p_prep_c(F, AP);); SEAM(5);
#if ENG_ATTN == 1
    PH(6, p_attn_mfma(F);); SEAM(6);
#else
    PH(6, p_attn_naive(F);); SEAM(6);
#endif
    PH(7, p_cs_a_part<0>(F, AP); p_cs_a_part<1>(F, AP);); SEAM(7);
    PH(8, p_cs_b(F);); SEAM(8);
    PH(9, p_cs_c(F, AP);); SEAM(9);
    PH(10,
        { Gemm g{(const bf16*)(F.ws + WS_Y), (const bf16*)(F.ws + WS_WB), NTOK, 1024, 512}; StaticOrder S; S.init(NTOK, 1024, F.G, (int)blockIdx.x);
          EpiBranch<false> E{(bf16*)(F.ws + WS_MG), (const bf16*)(F.ws + WS_SG), 0}; gemm_phase_any(F.lds, g, S, E, F.wave); }
        { Gemm g{(const bf16*)(F.ws + WS_YM), (const bf16*)(F.ws + WS_WB) + (size_t)1024 * 512, NTOK, 1024, 512}; StaticOrder S; S.init(NTOK, 1024, F.G, (int)blockIdx.x);
          EpiBranch<true> E{(bf16*)(F.ws + WS_MG), (const bf16*)(F.ws + WS_SG), 1024}; gemm_phase_any(F.lds, g, S, E, F.wave); }
    ); SEAM(10);
    PH(11, Gemm g{(const bf16*)(F.ws + WS_MG), (const bf16*)(F.ws + WS_WO), NTOK, 1024, 1024}; StaticOrder S; S.init(NTOK, 1024, F.G, (int)blockIdx.x);
        EpiOut E{(float*)F.dob, AP->in[I_X], mod}; gemm_phase_any(F.lds, g, S, E, F.wave);); SEAM(11);
    if constexpr (PROBE_REPEAT == 12) { p_ffn_route(F, AP, (unsigned*)(F.ws + WS_CTL) + CW_CNT + 64, (int*)(F.ws + WS_CS)); GRID_BAR(); }
    if constexpr (IN(12)) { asm volatile("" : "+s"(AP)); p_ffn_route(F, AP, (unsigned*)(F.ws + WS_CTL) + CW_CNT, (int*)(F.ws + WS_ROUTE)); } SEAM(12);
    PH(13, p_gather(F);); SEAM(13);
    PH(14, LAS int* offs = (LAS int*)(F.lds + LDS_MISC + 1024); LAS int* texp = (LAS int*)(F.lds + LDS_MISC + 1024 + 256); const int nt = moe_tables(F, offs, texp);
        Gemm g{(const bf16*)(F.ws + WS_XG), (const bf16*)(F.ws + WS_WGU), MPAD, 512, 1024}; TableOrder S{texp, nt, 2, F.G, (int)blockIdx.x};
        EpiGateUp E{(bf16*)(F.ws + WS_HID)}; gemm_phase_any(F.lds, g, S, E, F.wave);); SEAM(14);
    PH(15, LAS int* offs = (LAS int*)(F.lds + LDS_MISC + 1024); LAS int* texp = (LAS int*)(F.lds + LDS_MISC + 1024 + 256); const int nt = moe_tables(F, offs, texp);
        Gemm g{(const bf16*)(F.ws + WS_HID), (const bf16*)(F.ws + WS_WDN), MPAD, 1024, 256}; TableOrder S{texp, nt, 4, F.G, (int)blockIdx.x};
        EpiDown E{(bf16*)(F.ws + WS_YS)}; gemm_phase_any(F.lds, g, S, E, F.wave);); SEAM(15);
    if constexpr (PROBE_REPEAT == 16) { p_combine(F, (float*)(F.ws + WS_SG)); GRID_BAR(); }
    if constexpr (IN(16)) { p_combine(F, (float*)F.dob); }
}

#if N_LAUNCH_MODE == 1
static bool set_attrs() { return hipFuncSetAttribute((const void*)fwd<0, NPHASE>, hipFuncAttributeMaxDynamicSharedMemorySize, LDS_BYTES) == hipSuccess; }
#else
template <int P> static bool set_attr_all() { if constexpr (P < NPHASE) { return hipFuncSetAttribute((const void*)fwd<P, P + 1>, hipFuncAttributeMaxDynamicSharedMemorySize, LDS_BYTES) == hipSuccess && set_attr_all<P + 1>(); } else return true; }
static bool set_attrs() { return set_attr_all<0>(); }
template <int P> static void launch_all(int grid, hipStream_t stream, const Args& a) { if constexpr (P < NPHASE) { hipLaunchKernelGGL((fwd<P, P + 1>), dim3(grid), dim3(NTHR), LDS_BYTES, stream, a); launch_all<P + 1>(grid, stream, a); } }
#endif
extern "C" void kernel_launch(void* const* d_in, const int* in_sizes, int n_in, void* d_out, int out_size, void* d_ws, size_t ws_size, hipStream_t stream) {
    static int grid = 0;
    if (grid == 0) {
        if (n_in != 34 || out_size != NTOK * DM || ws_size < WS_END) { fprintf(stderr, "kernel_launch: unexpected shapes (n_in %d out %d ws %zu)\n", n_in, out_size, ws_size); grid = -1; return; }
        int dev = 0, cus = 0;
        if (hipGetDevice(&dev) != hipSuccess || hipDeviceGetAttribute(&cus, hipDeviceAttributeMultiprocessorCount, dev) != hipSuccess) { grid = -1; return; }
        if (!set_attrs()) { fprintf(stderr, "kernel_launch: hipFuncSetAttribute failed\n"); grid = -1; return; }
        grid = cus;
    }
    if (grid < 0) return;
    (void)hipMemsetAsync((char*)d_ws + WS_CTL, 0, CTL_ZERO_BYTES, stream);
    Args a{};
    for (int i = 0; i < 34; ++i) a.in[i] = (const float*)d_in[i];
    a.out = (float*)d_out; a.ws = (unsigned char*)d_ws;
    a.ph_lo = 0; a.ph_hi = NPHASE;
#if N_LAUNCH_MODE == 1
    hipLaunchKernelGGL((fwd<0, NPHASE>), dim3(grid), dim3(NTHR), LDS_BYTES, stream, a);
#else
    launch_all<0>(grid, stream, a);
#endif
}
```

```cpp
#include <hip/hip_runtime.h>
#include <cstdio>
#include <cstdint>

#ifndef N_LAUNCH_MODE
#define N_LAUNCH_MODE 1
#endif
#ifndef ENG_GEMM
#define ENG_GEMM 1
#endif
#ifndef ENG_ATTN
#define ENG_ATTN 1
#endif

#define GAS __attribute__((address_space(1)))
#define LAS __attribute__((address_space(3)))
typedef unsigned short bf16;
typedef float f32x4 __attribute__((ext_vector_type(4)));
typedef float f32x2 __attribute__((ext_vector_type(2)));
typedef unsigned u32x4 __attribute__((ext_vector_type(4)));
typedef unsigned u32x2 __attribute__((ext_vector_type(2)));
typedef short bf16x8 __attribute__((ext_vector_type(8)));

constexpr int BATCH = 8, SEQ = 8192, DM = 1024, NTOK = BATCH * SEQ;
constexpr int D_RWKV = 512, RWKV_COLS = 1792, MLA_COLS = 416, D_IN = 4256, N_IN_PAD = 4352;
constexpr int NH = 8, QKD = 96, NOPE = 64, ROPE = 32, VD = 64;
constexpr int NEXP = 32, DEXP = 256;
constexpr int MPAD = 139264;
constexpr float EPS = 1e-6f, LN_X_EPS = 64e-5f;
constexpr float QSCALE = 0.10206207261596577f * 1.4426950408889634f;

constexpr size_t MiB = 1u << 20;
constexpr size_t WS_CTL = 0, CTL_ZERO_BYTES = 1 * MiB;
constexpr size_t WS_MOD = 1 * MiB;
constexpr size_t WS_ROUTE = 2 * MiB;
constexpr size_t WS_CS = 4 * MiB;
constexpr size_t WS_ENT = 12 * MiB;
constexpr size_t WS_WIN = 16 * MiB;
constexpr size_t WS_WBLK = 25 * MiB;
constexpr size_t WS_WG = WS_WBLK + 256 * 1024;
constexpr size_t WS_WUQ = WS_WG + 128 * 1024;
constexpr size_t WS_WUKV = WS_WUQ + 384 * 1024;
constexpr size_t WS_WB = 26 * MiB;
constexpr size_t WS_WO = 28 * MiB;
constexpr size_t WS_WGU = 30 * MiB;
constexpr size_t WS_WDN = 62 * MiB;
constexpr size_t WS_SG = 80 * MiB;
constexpr size_t WS_H2 = 80 * MiB;
constexpr size_t WS_ZR = 336 * MiB;
constexpr size_t WS_VC = 752 * MiB;
constexpr size_t WS_KC = 816 * MiB;
constexpr size_t WS_Y = 912 * MiB;
constexpr size_t WS_XG = 336 * MiB;
constexpr size_t WS_ZM = 560 * MiB;
constexpr size_t WS_YM = 560 * MiB;
constexpr size_t WS_H = 624 * MiB;
constexpr size_t WS_LW = 624 * MiB;
constexpr size_t WS_A = 688 * MiB;
constexpr size_t WS_MG = 624 * MiB;
constexpr size_t WS_HID = 608 * MiB;
constexpr size_t WS_R = 752 * MiB;
constexpr size_t WS_V = 816 * MiB;
constexpr size_t WS_ZK = 880 * MiB;
constexpr size_t WS_TWA = 944 * MiB;
constexpr size_t WS_SGL = 960 * MiB;
constexpr size_t WS_QA = 976 * MiB;
constexpr size_t WS_KVA = 1008 * MiB;
constexpr size_t WS_KK = 944 * MiB;
constexpr size_t WS_YS = 752 * MiB;
constexpr size_t WS_END = 1024 * MiB;
constexpr size_t DO_G = 0;
constexpr size_t DO_Q = 64 * MiB;
constexpr size_t DO_KN = 160 * MiB;

constexpr int CW_CNT = 64;
constexpr int CW_BAR = 4096;

constexpr int NWAVES = 8, NTHR = 512;
constexpr int LDS_BYTES = 155648;
constexpr int LDS_MISC = 151552;

__device__ __forceinline__ int lane_id_fresh() { int l; asm volatile("v_mbcnt_lo_u32_b32 %0, -1, 0\n\tv_mbcnt_hi_u32_b32 %0, -1, %0" : "=v"(l)); return l; }
__device__ __forceinline__ float bf2f(unsigned short h) { return __builtin_bit_cast(float, (unsigned)h << 16); }
__device__ __forceinline__ unsigned f2bf(float f) { unsigned u = __builtin_bit_cast(unsigned, f); return (u + 0x7fffu + ((u >> 16) & 1u)) >> 16; }
typedef __bf16 bf16x2_t __attribute__((ext_vector_type(2)));
__device__ __forceinline__ unsigned pk2(float lo, float hi) { const f32x2 v = {lo, hi}; return __builtin_bit_cast(unsigned, __builtin_convertvector(v, bf16x2_t)); }
__device__ __forceinline__ float lo2f(unsigned w) { return __builtin_bit_cast(float, w << 16); }
__device__ __forceinline__ float hi2f(unsigned w) { return __builtin_bit_cast(float, w & 0xffff0000u); }
template <int CTRL> __device__ __forceinline__ float dpp_add(float x) { return x + __builtin_bit_cast(float, __builtin_amdgcn_update_dpp(0, __builtin_bit_cast(int, x), CTRL, 0xf, 0xf, false)); }
__device__ __forceinline__ float allsum16(float x) { x = dpp_add<0xB1>(x); x = dpp_add<0x4E>(x); x = dpp_add<0x141>(x); x = dpp_add<0x140>(x); return x; }
__device__ __forceinline__ float allsum32(float x) { x = allsum16(x); auto r = __builtin_amdgcn_permlane16_swap(__float_as_uint(x), __float_as_uint(x), false, false); return __uint_as_float(r[0]) + __uint_as_float(r[1]); }
__device__ __forceinline__ float sum8(float x) { x = dpp_add<0xB1>(x); x = dpp_add<0x4E>(x); x = dpp_add<0x141>(x); return x; }
__device__ __forceinline__ float wave_sum(float v) {
    v = allsum16(v);
    { auto r = __builtin_amdgcn_permlane16_swap(__float_as_uint(v), __float_as_uint(v), false, false); v = __uint_as_float(r[0]) + __uint_as_float(r[1]); }
    { auto r = __builtin_amdgcn_permlane32_swap(__float_as_uint(v), __float_as_uint(v), false, false); v = __uint_as_float(r[0]) + __uint_as_float(r[1]); }
    return v;
}
__device__ __forceinline__ float sigmoidf_(float x) { return __builtin_amdgcn_rcpf(1.f + __builtin_amdgcn_exp2f(-1.4426950408889634f * x)); }
__device__ __forceinline__ float siluf_(float x) { return x * __builtin_amdgcn_rcpf(1.f + __builtin_amdgcn_exp2f(-1.4426950408889634f * x)); }
__device__ __forceinline__ void unpack8(const u32x4 w, float (&v)[8]) {
    v[0] = lo2f(w.x); v[1] = hi2f(w.x); v[2] = lo2f(w.y); v[3] = hi2f(w.y); v[4] = lo2f(w.z); v[5] = hi2f(w.z); v[6] = lo2f(w.w); v[7] = hi2f(w.w);
}
__device__ __forceinline__ u32x4 pack8(const float (&v)[8]) { u32x4 w; w.x = pk2(v[0], v[1]); w.y = pk2(v[2], v[3]); w.z = pk2(v[4], v[5]); w.w = pk2(v[6], v[7]); return w; }

#define LDS_BAR() do { asm volatile("s_waitcnt lgkmcnt(0)" ::: "memory"); __builtin_amdgcn_s_barrier(); asm volatile("" ::: "memory"); } while (0)

#define XB_TMO      128
#define XB_XCNT(j)  (256  + 64 * (j))
#define XB_XSUB(j)  (1280 + 64 * (j))
#define XB_XGEN(j)  (2304 + 64 * (j))
#define XB_TOP      3328
#define XB_TOPGEN   3392
#define XCD_BAR_WORDS 3456
#define XB_SPIN_CAP (1u << 19)
__device__ __forceinline__ unsigned xb_ld(unsigned* p)              { return __hip_atomic_load(p, __ATOMIC_RELAXED, __HIP_MEMORY_SCOPE_AGENT); }
__device__ __forceinline__ unsigned xb_add(unsigned* p, unsigned v) { return __hip_atomic_fetch_add(p, v, __ATOMIC_RELAXED, __HIP_MEMORY_SCOPE_AGENT); }
__device__ __forceinline__ unsigned xb_xcc_id() { return (unsigned)__builtin_amdgcn_s_getreg((3 << 11) | 20) & 0xFu; }
#define XB_SPIN(cond, bar) do { unsigned _sp = 0; while (cond) { __builtin_amdgcn_s_sleep(1); \
    if ((++_sp & 255u) == 0u) { if (xb_ld(&(bar)[XB_TMO])) break; if (_sp > XB_SPIN_CAP) { atomicAdd(&(bar)[XB_TMO], 1u); break; } } } } while (0)
struct XcdBarrier { unsigned* bar; unsigned x; volatile LAS unsigned* st; };
__device__ __forceinline__ XcdBarrier xcd_barrier_post(unsigned* bar, volatile LAS unsigned* st) {
    XcdBarrier b; b.bar = bar; b.x = xb_xcc_id(); b.st = st;
    if (threadIdx.x == 0) (void)xb_add(&bar[XB_XCNT(b.x)], 1u);
    return b;
}
__device__ __forceinline__ void xcd_barrier_complete(unsigned* bar, unsigned x, unsigned& nloc, unsigned& nx) {
    const unsigned G = gridDim.x * gridDim.y * gridDim.z;
    unsigned sum, cnt, mine, sp = 0u;
    for (;;) {
        sum = 0u; cnt = 0u; mine = 0u;
#pragma unroll
        for (unsigned j = 0; j < 16; ++j) { const unsigned c = xb_ld(&bar[XB_XCNT(j)]); sum += c; cnt += (c > 0u) ? 1u : 0u; mine = (j == x) ? c : mine; }
        if (sum == G) break;
        __builtin_amdgcn_s_sleep(1);
        if ((++sp & 255u) == 0u) { if (xb_ld(&bar[XB_TMO])) break; if (sp > XB_SPIN_CAP) { atomicAdd(&bar[XB_TMO], 1u); break; } }
    }
    nloc = mine > 0u ? mine : 1u; nx = cnt > 0u ? cnt : 1u;
}
__device__ __forceinline__ void xcd_barrier(const XcdBarrier& b) {
    asm volatile("s_waitcnt vmcnt(0)" ::: "memory");
    __syncthreads();
    if (threadIdx.x == 0) {
        unsigned* bar = b.bar;
        __builtin_amdgcn_s_waitcnt(0);
        unsigned nloc = b.st[0], nx = b.st[1];
        if (nloc == 0u) { xcd_barrier_complete(bar, b.x, nloc, nx); b.st[0] = nloc; b.st[1] = nx; }
        const unsigned old = xb_add(&bar[XB_XSUB(b.x)], 1u);
        const unsigned gen = old / nloc;
        if (old + 1u == (gen + 1u) * nloc) {
            __builtin_amdgcn_fence(__ATOMIC_RELEASE, "agent");
            asm volatile("s_waitcnt vmcnt(0)" ::: "memory");
            const unsigned og = xb_add(&bar[XB_TOP], 1u);
            const unsigned tg = og / nx;
            if (og + 1u == (tg + 1u) * nx) xb_add(&bar[XB_TOPGEN], 1u);
            else XB_SPIN(xb_ld(&bar[XB_TOPGEN]) == tg, bar);
            __builtin_amdgcn_fence(__ATOMIC_ACQUIRE, "agent");
            xb_add(&bar[XB_XGEN(b.x)], 1u);
            asm volatile("s_waitcnt vmcnt(0)" ::: "memory");
        } else {
            XB_SPIN(xb_ld(&bar[XB_XGEN(b.x)]) == gen, bar);
            __builtin_amdgcn_fence(__ATOMIC_ACQUIRE, "agent");
            asm volatile("s_waitcnt vmcnt(0)" ::: "memory");
        }
    }
    __syncthreads();
}

struct Args {
    const float* in[34]; float* out; unsigned char* ws; int ph_lo, ph_hi;
};
typedef const __attribute__((address_space(4))) Args* ArgsP;
struct Frame {
    LAS unsigned char* lds;
    int wave, vcu, G, gw, NGW;
    unsigned char* ws; unsigned char* dob;
};
enum { I_X = 0, I_C, I_POS, I_WADA, I_BADA, I_GMIX, I_WIN, I_MU, I_W0, I_WDEC, I_A0, I_WAUP, I_WGUP, I_KK, I_KA, I_RK, I_LNW, I_LNB, I_GQA, I_WUQ, I_GKVA, I_WUKV,
       I_QN, I_KN, I_WBR, I_WOUT, I_GFFN, I_WRG, I_BRG, I_WRE, I_BRE, I_WEG, I_WEU, I_WED };

struct Unit { int pm, pn; };
struct Gemm { const bf16* A; const bf16* Bt; int M, N, K; const int* ridx = nullptr; };
constexpr int NXCD = 8, WGM = 8;
struct StaticOrder {
    int nM, nN, nwg, G, c;
    __device__ void init(int M, int N, int G_, int c_) { nM = M / 256; nN = N / 256; nwg = nM * nN; G = G_; c = c_; }
    __device__ bool next(int i, Unit& u) const {
        const long L = (long)i * G + c; if (L >= nwg) return false;
        int wgid = (int)L; { const int q = nwg / NXCD, r = nwg % NXCD, xcd = wgid % NXCD, off = wgid / NXCD; wgid = (xcd < r ? xcd * (q + 1) : r * (q + 1) + (xcd - r) * q) + off; }
        const int nig = WGM * nN, gid = wgid / nig, fm = gid * WGM, gsz = (nM - fm) < WGM ? (nM - fm) : WGM;
        u.pm = fm + ((wgid % nig) % gsz); u.pn = (wgid % nig) / gsz; return true;
    }
    __device__ __forceinline__ void a_ready(const Unit&) const {}
    __device__ __forceinline__ void done(const Unit&) const {}
};
struct TableOrder {
    const LAS int* texp; int ntiles, nN, G, c;
    __device__ bool next(int i, Unit& u) const {
        const long L = (long)i * G + c; if (L >= (long)ntiles * nN) return false;
        const int t = (int)(L / nN), j = (int)(L % nN); u.pm = t; u.pn = texp[t] * nN + j; return true;
    }
    __device__ __forceinline__ void a_ready(const Unit&) const {}
    __device__ __forceinline__ void done(const Unit&) const {}
};

template <class Epi, class Sched>
__device__ __forceinline__ void gemm_phase_naive(LAS unsigned char* lds, const Gemm g, const Sched& S, const Epi& E) {
    const int tid = (int)__builtin_amdgcn_readfirstlane((int)threadIdx.x >> 6) * 64 + lane_id_fresh(), ty = tid >> 5, tx = tid & 31;
    LAS bf16* As = (LAS bf16*)lds; LAS bf16* Bs = (LAS bf16*)(lds + 128 * 40 * 2);
    Unit u;
    for (int i = 0; S.next(i, u); ++i) {
        for (int half = 0; half < 2; ++half) {
            float acc[8][8];
#pragma unroll
            for (int r = 0; r < 8; ++r)
#pragma unroll
                for (int c = 0; c < 8; ++c) acc[r][c] = 0.f;
            const bf16* Ab = g.A + ((size_t)u.pm * 256 + half * 128) * g.K; const bf16* Bb = g.Bt + (size_t)u.pn * 256 * g.K;
            for (int k0 = 0; k0 < g.K; k0 += 32) {
                __syncthreads();
                { const int r = tid >> 2, c8 = (tid & 3) * 8; *(LAS u32x4*)(As + r * 40 + c8) = *(const u32x4*)(Ab + (size_t)r * g.K + k0 + c8); }
#pragma unroll
                for (int j = 0; j < 2; ++j) { const int ch = tid + j * 512, r = ch >> 2, c8 = (ch & 3) * 8; *(LAS u32x4*)(Bs + r * 40 + c8) = *(const u32x4*)(Bb + (size_t)r * g.K + k0 + c8); }
                __syncthreads();
#pragma unroll 2
                for (int k = 0; k < 32; k += 2) {
                    float b0[8], b1[8];
#pragma unroll
                    for (int c = 0; c < 8; ++c) { const unsigned w = *(const LAS unsigned*)(Bs + (tx * 8 + c) * 40 + k); b0[c] = lo2f(w); b1[c] = hi2f(w); }
#pragma unroll
                    for (int r = 0; r < 8; ++r) { const unsigned w = *(const LAS unsigned*)(As + (ty * 8 + r) * 40 + k); const float a0 = lo2f(w), a1 = hi2f(w);
#pragma unroll
                        for (int c = 0; c < 8; ++c) acc[r][c] = fmaf(a1, b1[c], fmaf(a0, b0[c], acc[r][c])); }
                }
            }
#pragma unroll
            for (int r = 0; r < 8; ++r) E.store8(u, half * 128 + ty * 8 + r, tx * 8, acc[r]);
        }
    }
    __syncthreads();
}

struct EpiZ { bf16 *ZR, *SG, *ZM;
    __device__ __forceinline__ void store8(const Unit& u, int r, int c, const float (&v)[8]) const {
        const size_t row = (size_t)u.pm * 256 + r;
        if (u.pn < 7) { *(u32x4*)(ZR + row * 1792 + u.pn * 256 + c) = pack8(v); }
        else if (u.pn < 15) { float s[8];
#pragma unroll
            for (int i = 0; i < 8; ++i) s[i] = sigmoidf_(v[i]);
            *(u32x4*)(SG + row * 2048 + (u.pn - 7) * 256 + c) = pack8(s); }
        else { *(u32x4*)(ZM + row * 512 + (u.pn - 15) * 256 + c) = pack8(v); }
    } };
struct EpiLora { bf16 *LW, *A; const float *w0, *a0;
    __device__ __forceinline__ void store8(const Unit& u, int r, int c, const float (&v)[8]) const {
        const size_t row = (size_t)u.pm * 256 + r; const int col = u.pn * 256 + c; float o[8];
        const bool isw = col < 512; const float* bp = isw ? (w0 + col) : (a0 + col - 512);
        const f32x4 b0 = *(const f32x4*)bp, b1 = *(const f32x4*)(bp + 4); const float bb[8] = {b0.x, b0.y, b0.z, b0.w, b1.x, b1.y, b1.z, b1.w};
#pragma unroll
        for (int i = 0; i < 8; ++i) { const float e = __builtin_amdgcn_exp2f(fminf(-1.4426950408889634f * (bb[i] + v[i]), 120.f)); const float s = __builtin_amdgcn_rcpf(1.0f + e); o[i] = isw ? -0.60653065971263342f * s : s; }
        bf16* dst = isw ? (LW + row * 512 + col) : (A + row * 512 + col - 512);
        *(u32x4*)dst = pack8(o);
    } };
struct EpiPlain { bf16* O0; bf16* O1; int split, ld0, ld1;
    __device__ __forceinline__ void store8(const Unit& u, int r, int c, const float (&v)[8]) const {
        const size_t row = (size_t)u.pm * 256 + r; int col = u.pn * 256 + c;
        if (col < split) *(u32x4*)(O0 + row * ld0 + col) = pack8(v); else *(u32x4*)(O1 + row * ld1 + col - split) = pack8(v);
    } };
template <bool ACCUM> struct EpiBranch { bf16* MG; const bf16* SG; int goff;
    __device__ __forceinline__ void store8(const Unit& u, int r, int c, const float (&v)[8]) const {
        const size_t row = (size_t)u.pm * 256 + r; const int col = u.pn * 256 + c; float gt[8], o[8];
        unpack8(*(const u32x4*)(SG + row * 2048 + goff + col), gt);
        if (ACCUM) { float p[8]; unpack8(*(const u32x4*)(MG + row * 1024 + col), p);
#pragma unroll
            for (int i = 0; i < 8; ++i) o[i] = p[i] + gt[i] * v[i]; }
        else {
#pragma unroll
            for (int i = 0; i < 8; ++i) o[i] = gt[i] * v[i]; }
        *(u32x4*)(MG + row * 1024 + col) = pack8(o);
    } };
struct EpiOut { float* X1; const float* x; const float* mod;
    __device__ __forceinline__ void store8(const Unit& u, int r, int c, const float (&v)[8]) const {
        const size_t row = (size_t)u.pm * 256 + r; const int col = u.pn * 256 + c; const int b = (int)(row / SEQ);
        const float* gt = mod + b * 6144 + 2048 + col; const float* xr = x + row * 1024 + col; float* o = X1 + row * 1024 + col;
        const f32x4 g0 = *(const f32x4*)gt, g1 = *(const f32x4*)(gt + 4), x0 = *(const f32x4*)xr, x1 = *(const f32x4*)(xr + 4);
        *(f32x4*)o = (f32x4){x0.x + g0.x * v[0], x0.y + g0.y * v[1], x0.z + g0.z * v[2], x0.w + g0.w * v[3]};
        *(f32x4*)(o + 4) = (f32x4){x1.x + g1.x * v[4], x1.y + g1.y * v[5], x1.z + g1.z * v[6], x1.w + g1.w * v[7]};
    } };
struct EpiGateUp { bf16* HID;
    __device__ __forceinline__ void store8(const Unit& u, int r, int c, const float (&v)[8]) const {
        const size_t row = (size_t)u.pm * 256 + r; const int col = ((u.pn & 1) * 256 + c) >> 1;
        u32x2 w; w.x = pk2(siluf_(v[0]) * v[4], siluf_(v[1]) * v[5]); w.y = pk2(siluf_(v[2]) * v[6], siluf_(v[3]) * v[7]);
        *(u32x2*)(HID + row * 256 + col) = w;
    } };
struct EpiDownAtomic { float* out; const int* ent; const float* mod;
    __device__ __forceinline__ void store8(const Unit& u, int r, int c, const float (&v)[8]) const {
        const int e0 = ent[2 * (u.pm * 256 + r)]; if (e0 < 0) return; const float w = __builtin_bit_cast(float, ent[2 * (u.pm * 256 + r) + 1]);
        const int col = (u.pn & 3) * 256 + c, b = e0 / SEQ; const float* gt = mod + b * 6144 + 5120 + col; float* o = out + (size_t)e0 * 1024 + col;
        const f32x4 g0 = *(const f32x4*)gt, g1 = *(const f32x4*)(gt + 4);
        unsafeAtomicAdd(o + 0, g0.x * w * v[0]); unsafeAtomicAdd(o + 1, g0.y * w * v[1]); unsafeAtomicAdd(o + 2, g0.z * w * v[2]); unsafeAtomicAdd(o + 3, g0.w * w * v[3]);
        unsafeAtomicAdd(o + 4, g1.x * w * v[4]); unsafeAtomicAdd(o + 5, g1.y * w * v[5]); unsafeAtomicAdd(o + 6, g1.z * w * v[6]); unsafeAtomicAdd(o + 7, g1.w * w * v[7]);
    } };
struct EpiDown { bf16* YS;
    __device__ __forceinline__ void store8(const Unit& u, int r, int c, const float (&v)[8]) const {
        const size_t row = (size_t)u.pm * 256 + r; *(u32x4*)(YS + row * 1024 + (u.pn & 3) * 256 + c) = pack8(v);
    } };


namespace pg8 {
#define PG8_LAS __attribute__((address_space(3)))
typedef ::bf16x8 bf16x8; typedef ::f32x4 f32x4;
using ::Unit; using ::Gemm;
constexpr int BM = 256, BK = 64, HALF = 128, HTB = HALF * BK * 2  , STAGE_BYTES = 8 * HTB;

__device__ __forceinline__ int lds_byte(int r, int c) { const int st = (r >> 4) * 2 + (c >> 5), rr = r & 15, cc = c & 31, ob = rr * 64 + cc * 2; return st * 1024 + (ob ^ (((ob >> 9) & 1) << 5)); }
__device__ __forceinline__ void stage_rc(int b, int& R, int& C) { const int st = b / 1024, sb = b % 1024, swz = sb ^ (((sb >> 9) & 1) << 5); R = (st >> 1) * 16 + swz / 64; C = (st & 1) * 32 + (swz % 64) / 2; }
__device__ __forceinline__ int perm32(int rho) { const int n = rho >> 4, i = rho & 15; return 8 * (i >> 2) + 4 * n + (i & 3); }
template <class Epi, class Sched, bool ALIGN_EPI = false, bool SP2 = false, bool GATHER = false>
__device__ __forceinline__ void gemm_phase(PG8_LAS unsigned char* lds, const Gemm g, const Sched& S, const Epi& E, const int wave_in) {
    const int lane = lane_id_fresh(), wid = wave_in, tid = wid * 64 + lane,
              wr = wid >> 2, wc = wid & 3, fr = lane & 15, fq = lane >> 4;
    const int K = g.K, nt = K / BK;
    unsigned voffA[2], voffB[2];
#pragma unroll
    for (int i = 0; i < 2; ++i) { int R, C; stage_rc(tid * 16 + i * 8192, R, C); const int Rb = Epi::PERM ? ((R & ~31) + perm32(R & 31)) : R;
        voffA[i] = (unsigned)(R * K + C) * 2u; voffB[i] = (unsigned)(Rb * K + C) * 2u; }
    unsigned vAc[2][2] = {{0u, 0u}, {0u, 0u}}, vAn[2][2] = {{0u, 0u}, {0u, 0u}}; int gR[2] = {0, 0}; unsigned gC[2] = {0u, 0u};
    if constexpr (GATHER) {
#pragma unroll
        for (int i = 0; i < 2; ++i) { int R, C; stage_rc(tid * 16 + i * 8192, R, C); gR[i] = R; gC[i] = (unsigned)C * 2u; } }
#define PG8_GIDX(dst, pm_) do { _Pragma("unroll") for (int _h = 0; _h < 2; ++_h) _Pragma("unroll") for (int _i = 0; _i < 2; ++_i) \
        dst[_h][_i] = (unsigned)g.ridx[(pm_) * BM + _h * HALF + gR[_i]] * (unsigned)(K * 2) + gC[_i]; } while (0)
    const size_t kstep = (size_t)(BK * 2);
    const size_t hstep = (size_t)HALF * K * 2;
    const size_t tstep = 2 * hstep;
    const unsigned ldsw = (unsigned)wid * 1024u;
    const int aoff = lds_byte(wr * 64 + fr, fq * 8), boff = lds_byte(wc * 32 + fr, fq * 8);
#define PG8_SA(b, h) (((b) * 2 + (h)) * HTB)
#define PG8_SB(b, h) ((4 + (b) * 2 + (h)) * HTB)
#define PG8_STAGE(bufoff, gbase, voff) do { _Pragma("unroll") for (int _i = 0; _i < 2; ++_i) \
        __builtin_amdgcn_global_load_lds((const unsigned*)((const char*)(gbase) + (voff)[_i]), (PG8_LAS unsigned*)(lds + (bufoff) + ldsw + _i * 8192), 16, 0, 0); } while (0)
#define PG8_STAGE_A(bufoff, kptr, h, isnext) do { if constexpr (GATHER) { unsigned _v[2]; _v[0] = (isnext) ? vAn[h][0] : vAc[h][0]; _v[1] = (isnext) ? vAn[h][1] : vAc[h][1]; PG8_STAGE(bufoff, kptr, _v); } \
        else { PG8_STAGE(bufoff, (kptr) + (h) * hstep, voffA); } } while (0)
#define PG8_LDA(dst, b, h) do { _Pragma("unroll") for (int m = 0; m < 4; ++m) _Pragma("unroll") for (int k = 0; k < 2; ++k) dst[m][k] = *(const PG8_LAS bf16x8*)(lds + PG8_SA(b, h) + aoff + m * 2048 + k * 1024); } while (0)
#define PG8_LDB(dst, b, h) do { _Pragma("unroll") for (int n = 0; n < 2; ++n) _Pragma("unroll") for (int k = 0; k < 2; ++k) dst[n][k] = *(const PG8_LAS bf16x8*)(lds + PG8_SB(b, h) + boff + n * 2048 + k * 1024); } while (0)
#define PG8_MMA(ai, bj, At, Bt) do { __builtin_amdgcn_s_setprio(1); _Pragma("unroll") for (int m = 0; m < 4; ++m) _Pragma("unroll") for (int n = 0; n < 2; ++n) _Pragma("unroll") for (int k = 0; k < 2; ++k) \
        acc[ai][bj][m][n] = __builtin_amdgcn_mfma_f32_16x16x32_bf16(Bt[n][k], At[m][k], acc[ai][bj][m][n], 0, 0, 0); __builtin_amdgcn_s_setprio(0); } while (0)
#define PG8_WAIT_V(n) asm volatile("s_waitcnt vmcnt(" #n ")" ::: "memory")
#define PG8_WAIT_L(n) asm volatile("s_waitcnt lgkmcnt(" #n ")" ::: "memory")
#define PG8_BAR __builtin_amdgcn_s_barrier()
#define PG8_SCHED __builtin_amdgcn_sched_barrier(0)
    Unit cur, nxt; int ui = 0;
    if (!S.next(0, cur)) return;
    f32x4 acc[2][2][4][2];
#pragma unroll
    for (int a = 0; a < 2; ++a)
#pragma unroll
        for (int b = 0; b < 2; ++b)
#pragma unroll
            for (int m = 0; m < 4; ++m)
#pragma unroll
                for (int n = 0; n < 2; ++n) acc[a][b][m][n] = (f32x4){0.f, 0.f, 0.f, 0.f};
    bf16x8 At[4][2], B0[2][2], B1[2][2];
    const char* cA = (const char*)g.A + (GATHER ? (size_t)0 : (size_t)cur.pm * tstep); const char* cB = (const char*)g.Bt + (size_t)cur.pn * tstep;
    if constexpr (GATHER) PG8_GIDX(vAc, cur.pm);
    S.a_ready(cur);
    if constexpr (SP2) {
        PG8_STAGE(PG8_SB(0, 0), cB, voffB); PG8_STAGE(PG8_SB(0, 1), cB + hstep, voffB); PG8_STAGE_A(PG8_SA(0, 0), cA, 0, false); PG8_STAGE_A(PG8_SA(0, 1), cA, 1, false);
        if (wr == 1) PG8_BAR;
        PG8_WAIT_V(2); PG8_BAR;
        PG8_STAGE(PG8_SB(1, 0), cB + kstep, voffB); PG8_STAGE_A(PG8_SA(1, 0), cA + kstep, 0, false); PG8_STAGE(PG8_SB(1, 1), cB + hstep + kstep, voffB);
        PG8_WAIT_V(6); PG8_BAR;
    } else {
        PG8_STAGE(PG8_SB(0, 0), cB, voffB); PG8_STAGE(PG8_SA(0, 0), cA, voffA); PG8_STAGE(PG8_SB(0, 1), cB + hstep, voffB); PG8_STAGE(PG8_SA(0, 1), cA + hstep, voffA);
        if (wr == 1) PG8_BAR;
        PG8_WAIT_V(4); PG8_BAR;
        PG8_STAGE(PG8_SB(1, 0), cB + kstep, voffB); PG8_STAGE(PG8_SA(1, 0), cA + kstep, voffA); PG8_STAGE(PG8_SB(1, 1), cB + hstep + kstep, voffB);
        PG8_WAIT_V(6); PG8_BAR;
    }
    for (;;) {
        const bool has_next = S.next(ui + 1, nxt);
        const char* nA = (has_next && !GATHER) ? (const char*)g.A + (size_t)nxt.pm * tstep : cA; const char* nB = has_next ? (const char*)g.Bt + (size_t)nxt.pn * tstep : cB;
        if constexpr (GATHER) { if (has_next) PG8_GIDX(vAn, nxt.pm); else { _Pragma("unroll") for (int _h = 0; _h < 2; ++_h) { vAn[_h][0] = vAc[_h][0]; vAn[_h][1] = vAc[_h][1]; } } }
        for (int t = 0; t < nt; t += 2) {
            const bool last = (t == nt - 2);
            const char* a1 = cA + (size_t)(t + 1) * kstep;
            const char* a2 = last ? nA : cA + (size_t)(t + 2) * kstep; const char* b2 = last ? nB : cB + (size_t)(t + 2) * kstep;
            const char* a3 = a2 + kstep; const char* b3 = b2 + kstep;
            if (last && has_next) S.a_ready(nxt);
            if constexpr (SP2) {
            PG8_LDB(B0, 0, 0); PG8_LDB(B1, 0, 1); PG8_SCHED; PG8_LDA(At, 0, 0); PG8_STAGE_A(PG8_SA(1, 1), a1, 1, false);
            PG8_WAIT_V(8); PG8_WAIT_L(0); PG8_BAR; PG8_MMA(0, 0, At, B0); PG8_MMA(0, 1, At, B1); PG8_BAR; PG8_SCHED;
            PG8_LDA(At, 0, 1); PG8_STAGE(PG8_SB(0, 0), b2, voffB); PG8_STAGE(PG8_SB(0, 1), b2 + hstep, voffB); PG8_STAGE_A(PG8_SA(0, 0), a2, 0, last);
            PG8_WAIT_V(8); PG8_WAIT_L(0); PG8_BAR; PG8_MMA(1, 0, At, B0); PG8_MMA(1, 1, At, B1); PG8_BAR; PG8_SCHED;
            PG8_LDB(B0, 1, 0); PG8_LDB(B1, 1, 1); PG8_SCHED; PG8_LDA(At, 1, 0); PG8_STAGE_A(PG8_SA(0, 1), a2, 1, last);
            PG8_WAIT_V(8); PG8_WAIT_L(0); PG8_BAR; PG8_MMA(0, 0, At, B0); PG8_MMA(0, 1, At, B1); PG8_BAR; PG8_SCHED;
            PG8_LDA(At, 1, 1); PG8_STAGE(PG8_SB(1, 0), b3, voffB); PG8_STAGE(PG8_SB(1, 1), b3 + hstep, voffB); PG8_STAGE_A(PG8_SA(1, 0), a3, 0, last);
            PG8_WAIT_V(8); PG8_WAIT_L(0); PG8_BAR; PG8_MMA(1, 0, At, B0); PG8_MMA(1, 1, At, B1); PG8_BAR; PG8_SCHED;
            } else {
            PG8_LDB(B0, 0, 0); PG8_SCHED; PG8_LDA(At, 0, 0); PG8_STAGE(PG8_SA(1, 1), a1 + hstep, voffA);
            PG8_WAIT_L(8); PG8_BAR; PG8_WAIT_L(0); PG8_MMA(0, 0, At, B0); PG8_BAR; PG8_SCHED;
            PG8_LDB(B1, 0, 1); PG8_STAGE(PG8_SB(0, 0), b2, voffB);
            PG8_BAR; PG8_WAIT_L(0); PG8_MMA(0, 1, At, B1); PG8_BAR;
            PG8_LDA(At, 0, 1); PG8_STAGE(PG8_SA(0, 0), a2, voffA);
            PG8_BAR; PG8_WAIT_L(0); PG8_MMA(1, 0, At, B0); PG8_BAR; PG8_SCHED;
            PG8_STAGE(PG8_SB(0, 1), b2 + hstep, voffB);
            PG8_WAIT_V(6); PG8_BAR; PG8_MMA(1, 1, At, B1); PG8_BAR;
            PG8_LDB(B0, 1, 0); PG8_SCHED; PG8_LDA(At, 1, 0); PG8_STAGE(PG8_SA(0, 1), a2 + hstep, voffA);
            PG8_WAIT_L(8); PG8_BAR; PG8_WAIT_L(0); PG8_MMA(0, 0, At, B0); PG8_BAR; PG8_SCHED;
            PG8_LDB(B1, 1, 1); PG8_STAGE(PG8_SB(1, 0), b3, voffB);
            PG8_BAR; PG8_WAIT_L(0); PG8_MMA(0, 1, At, B1); PG8_BAR;
            PG8_LDA(At, 1, 1); PG8_STAGE(PG8_SA(1, 0), a3, voffA);
            PG8_BAR; PG8_WAIT_L(0); PG8_MMA(1, 0, At, B0); PG8_BAR; PG8_SCHED;
            PG8_STAGE(PG8_SB(1, 1), b3 + hstep, voffB);
            PG8_WAIT_V(6); PG8_BAR; PG8_MMA(1, 1, At, B1); PG8_BAR;
            }
        }
        if constexpr (ALIGN_EPI) { if (wr == 0) PG8_BAR; }
        if constexpr (!Epi::AFTER_DRAIN) { E(acc, cur, wr, wc, fr, fq); S.done(cur); }
        if (!has_next) break;
#pragma unroll
        for (int a = 0; a < 2; ++a)
#pragma unroll
            for (int b = 0; b < 2; ++b)
#pragma unroll
                for (int m = 0; m < 4; ++m)
#pragma unroll
                    for (int n = 0; n < 2; ++n) acc[a][b][m][n] = (f32x4){0.f, 0.f, 0.f, 0.f};
        cur = nxt; cA = nA; cB = nB; ++ui;
        if constexpr (GATHER) { _Pragma("unroll") for (int _h = 0; _h < 2; ++_h) { vAc[_h][0] = vAn[_h][0]; vAc[_h][1] = vAn[_h][1]; } }
        if constexpr (ALIGN_EPI) { if (wr == 1) PG8_BAR; }
    }
    PG8_WAIT_V(0);
    if constexpr (!ALIGN_EPI) { if (wr == 0) PG8_BAR; }
    PG8_BAR;
    if constexpr (Epi::AFTER_DRAIN) { E.fused(acc, cur, wr, wc, fr, fq, lds, wid, lane); S.done(cur); }
#undef PG8_SA
#undef PG8_SB
#undef PG8_STAGE
#undef PG8_STAGE_A
#undef PG8_GIDX
#undef PG8_LDA
#undef PG8_LDB
#undef PG8_MMA
#undef PG8_WAIT_V
#undef PG8_WAIT_L
#undef PG8_BAR
#undef PG8_SCHED
}

template <class F> struct EpiAdapt {
    static constexpr bool PERM = true, AFTER_DRAIN = false; F f;
    __device__ __forceinline__ void operator()(const f32x4 (&acc)[2][2][4][2], const Unit& u, int wr, int wc, int fr, int fq) const {
        asm volatile("" : "+v"(fr), "+v"(fq));
#pragma unroll
        for (int ai = 0; ai < 2; ++ai)
#pragma unroll
            for (int m = 0; m < 4; ++m) { const int row = ai * HALF + wr * 64 + m * 16 + fr;
#pragma unroll
                for (int bj = 0; bj < 2; ++bj) { const f32x4 v0 = acc[ai][bj][m][0], v1 = acc[ai][bj][m][1];
                    const float v[8] = {v0[0], v0[1], v0[2], v0[3], v1[0], v1[1], v1[2], v1[3]};
                    f.store8(u, row, bj * HALF + wc * 32 + 8 * fq, v); } }
    }
};
}

template <class Epi, class Sched>
__device__ __forceinline__ void gemm_phase_gather(LAS unsigned char* lds, const Gemm g, const Sched& S, const Epi& E, const int wave_in) {
    pg8::EpiAdapt<Epi> EA{E};
    pg8::gemm_phase<pg8::EpiAdapt<Epi>, Sched, true, true, true>(lds, g, S, EA, wave_in);
}
template <class Epi, class Sched>
__device__ __forceinline__ void gemm_phase_any(LAS unsigned char* lds, const Gemm g, const Sched& S, const Epi& E, const int wave_in) {
#if ENG_GEMM == 1
    pg8::EpiAdapt<Epi> EA{E};
    pg8::gemm_phase<pg8::EpiAdapt<Epi>, Sched, true, true>(lds, g, S, EA, wave_in);
#else
    gemm_phase_naive<Epi, Sched>(lds, g, S, E);
#endif
}

template <class RowMap>
__device__ __forceinline__ void transpose_item(const float* W, int ldw, bf16* WT, int ldt, int koff, int k0, int n0, const RowMap& rm, LAS float* scr, int lane) {
#pragma unroll 8
    for (int i = 0; i < 32; ++i) { const int kk = 2 * i + (lane >> 5); scr[kk * 33 + (lane & 31)] = W[(size_t)(k0 + kk) * ldw + n0 + (lane & 31)]; }
    asm volatile("s_waitcnt lgkmcnt(0)" ::: "memory");
    const int c = lane & 7;
#pragma unroll
    for (int j = 0; j < 4; ++j) { const int n = (lane >> 3) + 8 * j; const LAS float* s = scr + (8 * c) * 33 + n;
        u32x4 o; o.x = pk2(s[0 * 33], s[1 * 33]); o.y = pk2(s[2 * 33], s[3 * 33]); o.z = pk2(s[4 * 33], s[5 * 33]); o.w = pk2(s[6 * 33], s[7 * 33]);
        *(u32x4*)(WT + (size_t)rm(n0 + n) * ldt + koff + k0 + 8 * c) = o; }
    asm volatile("s_waitcnt lgkmcnt(0)" ::: "memory");
}
struct RmId { int off; __device__ int operator()(int n) const { return off + n; } };
struct RmWin { __device__ int operator()(int n) const { return n < 1792 ? n : (n < 2208 ? 3840 + (n - 1792) : 1792 + (n - 2208)); } };
struct RmUkv { __device__ int operator()(int n) const { const int h = n >> 7, j = n & 127; return j < 64 ? h * 64 + j : 512 + h * 64 + (j - 64); } };
struct RmGU { int off; __device__ int operator()(int j) const { return off + 8 * (j >> 2) + (j & 3); } };

__device__ __forceinline__ void p0_prologue(const Frame& F, ArgsP a) {
    const int lane_f = lane_id_fresh(), tid_f = F.wave * 64 + lane_f;
    LAS float* scr = (LAS float*)(F.lds + F.wave * 16384);
    const int lane = lane_f;
    bf16* Win = (bf16*)(F.ws + WS_WIN); bf16* Wblk = (bf16*)(F.ws + WS_WBLK); bf16* Wg = (bf16*)(F.ws + WS_WG); bf16* Wuq = (bf16*)(F.ws + WS_WUQ);
    bf16* Wukv = (bf16*)(F.ws + WS_WUKV); bf16* Wb = (bf16*)(F.ws + WS_WB); bf16* Wo = (bf16*)(F.ws + WS_WO); bf16* Wgu = (bf16*)(F.ws + WS_WGU); bf16* Wdn = (bf16*)(F.ws + WS_WDN);
    constexpr int I_IN = 16 * 133, I_DEC = 1 * 16, I_AUP = 16, I_GUP = 2 * 16, I_UQ = 4 * 24, I_UKV = 2 * 32, I_BR = 2 * 8 * 32, I_O = 16 * 32;
    constexpr int I_EG = 32 * 16 * 8, I_EU = I_EG, I_ED = 32 * 4 * 32;
    constexpr int NITEMS = I_IN + I_DEC + I_AUP + I_GUP + I_UQ + I_UKV + I_BR + I_O + I_EG + I_EU + I_ED;
    for (int it = F.gw; it < NITEMS; it += F.NGW) {
        int r = it;
        if (r < I_IN) { const int kb = r / 133, nb = r % 133; transpose_item(a->in[I_WIN], D_IN, Win, 1024, 0, 64 * kb, 32 * nb, RmWin{}, scr, lane); continue; } r -= I_IN;
        if (r < I_DEC) { transpose_item(a->in[I_WDEC], 512, Wblk, 128, 0, 0, 32 * r, RmId{0}, scr, lane); continue; } r -= I_DEC;
        if (r < I_AUP) { transpose_item(a->in[I_WAUP], 512, Wblk, 128, 64, 0, 32 * r, RmId{512}, scr, lane); continue; } r -= I_AUP;
        if (r < I_GUP) { const int kb = r / 16, nb = r % 16; transpose_item(a->in[I_WGUP], 512, Wg, 128, 0, 64 * kb, 32 * nb, RmId{0}, scr, lane); continue; } r -= I_GUP;
        if (r < I_UQ) { const int kb = r / 24, nb = r % 24; transpose_item(a->in[I_WUQ], 768, Wuq, 256, 0, 64 * kb, 32 * nb, RmId{0}, scr, lane); continue; } r -= I_UQ;
        if (r < I_UKV) { const int kb = r / 32, nb = r % 32; transpose_item(a->in[I_WUKV], 1024, Wukv, 128, 0, 64 * kb, 32 * nb, RmUkv{}, scr, lane); continue; } r -= I_UKV;
        if (r < I_BR) { const int br = r / 256, q = r % 256, kb = q / 32, nb = q % 32; transpose_item(a->in[I_WBR] + (size_t)br * 512 * 1024, 1024, Wb + (size_t)br * 1024 * 512, 512, 0, 64 * kb, 32 * nb, RmId{0}, scr, lane); continue; } r -= I_BR;
        if (r < I_O) { const int kb = r / 32, nb = r % 32; transpose_item(a->in[I_WOUT], 1024, Wo, 1024, 0, 64 * kb, 32 * nb, RmId{0}, scr, lane); continue; } r -= I_O;
        if (r < I_EG) { const int e = r / 128, q = r % 128, kb = q / 8, nb = q % 8; transpose_item(a->in[I_WEG] + (size_t)e * 1024 * 256, 256, Wgu + (size_t)e * 512 * 1024, 1024, 0, 64 * kb, 32 * nb, RmGU{0}, scr, lane); continue; } r -= I_EG;
        if (r < I_EU) { const int e = r / 128, q = r % 128, kb = q / 8, nb = q % 8; transpose_item(a->in[I_WEU] + (size_t)e * 1024 * 256, 256, Wgu + (size_t)e * 512 * 1024, 1024, 0, 64 * kb, 32 * nb, RmGU{4}, scr, lane); continue; } r -= I_EU;
        { const int e = r / 128, q = r % 128, kb = q / 32, nb = q % 32; transpose_item(a->in[I_WED] + (size_t)e * 256 * 1024, 1024, Wdn + (size_t)e * 1024 * 256, 256, 0, 64 * kb, 32 * nb, RmId{0}, scr, lane); }
    }
    for (int i = F.gw * 64 + lane; i < 96 * 128; i += F.NGW * 64) *(u32x4*)(Win + (size_t)4256 * 1024 + (size_t)i * 8) = (u32x4){0u, 0u, 0u, 0u};
    for (int i = F.gw * 64 + lane; i < 1024 * 8; i += F.NGW * 64) { const int row = i >> 3, c8 = (i & 7) * 8; *(u32x4*)(Wblk + row * 128 + (row < 512 ? 64 : 0) + c8) = (u32x4){0u, 0u, 0u, 0u}; }
    { const int* pos = (const int*)a->in[I_POS]; float* cs = (float*)(F.ws + WS_CS);
      for (int i = F.gw * 64 + lane; i < NTOK * 16; i += F.NGW * 64) { const int t = i >> 4, j = i & 15;
          const float fr = exp2f(-(float)j * (13.287712379549449f / 16.0f));
          const float ang = (float)pos[t] * fr; cs[t * 32 + j] = cosf(ang); cs[t * 32 + 16 + j] = sinf(ang); } }
    { float* mod = (float*)(F.ws + WS_MOD); const float* c = a->in[I_C]; const float* wa = a->in[I_WADA]; const float* ba = a->in[I_BADA];
      LAS float* red = (LAS float*)(F.lds + 8 * 16384);
      for (int nb = F.vcu; nb < 96; nb += F.G) {
          float acc[8];
#pragma unroll
          for (int b = 0; b < 8; ++b) acc[b] = 0.f;
          const int n = nb * 64 + lane;
          for (int k = F.wave * 128; k < F.wave * 128 + 128; ++k) { const float w = wa[(size_t)k * 6144 + n];
#pragma unroll
              for (int b = 0; b < 8; ++b) acc[b] = fmaf(siluf_(c[b * 1024 + k]), w, acc[b]); }
#pragma unroll
          for (int b = 0; b < 8; ++b) red[(F.wave * 8 + b) * 64 + lane] = acc[b];
          __syncthreads();
          { const int b = F.wave; float s = ba[n];
#pragma unroll
            for (int w = 0; w < 8; ++w) s += red[(w * 8 + b) * 64 + lane];
            mod[b * 6144 + n] = s; }
          __syncthreads();
      } }
}

__device__ __forceinline__ void p_normmod(const Frame& F, const float* x, const float* g, const float* mod, int sh_off, int sc_off, bf16* H) {
    const int lane_f = lane_id_fresh();
    f32x4 nx[4];
    { const f32x4* xr = (const f32x4*)(x + (size_t)F.gw * 1024) + lane_f;
#pragma unroll
      for (int j = 0; j < 4; ++j) nx[j] = xr[64 * j]; }
    for (int m = F.gw; m < NTOK; m += F.NGW) {
        const int b = m / SEQ;
        f32x4 v[4]; float s = 0.f;
#pragma unroll
        for (int j = 0; j < 4; ++j) v[j] = nx[j];
        { const int mn = (m + F.NGW < NTOK) ? m + F.NGW : m; const f32x4* xr = (const f32x4*)(x + (size_t)mn * 1024) + lane_f;
#pragma unroll
          for (int j = 0; j < 4; ++j) nx[j] = xr[64 * j]; }
#pragma unroll
        for (int j = 0; j < 4; ++j) s += (v[j].x * v[j].x + v[j].y * v[j].y) + (v[j].z * v[j].z + v[j].w * v[j].w);
        const float rstd = 1.0f / sqrtf(wave_sum(s) * (1.f / 1024.f) + EPS);
        u32x2* o = (u32x2*)(H + (size_t)m * 1024) + lane_f;
#pragma unroll
        for (int j = 0; j < 4; ++j) { const int col = 4 * lane_f + 256 * j;
            const f32x4 gg = *(const f32x4*)(g + col), sc = *(const f32x4*)(mod + b * 6144 + sc_off + col), sh = *(const f32x4*)(mod + b * 6144 + sh_off + col);
            const f32x4 y = v[j] * rstd * gg * (sc + 1.0f) + sh; u32x2 w; w.x = pk2(y.x, y.y); w.y = pk2(y.z, y.w); o[64 * j] = w; }
    }
}

__device__ __forceinline__ void p_prep_a(const Frame& F, ArgsP a) {
    const int lane_f = lane_id_fresh();
    const bf16* ZR = (const bf16*)(F.ws + WS_ZR); const bf16* ZM = (const bf16*)(F.ws + WS_ZM);
    bf16* TWA = (bf16*)(F.ws + WS_TWA); bf16* SGL = (bf16*)(F.ws + WS_SGL); bf16* QA = (bf16*)(F.ws + WS_QA); bf16* KVA = (bf16*)(F.ws + WS_KVA);
    const float* mu = a->in[I_MU]; const float* gqa = a->in[I_GQA]; const float* gkva = a->in[I_GKVA];
    const int lane = lane_f;
    const f32x4 mm = *(const f32x4*)(mu + 1536 + 4 * lane), gq = *(const f32x4*)(gqa + 4 * lane), gk = *(const f32x4*)(gkva + 4 * (lane & 31));
    for (int m = F.gw; m < NTOK; m += F.NGW) {
        const bool first = (m % SEQ) == 0;
        { const u32x2 c = *((const u32x2*)(ZR + (size_t)m * 1792 + 1536) + lane); u32x2 p = *((const u32x2*)(ZR + (size_t)(first ? m : m - 1) * 1792 + 1536) + lane); if (first) { p.x = 0u; p.y = 0u; }
          float z[4] = {lo2f(c.x), hi2f(c.x), lo2f(c.y), hi2f(c.y)}; const float q[4] = {lo2f(p.x), hi2f(p.x), lo2f(p.y), hi2f(p.y)};
          z[0] += (q[0] - z[0]) * mm.x; z[1] += (q[1] - z[1]) * mm.y; z[2] += (q[2] - z[2]) * mm.z; z[3] += (q[3] - z[3]) * mm.w;
          if (lane < 16) { u32x2 w; w.x = pk2(tanhf(z[0]), tanhf(z[1])); w.y = pk2(tanhf(z[2]), tanhf(z[3])); *((u32x2*)(TWA + (size_t)m * 128) + lane) = w; }
          else if (lane < 32) { u32x2 w; w.x = pk2(z[0], z[1]); w.y = pk2(z[2], z[3]); *((u32x2*)(TWA + (size_t)m * 128) + lane) = w; }
          else { u32x2 w; w.x = pk2(sigmoidf_(z[0]), sigmoidf_(z[1])); w.y = pk2(sigmoidf_(z[2]), sigmoidf_(z[3])); *((u32x2*)(SGL + (size_t)m * 128) + (lane - 32)) = w; } }
        { const u32x2 c = *((const u32x2*)(ZM + (size_t)m * 512) + lane); const float z[4] = {lo2f(c.x), hi2f(c.x), lo2f(c.y), hi2f(c.y)};
          u32x2 c2 = (u32x2){0u, 0u}; if (lane < 32) c2 = *((const u32x2*)(ZM + (size_t)m * 512 + 256) + lane); const float y[4] = {lo2f(c2.x), hi2f(c2.x), lo2f(c2.y), hi2f(c2.y)};
          const float rstd = 1.0f / sqrtf(wave_sum((z[0] * z[0] + z[1] * z[1]) + (z[2] * z[2] + z[3] * z[3])) * (1.f / 256.f) + EPS);
          const float rstd2 = 1.0f / sqrtf(wave_sum((y[0] * y[0] + y[1] * y[1]) + (y[2] * y[2] + y[3] * y[3])) * (1.f / 128.f) + EPS);
          u32x2 w; w.x = pk2(z[0] * rstd * gq.x, z[1] * rstd * gq.y); w.y = pk2(z[2] * rstd * gq.z, z[3] * rstd * gq.w);
          *((u32x2*)(QA + (size_t)m * 256) + lane) = w;
          if (lane < 32) { u32x2 w2; w2.x = pk2(y[0] * rstd2 * gk.x, y[1] * rstd2 * gk.y); w2.y = pk2(y[2] * rstd2 * gk.z, y[3] * rstd2 * gk.w);
              *((u32x2*)(KVA + (size_t)m * 128) + lane) = w2; } }
    }
}

__device__ __forceinline__ void p_prep_c(const Frame& F, ArgsP a) {
    const int lane_f = lane_id_fresh(), tid_f = F.wave * 64 + lane_f;
    bf16* Q = (bf16*)(F.dob + DO_Q); const bf16* KN = (const bf16*)(F.dob + DO_KN); const bf16* ZM = (const bf16*)(F.ws + WS_ZM); bf16* KC = (bf16*)(F.ws + WS_KC);
    const float* cs = (const float*)(F.ws + WS_CS);
    const float* qn = a->in[I_QN]; const float* kn = a->in[I_KN];
    const int lane = lane_f, hd = lane >> 3, j = lane & 7;
    for (int m = F.gw; m < NTOK; m += F.NGW) {
        const f32x2 cc = *(const f32x2*)(cs + (size_t)m * 32 + 2 * j), sn = *(const f32x2*)(cs + (size_t)m * 32 + 16 + 2 * j);
        { bf16* qp = Q + (size_t)m * 768 + hd * 96; float v[8]; unpack8(*(const u32x4*)(qp + 8 * j), v);
          const unsigned w1 = *(const unsigned*)(qp + 64 + 2 * j), w2 = *(const unsigned*)(qp + 80 + 2 * j); float x1[2] = {lo2f(w1), hi2f(w1)}, x2[2] = {lo2f(w2), hi2f(w2)};
          float ss = (x1[0] * x1[0] + x1[1] * x1[1]) + (x2[0] * x2[0] + x2[1] * x2[1]);
#pragma unroll
          for (int i = 0; i < 8; ++i) ss += v[i] * v[i];
          const float rstd = 1.0f / sqrtf(sum8(ss) * (1.f / 96.f) + EPS);
#pragma unroll
          for (int i = 0; i < 8; ++i) v[i] = v[i] * rstd * qn[8 * j + i] * QSCALE;
          x1[0] *= rstd * qn[64 + 2 * j]; x1[1] *= rstd * qn[65 + 2 * j]; x2[0] *= rstd * qn[80 + 2 * j]; x2[1] *= rstd * qn[81 + 2 * j];
          const float o1a = (x1[0] * cc.x - x2[0] * sn.x) * QSCALE, o1b = (x1[1] * cc.y - x2[1] * sn.y) * QSCALE, o2a = (x2[0] * cc.x + x1[0] * sn.x) * QSCALE, o2b = (x2[1] * cc.y + x1[1] * sn.y) * QSCALE;
          *(u32x4*)(qp + 8 * j) = pack8(v); *(unsigned*)(qp + 64 + 2 * j) = pk2(o1a, o1b); *(unsigned*)(qp + 80 + 2 * j) = pk2(o2a, o2b); }
        { float v[8]; unpack8(*(const u32x4*)(KN + (size_t)m * 512 + hd * 64 + 8 * j), v);
          const unsigned w1 = *(const unsigned*)(ZM + (size_t)m * 512 + 384 + 2 * j), w2 = *(const unsigned*)(ZM + (size_t)m * 512 + 400 + 2 * j); float x1[2] = {lo2f(w1), hi2f(w1)}, x2[2] = {lo2f(w2), hi2f(w2)};
          float ss = (x1[0] * x1[0] + x1[1] * x1[1]) + (x2[0] * x2[0] + x2[1] * x2[1]);
#pragma unroll
          for (int i = 0; i < 8; ++i) ss += v[i] * v[i];
          const float rstd = 1.0f / sqrtf(sum8(ss) * (1.f / 96.f) + EPS);
#pragma unroll
          for (int i = 0; i < 8; ++i) v[i] = v[i] * rstd * kn[8 * j + i];
          x1[0] *= rstd * kn[64 + 2 * j]; x1[1] *= rstd * kn[65 + 2 * j]; x2[0] *= rstd * kn[80 + 2 * j]; x2[1] *= rstd * kn[81 + 2 * j];
          bf16* kp = KC + (size_t)m * 768 + hd * 96;
          *(u32x4*)(kp + 8 * j) = pack8(v); *(unsigned*)(kp + 64 + 2 * j) = pk2(x1[0] * cc.x - x2[0] * sn.x, x1[1] * cc.y - x2[1] * sn.y);
          *(unsigned*)(kp + 80 + 2 * j) = pk2(x2[0] * cc.x + x1[0] * sn.x, x2[1] * cc.y + x1[1] * sn.y); }
    }
}

constexpr int SC_T = 32;
constexpr int SC_BUF = 5 * SC_T * 64 * 4 + SC_T * 16 * 4 + SC_T * 16 * 4;
struct ScanRaw { u32x2 rc[2], rp[2], kc[2], kp[2], av[2], lw[2]; u32x4 vc, vp; };
__device__ __forceinline__ void scan_issue(ScanRaw& R, const bf16* ZR, const bf16* A, const bf16* LW, size_t row0, int t0, int st2, int col, int s2, int cv, bool dov) {
#pragma unroll
    for (int u = 0; u < 2; ++u) { const int tt = t0 + st2 + 16 * u; const size_t g = row0 + tt; const size_t gp = row0 + (tt > 0 ? tt - 1 : 0);
        R.rc[u] = *(const u32x2*)(ZR + g * 1792 + col); R.rp[u] = *(const u32x2*)(ZR + gp * 1792 + col);
        R.kc[u] = *(const u32x2*)(ZR + g * 1792 + 512 + col); R.kp[u] = *(const u32x2*)(ZR + gp * 1792 + 512 + col);
        R.av[u] = *(const u32x2*)(A + g * 512 + col); R.lw[u] = *(const u32x2*)(LW + g * 512 + col); }
    { const int tv = t0 + (dov ? s2 : 0); const size_t gv = row0 + tv; const size_t gvp = row0 + (tv > 0 ? tv - 1 : 0); R.vc = *(const u32x4*)(ZR + gv * 1792 + 1024 + cv); R.vp = *(const u32x4*)(ZR + gvp * 1792 + 1024 + cv); }
}
__device__ __forceinline__ void p_scan(const Frame& F, ArgsP a) {
    const int lane_f = lane_id_fresh(), tid_f = F.wave * 64 + lane_f;
    const bf16* ZR = (const bf16*)(F.ws + WS_ZR); const bf16* A = (const bf16*)(F.ws + WS_A); const bf16* LW = (const bf16*)(F.ws + WS_LW); bf16* Y = (bf16*)(F.ws + WS_Y);
    const float* mu = a->in[I_MU]; const float* k_k = a->in[I_KK]; const float* k_a = a->in[I_KA];
    const int lane = lane_f, wave = F.wave, tid = tid_f;
    for (int item = F.vcu; item < 256; item += F.G) {
        const int bh = item >> 2, qt = item & 3, b = bh >> 3, h = bh & 7;
        const size_t row0 = (size_t)b * SEQ; const int colh = h * 64;
        const int NCH = SEQ / SC_T;
        __syncthreads();
        if (wave >= 4) {
            const int lt = tid - 256, st2 = lt >> 4, j4 = (lt & 15) * 4, col = colh + j4, s2 = lt >> 1, hf = lt & 1, cv = colh + qt * 16 + hf * 8; const bool dov = lt < 64;
            f32x4 mur = *(const f32x4*)(mu + col), muk = *(const f32x4*)(mu + 512 + col), kkc = *(const f32x4*)(k_k + col), kac = *(const f32x4*)(k_a + col);
            f32x4 m0 = *(const f32x4*)(mu + 1024 + cv), m1 = *(const f32x4*)(mu + 1024 + cv + 4);
            asm volatile("" : "+v"(mur), "+v"(muk), "+v"(kkc), "+v"(kac), "+v"(m0), "+v"(m1));
            ScanRaw R0, R1;
            scan_issue(R0, ZR, A, LW, row0, 0, st2, col, s2, cv, dov);
#define SCAN_BUILD(RR, c_) do { LAS unsigned char* bs = F.lds + ((c_) & 1) * SC_BUF; \
                _Pragma("unroll") for (int u = 0; u < 2; ++u) { const int st = st2 + 16 * u; const bool t0_ = ((c_) * SC_T + st) == 0; \
                    const f32x4 rc = {lo2f(RR.rc[u].x), hi2f(RR.rc[u].x), lo2f(RR.rc[u].y), hi2f(RR.rc[u].y)}; f32x4 rp = {lo2f(RR.rp[u].x), hi2f(RR.rp[u].x), lo2f(RR.rp[u].y), hi2f(RR.rp[u].y)}; \
                    const f32x4 kc = {lo2f(RR.kc[u].x), hi2f(RR.kc[u].x), lo2f(RR.kc[u].y), hi2f(RR.kc[u].y)}; f32x4 kp = {lo2f(RR.kp[u].x), hi2f(RR.kp[u].x), lo2f(RR.kp[u].y), hi2f(RR.kp[u].y)}; \
                    const f32x4 av = {lo2f(RR.av[u].x), hi2f(RR.av[u].x), lo2f(RR.av[u].y), hi2f(RR.av[u].y)}; const f32x4 lw = {lo2f(RR.lw[u].x), hi2f(RR.lw[u].x), lo2f(RR.lw[u].y), hi2f(RR.lw[u].y)}; \
                    if (t0_) { rp = (f32x4){0.f, 0.f, 0.f, 0.f}; kp = rp; } \
                    const f32x4 r = rc + (rp - rc) * mur, zk = kc + (kp - kc) * muk, kq = zk * ((av - 1.0f) * kac + 1.0f), kr = zk * kkc; \
                    const float ss = allsum16((kr.x * kr.x + kr.y * kr.y) + (kr.z * kr.z + kr.w * kr.w)); const float inv = 1.0f / fmaxf(sqrtf(ss), 1e-12f); \
                    const f32x4 kk = kr * inv; const f32x4 wv = {__expf(lw.x), __expf(lw.y), __expf(lw.z), __expf(lw.w)}; \
                    LAS float* dst = (LAS float*)bs + st * 64 + j4; \
                    *(LAS f32x4*)dst = wv; *(LAS f32x4*)(dst + SC_T * 64) = -kk; *(LAS f32x4*)(dst + 2 * SC_T * 64) = kk * av; *(LAS f32x4*)(dst + 3 * SC_T * 64) = kq; *(LAS f32x4*)(dst + 4 * SC_T * 64) = r; } \
                if (dov) { float vc[8], vp[8]; unpack8(RR.vc, vc); unpack8(RR.vp, vp); if ((c_) * SC_T + s2 == 0) { _Pragma("unroll") for (int i = 0; i < 8; ++i) vp[i] = 0.f; } \
                    LAS float* dv = (LAS float*)(bs + 5 * SC_T * 256) + s2 * 16 + hf * 8; \
                    *(LAS f32x4*)dv = (f32x4){vc[0] + (vp[0] - vc[0]) * m0.x, vc[1] + (vp[1] - vc[1]) * m0.y, vc[2] + (vp[2] - vc[2]) * m0.z, vc[3] + (vp[3] - vc[3]) * m0.w}; \
                    *(LAS f32x4*)(dv + 4) = (f32x4){vc[4] + (vp[4] - vc[4]) * m1.x, vc[5] + (vp[5] - vc[5]) * m1.y, vc[6] + (vp[6] - vc[6]) * m1.z, vc[7] + (vp[7] - vc[7]) * m1.w}; } } while (0)
#define SCAN_FLUSH(c_) do { if ((c_) >= 2 && dov) { LAS unsigned char* bs = F.lds + ((c_) & 1) * SC_BUF; const LAS float* yy = (const LAS float*)(bs + 5 * SC_T * 256 + SC_T * 64) + s2 * 16 + hf * 8; \
                const f32x4 y0 = *(const LAS f32x4*)yy, y1 = *(const LAS f32x4*)(yy + 4); const float v[8] = {y0.x, y0.y, y0.z, y0.w, y1.x, y1.y, y1.z, y1.w}; \
                *(u32x4*)(Y + (row0 + (size_t)((c_) - 2) * SC_T + s2) * 512 + cv) = pack8(v); } } while (0)
            for (int c = 0; c <= NCH + 1; c += 2) {
                SCAN_FLUSH(c);
                scan_issue(R1, ZR, A, LW, row0, (c + 1 < NCH ? c + 1 : NCH - 1) * SC_T, st2, col, s2, cv, dov);
                if (c < NCH) SCAN_BUILD(R0, c);
                LDS_BAR();
                SCAN_FLUSH(c + 1);
                scan_issue(R0, ZR, A, LW, row0, (c + 2 < NCH ? c + 2 : NCH - 1) * SC_T, st2, col, s2, cv, dov);
                if (c + 1 < NCH) SCAN_BUILD(R1, c + 1);
                LDS_BAR();
            }
#undef SCAN_BUILD
#undef SCAN_FLUSH
        } else {
            const int rg = lane >> 4, jl = lane & 15;
            f32x2 Sa = {0.f, 0.f}, Sb = {0.f, 0.f};
            for (int c = 0; c <= NCH + 1; c += 2) {
#pragma unroll
                for (int half = 0; half < 2; ++half) {
                    const int cc = c + half;
                    if (cc >= 1 && cc <= NCH) {
                        LAS unsigned char* bc = F.lds + ((cc + 1) & 1) * SC_BUF;
                        const LAS float* base = (const LAS float*)bc + 4 * jl;
                        const LAS float* vb = (const LAS float*)(bc + 5 * SC_T * 256) + wave * 4 + rg;
                        LAS float* yb = (LAS float*)(bc + 5 * SC_T * 256 + SC_T * 64) + wave * 4 + rg;
                        f32x4 w[2][2], nk[2][2], bb[2][2], kv[2][2], rr[2][2]; float vv1[2][2];
#define SC_LOAD(slot, g_) do { _Pragma("unroll") for (int q = 0; q < 2; ++q) { const int st_ = (g_) * 2 + q; \
                            w[slot][q] = *(const LAS f32x4*)(base + st_ * 64); nk[slot][q] = *(const LAS f32x4*)(base + SC_T * 64 + st_ * 64); bb[slot][q] = *(const LAS f32x4*)(base + 2 * SC_T * 64 + st_ * 64); \
                            kv[slot][q] = *(const LAS f32x4*)(base + 3 * SC_T * 64 + st_ * 64); rr[slot][q] = *(const LAS f32x4*)(base + 4 * SC_T * 64 + st_ * 64); vv1[slot][q] = vb[st_ * 16]; } } while (0)
                        SC_LOAD(0, 0);
#pragma unroll
                        for (int g = 0; g < SC_T / 2; ++g) {
                            const int sl = g & 1;
                            if (g + 1 < SC_T / 2) { if (sl == 0) SC_LOAD(1, g + 1); else SC_LOAD(0, g + 1); }
                            float yo[2];
#pragma unroll
                            for (int q = 0; q < 2; ++q) {
                                const f32x4 w_ = w[sl][q], nk_ = nk[sl][q], bb_ = bb[sl][q], kv_ = kv[sl][q], rr_ = rr[sl][q]; const float v = vv1[sl][q];
                                const f32x2 t0 = Sa * (f32x2){nk_.x, nk_.y} + Sb * (f32x2){nk_.z, nk_.w};
                                const float sa = allsum16(t0.x + t0.y);
                                const f32x2 vv = {v, v}, ss = {sa, sa};
                                Sa = Sa * (f32x2){w_.x, w_.y} + (ss * (f32x2){bb_.x, bb_.y} + vv * (f32x2){kv_.x, kv_.y});
                                Sb = Sb * (f32x2){w_.z, w_.w} + (ss * (f32x2){bb_.z, bb_.w} + vv * (f32x2){kv_.z, kv_.w});
                                const f32x2 t1 = Sa * (f32x2){rr_.x, rr_.y} + Sb * (f32x2){rr_.z, rr_.w};
                                yo[q] = allsum16(t1.x + t1.y);
                            }
                            if (jl == 0) { yb[(g * 2) * 16] = yo[0]; yb[(g * 2 + 1) * 16] = yo[1]; }
                        }
#undef SC_LOAD
                    }
                    LDS_BAR();
                }
            }
        }
    }
}

__device__ __forceinline__ void p_attn_naive(const Frame& F) {
    const int lane_f = lane_id_fresh(), tid_f = F.wave * 64 + lane_f;
    const bf16* Q = (const bf16*)(F.dob + DO_Q); const bf16* KC = (const bf16*)(F.ws + WS_KC); const bf16* VC = (const bf16*)(F.ws + WS_VC); bf16* YM = (bf16*)(F.ws + WS_YM);
    LAS float* Ks = (LAS float*)F.lds; LAS float* Vs = (LAS float*)(F.lds + 32 * 96 * 4);
    const int tid = tid_f;
    for (int unit = F.vcu; unit < 64 * 16; unit += F.G) {
        const int bh = unit >> 4, qb = 15 - (unit & 15), b = bh >> 3, h = bh & 7; const size_t row0 = (size_t)b * SEQ; const int t = qb * 512 + tid;
        unsigned qp[48];
        { const u32x4* qg = (const u32x4*)(Q + (row0 + t) * 768 + h * 96);
#pragma unroll
          for (int i = 0; i < 12; ++i) { const u32x4 w = qg[i]; qp[4 * i] = w.x; qp[4 * i + 1] = w.y; qp[4 * i + 2] = w.z; qp[4 * i + 3] = w.w; } }
        float o[64];
#pragma unroll
        for (int i = 0; i < 64; ++i) o[i] = 0.f;
        float mx = -INFINITY, l = 0.f;
        const int nkt = (qb + 1) * 16;
        for (int kt = 0; kt < nkt; ++kt) {
            __syncthreads();
            if (tid < 384) { const int r = tid / 12, c8 = (tid % 12) * 8; float v[8]; unpack8(*(const u32x4*)(KC + (row0 + kt * 32 + r) * 768 + h * 96 + c8), v);
#pragma unroll
                for (int i = 0; i < 8; ++i) Ks[r * 96 + c8 + i] = v[i]; }
            if (tid < 256) { const int r = tid >> 3, c8 = (tid & 7) * 8; float v[8]; unpack8(*(const u32x4*)(VC + (row0 + kt * 32 + r) * 512 + h * 64 + c8), v);
#pragma unroll
                for (int i = 0; i < 8; ++i) Vs[r * 64 + c8 + i] = v[i]; }
            __syncthreads();
            for (int kk = 0; kk < 32; ++kk) {
                const int kv = kt * 32 + kk;
                float s = 0.f; const LAS f32x4* kr = (const LAS f32x4*)(Ks + kk * 96);
#pragma unroll
                for (int i = 0; i < 24; ++i) { const f32x4 k4 = kr[i]; s += lo2f(qp[2 * i]) * k4.x + hi2f(qp[2 * i]) * k4.y + lo2f(qp[2 * i + 1]) * k4.z + hi2f(qp[2 * i + 1]) * k4.w; }
                if (kv <= t) {
                    const float mn = fmaxf(mx, s), f = exp2f(mx - mn), p = exp2f(s - mn); mx = mn; l = l * f + p;
                    const LAS f32x4* vr = (const LAS f32x4*)(Vs + kk * 64);
#pragma unroll
                    for (int i = 0; i < 16; ++i) { const f32x4 v4 = vr[i]; o[4 * i] = o[4 * i] * f + p * v4.x; o[4 * i + 1] = o[4 * i + 1] * f + p * v4.y; o[4 * i + 2] = o[4 * i + 2] * f + p * v4.z; o[4 * i + 3] = o[4 * i + 3] * f + p * v4.w; }
                }
            }
        }
        const float il = 1.f / l; u32x4* og = (u32x4*)(YM + (row0 + t) * 512 + h * 64);
#pragma unroll
        for (int i = 0; i < 8; ++i) { u32x4 w; w.x = pk2(o[8 * i] * il, o[8 * i + 1] * il); w.y = pk2(o[8 * i + 2] * il, o[8 * i + 3] * il); w.z = pk2(o[8 * i + 4] * il, o[8 * i + 5] * il); w.w = pk2(o[8 * i + 6] * il, o[8 * i + 7] * il); og[i] = w; }
    }
    __syncthreads();
}

typedef float f32x16 __attribute__((ext_vector_type(16)));
typedef short s16x4 __attribute__((ext_vector_type(4)));
__device__ __forceinline__ int crow(int r, int hi) { return (r & 3) + 8 * (r >> 2) + 4 * hi; }
__device__ __forceinline__ float max3f(float a, float b, float c) { float r; asm("v_max3_f32 %0, %1, %2, %3" : "=v"(r) : "v"(a), "v"(b), "v"(c)); return r; }
__device__ __forceinline__ float max2f(float a, float b) { float r; asm("v_max_f32_e32 %0, %1, %2" : "=v"(r) : "v"(a), "v"(b)); return r; }
__device__ __forceinline__ float xhalf_max(float x) { auto rr = __builtin_amdgcn_permlane32_swap(__float_as_uint(x), __float_as_uint(x), false, false); return max2f(__uint_as_float(rr[0]), __uint_as_float(rr[1])); }
__device__ __forceinline__ float xhalf_sum(float x) { auto rr = __builtin_amdgcn_permlane32_swap(__float_as_uint(x), __float_as_uint(x), false, false); return __uint_as_float(rr[0]) + __uint_as_float(rr[1]); }
__device__ __forceinline__ bf16x8 packp(const f32x16& p, int s2) {
    u32x4 w; w.x = pk2(p[8 * s2 + 0], p[8 * s2 + 1]); w.y = pk2(p[8 * s2 + 2], p[8 * s2 + 3]); w.z = pk2(p[8 * s2 + 4], p[8 * s2 + 5]); w.w = pk2(p[8 * s2 + 6], p[8 * s2 + 7]);
    return __builtin_bit_cast(bf16x8, w);
}
__device__ __forceinline__ void p_attn_mfma(const Frame& F) {
    const int lane_f = lane_id_fresh(), tid_f = F.wave * 64 + lane_f;
    const bf16* Q = (const bf16*)(F.dob + DO_Q); const bf16* KC = (const bf16*)(F.ws + WS_KC); const bf16* VC = (const bf16*)(F.ws + WS_VC); bf16* YM = (bf16*)(F.ws + WS_YM);
    constexpr int KST = 208, VST = 192, KBYTES = 64 * KST, SUB = KBYTES + 64 * VST, BUF = 2 * SUB;
    const int tid = tid_f, lane = lane_f, wave = F.wave, r = lane & 31, hi = lane >> 5;
    int kg[3], kl[3], vg[2], vl[2];
#pragma unroll
    for (int i = 0; i < 3; ++i) { const int c = tid + 512 * i, row = c / 12, pc = c % 12; kg[i] = row * 768 + pc * 8; kl[i] = (row >> 6) * SUB + (row & 63) * KST + pc * 16; }
#pragma unroll
    for (int i = 0; i < 2; ++i) { const int c = tid + 512 * i, row = c >> 3, pc = c & 7; vg[i] = row * 512 + pc * 8; vl[i] = (row >> 6) * SUB + KBYTES + (row & 63) * VST + pc * 16; }
    const int g4 = lane >> 4, li = lane & 15;
    const int vtr = (4 * (g4 >> 1) + (li >> 2)) * VST + (16 * (g4 & 1) + 4 * (li & 3)) * 2;
    const int kfr = r * KST + hi * 16;
    LAS unsigned char* lds = F.lds;
    for (int item = F.vcu; item < 1024; item += F.G) {
        const int bh = item >> 4, sidx = item & 15, b = bh >> 3, h = bh & 7; const size_t row0 = (size_t)b * SEQ;
        const bf16* Kg = KC + row0 * 768 + h * 96; const bf16* Vg = VC + row0 * 512 + h * 64;
        for (int uu = 0; uu < 2; ++uu) {
            const int qb = uu == 0 ? 31 - sidx : sidx, q0 = qb * 256, NT = (q0 + 256) / 128;
            const int qw = q0 + wave * 32;
            bf16x8 qf[6];
            { const bf16* qp = Q + (row0 + qw + r) * 768 + h * 96 + hi * 8;
#pragma unroll
              for (int s = 0; s < 6; ++s) qf[s] = *(const bf16x8*)(qp + 16 * s); }
            f32x16 o0 = {}, o1 = {}, negm = {}; float m = 0.f, l = 0.f;
            u32x4 ak[3], av[2];
#pragma unroll
            for (int i = 0; i < 3; ++i) ak[i] = *(const u32x4*)(Kg + kg[i]);
#pragma unroll
            for (int i = 0; i < 2; ++i) av[i] = *(const u32x4*)(Vg + vg[i]);
            asm volatile("" : "+v"(qf[0]), "+v"(qf[1]), "+v"(qf[2]), "+v"(qf[3]), "+v"(qf[4]), "+v"(qf[5]));
            LDS_BAR();
#pragma unroll
            for (int i = 0; i < 3; ++i) *(LAS u32x4*)(lds + kl[i]) = ak[i];
#pragma unroll
            for (int i = 0; i < 2; ++i) *(LAS u32x4*)(lds + vl[i]) = av[i];
            LDS_BAR();
            for (int t = 0; t < NT; ++t) {
                LAS unsigned char* bb = lds + (t & 1) * BUF;
                { const int tn = (t + 1 < NT) ? t + 1 : t;
                  const bf16* kgp = Kg + (size_t)tn * 128 * 768; const bf16* vgp = Vg + (size_t)tn * 128 * 512;
#pragma unroll
                  for (int i = 0; i < 3; ++i) ak[i] = *(const u32x4*)(kgp + kg[i]);
#pragma unroll
                  for (int i = 0; i < 2; ++i) av[i] = *(const u32x4*)(vgp + vg[i]); }
#pragma unroll
                for (int sub = 0; sub < 2; ++sub) {
                    const int tt = 2 * t + sub;
                    if (64 * tt <= qw + 31) {
                        LAS unsigned char* kb = bb + sub * SUB; LAS unsigned char* vb = kb + KBYTES;
                        bf16x8 kf0[6], kf1[6];
#pragma unroll
                        for (int s = 0; s < 6; ++s) { kf0[s] = *(const LAS bf16x8*)(kb + kfr + s * 32); kf1[s] = *(const LAS bf16x8*)(kb + kfr + 32 * KST + s * 32); }
                        __builtin_amdgcn_sched_barrier(0);
                        f32x16 p0 = negm, p1 = negm;
#pragma unroll
                        for (int s = 0; s < 6; ++s) { p0 = __builtin_amdgcn_mfma_f32_32x32x16_bf16(kf0[s], qf[s], p0, 0, 0, 0); p1 = __builtin_amdgcn_mfma_f32_32x32x16_bf16(kf1[s], qf[s], p1, 0, 0, 0); }
                        if (64 * tt + 63 > qw) {
                            const int qrel = qw + r - 64 * tt;
#pragma unroll
                            for (int rg = 0; rg < 16; ++rg) { const int kv = crow(rg, hi); if (kv > qrel) p0[rg] = -INFINITY; if (kv + 32 > qrel) p1[rg] = -INFINITY; }
                        }
                        float mx;
                        { float a = max3f(p0[0], p0[1], p1[0]), b2 = max3f(p0[2], p0[3], p1[1]); a = max3f(a, p1[2], p1[3]);
#pragma unroll
                          for (int rg = 4; rg < 16; rg += 4) { a = max3f(a, p0[rg], p0[rg + 1]); b2 = max3f(b2, p0[rg + 2], p0[rg + 3]); a = max3f(a, p1[rg], p1[rg + 1]); b2 = max3f(b2, p1[rg + 2], p1[rg + 3]); }
                          mx = xhalf_max(max2f(a, b2)); }
                        if (!__all(mx <= 8.0f)) {
                            const float dl = max2f(mx, 0.f), f = __builtin_amdgcn_exp2f(-dl); m += dl; l *= f;
#pragma unroll
                            for (int rg = 0; rg < 16; ++rg) { p0[rg] -= dl; p1[rg] -= dl; o0[rg] *= f; o1[rg] *= f; negm[rg] = -m; }
                        }
                        float rs = 0.f;
#pragma unroll
                        for (int rg = 0; rg < 16; ++rg) { p0[rg] = __builtin_amdgcn_exp2f(p0[rg]); p1[rg] = __builtin_amdgcn_exp2f(p1[rg]); rs += p0[rg] + p1[rg]; }
                        l += rs;
#pragma unroll
                        for (int hh = 0; hh < 2; ++hh)
#pragma unroll
                            for (int s2 = 0; s2 < 2; ++s2) { const bf16x8 pf = packp(hh == 0 ? p0 : p1, s2);
#pragma unroll
                                for (int db = 0; db < 2; ++db) { LAS unsigned char* vp_ = vb + vtr + (32 * hh + 16 * s2) * VST + db * 64;
                                    const s16x4 lo = __builtin_bit_cast(s16x4, __builtin_amdgcn_ds_read_tr16_b64_v4i16((LAS s16x4*)vp_));
                                    const s16x4 hi4 = __builtin_bit_cast(s16x4, __builtin_amdgcn_ds_read_tr16_b64_v4i16((LAS s16x4*)(vp_ + 8 * VST)));
                                    const bf16x8 vf = (bf16x8){lo[0], lo[1], lo[2], lo[3], hi4[0], hi4[1], hi4[2], hi4[3]};
                                    if (db == 0) o0 = __builtin_amdgcn_mfma_f32_32x32x16_bf16(vf, pf, o0, 0, 0, 0); else o1 = __builtin_amdgcn_mfma_f32_32x32x16_bf16(vf, pf, o1, 0, 0, 0); } }
                    }
                }
                { LAS unsigned char* nb = lds + ((t + 1) & 1) * BUF;
#pragma unroll
                  for (int i = 0; i < 3; ++i) *(LAS u32x4*)(nb + kl[i]) = ak[i];
#pragma unroll
                  for (int i = 0; i < 2; ++i) *(LAS u32x4*)(nb + vl[i]) = av[i]; }
                LDS_BAR();
            }
            const float il = 1.0f / xhalf_sum(l);
            bf16* op = YM + (row0 + qw + r) * 512 + h * 64 + 4 * hi;
#pragma unroll
            for (int gq = 0; gq < 4; ++gq) { u32x2 w0, w1;
                w0.x = pk2(o0[4 * gq] * il, o0[4 * gq + 1] * il); w0.y = pk2(o0[4 * gq + 2] * il, o0[4 * gq + 3] * il);
                w1.x = pk2(o1[4 * gq] * il, o1[4 * gq + 1] * il); w1.y = pk2(o1[4 * gq + 2] * il, o1[4 * gq + 3] * il);
                *(u32x2*)(op + 8 * gq) = w0; *(u32x2*)(op + 32 + 8 * gq) = w1; }
        }
    }
    __syncthreads();
}

constexpr int CS_CH = 256, CS_NCH = SEQ / CS_CH;
constexpr int CS_RS = 144;
constexpr int CS_IMG = 16 * CS_RS;
constexpr int CS_WAVE = 8 * CS_IMG + 512;
enum { IM_A = 0, IM_R = 1, IM_B = 2, IM_K = 3, IM_BH = 4, IM_KH = 5, IM_V = 6, IM_G = 7 };
constexpr size_t DO_CSP = 64 * MiB, DO_CSG = 128 * MiB, DO_CSZ = 192 * MiB;
__device__ __forceinline__ int crow8(int q, int hi) { return (q & 3) + 8 * ((q >> 2) & 1) + 4 * hi; }
template <int N> __device__ __forceinline__ float dpp_shr0(float x) { return __builtin_bit_cast(float, __builtin_amdgcn_update_dpp(0, __builtin_bit_cast(int, x), 0x110 + N, 0xf, 0xf, true)); }
__device__ __forceinline__ float rowscan16(float x) { x += dpp_shr0<1>(x); x += dpp_shr0<2>(x); x += dpp_shr0<4>(x); x += dpp_shr0<8>(x); return x; }
__device__ __forceinline__ float xsum_16_32(float v) {
    { auto r = __builtin_amdgcn_permlane16_swap(__float_as_uint(v), __float_as_uint(v), false, false); v = __uint_as_float(r[0]) + __uint_as_float(r[1]); }
    { auto r = __builtin_amdgcn_permlane32_swap(__float_as_uint(v), __float_as_uint(v), false, false); v = __uint_as_float(r[0]) + __uint_as_float(r[1]); }
    return v;
}
__device__ __forceinline__ bf16x8 cs_rowfrag(const LAS unsigned char* rowp, int hi, int ks) {
    const LAS unsigned char* p = rowp + (16 * ks + 4 * hi) * 2; const u32x2 a = *(const LAS u32x2*)p, b = *(const LAS u32x2*)(p + 16);
    return __builtin_bit_cast(bf16x8, (u32x4){a.x, a.y, b.x, b.y});
}
__device__ __forceinline__ bf16x8 cs_trfrag(LAS unsigned char* img, int cb, int lane) {
    const int g4 = lane >> 4, li = lane & 15; LAS unsigned char* p = img + (4 * (g4 >> 1) + (li >> 2)) * CS_RS + (32 * cb + 16 * (g4 & 1) + 4 * (li & 3)) * 2;
    const s16x4 lo = __builtin_bit_cast(s16x4, __builtin_amdgcn_ds_read_tr16_b64_v4i16((LAS s16x4*)p));
    const s16x4 h4 = __builtin_bit_cast(s16x4, __builtin_amdgcn_ds_read_tr16_b64_v4i16((LAS s16x4*)(p + 8 * CS_RS)));
    return (bf16x8){lo[0], lo[1], lo[2], lo[3], h4[0], h4[1], h4[2], h4[3]};
}
__device__ __forceinline__ bf16x8 cs_zero8() { return (bf16x8){0, 0, 0, 0, 0, 0, 0, 0}; }
struct CsIn { const bf16 *ZR, *A, *LW, *G; const float *mu, *k_k, *k_a, *r_k; };
template <bool USE_V, bool WITH_Y>
__device__ __forceinline__ void cs_prep(const CsIn& in, size_t row0, int tok0, int h, LAS unsigned char* wl, int lane) {
    const int t = lane & 15, jq = lane >> 4, tok = tok0 + t; const bool first = tok == 0;
    const size_t g = row0 + tok, gp = row0 + (first ? 0 : tok - 1); const int c0 = h * 64 + 16 * jq;
    LAS float* gct = (LAS float*)(wl + 8 * CS_IMG); LAS float* btt = gct + 64;
    u32x4 Lrc[2], Lrp[2], Lkc[2], Lkp[2], Lav[2], Llw[2], Lvc[2], Lvp[2];
#pragma unroll
    for (int hf = 0; hf < 2; ++hf) { const int cc = c0 + 8 * hf;
        Lkc[hf] = *(const u32x4*)(in.ZR + g * 1792 + 512 + cc); Lkp[hf] = *(const u32x4*)(in.ZR + gp * 1792 + 512 + cc);
        Lrc[hf] = *(const u32x4*)(in.ZR + g * 1792 + cc); Lrp[hf] = *(const u32x4*)(in.ZR + gp * 1792 + cc);
        Lav[hf] = *(const u32x4*)(in.A + g * 512 + cc); Llw[hf] = *(const u32x4*)(in.LW + g * 512 + cc);
        if (USE_V) { Lvc[hf] = *(const u32x4*)(in.ZR + g * 1792 + 1024 + cc); Lvp[hf] = *(const u32x4*)(in.ZR + gp * 1792 + 1024 + cc); }
    }
    float inv;
    { float ss = 0.f;
#pragma unroll
      for (int hf = 0; hf < 2; ++hf) { float kc[8], kp[8]; unpack8(Lkc[hf], kc); unpack8(Lkp[hf], kp);
          const f32x4 m0 = *(const f32x4*)(in.mu + 512 + c0 + 8 * hf), m1 = *(const f32x4*)(in.mu + 512 + c0 + 8 * hf + 4), q0 = *(const f32x4*)(in.k_k + c0 + 8 * hf), q1 = *(const f32x4*)(in.k_k + c0 + 8 * hf + 4);
          const float mm[8] = {m0.x, m0.y, m0.z, m0.w, m1.x, m1.y, m1.z, m1.w}, qq[8] = {q0.x, q0.y, q0.z, q0.w, q1.x, q1.y, q1.z, q1.w};
#pragma unroll
          for (int e = 0; e < 8; ++e) { const float zk = kc[e] + ((first ? 0.f : kp[e]) - kc[e]) * mm[e]; const float kr = zk * qq[e]; ss += kr * kr; } }
      inv = 1.0f / fmaxf(sqrtf(xsum_16_32(ss)), 1e-12f); }
    float btacc = 0.f;
#pragma unroll
    for (int hf = 0; hf < 2; ++hf) {
        const int cc = c0 + 8 * hf;
        u32x4 Lgg = {}; if (WITH_Y) Lgg = *(const u32x4*)(in.G + g * 512 + cc);
        float rc[8], rp[8], kc[8], kp[8], av[8], lw[8];
        unpack8(Lrc[hf], rc); unpack8(Lrp[hf], rp); unpack8(Lkc[hf], kc); unpack8(Lkp[hf], kp); unpack8(Lav[hf], av); unpack8(Llw[hf], lw);
        float mr[8], mk[8], qk[8], qa[8], qr[8];
        { const f32x4 a0 = *(const f32x4*)(in.mu + cc), a1 = *(const f32x4*)(in.mu + cc + 4), b0 = *(const f32x4*)(in.mu + 512 + cc), b1 = *(const f32x4*)(in.mu + 512 + cc + 4);
          const f32x4 c0_ = *(const f32x4*)(in.k_k + cc), c1_ = *(const f32x4*)(in.k_k + cc + 4), d0 = *(const f32x4*)(in.k_a + cc), d1 = *(const f32x4*)(in.k_a + cc + 4);
          mr[0] = a0.x; mr[1] = a0.y; mr[2] = a0.z; mr[3] = a0.w; mr[4] = a1.x; mr[5] = a1.y; mr[6] = a1.z; mr[7] = a1.w;
          mk[0] = b0.x; mk[1] = b0.y; mk[2] = b0.z; mk[3] = b0.w; mk[4] = b1.x; mk[5] = b1.y; mk[6] = b1.z; mk[7] = b1.w;
          qk[0] = c0_.x; qk[1] = c0_.y; qk[2] = c0_.z; qk[3] = c0_.w; qk[4] = c1_.x; qk[5] = c1_.y; qk[6] = c1_.z; qk[7] = c1_.w;
          qa[0] = d0.x; qa[1] = d0.y; qa[2] = d0.z; qa[3] = d0.w; qa[4] = d1.x; qa[5] = d1.y; qa[6] = d1.z; qa[7] = d1.w; }
        if (WITH_Y) { const f32x4 e0 = *(const f32x4*)(in.r_k + cc), e1 = *(const f32x4*)(in.r_k + cc + 4); qr[0] = e0.x; qr[1] = e0.y; qr[2] = e0.z; qr[3] = e0.w; qr[4] = e1.x; qr[5] = e1.y; qr[6] = e1.z; qr[7] = e1.w; }
        float oA[8], oR[8], oB[8], oK[8], oBH[8], oKH[8];
#pragma unroll
        for (int e = 0; e < 8; ++e) {
            const float r = rc[e] + ((first ? 0.f : rp[e]) - rc[e]) * mr[e]; const float zk = kc[e] + ((first ? 0.f : kp[e]) - kc[e]) * mk[e];
            const float kq = zk * (1.f + (av[e] - 1.f) * qa[e]); const float kk = zk * qk[e] * inv; const float b = kk * av[e];
            const float Lg = rowscan16(lw[e]); const float eLg = __builtin_amdgcn_exp2f(1.4426950408889634f * Lg); const float enLg = __builtin_amdgcn_rcpf(eLg);
            const float eLgm = __builtin_bit_cast(float, __builtin_amdgcn_update_dpp(0x3f800000, __builtin_bit_cast(int, eLg), 0x111, 0xf, 0xf, false));
            const float eC = __builtin_bit_cast(float, __builtin_amdgcn_ds_bpermute(((lane & 48) | 15) << 2, __builtin_bit_cast(int, eLg)));
            oA[e] = -kk * eLgm; oR[e] = r * eLg; oB[e] = b * enLg; oK[e] = kq * enLg; oBH[e] = oB[e] * eC; oKH[e] = oK[e] * eC;
            if (WITH_Y) btacc += r * kq * qr[e];
            if (t == 15) gct[16 * jq + 8 * hf + e] = eC;
        }
        const int wo = t * CS_RS + (16 * jq + 8 * hf) * 2;
        *(LAS u32x4*)(wl + IM_A * CS_IMG + wo) = pack8(oA); *(LAS u32x4*)(wl + IM_R * CS_IMG + wo) = pack8(oR); *(LAS u32x4*)(wl + IM_B * CS_IMG + wo) = pack8(oB);
        *(LAS u32x4*)(wl + IM_K * CS_IMG + wo) = pack8(oK); *(LAS u32x4*)(wl + IM_BH * CS_IMG + wo) = pack8(oBH); *(LAS u32x4*)(wl + IM_KH * CS_IMG + wo) = pack8(oKH);
        if (USE_V) { float vc[8], vp[8], o[8]; unpack8(Lvc[hf], vc); unpack8(Lvp[hf], vp);
            const f32x4 a0 = *(const f32x4*)(in.mu + 1024 + cc), a1 = *(const f32x4*)(in.mu + 1024 + cc + 4); const float mv[8] = {a0.x, a0.y, a0.z, a0.w, a1.x, a1.y, a1.z, a1.w};
#pragma unroll
            for (int e = 0; e < 8; ++e) o[e] = vc[e] + ((first ? 0.f : vp[e]) - vc[e]) * mv[e];
            *(LAS u32x4*)(wl + IM_V * CS_IMG + wo) = pack8(o); }
        if (WITH_Y) *(LAS u32x4*)(wl + IM_G * CS_IMG + wo) = Lgg;
    }
    if (WITH_Y) { btacc = xsum_16_32(btacc); if (lane < 16) btt[lane] = btacc; }
}
struct CsFr { bf16x8 fAR[4], aL1, aL2, aL4, aL8, aLkMk, aMb; };
__device__ __forceinline__ void cs_gram(CsFr& fr, LAS unsigned char* wl, int lane) {
    const int hi = lane >> 5, row = lane & 15; const bool up = (lane & 16) != 0;
    const LAS unsigned char* rpAR = wl + (up ? IM_R : IM_A) * CS_IMG + row * CS_RS; const LAS unsigned char* rpBK = wl + (up ? IM_K : IM_B) * CS_IMG + row * CS_RS;
#pragma unroll
    for (int ks = 0; ks < 4; ++ks) fr.fAR[ks] = cs_rowfrag(rpAR, hi, ks);
    f32x16 F1 = {}, F2 = {};
#pragma unroll
    for (int ks = 0; ks < 4; ++ks) { const bf16x8 fBK = cs_rowfrag(rpBK, hi, ks);
        F1 = __builtin_amdgcn_mfma_f32_32x32x16_bf16(fBK, fr.fAR[ks], F1, 0, 0, 0);
        F2 = __builtin_amdgcn_mfma_f32_32x32x16_bf16(fr.fAR[ks], fBK, F2, 0, 0, 0); }
#pragma unroll
    for (int q = 0; q < 8; ++q) { const int s = crow8(q, hi); const bool k1 = up ? (s <= row) : (s < row);
        F1[q] = k1 ? F1[q] : 0.f; F1[8 + q] = k1 ? F1[8 + q] : 0.f; F2[q] = (!up && row < s) ? F2[q] : 0.f; }
    const bf16x8 f1lo = packp(F1, 0);
    fr.aL1 = up ? cs_zero8() : f1lo;
    fr.aMb = up ? f1lo : cs_zero8();
    fr.aLkMk = packp(F1, 1);
    const bf16x8 p2 = packp(F2, 0);
    const f32x16 z16 = {};
    const f32x16 Q1 = __builtin_amdgcn_mfma_f32_32x32x16_bf16(p2, fr.aL1, z16, 0, 0, 0), Q2 = __builtin_amdgcn_mfma_f32_32x32x16_bf16(fr.aL1, p2, z16, 0, 0, 0);
    fr.aL2 = packp(Q1, 0); const bf16x8 p2b = packp(Q2, 0);
    const f32x16 R1 = __builtin_amdgcn_mfma_f32_32x32x16_bf16(p2b, fr.aL2, z16, 0, 0, 0), R2 = __builtin_amdgcn_mfma_f32_32x32x16_bf16(fr.aL2, p2b, z16, 0, 0, 0);
    fr.aL4 = packp(R1, 0); const bf16x8 p2c = packp(R2, 0);
    const f32x16 S1 = __builtin_amdgcn_mfma_f32_32x32x16_bf16(p2c, fr.aL4, z16, 0, 0, 0);
    fr.aL8 = packp(S1, 0);
}
template <bool USE_V, bool WITH_Y>
__device__ __forceinline__ void cs_apply(f32x16 (&Z)[2][2], f32x16 (&D)[2], const CsFr& fr, LAS unsigned char* wl, int lane) {
    const int hi = lane >> 5;
    bf16x8 vf[2];
    if (USE_V) { vf[0] = cs_trfrag(wl + IM_V * CS_IMG, 0, lane); vf[1] = cs_trfrag(wl + IM_V * CS_IMG, 1, lane); }
#pragma unroll
    for (int nb = 0; nb < 2; ++nb) { f32x16 d = {};
#pragma unroll
        for (int jb = 0; jb < 2; ++jb)
#pragma unroll
            for (int k2 = 0; k2 < 2; ++k2) d = __builtin_amdgcn_mfma_f32_32x32x16_bf16(fr.fAR[2 * jb + k2], packp(Z[jb][nb], k2), d, 0, 0, 0);
        if (USE_V) d = __builtin_amdgcn_mfma_f32_32x32x16_bf16(fr.aLkMk, vf[nb], d, 0, 0, 0);
        D[nb] = d; }
#pragma unroll
    for (int nb = 0; nb < 2; ++nb) {
        D[nb] = __builtin_amdgcn_mfma_f32_32x32x16_bf16(fr.aL8, packp(D[nb], 0), D[nb], 0, 0, 0);
        D[nb] = __builtin_amdgcn_mfma_f32_32x32x16_bf16(fr.aL4, packp(D[nb], 0), D[nb], 0, 0, 0);
        D[nb] = __builtin_amdgcn_mfma_f32_32x32x16_bf16(fr.aL2, packp(D[nb], 0), D[nb], 0, 0, 0);
        D[nb] = __builtin_amdgcn_mfma_f32_32x32x16_bf16(fr.aL1, packp(D[nb], 0), D[nb], 0, 0, 0);
    }
    const bf16x8 u0 = packp(D[0], 0), u1 = packp(D[1], 0);
    if (WITH_Y) { D[0] = __builtin_amdgcn_mfma_f32_32x32x16_bf16(fr.aMb, u0, D[0], 0, 0, 0); D[1] = __builtin_amdgcn_mfma_f32_32x32x16_bf16(fr.aMb, u1, D[1], 0, 0, 0); }
    const LAS float* gct = (const LAS float*)(wl + 8 * CS_IMG);
#pragma unroll
    for (int jb = 0; jb < 2; ++jb) {
        const bf16x8 fb = cs_trfrag(wl + IM_BH * CS_IMG, jb, lane); bf16x8 fk = cs_zero8(); if (USE_V) fk = cs_trfrag(wl + IM_KH * CS_IMG, jb, lane);
        float gc[16];
#pragma unroll
        for (int g4 = 0; g4 < 4; ++g4) { const f32x4 x = *(const LAS f32x4*)(gct + 32 * jb + 8 * g4 + 4 * hi); gc[4 * g4] = x.x; gc[4 * g4 + 1] = x.y; gc[4 * g4 + 2] = x.z; gc[4 * g4 + 3] = x.w; }
#pragma unroll
        for (int nb = 0; nb < 2; ++nb) { f32x16 z = Z[jb][nb];
#pragma unroll
            for (int q = 0; q < 16; ++q) z[q] *= gc[q];
            z = __builtin_amdgcn_mfma_f32_32x32x16_bf16(fb, nb == 0 ? u0 : u1, z, 0, 0, 0);
            if (USE_V) z = __builtin_amdgcn_mfma_f32_32x32x16_bf16(fk, vf[nb], z, 0, 0, 0);
            Z[jb][nb] = z; }
    }
}
__device__ __forceinline__ void cs_apply_pk(bf16x8 (&Zp)[2][2][2], f32x16 (&D)[2], const CsFr& fr, LAS unsigned char* wl, int lane) {
    const int hi = lane >> 5;
#pragma unroll
    for (int nb = 0; nb < 2; ++nb) { f32x16 d = {};
#pragma unroll
        for (int jb = 0; jb < 2; ++jb)
#pragma unroll
            for (int k2 = 0; k2 < 2; ++k2) d = __builtin_amdgcn_mfma_f32_32x32x16_bf16(fr.fAR[2 * jb + k2], Zp[jb][nb][k2], d, 0, 0, 0);
        D[nb] = d; }
#pragma unroll
    for (int nb = 0; nb < 2; ++nb) {
        D[nb] = __builtin_amdgcn_mfma_f32_32x32x16_bf16(fr.aL8, packp(D[nb], 0), D[nb], 0, 0, 0);
        D[nb] = __builtin_amdgcn_mfma_f32_32x32x16_bf16(fr.aL4, packp(D[nb], 0), D[nb], 0, 0, 0);
        D[nb] = __builtin_amdgcn_mfma_f32_32x32x16_bf16(fr.aL2, packp(D[nb], 0), D[nb], 0, 0, 0);
        D[nb] = __builtin_amdgcn_mfma_f32_32x32x16_bf16(fr.aL1, packp(D[nb], 0), D[nb], 0, 0, 0);
    }
    const bf16x8 u0 = packp(D[0], 0), u1 = packp(D[1], 0);
    const LAS float* gct = (const LAS float*)(wl + 8 * CS_IMG);
#pragma unroll
    for (int jb = 0; jb < 2; ++jb) {
        const bf16x8 fb = cs_trfrag(wl + IM_BH * CS_IMG, jb, lane);
        float gc[16];
#pragma unroll
        for (int g4 = 0; g4 < 4; ++g4) { const f32x4 x = *(const LAS f32x4*)(gct + 32 * jb + 8 * g4 + 4 * hi); gc[4 * g4] = x.x; gc[4 * g4 + 1] = x.y; gc[4 * g4 + 2] = x.z; gc[4 * g4 + 3] = x.w; }
#pragma unroll
        for (int nb = 0; nb < 2; ++nb) { f32x16 z;
#pragma unroll
            for (int k2 = 0; k2 < 2; ++k2) { float e[8]; unpack8(__builtin_bit_cast(u32x4, Zp[jb][nb][k2]), e);
#pragma unroll
                for (int q = 0; q < 8; ++q) z[8 * k2 + q] = e[q] * gc[8 * k2 + q]; }
            z = __builtin_amdgcn_mfma_f32_32x32x16_bf16(fb, nb == 0 ? u0 : u1, z, 0, 0, 0);
            Zp[jb][nb][0] = packp(z, 0); Zp[jb][nb][1] = packp(z, 1); }
    }
}
template <bool USE_V, bool WITH_Y>
__device__ __forceinline__ void cs_step(f32x16 (&Z)[2][2], f32x16 (&D)[2], LAS unsigned char* wl, int lane) { CsFr fr; cs_gram(fr, wl, lane); cs_apply<USE_V, WITH_Y>(Z, D, fr, wl, lane); }
__device__ __forceinline__ void p_cs_a(const Frame& F, ArgsP a) {
    const int lane = lane_id_fresh();
    LAS unsigned char* wl = F.lds + F.wave * CS_WAVE;
    CsIn in{(const bf16*)(F.ws + WS_ZR), (const bf16*)(F.ws + WS_A), (const bf16*)(F.ws + WS_LW), (const bf16*)(F.dob + DO_G), a->in[I_MU], a->in[I_KK], a->in[I_KA], a->in[I_RK]};
    bf16* Pm = (bf16*)(F.dob + DO_CSP); bf16* Gf = (bf16*)(F.dob + DO_CSG);
    const int hi = lane >> 5;
    for (int uc = F.gw; uc < 64 * CS_NCH; uc += F.NGW) {
        const int bh = uc / CS_NCH, c = uc % CS_NCH, b = bh >> 3, h = bh & 7; const size_t row0 = (size_t)b * SEQ;
        f32x16 ZG[2][2], D[2]; bf16x8 ZP[2][2][2];
#pragma unroll
        for (int jb = 0; jb < 2; ++jb)
#pragma unroll
            for (int nb = 0; nb < 2; ++nb) { f32x16 z = {}; ZG[jb][nb] = z;
                if (jb == nb) {
#pragma unroll
                    for (int q = 0; q < 16; ++q) z[q] = (crow(q, hi) == (lane & 31)) ? 1.f : 0.f; }
                ZP[jb][nb][0] = packp(z, 0); ZP[jb][nb][1] = packp(z, 1); }
        for (int sc = 0; sc < CS_CH / 16; ++sc) { int ln = lane; asm volatile("" : "+v"(ln));
            cs_prep<true, false>(in, row0, c * CS_CH + sc * 16, h, wl, ln); asm volatile("s_waitcnt lgkmcnt(0)" ::: "memory");
            CsFr fr; cs_gram(fr, wl, ln);
            cs_apply_pk(ZP, D, fr, wl, ln); cs_apply<true, false>(ZG, D, fr, wl, ln); asm volatile("s_waitcnt lgkmcnt(0)" ::: "memory"); }
        int lo_ = lane; asm volatile("" : "+v"(lo_)); const int hi_o = lo_ >> 5;
        {
            LAS unsigned short* tb = (LAS unsigned short*)(wl + 4 * hi_o * CS_RS + (lo_ & 31) * 2);
#pragma unroll
            for (int jb = 0; jb < 2; ++jb)
#pragma unroll
                for (int nb = 0; nb < 2; ++nb)
#pragma unroll
                    for (int q = 0; q < 16; ++q) tb[((32 * jb + (q & 3) + 8 * (q >> 2)) * CS_RS + 64 * nb) / 2] = (unsigned short)ZP[jb][nb][q >> 3][q & 7];
            bf16* dst = Pm + (size_t)uc * 4096;
#pragma unroll
            for (int i = 0; i < 8; ++i) { const int ch = lo_ + 64 * i, rr = ch >> 3, c8 = (ch & 7) * 8; *(u32x4*)(dst + rr * 64 + c8) = *(const LAS u32x4*)(wl + rr * CS_RS + c8 * 2); }
            asm volatile("s_waitcnt lgkmcnt(0)" ::: "memory");
        }
        {
            bf16* dst = Gf + (size_t)uc * 4096;
#pragma unroll
            for (int jb = 0; jb < 2; ++jb)
#pragma unroll
                for (int nb = 0; nb < 2; ++nb) { u32x4 w0, w1; const f32x16& z = ZG[jb][nb];
                    w0.x = pk2(z[0], z[1]); w0.y = pk2(z[2], z[3]); w0.z = pk2(z[4], z[5]); w0.w = pk2(z[6], z[7]); w1.x = pk2(z[8], z[9]); w1.y = pk2(z[10], z[11]); w1.z = pk2(z[12], z[13]); w1.w = pk2(z[14], z[15]);
                    u32x4* p = (u32x4*)(dst + ((jb * 2 + nb) * 64 + lo_) * 16); p[0] = w0; p[1] = w1; }
        }
    }
}
struct CsB { u32x2 p[2][2][2][2]; u32x4 g[2][2]; };
__device__ __forceinline__ void csb_load(CsB& X, const bf16* Pm, const bf16* Gf, size_t uc, int nb, int lane) {
    const int hi = lane >> 5, r = lane & 31; const bf16* Pc = Pm + uc * 4096;
#pragma unroll
    for (int mb = 0; mb < 2; ++mb) {
#pragma unroll
        for (int jb = 0; jb < 2; ++jb)
#pragma unroll
            for (int k2 = 0; k2 < 2; ++k2) { const bf16* pr = Pc + (32 * mb + r) * 64 + 32 * jb + 16 * k2 + 4 * hi; X.p[mb][jb][k2][0] = *(const u32x2*)pr; X.p[mb][jb][k2][1] = *(const u32x2*)(pr + 8); }
        const u32x4* gp = (const u32x4*)(Gf + uc * 4096 + ((mb * 2 + nb) * 64 + lane) * 16); X.g[mb][0] = gp[0]; X.g[mb][1] = gp[1]; }
}
__device__ __forceinline__ void csb_step(f32x16 (&Z)[2], const CsB& X, bf16* Zf, size_t uc, int nb, int lane) {
#pragma unroll
    for (int jb = 0; jb < 2; ++jb) { u32x4 w0, w1; const f32x16& z = Z[jb];
        w0.x = pk2(z[0], z[1]); w0.y = pk2(z[2], z[3]); w0.z = pk2(z[4], z[5]); w0.w = pk2(z[6], z[7]); w1.x = pk2(z[8], z[9]); w1.y = pk2(z[10], z[11]); w1.z = pk2(z[12], z[13]); w1.w = pk2(z[14], z[15]);
        u32x4* p = (u32x4*)(Zf + uc * 4096 + ((jb * 2 + nb) * 64 + lane) * 16); p[0] = w0; p[1] = w1; }
    f32x16 N[2];
#pragma unroll
    for (int mb = 0; mb < 2; ++mb) { float g0[8], g1[8]; unpack8(X.g[mb][0], g0); unpack8(X.g[mb][1], g1);
#pragma unroll
        for (int q = 0; q < 8; ++q) { N[mb][q] = g0[q]; N[mb][8 + q] = g1[q]; } }
#pragma unroll
    for (int jb = 0; jb < 2; ++jb)
#pragma unroll
        for (int k2 = 0; k2 < 2; ++k2) { const bf16x8 zb = packp(Z[jb], k2);
#pragma unroll
            for (int mb = 0; mb < 2; ++mb) { const u32x2 x0 = X.p[mb][jb][k2][0], x1 = X.p[mb][jb][k2][1];
                N[mb] = __builtin_amdgcn_mfma_f32_32x32x16_bf16(__builtin_bit_cast(bf16x8, (u32x4){x0.x, x0.y, x1.x, x1.y}), zb, N[mb], 0, 0, 0); } }
    Z[0] = N[0]; Z[1] = N[1];
}
__device__ __forceinline__ void p_cs_b(const Frame& F) {
    const int lane = lane_id_fresh();
    const bf16* Pm = (const bf16*)(F.dob + DO_CSP); const bf16* Gf = (const bf16*)(F.dob + DO_CSG); bf16* Zf = (bf16*)(F.dob + DO_CSZ);
    for (int u16 = F.gw; u16 < 128 * 16; u16 += F.NGW) {
        if (u16 & 15) continue;
        const int u = u16 >> 4, bh = u >> 1, nb = u & 1; const size_t uc0 = (size_t)bh * CS_NCH;
        f32x16 Z[2] = {};
        CsB X0, X1;
        csb_load(X0, Pm, Gf, uc0, nb, lane);
        for (int c = 0; c < CS_NCH; c += 2) {
            csb_load(X1, Pm, Gf, uc0 + c + 1, nb, lane);
            csb_step(Z, X0, Zf, uc0 + c, nb, lane);
            csb_load(X0, Pm, Gf, uc0 + (c + 2 < CS_NCH ? c + 2 : CS_NCH - 1), nb, lane);
            csb_step(Z, X1, Zf, uc0 + c + 1, nb, lane);
        }
    }
}
__device__ __forceinline__ void p_cs_c(const Frame& F, ArgsP a) {
    const int lane = lane_id_fresh(), hi = lane >> 5;
    LAS unsigned char* wl = F.lds + F.wave * CS_WAVE;
    CsIn in{(const bf16*)(F.ws + WS_ZR), (const bf16*)(F.ws + WS_A), (const bf16*)(F.ws + WS_LW), (const bf16*)(F.dob + DO_G), a->in[I_MU], a->in[I_KK], a->in[I_KA], a->in[I_RK]};
    const bf16* Zf = (const bf16*)(F.dob + DO_CSZ); bf16* Y = (bf16*)(F.ws + WS_Y); const float* lnw = a->in[I_LNW]; const float* lnb = a->in[I_LNB];
    const LAS float* btt = (const LAS float*)(wl + 8 * CS_IMG) + 64;
    for (int uc = F.gw; uc < 64 * CS_NCH; uc += F.NGW) {
        const int bh = uc / CS_NCH, c = uc % CS_NCH, b = bh >> 3, h = bh & 7; const size_t row0 = (size_t)b * SEQ;
        f32x16 Z[2][2], D[2];
        int lu = lane; asm volatile("" : "+v"(lu));
#pragma unroll
        for (int jb = 0; jb < 2; ++jb)
#pragma unroll
            for (int nb = 0; nb < 2; ++nb) { const u32x4* p = (const u32x4*)(Zf + (size_t)uc * 4096 + ((jb * 2 + nb) * 64 + lu) * 16); float g0[8], g1[8]; unpack8(p[0], g0); unpack8(p[1], g1);
#pragma unroll
                for (int q = 0; q < 8; ++q) { Z[jb][nb][q] = g0[q]; Z[jb][nb][8 + q] = g1[q]; } }
        const float lw0 = lnw[h * 64 + (lu & 31)], lw1 = lnw[h * 64 + 32 + (lu & 31)], lb0 = lnb[h * 64 + (lu & 31)], lb1 = lnb[h * 64 + 32 + (lu & 31)];
        for (int sc = 0; sc < CS_CH / 16; ++sc) {
            const int tok0 = c * CS_CH + sc * 16;
            int ln = lane; asm volatile("" : "+v"(ln));
            cs_prep<true, true>(in, row0, tok0, h, wl, ln); asm volatile("s_waitcnt lgkmcnt(0)" ::: "memory");
            cs_step<true, true>(Z, D, wl, ln); asm volatile("s_waitcnt lgkmcnt(0)" ::: "memory");
            const int hl = ln >> 5;
            const bf16x8 v0 = cs_trfrag(wl + IM_V * CS_IMG, 0, ln), v1 = cs_trfrag(wl + IM_V * CS_IMG, 1, ln), g0 = cs_trfrag(wl + IM_G * CS_IMG, 0, ln), g1 = cs_trfrag(wl + IM_G * CS_IMG, 1, ln);
            const f32x4 bta = *(const LAS f32x4*)(btt + 4 * hl), btb = *(const LAS f32x4*)(btt + 8 + 4 * hl); const float bt[8] = {bta.x, bta.y, bta.z, bta.w, btb.x, btb.y, btb.z, btb.w};
#pragma unroll
            for (int q = 0; q < 8; ++q) {
                const float y0 = D[0][8 + q], y1 = D[1][8 + q];
                const float mean = allsum32(y0 + y1) * (1.f / 64.f); const float d0 = y0 - mean, d1 = y1 - mean;
                const float rstd = 1.0f / sqrtf(allsum32(d0 * d0 + d1 * d1) * (1.f / 64.f) + LN_X_EPS);
                const float o0 = (d0 * rstd * lw0 + lb0 + bt[q] * bf2f((unsigned short)v0[q])) * bf2f((unsigned short)g0[q]);
                const float o1 = (d1 * rstd * lw1 + lb1 + bt[q] * bf2f((unsigned short)v1[q])) * bf2f((unsigned short)g1[q]);
                bf16* yp = Y + (row0 + tok0 + crow8(q, hl)) * 512 + h * 64 + (ln & 31);
                yp[0] = (unsigned short)f2bf(o0); yp[32] = (unsigned short)f2bf(o1);
            }
            asm volatile("s_waitcnt lgkmcnt(0)" ::: "memory");
        }
    }
}

__device__ __forceinline__ void p_post_scan(const Frame& F, ArgsP a, bf16* YD) {
    const int lane_f = lane_id_fresh();
    bf16* Y = (bf16*)(F.ws + WS_Y); const bf16* ZR = (const bf16*)(F.ws + WS_ZR); const bf16* A = (const bf16*)(F.ws + WS_A); const bf16* G = (const bf16*)(F.dob + DO_G);
    const float* lnw = a->in[I_LNW]; const float* lnb = a->in[I_LNB]; const float* rk = a->in[I_RK]; const float* mu = a->in[I_MU]; const float* k_a = a->in[I_KA];
    const int lane = lane_f;
    for (int m = F.gw; m < NTOK; m += F.NGW) {
        const bool first = (m % SEQ) == 0; const size_t mp = first ? m : m - 1;
        float y[8], r[8], k[8], v[8], g[8], o[8], t[8], av[8];
        unpack8(*((const u32x4*)(Y + (size_t)m * 512) + lane), y); unpack8(*((const u32x4*)(G + (size_t)m * 512) + lane), g); unpack8(*((const u32x4*)(A + (size_t)m * 512) + lane), av);
        unpack8(*((const u32x4*)(ZR + (size_t)m * 1792) + lane), r); unpack8(*((const u32x4*)(ZR + mp * 1792) + lane), t);
#pragma unroll
        for (int i = 0; i < 8; ++i) r[i] += ((first ? 0.f : t[i]) - r[i]) * mu[8 * lane + i];
        unpack8(*((const u32x4*)(ZR + (size_t)m * 1792 + 512) + lane), k); unpack8(*((const u32x4*)(ZR + mp * 1792 + 512) + lane), t);
#pragma unroll
        for (int i = 0; i < 8; ++i) { const float zk = k[i] + ((first ? 0.f : t[i]) - k[i]) * mu[512 + 8 * lane + i]; k[i] = zk * (1.f + (av[i] - 1.f) * k_a[8 * lane + i]); }
        unpack8(*((const u32x4*)(ZR + (size_t)m * 1792 + 1024) + lane), v); unpack8(*((const u32x4*)(ZR + mp * 1792 + 1024) + lane), t);
#pragma unroll
        for (int i = 0; i < 8; ++i) v[i] += ((first ? 0.f : t[i]) - v[i]) * mu[1024 + 8 * lane + i];
        float s = 0.f, d = 0.f;
#pragma unroll
        for (int i = 0; i < 8; ++i) { s += y[i]; d += r[i] * k[i] * rk[8 * lane + i]; }
        const float mean = sum8(s) * (1.f / 64.f); d = sum8(d); float q = 0.f;
#pragma unroll
        for (int i = 0; i < 8; ++i) { y[i] -= mean; q += y[i] * y[i]; }
        const float rstd = 1.0f / sqrtf(sum8(q) * (1.f / 64.f) + LN_X_EPS);
#pragma unroll
        for (int i = 0; i < 8; ++i) o[i] = (y[i] * rstd * lnw[8 * lane + i] + lnb[8 * lane + i] + d * v[i]) * g[i];
        *((u32x4*)(YD + (size_t)m * 512) + lane) = pack8(o);
    }
}

__device__ __forceinline__ void p_ffn_route(const Frame& F, ArgsP a, unsigned* cnt, int* route) {
    const int lane_f = lane_id_fresh(), tid_f = F.wave * 64 + lane_f;
    const float* X1 = (const float*)F.dob; bf16* H2 = (bf16*)(F.ws + WS_H2); const float* mod = (const float*)(F.ws + WS_MOD); const float* g = a->in[I_GFFN];
    LAS float* wr = (LAS float*)F.lds;
    __syncthreads();
    for (int i = tid_f; i < 1024 * 4; i += NTHR) { const int k = i >> 2, o = i & 3; wr[o * 1024 + k] = a->in[I_WRG][i]; }
    for (int i = tid_f; i < 1024 * 32; i += NTHR) { const int k = i >> 5, o = i & 31; wr[(4 + o) * 1024 + k] = a->in[I_WRE][i]; }
    __syncthreads();
    const float* brg = a->in[I_BRG]; const float* bre = a->in[I_BRE];
    const int lane = lane_f;
    LAS unsigned* lcnt = (LAS unsigned*)(F.lds + LDS_MISC + 512);
    if (tid_f < 64) lcnt[tid_f] = 0u;
    __syncthreads();
    int my_e0 = 0, my_e1 = 0; float my_w0 = 0.f, my_w1 = 0.f; int kk_ = 0;
    for (int m = F.gw; m < NTOK; m += F.NGW, ++kk_) {
        const int b = m / SEQ; const f32x4* xr = (const f32x4*)(X1 + (size_t)m * 1024) + lane;
        f32x4 v[4]; float s = 0.f;
#pragma unroll
        for (int j = 0; j < 4; ++j) { v[j] = xr[64 * j]; s += (v[j].x * v[j].x + v[j].y * v[j].y) + (v[j].z * v[j].z + v[j].w * v[j].w); }
        const float rstd = 1.0f / sqrtf(wave_sum(s) * (1.f / 1024.f) + EPS);
        u32x2* o = (u32x2*)(H2 + (size_t)m * 1024) + lane;
#pragma unroll
        for (int j = 0; j < 4; ++j) { const int col = 4 * lane + 256 * j;
            const f32x4 gg = *(const f32x4*)(g + col), sc = *(const f32x4*)(mod + b * 6144 + 4096 + col), sh = *(const f32x4*)(mod + b * 6144 + 3072 + col);
            v[j] = v[j] * rstd * gg * (sc + 1.0f) + sh; u32x2 w; w.x = pk2(v[j].x, v[j].y); w.y = pk2(v[j].z, v[j].w); o[64 * j] = w; }
        float lgq[4];
#pragma unroll
        for (int oo = 0; oo < 4; ++oo) { float p = 0.f;
#pragma unroll
            for (int j = 0; j < 4; ++j) { const f32x4 w4 = *(const LAS f32x4*)(wr + oo * 1024 + 4 * lane + 256 * j); p += (v[j].x * w4.x + v[j].y * w4.y) + (v[j].z * w4.z + v[j].w * w4.w); }
            lgq[oo] = wave_sum(p) + brg[oo]; }
        int gi = 0; float gm = lgq[0];
#pragma unroll
        for (int i = 1; i < 4; ++i) { if (lgq[i] > gm) { gm = lgq[i]; gi = i; } }
        float gs = 0.f;
#pragma unroll
        for (int i = 0; i < 4; ++i) gs += __expf(lgq[i] - gm);
        const float pg = 1.f / gs;
        gi = __builtin_amdgcn_readfirstlane(gi);
        float el[8];
        { const LAS float* wg = wr + (4 + gi * 8) * 1024 + 4 * lane;
#pragma unroll
          for (int i = 0; i < 8; ++i) { float p = 0.f;
#pragma unroll
              for (int j = 0; j < 4; ++j) { const f32x4 w4 = *(const LAS f32x4*)(wg + i * 1024 + 256 * j); p += (v[j].x * w4.x + v[j].y * w4.y) + (v[j].z * w4.z + v[j].w * w4.w); }
              el[i] = wave_sum(p) + bre[gi * 8 + i]; } }
        int i0 = 0; float m0 = el[0];
#pragma unroll
        for (int i = 1; i < 8; ++i) if (el[i] > m0) { m0 = el[i]; i0 = i; }
        int i1 = -1; float m1 = -INFINITY;
#pragma unroll
        for (int i = 0; i < 8; ++i) if (i != i0 && el[i] > m1) { m1 = el[i]; i1 = i; }
        const float e1 = __expf(m1 - m0), w0 = pg / (1.f + e1), w1 = pg * e1 / (1.f + e1);
        if (lane == kk_) { my_e0 = gi * 8 + i0; my_e1 = gi * 8 + i1; my_w0 = w0; my_w1 = w1; }
    }
    unsigned lp0 = 0u, lp1 = 0u;
    if (lane < kk_) { lp0 = __hip_atomic_fetch_add(lcnt + my_e0, 1u, __ATOMIC_RELAXED, __HIP_MEMORY_SCOPE_WORKGROUP); lp1 = __hip_atomic_fetch_add(lcnt + my_e1, 1u, __ATOMIC_RELAXED, __HIP_MEMORY_SCOPE_WORKGROUP); }
    __syncthreads();
    if (tid_f < 32) lcnt[32 + tid_f] = __hip_atomic_fetch_add(cnt + tid_f, lcnt[tid_f], __ATOMIC_RELAXED, __HIP_MEMORY_SCOPE_AGENT);
    __syncthreads();
    if (lane < kk_) { const int m = F.gw + lane * F.NGW; int* rt = route + (size_t)m * 8;
        rt[0] = my_e0; rt[1] = my_e1; rt[2] = (int)(lcnt[32 + my_e0] + lp0); rt[3] = (int)(lcnt[32 + my_e1] + lp1); rt[4] = __builtin_bit_cast(int, my_w0); rt[5] = __builtin_bit_cast(int, my_w1); }
    __syncthreads();
}
__device__ __forceinline__ int moe_tables(const Frame& F, LAS int* offs, LAS int* texp) {
    const int lane_f = lane_id_fresh(), tid_f = F.wave * 64 + lane_f;
    const unsigned* cnt = (const unsigned*)(F.ws + WS_CTL) + CW_CNT;
    __syncthreads();
    if (tid_f == 0) { int o = 0; for (int e = 0; e < 32; ++e) { offs[e] = o; const int c = (int)__hip_atomic_load(cnt + e, __ATOMIC_RELAXED, __HIP_MEMORY_SCOPE_AGENT); const int nt = (c + 255) >> 8; for (int t = 0; t < nt; ++t) texp[(o >> 8) + t] = e; o += nt << 8; } offs[32] = o; }
    __syncthreads();
    return offs[32] >> 8;
}
__device__ __forceinline__ void p_gather(const Frame& F) {
    const int lane_f = lane_id_fresh(), tid_f = F.wave * 64 + lane_f;
    LAS int* offs = (LAS int*)(F.lds + 1024); LAS int* texp = (LAS int*)(F.lds + 2048);
    moe_tables(F, offs, texp);
    const int* route = (const int*)(F.ws + WS_ROUTE); int* ridx = (int*)(F.ws + WS_ENT);
    const unsigned* cnt = (const unsigned*)(F.ws + WS_CTL) + CW_CNT;
    for (int m = F.vcu * NTHR + tid_f; m < NTOK; m += F.G * NTHR) { const u32x4 rt = *(const u32x4*)(route + (size_t)m * 8); ridx[offs[rt.x] + (int)rt.z] = m; ridx[offs[rt.y] + (int)rt.w] = m; }
    for (int i = F.vcu * NTHR + tid_f; i < 32 * 256; i += F.G * NTHR) { const int e = i >> 8, r = i & 255; const int c = (int)cnt[e]; const int pad = ((c + 255) & ~255) - c; if (r < pad) ridx[offs[e] + c + r] = 0; }
    __syncthreads();
}
__device__ __forceinline__ void p_combine(const Frame& F, float* dst) {
    const int lane_f = lane_id_fresh(), tid_f = F.wave * 64 + lane_f;
    LAS int* offs = (LAS int*)(F.lds + 1024); LAS int* texp = (LAS int*)(F.lds + 2048);
    moe_tables(F, offs, texp);
    float* out = (float*)F.dob; const bf16* YS = (const bf16*)(F.ws + WS_YS); const int* route = (const int*)(F.ws + WS_ROUTE); const float* mod = (const float*)(F.ws + WS_MOD);
    const int lane = lane_f;
    for (int m = F.gw; m < NTOK; m += F.NGW) {
        const int b = m / SEQ; const int* rt = route + (size_t)m * 8; const int d0 = offs[rt[0]] + rt[2], d1 = offs[rt[1]] + rt[3];
        const float w0 = __builtin_bit_cast(float, rt[4]), w1 = __builtin_bit_cast(float, rt[5]);
#pragma unroll
        for (int j = 0; j < 2; ++j) { const int col = 8 * lane + 512 * j; float y0[8], y1[8];
            unpack8(*(const u32x4*)(YS + (size_t)d0 * 1024 + col), y0); unpack8(*(const u32x4*)(YS + (size_t)d1 * 1024 + col), y1);
            float* o = out + (size_t)m * 1024 + col; const float* gt = mod + b * 6144 + 5120 + col;
            f32x4 x0 = *(const f32x4*)o, x1 = *(const f32x4*)(o + 4); const f32x4 g0 = *(const f32x4*)gt, g1 = *(const f32x4*)(gt + 4);
            x0.x += g0.x * (w0 * y0[0] + w1 * y1[0]); x0.y += g0.y * (w0 * y0[1] + w1 * y1[1]); x0.z += g0.z * (w0 * y0[2] + w1 * y1[2]); x0.w += g0.w * (w0 * y0[3] + w1 * y1[3]);
            x1.x += g1.x * (w0 * y0[4] + w1 * y1[4]); x1.y += g1.y * (w0 * y0[5] + w1 * y1[5]); x1.z += g1.z * (w0 * y0[6] + w1 * y1[6]); x1.w += g1.w * (w0 * y0[7] + w1 * y1[7]);
            float* od = dst + (size_t)m * 1024 + col; *(f32x4*)od = x0; *(f32x4*)(od + 4) = x1; }
    }
}

constexpr int NPHASE = 17;
template <int LO, int HI>
__global__ void __launch_bounds__(NTHR, 2) fwd(Args args) {
    extern __shared__ __attribute__((aligned(16))) unsigned char lds_raw[];
    Frame F;
    F.lds = (LAS unsigned char*)lds_raw;
    F.wave = __builtin_amdgcn_readfirstlane((int)threadIdx.x >> 6);
    F.G = gridDim.x; { const int bx = blockIdx.x; F.vcu = (F.G % 8 == 0) ? (bx % 8) * (F.G / 8) + bx / 8 : bx; }
    F.gw = F.vcu * NWAVES + F.wave; F.NGW = F.G * NWAVES;
    F.ws = args.ws; F.dob = (unsigned char*)args.out;
    ArgsP AP = (ArgsP)__builtin_amdgcn_kernarg_segment_ptr();
    volatile LAS unsigned* MISC = (volatile LAS unsigned*)(F.lds + LDS_MISC);
    if (threadIdx.x < 64) MISC[threadIdx.x] = 0u;
    __syncthreads();
    XcdBarrier bar; bar.bar = (unsigned*)(F.ws + WS_CTL) + CW_BAR; bar.x = 0; bar.st = MISC + 8;
#if N_LAUNCH_MODE == 1
    bar = xcd_barrier_post((unsigned*)(F.ws + WS_CTL) + CW_BAR, MISC + 8);
#define GRID_BAR() xcd_barrier(bar)
#else
#define GRID_BAR() do { } while (0)
#endif
#ifndef PROBE_REPEAT
#define PROBE_REPEAT -1
#endif
#define IN(k) (LO <= (k) && (k) < HI)
#define SEAM(k) do { if constexpr (IN(k) && IN((k) + 1)) GRID_BAR(); } while (0)
    const float* mod = (const float*)(F.ws + WS_MOD);

#define PH(k, ...) do { if constexpr (IN(k)) { asm volatile("" : "+s"(AP)); { __VA_ARGS__ } if constexpr (PROBE_REPEAT == (k)) { GRID_BAR(); asm volatile("" : "+s"(AP)); { __VA_ARGS__ } } } } while (0)
    PH(0, p0_prologue(F, AP);); SEAM(0);
    PH(1, p_normmod(F, AP->in[I_X], AP->in[I_GMIX], mod, 0, 1024, (bf16*)(F.ws + WS_H));); SEAM(1);
    PH(2, Gemm g{(const bf16*)(F.ws + WS_H), (const bf16*)(F.ws + WS_WIN), NTOK, N_IN_PAD, 1024}; StaticOrder S; S.init(NTOK, N_IN_PAD, F.G, (int)blockIdx.x);
        EpiZ E{(bf16*)(F.ws + WS_ZR), (bf16*)(F.ws + WS_SG), (bf16*)(F.ws + WS_ZM)}; gemm_phase_any(F.lds, g, S, E, F.wave);); SEAM(2);
    PH(3, p_prep_a(F, AP);); SEAM(3);
    PH(4,
        { Gemm g{(const bf16*)(F.ws + WS_TWA), (const bf16*)(F.ws + WS_WBLK), NTOK, 1024, 128}; StaticOrder S; S.init(NTOK, 1024, F.G, (int)blockIdx.x);
          EpiLora E{(bf16*)(F.ws + WS_LW), (bf16*)(F.ws + WS_A), AP->in[I_W0], AP->in[I_A0]}; gemm_phase_any(F.lds, g, S, E, F.wave); }
        { Gemm g{(const bf16*)(F.ws + WS_SGL), (const bf16*)(F.ws + WS_WG), NTOK, 512, 128}; StaticOrder S; S.init(NTOK, 512, F.G, (int)blockIdx.x);
          EpiPlain E{(bf16*)(F.dob + DO_G), nullptr, 1 << 30, 512, 0}; gemm_phase_any(F.lds, g, S, E, F.wave); }
        { Gemm g{(const bf16*)(F.ws + WS_QA), (const bf16*)(F.ws + WS_WUQ), NTOK, 768, 256}; StaticOrder S; S.init(NTOK, 768, F.G, (int)blockIdx.x);
          EpiPlain E{(bf16*)(F.dob + DO_Q), nullptr, 1 << 30, 768, 0}; gemm_phase_any(F.lds, g, S, E, F.wave); }
        { Gemm g{(const bf16*)(F.ws + WS_KVA), (const bf16*)(F.ws + WS_WUKV), NTOK, 1024, 128}; StaticOrder S; S.init(NTOK, 1024, F.G, (int)blockIdx.x);
          EpiPlain E{(bf16*)(F.dob + DO_KN), (bf16*)(F.ws + WS_VC), 512, 512, 512}; gemm_phase_any(F.lds, g, S, E, F.wave); }
    ); SEAM(4);
    PH(5, p_prep_c(F, AP);); SEAM(5);
#if ENG_ATTN == 1
    PH(6, p_attn_mfma(F);); SEAM(6);
#else
    PH(6, p_attn_naive(F);); SEAM(6);
#endif
    PH(7, p_cs_a(F, AP);); SEAM(7);
    PH(8, p_cs_b(F);); SEAM(8);
    PH(9, p_cs_c(F, AP);); SEAM(9);
    PH(10,
        { Gemm g{(const bf16*)(F.ws + WS_Y), (const bf16*)(F.ws + WS_WB), NTOK, 1024, 512}; StaticOrder S; S.init(NTOK, 1024, F.G, (int)blockIdx.x);
          EpiBranch<false> E{(bf16*)(F.ws + WS_MG), (const bf16*)(F.ws + WS_SG), 0}; gemm_phase_any(F.lds, g, S, E, F.wave); }
        { Gemm g{(const bf16*)(F.ws + WS_YM), (const bf16*)(F.ws + WS_WB) + (size_t)1024 * 512, NTOK, 1024, 512}; StaticOrder S; S.init(NTOK, 1024, F.G, (int)blockIdx.x);
          EpiBranch<true> E{(bf16*)(F.ws + WS_MG), (const bf16*)(F.ws + WS_SG), 1024}; gemm_phase_any(F.lds, g, S, E, F.wave); }
    ); SEAM(10);
    PH(11, Gemm g{(const bf16*)(F.ws + WS_MG), (const bf16*)(F.ws + WS_WO), NTOK, 1024, 1024}; StaticOrder S; S.init(NTOK, 1024, F.G, (int)blockIdx.x);
        EpiOut E{(float*)F.dob, AP->in[I_X], mod}; gemm_phase_any(F.lds, g, S, E, F.wave);); SEAM(11);
    if constexpr (PROBE_REPEAT == 12) { p_ffn_route(F, AP, (unsigned*)(F.ws + WS_CTL) + CW_CNT + 64, (int*)(F.ws + WS_CS)); GRID_BAR(); }
    if constexpr (IN(12)) { asm volatile("" : "+s"(AP)); p_ffn_route(F, AP, (unsigned*)(F.ws + WS_CTL) + CW_CNT, (int*)(F.ws + WS_ROUTE)); } SEAM(12);
    PH(13, p_gather(F);); SEAM(13);
    PH(14, LAS int* offs = (LAS int*)(F.lds + LDS_MISC + 1024); LAS int* texp = (LAS int*)(F.lds + LDS_MISC + 1024 + 256); const int nt = moe_tables(F, offs, texp);
        Gemm g{(const bf16*)(F.ws + WS_H2), (const bf16*)(F.ws + WS_WGU), MPAD, 512, 1024, (const int*)(F.ws + WS_ENT)}; TableOrder S{texp, nt, 2, F.G, (int)blockIdx.x};
        EpiGateUp E{(bf16*)(F.ws + WS_HID)}; gemm_phase_gather(F.lds, g, S, E, F.wave);); SEAM(14);
    PH(15, LAS int* offs = (LAS int*)(F.lds + LDS_MISC + 1024); LAS int* texp = (LAS int*)(F.lds + LDS_MISC + 1024 + 256); const int nt = moe_tables(F, offs, texp);
        Gemm g{(const bf16*)(F.ws + WS_HID), (const bf16*)(F.ws + WS_WDN), MPAD, 1024, 256}; TableOrder S{texp, nt, 4, F.G, (int)blockIdx.x};
        EpiDown E{(bf16*)(F.ws + WS_YS)}; gemm_phase_any(F.lds, g, S, E, F.wave);); SEAM(15);
    if constexpr (PROBE_REPEAT == 16) { p_combine(F, (float*)(F.ws + WS_SG)); GRID_BAR(); }
    if constexpr (IN(16)) { p_combine(F, (float*)F.dob); }
}

#if N_LAUNCH_MODE == 1
static bool set_attrs() { return hipFuncSetAttribute((const void*)fwd<0, NPHASE>, hipFuncAttributeMaxDynamicSharedMemorySize, LDS_BYTES) == hipSuccess; }
#else
template <int P> static bool set_attr_all() { if constexpr (P < NPHASE) { return hipFuncSetAttribute((const void*)fwd<P, P + 1>, hipFuncAttributeMaxDynamicSharedMemorySize, LDS_BYTES) == hipSuccess && set_attr_all<P + 1>(); } else return true; }
static bool set_attrs() { return set_attr_all<0>(); }
template <int P> static void launch_all(int grid, hipStream_t stream, const Args& a) { if constexpr (P < NPHASE) { hipLaunchKernelGGL((fwd<P, P + 1>), dim3(grid), dim3(NTHR), LDS_BYTES, stream, a); launch_all<P + 1>(grid, stream, a); } }
#endif
extern "C" void kernel_launch(void* const* d_in, const int* in_sizes, int n_in, void* d_out, int out_size, void* d_ws, size_t ws_size, hipStream_t stream) {
    static int grid = 0;
    if (grid == 0) {
        if (n_in != 34 || out_size != NTOK * DM || ws_size < WS_END) { fprintf(stderr, "kernel_launch: unexpected shapes (n_in %d out %d ws %zu)\n", n_in, out_size, ws_size); grid = -1; return; }
        int dev = 0, cus = 0;
        if (hipGetDevice(&dev) != hipSuccess || hipDeviceGetAttribute(&cus, hipDeviceAttributeMultiprocessorCount, dev) != hipSuccess) { grid = -1; return; }
        if (!set_attrs()) { fprintf(stderr, "kernel_launch: hipFuncSetAttribute failed\n"); grid = -1; return; }
        grid = cus;
    }
    if (grid < 0) return;
    (void)hipMemsetAsync((char*)d_ws + WS_CTL, 0, CTL_ZERO_BYTES, stream);
    Args a{};
    for (int i = 0; i < 34; ++i) a.in[i] = (const float*)d_in[i];
    a.out = (float*)d_out; a.ws = (unsigned char*)d_ws;
    a.ph_lo = 0; a.ph_hi = NPHASE;
#if N_LAUNCH_MODE == 1
    hipLaunchKernelGGL((fwd<0, NPHASE>), dim3(grid), dim3(NTHR), LDS_BYTES, stream, a);
#else
    launch_all<0>(grid, stream, a);
#endif
}
```

```cpp
#include <hip/hip_runtime.h>
#include <cstdio>
#include <cstdint>

#ifndef N_LAUNCH_MODE
#define N_LAUNCH_MODE 1
#endif
#ifndef ENG_GEMM
#define ENG_GEMM 1
#endif
#ifndef ENG_ATTN
#define ENG_ATTN 1
#endif

#define GAS __attribute__((address_space(1)))
#define LAS __attribute__((address_space(3)))
typedef unsigned short bf16;
typedef float f32x4 __attribute__((ext_vector_type(4)));
typedef float f32x2 __attribute__((ext_vector_type(2)));
typedef unsigned u32x4 __attribute__((ext_vector_type(4)));
typedef unsigned u32x2 __attribute__((ext_vector_type(2)));
typedef short bf16x8 __attribute__((ext_vector_type(8)));

constexpr int BATCH = 8, SEQ = 8192, DM = 1024, NTOK = BATCH * SEQ;
constexpr int D_RWKV = 512, RWKV_COLS = 1792, MLA_COLS = 416, D_IN = 4256, N_IN_PAD = 4352;
constexpr int NH = 8, QKD = 96, NOPE = 64, ROPE = 32, VD = 64;
constexpr int NEXP = 32, DEXP = 256;
constexpr int MPAD = 139264;
constexpr float EPS = 1e-6f, LN_X_EPS = 64e-5f;
constexpr float QSCALE = 0.10206207261596577f * 1.4426950408889634f;

constexpr size_t MiB = 1u << 20;
constexpr size_t WS_CTL = 0, CTL_ZERO_BYTES = 1 * MiB;
constexpr size_t WS_MOD = 1 * MiB;
constexpr size_t WS_ROUTE = 2 * MiB;
constexpr size_t WS_CS = 4 * MiB;
constexpr size_t WS_ENT = 12 * MiB;
constexpr size_t WS_WIN = 16 * MiB;
constexpr size_t WS_WBLK = 25 * MiB;
constexpr size_t WS_WG = WS_WBLK + 256 * 1024;
constexpr size_t WS_WUQ = WS_WG + 128 * 1024;
constexpr size_t WS_WUKV = WS_WUQ + 384 * 1024;
constexpr size_t WS_WB = 26 * MiB;
constexpr size_t WS_WO = 28 * MiB;
constexpr size_t WS_WGU = 30 * MiB;
constexpr size_t WS_WDN = 62 * MiB;
constexpr size_t WS_SG = 80 * MiB;
constexpr size_t WS_H2 = 80 * MiB;
constexpr size_t WS_ZR = 336 * MiB;
constexpr size_t WS_VC = 816 * MiB;
constexpr size_t WS_KC = 880 * MiB;
constexpr size_t WS_Y = 560 * MiB;
constexpr size_t WS_XG = 336 * MiB;
constexpr size_t WS_ZM = 560 * MiB;
constexpr size_t WS_YM = 560 * MiB + 1024;
constexpr size_t WS_H = 688 * MiB;
constexpr size_t WS_LW = 688 * MiB;
constexpr size_t WS_A = 752 * MiB;
constexpr size_t WS_MG = 688 * MiB;
constexpr size_t WS_HID = 208 * MiB;
constexpr size_t WS_R = 752 * MiB;
constexpr size_t WS_V = 816 * MiB;
constexpr size_t WS_ZK = 880 * MiB;
constexpr size_t WS_TWA = 944 * MiB;
constexpr size_t WS_SGL = 960 * MiB;
constexpr size_t WS_QA = 976 * MiB;
constexpr size_t WS_KVA = 1008 * MiB;
constexpr size_t WS_KK = 944 * MiB;
constexpr size_t WS_YS = 752 * MiB;
constexpr size_t WS_MO = 560 * MiB;
constexpr int YYLD = 1024;
constexpr size_t WS_END = 1024 * MiB;
constexpr size_t DO_G = 0;
constexpr size_t DO_Q = 64 * MiB;
constexpr size_t DO_KN = 160 * MiB;

constexpr int CW_CNT = 64;
constexpr int CW_BAR = 4096;

constexpr int NWAVES = 8, NTHR = 512;
constexpr int LDS_BYTES = 155648;
constexpr int LDS_MISC = 151552;

__device__ __forceinline__ int lane_id_fresh() { int l; asm volatile("v_mbcnt_lo_u32_b32 %0, -1, 0\n\tv_mbcnt_hi_u32_b32 %0, -1, %0" : "=v"(l)); return l; }
__device__ __forceinline__ float bf2f(unsigned short h) { return __builtin_bit_cast(float, (unsigned)h << 16); }
__device__ __forceinline__ unsigned f2bf(float f) { unsigned u = __builtin_bit_cast(unsigned, f); return (u + 0x7fffu + ((u >> 16) & 1u)) >> 16; }
typedef __bf16 bf16x2_t __attribute__((ext_vector_type(2)));
__device__ __forceinline__ unsigned pk2(float lo, float hi) { const f32x2 v = {lo, hi}; return __builtin_bit_cast(unsigned, __builtin_convertvector(v, bf16x2_t)); }
__device__ __forceinline__ float lo2f(unsigned w) { return __builtin_bit_cast(float, w << 16); }
__device__ __forceinline__ float hi2f(unsigned w) { return __builtin_bit_cast(float, w & 0xffff0000u); }
template <int CTRL> __device__ __forceinline__ float dpp_add(float x) { return x + __builtin_bit_cast(float, __builtin_amdgcn_update_dpp(0, __builtin_bit_cast(int, x), CTRL, 0xf, 0xf, false)); }
__device__ __forceinline__ float allsum16(float x) { x = dpp_add<0xB1>(x); x = dpp_add<0x4E>(x); x = dpp_add<0x141>(x); x = dpp_add<0x140>(x); return x; }
__device__ __forceinline__ float allsum32(float x) { x = allsum16(x); auto r = __builtin_amdgcn_permlane16_swap(__float_as_uint(x), __float_as_uint(x), false, false); return __uint_as_float(r[0]) + __uint_as_float(r[1]); }
__device__ __forceinline__ float sum8(float x) { x = dpp_add<0xB1>(x); x = dpp_add<0x4E>(x); x = dpp_add<0x141>(x); return x; }
__device__ __forceinline__ float wave_sum(float v) {
    v = allsum16(v);
    { auto r = __builtin_amdgcn_permlane16_swap(__float_as_uint(v), __float_as_uint(v), false, false); v = __uint_as_float(r[0]) + __uint_as_float(r[1]); }
    { auto r = __builtin_amdgcn_permlane32_swap(__float_as_uint(v), __float_as_uint(v), false, false); v = __uint_as_float(r[0]) + __uint_as_float(r[1]); }
    return v;
}
__device__ __forceinline__ float sigmoidf_(float x) { return __builtin_amdgcn_rcpf(1.f + __builtin_amdgcn_exp2f(-1.4426950408889634f * x)); }
__device__ __forceinline__ float siluf_(float x) { return x * __builtin_amdgcn_rcpf(1.f + __builtin_amdgcn_exp2f(-1.4426950408889634f * x)); }
__device__ __forceinline__ void unpack8(const u32x4 w, float (&v)[8]) {
    v[0] = lo2f(w.x); v[1] = hi2f(w.x); v[2] = lo2f(w.y); v[3] = hi2f(w.y); v[4] = lo2f(w.z); v[5] = hi2f(w.z); v[6] = lo2f(w.w); v[7] = hi2f(w.w);
}
__device__ __forceinline__ u32x4 pack8(const float (&v)[8]) { u32x4 w; w.x = pk2(v[0], v[1]); w.y = pk2(v[2], v[3]); w.z = pk2(v[4], v[5]); w.w = pk2(v[6], v[7]); return w; }

#define LDS_BAR() do { asm volatile("s_waitcnt lgkmcnt(0)" ::: "memory"); __builtin_amdgcn_s_barrier(); asm volatile("" ::: "memory"); } while (0)

#define XB_TMO      128
#define XB_XCNT(j)  (256  + 64 * (j))
#define XB_XSUB(j)  (1280 + 64 * (j))
#define XB_XGEN(j)  (2304 + 64 * (j))
#define XB_TOP      3328
#define XB_TOPGEN   3392
#define XCD_BAR_WORDS 3456
#define XB_SPIN_CAP (1u << 19)
__device__ __forceinline__ unsigned xb_ld(unsigned* p)              { return __hip_atomic_load(p, __ATOMIC_RELAXED, __HIP_MEMORY_SCOPE_AGENT); }
__device__ __forceinline__ unsigned xb_add(unsigned* p, unsigned v) { return __hip_atomic_fetch_add(p, v, __ATOMIC_RELAXED, __HIP_MEMORY_SCOPE_AGENT); }
__device__ __forceinline__ unsigned xb_xcc_id() { return (unsigned)__builtin_amdgcn_s_getreg((3 << 11) | 20) & 0xFu; }
#define XB_SPIN(cond, bar) do { unsigned _sp = 0; while (cond) { __builtin_amdgcn_s_sleep(1); \
    if ((++_sp & 255u) == 0u) { if (xb_ld(&(bar)[XB_TMO])) break; if (_sp > XB_SPIN_CAP) { atomicAdd(&(bar)[XB_TMO], 1u); break; } } } } while (0)
struct XcdBarrier { unsigned* bar; unsigned x; volatile LAS unsigned* st; };
__device__ __forceinline__ XcdBarrier xcd_barrier_post(unsigned* bar, volatile LAS unsigned* st) {
    XcdBarrier b; b.bar = bar; b.x = xb_xcc_id(); b.st = st;
    if (threadIdx.x == 0) (void)xb_add(&bar[XB_XCNT(b.x)], 1u);
    return b;
}
__device__ __forceinline__ void xcd_barrier_complete(unsigned* bar, unsigned x, unsigned& nloc, unsigned& nx) {
    const unsigned G = gridDim.x * gridDim.y * gridDim.z;
    unsigned sum, cnt, mine, sp = 0u;
    for (;;) {
        sum = 0u; cnt = 0u; mine = 0u;
#pragma unroll
        for (unsigned j = 0; j < 16; ++j) { const unsigned c = xb_ld(&bar[XB_XCNT(j)]); sum += c; cnt += (c > 0u) ? 1u : 0u; mine = (j == x) ? c : mine; }
        if (sum == G) break;
        __builtin_amdgcn_s_sleep(1);
        if ((++sp & 255u) == 0u) { if (xb_ld(&bar[XB_TMO])) break; if (sp > XB_SPIN_CAP) { atomicAdd(&bar[XB_TMO], 1u); break; } }
    }
    nloc = mine > 0u ? mine : 1u; nx = cnt > 0u ? cnt : 1u;
}
__device__ __forceinline__ void xcd_barrier(const XcdBarrier& b) {
    asm volatile("s_waitcnt vmcnt(0)" ::: "memory");
    __syncthreads();
    if (threadIdx.x == 0) {
        unsigned* bar = b.bar;
        __builtin_amdgcn_s_waitcnt(0);
        unsigned nloc = b.st[0], nx = b.st[1];
        if (nloc == 0u) { xcd_barrier_complete(bar, b.x, nloc, nx); b.st[0] = nloc; b.st[1] = nx; }
        const unsigned old = xb_add(&bar[XB_XSUB(b.x)], 1u);
        const unsigned gen = old / nloc;
        if (old + 1u == (gen + 1u) * nloc) {
            __builtin_amdgcn_fence(__ATOMIC_RELEASE, "agent");
            asm volatile("s_waitcnt vmcnt(0)" ::: "memory");
            const unsigned og = xb_add(&bar[XB_TOP], 1u);
            const unsigned tg = og / nx;
            if (og + 1u == (tg + 1u) * nx) xb_add(&bar[XB_TOPGEN], 1u);
            else XB_SPIN(xb_ld(&bar[XB_TOPGEN]) == tg, bar);
            __builtin_amdgcn_fence(__ATOMIC_ACQUIRE, "agent");
            xb_add(&bar[XB_XGEN(b.x)], 1u);
            asm volatile("s_waitcnt vmcnt(0)" ::: "memory");
        } else {
            XB_SPIN(xb_ld(&bar[XB_XGEN(b.x)]) == gen, bar);
            __builtin_amdgcn_fence(__ATOMIC_ACQUIRE, "agent");
            asm volatile("s_waitcnt vmcnt(0)" ::: "memory");
        }
    }
    __syncthreads();
}

struct Args {
    const float* in[34]; float* out; unsigned char* ws; int ph_lo, ph_hi;
};
typedef const __attribute__((address_space(4))) Args* ArgsP;
struct Frame {
    LAS unsigned char* lds;
    int wave, vcu, G, gw, NGW;
    unsigned char* ws; unsigned char* dob;
};
enum { I_X = 0, I_C, I_POS, I_WADA, I_BADA, I_GMIX, I_WIN, I_MU, I_W0, I_WDEC, I_A0, I_WAUP, I_WGUP, I_KK, I_KA, I_RK, I_LNW, I_LNB, I_GQA, I_WUQ, I_GKVA, I_WUKV,
       I_QN, I_KN, I_WBR, I_WOUT, I_GFFN, I_WRG, I_BRG, I_WRE, I_BRE, I_WEG, I_WEU, I_WED };

struct Unit { int pm, pn; };
struct Gemm { const bf16* A; const bf16* Bt; int M, N, K; const int* ridx = nullptr; };
constexpr int NXCD = 8, WGM = 8;
struct StaticOrder {
    int nM, nN, nwg, G, c;
    __device__ void init(int M, int N, int G_, int c_) { nM = M / 256; nN = N / 256; nwg = nM * nN; G = G_; c = c_; }
    __device__ bool next(int i, Unit& u) const {
        const long L = (long)i * G + c; if (L >= nwg) return false;
        int wgid = (int)L; { const int q = nwg / NXCD, r = nwg % NXCD, xcd = wgid % NXCD, off = wgid / NXCD; wgid = (xcd < r ? xcd * (q + 1) : r * (q + 1) + (xcd - r) * q) + off; }
        const int nig = WGM * nN, gid = wgid / nig, fm = gid * WGM, gsz = (nM - fm) < WGM ? (nM - fm) : WGM;
        u.pm = fm + ((wgid % nig) % gsz); u.pn = (wgid % nig) / gsz; return true;
    }
    __device__ __forceinline__ void a_ready(const Unit&) const {}
    __device__ __forceinline__ void done(const Unit&) const {}
};
struct TableOrder {
    const LAS int* texp; int ntiles, nN, G, c;
    __device__ bool next(int i, Unit& u) const {
        const long L = (long)i * G + c; if (L >= (long)ntiles * nN) return false;
        const int t = (int)(L / nN), j = (int)(L % nN); u.pm = t; u.pn = texp[t] * nN + j; return true;
    }
    __device__ __forceinline__ void a_ready(const Unit&) const {}
    __device__ __forceinline__ void done(const Unit&) const {}
};

template <class Epi, class Sched>
__device__ __forceinline__ void gemm_phase_naive(LAS unsigned char* lds, const Gemm g, const Sched& S, const Epi& E) {
    const int tid = (int)__builtin_amdgcn_readfirstlane((int)threadIdx.x >> 6) * 64 + lane_id_fresh(), ty = tid >> 5, tx = tid & 31;
    LAS bf16* As = (LAS bf16*)lds; LAS bf16* Bs = (LAS bf16*)(lds + 128 * 40 * 2);
    Unit u;
    for (int i = 0; S.next(i, u); ++i) {
        for (int half = 0; half < 2; ++half) {
            float acc[8][8];
#pragma unroll
            for (int r = 0; r < 8; ++r)
#pragma unroll
                for (int c = 0; c < 8; ++c) acc[r][c] = 0.f;
            const bf16* Ab = g.A + ((size_t)u.pm * 256 + half * 128) * g.K; const bf16* Bb = g.Bt + (size_t)u.pn * 256 * g.K;
            for (int k0 = 0; k0 < g.K; k0 += 32) {
                __syncthreads();
                { const int r = tid >> 2, c8 = (tid & 3) * 8; *(LAS u32x4*)(As + r * 40 + c8) = *(const u32x4*)(Ab + (size_t)r * g.K + k0 + c8); }
#pragma unroll
                for (int j = 0; j < 2; ++j) { const int ch = tid + j * 512, r = ch >> 2, c8 = (ch & 3) * 8; *(LAS u32x4*)(Bs + r * 40 + c8) = *(const u32x4*)(Bb + (size_t)r * g.K + k0 + c8); }
                __syncthreads();
#pragma unroll 2
                for (int k = 0; k < 32; k += 2) {
                    float b0[8], b1[8];
#pragma unroll
                    for (int c = 0; c < 8; ++c) { const unsigned w = *(const LAS unsigned*)(Bs + (tx * 8 + c) * 40 + k); b0[c] = lo2f(w); b1[c] = hi2f(w); }
#pragma unroll
                    for (int r = 0; r < 8; ++r) { const unsigned w = *(const LAS unsigned*)(As + (ty * 8 + r) * 40 + k); const float a0 = lo2f(w), a1 = hi2f(w);
#pragma unroll
                        for (int c = 0; c < 8; ++c) acc[r][c] = fmaf(a1, b1[c], fmaf(a0, b0[c], acc[r][c])); }
                }
            }
#pragma unroll
            for (int r = 0; r < 8; ++r) E.store8(u, half * 128 + ty * 8 + r, tx * 8, acc[r]);
        }
    }
    __syncthreads();
}

struct EpiZ { bf16 *ZR, *SG, *ZM;
    __device__ __forceinline__ void store8(const Unit& u, int r, int c, const float (&v)[8]) const {
        const size_t row = (size_t)u.pm * 256 + r;
        if (u.pn < 7) { *(u32x4*)(ZR + row * 1792 + u.pn * 256 + c) = pack8(v); }
        else if (u.pn < 15) { *(u32x4*)(SG + row * 2048 + (u.pn - 7) * 256 + c) = pack8(v); }
        else { *(u32x4*)(ZM + row * 512 + (u.pn - 15) * 256 + c) = pack8(v); }
    } };
struct EpiLora { bf16 *LW, *A; const float *w0, *a0;
    __device__ __forceinline__ void store8(const Unit& u, int r, int c, const float (&v)[8]) const {
        const size_t row = (size_t)u.pm * 256 + r; const int col = u.pn * 256 + c; float o[8];
        const bool isw = col < 512; const float* bp = isw ? (w0 + col) : (a0 + col - 512);
        const f32x4 b0 = *(const f32x4*)bp, b1 = *(const f32x4*)(bp + 4); const float bb[8] = {b0.x, b0.y, b0.z, b0.w, b1.x, b1.y, b1.z, b1.w};
#pragma unroll
        for (int i = 0; i < 8; ++i) { const float e = __builtin_amdgcn_exp2f(fminf(-1.4426950408889634f * (bb[i] + v[i]), 120.f)); const float s = __builtin_amdgcn_rcpf(1.0f + e); o[i] = isw ? -0.60653065971263342f * s : s; }
        bf16* dst = isw ? (LW + row * 512 + col) : (A + row * 512 + col - 512);
        *(u32x4*)dst = pack8(o);
    } };
struct EpiPlain { bf16* O0; bf16* O1; int split, ld0, ld1;
    __device__ __forceinline__ void store8(const Unit& u, int r, int c, const float (&v)[8]) const {
        const size_t row = (size_t)u.pm * 256 + r; int col = u.pn * 256 + c;
        if (col < split) *(u32x4*)(O0 + row * ld0 + col) = pack8(v); else *(u32x4*)(O1 + row * ld1 + col - split) = pack8(v);
    } };
template <bool ACCUM> struct EpiBranch { bf16* MG; const bf16* SG; int goff;
    __device__ __forceinline__ void store8(const Unit& u, int r, int c, const float (&v)[8]) const {
        const size_t row = (size_t)u.pm * 256 + r; const int col = u.pn * 256 + c; float gt[8], o[8];
        unpack8(*(const u32x4*)(SG + row * 2048 + goff + col), gt);
#pragma unroll
        for (int i = 0; i < 8; ++i) gt[i] = sigmoidf_(gt[i]);
        if (ACCUM) { float p[8]; unpack8(*(const u32x4*)(MG + row * 1024 + col), p);
#pragma unroll
            for (int i = 0; i < 8; ++i) o[i] = p[i] + gt[i] * v[i]; }
        else {
#pragma unroll
            for (int i = 0; i < 8; ++i) o[i] = gt[i] * v[i]; }
        *(u32x4*)(MG + row * 1024 + col) = pack8(o);
    } };
struct EpiBranch2 { bf16* MG; const bf16* SG;
    __device__ __forceinline__ void mid8(const Unit& u, int r, int c, float (&v)[8]) const {
        const size_t row = (size_t)u.pm * 256 + r; const int col = u.pn * 256 + c; float gr[8], gm[8];
        unpack8(*(const u32x4*)(SG + row * 2048 + col), gr); unpack8(*(const u32x4*)(SG + row * 2048 + 1024 + col), gm);
#pragma unroll
        for (int i = 0; i < 8; ++i) v[i] *= (1.f + __builtin_amdgcn_exp2f(-1.4426950408889634f * gm[i])) * __builtin_amdgcn_rcpf(1.f + __builtin_amdgcn_exp2f(-1.4426950408889634f * gr[i]));
    }
    __device__ __forceinline__ void store8(const Unit& u, int r, int c, const float (&v)[8]) const {
        const size_t row = (size_t)u.pm * 256 + r; const int col = u.pn * 256 + c; float gm[8], o[8];
        unpack8(*(const u32x4*)(SG + row * 2048 + 1024 + col), gm);
#pragma unroll
        for (int i = 0; i < 8; ++i) o[i] = sigmoidf_(gm[i]) * v[i];
        *(u32x4*)(MG + row * 1024 + col) = pack8(o);
    } };
struct EpiOut { float* X1; const float* x; const float* mod;
    __device__ __forceinline__ void store8(const Unit& u, int r, int c, const float (&v)[8]) const {
        const size_t row = (size_t)u.pm * 256 + r; const int col = u.pn * 256 + c; const int b = (int)(row / SEQ);
        const float* gt = mod + b * 6144 + 2048 + col; const float* xr = x + row * 1024 + col; float* o = X1 + row * 1024 + col;
        const f32x4 g0 = *(const f32x4*)gt, g1 = *(const f32x4*)(gt + 4), x0 = *(const f32x4*)xr, x1 = *(const f32x4*)(xr + 4);
        *(f32x4*)o = (f32x4){x0.x + g0.x * v[0], x0.y + g0.y * v[1], x0.z + g0.z * v[2], x0.w + g0.w * v[3]};
        *(f32x4*)(o + 4) = (f32x4){x1.x + g1.x * v[4], x1.y + g1.y * v[5], x1.z + g1.z * v[6], x1.w + g1.w * v[7]};
    } };
struct EpiGateUp { bf16* HID;
    __device__ __forceinline__ void store8(const Unit& u, int r, int c, const float (&v)[8]) const {
        const size_t row = (size_t)u.pm * 256 + r; const int col = ((u.pn & 1) * 256 + c) >> 1;
        u32x2 w; w.x = pk2(siluf_(v[0]) * v[4], siluf_(v[1]) * v[5]); w.y = pk2(siluf_(v[2]) * v[6], siluf_(v[3]) * v[7]);
        *(u32x2*)(HID + row * 256 + col) = w;
    } };
struct EpiDownAtomic { float* out; const int* ent; const float* mod;
    __device__ __forceinline__ void store8(const Unit& u, int r, int c, const float (&v)[8]) const {
        const int e0 = ent[2 * (u.pm * 256 + r)]; if (e0 < 0) return; const float w = __builtin_bit_cast(float, ent[2 * (u.pm * 256 + r) + 1]);
        const int col = (u.pn & 3) * 256 + c, b = e0 / SEQ; const float* gt = mod + b * 6144 + 5120 + col; float* o = out + (size_t)e0 * 1024 + col;
        const f32x4 g0 = *(const f32x4*)gt, g1 = *(const f32x4*)(gt + 4);
        unsafeAtomicAdd(o + 0, g0.x * w * v[0]); unsafeAtomicAdd(o + 1, g0.y * w * v[1]); unsafeAtomicAdd(o + 2, g0.z * w * v[2]); unsafeAtomicAdd(o + 3, g0.w * w * v[3]);
        unsafeAtomicAdd(o + 4, g1.x * w * v[4]); unsafeAtomicAdd(o + 5, g1.y * w * v[5]); unsafeAtomicAdd(o + 6, g1.z * w * v[6]); unsafeAtomicAdd(o + 7, g1.w * w * v[7]);
    } };
struct EpiDown { bf16* YS;
    __device__ __forceinline__ void store8(const Unit& u, int r, int c, const float (&v)[8]) const {
        const size_t row = (size_t)u.pm * 256 + r; *(u32x4*)(YS + row * 1024 + (u.pn & 3) * 256 + c) = pack8(v);
    } };


namespace pg8 {
#define PG8_LAS __attribute__((address_space(3)))
typedef ::bf16x8 bf16x8; typedef ::f32x4 f32x4;
using ::Unit; using ::Gemm;
constexpr int BM = 256, BK = 64, HALF = 128, HTB = HALF * BK * 2  , STAGE_BYTES = 8 * HTB;

__device__ __forceinline__ int lds_byte(int r, int c) { const int st = (r >> 4) * 2 + (c >> 5), rr = r & 15, cc = c & 31, ob = rr * 64 + cc * 2; return st * 1024 + (ob ^ (((ob >> 9) & 1) << 5)); }
__device__ __forceinline__ void stage_rc(int b, int& R, int& C) { const int st = b / 1024, sb = b % 1024, swz = sb ^ (((sb >> 9) & 1) << 5); R = (st >> 1) * 16 + swz / 64; C = (st & 1) * 32 + (swz % 64) / 2; }
__device__ __forceinline__ int perm32(int rho) { const int n = rho >> 4, i = rho & 15; return 8 * (i >> 2) + 4 * n + (i & 3); }
template <class Epi, class Sched, bool ALIGN_EPI = false, bool SP2 = false, bool GATHER = false, bool MIDHOOK = false>
__device__ __forceinline__ void gemm_phase(PG8_LAS unsigned char* lds, const Gemm g, const Sched& S, const Epi& E, const int wave_in) {
    const int lane = lane_id_fresh(), wid = wave_in, tid = wid * 64 + lane,
              wr = wid >> 2, wc = wid & 3, fr = lane & 15, fq = lane >> 4;
    const int K = g.K, nt = K / BK;
    unsigned voffA[2], voffB[2];
#pragma unroll
    for (int i = 0; i < 2; ++i) { int R, C; stage_rc(tid * 16 + i * 8192, R, C); const int Rb = Epi::PERM ? ((R & ~31) + perm32(R & 31)) : R;
        voffA[i] = (unsigned)(R * K + C) * 2u; voffB[i] = (unsigned)(Rb * K + C) * 2u; }
    unsigned vAc[2][2] = {{0u, 0u}, {0u, 0u}}, vAn[2][2] = {{0u, 0u}, {0u, 0u}}; int gR[2] = {0, 0}; unsigned gC[2] = {0u, 0u};
    if constexpr (GATHER) {
#pragma unroll
        for (int i = 0; i < 2; ++i) { int R, C; stage_rc(tid * 16 + i * 8192, R, C); gR[i] = R; gC[i] = (unsigned)C * 2u; } }
#define PG8_GIDX(dst, pm_) do { _Pragma("unroll") for (int _h = 0; _h < 2; ++_h) _Pragma("unroll") for (int _i = 0; _i < 2; ++_i) \
        dst[_h][_i] = (unsigned)g.ridx[(pm_) * BM + _h * HALF + gR[_i]] * (unsigned)(K * 2) + gC[_i]; } while (0)
    const size_t kstep = (size_t)(BK * 2);
    const size_t hstep = (size_t)HALF * K * 2;
    const size_t tstep = 2 * hstep;
    const unsigned ldsw = (unsigned)wid * 1024u;
    const int aoff = lds_byte(wr * 64 + fr, fq * 8), boff = lds_byte(wc * 32 + fr, fq * 8);
#define PG8_SA(b, h) (((b) * 2 + (h)) * HTB)
#define PG8_SB(b, h) ((4 + (b) * 2 + (h)) * HTB)
#define PG8_STAGE(bufoff, gbase, voff) do { _Pragma("unroll") for (int _i = 0; _i < 2; ++_i) \
        __builtin_amdgcn_global_load_lds((const unsigned*)((const char*)(gbase) + (voff)[_i]), (PG8_LAS unsigned*)(lds + (bufoff) + ldsw + _i * 8192), 16, 0, 0); } while (0)
#define PG8_STAGE_A(bufoff, kptr, h, isnext) do { if constexpr (GATHER) { unsigned _v[2]; _v[0] = (isnext) ? vAn[h][0] : vAc[h][0]; _v[1] = (isnext) ? vAn[h][1] : vAc[h][1]; PG8_STAGE(bufoff, kptr, _v); } \
        else { PG8_STAGE(bufoff, (kptr) + (h) * hstep, voffA); } } while (0)
#define PG8_LDA(dst, b, h) do { _Pragma("unroll") for (int m = 0; m < 4; ++m) _Pragma("unroll") for (int k = 0; k < 2; ++k) dst[m][k] = *(const PG8_LAS bf16x8*)(lds + PG8_SA(b, h) + aoff + m * 2048 + k * 1024); } while (0)
#define PG8_LDB(dst, b, h) do { _Pragma("unroll") for (int n = 0; n < 2; ++n) _Pragma("unroll") for (int k = 0; k < 2; ++k) dst[n][k] = *(const PG8_LAS bf16x8*)(lds + PG8_SB(b, h) + boff + n * 2048 + k * 1024); } while (0)
#define PG8_MMA(ai, bj, At, Bt) do { __builtin_amdgcn_s_setprio(1); _Pragma("unroll") for (int m = 0; m < 4; ++m) _Pragma("unroll") for (int n = 0; n < 2; ++n) _Pragma("unroll") for (int k = 0; k < 2; ++k) \
        acc[ai][bj][m][n] = __builtin_amdgcn_mfma_f32_16x16x32_bf16(Bt[n][k], At[m][k], acc[ai][bj][m][n], 0, 0, 0); __builtin_amdgcn_s_setprio(0); } while (0)
#define PG8_WAIT_V(n) asm volatile("s_waitcnt vmcnt(" #n ")" ::: "memory")
#define PG8_WAIT_L(n) asm volatile("s_waitcnt lgkmcnt(" #n ")" ::: "memory")
#define PG8_BAR __builtin_amdgcn_s_barrier()
#define PG8_SCHED __builtin_amdgcn_sched_barrier(0)
    Unit cur, nxt; int ui = 0;
    if (!S.next(0, cur)) return;
    f32x4 acc[2][2][4][2];
#pragma unroll
    for (int a = 0; a < 2; ++a)
#pragma unroll
        for (int b = 0; b < 2; ++b)
#pragma unroll
            for (int m = 0; m < 4; ++m)
#pragma unroll
                for (int n = 0; n < 2; ++n) acc[a][b][m][n] = (f32x4){0.f, 0.f, 0.f, 0.f};
    bf16x8 At[4][2], B0[2][2], B1[2][2];
    const char* cA = (const char*)g.A + (GATHER ? (size_t)0 : (size_t)cur.pm * tstep); const char* cB = (const char*)g.Bt + (size_t)cur.pn * tstep;
    if constexpr (GATHER) PG8_GIDX(vAc, cur.pm);
    S.a_ready(cur);
    if constexpr (SP2) {
        PG8_STAGE(PG8_SB(0, 0), cB, voffB); PG8_STAGE(PG8_SB(0, 1), cB + hstep, voffB); PG8_STAGE_A(PG8_SA(0, 0), cA, 0, false); PG8_STAGE_A(PG8_SA(0, 1), cA, 1, false);
        if (wr == 1) PG8_BAR;
        PG8_WAIT_V(2); PG8_BAR;
        PG8_STAGE(PG8_SB(1, 0), cB + kstep, voffB); PG8_STAGE_A(PG8_SA(1, 0), cA + kstep, 0, false); PG8_STAGE(PG8_SB(1, 1), cB + hstep + kstep, voffB);
        PG8_WAIT_V(6); PG8_BAR;
    } else {
        PG8_STAGE(PG8_SB(0, 0), cB, voffB); PG8_STAGE(PG8_SA(0, 0), cA, voffA); PG8_STAGE(PG8_SB(0, 1), cB + hstep, voffB); PG8_STAGE(PG8_SA(0, 1), cA + hstep, voffA);
        if (wr == 1) PG8_BAR;
        PG8_WAIT_V(4); PG8_BAR;
        PG8_STAGE(PG8_SB(1, 0), cB + kstep, voffB); PG8_STAGE(PG8_SA(1, 0), cA + kstep, voffA); PG8_STAGE(PG8_SB(1, 1), cB + hstep + kstep, voffB);
        PG8_WAIT_V(6); PG8_BAR;
    }
    for (;;) {
        const bool has_next = S.next(ui + 1, nxt);
        const char* nA = (has_next && !GATHER) ? (const char*)g.A + (size_t)nxt.pm * tstep : cA; const char* nB = has_next ? (const char*)g.Bt + (size_t)nxt.pn * tstep : cB;
        if constexpr (GATHER) { if (has_next) PG8_GIDX(vAn, nxt.pm); else { _Pragma("unroll") for (int _h = 0; _h < 2; ++_h) { vAn[_h][0] = vAc[_h][0]; vAn[_h][1] = vAc[_h][1]; } } }
        for (int t = 0; t < nt; t += 2) {
            if constexpr (MIDHOOK) { if (t == nt / 2) { E.mid(acc, cur, wr, wc, fr, fq); PG8_WAIT_V(0); } }
            const bool last = (t == nt - 2);
            const char* a1 = cA + (size_t)(t + 1) * kstep;
            const char* a2 = last ? nA : cA + (size_t)(t + 2) * kstep; const char* b2 = last ? nB : cB + (size_t)(t + 2) * kstep;
            const char* a3 = a2 + kstep; const char* b3 = b2 + kstep;
            if (last && has_next) S.a_ready(nxt);
            if constexpr (SP2) {
            PG8_LDB(B0, 0, 0); PG8_LDB(B1, 0, 1); PG8_SCHED; PG8_LDA(At, 0, 0); PG8_STAGE_A(PG8_SA(1, 1), a1, 1, false);
            PG8_WAIT_V(8); PG8_WAIT_L(0); PG8_BAR; PG8_MMA(0, 0, At, B0); PG8_MMA(0, 1, At, B1); PG8_BAR; PG8_SCHED;
            PG8_LDA(At, 0, 1); PG8_STAGE(PG8_SB(0, 0), b2, voffB); PG8_STAGE(PG8_SB(0, 1), b2 + hstep, voffB); PG8_STAGE_A(PG8_SA(0, 0), a2, 0, last);
            PG8_WAIT_V(8); PG8_WAIT_L(0); PG8_BAR; PG8_MMA(1, 0, At, B0); PG8_MMA(1, 1, At, B1); PG8_BAR; PG8_SCHED;
            PG8_LDB(B0, 1, 0); PG8_LDB(B1, 1, 1); PG8_SCHED; PG8_LDA(At, 1, 0); PG8_STAGE_A(PG8_SA(0, 1), a2, 1, last);
            PG8_WAIT_V(8); PG8_WAIT_L(0); PG8_BAR; PG8_MMA(0, 0, At, B0); PG8_MMA(0, 1, At, B1); PG8_BAR; PG8_SCHED;
            PG8_LDA(At, 1, 1); PG8_STAGE(PG8_SB(1, 0), b3, voffB); PG8_STAGE(PG8_SB(1, 1), b3 + hstep, voffB); PG8_STAGE_A(PG8_SA(1, 0), a3, 0, last);
            PG8_WAIT_V(8); PG8_WAIT_L(0); PG8_BAR; PG8_MMA(1, 0, At, B0); PG8_MMA(1, 1, At, B1); PG8_BAR; PG8_SCHED;
            } else {
            PG8_LDB(B0, 0, 0); PG8_SCHED; PG8_LDA(At, 0, 0); PG8_STAGE(PG8_SA(1, 1), a1 + hstep, voffA);
            PG8_WAIT_L(8); PG8_BAR; PG8_WAIT_L(0); PG8_MMA(0, 0, At, B0); PG8_BAR; PG8_SCHED;
            PG8_LDB(B1, 0, 1); PG8_STAGE(PG8_SB(0, 0), b2, voffB);
            PG8_BAR; PG8_WAIT_L(0); PG8_MMA(0, 1, At, B1); PG8_BAR;
            PG8_LDA(At, 0, 1); PG8_STAGE(PG8_SA(0, 0), a2, voffA);
            PG8_BAR; PG8_WAIT_L(0); PG8_MMA(1, 0, At, B0); PG8_BAR; PG8_SCHED;
            PG8_STAGE(PG8_SB(0, 1), b2 + hstep, voffB);
            PG8_WAIT_V(6); PG8_BAR; PG8_MMA(1, 1, At, B1); PG8_BAR;
            PG8_LDB(B0, 1, 0); PG8_SCHED; PG8_LDA(At, 1, 0); PG8_STAGE(PG8_SA(0, 1), a2 + hstep, voffA);
            PG8_WAIT_L(8); PG8_BAR; PG8_WAIT_L(0); PG8_MMA(0, 0, At, B0); PG8_BAR; PG8_SCHED;
            PG8_LDB(B1, 1, 1); PG8_STAGE(PG8_SB(1, 0), b3, voffB);
            PG8_BAR; PG8_WAIT_L(0); PG8_MMA(0, 1, At, B1); PG8_BAR;
            PG8_LDA(At, 1, 1); PG8_STAGE(PG8_SA(1, 0), a3, voffA);
            PG8_BAR; PG8_WAIT_L(0); PG8_MMA(1, 0, At, B0); PG8_BAR; PG8_SCHED;
            PG8_STAGE(PG8_SB(1, 1), b3 + hstep, voffB);
            PG8_WAIT_V(6); PG8_BAR; PG8_MMA(1, 1, At, B1); PG8_BAR;
            }
        }
        if constexpr (ALIGN_EPI) { if (wr == 0) PG8_BAR; }
        if constexpr (!Epi::AFTER_DRAIN) { E(acc, cur, wr, wc, fr, fq); S.done(cur); }
        if (!has_next) break;
#pragma unroll
        for (int a = 0; a < 2; ++a)
#pragma unroll
            for (int b = 0; b < 2; ++b)
#pragma unroll
                for (int m = 0; m < 4; ++m)
#pragma unroll
                    for (int n = 0; n < 2; ++n) acc[a][b][m][n] = (f32x4){0.f, 0.f, 0.f, 0.f};
        cur = nxt; cA = nA; cB = nB; ++ui;
        if constexpr (GATHER) { _Pragma("unroll") for (int _h = 0; _h < 2; ++_h) { vAc[_h][0] = vAn[_h][0]; vAc[_h][1] = vAn[_h][1]; } }
        if constexpr (ALIGN_EPI) { if (wr == 1) PG8_BAR; }
    }
    PG8_WAIT_V(0);
    if constexpr (!ALIGN_EPI) { if (wr == 0) PG8_BAR; }
    PG8_BAR;
    if constexpr (Epi::AFTER_DRAIN) { E.fused(acc, cur, wr, wc, fr, fq, lds, wid, lane); S.done(cur); }
#undef PG8_SA
#undef PG8_SB
#undef PG8_STAGE
#undef PG8_STAGE_A
#undef PG8_GIDX
#undef PG8_LDA
#undef PG8_LDB
#undef PG8_MMA
#undef PG8_WAIT_V
#undef PG8_WAIT_L
#undef PG8_BAR
#undef PG8_SCHED
}

template <class F> struct EpiAdapt {
    static constexpr bool PERM = true, AFTER_DRAIN = false; F f;
    __device__ __forceinline__ void mid(f32x4 (&acc)[2][2][4][2], const Unit& u, int wr, int wc, int fr, int fq) const {
        asm volatile("" : "+v"(fr), "+v"(fq));
#pragma unroll
        for (int ai = 0; ai < 2; ++ai)
#pragma unroll
            for (int m = 0; m < 4; ++m) { const int row = ai * HALF + wr * 64 + m * 16 + fr;
#pragma unroll
                for (int bj = 0; bj < 2; ++bj) { float v[8] = {acc[ai][bj][m][0][0], acc[ai][bj][m][0][1], acc[ai][bj][m][0][2], acc[ai][bj][m][0][3], acc[ai][bj][m][1][0], acc[ai][bj][m][1][1], acc[ai][bj][m][1][2], acc[ai][bj][m][1][3]};
                    f.mid8(u, row, bj * HALF + wc * 32 + 8 * fq, v);
                    acc[ai][bj][m][0] = (f32x4){v[0], v[1], v[2], v[3]}; acc[ai][bj][m][1] = (f32x4){v[4], v[5], v[6], v[7]}; } }
    }
    __device__ __forceinline__ void operator()(const f32x4 (&acc)[2][2][4][2], const Unit& u, int wr, int wc, int fr, int fq) const {
        asm volatile("" : "+v"(fr), "+v"(fq));
#pragma unroll
        for (int ai = 0; ai < 2; ++ai)
#pragma unroll
            for (int m = 0; m < 4; ++m) { const int row = ai * HALF + wr * 64 + m * 16 + fr;
#pragma unroll
                for (int bj = 0; bj < 2; ++bj) { const f32x4 v0 = acc[ai][bj][m][0], v1 = acc[ai][bj][m][1];
                    const float v[8] = {v0[0], v0[1], v0[2], v0[3], v1[0], v1[1], v1[2], v1[3]};
                    f.store8(u, row, bj * HALF + wc * 32 + 8 * fq, v); } }
    }
};
}

template <class Epi, class Sched>
__device__ __forceinline__ void gemm_phase_mid(LAS unsigned char* lds, const Gemm g, const Sched& S, const Epi& E, const int wave_in) {
    pg8::EpiAdapt<Epi> EA{E};
    pg8::gemm_phase<pg8::EpiAdapt<Epi>, Sched, true, true, false, true>(lds, g, S, EA, wave_in);
}
template <class Epi, class Sched>
__device__ __forceinline__ void gemm_phase_gather(LAS unsigned char* lds, const Gemm g, const Sched& S, const Epi& E, const int wave_in) {
    pg8::EpiAdapt<Epi> EA{E};
    pg8::gemm_phase<pg8::EpiAdapt<Epi>, Sched, true, true, true>(lds, g, S, EA, wave_in);
}
template <class Epi, class Sched>
__device__ __forceinline__ void gemm_phase_any(LAS unsigned char* lds, const Gemm g, const Sched& S, const Epi& E, const int wave_in) {
#if ENG_GEMM == 1
    pg8::EpiAdapt<Epi> EA{E};
    pg8::gemm_phase<pg8::EpiAdapt<Epi>, Sched, true, true>(lds, g, S, EA, wave_in);
#else
    gemm_phase_naive<Epi, Sched>(lds, g, S, E);
#endif
}

template <class RowMap>
__device__ __forceinline__ void transpose_item(const float* W, int ldw, bf16* WT, int ldt, int koff, int k0, int n0, const RowMap& rm, LAS float* scr, int lane) {
#pragma unroll 8
    for (int i = 0; i < 32; ++i) { const int kk = 2 * i + (lane >> 5); scr[kk * 33 + (lane & 31)] = W[(size_t)(k0 + kk) * ldw + n0 + (lane & 31)]; }
    asm volatile("s_waitcnt lgkmcnt(0)" ::: "memory");
    const int c = lane & 7;
#pragma unroll
    for (int j = 0; j < 4; ++j) { const int n = (lane >> 3) + 8 * j; const LAS float* s = scr + (8 * c) * 33 + n;
        u32x4 o; o.x = pk2(s[0 * 33], s[1 * 33]); o.y = pk2(s[2 * 33], s[3 * 33]); o.z = pk2(s[4 * 33], s[5 * 33]); o.w = pk2(s[6 * 33], s[7 * 33]);
        *(u32x4*)(WT + (size_t)rm(n0 + n) * ldt + koff + k0 + 8 * c) = o; }
    asm volatile("s_waitcnt lgkmcnt(0)" ::: "memory");
}
struct RmId { int off; __device__ int operator()(int n) const { return off + n; } };
struct RmWin { __device__ int operator()(int n) const { return n < 1792 ? n : (n < 2208 ? 3840 + (n - 1792) : 1792 + (n - 2208)); } };
struct RmUkv { __device__ int operator()(int n) const { const int h = n >> 7, j = n & 127; return j < 64 ? h * 64 + j : 512 + h * 64 + (j - 64); } };
struct RmGU { int off; __device__ int operator()(int j) const { return off + 8 * (j >> 2) + (j & 3); } };

__device__ __forceinline__ void p0_prologue(const Frame& F, ArgsP a) {
    const int lane_f = lane_id_fresh(), tid_f = F.wave * 64 + lane_f;
    LAS float* scr = (LAS float*)(F.lds + F.wave * 16384);
    const int lane = lane_f;
    bf16* Win = (bf16*)(F.ws + WS_WIN); bf16* Wblk = (bf16*)(F.ws + WS_WBLK); bf16* Wg = (bf16*)(F.ws + WS_WG); bf16* Wuq = (bf16*)(F.ws + WS_WUQ);
    bf16* Wukv = (bf16*)(F.ws + WS_WUKV); bf16* Wb = (bf16*)(F.ws + WS_WB); bf16* Wo = (bf16*)(F.ws + WS_WO); bf16* Wgu = (bf16*)(F.ws + WS_WGU); bf16* Wdn = (bf16*)(F.ws + WS_WDN);
    constexpr int I_IN = 16 * 133, I_DEC = 1 * 16, I_AUP = 16, I_GUP = 2 * 16, I_UQ = 4 * 24, I_UKV = 2 * 32, I_BR = 2 * 8 * 32, I_O = 16 * 32;
    constexpr int I_EG = 32 * 16 * 8, I_EU = I_EG, I_ED = 32 * 4 * 32;
    constexpr int NITEMS = I_IN + I_DEC + I_AUP + I_GUP + I_UQ + I_UKV + I_BR + I_O + I_EG + I_EU + I_ED;
    for (int it = F.gw; it < NITEMS; it += F.NGW) {
        int r = it;
        if (r < I_IN) { const int kb = r / 133, nb = r % 133; transpose_item(a->in[I_WIN], D_IN, Win, 1024, 0, 64 * kb, 32 * nb, RmWin{}, scr, lane); continue; } r -= I_IN;
        if (r < I_DEC) { transpose_item(a->in[I_WDEC], 512, Wblk, 128, 0, 0, 32 * r, RmId{0}, scr, lane); continue; } r -= I_DEC;
        if (r < I_AUP) { transpose_item(a->in[I_WAUP], 512, Wblk, 128, 64, 0, 32 * r, RmId{512}, scr, lane); continue; } r -= I_AUP;
        if (r < I_GUP) { const int kb = r / 16, nb = r % 16; transpose_item(a->in[I_WGUP], 512, Wg, 128, 0, 64 * kb, 32 * nb, RmId{0}, scr, lane); continue; } r -= I_GUP;
        if (r < I_UQ) { const int kb = r / 24, nb = r % 24; transpose_item(a->in[I_WUQ], 768, Wuq, 256, 0, 64 * kb, 32 * nb, RmId{0}, scr, lane); continue; } r -= I_UQ;
        if (r < I_UKV) { const int kb = r / 32, nb = r % 32; transpose_item(a->in[I_WUKV], 1024, Wukv, 128, 0, 64 * kb, 32 * nb, RmUkv{}, scr, lane); continue; } r -= I_UKV;
        if (r < I_BR) { const int br = r / 256, q = r % 256, kb = q / 32, nb = q % 32; transpose_item(a->in[I_WBR] + (size_t)br * 512 * 1024, 1024, Wb, 1024, 512 * br, 64 * kb, 32 * nb, RmId{0}, scr, lane); continue; } r -= I_BR;
        if (r < I_O) { const int kb = r / 32, nb = r % 32; transpose_item(a->in[I_WOUT], 1024, Wo, 1024, 0, 64 * kb, 32 * nb, RmId{0}, scr, lane); continue; } r -= I_O;
        if (r < I_EG) { const int e = r / 128, q = r % 128, kb = q / 8, nb = q % 8; transpose_item(a->in[I_WEG] + (size_t)e * 1024 * 256, 256, Wgu + (size_t)e * 512 * 1024, 1024, 0, 64 * kb, 32 * nb, RmGU{0}, scr, lane); continue; } r -= I_EG;
        if (r < I_EU) { const int e = r / 128, q = r % 128, kb = q / 8, nb = q % 8; transpose_item(a->in[I_WEU] + (size_t)e * 1024 * 256, 256, Wgu + (size_t)e * 512 * 1024, 1024, 0, 64 * kb, 32 * nb, RmGU{4}, scr, lane); continue; } r -= I_EU;
        { const int e = r / 128, q = r % 128, kb = q / 32, nb = q % 32; transpose_item(a->in[I_WED] + (size_t)e * 256 * 1024, 1024, Wdn + (size_t)e * 1024 * 256, 256, 0, 64 * kb, 32 * nb, RmId{0}, scr, lane); }
    }
    for (int i = F.gw * 64 + lane; i < 96 * 128; i += F.NGW * 64) *(u32x4*)(Win + (size_t)4256 * 1024 + (size_t)i * 8) = (u32x4){0u, 0u, 0u, 0u};
    for (int i = F.gw * 64 + lane; i < 1024 * 8; i += F.NGW * 64) { const int row = i >> 3, c8 = (i & 7) * 8; *(u32x4*)(Wblk + row * 128 + (row < 512 ? 64 : 0) + c8) = (u32x4){0u, 0u, 0u, 0u}; }
    { const int* pos = (const int*)a->in[I_POS]; float* cs = (float*)(F.ws + WS_CS);
      for (int i = F.gw * 64 + lane; i < NTOK * 16; i += F.NGW * 64) { const int t = i >> 4, j = i & 15;
          const float fr = exp2f(-(float)j * (13.287712379549449f / 16.0f));
          const float ang = (float)pos[t] * fr; cs[t * 32 + j] = cosf(ang); cs[t * 32 + 16 + j] = sinf(ang); } }
    { float* mod = (float*)(F.ws + WS_MOD); const float* c = a->in[I_C]; const float* wa = a->in[I_WADA]; const float* ba = a->in[I_BADA];
      LAS float* red = (LAS float*)(F.lds + 8 * 16384);
      for (int nb = F.vcu; nb < 96; nb += F.G) {
          float acc[8];
#pragma unroll
          for (int b = 0; b < 8; ++b) acc[b] = 0.f;
          const int n = nb * 64 + lane;
          for (int k = F.wave * 128; k < F.wave * 128 + 128; ++k) { const float w = wa[(size_t)k * 6144 + n];
#pragma unroll
              for (int b = 0; b < 8; ++b) acc[b] = fmaf(siluf_(c[b * 1024 + k]), w, acc[b]); }
#pragma unroll
          for (int b = 0; b < 8; ++b) red[(F.wave * 8 + b) * 64 + lane] = acc[b];
          __syncthreads();
          { const int b = F.wave; float s = ba[n];
#pragma unroll
            for (int w = 0; w < 8; ++w) s += red[(w * 8 + b) * 64 + lane];
            mod[b * 6144 + n] = s; }
          __syncthreads();
      } }
}

__device__ __forceinline__ void p_normmod(const Frame& F, const float* x, const float* g, const float* mod, int sh_off, int sc_off, bf16* H) {
    const int lane_f = lane_id_fresh();
    f32x4 nx[4];
    { const f32x4* xr = (const f32x4*)(x + (size_t)F.gw * 1024) + lane_f;
#pragma unroll
      for (int j = 0; j < 4; ++j) nx[j] = xr[64 * j]; }
    for (int m = F.gw; m < NTOK; m += F.NGW) {
        const int b = m / SEQ;
        f32x4 v[4]; float s = 0.f;
#pragma unroll
        for (int j = 0; j < 4; ++j) v[j] = nx[j];
        { const int mn = (m + F.NGW < NTOK) ? m + F.NGW : m; const f32x4* xr = (const f32x4*)(x + (size_t)mn * 1024) + lane_f;
#pragma unroll
          for (int j = 0; j < 4; ++j) nx[j] = xr[64 * j]; }
#pragma unroll
        for (int j = 0; j < 4; ++j) s += (v[j].x * v[j].x + v[j].y * v[j].y) + (v[j].z * v[j].z + v[j].w * v[j].w);
        const float rstd = 1.0f / sqrtf(wave_sum(s) * (1.f / 1024.f) + EPS);
        u32x2* o = (u32x2*)(H + (size_t)m * 1024) + lane_f;
#pragma unroll
        for (int j = 0; j < 4; ++j) { const int col = 4 * lane_f + 256 * j;
            const f32x4 gg = *(const f32x4*)(g + col), sc = *(const f32x4*)(mod + b * 6144 + sc_off + col), sh = *(const f32x4*)(mod + b * 6144 + sh_off + col);
            const f32x4 y = v[j] * rstd * gg * (sc + 1.0f) + sh; u32x2 w; w.x = pk2(y.x, y.y); w.y = pk2(y.z, y.w); o[64 * j] = w; }
    }
}

__device__ __forceinline__ void p_prep_a(const Frame& F, ArgsP a) {
    const int lane_f = lane_id_fresh();
    const bf16* ZR = (const bf16*)(F.ws + WS_ZR); const bf16* ZM = (const bf16*)(F.ws + WS_ZM);
    bf16* TWA = (bf16*)(F.ws + WS_TWA); bf16* SGL = (bf16*)(F.ws + WS_SGL); bf16* QA = (bf16*)(F.ws + WS_QA); bf16* KVA = (bf16*)(F.ws + WS_KVA);
    const float* mu = a->in[I_MU]; const float* gqa = a->in[I_GQA]; const float* gkva = a->in[I_GKVA];
    const int lane = lane_f;
    const f32x4 mm = *(const f32x4*)(mu + 1536 + 4 * lane), gq = *(const f32x4*)(gqa + 4 * lane), gk = *(const f32x4*)(gkva + 4 * (lane & 31));
    for (int m = F.gw; m < NTOK; m += F.NGW) {
        const bool first = (m % SEQ) == 0;
        { const u32x2 c = *((const u32x2*)(ZR + (size_t)m * 1792 + 1536) + lane); u32x2 p = *((const u32x2*)(ZR + (size_t)(first ? m : m - 1) * 1792 + 1536) + lane); if (first) { p.x = 0u; p.y = 0u; }
          float z[4] = {lo2f(c.x), hi2f(c.x), lo2f(c.y), hi2f(c.y)}; const float q[4] = {lo2f(p.x), hi2f(p.x), lo2f(p.y), hi2f(p.y)};
          z[0] += (q[0] - z[0]) * mm.x; z[1] += (q[1] - z[1]) * mm.y; z[2] += (q[2] - z[2]) * mm.z; z[3] += (q[3] - z[3]) * mm.w;
          if (lane < 16) { u32x2 w; w.x = pk2(tanhf(z[0]), tanhf(z[1])); w.y = pk2(tanhf(z[2]), tanhf(z[3])); *((u32x2*)(TWA + (size_t)m * 128) + lane) = w; }
          else if (lane < 32) { u32x2 w; w.x = pk2(z[0], z[1]); w.y = pk2(z[2], z[3]); *((u32x2*)(TWA + (size_t)m * 128) + lane) = w; }
          else { u32x2 w; w.x = pk2(sigmoidf_(z[0]), sigmoidf_(z[1])); w.y = pk2(sigmoidf_(z[2]), sigmoidf_(z[3])); *((u32x2*)(SGL + (size_t)m * 128) + (lane - 32)) = w; } }
        { const u32x2 c = *((const u32x2*)(ZM + (size_t)m * 512) + lane); const float z[4] = {lo2f(c.x), hi2f(c.x), lo2f(c.y), hi2f(c.y)};
          u32x2 c2 = (u32x2){0u, 0u}; if (lane < 32) c2 = *((const u32x2*)(ZM + (size_t)m * 512 + 256) + lane); const float y[4] = {lo2f(c2.x), hi2f(c2.x), lo2f(c2.y), hi2f(c2.y)};
          const float rstd = 1.0f / sqrtf(wave_sum((z[0] * z[0] + z[1] * z[1]) + (z[2] * z[2] + z[3] * z[3])) * (1.f / 256.f) + EPS);
          const float rstd2 = 1.0f / sqrtf(wave_sum((y[0] * y[0] + y[1] * y[1]) + (y[2] * y[2] + y[3] * y[3])) * (1.f / 128.f) + EPS);
          u32x2 w; w.x = pk2(z[0] * rstd * gq.x, z[1] * rstd * gq.y); w.y = pk2(z[2] * rstd * gq.z, z[3] * rstd * gq.w);
          *((u32x2*)(QA + (size_t)m * 256) + lane) = w;
          if (lane < 32) { u32x2 w2; w2.x = pk2(y[0] * rstd2 * gk.x, y[1] * rstd2 * gk.y); w2.y = pk2(y[2] * rstd2 * gk.z, y[3] * rstd2 * gk.w);
              *((u32x2*)(KVA + (size_t)m * 128) + lane) = w2; } }
    }
}

__device__ __forceinline__ void p_prep_c(const Frame& F, ArgsP a) {
    const int lane_f = lane_id_fresh(), tid_f = F.wave * 64 + lane_f;
    bf16* Q = (bf16*)(F.dob + DO_Q); const bf16* KN = (const bf16*)(F.dob + DO_KN); const bf16* ZM = (const bf16*)(F.ws + WS_ZM); bf16* KC = (bf16*)(F.ws + WS_KC);
    const float* cs = (const float*)(F.ws + WS_CS);
    const float* qn = a->in[I_QN]; const float* kn = a->in[I_KN];
    const int lane = lane_f, hd = lane >> 3, j = lane & 7;
    for (int m = F.gw; m < NTOK; m += F.NGW) {
        const f32x2 cc = *(const f32x2*)(cs + (size_t)m * 32 + 2 * j), sn = *(const f32x2*)(cs + (size_t)m * 32 + 16 + 2 * j);
        { bf16* qp = Q + (size_t)m * 768 + hd * 96; float v[8]; unpack8(*(const u32x4*)(qp + 8 * j), v);
          const unsigned w1 = *(const unsigned*)(qp + 64 + 2 * j), w2 = *(const unsigned*)(qp + 80 + 2 * j); float x1[2] = {lo2f(w1), hi2f(w1)}, x2[2] = {lo2f(w2), hi2f(w2)};
          float ss = (x1[0] * x1[0] + x1[1] * x1[1]) + (x2[0] * x2[0] + x2[1] * x2[1]);
#pragma unroll
          for (int i = 0; i < 8; ++i) ss += v[i] * v[i];
          const float rstd = 1.0f / sqrtf(sum8(ss) * (1.f / 96.f) + EPS);
#pragma unroll
          for (int i = 0; i < 8; ++i) v[i] = v[i] * rstd * qn[8 * j + i] * QSCALE;
          x1[0] *= rstd * qn[64 + 2 * j]; x1[1] *= rstd * qn[65 + 2 * j]; x2[0] *= rstd * qn[80 + 2 * j]; x2[1] *= rstd * qn[81 + 2 * j];
          const float o1a = (x1[0] * cc.x - x2[0] * sn.x) * QSCALE, o1b = (x1[1] * cc.y - x2[1] * sn.y) * QSCALE, o2a = (x2[0] * cc.x + x1[0] * sn.x) * QSCALE, o2b = (x2[1] * cc.y + x1[1] * sn.y) * QSCALE;
          *(u32x4*)(qp + 8 * j) = pack8(v); *(unsigned*)(qp + 64 + 2 * j) = pk2(o1a, o1b); *(unsigned*)(qp + 80 + 2 * j) = pk2(o2a, o2b); }
        { float v[8]; unpack8(*(const u32x4*)(KN + (size_t)m * 512 + hd * 64 + 8 * j), v);
          const unsigned w1 = *(const unsigned*)(ZM + (size_t)m * 512 + 384 + 2 * j), w2 = *(const unsigned*)(ZM + (size_t)m * 512 + 400 + 2 * j); float x1[2] = {lo2f(w1), hi2f(w1)}, x2[2] = {lo2f(w2), hi2f(w2)};
          float ss = (x1[0] * x1[0] + x1[1] * x1[1]) + (x2[0] * x2[0] + x2[1] * x2[1]);
#pragma unroll
          for (int i = 0; i < 8; ++i) ss += v[i] * v[i];
          const float rstd = 1.0f / sqrtf(sum8(ss) * (1.f / 96.f) + EPS);
#pragma unroll
          for (int i = 0; i < 8; ++i) v[i] = v[i] * rstd * kn[8 * j + i];
          x1[0] *= rstd * kn[64 + 2 * j]; x1[1] *= rstd * kn[65 + 2 * j]; x2[0] *= rstd * kn[80 + 2 * j]; x2[1] *= rstd * kn[81 + 2 * j];
          bf16* kp = KC + (size_t)m * 768 + hd * 96;
          *(u32x4*)(kp + 8 * j) = pack8(v); *(unsigned*)(kp + 64 + 2 * j) = pk2(x1[0] * cc.x - x2[0] * sn.x, x1[1] * cc.y - x2[1] * sn.y);
          *(unsigned*)(kp + 80 + 2 * j) = pk2(x2[0] * cc.x + x1[0] * sn.x, x2[1] * cc.y + x1[1] * sn.y); }
    }
}

constexpr int SC_T = 32;
constexpr int SC_BUF = 5 * SC_T * 64 * 4 + SC_T * 16 * 4 + SC_T * 16 * 4;
struct ScanRaw { u32x2 rc[2], rp[2], kc[2], kp[2], av[2], lw[2]; u32x4 vc, vp; };
__device__ __forceinline__ void scan_issue(ScanRaw& R, const bf16* ZR, const bf16* A, const bf16* LW, size_t row0, int t0, int st2, int col, int s2, int cv, bool dov) {
#pragma unroll
    for (int u = 0; u < 2; ++u) { const int tt = t0 + st2 + 16 * u; const size_t g = row0 + tt; const size_t gp = row0 + (tt > 0 ? tt - 1 : 0);
        R.rc[u] = *(const u32x2*)(ZR + g * 1792 + col); R.rp[u] = *(const u32x2*)(ZR + gp * 1792 + col);
        R.kc[u] = *(const u32x2*)(ZR + g * 1792 + 512 + col); R.kp[u] = *(const u32x2*)(ZR + gp * 1792 + 512 + col);
        R.av[u] = *(const u32x2*)(A + g * 512 + col); R.lw[u] = *(const u32x2*)(LW + g * 512 + col); }
    { const int tv = t0 + (dov ? s2 : 0); const size_t gv = row0 + tv; const size_t gvp = row0 + (tv > 0 ? tv - 1 : 0); R.vc = *(const u32x4*)(ZR + gv * 1792 + 1024 + cv); R.vp = *(const u32x4*)(ZR + gvp * 1792 + 1024 + cv); }
}
__device__ __forceinline__ void p_scan(const Frame& F, ArgsP a) {
    const int lane_f = lane_id_fresh(), tid_f = F.wave * 64 + lane_f;
    const bf16* ZR = (const bf16*)(F.ws + WS_ZR); const bf16* A = (const bf16*)(F.ws + WS_A); const bf16* LW = (const bf16*)(F.ws + WS_LW); bf16* Y = (bf16*)(F.ws + WS_Y);
    const float* mu = a->in[I_MU]; const float* k_k = a->in[I_KK]; const float* k_a = a->in[I_KA];
    const int lane = lane_f, wave = F.wave, tid = tid_f;
    for (int item = F.vcu; item < 256; item += F.G) {
        const int bh = item >> 2, qt = item & 3, b = bh >> 3, h = bh & 7;
        const size_t row0 = (size_t)b * SEQ; const int colh = h * 64;
        const int NCH = SEQ / SC_T;
        __syncthreads();
        if (wave >= 4) {
            const int lt = tid - 256, st2 = lt >> 4, j4 = (lt & 15) * 4, col = colh + j4, s2 = lt >> 1, hf = lt & 1, cv = colh + qt * 16 + hf * 8; const bool dov = lt < 64;
            f32x4 mur = *(const f32x4*)(mu + col), muk = *(const f32x4*)(mu + 512 + col), kkc = *(const f32x4*)(k_k + col), kac = *(const f32x4*)(k_a + col);
            f32x4 m0 = *(const f32x4*)(mu + 1024 + cv), m1 = *(const f32x4*)(mu + 1024 + cv + 4);
            asm volatile("" : "+v"(mur), "+v"(muk), "+v"(kkc), "+v"(kac), "+v"(m0), "+v"(m1));
            ScanRaw R0, R1;
            scan_issue(R0, ZR, A, LW, row0, 0, st2, col, s2, cv, dov);
#define SCAN_BUILD(RR, c_) do { LAS unsigned char* bs = F.lds + ((c_) & 1) * SC_BUF; \
                _Pragma("unroll") for (int u = 0; u < 2; ++u) { const int st = st2 + 16 * u; const bool t0_ = ((c_) * SC_T + st) == 0; \
                    const f32x4 rc = {lo2f(RR.rc[u].x), hi2f(RR.rc[u].x), lo2f(RR.rc[u].y), hi2f(RR.rc[u].y)}; f32x4 rp = {lo2f(RR.rp[u].x), hi2f(RR.rp[u].x), lo2f(RR.rp[u].y), hi2f(RR.rp[u].y)}; \
                    const f32x4 kc = {lo2f(RR.kc[u].x), hi2f(RR.kc[u].x), lo2f(RR.kc[u].y), hi2f(RR.kc[u].y)}; f32x4 kp = {lo2f(RR.kp[u].x), hi2f(RR.kp[u].x), lo2f(RR.kp[u].y), hi2f(RR.kp[u].y)}; \
                    const f32x4 av = {lo2f(RR.av[u].x), hi2f(RR.av[u].x), lo2f(RR.av[u].y), hi2f(RR.av[u].y)}; const f32x4 lw = {lo2f(RR.lw[u].x), hi2f(RR.lw[u].x), lo2f(RR.lw[u].y), hi2f(RR.lw[u].y)}; \
                    if (t0_) { rp = (f32x4){0.f, 0.f, 0.f, 0.f}; kp = rp; } \
                    const f32x4 r = rc + (rp - rc) * mur, zk = kc + (kp - kc) * muk, kq = zk * ((av - 1.0f) * kac + 1.0f), kr = zk * kkc; \
                    const float ss = allsum16((kr.x * kr.x + kr.y * kr.y) + (kr.z * kr.z + kr.w * kr.w)); const float inv = 1.0f / fmaxf(sqrtf(ss), 1e-12f); \
                    const f32x4 kk = kr * inv; const f32x4 wv = {__expf(lw.x), __expf(lw.y), __expf(lw.z), __expf(lw.w)}; \
                    LAS float* dst = (LAS float*)bs + st * 64 + j4; \
                    *(LAS f32x4*)dst = wv; *(LAS f32x4*)(dst + SC_T * 64) = -kk; *(LAS f32x4*)(dst + 2 * SC_T * 64) = kk * av; *(LAS f32x4*)(dst + 3 * SC_T * 64) = kq; *(LAS f32x4*)(dst + 4 * SC_T * 64) = r; } \
                if (dov) { float vc[8], vp[8]; unpack8(RR.vc, vc); unpack8(RR.vp, vp); if ((c_) * SC_T + s2 == 0) { _Pragma("unroll") for (int i = 0; i < 8; ++i) vp[i] = 0.f; } \
                    LAS float* dv = (LAS float*)(bs + 5 * SC_T * 256) + s2 * 16 + hf * 8; \
                    *(LAS f32x4*)dv = (f32x4){vc[0] + (vp[0] - vc[0]) * m0.x, vc[1] + (vp[1] - vc[1]) * m0.y, vc[2] + (vp[2] - vc[2]) * m0.z, vc[3] + (vp[3] - vc[3]) * m0.w}; \
                    *(LAS f32x4*)(dv + 4) = (f32x4){vc[4] + (vp[4] - vc[4]) * m1.x, vc[5] + (vp[5] - vc[5]) * m1.y, vc[6] + (vp[6] - vc[6]) * m1.z, vc[7] + (vp[7] - vc[7]) * m1.w}; } } while (0)
#define SCAN_FLUSH(c_) do { if ((c_) >= 2 && dov) { LAS unsigned char* bs = F.lds + ((c_) & 1) * SC_BUF; const LAS float* yy = (const LAS float*)(bs + 5 * SC_T * 256 + SC_T * 64) + s2 * 16 + hf * 8; \
                const f32x4 y0 = *(const LAS f32x4*)yy, y1 = *(const LAS f32x4*)(yy + 4); const float v[8] = {y0.x, y0.y, y0.z, y0.w, y1.x, y1.y, y1.z, y1.w}; \
                *(u32x4*)(Y + (row0 + (size_t)((c_) - 2) * SC_T + s2) * 512 + cv) = pack8(v); } } while (0)
            for (int c = 0; c <= NCH + 1; c += 2) {
                SCAN_FLUSH(c);
                scan_issue(R1, ZR, A, LW, row0, (c + 1 < NCH ? c + 1 : NCH - 1) * SC_T, st2, col, s2, cv, dov);
                if (c < NCH) SCAN_BUILD(R0, c);
                LDS_BAR();
                SCAN_FLUSH(c + 1);
                scan_issue(R0, ZR, A, LW, row0, (c + 2 < NCH ? c + 2 : NCH - 1) * SC_T, st2, col, s2, cv, dov);
                if (c + 1 < NCH) SCAN_BUILD(R1, c + 1);
                LDS_BAR();
            }
#undef SCAN_BUILD
#undef SCAN_FLUSH
        } else {
            const int rg = lane >> 4, jl = lane & 15;
            f32x2 Sa = {0.f, 0.f}, Sb = {0.f, 0.f};
            for (int c = 0; c <= NCH + 1; c += 2) {
#pragma unroll
                for (int half = 0; half < 2; ++half) {
                    const int cc = c + half;
                    if (cc >= 1 && cc <= NCH) {
                        LAS unsigned char* bc = F.lds + ((cc + 1) & 1) * SC_BUF;
                        const LAS float* base = (const LAS float*)bc + 4 * jl;
                        const LAS float* vb = (const LAS float*)(bc + 5 * SC_T * 256) + wave * 4 + rg;
                        LAS float* yb = (LAS float*)(bc + 5 * SC_T * 256 + SC_T * 64) + wave * 4 + rg;
                        f32x4 w[2][2], nk[2][2], bb[2][2], kv[2][2], rr[2][2]; float vv1[2][2];
#define SC_LOAD(slot, g_) do { _Pragma("unroll") for (int q = 0; q < 2; ++q) { const int st_ = (g_) * 2 + q; \
                            w[slot][q] = *(const LAS f32x4*)(base + st_ * 64); nk[slot][q] = *(const LAS f32x4*)(base + SC_T * 64 + st_ * 64); bb[slot][q] = *(const LAS f32x4*)(base + 2 * SC_T * 64 + st_ * 64); \
                            kv[slot][q] = *(const LAS f32x4*)(base + 3 * SC_T * 64 + st_ * 64); rr[slot][q] = *(const LAS f32x4*)(base + 4 * SC_T * 64 + st_ * 64); vv1[slot][q] = vb[st_ * 16]; } } while (0)
                        SC_LOAD(0, 0);
#pragma unroll
                        for (int g = 0; g < SC_T / 2; ++g) {
                            const int sl = g & 1;
                            if (g + 1 < SC_T / 2) { if (sl == 0) SC_LOAD(1, g + 1); else SC_LOAD(0, g + 1); }
                            float yo[2];
#pragma unroll
                            for (int q = 0; q < 2; ++q) {
                                const f32x4 w_ = w[sl][q], nk_ = nk[sl][q], bb_ = bb[sl][q], kv_ = kv[sl][q], rr_ = rr[sl][q]; const float v = vv1[sl][q];
                                const f32x2 t0 = Sa * (f32x2){nk_.x, nk_.y} + Sb * (f32x2){nk_.z, nk_.w};
                                const float sa = allsum16(t0.x + t0.y);
                                const f32x2 vv = {v, v}, ss = {sa, sa};
                                Sa = Sa * (f32x2){w_.x, w_.y} + (ss * (f32x2){bb_.x, bb_.y} + vv * (f32x2){kv_.x, kv_.y});
                                Sb = Sb * (f32x2){w_.z, w_.w} + (ss * (f32x2){bb_.z, bb_.w} + vv * (f32x2){kv_.z, kv_.w});
                                const f32x2 t1 = Sa * (f32x2){rr_.x, rr_.y} + Sb * (f32x2){rr_.z, rr_.w};
                                yo[q] = allsum16(t1.x + t1.y);
                            }
                            if (jl == 0) { yb[(g * 2) * 16] = yo[0]; yb[(g * 2 + 1) * 16] = yo[1]; }
                        }
#undef SC_LOAD
                    }
                    LDS_BAR();
                }
            }
        }
    }
}

__device__ __forceinline__ void p_attn_naive(const Frame& F) {
    const int lane_f = lane_id_fresh(), tid_f = F.wave * 64 + lane_f;
    const bf16* Q = (const bf16*)(F.dob + DO_Q); const bf16* KC = (const bf16*)(F.ws + WS_KC); const bf16* VC = (const bf16*)(F.ws + WS_VC); bf16* YM = (bf16*)(F.ws + WS_YM);
    LAS float* Ks = (LAS float*)F.lds; LAS float* Vs = (LAS float*)(F.lds + 32 * 96 * 4);
    const int tid = tid_f;
    for (int unit = F.vcu; unit < 64 * 16; unit += F.G) {
        const int bh = unit >> 4, qb = 15 - (unit & 15), b = bh >> 3, h = bh & 7; const size_t row0 = (size_t)b * SEQ; const int t = qb * 512 + tid;
        unsigned qp[48];
        { const u32x4* qg = (const u32x4*)(Q + (row0 + t) * 768 + h * 96);
#pragma unroll
          for (int i = 0; i < 12; ++i) { const u32x4 w = qg[i]; qp[4 * i] = w.x; qp[4 * i + 1] = w.y; qp[4 * i + 2] = w.z; qp[4 * i + 3] = w.w; } }
        float o[64];
#pragma unroll
        for (int i = 0; i < 64; ++i) o[i] = 0.f;
        float mx = -INFINITY, l = 0.f;
        const int nkt = (qb + 1) * 16;
        for (int kt = 0; kt < nkt; ++kt) {
            __syncthreads();
            if (tid < 384) { const int r = tid / 12, c8 = (tid % 12) * 8; float v[8]; unpack8(*(const u32x4*)(KC + (row0 + kt * 32 + r) * 768 + h * 96 + c8), v);
#pragma unroll
                for (int i = 0; i < 8; ++i) Ks[r * 96 + c8 + i] = v[i]; }
            if (tid < 256) { const int r = tid >> 3, c8 = (tid & 7) * 8; float v[8]; unpack8(*(const u32x4*)(VC + (row0 + kt * 32 + r) * 512 + h * 64 + c8), v);
#pragma unroll
                for (int i = 0; i < 8; ++i) Vs[r * 64 + c8 + i] = v[i]; }
            __syncthreads();
            for (int kk = 0; kk < 32; ++kk) {
                const int kv = kt * 32 + kk;
                float s = 0.f; const LAS f32x4* kr = (const LAS f32x4*)(Ks + kk * 96);
#pragma unroll
                for (int i = 0; i < 24; ++i) { const f32x4 k4 = kr[i]; s += lo2f(qp[2 * i]) * k4.x + hi2f(qp[2 * i]) * k4.y + lo2f(qp[2 * i + 1]) * k4.z + hi2f(qp[2 * i + 1]) * k4.w; }
                if (kv <= t) {
                    const float mn = fmaxf(mx, s), f = exp2f(mx - mn), p = exp2f(s - mn); mx = mn; l = l * f + p;
                    const LAS f32x4* vr = (const LAS f32x4*)(Vs + kk * 64);
#pragma unroll
                    for (int i = 0; i < 16; ++i) { const f32x4 v4 = vr[i]; o[4 * i] = o[4 * i] * f + p * v4.x; o[4 * i + 1] = o[4 * i + 1] * f + p * v4.y; o[4 * i + 2] = o[4 * i + 2] * f + p * v4.z; o[4 * i + 3] = o[4 * i + 3] * f + p * v4.w; }
                }
            }
        }
        const float il = 1.f / l; u32x4* og = (u32x4*)(YM + (row0 + t) * 512 + h * 64);
#pragma unroll
        for (int i = 0; i < 8; ++i) { u32x4 w; w.x = pk2(o[8 * i] * il, o[8 * i + 1] * il); w.y = pk2(o[8 * i + 2] * il, o[8 * i + 3] * il); w.z = pk2(o[8 * i + 4] * il, o[8 * i + 5] * il); w.w = pk2(o[8 * i + 6] * il, o[8 * i + 7] * il); og[i] = w; }
    }
    __syncthreads();
}

typedef float f32x16 __attribute__((ext_vector_type(16)));
typedef short s16x4 __attribute__((ext_vector_type(4)));
__device__ __forceinline__ int crow(int r, int hi) { return (r & 3) + 8 * (r >> 2) + 4 * hi; }
__device__ __forceinline__ float max3f(float a, float b, float c) { float r; asm("v_max3_f32 %0, %1, %2, %3" : "=v"(r) : "v"(a), "v"(b), "v"(c)); return r; }
__device__ __forceinline__ float max2f(float a, float b) { float r; asm("v_max_f32_e32 %0, %1, %2" : "=v"(r) : "v"(a), "v"(b)); return r; }
__device__ __forceinline__ float xhalf_max(float x) { auto rr = __builtin_amdgcn_permlane32_swap(__float_as_uint(x), __float_as_uint(x), false, false); return max2f(__uint_as_float(rr[0]), __uint_as_float(rr[1])); }
__device__ __forceinline__ float xhalf_sum(float x) { auto rr = __builtin_amdgcn_permlane32_swap(__float_as_uint(x), __float_as_uint(x), false, false); return __uint_as_float(rr[0]) + __uint_as_float(rr[1]); }
__device__ __forceinline__ bf16x8 packp(const f32x16& p, int s2) {
    u32x4 w; w.x = pk2(p[8 * s2 + 0], p[8 * s2 + 1]); w.y = pk2(p[8 * s2 + 2], p[8 * s2 + 3]); w.z = pk2(p[8 * s2 + 4], p[8 * s2 + 5]); w.w = pk2(p[8 * s2 + 6], p[8 * s2 + 7]);
    return __builtin_bit_cast(bf16x8, w);
}
__device__ __forceinline__ void p_attn_mfma(const Frame& F) {
    const int lane_f = lane_id_fresh(), tid_f = F.wave * 64 + lane_f;
    const bf16* Q = (const bf16*)(F.dob + DO_Q); const bf16* KC = (const bf16*)(F.ws + WS_KC); const bf16* VC = (const bf16*)(F.ws + WS_VC); bf16* YM = (bf16*)(F.ws + WS_YM);
    constexpr int KST = 208, VST = 192, KBYTES = 64 * KST, SUB = KBYTES + 64 * VST, BUF = 2 * SUB;
    const int tid = tid_f, lane = lane_f, wave = F.wave, r = lane & 31, hi = lane >> 5;
    int kg[3], kl[3], vg[2], vl[2];
#pragma unroll
    for (int i = 0; i < 3; ++i) { const int c = tid + 512 * i, row = c / 12, pc = c % 12; kg[i] = row * 768 + pc * 8; kl[i] = (row >> 6) * SUB + (row & 63) * KST + pc * 16; }
#pragma unroll
    for (int i = 0; i < 2; ++i) { const int c = tid + 512 * i, row = c >> 3, pc = c & 7; vg[i] = row * 512 + pc * 8; vl[i] = (row >> 6) * SUB + KBYTES + (row & 63) * VST + pc * 16; }
    const int g4 = lane >> 4, li = lane & 15;
    const int vtr = (4 * (g4 >> 1) + (li >> 2)) * VST + (16 * (g4 & 1) + 4 * (li & 3)) * 2;
    const int kfr = r * KST + hi * 16;
    LAS unsigned char* lds = F.lds;
    for (int item = F.vcu; item < 1024; item += F.G) {
        const int bh = item >> 4, sidx = item & 15, b = bh >> 3, h = bh & 7; const size_t row0 = (size_t)b * SEQ;
        const bf16* Kg = KC + row0 * 768 + h * 96; const bf16* Vg = VC + row0 * 512 + h * 64;
        for (int uu = 0; uu < 2; ++uu) {
            const int qb = uu == 0 ? 31 - sidx : sidx, q0 = qb * 256, NT = (q0 + 256) / 128;
            const int qw = q0 + wave * 32;
            bf16x8 qf[6];
            { const bf16* qp = Q + (row0 + qw + r) * 768 + h * 96 + hi * 8;
#pragma unroll
              for (int s = 0; s < 6; ++s) qf[s] = *(const bf16x8*)(qp + 16 * s); }
            f32x16 o0 = {}, o1 = {}, negm = {}; float m = 0.f, l = 0.f;
            u32x4 ak[3], av[2];
#pragma unroll
            for (int i = 0; i < 3; ++i) ak[i] = *(const u32x4*)(Kg + kg[i]);
#pragma unroll
            for (int i = 0; i < 2; ++i) av[i] = *(const u32x4*)(Vg + vg[i]);
            asm volatile("" : "+v"(qf[0]), "+v"(qf[1]), "+v"(qf[2]), "+v"(qf[3]), "+v"(qf[4]), "+v"(qf[5]));
            LDS_BAR();
#pragma unroll
            for (int i = 0; i < 3; ++i) *(LAS u32x4*)(lds + kl[i]) = ak[i];
#pragma unroll
            for (int i = 0; i < 2; ++i) *(LAS u32x4*)(lds + vl[i]) = av[i];
            LDS_BAR();
            for (int t = 0; t < NT; ++t) {
                LAS unsigned char* bb = lds + (t & 1) * BUF;
                { const int tn = (t + 1 < NT) ? t + 1 : t;
                  const bf16* kgp = Kg + (size_t)tn * 128 * 768; const bf16* vgp = Vg + (size_t)tn * 128 * 512;
#pragma unroll
                  for (int i = 0; i < 3; ++i) ak[i] = *(const u32x4*)(kgp + kg[i]);
#pragma unroll
                  for (int i = 0; i < 2; ++i) av[i] = *(const u32x4*)(vgp + vg[i]); }
#pragma unroll
                for (int sub = 0; sub < 2; ++sub) {
                    const int tt = 2 * t + sub;
                    if (64 * tt <= qw + 31) {
                        LAS unsigned char* kb = bb + sub * SUB; LAS unsigned char* vb = kb + KBYTES;
                        bf16x8 kf0[6], kf1[6];
#pragma unroll
                        for (int s = 0; s < 6; ++s) { kf0[s] = *(const LAS bf16x8*)(kb + kfr + s * 32); kf1[s] = *(const LAS bf16x8*)(kb + kfr + 32 * KST + s * 32); }
                        __builtin_amdgcn_sched_barrier(0);
                        f32x16 p0 = negm, p1 = negm;
#pragma unroll
                        for (int s = 0; s < 6; ++s) { p0 = __builtin_amdgcn_mfma_f32_32x32x16_bf16(kf0[s], qf[s], p0, 0, 0, 0); p1 = __builtin_amdgcn_mfma_f32_32x32x16_bf16(kf1[s], qf[s], p1, 0, 0, 0); }
                        if (64 * tt + 63 > qw) {
                            const int qrel = qw + r - 64 * tt;
#pragma unroll
                            for (int rg = 0; rg < 16; ++rg) { const int kv = crow(rg, hi); if (kv > qrel) p0[rg] = -INFINITY; if (kv + 32 > qrel) p1[rg] = -INFINITY; }
                        }
                        float mx;
                        { float a = max3f(p0[0], p0[1], p1[0]), b2 = max3f(p0[2], p0[3], p1[1]); a = max3f(a, p1[2], p1[3]);
#pragma unroll
                          for (int rg = 4; rg < 16; rg += 4) { a = max3f(a, p0[rg], p0[rg + 1]); b2 = max3f(b2, p0[rg + 2], p0[rg + 3]); a = max3f(a, p1[rg], p1[rg + 1]); b2 = max3f(b2, p1[rg + 2], p1[rg + 3]); }
                          mx = xhalf_max(max2f(a, b2)); }
                        if (!__all(mx <= 8.0f)) {
                            const float dl = max2f(mx, 0.f), f = __builtin_amdgcn_exp2f(-dl); m += dl; l *= f;
#pragma unroll
                            for (int rg = 0; rg < 16; ++rg) { p0[rg] -= dl; p1[rg] -= dl; o0[rg] *= f; o1[rg] *= f; negm[rg] = -m; }
                        }
                        float rs = 0.f;
#pragma unroll
                        for (int rg = 0; rg < 16; ++rg) { p0[rg] = __builtin_amdgcn_exp2f(p0[rg]); p1[rg] = __builtin_amdgcn_exp2f(p1[rg]); rs += p0[rg] + p1[rg]; }
                        l += rs;
#pragma unroll
                        for (int hh = 0; hh < 2; ++hh)
#pragma unroll
                            for (int s2 = 0; s2 < 2; ++s2) { const bf16x8 pf = packp(hh == 0 ? p0 : p1, s2);
#pragma unroll
                                for (int db = 0; db < 2; ++db) { LAS unsigned char* vp_ = vb + vtr + (32 * hh + 16 * s2) * VST + db * 64;
                                    const s16x4 lo = __builtin_bit_cast(s16x4, __builtin_amdgcn_ds_read_tr16_b64_v4i16((LAS s16x4*)vp_));
                                    const s16x4 hi4 = __builtin_bit_cast(s16x4, __builtin_amdgcn_ds_read_tr16_b64_v4i16((LAS s16x4*)(vp_ + 8 * VST)));
                                    const bf16x8 vf = (bf16x8){lo[0], lo[1], lo[2], lo[3], hi4[0], hi4[1], hi4[2], hi4[3]};
                                    if (db == 0) o0 = __builtin_amdgcn_mfma_f32_32x32x16_bf16(vf, pf, o0, 0, 0, 0); else o1 = __builtin_amdgcn_mfma_f32_32x32x16_bf16(vf, pf, o1, 0, 0, 0); } }
                    }
                }
                { LAS unsigned char* nb = lds + ((t + 1) & 1) * BUF;
#pragma unroll
                  for (int i = 0; i < 3; ++i) *(LAS u32x4*)(nb + kl[i]) = ak[i];
#pragma unroll
                  for (int i = 0; i < 2; ++i) *(LAS u32x4*)(nb + vl[i]) = av[i]; }
                LDS_BAR();
            }
            const float il = 1.0f / xhalf_sum(l);
            bf16* op = YM + (row0 + qw + r) * YYLD + h * 64 + 4 * hi;
#pragma unroll
            for (int gq = 0; gq < 4; ++gq) { u32x2 w0, w1;
                w0.x = pk2(o0[4 * gq] * il, o0[4 * gq + 1] * il); w0.y = pk2(o0[4 * gq + 2] * il, o0[4 * gq + 3] * il);
                w1.x = pk2(o1[4 * gq] * il, o1[4 * gq + 1] * il); w1.y = pk2(o1[4 * gq + 2] * il, o1[4 * gq + 3] * il);
                *(u32x2*)(op + 8 * gq) = w0; *(u32x2*)(op + 32 + 8 * gq) = w1; }
        }
    }
    __syncthreads();
}

constexpr int CS_CH = 256, CS_NCH = SEQ / CS_CH;
constexpr int CS_RS = 144;
constexpr int CS_IMG = 16 * CS_RS;
constexpr int CS_WAVE = 8 * CS_IMG + 512;
enum { IM_A = 0, IM_R = 1, IM_B = 2, IM_K = 3, IM_BH = 4, IM_KH = 5, IM_V = 6, IM_G = 7 };
constexpr size_t DO_CSP = 64 * MiB, DO_CSG = 128 * MiB, DO_CSZ = 192 * MiB;
__device__ __forceinline__ int crow8(int q, int hi) { return (q & 3) + 8 * ((q >> 2) & 1) + 4 * hi; }
template <int N> __device__ __forceinline__ float dpp_shr0(float x) { return __builtin_bit_cast(float, __builtin_amdgcn_update_dpp(0, __builtin_bit_cast(int, x), 0x110 + N, 0xf, 0xf, true)); }
__device__ __forceinline__ float rowscan16(float x) { x += dpp_shr0<1>(x); x += dpp_shr0<2>(x); x += dpp_shr0<4>(x); x += dpp_shr0<8>(x); return x; }
__device__ __forceinline__ float xsum_16_32(float v) {
    { auto r = __builtin_amdgcn_permlane16_swap(__float_as_uint(v), __float_as_uint(v), false, false); v = __uint_as_float(r[0]) + __uint_as_float(r[1]); }
    { auto r = __builtin_amdgcn_permlane32_swap(__float_as_uint(v), __float_as_uint(v), false, false); v = __uint_as_float(r[0]) + __uint_as_float(r[1]); }
    return v;
}
__device__ __forceinline__ bf16x8 cs_rowfrag(const LAS unsigned char* rowp, int hi, int ks) {
    const LAS unsigned char* p = rowp + (16 * ks + 4 * hi) * 2; const u32x2 a = *(const LAS u32x2*)p, b = *(const LAS u32x2*)(p + 16);
    return __builtin_bit_cast(bf16x8, (u32x4){a.x, a.y, b.x, b.y});
}
__device__ __forceinline__ bf16x8 cs_trfrag(LAS unsigned char* img, int cb, int lane) {
    const int g4 = lane >> 4, li = lane & 15; LAS unsigned char* p = img + (4 * (g4 >> 1) + (li >> 2)) * CS_RS + (32 * cb + 16 * (g4 & 1) + 4 * (li & 3)) * 2;
    const s16x4 lo = __builtin_bit_cast(s16x4, __builtin_amdgcn_ds_read_tr16_b64_v4i16((LAS s16x4*)p));
    const s16x4 h4 = __builtin_bit_cast(s16x4, __builtin_amdgcn_ds_read_tr16_b64_v4i16((LAS s16x4*)(p + 8 * CS_RS)));
    return (bf16x8){lo[0], lo[1], lo[2], lo[3], h4[0], h4[1], h4[2], h4[3]};
}
__device__ __forceinline__ bf16x8 cs_zero8() { return (bf16x8){0, 0, 0, 0, 0, 0, 0, 0}; }
struct CsIn { const bf16 *ZR, *A, *LW, *G; const float *mu, *k_k, *k_a, *r_k; };
template <bool USE_V, bool WITH_Y>
__device__ __forceinline__ void cs_prep(const CsIn& in, size_t row0, int tok0, int h, LAS unsigned char* wl, int lane) {
    const int t = lane & 15, jq = lane >> 4, tok = tok0 + t; const bool first = tok == 0;
    const size_t g = row0 + tok, gp = row0 + (first ? 0 : tok - 1); const int c0 = h * 64 + 16 * jq;
    LAS float* gct = (LAS float*)(wl + 8 * CS_IMG); LAS float* btt = gct + 64;
    u32x4 Lrc[2], Lrp[2], Lkc[2], Lkp[2], Lav[2], Llw[2], Lvc[2], Lvp[2];
#pragma unroll
    for (int hf = 0; hf < 2; ++hf) { const int cc = c0 + 8 * hf;
        Lkc[hf] = *(const u32x4*)(in.ZR + g * 1792 + 512 + cc); Lkp[hf] = *(const u32x4*)(in.ZR + gp * 1792 + 512 + cc);
        Lrc[hf] = *(const u32x4*)(in.ZR + g * 1792 + cc); Lrp[hf] = *(const u32x4*)(in.ZR + gp * 1792 + cc);
        Lav[hf] = *(const u32x4*)(in.A + g * 512 + cc); Llw[hf] = *(const u32x4*)(in.LW + g * 512 + cc);
        if (USE_V) { Lvc[hf] = *(const u32x4*)(in.ZR + g * 1792 + 1024 + cc); Lvp[hf] = *(const u32x4*)(in.ZR + gp * 1792 + 1024 + cc); }
    }
    float inv;
    { float ss = 0.f;
#pragma unroll
      for (int hf = 0; hf < 2; ++hf) { float kc[8], kp[8]; unpack8(Lkc[hf], kc); unpack8(Lkp[hf], kp);
          const f32x4 m0 = *(const f32x4*)(in.mu + 512 + c0 + 8 * hf), m1 = *(const f32x4*)(in.mu + 512 + c0 + 8 * hf + 4), q0 = *(const f32x4*)(in.k_k + c0 + 8 * hf), q1 = *(const f32x4*)(in.k_k + c0 + 8 * hf + 4);
          const float mm[8] = {m0.x, m0.y, m0.z, m0.w, m1.x, m1.y, m1.z, m1.w}, qq[8] = {q0.x, q0.y, q0.z, q0.w, q1.x, q1.y, q1.z, q1.w};
#pragma unroll
          for (int e = 0; e < 8; ++e) { const float zk = kc[e] + ((first ? 0.f : kp[e]) - kc[e]) * mm[e]; const float kr = zk * qq[e]; ss += kr * kr; } }
      inv = 1.0f / fmaxf(sqrtf(xsum_16_32(ss)), 1e-12f); }
    float btacc = 0.f;
#pragma unroll
    for (int hf = 0; hf < 2; ++hf) {
        const int cc = c0 + 8 * hf;
        u32x4 Lgg = {}; if (WITH_Y) Lgg = *(const u32x4*)(in.G + g * 512 + cc);
        float rc[8], rp[8], kc[8], kp[8], av[8], lw[8];
        unpack8(Lrc[hf], rc); unpack8(Lrp[hf], rp); unpack8(Lkc[hf], kc); unpack8(Lkp[hf], kp); unpack8(Lav[hf], av); unpack8(Llw[hf], lw);
        float mr[8], mk[8], qk[8], qa[8], qr[8];
        { const f32x4 a0 = *(const f32x4*)(in.mu + cc), a1 = *(const f32x4*)(in.mu + cc + 4), b0 = *(const f32x4*)(in.mu + 512 + cc), b1 = *(const f32x4*)(in.mu + 512 + cc + 4);
          const f32x4 c0_ = *(const f32x4*)(in.k_k + cc), c1_ = *(const f32x4*)(in.k_k + cc + 4), d0 = *(const f32x4*)(in.k_a + cc), d1 = *(const f32x4*)(in.k_a + cc + 4);
          mr[0] = a0.x; mr[1] = a0.y; mr[2] = a0.z; mr[3] = a0.w; mr[4] = a1.x; mr[5] = a1.y; mr[6] = a1.z; mr[7] = a1.w;
          mk[0] = b0.x; mk[1] = b0.y; mk[2] = b0.z; mk[3] = b0.w; mk[4] = b1.x; mk[5] = b1.y; mk[6] = b1.z; mk[7] = b1.w;
          qk[0] = c0_.x; qk[1] = c0_.y; qk[2] = c0_.z; qk[3] = c0_.w; qk[4] = c1_.x; qk[5] = c1_.y; qk[6] = c1_.z; qk[7] = c1_.w;
          qa[0] = d0.x; qa[1] = d0.y; qa[2] = d0.z; qa[3] = d0.w; qa[4] = d1.x; qa[5] = d1.y; qa[6] = d1.z; qa[7] = d1.w; }
        if (WITH_Y) { const f32x4 e0 = *(const f32x4*)(in.r_k + cc), e1 = *(const f32x4*)(in.r_k + cc + 4); qr[0] = e0.x; qr[1] = e0.y; qr[2] = e0.z; qr[3] = e0.w; qr[4] = e1.x; qr[5] = e1.y; qr[6] = e1.z; qr[7] = e1.w; }
        float oA[8], oR[8], oB[8], oK[8], oBH[8], oKH[8];
#pragma unroll
        for (int e = 0; e < 8; ++e) {
            const float r = rc[e] + ((first ? 0.f : rp[e]) - rc[e]) * mr[e]; const float zk = kc[e] + ((first ? 0.f : kp[e]) - kc[e]) * mk[e];
            const float kq = zk * (1.f + (av[e] - 1.f) * qa[e]); const float kk = zk * qk[e] * inv; const float b = kk * av[e];
            const float Lg = rowscan16(lw[e]); const float eLg = __builtin_amdgcn_exp2f(1.4426950408889634f * Lg); const float enLg = __builtin_amdgcn_rcpf(eLg);
            const float eLgm = __builtin_bit_cast(float, __builtin_amdgcn_update_dpp(0x3f800000, __builtin_bit_cast(int, eLg), 0x111, 0xf, 0xf, false));
            const float eC = __builtin_bit_cast(float, __builtin_amdgcn_ds_bpermute(((lane & 48) | 15) << 2, __builtin_bit_cast(int, eLg)));
            oA[e] = -kk * eLgm; oR[e] = r * eLg; oB[e] = b * enLg; oK[e] = kq * enLg; oBH[e] = oB[e] * eC; oKH[e] = oK[e] * eC;
            if (WITH_Y) btacc += r * kq * qr[e];
            if (t == 15) gct[16 * jq + 8 * hf + e] = eC;
        }
        const int wo = t * CS_RS + (16 * jq + 8 * hf) * 2;
        *(LAS u32x4*)(wl + IM_A * CS_IMG + wo) = pack8(oA); *(LAS u32x4*)(wl + IM_R * CS_IMG + wo) = pack8(oR); *(LAS u32x4*)(wl + IM_B * CS_IMG + wo) = pack8(oB);
        *(LAS u32x4*)(wl + IM_K * CS_IMG + wo) = pack8(oK); *(LAS u32x4*)(wl + IM_BH * CS_IMG + wo) = pack8(oBH); *(LAS u32x4*)(wl + IM_KH * CS_IMG + wo) = pack8(oKH);
        if (USE_V) { float vc[8], vp[8], o[8]; unpack8(Lvc[hf], vc); unpack8(Lvp[hf], vp);
            const f32x4 a0 = *(const f32x4*)(in.mu + 1024 + cc), a1 = *(const f32x4*)(in.mu + 1024 + cc + 4); const float mv[8] = {a0.x, a0.y, a0.z, a0.w, a1.x, a1.y, a1.z, a1.w};
#pragma unroll
            for (int e = 0; e < 8; ++e) o[e] = vc[e] + ((first ? 0.f : vp[e]) - vc[e]) * mv[e];
            *(LAS u32x4*)(wl + IM_V * CS_IMG + wo) = pack8(o); }
        if (WITH_Y) *(LAS u32x4*)(wl + IM_G * CS_IMG + wo) = Lgg;
    }
    if (WITH_Y) { btacc = xsum_16_32(btacc); if (lane < 16) btt[lane] = btacc; }
}
struct CsFr { bf16x8 fAR[4], aL1, aL2, aL4, aL8, aLkMk, aMb; };
__device__ __forceinline__ void cs_gram(CsFr& fr, LAS unsigned char* wl, int lane) {
    const int hi = lane >> 5, row = lane & 15; const bool up = (lane & 16) != 0;
    const LAS unsigned char* rpAR = wl + (up ? IM_R : IM_A) * CS_IMG + row * CS_RS; const LAS unsigned char* rpBK = wl + (up ? IM_K : IM_B) * CS_IMG + row * CS_RS;
#pragma unroll
    for (int ks = 0; ks < 4; ++ks) fr.fAR[ks] = cs_rowfrag(rpAR, hi, ks);
    f32x16 F1 = {}, F2 = {};
#pragma unroll
    for (int ks = 0; ks < 4; ++ks) { const bf16x8 fBK = cs_rowfrag(rpBK, hi, ks);
        F1 = __builtin_amdgcn_mfma_f32_32x32x16_bf16(fBK, fr.fAR[ks], F1, 0, 0, 0);
        F2 = __builtin_amdgcn_mfma_f32_32x32x16_bf16(fr.fAR[ks], fBK, F2, 0, 0, 0); }
#pragma unroll
    for (int q = 0; q < 8; ++q) { const int s = crow8(q, hi); const bool k1 = up ? (s <= row) : (s < row);
        F1[q] = k1 ? F1[q] : 0.f; F1[8 + q] = k1 ? F1[8 + q] : 0.f; F2[q] = (!up && row < s) ? F2[q] : 0.f; }
    const bf16x8 f1lo = packp(F1, 0);
    fr.aL1 = up ? cs_zero8() : f1lo;
    fr.aMb = up ? f1lo : cs_zero8();
    fr.aLkMk = packp(F1, 1);
    const bf16x8 p2 = packp(F2, 0);
    const f32x16 z16 = {};
    const f32x16 Q1 = __builtin_amdgcn_mfma_f32_32x32x16_bf16(p2, fr.aL1, z16, 0, 0, 0), Q2 = __builtin_amdgcn_mfma_f32_32x32x16_bf16(fr.aL1, p2, z16, 0, 0, 0);
    fr.aL2 = packp(Q1, 0); const bf16x8 p2b = packp(Q2, 0);
    const f32x16 R1 = __builtin_amdgcn_mfma_f32_32x32x16_bf16(p2b, fr.aL2, z16, 0, 0, 0), R2 = __builtin_amdgcn_mfma_f32_32x32x16_bf16(fr.aL2, p2b, z16, 0, 0, 0);
    fr.aL4 = packp(R1, 0); const bf16x8 p2c = packp(R2, 0);
    const f32x16 S1 = __builtin_amdgcn_mfma_f32_32x32x16_bf16(p2c, fr.aL4, z16, 0, 0, 0);
    fr.aL8 = packp(S1, 0);
}
template <bool USE_V, bool WITH_Y>
__device__ __forceinline__ void cs_apply(f32x16 (&Z)[2][2], f32x16 (&D)[2], const CsFr& fr, LAS unsigned char* wl, int lane) {
    const int hi = lane >> 5;
    bf16x8 vf[2];
    if (USE_V) { vf[0] = cs_trfrag(wl + IM_V * CS_IMG, 0, lane); vf[1] = cs_trfrag(wl + IM_V * CS_IMG, 1, lane); }
#pragma unroll
    for (int nb = 0; nb < 2; ++nb) { f32x16 d = {};
#pragma unroll
        for (int jb = 0; jb < 2; ++jb)
#pragma unroll
            for (int k2 = 0; k2 < 2; ++k2) d = __builtin_amdgcn_mfma_f32_32x32x16_bf16(fr.fAR[2 * jb + k2], packp(Z[jb][nb], k2), d, 0, 0, 0);
        if (USE_V) d = __builtin_amdgcn_mfma_f32_32x32x16_bf16(fr.aLkMk, vf[nb], d, 0, 0, 0);
        D[nb] = d; }
#pragma unroll
    for (int nb = 0; nb < 2; ++nb) {
        D[nb] = __builtin_amdgcn_mfma_f32_32x32x16_bf16(fr.aL8, packp(D[nb], 0), D[nb], 0, 0, 0);
        D[nb] = __builtin_amdgcn_mfma_f32_32x32x16_bf16(fr.aL4, packp(D[nb], 0), D[nb], 0, 0, 0);
        D[nb] = __builtin_amdgcn_mfma_f32_32x32x16_bf16(fr.aL2, packp(D[nb], 0), D[nb], 0, 0, 0);
        D[nb] = __builtin_amdgcn_mfma_f32_32x32x16_bf16(fr.aL1, packp(D[nb], 0), D[nb], 0, 0, 0);
    }
    const bf16x8 u0 = packp(D[0], 0), u1 = packp(D[1], 0);
    if (WITH_Y) { D[0] = __builtin_amdgcn_mfma_f32_32x32x16_bf16(fr.aMb, u0, D[0], 0, 0, 0); D[1] = __builtin_amdgcn_mfma_f32_32x32x16_bf16(fr.aMb, u1, D[1], 0, 0, 0); }
    const LAS float* gct = (const LAS float*)(wl + 8 * CS_IMG);
#pragma unroll
    for (int jb = 0; jb < 2; ++jb) {
        const bf16x8 fb = cs_trfrag(wl + IM_BH * CS_IMG, jb, lane); bf16x8 fk = cs_zero8(); if (USE_V) fk = cs_trfrag(wl + IM_KH * CS_IMG, jb, lane);
        float gc[16];
#pragma unroll
        for (int g4 = 0; g4 < 4; ++g4) { const f32x4 x = *(const LAS f32x4*)(gct + 32 * jb + 8 * g4 + 4 * hi); gc[4 * g4] = x.x; gc[4 * g4 + 1] = x.y; gc[4 * g4 + 2] = x.z; gc[4 * g4 + 3] = x.w; }
#pragma unroll
        for (int nb = 0; nb < 2; ++nb) { f32x16 z = Z[jb][nb];
#pragma unroll
            for (int q = 0; q < 16; ++q) z[q] *= gc[q];
            z = __builtin_amdgcn_mfma_f32_32x32x16_bf16(fb, nb == 0 ? u0 : u1, z, 0, 0, 0);
            if (USE_V) z = __builtin_amdgcn_mfma_f32_32x32x16_bf16(fk, vf[nb], z, 0, 0, 0);
            Z[jb][nb] = z; }
    }
}
__device__ __forceinline__ void cs_apply_pk(bf16x8 (&Zp)[2][2][2], f32x16 (&D)[2], const CsFr& fr, LAS unsigned char* wl, int lane) {
    const int hi = lane >> 5;
#pragma unroll
    for (int nb = 0; nb < 2; ++nb) { f32x16 d = {};
#pragma unroll
        for (int jb = 0; jb < 2; ++jb)
#pragma unroll
            for (int k2 = 0; k2 < 2; ++k2) d = __builtin_amdgcn_mfma_f32_32x32x16_bf16(fr.fAR[2 * jb + k2], Zp[jb][nb][k2], d, 0, 0, 0);
        D[nb] = d; }
#pragma unroll
    for (int nb = 0; nb < 2; ++nb) {
        D[nb] = __builtin_amdgcn_mfma_f32_32x32x16_bf16(fr.aL8, packp(D[nb], 0), D[nb], 0, 0, 0);
        D[nb] = __builtin_amdgcn_mfma_f32_32x32x16_bf16(fr.aL4, packp(D[nb], 0), D[nb], 0, 0, 0);
        D[nb] = __builtin_amdgcn_mfma_f32_32x32x16_bf16(fr.aL2, packp(D[nb], 0), D[nb], 0, 0, 0);
        D[nb] = __builtin_amdgcn_mfma_f32_32x32x16_bf16(fr.aL1, packp(D[nb], 0), D[nb], 0, 0, 0);
    }
    const bf16x8 u0 = packp(D[0], 0), u1 = packp(D[1], 0);
    const LAS float* gct = (const LAS float*)(wl + 8 * CS_IMG);
#pragma unroll
    for (int jb = 0; jb < 2; ++jb) {
        const bf16x8 fb = cs_trfrag(wl + IM_BH * CS_IMG, jb, lane);
        float gc[16];
#pragma unroll
        for (int g4 = 0; g4 < 4; ++g4) { const f32x4 x = *(const LAS f32x4*)(gct + 32 * jb + 8 * g4 + 4 * hi); gc[4 * g4] = x.x; gc[4 * g4 + 1] = x.y; gc[4 * g4 + 2] = x.z; gc[4 * g4 + 3] = x.w; }
#pragma unroll
        for (int nb = 0; nb < 2; ++nb) { f32x16 z;
#pragma unroll
            for (int k2 = 0; k2 < 2; ++k2) { float e[8]; unpack8(__builtin_bit_cast(u32x4, Zp[jb][nb][k2]), e);
#pragma unroll
                for (int q = 0; q < 8; ++q) z[8 * k2 + q] = e[q] * gc[8 * k2 + q]; }
            z = __builtin_amdgcn_mfma_f32_32x32x16_bf16(fb, nb == 0 ? u0 : u1, z, 0, 0, 0);
            Zp[jb][nb][0] = packp(z, 0); Zp[jb][nb][1] = packp(z, 1); }
    }
}
template <bool USE_V, bool WITH_Y>
__device__ __forceinline__ void cs_step(f32x16 (&Z)[2][2], f32x16 (&D)[2], LAS unsigned char* wl, int lane) { CsFr fr; cs_gram(fr, wl, lane); cs_apply<USE_V, WITH_Y>(Z, D, fr, wl, lane); }
__device__ __forceinline__ void p_cs_a(const Frame& F, ArgsP a) {
    const int lane = lane_id_fresh();
    LAS unsigned char* wl = F.lds + F.wave * CS_WAVE;
    CsIn in{(const bf16*)(F.ws + WS_ZR), (const bf16*)(F.ws + WS_A), (const bf16*)(F.ws + WS_LW), (const bf16*)(F.dob + DO_G), a->in[I_MU], a->in[I_KK], a->in[I_KA], a->in[I_RK]};
    bf16* Pm = (bf16*)(F.dob + DO_CSP); bf16* Gf = (bf16*)(F.dob + DO_CSG);
    const int hi = lane >> 5;
    for (int uc = F.gw; uc < 64 * CS_NCH; uc += F.NGW) {
        const int bh = uc / CS_NCH, c = uc % CS_NCH, b = bh >> 3, h = bh & 7; const size_t row0 = (size_t)b * SEQ;
        f32x16 ZG[2][2], D[2]; bf16x8 ZP[2][2][2];
#pragma unroll
        for (int jb = 0; jb < 2; ++jb)
#pragma unroll
            for (int nb = 0; nb < 2; ++nb) { f32x16 z = {}; ZG[jb][nb] = z;
                if (jb == nb) {
#pragma unroll
                    for (int q = 0; q < 16; ++q) z[q] = (crow(q, hi) == (lane & 31)) ? 1.f : 0.f; }
                ZP[jb][nb][0] = packp(z, 0); ZP[jb][nb][1] = packp(z, 1); }
        for (int sc = 0; sc < CS_CH / 16; ++sc) { int ln = lane; asm volatile("" : "+v"(ln));
            cs_prep<true, false>(in, row0, c * CS_CH + sc * 16, h, wl, ln); asm volatile("s_waitcnt lgkmcnt(0)" ::: "memory");
            CsFr fr; cs_gram(fr, wl, ln);
            cs_apply_pk(ZP, D, fr, wl, ln); cs_apply<true, false>(ZG, D, fr, wl, ln); asm volatile("s_waitcnt lgkmcnt(0)" ::: "memory"); }
        int lo_ = lane; asm volatile("" : "+v"(lo_)); const int hi_o = lo_ >> 5;
        {
            LAS unsigned short* tb = (LAS unsigned short*)(wl + 4 * hi_o * CS_RS + (lo_ & 31) * 2);
#pragma unroll
            for (int jb = 0; jb < 2; ++jb)
#pragma unroll
                for (int nb = 0; nb < 2; ++nb)
#pragma unroll
                    for (int q = 0; q < 16; ++q) tb[((32 * jb + (q & 3) + 8 * (q >> 2)) * CS_RS + 64 * nb) / 2] = (unsigned short)ZP[jb][nb][q >> 3][q & 7];
            bf16* dst = Pm + (size_t)uc * 4096;
#pragma unroll
            for (int i = 0; i < 8; ++i) { const int ch = lo_ + 64 * i, rr = ch >> 3, c8 = (ch & 7) * 8; *(u32x4*)(dst + rr * 64 + c8) = *(const LAS u32x4*)(wl + rr * CS_RS + c8 * 2); }
            asm volatile("s_waitcnt lgkmcnt(0)" ::: "memory");
        }
        {
            bf16* dst = Gf + (size_t)uc * 4096;
#pragma unroll
            for (int jb = 0; jb < 2; ++jb)
#pragma unroll
                for (int nb = 0; nb < 2; ++nb) { u32x4 w0, w1; const f32x16& z = ZG[jb][nb];
                    w0.x = pk2(z[0], z[1]); w0.y = pk2(z[2], z[3]); w0.z = pk2(z[4], z[5]); w0.w = pk2(z[6], z[7]); w1.x = pk2(z[8], z[9]); w1.y = pk2(z[10], z[11]); w1.z = pk2(z[12], z[13]); w1.w = pk2(z[14], z[15]);
                    u32x4* p = (u32x4*)(dst + ((jb * 2 + nb) * 64 + lo_) * 16); p[0] = w0; p[1] = w1; }
        }
    }
}
struct CsB { u32x2 p[2][2][2][2]; u32x4 g[2][2]; };
__device__ __forceinline__ void csb_load(CsB& X, const bf16* Pm, const bf16* Gf, size_t uc, int nb, int lane) {
    const int hi = lane >> 5, r = lane & 31; const bf16* Pc = Pm + uc * 4096;
#pragma unroll
    for (int mb = 0; mb < 2; ++mb) {
#pragma unroll
        for (int jb = 0; jb < 2; ++jb)
#pragma unroll
            for (int k2 = 0; k2 < 2; ++k2) { const bf16* pr = Pc + (32 * mb + r) * 64 + 32 * jb + 16 * k2 + 4 * hi; X.p[mb][jb][k2][0] = *(const u32x2*)pr; X.p[mb][jb][k2][1] = *(const u32x2*)(pr + 8); }
        const u32x4* gp = (const u32x4*)(Gf + uc * 4096 + ((mb * 2 + nb) * 64 + lane) * 16); X.g[mb][0] = gp[0]; X.g[mb][1] = gp[1]; }
}
__device__ __forceinline__ void csb_step(f32x16 (&Z)[2], const CsB& X, bf16* Zf, size_t uc, int nb, int lane) {
#pragma unroll
    for (int jb = 0; jb < 2; ++jb) { u32x4 w0, w1; const f32x16& z = Z[jb];
        w0.x = pk2(z[0], z[1]); w0.y = pk2(z[2], z[3]); w0.z = pk2(z[4], z[5]); w0.w = pk2(z[6], z[7]); w1.x = pk2(z[8], z[9]); w1.y = pk2(z[10], z[11]); w1.z = pk2(z[12], z[13]); w1.w = pk2(z[14], z[15]);
        u32x4* p = (u32x4*)(Zf + uc * 4096 + ((jb * 2 + nb) * 64 + lane) * 16); p[0] = w0; p[1] = w1; }
    f32x16 N[2];
#pragma unroll
    for (int mb = 0; mb < 2; ++mb) { float g0[8], g1[8]; unpack8(X.g[mb][0], g0); unpack8(X.g[mb][1], g1);
#pragma unroll
        for (int q = 0; q < 8; ++q) { N[mb][q] = g0[q]; N[mb][8 + q] = g1[q]; } }
#pragma unroll
    for (int jb = 0; jb < 2; ++jb)
#pragma unroll
        for (int k2 = 0; k2 < 2; ++k2) { const bf16x8 zb = packp(Z[jb], k2);
#pragma unroll
            for (int mb = 0; mb < 2; ++mb) { const u32x2 x0 = X.p[mb][jb][k2][0], x1 = X.p[mb][jb][k2][1];
                N[mb] = __builtin_amdgcn_mfma_f32_32x32x16_bf16(__builtin_bit_cast(bf16x8, (u32x4){x0.x, x0.y, x1.x, x1.y}), zb, N[mb], 0, 0, 0); } }
    Z[0] = N[0]; Z[1] = N[1];
}
__device__ __forceinline__ void p_cs_b(const Frame& F) {
    const int lane = lane_id_fresh();
    const bf16* Pm = (const bf16*)(F.dob + DO_CSP); const bf16* Gf = (const bf16*)(F.dob + DO_CSG); bf16* Zf = (bf16*)(F.dob + DO_CSZ);
    for (int u16 = F.gw; u16 < 128 * 16; u16 += F.NGW) {
        if (u16 & 15) continue;
        const int u = u16 >> 4, bh = u >> 1, nb = u & 1; const size_t uc0 = (size_t)bh * CS_NCH;
        f32x16 Z[2] = {};
        CsB X0, X1;
        csb_load(X0, Pm, Gf, uc0, nb, lane);
        for (int c = 0; c < CS_NCH; c += 2) {
            csb_load(X1, Pm, Gf, uc0 + c + 1, nb, lane);
            csb_step(Z, X0, Zf, uc0 + c, nb, lane);
            csb_load(X0, Pm, Gf, uc0 + (c + 2 < CS_NCH ? c + 2 : CS_NCH - 1), nb, lane);
            csb_step(Z, X1, Zf, uc0 + c + 1, nb, lane);
        }
    }
}
__device__ __forceinline__ void p_cs_c(const Frame& F, ArgsP a) {
    const int lane = lane_id_fresh(), hi = lane >> 5;
    LAS unsigned char* wl = F.lds + F.wave * CS_WAVE;
    CsIn in{(const bf16*)(F.ws + WS_ZR), (const bf16*)(F.ws + WS_A), (const bf16*)(F.ws + WS_LW), (const bf16*)(F.dob + DO_G), a->in[I_MU], a->in[I_KK], a->in[I_KA], a->in[I_RK]};
    const bf16* Zf = (const bf16*)(F.dob + DO_CSZ); bf16* Y = (bf16*)(F.ws + WS_Y); const float* lnw = a->in[I_LNW]; const float* lnb = a->in[I_LNB];
    const LAS float* btt = (const LAS float*)(wl + 8 * CS_IMG) + 64;
    for (int uc = F.gw; uc < 64 * CS_NCH; uc += F.NGW) {
        const int bh = uc / CS_NCH, c = uc % CS_NCH, b = bh >> 3, h = bh & 7; const size_t row0 = (size_t)b * SEQ;
        f32x16 Z[2][2], D[2];
        int lu = lane; asm volatile("" : "+v"(lu));
#pragma unroll
        for (int jb = 0; jb < 2; ++jb)
#pragma unroll
            for (int nb = 0; nb < 2; ++nb) { const u32x4* p = (const u32x4*)(Zf + (size_t)uc * 4096 + ((jb * 2 + nb) * 64 + lu) * 16); float g0[8], g1[8]; unpack8(p[0], g0); unpack8(p[1], g1);
#pragma unroll
                for (int q = 0; q < 8; ++q) { Z[jb][nb][q] = g0[q]; Z[jb][nb][8 + q] = g1[q]; } }
        const float lw0 = lnw[h * 64 + (lu & 31)], lw1 = lnw[h * 64 + 32 + (lu & 31)], lb0 = lnb[h * 64 + (lu & 31)], lb1 = lnb[h * 64 + 32 + (lu & 31)];
        for (int sc = 0; sc < CS_CH / 16; ++sc) {
            const int tok0 = c * CS_CH + sc * 16;
            int ln = lane; asm volatile("" : "+v"(ln));
            cs_prep<true, true>(in, row0, tok0, h, wl, ln); asm volatile("s_waitcnt lgkmcnt(0)" ::: "memory");
            cs_step<true, true>(Z, D, wl, ln); asm volatile("s_waitcnt lgkmcnt(0)" ::: "memory");
            const int hl = ln >> 5;
            const bf16x8 v0 = cs_trfrag(wl + IM_V * CS_IMG, 0, ln), v1 = cs_trfrag(wl + IM_V * CS_IMG, 1, ln), g0 = cs_trfrag(wl + IM_G * CS_IMG, 0, ln), g1 = cs_trfrag(wl + IM_G * CS_IMG, 1, ln);
            const f32x4 bta = *(const LAS f32x4*)(btt + 4 * hl), btb = *(const LAS f32x4*)(btt + 8 + 4 * hl); const float bt[8] = {bta.x, bta.y, bta.z, bta.w, btb.x, btb.y, btb.z, btb.w};
#pragma unroll
            for (int q = 0; q < 8; ++q) {
                const float y0 = D[0][8 + q], y1 = D[1][8 + q];
                const float mean = allsum32(y0 + y1) * (1.f / 64.f); const float d0 = y0 - mean, d1 = y1 - mean;
                const float rstd = 1.0f / sqrtf(allsum32(d0 * d0 + d1 * d1) * (1.f / 64.f) + LN_X_EPS);
                const float o0 = (d0 * rstd * lw0 + lb0 + bt[q] * bf2f((unsigned short)v0[q])) * bf2f((unsigned short)g0[q]);
                const float o1 = (d1 * rstd * lw1 + lb1 + bt[q] * bf2f((unsigned short)v1[q])) * bf2f((unsigned short)g1[q]);
                bf16* yp = Y + (row0 + tok0 + crow8(q, hl)) * YYLD + h * 64 + (ln & 31);
                yp[0] = (unsigned short)f2bf(o0); yp[32] = (unsigned short)f2bf(o1);
            }
            asm volatile("s_waitcnt lgkmcnt(0)" ::: "memory");
        }
    }
}

__device__ __forceinline__ void p_post_scan(const Frame& F, ArgsP a, bf16* YD) {
    const int lane_f = lane_id_fresh();
    bf16* Y = (bf16*)(F.ws + WS_Y); const bf16* ZR = (const bf16*)(F.ws + WS_ZR); const bf16* A = (const bf16*)(F.ws + WS_A); const bf16* G = (const bf16*)(F.dob + DO_G);
    const float* lnw = a->in[I_LNW]; const float* lnb = a->in[I_LNB]; const float* rk = a->in[I_RK]; const float* mu = a->in[I_MU]; const float* k_a = a->in[I_KA];
    const int lane = lane_f;
    for (int m = F.gw; m < NTOK; m += F.NGW) {
        const bool first = (m % SEQ) == 0; const size_t mp = first ? m : m - 1;
        float y[8], r[8], k[8], v[8], g[8], o[8], t[8], av[8];
        unpack8(*((const u32x4*)(Y + (size_t)m * 512) + lane), y); unpack8(*((const u32x4*)(G + (size_t)m * 512) + lane), g); unpack8(*((const u32x4*)(A + (size_t)m * 512) + lane), av);
        unpack8(*((const u32x4*)(ZR + (size_t)m * 1792) + lane), r); unpack8(*((const u32x4*)(ZR + mp * 1792) + lane), t);
#pragma unroll
        for (int i = 0; i < 8; ++i) r[i] += ((first ? 0.f : t[i]) - r[i]) * mu[8 * lane + i];
        unpack8(*((const u32x4*)(ZR + (size_t)m * 1792 + 512) + lane), k); unpack8(*((const u32x4*)(ZR + mp * 1792 + 512) + lane), t);
#pragma unroll
        for (int i = 0; i < 8; ++i) { const float zk = k[i] + ((first ? 0.f : t[i]) - k[i]) * mu[512 + 8 * lane + i]; k[i] = zk * (1.f + (av[i] - 1.f) * k_a[8 * lane + i]); }
        unpack8(*((const u32x4*)(ZR + (size_t)m * 1792 + 1024) + lane), v); unpack8(*((const u32x4*)(ZR + mp * 1792 + 1024) + lane), t);
#pragma unroll
        for (int i = 0; i < 8; ++i) v[i] += ((first ? 0.f : t[i]) - v[i]) * mu[1024 + 8 * lane + i];
        float s = 0.f, d = 0.f;
#pragma unroll
        for (int i = 0; i < 8; ++i) { s += y[i]; d += r[i] * k[i] * rk[8 * lane + i]; }
        const float mean = sum8(s) * (1.f / 64.f); d = sum8(d); float q = 0.f;
#pragma unroll
        for (int i = 0; i < 8; ++i) { y[i] -= mean; q += y[i] * y[i]; }
        const float rstd = 1.0f / sqrtf(sum8(q) * (1.f / 64.f) + LN_X_EPS);
#pragma unroll
        for (int i = 0; i < 8; ++i) o[i] = (y[i] * rstd * lnw[8 * lane + i] + lnb[8 * lane + i] + d * v[i]) * g[i];
        *((u32x4*)(YD + (size_t)m * 512) + lane) = pack8(o);
    }
}

__device__ __forceinline__ void p_ffn_route(const Frame& F, ArgsP a, unsigned* cnt, int* route) {
    const int lane_f = lane_id_fresh(), tid_f = F.wave * 64 + lane_f;
    const float* X = a->in[I_X]; const bf16* MO = (const bf16*)(F.ws + WS_MO); bf16* H2 = (bf16*)(F.ws + WS_H2); const float* mod = (const float*)(F.ws + WS_MOD); const float* g = a->in[I_GFFN];
    LAS float* wr = (LAS float*)F.lds;
    __syncthreads();
    for (int i = tid_f; i < 1024 * 4; i += NTHR) { const int k = i >> 2, o = i & 3; wr[o * 1024 + k] = a->in[I_WRG][i]; }
    for (int i = tid_f; i < 1024 * 32; i += NTHR) { const int k = i >> 5, o = i & 31; wr[(4 + o) * 1024 + k] = a->in[I_WRE][i]; }
    __syncthreads();
    const float* brg = a->in[I_BRG]; const float* bre = a->in[I_BRE];
    const int lane = lane_f;
    LAS unsigned* lcnt = (LAS unsigned*)(F.lds + LDS_MISC + 512);
    if (tid_f < 64) lcnt[tid_f] = 0u;
    __syncthreads();
    int my_e0 = 0, my_e1 = 0; float my_w0 = 0.f, my_w1 = 0.f; int kk_ = 0;
    for (int m = F.gw; m < NTOK; m += F.NGW, ++kk_) {
        const int b = m / SEQ; const f32x4* xr = (const f32x4*)(X + (size_t)m * 1024) + lane; const u32x2* mr = (const u32x2*)(MO + (size_t)m * 1024) + lane;
        f32x4 v[4]; float s = 0.f;
#pragma unroll
        for (int j = 0; j < 4; ++j) { const u32x2 mo = mr[64 * j]; const f32x4 gm = *(const f32x4*)(mod + b * 6144 + 2048 + 4 * lane + 256 * j);
            v[j] = xr[64 * j] + gm * (f32x4){lo2f(mo.x), hi2f(mo.x), lo2f(mo.y), hi2f(mo.y)};
            s += (v[j].x * v[j].x + v[j].y * v[j].y) + (v[j].z * v[j].z + v[j].w * v[j].w); }
        const float rstd = 1.0f / sqrtf(wave_sum(s) * (1.f / 1024.f) + EPS);
        u32x2* o = (u32x2*)(H2 + (size_t)m * 1024) + lane;
#pragma unroll
        for (int j = 0; j < 4; ++j) { const int col = 4 * lane + 256 * j;
            const f32x4 gg = *(const f32x4*)(g + col), sc = *(const f32x4*)(mod + b * 6144 + 4096 + col), sh = *(const f32x4*)(mod + b * 6144 + 3072 + col);
            v[j] = v[j] * rstd * gg * (sc + 1.0f) + sh; u32x2 w; w.x = pk2(v[j].x, v[j].y); w.y = pk2(v[j].z, v[j].w); o[64 * j] = w; }
        float lgq[4];
#pragma unroll
        for (int oo = 0; oo < 4; ++oo) { float p = 0.f;
#pragma unroll
            for (int j = 0; j < 4; ++j) { const f32x4 w4 = *(const LAS f32x4*)(wr + oo * 1024 + 4 * lane + 256 * j); p += (v[j].x * w4.x + v[j].y * w4.y) + (v[j].z * w4.z + v[j].w * w4.w); }
            lgq[oo] = wave_sum(p) + brg[oo]; }
        int gi = 0; float gm = lgq[0];
#pragma unroll
        for (int i = 1; i < 4; ++i) { if (lgq[i] > gm) { gm = lgq[i]; gi = i; } }
        float gs = 0.f;
#pragma unroll
        for (int i = 0; i < 4; ++i) gs += __expf(lgq[i] - gm);
        const float pg = 1.f / gs;
        gi = __builtin_amdgcn_readfirstlane(gi);
        float el[8];
        { const LAS float* wg = wr + (4 + gi * 8) * 1024 + 4 * lane;
#pragma unroll
          for (int i = 0; i < 8; ++i) { float p = 0.f;
#pragma unroll
              for (int j = 0; j < 4; ++j) { const f32x4 w4 = *(const LAS f32x4*)(wg + i * 1024 + 256 * j); p += (v[j].x * w4.x + v[j].y * w4.y) + (v[j].z * w4.z + v[j].w * w4.w); }
              el[i] = wave_sum(p) + bre[gi * 8 + i]; } }
        int i0 = 0; float m0 = el[0];
#pragma unroll
        for (int i = 1; i < 8; ++i) if (el[i] > m0) { m0 = el[i]; i0 = i; }
        int i1 = -1; float m1 = -INFINITY;
#pragma unroll
        for (int i = 0; i < 8; ++i) if (i != i0 && el[i] > m1) { m1 = el[i]; i1 = i; }
        const float e1 = __expf(m1 - m0), w0 = pg / (1.f + e1), w1 = pg * e1 / (1.f + e1);
        if (lane == kk_) { my_e0 = gi * 8 + i0; my_e1 = gi * 8 + i1; my_w0 = w0; my_w1 = w1; }
    }
    unsigned lp0 = 0u, lp1 = 0u;
    if (lane < kk_) { lp0 = __hip_atomic_fetch_add(lcnt + my_e0, 1u, __ATOMIC_RELAXED, __HIP_MEMORY_SCOPE_WORKGROUP); lp1 = __hip_atomic_fetch_add(lcnt + my_e1, 1u, __ATOMIC_RELAXED, __HIP_MEMORY_SCOPE_WORKGROUP); }
    __syncthreads();
    if (tid_f < 32) lcnt[32 + tid_f] = __hip_atomic_fetch_add(cnt + tid_f, lcnt[tid_f], __ATOMIC_RELAXED, __HIP_MEMORY_SCOPE_AGENT);
    __syncthreads();
    if (lane < kk_) { const int m = F.gw + lane * F.NGW; int* rt = route + (size_t)m * 8;
        rt[0] = my_e0; rt[1] = my_e1; rt[2] = (int)(lcnt[32 + my_e0] + lp0); rt[3] = (int)(lcnt[32 + my_e1] + lp1); rt[4] = __builtin_bit_cast(int, my_w0); rt[5] = __builtin_bit_cast(int, my_w1); }
    __syncthreads();
}
__device__ __forceinline__ int moe_tables(const Frame& F, LAS int* offs, LAS int* texp) {
    const int lane_f = lane_id_fresh(), tid_f = F.wave * 64 + lane_f;
    const unsigned* cnt = (const unsigned*)(F.ws + WS_CTL) + CW_CNT;
    __syncthreads();
    if (tid_f == 0) { int o = 0; for (int e = 0; e < 32; ++e) { offs[e] = o; const int c = (int)__hip_atomic_load(cnt + e, __ATOMIC_RELAXED, __HIP_MEMORY_SCOPE_AGENT); const int nt = (c + 255) >> 8; for (int t = 0; t < nt; ++t) texp[(o >> 8) + t] = e; o += nt << 8; } offs[32] = o; }
    __syncthreads();
    return offs[32] >> 8;
}
__device__ __forceinline__ void p_gather(const Frame& F) {
    const int lane_f = lane_id_fresh(), tid_f = F.wave * 64 + lane_f;
    LAS int* offs = (LAS int*)(F.lds + 1024); LAS int* texp = (LAS int*)(F.lds + 2048);
    moe_tables(F, offs, texp);
    const int* route = (const int*)(F.ws + WS_ROUTE); int* ridx = (int*)(F.ws + WS_ENT);
    const unsigned* cnt = (const unsigned*)(F.ws + WS_CTL) + CW_CNT;
    for (int m = F.vcu * NTHR + tid_f; m < NTOK; m += F.G * NTHR) { const u32x4 rt = *(const u32x4*)(route + (size_t)m * 8); ridx[offs[rt.x] + (int)rt.z] = m; ridx[offs[rt.y] + (int)rt.w] = m; }
    for (int i = F.vcu * NTHR + tid_f; i < 32 * 256; i += F.G * NTHR) { const int e = i >> 8, r = i & 255; const int c = (int)cnt[e]; const int pad = ((c + 255) & ~255) - c; if (r < pad) ridx[offs[e] + c + r] = 0; }
    __syncthreads();
}
__device__ __forceinline__ void p_combine(const Frame& F, const float* xin, float* dst) {
    const int lane_f = lane_id_fresh(), tid_f = F.wave * 64 + lane_f;
    LAS int* offs = (LAS int*)(F.lds + 1024); LAS int* texp = (LAS int*)(F.lds + 2048);
    moe_tables(F, offs, texp);
    const bf16* MO = (const bf16*)(F.ws + WS_MO); const bf16* YS = (const bf16*)(F.ws + WS_YS); const int* route = (const int*)(F.ws + WS_ROUTE); const float* mod = (const float*)(F.ws + WS_MOD);
    const int lane = lane_f;
    for (int m = F.gw; m < NTOK; m += F.NGW) {
        const int b = m / SEQ; const int* rt = route + (size_t)m * 8; const int d0 = offs[rt[0]] + rt[2], d1 = offs[rt[1]] + rt[3];
        const float w0 = __builtin_bit_cast(float, rt[4]), w1 = __builtin_bit_cast(float, rt[5]);
#pragma unroll
        for (int j = 0; j < 2; ++j) { const int col = 8 * lane + 512 * j; float y0[8], y1[8];
            unpack8(*(const u32x4*)(YS + (size_t)d0 * 1024 + col), y0); unpack8(*(const u32x4*)(YS + (size_t)d1 * 1024 + col), y1);
            const float* o = xin + (size_t)m * 1024 + col; const float* gt = mod + b * 6144 + 5120 + col; const float* gm = mod + b * 6144 + 2048 + col; float mo[8]; unpack8(*(const u32x4*)(MO + (size_t)m * 1024 + col), mo);
            f32x4 x0 = *(const f32x4*)o, x1 = *(const f32x4*)(o + 4); const f32x4 g0 = *(const f32x4*)gt, g1 = *(const f32x4*)(gt + 4), h0 = *(const f32x4*)gm, h1 = *(const f32x4*)(gm + 4);
            x0.x += h0.x * mo[0]; x0.y += h0.y * mo[1]; x0.z += h0.z * mo[2]; x0.w += h0.w * mo[3]; x1.x += h1.x * mo[4]; x1.y += h1.y * mo[5]; x1.z += h1.z * mo[6]; x1.w += h1.w * mo[7];
            x0.x += g0.x * (w0 * y0[0] + w1 * y1[0]); x0.y += g0.y * (w0 * y0[1] + w1 * y1[1]); x0.z += g0.z * (w0 * y0[2] + w1 * y1[2]); x0.w += g0.w * (w0 * y0[3] + w1 * y1[3]);
            x1.x += g1.x * (w0 * y0[4] + w1 * y1[4]); x1.y += g1.y * (w0 * y0[5] + w1 * y1[5]); x1.z += g1.z * (w0 * y0[6] + w1 * y1[6]); x1.w += g1.w * (w0 * y0[7] + w1 * y1[7]);
            float* od = dst + (size_t)m * 1024 + col; *(f32x4*)od = x0; *(f32x4*)(od + 4) = x1; }
    }
}

constexpr int NPHASE = 17;
template <int LO, int HI>
__global__ void __launch_bounds__(NTHR, 2) fwd(Args args) {
    extern __shared__ __attribute__((aligned(16))) unsigned char lds_raw[];
    Frame F;
    F.lds = (LAS unsigned char*)lds_raw;
    F.wave = __builtin_amdgcn_readfirstlane((int)threadIdx.x >> 6);
    F.G = gridDim.x; { const int bx = blockIdx.x; F.vcu = (F.G % 8 == 0) ? (bx % 8) * (F.G / 8) + bx / 8 : bx; }
    F.gw = F.vcu * NWAVES + F.wave; F.NGW = F.G * NWAVES;
    F.ws = args.ws; F.dob = (unsigned char*)args.out;
    ArgsP AP = (ArgsP)__builtin_amdgcn_kernarg_segment_ptr();
    volatile LAS unsigned* MISC = (volatile LAS unsigned*)(F.lds + LDS_MISC);
    if (threadIdx.x < 64) MISC[threadIdx.x] = 0u;
    __syncthreads();
    XcdBarrier bar; bar.bar = (unsigned*)(F.ws + WS_CTL) + CW_BAR; bar.x = 0; bar.st = MISC + 8;
#if N_LAUNCH_MODE == 1
    bar = xcd_barrier_post((unsigned*)(F.ws + WS_CTL) + CW_BAR, MISC + 8);
#define GRID_BAR() xcd_barrier(bar)
#else
#define GRID_BAR() do { } while (0)
#endif
#ifndef PROBE_REPEAT
#define PROBE_REPEAT -1
#endif
#define IN(k) (LO <= (k) && (k) < HI)
#define SEAM(k) do { if constexpr (IN(k) && IN((k) + 1)) GRID_BAR(); } while (0)
    const float* mod = (const float*)(F.ws + WS_MOD);

#define PH(k, ...) do { if constexpr (IN(k)) { asm volatile("" : "+s"(AP)); { __VA_ARGS__ } if constexpr (PROBE_REPEAT == (k)) { GRID_BAR(); asm volatile("" : "+s"(AP)); { __VA_ARGS__ } } } } while (0)
    PH(0, p0_prologue(F, AP);); SEAM(0);
    PH(1, p_normmod(F, AP->in[I_X], AP->in[I_GMIX], mod, 0, 1024, (bf16*)(F.ws + WS_H));); SEAM(1);
    PH(2, Gemm g{(const bf16*)(F.ws + WS_H), (const bf16*)(F.ws + WS_WIN), NTOK, N_IN_PAD, 1024}; StaticOrder S; S.init(NTOK, N_IN_PAD, F.G, (int)blockIdx.x);
        EpiZ E{(bf16*)(F.ws + WS_ZR), (bf16*)(F.ws + WS_SG), (bf16*)(F.ws + WS_ZM)}; gemm_phase_any(F.lds, g, S, E, F.wave);); SEAM(2);
    PH(3, p_prep_a(F, AP);); SEAM(3);
    PH(4,
        { Gemm g{(const bf16*)(F.ws + WS_TWA), (const bf16*)(F.ws + WS_WBLK), NTOK, 1024, 128}; StaticOrder S; S.init(NTOK, 1024, F.G, (int)blockIdx.x);
          EpiLora E{(bf16*)(F.ws + WS_LW), (bf16*)(F.ws + WS_A), AP->in[I_W0], AP->in[I_A0]}; gemm_phase_any(F.lds, g, S, E, F.wave); }
        { Gemm g{(const bf16*)(F.ws + WS_SGL), (const bf16*)(F.ws + WS_WG), NTOK, 512, 128}; StaticOrder S; S.init(NTOK, 512, F.G, (int)blockIdx.x);
          EpiPlain E{(bf16*)(F.dob + DO_G), nullptr, 1 << 30, 512, 0}; gemm_phase_any(F.lds, g, S, E, F.wave); }
        { Gemm g{(const bf16*)(F.ws + WS_QA), (const bf16*)(F.ws + WS_WUQ), NTOK, 768, 256}; StaticOrder S; S.init(NTOK, 768, F.G, (int)blockIdx.x);
          EpiPlain E{(bf16*)(F.dob + DO_Q), nullptr, 1 << 30, 768, 0}; gemm_phase_any(F.lds, g, S, E, F.wave); }
        { Gemm g{(const bf16*)(F.ws + WS_KVA), (const bf16*)(F.ws + WS_WUKV), NTOK, 1024, 128}; StaticOrder S; S.init(NTOK, 1024, F.G, (int)blockIdx.x);
          EpiPlain E{(bf16*)(F.dob + DO_KN), (bf16*)(F.ws + WS_VC), 512, 512, 512}; gemm_phase_any(F.lds, g, S, E, F.wave); }
    ); SEAM(4);
    PH(5, p_prep_c(F, AP);); SEAM(5);
#if ENG_ATTN == 1
    PH(6, p_attn_mfma(F);); SEAM(6);
#else
    PH(6, p_attn_naive(F);); SEAM(6);
#endif
    PH(7, p_cs_a(F, AP);); SEAM(7);
    PH(8, p_cs_b(F);); SEAM(8);
    PH(9, p_cs_c(F, AP);); SEAM(9);
    PH(10, Gemm g{(const bf16*)(F.ws + WS_Y), (const bf16*)(F.ws + WS_WB), NTOK, 1024, 1024}; StaticOrder S; S.init(NTOK, 1024, F.G, (int)blockIdx.x);
        EpiBranch2 E{(bf16*)(F.ws + WS_MG), (const bf16*)(F.ws + WS_SG)}; gemm_phase_mid(F.lds, g, S, E, F.wave);); SEAM(10);
    PH(11, Gemm g{(const bf16*)(F.ws + WS_MG), (const bf16*)(F.ws + WS_WO), NTOK, 1024, 1024}; StaticOrder S; S.init(NTOK, 1024, F.G, (int)blockIdx.x);
        EpiPlain E{(bf16*)(F.ws + WS_MO), nullptr, 1 << 30, 1024, 0}; gemm_phase_any(F.lds, g, S, E, F.wave);); SEAM(11);
    if constexpr (PROBE_REPEAT == 12) { p_ffn_route(F, AP, (unsigned*)(F.ws + WS_CTL) + CW_CNT + 64, (int*)(F.ws + WS_CS)); GRID_BAR(); }
    if constexpr (IN(12)) { asm volatile("" : "+s"(AP)); p_ffn_route(F, AP, (unsigned*)(F.ws + WS_CTL) + CW_CNT, (int*)(F.ws + WS_ROUTE)); } SEAM(12);
    PH(13, p_gather(F);); SEAM(13);
    PH(14, LAS int* offs = (LAS int*)(F.lds + LDS_MISC + 1024); LAS int* texp = (LAS int*)(F.lds + LDS_MISC + 1024 + 256); const int nt = moe_tables(F, offs, texp);
        Gemm g{(const bf16*)(F.ws + WS_H2), (const bf16*)(F.ws + WS_WGU), MPAD, 512, 1024, (const int*)(F.ws + WS_ENT)}; TableOrder S{texp, nt, 2, F.G, (int)blockIdx.x};
        EpiGateUp E{(bf16*)(F.ws + WS_HID)}; gemm_phase_gather(F.lds, g, S, E, F.wave);); SEAM(14);
    PH(15, LAS int* offs = (LAS int*)(F.lds + LDS_MISC + 1024); LAS int* texp = (LAS int*)(F.lds + LDS_MISC + 1024 + 256); const int nt = moe_tables(F, offs, texp);
        Gemm g{(const bf16*)(F.ws + WS_HID), (const bf16*)(F.ws + WS_WDN), MPAD, 1024, 256}; TableOrder S{texp, nt, 4, F.G, (int)blockIdx.x};
        EpiDown E{(bf16*)(F.ws + WS_YS)}; gemm_phase_any(F.lds, g, S, E, F.wave);); SEAM(15);
    if constexpr (PROBE_REPEAT == 16) { asm volatile("" : "+s"(AP)); p_combine(F, AP->in[I_X], (float*)(F.ws + WS_SG)); GRID_BAR(); }
    if constexpr (IN(16)) { asm volatile("" : "+s"(AP)); p_combine(F, AP->in[I_X], (float*)F.dob); }
}

#if N_LAUNCH_MODE == 1
static bool set_attrs() { return hipFuncSetAttribute((const void*)fwd<0, NPHASE>, hipFuncAttributeMaxDynamicSharedMemorySize, LDS_BYTES) == hipSuccess; }
#else
template <int P> static bool set_attr_all() { if constexpr (P < NPHASE) { return hipFuncSetAttribute((const void*)fwd<P, P + 1>, hipFuncAttributeMaxDynamicSharedMemorySize, LDS_BYTES) == hipSuccess && set_attr_all<P + 1>(); } else return true; }
static bool set_attrs() { return set_attr_all<0>(); }
template <int P> static void launch_all(int grid, hipStream_t stream, const Args& a) { if constexpr (P < NPHASE) { hipLaunchKernelGGL((fwd<P, P + 1>), dim3(grid), dim3(NTHR), LDS_BYTES, stream, a); launch_all<P + 1>(grid, stream, a); } }
#endif
extern "C" void kernel_launch(void* const* d_in, const int* in_sizes, int n_in, void* d_out, int out_size, void* d_ws, size_t ws_size, hipStream_t stream) {
    static int grid = 0;
    if (grid == 0) {
        if (n_in != 34 || out_size != NTOK * DM || ws_size < WS_END) { fprintf(stderr, "kernel_launch: unexpected shapes (n_in %d out %d ws %zu)\n", n_in, out_size, ws_size); grid = -1; return; }
        int dev = 0, cus = 0;
        if (hipGetDevice(&dev) != hipSuccess || hipDeviceGetAttribute(&cus, hipDeviceAttributeMultiprocessorCount, dev) != hipSuccess) { grid = -1; return; }
        if (!set_attrs()) { fprintf(stderr, "kernel_launch: hipFuncSetAttribute failed\n"); grid = -1; return; }
        grid = cus;
    }
    if (grid < 0) return;
    (void)hipMemsetAsync((char*)d_ws + WS_CTL, 0, CTL_ZERO_BYTES, stream);
    Args a{};
    for (int i = 0; i < 34; ++i) a.in[i] = (const float*)d_in[i];
    a.out = (float*)d_out; a.ws = (unsigned char*)d_ws;
    a.ph_lo = 0; a.ph_hi = NPHASE;
#if N_LAUNCH_MODE == 1
    hipLaunchKernelGGL((fwd<0, NPHASE>), dim3(grid), dim3(NTHR), LDS_BYTES, stream, a);
#else
    launch_all<0>(grid, stream, a);
#endif
}
```

```cpp
#include <hip/hip_runtime.h>
#include <cstdio>
#include <cstdint>

#ifndef N_LAUNCH_MODE
#define N_LAUNCH_MODE 1
#endif
#ifndef ENG_GEMM
#define ENG_GEMM 1
#endif
#ifndef ENG_ATTN
#define ENG_ATTN 1
#endif

#define GAS __attribute__((address_space(1)))
#define LAS __attribute__((address_space(3)))
typedef unsigned short bf16;
typedef float f32x4 __attribute__((ext_vector_type(4)));
typedef float f32x2 __attribute__((ext_vector_type(2)));
typedef unsigned u32x4 __attribute__((ext_vector_type(4)));
typedef unsigned u32x2 __attribute__((ext_vector_type(2)));
typedef short bf16x8 __attribute__((ext_vector_type(8)));

constexpr int BATCH = 8, SEQ = 8192, DM = 1024, NTOK = BATCH * SEQ;
constexpr int D_RWKV = 512, RWKV_COLS = 1792, MLA_COLS = 416, D_IN = 4256, N_IN_PAD = 4352;
constexpr int NH = 8, QKD = 96, NOPE = 64, ROPE = 32, VD = 64;
constexpr int NEXP = 32, DEXP = 256;
constexpr int MPAD = 139264;
constexpr float EPS = 1e-6f, LN_X_EPS = 64e-5f;
constexpr float QSCALE = 0.10206207261596577f * 1.4426950408889634f;

constexpr size_t MiB = 1u << 20;
constexpr size_t WS_CTL = 0, CTL_ZERO_BYTES = 1 * MiB;
constexpr size_t WS_MOD = 1 * MiB;
constexpr size_t WS_ROUTE = 2 * MiB;
constexpr size_t WS_CS = 4 * MiB;
constexpr size_t WS_ENT = 12 * MiB;
constexpr size_t WS_WIN = 16 * MiB;
constexpr size_t WS_WBLK = 25 * MiB;
constexpr size_t WS_WG = WS_WBLK + 256 * 1024;
constexpr size_t WS_WUQ = WS_WG + 128 * 1024;
constexpr size_t WS_WUKV = WS_WUQ + 384 * 1024;
constexpr size_t WS_WB = 26 * MiB;
constexpr size_t WS_WO = 28 * MiB;
constexpr size_t WS_WGU = 30 * MiB;
constexpr size_t WS_WDN = 62 * MiB;
constexpr size_t WS_SG = 80 * MiB;
constexpr size_t WS_H2 = 80 * MiB;
constexpr size_t WS_ZR = 336 * MiB;
constexpr size_t WS_VC = 816 * MiB;
constexpr size_t WS_KC = 880 * MiB;
constexpr size_t WS_Y = 560 * MiB;
constexpr size_t WS_XG = 336 * MiB;
constexpr size_t WS_ZM = 560 * MiB;
constexpr size_t WS_YM = 560 * MiB + 1024;
constexpr size_t WS_H = 688 * MiB;
constexpr size_t WS_LW = 688 * MiB;
constexpr size_t WS_A = 752 * MiB;
constexpr size_t WS_MG = 688 * MiB;
constexpr size_t WS_HID = 208 * MiB;
constexpr size_t WS_R = 752 * MiB;
constexpr size_t WS_V = 816 * MiB;
constexpr size_t WS_ZK = 880 * MiB;
constexpr size_t WS_TWA = 944 * MiB;
constexpr size_t WS_SGL = 960 * MiB;
constexpr size_t WS_QA = 976 * MiB;
constexpr size_t WS_KVA = 1008 * MiB;
constexpr size_t WS_KK = 944 * MiB;
constexpr size_t WS_YS = 752 * MiB;
constexpr size_t WS_MO = 560 * MiB;
constexpr int YYLD = 1024;
constexpr size_t WS_END = 1024 * MiB;
constexpr size_t DO_G = 0;
constexpr size_t DO_Q = 64 * MiB;
constexpr size_t DO_KN = 160 * MiB;

constexpr int CW_CNT = 64;
constexpr int CW_BAR = 4096;

constexpr int NWAVES = 8, NTHR = 512;
constexpr int LDS_BYTES = 155648;
constexpr int LDS_MISC = 151552;

__device__ __forceinline__ int lane_id_fresh() { int l; asm volatile("v_mbcnt_lo_u32_b32 %0, -1, 0\n\tv_mbcnt_hi_u32_b32 %0, -1, %0" : "=v"(l)); return l; }
__device__ __forceinline__ float bf2f(unsigned short h) { return __builtin_bit_cast(float, (unsigned)h << 16); }
__device__ __forceinline__ unsigned f2bf(float f) { unsigned u = __builtin_bit_cast(unsigned, f); return (u + 0x7fffu + ((u >> 16) & 1u)) >> 16; }
typedef __bf16 bf16x2_t __attribute__((ext_vector_type(2)));
__device__ __forceinline__ unsigned pk2(float lo, float hi) { const f32x2 v = {lo, hi}; return __builtin_bit_cast(unsigned, __builtin_convertvector(v, bf16x2_t)); }
__device__ __forceinline__ float lo2f(unsigned w) { return __builtin_bit_cast(float, w << 16); }
__device__ __forceinline__ float hi2f(unsigned w) { return __builtin_bit_cast(float, w & 0xffff0000u); }
template <int CTRL> __device__ __forceinline__ float dpp_add(float x) { return x + __builtin_bit_cast(float, __builtin_amdgcn_update_dpp(0, __builtin_bit_cast(int, x), CTRL, 0xf, 0xf, false)); }
__device__ __forceinline__ float allsum16(float x) { x = dpp_add<0xB1>(x); x = dpp_add<0x4E>(x); x = dpp_add<0x141>(x); x = dpp_add<0x140>(x); return x; }
__device__ __forceinline__ float allsum32(float x) { x = allsum16(x); auto r = __builtin_amdgcn_permlane16_swap(__float_as_uint(x), __float_as_uint(x), false, false); return __uint_as_float(r[0]) + __uint_as_float(r[1]); }
__device__ __forceinline__ float sum8(float x) { x = dpp_add<0xB1>(x); x = dpp_add<0x4E>(x); x = dpp_add<0x141>(x); return x; }
__device__ __forceinline__ float wave_sum(float v) {
    v = allsum16(v);
    { auto r = __builtin_amdgcn_permlane16_swap(__float_as_uint(v), __float_as_uint(v), false, false); v = __uint_as_float(r[0]) + __uint_as_float(r[1]); }
    { auto r = __builtin_amdgcn_permlane32_swap(__float_as_uint(v), __float_as_uint(v), false, false); v = __uint_as_float(r[0]) + __uint_as_float(r[1]); }
    return v;
}
__device__ __forceinline__ float sigmoidf_(float x) { return __builtin_amdgcn_rcpf(1.f + __builtin_amdgcn_exp2f(-1.4426950408889634f * x)); }
__device__ __forceinline__ float siluf_(float x) { return x * __builtin_amdgcn_rcpf(1.f + __builtin_amdgcn_exp2f(-1.4426950408889634f * x)); }
__device__ __forceinline__ void unpack8(const u32x4 w, float (&v)[8]) {
    v[0] = lo2f(w.x); v[1] = hi2f(w.x); v[2] = lo2f(w.y); v[3] = hi2f(w.y); v[4] = lo2f(w.z); v[5] = hi2f(w.z); v[6] = lo2f(w.w); v[7] = hi2f(w.w);
}
__device__ __forceinline__ u32x4 pack8(const float (&v)[8]) { u32x4 w; w.x = pk2(v[0], v[1]); w.y = pk2(v[2], v[3]); w.z = pk2(v[4], v[5]); w.w = pk2(v[6], v[7]); return w; }

#define LDS_BAR() do { asm volatile("s_waitcnt lgkmcnt(0)" ::: "memory"); __builtin_amdgcn_s_barrier(); asm volatile("" ::: "memory"); } while (0)

#define XB_TMO      128
#define XB_XCNT(j)  (256  + 64 * (j))
#define XB_XSUB(j)  (1280 + 64 * (j))
#define XB_XGEN(j)  (2304 + 64 * (j))
#define XB_TOP      3328
#define XB_TOPGEN   3392
#define XCD_BAR_WORDS 3456
#define XB_SPIN_CAP (1u << 19)
__device__ __forceinline__ unsigned xb_ld(unsigned* p)              { return __hip_atomic_load(p, __ATOMIC_RELAXED, __HIP_MEMORY_SCOPE_AGENT); }
__device__ __forceinline__ unsigned xb_add(unsigned* p, unsigned v) { return __hip_atomic_fetch_add(p, v, __ATOMIC_RELAXED, __HIP_MEMORY_SCOPE_AGENT); }
__device__ __forceinline__ unsigned xb_xcc_id() { return (unsigned)__builtin_amdgcn_s_getreg((3 << 11) | 20) & 0xFu; }
#define XB_SPIN(cond, bar) do { unsigned _sp = 0; while (cond) { __builtin_amdgcn_s_sleep(1); \
    if ((++_sp & 255u) == 0u) { if (xb_ld(&(bar)[XB_TMO])) break; if (_sp > XB_SPIN_CAP) { atomicAdd(&(bar)[XB_TMO], 1u); break; } } } } while (0)
struct XcdBarrier { unsigned* bar; unsigned x; volatile LAS unsigned* st; };
__device__ __forceinline__ XcdBarrier xcd_barrier_post(unsigned* bar, volatile LAS unsigned* st) {
    XcdBarrier b; b.bar = bar; b.x = xb_xcc_id(); b.st = st;
    if (threadIdx.x == 0) (void)xb_add(&bar[XB_XCNT(b.x)], 1u);
    return b;
}
__device__ __forceinline__ void xcd_barrier_complete(unsigned* bar, unsigned x, unsigned& nloc, unsigned& nx) {
    const unsigned G = gridDim.x * gridDim.y * gridDim.z;
    unsigned sum, cnt, mine, sp = 0u;
    for (;;) {
        sum = 0u; cnt = 0u; mine = 0u;
#pragma unroll
        for (unsigned j = 0; j < 16; ++j) { const unsigned c = xb_ld(&bar[XB_XCNT(j)]); sum += c; cnt += (c > 0u) ? 1u : 0u; mine = (j == x) ? c : mine; }
        if (sum == G) break;
        __builtin_amdgcn_s_sleep(1);
        if ((++sp & 255u) == 0u) { if (xb_ld(&bar[XB_TMO])) break; if (sp > XB_SPIN_CAP) { atomicAdd(&bar[XB_TMO], 1u); break; } }
    }
    nloc = mine > 0u ? mine : 1u; nx = cnt > 0u ? cnt : 1u;
}
__device__ __forceinline__ void xcd_barrier(const XcdBarrier& b) {
    asm volatile("s_waitcnt vmcnt(0)" ::: "memory");
    __syncthreads();
    if (threadIdx.x == 0) {
        unsigned* bar = b.bar;
        __builtin_amdgcn_s_waitcnt(0);
        unsigned nloc = b.st[0], nx = b.st[1];
        if (nloc == 0u) { xcd_barrier_complete(bar, b.x, nloc, nx); b.st[0] = nloc; b.st[1] = nx; }
        const unsigned old = xb_add(&bar[XB_XSUB(b.x)], 1u);
        const unsigned gen = old / nloc;
        if (old + 1u == (gen + 1u) * nloc) {
            __builtin_amdgcn_fence(__ATOMIC_RELEASE, "agent");
            asm volatile("s_waitcnt vmcnt(0)" ::: "memory");
            const unsigned og = xb_add(&bar[XB_TOP], 1u);
            const unsigned tg = og / nx;
            if (og + 1u == (tg + 1u) * nx) xb_add(&bar[XB_TOPGEN], 1u);
            else XB_SPIN(xb_ld(&bar[XB_TOPGEN]) == tg, bar);
            __builtin_amdgcn_fence(__ATOMIC_ACQUIRE, "agent");
            xb_add(&bar[XB_XGEN(b.x)], 1u);
            asm volatile("s_waitcnt vmcnt(0)" ::: "memory");
        } else {
            XB_SPIN(xb_ld(&bar[XB_XGEN(b.x)]) == gen, bar);
            __builtin_amdgcn_fence(__ATOMIC_ACQUIRE, "agent");
            asm volatile("s_waitcnt vmcnt(0)" ::: "memory");
        }
    }
    __syncthreads();
}

struct Args {
    const float* in[34]; float* out; unsigned char* ws; int ph_lo, ph_hi;
};
typedef const __attribute__((address_space(4))) Args* ArgsP;
struct Frame {
    LAS unsigned char* lds;
    int wave, vcu, G, gw, NGW;
    unsigned char* ws; unsigned char* dob;
};
enum { I_X = 0, I_C, I_POS, I_WADA, I_BADA, I_GMIX, I_WIN, I_MU, I_W0, I_WDEC, I_A0, I_WAUP, I_WGUP, I_KK, I_KA, I_RK, I_LNW, I_LNB, I_GQA, I_WUQ, I_GKVA, I_WUKV,
       I_QN, I_KN, I_WBR, I_WOUT, I_GFFN, I_WRG, I_BRG, I_WRE, I_BRE, I_WEG, I_WEU, I_WED };

struct Unit { int pm, pn; };
struct Gemm { const bf16* A; const bf16* Bt; int M, N, K; const int* ridx = nullptr; };
constexpr int NXCD = 8, WGM = 8;
struct StaticOrder {
    int nM, nN, nwg, G, c;
    __device__ void init(int M, int N, int G_, int c_) { nM = M / 256; nN = N / 256; nwg = nM * nN; G = G_; c = c_; }
    __device__ bool next(int i, Unit& u) const {
        const long L = (long)i * G + c; if (L >= nwg) return false;
        int wgid = (int)L; { const int q = nwg / NXCD, r = nwg % NXCD, xcd = wgid % NXCD, off = wgid / NXCD; wgid = (xcd < r ? xcd * (q + 1) : r * (q + 1) + (xcd - r) * q) + off; }
        const int nig = WGM * nN, gid = wgid / nig, fm = gid * WGM, gsz = (nM - fm) < WGM ? (nM - fm) : WGM;
        u.pm = fm + ((wgid % nig) % gsz); u.pn = (wgid % nig) / gsz; return true;
    }
    __device__ __forceinline__ void a_ready(const Unit&) const {}
    __device__ __forceinline__ void done(const Unit&) const {}
};
struct TableOrder {
    const LAS int* texp; int ntiles, nN, G, c;
    __device__ bool next(int i, Unit& u) const {
        const long L = (long)i * G + c; if (L >= (long)ntiles * nN) return false;
        const int t = (int)(L / nN), j = (int)(L % nN); u.pm = t; u.pn = texp[t] * nN + j; return true;
    }
    __device__ __forceinline__ void a_ready(const Unit&) const {}
    __device__ __forceinline__ void done(const Unit&) const {}
};

template <class Epi, class Sched>
__device__ __forceinline__ void gemm_phase_naive(LAS unsigned char* lds, const Gemm g, const Sched& S, const Epi& E) {
    const int tid = (int)__builtin_amdgcn_readfirstlane((int)threadIdx.x >> 6) * 64 + lane_id_fresh(), ty = tid >> 5, tx = tid & 31;
    LAS bf16* As = (LAS bf16*)lds; LAS bf16* Bs = (LAS bf16*)(lds + 128 * 40 * 2);
    Unit u;
    for (int i = 0; S.next(i, u); ++i) {
        for (int half = 0; half < 2; ++half) {
            float acc[8][8];
#pragma unroll
            for (int r = 0; r < 8; ++r)
#pragma unroll
                for (int c = 0; c < 8; ++c) acc[r][c] = 0.f;
            const bf16* Ab = g.A + ((size_t)u.pm * 256 + half * 128) * g.K; const bf16* Bb = g.Bt + (size_t)u.pn * 256 * g.K;
            for (int k0 = 0; k0 < g.K; k0 += 32) {
                __syncthreads();
                { const int r = tid >> 2, c8 = (tid & 3) * 8; *(LAS u32x4*)(As + r * 40 + c8) = *(const u32x4*)(Ab + (size_t)r * g.K + k0 + c8); }
#pragma unroll
                for (int j = 0; j < 2; ++j) { const int ch = tid + j * 512, r = ch >> 2, c8 = (ch & 3) * 8; *(LAS u32x4*)(Bs + r * 40 + c8) = *(const u32x4*)(Bb + (size_t)r * g.K + k0 + c8); }
                __syncthreads();
#pragma unroll 2
                for (int k = 0; k < 32; k += 2) {
                    float b0[8], b1[8];
#pragma unroll
                    for (int c = 0; c < 8; ++c) { const unsigned w = *(const LAS unsigned*)(Bs + (tx * 8 + c) * 40 + k); b0[c] = lo2f(w); b1[c] = hi2f(w); }
#pragma unroll
                    for (int r = 0; r < 8; ++r) { const unsigned w = *(const LAS unsigned*)(As + (ty * 8 + r) * 40 + k); const float a0 = lo2f(w), a1 = hi2f(w);
#pragma unroll
                        for (int c = 0; c < 8; ++c) acc[r][c] = fmaf(a1, b1[c], fmaf(a0, b0[c], acc[r][c])); }
                }
            }
#pragma unroll
            for (int r = 0; r < 8; ++r) E.store8(u, half * 128 + ty * 8 + r, tx * 8, acc[r]);
        }
    }
    __syncthreads();
}

struct EpiZ { bf16 *ZR, *SG, *ZM;
    __device__ __forceinline__ void store8(const Unit& u, int r, int c, const float (&v)[8]) const {
        const size_t row = (size_t)u.pm * 256 + r;
        if (u.pn < 7) { *(u32x4*)(ZR + row * 1792 + u.pn * 256 + c) = pack8(v); }
        else if (u.pn < 15) { *(u32x4*)(SG + row * 2048 + (u.pn - 7) * 256 + c) = pack8(v); }
        else { *(u32x4*)(ZM + row * 512 + (u.pn - 15) * 256 + c) = pack8(v); }
    } };
struct EpiLora { bf16 *LW, *A; const float *w0, *a0;
    __device__ __forceinline__ void store8(const Unit& u, int r, int c, const float (&v)[8]) const {
        const size_t row = (size_t)u.pm * 256 + r; const int col = u.pn * 256 + c; float o[8];
        const bool isw = col < 512; const float* bp = isw ? (w0 + col) : (a0 + col - 512);
        const f32x4 b0 = *(const f32x4*)bp, b1 = *(const f32x4*)(bp + 4); const float bb[8] = {b0.x, b0.y, b0.z, b0.w, b1.x, b1.y, b1.z, b1.w};
#pragma unroll
        for (int i = 0; i < 8; ++i) { const float e = __builtin_amdgcn_exp2f(fminf(-1.4426950408889634f * (bb[i] + v[i]), 120.f)); const float s = __builtin_amdgcn_rcpf(1.0f + e); o[i] = isw ? -0.60653065971263342f * s : s; }
        bf16* dst = isw ? (LW + row * 512 + col) : (A + row * 512 + col - 512);
        *(u32x4*)dst = pack8(o);
    } };
struct EpiPlain { bf16* O0; bf16* O1; int split, ld0, ld1;
    __device__ __forceinline__ void store8(const Unit& u, int r, int c, const float (&v)[8]) const {
        const size_t row = (size_t)u.pm * 256 + r; int col = u.pn * 256 + c;
        if (col < split) *(u32x4*)(O0 + row * ld0 + col) = pack8(v); else *(u32x4*)(O1 + row * ld1 + col - split) = pack8(v);
    } };
template <bool ACCUM> struct EpiBranch { bf16* MG; const bf16* SG; int goff;
    __device__ __forceinline__ void store8(const Unit& u, int r, int c, const float (&v)[8]) const {
        const size_t row = (size_t)u.pm * 256 + r; const int col = u.pn * 256 + c; float gt[8], o[8];
        unpack8(*(const u32x4*)(SG + row * 2048 + goff + col), gt);
#pragma unroll
        for (int i = 0; i < 8; ++i) gt[i] = sigmoidf_(gt[i]);
        if (ACCUM) { float p[8]; unpack8(*(const u32x4*)(MG + row * 1024 + col), p);
#pragma unroll
            for (int i = 0; i < 8; ++i) o[i] = p[i] + gt[i] * v[i]; }
        else {
#pragma unroll
            for (int i = 0; i < 8; ++i) o[i] = gt[i] * v[i]; }
        *(u32x4*)(MG + row * 1024 + col) = pack8(o);
    } };
struct EpiBranch2 { bf16* MG; const bf16* SG;
    __device__ __forceinline__ void mid8(const Unit& u, int r, int c, float (&v)[8]) const {
        const size_t row = (size_t)u.pm * 256 + r; const int col = u.pn * 256 + c; float gr[8], gm[8];
        unpack8(*(const u32x4*)(SG + row * 2048 + col), gr); unpack8(*(const u32x4*)(SG + row * 2048 + 1024 + col), gm);
#pragma unroll
        for (int i = 0; i < 8; ++i) v[i] *= (1.f + __builtin_amdgcn_exp2f(-1.4426950408889634f * gm[i])) * __builtin_amdgcn_rcpf(1.f + __builtin_amdgcn_exp2f(-1.4426950408889634f * gr[i]));
    }
    __device__ __forceinline__ void store8(const Unit& u, int r, int c, const float (&v)[8]) const {
        const size_t row = (size_t)u.pm * 256 + r; const int col = u.pn * 256 + c; float gm[8], o[8];
        unpack8(*(const u32x4*)(SG + row * 2048 + 1024 + col), gm);
#pragma unroll
        for (int i = 0; i < 8; ++i) o[i] = sigmoidf_(gm[i]) * v[i];
        *(u32x4*)(MG + row * 1024 + col) = pack8(o);
    } };
struct EpiOut { float* X1; const float* x; const float* mod;
    __device__ __forceinline__ void store8(const Unit& u, int r, int c, const float (&v)[8]) const {
        const size_t row = (size_t)u.pm * 256 + r; const int col = u.pn * 256 + c; const int b = (int)(row / SEQ);
        const float* gt = mod + b * 6144 + 2048 + col; const float* xr = x + row * 1024 + col; float* o = X1 + row * 1024 + col;
        const f32x4 g0 = *(const f32x4*)gt, g1 = *(const f32x4*)(gt + 4), x0 = *(const f32x4*)xr, x1 = *(const f32x4*)(xr + 4);
        *(f32x4*)o = (f32x4){x0.x + g0.x * v[0], x0.y + g0.y * v[1], x0.z + g0.z * v[2], x0.w + g0.w * v[3]};
        *(f32x4*)(o + 4) = (f32x4){x1.x + g1.x * v[4], x1.y + g1.y * v[5], x1.z + g1.z * v[6], x1.w + g1.w * v[7]};
    } };
struct EpiGateUp { bf16* HID;
    __device__ __forceinline__ void store8(const Unit& u, int r, int c, const float (&v)[8]) const {
        const size_t row = (size_t)u.pm * 256 + r; const int col = ((u.pn & 1) * 256 + c) >> 1;
        u32x2 w; w.x = pk2(siluf_(v[0]) * v[4], siluf_(v[1]) * v[5]); w.y = pk2(siluf_(v[2]) * v[6], siluf_(v[3]) * v[7]);
        *(u32x2*)(HID + row * 256 + col) = w;
    } };
struct EpiDownAtomic { float* out; const int* ent; const float* mod;
    __device__ __forceinline__ void store8(const Unit& u, int r, int c, const float (&v)[8]) const {
        const int e0 = ent[2 * (u.pm * 256 + r)]; if (e0 < 0) return; const float w = __builtin_bit_cast(float, ent[2 * (u.pm * 256 + r) + 1]);
        const int col = (u.pn & 3) * 256 + c, b = e0 / SEQ; const float* gt = mod + b * 6144 + 5120 + col; float* o = out + (size_t)e0 * 1024 + col;
        const f32x4 g0 = *(const f32x4*)gt, g1 = *(const f32x4*)(gt + 4);
        unsafeAtomicAdd(o + 0, g0.x * w * v[0]); unsafeAtomicAdd(o + 1, g0.y * w * v[1]); unsafeAtomicAdd(o + 2, g0.z * w * v[2]); unsafeAtomicAdd(o + 3, g0.w * w * v[3]);
        unsafeAtomicAdd(o + 4, g1.x * w * v[4]); unsafeAtomicAdd(o + 5, g1.y * w * v[5]); unsafeAtomicAdd(o + 6, g1.z * w * v[6]); unsafeAtomicAdd(o + 7, g1.w * w * v[7]);
    } };
struct EpiDown { bf16* YS;
    __device__ __forceinline__ void store8(const Unit& u, int r, int c, const float (&v)[8]) const {
        const size_t row = (size_t)u.pm * 256 + r; *(u32x4*)(YS + row * 1024 + (u.pn & 3) * 256 + c) = pack8(v);
    } };


namespace pg8 {
#define PG8_LAS __attribute__((address_space(3)))
typedef ::bf16x8 bf16x8; typedef ::f32x4 f32x4;
using ::Unit; using ::Gemm;
constexpr int BM = 256, BK = 64, HALF = 128, HTB = HALF * BK * 2  , STAGE_BYTES = 8 * HTB;

__device__ __forceinline__ int lds_byte(int r, int c) { const int st = (r >> 4) * 2 + (c >> 5), rr = r & 15, cc = c & 31, ob = rr * 64 + cc * 2; return st * 1024 + (ob ^ (((ob >> 9) & 1) << 5)); }
__device__ __forceinline__ void stage_rc(int b, int& R, int& C) { const int st = b / 1024, sb = b % 1024, swz = sb ^ (((sb >> 9) & 1) << 5); R = (st >> 1) * 16 + swz / 64; C = (st & 1) * 32 + (swz % 64) / 2; }
__device__ __forceinline__ int perm32(int rho) { const int n = rho >> 4, i = rho & 15; return 8 * (i >> 2) + 4 * n + (i & 3); }
template <class Epi, class Sched, bool ALIGN_EPI = false, bool SP2 = false, bool GATHER = false, bool MIDHOOK = false>
__device__ __forceinline__ void gemm_phase(PG8_LAS unsigned char* lds, const Gemm g, const Sched& S, const Epi& E, const int wave_in) {
    const int lane = lane_id_fresh(), wid = wave_in, tid = wid * 64 + lane,
              wr = wid >> 2, wc = wid & 3, fr = lane & 15, fq = lane >> 4;
    const int K = g.K, nt = K / BK;
    unsigned voffA[2], voffB[2];
#pragma unroll
    for (int i = 0; i < 2; ++i) { int R, C; stage_rc(tid * 16 + i * 8192, R, C); const int Rb = Epi::PERM ? ((R & ~31) + perm32(R & 31)) : R;
        voffA[i] = (unsigned)(R * K + C) * 2u; voffB[i] = (unsigned)(Rb * K + C) * 2u; }
    unsigned vAc[2][2] = {{0u, 0u}, {0u, 0u}}, vAn[2][2] = {{0u, 0u}, {0u, 0u}}; int gR[2] = {0, 0}; unsigned gC[2] = {0u, 0u};
    if constexpr (GATHER) {
#pragma unroll
        for (int i = 0; i < 2; ++i) { int R, C; stage_rc(tid * 16 + i * 8192, R, C); gR[i] = R; gC[i] = (unsigned)C * 2u; } }
#define PG8_GIDX(dst, pm_) do { _Pragma("unroll") for (int _h = 0; _h < 2; ++_h) _Pragma("unroll") for (int _i = 0; _i < 2; ++_i) \
        dst[_h][_i] = (unsigned)g.ridx[(pm_) * BM + _h * HALF + gR[_i]] * (unsigned)(K * 2) + gC[_i]; } while (0)
    const size_t kstep = (size_t)(BK * 2);
    const size_t hstep = (size_t)HALF * K * 2;
    const size_t tstep = 2 * hstep;
    const unsigned ldsw = (unsigned)wid * 1024u;
    const int aoff = lds_byte(wr * 64 + fr, fq * 8), boff = lds_byte(wc * 32 + fr, fq * 8);
#define PG8_SA(b, h) (((b) * 2 + (h)) * HTB)
#define PG8_SB(b, h) ((4 + (b) * 2 + (h)) * HTB)
#define PG8_STAGE(bufoff, gbase, voff) do { _Pragma("unroll") for (int _i = 0; _i < 2; ++_i) \
        __builtin_amdgcn_global_load_lds((const unsigned*)((const char*)(gbase) + (voff)[_i]), (PG8_LAS unsigned*)(lds + (bufoff) + ldsw + _i * 8192), 16, 0, 0); } while (0)
#define PG8_STAGE_A(bufoff, kptr, h, isnext) do { if constexpr (GATHER) { unsigned _v[2]; _v[0] = (isnext) ? vAn[h][0] : vAc[h][0]; _v[1] = (isnext) ? vAn[h][1] : vAc[h][1]; PG8_STAGE(bufoff, kptr, _v); } \
        else { PG8_STAGE(bufoff, (kptr) + (h) * hstep, voffA); } } while (0)
#define PG8_LDA(dst, b, h) do { _Pragma("unroll") for (int m = 0; m < 4; ++m) _Pragma("unroll") for (int k = 0; k < 2; ++k) dst[m][k] = *(const PG8_LAS bf16x8*)(lds + PG8_SA(b, h) + aoff + m * 2048 + k * 1024); } while (0)
#define PG8_LDB(dst, b, h) do { _Pragma("unroll") for (int n = 0; n < 2; ++n) _Pragma("unroll") for (int k = 0; k < 2; ++k) dst[n][k] = *(const PG8_LAS bf16x8*)(lds + PG8_SB(b, h) + boff + n * 2048 + k * 1024); } while (0)
#define PG8_MMA(ai, bj, At, Bt) do { __builtin_amdgcn_s_setprio(1); _Pragma("unroll") for (int m = 0; m < 4; ++m) _Pragma("unroll") for (int n = 0; n < 2; ++n) _Pragma("unroll") for (int k = 0; k < 2; ++k) \
        acc[ai][bj][m][n] = __builtin_amdgcn_mfma_f32_16x16x32_bf16(Bt[n][k], At[m][k], acc[ai][bj][m][n], 0, 0, 0); __builtin_amdgcn_s_setprio(0); } while (0)
#define PG8_WAIT_V(n) asm volatile("s_waitcnt vmcnt(" #n ")" ::: "memory")
#define PG8_WAIT_L(n) asm volatile("s_waitcnt lgkmcnt(" #n ")" ::: "memory")
#define PG8_BAR __builtin_amdgcn_s_barrier()
#define PG8_SCHED __builtin_amdgcn_sched_barrier(0)
    Unit cur, nxt; int ui = 0;
    if (!S.next(0, cur)) return;
    f32x4 acc[2][2][4][2];
#pragma unroll
    for (int a = 0; a < 2; ++a)
#pragma unroll
        for (int b = 0; b < 2; ++b)
#pragma unroll
            for (int m = 0; m < 4; ++m)
#pragma unroll
                for (int n = 0; n < 2; ++n) acc[a][b][m][n] = (f32x4){0.f, 0.f, 0.f, 0.f};
    bf16x8 At[4][2], B0[2][2], B1[2][2];
    const char* cA = (const char*)g.A + (GATHER ? (size_t)0 : (size_t)cur.pm * tstep); const char* cB = (const char*)g.Bt + (size_t)cur.pn * tstep;
    if constexpr (GATHER) PG8_GIDX(vAc, cur.pm);
    S.a_ready(cur);
    if constexpr (SP2) {
        PG8_STAGE(PG8_SB(0, 0), cB, voffB); PG8_STAGE(PG8_SB(0, 1), cB + hstep, voffB); PG8_STAGE_A(PG8_SA(0, 0), cA, 0, false); PG8_STAGE_A(PG8_SA(0, 1), cA, 1, false);
        if (wr == 1) PG8_BAR;
        PG8_WAIT_V(2); PG8_BAR;
        PG8_STAGE(PG8_SB(1, 0), cB + kstep, voffB); PG8_STAGE_A(PG8_SA(1, 0), cA + kstep, 0, false); PG8_STAGE(PG8_SB(1, 1), cB + hstep + kstep, voffB);
        PG8_WAIT_V(6); PG8_BAR;
    } else {
        PG8_STAGE(PG8_SB(0, 0), cB, voffB); PG8_STAGE(PG8_SA(0, 0), cA, voffA); PG8_STAGE(PG8_SB(0, 1), cB + hstep, voffB); PG8_STAGE(PG8_SA(0, 1), cA + hstep, voffA);
        if (wr == 1) PG8_BAR;
        PG8_WAIT_V(4); PG8_BAR;
        PG8_STAGE(PG8_SB(1, 0), cB + kstep, voffB); PG8_STAGE(PG8_SA(1, 0), cA + kstep, voffA); PG8_STAGE(PG8_SB(1, 1), cB + hstep + kstep, voffB);
        PG8_WAIT_V(6); PG8_BAR;
    }
    for (;;) {
        const bool has_next = S.next(ui + 1, nxt);
        const char* nA = (has_next && !GATHER) ? (const char*)g.A + (size_t)nxt.pm * tstep : cA; const char* nB = has_next ? (const char*)g.Bt + (size_t)nxt.pn * tstep : cB;
        if constexpr (GATHER) { if (has_next) PG8_GIDX(vAn, nxt.pm); else { _Pragma("unroll") for (int _h = 0; _h < 2; ++_h) { vAn[_h][0] = vAc[_h][0]; vAn[_h][1] = vAc[_h][1]; } } }
        for (int t = 0; t < nt; t += 2) {
            if constexpr (MIDHOOK) { if (t == nt / 2) { E.mid(acc, cur, wr, wc, fr, fq); PG8_WAIT_V(0); } }
            const bool last = (t == nt - 2);
            const char* a1 = cA + (size_t)(t + 1) * kstep;
            const char* a2 = last ? nA : cA + (size_t)(t + 2) * kstep; const char* b2 = last ? nB : cB + (size_t)(t + 2) * kstep;
            const char* a3 = a2 + kstep; const char* b3 = b2 + kstep;
            if (last && has_next) S.a_ready(nxt);
            if constexpr (SP2) {
            PG8_LDB(B0, 0, 0); PG8_LDB(B1, 0, 1); PG8_SCHED; PG8_LDA(At, 0, 0); PG8_STAGE_A(PG8_SA(1, 1), a1, 1, false);
            PG8_WAIT_V(8); PG8_WAIT_L(0); PG8_BAR; PG8_MMA(0, 0, At, B0); PG8_MMA(0, 1, At, B1); PG8_BAR; PG8_SCHED;
            PG8_LDA(At, 0, 1); PG8_STAGE(PG8_SB(0, 0), b2, voffB); PG8_STAGE(PG8_SB(0, 1), b2 + hstep, voffB); PG8_STAGE_A(PG8_SA(0, 0), a2, 0, last);
            PG8_WAIT_V(8); PG8_WAIT_L(0); PG8_BAR; PG8_MMA(1, 0, At, B0); PG8_MMA(1, 1, At, B1); PG8_BAR; PG8_SCHED;
            PG8_LDB(B0, 1, 0); PG8_LDB(B1, 1, 1); PG8_SCHED; PG8_LDA(At, 1, 0); PG8_STAGE_A(PG8_SA(0, 1), a2, 1, last);
            PG8_WAIT_V(8); PG8_WAIT_L(0); PG8_BAR; PG8_MMA(0, 0, At, B0); PG8_MMA(0, 1, At, B1); PG8_BAR; PG8_SCHED;
            PG8_LDA(At, 1, 1); PG8_STAGE(PG8_SB(1, 0), b3, voffB); PG8_STAGE(PG8_SB(1, 1), b3 + hstep, voffB); PG8_STAGE_A(PG8_SA(1, 0), a3, 0, last);
            PG8_WAIT_V(8); PG8_WAIT_L(0); PG8_BAR; PG8_MMA(1, 0, At, B0); PG8_MMA(1, 1, At, B1); PG8_BAR; PG8_SCHED;
            } else {
            PG8_LDB(B0, 0, 0); PG8_SCHED; PG8_LDA(At, 0, 0); PG8_STAGE(PG8_SA(1, 1), a1 + hstep, voffA);
            PG8_WAIT_L(8); PG8_BAR; PG8_WAIT_L(0); PG8_MMA(0, 0, At, B0); PG8_BAR; PG8_SCHED;
            PG8_LDB(B1, 0, 1); PG8_STAGE(PG8_SB(0, 0), b2, voffB);
            PG8_BAR; PG8_WAIT_L(0); PG8_MMA(0, 1, At, B1); PG8_BAR;
            PG8_LDA(At, 0, 1); PG8_STAGE(PG8_SA(0, 0), a2, voffA);
            PG8_BAR; PG8_WAIT_L(0); PG8_MMA(1, 0, At, B0); PG8_BAR; PG8_SCHED;
            PG8_STAGE(PG8_SB(0, 1), b2 + hstep, voffB);
            PG8_WAIT_V(6); PG8_BAR; PG8_MMA(1, 1, At, B1); PG8_BAR;
            PG8_LDB(B0, 1, 0); PG8_SCHED; PG8_LDA(At, 1, 0); PG8_STAGE(PG8_SA(0, 1), a2 + hstep, voffA);
            PG8_WAIT_L(8); PG8_BAR; PG8_WAIT_L(0); PG8_MMA(0, 0, At, B0); PG8_BAR; PG8_SCHED;
            PG8_LDB(B1, 1, 1); PG8_STAGE(PG8_SB(1, 0), b3, voffB);
            PG8_BAR; PG8_WAIT_L(0); PG8_MMA(0, 1, At, B1); PG8_BAR;
            PG8_LDA(At, 1, 1); PG8_STAGE(PG8_SA(1, 0), a3, voffA);
            PG8_BAR; PG8_WAIT_L(0); PG8_MMA(1, 0, At, B0); PG8_BAR; PG8_SCHED;
            PG8_STAGE(PG8_SB(1, 1), b3 + hstep, voffB);
            PG8_WAIT_V(6); PG8_BAR; PG8_MMA(1, 1, At, B1); PG8_BAR;
            }
        }
        if constexpr (ALIGN_EPI) { if (wr == 0) PG8_BAR; }
        if constexpr (!Epi::AFTER_DRAIN) { E(acc, cur, wr, wc, fr, fq); S.done(cur); }
        if (!has_next) break;
#pragma unroll
        for (int a = 0; a < 2; ++a)
#pragma unroll
            for (int b = 0; b < 2; ++b)
#pragma unroll
                for (int m = 0; m < 4; ++m)
#pragma unroll
                    for (int n = 0; n < 2; ++n) acc[a][b][m][n] = (f32x4){0.f, 0.f, 0.f, 0.f};
        cur = nxt; cA = nA; cB = nB; ++ui;
        if constexpr (GATHER) { _Pragma("unroll") for (int _h = 0; _h < 2; ++_h) { vAc[_h][0] = vAn[_h][0]; vAc[_h][1] = vAn[_h][1]; } }
        if constexpr (ALIGN_EPI) { if (wr == 1) PG8_BAR; }
    }
    PG8_WAIT_V(0);
    if constexpr (!ALIGN_EPI) { if (wr == 0) PG8_BAR; }
    PG8_BAR;
    if constexpr (Epi::AFTER_DRAIN) { E.fused(acc, cur, wr, wc, fr, fq, lds, wid, lane); S.done(cur); }
#undef PG8_SA
#undef PG8_SB
#undef PG8_STAGE
#undef PG8_STAGE_A
#undef PG8_GIDX
#undef PG8_LDA
#undef PG8_LDB
#undef PG8_MMA
#undef PG8_WAIT_V
#undef PG8_WAIT_L
#undef PG8_BAR
#undef PG8_SCHED
}

template <class F> struct EpiAdapt {
    static constexpr bool PERM = true, AFTER_DRAIN = false; F f;
    __device__ __forceinline__ void mid(f32x4 (&acc)[2][2][4][2], const Unit& u, int wr, int wc, int fr, int fq) const {
        asm volatile("" : "+v"(fr), "+v"(fq));
#pragma unroll
        for (int ai = 0; ai < 2; ++ai)
#pragma unroll
            for (int m = 0; m < 4; ++m) { const int row = ai * HALF + wr * 64 + m * 16 + fr;
#pragma unroll
                for (int bj = 0; bj < 2; ++bj) { float v[8] = {acc[ai][bj][m][0][0], acc[ai][bj][m][0][1], acc[ai][bj][m][0][2], acc[ai][bj][m][0][3], acc[ai][bj][m][1][0], acc[ai][bj][m][1][1], acc[ai][bj][m][1][2], acc[ai][bj][m][1][3]};
                    f.mid8(u, row, bj * HALF + wc * 32 + 8 * fq, v);
                    acc[ai][bj][m][0] = (f32x4){v[0], v[1], v[2], v[3]}; acc[ai][bj][m][1] = (f32x4){v[4], v[5], v[6], v[7]}; } }
    }
    __device__ __forceinline__ void operator()(const f32x4 (&acc)[2][2][4][2], const Unit& u, int wr, int wc, int fr, int fq) const {
        asm volatile("" : "+v"(fr), "+v"(fq));
#pragma unroll
        for (int ai = 0; ai < 2; ++ai)
#pragma unroll
            for (int m = 0; m < 4; ++m) { const int row = ai * HALF + wr * 64 + m * 16 + fr;
#pragma unroll
                for (int bj = 0; bj < 2; ++bj) { const f32x4 v0 = acc[ai][bj][m][0], v1 = acc[ai][bj][m][1];
                    const float v[8] = {v0[0], v0[1], v0[2], v0[3], v1[0], v1[1], v1[2], v1[3]};
                    f.store8(u, row, bj * HALF + wc * 32 + 8 * fq, v); } }
    }
};
}

template <class Epi, class Sched>
__device__ __forceinline__ void gemm_phase_mid(LAS unsigned char* lds, const Gemm g, const Sched& S, const Epi& E, const int wave_in) {
    pg8::EpiAdapt<Epi> EA{E};
    pg8::gemm_phase<pg8::EpiAdapt<Epi>, Sched, true, true, false, true>(lds, g, S, EA, wave_in);
}
template <class Epi, class Sched>
__device__ __forceinline__ void gemm_phase_gather(LAS unsigned char* lds, const Gemm g, const Sched& S, const Epi& E, const int wave_in) {
    pg8::EpiAdapt<Epi> EA{E};
    pg8::gemm_phase<pg8::EpiAdapt<Epi>, Sched, true, true, true>(lds, g, S, EA, wave_in);
}
template <class Epi, class Sched>
__device__ __forceinline__ void gemm_phase_any(LAS unsigned char* lds, const Gemm g, const Sched& S, const Epi& E, const int wave_in) {
#if ENG_GEMM == 1
    pg8::EpiAdapt<Epi> EA{E};
    pg8::gemm_phase<pg8::EpiAdapt<Epi>, Sched, true, true>(lds, g, S, EA, wave_in);
#else
    gemm_phase_naive<Epi, Sched>(lds, g, S, E);
#endif
}

template <class RowMap>
__device__ __forceinline__ void transpose_item(const float* W, int ldw, bf16* WT, int ldt, int koff, int k0, int n0, const RowMap& rm, LAS float* scr, int lane) {
#pragma unroll 8
    for (int i = 0; i < 32; ++i) { const int kk = 2 * i + (lane >> 5); scr[kk * 33 + (lane & 31)] = W[(size_t)(k0 + kk) * ldw + n0 + (lane & 31)]; }
    asm volatile("s_waitcnt lgkmcnt(0)" ::: "memory");
    const int c = lane & 7;
#pragma unroll
    for (int j = 0; j < 4; ++j) { const int n = (lane >> 3) + 8 * j; const LAS float* s = scr + (8 * c) * 33 + n;
        u32x4 o; o.x = pk2(s[0 * 33], s[1 * 33]); o.y = pk2(s[2 * 33], s[3 * 33]); o.z = pk2(s[4 * 33], s[5 * 33]); o.w = pk2(s[6 * 33], s[7 * 33]);
        *(u32x4*)(WT + (size_t)rm(n0 + n) * ldt + koff + k0 + 8 * c) = o; }
    asm volatile("s_waitcnt lgkmcnt(0)" ::: "memory");
}
struct RmId { int off; __device__ int operator()(int n) const { return off + n; } };
struct RmWin { __device__ int operator()(int n) const { return n < 1792 ? n : (n < 2208 ? 3840 + (n - 1792) : 1792 + (n - 2208)); } };
struct RmUkv { __device__ int operator()(int n) const { const int h = n >> 7, j = n & 127; return j < 64 ? h * 64 + j : 512 + h * 64 + (j - 64); } };
struct RmGU { int off; __device__ int operator()(int j) const { return off + 8 * (j >> 2) + (j & 3); } };

__device__ __forceinline__ void p0_prologue(const Frame& F, ArgsP a) {
    const int lane_f = lane_id_fresh(), tid_f = F.wave * 64 + lane_f;
    LAS float* scr = (LAS float*)(F.lds + F.wave * 16384);
    const int lane = lane_f;
    bf16* Win = (bf16*)(F.ws + WS_WIN); bf16* Wblk = (bf16*)(F.ws + WS_WBLK); bf16* Wg = (bf16*)(F.ws + WS_WG); bf16* Wuq = (bf16*)(F.ws + WS_WUQ);
    bf16* Wukv = (bf16*)(F.ws + WS_WUKV); bf16* Wb = (bf16*)(F.ws + WS_WB); bf16* Wo = (bf16*)(F.ws + WS_WO); bf16* Wgu = (bf16*)(F.ws + WS_WGU); bf16* Wdn = (bf16*)(F.ws + WS_WDN);
    constexpr int I_IN = 16 * 133, I_DEC = 1 * 16, I_AUP = 16, I_GUP = 2 * 16, I_UQ = 4 * 24, I_UKV = 2 * 32, I_BR = 2 * 8 * 32, I_O = 16 * 32;
    constexpr int I_EG = 32 * 16 * 8, I_EU = I_EG, I_ED = 32 * 4 * 32;
    constexpr int NITEMS = I_IN + I_DEC + I_AUP + I_GUP + I_UQ + I_UKV + I_BR + I_O + I_EG + I_EU + I_ED;
    for (int it = F.gw; it < NITEMS; it += F.NGW) {
        int r = it;
        if (r < I_IN) { const int kb = r / 133, nb = r % 133; transpose_item(a->in[I_WIN], D_IN, Win, 1024, 0, 64 * kb, 32 * nb, RmWin{}, scr, lane); continue; } r -= I_IN;
        if (r < I_DEC) { transpose_item(a->in[I_WDEC], 512, Wblk, 128, 0, 0, 32 * r, RmId{0}, scr, lane); continue; } r -= I_DEC;
        if (r < I_AUP) { transpose_item(a->in[I_WAUP], 512, Wblk, 128, 64, 0, 32 * r, RmId{512}, scr, lane); continue; } r -= I_AUP;
        if (r < I_GUP) { const int kb = r / 16, nb = r % 16; transpose_item(a->in[I_WGUP], 512, Wg, 128, 0, 64 * kb, 32 * nb, RmId{0}, scr, lane); continue; } r -= I_GUP;
        if (r < I_UQ) { const int kb = r / 24, nb = r % 24; transpose_item(a->in[I_WUQ], 768, Wuq, 256, 0, 64 * kb, 32 * nb, RmId{0}, scr, lane); continue; } r -= I_UQ;
        if (r < I_UKV) { const int kb = r / 32, nb = r % 32; transpose_item(a->in[I_WUKV], 1024, Wukv, 128, 0, 64 * kb, 32 * nb, RmUkv{}, scr, lane); continue; } r -= I_UKV;
        if (r < I_BR) { const int br = r / 256, q = r % 256, kb = q / 32, nb = q % 32; transpose_item(a->in[I_WBR] + (size_t)br * 512 * 1024, 1024, Wb, 1024, 512 * br, 64 * kb, 32 * nb, RmId{0}, scr, lane); continue; } r -= I_BR;
        if (r < I_O) { const int kb = r / 32, nb = r % 32; transpose_item(a->in[I_WOUT], 1024, Wo, 1024, 0, 64 * kb, 32 * nb, RmId{0}, scr, lane); continue; } r -= I_O;
        if (r < I_EG) { const int e = r / 128, q = r % 128, kb = q / 8, nb = q % 8; transpose_item(a->in[I_WEG] + (size_t)e * 1024 * 256, 256, Wgu + (size_t)e * 512 * 1024, 1024, 0, 64 * kb, 32 * nb, RmGU{0}, scr, lane); continue; } r -= I_EG;
        if (r < I_EU) { const int e = r / 128, q = r % 128, kb = q / 8, nb = q % 8; transpose_item(a->in[I_WEU] + (size_t)e * 1024 * 256, 256, Wgu + (size_t)e * 512 * 1024, 1024, 0, 64 * kb, 32 * nb, RmGU{4}, scr, lane); continue; } r -= I_EU;
        { const int e = r / 128, q = r % 128, kb = q / 32, nb = q % 32; transpose_item(a->in[I_WED] + (size_t)e * 256 * 1024, 1024, Wdn + (size_t)e * 1024 * 256, 256, 0, 64 * kb, 32 * nb, RmId{0}, scr, lane); }
    }
    for (int i = F.gw * 64 + lane; i < 96 * 128; i += F.NGW * 64) *(u32x4*)(Win + (size_t)4256 * 1024 + (size_t)i * 8) = (u32x4){0u, 0u, 0u, 0u};
    for (int i = F.gw * 64 + lane; i < 1024 * 8; i += F.NGW * 64) { const int row = i >> 3, c8 = (i & 7) * 8; *(u32x4*)(Wblk + row * 128 + (row < 512 ? 64 : 0) + c8) = (u32x4){0u, 0u, 0u, 0u}; }
    { const int* pos = (const int*)a->in[I_POS]; float* cs = (float*)(F.ws + WS_CS);
      for (int i = F.gw * 64 + lane; i < NTOK * 16; i += F.NGW * 64) { const int t = i >> 4, j = i & 15;
          const float fr = exp2f(-(float)j * (13.287712379549449f / 16.0f));
          const float ang = (float)pos[t] * fr; cs[t * 32 + j] = cosf(ang); cs[t * 32 + 16 + j] = sinf(ang); } }
    { float* mod = (float*)(F.ws + WS_MOD); const float* c = a->in[I_C]; const float* wa = a->in[I_WADA]; const float* ba = a->in[I_BADA];
      LAS float* red = (LAS float*)(F.lds + 8 * 16384);
      for (int nb = F.vcu; nb < 96; nb += F.G) {
          float acc[8];
#pragma unroll
          for (int b = 0; b < 8; ++b) acc[b] = 0.f;
          const int n = nb * 64 + lane;
          for (int k = F.wave * 128; k < F.wave * 128 + 128; ++k) { const float w = wa[(size_t)k * 6144 + n];
#pragma unroll
              for (int b = 0; b < 8; ++b) acc[b] = fmaf(siluf_(c[b * 1024 + k]), w, acc[b]); }
#pragma unroll
          for (int b = 0; b < 8; ++b) red[(F.wave * 8 + b) * 64 + lane] = acc[b];
          __syncthreads();
          { const int b = F.wave; float s = ba[n];
#pragma unroll
            for (int w = 0; w < 8; ++w) s += red[(w * 8 + b) * 64 + lane];
            mod[b * 6144 + n] = s; }
          __syncthreads();
      } }
}

__device__ __forceinline__ void p_normmod(const Frame& F, const float* x, const float* g, const float* mod, int sh_off, int sc_off, bf16* H) {
    const int lane_f = lane_id_fresh();
    f32x4 xa[4], xb[4];
    { const f32x4* xr = (const f32x4*)(x + (size_t)F.gw * 1024) + lane_f;
#pragma unroll
      for (int j = 0; j < 4; ++j) xa[j] = xr[64 * j]; }
    f32x4 gs[4], sh[4]; int bcur = -1;
#define NM_ROW(CUR, NXT, m_) do { const int mm = (m_); const int b = mm / SEQ; \
        if (b != bcur) { bcur = b; \
            _Pragma("unroll") for (int j = 0; j < 4; ++j) { const int col = 4 * lane_f + 256 * j; gs[j] = *(const f32x4*)(g + col) * (*(const f32x4*)(mod + b * 6144 + sc_off + col) + 1.0f); sh[j] = *(const f32x4*)(mod + b * 6144 + sh_off + col); } \
            asm volatile("s_waitcnt vmcnt(0)" : "+v"(gs[0]), "+v"(gs[1]), "+v"(gs[2]), "+v"(gs[3]), "+v"(sh[0]), "+v"(sh[1]), "+v"(sh[2]), "+v"(sh[3]), "+v"(CUR[0]), "+v"(CUR[1]), "+v"(CUR[2]), "+v"(CUR[3])); } \
        { const int mn = (mm + F.NGW < NTOK) ? mm + F.NGW : mm; const f32x4* xr = (const f32x4*)(x + (size_t)mn * 1024) + lane_f; \
          _Pragma("unroll") for (int j = 0; j < 4; ++j) NXT[j] = xr[64 * j]; } \
        float s = 0.f; \
        _Pragma("unroll") for (int j = 0; j < 4; ++j) s += (CUR[j].x * CUR[j].x + CUR[j].y * CUR[j].y) + (CUR[j].z * CUR[j].z + CUR[j].w * CUR[j].w); \
        const float rstd = 1.0f / sqrtf(wave_sum(s) * (1.f / 1024.f) + EPS); \
        u32x2* o = (u32x2*)(H + (size_t)mm * 1024) + lane_f; \
        _Pragma("unroll") for (int j = 0; j < 4; ++j) { const f32x4 y = CUR[j] * rstd * gs[j] + sh[j]; u32x2 w; w.x = pk2(y.x, y.y); w.y = pk2(y.z, y.w); o[64 * j] = w; } } while (0)
    for (int m = F.gw; m < NTOK; m += 2 * F.NGW) {
        NM_ROW(xa, xb, m);
        if (m + F.NGW < NTOK) NM_ROW(xb, xa, m + F.NGW);
    }
#undef NM_ROW
}

__device__ __forceinline__ void p_prep_a(const Frame& F, ArgsP a) {
    const int lane_f = lane_id_fresh();
    const bf16* ZR = (const bf16*)(F.ws + WS_ZR); const bf16* ZM = (const bf16*)(F.ws + WS_ZM);
    bf16* TWA = (bf16*)(F.ws + WS_TWA); bf16* SGL = (bf16*)(F.ws + WS_SGL); bf16* QA = (bf16*)(F.ws + WS_QA); bf16* KVA = (bf16*)(F.ws + WS_KVA);
    const float* mu = a->in[I_MU]; const float* gqa = a->in[I_GQA]; const float* gkva = a->in[I_GKVA];
    const int lane = lane_f;
    const f32x4 mm = *(const f32x4*)(mu + 1536 + 4 * lane), gq = *(const f32x4*)(gqa + 4 * lane), gk = *(const f32x4*)(gkva + 4 * (lane & 31));
    for (int m = F.gw; m < NTOK; m += F.NGW) {
        const bool first = (m % SEQ) == 0;
        { const u32x2 c = *((const u32x2*)(ZR + (size_t)m * 1792 + 1536) + lane); u32x2 p = *((const u32x2*)(ZR + (size_t)(first ? m : m - 1) * 1792 + 1536) + lane); if (first) { p.x = 0u; p.y = 0u; }
          float z[4] = {lo2f(c.x), hi2f(c.x), lo2f(c.y), hi2f(c.y)}; const float q[4] = {lo2f(p.x), hi2f(p.x), lo2f(p.y), hi2f(p.y)};
          z[0] += (q[0] - z[0]) * mm.x; z[1] += (q[1] - z[1]) * mm.y; z[2] += (q[2] - z[2]) * mm.z; z[3] += (q[3] - z[3]) * mm.w;
          if (lane < 16) { u32x2 w; w.x = pk2(tanhf(z[0]), tanhf(z[1])); w.y = pk2(tanhf(z[2]), tanhf(z[3])); *((u32x2*)(TWA + (size_t)m * 128) + lane) = w; }
          else if (lane < 32) { u32x2 w; w.x = pk2(z[0], z[1]); w.y = pk2(z[2], z[3]); *((u32x2*)(TWA + (size_t)m * 128) + lane) = w; }
          else { u32x2 w; w.x = pk2(sigmoidf_(z[0]), sigmoidf_(z[1])); w.y = pk2(sigmoidf_(z[2]), sigmoidf_(z[3])); *((u32x2*)(SGL + (size_t)m * 128) + (lane - 32)) = w; } }
        { const u32x2 c = *((const u32x2*)(ZM + (size_t)m * 512) + lane); const float z[4] = {lo2f(c.x), hi2f(c.x), lo2f(c.y), hi2f(c.y)};
          u32x2 c2 = (u32x2){0u, 0u}; if (lane < 32) c2 = *((const u32x2*)(ZM + (size_t)m * 512 + 256) + lane); const float y[4] = {lo2f(c2.x), hi2f(c2.x), lo2f(c2.y), hi2f(c2.y)};
          const float rstd = 1.0f / sqrtf(wave_sum((z[0] * z[0] + z[1] * z[1]) + (z[2] * z[2] + z[3] * z[3])) * (1.f / 256.f) + EPS);
          const float rstd2 = 1.0f / sqrtf(wave_sum((y[0] * y[0] + y[1] * y[1]) + (y[2] * y[2] + y[3] * y[3])) * (1.f / 128.f) + EPS);
          u32x2 w; w.x = pk2(z[0] * rstd * gq.x, z[1] * rstd * gq.y); w.y = pk2(z[2] * rstd * gq.z, z[3] * rstd * gq.w);
          *((u32x2*)(QA + (size_t)m * 256) + lane) = w;
          if (lane < 32) { u32x2 w2; w2.x = pk2(y[0] * rstd2 * gk.x, y[1] * rstd2 * gk.y); w2.y = pk2(y[2] * rstd2 * gk.z, y[3] * rstd2 * gk.w);
              *((u32x2*)(KVA + (size_t)m * 128) + lane) = w2; } }
    }
}

__device__ __forceinline__ void p_prep_c(const Frame& F, ArgsP a) {
    const int lane_f = lane_id_fresh(), tid_f = F.wave * 64 + lane_f;
    bf16* Q = (bf16*)(F.dob + DO_Q); const bf16* KN = (const bf16*)(F.dob + DO_KN); const bf16* ZM = (const bf16*)(F.ws + WS_ZM); bf16* KC = (bf16*)(F.ws + WS_KC);
    const float* cs = (const float*)(F.ws + WS_CS);
    const float* qn = a->in[I_QN]; const float* kn = a->in[I_KN];
    const int lane = lane_f, hd = lane >> 3, j = lane & 7;
    for (int m = F.gw; m < NTOK; m += F.NGW) {
        const f32x2 cc = *(const f32x2*)(cs + (size_t)m * 32 + 2 * j), sn = *(const f32x2*)(cs + (size_t)m * 32 + 16 + 2 * j);
        { bf16* qp = Q + (size_t)m * 768 + hd * 96; float v[8]; unpack8(*(const u32x4*)(qp + 8 * j), v);
          const unsigned w1 = *(const unsigned*)(qp + 64 + 2 * j), w2 = *(const unsigned*)(qp + 80 + 2 * j); float x1[2] = {lo2f(w1), hi2f(w1)}, x2[2] = {lo2f(w2), hi2f(w2)};
          float ss = (x1[0] * x1[0] + x1[1] * x1[1]) + (x2[0] * x2[0] + x2[1] * x2[1]);
#pragma unroll
          for (int i = 0; i < 8; ++i) ss += v[i] * v[i];
          const float rstd = 1.0f / sqrtf(sum8(ss) * (1.f / 96.f) + EPS);
#pragma unroll
          for (int i = 0; i < 8; ++i) v[i] = v[i] * rstd * qn[8 * j + i] * QSCALE;
          x1[0] *= rstd * qn[64 + 2 * j]; x1[1] *= rstd * qn[65 + 2 * j]; x2[0] *= rstd * qn[80 + 2 * j]; x2[1] *= rstd * qn[81 + 2 * j];
          const float o1a = (x1[0] * cc.x - x2[0] * sn.x) * QSCALE, o1b = (x1[1] * cc.y - x2[1] * sn.y) * QSCALE, o2a = (x2[0] * cc.x + x1[0] * sn.x) * QSCALE, o2b = (x2[1] * cc.y + x1[1] * sn.y) * QSCALE;
          *(u32x4*)(qp + 8 * j) = pack8(v); *(unsigned*)(qp + 64 + 2 * j) = pk2(o1a, o1b); *(unsigned*)(qp + 80 + 2 * j) = pk2(o2a, o2b); }
        { float v[8]; unpack8(*(const u32x4*)(KN + (size_t)m * 512 + hd * 64 + 8 * j), v);
          const unsigned w1 = *(const unsigned*)(ZM + (size_t)m * 512 + 384 + 2 * j), w2 = *(const unsigned*)(ZM + (size_t)m * 512 + 400 + 2 * j); float x1[2] = {lo2f(w1), hi2f(w1)}, x2[2] = {lo2f(w2), hi2f(w2)};
          float ss = (x1[0] * x1[0] + x1[1] * x1[1]) + (x2[0] * x2[0] + x2[1] * x2[1]);
#pragma unroll
          for (int i = 0; i < 8; ++i) ss += v[i] * v[i];
          const float rstd = 1.0f / sqrtf(sum8(ss) * (1.f / 96.f) + EPS);
#pragma unroll
          for (int i = 0; i < 8; ++i) v[i] = v[i] * rstd * kn[8 * j + i];
          x1[0] *= rstd * kn[64 + 2 * j]; x1[1] *= rstd * kn[65 + 2 * j]; x2[0] *= rstd * kn[80 + 2 * j]; x2[1] *= rstd * kn[81 + 2 * j];
          bf16* kp = KC + (size_t)m * 768 + hd * 96;
          *(u32x4*)(kp + 8 * j) = pack8(v); *(unsigned*)(kp + 64 + 2 * j) = pk2(x1[0] * cc.x - x2[0] * sn.x, x1[1] * cc.y - x2[1] * sn.y);
          *(unsigned*)(kp + 80 + 2 * j) = pk2(x2[0] * cc.x + x1[0] * sn.x, x2[1] * cc.y + x1[1] * sn.y); }
    }
}

constexpr int SC_T = 32;
constexpr int SC_BUF = 5 * SC_T * 64 * 4 + SC_T * 16 * 4 + SC_T * 16 * 4;
struct ScanRaw { u32x2 rc[2], rp[2], kc[2], kp[2], av[2], lw[2]; u32x4 vc, vp; };
__device__ __forceinline__ void scan_issue(ScanRaw& R, const bf16* ZR, const bf16* A, const bf16* LW, size_t row0, int t0, int st2, int col, int s2, int cv, bool dov) {
#pragma unroll
    for (int u = 0; u < 2; ++u) { const int tt = t0 + st2 + 16 * u; const size_t g = row0 + tt; const size_t gp = row0 + (tt > 0 ? tt - 1 : 0);
        R.rc[u] = *(const u32x2*)(ZR + g * 1792 + col); R.rp[u] = *(const u32x2*)(ZR + gp * 1792 + col);
        R.kc[u] = *(const u32x2*)(ZR + g * 1792 + 512 + col); R.kp[u] = *(const u32x2*)(ZR + gp * 1792 + 512 + col);
        R.av[u] = *(const u32x2*)(A + g * 512 + col); R.lw[u] = *(const u32x2*)(LW + g * 512 + col); }
    { const int tv = t0 + (dov ? s2 : 0); const size_t gv = row0 + tv; const size_t gvp = row0 + (tv > 0 ? tv - 1 : 0); R.vc = *(const u32x4*)(ZR + gv * 1792 + 1024 + cv); R.vp = *(const u32x4*)(ZR + gvp * 1792 + 1024 + cv); }
}
__device__ __forceinline__ void p_scan(const Frame& F, ArgsP a) {
    const int lane_f = lane_id_fresh(), tid_f = F.wave * 64 + lane_f;
    const bf16* ZR = (const bf16*)(F.ws + WS_ZR); const bf16* A = (const bf16*)(F.ws + WS_A); const bf16* LW = (const bf16*)(F.ws + WS_LW); bf16* Y = (bf16*)(F.ws + WS_Y);
    const float* mu = a->in[I_MU]; const float* k_k = a->in[I_KK]; const float* k_a = a->in[I_KA];
    const int lane = lane_f, wave = F.wave, tid = tid_f;
    for (int item = F.vcu; item < 256; item += F.G) {
        const int bh = item >> 2, qt = item & 3, b = bh >> 3, h = bh & 7;
        const size_t row0 = (size_t)b * SEQ; const int colh = h * 64;
        const int NCH = SEQ / SC_T;
        __syncthreads();
        if (wave >= 4) {
            const int lt = tid - 256, st2 = lt >> 4, j4 = (lt & 15) * 4, col = colh + j4, s2 = lt >> 1, hf = lt & 1, cv = colh + qt * 16 + hf * 8; const bool dov = lt < 64;
            f32x4 mur = *(const f32x4*)(mu + col), muk = *(const f32x4*)(mu + 512 + col), kkc = *(const f32x4*)(k_k + col), kac = *(const f32x4*)(k_a + col);
            f32x4 m0 = *(const f32x4*)(mu + 1024 + cv), m1 = *(const f32x4*)(mu + 1024 + cv + 4);
            asm volatile("" : "+v"(mur), "+v"(muk), "+v"(kkc), "+v"(kac), "+v"(m0), "+v"(m1));
            ScanRaw R0, R1;
            scan_issue(R0, ZR, A, LW, row0, 0, st2, col, s2, cv, dov);
#define SCAN_BUILD(RR, c_) do { LAS unsigned char* bs = F.lds + ((c_) & 1) * SC_BUF; \
                _Pragma("unroll") for (int u = 0; u < 2; ++u) { const int st = st2 + 16 * u; const bool t0_ = ((c_) * SC_T + st) == 0; \
                    const f32x4 rc = {lo2f(RR.rc[u].x), hi2f(RR.rc[u].x), lo2f(RR.rc[u].y), hi2f(RR.rc[u].y)}; f32x4 rp = {lo2f(RR.rp[u].x), hi2f(RR.rp[u].x), lo2f(RR.rp[u].y), hi2f(RR.rp[u].y)}; \
                    const f32x4 kc = {lo2f(RR.kc[u].x), hi2f(RR.kc[u].x), lo2f(RR.kc[u].y), hi2f(RR.kc[u].y)}; f32x4 kp = {lo2f(RR.kp[u].x), hi2f(RR.kp[u].x), lo2f(RR.kp[u].y), hi2f(RR.kp[u].y)}; \
                    const f32x4 av = {lo2f(RR.av[u].x), hi2f(RR.av[u].x), lo2f(RR.av[u].y), hi2f(RR.av[u].y)}; const f32x4 lw = {lo2f(RR.lw[u].x), hi2f(RR.lw[u].x), lo2f(RR.lw[u].y), hi2f(RR.lw[u].y)}; \
                    if (t0_) { rp = (f32x4){0.f, 0.f, 0.f, 0.f}; kp = rp; } \
                    const f32x4 r = rc + (rp - rc) * mur, zk = kc + (kp - kc) * muk, kq = zk * ((av - 1.0f) * kac + 1.0f), kr = zk * kkc; \
                    const float ss = allsum16((kr.x * kr.x + kr.y * kr.y) + (kr.z * kr.z + kr.w * kr.w)); const float inv = 1.0f / fmaxf(sqrtf(ss), 1e-12f); \
                    const f32x4 kk = kr * inv; const f32x4 wv = {__expf(lw.x), __expf(lw.y), __expf(lw.z), __expf(lw.w)}; \
                    LAS float* dst = (LAS float*)bs + st * 64 + j4; \
                    *(LAS f32x4*)dst = wv; *(LAS f32x4*)(dst + SC_T * 64) = -kk; *(LAS f32x4*)(dst + 2 * SC_T * 64) = kk * av; *(LAS f32x4*)(dst + 3 * SC_T * 64) = kq; *(LAS f32x4*)(dst + 4 * SC_T * 64) = r; } \
                if (dov) { float vc[8], vp[8]; unpack8(RR.vc, vc); unpack8(RR.vp, vp); if ((c_) * SC_T + s2 == 0) { _Pragma("unroll") for (int i = 0; i < 8; ++i) vp[i] = 0.f; } \
                    LAS float* dv = (LAS float*)(bs + 5 * SC_T * 256) + s2 * 16 + hf * 8; \
                    *(LAS f32x4*)dv = (f32x4){vc[0] + (vp[0] - vc[0]) * m0.x, vc[1] + (vp[1] - vc[1]) * m0.y, vc[2] + (vp[2] - vc[2]) * m0.z, vc[3] + (vp[3] - vc[3]) * m0.w}; \
                    *(LAS f32x4*)(dv + 4) = (f32x4){vc[4] + (vp[4] - vc[4]) * m1.x, vc[5] + (vp[5] - vc[5]) * m1.y, vc[6] + (vp[6] - vc[6]) * m1.z, vc[7] + (vp[7] - vc[7]) * m1.w}; } } while (0)
#define SCAN_FLUSH(c_) do { if ((c_) >= 2 && dov) { LAS unsigned char* bs = F.lds + ((c_) & 1) * SC_BUF; const LAS float* yy = (const LAS float*)(bs + 5 * SC_T * 256 + SC_T * 64) + s2 * 16 + hf * 8; \
                const f32x4 y0 = *(const LAS f32x4*)yy, y1 = *(const LAS f32x4*)(yy + 4); const float v[8] = {y0.x, y0.y, y0.z, y0.w, y1.x, y1.y, y1.z, y1.w}; \
                *(u32x4*)(Y + (row0 + (size_t)((c_) - 2) * SC_T + s2) * 512 + cv) = pack8(v); } } while (0)
            for (int c = 0; c <= NCH + 1; c += 2) {
                SCAN_FLUSH(c);
                scan_issue(R1, ZR, A, LW, row0, (c + 1 < NCH ? c + 1 : NCH - 1) * SC_T, st2, col, s2, cv, dov);
                if (c < NCH) SCAN_BUILD(R0, c);
                LDS_BAR();
                SCAN_FLUSH(c + 1);
                scan_issue(R0, ZR, A, LW, row0, (c + 2 < NCH ? c + 2 : NCH - 1) * SC_T, st2, col, s2, cv, dov);
                if (c + 1 < NCH) SCAN_BUILD(R1, c + 1);
                LDS_BAR();
            }
#undef SCAN_BUILD
#undef SCAN_FLUSH
        } else {
            const int rg = lane >> 4, jl = lane & 15;
            f32x2 Sa = {0.f, 0.f}, Sb = {0.f, 0.f};
            for (int c = 0; c <= NCH + 1; c += 2) {
#pragma unroll
                for (int half = 0; half < 2; ++half) {
                    const int cc = c + half;
                    if (cc >= 1 && cc <= NCH) {
                        LAS unsigned char* bc = F.lds + ((cc + 1) & 1) * SC_BUF;
                        const LAS float* base = (const LAS float*)bc + 4 * jl;
                        const LAS float* vb = (const LAS float*)(bc + 5 * SC_T * 256) + wave * 4 + rg;
                        LAS float* yb = (LAS float*)(bc + 5 * SC_T * 256 + SC_T * 64) + wave * 4 + rg;
                        f32x4 w[2][2], nk[2][2], bb[2][2], kv[2][2], rr[2][2]; float vv1[2][2];
#define SC_LOAD(slot, g_) do { _Pragma("unroll") for (int q = 0; q < 2; ++q) { const int st_ = (g_) * 2 + q; \
                            w[slot][q] = *(const LAS f32x4*)(base + st_ * 64); nk[slot][q] = *(const LAS f32x4*)(base + SC_T * 64 + st_ * 64); bb[slot][q] = *(const LAS f32x4*)(base + 2 * SC_T * 64 + st_ * 64); \
                            kv[slot][q] = *(const LAS f32x4*)(base + 3 * SC_T * 64 + st_ * 64); rr[slot][q] = *(const LAS f32x4*)(base + 4 * SC_T * 64 + st_ * 64); vv1[slot][q] = vb[st_ * 16]; } } while (0)
                        SC_LOAD(0, 0);
#pragma unroll
                        for (int g = 0; g < SC_T / 2; ++g) {
                            const int sl = g & 1;
                            if (g + 1 < SC_T / 2) { if (sl == 0) SC_LOAD(1, g + 1); else SC_LOAD(0, g + 1); }
                            float yo[2];
#pragma unroll
                            for (int q = 0; q < 2; ++q) {
                                const f32x4 w_ = w[sl][q], nk_ = nk[sl][q], bb_ = bb[sl][q], kv_ = kv[sl][q], rr_ = rr[sl][q]; const float v = vv1[sl][q];
                                const f32x2 t0 = Sa * (f32x2){nk_.x, nk_.y} + Sb * (f32x2){nk_.z, nk_.w};
                                const float sa = allsum16(t0.x + t0.y);
                                const f32x2 vv = {v, v}, ss = {sa, sa};
                                Sa = Sa * (f32x2){w_.x, w_.y} + (ss * (f32x2){bb_.x, bb_.y} + vv * (f32x2){kv_.x, kv_.y});
                                Sb = Sb * (f32x2){w_.z, w_.w} + (ss * (f32x2){bb_.z, bb_.w} + vv * (f32x2){kv_.z, kv_.w});
                                const f32x2 t1 = Sa * (f32x2){rr_.x, rr_.y} + Sb * (f32x2){rr_.z, rr_.w};
                                yo[q] = allsum16(t1.x + t1.y);
                            }
                            if (jl == 0) { yb[(g * 2) * 16] = yo[0]; yb[(g * 2 + 1) * 16] = yo[1]; }
                        }
#undef SC_LOAD
                    }
                    LDS_BAR();
                }
            }
        }
    }
}

__device__ __forceinline__ void p_attn_naive(const Frame& F) {
    const int lane_f = lane_id_fresh(), tid_f = F.wave * 64 + lane_f;
    const bf16* Q = (const bf16*)(F.dob + DO_Q); const bf16* KC = (const bf16*)(F.ws + WS_KC); const bf16* VC = (const bf16*)(F.ws + WS_VC); bf16* YM = (bf16*)(F.ws + WS_YM);
    LAS float* Ks = (LAS float*)F.lds; LAS float* Vs = (LAS float*)(F.lds + 32 * 96 * 4);
    const int tid = tid_f;
    for (int unit = F.vcu; unit < 64 * 16; unit += F.G) {
        const int bh = unit >> 4, qb = 15 - (unit & 15), b = bh >> 3, h = bh & 7; const size_t row0 = (size_t)b * SEQ; const int t = qb * 512 + tid;
        unsigned qp[48];
        { const u32x4* qg = (const u32x4*)(Q + (row0 + t) * 768 + h * 96);
#pragma unroll
          for (int i = 0; i < 12; ++i) { const u32x4 w = qg[i]; qp[4 * i] = w.x; qp[4 * i + 1] = w.y; qp[4 * i + 2] = w.z; qp[4 * i + 3] = w.w; } }
        float o[64];
#pragma unroll
        for (int i = 0; i < 64; ++i) o[i] = 0.f;
        float mx = -INFINITY, l = 0.f;
        const int nkt = (qb + 1) * 16;
        for (int kt = 0; kt < nkt; ++kt) {
            __syncthreads();
            if (tid < 384) { const int r = tid / 12, c8 = (tid % 12) * 8; float v[8]; unpack8(*(const u32x4*)(KC + (row0 + kt * 32 + r) * 768 + h * 96 + c8), v);
#pragma unroll
                for (int i = 0; i < 8; ++i) Ks[r * 96 + c8 + i] = v[i]; }
            if (tid < 256) { const int r = tid >> 3, c8 = (tid & 7) * 8; float v[8]; unpack8(*(const u32x4*)(VC + (row0 + kt * 32 + r) * 512 + h * 64 + c8), v);
#pragma unroll
                for (int i = 0; i < 8; ++i) Vs[r * 64 + c8 + i] = v[i]; }
            __syncthreads();
            for (int kk = 0; kk < 32; ++kk) {
                const int kv = kt * 32 + kk;
                float s = 0.f; const LAS f32x4* kr = (const LAS f32x4*)(Ks + kk * 96);
#pragma unroll
                for (int i = 0; i < 24; ++i) { const f32x4 k4 = kr[i]; s += lo2f(qp[2 * i]) * k4.x + hi2f(qp[2 * i]) * k4.y + lo2f(qp[2 * i + 1]) * k4.z + hi2f(qp[2 * i + 1]) * k4.w; }
                if (kv <= t) {
                    const float mn = fmaxf(mx, s), f = exp2f(mx - mn), p = exp2f(s - mn); mx = mn; l = l * f + p;
                    const LAS f32x4* vr = (const LAS f32x4*)(Vs + kk * 64);
#pragma unroll
                    for (int i = 0; i < 16; ++i) { const f32x4 v4 = vr[i]; o[4 * i] = o[4 * i] * f + p * v4.x; o[4 * i + 1] = o[4 * i + 1] * f + p * v4.y; o[4 * i + 2] = o[4 * i + 2] * f + p * v4.z; o[4 * i + 3] = o[4 * i + 3] * f + p * v4.w; }
                }
            }
        }
        const float il = 1.f / l; u32x4* og = (u32x4*)(YM + (row0 + t) * 512 + h * 64);
#pragma unroll
        for (int i = 0; i < 8; ++i) { u32x4 w; w.x = pk2(o[8 * i] * il, o[8 * i + 1] * il); w.y = pk2(o[8 * i + 2] * il, o[8 * i + 3] * il); w.z = pk2(o[8 * i + 4] * il, o[8 * i + 5] * il); w.w = pk2(o[8 * i + 6] * il, o[8 * i + 7] * il); og[i] = w; }
    }
    __syncthreads();
}

typedef float f32x16 __attribute__((ext_vector_type(16)));
typedef short s16x4 __attribute__((ext_vector_type(4)));
__device__ __forceinline__ int crow(int r, int hi) { return (r & 3) + 8 * (r >> 2) + 4 * hi; }
__device__ __forceinline__ float max3f(float a, float b, float c) { float r; asm("v_max3_f32 %0, %1, %2, %3" : "=v"(r) : "v"(a), "v"(b), "v"(c)); return r; }
__device__ __forceinline__ float max2f(float a, float b) { float r; asm("v_max_f32_e32 %0, %1, %2" : "=v"(r) : "v"(a), "v"(b)); return r; }
__device__ __forceinline__ float xhalf_max(float x) { auto rr = __builtin_amdgcn_permlane32_swap(__float_as_uint(x), __float_as_uint(x), false, false); return max2f(__uint_as_float(rr[0]), __uint_as_float(rr[1])); }
__device__ __forceinline__ float xhalf_sum(float x) { auto rr = __builtin_amdgcn_permlane32_swap(__float_as_uint(x), __float_as_uint(x), false, false); return __uint_as_float(rr[0]) + __uint_as_float(rr[1]); }
__device__ __forceinline__ bf16x8 packp(const f32x16& p, int s2) {
    u32x4 w; w.x = pk2(p[8 * s2 + 0], p[8 * s2 + 1]); w.y = pk2(p[8 * s2 + 2], p[8 * s2 + 3]); w.z = pk2(p[8 * s2 + 4], p[8 * s2 + 5]); w.w = pk2(p[8 * s2 + 6], p[8 * s2 + 7]);
    return __builtin_bit_cast(bf16x8, w);
}
__device__ __forceinline__ void p_attn_mfma(const Frame& F) {
    const int lane_f = lane_id_fresh(), tid_f = F.wave * 64 + lane_f;
    const bf16* Q = (const bf16*)(F.dob + DO_Q); const bf16* KC = (const bf16*)(F.ws + WS_KC); const bf16* VC = (const bf16*)(F.ws + WS_VC); bf16* YM = (bf16*)(F.ws + WS_YM);
    constexpr int KST = 208, VST = 192, KBYTES = 64 * KST, SUB = KBYTES + 64 * VST, BUF = 2 * SUB;
    const int tid = tid_f, lane = lane_f, wave = F.wave, r = lane & 31, hi = lane >> 5;
    int kg[3], kl[3], vg[2], vl[2];
#pragma unroll
    for (int i = 0; i < 3; ++i) { const int c = tid + 512 * i, row = c / 12, pc = c % 12; kg[i] = row * 768 + pc * 8; kl[i] = (row >> 6) * SUB + (row & 63) * KST + pc * 16; }
#pragma unroll
    for (int i = 0; i < 2; ++i) { const int c = tid + 512 * i, row = c >> 3, pc = c & 7; vg[i] = row * 512 + pc * 8; vl[i] = (row >> 6) * SUB + KBYTES + (row & 63) * VST + pc * 16; }
    const int g4 = lane >> 4, li = lane & 15;
    const int vtr = (4 * (g4 >> 1) + (li >> 2)) * VST + (16 * (g4 & 1) + 4 * (li & 3)) * 2;
    const int kfr = r * KST + hi * 16;
    LAS unsigned char* lds = F.lds;
    for (int item = F.vcu; item < 1024; item += F.G) {
        const int bh = item >> 4, sidx = item & 15, b = bh >> 3, h = bh & 7; const size_t row0 = (size_t)b * SEQ;
        const bf16* Kg = KC + row0 * 768 + h * 96; const bf16* Vg = VC + row0 * 512 + h * 64;
        for (int uu = 0; uu < 2; ++uu) {
            const int qb = uu == 0 ? 31 - sidx : sidx, q0 = qb * 256, NT = (q0 + 256) / 128;
            const int qw = q0 + wave * 32;
            bf16x8 qf[6];
            { const bf16* qp = Q + (row0 + qw + r) * 768 + h * 96 + hi * 8;
#pragma unroll
              for (int s = 0; s < 6; ++s) qf[s] = *(const bf16x8*)(qp + 16 * s); }
            f32x16 o0 = {}, o1 = {}, negm = {}; float m = 0.f, l = 0.f;
            u32x4 ak[3], av[2];
#pragma unroll
            for (int i = 0; i < 3; ++i) ak[i] = *(const u32x4*)(Kg + kg[i]);
#pragma unroll
            for (int i = 0; i < 2; ++i) av[i] = *(const u32x4*)(Vg + vg[i]);
            asm volatile("" : "+v"(qf[0]), "+v"(qf[1]), "+v"(qf[2]), "+v"(qf[3]), "+v"(qf[4]), "+v"(qf[5]));
            LDS_BAR();
#pragma unroll
            for (int i = 0; i < 3; ++i) *(LAS u32x4*)(lds + kl[i]) = ak[i];
#pragma unroll
            for (int i = 0; i < 2; ++i) *(LAS u32x4*)(lds + vl[i]) = av[i];
            LDS_BAR();
            for (int t = 0; t < NT; ++t) {
                LAS unsigned char* bb = lds + (t & 1) * BUF;
                { const int tn = (t + 1 < NT) ? t + 1 : t;
                  const bf16* kgp = Kg + (size_t)tn * 128 * 768; const bf16* vgp = Vg + (size_t)tn * 128 * 512;
#pragma unroll
                  for (int i = 0; i < 3; ++i) ak[i] = *(const u32x4*)(kgp + kg[i]);
#pragma unroll
                  for (int i = 0; i < 2; ++i) av[i] = *(const u32x4*)(vgp + vg[i]); }
#pragma unroll
                for (int sub = 0; sub < 2; ++sub) {
                    const int tt = 2 * t + sub;
                    if (64 * tt <= qw + 31) {
                        LAS unsigned char* kb = bb + sub * SUB; LAS unsigned char* vb = kb + KBYTES;
                        bf16x8 kf0[6], kf1[6];
#pragma unroll
                        for (int s = 0; s < 6; ++s) { kf0[s] = *(const LAS bf16x8*)(kb + kfr + s * 32); kf1[s] = *(const LAS bf16x8*)(kb + kfr + 32 * KST + s * 32); }
                        __builtin_amdgcn_sched_barrier(0);
                        f32x16 p0 = negm, p1 = negm;
#pragma unroll
                        for (int s = 0; s < 6; ++s) { p0 = __builtin_amdgcn_mfma_f32_32x32x16_bf16(kf0[s], qf[s], p0, 0, 0, 0); p1 = __builtin_amdgcn_mfma_f32_32x32x16_bf16(kf1[s], qf[s], p1, 0, 0, 0); }
                        if (64 * tt + 63 > qw) {
                            const int qrel = qw + r - 64 * tt;
#pragma unroll
                            for (int rg = 0; rg < 16; ++rg) { const int kv = crow(rg, hi); if (kv > qrel) p0[rg] = -INFINITY; if (kv + 32 > qrel) p1[rg] = -INFINITY; }
                        }
                        float mx;
                        { float a = max3f(p0[0], p0[1], p1[0]), b2 = max3f(p0[2], p0[3], p1[1]); a = max3f(a, p1[2], p1[3]);
#pragma unroll
                          for (int rg = 4; rg < 16; rg += 4) { a = max3f(a, p0[rg], p0[rg + 1]); b2 = max3f(b2, p0[rg + 2], p0[rg + 3]); a = max3f(a, p1[rg], p1[rg + 1]); b2 = max3f(b2, p1[rg + 2], p1[rg + 3]); }
                          mx = xhalf_max(max2f(a, b2)); }
                        if (!__all(mx <= 8.0f)) {
                            const float dl = max2f(mx, 0.f), f = __builtin_amdgcn_exp2f(-dl); m += dl; l *= f;
#pragma unroll
                            for (int rg = 0; rg < 16; ++rg) { p0[rg] -= dl; p1[rg] -= dl; o0[rg] *= f; o1[rg] *= f; negm[rg] = -m; }
                        }
                        float rs = 0.f;
#pragma unroll
                        for (int rg = 0; rg < 16; ++rg) { p0[rg] = __builtin_amdgcn_exp2f(p0[rg]); p1[rg] = __builtin_amdgcn_exp2f(p1[rg]); rs += p0[rg] + p1[rg]; }
                        l += rs;
#pragma unroll
                        for (int hh = 0; hh < 2; ++hh)
#pragma unroll
                            for (int s2 = 0; s2 < 2; ++s2) { const bf16x8 pf = packp(hh == 0 ? p0 : p1, s2);
#pragma unroll
                                for (int db = 0; db < 2; ++db) { LAS unsigned char* vp_ = vb + vtr + (32 * hh + 16 * s2) * VST + db * 64;
                                    const s16x4 lo = __builtin_bit_cast(s16x4, __builtin_amdgcn_ds_read_tr16_b64_v4i16((LAS s16x4*)vp_));
                                    const s16x4 hi4 = __builtin_bit_cast(s16x4, __builtin_amdgcn_ds_read_tr16_b64_v4i16((LAS s16x4*)(vp_ + 8 * VST)));
                                    const bf16x8 vf = (bf16x8){lo[0], lo[1], lo[2], lo[3], hi4[0], hi4[1], hi4[2], hi4[3]};
                                    if (db == 0) o0 = __builtin_amdgcn_mfma_f32_32x32x16_bf16(vf, pf, o0, 0, 0, 0); else o1 = __builtin_amdgcn_mfma_f32_32x32x16_bf16(vf, pf, o1, 0, 0, 0); } }
                    }
                }
                { LAS unsigned char* nb = lds + ((t + 1) & 1) * BUF;
#pragma unroll
                  for (int i = 0; i < 3; ++i) *(LAS u32x4*)(nb + kl[i]) = ak[i];
#pragma unroll
                  for (int i = 0; i < 2; ++i) *(LAS u32x4*)(nb + vl[i]) = av[i]; }
                LDS_BAR();
            }
            const float il = 1.0f / xhalf_sum(l);
            bf16* op = YM + (row0 + qw + r) * YYLD + h * 64 + 4 * hi;
#pragma unroll
            for (int gq = 0; gq < 4; ++gq) { u32x2 w0, w1;
                w0.x = pk2(o0[4 * gq] * il, o0[4 * gq + 1] * il); w0.y = pk2(o0[4 * gq + 2] * il, o0[4 * gq + 3] * il);
                w1.x = pk2(o1[4 * gq] * il, o1[4 * gq + 1] * il); w1.y = pk2(o1[4 * gq + 2] * il, o1[4 * gq + 3] * il);
                *(u32x2*)(op + 8 * gq) = w0; *(u32x2*)(op + 32 + 8 * gq) = w1; }
        }
    }
    __syncthreads();
}

constexpr int CS_CH = 256, CS_NCH = SEQ / CS_CH;
constexpr int CS_RS = 144;
constexpr int CS_IMG = 16 * CS_RS;
constexpr int CS_WAVE = 8 * CS_IMG + 512;
enum { IM_A = 0, IM_R = 1, IM_B = 2, IM_K = 3, IM_BH = 4, IM_KH = 5, IM_V = 6, IM_G = 7 };
constexpr size_t DO_CSP = 64 * MiB, DO_CSG = 128 * MiB, DO_CSZ = 192 * MiB;
__device__ __forceinline__ int crow8(int q, int hi) { return (q & 3) + 8 * ((q >> 2) & 1) + 4 * hi; }
template <int N> __device__ __forceinline__ float dpp_shr0(float x) { return __builtin_bit_cast(float, __builtin_amdgcn_update_dpp(0, __builtin_bit_cast(int, x), 0x110 + N, 0xf, 0xf, true)); }
__device__ __forceinline__ float rowscan16(float x) { x += dpp_shr0<1>(x); x += dpp_shr0<2>(x); x += dpp_shr0<4>(x); x += dpp_shr0<8>(x); return x; }
__device__ __forceinline__ float xsum_16_32(float v) {
    { auto r = __builtin_amdgcn_permlane16_swap(__float_as_uint(v), __float_as_uint(v), false, false); v = __uint_as_float(r[0]) + __uint_as_float(r[1]); }
    { auto r = __builtin_amdgcn_permlane32_swap(__float_as_uint(v), __float_as_uint(v), false, false); v = __uint_as_float(r[0]) + __uint_as_float(r[1]); }
    return v;
}
__device__ __forceinline__ bf16x8 cs_rowfrag(const LAS unsigned char* rowp, int hi, int ks) {
    const LAS unsigned char* p = rowp + (16 * ks + 4 * hi) * 2; const u32x2 a = *(const LAS u32x2*)p, b = *(const LAS u32x2*)(p + 16);
    return __builtin_bit_cast(bf16x8, (u32x4){a.x, a.y, b.x, b.y});
}
__device__ __forceinline__ bf16x8 cs_trfrag(LAS unsigned char* img, int cb, int lane) {
    const int g4 = lane >> 4, li = lane & 15; LAS unsigned char* p = img + (4 * (g4 >> 1) + (li >> 2)) * CS_RS + (32 * cb + 16 * (g4 & 1) + 4 * (li & 3)) * 2;
    const s16x4 lo = __builtin_bit_cast(s16x4, __builtin_amdgcn_ds_read_tr16_b64_v4i16((LAS s16x4*)p));
    const s16x4 h4 = __builtin_bit_cast(s16x4, __builtin_amdgcn_ds_read_tr16_b64_v4i16((LAS s16x4*)(p + 8 * CS_RS)));
    return (bf16x8){lo[0], lo[1], lo[2], lo[3], h4[0], h4[1], h4[2], h4[3]};
}
__device__ __forceinline__ bf16x8 cs_zero8() { return (bf16x8){0, 0, 0, 0, 0, 0, 0, 0}; }
struct CsIn { const bf16 *ZR, *A, *LW, *G; const float *mu, *k_k, *k_a, *r_k; };
template <bool USE_V, bool WITH_Y>
__device__ __forceinline__ void cs_prep(const CsIn& in, size_t row0, int tok0, int h, LAS unsigned char* wl, int lane) {
    const int t = lane & 15, jq = lane >> 4, tok = tok0 + t; const bool first = tok == 0;
    const size_t g = row0 + tok, gp = row0 + (first ? 0 : tok - 1); const int c0 = h * 64 + 16 * jq;
    LAS float* gct = (LAS float*)(wl + 8 * CS_IMG); LAS float* btt = gct + 64;
    u32x4 Lrc[2], Lrp[2], Lkc[2], Lkp[2], Lav[2], Llw[2], Lvc[2], Lvp[2];
#pragma unroll
    for (int hf = 0; hf < 2; ++hf) { const int cc = c0 + 8 * hf;
        Lkc[hf] = *(const u32x4*)(in.ZR + g * 1792 + 512 + cc); Lkp[hf] = *(const u32x4*)(in.ZR + gp * 1792 + 512 + cc);
        Lrc[hf] = *(const u32x4*)(in.ZR + g * 1792 + cc); Lrp[hf] = *(const u32x4*)(in.ZR + gp * 1792 + cc);
        Lav[hf] = *(const u32x4*)(in.A + g * 512 + cc); Llw[hf] = *(const u32x4*)(in.LW + g * 512 + cc);
        if (USE_V) { Lvc[hf] = *(const u32x4*)(in.ZR + g * 1792 + 1024 + cc); Lvp[hf] = *(const u32x4*)(in.ZR + gp * 1792 + 1024 + cc); }
    }
    float inv;
    { float ss = 0.f;
#pragma unroll
      for (int hf = 0; hf < 2; ++hf) { float kc[8], kp[8]; unpack8(Lkc[hf], kc); unpack8(Lkp[hf], kp);
          const f32x4 m0 = *(const f32x4*)(in.mu + 512 + c0 + 8 * hf), m1 = *(const f32x4*)(in.mu + 512 + c0 + 8 * hf + 4), q0 = *(const f32x4*)(in.k_k + c0 + 8 * hf), q1 = *(const f32x4*)(in.k_k + c0 + 8 * hf + 4);
          const float mm[8] = {m0.x, m0.y, m0.z, m0.w, m1.x, m1.y, m1.z, m1.w}, qq[8] = {q0.x, q0.y, q0.z, q0.w, q1.x, q1.y, q1.z, q1.w};
#pragma unroll
          for (int e = 0; e < 8; ++e) { const float zk = kc[e] + ((first ? 0.f : kp[e]) - kc[e]) * mm[e]; const float kr = zk * qq[e]; ss += kr * kr; } }
      inv = 1.0f / fmaxf(sqrtf(xsum_16_32(ss)), 1e-12f); }
    float btacc = 0.f;
#pragma unroll
    for (int hf = 0; hf < 2; ++hf) {
        const int cc = c0 + 8 * hf;
        u32x4 Lgg = {}; if (WITH_Y) Lgg = *(const u32x4*)(in.G + g * 512 + cc);
        float rc[8], rp[8], kc[8], kp[8], av[8], lw[8];
        unpack8(Lrc[hf], rc); unpack8(Lrp[hf], rp); unpack8(Lkc[hf], kc); unpack8(Lkp[hf], kp); unpack8(Lav[hf], av); unpack8(Llw[hf], lw);
        float mr[8], mk[8], qk[8], qa[8], qr[8];
        { const f32x4 a0 = *(const f32x4*)(in.mu + cc), a1 = *(const f32x4*)(in.mu + cc + 4), b0 = *(const f32x4*)(in.mu + 512 + cc), b1 = *(const f32x4*)(in.mu + 512 + cc + 4);
          const f32x4 c0_ = *(const f32x4*)(in.k_k + cc), c1_ = *(const f32x4*)(in.k_k + cc + 4), d0 = *(const f32x4*)(in.k_a + cc), d1 = *(const f32x4*)(in.k_a + cc + 4);
          mr[0] = a0.x; mr[1] = a0.y; mr[2] = a0.z; mr[3] = a0.w; mr[4] = a1.x; mr[5] = a1.y; mr[6] = a1.z; mr[7] = a1.w;
          mk[0] = b0.x; mk[1] = b0.y; mk[2] = b0.z; mk[3] = b0.w; mk[4] = b1.x; mk[5] = b1.y; mk[6] = b1.z; mk[7] = b1.w;
          qk[0] = c0_.x; qk[1] = c0_.y; qk[2] = c0_.z; qk[3] = c0_.w; qk[4] = c1_.x; qk[5] = c1_.y; qk[6] = c1_.z; qk[7] = c1_.w;
          qa[0] = d0.x; qa[1] = d0.y; qa[2] = d0.z; qa[3] = d0.w; qa[4] = d1.x; qa[5] = d1.y; qa[6] = d1.z; qa[7] = d1.w; }
        if (WITH_Y) { const f32x4 e0 = *(const f32x4*)(in.r_k + cc), e1 = *(const f32x4*)(in.r_k + cc + 4); qr[0] = e0.x; qr[1] = e0.y; qr[2] = e0.z; qr[3] = e0.w; qr[4] = e1.x; qr[5] = e1.y; qr[6] = e1.z; qr[7] = e1.w; }
        float oA[8], oR[8], oB[8], oK[8], oBH[8], oKH[8];
#pragma unroll
        for (int e = 0; e < 8; ++e) {
            const float r = rc[e] + ((first ? 0.f : rp[e]) - rc[e]) * mr[e]; const float zk = kc[e] + ((first ? 0.f : kp[e]) - kc[e]) * mk[e];
            const float kq = zk * (1.f + (av[e] - 1.f) * qa[e]); const float kk = zk * qk[e] * inv; const float b = kk * av[e];
            const float Lg = rowscan16(lw[e]); const float eLg = __builtin_amdgcn_exp2f(1.4426950408889634f * Lg); const float enLg = __builtin_amdgcn_rcpf(eLg);
            const float eLgm = __builtin_bit_cast(float, __builtin_amdgcn_update_dpp(0x3f800000, __builtin_bit_cast(int, eLg), 0x111, 0xf, 0xf, false));
            const float eC = __builtin_bit_cast(float, __builtin_amdgcn_ds_bpermute(((lane & 48) | 15) << 2, __builtin_bit_cast(int, eLg)));
            oA[e] = -kk * eLgm; oR[e] = r * eLg; oB[e] = b * enLg; oK[e] = kq * enLg; oBH[e] = oB[e] * eC; oKH[e] = oK[e] * eC;
            if (WITH_Y) btacc += r * kq * qr[e];
            if (t == 15) gct[16 * jq + 8 * hf + e] = eC;
        }
        const int wo = t * CS_RS + (16 * jq + 8 * hf) * 2;
        *(LAS u32x4*)(wl + IM_A * CS_IMG + wo) = pack8(oA); *(LAS u32x4*)(wl + IM_R * CS_IMG + wo) = pack8(oR); *(LAS u32x4*)(wl + IM_B * CS_IMG + wo) = pack8(oB);
        *(LAS u32x4*)(wl + IM_K * CS_IMG + wo) = pack8(oK); *(LAS u32x4*)(wl + IM_BH * CS_IMG + wo) = pack8(oBH); *(LAS u32x4*)(wl + IM_KH * CS_IMG + wo) = pack8(oKH);
        if (USE_V) { float vc[8], vp[8], o[8]; unpack8(Lvc[hf], vc); unpack8(Lvp[hf], vp);
            const f32x4 a0 = *(const f32x4*)(in.mu + 1024 + cc), a1 = *(const f32x4*)(in.mu + 1024 + cc + 4); const float mv[8] = {a0.x, a0.y, a0.z, a0.w, a1.x, a1.y, a1.z, a1.w};
#pragma unroll
            for (int e = 0; e < 8; ++e) o[e] = vc[e] + ((first ? 0.f : vp[e]) - vc[e]) * mv[e];
            *(LAS u32x4*)(wl + IM_V * CS_IMG + wo) = pack8(o); }
        if (WITH_Y) *(LAS u32x4*)(wl + IM_G * CS_IMG + wo) = Lgg;
    }
    if (WITH_Y) { btacc = xsum_16_32(btacc); if (lane < 16) btt[lane] = btacc; }
}
struct CsFr { bf16x8 fAR[4], aL1, aL2, aL4, aL8, aLkMk, aMb; };
__device__ __forceinline__ void cs_gram(CsFr& fr, LAS unsigned char* wl, int lane) {
    const int hi = lane >> 5, row = lane & 15; const bool up = (lane & 16) != 0;
    const LAS unsigned char* rpAR = wl + (up ? IM_R : IM_A) * CS_IMG + row * CS_RS; const LAS unsigned char* rpBK = wl + (up ? IM_K : IM_B) * CS_IMG + row * CS_RS;
#pragma unroll
    for (int ks = 0; ks < 4; ++ks) fr.fAR[ks] = cs_rowfrag(rpAR, hi, ks);
    f32x16 F1 = {}, F2 = {};
#pragma unroll
    for (int ks = 0; ks < 4; ++ks) { const bf16x8 fBK = cs_rowfrag(rpBK, hi, ks);
        F1 = __builtin_amdgcn_mfma_f32_32x32x16_bf16(fBK, fr.fAR[ks], F1, 0, 0, 0);
        F2 = __builtin_amdgcn_mfma_f32_32x32x16_bf16(fr.fAR[ks], fBK, F2, 0, 0, 0); }
#pragma unroll
    for (int q = 0; q < 8; ++q) { const int s = crow8(q, hi); const bool k1 = up ? (s <= row) : (s < row);
        F1[q] = k1 ? F1[q] : 0.f; F1[8 + q] = k1 ? F1[8 + q] : 0.f; F2[q] = (!up && row < s) ? F2[q] : 0.f; }
    const bf16x8 f1lo = packp(F1, 0);
    fr.aL1 = up ? cs_zero8() : f1lo;
    fr.aMb = up ? f1lo : cs_zero8();
    fr.aLkMk = packp(F1, 1);
    const bf16x8 p2 = packp(F2, 0);
    const f32x16 z16 = {};
    const f32x16 Q1 = __builtin_amdgcn_mfma_f32_32x32x16_bf16(p2, fr.aL1, z16, 0, 0, 0), Q2 = __builtin_amdgcn_mfma_f32_32x32x16_bf16(fr.aL1, p2, z16, 0, 0, 0);
    fr.aL2 = packp(Q1, 0); const bf16x8 p2b = packp(Q2, 0);
    const f32x16 R1 = __builtin_amdgcn_mfma_f32_32x32x16_bf16(p2b, fr.aL2, z16, 0, 0, 0), R2 = __builtin_amdgcn_mfma_f32_32x32x16_bf16(fr.aL2, p2b, z16, 0, 0, 0);
    fr.aL4 = packp(R1, 0); const bf16x8 p2c = packp(R2, 0);
    const f32x16 S1 = __builtin_amdgcn_mfma_f32_32x32x16_bf16(p2c, fr.aL4, z16, 0, 0, 0);
    fr.aL8 = packp(S1, 0);
}
template <bool USE_V, bool WITH_Y>
__device__ __forceinline__ void cs_apply(f32x16 (&Z)[2][2], f32x16 (&D)[2], const CsFr& fr, LAS unsigned char* wl, int lane) {
    const int hi = lane >> 5;
    bf16x8 vf[2];
    if (USE_V) { vf[0] = cs_trfrag(wl + IM_V * CS_IMG, 0, lane); vf[1] = cs_trfrag(wl + IM_V * CS_IMG, 1, lane); }
#pragma unroll
    for (int nb = 0; nb < 2; ++nb) { f32x16 d = {};
#pragma unroll
        for (int jb = 0; jb < 2; ++jb)
#pragma unroll
            for (int k2 = 0; k2 < 2; ++k2) d = __builtin_amdgcn_mfma_f32_32x32x16_bf16(fr.fAR[2 * jb + k2], packp(Z[jb][nb], k2), d, 0, 0, 0);
        if (USE_V) d = __builtin_amdgcn_mfma_f32_32x32x16_bf16(fr.aLkMk, vf[nb], d, 0, 0, 0);
        D[nb] = d; }
#pragma unroll
    for (int nb = 0; nb < 2; ++nb) {
        D[nb] = __builtin_amdgcn_mfma_f32_32x32x16_bf16(fr.aL8, packp(D[nb], 0), D[nb], 0, 0, 0);
        D[nb] = __builtin_amdgcn_mfma_f32_32x32x16_bf16(fr.aL4, packp(D[nb], 0), D[nb], 0, 0, 0);
        D[nb] = __builtin_amdgcn_mfma_f32_32x32x16_bf16(fr.aL2, packp(D[nb], 0), D[nb], 0, 0, 0);
        D[nb] = __builtin_amdgcn_mfma_f32_32x32x16_bf16(fr.aL1, packp(D[nb], 0), D[nb], 0, 0, 0);
    }
    const bf16x8 u0 = packp(D[0], 0), u1 = packp(D[1], 0);
    if (WITH_Y) { D[0] = __builtin_amdgcn_mfma_f32_32x32x16_bf16(fr.aMb, u0, D[0], 0, 0, 0); D[1] = __builtin_amdgcn_mfma_f32_32x32x16_bf16(fr.aMb, u1, D[1], 0, 0, 0); }
    const LAS float* gct = (const LAS float*)(wl + 8 * CS_IMG);
#pragma unroll
    for (int jb = 0; jb < 2; ++jb) {
        const bf16x8 fb = cs_trfrag(wl + IM_BH * CS_IMG, jb, lane); bf16x8 fk = cs_zero8(); if (USE_V) fk = cs_trfrag(wl + IM_KH * CS_IMG, jb, lane);
        float gc[16];
#pragma unroll
        for (int g4 = 0; g4 < 4; ++g4) { const f32x4 x = *(const LAS f32x4*)(gct + 32 * jb + 8 * g4 + 4 * hi); gc[4 * g4] = x.x; gc[4 * g4 + 1] = x.y; gc[4 * g4 + 2] = x.z; gc[4 * g4 + 3] = x.w; }
#pragma unroll
        for (int nb = 0; nb < 2; ++nb) { f32x16 z = Z[jb][nb];
#pragma unroll
            for (int q = 0; q < 16; ++q) z[q] *= gc[q];
            z = __builtin_amdgcn_mfma_f32_32x32x16_bf16(fb, nb == 0 ? u0 : u1, z, 0, 0, 0);
            if (USE_V) z = __builtin_amdgcn_mfma_f32_32x32x16_bf16(fk, vf[nb], z, 0, 0, 0);
            Z[jb][nb] = z; }
    }
}
__device__ __forceinline__ void cs_apply_pk(bf16x8 (&Zp)[2][2][2], f32x16 (&D)[2], const CsFr& fr, LAS unsigned char* wl, int lane) {
    const int hi = lane >> 5;
#pragma unroll
    for (int nb = 0; nb < 2; ++nb) { f32x16 d = {};
#pragma unroll
        for (int jb = 0; jb < 2; ++jb)
#pragma unroll
            for (int k2 = 0; k2 < 2; ++k2) d = __builtin_amdgcn_mfma_f32_32x32x16_bf16(fr.fAR[2 * jb + k2], Zp[jb][nb][k2], d, 0, 0, 0);
        D[nb] = d; }
#pragma unroll
    for (int nb = 0; nb < 2; ++nb) {
        D[nb] = __builtin_amdgcn_mfma_f32_32x32x16_bf16(fr.aL8, packp(D[nb], 0), D[nb], 0, 0, 0);
        D[nb] = __builtin_amdgcn_mfma_f32_32x32x16_bf16(fr.aL4, packp(D[nb], 0), D[nb], 0, 0, 0);
        D[nb] = __builtin_amdgcn_mfma_f32_32x32x16_bf16(fr.aL2, packp(D[nb], 0), D[nb], 0, 0, 0);
        D[nb] = __builtin_amdgcn_mfma_f32_32x32x16_bf16(fr.aL1, packp(D[nb], 0), D[nb], 0, 0, 0);
    }
    const bf16x8 u0 = packp(D[0], 0), u1 = packp(D[1], 0);
    const LAS float* gct = (const LAS float*)(wl + 8 * CS_IMG);
#pragma unroll
    for (int jb = 0; jb < 2; ++jb) {
        const bf16x8 fb = cs_trfrag(wl + IM_BH * CS_IMG, jb, lane);
        float gc[16];
#pragma unroll
        for (int g4 = 0; g4 < 4; ++g4) { const f32x4 x = *(const LAS f32x4*)(gct + 32 * jb + 8 * g4 + 4 * hi); gc[4 * g4] = x.x; gc[4 * g4 + 1] = x.y; gc[4 * g4 + 2] = x.z; gc[4 * g4 + 3] = x.w; }
#pragma unroll
        for (int nb = 0; nb < 2; ++nb) { f32x16 z;
#pragma unroll
            for (int k2 = 0; k2 < 2; ++k2) { float e[8]; unpack8(__builtin_bit_cast(u32x4, Zp[jb][nb][k2]), e);
#pragma unroll
                for (int q = 0; q < 8; ++q) z[8 * k2 + q] = e[q] * gc[8 * k2 + q]; }
            z = __builtin_amdgcn_mfma_f32_32x32x16_bf16(fb, nb == 0 ? u0 : u1, z, 0, 0, 0);
            Zp[jb][nb][0] = packp(z, 0); Zp[jb][nb][1] = packp(z, 1); }
    }
}
template <bool USE_V, bool WITH_Y>
__device__ __forceinline__ void cs_step(f32x16 (&Z)[2][2], f32x16 (&D)[2], LAS unsigned char* wl, int lane) { CsFr fr; cs_gram(fr, wl, lane); cs_apply<USE_V, WITH_Y>(Z, D, fr, wl, lane); }
__device__ __forceinline__ void p_cs_a(const Frame& F, ArgsP a) {
    const int lane = lane_id_fresh();
    LAS unsigned char* wl = F.lds + F.wave * CS_WAVE;
    CsIn in{(const bf16*)(F.ws + WS_ZR), (const bf16*)(F.ws + WS_A), (const bf16*)(F.ws + WS_LW), (const bf16*)(F.dob + DO_G), a->in[I_MU], a->in[I_KK], a->in[I_KA], a->in[I_RK]};
    bf16* Pm = (bf16*)(F.dob + DO_CSP); bf16* Gf = (bf16*)(F.dob + DO_CSG);
    const int hi = lane >> 5;
    for (int uc = F.gw; uc < 64 * CS_NCH; uc += F.NGW) {
        const int bh = uc / CS_NCH, c = uc % CS_NCH, b = bh >> 3, h = bh & 7; const size_t row0 = (size_t)b * SEQ;
        f32x16 ZG[2][2], D[2]; bf16x8 ZP[2][2][2];
#pragma unroll
        for (int jb = 0; jb < 2; ++jb)
#pragma unroll
            for (int nb = 0; nb < 2; ++nb) { f32x16 z = {}; ZG[jb][nb] = z;
                if (jb == nb) {
#pragma unroll
                    for (int q = 0; q < 16; ++q) z[q] = (crow(q, hi) == (lane & 31)) ? 1.f : 0.f; }
                ZP[jb][nb][0] = packp(z, 0); ZP[jb][nb][1] = packp(z, 1); }
        for (int sc = 0; sc < CS_CH / 16; ++sc) { int ln = lane; asm volatile("" : "+v"(ln));
            cs_prep<true, false>(in, row0, c * CS_CH + sc * 16, h, wl, ln); asm volatile("s_waitcnt lgkmcnt(0)" ::: "memory");
            CsFr fr; cs_gram(fr, wl, ln);
            cs_apply_pk(ZP, D, fr, wl, ln); cs_apply<true, false>(ZG, D, fr, wl, ln); asm volatile("s_waitcnt lgkmcnt(0)" ::: "memory"); }
        int lo_ = lane; asm volatile("" : "+v"(lo_)); const int hi_o = lo_ >> 5;
        {
            LAS unsigned short* tb = (LAS unsigned short*)(wl + 4 * hi_o * CS_RS + (lo_ & 31) * 2);
#pragma unroll
            for (int jb = 0; jb < 2; ++jb)
#pragma unroll
                for (int nb = 0; nb < 2; ++nb)
#pragma unroll
                    for (int q = 0; q < 16; ++q) tb[((32 * jb + (q & 3) + 8 * (q >> 2)) * CS_RS + 64 * nb) / 2] = (unsigned short)ZP[jb][nb][q >> 3][q & 7];
            bf16* dst = Pm + (size_t)uc * 4096;
#pragma unroll
            for (int i = 0; i < 8; ++i) { const int ch = lo_ + 64 * i, rr = ch >> 3, c8 = (ch & 7) * 8; *(u32x4*)(dst + rr * 64 + c8) = *(const LAS u32x4*)(wl + rr * CS_RS + c8 * 2); }
            asm volatile("s_waitcnt lgkmcnt(0)" ::: "memory");
        }
        {
            bf16* dst = Gf + (size_t)uc * 4096;
#pragma unroll
            for (int jb = 0; jb < 2; ++jb)
#pragma unroll
                for (int nb = 0; nb < 2; ++nb) { u32x4 w0, w1; const f32x16& z = ZG[jb][nb];
                    w0.x = pk2(z[0], z[1]); w0.y = pk2(z[2], z[3]); w0.z = pk2(z[4], z[5]); w0.w = pk2(z[6], z[7]); w1.x = pk2(z[8], z[9]); w1.y = pk2(z[10], z[11]); w1.z = pk2(z[12], z[13]); w1.w = pk2(z[14], z[15]);
                    u32x4* p = (u32x4*)(dst + ((jb * 2 + nb) * 64 + lo_) * 16); p[0] = w0; p[1] = w1; }
        }
    }
}
struct CsB { u32x2 p[2][2][2][2]; u32x4 g[2][2]; };
__device__ __forceinline__ void csb_load(CsB& X, const bf16* Pm, const bf16* Gf, size_t uc, int nb, int lane) {
    const int hi = lane >> 5, r = lane & 31; const bf16* Pc = Pm + uc * 4096;
#pragma unroll
    for (int mb = 0; mb < 2; ++mb) {
#pragma unroll
        for (int jb = 0; jb < 2; ++jb)
#pragma unroll
            for (int k2 = 0; k2 < 2; ++k2) { const bf16* pr = Pc + (32 * mb + r) * 64 + 32 * jb + 16 * k2 + 4 * hi; X.p[mb][jb][k2][0] = *(const u32x2*)pr; X.p[mb][jb][k2][1] = *(const u32x2*)(pr + 8); }
        const u32x4* gp = (const u32x4*)(Gf + uc * 4096 + ((mb * 2 + nb) * 64 + lane) * 16); X.g[mb][0] = gp[0]; X.g[mb][1] = gp[1]; }
}
__device__ __forceinline__ void csb_step(f32x16 (&Z)[2], const CsB& X, bf16* Zf, size_t uc, int nb, int lane) {
#pragma unroll
    for (int jb = 0; jb < 2; ++jb) { u32x4 w0, w1; const f32x16& z = Z[jb];
        w0.x = pk2(z[0], z[1]); w0.y = pk2(z[2], z[3]); w0.z = pk2(z[4], z[5]); w0.w = pk2(z[6], z[7]); w1.x = pk2(z[8], z[9]); w1.y = pk2(z[10], z[11]); w1.z = pk2(z[12], z[13]); w1.w = pk2(z[14], z[15]);
        u32x4* p = (u32x4*)(Zf + uc * 4096 + ((jb * 2 + nb) * 64 + lane) * 16); p[0] = w0; p[1] = w1; }
    f32x16 N[2];
#pragma unroll
    for (int mb = 0; mb < 2; ++mb) { float g0[8], g1[8]; unpack8(X.g[mb][0], g0); unpack8(X.g[mb][1], g1);
#pragma unroll
        for (int q = 0; q < 8; ++q) { N[mb][q] = g0[q]; N[mb][8 + q] = g1[q]; } }
#pragma unroll
    for (int jb = 0; jb < 2; ++jb)
#pragma unroll
        for (int k2 = 0; k2 < 2; ++k2) { const bf16x8 zb = packp(Z[jb], k2);
#pragma unroll
            for (int mb = 0; mb < 2; ++mb) { const u32x2 x0 = X.p[mb][jb][k2][0], x1 = X.p[mb][jb][k2][1];
                N[mb] = __builtin_amdgcn_mfma_f32_32x32x16_bf16(__builtin_bit_cast(bf16x8, (u32x4){x0.x, x0.y, x1.x, x1.y}), zb, N[mb], 0, 0, 0); } }
    Z[0] = N[0]; Z[1] = N[1];
}
__device__ __forceinline__ void p_cs_b(const Frame& F) {
    const int lane = lane_id_fresh();
    const bf16* Pm = (const bf16*)(F.dob + DO_CSP); const bf16* Gf = (const bf16*)(F.dob + DO_CSG); bf16* Zf = (bf16*)(F.dob + DO_CSZ);
    for (int u16 = F.gw; u16 < 128 * 16; u16 += F.NGW) {
        if (u16 & 15) continue;
        const int u = u16 >> 4, bh = u >> 1, nb = u & 1; const size_t uc0 = (size_t)bh * CS_NCH;
        f32x16 Z[2] = {};
        CsB X0, X1;
        csb_load(X0, Pm, Gf, uc0, nb, lane);
        for (int c = 0; c < CS_NCH; c += 2) {
            csb_load(X1, Pm, Gf, uc0 + c + 1, nb, lane);
            csb_step(Z, X0, Zf, uc0 + c, nb, lane);
            csb_load(X0, Pm, Gf, uc0 + (c + 2 < CS_NCH ? c + 2 : CS_NCH - 1), nb, lane);
            csb_step(Z, X1, Zf, uc0 + c + 1, nb, lane);
        }
    }
}
__device__ __forceinline__ void p_cs_c(const Frame& F, ArgsP a) {
    const int lane = lane_id_fresh(), hi = lane >> 5;
    LAS unsigned char* wl = F.lds + F.wave * CS_WAVE;
    CsIn in{(const bf16*)(F.ws + WS_ZR), (const bf16*)(F.ws + WS_A), (const bf16*)(F.ws + WS_LW), (const bf16*)(F.dob + DO_G), a->in[I_MU], a->in[I_KK], a->in[I_KA], a->in[I_RK]};
    const bf16* Zf = (const bf16*)(F.dob + DO_CSZ); bf16* Y = (bf16*)(F.ws + WS_Y); const float* lnw = a->in[I_LNW]; const float* lnb = a->in[I_LNB];
    const LAS float* btt = (const LAS float*)(wl + 8 * CS_IMG) + 64;
    for (int uc = F.gw; uc < 64 * CS_NCH; uc += F.NGW) {
        const int bh = uc / CS_NCH, c = uc % CS_NCH, b = bh >> 3, h = bh & 7; const size_t row0 = (size_t)b * SEQ;
        f32x16 Z[2][2], D[2];
        int lu = lane; asm volatile("" : "+v"(lu));
#pragma unroll
        for (int jb = 0; jb < 2; ++jb)
#pragma unroll
            for (int nb = 0; nb < 2; ++nb) { const u32x4* p = (const u32x4*)(Zf + (size_t)uc * 4096 + ((jb * 2 + nb) * 64 + lu) * 16); float g0[8], g1[8]; unpack8(p[0], g0); unpack8(p[1], g1);
#pragma unroll
                for (int q = 0; q < 8; ++q) { Z[jb][nb][q] = g0[q]; Z[jb][nb][8 + q] = g1[q]; } }
        const float lw0 = lnw[h * 64 + (lu & 31)], lw1 = lnw[h * 64 + 32 + (lu & 31)], lb0 = lnb[h * 64 + (lu & 31)], lb1 = lnb[h * 64 + 32 + (lu & 31)];
        for (int sc = 0; sc < CS_CH / 16; ++sc) {
            const int tok0 = c * CS_CH + sc * 16;
            int ln = lane; asm volatile("" : "+v"(ln));
            cs_prep<true, true>(in, row0, tok0, h, wl, ln); asm volatile("s_waitcnt lgkmcnt(0)" ::: "memory");
            cs_step<true, true>(Z, D, wl, ln); asm volatile("s_waitcnt lgkmcnt(0)" ::: "memory");
            const int hl = ln >> 5;
            const bf16x8 v0 = cs_trfrag(wl + IM_V * CS_IMG, 0, ln), v1 = cs_trfrag(wl + IM_V * CS_IMG, 1, ln), g0 = cs_trfrag(wl + IM_G * CS_IMG, 0, ln), g1 = cs_trfrag(wl + IM_G * CS_IMG, 1, ln);
            const f32x4 bta = *(const LAS f32x4*)(btt + 4 * hl), btb = *(const LAS f32x4*)(btt + 8 + 4 * hl); const float bt[8] = {bta.x, bta.y, bta.z, bta.w, btb.x, btb.y, btb.z, btb.w};
#pragma unroll
            for (int q = 0; q < 8; ++q) {
                const float y0 = D[0][8 + q], y1 = D[1][8 + q];
                const float mean = allsum32(y0 + y1) * (1.f / 64.f); const float d0 = y0 - mean, d1 = y1 - mean;
                const float rstd = 1.0f / sqrtf(allsum32(d0 * d0 + d1 * d1) * (1.f / 64.f) + LN_X_EPS);
                const float o0 = (d0 * rstd * lw0 + lb0 + bt[q] * bf2f((unsigned short)v0[q])) * bf2f((unsigned short)g0[q]);
                const float o1 = (d1 * rstd * lw1 + lb1 + bt[q] * bf2f((unsigned short)v1[q])) * bf2f((unsigned short)g1[q]);
                bf16* yp = Y + (row0 + tok0 + crow8(q, hl)) * YYLD + h * 64 + (ln & 31);
                yp[0] = (unsigned short)f2bf(o0); yp[32] = (unsigned short)f2bf(o1);
            }
            asm volatile("s_waitcnt lgkmcnt(0)" ::: "memory");
        }
    }
}

__device__ __forceinline__ void p_post_scan(const Frame& F, ArgsP a, bf16* YD) {
    const int lane_f = lane_id_fresh();
    bf16* Y = (bf16*)(F.ws + WS_Y); const bf16* ZR = (const bf16*)(F.ws + WS_ZR); const bf16* A = (const bf16*)(F.ws + WS_A); const bf16* G = (const bf16*)(F.dob + DO_G);
    const float* lnw = a->in[I_LNW]; const float* lnb = a->in[I_LNB]; const float* rk = a->in[I_RK]; const float* mu = a->in[I_MU]; const float* k_a = a->in[I_KA];
    const int lane = lane_f;
    for (int m = F.gw; m < NTOK; m += F.NGW) {
        const bool first = (m % SEQ) == 0; const size_t mp = first ? m : m - 1;
        float y[8], r[8], k[8], v[8], g[8], o[8], t[8], av[8];
        unpack8(*((const u32x4*)(Y + (size_t)m * 512) + lane), y); unpack8(*((const u32x4*)(G + (size_t)m * 512) + lane), g); unpack8(*((const u32x4*)(A + (size_t)m * 512) + lane), av);
        unpack8(*((const u32x4*)(ZR + (size_t)m * 1792) + lane), r); unpack8(*((const u32x4*)(ZR + mp * 1792) + lane), t);
#pragma unroll
        for (int i = 0; i < 8; ++i) r[i] += ((first ? 0.f : t[i]) - r[i]) * mu[8 * lane + i];
        unpack8(*((const u32x4*)(ZR + (size_t)m * 1792 + 512) + lane), k); unpack8(*((const u32x4*)(ZR + mp * 1792 + 512) + lane), t);
#pragma unroll
        for (int i = 0; i < 8; ++i) { const float zk = k[i] + ((first ? 0.f : t[i]) - k[i]) * mu[512 + 8 * lane + i]; k[i] = zk * (1.f + (av[i] - 1.f) * k_a[8 * lane + i]); }
        unpack8(*((const u32x4*)(ZR + (size_t)m * 1792 + 1024) + lane), v); unpack8(*((const u32x4*)(ZR + mp * 1792 + 1024) + lane), t);
#pragma unroll
        for (int i = 0; i < 8; ++i) v[i] += ((first ? 0.f : t[i]) - v[i]) * mu[1024 + 8 * lane + i];
        float s = 0.f, d = 0.f;
#pragma unroll
        for (int i = 0; i < 8; ++i) { s += y[i]; d += r[i] * k[i] * rk[8 * lane + i]; }
        const float mean = sum8(s) * (1.f / 64.f); d = sum8(d); float q = 0.f;
#pragma unroll
        for (int i = 0; i < 8; ++i) { y[i] -= mean; q += y[i] * y[i]; }
        const float rstd = 1.0f / sqrtf(sum8(q) * (1.f / 64.f) + LN_X_EPS);
#pragma unroll
        for (int i = 0; i < 8; ++i) o[i] = (y[i] * rstd * lnw[8 * lane + i] + lnb[8 * lane + i] + d * v[i]) * g[i];
        *((u32x4*)(YD + (size_t)m * 512) + lane) = pack8(o);
    }
}

__device__ __forceinline__ void p_ffn_route(const Frame& F, ArgsP a, unsigned* cnt, int* route) {
    const int lane_f = lane_id_fresh(), tid_f = F.wave * 64 + lane_f;
    const float* X = a->in[I_X]; const bf16* MO = (const bf16*)(F.ws + WS_MO); bf16* H2 = (bf16*)(F.ws + WS_H2); const float* mod = (const float*)(F.ws + WS_MOD); const float* g = a->in[I_GFFN];
    LAS float* wr = (LAS float*)F.lds;
    __syncthreads();
    for (int i = tid_f; i < 1024 * 4; i += NTHR) { const int k = i >> 2, o = i & 3; wr[o * 1024 + k] = a->in[I_WRG][i]; }
    for (int i = tid_f; i < 1024 * 32; i += NTHR) { const int k = i >> 5, o = i & 31; wr[(4 + o) * 1024 + k] = a->in[I_WRE][i]; }
    __syncthreads();
    LAS float* brl = wr + 36 * 1024;
    if (tid_f < 4) brl[tid_f] = a->in[I_BRG][tid_f]; else if (tid_f < 36) brl[tid_f] = a->in[I_BRE][tid_f - 4];
    const int lane = lane_f;
    LAS unsigned* lcnt = (LAS unsigned*)(F.lds + LDS_MISC + 512);
    if (tid_f < 64) lcnt[tid_f] = 0u;
    __syncthreads();
    int my_e0 = 0, my_e1 = 0; float my_w0 = 0.f, my_w1 = 0.f; int kk_ = 0;
    f32x4 xa[4], xb[4]; u32x2 ma[4], mb[4]; f32x4 gmv[4], gsv[4], shv[4]; int bcur = -1;
    { const f32x4* xr = (const f32x4*)(X + (size_t)F.gw * 1024) + lane; const u32x2* mr = (const u32x2*)(MO + (size_t)F.gw * 1024) + lane;
#pragma unroll
      for (int j = 0; j < 4; ++j) { xa[j] = xr[64 * j]; ma[j] = mr[64 * j]; } }
#define RT_ROW(CX, CM, NX, NM, m_) do { const int mm = (m_); const int b = mm / SEQ; \
        if (b != bcur) { bcur = b; \
            _Pragma("unroll") for (int j = 0; j < 4; ++j) { const int col = 4 * lane + 256 * j; gmv[j] = *(const f32x4*)(mod + b * 6144 + 2048 + col); \
                gsv[j] = *(const f32x4*)(g + col) * (*(const f32x4*)(mod + b * 6144 + 4096 + col) + 1.0f); shv[j] = *(const f32x4*)(mod + b * 6144 + 3072 + col); } \
            asm volatile("s_waitcnt vmcnt(0)" : "+v"(gmv[0]), "+v"(gmv[1]), "+v"(gmv[2]), "+v"(gmv[3]), "+v"(gsv[0]), "+v"(gsv[1]), "+v"(gsv[2]), "+v"(gsv[3]), "+v"(shv[0]), "+v"(shv[1]), "+v"(shv[2]), "+v"(shv[3])); \
            asm volatile("" : "+v"(CX[0]), "+v"(CX[1]), "+v"(CX[2]), "+v"(CX[3]), "+v"(CM[0]), "+v"(CM[1]), "+v"(CM[2]), "+v"(CM[3])); } \
        { const int mn = (mm + F.NGW < NTOK) ? mm + F.NGW : mm; const f32x4* xr = (const f32x4*)(X + (size_t)mn * 1024) + lane; const u32x2* mr = (const u32x2*)(MO + (size_t)mn * 1024) + lane; \
          _Pragma("unroll") for (int j = 0; j < 4; ++j) { NX[j] = xr[64 * j]; NM[j] = mr[64 * j]; } } \
        f32x4 v[4]; float s = 0.f; \
        _Pragma("unroll") for (int j = 0; j < 4; ++j) { v[j] = CX[j] + gmv[j] * (f32x4){lo2f(CM[j].x), hi2f(CM[j].x), lo2f(CM[j].y), hi2f(CM[j].y)}; \
            s += (v[j].x * v[j].x + v[j].y * v[j].y) + (v[j].z * v[j].z + v[j].w * v[j].w); } \
        const float rstd = 1.0f / sqrtf(wave_sum(s) * (1.f / 1024.f) + EPS); \
        u32x2* o = (u32x2*)(H2 + (size_t)mm * 1024) + lane; \
        _Pragma("unroll") for (int j = 0; j < 4; ++j) { v[j] = v[j] * rstd * gsv[j] + shv[j]; u32x2 w; w.x = pk2(v[j].x, v[j].y); w.y = pk2(v[j].z, v[j].w); o[64 * j] = w; } \
        float lgq[4]; \
        _Pragma("unroll") for (int oo = 0; oo < 4; ++oo) { float p = 0.f; \
            _Pragma("unroll") for (int j = 0; j < 4; ++j) { const f32x4 w4 = *(const LAS f32x4*)(wr + oo * 1024 + 4 * lane + 256 * j); p += (v[j].x * w4.x + v[j].y * w4.y) + (v[j].z * w4.z + v[j].w * w4.w); } \
            lgq[oo] = wave_sum(p) + brl[oo]; } \
        int gi = 0; float gmx = lgq[0]; \
        _Pragma("unroll") for (int i = 1; i < 4; ++i) { if (lgq[i] > gmx) { gmx = lgq[i]; gi = i; } } \
        float gsum = 0.f; \
        _Pragma("unroll") for (int i = 0; i < 4; ++i) gsum += __expf(lgq[i] - gmx); \
        const float pg = 1.f / gsum; \
        gi = __builtin_amdgcn_readfirstlane(gi); \
        float el[8]; \
        { const LAS float* wg = wr + (4 + gi * 8) * 1024 + 4 * lane; \
          _Pragma("unroll") for (int i = 0; i < 8; ++i) { float p = 0.f; \
              _Pragma("unroll") for (int j = 0; j < 4; ++j) { const f32x4 w4 = *(const LAS f32x4*)(wg + i * 1024 + 256 * j); p += (v[j].x * w4.x + v[j].y * w4.y) + (v[j].z * w4.z + v[j].w * w4.w); } \
              el[i] = wave_sum(p) + brl[4 + gi * 8 + i]; } } \
        int i0 = 0; float m0 = el[0]; \
        _Pragma("unroll") for (int i = 1; i < 8; ++i) if (el[i] > m0) { m0 = el[i]; i0 = i; } \
        int i1 = -1; float m1 = -INFINITY; \
        _Pragma("unroll") for (int i = 0; i < 8; ++i) if (i != i0 && el[i] > m1) { m1 = el[i]; i1 = i; } \
        const float e1 = __expf(m1 - m0), w0 = pg / (1.f + e1), w1 = pg * e1 / (1.f + e1); \
        if (lane == kk_) { my_e0 = gi * 8 + i0; my_e1 = gi * 8 + i1; my_w0 = w0; my_w1 = w1; } \
        ++kk_; } while (0)
    for (int m = F.gw; m < NTOK; m += 2 * F.NGW) {
        RT_ROW(xa, ma, xb, mb, m);
        if (m + F.NGW < NTOK) RT_ROW(xb, mb, xa, ma, m + F.NGW);
    }
#undef RT_ROW
    unsigned lp0 = 0u, lp1 = 0u;
    if (lane < kk_) { lp0 = __hip_atomic_fetch_add(lcnt + my_e0, 1u, __ATOMIC_RELAXED, __HIP_MEMORY_SCOPE_WORKGROUP); lp1 = __hip_atomic_fetch_add(lcnt + my_e1, 1u, __ATOMIC_RELAXED, __HIP_MEMORY_SCOPE_WORKGROUP); }
    __syncthreads();
    if (tid_f < 32) lcnt[32 + tid_f] = __hip_atomic_fetch_add(cnt + tid_f, lcnt[tid_f], __ATOMIC_RELAXED, __HIP_MEMORY_SCOPE_AGENT);
    __syncthreads();
    if (lane < kk_) { const int m = F.gw + lane * F.NGW; int* rt = route + (size_t)m * 8;
        rt[0] = my_e0; rt[1] = my_e1; rt[2] = (int)(lcnt[32 + my_e0] + lp0); rt[3] = (int)(lcnt[32 + my_e1] + lp1); rt[4] = __builtin_bit_cast(int, my_w0); rt[5] = __builtin_bit_cast(int, my_w1); }
    __syncthreads();
}
__device__ __forceinline__ int moe_tables(const Frame& F, LAS int* offs, LAS int* texp) {
    const int lane_f = lane_id_fresh(), tid_f = F.wave * 64 + lane_f;
    const unsigned* cnt = (const unsigned*)(F.ws + WS_CTL) + CW_CNT;
    __syncthreads();
    if (tid_f == 0) { int o = 0; for (int e = 0; e < 32; ++e) { offs[e] = o; const int c = (int)__hip_atomic_load(cnt + e, __ATOMIC_RELAXED, __HIP_MEMORY_SCOPE_AGENT); const int nt = (c + 255) >> 8; for (int t = 0; t < nt; ++t) texp[(o >> 8) + t] = e; o += nt << 8; } offs[32] = o; }
    __syncthreads();
    return offs[32] >> 8;
}
__device__ __forceinline__ void p_gather(const Frame& F) {
    const int lane_f = lane_id_fresh(), tid_f = F.wave * 64 + lane_f;
    LAS int* offs = (LAS int*)(F.lds + 1024); LAS int* texp = (LAS int*)(F.lds + 2048);
    moe_tables(F, offs, texp);
    const int* route = (const int*)(F.ws + WS_ROUTE); int* ridx = (int*)(F.ws + WS_ENT);
    const unsigned* cnt = (const unsigned*)(F.ws + WS_CTL) + CW_CNT;
    for (int m = F.vcu * NTHR + tid_f; m < NTOK; m += F.G * NTHR) { const u32x4 rt = *(const u32x4*)(route + (size_t)m * 8); ridx[offs[rt.x] + (int)rt.z] = m; ridx[offs[rt.y] + (int)rt.w] = m; }
    for (int i = F.vcu * NTHR + tid_f; i < 32 * 256; i += F.G * NTHR) { const int e = i >> 8, r = i & 255; const int c = (int)cnt[e]; const int pad = ((c + 255) & ~255) - c; if (r < pad) ridx[offs[e] + c + r] = 0; }
    __syncthreads();
}
__device__ __forceinline__ void p_combine(const Frame& F, const float* xin, float* dst) {
    const int lane_f = lane_id_fresh(), tid_f = F.wave * 64 + lane_f;
    LAS int* offs = (LAS int*)(F.lds + 1024); LAS int* texp = (LAS int*)(F.lds + 2048);
    moe_tables(F, offs, texp);
    const bf16* MO = (const bf16*)(F.ws + WS_MO); const bf16* YS = (const bf16*)(F.ws + WS_YS); const int* route = (const int*)(F.ws + WS_ROUTE); const float* mod = (const float*)(F.ws + WS_MOD);
    const int lane = lane_f;
    for (int m = F.gw; m < NTOK; m += F.NGW) {
        const int b = m / SEQ; const int* rt = route + (size_t)m * 8; const int d0 = offs[rt[0]] + rt[2], d1 = offs[rt[1]] + rt[3];
        const float w0 = __builtin_bit_cast(float, rt[4]), w1 = __builtin_bit_cast(float, rt[5]);
#pragma unroll
        for (int j = 0; j < 2; ++j) { const int col = 8 * lane + 512 * j; float y0[8], y1[8];
            unpack8(*(const u32x4*)(YS + (size_t)d0 * 1024 + col), y0); unpack8(*(const u32x4*)(YS + (size_t)d1 * 1024 + col), y1);
            const float* o = xin + (size_t)m * 1024 + col; const float* gt = mod + b * 6144 + 5120 + col; const float* gm = mod + b * 6144 + 2048 + col; float mo[8]; unpack8(*(const u32x4*)(MO + (size_t)m * 1024 + col), mo);
            f32x4 x0 = *(const f32x4*)o, x1 = *(const f32x4*)(o + 4); const f32x4 g0 = *(const f32x4*)gt, g1 = *(const f32x4*)(gt + 4), h0 = *(const f32x4*)gm, h1 = *(const f32x4*)(gm + 4);
            x0.x += h0.x * mo[0]; x0.y += h0.y * mo[1]; x0.z += h0.z * mo[2]; x0.w += h0.w * mo[3]; x1.x += h1.x * mo[4]; x1.y += h1.y * mo[5]; x1.z += h1.z * mo[6]; x1.w += h1.w * mo[7];
            x0.x += g0.x * (w0 * y0[0] + w1 * y1[0]); x0.y += g0.y * (w0 * y0[1] + w1 * y1[1]); x0.z += g0.z * (w0 * y0[2] + w1 * y1[2]); x0.w += g0.w * (w0 * y0[3] + w1 * y1[3]);
            x1.x += g1.x * (w0 * y0[4] + w1 * y1[4]); x1.y += g1.y * (w0 * y0[5] + w1 * y1[5]); x1.z += g1.z * (w0 * y0[6] + w1 * y1[6]); x1.w += g1.w * (w0 * y0[7] + w1 * y1[7]);
            float* od = dst + (size_t)m * 1024 + col; *(f32x4*)od = x0; *(f32x4*)(od + 4) = x1; }
    }
}

constexpr int NPHASE = 17;
template <int LO, int HI>
__global__ void __launch_bounds__(NTHR, 2) fwd(Args args) {
    extern __shared__ __attribute__((aligned(16))) unsigned char lds_raw[];
    Frame F;
    F.lds = (LAS unsigned char*)lds_raw;
    F.wave = __builtin_amdgcn_readfirstlane((int)threadIdx.x >> 6);
    F.G = gridDim.x; { const int bx = blockIdx.x; F.vcu = (F.G % 8 == 0) ? (bx % 8) * (F.G / 8) + bx / 8 : bx; }
    F.gw = F.vcu * NWAVES + F.wave; F.NGW = F.G * NWAVES;
    F.ws = args.ws; F.dob = (unsigned char*)args.out;
    ArgsP AP = (ArgsP)__builtin_amdgcn_kernarg_segment_ptr();
    volatile LAS unsigned* MISC = (volatile LAS unsigned*)(F.lds + LDS_MISC);
    if (threadIdx.x < 64) MISC[threadIdx.x] = 0u;
    __syncthreads();
    XcdBarrier bar; bar.bar = (unsigned*)(F.ws + WS_CTL) + CW_BAR; bar.x = 0; bar.st = MISC + 8;
#if N_LAUNCH_MODE == 1
    bar = xcd_barrier_post((unsigned*)(F.ws + WS_CTL) + CW_BAR, MISC + 8);
#define GRID_BAR() xcd_barrier(bar)
#else
#define GRID_BAR() do { } while (0)
#endif
#ifndef PROBE_REPEAT
#define PROBE_REPEAT -1
#endif
#define IN(k) (LO <= (k) && (k) < HI)
#define SEAM(k) do { if constexpr (IN(k) && IN((k) + 1)) GRID_BAR(); } while (0)
    const float* mod = (const float*)(F.ws + WS_MOD);

#define PH(k, ...) do { if constexpr (IN(k)) { asm volatile("" : "+s"(AP)); { __VA_ARGS__ } if constexpr (PROBE_REPEAT == (k)) { GRID_BAR(); asm volatile("" : "+s"(AP)); { __VA_ARGS__ } } } } while (0)
    PH(0, p0_prologue(F, AP);); SEAM(0);
    PH(1, p_normmod(F, AP->in[I_X], AP->in[I_GMIX], mod, 0, 1024, (bf16*)(F.ws + WS_H));); SEAM(1);
    PH(2, Gemm g{(const bf16*)(F.ws + WS_H), (const bf16*)(F.ws + WS_WIN), NTOK, N_IN_PAD, 1024}; StaticOrder S; S.init(NTOK, N_IN_PAD, F.G, (int)blockIdx.x);
        EpiZ E{(bf16*)(F.ws + WS_ZR), (bf16*)(F.ws + WS_SG), (bf16*)(F.ws + WS_ZM)}; gemm_phase_any(F.lds, g, S, E, F.wave);); SEAM(2);
    PH(3, p_prep_a(F, AP);); SEAM(3);
    PH(4,
        { Gemm g{(const bf16*)(F.ws + WS_TWA), (const bf16*)(F.ws + WS_WBLK), NTOK, 1024, 128}; StaticOrder S; S.init(NTOK, 1024, F.G, (int)blockIdx.x);
          EpiLora E{(bf16*)(F.ws + WS_LW), (bf16*)(F.ws + WS_A), AP->in[I_W0], AP->in[I_A0]}; gemm_phase_any(F.lds, g, S, E, F.wave); }
        { Gemm g{(const bf16*)(F.ws + WS_SGL), (const bf16*)(F.ws + WS_WG), NTOK, 512, 128}; StaticOrder S; S.init(NTOK, 512, F.G, (int)blockIdx.x);
          EpiPlain E{(bf16*)(F.dob + DO_G), nullptr, 1 << 30, 512, 0}; gemm_phase_any(F.lds, g, S, E, F.wave); }
        { Gemm g{(const bf16*)(F.ws + WS_QA), (const bf16*)(F.ws + WS_WUQ), NTOK, 768, 256}; StaticOrder S; S.init(NTOK, 768, F.G, (int)blockIdx.x);
          EpiPlain E{(bf16*)(F.dob + DO_Q), nullptr, 1 << 30, 768, 0}; gemm_phase_any(F.lds, g, S, E, F.wave); }
        { Gemm g{(const bf16*)(F.ws + WS_KVA), (const bf16*)(F.ws + WS_WUKV), NTOK, 1024, 128}; StaticOrder S; S.init(NTOK, 1024, F.G, (int)blockIdx.x);
          EpiPlain E{(bf16*)(F.dob + DO_KN), (bf16*)(F.ws + WS_VC), 512, 512, 512}; gemm_phase_any(F.lds, g, S, E, F.wave); }
    ); SEAM(4);
    PH(5, p_prep_c(F, AP);); SEAM(5);
#if ENG_ATTN == 1
    PH(6, p_attn_mfma(F);); SEAM(6);
#else
    PH(6, p_attn_naive(F);); SEAM(6);
#endif
    PH(7, p_cs_a(F, AP);); SEAM(7);
    PH(8, p_cs_b(F);); SEAM(8);
    PH(9, p_cs_c(F, AP);); SEAM(9);
    PH(10, Gemm g{(const bf16*)(F.ws + WS_Y), (const bf16*)(F.ws + WS_WB), NTOK, 1024, 1024}; StaticOrder S; S.init(NTOK, 1024, F.G, (int)blockIdx.x);
        EpiBranch2 E{(bf16*)(F.ws + WS_MG), (const bf16*)(F.ws + WS_SG)}; gemm_phase_mid(F.lds, g, S, E, F.wave);); SEAM(10);
    PH(11, Gemm g{(const bf16*)(F.ws + WS_MG), (const bf16*)(F.ws + WS_WO), NTOK, 1024, 1024}; StaticOrder S; S.init(NTOK, 1024, F.G, (int)blockIdx.x);
        EpiPlain E{(bf16*)(F.ws + WS_MO), nullptr, 1 << 30, 1024, 0}; gemm_phase_any(F.lds, g, S, E, F.wave);); SEAM(11);
    if constexpr (PROBE_REPEAT == 12) { p_ffn_route(F, AP, (unsigned*)(F.ws + WS_CTL) + CW_CNT + 64, (int*)(F.ws + WS_CS)); GRID_BAR(); }
    if constexpr (IN(12)) { asm volatile("" : "+s"(AP)); p_ffn_route(F, AP, (unsigned*)(F.ws + WS_CTL) + CW_CNT, (int*)(F.ws + WS_ROUTE)); } SEAM(12);
    PH(13, p_gather(F);); SEAM(13);
    PH(14, LAS int* offs = (LAS int*)(F.lds + LDS_MISC + 1024); LAS int* texp = (LAS int*)(F.lds + LDS_MISC + 1024 + 256); const int nt = moe_tables(F, offs, texp);
        Gemm g{(const bf16*)(F.ws + WS_H2), (const bf16*)(F.ws + WS_WGU), MPAD, 512, 1024, (const int*)(F.ws + WS_ENT)}; TableOrder S{texp, nt, 2, F.G, (int)blockIdx.x};
        EpiGateUp E{(bf16*)(F.ws + WS_HID)}; gemm_phase_gather(F.lds, g, S, E, F.wave);); SEAM(14);
    PH(15, LAS int* offs = (LAS int*)(F.lds + LDS_MISC + 1024); LAS int* texp = (LAS int*)(F.lds + LDS_MISC + 1024 + 256); const int nt = moe_tables(F, offs, texp);
        Gemm g{(const bf16*)(F.ws + WS_HID), (const bf16*)(F.ws + WS_WDN), MPAD, 1024, 256}; TableOrder S{texp, nt, 4, F.G, (int)blockIdx.x};
        EpiDown E{(bf16*)(F.ws + WS_YS)}; gemm_phase_any(F.lds, g, S, E, F.wave);); SEAM(15);
    if constexpr (PROBE_REPEAT == 16) { asm volatile("" : "+s"(AP)); p_combine(F, AP->in[I_X], (float*)(F.ws + WS_SG)); GRID_BAR(); }
    if constexpr (IN(16)) { asm volatile("" : "+s"(AP)); p_combine(F, AP->in[I_X], (float*)F.dob); }
}

#if N_LAUNCH_MODE == 1
static bool set_attrs() { return hipFuncSetAttribute((const void*)fwd<0, NPHASE>, hipFuncAttributeMaxDynamicSharedMemorySize, LDS_BYTES) == hipSuccess; }
#else
template <int P> static bool set_attr_all() { if constexpr (P < NPHASE) { return hipFuncSetAttribute((const void*)fwd<P, P + 1>, hipFuncAttributeMaxDynamicSharedMemorySize, LDS_BYTES) == hipSuccess && set_attr_all<P + 1>(); } else return true; }
static bool set_attrs() { return set_attr_all<0>(); }
template <int P> static void launch_all(int grid, hipStream_t stream, const Args& a) { if constexpr (P < NPHASE) { hipLaunchKernelGGL((fwd<P, P + 1>), dim3(grid), dim3(NTHR), LDS_BYTES, stream, a); launch_all<P + 1>(grid, stream, a); } }
#endif
extern "C" void kernel_launch(void* const* d_in, const int* in_sizes, int n_in, void* d_out, int out_size, void* d_ws, size_t ws_size, hipStream_t stream) {
    static int grid = 0;
    if (grid == 0) {
        if (n_in != 34 || out_size != NTOK * DM || ws_size < WS_END) { fprintf(stderr, "kernel_launch: unexpected shapes (n_in %d out %d ws %zu)\n", n_in, out_size, ws_size); grid = -1; return; }
        int dev = 0, cus = 0;
        if (hipGetDevice(&dev) != hipSuccess || hipDeviceGetAttribute(&cus, hipDeviceAttributeMultiprocessorCount, dev) != hipSuccess) { grid = -1; return; }
        if (!set_attrs()) { fprintf(stderr, "kernel_launch: hipFuncSetAttribute failed\n"); grid = -1; return; }
        grid = cus;
    }
    if (grid < 0) return;
    (void)hipMemsetAsync((char*)d_ws + WS_CTL, 0, CTL_ZERO_BYTES, stream);
    Args a{};
    for (int i = 0; i < 34; ++i) a.in[i] = (const float*)d_in[i];
    a.out = (float*)d_out; a.ws = (unsigned char*)d_ws;
    a.ph_lo = 0; a.ph_hi = NPHASE;
#if N_LAUNCH_MODE == 1
    hipLaunchKernelGGL((fwd<0, NPHASE>), dim3(grid), dim3(NTHR), LDS_BYTES, stream, a);
#else
    launch_all<0>(grid, stream, a);
#endif
}
```

```cpp
#include <hip/hip_runtime.h>
#include <cstdio>
#include <cstdint>

#ifndef N_LAUNCH_MODE
#define N_LAUNCH_MODE 1
#endif
#ifndef ENG_GEMM
#define ENG_GEMM 1
#endif
#ifndef ENG_ATTN
#define ENG_ATTN 1
#endif

#define GAS __attribute__((address_space(1)))
#define LAS __attribute__((address_space(3)))
typedef unsigned short bf16;
typedef float f32x4 __attribute__((ext_vector_type(4)));
typedef float f32x2 __attribute__((ext_vector_type(2)));
typedef unsigned u32x4 __attribute__((ext_vector_type(4)));
typedef unsigned u32x2 __attribute__((ext_vector_type(2)));
typedef short bf16x8 __attribute__((ext_vector_type(8)));

constexpr int BATCH = 8, SEQ = 8192, DM = 1024, NTOK = BATCH * SEQ;
constexpr int D_RWKV = 512, RWKV_COLS = 1792, MLA_COLS = 416, D_IN = 4256, N_IN_PAD = 4352;
constexpr int NH = 8, QKD = 96, NOPE = 64, ROPE = 32, VD = 64;
constexpr int NEXP = 32, DEXP = 256;
constexpr int MPAD = 139264;
constexpr float EPS = 1e-6f, LN_X_EPS = 64e-5f;
constexpr float QSCALE = 0.10206207261596577f * 1.4426950408889634f;

constexpr size_t MiB = 1u << 20;
constexpr size_t WS_CTL = 0, CTL_ZERO_BYTES = 1 * MiB;
constexpr size_t WS_MOD = 1 * MiB;
constexpr size_t WS_ROUTE = 2 * MiB;
constexpr size_t WS_CS = 4 * MiB;
constexpr size_t WS_ENT = 12 * MiB;
constexpr size_t WS_WIN = 16 * MiB;
constexpr size_t WS_WBLK = 25 * MiB;
constexpr size_t WS_WG = WS_WBLK + 256 * 1024;
constexpr size_t WS_WUQ = WS_WG + 128 * 1024;
constexpr size_t WS_WUKV = WS_WUQ + 384 * 1024;
constexpr size_t WS_WB = 26 * MiB;
constexpr size_t WS_WO = 28 * MiB;
constexpr size_t WS_WGU = 30 * MiB;
constexpr size_t WS_WDN = 62 * MiB;
constexpr size_t WS_SG = 80 * MiB;
constexpr size_t WS_H2 = 80 * MiB;
constexpr size_t WS_ZR = 336 * MiB;
constexpr size_t WS_VC = 816 * MiB;
constexpr size_t WS_KC = 880 * MiB;
constexpr size_t WS_Y = 560 * MiB;
constexpr size_t WS_XG = 336 * MiB;
constexpr size_t WS_ZM = 560 * MiB;
constexpr size_t WS_YM = 560 * MiB + 1024;
constexpr size_t WS_H = 688 * MiB;
constexpr size_t WS_LW = 688 * MiB;
constexpr size_t WS_A = 752 * MiB;
constexpr size_t WS_MG = 688 * MiB;
constexpr size_t WS_HID = 208 * MiB;
constexpr size_t WS_R = 752 * MiB;
constexpr size_t WS_V = 816 * MiB;
constexpr size_t WS_ZK = 880 * MiB;
constexpr size_t WS_TWA = 944 * MiB;
constexpr size_t WS_SGL = 960 * MiB;
constexpr size_t WS_QA = 976 * MiB;
constexpr size_t WS_KVA = 1008 * MiB;
constexpr size_t WS_KK = 944 * MiB;
constexpr size_t WS_YS = 752 * MiB;
constexpr size_t WS_MO = 560 * MiB;
constexpr int YYLD = 1024;
constexpr size_t WS_END = 1024 * MiB;
constexpr size_t DO_G = 0;
constexpr size_t DO_Q = 64 * MiB;
constexpr size_t DO_KN = 160 * MiB;

constexpr int CW_CNT = 64;
constexpr int CW_BAR = 4096;

constexpr int NWAVES = 8, NTHR = 512;
constexpr int LDS_BYTES = 155648;
constexpr int LDS_MISC = 151552;

__device__ __forceinline__ int lane_id_fresh() { int l; asm volatile("v_mbcnt_lo_u32_b32 %0, -1, 0\n\tv_mbcnt_hi_u32_b32 %0, -1, %0" : "=v"(l)); return l; }
__device__ __forceinline__ float bf2f(unsigned short h) { return __builtin_bit_cast(float, (unsigned)h << 16); }
__device__ __forceinline__ unsigned f2bf(float f) { unsigned u = __builtin_bit_cast(unsigned, f); return (u + 0x7fffu + ((u >> 16) & 1u)) >> 16; }
typedef __bf16 bf16x2_t __attribute__((ext_vector_type(2)));
__device__ __forceinline__ unsigned pk2(float lo, float hi) { const f32x2 v = {lo, hi}; return __builtin_bit_cast(unsigned, __builtin_convertvector(v, bf16x2_t)); }
__device__ __forceinline__ float lo2f(unsigned w) { return __builtin_bit_cast(float, w << 16); }
__device__ __forceinline__ float hi2f(unsigned w) { return __builtin_bit_cast(float, w & 0xffff0000u); }
template <int CTRL> __device__ __forceinline__ float dpp_add(float x) { return x + __builtin_bit_cast(float, __builtin_amdgcn_update_dpp(0, __builtin_bit_cast(int, x), CTRL, 0xf, 0xf, false)); }
__device__ __forceinline__ float allsum16(float x) { x = dpp_add<0xB1>(x); x = dpp_add<0x4E>(x); x = dpp_add<0x141>(x); x = dpp_add<0x140>(x); return x; }
__device__ __forceinline__ float allsum32(float x) { x = allsum16(x); auto r = __builtin_amdgcn_permlane16_swap(__float_as_uint(x), __float_as_uint(x), false, false); return __uint_as_float(r[0]) + __uint_as_float(r[1]); }
__device__ __forceinline__ float sum8(float x) { x = dpp_add<0xB1>(x); x = dpp_add<0x4E>(x); x = dpp_add<0x141>(x); return x; }
__device__ __forceinline__ float wave_sum(float v) {
    v = allsum16(v);
    { auto r = __builtin_amdgcn_permlane16_swap(__float_as_uint(v), __float_as_uint(v), false, false); v = __uint_as_float(r[0]) + __uint_as_float(r[1]); }
    { auto r = __builtin_amdgcn_permlane32_swap(__float_as_uint(v), __float_as_uint(v), false, false); v = __uint_as_float(r[0]) + __uint_as_float(r[1]); }
    return v;
}
__device__ __forceinline__ float sigmoidf_(float x) { return __builtin_amdgcn_rcpf(1.f + __builtin_amdgcn_exp2f(-1.4426950408889634f * x)); }
__device__ __forceinline__ float siluf_(float x) { return x * __builtin_amdgcn_rcpf(1.f + __builtin_amdgcn_exp2f(-1.4426950408889634f * x)); }
__device__ __forceinline__ void unpack8(const u32x4 w, float (&v)[8]) {
    v[0] = lo2f(w.x); v[1] = hi2f(w.x); v[2] = lo2f(w.y); v[3] = hi2f(w.y); v[4] = lo2f(w.z); v[5] = hi2f(w.z); v[6] = lo2f(w.w); v[7] = hi2f(w.w);
}
__device__ __forceinline__ u32x4 pack8(const float (&v)[8]) { u32x4 w; w.x = pk2(v[0], v[1]); w.y = pk2(v[2], v[3]); w.z = pk2(v[4], v[5]); w.w = pk2(v[6], v[7]); return w; }

#define LDS_BAR() do { asm volatile("s_waitcnt lgkmcnt(0)" ::: "memory"); __builtin_amdgcn_s_barrier(); asm volatile("" ::: "memory"); } while (0)

#define XB_TMO      128
#define XB_XCNT(j)  (256  + 64 * (j))
#define XB_XSUB(j)  (1280 + 64 * (j))
#define XB_XGEN(j)  (2304 + 64 * (j))
#define XB_TOP      3328
#define XB_TOPGEN   3392
#define XCD_BAR_WORDS 3456
#define XB_SPIN_CAP (1u << 19)
__device__ __forceinline__ unsigned xb_ld(unsigned* p)              { return __hip_atomic_load(p, __ATOMIC_RELAXED, __HIP_MEMORY_SCOPE_AGENT); }
__device__ __forceinline__ unsigned xb_add(unsigned* p, unsigned v) { return __hip_atomic_fetch_add(p, v, __ATOMIC_RELAXED, __HIP_MEMORY_SCOPE_AGENT); }
__device__ __forceinline__ unsigned xb_xcc_id() { return (unsigned)__builtin_amdgcn_s_getreg((3 << 11) | 20) & 0xFu; }
#define XB_SPIN(cond, bar) do { unsigned _sp = 0; while (cond) { __builtin_amdgcn_s_sleep(1); \
    if ((++_sp & 255u) == 0u) { if (xb_ld(&(bar)[XB_TMO])) break; if (_sp > XB_SPIN_CAP) { atomicAdd(&(bar)[XB_TMO], 1u); break; } } } } while (0)
struct XcdBarrier { unsigned* bar; unsigned x; volatile LAS unsigned* st; };
__device__ __forceinline__ XcdBarrier xcd_barrier_post(unsigned* bar, volatile LAS unsigned* st) {
    XcdBarrier b; b.bar = bar; b.x = xb_xcc_id(); b.st = st;
    if (threadIdx.x == 0) (void)xb_add(&bar[XB_XCNT(b.x)], 1u);
    return b;
}
__device__ __forceinline__ void xcd_barrier_complete(unsigned* bar, unsigned x, unsigned& nloc, unsigned& nx) {
    const unsigned G = gridDim.x * gridDim.y * gridDim.z;
    unsigned sum, cnt, mine, sp = 0u;
    for (;;) {
        sum = 0u; cnt = 0u; mine = 0u;
#pragma unroll
        for (unsigned j = 0; j < 16; ++j) { const unsigned c = xb_ld(&bar[XB_XCNT(j)]); sum += c; cnt += (c > 0u) ? 1u : 0u; mine = (j == x) ? c : mine; }
        if (sum == G) break;
        __builtin_amdgcn_s_sleep(1);
        if ((++sp & 255u) == 0u) { if (xb_ld(&bar[XB_TMO])) break; if (sp > XB_SPIN_CAP) { atomicAdd(&bar[XB_TMO], 1u); break; } }
    }
    nloc = mine > 0u ? mine : 1u; nx = cnt > 0u ? cnt : 1u;
}
__device__ __forceinline__ void xcd_barrier(const XcdBarrier& b) {
    asm volatile("s_waitcnt vmcnt(0)" ::: "memory");
    __syncthreads();
    if (threadIdx.x == 0) {
        unsigned* bar = b.bar;
        __builtin_amdgcn_s_waitcnt(0);
        unsigned nloc = b.st[0], nx = b.st[1];
        if (nloc == 0u) { xcd_barrier_complete(bar, b.x, nloc, nx); b.st[0] = nloc; b.st[1] = nx; }
        const unsigned old = xb_add(&bar[XB_XSUB(b.x)], 1u);
        const unsigned gen = old / nloc;
        if (old + 1u == (gen + 1u) * nloc) {
            __builtin_amdgcn_fence(__ATOMIC_RELEASE, "agent");
            asm volatile("s_waitcnt vmcnt(0)" ::: "memory");
            const unsigned og = xb_add(&bar[XB_TOP], 1u);
            const unsigned tg = og / nx;
            if (og + 1u == (tg + 1u) * nx) xb_add(&bar[XB_TOPGEN], 1u);
            else XB_SPIN(xb_ld(&bar[XB_TOPGEN]) == tg, bar);
            __builtin_amdgcn_fence(__ATOMIC_ACQUIRE, "agent");
            xb_add(&bar[XB_XGEN(b.x)], 1u);
            asm volatile("s_waitcnt vmcnt(0)" ::: "memory");
        } else {
            XB_SPIN(xb_ld(&bar[XB_XGEN(b.x)]) == gen, bar);
            __builtin_amdgcn_fence(__ATOMIC_ACQUIRE, "agent");
            asm volatile("s_waitcnt vmcnt(0)" ::: "memory");
        }
    }
    __syncthreads();
}

struct Args {
    const float* in[34]; float* out; unsigned char* ws; int ph_lo, ph_hi;
};
typedef const __attribute__((address_space(4))) Args* ArgsP;
struct Frame {
    LAS unsigned char* lds;
    int wave, vcu, G, gw, NGW;
    unsigned char* ws; unsigned char* dob;
};
enum { I_X = 0, I_C, I_POS, I_WADA, I_BADA, I_GMIX, I_WIN, I_MU, I_W0, I_WDEC, I_A0, I_WAUP, I_WGUP, I_KK, I_KA, I_RK, I_LNW, I_LNB, I_GQA, I_WUQ, I_GKVA, I_WUKV,
       I_QN, I_KN, I_WBR, I_WOUT, I_GFFN, I_WRG, I_BRG, I_WRE, I_BRE, I_WEG, I_WEU, I_WED };

struct Unit { int pm, pn; };
struct Gemm { const bf16* A; const bf16* Bt; int M, N, K; const int* ridx = nullptr; };
constexpr int NXCD = 8, WGM = 8;
struct StaticOrder {
    int nM, nN, nwg, G, c;
    __device__ void init(int M, int N, int G_, int c_) { nM = M / 256; nN = N / 256; nwg = nM * nN; G = G_; c = c_; }
    __device__ bool next(int i, Unit& u) const {
        const long L = (long)i * G + c; if (L >= nwg) return false;
        int wgid = (int)L; { const int q = nwg / NXCD, r = nwg % NXCD, xcd = wgid % NXCD, off = wgid / NXCD; wgid = (xcd < r ? xcd * (q + 1) : r * (q + 1) + (xcd - r) * q) + off; }
        const int nig = WGM * nN, gid = wgid / nig, fm = gid * WGM, gsz = (nM - fm) < WGM ? (nM - fm) : WGM;
        u.pm = fm + ((wgid % nig) % gsz); u.pn = (wgid % nig) / gsz; return true;
    }
    __device__ __forceinline__ void a_ready(const Unit&) const {}
    __device__ __forceinline__ void done(const Unit&) const {}
};
struct TableOrder {
    const LAS int* texp; int ntiles, nN, G, c;
    __device__ bool next(int i, Unit& u) const {
        const long L = (long)i * G + c; if (L >= (long)ntiles * nN) return false;
        const int t = (int)(L / nN), j = (int)(L % nN); u.pm = t; u.pn = texp[t] * nN + j; return true;
    }
    __device__ __forceinline__ void a_ready(const Unit&) const {}
    __device__ __forceinline__ void done(const Unit&) const {}
};

template <class Epi, class Sched>
__device__ __forceinline__ void gemm_phase_naive(LAS unsigned char* lds, const Gemm g, const Sched& S, const Epi& E) {
    const int tid = (int)__builtin_amdgcn_readfirstlane((int)threadIdx.x >> 6) * 64 + lane_id_fresh(), ty = tid >> 5, tx = tid & 31;
    LAS bf16* As = (LAS bf16*)lds; LAS bf16* Bs = (LAS bf16*)(lds + 128 * 40 * 2);
    Unit u;
    for (int i = 0; S.next(i, u); ++i) {
        for (int half = 0; half < 2; ++half) {
            float acc[8][8];
#pragma unroll
            for (int r = 0; r < 8; ++r)
#pragma unroll
                for (int c = 0; c < 8; ++c) acc[r][c] = 0.f;
            const bf16* Ab = g.A + ((size_t)u.pm * 256 + half * 128) * g.K; const bf16* Bb = g.Bt + (size_t)u.pn * 256 * g.K;
            for (int k0 = 0; k0 < g.K; k0 += 32) {
                __syncthreads();
                { const int r = tid >> 2, c8 = (tid & 3) * 8; *(LAS u32x4*)(As + r * 40 + c8) = *(const u32x4*)(Ab + (size_t)r * g.K + k0 + c8); }
#pragma unroll
                for (int j = 0; j < 2; ++j) { const int ch = tid + j * 512, r = ch >> 2, c8 = (ch & 3) * 8; *(LAS u32x4*)(Bs + r * 40 + c8) = *(const u32x4*)(Bb + (size_t)r * g.K + k0 + c8); }
                __syncthreads();
#pragma unroll 2
                for (int k = 0; k < 32; k += 2) {
                    float b0[8], b1[8];
#pragma unroll
                    for (int c = 0; c < 8; ++c) { const unsigned w = *(const LAS unsigned*)(Bs + (tx * 8 + c) * 40 + k); b0[c] = lo2f(w); b1[c] = hi2f(w); }
#pragma unroll
                    for (int r = 0; r < 8; ++r) { const unsigned w = *(const LAS unsigned*)(As + (ty * 8 + r) * 40 + k); const float a0 = lo2f(w), a1 = hi2f(w);
#pragma unroll
                        for (int c = 0; c < 8; ++c) acc[r][c] = fmaf(a1, b1[c], fmaf(a0, b0[c], acc[r][c])); }
                }
            }
#pragma unroll
            for (int r = 0; r < 8; ++r) E.store8(u, half * 128 + ty * 8 + r, tx * 8, acc[r]);
        }
    }
    __syncthreads();
}

struct EpiZ { bf16 *ZR, *SG, *ZM;
    __device__ __forceinline__ void store8(const Unit& u, int r, int c, const float (&v)[8]) const {
        const size_t row = (size_t)u.pm * 256 + r;
        if (u.pn < 7) { *(u32x4*)(ZR + row * 1792 + u.pn * 256 + c) = pack8(v); }
        else if (u.pn < 15) { *(u32x4*)(SG + row * 2048 + (u.pn - 7) * 256 + c) = pack8(v); }
        else { *(u32x4*)(ZM + row * 512 + (u.pn - 15) * 256 + c) = pack8(v); }
    } };
struct EpiLora { bf16 *LW, *A; const float *w0, *a0;
    __device__ __forceinline__ void store8(const Unit& u, int r, int c, const float (&v)[8]) const {
        const size_t row = (size_t)u.pm * 256 + r; const int col = u.pn * 256 + c; float o[8];
        const bool isw = col < 512; const float* bp = isw ? (w0 + col) : (a0 + col - 512);
        const f32x4 b0 = *(const f32x4*)bp, b1 = *(const f32x4*)(bp + 4); const float bb[8] = {b0.x, b0.y, b0.z, b0.w, b1.x, b1.y, b1.z, b1.w};
#pragma unroll
        for (int i = 0; i < 8; ++i) { const float e = __builtin_amdgcn_exp2f(fminf(-1.4426950408889634f * (bb[i] + v[i]), 120.f)); const float s = __builtin_amdgcn_rcpf(1.0f + e); o[i] = isw ? -0.60653065971263342f * s : s; }
        bf16* dst = isw ? (LW + row * 512 + col) : (A + row * 512 + col - 512);
        *(u32x4*)dst = pack8(o);
    } };
struct EpiPlain { bf16* O0; bf16* O1; int split, ld0, ld1;
    __device__ __forceinline__ void store8(const Unit& u, int r, int c, const float (&v)[8]) const {
        const size_t row = (size_t)u.pm * 256 + r; int col = u.pn * 256 + c;
        if (col < split) *(u32x4*)(O0 + row * ld0 + col) = pack8(v); else *(u32x4*)(O1 + row * ld1 + col - split) = pack8(v);
    } };
struct EpiBranch2 { bf16* MG; const bf16* SG;
    __device__ __forceinline__ void mid8(const Unit& u, int r, int c, float (&v)[8]) const {
        const size_t row = (size_t)u.pm * 256 + r; const int col = u.pn * 256 + c; float gr[8], gm[8];
        unpack8(*(const u32x4*)(SG + row * 2048 + col), gr); unpack8(*(const u32x4*)(SG + row * 2048 + 1024 + col), gm);
#pragma unroll
        for (int i = 0; i < 8; ++i) v[i] *= (1.f + __builtin_amdgcn_exp2f(-1.4426950408889634f * gm[i])) * __builtin_amdgcn_rcpf(1.f + __builtin_amdgcn_exp2f(-1.4426950408889634f * gr[i]));
    }
    __device__ __forceinline__ void store8(const Unit& u, int r, int c, const float (&v)[8]) const {
        const size_t row = (size_t)u.pm * 256 + r; const int col = u.pn * 256 + c; float gm[8], o[8];
        unpack8(*(const u32x4*)(SG + row * 2048 + 1024 + col), gm);
#pragma unroll
        for (int i = 0; i < 8; ++i) o[i] = sigmoidf_(gm[i]) * v[i];
        *(u32x4*)(MG + row * 1024 + col) = pack8(o);
    } };
struct EpiGateUp { bf16* HID;
    __device__ __forceinline__ void store8(const Unit& u, int r, int c, const float (&v)[8]) const {
        const size_t row = (size_t)u.pm * 256 + r; const int col = ((u.pn & 1) * 256 + c) >> 1;
        u32x2 w; w.x = pk2(siluf_(v[0]) * v[4], siluf_(v[1]) * v[5]); w.y = pk2(siluf_(v[2]) * v[6], siluf_(v[3]) * v[7]);
        *(u32x2*)(HID + row * 256 + col) = w;
    } };
struct EpiDown { bf16* YS;
    __device__ __forceinline__ void store8(const Unit& u, int r, int c, const float (&v)[8]) const {
        const size_t row = (size_t)u.pm * 256 + r; *(u32x4*)(YS + row * 1024 + (u.pn & 3) * 256 + c) = pack8(v);
    } };


namespace pg8 {
#define PG8_LAS __attribute__((address_space(3)))
typedef ::bf16x8 bf16x8; typedef ::f32x4 f32x4;
using ::Unit; using ::Gemm;
constexpr int BM = 256, BK = 64, HALF = 128, HTB = HALF * BK * 2  , STAGE_BYTES = 8 * HTB;

__device__ __forceinline__ int lds_byte(int r, int c) { const int st = (r >> 4) * 2 + (c >> 5), rr = r & 15, cc = c & 31, ob = rr * 64 + cc * 2; return st * 1024 + (ob ^ (((ob >> 9) & 1) << 5)); }
__device__ __forceinline__ void stage_rc(int b, int& R, int& C) { const int st = b / 1024, sb = b % 1024, swz = sb ^ (((sb >> 9) & 1) << 5); R = (st >> 1) * 16 + swz / 64; C = (st & 1) * 32 + (swz % 64) / 2; }
__device__ __forceinline__ int perm32(int rho) { const int n = rho >> 4, i = rho & 15; return 8 * (i >> 2) + 4 * n + (i & 3); }
template <class Epi, class Sched, bool ALIGN_EPI = false, bool SP2 = false, bool GATHER = false, bool MIDHOOK = false>
__device__ __forceinline__ void gemm_phase(PG8_LAS unsigned char* lds, const Gemm g, const Sched& S, const Epi& E, const int wave_in) {
    const int lane = lane_id_fresh(), wid = wave_in, tid = wid * 64 + lane,
              wr = wid >> 2, wc = wid & 3, fr = lane & 15, fq = lane >> 4;
    const int K = g.K, nt = K / BK;
    unsigned voffA[2], voffB[2];
#pragma unroll
    for (int i = 0; i < 2; ++i) { int R, C; stage_rc(tid * 16 + i * 8192, R, C); const int Rb = Epi::PERM ? ((R & ~31) + perm32(R & 31)) : R;
        voffA[i] = (unsigned)(R * K + C) * 2u; voffB[i] = (unsigned)(Rb * K + C) * 2u; }
    unsigned vAc[2][2] = {{0u, 0u}, {0u, 0u}}, vAn[2][2] = {{0u, 0u}, {0u, 0u}}; int gR[2] = {0, 0}; unsigned gC[2] = {0u, 0u};
    if constexpr (GATHER) {
#pragma unroll
        for (int i = 0; i < 2; ++i) { int R, C; stage_rc(tid * 16 + i * 8192, R, C); gR[i] = R; gC[i] = (unsigned)C * 2u; } }
#define PG8_GIDX(dst, pm_) do { _Pragma("unroll") for (int _h = 0; _h < 2; ++_h) _Pragma("unroll") for (int _i = 0; _i < 2; ++_i) \
        dst[_h][_i] = (unsigned)g.ridx[(pm_) * BM + _h * HALF + gR[_i]] * (unsigned)(K * 2) + gC[_i]; } while (0)
    const size_t kstep = (size_t)(BK * 2);
    const size_t hstep = (size_t)HALF * K * 2;
    const size_t tstep = 2 * hstep;
    const unsigned ldsw = (unsigned)wid * 1024u;
    const int aoff = lds_byte(wr * 64 + fr, fq * 8), boff = lds_byte(wc * 32 + fr, fq * 8);
#define PG8_SA(b, h) (((b) * 2 + (h)) * HTB)
#define PG8_SB(b, h) ((4 + (b) * 2 + (h)) * HTB)
#define PG8_STAGE(bufoff, gbase, voff) do { _Pragma("unroll") for (int _i = 0; _i < 2; ++_i) \
        __builtin_amdgcn_global_load_lds((const unsigned*)((const char*)(gbase) + (voff)[_i]), (PG8_LAS unsigned*)(lds + (bufoff) + ldsw + _i * 8192), 16, 0, 0); } while (0)
#define PG8_STAGE_A(bufoff, kptr, h, isnext) do { if constexpr (GATHER) { unsigned _v[2]; _v[0] = (isnext) ? vAn[h][0] : vAc[h][0]; _v[1] = (isnext) ? vAn[h][1] : vAc[h][1]; PG8_STAGE(bufoff, kptr, _v); } \
        else { PG8_STAGE(bufoff, (kptr) + (h) * hstep, voffA); } } while (0)
#define PG8_LDA(dst, b, h) do { _Pragma("unroll") for (int m = 0; m < 4; ++m) _Pragma("unroll") for (int k = 0; k < 2; ++k) dst[m][k] = *(const PG8_LAS bf16x8*)(lds + PG8_SA(b, h) + aoff + m * 2048 + k * 1024); } while (0)
#define PG8_LDB(dst, b, h) do { _Pragma("unroll") for (int n = 0; n < 2; ++n) _Pragma("unroll") for (int k = 0; k < 2; ++k) dst[n][k] = *(const PG8_LAS bf16x8*)(lds + PG8_SB(b, h) + boff + n * 2048 + k * 1024); } while (0)
#define PG8_MMA(ai, bj, At, Bt) do { __builtin_amdgcn_s_setprio(1); _Pragma("unroll") for (int m = 0; m < 4; ++m) _Pragma("unroll") for (int n = 0; n < 2; ++n) _Pragma("unroll") for (int k = 0; k < 2; ++k) \
        acc[ai][bj][m][n] = __builtin_amdgcn_mfma_f32_16x16x32_bf16(Bt[n][k], At[m][k], acc[ai][bj][m][n], 0, 0, 0); __builtin_amdgcn_s_setprio(0); } while (0)
#define PG8_WAIT_V(n) asm volatile("s_waitcnt vmcnt(" #n ")" ::: "memory")
#define PG8_WAIT_L(n) asm volatile("s_waitcnt lgkmcnt(" #n ")" ::: "memory")
#define PG8_BAR __builtin_amdgcn_s_barrier()
#define PG8_SCHED __builtin_amdgcn_sched_barrier(0)
    Unit cur, nxt; int ui = 0;
    if (!S.next(0, cur)) return;
    f32x4 acc[2][2][4][2];
#pragma unroll
    for (int a = 0; a < 2; ++a)
#pragma unroll
        for (int b = 0; b < 2; ++b)
#pragma unroll
            for (int m = 0; m < 4; ++m)
#pragma unroll
                for (int n = 0; n < 2; ++n) acc[a][b][m][n] = (f32x4){0.f, 0.f, 0.f, 0.f};
    bf16x8 At[4][2], B0[2][2], B1[2][2];
    const char* cA = (const char*)g.A + (GATHER ? (size_t)0 : (size_t)cur.pm * tstep); const char* cB = (const char*)g.Bt + (size_t)cur.pn * tstep;
    if constexpr (GATHER) PG8_GIDX(vAc, cur.pm);
    S.a_ready(cur);
    if constexpr (SP2) {
        PG8_STAGE(PG8_SB(0, 0), cB, voffB); PG8_STAGE(PG8_SB(0, 1), cB + hstep, voffB); PG8_STAGE_A(PG8_SA(0, 0), cA, 0, false); PG8_STAGE_A(PG8_SA(0, 1), cA, 1, false);
        if (wr == 1) PG8_BAR;
        PG8_WAIT_V(2); PG8_BAR;
        PG8_STAGE(PG8_SB(1, 0), cB + kstep, voffB); PG8_STAGE_A(PG8_SA(1, 0), cA + kstep, 0, false); PG8_STAGE(PG8_SB(1, 1), cB + hstep + kstep, voffB);
        PG8_WAIT_V(6); PG8_BAR;
    } else {
        PG8_STAGE(PG8_SB(0, 0), cB, voffB); PG8_STAGE(PG8_SA(0, 0), cA, voffA); PG8_STAGE(PG8_SB(0, 1), cB + hstep, voffB); PG8_STAGE(PG8_SA(0, 1), cA + hstep, voffA);
        if (wr == 1) PG8_BAR;
        PG8_WAIT_V(4); PG8_BAR;
        PG8_STAGE(PG8_SB(1, 0), cB + kstep, voffB); PG8_STAGE(PG8_SA(1, 0), cA + kstep, voffA); PG8_STAGE(PG8_SB(1, 1), cB + hstep + kstep, voffB);
        PG8_WAIT_V(6); PG8_BAR;
    }
    for (;;) {
        const bool has_next = S.next(ui + 1, nxt);
        const char* nA = (has_next && !GATHER) ? (const char*)g.A + (size_t)nxt.pm * tstep : cA; const char* nB = has_next ? (const char*)g.Bt + (size_t)nxt.pn * tstep : cB;
        if constexpr (GATHER) { if (has_next) PG8_GIDX(vAn, nxt.pm); else { _Pragma("unroll") for (int _h = 0; _h < 2; ++_h) { vAn[_h][0] = vAc[_h][0]; vAn[_h][1] = vAc[_h][1]; } } }
        for (int t = 0; t < nt; t += 2) {
            if constexpr (MIDHOOK) { if (t == nt / 2) { E.mid(acc, cur, wr, wc, fr, fq); PG8_WAIT_V(0); } }
            const bool last = (t == nt - 2);
            const char* a1 = cA + (size_t)(t + 1) * kstep;
            const char* a2 = last ? nA : cA + (size_t)(t + 2) * kstep; const char* b2 = last ? nB : cB + (size_t)(t + 2) * kstep;
            const char* a3 = a2 + kstep; const char* b3 = b2 + kstep;
            if (last && has_next) S.a_ready(nxt);
            if constexpr (SP2) {
            PG8_LDB(B0, 0, 0); PG8_LDB(B1, 0, 1); PG8_SCHED; PG8_LDA(At, 0, 0); PG8_STAGE_A(PG8_SA(1, 1), a1, 1, false);
            PG8_WAIT_V(8); PG8_WAIT_L(0); PG8_BAR; PG8_MMA(0, 0, At, B0); PG8_MMA(0, 1, At, B1); PG8_BAR; PG8_SCHED;
            PG8_LDA(At, 0, 1); PG8_STAGE(PG8_SB(0, 0), b2, voffB); PG8_STAGE(PG8_SB(0, 1), b2 + hstep, voffB); PG8_STAGE_A(PG8_SA(0, 0), a2, 0, last);
            PG8_WAIT_V(8); PG8_WAIT_L(0); PG8_BAR; PG8_MMA(1, 0, At, B0); PG8_MMA(1, 1, At, B1); PG8_BAR; PG8_SCHED;
            PG8_LDB(B0, 1, 0); PG8_LDB(B1, 1, 1); PG8_SCHED; PG8_LDA(At, 1, 0); PG8_STAGE_A(PG8_SA(0, 1), a2, 1, last);
            PG8_WAIT_V(8); PG8_WAIT_L(0); PG8_BAR; PG8_MMA(0, 0, At, B0); PG8_MMA(0, 1, At, B1); PG8_BAR; PG8_SCHED;
            PG8_LDA(At, 1, 1); PG8_STAGE(PG8_SB(1, 0), b3, voffB); PG8_STAGE(PG8_SB(1, 1), b3 + hstep, voffB); PG8_STAGE_A(PG8_SA(1, 0), a3, 0, last);
            PG8_WAIT_V(8); PG8_WAIT_L(0); PG8_BAR; PG8_MMA(1, 0, At, B0); PG8_MMA(1, 1, At, B1); PG8_BAR; PG8_SCHED;
            } else {
            PG8_LDB(B0, 0, 0); PG8_SCHED; PG8_LDA(At, 0, 0); PG8_STAGE(PG8_SA(1, 1), a1 + hstep, voffA);
            PG8_WAIT_L(8); PG8_BAR; PG8_WAIT_L(0); PG8_MMA(0, 0, At, B0); PG8_BAR; PG8_SCHED;
            PG8_LDB(B1, 0, 1); PG8_STAGE(PG8_SB(0, 0), b2, voffB);
            PG8_BAR; PG8_WAIT_L(0); PG8_MMA(0, 1, At, B1); PG8_BAR;
            PG8_LDA(At, 0, 1); PG8_STAGE(PG8_SA(0, 0), a2, voffA);
            PG8_BAR; PG8_WAIT_L(0); PG8_MMA(1, 0, At, B0); PG8_BAR; PG8_SCHED;
            PG8_STAGE(PG8_SB(0, 1), b2 + hstep, voffB);
            PG8_WAIT_V(6); PG8_BAR; PG8_MMA(1, 1, At, B1); PG8_BAR;
            PG8_LDB(B0, 1, 0); PG8_SCHED; PG8_LDA(At, 1, 0); PG8_STAGE(PG8_SA(0, 1), a2 + hstep, voffA);
            PG8_WAIT_L(8); PG8_BAR; PG8_WAIT_L(0); PG8_MMA(0, 0, At, B0); PG8_BAR; PG8_SCHED;
            PG8_LDB(B1, 1, 1); PG8_STAGE(PG8_SB(1, 0), b3, voffB);
            PG8_BAR; PG8_WAIT_L(0); PG8_MMA(0, 1, At, B1); PG8_BAR;
            PG8_LDA(At, 1, 1); PG8_STAGE(PG8_SA(1, 0), a3, voffA);
            PG8_BAR; PG8_WAIT_L(0); PG8_MMA(1, 0, At, B0); PG8_BAR; PG8_SCHED;
            PG8_STAGE(PG8_SB(1, 1), b3 + hstep, voffB);
            PG8_WAIT_V(6); PG8_BAR; PG8_MMA(1, 1, At, B1); PG8_BAR;
            }
        }
        if constexpr (ALIGN_EPI) { if (wr == 0) PG8_BAR; }
        if constexpr (!Epi::AFTER_DRAIN) { E(acc, cur, wr, wc, fr, fq); S.done(cur); }
        if (!has_next) break;
#pragma unroll
        for (int a = 0; a < 2; ++a)
#pragma unroll
            for (int b = 0; b < 2; ++b)
#pragma unroll
                for (int m = 0; m < 4; ++m)
#pragma unroll
                    for (int n = 0; n < 2; ++n) acc[a][b][m][n] = (f32x4){0.f, 0.f, 0.f, 0.f};
        cur = nxt; cA = nA; cB = nB; ++ui;
        if constexpr (GATHER) { _Pragma("unroll") for (int _h = 0; _h < 2; ++_h) { vAc[_h][0] = vAn[_h][0]; vAc[_h][1] = vAn[_h][1]; } }
        if constexpr (ALIGN_EPI) { if (wr == 1) PG8_BAR; }
    }
    PG8_WAIT_V(0);
    if constexpr (!ALIGN_EPI) { if (wr == 0) PG8_BAR; }
    PG8_BAR;
    if constexpr (Epi::AFTER_DRAIN) { E.fused(acc, cur, wr, wc, fr, fq, lds, wid, lane); S.done(cur); }
#undef PG8_SA
#undef PG8_SB
#undef PG8_STAGE
#undef PG8_STAGE_A
#undef PG8_GIDX
#undef PG8_LDA
#undef PG8_LDB
#undef PG8_MMA
#undef PG8_WAIT_V
#undef PG8_WAIT_L
#undef PG8_BAR
#undef PG8_SCHED
}

template <class F> struct EpiAdapt {
    static constexpr bool PERM = true, AFTER_DRAIN = false; F f;
    __device__ __forceinline__ void mid(f32x4 (&acc)[2][2][4][2], const Unit& u, int wr, int wc, int fr, int fq) const {
        asm volatile("" : "+v"(fr), "+v"(fq));
#pragma unroll
        for (int ai = 0; ai < 2; ++ai)
#pragma unroll
            for (int m = 0; m < 4; ++m) { const int row = ai * HALF + wr * 64 + m * 16 + fr;
#pragma unroll
                for (int bj = 0; bj < 2; ++bj) { float v[8] = {acc[ai][bj][m][0][0], acc[ai][bj][m][0][1], acc[ai][bj][m][0][2], acc[ai][bj][m][0][3], acc[ai][bj][m][1][0], acc[ai][bj][m][1][1], acc[ai][bj][m][1][2], acc[ai][bj][m][1][3]};
                    f.mid8(u, row, bj * HALF + wc * 32 + 8 * fq, v);
                    acc[ai][bj][m][0] = (f32x4){v[0], v[1], v[2], v[3]}; acc[ai][bj][m][1] = (f32x4){v[4], v[5], v[6], v[7]}; } }
    }
    __device__ __forceinline__ void operator()(const f32x4 (&acc)[2][2][4][2], const Unit& u, int wr, int wc, int fr, int fq) const {
        asm volatile("" : "+v"(fr), "+v"(fq));
#pragma unroll
        for (int ai = 0; ai < 2; ++ai)
#pragma unroll
            for (int m = 0; m < 4; ++m) { const int row = ai * HALF + wr * 64 + m * 16 + fr;
#pragma unroll
                for (int bj = 0; bj < 2; ++bj) { const f32x4 v0 = acc[ai][bj][m][0], v1 = acc[ai][bj][m][1];
                    const float v[8] = {v0[0], v0[1], v0[2], v0[3], v1[0], v1[1], v1[2], v1[3]};
                    f.store8(u, row, bj * HALF + wc * 32 + 8 * fq, v); } }
    }
};
}

template <class Epi, class Sched>
__device__ __forceinline__ void gemm_phase_mid(LAS unsigned char* lds, const Gemm g, const Sched& S, const Epi& E, const int wave_in) {
    pg8::EpiAdapt<Epi> EA{E};
    pg8::gemm_phase<pg8::EpiAdapt<Epi>, Sched, true, true, false, true>(lds, g, S, EA, wave_in);
}
template <class Epi, class Sched>
__device__ __forceinline__ void gemm_phase_gather(LAS unsigned char* lds, const Gemm g, const Sched& S, const Epi& E, const int wave_in) {
    pg8::EpiAdapt<Epi> EA{E};
    pg8::gemm_phase<pg8::EpiAdapt<Epi>, Sched, true, true, true>(lds, g, S, EA, wave_in);
}
template <class Epi, class Sched>
__device__ __forceinline__ void gemm_phase_any(LAS unsigned char* lds, const Gemm g, const Sched& S, const Epi& E, const int wave_in) {
#if ENG_GEMM == 1
    pg8::EpiAdapt<Epi> EA{E};
    pg8::gemm_phase<pg8::EpiAdapt<Epi>, Sched, true, true>(lds, g, S, EA, wave_in);
#else
    gemm_phase_naive<Epi, Sched>(lds, g, S, E);
#endif
}

template <class RowMap>
__device__ __forceinline__ void transpose_item(const float* W, int ldw, bf16* WT, int ldt, int koff, int k0, int n0, const RowMap& rm, LAS float* scr, int lane) {
#pragma unroll 8
    for (int i = 0; i < 32; ++i) { const int kk = 2 * i + (lane >> 5); scr[kk * 33 + (lane & 31)] = W[(size_t)(k0 + kk) * ldw + n0 + (lane & 31)]; }
    asm volatile("s_waitcnt lgkmcnt(0)" ::: "memory");
    const int c = lane & 7;
#pragma unroll
    for (int j = 0; j < 4; ++j) { const int n = (lane >> 3) + 8 * j; const LAS float* s = scr + (8 * c) * 33 + n;
        u32x4 o; o.x = pk2(s[0 * 33], s[1 * 33]); o.y = pk2(s[2 * 33], s[3 * 33]); o.z = pk2(s[4 * 33], s[5 * 33]); o.w = pk2(s[6 * 33], s[7 * 33]);
        *(u32x4*)(WT + (size_t)rm(n0 + n) * ldt + koff + k0 + 8 * c) = o; }
    asm volatile("s_waitcnt lgkmcnt(0)" ::: "memory");
}
struct RmId { int off; __device__ int operator()(int n) const { return off + n; } };
struct RmWin { __device__ int operator()(int n) const { return n < 1792 ? n : (n < 2208 ? 3840 + (n - 1792) : 1792 + (n - 2208)); } };
struct RmUkv { __device__ int operator()(int n) const { const int h = n >> 7, j = n & 127; return j < 64 ? h * 64 + j : 512 + h * 64 + (j - 64); } };
struct RmGU { int off; __device__ int operator()(int j) const { return off + 8 * (j >> 2) + (j & 3); } };

__device__ __forceinline__ void p0_prologue(const Frame& F, ArgsP a) {
    const int lane_f = lane_id_fresh(), tid_f = F.wave * 64 + lane_f;
    LAS float* scr = (LAS float*)(F.lds + F.wave * 16384);
    const int lane = lane_f;
    bf16* Win = (bf16*)(F.ws + WS_WIN); bf16* Wblk = (bf16*)(F.ws + WS_WBLK); bf16* Wg = (bf16*)(F.ws + WS_WG); bf16* Wuq = (bf16*)(F.ws + WS_WUQ);
    bf16* Wukv = (bf16*)(F.ws + WS_WUKV); bf16* Wb = (bf16*)(F.ws + WS_WB); bf16* Wo = (bf16*)(F.ws + WS_WO); bf16* Wgu = (bf16*)(F.ws + WS_WGU); bf16* Wdn = (bf16*)(F.ws + WS_WDN);
    constexpr int I_IN = 16 * 133, I_DEC = 1 * 16, I_AUP = 16, I_GUP = 2 * 16, I_UQ = 4 * 24, I_UKV = 2 * 32, I_BR = 2 * 8 * 32, I_O = 16 * 32;
    constexpr int I_EG = 32 * 16 * 8, I_EU = I_EG, I_ED = 32 * 4 * 32;
    constexpr int NITEMS = I_IN + I_DEC + I_AUP + I_GUP + I_UQ + I_UKV + I_BR + I_O + I_EG + I_EU + I_ED;
    for (int it = F.gw; it < NITEMS; it += F.NGW) {
        int r = it;
        if (r < I_IN) { const int kb = r / 133, nb = r % 133; transpose_item(a->in[I_WIN], D_IN, Win, 1024, 0, 64 * kb, 32 * nb, RmWin{}, scr, lane); continue; } r -= I_IN;
        if (r < I_DEC) { transpose_item(a->in[I_WDEC], 512, Wblk, 128, 0, 0, 32 * r, RmId{0}, scr, lane); continue; } r -= I_DEC;
        if (r < I_AUP) { transpose_item(a->in[I_WAUP], 512, Wblk, 128, 64, 0, 32 * r, RmId{512}, scr, lane); continue; } r -= I_AUP;
        if (r < I_GUP) { const int kb = r / 16, nb = r % 16; transpose_item(a->in[I_WGUP], 512, Wg, 128, 0, 64 * kb, 32 * nb, RmId{0}, scr, lane); continue; } r -= I_GUP;
        if (r < I_UQ) { const int kb = r / 24, nb = r % 24; transpose_item(a->in[I_WUQ], 768, Wuq, 256, 0, 64 * kb, 32 * nb, RmId{0}, scr, lane); continue; } r -= I_UQ;
        if (r < I_UKV) { const int kb = r / 32, nb = r % 32; transpose_item(a->in[I_WUKV], 1024, Wukv, 128, 0, 64 * kb, 32 * nb, RmUkv{}, scr, lane); continue; } r -= I_UKV;
        if (r < I_BR) { const int br = r / 256, q = r % 256, kb = q / 32, nb = q % 32; transpose_item(a->in[I_WBR] + (size_t)br * 512 * 1024, 1024, Wb, 1024, 512 * br, 64 * kb, 32 * nb, RmId{0}, scr, lane); continue; } r -= I_BR;
        if (r < I_O) { const int kb = r / 32, nb = r % 32; transpose_item(a->in[I_WOUT], 1024, Wo, 1024, 0, 64 * kb, 32 * nb, RmId{0}, scr, lane); continue; } r -= I_O;
        if (r < I_EG) { const int e = r / 128, q = r % 128, kb = q / 8, nb = q % 8; transpose_item(a->in[I_WEG] + (size_t)e * 1024 * 256, 256, Wgu + (size_t)e * 512 * 1024, 1024, 0, 64 * kb, 32 * nb, RmGU{0}, scr, lane); continue; } r -= I_EG;
        if (r < I_EU) { const int e = r / 128, q = r % 128, kb = q / 8, nb = q % 8; transpose_item(a->in[I_WEU] + (size_t)e * 1024 * 256, 256, Wgu + (size_t)e * 512 * 1024, 1024, 0, 64 * kb, 32 * nb, RmGU{4}, scr, lane); continue; } r -= I_EU;
        { const int e = r / 128, q = r % 128, kb = q / 32, nb = q % 32; transpose_item(a->in[I_WED] + (size_t)e * 256 * 1024, 1024, Wdn + (size_t)e * 1024 * 256, 256, 0, 64 * kb, 32 * nb, RmId{0}, scr, lane); }
    }
    for (int i = F.gw * 64 + lane; i < 96 * 128; i += F.NGW * 64) *(u32x4*)(Win + (size_t)4256 * 1024 + (size_t)i * 8) = (u32x4){0u, 0u, 0u, 0u};
    for (int i = F.gw * 64 + lane; i < 1024 * 8; i += F.NGW * 64) { const int row = i >> 3, c8 = (i & 7) * 8; *(u32x4*)(Wblk + row * 128 + (row < 512 ? 64 : 0) + c8) = (u32x4){0u, 0u, 0u, 0u}; }
    { const int* pos = (const int*)a->in[I_POS]; float* cs = (float*)(F.ws + WS_CS);
      for (int i = F.gw * 64 + lane; i < NTOK * 16; i += F.NGW * 64) { const int t = i >> 4, j = i & 15;
          const float fr = exp2f(-(float)j * (13.287712379549449f / 16.0f));
          const float ang = (float)pos[t] * fr; cs[t * 32 + j] = cosf(ang); cs[t * 32 + 16 + j] = sinf(ang); } }
    { float* mod = (float*)(F.ws + WS_MOD); const float* c = a->in[I_C]; const float* wa = a->in[I_WADA]; const float* ba = a->in[I_BADA];
      LAS float* red = (LAS float*)(F.lds + 8 * 16384);
      for (int nb = F.vcu; nb < 96; nb += F.G) {
          float acc[8];
#pragma unroll
          for (int b = 0; b < 8; ++b) acc[b] = 0.f;
          const int n = nb * 64 + lane;
          for (int k = F.wave * 128; k < F.wave * 128 + 128; ++k) { const float w = wa[(size_t)k * 6144 + n];
#pragma unroll
              for (int b = 0; b < 8; ++b) acc[b] = fmaf(siluf_(c[b * 1024 + k]), w, acc[b]); }
#pragma unroll
          for (int b = 0; b < 8; ++b) red[(F.wave * 8 + b) * 64 + lane] = acc[b];
          __syncthreads();
          { const int b = F.wave; float s = ba[n];
#pragma unroll
            for (int w = 0; w < 8; ++w) s += red[(w * 8 + b) * 64 + lane];
            mod[b * 6144 + n] = s; }
          __syncthreads();
      } }
}

__device__ __forceinline__ void p_normmod(const Frame& F, const float* x, const float* g, const float* mod, int sh_off, int sc_off, bf16* H) {
    const int lane_f = lane_id_fresh();
    f32x4 xa[4], xb[4];
    { const f32x4* xr = (const f32x4*)(x + (size_t)F.gw * 1024) + lane_f;
#pragma unroll
      for (int j = 0; j < 4; ++j) xa[j] = xr[64 * j]; }
    f32x4 gs[4], sh[4]; int bcur = -1;
#define NM_ROW(CUR, NXT, m_) do { const int mm = (m_); const int b = mm / SEQ; \
        if (b != bcur) { bcur = b; \
            _Pragma("unroll") for (int j = 0; j < 4; ++j) { const int col = 4 * lane_f + 256 * j; gs[j] = *(const f32x4*)(g + col) * (*(const f32x4*)(mod + b * 6144 + sc_off + col) + 1.0f); sh[j] = *(const f32x4*)(mod + b * 6144 + sh_off + col); } \
            asm volatile("s_waitcnt vmcnt(0)" : "+v"(gs[0]), "+v"(gs[1]), "+v"(gs[2]), "+v"(gs[3]), "+v"(sh[0]), "+v"(sh[1]), "+v"(sh[2]), "+v"(sh[3]), "+v"(CUR[0]), "+v"(CUR[1]), "+v"(CUR[2]), "+v"(CUR[3])); } \
        { const int mn = (mm + F.NGW < NTOK) ? mm + F.NGW : mm; const f32x4* xr = (const f32x4*)(x + (size_t)mn * 1024) + lane_f; \
          _Pragma("unroll") for (int j = 0; j < 4; ++j) NXT[j] = xr[64 * j]; } \
        float s = 0.f; \
        _Pragma("unroll") for (int j = 0; j < 4; ++j) s += (CUR[j].x * CUR[j].x + CUR[j].y * CUR[j].y) + (CUR[j].z * CUR[j].z + CUR[j].w * CUR[j].w); \
        const float rstd = 1.0f / sqrtf(wave_sum(s) * (1.f / 1024.f) + EPS); \
        u32x2* o = (u32x2*)(H + (size_t)mm * 1024) + lane_f; \
        _Pragma("unroll") for (int j = 0; j < 4; ++j) { const f32x4 y = CUR[j] * rstd * gs[j] + sh[j]; u32x2 w; w.x = pk2(y.x, y.y); w.y = pk2(y.z, y.w); o[64 * j] = w; } } while (0)
    for (int m = F.gw; m < NTOK; m += 2 * F.NGW) {
        NM_ROW(xa, xb, m);
        if (m + F.NGW < NTOK) NM_ROW(xb, xa, m + F.NGW);
    }
#undef NM_ROW
}

__device__ __forceinline__ void p_prep_a(const Frame& F, ArgsP a) {
    const int lane_f = lane_id_fresh();
    const bf16* ZR = (const bf16*)(F.ws + WS_ZR); const bf16* ZM = (const bf16*)(F.ws + WS_ZM);
    bf16* TWA = (bf16*)(F.ws + WS_TWA); bf16* SGL = (bf16*)(F.ws + WS_SGL); bf16* QA = (bf16*)(F.ws + WS_QA); bf16* KVA = (bf16*)(F.ws + WS_KVA);
    const float* mu = a->in[I_MU]; const float* gqa = a->in[I_GQA]; const float* gkva = a->in[I_GKVA];
    const int lane = lane_f;
    const f32x4 mm = *(const f32x4*)(mu + 1536 + 4 * lane), gq = *(const f32x4*)(gqa + 4 * lane), gk = *(const f32x4*)(gkva + 4 * (lane & 31));
    for (int m = F.gw; m < NTOK; m += F.NGW) {
        const bool first = (m % SEQ) == 0;
        { const u32x2 c = *((const u32x2*)(ZR + (size_t)m * 1792 + 1536) + lane); u32x2 p = *((const u32x2*)(ZR + (size_t)(first ? m : m - 1) * 1792 + 1536) + lane); if (first) { p.x = 0u; p.y = 0u; }
          float z[4] = {lo2f(c.x), hi2f(c.x), lo2f(c.y), hi2f(c.y)}; const float q[4] = {lo2f(p.x), hi2f(p.x), lo2f(p.y), hi2f(p.y)};
          z[0] += (q[0] - z[0]) * mm.x; z[1] += (q[1] - z[1]) * mm.y; z[2] += (q[2] - z[2]) * mm.z; z[3] += (q[3] - z[3]) * mm.w;
          if (lane < 16) { u32x2 w; w.x = pk2(tanhf(z[0]), tanhf(z[1])); w.y = pk2(tanhf(z[2]), tanhf(z[3])); *((u32x2*)(TWA + (size_t)m * 128) + lane) = w; }
          else if (lane < 32) { u32x2 w; w.x = pk2(z[0], z[1]); w.y = pk2(z[2], z[3]); *((u32x2*)(TWA + (size_t)m * 128) + lane) = w; }
          else { u32x2 w; w.x = pk2(sigmoidf_(z[0]), sigmoidf_(z[1])); w.y = pk2(sigmoidf_(z[2]), sigmoidf_(z[3])); *((u32x2*)(SGL + (size_t)m * 128) + (lane - 32)) = w; } }
        { const u32x2 c = *((const u32x2*)(ZM + (size_t)m * 512) + lane); const float z[4] = {lo2f(c.x), hi2f(c.x), lo2f(c.y), hi2f(c.y)};
          u32x2 c2 = (u32x2){0u, 0u}; if (lane < 32) c2 = *((const u32x2*)(ZM + (size_t)m * 512 + 256) + lane); const float y[4] = {lo2f(c2.x), hi2f(c2.x), lo2f(c2.y), hi2f(c2.y)};
          const float rstd = 1.0f / sqrtf(wave_sum((z[0] * z[0] + z[1] * z[1]) + (z[2] * z[2] + z[3] * z[3])) * (1.f / 256.f) + EPS);
          const float rstd2 = 1.0f / sqrtf(wave_sum((y[0] * y[0] + y[1] * y[1]) + (y[2] * y[2] + y[3] * y[3])) * (1.f / 128.f) + EPS);
          u32x2 w; w.x = pk2(z[0] * rstd * gq.x, z[1] * rstd * gq.y); w.y = pk2(z[2] * rstd * gq.z, z[3] * rstd * gq.w);
          *((u32x2*)(QA + (size_t)m * 256) + lane) = w;
          if (lane < 32) { u32x2 w2; w2.x = pk2(y[0] * rstd2 * gk.x, y[1] * rstd2 * gk.y); w2.y = pk2(y[2] * rstd2 * gk.z, y[3] * rstd2 * gk.w);
              *((u32x2*)(KVA + (size_t)m * 128) + lane) = w2; } }
    }
}

__device__ __forceinline__ void p_prep_c(const Frame& F, ArgsP a) {
    const int lane_f = lane_id_fresh(), tid_f = F.wave * 64 + lane_f;
    const bf16* KN = (const bf16*)(F.dob + DO_KN); const bf16* ZM = (const bf16*)(F.ws + WS_ZM); bf16* KC = (bf16*)(F.ws + WS_KC);
    const float* cs = (const float*)(F.ws + WS_CS);
    const float* kn = a->in[I_KN];
    const int lane = lane_f, hd = lane >> 3, j = lane & 7;
    for (int m = F.gw; m < NTOK; m += F.NGW) {
        const f32x2 cc = *(const f32x2*)(cs + (size_t)m * 32 + 2 * j), sn = *(const f32x2*)(cs + (size_t)m * 32 + 16 + 2 * j);
        { float v[8]; unpack8(*(const u32x4*)(KN + (size_t)m * 512 + hd * 64 + 8 * j), v);
          const unsigned w1 = *(const unsigned*)(ZM + (size_t)m * 512 + 384 + 2 * j), w2 = *(const unsigned*)(ZM + (size_t)m * 512 + 400 + 2 * j); float x1[2] = {lo2f(w1), hi2f(w1)}, x2[2] = {lo2f(w2), hi2f(w2)};
          float ss = (x1[0] * x1[0] + x1[1] * x1[1]) + (x2[0] * x2[0] + x2[1] * x2[1]);
#pragma unroll
          for (int i = 0; i < 8; ++i) ss += v[i] * v[i];
          const float rstd = 1.0f / sqrtf(sum8(ss) * (1.f / 96.f) + EPS);
#pragma unroll
          for (int i = 0; i < 8; ++i) v[i] = v[i] * rstd * kn[8 * j + i];
          x1[0] *= rstd * kn[64 + 2 * j]; x1[1] *= rstd * kn[65 + 2 * j]; x2[0] *= rstd * kn[80 + 2 * j]; x2[1] *= rstd * kn[81 + 2 * j];
          bf16* kp = KC + (size_t)m * 768 + hd * 96;
          *(u32x4*)(kp + 8 * j) = pack8(v); *(unsigned*)(kp + 64 + 2 * j) = pk2(x1[0] * cc.x - x2[0] * sn.x, x1[1] * cc.y - x2[1] * sn.y);
          *(unsigned*)(kp + 80 + 2 * j) = pk2(x2[0] * cc.x + x1[0] * sn.x, x2[1] * cc.y + x1[1] * sn.y); }
    }
}

__device__ __forceinline__ void p_attn_naive(const Frame& F) {
    const int lane_f = lane_id_fresh(), tid_f = F.wave * 64 + lane_f;
    const bf16* Q = (const bf16*)(F.dob + DO_Q); const bf16* KC = (const bf16*)(F.ws + WS_KC); const bf16* VC = (const bf16*)(F.ws + WS_VC); bf16* YM = (bf16*)(F.ws + WS_YM);
    LAS float* Ks = (LAS float*)F.lds; LAS float* Vs = (LAS float*)(F.lds + 32 * 96 * 4);
    const int tid = tid_f;
    for (int unit = F.vcu; unit < 64 * 16; unit += F.G) {
        const int bh = unit >> 4, qb = 15 - (unit & 15), b = bh >> 3, h = bh & 7; const size_t row0 = (size_t)b * SEQ; const int t = qb * 512 + tid;
        unsigned qp[48];
        { const u32x4* qg = (const u32x4*)(Q + (row0 + t) * 768 + h * 96);
#pragma unroll
          for (int i = 0; i < 12; ++i) { const u32x4 w = qg[i]; qp[4 * i] = w.x; qp[4 * i + 1] = w.y; qp[4 * i + 2] = w.z; qp[4 * i + 3] = w.w; } }
        float o[64];
#pragma unroll
        for (int i = 0; i < 64; ++i) o[i] = 0.f;
        float mx = -INFINITY, l = 0.f;
        const int nkt = (qb + 1) * 16;
        for (int kt = 0; kt < nkt; ++kt) {
            __syncthreads();
            if (tid < 384) { const int r = tid / 12, c8 = (tid % 12) * 8; float v[8]; unpack8(*(const u32x4*)(KC + (row0 + kt * 32 + r) * 768 + h * 96 + c8), v);
#pragma unroll
                for (int i = 0; i < 8; ++i) Ks[r * 96 + c8 + i] = v[i]; }
            if (tid < 256) { const int r = tid >> 3, c8 = (tid & 7) * 8; float v[8]; unpack8(*(const u32x4*)(VC + (row0 + kt * 32 + r) * 512 + h * 64 + c8), v);
#pragma unroll
                for (int i = 0; i < 8; ++i) Vs[r * 64 + c8 + i] = v[i]; }
            __syncthreads();
            for (int kk = 0; kk < 32; ++kk) {
                const int kv = kt * 32 + kk;
                float s = 0.f; const LAS f32x4* kr = (const LAS f32x4*)(Ks + kk * 96);
#pragma unroll
                for (int i = 0; i < 24; ++i) { const f32x4 k4 = kr[i]; s += lo2f(qp[2 * i]) * k4.x + hi2f(qp[2 * i]) * k4.y + lo2f(qp[2 * i + 1]) * k4.z + hi2f(qp[2 * i + 1]) * k4.w; }
                if (kv <= t) {
                    const float mn = fmaxf(mx, s), f = exp2f(mx - mn), p = exp2f(s - mn); mx = mn; l = l * f + p;
                    const LAS f32x4* vr = (const LAS f32x4*)(Vs + kk * 64);
#pragma unroll
                    for (int i = 0; i < 16; ++i) { const f32x4 v4 = vr[i]; o[4 * i] = o[4 * i] * f + p * v4.x; o[4 * i + 1] = o[4 * i + 1] * f + p * v4.y; o[4 * i + 2] = o[4 * i + 2] * f + p * v4.z; o[4 * i + 3] = o[4 * i + 3] * f + p * v4.w; }
                }
            }
        }
        const float il = 1.f / l; u32x4* og = (u32x4*)(YM + (row0 + t) * 512 + h * 64);
#pragma unroll
        for (int i = 0; i < 8; ++i) { u32x4 w; w.x = pk2(o[8 * i] * il, o[8 * i + 1] * il); w.y = pk2(o[8 * i + 2] * il, o[8 * i + 3] * il); w.z = pk2(o[8 * i + 4] * il, o[8 * i + 5] * il); w.w = pk2(o[8 * i + 6] * il, o[8 * i + 7] * il); og[i] = w; }
    }
    __syncthreads();
}

typedef float f32x16 __attribute__((ext_vector_type(16)));
typedef short s16x4 __attribute__((ext_vector_type(4)));
__device__ __forceinline__ int crow(int r, int hi) { return (r & 3) + 8 * (r >> 2) + 4 * hi; }
__device__ __forceinline__ float max3f(float a, float b, float c) { float r; asm("v_max3_f32 %0, %1, %2, %3" : "=v"(r) : "v"(a), "v"(b), "v"(c)); return r; }
__device__ __forceinline__ float max2f(float a, float b) { float r; asm("v_max_f32_e32 %0, %1, %2" : "=v"(r) : "v"(a), "v"(b)); return r; }
__device__ __forceinline__ float xhalf_max(float x) { auto rr = __builtin_amdgcn_permlane32_swap(__float_as_uint(x), __float_as_uint(x), false, false); return max2f(__uint_as_float(rr[0]), __uint_as_float(rr[1])); }
__device__ __forceinline__ float xhalf_sum(float x) { auto rr = __builtin_amdgcn_permlane32_swap(__float_as_uint(x), __float_as_uint(x), false, false); return __uint_as_float(rr[0]) + __uint_as_float(rr[1]); }
__device__ __forceinline__ bf16x8 packp(const f32x16& p, int s2) {
    u32x4 w; w.x = pk2(p[8 * s2 + 0], p[8 * s2 + 1]); w.y = pk2(p[8 * s2 + 2], p[8 * s2 + 3]); w.z = pk2(p[8 * s2 + 4], p[8 * s2 + 5]); w.w = pk2(p[8 * s2 + 6], p[8 * s2 + 7]);
    return __builtin_bit_cast(bf16x8, w);
}
__device__ __forceinline__ void p_attn_mfma(const Frame& F, const float* qn) {
    const int lane_f = lane_id_fresh(), tid_f = F.wave * 64 + lane_f;
    const bf16* Q = (const bf16*)(F.dob + DO_Q); const bf16* KC = (const bf16*)(F.ws + WS_KC); const bf16* VC = (const bf16*)(F.ws + WS_VC); bf16* YM = (bf16*)(F.ws + WS_YM);
    const float* cs = (const float*)(F.ws + WS_CS);
    constexpr int KST = 208, VST = 192, KBYTES = 64 * KST, SUB = KBYTES + 64 * VST, BUF = 2 * SUB;
    const int tid = tid_f, lane = lane_f, wave = F.wave, r = lane & 31, hi = lane >> 5;
    int kg[3], kl[3], vg[2], vl[2];
#pragma unroll
    for (int i = 0; i < 3; ++i) { const int c = tid + 512 * i, row = c / 12, pc = c % 12; kg[i] = row * 768 + pc * 8; kl[i] = (row >> 6) * SUB + (row & 63) * KST + pc * 16; }
#pragma unroll
    for (int i = 0; i < 2; ++i) { const int c = tid + 512 * i, row = c >> 3, pc = c & 7; vg[i] = row * 512 + pc * 8; vl[i] = (row >> 6) * SUB + KBYTES + (row & 63) * VST + pc * 16; }
    const int g4 = lane >> 4, li = lane & 15;
    const int vtr = (4 * (g4 >> 1) + (li >> 2)) * VST + (16 * (g4 & 1) + 4 * (li & 3)) * 2;
    const int kfr = r * KST + hi * 16;
    LAS unsigned char* lds = F.lds;
    for (int item = F.vcu; item < 1024; item += F.G) {
        const int bh = item >> 4, sidx = item & 15, b = bh >> 3, h = bh & 7; const size_t row0 = (size_t)b * SEQ;
        const bf16* Kg = KC + row0 * 768 + h * 96; const bf16* Vg = VC + row0 * 512 + h * 64;
        for (int uu = 0; uu < 2; ++uu) {
            const int qb = uu == 0 ? 31 - sidx : sidx, q0 = qb * 256, NT = (q0 + 256) / 128;
            const int qw = q0 + wave * 32;
            bf16x8 qf[6];
            {
              const bf16* qp = Q + (row0 + qw + r) * 768 + h * 96 + hi * 8; const float* csr = cs + (row0 + qw + r) * 32 + 8 * hi;
              u32x4 raw[6];
#pragma unroll
              for (int s = 0; s < 6; ++s) raw[s] = *(const u32x4*)(qp + 16 * s);
              const f32x4 c0 = *(const f32x4*)csr, c1 = *(const f32x4*)(csr + 4), s0 = *(const f32x4*)(csr + 16), s1 = *(const f32x4*)(csr + 20);
              float ss = 0.f;
#pragma unroll
              for (int s = 0; s < 6; ++s) { float t[8]; unpack8(raw[s], t);
#pragma unroll
                  for (int e = 0; e < 8; ++e) ss += t[e] * t[e]; }
              const float rstd = QSCALE / sqrtf(xhalf_sum(ss) * (1.f / 96.f) + EPS);
#pragma unroll
              for (int s = 0; s < 4; ++s) { float t[8]; unpack8(raw[s], t); const f32x4 g0 = *(const f32x4*)(qn + 16 * s + 8 * hi), g1 = *(const f32x4*)(qn + 16 * s + 8 * hi + 4);
                  t[0] *= rstd * g0.x; t[1] *= rstd * g0.y; t[2] *= rstd * g0.z; t[3] *= rstd * g0.w; t[4] *= rstd * g1.x; t[5] *= rstd * g1.y; t[6] *= rstd * g1.z; t[7] *= rstd * g1.w;
                  qf[s] = __builtin_bit_cast(bf16x8, pack8(t)); }
              { float a4[8], a5[8]; unpack8(raw[4], a4); unpack8(raw[5], a5);
                const f32x4 g0 = *(const f32x4*)(qn + 64 + 8 * hi), g1 = *(const f32x4*)(qn + 64 + 8 * hi + 4), h0 = *(const f32x4*)(qn + 80 + 8 * hi), h1 = *(const f32x4*)(qn + 80 + 8 * hi + 4);
                const float ga[8] = {g0.x, g0.y, g0.z, g0.w, g1.x, g1.y, g1.z, g1.w}, gb[8] = {h0.x, h0.y, h0.z, h0.w, h1.x, h1.y, h1.z, h1.w};
                const float cc[8] = {c0.x, c0.y, c0.z, c0.w, c1.x, c1.y, c1.z, c1.w}, sn[8] = {s0.x, s0.y, s0.z, s0.w, s1.x, s1.y, s1.z, s1.w};
#pragma unroll
                for (int e = 0; e < 8; ++e) { const float x1 = a4[e] * rstd * ga[e], x2 = a5[e] * rstd * gb[e]; a4[e] = x1 * cc[e] - x2 * sn[e]; a5[e] = x2 * cc[e] + x1 * sn[e]; }
                qf[4] = __builtin_bit_cast(bf16x8, pack8(a4)); qf[5] = __builtin_bit_cast(bf16x8, pack8(a5)); } }
            f32x16 o0 = {}, o1 = {}, negm = {}; float m = 0.f, l = 0.f;
            u32x4 ak[3], av[2];
#pragma unroll
            for (int i = 0; i < 3; ++i) ak[i] = *(const u32x4*)(Kg + kg[i]);
#pragma unroll
            for (int i = 0; i < 2; ++i) av[i] = *(const u32x4*)(Vg + vg[i]);
            asm volatile("" : "+v"(qf[0]), "+v"(qf[1]), "+v"(qf[2]), "+v"(qf[3]), "+v"(qf[4]), "+v"(qf[5]));
            LDS_BAR();
#pragma unroll
            for (int i = 0; i < 3; ++i) *(LAS u32x4*)(lds + kl[i]) = ak[i];
#pragma unroll
            for (int i = 0; i < 2; ++i) *(LAS u32x4*)(lds + vl[i]) = av[i];
            LDS_BAR();
            for (int t = 0; t < NT; ++t) {
                LAS unsigned char* bb = lds + (t & 1) * BUF;
                { const int tn = (t + 1 < NT) ? t + 1 : t;
                  const bf16* kgp = Kg + (size_t)tn * 128 * 768; const bf16* vgp = Vg + (size_t)tn * 128 * 512;
#pragma unroll
                  for (int i = 0; i < 3; ++i) ak[i] = *(const u32x4*)(kgp + kg[i]);
#pragma unroll
                  for (int i = 0; i < 2; ++i) av[i] = *(const u32x4*)(vgp + vg[i]); }
#pragma unroll
                for (int sub = 0; sub < 2; ++sub) {
                    const int tt = 2 * t + sub;
                    if (64 * tt <= qw + 31) {
                        LAS unsigned char* kb = bb + sub * SUB; LAS unsigned char* vb = kb + KBYTES;
                        bf16x8 kf0[6], kf1[6];
#pragma unroll
                        for (int s = 0; s < 6; ++s) { kf0[s] = *(const LAS bf16x8*)(kb + kfr + s * 32); kf1[s] = *(const LAS bf16x8*)(kb + kfr + 32 * KST + s * 32); }
                        __builtin_amdgcn_sched_barrier(0);
                        f32x16 p0 = negm, p1 = negm;
#pragma unroll
                        for (int s = 0; s < 6; ++s) { p0 = __builtin_amdgcn_mfma_f32_32x32x16_bf16(kf0[s], qf[s], p0, 0, 0, 0); p1 = __builtin_amdgcn_mfma_f32_32x32x16_bf16(kf1[s], qf[s], p1, 0, 0, 0); }
                        if (64 * tt + 63 > qw) {
                            int hm = hi; asm volatile("" : "+v"(hm));
                            const int qrel = qw + r - 64 * tt - 4 * hm;
#pragma unroll
                            for (int rg = 0; rg < 16; ++rg) { const int kv = (rg & 3) + 8 * (rg >> 2); if (kv > qrel) p0[rg] = -INFINITY; if (kv + 32 > qrel) p1[rg] = -INFINITY; }
                        }
                        float mx;
                        { float a = max3f(p0[0], p0[1], p1[0]), b2 = max3f(p0[2], p0[3], p1[1]); a = max3f(a, p1[2], p1[3]);
#pragma unroll
                          for (int rg = 4; rg < 16; rg += 4) { a = max3f(a, p0[rg], p0[rg + 1]); b2 = max3f(b2, p0[rg + 2], p0[rg + 3]); a = max3f(a, p1[rg], p1[rg + 1]); b2 = max3f(b2, p1[rg + 2], p1[rg + 3]); }
                          mx = xhalf_max(max2f(a, b2)); }
                        if (!__all(mx <= 8.0f)) {
                            const float dl = max2f(mx, 0.f), f = __builtin_amdgcn_exp2f(-dl); m += dl; l *= f;
#pragma unroll
                            for (int rg = 0; rg < 16; ++rg) { p0[rg] -= dl; p1[rg] -= dl; o0[rg] *= f; o1[rg] *= f; negm[rg] = -m; }
                        }
                        float rs = 0.f;
#pragma unroll
                        for (int rg = 0; rg < 16; ++rg) { p0[rg] = __builtin_amdgcn_exp2f(p0[rg]); p1[rg] = __builtin_amdgcn_exp2f(p1[rg]); rs += p0[rg] + p1[rg]; }
                        l += rs;
#pragma unroll
                        for (int hh = 0; hh < 2; ++hh)
#pragma unroll
                            for (int s2 = 0; s2 < 2; ++s2) { const bf16x8 pf = packp(hh == 0 ? p0 : p1, s2);
#pragma unroll
                                for (int db = 0; db < 2; ++db) { LAS unsigned char* vp_ = vb + vtr + (32 * hh + 16 * s2) * VST + db * 64;
                                    const s16x4 lo = __builtin_bit_cast(s16x4, __builtin_amdgcn_ds_read_tr16_b64_v4i16((LAS s16x4*)vp_));
                                    const s16x4 hi4 = __builtin_bit_cast(s16x4, __builtin_amdgcn_ds_read_tr16_b64_v4i16((LAS s16x4*)(vp_ + 8 * VST)));
                                    const bf16x8 vf = (bf16x8){lo[0], lo[1], lo[2], lo[3], hi4[0], hi4[1], hi4[2], hi4[3]};
                                    if (db == 0) o0 = __builtin_amdgcn_mfma_f32_32x32x16_bf16(vf, pf, o0, 0, 0, 0); else o1 = __builtin_amdgcn_mfma_f32_32x32x16_bf16(vf, pf, o1, 0, 0, 0); } }
                    }
                }
                { LAS unsigned char* nb = lds + ((t + 1) & 1) * BUF;
#pragma unroll
                  for (int i = 0; i < 3; ++i) *(LAS u32x4*)(nb + kl[i]) = ak[i];
#pragma unroll
                  for (int i = 0; i < 2; ++i) *(LAS u32x4*)(nb + vl[i]) = av[i]; }
                LDS_BAR();
            }
            const float il = 1.0f / xhalf_sum(l);
            bf16* op = YM + (row0 + qw + r) * YYLD + h * 64 + 4 * hi;
#pragma unroll
            for (int gq = 0; gq < 4; ++gq) { u32x2 w0, w1;
                w0.x = pk2(o0[4 * gq] * il, o0[4 * gq + 1] * il); w0.y = pk2(o0[4 * gq + 2] * il, o0[4 * gq + 3] * il);
                w1.x = pk2(o1[4 * gq] * il, o1[4 * gq + 1] * il); w1.y = pk2(o1[4 * gq + 2] * il, o1[4 * gq + 3] * il);
                *(u32x2*)(op + 8 * gq) = w0; *(u32x2*)(op + 32 + 8 * gq) = w1; }
        }
    }
    __syncthreads();
}

constexpr int CS_CH = 256, CS_NCH = SEQ / CS_CH;
constexpr int CS_RS = 144;
constexpr int CS_IMG = 16 * CS_RS;
constexpr int CS_WAVE = 8 * CS_IMG + 512;
enum { IM_A = 0, IM_R = 1, IM_B = 2, IM_K = 3, IM_BH = 4, IM_KH = 5, IM_V = 6, IM_G = 7 };
constexpr size_t DO_CSP = 64 * MiB, DO_CSG = 128 * MiB, DO_CSZ = 192 * MiB;
__device__ __forceinline__ int crow8(int q, int hi) { return (q & 3) + 8 * ((q >> 2) & 1) + 4 * hi; }
template <int N> __device__ __forceinline__ float dpp_shr0(float x) { return __builtin_bit_cast(float, __builtin_amdgcn_update_dpp(0, __builtin_bit_cast(int, x), 0x110 + N, 0xf, 0xf, true)); }
__device__ __forceinline__ float rowscan16(float x) { x += dpp_shr0<1>(x); x += dpp_shr0<2>(x); x += dpp_shr0<4>(x); x += dpp_shr0<8>(x); return x; }
__device__ __forceinline__ float xsum_16_32(float v) {
    { auto r = __builtin_amdgcn_permlane16_swap(__float_as_uint(v), __float_as_uint(v), false, false); v = __uint_as_float(r[0]) + __uint_as_float(r[1]); }
    { auto r = __builtin_amdgcn_permlane32_swap(__float_as_uint(v), __float_as_uint(v), false, false); v = __uint_as_float(r[0]) + __uint_as_float(r[1]); }
    return v;
}
__device__ __forceinline__ bf16x8 cs_rowfrag(const LAS unsigned char* rowp, int hi, int ks) {
    const LAS unsigned char* p = rowp + (16 * ks + 4 * hi) * 2; const u32x2 a = *(const LAS u32x2*)p, b = *(const LAS u32x2*)(p + 16);
    return __builtin_bit_cast(bf16x8, (u32x4){a.x, a.y, b.x, b.y});
}
__device__ __forceinline__ bf16x8 cs_trfrag(LAS unsigned char* img, int cb, int lane) {
    const int g4 = lane >> 4, li = lane & 15; LAS unsigned char* p = img + (4 * (g4 >> 1) + (li >> 2)) * CS_RS + (32 * cb + 16 * (g4 & 1) + 4 * (li & 3)) * 2;
    const s16x4 lo = __builtin_bit_cast(s16x4, __builtin_amdgcn_ds_read_tr16_b64_v4i16((LAS s16x4*)p));
    const s16x4 h4 = __builtin_bit_cast(s16x4, __builtin_amdgcn_ds_read_tr16_b64_v4i16((LAS s16x4*)(p + 8 * CS_RS)));
    return (bf16x8){lo[0], lo[1], lo[2], lo[3], h4[0], h4[1], h4[2], h4[3]};
}
__device__ __forceinline__ bf16x8 cs_zero8() { return (bf16x8){0, 0, 0, 0, 0, 0, 0, 0}; }
struct CsIn { const bf16 *ZR, *A, *LW, *G; const float *mu, *k_k, *k_a, *r_k; };
template <bool USE_V, bool WITH_Y>
__device__ __forceinline__ void cs_prep(const CsIn& in, size_t row0, int tok0, int h, LAS unsigned char* wl, int lane) {
    const int t = lane & 15, jq = lane >> 4, tok = tok0 + t; const bool first = tok == 0;
    const size_t g = row0 + tok, gp = row0 + (first ? 0 : tok - 1); const int c0 = h * 64 + 16 * jq;
    LAS float* gct = (LAS float*)(wl + 8 * CS_IMG); LAS float* btt = gct + 64;
    u32x4 Lrc[2], Lrp[2], Lkc[2], Lkp[2], Lav[2], Llw[2], Lvc[2], Lvp[2];
#pragma unroll
    for (int hf = 0; hf < 2; ++hf) { const int cc = c0 + 8 * hf;
        Lkc[hf] = *(const u32x4*)(in.ZR + g * 1792 + 512 + cc); Lkp[hf] = *(const u32x4*)(in.ZR + gp * 1792 + 512 + cc);
        Lrc[hf] = *(const u32x4*)(in.ZR + g * 1792 + cc); Lrp[hf] = *(const u32x4*)(in.ZR + gp * 1792 + cc);
        Lav[hf] = *(const u32x4*)(in.A + g * 512 + cc); Llw[hf] = *(const u32x4*)(in.LW + g * 512 + cc);
        if (USE_V) { Lvc[hf] = *(const u32x4*)(in.ZR + g * 1792 + 1024 + cc); Lvp[hf] = *(const u32x4*)(in.ZR + gp * 1792 + 1024 + cc); }
    }
    float inv;
    { float ss = 0.f;
#pragma unroll
      for (int hf = 0; hf < 2; ++hf) { float kc[8], kp[8]; unpack8(Lkc[hf], kc); unpack8(Lkp[hf], kp);
          const f32x4 m0 = *(const f32x4*)(in.mu + 512 + c0 + 8 * hf), m1 = *(const f32x4*)(in.mu + 512 + c0 + 8 * hf + 4), q0 = *(const f32x4*)(in.k_k + c0 + 8 * hf), q1 = *(const f32x4*)(in.k_k + c0 + 8 * hf + 4);
          const float mm[8] = {m0.x, m0.y, m0.z, m0.w, m1.x, m1.y, m1.z, m1.w}, qq[8] = {q0.x, q0.y, q0.z, q0.w, q1.x, q1.y, q1.z, q1.w};
#pragma unroll
          for (int e = 0; e < 8; ++e) { const float zk = kc[e] + ((first ? 0.f : kp[e]) - kc[e]) * mm[e]; const float kr = zk * qq[e]; ss += kr * kr; } }
      inv = 1.0f / fmaxf(sqrtf(xsum_16_32(ss)), 1e-12f); }
    float btacc = 0.f;
#pragma unroll
    for (int hf = 0; hf < 2; ++hf) {
        const int cc = c0 + 8 * hf;
        u32x4 Lgg = {}; if (WITH_Y) Lgg = *(const u32x4*)(in.G + g * 512 + cc);
        float rc[8], rp[8], kc[8], kp[8], av[8], lw[8];
        unpack8(Lrc[hf], rc); unpack8(Lrp[hf], rp); unpack8(Lkc[hf], kc); unpack8(Lkp[hf], kp); unpack8(Lav[hf], av); unpack8(Llw[hf], lw);
        float mr[8], mk[8], qk[8], qa[8], qr[8];
        { const f32x4 a0 = *(const f32x4*)(in.mu + cc), a1 = *(const f32x4*)(in.mu + cc + 4), b0 = *(const f32x4*)(in.mu + 512 + cc), b1 = *(const f32x4*)(in.mu + 512 + cc + 4);
          const f32x4 c0_ = *(const f32x4*)(in.k_k + cc), c1_ = *(const f32x4*)(in.k_k + cc + 4), d0 = *(const f32x4*)(in.k_a + cc), d1 = *(const f32x4*)(in.k_a + cc + 4);
          mr[0] = a0.x; mr[1] = a0.y; mr[2] = a0.z; mr[3] = a0.w; mr[4] = a1.x; mr[5] = a1.y; mr[6] = a1.z; mr[7] = a1.w;
          mk[0] = b0.x; mk[1] = b0.y; mk[2] = b0.z; mk[3] = b0.w; mk[4] = b1.x; mk[5] = b1.y; mk[6] = b1.z; mk[7] = b1.w;
          qk[0] = c0_.x; qk[1] = c0_.y; qk[2] = c0_.z; qk[3] = c0_.w; qk[4] = c1_.x; qk[5] = c1_.y; qk[6] = c1_.z; qk[7] = c1_.w;
          qa[0] = d0.x; qa[1] = d0.y; qa[2] = d0.z; qa[3] = d0.w; qa[4] = d1.x; qa[5] = d1.y; qa[6] = d1.z; qa[7] = d1.w; }
        if (WITH_Y) { const f32x4 e0 = *(const f32x4*)(in.r_k + cc), e1 = *(const f32x4*)(in.r_k + cc + 4); qr[0] = e0.x; qr[1] = e0.y; qr[2] = e0.z; qr[3] = e0.w; qr[4] = e1.x; qr[5] = e1.y; qr[6] = e1.z; qr[7] = e1.w; }
        float oA[8], oR[8], oB[8], oK[8], oBH[8], oKH[8];
#pragma unroll
        for (int e = 0; e < 8; ++e) {
            const float r = rc[e] + ((first ? 0.f : rp[e]) - rc[e]) * mr[e]; const float zk = kc[e] + ((first ? 0.f : kp[e]) - kc[e]) * mk[e];
            const float kq = zk * (1.f + (av[e] - 1.f) * qa[e]); const float kk = zk * qk[e] * inv; const float b = kk * av[e];
            const float Lg = rowscan16(lw[e]); const float eLg = __builtin_amdgcn_exp2f(1.4426950408889634f * Lg); const float enLg = __builtin_amdgcn_rcpf(eLg);
            const float eLgm = __builtin_bit_cast(float, __builtin_amdgcn_update_dpp(0x3f800000, __builtin_bit_cast(int, eLg), 0x111, 0xf, 0xf, false));
            const float eC = __builtin_bit_cast(float, __builtin_amdgcn_ds_bpermute(((lane & 48) | 15) << 2, __builtin_bit_cast(int, eLg)));
            oA[e] = -kk * eLgm; oR[e] = r * eLg; oB[e] = b * enLg; oK[e] = kq * enLg; oBH[e] = oB[e] * eC; oKH[e] = oK[e] * eC;
            if (WITH_Y) btacc += r * kq * qr[e];
            if (t == 15) gct[16 * jq + 8 * hf + e] = eC;
        }
        const int wo = t * CS_RS + (16 * jq + 8 * hf) * 2;
        *(LAS u32x4*)(wl + IM_A * CS_IMG + wo) = pack8(oA); *(LAS u32x4*)(wl + IM_R * CS_IMG + wo) = pack8(oR); *(LAS u32x4*)(wl + IM_B * CS_IMG + wo) = pack8(oB);
        *(LAS u32x4*)(wl + IM_K * CS_IMG + wo) = pack8(oK); *(LAS u32x4*)(wl + IM_BH * CS_IMG + wo) = pack8(oBH); *(LAS u32x4*)(wl + IM_KH * CS_IMG + wo) = pack8(oKH);
        if (USE_V) { float vc[8], vp[8], o[8]; unpack8(Lvc[hf], vc); unpack8(Lvp[hf], vp);
            const f32x4 a0 = *(const f32x4*)(in.mu + 1024 + cc), a1 = *(const f32x4*)(in.mu + 1024 + cc + 4); const float mv[8] = {a0.x, a0.y, a0.z, a0.w, a1.x, a1.y, a1.z, a1.w};
#pragma unroll
            for (int e = 0; e < 8; ++e) o[e] = vc[e] + ((first ? 0.f : vp[e]) - vc[e]) * mv[e];
            *(LAS u32x4*)(wl + IM_V * CS_IMG + wo) = pack8(o); }
        if (WITH_Y) *(LAS u32x4*)(wl + IM_G * CS_IMG + wo) = Lgg;
    }
    if (WITH_Y) { btacc = xsum_16_32(btacc); if (lane < 16) btt[lane] = btacc; }
}
struct CsFr { bf16x8 fAR[4], aL1, aL2, aL4, aL8, aLkMk, aMb; };
__device__ __forceinline__ void cs_gram(CsFr& fr, LAS unsigned char* wl, int lane) {
    const int hi = lane >> 5, row = lane & 15; const bool up = (lane & 16) != 0;
    const LAS unsigned char* rpAR = wl + (up ? IM_R : IM_A) * CS_IMG + row * CS_RS; const LAS unsigned char* rpBK = wl + (up ? IM_K : IM_B) * CS_IMG + row * CS_RS;
#pragma unroll
    for (int ks = 0; ks < 4; ++ks) fr.fAR[ks] = cs_rowfrag(rpAR, hi, ks);
    f32x16 F1 = {}, F2 = {};
#pragma unroll
    for (int ks = 0; ks < 4; ++ks) { const bf16x8 fBK = cs_rowfrag(rpBK, hi, ks);
        F1 = __builtin_amdgcn_mfma_f32_32x32x16_bf16(fBK, fr.fAR[ks], F1, 0, 0, 0);
        F2 = __builtin_amdgcn_mfma_f32_32x32x16_bf16(fr.fAR[ks], fBK, F2, 0, 0, 0); }
#pragma unroll
    for (int q = 0; q < 8; ++q) { const int s = crow8(q, hi); const bool k1 = up ? (s <= row) : (s < row);
        F1[q] = k1 ? F1[q] : 0.f; F1[8 + q] = k1 ? F1[8 + q] : 0.f; F2[q] = (!up && row < s) ? F2[q] : 0.f; }
    const bf16x8 f1lo = packp(F1, 0);
    fr.aL1 = up ? cs_zero8() : f1lo;
    fr.aMb = up ? f1lo : cs_zero8();
    fr.aLkMk = packp(F1, 1);
    const bf16x8 p2 = packp(F2, 0);
    const f32x16 z16 = {};
    const f32x16 Q1 = __builtin_amdgcn_mfma_f32_32x32x16_bf16(p2, fr.aL1, z16, 0, 0, 0), Q2 = __builtin_amdgcn_mfma_f32_32x32x16_bf16(fr.aL1, p2, z16, 0, 0, 0);
    fr.aL2 = packp(Q1, 0); const bf16x8 p2b = packp(Q2, 0);
    const f32x16 R1 = __builtin_amdgcn_mfma_f32_32x32x16_bf16(p2b, fr.aL2, z16, 0, 0, 0), R2 = __builtin_amdgcn_mfma_f32_32x32x16_bf16(fr.aL2, p2b, z16, 0, 0, 0);
    fr.aL4 = packp(R1, 0); const bf16x8 p2c = packp(R2, 0);
    const f32x16 S1 = __builtin_amdgcn_mfma_f32_32x32x16_bf16(p2c, fr.aL4, z16, 0, 0, 0);
    fr.aL8 = packp(S1, 0);
}
template <bool USE_V, bool WITH_Y>
__device__ __forceinline__ void cs_apply(f32x16 (&Z)[2][2], f32x16 (&D)[2], const CsFr& fr, LAS unsigned char* wl, int lane) {
    const int hi = lane >> 5;
    bf16x8 vf[2];
    if (USE_V) { vf[0] = cs_trfrag(wl + IM_V * CS_IMG, 0, lane); vf[1] = cs_trfrag(wl + IM_V * CS_IMG, 1, lane); }
#pragma unroll
    for (int nb = 0; nb < 2; ++nb) { f32x16 d = {};
#pragma unroll
        for (int jb = 0; jb < 2; ++jb)
#pragma unroll
            for (int k2 = 0; k2 < 2; ++k2) d = __builtin_amdgcn_mfma_f32_32x32x16_bf16(fr.fAR[2 * jb + k2], packp(Z[jb][nb], k2), d, 0, 0, 0);
        if (USE_V) d = __builtin_amdgcn_mfma_f32_32x32x16_bf16(fr.aLkMk, vf[nb], d, 0, 0, 0);
        D[nb] = d; }
#pragma unroll
    for (int nb = 0; nb < 2; ++nb) {
        D[nb] = __builtin_amdgcn_mfma_f32_32x32x16_bf16(fr.aL8, packp(D[nb], 0), D[nb], 0, 0, 0);
        D[nb] = __builtin_amdgcn_mfma_f32_32x32x16_bf16(fr.aL4, packp(D[nb], 0), D[nb], 0, 0, 0);
        D[nb] = __builtin_amdgcn_mfma_f32_32x32x16_bf16(fr.aL2, packp(D[nb], 0), D[nb], 0, 0, 0);
        D[nb] = __builtin_amdgcn_mfma_f32_32x32x16_bf16(fr.aL1, packp(D[nb], 0), D[nb], 0, 0, 0);
    }
    const bf16x8 u0 = packp(D[0], 0), u1 = packp(D[1], 0);
    if (WITH_Y) { D[0] = __builtin_amdgcn_mfma_f32_32x32x16_bf16(fr.aMb, u0, D[0], 0, 0, 0); D[1] = __builtin_amdgcn_mfma_f32_32x32x16_bf16(fr.aMb, u1, D[1], 0, 0, 0); }
    const LAS float* gct = (const LAS float*)(wl + 8 * CS_IMG);
#pragma unroll
    for (int jb = 0; jb < 2; ++jb) {
        const bf16x8 fb = cs_trfrag(wl + IM_BH * CS_IMG, jb, lane); bf16x8 fk = cs_zero8(); if (USE_V) fk = cs_trfrag(wl + IM_KH * CS_IMG, jb, lane);
        float gc[16];
#pragma unroll
        for (int g4 = 0; g4 < 4; ++g4) { const f32x4 x = *(const LAS f32x4*)(gct + 32 * jb + 8 * g4 + 4 * hi); gc[4 * g4] = x.x; gc[4 * g4 + 1] = x.y; gc[4 * g4 + 2] = x.z; gc[4 * g4 + 3] = x.w; }
#pragma unroll
        for (int nb = 0; nb < 2; ++nb) { f32x16 z = Z[jb][nb];
#pragma unroll
            for (int q = 0; q < 16; ++q) z[q] *= gc[q];
            z = __builtin_amdgcn_mfma_f32_32x32x16_bf16(fb, nb == 0 ? u0 : u1, z, 0, 0, 0);
            if (USE_V) z = __builtin_amdgcn_mfma_f32_32x32x16_bf16(fk, vf[nb], z, 0, 0, 0);
            Z[jb][nb] = z; }
    }
}
__device__ __forceinline__ void cs_apply_pk(bf16x8 (&Zp)[2][2][2], f32x16 (&D)[2], const CsFr& fr, LAS unsigned char* wl, int lane) {
    const int hi = lane >> 5;
#pragma unroll
    for (int nb = 0; nb < 2; ++nb) { f32x16 d = {};
#pragma unroll
        for (int jb = 0; jb < 2; ++jb)
#pragma unroll
            for (int k2 = 0; k2 < 2; ++k2) d = __builtin_amdgcn_mfma_f32_32x32x16_bf16(fr.fAR[2 * jb + k2], Zp[jb][nb][k2], d, 0, 0, 0);
        D[nb] = d; }
#pragma unroll
    for (int nb = 0; nb < 2; ++nb) {
        D[nb] = __builtin_amdgcn_mfma_f32_32x32x16_bf16(fr.aL8, packp(D[nb], 0), D[nb], 0, 0, 0);
        D[nb] = __builtin_amdgcn_mfma_f32_32x32x16_bf16(fr.aL4, packp(D[nb], 0), D[nb], 0, 0, 0);
        D[nb] = __builtin_amdgcn_mfma_f32_32x32x16_bf16(fr.aL2, packp(D[nb], 0), D[nb], 0, 0, 0);
        D[nb] = __builtin_amdgcn_mfma_f32_32x32x16_bf16(fr.aL1, packp(D[nb], 0), D[nb], 0, 0, 0);
    }
    const bf16x8 u0 = packp(D[0], 0), u1 = packp(D[1], 0);
    const LAS float* gct = (const LAS float*)(wl + 8 * CS_IMG);
#pragma unroll
    for (int jb = 0; jb < 2; ++jb) {
        const bf16x8 fb = cs_trfrag(wl + IM_BH * CS_IMG, jb, lane);
        float gc[16];
#pragma unroll
        for (int g4 = 0; g4 < 4; ++g4) { const f32x4 x = *(const LAS f32x4*)(gct + 32 * jb + 8 * g4 + 4 * hi); gc[4 * g4] = x.x; gc[4 * g4 + 1] = x.y; gc[4 * g4 + 2] = x.z; gc[4 * g4 + 3] = x.w; }
#pragma unroll
        for (int nb = 0; nb < 2; ++nb) { f32x16 z;
#pragma unroll
            for (int k2 = 0; k2 < 2; ++k2) { float e[8]; unpack8(__builtin_bit_cast(u32x4, Zp[jb][nb][k2]), e);
#pragma unroll
                for (int q = 0; q < 8; ++q) z[8 * k2 + q] = e[q] * gc[8 * k2 + q]; }
            z = __builtin_amdgcn_mfma_f32_32x32x16_bf16(fb, nb == 0 ? u0 : u1, z, 0, 0, 0);
            Zp[jb][nb][0] = packp(z, 0); Zp[jb][nb][1] = packp(z, 1); }
    }
}
template <bool USE_V, bool WITH_Y>
__device__ __forceinline__ void cs_step(f32x16 (&Z)[2][2], f32x16 (&D)[2], LAS unsigned char* wl, int lane) { CsFr fr; cs_gram(fr, wl, lane); cs_apply<USE_V, WITH_Y>(Z, D, fr, wl, lane); }
__device__ __forceinline__ void p_cs_a(const Frame& F, ArgsP a) {
    const int lane = lane_id_fresh();
    LAS unsigned char* wl = F.lds + F.wave * CS_WAVE;
    CsIn in{(const bf16*)(F.ws + WS_ZR), (const bf16*)(F.ws + WS_A), (const bf16*)(F.ws + WS_LW), (const bf16*)(F.dob + DO_G), a->in[I_MU], a->in[I_KK], a->in[I_KA], a->in[I_RK]};
    bf16* Pm = (bf16*)(F.dob + DO_CSP); bf16* Gf = (bf16*)(F.dob + DO_CSG);
    const int hi = lane >> 5;
    for (int uc = F.gw; uc < 64 * CS_NCH; uc += F.NGW) {
        const int bh = uc / CS_NCH, c = uc % CS_NCH, b = bh >> 3, h = bh & 7; const size_t row0 = (size_t)b * SEQ;
        f32x16 ZG[2][2], D[2]; bf16x8 ZP[2][2][2];
#pragma unroll
        for (int jb = 0; jb < 2; ++jb)
#pragma unroll
            for (int nb = 0; nb < 2; ++nb) { f32x16 z = {}; ZG[jb][nb] = z;
                if (jb == nb) {
#pragma unroll
                    for (int q = 0; q < 16; ++q) z[q] = (crow(q, hi) == (lane & 31)) ? 1.f : 0.f; }
                ZP[jb][nb][0] = packp(z, 0); ZP[jb][nb][1] = packp(z, 1); }
        for (int sc = 0; sc < CS_CH / 16; ++sc) { int ln = lane; asm volatile("" : "+v"(ln));
            cs_prep<true, false>(in, row0, c * CS_CH + sc * 16, h, wl, ln); asm volatile("s_waitcnt lgkmcnt(0)" ::: "memory");
            CsFr fr; cs_gram(fr, wl, ln);
            cs_apply_pk(ZP, D, fr, wl, ln); cs_apply<true, false>(ZG, D, fr, wl, ln); asm volatile("s_waitcnt lgkmcnt(0)" ::: "memory"); }
        int lo_ = lane; asm volatile("" : "+v"(lo_)); const int hi_o = lo_ >> 5;
        {
            LAS unsigned short* tb = (LAS unsigned short*)(wl + 4 * hi_o * CS_RS + (lo_ & 31) * 2);
#pragma unroll
            for (int jb = 0; jb < 2; ++jb)
#pragma unroll
                for (int nb = 0; nb < 2; ++nb)
#pragma unroll
                    for (int q = 0; q < 16; ++q) tb[((32 * jb + (q & 3) + 8 * (q >> 2)) * CS_RS + 64 * nb) / 2] = (unsigned short)ZP[jb][nb][q >> 3][q & 7];
            bf16* dst = Pm + (size_t)uc * 4096;
#pragma unroll
            for (int i = 0; i < 8; ++i) { const int ch = lo_ + 64 * i, rr = ch >> 3, c8 = (ch & 7) * 8; *(u32x4*)(dst + rr * 64 + c8) = *(const LAS u32x4*)(wl + rr * CS_RS + c8 * 2); }
            asm volatile("s_waitcnt lgkmcnt(0)" ::: "memory");
        }
        {
            bf16* dst = Gf + (size_t)uc * 4096;
#pragma unroll
            for (int jb = 0; jb < 2; ++jb)
#pragma unroll
                for (int nb = 0; nb < 2; ++nb) { u32x4 w0, w1; const f32x16& z = ZG[jb][nb];
                    w0.x = pk2(z[0], z[1]); w0.y = pk2(z[2], z[3]); w0.z = pk2(z[4], z[5]); w0.w = pk2(z[6], z[7]); w1.x = pk2(z[8], z[9]); w1.y = pk2(z[10], z[11]); w1.z = pk2(z[12], z[13]); w1.w = pk2(z[14], z[15]);
                    u32x4* p = (u32x4*)(dst + ((jb * 2 + nb) * 64 + lo_) * 16); p[0] = w0; p[1] = w1; }
        }
    }
}
struct CsB { u32x2 p[2][2][2][2]; u32x4 g[2][2]; };
__device__ __forceinline__ void csb_load(CsB& X, const bf16* Pm, const bf16* Gf, size_t uc, int nb, int lane) {
    const int hi = lane >> 5, r = lane & 31; const bf16* Pc = Pm + uc * 4096;
#pragma unroll
    for (int mb = 0; mb < 2; ++mb) {
#pragma unroll
        for (int jb = 0; jb < 2; ++jb)
#pragma unroll
            for (int k2 = 0; k2 < 2; ++k2) { const bf16* pr = Pc + (32 * mb + r) * 64 + 32 * jb + 16 * k2 + 4 * hi; X.p[mb][jb][k2][0] = *(const u32x2*)pr; X.p[mb][jb][k2][1] = *(const u32x2*)(pr + 8); }
        const u32x4* gp = (const u32x4*)(Gf + uc * 4096 + ((mb * 2 + nb) * 64 + lane) * 16); X.g[mb][0] = gp[0]; X.g[mb][1] = gp[1]; }
}
__device__ __forceinline__ void csb_step(f32x16 (&Z)[2], const CsB& X, bf16* Zf, size_t uc, int nb, int lane) {
#pragma unroll
    for (int jb = 0; jb < 2; ++jb) { u32x4 w0, w1; const f32x16& z = Z[jb];
        w0.x = pk2(z[0], z[1]); w0.y = pk2(z[2], z[3]); w0.z = pk2(z[4], z[5]); w0.w = pk2(z[6], z[7]); w1.x = pk2(z[8], z[9]); w1.y = pk2(z[10], z[11]); w1.z = pk2(z[12], z[13]); w1.w = pk2(z[14], z[15]);
        u32x4* p = (u32x4*)(Zf + uc * 4096 + ((jb * 2 + nb) * 64 + lane) * 16); p[0] = w0; p[1] = w1; }
    f32x16 N[2];
#pragma unroll
    for (int mb = 0; mb < 2; ++mb) { float g0[8], g1[8]; unpack8(X.g[mb][0], g0); unpack8(X.g[mb][1], g1);
#pragma unroll
        for (int q = 0; q < 8; ++q) { N[mb][q] = g0[q]; N[mb][8 + q] = g1[q]; } }
#pragma unroll
    for (int jb = 0; jb < 2; ++jb)
#pragma unroll
        for (int k2 = 0; k2 < 2; ++k2) { const bf16x8 zb = packp(Z[jb], k2);
#pragma unroll
            for (int mb = 0; mb < 2; ++mb) { const u32x2 x0 = X.p[mb][jb][k2][0], x1 = X.p[mb][jb][k2][1];
                N[mb] = __builtin_amdgcn_mfma_f32_32x32x16_bf16(__builtin_bit_cast(bf16x8, (u32x4){x0.x, x0.y, x1.x, x1.y}), zb, N[mb], 0, 0, 0); } }
    Z[0] = N[0]; Z[1] = N[1];
}
__device__ __forceinline__ void p_cs_b(const Frame& F) {
    const int lane = lane_id_fresh();
    const bf16* Pm = (const bf16*)(F.dob + DO_CSP); const bf16* Gf = (const bf16*)(F.dob + DO_CSG); bf16* Zf = (bf16*)(F.dob + DO_CSZ);
    for (int u16 = F.gw; u16 < 128 * 16; u16 += F.NGW) {
        if (u16 & 15) continue;
        const int u = u16 >> 4, bh = u >> 1, nb = u & 1; const size_t uc0 = (size_t)bh * CS_NCH;
        f32x16 Z[2] = {};
        CsB X0, X1;
        csb_load(X0, Pm, Gf, uc0, nb, lane);
        for (int c = 0; c < CS_NCH; c += 2) {
            csb_load(X1, Pm, Gf, uc0 + c + 1, nb, lane);
            csb_step(Z, X0, Zf, uc0 + c, nb, lane);
            csb_load(X0, Pm, Gf, uc0 + (c + 2 < CS_NCH ? c + 2 : CS_NCH - 1), nb, lane);
            csb_step(Z, X1, Zf, uc0 + c + 1, nb, lane);
        }
    }
}
__device__ __forceinline__ void p_cs_c(const Frame& F, ArgsP a) {
    const int lane = lane_id_fresh(), hi = lane >> 5;
    LAS unsigned char* wl = F.lds + F.wave * CS_WAVE;
    CsIn in{(const bf16*)(F.ws + WS_ZR), (const bf16*)(F.ws + WS_A), (const bf16*)(F.ws + WS_LW), (const bf16*)(F.dob + DO_G), a->in[I_MU], a->in[I_KK], a->in[I_KA], a->in[I_RK]};
    const bf16* Zf = (const bf16*)(F.dob + DO_CSZ); bf16* Y = (bf16*)(F.ws + WS_Y); const float* lnw = a->in[I_LNW]; const float* lnb = a->in[I_LNB];
    const LAS float* btt = (const LAS float*)(wl + 8 * CS_IMG) + 64;
    for (int uc = F.gw; uc < 64 * CS_NCH; uc += F.NGW) {
        const int bh = uc / CS_NCH, c = uc % CS_NCH, b = bh >> 3, h = bh & 7; const size_t row0 = (size_t)b * SEQ;
        f32x16 Z[2][2], D[2];
        int lu = lane; asm volatile("" : "+v"(lu));
#pragma unroll
        for (int jb = 0; jb < 2; ++jb)
#pragma unroll
            for (int nb = 0; nb < 2; ++nb) { const u32x4* p = (const u32x4*)(Zf + (size_t)uc * 4096 + ((jb * 2 + nb) * 64 + lu) * 16); float g0[8], g1[8]; unpack8(p[0], g0); unpack8(p[1], g1);
#pragma unroll
                for (int q = 0; q < 8; ++q) { Z[jb][nb][q] = g0[q]; Z[jb][nb][8 + q] = g1[q]; } }
        const float lw0 = lnw[h * 64 + (lu & 31)], lw1 = lnw[h * 64 + 32 + (lu & 31)], lb0 = lnb[h * 64 + (lu & 31)], lb1 = lnb[h * 64 + 32 + (lu & 31)];
        for (int sc = 0; sc < CS_CH / 16; ++sc) {
            const int tok0 = c * CS_CH + sc * 16;
            int ln = lane; asm volatile("" : "+v"(ln));
            cs_prep<true, true>(in, row0, tok0, h, wl, ln); asm volatile("s_waitcnt lgkmcnt(0)" ::: "memory");
            cs_step<true, true>(Z, D, wl, ln); asm volatile("s_waitcnt lgkmcnt(0)" ::: "memory");
            const int hl = ln >> 5;
            const bf16x8 v0 = cs_trfrag(wl + IM_V * CS_IMG, 0, ln), v1 = cs_trfrag(wl + IM_V * CS_IMG, 1, ln), g0 = cs_trfrag(wl + IM_G * CS_IMG, 0, ln), g1 = cs_trfrag(wl + IM_G * CS_IMG, 1, ln);
            const f32x4 bta = *(const LAS f32x4*)(btt + 4 * hl), btb = *(const LAS f32x4*)(btt + 8 + 4 * hl); const float bt[8] = {bta.x, bta.y, bta.z, bta.w, btb.x, btb.y, btb.z, btb.w};
#pragma unroll
            for (int q = 0; q < 8; ++q) {
                const float y0 = D[0][8 + q], y1 = D[1][8 + q];
                const float mean = allsum32(y0 + y1) * (1.f / 64.f); const float d0 = y0 - mean, d1 = y1 - mean;
                const float rstd = 1.0f / sqrtf(allsum32(d0 * d0 + d1 * d1) * (1.f / 64.f) + LN_X_EPS);
                const float o0 = (d0 * rstd * lw0 + lb0 + bt[q] * bf2f((unsigned short)v0[q])) * bf2f((unsigned short)g0[q]);
                const float o1 = (d1 * rstd * lw1 + lb1 + bt[q] * bf2f((unsigned short)v1[q])) * bf2f((unsigned short)g1[q]);
                bf16* yp = Y + (row0 + tok0 + crow8(q, hl)) * YYLD + h * 64 + (ln & 31);
                yp[0] = (unsigned short)f2bf(o0); yp[32] = (unsigned short)f2bf(o1);
            }
            asm volatile("s_waitcnt lgkmcnt(0)" ::: "memory");
        }
    }
}

__device__ __forceinline__ void p_ffn_route(const Frame& F, ArgsP a, unsigned* cnt, int* route) {
    const int lane_f = lane_id_fresh(), tid_f = F.wave * 64 + lane_f;
    const float* X = a->in[I_X]; const bf16* MO = (const bf16*)(F.ws + WS_MO); bf16* H2 = (bf16*)(F.ws + WS_H2); const float* mod = (const float*)(F.ws + WS_MOD); const float* g = a->in[I_GFFN];
    LAS float* wr = (LAS float*)F.lds;
    __syncthreads();
    for (int i = tid_f; i < 1024 * 4; i += NTHR) { const int k = i >> 2, o = i & 3; wr[o * 1024 + k] = a->in[I_WRG][i]; }
    for (int i = tid_f; i < 1024 * 32; i += NTHR) { const int k = i >> 5, o = i & 31; wr[(4 + o) * 1024 + k] = a->in[I_WRE][i]; }
    __syncthreads();
    LAS float* brl = wr + 36 * 1024;
    if (tid_f < 4) brl[tid_f] = a->in[I_BRG][tid_f]; else if (tid_f < 36) brl[tid_f] = a->in[I_BRE][tid_f - 4];
    const int lane = lane_f;
    LAS unsigned* lcnt = (LAS unsigned*)(F.lds + LDS_MISC + 512);
    if (tid_f < 64) lcnt[tid_f] = 0u;
    __syncthreads();
    int my_e0 = 0, my_e1 = 0; float my_w0 = 0.f, my_w1 = 0.f; int kk_ = 0;
    f32x4 xa[4], xb[4]; u32x2 ma[4], mb[4]; f32x4 gmv[4], gsv[4], shv[4]; int bcur = -1;
    { const f32x4* xr = (const f32x4*)(X + (size_t)F.gw * 1024) + lane; const u32x2* mr = (const u32x2*)(MO + (size_t)F.gw * 1024) + lane;
#pragma unroll
      for (int j = 0; j < 4; ++j) { xa[j] = xr[64 * j]; ma[j] = mr[64 * j]; } }
#define RT_ROW(CX, CM, NX, NM, m_) do { const int mm = (m_); const int b = mm / SEQ; \
        if (b != bcur) { bcur = b; \
            _Pragma("unroll") for (int j = 0; j < 4; ++j) { const int col = 4 * lane + 256 * j; gmv[j] = *(const f32x4*)(mod + b * 6144 + 2048 + col); \
                gsv[j] = *(const f32x4*)(g + col) * (*(const f32x4*)(mod + b * 6144 + 4096 + col) + 1.0f); shv[j] = *(const f32x4*)(mod + b * 6144 + 3072 + col); } \
            asm volatile("s_waitcnt vmcnt(0)" : "+v"(gmv[0]), "+v"(gmv[1]), "+v"(gmv[2]), "+v"(gmv[3]), "+v"(gsv[0]), "+v"(gsv[1]), "+v"(gsv[2]), "+v"(gsv[3]), "+v"(shv[0]), "+v"(shv[1]), "+v"(shv[2]), "+v"(shv[3])); \
            asm volatile("" : "+v"(CX[0]), "+v"(CX[1]), "+v"(CX[2]), "+v"(CX[3]), "+v"(CM[0]), "+v"(CM[1]), "+v"(CM[2]), "+v"(CM[3])); } \
        { const int mn = (mm + F.NGW < NTOK) ? mm + F.NGW : mm; const f32x4* xr = (const f32x4*)(X + (size_t)mn * 1024) + lane; const u32x2* mr = (const u32x2*)(MO + (size_t)mn * 1024) + lane; \
          _Pragma("unroll") for (int j = 0; j < 4; ++j) { NX[j] = xr[64 * j]; NM[j] = mr[64 * j]; } } \
        f32x4 v[4]; float s = 0.f; \
        _Pragma("unroll") for (int j = 0; j < 4; ++j) { v[j] = CX[j] + gmv[j] * (f32x4){lo2f(CM[j].x), hi2f(CM[j].x), lo2f(CM[j].y), hi2f(CM[j].y)}; \
            s += (v[j].x * v[j].x + v[j].y * v[j].y) + (v[j].z * v[j].z + v[j].w * v[j].w); } \
        const float rstd = 1.0f / sqrtf(wave_sum(s) * (1.f / 1024.f) + EPS); \
        u32x2* o = (u32x2*)(H2 + (size_t)mm * 1024) + lane; \
        _Pragma("unroll") for (int j = 0; j < 4; ++j) { v[j] = v[j] * rstd * gsv[j] + shv[j]; u32x2 w; w.x = pk2(v[j].x, v[j].y); w.y = pk2(v[j].z, v[j].w); o[64 * j] = w; } \
        float lgq[4]; \
        _Pragma("unroll") for (int oo = 0; oo < 4; ++oo) { float p = 0.f; \
            _Pragma("unroll") for (int j = 0; j < 4; ++j) { const f32x4 w4 = *(const LAS f32x4*)(wr + oo * 1024 + 4 * lane + 256 * j); p += (v[j].x * w4.x + v[j].y * w4.y) + (v[j].z * w4.z + v[j].w * w4.w); } \
            lgq[oo] = wave_sum(p) + brl[oo]; } \
        int gi = 0; float gmx = lgq[0]; \
        _Pragma("unroll") for (int i = 1; i < 4; ++i) { if (lgq[i] > gmx) { gmx = lgq[i]; gi = i; } } \
        float gsum = 0.f; \
        _Pragma("unroll") for (int i = 0; i < 4; ++i) gsum += __expf(lgq[i] - gmx); \
        const float pg = 1.f / gsum; \
        gi = __builtin_amdgcn_readfirstlane(gi); \
        float el[8]; \
        { const LAS float* wg = wr + (4 + gi * 8) * 1024 + 4 * lane; \
          _Pragma("unroll") for (int i = 0; i < 8; ++i) { float p = 0.f; \
              _Pragma("unroll") for (int j = 0; j < 4; ++j) { const f32x4 w4 = *(const LAS f32x4*)(wg + i * 1024 + 256 * j); p += (v[j].x * w4.x + v[j].y * w4.y) + (v[j].z * w4.z + v[j].w * w4.w); } \
              el[i] = wave_sum(p) + brl[4 + gi * 8 + i]; } } \
        int i0 = 0; float m0 = el[0]; \
        _Pragma("unroll") for (int i = 1; i < 8; ++i) if (el[i] > m0) { m0 = el[i]; i0 = i; } \
        int i1 = -1; float m1 = -INFINITY; \
        _Pragma("unroll") for (int i = 0; i < 8; ++i) if (i != i0 && el[i] > m1) { m1 = el[i]; i1 = i; } \
        const float e1 = __expf(m1 - m0), w0 = pg / (1.f + e1), w1 = pg * e1 / (1.f + e1); \
        if (lane == kk_) { my_e0 = gi * 8 + i0; my_e1 = gi * 8 + i1; my_w0 = w0; my_w1 = w1; } \
        ++kk_; } while (0)
    for (int m = F.gw; m < NTOK; m += 2 * F.NGW) {
        RT_ROW(xa, ma, xb, mb, m);
        if (m + F.NGW < NTOK) RT_ROW(xb, mb, xa, ma, m + F.NGW);
    }
#undef RT_ROW
    unsigned lp0 = 0u, lp1 = 0u;
    if (lane < kk_) { lp0 = __hip_atomic_fetch_add(lcnt + my_e0, 1u, __ATOMIC_RELAXED, __HIP_MEMORY_SCOPE_WORKGROUP); lp1 = __hip_atomic_fetch_add(lcnt + my_e1, 1u, __ATOMIC_RELAXED, __HIP_MEMORY_SCOPE_WORKGROUP); }
    __syncthreads();
    if (tid_f < 32) lcnt[32 + tid_f] = __hip_atomic_fetch_add(cnt + tid_f, lcnt[tid_f], __ATOMIC_RELAXED, __HIP_MEMORY_SCOPE_AGENT);
    __syncthreads();
    if (lane < kk_) { const int m = F.gw + lane * F.NGW; int* rt = route + (size_t)m * 8;
        rt[0] = my_e0; rt[1] = my_e1; rt[2] = (int)(lcnt[32 + my_e0] + lp0); rt[3] = (int)(lcnt[32 + my_e1] + lp1); rt[4] = __builtin_bit_cast(int, my_w0); rt[5] = __builtin_bit_cast(int, my_w1); }
    __syncthreads();
}
__device__ __forceinline__ int moe_tables(const Frame& F, LAS int* offs, LAS int* texp) {
    const int lane_f = lane_id_fresh(), tid_f = F.wave * 64 + lane_f;
    const unsigned* cnt = (const unsigned*)(F.ws + WS_CTL) + CW_CNT;
    __syncthreads();
    if (tid_f == 0) { int o = 0; for (int e = 0; e < 32; ++e) { offs[e] = o; const int c = (int)__hip_atomic_load(cnt + e, __ATOMIC_RELAXED, __HIP_MEMORY_SCOPE_AGENT); const int nt = (c + 255) >> 8; for (int t = 0; t < nt; ++t) texp[(o >> 8) + t] = e; o += nt << 8; } offs[32] = o; }
    __syncthreads();
    return offs[32] >> 8;
}
__device__ __forceinline__ void p_gather(const Frame& F) {
    const int lane_f = lane_id_fresh(), tid_f = F.wave * 64 + lane_f;
    LAS int* offs = (LAS int*)(F.lds + 1024); LAS int* texp = (LAS int*)(F.lds + 2048);
    moe_tables(F, offs, texp);
    const int* route = (const int*)(F.ws + WS_ROUTE); int* ridx = (int*)(F.ws + WS_ENT);
    const unsigned* cnt = (const unsigned*)(F.ws + WS_CTL) + CW_CNT;
    for (int m = F.vcu * NTHR + tid_f; m < NTOK; m += F.G * NTHR) { const u32x4 rt = *(const u32x4*)(route + (size_t)m * 8); ridx[offs[rt.x] + (int)rt.z] = m; ridx[offs[rt.y] + (int)rt.w] = m; }
    for (int i = F.vcu * NTHR + tid_f; i < 32 * 256; i += F.G * NTHR) { const int e = i >> 8, r = i & 255; const int c = (int)cnt[e]; const int pad = ((c + 255) & ~255) - c; if (r < pad) ridx[offs[e] + c + r] = 0; }
    __syncthreads();
}
__device__ __forceinline__ void p_combine(const Frame& F, const float* xin, float* dst) {
    const int lane_f = lane_id_fresh(), tid_f = F.wave * 64 + lane_f;
    LAS int* offs = (LAS int*)(F.lds + 1024); LAS int* texp = (LAS int*)(F.lds + 2048);
    moe_tables(F, offs, texp);
    const bf16* MO = (const bf16*)(F.ws + WS_MO); const bf16* YS = (const bf16*)(F.ws + WS_YS); const int* route = (const int*)(F.ws + WS_ROUTE); const float* mod = (const float*)(F.ws + WS_MOD);
    const int lane = lane_f;
    for (int m = F.gw; m < NTOK; m += F.NGW) {
        const int b = m / SEQ; const int* rt = route + (size_t)m * 8; const int d0 = offs[rt[0]] + rt[2], d1 = offs[rt[1]] + rt[3];
        const float w0 = __builtin_bit_cast(float, rt[4]), w1 = __builtin_bit_cast(float, rt[5]);
#pragma unroll
        for (int j = 0; j < 2; ++j) { const int col = 8 * lane + 512 * j; float y0[8], y1[8];
            unpack8(*(const u32x4*)(YS + (size_t)d0 * 1024 + col), y0); unpack8(*(const u32x4*)(YS + (size_t)d1 * 1024 + col), y1);
            const float* o = xin + (size_t)m * 1024 + col; const float* gt = mod + b * 6144 + 5120 + col; const float* gm = mod + b * 6144 + 2048 + col; float mo[8]; unpack8(*(const u32x4*)(MO + (size_t)m * 1024 + col), mo);
            f32x4 x0 = *(const f32x4*)o, x1 = *(const f32x4*)(o + 4); const f32x4 g0 = *(const f32x4*)gt, g1 = *(const f32x4*)(gt + 4), h0 = *(const f32x4*)gm, h1 = *(const f32x4*)(gm + 4);
            x0.x += h0.x * mo[0]; x0.y += h0.y * mo[1]; x0.z += h0.z * mo[2]; x0.w += h0.w * mo[3]; x1.x += h1.x * mo[4]; x1.y += h1.y * mo[5]; x1.z += h1.z * mo[6]; x1.w += h1.w * mo[7];
            x0.x += g0.x * (w0 * y0[0] + w1 * y1[0]); x0.y += g0.y * (w0 * y0[1] + w1 * y1[1]); x0.z += g0.z * (w0 * y0[2] + w1 * y1[2]); x0.w += g0.w * (w0 * y0[3] + w1 * y1[3]);
            x1.x += g1.x * (w0 * y0[4] + w1 * y1[4]); x1.y += g1.y * (w0 * y0[5] + w1 * y1[5]); x1.z += g1.z * (w0 * y0[6] + w1 * y1[6]); x1.w += g1.w * (w0 * y0[7] + w1 * y1[7]);
            float* od = dst + (size_t)m * 1024 + col; *(f32x4*)od = x0; *(f32x4*)(od + 4) = x1; }
    }
}

constexpr int NPHASE = 17;
template <int LO, int HI>
__global__ void __launch_bounds__(NTHR, 2) fwd(Args args) {
    extern __shared__ __attribute__((aligned(16))) unsigned char lds_raw[];
    Frame F;
    F.lds = (LAS unsigned char*)lds_raw;
    F.wave = __builtin_amdgcn_readfirstlane((int)threadIdx.x >> 6);
    F.G = gridDim.x; { const int bx = blockIdx.x; F.vcu = (F.G % 8 == 0) ? (bx % 8) * (F.G / 8) + bx / 8 : bx; }
    F.gw = F.vcu * NWAVES + F.wave; F.NGW = F.G * NWAVES;
    F.ws = args.ws; F.dob = (unsigned char*)args.out;
    ArgsP AP = (ArgsP)__builtin_amdgcn_kernarg_segment_ptr();
    volatile LAS unsigned* MISC = (volatile LAS unsigned*)(F.lds + LDS_MISC);
    if (threadIdx.x < 64) MISC[threadIdx.x] = 0u;
    __syncthreads();
    XcdBarrier bar; bar.bar = (unsigned*)(F.ws + WS_CTL) + CW_BAR; bar.x = 0; bar.st = MISC + 8;
#if N_LAUNCH_MODE == 1
    bar = xcd_barrier_post((unsigned*)(F.ws + WS_CTL) + CW_BAR, MISC + 8);
#define GRID_BAR() xcd_barrier(bar)
#else
#define GRID_BAR() do { } while (0)
#endif
#ifndef PROBE_REPEAT
#define PROBE_REPEAT -1
#endif
#define IN(k) (LO <= (k) && (k) < HI)
#define SEAM(k) do { if constexpr (IN(k) && IN((k) + 1)) GRID_BAR(); } while (0)
    const float* mod = (const float*)(F.ws + WS_MOD);

#define PH(k, ...) do { if constexpr (IN(k)) { asm volatile("" : "+s"(AP)); { __VA_ARGS__ } if constexpr (PROBE_REPEAT == (k)) { GRID_BAR(); asm volatile("" : "+s"(AP)); { __VA_ARGS__ } } } } while (0)
    PH(0, p0_prologue(F, AP);); SEAM(0);
    PH(1, p_normmod(F, AP->in[I_X], AP->in[I_GMIX], mod, 0, 1024, (bf16*)(F.ws + WS_H));); SEAM(1);
    PH(2, Gemm g{(const bf16*)(F.ws + WS_H), (const bf16*)(F.ws + WS_WIN), NTOK, N_IN_PAD, 1024}; StaticOrder S; S.init(NTOK, N_IN_PAD, F.G, (int)blockIdx.x);
        EpiZ E{(bf16*)(F.ws + WS_ZR), (bf16*)(F.ws + WS_SG), (bf16*)(F.ws + WS_ZM)}; gemm_phase_any(F.lds, g, S, E, F.wave);); SEAM(2);
    PH(3, p_prep_a(F, AP);); SEAM(3);
    PH(4,
        { Gemm g{(const bf16*)(F.ws + WS_TWA), (const bf16*)(F.ws + WS_WBLK), NTOK, 1024, 128}; StaticOrder S; S.init(NTOK, 1024, F.G, (int)blockIdx.x);
          EpiLora E{(bf16*)(F.ws + WS_LW), (bf16*)(F.ws + WS_A), AP->in[I_W0], AP->in[I_A0]}; gemm_phase_any(F.lds, g, S, E, F.wave); }
        { Gemm g{(const bf16*)(F.ws + WS_SGL), (const bf16*)(F.ws + WS_WG), NTOK, 512, 128}; StaticOrder S; S.init(NTOK, 512, F.G, (int)blockIdx.x);
          EpiPlain E{(bf16*)(F.dob + DO_G), nullptr, 1 << 30, 512, 0}; gemm_phase_any(F.lds, g, S, E, F.wave); }
        { Gemm g{(const bf16*)(F.ws + WS_QA), (const bf16*)(F.ws + WS_WUQ), NTOK, 768, 256}; StaticOrder S; S.init(NTOK, 768, F.G, (int)blockIdx.x);
          EpiPlain E{(bf16*)(F.dob + DO_Q), nullptr, 1 << 30, 768, 0}; gemm_phase_any(F.lds, g, S, E, F.wave); }
        { Gemm g{(const bf16*)(F.ws + WS_KVA), (const bf16*)(F.ws + WS_WUKV), NTOK, 1024, 128}; StaticOrder S; S.init(NTOK, 1024, F.G, (int)blockIdx.x);
          EpiPlain E{(bf16*)(F.dob + DO_KN), (bf16*)(F.ws + WS_VC), 512, 512, 512}; gemm_phase_any(F.lds, g, S, E, F.wave); }
    ); SEAM(4);
    PH(5, p_prep_c(F, AP);); SEAM(5);
#if ENG_ATTN == 1
    PH(6, p_attn_mfma(F, AP->in[I_QN]);); SEAM(6);
#else
    PH(6, p_attn_naive(F);); SEAM(6);
#endif
    PH(7, p_cs_a(F, AP);); SEAM(7);
    PH(8, p_cs_b(F);); SEAM(8);
    PH(9, p_cs_c(F, AP);); SEAM(9);
    PH(10, Gemm g{(const bf16*)(F.ws + WS_Y), (const bf16*)(F.ws + WS_WB), NTOK, 1024, 1024}; StaticOrder S; S.init(NTOK, 1024, F.G, (int)blockIdx.x);
        EpiBranch2 E{(bf16*)(F.ws + WS_MG), (const bf16*)(F.ws + WS_SG)}; gemm_phase_mid(F.lds, g, S, E, F.wave);); SEAM(10);
    PH(11, Gemm g{(const bf16*)(F.ws + WS_MG), (const bf16*)(F.ws + WS_WO), NTOK, 1024, 1024}; StaticOrder S; S.init(NTOK, 1024, F.G, (int)blockIdx.x);
        EpiPlain E{(bf16*)(F.ws + WS_MO), nullptr, 1 << 30, 1024, 0}; gemm_phase_any(F.lds, g, S, E, F.wave);); SEAM(11);
    if constexpr (PROBE_REPEAT == 12) { p_ffn_route(F, AP, (unsigned*)(F.ws + WS_CTL) + CW_CNT + 64, (int*)(F.ws + WS_CS)); GRID_BAR(); }
    if constexpr (IN(12)) { asm volatile("" : "+s"(AP)); p_ffn_route(F, AP, (unsigned*)(F.ws + WS_CTL) + CW_CNT, (int*)(F.ws + WS_ROUTE)); } SEAM(12);
    PH(13, p_gather(F);); SEAM(13);
    PH(14, LAS int* offs = (LAS int*)(F.lds + LDS_MISC + 1024); LAS int* texp = (LAS int*)(F.lds + LDS_MISC + 1024 + 256); const int nt = moe_tables(F, offs, texp);
        Gemm g{(const bf16*)(F.ws + WS_H2), (const bf16*)(F.ws + WS_WGU), MPAD, 512, 1024, (const int*)(F.ws + WS_ENT)}; TableOrder S{texp, nt, 2, F.G, (int)blockIdx.x};
        EpiGateUp E{(bf16*)(F.ws + WS_HID)}; gemm_phase_gather(F.lds, g, S, E, F.wave);); SEAM(14);
    PH(15, LAS int* offs = (LAS int*)(F.lds + LDS_MISC + 1024); LAS int* texp = (LAS int*)(F.lds + LDS_MISC + 1024 + 256); const int nt = moe_tables(F, offs, texp);
        Gemm g{(const bf16*)(F.ws + WS_HID), (const bf16*)(F.ws + WS_WDN), MPAD, 1024, 256}; TableOrder S{texp, nt, 4, F.G, (int)blockIdx.x};
        EpiDown E{(bf16*)(F.ws + WS_YS)}; gemm_phase_any(F.lds, g, S, E, F.wave);); SEAM(15);
    if constexpr (PROBE_REPEAT == 16) { asm volatile("" : "+s"(AP)); p_combine(F, AP->in[I_X], (float*)(F.ws + WS_SG)); GRID_BAR(); }
    if constexpr (IN(16)) { asm volatile("" : "+s"(AP)); p_combine(F, AP->in[I_X], (float*)F.dob); }
}

#if N_LAUNCH_MODE == 1
static bool set_attrs() { return hipFuncSetAttribute((const void*)fwd<0, NPHASE>, hipFuncAttributeMaxDynamicSharedMemorySize, LDS_BYTES) == hipSuccess; }
#else
template <int P> static bool set_attr_all() { if constexpr (P < NPHASE) { return hipFuncSetAttribute((const void*)fwd<P, P + 1>, hipFuncAttributeMaxDynamicSharedMemorySize, LDS_BYTES) == hipSuccess && set_attr_all<P + 1>(); } else return true; }
static bool set_attrs() { return set_attr_all<0>(); }
template <int P> static void launch_all(int grid, hipStream_t stream, const Args& a) { if constexpr (P < NPHASE) { hipLaunchKernelGGL((fwd<P, P + 1>), dim3(grid), dim3(NTHR), LDS_BYTES, stream, a); launch_all<P + 1>(grid, stream, a); } }
#endif
extern "C" void kernel_launch(void* const* d_in, const int* in_sizes, int n_in, void* d_out, int out_size, void* d_ws, size_t ws_size, hipStream_t stream) {
    static int grid = 0;
    if (grid == 0) {
        if (n_in != 34 || out_size != NTOK * DM || ws_size < WS_END) { fprintf(stderr, "kernel_launch: unexpected shapes (n_in %d out %d ws %zu)\n", n_in, out_size, ws_size); grid = -1; return; }
        int dev = 0, cus = 0;
        if (hipGetDevice(&dev) != hipSuccess || hipDeviceGetAttribute(&cus, hipDeviceAttributeMultiprocessorCount, dev) != hipSuccess) { grid = -1; return; }
        if (!set_attrs()) { fprintf(stderr, "kernel_launch: hipFuncSetAttribute failed\n"); grid = -1; return; }
        grid = cus;
    }
    if (grid < 0) return;
    (void)hipMemsetAsync((char*)d_ws + WS_CTL, 0, CTL_ZERO_BYTES, stream);
    Args a{};
    for (int i = 0; i < 34; ++i) a.in[i] = (const float*)d_in[i];
    a.out = (float*)d_out; a.ws = (unsigned char*)d_ws;
    a.ph_lo = 0; a.ph_hi = NPHASE;
#if N_LAUNCH_MODE == 1
    hipLaunchKernelGGL((fwd<0, NPHASE>), dim3(grid), dim3(NTHR), LDS_BYTES, stream, a);
#else
    launch_all<0>(grid, stream, a);
#endif
}
```

```cpp
#include <hip/hip_runtime.h>
#include <cstdio>
#include <cstdint>

#ifndef N_LAUNCH_MODE
#define N_LAUNCH_MODE 1
#endif
#ifndef ENG_GEMM
#define ENG_GEMM 1
#endif
#ifndef ENG_ATTN
#define ENG_ATTN 1
#endif

#define GAS __attribute__((address_space(1)))
#define LAS __attribute__((address_space(3)))
typedef unsigned short bf16;
typedef float f32x4 __attribute__((ext_vector_type(4)));
typedef float f32x2 __attribute__((ext_vector_type(2)));
typedef unsigned u32x4 __attribute__((ext_vector_type(4)));
typedef unsigned u32x2 __attribute__((ext_vector_type(2)));
typedef short bf16x8 __attribute__((ext_vector_type(8)));

constexpr int BATCH = 8, SEQ = 8192, DM = 1024, NTOK = BATCH * SEQ;
constexpr int D_RWKV = 512, RWKV_COLS = 1792, MLA_COLS = 416, D_IN = 4256, N_IN_PAD = 4352;
constexpr int NH = 8, QKD = 96, NOPE = 64, ROPE = 32, VD = 64;
constexpr int NEXP = 32, DEXP = 256;
constexpr int MPAD = 139264;
constexpr float EPS = 1e-6f, LN_X_EPS = 64e-5f;
constexpr float QSCALE = 0.10206207261596577f * 1.4426950408889634f;

constexpr size_t MiB = 1u << 20;
constexpr size_t WS_CTL = 0, CTL_ZERO_BYTES = 1 * MiB;
constexpr size_t WS_MOD = 1 * MiB;
constexpr size_t WS_ROUTE = 2 * MiB;
constexpr size_t WS_CS = 4 * MiB;
constexpr size_t WS_ENT = 12 * MiB;
constexpr size_t WS_WIN = 16 * MiB;
constexpr size_t WS_WBLK = 25 * MiB;
constexpr size_t WS_WG = WS_WBLK + 256 * 1024;
constexpr size_t WS_WUQ = WS_WG + 128 * 1024;
constexpr size_t WS_WUKV = WS_WUQ + 384 * 1024;
constexpr size_t WS_WB = 26 * MiB;
constexpr size_t WS_WO = 28 * MiB;
constexpr size_t WS_WGU = 30 * MiB;
constexpr size_t WS_WDN = 62 * MiB;
constexpr size_t WS_SG = 80 * MiB;
constexpr size_t WS_H2 = 80 * MiB;
constexpr size_t WS_ZR = 336 * MiB;
constexpr size_t WS_VC = 816 * MiB;
constexpr size_t WS_KC = 880 * MiB;
constexpr size_t WS_Y = 560 * MiB;
constexpr size_t WS_XG = 336 * MiB;
constexpr size_t WS_ZM = 560 * MiB;
constexpr size_t WS_YM = 560 * MiB + 1024;
constexpr size_t WS_H = 688 * MiB;
constexpr size_t WS_LW = 688 * MiB;
constexpr size_t WS_A = 752 * MiB;
constexpr size_t WS_MG = 688 * MiB;
constexpr size_t WS_HID = 208 * MiB;
constexpr size_t WS_R = 752 * MiB;
constexpr size_t WS_V = 816 * MiB;
constexpr size_t WS_ZK = 880 * MiB;
constexpr size_t WS_TWA = 944 * MiB;
constexpr size_t WS_SGL = 960 * MiB;
constexpr size_t WS_QA = 976 * MiB;
constexpr size_t WS_KVA = 1008 * MiB;
constexpr size_t WS_KK = 944 * MiB;
constexpr size_t WS_YS = 752 * MiB;
constexpr size_t WS_MO = 560 * MiB;
constexpr int YYLD = 1024;
constexpr size_t WS_END = 1024 * MiB;
constexpr size_t DO_G = 0;
constexpr size_t DO_Q = 64 * MiB;
constexpr size_t DO_KN = 160 * MiB;

constexpr int CW_CNT = 64;
constexpr int CW_BAR = 4096;

constexpr int NWAVES = 8, NTHR = 512;
constexpr int LDS_BYTES = 155648;
constexpr int LDS_MISC = 151552;

__device__ __forceinline__ int lane_id_fresh() { int l; asm volatile("v_mbcnt_lo_u32_b32 %0, -1, 0\n\tv_mbcnt_hi_u32_b32 %0, -1, %0" : "=v"(l)); return l; }
__device__ __forceinline__ float bf2f(unsigned short h) { return __builtin_bit_cast(float, (unsigned)h << 16); }
__device__ __forceinline__ unsigned f2bf(float f) { unsigned u = __builtin_bit_cast(unsigned, f); return (u + 0x7fffu + ((u >> 16) & 1u)) >> 16; }
typedef __bf16 bf16x2_t __attribute__((ext_vector_type(2)));
__device__ __forceinline__ unsigned pk2(float lo, float hi) { const f32x2 v = {lo, hi}; return __builtin_bit_cast(unsigned, __builtin_convertvector(v, bf16x2_t)); }
__device__ __forceinline__ float lo2f(unsigned w) { return __builtin_bit_cast(float, w << 16); }
__device__ __forceinline__ float hi2f(unsigned w) { return __builtin_bit_cast(float, w & 0xffff0000u); }
template <int CTRL> __device__ __forceinline__ float dpp_add(float x) { return x + __builtin_bit_cast(float, __builtin_amdgcn_update_dpp(0, __builtin_bit_cast(int, x), CTRL, 0xf, 0xf, false)); }
__device__ __forceinline__ float allsum16(float x) { x = dpp_add<0xB1>(x); x = dpp_add<0x4E>(x); x = dpp_add<0x141>(x); x = dpp_add<0x140>(x); return x; }
__device__ __forceinline__ float allsum32(float x) { x = allsum16(x); auto r = __builtin_amdgcn_permlane16_swap(__float_as_uint(x), __float_as_uint(x), false, false); return __uint_as_float(r[0]) + __uint_as_float(r[1]); }
__device__ __forceinline__ float sum8(float x) { x = dpp_add<0xB1>(x); x = dpp_add<0x4E>(x); x = dpp_add<0x141>(x); return x; }
__device__ __forceinline__ float wave_sum(float v) {
    v = allsum16(v);
    { auto r = __builtin_amdgcn_permlane16_swap(__float_as_uint(v), __float_as_uint(v), false, false); v = __uint_as_float(r[0]) + __uint_as_float(r[1]); }
    { auto r = __builtin_amdgcn_permlane32_swap(__float_as_uint(v), __float_as_uint(v), false, false); v = __uint_as_float(r[0]) + __uint_as_float(r[1]); }
    return v;
}
__device__ __forceinline__ float sigmoidf_(float x) { return __builtin_amdgcn_rcpf(1.f + __builtin_amdgcn_exp2f(-1.4426950408889634f * x)); }
__device__ __forceinline__ float siluf_(float x) { return x * __builtin_amdgcn_rcpf(1.f + __builtin_amdgcn_exp2f(-1.4426950408889634f * x)); }
__device__ __forceinline__ void unpack8(const u32x4 w, float (&v)[8]) {
    v[0] = lo2f(w.x); v[1] = hi2f(w.x); v[2] = lo2f(w.y); v[3] = hi2f(w.y); v[4] = lo2f(w.z); v[5] = hi2f(w.z); v[6] = lo2f(w.w); v[7] = hi2f(w.w);
}
__device__ __forceinline__ u32x4 pack8(const float (&v)[8]) { u32x4 w; w.x = pk2(v[0], v[1]); w.y = pk2(v[2], v[3]); w.z = pk2(v[4], v[5]); w.w = pk2(v[6], v[7]); return w; }

#define LDS_BAR() do { asm volatile("s_waitcnt lgkmcnt(0)" ::: "memory"); __builtin_amdgcn_s_barrier(); asm volatile("" ::: "memory"); } while (0)

#define XB_TMO      128
#define XB_XCNT(j)  (256  + 64 * (j))
#define XB_XSUB(j)  (1280 + 64 * (j))
#define XB_XGEN(j)  (2304 + 64 * (j))
#define XB_TOP      3328
#define XB_TOPGEN   3392
#define XCD_BAR_WORDS 3456
#define XB_SPIN_CAP (1u << 19)
__device__ __forceinline__ unsigned xb_ld(unsigned* p)              { return __hip_atomic_load(p, __ATOMIC_RELAXED, __HIP_MEMORY_SCOPE_AGENT); }
__device__ __forceinline__ unsigned xb_add(unsigned* p, unsigned v) { return __hip_atomic_fetch_add(p, v, __ATOMIC_RELAXED, __HIP_MEMORY_SCOPE_AGENT); }
__device__ __forceinline__ unsigned xb_xcc_id() { return (unsigned)__builtin_amdgcn_s_getreg((3 << 11) | 20) & 0xFu; }
#define XB_SPIN(cond, bar) do { unsigned _sp = 0; while (cond) { __builtin_amdgcn_s_sleep(1); \
    if ((++_sp & 255u) == 0u) { if (xb_ld(&(bar)[XB_TMO])) break; if (_sp > XB_SPIN_CAP) { atomicAdd(&(bar)[XB_TMO], 1u); break; } } } } while (0)
struct XcdBarrier { unsigned* bar; unsigned x; volatile LAS unsigned* st; };
__device__ __forceinline__ XcdBarrier xcd_barrier_post(unsigned* bar, volatile LAS unsigned* st) {
    XcdBarrier b; b.bar = bar; b.x = xb_xcc_id(); b.st = st;
    if (threadIdx.x == 0) (void)xb_add(&bar[XB_XCNT(b.x)], 1u);
    return b;
}
__device__ __forceinline__ void xcd_barrier_complete(unsigned* bar, unsigned x, unsigned& nloc, unsigned& nx) {
    const unsigned G = gridDim.x * gridDim.y * gridDim.z;
    unsigned sum, cnt, mine, sp = 0u;
    for (;;) {
        sum = 0u; cnt = 0u; mine = 0u;
#pragma unroll
        for (unsigned j = 0; j < 16; ++j) { const unsigned c = xb_ld(&bar[XB_XCNT(j)]); sum += c; cnt += (c > 0u) ? 1u : 0u; mine = (j == x) ? c : mine; }
        if (sum == G) break;
        __builtin_amdgcn_s_sleep(1);
        if ((++sp & 255u) == 0u) { if (xb_ld(&bar[XB_TMO])) break; if (sp > XB_SPIN_CAP) { atomicAdd(&bar[XB_TMO], 1u); break; } }
    }
    nloc = mine > 0u ? mine : 1u; nx = cnt > 0u ? cnt : 1u;
}
__device__ __forceinline__ void xcd_barrier(const XcdBarrier& b) {
    asm volatile("s_waitcnt vmcnt(0)" ::: "memory");
    __syncthreads();
    if (threadIdx.x == 0) {
        unsigned* bar = b.bar;
        __builtin_amdgcn_s_waitcnt(0);
        unsigned nloc = b.st[0], nx = b.st[1];
        if (nloc == 0u) { xcd_barrier_complete(bar, b.x, nloc, nx); b.st[0] = nloc; b.st[1] = nx; }
        const unsigned old = xb_add(&bar[XB_XSUB(b.x)], 1u);
        const unsigned gen = old / nloc;
        if (old + 1u == (gen + 1u) * nloc) {
            __builtin_amdgcn_fence(__ATOMIC_RELEASE, "agent");
            asm volatile("s_waitcnt vmcnt(0)" ::: "memory");
            const unsigned og = xb_add(&bar[XB_TOP], 1u);
            const unsigned tg = og / nx;
            if (og + 1u == (tg + 1u) * nx) xb_add(&bar[XB_TOPGEN], 1u);
            else XB_SPIN(xb_ld(&bar[XB_TOPGEN]) == tg, bar);
            __builtin_amdgcn_fence(__ATOMIC_ACQUIRE, "agent");
            xb_add(&bar[XB_XGEN(b.x)], 1u);
            asm volatile("s_waitcnt vmcnt(0)" ::: "memory");
        } else {
            XB_SPIN(xb_ld(&bar[XB_XGEN(b.x)]) == gen, bar);
            __builtin_amdgcn_fence(__ATOMIC_ACQUIRE, "agent");
            asm volatile("s_waitcnt vmcnt(0)" ::: "memory");
        }
    }
    __syncthreads();
}

struct Args {
    const float* in[34]; float* out; unsigned char* ws; int ph_lo, ph_hi;
};
typedef const __attribute__((address_space(4))) Args* ArgsP;
struct Frame {
    LAS unsigned char* lds;
    int wave, vcu, G, gw, NGW;
    unsigned char* ws; unsigned char* dob;
};
enum { I_X = 0, I_C, I_POS, I_WADA, I_BADA, I_GMIX, I_WIN, I_MU, I_W0, I_WDEC, I_A0, I_WAUP, I_WGUP, I_KK, I_KA, I_RK, I_LNW, I_LNB, I_GQA, I_WUQ, I_GKVA, I_WUKV,
       I_QN, I_KN, I_WBR, I_WOUT, I_GFFN, I_WRG, I_BRG, I_WRE, I_BRE, I_WEG, I_WEU, I_WED };

struct Unit { int pm, pn; };
struct Gemm { const bf16* A; const bf16* Bt; int M, N, K; const int* ridx = nullptr; };
constexpr int NXCD = 8, WGM = 8;
struct StaticOrder {
    int nM, nN, nwg, G, c;
    __device__ void init(int M, int N, int G_, int c_) { nM = M / 256; nN = N / 256; nwg = nM * nN; G = G_; c = c_; }
    __device__ bool next(int i, Unit& u) const {
        const long L = (long)i * G + c; if (L >= nwg) return false;
        int wgid = (int)L; { const int q = nwg / NXCD, r = nwg % NXCD, xcd = wgid % NXCD, off = wgid / NXCD; wgid = (xcd < r ? xcd * (q + 1) : r * (q + 1) + (xcd - r) * q) + off; }
        const int nig = WGM * nN, gid = wgid / nig, fm = gid * WGM, gsz = (nM - fm) < WGM ? (nM - fm) : WGM;
        u.pm = fm + ((wgid % nig) % gsz); u.pn = (wgid % nig) / gsz; return true;
    }
    __device__ __forceinline__ void a_ready(const Unit&) const {}
    __device__ __forceinline__ void done(const Unit&) const {}
};
struct TableOrder {
    const LAS int* texp; int ntiles, nN, G, c;
    __device__ bool next(int i, Unit& u) const {
        const long L = (long)i * G + c; if (L >= (long)ntiles * nN) return false;
        const int t = (int)(L / nN), j = (int)(L % nN); u.pm = t; u.pn = texp[t] * nN + j; return true;
    }
    __device__ __forceinline__ void a_ready(const Unit&) const {}
    __device__ __forceinline__ void done(const Unit&) const {}
};

template <class Epi, class Sched>
__device__ __forceinline__ void gemm_phase_naive(LAS unsigned char* lds, const Gemm g, const Sched& S, const Epi& E) {
    const int tid = (int)__builtin_amdgcn_readfirstlane((int)threadIdx.x >> 6) * 64 + lane_id_fresh(), ty = tid >> 5, tx = tid & 31;
    LAS bf16* As = (LAS bf16*)lds; LAS bf16* Bs = (LAS bf16*)(lds + 128 * 40 * 2);
    Unit u;
    for (int i = 0; S.next(i, u); ++i) {
        for (int half = 0; half < 2; ++half) {
            float acc[8][8];
#pragma unroll
            for (int r = 0; r < 8; ++r)
#pragma unroll
                for (int c = 0; c < 8; ++c) acc[r][c] = 0.f;
            const bf16* Ab = g.A + ((size_t)u.pm * 256 + half * 128) * g.K; const bf16* Bb = g.Bt + (size_t)u.pn * 256 * g.K;
            for (int k0 = 0; k0 < g.K; k0 += 32) {
                __syncthreads();
                { const int r = tid >> 2, c8 = (tid & 3) * 8; *(LAS u32x4*)(As + r * 40 + c8) = *(const u32x4*)(Ab + (size_t)r * g.K + k0 + c8); }
#pragma unroll
                for (int j = 0; j < 2; ++j) { const int ch = tid + j * 512, r = ch >> 2, c8 = (ch & 3) * 8; *(LAS u32x4*)(Bs + r * 40 + c8) = *(const u32x4*)(Bb + (size_t)r * g.K + k0 + c8); }
                __syncthreads();
#pragma unroll 2
                for (int k = 0; k < 32; k += 2) {
                    float b0[8], b1[8];
#pragma unroll
                    for (int c = 0; c < 8; ++c) { const unsigned w = *(const LAS unsigned*)(Bs + (tx * 8 + c) * 40 + k); b0[c] = lo2f(w); b1[c] = hi2f(w); }
#pragma unroll
                    for (int r = 0; r < 8; ++r) { const unsigned w = *(const LAS unsigned*)(As + (ty * 8 + r) * 40 + k); const float a0 = lo2f(w), a1 = hi2f(w);
#pragma unroll
                        for (int c = 0; c < 8; ++c) acc[r][c] = fmaf(a1, b1[c], fmaf(a0, b0[c], acc[r][c])); }
                }
            }
#pragma unroll
            for (int r = 0; r < 8; ++r) E.store8(u, half * 128 + ty * 8 + r, tx * 8, acc[r]);
        }
    }
    __syncthreads();
}

struct EpiZ { bf16 *ZR, *SG, *ZM;
    __device__ __forceinline__ void store8(const Unit& u, int r, int c, const float (&v)[8]) const {
        const size_t row = (size_t)u.pm * 256 + r;
        if (u.pn < 7) { *(u32x4*)(ZR + row * 1792 + u.pn * 256 + c) = pack8(v); }
        else if (u.pn < 15) { *(u32x4*)(SG + row * 2048 + (u.pn - 7) * 256 + c) = pack8(v); }
        else { *(u32x4*)(ZM + row * 512 + (u.pn - 15) * 256 + c) = pack8(v); }
    } };
struct EpiLora { bf16 *LW, *A; const float *w0, *a0;
    __device__ __forceinline__ void store8(const Unit& u, int r, int c, const float (&v)[8]) const {
        const size_t row = (size_t)u.pm * 256 + r; const int col = u.pn * 256 + c; float o[8];
        const bool isw = col < 512; const float* bp = isw ? (w0 + col) : (a0 + col - 512);
        const f32x4 b0 = *(const f32x4*)bp, b1 = *(const f32x4*)(bp + 4); const float bb[8] = {b0.x, b0.y, b0.z, b0.w, b1.x, b1.y, b1.z, b1.w};
#pragma unroll
        for (int i = 0; i < 8; ++i) { const float e = __builtin_amdgcn_exp2f(fminf(-1.4426950408889634f * (bb[i] + v[i]), 120.f)); const float s = __builtin_amdgcn_rcpf(1.0f + e); o[i] = isw ? -0.60653065971263342f * s : s; }
        bf16* dst = isw ? (LW + row * 512 + col) : (A + row * 512 + col - 512);
        *(u32x4*)dst = pack8(o);
    } };
struct EpiPlain { bf16* O0; bf16* O1; int split, ld0, ld1;
    __device__ __forceinline__ void store8(const Unit& u, int r, int c, const float (&v)[8]) const {
        const size_t row = (size_t)u.pm * 256 + r; int col = u.pn * 256 + c;
        if (col < split) *(u32x4*)(O0 + row * ld0 + col) = pack8(v); else *(u32x4*)(O1 + row * ld1 + col - split) = pack8(v);
    } };
struct EpiBranch2 { bf16* MG; const bf16* SG;
    __device__ __forceinline__ void mid8(const Unit& u, int r, int c, float (&v)[8]) const {
        const size_t row = (size_t)u.pm * 256 + r; const int col = u.pn * 256 + c; float gr[8], gm[8];
        unpack8(*(const u32x4*)(SG + row * 2048 + col), gr); unpack8(*(const u32x4*)(SG + row * 2048 + 1024 + col), gm);
#pragma unroll
        for (int i = 0; i < 8; ++i) v[i] *= (1.f + __builtin_amdgcn_exp2f(-1.4426950408889634f * fmaxf(gm[i], -30.f))) * __builtin_amdgcn_rcpf(1.f + __builtin_amdgcn_exp2f(-1.4426950408889634f * gr[i]));
    }
    __device__ __forceinline__ void store8(const Unit& u, int r, int c, const float (&v)[8]) const {
        const size_t row = (size_t)u.pm * 256 + r; const int col = u.pn * 256 + c; float gm[8], o[8];
        unpack8(*(const u32x4*)(SG + row * 2048 + 1024 + col), gm);
#pragma unroll
        for (int i = 0; i < 8; ++i) o[i] = sigmoidf_(fmaxf(gm[i], -30.f)) * v[i];
        *(u32x4*)(MG + row * 1024 + col) = pack8(o);
    } };
struct EpiGateUp { bf16* HID;
    __device__ __forceinline__ void store8(const Unit& u, int r, int c, const float (&v)[8]) const {
        const size_t row = (size_t)u.pm * 256 + r; const int col = ((u.pn & 1) * 256 + c) >> 1;
        u32x2 w; w.x = pk2(siluf_(v[0]) * v[4], siluf_(v[1]) * v[5]); w.y = pk2(siluf_(v[2]) * v[6], siluf_(v[3]) * v[7]);
        *(u32x2*)(HID + row * 256 + col) = w;
    } };
struct EpiDown { bf16* YS;
    __device__ __forceinline__ void store8(const Unit& u, int r, int c, const float (&v)[8]) const {
        const size_t row = (size_t)u.pm * 256 + r; *(u32x4*)(YS + row * 1024 + (u.pn & 3) * 256 + c) = pack8(v);
    } };


namespace pg8 {
#define PG8_LAS __attribute__((address_space(3)))
typedef ::bf16x8 bf16x8; typedef ::f32x4 f32x4;
using ::Unit; using ::Gemm;
constexpr int BM = 256, BK = 64, HALF = 128, HTB = HALF * BK * 2  , STAGE_BYTES = 8 * HTB;

__device__ __forceinline__ int lds_byte(int r, int c) { const int st = (r >> 4) * 2 + (c >> 5), rr = r & 15, cc = c & 31, ob = rr * 64 + cc * 2; return st * 1024 + (ob ^ (((ob >> 9) & 1) << 5)); }
__device__ __forceinline__ void stage_rc(int b, int& R, int& C) { const int st = b / 1024, sb = b % 1024, swz = sb ^ (((sb >> 9) & 1) << 5); R = (st >> 1) * 16 + swz / 64; C = (st & 1) * 32 + (swz % 64) / 2; }
__device__ __forceinline__ int perm32(int rho) { const int n = rho >> 4, i = rho & 15; return 8 * (i >> 2) + 4 * n + (i & 3); }
template <class Epi, class Sched, bool ALIGN_EPI = false, bool SP2 = false, bool GATHER = false, bool MIDHOOK = false>
__device__ __forceinline__ void gemm_phase(PG8_LAS unsigned char* lds, const Gemm g, const Sched& S, const Epi& E, const int wave_in) {
    const int lane = lane_id_fresh(), wid = wave_in, tid = wid * 64 + lane,
              wr = wid >> 2, wc = wid & 3, fr = lane & 15, fq = lane >> 4;
    const int K = g.K, nt = K / BK;
    unsigned voffA[2], voffB[2];
#pragma unroll
    for (int i = 0; i < 2; ++i) { int R, C; stage_rc(tid * 16 + i * 8192, R, C); const int Rb = Epi::PERM ? ((R & ~31) + perm32(R & 31)) : R;
        voffA[i] = (unsigned)(R * K + C) * 2u; voffB[i] = (unsigned)(Rb * K + C) * 2u; }
    unsigned vAc[2][2] = {{0u, 0u}, {0u, 0u}}, vAn[2][2] = {{0u, 0u}, {0u, 0u}}; int gR[2] = {0, 0}; unsigned gC[2] = {0u, 0u};
    if constexpr (GATHER) {
#pragma unroll
        for (int i = 0; i < 2; ++i) { int R, C; stage_rc(tid * 16 + i * 8192, R, C); gR[i] = R; gC[i] = (unsigned)C * 2u; } }
#define PG8_GIDX(dst, pm_) do { _Pragma("unroll") for (int _h = 0; _h < 2; ++_h) _Pragma("unroll") for (int _i = 0; _i < 2; ++_i) \
        dst[_h][_i] = (unsigned)g.ridx[(pm_) * BM + _h * HALF + gR[_i]] * (unsigned)(K * 2) + gC[_i]; } while (0)
    const size_t kstep = (size_t)(BK * 2);
    const size_t hstep = (size_t)HALF * K * 2;
    const size_t tstep = 2 * hstep;
    const unsigned ldsw = (unsigned)wid * 1024u;
    const int aoff = lds_byte(wr * 64 + fr, fq * 8), boff = lds_byte(wc * 32 + fr, fq * 8);
#define PG8_SA(b, h) (((b) * 2 + (h)) * HTB)
#define PG8_SB(b, h) ((4 + (b) * 2 + (h)) * HTB)
#define PG8_STAGE(bufoff, gbase, voff) do { _Pragma("unroll") for (int _i = 0; _i < 2; ++_i) \
        __builtin_amdgcn_global_load_lds((const unsigned*)((const char*)(gbase) + (voff)[_i]), (PG8_LAS unsigned*)(lds + (bufoff) + ldsw + _i * 8192), 16, 0, 0); } while (0)
#define PG8_STAGE_A(bufoff, kptr, h, isnext) do { if constexpr (GATHER) { unsigned _v[2]; _v[0] = (isnext) ? vAn[h][0] : vAc[h][0]; _v[1] = (isnext) ? vAn[h][1] : vAc[h][1]; PG8_STAGE(bufoff, kptr, _v); } \
        else { PG8_STAGE(bufoff, (kptr) + (h) * hstep, voffA); } } while (0)
#define PG8_LDA(dst, b, h) do { _Pragma("unroll") for (int m = 0; m < 4; ++m) _Pragma("unroll") for (int k = 0; k < 2; ++k) dst[m][k] = *(const PG8_LAS bf16x8*)(lds + PG8_SA(b, h) + aoff + m * 2048 + k * 1024); } while (0)
#define PG8_LDB(dst, b, h) do { _Pragma("unroll") for (int n = 0; n < 2; ++n) _Pragma("unroll") for (int k = 0; k < 2; ++k) dst[n][k] = *(const PG8_LAS bf16x8*)(lds + PG8_SB(b, h) + boff + n * 2048 + k * 1024); } while (0)
#define PG8_MMA(ai, bj, At, Bt) do { __builtin_amdgcn_s_setprio(1); _Pragma("unroll") for (int m = 0; m < 4; ++m) _Pragma("unroll") for (int n = 0; n < 2; ++n) _Pragma("unroll") for (int k = 0; k < 2; ++k) \
        acc[ai][bj][m][n] = __builtin_amdgcn_mfma_f32_16x16x32_bf16(Bt[n][k], At[m][k], acc[ai][bj][m][n], 0, 0, 0); __builtin_amdgcn_s_setprio(0); } while (0)
#define PG8_WAIT_V(n) asm volatile("s_waitcnt vmcnt(" #n ")" ::: "memory")
#define PG8_WAIT_L(n) asm volatile("s_waitcnt lgkmcnt(" #n ")" ::: "memory")
#define PG8_BAR __builtin_amdgcn_s_barrier()
#define PG8_SCHED __builtin_amdgcn_sched_barrier(0)
    Unit cur, nxt; int ui = 0;
    if (!S.next(0, cur)) return;
    f32x4 acc[2][2][4][2];
#pragma unroll
    for (int a = 0; a < 2; ++a)
#pragma unroll
        for (int b = 0; b < 2; ++b)
#pragma unroll
            for (int m = 0; m < 4; ++m)
#pragma unroll
                for (int n = 0; n < 2; ++n) acc[a][b][m][n] = (f32x4){0.f, 0.f, 0.f, 0.f};
    bf16x8 At[4][2], B0[2][2], B1[2][2];
    const char* cA = (const char*)g.A + (GATHER ? (size_t)0 : (size_t)cur.pm * tstep); const char* cB = (const char*)g.Bt + (size_t)cur.pn * tstep;
    if constexpr (GATHER) PG8_GIDX(vAc, cur.pm);
    S.a_ready(cur);
    if constexpr (SP2) {
        PG8_STAGE(PG8_SB(0, 0), cB, voffB); PG8_STAGE(PG8_SB(0, 1), cB + hstep, voffB); PG8_STAGE_A(PG8_SA(0, 0), cA, 0, false); PG8_STAGE_A(PG8_SA(0, 1), cA, 1, false);
        if (wr == 1) PG8_BAR;
        PG8_WAIT_V(2); PG8_BAR;
        PG8_STAGE(PG8_SB(1, 0), cB + kstep, voffB); PG8_STAGE_A(PG8_SA(1, 0), cA + kstep, 0, false); PG8_STAGE(PG8_SB(1, 1), cB + hstep + kstep, voffB);
        PG8_WAIT_V(6); PG8_BAR;
    } else {
        PG8_STAGE(PG8_SB(0, 0), cB, voffB); PG8_STAGE(PG8_SA(0, 0), cA, voffA); PG8_STAGE(PG8_SB(0, 1), cB + hstep, voffB); PG8_STAGE(PG8_SA(0, 1), cA + hstep, voffA);
        if (wr == 1) PG8_BAR;
        PG8_WAIT_V(4); PG8_BAR;
        PG8_STAGE(PG8_SB(1, 0), cB + kstep, voffB); PG8_STAGE(PG8_SA(1, 0), cA + kstep, voffA); PG8_STAGE(PG8_SB(1, 1), cB + hstep + kstep, voffB);
        PG8_WAIT_V(6); PG8_BAR;
    }
    for (;;) {
        const bool has_next = S.next(ui + 1, nxt);
        const char* nA = (has_next && !GATHER) ? (const char*)g.A + (size_t)nxt.pm * tstep : cA; const char* nB = has_next ? (const char*)g.Bt + (size_t)nxt.pn * tstep : cB;
        if constexpr (GATHER) { if (has_next) PG8_GIDX(vAn, nxt.pm); else { _Pragma("unroll") for (int _h = 0; _h < 2; ++_h) { vAn[_h][0] = vAc[_h][0]; vAn[_h][1] = vAc[_h][1]; } } }
        for (int t = 0; t < nt; t += 2) {
            if constexpr (MIDHOOK) { if (t == nt / 2) { E.mid(acc, cur, wr, wc, fr, fq); PG8_WAIT_V(0); } }
            const bool last = (t == nt - 2);
            const char* a1 = cA + (size_t)(t + 1) * kstep;
            const char* a2 = last ? nA : cA + (size_t)(t + 2) * kstep; const char* b2 = last ? nB : cB + (size_t)(t + 2) * kstep;
            const char* a3 = a2 + kstep; const char* b3 = b2 + kstep;
            if (last && has_next) S.a_ready(nxt);
            if constexpr (SP2) {
            PG8_LDB(B0, 0, 0); PG8_LDB(B1, 0, 1); PG8_SCHED; PG8_LDA(At, 0, 0); PG8_STAGE_A(PG8_SA(1, 1), a1, 1, false);
            PG8_WAIT_V(8); PG8_WAIT_L(0); PG8_BAR; PG8_MMA(0, 0, At, B0); PG8_MMA(0, 1, At, B1); PG8_BAR; PG8_SCHED;
            PG8_LDA(At, 0, 1); PG8_STAGE(PG8_SB(0, 0), b2, voffB); PG8_STAGE(PG8_SB(0, 1), b2 + hstep, voffB); PG8_STAGE_A(PG8_SA(0, 0), a2, 0, last);
            PG8_WAIT_V(8); PG8_WAIT_L(0); PG8_BAR; PG8_MMA(1, 0, At, B0); PG8_MMA(1, 1, At, B1); PG8_BAR; PG8_SCHED;
            PG8_LDB(B0, 1, 0); PG8_LDB(B1, 1, 1); PG8_SCHED; PG8_LDA(At, 1, 0); PG8_STAGE_A(PG8_SA(0, 1), a2, 1, last);
            PG8_WAIT_V(8); PG8_WAIT_L(0); PG8_BAR; PG8_MMA(0, 0, At, B0); PG8_MMA(0, 1, At, B1); PG8_BAR; PG8_SCHED;
            PG8_LDA(At, 1, 1); PG8_STAGE(PG8_SB(1, 0), b3, voffB); PG8_STAGE(PG8_SB(1, 1), b3 + hstep, voffB); PG8_STAGE_A(PG8_SA(1, 0), a3, 0, last);
            PG8_WAIT_V(8); PG8_WAIT_L(0); PG8_BAR; PG8_MMA(1, 0, At, B0); PG8_MMA(1, 1, At, B1); PG8_BAR; PG8_SCHED;
            } else {
            PG8_LDB(B0, 0, 0); PG8_SCHED; PG8_LDA(At, 0, 0); PG8_STAGE(PG8_SA(1, 1), a1 + hstep, voffA);
            PG8_WAIT_L(8); PG8_BAR; PG8_WAIT_L(0); PG8_MMA(0, 0, At, B0); PG8_BAR; PG8_SCHED;
            PG8_LDB(B1, 0, 1); PG8_STAGE(PG8_SB(0, 0), b2, voffB);
            PG8_BAR; PG8_WAIT_L(0); PG8_MMA(0, 1, At, B1); PG8_BAR;
            PG8_LDA(At, 0, 1); PG8_STAGE(PG8_SA(0, 0), a2, voffA);
            PG8_BAR; PG8_WAIT_L(0); PG8_MMA(1, 0, At, B0); PG8_BAR; PG8_SCHED;
            PG8_STAGE(PG8_SB(0, 1), b2 + hstep, voffB);
            PG8_WAIT_V(6); PG8_BAR; PG8_MMA(1, 1, At, B1); PG8_BAR;
            PG8_LDB(B0, 1, 0); PG8_SCHED; PG8_LDA(At, 1, 0); PG8_STAGE(PG8_SA(0, 1), a2 + hstep, voffA);
            PG8_WAIT_L(8); PG8_BAR; PG8_WAIT_L(0); PG8_MMA(0, 0, At, B0); PG8_BAR; PG8_SCHED;
            PG8_LDB(B1, 1, 1); PG8_STAGE(PG8_SB(1, 0), b3, voffB);
            PG8_BAR; PG8_WAIT_L(0); PG8_MMA(0, 1, At, B1); PG8_BAR;
            PG8_LDA(At, 1, 1); PG8_STAGE(PG8_SA(1, 0), a3, voffA);
            PG8_BAR; PG8_WAIT_L(0); PG8_MMA(1, 0, At, B0); PG8_BAR; PG8_SCHED;
            PG8_STAGE(PG8_SB(1, 1), b3 + hstep, voffB);
            PG8_WAIT_V(6); PG8_BAR; PG8_MMA(1, 1, At, B1); PG8_BAR;
            }
        }
        if constexpr (ALIGN_EPI) { if (wr == 0) PG8_BAR; }
        if constexpr (!Epi::AFTER_DRAIN) { E(acc, cur, wr, wc, fr, fq); S.done(cur); }
        if (!has_next) break;
#pragma unroll
        for (int a = 0; a < 2; ++a)
#pragma unroll
            for (int b = 0; b < 2; ++b)
#pragma unroll
                for (int m = 0; m < 4; ++m)
#pragma unroll
                    for (int n = 0; n < 2; ++n) acc[a][b][m][n] = (f32x4){0.f, 0.f, 0.f, 0.f};
        cur = nxt; cA = nA; cB = nB; ++ui;
        if constexpr (GATHER) { _Pragma("unroll") for (int _h = 0; _h < 2; ++_h) { vAc[_h][0] = vAn[_h][0]; vAc[_h][1] = vAn[_h][1]; } }
        if constexpr (ALIGN_EPI) { if (wr == 1) PG8_BAR; }
    }
    PG8_WAIT_V(0);
    if constexpr (!ALIGN_EPI) { if (wr == 0) PG8_BAR; }
    PG8_BAR;
    if constexpr (Epi::AFTER_DRAIN) { E.fused(acc, cur, wr, wc, fr, fq, lds, wid, lane); S.done(cur); }
#undef PG8_SA
#undef PG8_SB
#undef PG8_STAGE
#undef PG8_STAGE_A
#undef PG8_GIDX
#undef PG8_LDA
#undef PG8_LDB
#undef PG8_MMA
#undef PG8_WAIT_V
#undef PG8_WAIT_L
#undef PG8_BAR
#undef PG8_SCHED
}

template <class F> struct EpiAdapt {
    static constexpr bool PERM = true, AFTER_DRAIN = false; F f;
    __device__ __forceinline__ void mid(f32x4 (&acc)[2][2][4][2], const Unit& u, int wr, int wc, int fr, int fq) const {
        asm volatile("" : "+v"(fr), "+v"(fq));
#pragma unroll
        for (int ai = 0; ai < 2; ++ai)
#pragma unroll
            for (int m = 0; m < 4; ++m) { const int row = ai * HALF + wr * 64 + m * 16 + fr;
#pragma unroll
                for (int bj = 0; bj < 2; ++bj) { float v[8] = {acc[ai][bj][m][0][0], acc[ai][bj][m][0][1], acc[ai][bj][m][0][2], acc[ai][bj][m][0][3], acc[ai][bj][m][1][0], acc[ai][bj][m][1][1], acc[ai][bj][m][1][2], acc[ai][bj][m][1][3]};
                    f.mid8(u, row, bj * HALF + wc * 32 + 8 * fq, v);
                    acc[ai][bj][m][0] = (f32x4){v[0], v[1], v[2], v[3]}; acc[ai][bj][m][1] = (f32x4){v[4], v[5], v[6], v[7]}; } }
    }
    __device__ __forceinline__ void operator()(const f32x4 (&acc)[2][2][4][2], const Unit& u, int wr, int wc, int fr, int fq) const {
        asm volatile("" : "+v"(fr), "+v"(fq));
#pragma unroll
        for (int ai = 0; ai < 2; ++ai)
#pragma unroll
            for (int m = 0; m < 4; ++m) { const int row = ai * HALF + wr * 64 + m * 16 + fr;
#pragma unroll
                for (int bj = 0; bj < 2; ++bj) { const f32x4 v0 = acc[ai][bj][m][0], v1 = acc[ai][bj][m][1];
                    const float v[8] = {v0[0], v0[1], v0[2], v0[3], v1[0], v1[1], v1[2], v1[3]};
                    f.store8(u, row, bj * HALF + wc * 32 + 8 * fq, v); } }
    }
};
}

template <class Epi, class Sched>
__device__ __forceinline__ void gemm_phase_mid(LAS unsigned char* lds, const Gemm g, const Sched& S, const Epi& E, const int wave_in) {
    pg8::EpiAdapt<Epi> EA{E};
    pg8::gemm_phase<pg8::EpiAdapt<Epi>, Sched, true, true, false, true>(lds, g, S, EA, wave_in);
}
template <class Epi, class Sched>
__device__ __forceinline__ void gemm_phase_gather(LAS unsigned char* lds, const Gemm g, const Sched& S, const Epi& E, const int wave_in) {
    pg8::EpiAdapt<Epi> EA{E};
    pg8::gemm_phase<pg8::EpiAdapt<Epi>, Sched, true, true, true>(lds, g, S, EA, wave_in);
}
template <class Epi, class Sched>
__device__ __forceinline__ void gemm_phase_any(LAS unsigned char* lds, const Gemm g, const Sched& S, const Epi& E, const int wave_in) {
#if ENG_GEMM == 1
    pg8::EpiAdapt<Epi> EA{E};
    pg8::gemm_phase<pg8::EpiAdapt<Epi>, Sched, true, true>(lds, g, S, EA, wave_in);
#else
    gemm_phase_naive<Epi, Sched>(lds, g, S, E);
#endif
}

template <class RowMap>
__device__ __forceinline__ void transpose_item(const float* W, int ldw, bf16* WT, int ldt, int koff, int k0, int n0, const RowMap& rm, LAS float* scr, int lane) {
#pragma unroll 8
    for (int i = 0; i < 32; ++i) { const int kk = 2 * i + (lane >> 5); scr[kk * 33 + (lane & 31)] = W[(size_t)(k0 + kk) * ldw + n0 + (lane & 31)]; }
    asm volatile("s_waitcnt lgkmcnt(0)" ::: "memory");
    const int c = lane & 7;
#pragma unroll
    for (int j = 0; j < 4; ++j) { const int n = (lane >> 3) + 8 * j; const LAS float* s = scr + (8 * c) * 33 + n;
        u32x4 o; o.x = pk2(s[0 * 33], s[1 * 33]); o.y = pk2(s[2 * 33], s[3 * 33]); o.z = pk2(s[4 * 33], s[5 * 33]); o.w = pk2(s[6 * 33], s[7 * 33]);
        *(u32x4*)(WT + (size_t)rm(n0 + n) * ldt + koff + k0 + 8 * c) = o; }
    asm volatile("s_waitcnt lgkmcnt(0)" ::: "memory");
}
struct RmId { int off; __device__ int operator()(int n) const { return off + n; } };
struct RmWin { __device__ int operator()(int n) const { return n < 1792 ? n : (n < 2208 ? 3840 + (n - 1792) : 1792 + (n - 2208)); } };
struct RmUkv { __device__ int operator()(int n) const { const int h = n >> 7, j = n & 127; return j < 64 ? h * 64 + j : 512 + h * 64 + (j - 64); } };
struct RmGU { int off; __device__ int operator()(int j) const { return off + 8 * (j >> 2) + (j & 3); } };

__device__ __forceinline__ void p0_prologue(const Frame& F, ArgsP a) {
    const int lane_f = lane_id_fresh(), tid_f = F.wave * 64 + lane_f;
    LAS float* scr = (LAS float*)(F.lds + F.wave * 16384);
    const int lane = lane_f;
    bf16* Win = (bf16*)(F.ws + WS_WIN); bf16* Wblk = (bf16*)(F.ws + WS_WBLK); bf16* Wg = (bf16*)(F.ws + WS_WG); bf16* Wuq = (bf16*)(F.ws + WS_WUQ);
    bf16* Wukv = (bf16*)(F.ws + WS_WUKV); bf16* Wb = (bf16*)(F.ws + WS_WB); bf16* Wo = (bf16*)(F.ws + WS_WO); bf16* Wgu = (bf16*)(F.ws + WS_WGU); bf16* Wdn = (bf16*)(F.ws + WS_WDN);
    constexpr int I_IN = 16 * 133, I_DEC = 1 * 16, I_AUP = 16, I_GUP = 2 * 16, I_UQ = 4 * 24, I_UKV = 2 * 32, I_BR = 2 * 8 * 32, I_O = 16 * 32;
    constexpr int I_EG = 32 * 16 * 8, I_EU = I_EG, I_ED = 32 * 4 * 32;
    constexpr int NITEMS = I_IN + I_DEC + I_AUP + I_GUP + I_UQ + I_UKV + I_BR + I_O + I_EG + I_EU + I_ED;
    for (int it = F.gw; it < NITEMS; it += F.NGW) {
        int r = it;
        if (r < I_IN) { const int kb = r / 133, nb = r % 133; transpose_item(a->in[I_WIN], D_IN, Win, 1024, 0, 64 * kb, 32 * nb, RmWin{}, scr, lane); continue; } r -= I_IN;
        if (r < I_DEC) { transpose_item(a->in[I_WDEC], 512, Wblk, 128, 0, 0, 32 * r, RmId{0}, scr, lane); continue; } r -= I_DEC;
        if (r < I_AUP) { transpose_item(a->in[I_WAUP], 512, Wblk, 128, 64, 0, 32 * r, RmId{512}, scr, lane); continue; } r -= I_AUP;
        if (r < I_GUP) { const int kb = r / 16, nb = r % 16; transpose_item(a->in[I_WGUP], 512, Wg, 128, 0, 64 * kb, 32 * nb, RmId{0}, scr, lane); continue; } r -= I_GUP;
        if (r < I_UQ) { const int kb = r / 24, nb = r % 24; transpose_item(a->in[I_WUQ], 768, Wuq, 256, 0, 64 * kb, 32 * nb, RmId{0}, scr, lane); continue; } r -= I_UQ;
        if (r < I_UKV) { const int kb = r / 32, nb = r % 32; transpose_item(a->in[I_WUKV], 1024, Wukv, 128, 0, 64 * kb, 32 * nb, RmUkv{}, scr, lane); continue; } r -= I_UKV;
        if (r < I_BR) { const int br = r / 256, q = r % 256, kb = q / 32, nb = q % 32; transpose_item(a->in[I_WBR] + (size_t)br * 512 * 1024, 1024, Wb, 1024, 512 * br, 64 * kb, 32 * nb, RmId{0}, scr, lane); continue; } r -= I_BR;
        if (r < I_O) { const int kb = r / 32, nb = r % 32; transpose_item(a->in[I_WOUT], 1024, Wo, 1024, 0, 64 * kb, 32 * nb, RmId{0}, scr, lane); continue; } r -= I_O;
        if (r < I_EG) { const int e = r / 128, q = r % 128, kb = q / 8, nb = q % 8; transpose_item(a->in[I_WEG] + (size_t)e * 1024 * 256, 256, Wgu + (size_t)e * 512 * 1024, 1024, 0, 64 * kb, 32 * nb, RmGU{0}, scr, lane); continue; } r -= I_EG;
        if (r < I_EU) { const int e = r / 128, q = r % 128, kb = q / 8, nb = q % 8; transpose_item(a->in[I_WEU] + (size_t)e * 1024 * 256, 256, Wgu + (size_t)e * 512 * 1024, 1024, 0, 64 * kb, 32 * nb, RmGU{4}, scr, lane); continue; } r -= I_EU;
        { const int e = r / 128, q = r % 128, kb = q / 32, nb = q % 32; transpose_item(a->in[I_WED] + (size_t)e * 256 * 1024, 1024, Wdn + (size_t)e * 1024 * 256, 256, 0, 64 * kb, 32 * nb, RmId{0}, scr, lane); }
    }
    for (int i = F.gw * 64 + lane; i < 96 * 128; i += F.NGW * 64) *(u32x4*)(Win + (size_t)4256 * 1024 + (size_t)i * 8) = (u32x4){0u, 0u, 0u, 0u};
    for (int i = F.gw * 64 + lane; i < 1024 * 8; i += F.NGW * 64) { const int row = i >> 3, c8 = (i & 7) * 8; *(u32x4*)(Wblk + row * 128 + (row < 512 ? 64 : 0) + c8) = (u32x4){0u, 0u, 0u, 0u}; }
    { const int* pos = (const int*)a->in[I_POS]; float* cs = (float*)(F.ws + WS_CS);
      for (int i = F.gw * 64 + lane; i < NTOK * 16; i += F.NGW * 64) { const int t = i >> 4, j = i & 15;
          const float fr = exp2f(-(float)j * (13.287712379549449f / 16.0f));
          const float ang = (float)pos[t] * fr; cs[t * 32 + j] = cosf(ang); cs[t * 32 + 16 + j] = sinf(ang); } }
    { float* mod = (float*)(F.ws + WS_MOD); const float* c = a->in[I_C]; const float* wa = a->in[I_WADA]; const float* ba = a->in[I_BADA];
      LAS float* red = (LAS float*)(F.lds + 8 * 16384);
      LAS float* sc = (LAS float*)F.lds;
      if (F.vcu < 96) {
          __syncthreads();
          for (int i = tid_f; i < 8192; i += NTHR) sc[i] = siluf_(c[i]);
          __syncthreads();
      }
      for (int nb = F.vcu; nb < 96; nb += F.G) {
          float acc[8];
#pragma unroll
          for (int b = 0; b < 8; ++b) acc[b] = 0.f;
          const int n = nb * 64 + lane;
          for (int k0 = F.wave * 128; k0 < F.wave * 128 + 128; k0 += 16) { float w[16];
#pragma unroll
              for (int kk = 0; kk < 16; ++kk) w[kk] = wa[(size_t)(k0 + kk) * 6144 + n];
#pragma unroll
              for (int kk = 0; kk < 16; ++kk)
#pragma unroll
                  for (int b = 0; b < 8; ++b) acc[b] = fmaf(sc[b * 1024 + k0 + kk], w[kk], acc[b]); }
#pragma unroll
          for (int b = 0; b < 8; ++b) red[(F.wave * 8 + b) * 64 + lane] = acc[b];
          __syncthreads();
          { const int b = F.wave; float s = ba[n];
#pragma unroll
            for (int w = 0; w < 8; ++w) s += red[(w * 8 + b) * 64 + lane];
            mod[b * 6144 + n] = s; }
          __syncthreads();
      } }
}

__device__ __forceinline__ void p_normmod(const Frame& F, const float* x, const float* g, const float* mod, int sh_off, int sc_off, bf16* H) {
    const int lane_f = lane_id_fresh();
    f32x4 xa[4], xb[4];
    { const f32x4* xr = (const f32x4*)(x + (size_t)F.gw * 1024) + lane_f;
#pragma unroll
      for (int j = 0; j < 4; ++j) xa[j] = xr[64 * j]; }
    f32x4 gs[4], sh[4]; int bcur = -1;
#define NM_ROW(CUR, NXT, m_) do { const int mm = (m_); const int b = mm / SEQ; \
        if (b != bcur) { bcur = b; \
            _Pragma("unroll") for (int j = 0; j < 4; ++j) { const int col = 4 * lane_f + 256 * j; gs[j] = *(const f32x4*)(g + col) * (*(const f32x4*)(mod + b * 6144 + sc_off + col) + 1.0f); sh[j] = *(const f32x4*)(mod + b * 6144 + sh_off + col); } \
            asm volatile("s_waitcnt vmcnt(0)" : "+v"(gs[0]), "+v"(gs[1]), "+v"(gs[2]), "+v"(gs[3]), "+v"(sh[0]), "+v"(sh[1]), "+v"(sh[2]), "+v"(sh[3]), "+v"(CUR[0]), "+v"(CUR[1]), "+v"(CUR[2]), "+v"(CUR[3])); } \
        { const int mn = (mm + F.NGW < NTOK) ? mm + F.NGW : mm; const f32x4* xr = (const f32x4*)(x + (size_t)mn * 1024) + lane_f; \
          _Pragma("unroll") for (int j = 0; j < 4; ++j) NXT[j] = xr[64 * j]; } \
        float s = 0.f; \
        _Pragma("unroll") for (int j = 0; j < 4; ++j) s += (CUR[j].x * CUR[j].x + CUR[j].y * CUR[j].y) + (CUR[j].z * CUR[j].z + CUR[j].w * CUR[j].w); \
        const float rstd = 1.0f / sqrtf(wave_sum(s) * (1.f / 1024.f) + EPS); \
        u32x2* o = (u32x2*)(H + (size_t)mm * 1024) + lane_f; \
        _Pragma("unroll") for (int j = 0; j < 4; ++j) { const f32x4 y = CUR[j] * rstd * gs[j] + sh[j]; u32x2 w; w.x = pk2(y.x, y.y); w.y = pk2(y.z, y.w); o[64 * j] = w; } } while (0)
    for (int m = F.gw; m < NTOK; m += 2 * F.NGW) {
        NM_ROW(xa, xb, m);
        if (m + F.NGW < NTOK) NM_ROW(xb, xa, m + F.NGW);
    }
#undef NM_ROW
}

__device__ __forceinline__ void p_prep_a(const Frame& F, ArgsP a) {
    const int lane_f = lane_id_fresh();
    const bf16* ZR = (const bf16*)(F.ws + WS_ZR); const bf16* ZM = (const bf16*)(F.ws + WS_ZM);
    bf16* TWA = (bf16*)(F.ws + WS_TWA); bf16* SGL = (bf16*)(F.ws + WS_SGL); bf16* QA = (bf16*)(F.ws + WS_QA); bf16* KVA = (bf16*)(F.ws + WS_KVA);
    const float* mu = a->in[I_MU]; const float* gqa = a->in[I_GQA]; const float* gkva = a->in[I_GKVA];
    const int lane = lane_f;
    const f32x4 mm = *(const f32x4*)(mu + 1536 + 4 * lane), gq = *(const f32x4*)(gqa + 4 * lane), gk = *(const f32x4*)(gkva + 4 * (lane & 31));
    for (int m = F.gw; m < NTOK; m += F.NGW) {
        const bool first = (m % SEQ) == 0;
        { const u32x2 c = *((const u32x2*)(ZR + (size_t)m * 1792 + 1536) + lane); u32x2 p = *((const u32x2*)(ZR + (size_t)(first ? m : m - 1) * 1792 + 1536) + lane); if (first) { p.x = 0u; p.y = 0u; }
          float z[4] = {lo2f(c.x), hi2f(c.x), lo2f(c.y), hi2f(c.y)}; const float q[4] = {lo2f(p.x), hi2f(p.x), lo2f(p.y), hi2f(p.y)};
          z[0] += (q[0] - z[0]) * mm.x; z[1] += (q[1] - z[1]) * mm.y; z[2] += (q[2] - z[2]) * mm.z; z[3] += (q[3] - z[3]) * mm.w;
          if (lane < 16) { u32x2 w; w.x = pk2(tanhf(z[0]), tanhf(z[1])); w.y = pk2(tanhf(z[2]), tanhf(z[3])); *((u32x2*)(TWA + (size_t)m * 128) + lane) = w; }
          else if (lane < 32) { u32x2 w; w.x = pk2(z[0], z[1]); w.y = pk2(z[2], z[3]); *((u32x2*)(TWA + (size_t)m * 128) + lane) = w; }
          else { u32x2 w; w.x = pk2(sigmoidf_(z[0]), sigmoidf_(z[1])); w.y = pk2(sigmoidf_(z[2]), sigmoidf_(z[3])); *((u32x2*)(SGL + (size_t)m * 128) + (lane - 32)) = w; } }
        { const u32x2 c = *((const u32x2*)(ZM + (size_t)m * 512) + lane); const float z[4] = {lo2f(c.x), hi2f(c.x), lo2f(c.y), hi2f(c.y)};
          u32x2 c2 = (u32x2){0u, 0u}; if (lane < 32) c2 = *((const u32x2*)(ZM + (size_t)m * 512 + 256) + lane); const float y[4] = {lo2f(c2.x), hi2f(c2.x), lo2f(c2.y), hi2f(c2.y)};
          const float rstd = 1.0f / sqrtf(wave_sum((z[0] * z[0] + z[1] * z[1]) + (z[2] * z[2] + z[3] * z[3])) * (1.f / 256.f) + EPS);
          const float rstd2 = 1.0f / sqrtf(wave_sum((y[0] * y[0] + y[1] * y[1]) + (y[2] * y[2] + y[3] * y[3])) * (1.f / 128.f) + EPS);
          u32x2 w; w.x = pk2(z[0] * rstd * gq.x, z[1] * rstd * gq.y); w.y = pk2(z[2] * rstd * gq.z, z[3] * rstd * gq.w);
          *((u32x2*)(QA + (size_t)m * 256) + lane) = w;
          if (lane < 32) { u32x2 w2; w2.x = pk2(y[0] * rstd2 * gk.x, y[1] * rstd2 * gk.y); w2.y = pk2(y[2] * rstd2 * gk.z, y[3] * rstd2 * gk.w);
              *((u32x2*)(KVA + (size_t)m * 128) + lane) = w2; } }
    }
}

__device__ __forceinline__ void p_prep_c(const Frame& F, ArgsP a) {
    const int lane_f = lane_id_fresh(), tid_f = F.wave * 64 + lane_f;
    const bf16* KN = (const bf16*)(F.dob + DO_KN); const bf16* ZM = (const bf16*)(F.ws + WS_ZM); bf16* KC = (bf16*)(F.ws + WS_KC);
    const float* cs = (const float*)(F.ws + WS_CS);
    const float* kn = a->in[I_KN];
    const int lane = lane_f, hd = lane >> 3, j = lane & 7;
    for (int m = F.gw; m < NTOK; m += F.NGW) {
        const f32x2 cc = *(const f32x2*)(cs + (size_t)m * 32 + 2 * j), sn = *(const f32x2*)(cs + (size_t)m * 32 + 16 + 2 * j);
        { float v[8]; unpack8(*(const u32x4*)(KN + (size_t)m * 512 + hd * 64 + 8 * j), v);
          const unsigned w1 = *(const unsigned*)(ZM + (size_t)m * 512 + 384 + 2 * j), w2 = *(const unsigned*)(ZM + (size_t)m * 512 + 400 + 2 * j); float x1[2] = {lo2f(w1), hi2f(w1)}, x2[2] = {lo2f(w2), hi2f(w2)};
          float ss = (x1[0] * x1[0] + x1[1] * x1[1]) + (x2[0] * x2[0] + x2[1] * x2[1]);
#pragma unroll
          for (int i = 0; i < 8; ++i) ss += v[i] * v[i];
          const float rstd = 1.0f / sqrtf(sum8(ss) * (1.f / 96.f) + EPS);
#pragma unroll
          for (int i = 0; i < 8; ++i) v[i] = v[i] * rstd * kn[8 * j + i];
          x1[0] *= rstd * kn[64 + 2 * j]; x1[1] *= rstd * kn[65 + 2 * j]; x2[0] *= rstd * kn[80 + 2 * j]; x2[1] *= rstd * kn[81 + 2 * j];
          bf16* kp = KC + (size_t)m * 768 + hd * 96;
          *(u32x4*)(kp + 8 * j) = pack8(v); *(unsigned*)(kp + 64 + 2 * j) = pk2(x1[0] * cc.x - x2[0] * sn.x, x1[1] * cc.y - x2[1] * sn.y);
          *(unsigned*)(kp + 80 + 2 * j) = pk2(x2[0] * cc.x + x1[0] * sn.x, x2[1] * cc.y + x1[1] * sn.y); }
    }
}

__device__ __forceinline__ void p_attn_naive(const Frame& F) {
    const int lane_f = lane_id_fresh(), tid_f = F.wave * 64 + lane_f;
    const bf16* Q = (const bf16*)(F.dob + DO_Q); const bf16* KC = (const bf16*)(F.ws + WS_KC); const bf16* VC = (const bf16*)(F.ws + WS_VC); bf16* YM = (bf16*)(F.ws + WS_YM);
    LAS float* Ks = (LAS float*)F.lds; LAS float* Vs = (LAS float*)(F.lds + 32 * 96 * 4);
    const int tid = tid_f;
    for (int unit = F.vcu; unit < 64 * 16; unit += F.G) {
        const int bh = unit >> 4, qb = 15 - (unit & 15), b = bh >> 3, h = bh & 7; const size_t row0 = (size_t)b * SEQ; const int t = qb * 512 + tid;
        unsigned qp[48];
        { const u32x4* qg = (const u32x4*)(Q + (row0 + t) * 768 + h * 96);
#pragma unroll
          for (int i = 0; i < 12; ++i) { const u32x4 w = qg[i]; qp[4 * i] = w.x; qp[4 * i + 1] = w.y; qp[4 * i + 2] = w.z; qp[4 * i + 3] = w.w; } }
        float o[64];
#pragma unroll
        for (int i = 0; i < 64; ++i) o[i] = 0.f;
        float mx = -INFINITY, l = 0.f;
        const int nkt = (qb + 1) * 16;
        for (int kt = 0; kt < nkt; ++kt) {
            __syncthreads();
            if (tid < 384) { const int r = tid / 12, c8 = (tid % 12) * 8; float v[8]; unpack8(*(const u32x4*)(KC + (row0 + kt * 32 + r) * 768 + h * 96 + c8), v);
#pragma unroll
                for (int i = 0; i < 8; ++i) Ks[r * 96 + c8 + i] = v[i]; }
            if (tid < 256) { const int r = tid >> 3, c8 = (tid & 7) * 8; float v[8]; unpack8(*(const u32x4*)(VC + (row0 + kt * 32 + r) * 512 + h * 64 + c8), v);
#pragma unroll
                for (int i = 0; i < 8; ++i) Vs[r * 64 + c8 + i] = v[i]; }
            __syncthreads();
            for (int kk = 0; kk < 32; ++kk) {
                const int kv = kt * 32 + kk;
                float s = 0.f; const LAS f32x4* kr = (const LAS f32x4*)(Ks + kk * 96);
#pragma unroll
                for (int i = 0; i < 24; ++i) { const f32x4 k4 = kr[i]; s += lo2f(qp[2 * i]) * k4.x + hi2f(qp[2 * i]) * k4.y + lo2f(qp[2 * i + 1]) * k4.z + hi2f(qp[2 * i + 1]) * k4.w; }
                if (kv <= t) {
                    const float mn = fmaxf(mx, s), f = exp2f(mx - mn), p = exp2f(s - mn); mx = mn; l = l * f + p;
                    const LAS f32x4* vr = (const LAS f32x4*)(Vs + kk * 64);
#pragma unroll
                    for (int i = 0; i < 16; ++i) { const f32x4 v4 = vr[i]; o[4 * i] = o[4 * i] * f + p * v4.x; o[4 * i + 1] = o[4 * i + 1] * f + p * v4.y; o[4 * i + 2] = o[4 * i + 2] * f + p * v4.z; o[4 * i + 3] = o[4 * i + 3] * f + p * v4.w; }
                }
            }
        }
        const float il = 1.f / l; u32x4* og = (u32x4*)(YM + (row0 + t) * 512 + h * 64);
#pragma unroll
        for (int i = 0; i < 8; ++i) { u32x4 w; w.x = pk2(o[8 * i] * il, o[8 * i + 1] * il); w.y = pk2(o[8 * i + 2] * il, o[8 * i + 3] * il); w.z = pk2(o[8 * i + 4] * il, o[8 * i + 5] * il); w.w = pk2(o[8 * i + 6] * il, o[8 * i + 7] * il); og[i] = w; }
    }
    __syncthreads();
}

typedef float f32x16 __attribute__((ext_vector_type(16)));
typedef short s16x4 __attribute__((ext_vector_type(4)));
__device__ __forceinline__ int crow(int r, int hi) { return (r & 3) + 8 * (r >> 2) + 4 * hi; }
__device__ __forceinline__ float max3f(float a, float b, float c) { float r; asm("v_max3_f32 %0, %1, %2, %3" : "=v"(r) : "v"(a), "v"(b), "v"(c)); return r; }
__device__ __forceinline__ float max2f(float a, float b) { float r; asm("v_max_f32_e32 %0, %1, %2" : "=v"(r) : "v"(a), "v"(b)); return r; }
__device__ __forceinline__ float xhalf_max(float x) { auto rr = __builtin_amdgcn_permlane32_swap(__float_as_uint(x), __float_as_uint(x), false, false); return max2f(__uint_as_float(rr[0]), __uint_as_float(rr[1])); }
__device__ __forceinline__ float xhalf_sum(float x) { auto rr = __builtin_amdgcn_permlane32_swap(__float_as_uint(x), __float_as_uint(x), false, false); return __uint_as_float(rr[0]) + __uint_as_float(rr[1]); }
__device__ __forceinline__ bf16x8 packp(const f32x16& p, int s2) {
    u32x4 w; w.x = pk2(p[8 * s2 + 0], p[8 * s2 + 1]); w.y = pk2(p[8 * s2 + 2], p[8 * s2 + 3]); w.z = pk2(p[8 * s2 + 4], p[8 * s2 + 5]); w.w = pk2(p[8 * s2 + 6], p[8 * s2 + 7]);
    return __builtin_bit_cast(bf16x8, w);
}
__device__ __forceinline__ void p_attn_mfma(const Frame& F, const float* qn) {
    const int lane_f = lane_id_fresh(), tid_f = F.wave * 64 + lane_f;
    const bf16* Q = (const bf16*)(F.dob + DO_Q); const bf16* KC = (const bf16*)(F.ws + WS_KC); const bf16* VC = (const bf16*)(F.ws + WS_VC); bf16* YM = (bf16*)(F.ws + WS_YM);
    const float* cs = (const float*)(F.ws + WS_CS);
    constexpr int KST = 208, VST = 192, KBYTES = 64 * KST, SUB = KBYTES + 64 * VST, BUF = 2 * SUB;
    const int tid = tid_f, lane = lane_f, wave = F.wave, r = lane & 31, hi = lane >> 5;
    int kg[3], kl[3], vg[2], vl[2];
#pragma unroll
    for (int i = 0; i < 3; ++i) { const int c = tid + 512 * i, row = c / 12, pc = c % 12; kg[i] = row * 768 + pc * 8; kl[i] = (row >> 6) * SUB + (row & 63) * KST + pc * 16; }
#pragma unroll
    for (int i = 0; i < 2; ++i) { const int c = tid + 512 * i, row = c >> 3, pc = c & 7; vg[i] = row * 512 + pc * 8; vl[i] = (row >> 6) * SUB + KBYTES + (row & 63) * VST + pc * 16; }
    const int g4 = lane >> 4, li = lane & 15;
    const int vtr = (4 * (g4 >> 1) + (li >> 2)) * VST + (16 * (g4 & 1) + 4 * (li & 3)) * 2;
    const int kfr = r * KST + hi * 16;
    LAS unsigned char* lds = F.lds;
    for (int item = F.vcu; item < 1024; item += F.G) {
        const int bh = item >> 4, sidx = item & 15, b = bh >> 3, h = bh & 7; const size_t row0 = (size_t)b * SEQ;
        const bf16* Kg = KC + row0 * 768 + h * 96; const bf16* Vg = VC + row0 * 512 + h * 64;
        for (int uu = 0; uu < 2; ++uu) {
            const int qb = uu == 0 ? 31 - sidx : sidx, q0 = qb * 256, NT = (q0 + 256) / 128;
            const int qw = q0 + wave * 32;
            bf16x8 qf[6];
            {
              const bf16* qp = Q + (row0 + qw + r) * 768 + h * 96 + hi * 8; const float* csr = cs + (row0 + qw + r) * 32 + 8 * hi;
              u32x4 raw[6];
#pragma unroll
              for (int s = 0; s < 6; ++s) raw[s] = *(const u32x4*)(qp + 16 * s);
              const f32x4 c0 = *(const f32x4*)csr, c1 = *(const f32x4*)(csr + 4), s0 = *(const f32x4*)(csr + 16), s1 = *(const f32x4*)(csr + 20);
              float ss = 0.f;
#pragma unroll
              for (int s = 0; s < 6; ++s) { float t[8]; unpack8(raw[s], t);
#pragma unroll
                  for (int e = 0; e < 8; ++e) ss += t[e] * t[e]; }
              const float rstd = QSCALE / sqrtf(xhalf_sum(ss) * (1.f / 96.f) + EPS);
#pragma unroll
              for (int s = 0; s < 4; ++s) { float t[8]; unpack8(raw[s], t); const f32x4 g0 = *(const f32x4*)(qn + 16 * s + 8 * hi), g1 = *(const f32x4*)(qn + 16 * s + 8 * hi + 4);
                  t[0] *= rstd * g0.x; t[1] *= rstd * g0.y; t[2] *= rstd * g0.z; t[3] *= rstd * g0.w; t[4] *= rstd * g1.x; t[5] *= rstd * g1.y; t[6] *= rstd * g1.z; t[7] *= rstd * g1.w;
                  qf[s] = __builtin_bit_cast(bf16x8, pack8(t)); }
              { float a4[8], a5[8]; unpack8(raw[4], a4); unpack8(raw[5], a5);
                const f32x4 g0 = *(const f32x4*)(qn + 64 + 8 * hi), g1 = *(const f32x4*)(qn + 64 + 8 * hi + 4), h0 = *(const f32x4*)(qn + 80 + 8 * hi), h1 = *(const f32x4*)(qn + 80 + 8 * hi + 4);
                const float ga[8] = {g0.x, g0.y, g0.z, g0.w, g1.x, g1.y, g1.z, g1.w}, gb[8] = {h0.x, h0.y, h0.z, h0.w, h1.x, h1.y, h1.z, h1.w};
                const float cc[8] = {c0.x, c0.y, c0.z, c0.w, c1.x, c1.y, c1.z, c1.w}, sn[8] = {s0.x, s0.y, s0.z, s0.w, s1.x, s1.y, s1.z, s1.w};
#pragma unroll
                for (int e = 0; e < 8; ++e) { const float x1 = a4[e] * rstd * ga[e], x2 = a5[e] * rstd * gb[e]; a4[e] = x1 * cc[e] - x2 * sn[e]; a5[e] = x2 * cc[e] + x1 * sn[e]; }
                qf[4] = __builtin_bit_cast(bf16x8, pack8(a4)); qf[5] = __builtin_bit_cast(bf16x8, pack8(a5)); } }
            f32x16 o0 = {}, o1 = {}, negm = {}; float m = 0.f, l = 0.f;
            u32x4 ak[3], av[2];
#pragma unroll
            for (int i = 0; i < 3; ++i) ak[i] = *(const u32x4*)(Kg + kg[i]);
#pragma unroll
            for (int i = 0; i < 2; ++i) av[i] = *(const u32x4*)(Vg + vg[i]);
            asm volatile("" : "+v"(qf[0]), "+v"(qf[1]), "+v"(qf[2]), "+v"(qf[3]), "+v"(qf[4]), "+v"(qf[5]));
            LDS_BAR();
#pragma unroll
            for (int i = 0; i < 3; ++i) *(LAS u32x4*)(lds + kl[i]) = ak[i];
#pragma unroll
            for (int i = 0; i < 2; ++i) *(LAS u32x4*)(lds + vl[i]) = av[i];
            LDS_BAR();
            for (int t = 0; t < NT; ++t) {
                LAS unsigned char* bb = lds + (t & 1) * BUF;
                { const int tn = (t + 1 < NT) ? t + 1 : t;
                  const bf16* kgp = Kg + (size_t)tn * 128 * 768; const bf16* vgp = Vg + (size_t)tn * 128 * 512;
#pragma unroll
                  for (int i = 0; i < 3; ++i) ak[i] = *(const u32x4*)(kgp + kg[i]);
#pragma unroll
                  for (int i = 0; i < 2; ++i) av[i] = *(const u32x4*)(vgp + vg[i]); }
#pragma unroll
                for (int sub = 0; sub < 2; ++sub) {
                    const int tt = 2 * t + sub;
                    if (64 * tt <= qw + 31) {
                        LAS unsigned char* kb = bb + sub * SUB; LAS unsigned char* vb = kb + KBYTES;
                        bf16x8 kf0[6], kf1[6];
#pragma unroll
                        for (int s = 0; s < 6; ++s) { kf0[s] = *(const LAS bf16x8*)(kb + kfr + s * 32); kf1[s] = *(const LAS bf16x8*)(kb + kfr + 32 * KST + s * 32); }
                        __builtin_amdgcn_sched_barrier(0);
                        f32x16 p0 = negm, p1 = negm;
#pragma unroll
                        for (int s = 0; s < 6; ++s) { p0 = __builtin_amdgcn_mfma_f32_32x32x16_bf16(kf0[s], qf[s], p0, 0, 0, 0); p1 = __builtin_amdgcn_mfma_f32_32x32x16_bf16(kf1[s], qf[s], p1, 0, 0, 0); }
                        if (64 * tt + 63 > qw) {
                            int hm = hi; asm volatile("" : "+v"(hm));
                            const int qrel = qw + r - 64 * tt - 4 * hm;
#pragma unroll
                            for (int rg = 0; rg < 16; ++rg) { const int kv = (rg & 3) + 8 * (rg >> 2); if (kv > qrel) p0[rg] = -INFINITY; if (kv + 32 > qrel) p1[rg] = -INFINITY; }
                        }
                        float mx;
                        { float a = max3f(p0[0], p0[1], p1[0]), b2 = max3f(p0[2], p0[3], p1[1]); a = max3f(a, p1[2], p1[3]);
#pragma unroll
                          for (int rg = 4; rg < 16; rg += 4) { a = max3f(a, p0[rg], p0[rg + 1]); b2 = max3f(b2, p0[rg + 2], p0[rg + 3]); a = max3f(a, p1[rg], p1[rg + 1]); b2 = max3f(b2, p1[rg + 2], p1[rg + 3]); }
                          mx = xhalf_max(max2f(a, b2)); }
                        if (!__all(mx <= 8.0f)) {
                            const float dl = max2f(mx, 0.f), f = __builtin_amdgcn_exp2f(-dl); m += dl; l *= f;
#pragma unroll
                            for (int rg = 0; rg < 16; ++rg) { p0[rg] -= dl; p1[rg] -= dl; o0[rg] *= f; o1[rg] *= f; negm[rg] = -m; }
                        }
                        float rs = 0.f;
#pragma unroll
                        for (int rg = 0; rg < 16; ++rg) { p0[rg] = __builtin_amdgcn_exp2f(p0[rg]); p1[rg] = __builtin_amdgcn_exp2f(p1[rg]); rs += p0[rg] + p1[rg]; }
                        l += rs;
#pragma unroll
                        for (int hh = 0; hh < 2; ++hh)
#pragma unroll
                            for (int s2 = 0; s2 < 2; ++s2) { const bf16x8 pf = packp(hh == 0 ? p0 : p1, s2);
#pragma unroll
                                for (int db = 0; db < 2; ++db) { LAS unsigned char* vp_ = vb + vtr + (32 * hh + 16 * s2) * VST + db * 64;
                                    const s16x4 lo = __builtin_bit_cast(s16x4, __builtin_amdgcn_ds_read_tr16_b64_v4i16((LAS s16x4*)vp_));
                                    const s16x4 hi4 = __builtin_bit_cast(s16x4, __builtin_amdgcn_ds_read_tr16_b64_v4i16((LAS s16x4*)(vp_ + 8 * VST)));
                                    const bf16x8 vf = (bf16x8){lo[0], lo[1], lo[2], lo[3], hi4[0], hi4[1], hi4[2], hi4[3]};
                                    if (db == 0) o0 = __builtin_amdgcn_mfma_f32_32x32x16_bf16(vf, pf, o0, 0, 0, 0); else o1 = __builtin_amdgcn_mfma_f32_32x32x16_bf16(vf, pf, o1, 0, 0, 0); } }
                    }
                }
                { LAS unsigned char* nb = lds + ((t + 1) & 1) * BUF;
#pragma unroll
                  for (int i = 0; i < 3; ++i) *(LAS u32x4*)(nb + kl[i]) = ak[i];
#pragma unroll
                  for (int i = 0; i < 2; ++i) *(LAS u32x4*)(nb + vl[i]) = av[i]; }
                LDS_BAR();
            }
            const float il = 1.0f / xhalf_sum(l);
            bf16* op = YM + (row0 + qw + r) * YYLD + h * 64 + 4 * hi;
#pragma unroll
            for (int gq = 0; gq < 4; ++gq) { u32x2 w0, w1;
                w0.x = pk2(o0[4 * gq] * il, o0[4 * gq + 1] * il); w0.y = pk2(o0[4 * gq + 2] * il, o0[4 * gq + 3] * il);
                w1.x = pk2(o1[4 * gq] * il, o1[4 * gq + 1] * il); w1.y = pk2(o1[4 * gq + 2] * il, o1[4 * gq + 3] * il);
                *(u32x2*)(op + 8 * gq) = w0; *(u32x2*)(op + 32 + 8 * gq) = w1; }
        }
    }
    __syncthreads();
}

constexpr int CS_CH = 256, CS_NCH = SEQ / CS_CH;
constexpr int CS_RS = 144;
constexpr int CS_IMG = 16 * CS_RS;
constexpr int CS_WAVE = 8 * CS_IMG + 512;
enum { IM_A = 0, IM_R = 1, IM_B = 2, IM_K = 3, IM_BH = 4, IM_KH = 5, IM_V = 6, IM_G = 7 };
constexpr size_t DO_CSP = 64 * MiB, DO_CSG = 128 * MiB, DO_CSZ = 192 * MiB;
__device__ __forceinline__ int crow8(int q, int hi) { return (q & 3) + 8 * ((q >> 2) & 1) + 4 * hi; }
template <int N> __device__ __forceinline__ float dpp_shr0(float x) { return __builtin_bit_cast(float, __builtin_amdgcn_update_dpp(0, __builtin_bit_cast(int, x), 0x110 + N, 0xf, 0xf, true)); }
__device__ __forceinline__ float rowscan16(float x) { x += dpp_shr0<1>(x); x += dpp_shr0<2>(x); x += dpp_shr0<4>(x); x += dpp_shr0<8>(x); return x; }
__device__ __forceinline__ float xsum_16_32(float v) {
    { auto r = __builtin_amdgcn_permlane16_swap(__float_as_uint(v), __float_as_uint(v), false, false); v = __uint_as_float(r[0]) + __uint_as_float(r[1]); }
    { auto r = __builtin_amdgcn_permlane32_swap(__float_as_uint(v), __float_as_uint(v), false, false); v = __uint_as_float(r[0]) + __uint_as_float(r[1]); }
    return v;
}
__device__ __forceinline__ bf16x8 cs_rowfrag(const LAS unsigned char* rowp, int hi, int ks) {
    const LAS unsigned char* p = rowp + (16 * ks + 4 * hi) * 2; const u32x2 a = *(const LAS u32x2*)p, b = *(const LAS u32x2*)(p + 16);
    return __builtin_bit_cast(bf16x8, (u32x4){a.x, a.y, b.x, b.y});
}
__device__ __forceinline__ bf16x8 cs_trfrag(LAS unsigned char* img, int cb, int lane) {
    const int g4 = lane >> 4, li = lane & 15; LAS unsigned char* p = img + (4 * (g4 >> 1) + (li >> 2)) * CS_RS + (32 * cb + 16 * (g4 & 1) + 4 * (li & 3)) * 2;
    const s16x4 lo = __builtin_bit_cast(s16x4, __builtin_amdgcn_ds_read_tr16_b64_v4i16((LAS s16x4*)p));
    const s16x4 h4 = __builtin_bit_cast(s16x4, __builtin_amdgcn_ds_read_tr16_b64_v4i16((LAS s16x4*)(p + 8 * CS_RS)));
    return (bf16x8){lo[0], lo[1], lo[2], lo[3], h4[0], h4[1], h4[2], h4[3]};
}
__device__ __forceinline__ bf16x8 cs_zero8() { return (bf16x8){0, 0, 0, 0, 0, 0, 0, 0}; }
struct CsIn { const bf16 *ZR, *A, *LW, *G; const float *mu, *k_k, *k_a, *r_k; };
template <bool USE_V, bool WITH_Y>
__device__ __forceinline__ void cs_prep(const CsIn& in, size_t row0, int tok0, int h, LAS unsigned char* wl, int lane) {
    const int t = lane & 15, jq = lane >> 4, tok = tok0 + t; const bool first = tok == 0;
    const size_t g = row0 + tok, gp = row0 + (first ? 0 : tok - 1); const int c0 = h * 64 + 16 * jq;
    LAS float* gct = (LAS float*)(wl + 8 * CS_IMG); LAS float* btt = gct + 64;
    u32x4 Lrc[2], Lrp[2], Lkc[2], Lkp[2], Lav[2], Llw[2], Lvc[2], Lvp[2];
#pragma unroll
    for (int hf = 0; hf < 2; ++hf) { const int cc = c0 + 8 * hf;
        Lkc[hf] = *(const u32x4*)(in.ZR + g * 1792 + 512 + cc); Lkp[hf] = *(const u32x4*)(in.ZR + gp * 1792 + 512 + cc);
        Lrc[hf] = *(const u32x4*)(in.ZR + g * 1792 + cc); Lrp[hf] = *(const u32x4*)(in.ZR + gp * 1792 + cc);
        Lav[hf] = *(const u32x4*)(in.A + g * 512 + cc); Llw[hf] = *(const u32x4*)(in.LW + g * 512 + cc);
        if (USE_V) { Lvc[hf] = *(const u32x4*)(in.ZR + g * 1792 + 1024 + cc); Lvp[hf] = *(const u32x4*)(in.ZR + gp * 1792 + 1024 + cc); }
    }
    float inv;
    { float ss = 0.f;
#pragma unroll
      for (int hf = 0; hf < 2; ++hf) { float kc[8], kp[8]; unpack8(Lkc[hf], kc); unpack8(Lkp[hf], kp);
          const f32x4 m0 = *(const f32x4*)(in.mu + 512 + c0 + 8 * hf), m1 = *(const f32x4*)(in.mu + 512 + c0 + 8 * hf + 4), q0 = *(const f32x4*)(in.k_k + c0 + 8 * hf), q1 = *(const f32x4*)(in.k_k + c0 + 8 * hf + 4);
          const float mm[8] = {m0.x, m0.y, m0.z, m0.w, m1.x, m1.y, m1.z, m1.w}, qq[8] = {q0.x, q0.y, q0.z, q0.w, q1.x, q1.y, q1.z, q1.w};
#pragma unroll
          for (int e = 0; e < 8; ++e) { const float zk = kc[e] + ((first ? 0.f : kp[e]) - kc[e]) * mm[e]; const float kr = zk * qq[e]; ss += kr * kr; } }
      inv = 1.0f / fmaxf(sqrtf(xsum_16_32(ss)), 1e-12f); }
    float btacc = 0.f;
#pragma unroll
    for (int hf = 0; hf < 2; ++hf) {
        const int cc = c0 + 8 * hf;
        u32x4 Lgg = {}; if (WITH_Y) Lgg = *(const u32x4*)(in.G + g * 512 + cc);
        float rc[8], rp[8], kc[8], kp[8], av[8], lw[8];
        unpack8(Lrc[hf], rc); unpack8(Lrp[hf], rp); unpack8(Lkc[hf], kc); unpack8(Lkp[hf], kp); unpack8(Lav[hf], av); unpack8(Llw[hf], lw);
        float mr[8], mk[8], qk[8], qa[8], qr[8];
        { const f32x4 a0 = *(const f32x4*)(in.mu + cc), a1 = *(const f32x4*)(in.mu + cc + 4), b0 = *(const f32x4*)(in.mu + 512 + cc), b1 = *(const f32x4*)(in.mu + 512 + cc + 4);
          const f32x4 c0_ = *(const f32x4*)(in.k_k + cc), c1_ = *(const f32x4*)(in.k_k + cc + 4), d0 = *(const f32x4*)(in.k_a + cc), d1 = *(const f32x4*)(in.k_a + cc + 4);
          mr[0] = a0.x; mr[1] = a0.y; mr[2] = a0.z; mr[3] = a0.w; mr[4] = a1.x; mr[5] = a1.y; mr[6] = a1.z; mr[7] = a1.w;
          mk[0] = b0.x; mk[1] = b0.y; mk[2] = b0.z; mk[3] = b0.w; mk[4] = b1.x; mk[5] = b1.y; mk[6] = b1.z; mk[7] = b1.w;
          qk[0] = c0_.x; qk[1] = c0_.y; qk[2] = c0_.z; qk[3] = c0_.w; qk[4] = c1_.x; qk[5] = c1_.y; qk[6] = c1_.z; qk[7] = c1_.w;
          qa[0] = d0.x; qa[1] = d0.y; qa[2] = d0.z; qa[3] = d0.w; qa[4] = d1.x; qa[5] = d1.y; qa[6] = d1.z; qa[7] = d1.w; }
        if (WITH_Y) { const f32x4 e0 = *(const f32x4*)(in.r_k + cc), e1 = *(const f32x4*)(in.r_k + cc + 4); qr[0] = e0.x; qr[1] = e0.y; qr[2] = e0.z; qr[3] = e0.w; qr[4] = e1.x; qr[5] = e1.y; qr[6] = e1.z; qr[7] = e1.w; }
        float oA[8], oR[8], oB[8], oK[8], oBH[8], oKH[8];
#pragma unroll
        for (int e = 0; e < 8; ++e) {
            const float r = rc[e] + ((first ? 0.f : rp[e]) - rc[e]) * mr[e]; const float zk = kc[e] + ((first ? 0.f : kp[e]) - kc[e]) * mk[e];
            const float kq = zk * (1.f + (av[e] - 1.f) * qa[e]); const float kk = zk * qk[e] * inv; const float b = kk * av[e];
            const float Lg = rowscan16(lw[e]); const float eLg = __builtin_amdgcn_exp2f(1.4426950408889634f * Lg); const float enLg = __builtin_amdgcn_rcpf(eLg);
            const float eLgm = __builtin_bit_cast(float, __builtin_amdgcn_update_dpp(0x3f800000, __builtin_bit_cast(int, eLg), 0x111, 0xf, 0xf, false));
            const float eC = __builtin_bit_cast(float, __builtin_amdgcn_ds_bpermute(((lane & 48) | 15) << 2, __builtin_bit_cast(int, eLg)));
            oA[e] = -kk * eLgm; oR[e] = r * eLg; oB[e] = b * enLg; oK[e] = kq * enLg; oBH[e] = oB[e] * eC; oKH[e] = oK[e] * eC;
            if (WITH_Y) btacc += r * kq * qr[e];
            if (t == 15) gct[16 * jq + 8 * hf + e] = eC;
        }
        const int wo = t * CS_RS + (16 * jq + 8 * hf) * 2;
        *(LAS u32x4*)(wl + IM_A * CS_IMG + wo) = pack8(oA); *(LAS u32x4*)(wl + IM_R * CS_IMG + wo) = pack8(oR); *(LAS u32x4*)(wl + IM_B * CS_IMG + wo) = pack8(oB);
        *(LAS u32x4*)(wl + IM_K * CS_IMG + wo) = pack8(oK); *(LAS u32x4*)(wl + IM_BH * CS_IMG + wo) = pack8(oBH); *(LAS u32x4*)(wl + IM_KH * CS_IMG + wo) = pack8(oKH);
        if (USE_V) { float vc[8], vp[8], o[8]; unpack8(Lvc[hf], vc); unpack8(Lvp[hf], vp);
            const f32x4 a0 = *(const f32x4*)(in.mu + 1024 + cc), a1 = *(const f32x4*)(in.mu + 1024 + cc + 4); const float mv[8] = {a0.x, a0.y, a0.z, a0.w, a1.x, a1.y, a1.z, a1.w};
#pragma unroll
            for (int e = 0; e < 8; ++e) o[e] = vc[e] + ((first ? 0.f : vp[e]) - vc[e]) * mv[e];
            *(LAS u32x4*)(wl + IM_V * CS_IMG + wo) = pack8(o); }
        if (WITH_Y) *(LAS u32x4*)(wl + IM_G * CS_IMG + wo) = Lgg;
    }
    if (WITH_Y) { btacc = xsum_16_32(btacc); if (lane < 16) btt[lane] = btacc; }
}
struct CsFr { bf16x8 fAR[4], aL1, aL2, aL4, aL8, aLkMk, aMb; };
__device__ __forceinline__ void cs_gram(CsFr& fr, LAS unsigned char* wl, int lane) {
    const int hi = lane >> 5, row = lane & 15; const bool up = (lane & 16) != 0;
    const LAS unsigned char* rpAR = wl + (up ? IM_R : IM_A) * CS_IMG + row * CS_RS; const LAS unsigned char* rpBK = wl + (up ? IM_K : IM_B) * CS_IMG + row * CS_RS;
#pragma unroll
    for (int ks = 0; ks < 4; ++ks) fr.fAR[ks] = cs_rowfrag(rpAR, hi, ks);
    f32x16 F1 = {}, F2 = {};
#pragma unroll
    for (int ks = 0; ks < 4; ++ks) { const bf16x8 fBK = cs_rowfrag(rpBK, hi, ks);
        F1 = __builtin_amdgcn_mfma_f32_32x32x16_bf16(fBK, fr.fAR[ks], F1, 0, 0, 0);
        F2 = __builtin_amdgcn_mfma_f32_32x32x16_bf16(fr.fAR[ks], fBK, F2, 0, 0, 0); }
#pragma unroll
    for (int q = 0; q < 8; ++q) { const int s = crow8(q, hi); const bool k1 = up ? (s <= row) : (s < row);
        F1[q] = k1 ? F1[q] : 0.f; F1[8 + q] = k1 ? F1[8 + q] : 0.f; F2[q] = (!up && row < s) ? F2[q] : 0.f; }
    const bf16x8 f1lo = packp(F1, 0);
    fr.aL1 = up ? cs_zero8() : f1lo;
    fr.aMb = up ? f1lo : cs_zero8();
    fr.aLkMk = packp(F1, 1);
    const bf16x8 p2 = packp(F2, 0);
    const f32x16 z16 = {};
    const f32x16 Q1 = __builtin_amdgcn_mfma_f32_32x32x16_bf16(p2, fr.aL1, z16, 0, 0, 0), Q2 = __builtin_amdgcn_mfma_f32_32x32x16_bf16(fr.aL1, p2, z16, 0, 0, 0);
    fr.aL2 = packp(Q1, 0); const bf16x8 p2b = packp(Q2, 0);
    const f32x16 R1 = __builtin_amdgcn_mfma_f32_32x32x16_bf16(p2b, fr.aL2, z16, 0, 0, 0), R2 = __builtin_amdgcn_mfma_f32_32x32x16_bf16(fr.aL2, p2b, z16, 0, 0, 0);
    fr.aL4 = packp(R1, 0); const bf16x8 p2c = packp(R2, 0);
    const f32x16 S1 = __builtin_amdgcn_mfma_f32_32x32x16_bf16(p2c, fr.aL4, z16, 0, 0, 0);
    fr.aL8 = packp(S1, 0);
}
template <bool USE_V, bool WITH_Y>
__device__ __forceinline__ void cs_apply(f32x16 (&Z)[2][2], f32x16 (&D)[2], const CsFr& fr, LAS unsigned char* wl, int lane) {
    const int hi = lane >> 5;
    bf16x8 vf[2];
    if (USE_V) { vf[0] = cs_trfrag(wl + IM_V * CS_IMG, 0, lane); vf[1] = cs_trfrag(wl + IM_V * CS_IMG, 1, lane); }
#pragma unroll
    for (int nb = 0; nb < 2; ++nb) { f32x16 d = {};
#pragma unroll
        for (int jb = 0; jb < 2; ++jb)
#pragma unroll
            for (int k2 = 0; k2 < 2; ++k2) d = __builtin_amdgcn_mfma_f32_32x32x16_bf16(fr.fAR[2 * jb + k2], packp(Z[jb][nb], k2), d, 0, 0, 0);
        if (USE_V) d = __builtin_amdgcn_mfma_f32_32x32x16_bf16(fr.aLkMk, vf[nb], d, 0, 0, 0);
        D[nb] = d; }
#pragma unroll
    for (int nb = 0; nb < 2; ++nb) {
        D[nb] = __builtin_amdgcn_mfma_f32_32x32x16_bf16(fr.aL8, packp(D[nb], 0), D[nb], 0, 0, 0);
        D[nb] = __builtin_amdgcn_mfma_f32_32x32x16_bf16(fr.aL4, packp(D[nb], 0), D[nb], 0, 0, 0);
        D[nb] = __builtin_amdgcn_mfma_f32_32x32x16_bf16(fr.aL2, packp(D[nb], 0), D[nb], 0, 0, 0);
        D[nb] = __builtin_amdgcn_mfma_f32_32x32x16_bf16(fr.aL1, packp(D[nb], 0), D[nb], 0, 0, 0);
    }
    const bf16x8 u0 = packp(D[0], 0), u1 = packp(D[1], 0);
    if (WITH_Y) { D[0] = __builtin_amdgcn_mfma_f32_32x32x16_bf16(fr.aMb, u0, D[0], 0, 0, 0); D[1] = __builtin_amdgcn_mfma_f32_32x32x16_bf16(fr.aMb, u1, D[1], 0, 0, 0); }
    const LAS float* gct = (const LAS float*)(wl + 8 * CS_IMG);
#pragma unroll
    for (int jb = 0; jb < 2; ++jb) {
        const bf16x8 fb = cs_trfrag(wl + IM_BH * CS_IMG, jb, lane); bf16x8 fk = cs_zero8(); if (USE_V) fk = cs_trfrag(wl + IM_KH * CS_IMG, jb, lane);
        float gc[16];
#pragma unroll
        for (int g4 = 0; g4 < 4; ++g4) { const f32x4 x = *(const LAS f32x4*)(gct + 32 * jb + 8 * g4 + 4 * hi); gc[4 * g4] = x.x; gc[4 * g4 + 1] = x.y; gc[4 * g4 + 2] = x.z; gc[4 * g4 + 3] = x.w; }
#pragma unroll
        for (int nb = 0; nb < 2; ++nb) { f32x16 z = Z[jb][nb];
#pragma unroll
            for (int q = 0; q < 16; ++q) z[q] *= gc[q];
            z = __builtin_amdgcn_mfma_f32_32x32x16_bf16(fb, nb == 0 ? u0 : u1, z, 0, 0, 0);
            if (USE_V) z = __builtin_amdgcn_mfma_f32_32x32x16_bf16(fk, vf[nb], z, 0, 0, 0);
            Z[jb][nb] = z; }
    }
}
__device__ __forceinline__ void cs_apply_pk(bf16x8 (&Zp)[2][2][2], f32x16 (&D)[2], const CsFr& fr, LAS unsigned char* wl, int lane) {
    const int hi = lane >> 5;
#pragma unroll
    for (int nb = 0; nb < 2; ++nb) { f32x16 d = {};
#pragma unroll
        for (int jb = 0; jb < 2; ++jb)
#pragma unroll
            for (int k2 = 0; k2 < 2; ++k2) d = __builtin_amdgcn_mfma_f32_32x32x16_bf16(fr.fAR[2 * jb + k2], Zp[jb][nb][k2], d, 0, 0, 0);
        D[nb] = d; }
#pragma unroll
    for (int nb = 0; nb < 2; ++nb) {
        D[nb] = __builtin_amdgcn_mfma_f32_32x32x16_bf16(fr.aL8, packp(D[nb], 0), D[nb], 0, 0, 0);
        D[nb] = __builtin_amdgcn_mfma_f32_32x32x16_bf16(fr.aL4, packp(D[nb], 0), D[nb], 0, 0, 0);
        D[nb] = __builtin_amdgcn_mfma_f32_32x32x16_bf16(fr.aL2, packp(D[nb], 0), D[nb], 0, 0, 0);
        D[nb] = __builtin_amdgcn_mfma_f32_32x32x16_bf16(fr.aL1, packp(D[nb], 0), D[nb], 0, 0, 0);
    }
    const bf16x8 u0 = packp(D[0], 0), u1 = packp(D[1], 0);
    const LAS float* gct = (const LAS float*)(wl + 8 * CS_IMG);
#pragma unroll
    for (int jb = 0; jb < 2; ++jb) {
        const bf16x8 fb = cs_trfrag(wl + IM_BH * CS_IMG, jb, lane);
        float gc[16];
#pragma unroll
        for (int g4 = 0; g4 < 4; ++g4) { const f32x4 x = *(const LAS f32x4*)(gct + 32 * jb + 8 * g4 + 4 * hi); gc[4 * g4] = x.x; gc[4 * g4 + 1] = x.y; gc[4 * g4 + 2] = x.z; gc[4 * g4 + 3] = x.w; }
#pragma unroll
        for (int nb = 0; nb < 2; ++nb) { f32x16 z;
#pragma unroll
            for (int k2 = 0; k2 < 2; ++k2) { float e[8]; unpack8(__builtin_bit_cast(u32x4, Zp[jb][nb][k2]), e);
#pragma unroll
                for (int q = 0; q < 8; ++q) z[8 * k2 + q] = e[q] * gc[8 * k2 + q]; }
            z = __builtin_amdgcn_mfma_f32_32x32x16_bf16(fb, nb == 0 ? u0 : u1, z, 0, 0, 0);
            Zp[jb][nb][0] = packp(z, 0); Zp[jb][nb][1] = packp(z, 1); }
    }
}
template <bool USE_V, bool WITH_Y>
__device__ __forceinline__ void cs_step(f32x16 (&Z)[2][2], f32x16 (&D)[2], LAS unsigned char* wl, int lane) { CsFr fr; cs_gram(fr, wl, lane); cs_apply<USE_V, WITH_Y>(Z, D, fr, wl, lane); }
__device__ __forceinline__ void p_cs_a(const Frame& F, ArgsP a) {
    const int lane = lane_id_fresh();
    LAS unsigned char* wl = F.lds + F.wave * CS_WAVE;
    CsIn in{(const bf16*)(F.ws + WS_ZR), (const bf16*)(F.ws + WS_A), (const bf16*)(F.ws + WS_LW), (const bf16*)(F.dob + DO_G), a->in[I_MU], a->in[I_KK], a->in[I_KA], a->in[I_RK]};
    bf16* Pm = (bf16*)(F.dob + DO_CSP); bf16* Gf = (bf16*)(F.dob + DO_CSG);
    const int hi = lane >> 5;
    for (int uc = F.gw; uc < 64 * CS_NCH; uc += F.NGW) {
        const int bh = uc / CS_NCH, c = uc % CS_NCH, b = bh >> 3, h = bh & 7; const size_t row0 = (size_t)b * SEQ;
        f32x16 ZG[2][2], D[2]; bf16x8 ZP[2][2][2];
#pragma unroll
        for (int jb = 0; jb < 2; ++jb)
#pragma unroll
            for (int nb = 0; nb < 2; ++nb) { f32x16 z = {}; ZG[jb][nb] = z;
                if (jb == nb) {
#pragma unroll
                    for (int q = 0; q < 16; ++q) z[q] = (crow(q, hi) == (lane & 31)) ? 1.f : 0.f; }
                ZP[jb][nb][0] = packp(z, 0); ZP[jb][nb][1] = packp(z, 1); }
        for (int sc = 0; sc < CS_CH / 16; ++sc) { int ln = lane; asm volatile("" : "+v"(ln));
            cs_prep<true, false>(in, row0, c * CS_CH + sc * 16, h, wl, ln); asm volatile("s_waitcnt lgkmcnt(0)" ::: "memory");
            CsFr fr; cs_gram(fr, wl, ln);
            cs_apply_pk(ZP, D, fr, wl, ln); cs_apply<true, false>(ZG, D, fr, wl, ln); asm volatile("s_waitcnt lgkmcnt(0)" ::: "memory"); }
        int lo_ = lane; asm volatile("" : "+v"(lo_)); const int hi_o = lo_ >> 5;
        {
            LAS unsigned short* tb = (LAS unsigned short*)(wl + 4 * hi_o * CS_RS + (lo_ & 31) * 2);
#pragma unroll
            for (int jb = 0; jb < 2; ++jb)
#pragma unroll
                for (int nb = 0; nb < 2; ++nb)
#pragma unroll
                    for (int q = 0; q < 16; ++q) tb[((32 * jb + (q & 3) + 8 * (q >> 2)) * CS_RS + 64 * nb) / 2] = (unsigned short)ZP[jb][nb][q >> 3][q & 7];
            bf16* dst = Pm + (size_t)uc * 4096;
#pragma unroll
            for (int i = 0; i < 8; ++i) { const int ch = lo_ + 64 * i, rr = ch >> 3, c8 = (ch & 7) * 8; *(u32x4*)(dst + rr * 64 + c8) = *(const LAS u32x4*)(wl + rr * CS_RS + c8 * 2); }
            asm volatile("s_waitcnt lgkmcnt(0)" ::: "memory");
        }
        {
            bf16* dst = Gf + (size_t)uc * 4096;
#pragma unroll
            for (int jb = 0; jb < 2; ++jb)
#pragma unroll
                for (int nb = 0; nb < 2; ++nb) { u32x4 w0, w1; const f32x16& z = ZG[jb][nb];
                    w0.x = pk2(z[0], z[1]); w0.y = pk2(z[2], z[3]); w0.z = pk2(z[4], z[5]); w0.w = pk2(z[6], z[7]); w1.x = pk2(z[8], z[9]); w1.y = pk2(z[10], z[11]); w1.z = pk2(z[12], z[13]); w1.w = pk2(z[14], z[15]);
                    u32x4* p = (u32x4*)(dst + ((jb * 2 + nb) * 64 + lo_) * 16); p[0] = w0; p[1] = w1; }
        }
    }
}
struct CsB { u32x2 p[2][2][2][2]; u32x4 g[2][2]; };
__device__ __forceinline__ void csb_load(CsB& X, const bf16* Pm, const bf16* Gf, size_t uc, int nb, int lane) {
    const int hi = lane >> 5, r = lane & 31; const bf16* Pc = Pm + uc * 4096;
#pragma unroll
    for (int mb = 0; mb < 2; ++mb) {
#pragma unroll
        for (int jb = 0; jb < 2; ++jb)
#pragma unroll
            for (int k2 = 0; k2 < 2; ++k2) { const bf16* pr = Pc + (32 * mb + r) * 64 + 32 * jb + 16 * k2 + 4 * hi; X.p[mb][jb][k2][0] = *(const u32x2*)pr; X.p[mb][jb][k2][1] = *(const u32x2*)(pr + 8); }
        const u32x4* gp = (const u32x4*)(Gf + uc * 4096 + ((mb * 2 + nb) * 64 + lane) * 16); X.g[mb][0] = gp[0]; X.g[mb][1] = gp[1]; }
}
__device__ __forceinline__ void csb_step(f32x16 (&Z)[2], const CsB& X, bf16* Zf, size_t uc, int nb, int lane) {
#pragma unroll
    for (int jb = 0; jb < 2; ++jb) { u32x4 w0, w1; const f32x16& z = Z[jb];
        w0.x = pk2(z[0], z[1]); w0.y = pk2(z[2], z[3]); w0.z = pk2(z[4], z[5]); w0.w = pk2(z[6], z[7]); w1.x = pk2(z[8], z[9]); w1.y = pk2(z[10], z[11]); w1.z = pk2(z[12], z[13]); w1.w = pk2(z[14], z[15]);
        u32x4* p = (u32x4*)(Zf + uc * 4096 + ((jb * 2 + nb) * 64 + lane) * 16); p[0] = w0; p[1] = w1; }
    f32x16 N[2];
#pragma unroll
    for (int mb = 0; mb < 2; ++mb) { float g0[8], g1[8]; unpack8(X.g[mb][0], g0); unpack8(X.g[mb][1], g1);
#pragma unroll
        for (int q = 0; q < 8; ++q) { N[mb][q] = g0[q]; N[mb][8 + q] = g1[q]; } }
#pragma unroll
    for (int jb = 0; jb < 2; ++jb)
#pragma unroll
        for (int k2 = 0; k2 < 2; ++k2) { const bf16x8 zb = packp(Z[jb], k2);
#pragma unroll
            for (int mb = 0; mb < 2; ++mb) { const u32x2 x0 = X.p[mb][jb][k2][0], x1 = X.p[mb][jb][k2][1];
                N[mb] = __builtin_amdgcn_mfma_f32_32x32x16_bf16(__builtin_bit_cast(bf16x8, (u32x4){x0.x, x0.y, x1.x, x1.y}), zb, N[mb], 0, 0, 0); } }
    Z[0] = N[0]; Z[1] = N[1];
}
__device__ __forceinline__ void p_cs_b(const Frame& F) {
    const int lane = lane_id_fresh();
    const bf16* Pm = (const bf16*)(F.dob + DO_CSP); const bf16* Gf = (const bf16*)(F.dob + DO_CSG); bf16* Zf = (bf16*)(F.dob + DO_CSZ);
    for (int u16 = F.gw; u16 < 128 * 16; u16 += F.NGW) {
        if (u16 & 15) continue;
        const int u = u16 >> 4, bh = u >> 1, nb = u & 1; const size_t uc0 = (size_t)bh * CS_NCH;
        f32x16 Z[2] = {};
        CsB X0, X1;
        csb_load(X0, Pm, Gf, uc0, nb, lane);
        for (int c = 0; c < CS_NCH; c += 2) {
            csb_load(X1, Pm, Gf, uc0 + c + 1, nb, lane);
            csb_step(Z, X0, Zf, uc0 + c, nb, lane);
            csb_load(X0, Pm, Gf, uc0 + (c + 2 < CS_NCH ? c + 2 : CS_NCH - 1), nb, lane);
            csb_step(Z, X1, Zf, uc0 + c + 1, nb, lane);
        }
    }
}
__device__ __forceinline__ void p_cs_c(const Frame& F, ArgsP a) {
    const int lane = lane_id_fresh(), hi = lane >> 5;
    LAS unsigned char* wl = F.lds + F.wave * CS_WAVE;
    CsIn in{(const bf16*)(F.ws + WS_ZR), (const bf16*)(F.ws + WS_A), (const bf16*)(F.ws + WS_LW), (const bf16*)(F.dob + DO_G), a->in[I_MU], a->in[I_KK], a->in[I_KA], a->in[I_RK]};
    const bf16* Zf = (const bf16*)(F.dob + DO_CSZ); bf16* Y = (bf16*)(F.ws + WS_Y); const float* lnw = a->in[I_LNW]; const float* lnb = a->in[I_LNB];
    const LAS float* btt = (const LAS float*)(wl + 8 * CS_IMG) + 64;
    for (int uc = F.gw; uc < 64 * CS_NCH; uc += F.NGW) {
        const int bh = uc / CS_NCH, c = uc % CS_NCH, b = bh >> 3, h = bh & 7; const size_t row0 = (size_t)b * SEQ;
        f32x16 Z[2][2], D[2];
        int lu = lane; asm volatile("" : "+v"(lu));
#pragma unroll
        for (int jb = 0; jb < 2; ++jb)
#pragma unroll
            for (int nb = 0; nb < 2; ++nb) { const u32x4* p = (const u32x4*)(Zf + (size_t)uc * 4096 + ((jb * 2 + nb) * 64 + lu) * 16); float g0[8], g1[8]; unpack8(p[0], g0); unpack8(p[1], g1);
#pragma unroll
                for (int q = 0; q < 8; ++q) { Z[jb][nb][q] = g0[q]; Z[jb][nb][8 + q] = g1[q]; } }
        const float lw0 = lnw[h * 64 + (lu & 31)], lw1 = lnw[h * 64 + 32 + (lu & 31)], lb0 = lnb[h * 64 + (lu & 31)], lb1 = lnb[h * 64 + 32 + (lu & 31)];
        for (int sc = 0; sc < CS_CH / 16; ++sc) {
            const int tok0 = c * CS_CH + sc * 16;
            int ln = lane; asm volatile("" : "+v"(ln));
            cs_prep<true, true>(in, row0, tok0, h, wl, ln); asm volatile("s_waitcnt lgkmcnt(0)" ::: "memory");
            cs_step<true, true>(Z, D, wl, ln); asm volatile("s_waitcnt lgkmcnt(0)" ::: "memory");
            const int hl = ln >> 5;
            const bf16x8 v0 = cs_trfrag(wl + IM_V * CS_IMG, 0, ln), v1 = cs_trfrag(wl + IM_V * CS_IMG, 1, ln), g0 = cs_trfrag(wl + IM_G * CS_IMG, 0, ln), g1 = cs_trfrag(wl + IM_G * CS_IMG, 1, ln);
            const f32x4 bta = *(const LAS f32x4*)(btt + 4 * hl), btb = *(const LAS f32x4*)(btt + 8 + 4 * hl); const float bt[8] = {bta.x, bta.y, bta.z, bta.w, btb.x, btb.y, btb.z, btb.w};
#pragma unroll
            for (int q = 0; q < 8; ++q) {
                const float y0 = D[0][8 + q], y1 = D[1][8 + q];
                const float mean = allsum32(y0 + y1) * (1.f / 64.f); const float d0 = y0 - mean, d1 = y1 - mean;
                const float rstd = 1.0f / sqrtf(allsum32(d0 * d0 + d1 * d1) * (1.f / 64.f) + LN_X_EPS);
                const float o0 = (d0 * rstd * lw0 + lb0 + bt[q] * bf2f((unsigned short)v0[q])) * bf2f((unsigned short)g0[q]);
                const float o1 = (d1 * rstd * lw1 + lb1 + bt[q] * bf2f((unsigned short)v1[q])) * bf2f((unsigned short)g1[q]);
                bf16* yp = Y + (row0 + tok0 + crow8(q, hl)) * YYLD + h * 64 + (ln & 31);
                yp[0] = (unsigned short)f2bf(o0); yp[32] = (unsigned short)f2bf(o1);
            }
            asm volatile("s_waitcnt lgkmcnt(0)" ::: "memory");
        }
    }
}

__device__ __forceinline__ void p_ffn_route(const Frame& F, ArgsP a, unsigned* cnt, int* route) {
    const int lane_f = lane_id_fresh(), tid_f = F.wave * 64 + lane_f;
    const float* X = a->in[I_X]; const bf16* MO = (const bf16*)(F.ws + WS_MO); bf16* H2 = (bf16*)(F.ws + WS_H2); const float* mod = (const float*)(F.ws + WS_MOD); const float* g = a->in[I_GFFN];
    constexpr int RTS = 1028;
    LAS float* wr = (LAS float*)F.lds;
    __syncthreads();
    for (int i = tid_f; i < 1024 * 4; i += NTHR) { const int k = i >> 2, o = i & 3; wr[o * RTS + k] = a->in[I_WRG][i]; }
    for (int i = tid_f; i < 1024 * 32; i += NTHR) { const int k = i >> 5, o = i & 31; wr[(4 + o) * RTS + k] = a->in[I_WRE][i]; }
    __syncthreads();
    LAS float* brl = wr + 36 * RTS;
    if (tid_f < 4) brl[tid_f] = a->in[I_BRG][tid_f]; else if (tid_f < 36) brl[tid_f] = a->in[I_BRE][tid_f - 4];
    const int lane = lane_f;
    LAS unsigned* lcnt = (LAS unsigned*)(F.lds + LDS_MISC + 512);
    if (tid_f < 64) lcnt[tid_f] = 0u;
    __syncthreads();
    int my_e0 = 0, my_e1 = 0; float my_w0 = 0.f, my_w1 = 0.f; int kk_ = 0;
    f32x4 xa[4], xb[4]; u32x2 ma[4], mb[4]; f32x4 gmv[4], gsv[4], shv[4]; int bcur = -1;
    { const f32x4* xr = (const f32x4*)(X + (size_t)F.gw * 1024) + lane; const u32x2* mr = (const u32x2*)(MO + (size_t)F.gw * 1024) + lane;
#pragma unroll
      for (int j = 0; j < 4; ++j) { xa[j] = xr[64 * j]; ma[j] = mr[64 * j]; } }
#define RT_ROW(CX, CM, NX, NM, m_) do { const int mm = (m_); const int b = mm / SEQ; \
        if (b != bcur) { bcur = b; \
            _Pragma("unroll") for (int j = 0; j < 4; ++j) { const int col = 4 * lane + 256 * j; gmv[j] = *(const f32x4*)(mod + b * 6144 + 2048 + col); \
                gsv[j] = *(const f32x4*)(g + col) * (*(const f32x4*)(mod + b * 6144 + 4096 + col) + 1.0f); shv[j] = *(const f32x4*)(mod + b * 6144 + 3072 + col); } \
            asm volatile("s_waitcnt vmcnt(0)" : "+v"(gmv[0]), "+v"(gmv[1]), "+v"(gmv[2]), "+v"(gmv[3]), "+v"(gsv[0]), "+v"(gsv[1]), "+v"(gsv[2]), "+v"(gsv[3]), "+v"(shv[0]), "+v"(shv[1]), "+v"(shv[2]), "+v"(shv[3])); \
            asm volatile("" : "+v"(CX[0]), "+v"(CX[1]), "+v"(CX[2]), "+v"(CX[3]), "+v"(CM[0]), "+v"(CM[1]), "+v"(CM[2]), "+v"(CM[3])); } \
        { const int mn = (mm + F.NGW < NTOK) ? mm + F.NGW : mm; const f32x4* xr = (const f32x4*)(X + (size_t)mn * 1024) + lane; const u32x2* mr = (const u32x2*)(MO + (size_t)mn * 1024) + lane; \
          _Pragma("unroll") for (int j = 0; j < 4; ++j) { NX[j] = xr[64 * j]; NM[j] = mr[64 * j]; } } \
        f32x4 v[4]; float s = 0.f; \
        _Pragma("unroll") for (int j = 0; j < 4; ++j) { v[j] = CX[j] + gmv[j] * (f32x4){lo2f(CM[j].x), hi2f(CM[j].x), lo2f(CM[j].y), hi2f(CM[j].y)}; \
            s += (v[j].x * v[j].x + v[j].y * v[j].y) + (v[j].z * v[j].z + v[j].w * v[j].w); } \
        const float rstd = 1.0f / sqrtf(wave_sum(s) * (1.f / 1024.f) + EPS); \
        u32x2* o = (u32x2*)(H2 + (size_t)mm * 1024) + lane; \
        _Pragma("unroll") for (int j = 0; j < 4; ++j) { v[j] = v[j] * rstd * gsv[j] + shv[j]; u32x2 w; w.x = pk2(v[j].x, v[j].y); w.y = pk2(v[j].z, v[j].w); o[64 * j] = w; } \
        float lgq[4]; \
        _Pragma("unroll") for (int oo = 0; oo < 4; ++oo) { float p = 0.f; \
            _Pragma("unroll") for (int j = 0; j < 4; ++j) { const f32x4 w4 = *(const LAS f32x4*)(wr + oo * RTS + 4 * lane + 256 * j); p += (v[j].x * w4.x + v[j].y * w4.y) + (v[j].z * w4.z + v[j].w * w4.w); } \
            lgq[oo] = wave_sum(p) + brl[oo]; } \
        int gi = 0; float gmx = lgq[0]; \
        _Pragma("unroll") for (int i = 1; i < 4; ++i) { if (lgq[i] > gmx) { gmx = lgq[i]; gi = i; } } \
        float gsum = 0.f; \
        _Pragma("unroll") for (int i = 0; i < 4; ++i) gsum += __expf(lgq[i] - gmx); \
        const float pg = 1.f / gsum; \
        gi = __builtin_amdgcn_readfirstlane(gi); \
        float el[8]; \
        { const LAS float* wg = wr + (4 + gi * 8) * RTS + 4 * lane; \
          _Pragma("unroll") for (int i = 0; i < 8; ++i) { float p = 0.f; \
              _Pragma("unroll") for (int j = 0; j < 4; ++j) { const f32x4 w4 = *(const LAS f32x4*)(wg + i * RTS + 256 * j); p += (v[j].x * w4.x + v[j].y * w4.y) + (v[j].z * w4.z + v[j].w * w4.w); } \
              el[i] = wave_sum(p) + brl[4 + gi * 8 + i]; } } \
        int i0 = 0; float m0 = el[0]; \
        _Pragma("unroll") for (int i = 1; i < 8; ++i) if (el[i] > m0) { m0 = el[i]; i0 = i; } \
        int i1 = -1; float m1 = -INFINITY; \
        _Pragma("unroll") for (int i = 0; i < 8; ++i) if (i != i0 && el[i] > m1) { m1 = el[i]; i1 = i; } \
        const float e1 = __expf(m1 - m0), w0 = pg / (1.f + e1), w1 = pg * e1 / (1.f + e1); \
        if (lane == kk_) { my_e0 = gi * 8 + i0; my_e1 = gi * 8 + i1; my_w0 = w0; my_w1 = w1; } \
        ++kk_; } while (0)
    for (int m = F.gw; m < NTOK; m += 2 * F.NGW) {
        RT_ROW(xa, ma, xb, mb, m);
        if (m + F.NGW < NTOK) RT_ROW(xb, mb, xa, ma, m + F.NGW);
    }
#undef RT_ROW
    unsigned lp0 = 0u, lp1 = 0u;
    if (lane < kk_) { lp0 = __hip_atomic_fetch_add(lcnt + my_e0, 1u, __ATOMIC_RELAXED, __HIP_MEMORY_SCOPE_WORKGROUP); lp1 = __hip_atomic_fetch_add(lcnt + my_e1, 1u, __ATOMIC_RELAXED, __HIP_MEMORY_SCOPE_WORKGROUP); }
    __syncthreads();
    if (tid_f < 32) lcnt[32 + tid_f] = __hip_atomic_fetch_add(cnt + tid_f, lcnt[tid_f], __ATOMIC_RELAXED, __HIP_MEMORY_SCOPE_AGENT);
    __syncthreads();
    if (lane < kk_) { const int m = F.gw + lane * F.NGW; int* rt = route + (size_t)m * 8;
        rt[0] = my_e0; rt[1] = my_e1; rt[2] = (int)(lcnt[32 + my_e0] + lp0); rt[3] = (int)(lcnt[32 + my_e1] + lp1); rt[4] = __builtin_bit_cast(int, my_w0); rt[5] = __builtin_bit_cast(int, my_w1); }
    __syncthreads();
}
__device__ __forceinline__ int moe_tables(const Frame& F, LAS int* offs, LAS int* texp) {
    const int lane_f = lane_id_fresh(), tid_f = F.wave * 64 + lane_f;
    const unsigned* cnt = (const unsigned*)(F.ws + WS_CTL) + CW_CNT;
    __syncthreads();
    if (F.wave == 0) {
        const int e = lane_f & 31; const int c = (int)__hip_atomic_load(cnt + e, __ATOMIC_RELAXED, __HIP_MEMORY_SCOPE_AGENT); const int nt = (c + 255) >> 8;
        int incl = nt;
#pragma unroll
        for (int d = 1; d < 32; d <<= 1) { const int o = __shfl_up(incl, d, 32); if (e >= d) incl += o; }
        const int t0 = incl - nt;
        if (lane_f < 32) { offs[e] = t0 << 8; if (e == 31) offs[32] = incl << 8; for (int t = 0; t < nt; ++t) texp[t0 + t] = e; }
    }
    __syncthreads();
    return offs[32] >> 8;
}
__device__ __forceinline__ void p_gather(const Frame& F) {
    const int lane_f = lane_id_fresh(), tid_f = F.wave * 64 + lane_f;
    LAS int* offs = (LAS int*)(F.lds + 1024); LAS int* texp = (LAS int*)(F.lds + 2048);
    moe_tables(F, offs, texp);
    const int* route = (const int*)(F.ws + WS_ROUTE); int* ridx = (int*)(F.ws + WS_ENT);
    const unsigned* cnt = (const unsigned*)(F.ws + WS_CTL) + CW_CNT;
    for (int m = F.vcu * NTHR + tid_f; m < NTOK; m += F.G * NTHR) { const u32x4 rt = *(const u32x4*)(route + (size_t)m * 8); ridx[offs[rt.x] + (int)rt.z] = m; ridx[offs[rt.y] + (int)rt.w] = m; }
    for (int i = F.vcu * NTHR + tid_f; i < 32 * 256; i += F.G * NTHR) { const int e = i >> 8, r = i & 255; const int c = (int)cnt[e]; const int pad = ((c + 255) & ~255) - c; if (r < pad) ridx[offs[e] + c + r] = 0; }
    __syncthreads();
}
__device__ __forceinline__ void p_combine(const Frame& F, const float* xin, float* dst) {
    const int lane_f = lane_id_fresh(), tid_f = F.wave * 64 + lane_f;
    LAS int* offs = (LAS int*)(F.lds + 1024); LAS int* texp = (LAS int*)(F.lds + 2048);
    moe_tables(F, offs, texp);
    const bf16* MO = (const bf16*)(F.ws + WS_MO); const bf16* YS = (const bf16*)(F.ws + WS_YS); const int* route = (const int*)(F.ws + WS_ROUTE); const float* mod = (const float*)(F.ws + WS_MOD);
    const int lane = lane_f;
    for (int m = F.gw; m < NTOK; m += F.NGW) {
        const int b = m / SEQ; const int* rt = route + (size_t)m * 8; const int d0 = offs[rt[0]] + rt[2], d1 = offs[rt[1]] + rt[3];
        const float w0 = __builtin_bit_cast(float, rt[4]), w1 = __builtin_bit_cast(float, rt[5]);
#pragma unroll
        for (int j = 0; j < 2; ++j) { const int col = 8 * lane + 512 * j; float y0[8], y1[8];
            unpack8(*(const u32x4*)(YS + (size_t)d0 * 1024 + col), y0); unpack8(*(const u32x4*)(YS + (size_t)d1 * 1024 + col), y1);
            const float* o = xin + (size_t)m * 1024 + col; const float* gt = mod + b * 6144 + 5120 + col; const float* gm = mod + b * 6144 + 2048 + col; float mo[8]; unpack8(*(const u32x4*)(MO + (size_t)m * 1024 + col), mo);
            f32x4 x0 = *(const f32x4*)o, x1 = *(const f32x4*)(o + 4); const f32x4 g0 = *(const f32x4*)gt, g1 = *(const f32x4*)(gt + 4), h0 = *(const f32x4*)gm, h1 = *(const f32x4*)(gm + 4);
            x0.x += h0.x * mo[0]; x0.y += h0.y * mo[1]; x0.z += h0.z * mo[2]; x0.w += h0.w * mo[3]; x1.x += h1.x * mo[4]; x1.y += h1.y * mo[5]; x1.z += h1.z * mo[6]; x1.w += h1.w * mo[7];
            x0.x += g0.x * (w0 * y0[0] + w1 * y1[0]); x0.y += g0.y * (w0 * y0[1] + w1 * y1[1]); x0.z += g0.z * (w0 * y0[2] + w1 * y1[2]); x0.w += g0.w * (w0 * y0[3] + w1 * y1[3]);
            x1.x += g1.x * (w0 * y0[4] + w1 * y1[4]); x1.y += g1.y * (w0 * y0[5] + w1 * y1[5]); x1.z += g1.z * (w0 * y0[6] + w1 * y1[6]); x1.w += g1.w * (w0 * y0[7] + w1 * y1[7]);
            float* od = dst + (size_t)m * 1024 + col; *(f32x4*)od = x0; *(f32x4*)(od + 4) = x1; }
    }
}

constexpr int NPHASE = 17;
template <int LO, int HI>
__global__ void __launch_bounds__(NTHR, 2) fwd(Args args) {
    extern __shared__ __attribute__((aligned(16))) unsigned char lds_raw[];
    Frame F;
    F.lds = (LAS unsigned char*)lds_raw;
    F.wave = __builtin_amdgcn_readfirstlane((int)threadIdx.x >> 6);
    F.G = gridDim.x; { const int bx = blockIdx.x; F.vcu = (F.G % 8 == 0) ? (bx % 8) * (F.G / 8) + bx / 8 : bx; }
    F.gw = F.vcu * NWAVES + F.wave; F.NGW = F.G * NWAVES;
    F.ws = args.ws; F.dob = (unsigned char*)args.out;
    ArgsP AP = (ArgsP)__builtin_amdgcn_kernarg_segment_ptr();
    volatile LAS unsigned* MISC = (volatile LAS unsigned*)(F.lds + LDS_MISC);
    if (threadIdx.x < 64) MISC[threadIdx.x] = 0u;
    __syncthreads();
    XcdBarrier bar; bar.bar = (unsigned*)(F.ws + WS_CTL) + CW_BAR; bar.x = 0; bar.st = MISC + 8;
#if N_LAUNCH_MODE == 1
    bar = xcd_barrier_post((unsigned*)(F.ws + WS_CTL) + CW_BAR, MISC + 8);
#define GRID_BAR() xcd_barrier(bar)
#else
#define GRID_BAR() do { } while (0)
#endif
#ifndef PROBE_REPEAT
#define PROBE_REPEAT -1
#endif
#define IN(k) (LO <= (k) && (k) < HI)
#define SEAM(k) do { if constexpr (IN(k) && IN((k) + 1)) GRID_BAR(); } while (0)
    const float* mod = (const float*)(F.ws + WS_MOD);

#define PH(k, ...) do { if constexpr (IN(k)) { asm volatile("" : "+s"(AP)); { __VA_ARGS__ } if constexpr (PROBE_REPEAT == (k)) { GRID_BAR(); asm volatile("" : "+s"(AP)); { __VA_ARGS__ } } } } while (0)
    PH(0, p0_prologue(F, AP);); SEAM(0);
    PH(1, p_normmod(F, AP->in[I_X], AP->in[I_GMIX], mod, 0, 1024, (bf16*)(F.ws + WS_H));); SEAM(1);
    PH(2, Gemm g{(const bf16*)(F.ws + WS_H), (const bf16*)(F.ws + WS_WIN), NTOK, N_IN_PAD, 1024}; StaticOrder S; S.init(NTOK, N_IN_PAD, F.G, (int)blockIdx.x);
        EpiZ E{(bf16*)(F.ws + WS_ZR), (bf16*)(F.ws + WS_SG), (bf16*)(F.ws + WS_ZM)}; gemm_phase_any(F.lds, g, S, E, F.wave);); SEAM(2);
    PH(3, p_prep_a(F, AP);); SEAM(3);
    PH(4,
        { Gemm g{(const bf16*)(F.ws + WS_TWA), (const bf16*)(F.ws + WS_WBLK), NTOK, 1024, 128}; StaticOrder S; S.init(NTOK, 1024, F.G, (int)blockIdx.x);
          EpiLora E{(bf16*)(F.ws + WS_LW), (bf16*)(F.ws + WS_A), AP->in[I_W0], AP->in[I_A0]}; gemm_phase_any(F.lds, g, S, E, F.wave); }
        { Gemm g{(const bf16*)(F.ws + WS_SGL), (const bf16*)(F.ws + WS_WG), NTOK, 512, 128}; StaticOrder S; S.init(NTOK, 512, F.G, (int)blockIdx.x);
          EpiPlain E{(bf16*)(F.dob + DO_G), nullptr, 1 << 30, 512, 0}; gemm_phase_any(F.lds, g, S, E, F.wave); }
        { Gemm g{(const bf16*)(F.ws + WS_QA), (const bf16*)(F.ws + WS_WUQ), NTOK, 768, 256}; StaticOrder S; S.init(NTOK, 768, F.G, (int)blockIdx.x);
          EpiPlain E{(bf16*)(F.dob + DO_Q), nullptr, 1 << 30, 768, 0}; gemm_phase_any(F.lds, g, S, E, F.wave); }
        { Gemm g{(const bf16*)(F.ws + WS_KVA), (const bf16*)(F.ws + WS_WUKV), NTOK, 1024, 128}; StaticOrder S; S.init(NTOK, 1024, F.G, (int)blockIdx.x);
          EpiPlain E{(bf16*)(F.dob + DO_KN), (bf16*)(F.ws + WS_VC), 512, 512, 512}; gemm_phase_any(F.lds, g, S, E, F.wave); }
    ); SEAM(4);
    PH(5, p_prep_c(F, AP);); SEAM(5);
#if ENG_ATTN == 1
    PH(6, p_attn_mfma(F, AP->in[I_QN]);); SEAM(6);
#else
    PH(6, p_attn_naive(F);); SEAM(6);
#endif
    PH(7, p_cs_a(F, AP);); SEAM(7);
    PH(8, p_cs_b(F);); SEAM(8);
    PH(9, p_cs_c(F, AP);); SEAM(9);
    PH(10, Gemm g{(const bf16*)(F.ws + WS_Y), (const bf16*)(F.ws + WS_WB), NTOK, 1024, 1024}; StaticOrder S; S.init(NTOK, 1024, F.G, (int)blockIdx.x);
        EpiBranch2 E{(bf16*)(F.ws + WS_MG), (const bf16*)(F.ws + WS_SG)}; gemm_phase_mid(F.lds, g, S, E, F.wave);); SEAM(10);
    PH(11, Gemm g{(const bf16*)(F.ws + WS_MG), (const bf16*)(F.ws + WS_WO), NTOK, 1024, 1024}; StaticOrder S; S.init(NTOK, 1024, F.G, (int)blockIdx.x);
        EpiPlain E{(bf16*)(F.ws + WS_MO), nullptr, 1 << 30, 1024, 0}; gemm_phase_any(F.lds, g, S, E, F.wave);); SEAM(11);
    if constexpr (PROBE_REPEAT == 12) { p_ffn_route(F, AP, (unsigned*)(F.ws + WS_CTL) + CW_CNT + 64, (int*)(F.ws + WS_CS)); GRID_BAR(); }
    if constexpr (IN(12)) { asm volatile("" : "+s"(AP)); p_ffn_route(F, AP, (unsigned*)(F.ws + WS_CTL) + CW_CNT, (int*)(F.ws + WS_ROUTE)); } SEAM(12);
    PH(13, p_gather(F);); SEAM(13);
    PH(14, LAS int* offs = (LAS int*)(F.lds + LDS_MISC + 1024); LAS int* texp = (LAS int*)(F.lds + LDS_MISC + 1024 + 256); const int nt = moe_tables(F, offs, texp);
        Gemm g{(const bf16*)(F.ws + WS_H2), (const bf16*)(F.ws + WS_WGU), MPAD, 512, 1024, (const int*)(F.ws + WS_ENT)}; TableOrder S{texp, nt, 2, F.G, (int)blockIdx.x};
        EpiGateUp E{(bf16*)(F.ws + WS_HID)}; gemm_phase_gather(F.lds, g, S, E, F.wave);); SEAM(14);
    PH(15, LAS int* offs = (LAS int*)(F.lds + LDS_MISC + 1024); LAS int* texp = (LAS int*)(F.lds + LDS_MISC + 1024 + 256); const int nt = moe_tables(F, offs, texp);
        Gemm g{(const bf16*)(F.ws + WS_HID), (const bf16*)(F.ws + WS_WDN), MPAD, 1024, 256}; TableOrder S{texp, nt, 4, F.G, (int)blockIdx.x};
        EpiDown E{(bf16*)(F.ws + WS_YS)}; gemm_phase_any(F.lds, g, S, E, F.wave);); SEAM(15);
    if constexpr (PROBE_REPEAT == 16) { asm volatile("" : "+s"(AP)); p_combine(F, AP->in[I_X], (float*)(F.ws + WS_SG)); GRID_BAR(); }
    if constexpr (IN(16)) { asm volatile("" : "+s"(AP)); p_combine(F, AP->in[I_X], (float*)F.dob); }
}

#if N_LAUNCH_MODE == 1
static bool set_attrs() { return hipFuncSetAttribute((const void*)fwd<0, NPHASE>, hipFuncAttributeMaxDynamicSharedMemorySize, LDS_BYTES) == hipSuccess; }
#else
template <int P> static bool set_attr_all() { if constexpr (P < NPHASE) { return hipFuncSetAttribute((const void*)fwd<P, P + 1>, hipFuncAttributeMaxDynamicSharedMemorySize, LDS_BYTES) == hipSuccess && set_attr_all<P + 1>(); } else return true; }
static bool set_attrs() { return set_attr_all<0>(); }
template <int P> static void launch_all(int grid, hipStream_t stream, const Args& a) { if constexpr (P < NPHASE) { hipLaunchKernelGGL((fwd<P, P + 1>), dim3(grid), dim3(NTHR), LDS_BYTES, stream, a); launch_all<P + 1>(grid, stream, a); } }
#endif
extern "C" void kernel_launch(void* const* d_in, const int* in_sizes, int n_in, void* d_out, int out_size, void* d_ws, size_t ws_size, hipStream_t stream) {
    static int grid = 0;
    if (grid == 0) {
        if (n_in != 34 || out_size != NTOK * DM || ws_size < WS_END) { fprintf(stderr, "kernel_launch: unexpected shapes (n_in %d out %d ws %zu)\n", n_in, out_size, ws_size); grid = -1; return; }
        int dev = 0, cus = 0;
        if (hipGetDevice(&dev) != hipSuccess || hipDeviceGetAttribute(&cus, hipDeviceAttributeMultiprocessorCount, dev) != hipSuccess) { grid = -1; return; }
        if (!set_attrs()) { fprintf(stderr, "kernel_launch: hipFuncSetAttribute failed\n"); grid = -1; return; }
        grid = cus;
    }
    if (grid < 0) return;
    (void)hipMemsetAsync((char*)d_ws + WS_CTL, 0, CTL_ZERO_BYTES, stream);
    Args a{};
    for (int i = 0; i < 34; ++i) a.in[i] = (const float*)d_in[i];
    a.out = (float*)d_out; a.ws = (unsigned char*)d_ws;
    a.ph_lo = 0; a.ph_hi = NPHASE;
#if N_LAUNCH_MODE == 1
    hipLaunchKernelGGL((fwd<0, NPHASE>), dim3(grid), dim3(NTHR), LDS_BYTES, stream, a);
#else
    launch_all<0>(grid, stream, a);
#endif
}
```

```cpp
#include <hip/hip_runtime.h>
#include <cstdio>
#include <cstdint>

#ifndef N_LAUNCH_MODE
#define N_LAUNCH_MODE 1
#endif
#ifndef ENG_GEMM
#define ENG_GEMM 1
#endif
#ifndef ENG_ATTN
#define ENG_ATTN 1
#endif

#define GAS __attribute__((address_space(1)))
#define LAS __attribute__((address_space(3)))
typedef unsigned short bf16;
typedef float f32x4 __attribute__((ext_vector_type(4)));
typedef float f32x2 __attribute__((ext_vector_type(2)));
typedef unsigned u32x4 __attribute__((ext_vector_type(4)));
typedef unsigned u32x2 __attribute__((ext_vector_type(2)));
typedef short bf16x8 __attribute__((ext_vector_type(8)));

constexpr int BATCH = 8, SEQ = 8192, DM = 1024, NTOK = BATCH * SEQ;
constexpr int D_RWKV = 512, RWKV_COLS = 1792, MLA_COLS = 416, D_IN = 4256, N_IN_PAD = 4352;
constexpr int NH = 8, QKD = 96, NOPE = 64, ROPE = 32, VD = 64;
constexpr int NEXP = 32, DEXP = 256;
constexpr int MPAD = 139264;
constexpr float EPS = 1e-6f, LN_X_EPS = 64e-5f;
constexpr float QSCALE = 0.10206207261596577f * 1.4426950408889634f;

constexpr size_t MiB = 1u << 20;
constexpr size_t WS_CTL = 0, CTL_ZERO_BYTES = 1 * MiB;
constexpr size_t WS_MOD = 1 * MiB;
constexpr size_t WS_ROUTE = 2 * MiB;
constexpr size_t WS_CS = 4 * MiB;
constexpr size_t WS_ENT = 12 * MiB;
constexpr size_t WS_WIN = 16 * MiB;
constexpr size_t WS_WBLK = 25 * MiB;
constexpr size_t WS_WG = WS_WBLK + 256 * 1024;
constexpr size_t WS_WUQ = WS_WG + 128 * 1024;
constexpr size_t WS_WUKV = WS_WUQ + 384 * 1024;
constexpr size_t WS_WB = 26 * MiB;
constexpr size_t WS_WO = 28 * MiB;
constexpr size_t WS_WGU = 30 * MiB;
constexpr size_t WS_WDN = 62 * MiB;
constexpr size_t WS_SG = 80 * MiB;
constexpr size_t WS_H2 = 80 * MiB;
constexpr size_t WS_ZR = 336 * MiB;
constexpr size_t WS_VC = 816 * MiB;
constexpr size_t WS_KC = 880 * MiB;
constexpr size_t WS_Y = 560 * MiB;
constexpr size_t WS_XG = 336 * MiB;
constexpr size_t WS_ZM = 560 * MiB;
constexpr size_t WS_YM = 560 * MiB + 1024;
constexpr size_t WS_H = 688 * MiB;
constexpr size_t WS_LW = 688 * MiB;
constexpr size_t WS_A = 752 * MiB;
constexpr size_t WS_MG = 688 * MiB;
constexpr size_t WS_HID = 208 * MiB;
constexpr size_t WS_R = 752 * MiB;
constexpr size_t WS_V = 816 * MiB;
constexpr size_t WS_ZK = 880 * MiB;
constexpr size_t WS_TWA = 944 * MiB;
constexpr size_t WS_SGL = 960 * MiB;
constexpr size_t WS_QA = 976 * MiB;
constexpr size_t WS_KVA = 1008 * MiB;
constexpr size_t WS_KK = 944 * MiB;
constexpr size_t WS_YS = 752 * MiB;
constexpr size_t WS_MO = 560 * MiB;
constexpr int YYLD = 1024;
constexpr size_t WS_END = 1024 * MiB;
constexpr size_t DO_G = 0;
constexpr size_t DO_Q = 64 * MiB;
constexpr size_t DO_KN = 160 * MiB;

constexpr int CW_CNT = 64;
constexpr int CW_BAR = 4096;

constexpr int NWAVES = 8, NTHR = 512;
constexpr int LDS_BYTES = 155648;
constexpr int LDS_MISC = 151552;

__device__ __forceinline__ int lane_id_fresh() { int l; asm volatile("v_mbcnt_lo_u32_b32 %0, -1, 0\n\tv_mbcnt_hi_u32_b32 %0, -1, %0" : "=v"(l)); return l; }
__device__ __forceinline__ float bf2f(unsigned short h) { return __builtin_bit_cast(float, (unsigned)h << 16); }
__device__ __forceinline__ unsigned f2bf(float f) { unsigned u = __builtin_bit_cast(unsigned, f); return (u + 0x7fffu + ((u >> 16) & 1u)) >> 16; }
typedef __bf16 bf16x2_t __attribute__((ext_vector_type(2)));
__device__ __forceinline__ unsigned pk2(float lo, float hi) { const f32x2 v = {lo, hi}; return __builtin_bit_cast(unsigned, __builtin_convertvector(v, bf16x2_t)); }
__device__ __forceinline__ float lo2f(unsigned w) { return __builtin_bit_cast(float, w << 16); }
__device__ __forceinline__ float hi2f(unsigned w) { return __builtin_bit_cast(float, w & 0xffff0000u); }
template <int CTRL> __device__ __forceinline__ float dpp_add(float x) { return x + __builtin_bit_cast(float, __builtin_amdgcn_update_dpp(0, __builtin_bit_cast(int, x), CTRL, 0xf, 0xf, false)); }
__device__ __forceinline__ float allsum16(float x) { x = dpp_add<0xB1>(x); x = dpp_add<0x4E>(x); x = dpp_add<0x141>(x); x = dpp_add<0x140>(x); return x; }
__device__ __forceinline__ float allsum32(float x) { x = allsum16(x); auto r = __builtin_amdgcn_permlane16_swap(__float_as_uint(x), __float_as_uint(x), false, false); return __uint_as_float(r[0]) + __uint_as_float(r[1]); }
__device__ __forceinline__ float sum8(float x) { x = dpp_add<0xB1>(x); x = dpp_add<0x4E>(x); x = dpp_add<0x141>(x); return x; }
__device__ __forceinline__ float wave_sum(float v) {
    v = allsum16(v);
    { auto r = __builtin_amdgcn_permlane16_swap(__float_as_uint(v), __float_as_uint(v), false, false); v = __uint_as_float(r[0]) + __uint_as_float(r[1]); }
    { auto r = __builtin_amdgcn_permlane32_swap(__float_as_uint(v), __float_as_uint(v), false, false); v = __uint_as_float(r[0]) + __uint_as_float(r[1]); }
    return v;
}
__device__ __forceinline__ float sigmoidf_(float x) { return __builtin_amdgcn_rcpf(1.f + __builtin_amdgcn_exp2f(-1.4426950408889634f * x)); }
__device__ __forceinline__ float tanhf_(float x) { return 1.0f - 2.0f * __builtin_amdgcn_rcpf(1.f + __builtin_amdgcn_exp2f(2.8853900817779268f * x)); }
__device__ __forceinline__ float siluf_(float x) { return x * __builtin_amdgcn_rcpf(1.f + __builtin_amdgcn_exp2f(-1.4426950408889634f * x)); }
__device__ __forceinline__ void unpack8(const u32x4 w, float (&v)[8]) {
    v[0] = lo2f(w.x); v[1] = hi2f(w.x); v[2] = lo2f(w.y); v[3] = hi2f(w.y); v[4] = lo2f(w.z); v[5] = hi2f(w.z); v[6] = lo2f(w.w); v[7] = hi2f(w.w);
}
__device__ __forceinline__ u32x4 pack8(const float (&v)[8]) { u32x4 w; w.x = pk2(v[0], v[1]); w.y = pk2(v[2], v[3]); w.z = pk2(v[4], v[5]); w.w = pk2(v[6], v[7]); return w; }

#define LDS_BAR() do { asm volatile("s_waitcnt lgkmcnt(0)" ::: "memory"); __builtin_amdgcn_s_barrier(); asm volatile("" ::: "memory"); } while (0)

#define XB_TMO      128
#define XB_XCNT(j)  (256  + 64 * (j))
#define XB_XSUB(j)  (1280 + 64 * (j))
#define XB_XGEN(j)  (2304 + 64 * (j))
#define XB_TOP      3328
#define XB_TOPGEN   3392
#define XCD_BAR_WORDS 3456
#define XB_SPIN_CAP (1u << 19)
__device__ __forceinline__ unsigned xb_ld(unsigned* p)              { return __hip_atomic_load(p, __ATOMIC_RELAXED, __HIP_MEMORY_SCOPE_AGENT); }
__device__ __forceinline__ unsigned xb_add(unsigned* p, unsigned v) { return __hip_atomic_fetch_add(p, v, __ATOMIC_RELAXED, __HIP_MEMORY_SCOPE_AGENT); }
__device__ __forceinline__ unsigned xb_xcc_id() { return (unsigned)__builtin_amdgcn_s_getreg((3 << 11) | 20) & 0xFu; }
#define XB_SPIN(cond, bar) do { unsigned _sp = 0; while (cond) { __builtin_amdgcn_s_sleep(1); \
    if ((++_sp & 255u) == 0u) { if (xb_ld(&(bar)[XB_TMO])) break; if (_sp > XB_SPIN_CAP) { atomicAdd(&(bar)[XB_TMO], 1u); break; } } } } while (0)
struct XcdBarrier { unsigned* bar; unsigned x; volatile LAS unsigned* st; };
__device__ __forceinline__ XcdBarrier xcd_barrier_post(unsigned* bar, volatile LAS unsigned* st) {
    XcdBarrier b; b.bar = bar; b.x = xb_xcc_id(); b.st = st;
    if (threadIdx.x == 0) (void)xb_add(&bar[XB_XCNT(b.x)], 1u);
    return b;
}
__device__ __forceinline__ void xcd_barrier_complete(unsigned* bar, unsigned x, unsigned& nloc, unsigned& nx) {
    const unsigned G = gridDim.x * gridDim.y * gridDim.z;
    unsigned sum, cnt, mine, sp = 0u;
    for (;;) {
        sum = 0u; cnt = 0u; mine = 0u;
#pragma unroll
        for (unsigned j = 0; j < 16; ++j) { const unsigned c = xb_ld(&bar[XB_XCNT(j)]); sum += c; cnt += (c > 0u) ? 1u : 0u; mine = (j == x) ? c : mine; }
        if (sum == G) break;
        __builtin_amdgcn_s_sleep(1);
        if ((++sp & 255u) == 0u) { if (xb_ld(&bar[XB_TMO])) break; if (sp > XB_SPIN_CAP) { atomicAdd(&bar[XB_TMO], 1u); break; } }
    }
    nloc = mine > 0u ? mine : 1u; nx = cnt > 0u ? cnt : 1u;
}
__device__ __forceinline__ void xcd_barrier(const XcdBarrier& b) {
    asm volatile("s_waitcnt vmcnt(0)" ::: "memory");
    __syncthreads();
    if (threadIdx.x == 0) {
        unsigned* bar = b.bar;
        __builtin_amdgcn_s_waitcnt(0);
        unsigned nloc = b.st[0], nx = b.st[1];
        if (nloc == 0u) { xcd_barrier_complete(bar, b.x, nloc, nx); b.st[0] = nloc; b.st[1] = nx; }
        const unsigned old = xb_add(&bar[XB_XSUB(b.x)], 1u);
        const unsigned gen = old / nloc;
        if (old + 1u == (gen + 1u) * nloc) {
            __builtin_amdgcn_fence(__ATOMIC_RELEASE, "agent");
            asm volatile("s_waitcnt vmcnt(0)" ::: "memory");
            const unsigned og = xb_add(&bar[XB_TOP], 1u);
            const unsigned tg = og / nx;
            if (og + 1u == (tg + 1u) * nx) xb_add(&bar[XB_TOPGEN], 1u);
            else XB_SPIN(xb_ld(&bar[XB_TOPGEN]) == tg, bar);
            __builtin_amdgcn_fence(__ATOMIC_ACQUIRE, "agent");
            xb_add(&bar[XB_XGEN(b.x)], 1u);
            asm volatile("s_waitcnt vmcnt(0)" ::: "memory");
        } else {
            XB_SPIN(xb_ld(&bar[XB_XGEN(b.x)]) == gen, bar);
            __builtin_amdgcn_fence(__ATOMIC_ACQUIRE, "agent");
            asm volatile("s_waitcnt vmcnt(0)" ::: "memory");
        }
    }
    __syncthreads();
}

struct Args {
    const float* in[34]; float* out; unsigned char* ws; int ph_lo, ph_hi;
};
typedef const __attribute__((address_space(4))) Args* ArgsP;
struct Frame {
    LAS unsigned char* lds;
    int wave, vcu, G, gw, NGW;
    unsigned char* ws; unsigned char* dob;
};
enum { I_X = 0, I_C, I_POS, I_WADA, I_BADA, I_GMIX, I_WIN, I_MU, I_W0, I_WDEC, I_A0, I_WAUP, I_WGUP, I_KK, I_KA, I_RK, I_LNW, I_LNB, I_GQA, I_WUQ, I_GKVA, I_WUKV,
       I_QN, I_KN, I_WBR, I_WOUT, I_GFFN, I_WRG, I_BRG, I_WRE, I_BRE, I_WEG, I_WEU, I_WED };

struct Unit { int pm, pn; };
struct Gemm { const bf16* A; const bf16* Bt; int M, N, K; const int* ridx = nullptr; };
constexpr int NXCD = 8, WGM = 8;
struct StaticOrder {
    int nM, nN, nwg, G, c;
    __device__ void init(int M, int N, int G_, int c_) { nM = M / 256; nN = N / 256; nwg = nM * nN; G = G_; c = c_; }
    __device__ bool next(int i, Unit& u) const {
        const long L = (long)i * G + c; if (L >= nwg) return false;
        int wgid = (int)L; { const int q = nwg / NXCD, r = nwg % NXCD, xcd = wgid % NXCD, off = wgid / NXCD; wgid = (xcd < r ? xcd * (q + 1) : r * (q + 1) + (xcd - r) * q) + off; }
        const int nig = WGM * nN, gid = wgid / nig, fm = gid * WGM, gsz = (nM - fm) < WGM ? (nM - fm) : WGM;
        u.pm = fm + ((wgid % nig) % gsz); u.pn = (wgid % nig) / gsz; return true;
    }
    __device__ __forceinline__ void a_ready(const Unit&) const {}
    __device__ __forceinline__ void done(const Unit&) const {}
};
struct TableOrder {
    const LAS int* texp; int ntiles, nN, G, c;
    __device__ bool next(int i, Unit& u) const {
        const long L = (long)i * G + c; if (L >= (long)ntiles * nN) return false;
        const int t = (int)(L / nN), j = (int)(L % nN); u.pm = t; u.pn = texp[t] * nN + j; return true;
    }
    __device__ __forceinline__ void a_ready(const Unit&) const {}
    __device__ __forceinline__ void done(const Unit&) const {}
};

template <class Epi, class Sched>
__device__ __forceinline__ void gemm_phase_naive(LAS unsigned char* lds, const Gemm g, const Sched& S, const Epi& E) {
    const int tid = (int)__builtin_amdgcn_readfirstlane((int)threadIdx.x >> 6) * 64 + lane_id_fresh(), ty = tid >> 5, tx = tid & 31;
    LAS bf16* As = (LAS bf16*)lds; LAS bf16* Bs = (LAS bf16*)(lds + 128 * 40 * 2);
    Unit u;
    for (int i = 0; S.next(i, u); ++i) {
        for (int half = 0; half < 2; ++half) {
            float acc[8][8];
#pragma unroll
            for (int r = 0; r < 8; ++r)
#pragma unroll
                for (int c = 0; c < 8; ++c) acc[r][c] = 0.f;
            const bf16* Ab = g.A + ((size_t)u.pm * 256 + half * 128) * g.K; const bf16* Bb = g.Bt + (size_t)u.pn * 256 * g.K;
            for (int k0 = 0; k0 < g.K; k0 += 32) {
                __syncthreads();
                { const int r = tid >> 2, c8 = (tid & 3) * 8; *(LAS u32x4*)(As + r * 40 + c8) = *(const u32x4*)(Ab + (size_t)r * g.K + k0 + c8); }
#pragma unroll
                for (int j = 0; j < 2; ++j) { const int ch = tid + j * 512, r = ch >> 2, c8 = (ch & 3) * 8; *(LAS u32x4*)(Bs + r * 40 + c8) = *(const u32x4*)(Bb + (size_t)r * g.K + k0 + c8); }
                __syncthreads();
#pragma unroll 2
                for (int k = 0; k < 32; k += 2) {
                    float b0[8], b1[8];
#pragma unroll
                    for (int c = 0; c < 8; ++c) { const unsigned w = *(const LAS unsigned*)(Bs + (tx * 8 + c) * 40 + k); b0[c] = lo2f(w); b1[c] = hi2f(w); }
#pragma unroll
                    for (int r = 0; r < 8; ++r) { const unsigned w = *(const LAS unsigned*)(As + (ty * 8 + r) * 40 + k); const float a0 = lo2f(w), a1 = hi2f(w);
#pragma unroll
                        for (int c = 0; c < 8; ++c) acc[r][c] = fmaf(a1, b1[c], fmaf(a0, b0[c], acc[r][c])); }
                }
            }
#pragma unroll
            for (int r = 0; r < 8; ++r) E.store8(u, half * 128 + ty * 8 + r, tx * 8, acc[r]);
        }
    }
    __syncthreads();
}

struct EpiZ { bf16 *ZR, *SG, *ZM;
    __device__ __forceinline__ void store8(const Unit& u, int r, int c, const float (&v)[8]) const {
        const size_t row = (size_t)u.pm * 256 + r;
        if (u.pn < 7) { *(u32x4*)(ZR + row * 1792 + u.pn * 256 + c) = pack8(v); }
        else if (u.pn < 15) { *(u32x4*)(SG + row * 2048 + (u.pn - 7) * 256 + c) = pack8(v); }
        else { *(u32x4*)(ZM + row * 512 + (u.pn - 15) * 256 + c) = pack8(v); }
    } };
struct EpiLora { bf16 *LW, *A; const float *w0, *a0;
    __device__ __forceinline__ void store8(const Unit& u, int r, int c, const float (&v)[8]) const {
        const size_t row = (size_t)u.pm * 256 + r; const int col = u.pn * 256 + c; float o[8];
        const bool isw = col < 512; const float* bp = isw ? (w0 + col) : (a0 + col - 512);
        const f32x4 b0 = *(const f32x4*)bp, b1 = *(const f32x4*)(bp + 4); const float bb[8] = {b0.x, b0.y, b0.z, b0.w, b1.x, b1.y, b1.z, b1.w};
#pragma unroll
        for (int i = 0; i < 8; ++i) { const float e = __builtin_amdgcn_exp2f(fminf(-1.4426950408889634f * (bb[i] + v[i]), 120.f)); const float s = __builtin_amdgcn_rcpf(1.0f + e); o[i] = isw ? -0.60653065971263342f * s : s; }
        bf16* dst = isw ? (LW + row * 512 + col) : (A + row * 512 + col - 512);
        *(u32x4*)dst = pack8(o);
    } };
struct EpiPlain { bf16* O0; bf16* O1; int split, ld0, ld1;
    __device__ __forceinline__ void store8(const Unit& u, int r, int c, const float (&v)[8]) const {
        const size_t row = (size_t)u.pm * 256 + r; int col = u.pn * 256 + c;
        if (col < split) *(u32x4*)(O0 + row * ld0 + col) = pack8(v); else *(u32x4*)(O1 + row * ld1 + col - split) = pack8(v);
    } };
struct EpiBranch2 { bf16* MG; const bf16* SG;
    __device__ __forceinline__ void mid8(const Unit& u, int r, int c, float (&v)[8]) const {
        const size_t row = (size_t)u.pm * 256 + r; const int col = u.pn * 256 + c; float gr[8], gm[8];
        unpack8(*(const u32x4*)(SG + row * 2048 + col), gr); unpack8(*(const u32x4*)(SG + row * 2048 + 1024 + col), gm);
#pragma unroll
        for (int i = 0; i < 8; ++i) v[i] *= (1.f + __builtin_amdgcn_exp2f(-1.4426950408889634f * fmaxf(gm[i], -30.f))) * __builtin_amdgcn_rcpf(1.f + __builtin_amdgcn_exp2f(-1.4426950408889634f * gr[i]));
    }
    __device__ __forceinline__ void store8(const Unit& u, int r, int c, const float (&v)[8]) const {
        const size_t row = (size_t)u.pm * 256 + r; const int col = u.pn * 256 + c; float gm[8], o[8];
        unpack8(*(const u32x4*)(SG + row * 2048 + 1024 + col), gm);
#pragma unroll
        for (int i = 0; i < 8; ++i) o[i] = sigmoidf_(fmaxf(gm[i], -30.f)) * v[i];
        *(u32x4*)(MG + row * 1024 + col) = pack8(o);
    } };
struct EpiGateUp { bf16* HID;
    __device__ __forceinline__ void store8(const Unit& u, int r, int c, const float (&v)[8]) const {
        const size_t row = (size_t)u.pm * 256 + r; const int col = ((u.pn & 1) * 256 + c) >> 1;
        u32x2 w; w.x = pk2(siluf_(v[0]) * v[4], siluf_(v[1]) * v[5]); w.y = pk2(siluf_(v[2]) * v[6], siluf_(v[3]) * v[7]);
        *(u32x2*)(HID + row * 256 + col) = w;
    } };
struct EpiDown { bf16* YS;
    __device__ __forceinline__ void store8(const Unit& u, int r, int c, const float (&v)[8]) const {
        const size_t row = (size_t)u.pm * 256 + r; *(u32x4*)(YS + row * 1024 + (u.pn & 3) * 256 + c) = pack8(v);
    } };


namespace pg8 {
#define PG8_LAS __attribute__((address_space(3)))
typedef ::bf16x8 bf16x8; typedef ::f32x4 f32x4;
using ::Unit; using ::Gemm;
constexpr int BM = 256, BK = 64, HALF = 128, HTB = HALF * BK * 2  , STAGE_BYTES = 8 * HTB;

__device__ __forceinline__ int lds_byte(int r, int c) { const int st = (r >> 4) * 2 + (c >> 5), rr = r & 15, cc = c & 31, ob = rr * 64 + cc * 2; return st * 1024 + (ob ^ (((ob >> 9) & 1) << 5)); }
__device__ __forceinline__ void stage_rc(int b, int& R, int& C) { const int st = b / 1024, sb = b % 1024, swz = sb ^ (((sb >> 9) & 1) << 5); R = (st >> 1) * 16 + swz / 64; C = (st & 1) * 32 + (swz % 64) / 2; }
__device__ __forceinline__ int perm32(int rho) { const int n = rho >> 4, i = rho & 15; return 8 * (i >> 2) + 4 * n + (i & 3); }
template <class Epi, class Sched, bool ALIGN_EPI = false, bool SP2 = false, bool GATHER = false, bool MIDHOOK = false>
__device__ __forceinline__ void gemm_phase(PG8_LAS unsigned char* lds, const Gemm g, const Sched& S, const Epi& E, const int wave_in) {
    const int lane = lane_id_fresh(), wid = wave_in, tid = wid * 64 + lane,
              wr = wid >> 2, wc = wid & 3, fr = lane & 15, fq = lane >> 4;
    const int K = g.K, nt = K / BK;
    unsigned voffA[2], voffB[2];
#pragma unroll
    for (int i = 0; i < 2; ++i) { int R, C; stage_rc(tid * 16 + i * 8192, R, C); const int Rb = Epi::PERM ? ((R & ~31) + perm32(R & 31)) : R;
        voffA[i] = (unsigned)(R * K + C) * 2u; voffB[i] = (unsigned)(Rb * K + C) * 2u; }
    unsigned vAc[2][2] = {{0u, 0u}, {0u, 0u}}, vAn[2][2] = {{0u, 0u}, {0u, 0u}}; int gR[2] = {0, 0}; unsigned gC[2] = {0u, 0u};
    if constexpr (GATHER) {
#pragma unroll
        for (int i = 0; i < 2; ++i) { int R, C; stage_rc(tid * 16 + i * 8192, R, C); gR[i] = R; gC[i] = (unsigned)C * 2u; } }
#define PG8_GIDX(dst, pm_) do { _Pragma("unroll") for (int _h = 0; _h < 2; ++_h) _Pragma("unroll") for (int _i = 0; _i < 2; ++_i) \
        dst[_h][_i] = (unsigned)g.ridx[(pm_) * BM + _h * HALF + gR[_i]] * (unsigned)(K * 2) + gC[_i]; } while (0)
    const size_t kstep = (size_t)(BK * 2);
    const size_t hstep = (size_t)HALF * K * 2;
    const size_t tstep = 2 * hstep;
    const unsigned ldsw = (unsigned)wid * 1024u;
    const int aoff = lds_byte(wr * 64 + fr, fq * 8), boff = lds_byte(wc * 32 + fr, fq * 8);
#define PG8_SA(b, h) (((b) * 2 + (h)) * HTB)
#define PG8_SB(b, h) ((4 + (b) * 2 + (h)) * HTB)
#define PG8_STAGE(bufoff, gbase, voff) do { _Pragma("unroll") for (int _i = 0; _i < 2; ++_i) \
        __builtin_amdgcn_global_load_lds((const unsigned*)((const char*)(gbase) + (voff)[_i]), (PG8_LAS unsigned*)(lds + (bufoff) + ldsw + _i * 8192), 16, 0, 0); } while (0)
#define PG8_STAGE_A(bufoff, kptr, h, isnext) do { if constexpr (GATHER) { unsigned _v[2]; _v[0] = (isnext) ? vAn[h][0] : vAc[h][0]; _v[1] = (isnext) ? vAn[h][1] : vAc[h][1]; PG8_STAGE(bufoff, kptr, _v); } \
        else { PG8_STAGE(bufoff, (kptr) + (h) * hstep, voffA); } } while (0)
#define PG8_LDA(dst, b, h) do { _Pragma("unroll") for (int m = 0; m < 4; ++m) _Pragma("unroll") for (int k = 0; k < 2; ++k) dst[m][k] = *(const PG8_LAS bf16x8*)(lds + PG8_SA(b, h) + aoff + m * 2048 + k * 1024); } while (0)
#define PG8_LDB(dst, b, h) do { _Pragma("unroll") for (int n = 0; n < 2; ++n) _Pragma("unroll") for (int k = 0; k < 2; ++k) dst[n][k] = *(const PG8_LAS bf16x8*)(lds + PG8_SB(b, h) + boff + n * 2048 + k * 1024); } while (0)
#define PG8_MMA(ai, bj, At, Bt) do { __builtin_amdgcn_s_setprio(1); _Pragma("unroll") for (int m = 0; m < 4; ++m) _Pragma("unroll") for (int n = 0; n < 2; ++n) _Pragma("unroll") for (int k = 0; k < 2; ++k) \
        acc[ai][bj][m][n] = __builtin_amdgcn_mfma_f32_16x16x32_bf16(Bt[n][k], At[m][k], acc[ai][bj][m][n], 0, 0, 0); __builtin_amdgcn_s_setprio(0); } while (0)
#define PG8_WAIT_V(n) asm volatile("s_waitcnt vmcnt(" #n ")" ::: "memory")
#define PG8_WAIT_L(n) asm volatile("s_waitcnt lgkmcnt(" #n ")" ::: "memory")
#define PG8_BAR __builtin_amdgcn_s_barrier()
#define PG8_SCHED __builtin_amdgcn_sched_barrier(0)
    Unit cur, nxt; int ui = 0;
    if (!S.next(0, cur)) return;
    f32x4 acc[2][2][4][2];
#pragma unroll
    for (int a = 0; a < 2; ++a)
#pragma unroll
        for (int b = 0; b < 2; ++b)
#pragma unroll
            for (int m = 0; m < 4; ++m)
#pragma unroll
                for (int n = 0; n < 2; ++n) acc[a][b][m][n] = (f32x4){0.f, 0.f, 0.f, 0.f};
    bf16x8 At[4][2], B0[2][2], B1[2][2];
    const char* cA = (const char*)g.A + (GATHER ? (size_t)0 : (size_t)cur.pm * tstep); const char* cB = (const char*)g.Bt + (size_t)cur.pn * tstep;
    if constexpr (GATHER) PG8_GIDX(vAc, cur.pm);
    S.a_ready(cur);
    if constexpr (SP2) {
        PG8_STAGE(PG8_SB(0, 0), cB, voffB); PG8_STAGE(PG8_SB(0, 1), cB + hstep, voffB); PG8_STAGE_A(PG8_SA(0, 0), cA, 0, false); PG8_STAGE_A(PG8_SA(0, 1), cA, 1, false);
        if (wr == 1) PG8_BAR;
        PG8_WAIT_V(2); PG8_BAR;
        PG8_STAGE(PG8_SB(1, 0), cB + kstep, voffB); PG8_STAGE_A(PG8_SA(1, 0), cA + kstep, 0, false); PG8_STAGE(PG8_SB(1, 1), cB + hstep + kstep, voffB);
        PG8_WAIT_V(6); PG8_BAR;
    } else {
        PG8_STAGE(PG8_SB(0, 0), cB, voffB); PG8_STAGE(PG8_SA(0, 0), cA, voffA); PG8_STAGE(PG8_SB(0, 1), cB + hstep, voffB); PG8_STAGE(PG8_SA(0, 1), cA + hstep, voffA);
        if (wr == 1) PG8_BAR;
        PG8_WAIT_V(4); PG8_BAR;
        PG8_STAGE(PG8_SB(1, 0), cB + kstep, voffB); PG8_STAGE(PG8_SA(1, 0), cA + kstep, voffA); PG8_STAGE(PG8_SB(1, 1), cB + hstep + kstep, voffB);
        PG8_WAIT_V(6); PG8_BAR;
    }
    for (;;) {
        const bool has_next = S.next(ui + 1, nxt);
        const char* nA = (has_next && !GATHER) ? (const char*)g.A + (size_t)nxt.pm * tstep : cA; const char* nB = has_next ? (const char*)g.Bt + (size_t)nxt.pn * tstep : cB;
        if constexpr (GATHER) { if (has_next) PG8_GIDX(vAn, nxt.pm); else { _Pragma("unroll") for (int _h = 0; _h < 2; ++_h) { vAn[_h][0] = vAc[_h][0]; vAn[_h][1] = vAc[_h][1]; } } }
        for (int t = 0; t < nt; t += 2) {
            if constexpr (MIDHOOK) { if (t == nt / 2) { E.mid(acc, cur, wr, wc, fr, fq); PG8_WAIT_V(0); } }
            const bool last = (t == nt - 2);
            const char* a1 = cA + (size_t)(t + 1) * kstep;
            const char* a2 = last ? nA : cA + (size_t)(t + 2) * kstep; const char* b2 = last ? nB : cB + (size_t)(t + 2) * kstep;
            const char* a3 = a2 + kstep; const char* b3 = b2 + kstep;
            if (last && has_next) S.a_ready(nxt);
            if constexpr (SP2) {
            PG8_LDB(B0, 0, 0); PG8_LDB(B1, 0, 1); PG8_SCHED; PG8_LDA(At, 0, 0); PG8_STAGE_A(PG8_SA(1, 1), a1, 1, false);
            PG8_WAIT_V(8); PG8_WAIT_L(0); PG8_BAR; PG8_MMA(0, 0, At, B0); PG8_MMA(0, 1, At, B1); PG8_BAR; PG8_SCHED;
            PG8_LDA(At, 0, 1); PG8_STAGE(PG8_SB(0, 0), b2, voffB); PG8_STAGE(PG8_SB(0, 1), b2 + hstep, voffB); PG8_STAGE_A(PG8_SA(0, 0), a2, 0, last);
            PG8_WAIT_V(8); PG8_WAIT_L(0); PG8_BAR; PG8_MMA(1, 0, At, B0); PG8_MMA(1, 1, At, B1); PG8_BAR; PG8_SCHED;
            PG8_LDB(B0, 1, 0); PG8_LDB(B1, 1, 1); PG8_SCHED; PG8_LDA(At, 1, 0); PG8_STAGE_A(PG8_SA(0, 1), a2, 1, last);
            PG8_WAIT_V(8); PG8_WAIT_L(0); PG8_BAR; PG8_MMA(0, 0, At, B0); PG8_MMA(0, 1, At, B1); PG8_BAR; PG8_SCHED;
            PG8_LDA(At, 1, 1); PG8_STAGE(PG8_SB(1, 0), b3, voffB); PG8_STAGE(PG8_SB(1, 1), b3 + hstep, voffB); PG8_STAGE_A(PG8_SA(1, 0), a3, 0, last);
            PG8_WAIT_V(8); PG8_WAIT_L(0); PG8_BAR; PG8_MMA(1, 0, At, B0); PG8_MMA(1, 1, At, B1); PG8_BAR; PG8_SCHED;
            } else {
            PG8_LDB(B0, 0, 0); PG8_SCHED; PG8_LDA(At, 0, 0); PG8_STAGE(PG8_SA(1, 1), a1 + hstep, voffA);
            PG8_WAIT_L(8); PG8_BAR; PG8_WAIT_L(0); PG8_MMA(0, 0, At, B0); PG8_BAR; PG8_SCHED;
            PG8_LDB(B1, 0, 1); PG8_STAGE(PG8_SB(0, 0), b2, voffB);
            PG8_BAR; PG8_WAIT_L(0); PG8_MMA(0, 1, At, B1); PG8_BAR;
            PG8_LDA(At, 0, 1); PG8_STAGE(PG8_SA(0, 0), a2, voffA);
            PG8_BAR; PG8_WAIT_L(0); PG8_MMA(1, 0, At, B0); PG8_BAR; PG8_SCHED;
            PG8_STAGE(PG8_SB(0, 1), b2 + hstep, voffB);
            PG8_WAIT_V(6); PG8_BAR; PG8_MMA(1, 1, At, B1); PG8_BAR;
            PG8_LDB(B0, 1, 0); PG8_SCHED; PG8_LDA(At, 1, 0); PG8_STAGE(PG8_SA(0, 1), a2 + hstep, voffA);
            PG8_WAIT_L(8); PG8_BAR; PG8_WAIT_L(0); PG8_MMA(0, 0, At, B0); PG8_BAR; PG8_SCHED;
            PG8_LDB(B1, 1, 1); PG8_STAGE(PG8_SB(1, 0), b3, voffB);
            PG8_BAR; PG8_WAIT_L(0); PG8_MMA(0, 1, At, B1); PG8_BAR;
            PG8_LDA(At, 1, 1); PG8_STAGE(PG8_SA(1, 0), a3, voffA);
            PG8_BAR; PG8_WAIT_L(0); PG8_MMA(1, 0, At, B0); PG8_BAR; PG8_SCHED;
            PG8_STAGE(PG8_SB(1, 1), b3 + hstep, voffB);
            PG8_WAIT_V(6); PG8_BAR; PG8_MMA(1, 1, At, B1); PG8_BAR;
            }
        }
        if constexpr (ALIGN_EPI) { if (wr == 0) PG8_BAR; }
        if constexpr (!Epi::AFTER_DRAIN) { E(acc, cur, wr, wc, fr, fq); S.done(cur); }
        if (!has_next) break;
#pragma unroll
        for (int a = 0; a < 2; ++a)
#pragma unroll
            for (int b = 0; b < 2; ++b)
#pragma unroll
                for (int m = 0; m < 4; ++m)
#pragma unroll
                    for (int n = 0; n < 2; ++n) acc[a][b][m][n] = (f32x4){0.f, 0.f, 0.f, 0.f};
        cur = nxt; cA = nA; cB = nB; ++ui;
        if constexpr (GATHER) { _Pragma("unroll") for (int _h = 0; _h < 2; ++_h) { vAc[_h][0] = vAn[_h][0]; vAc[_h][1] = vAn[_h][1]; } }
        if constexpr (ALIGN_EPI) { if (wr == 1) PG8_BAR; }
    }
    PG8_WAIT_V(0);
    if constexpr (!ALIGN_EPI) { if (wr == 0) PG8_BAR; }
    PG8_BAR;
    if constexpr (Epi::AFTER_DRAIN) { E.fused(acc, cur, wr, wc, fr, fq, lds, wid, lane); S.done(cur); }
#undef PG8_SA
#undef PG8_SB
#undef PG8_STAGE
#undef PG8_STAGE_A
#undef PG8_GIDX
#undef PG8_LDA
#undef PG8_LDB
#undef PG8_MMA
#undef PG8_WAIT_V
#undef PG8_WAIT_L
#undef PG8_BAR
#undef PG8_SCHED
}

template <class F> struct EpiAdapt {
    static constexpr bool PERM = true, AFTER_DRAIN = false; F f;
    __device__ __forceinline__ void mid(f32x4 (&acc)[2][2][4][2], const Unit& u, int wr, int wc, int fr, int fq) const {
        asm volatile("" : "+v"(fr), "+v"(fq));
#pragma unroll
        for (int ai = 0; ai < 2; ++ai)
#pragma unroll
            for (int m = 0; m < 4; ++m) { const int row = ai * HALF + wr * 64 + m * 16 + fr;
#pragma unroll
                for (int bj = 0; bj < 2; ++bj) { float v[8] = {acc[ai][bj][m][0][0], acc[ai][bj][m][0][1], acc[ai][bj][m][0][2], acc[ai][bj][m][0][3], acc[ai][bj][m][1][0], acc[ai][bj][m][1][1], acc[ai][bj][m][1][2], acc[ai][bj][m][1][3]};
                    f.mid8(u, row, bj * HALF + wc * 32 + 8 * fq, v);
                    acc[ai][bj][m][0] = (f32x4){v[0], v[1], v[2], v[3]}; acc[ai][bj][m][1] = (f32x4){v[4], v[5], v[6], v[7]}; } }
    }
    __device__ __forceinline__ void operator()(const f32x4 (&acc)[2][2][4][2], const Unit& u, int wr, int wc, int fr, int fq) const {
        asm volatile("" : "+v"(fr), "+v"(fq));
#pragma unroll
        for (int ai = 0; ai < 2; ++ai)
#pragma unroll
            for (int m = 0; m < 4; ++m) { const int row = ai * HALF + wr * 64 + m * 16 + fr;
#pragma unroll
                for (int bj = 0; bj < 2; ++bj) { const f32x4 v0 = acc[ai][bj][m][0], v1 = acc[ai][bj][m][1];
                    const float v[8] = {v0[0], v0[1], v0[2], v0[3], v1[0], v1[1], v1[2], v1[3]};
                    f.store8(u, row, bj * HALF + wc * 32 + 8 * fq, v); } }
    }
};
}

template <class Epi, class Sched>
__device__ __forceinline__ void gemm_phase_mid(LAS unsigned char* lds, const Gemm g, const Sched& S, const Epi& E, const int wave_in) {
    pg8::EpiAdapt<Epi> EA{E};
    pg8::gemm_phase<pg8::EpiAdapt<Epi>, Sched, true, true, false, true>(lds, g, S, EA, wave_in);
}
template <class Epi, class Sched>
__device__ __forceinline__ void gemm_phase_gather(LAS unsigned char* lds, const Gemm g, const Sched& S, const Epi& E, const int wave_in) {
    pg8::EpiAdapt<Epi> EA{E};
    pg8::gemm_phase<pg8::EpiAdapt<Epi>, Sched, true, true, true>(lds, g, S, EA, wave_in);
}
template <class Epi, class Sched>
__device__ __forceinline__ void gemm_phase_any(LAS unsigned char* lds, const Gemm g, const Sched& S, const Epi& E, const int wave_in) {
#if ENG_GEMM == 1
    pg8::EpiAdapt<Epi> EA{E};
    pg8::gemm_phase<pg8::EpiAdapt<Epi>, Sched, true, true>(lds, g, S, EA, wave_in);
#else
    gemm_phase_naive<Epi, Sched>(lds, g, S, E);
#endif
}

template <class RowMap>
__device__ __forceinline__ void transpose_item(const float* W, int ldw, bf16* WT, int ldt, int koff, int k0, int n0, const RowMap& rm, LAS float* scr, int lane) {
#pragma unroll 8
    for (int i = 0; i < 32; ++i) { const int kk = 2 * i + (lane >> 5); scr[kk * 33 + (lane & 31)] = W[(size_t)(k0 + kk) * ldw + n0 + (lane & 31)]; }
    asm volatile("s_waitcnt lgkmcnt(0)" ::: "memory");
    const int c = lane & 7;
#pragma unroll
    for (int j = 0; j < 4; ++j) { const int n = (lane >> 3) + 8 * j; const LAS float* s = scr + (8 * c) * 33 + n;
        u32x4 o; o.x = pk2(s[0 * 33], s[1 * 33]); o.y = pk2(s[2 * 33], s[3 * 33]); o.z = pk2(s[4 * 33], s[5 * 33]); o.w = pk2(s[6 * 33], s[7 * 33]);
        *(u32x4*)(WT + (size_t)rm(n0 + n) * ldt + koff + k0 + 8 * c) = o; }
    asm volatile("s_waitcnt lgkmcnt(0)" ::: "memory");
}
struct RmId { int off; __device__ int operator()(int n) const { return off + n; } };
struct RmWin { __device__ int operator()(int n) const { return n < 1792 ? n : (n < 2208 ? 3840 + (n - 1792) : 1792 + (n - 2208)); } };
struct RmUkv { __device__ int operator()(int n) const { const int h = n >> 7, j = n & 127; return j < 64 ? h * 64 + j : 512 + h * 64 + (j - 64); } };
struct RmGU { int off; __device__ int operator()(int j) const { return off + 8 * (j >> 2) + (j & 3); } };

__device__ __forceinline__ void p0_prologue(const Frame& F, ArgsP a) {
    const int lane_f = lane_id_fresh(), tid_f = F.wave * 64 + lane_f;
    LAS float* scr = (LAS float*)(F.lds + F.wave * 16384);
    const int lane = lane_f;
    bf16* Win = (bf16*)(F.ws + WS_WIN); bf16* Wblk = (bf16*)(F.ws + WS_WBLK); bf16* Wg = (bf16*)(F.ws + WS_WG); bf16* Wuq = (bf16*)(F.ws + WS_WUQ);
    bf16* Wukv = (bf16*)(F.ws + WS_WUKV); bf16* Wb = (bf16*)(F.ws + WS_WB); bf16* Wo = (bf16*)(F.ws + WS_WO); bf16* Wgu = (bf16*)(F.ws + WS_WGU); bf16* Wdn = (bf16*)(F.ws + WS_WDN);
    constexpr int I_IN = 16 * 133, I_DEC = 1 * 16, I_AUP = 16, I_GUP = 2 * 16, I_UQ = 4 * 24, I_UKV = 2 * 32, I_BR = 2 * 8 * 32, I_O = 16 * 32;
    constexpr int I_EG = 32 * 16 * 8, I_EU = I_EG, I_ED = 32 * 4 * 32;
    constexpr int NITEMS = I_IN + I_DEC + I_AUP + I_GUP + I_UQ + I_UKV + I_BR + I_O + I_EG + I_EU + I_ED;
    for (int it = F.gw; it < NITEMS; it += F.NGW) {
        int r = it;
        if (r < I_IN) { const int kb = r / 133, nb = r % 133; transpose_item(a->in[I_WIN], D_IN, Win, 1024, 0, 64 * kb, 32 * nb, RmWin{}, scr, lane); continue; } r -= I_IN;
        if (r < I_DEC) { transpose_item(a->in[I_WDEC], 512, Wblk, 128, 0, 0, 32 * r, RmId{0}, scr, lane); continue; } r -= I_DEC;
        if (r < I_AUP) { transpose_item(a->in[I_WAUP], 512, Wblk, 128, 64, 0, 32 * r, RmId{512}, scr, lane); continue; } r -= I_AUP;
        if (r < I_GUP) { const int kb = r / 16, nb = r % 16; transpose_item(a->in[I_WGUP], 512, Wg, 128, 0, 64 * kb, 32 * nb, RmId{0}, scr, lane); continue; } r -= I_GUP;
        if (r < I_UQ) { const int kb = r / 24, nb = r % 24; transpose_item(a->in[I_WUQ], 768, Wuq, 256, 0, 64 * kb, 32 * nb, RmId{0}, scr, lane); continue; } r -= I_UQ;
        if (r < I_UKV) { const int kb = r / 32, nb = r % 32; transpose_item(a->in[I_WUKV], 1024, Wukv, 128, 0, 64 * kb, 32 * nb, RmUkv{}, scr, lane); continue; } r -= I_UKV;
        if (r < I_BR) { const int br = r / 256, q = r % 256, kb = q / 32, nb = q % 32; transpose_item(a->in[I_WBR] + (size_t)br * 512 * 1024, 1024, Wb, 1024, 512 * br, 64 * kb, 32 * nb, RmId{0}, scr, lane); continue; } r -= I_BR;
        if (r < I_O) { const int kb = r / 32, nb = r % 32; transpose_item(a->in[I_WOUT], 1024, Wo, 1024, 0, 64 * kb, 32 * nb, RmId{0}, scr, lane); continue; } r -= I_O;
        if (r < I_EG) { const int e = r / 128, q = r % 128, kb = q / 8, nb = q % 8; transpose_item(a->in[I_WEG] + (size_t)e * 1024 * 256, 256, Wgu + (size_t)e * 512 * 1024, 1024, 0, 64 * kb, 32 * nb, RmGU{0}, scr, lane); continue; } r -= I_EG;
        if (r < I_EU) { const int e = r / 128, q = r % 128, kb = q / 8, nb = q % 8; transpose_item(a->in[I_WEU] + (size_t)e * 1024 * 256, 256, Wgu + (size_t)e * 512 * 1024, 1024, 0, 64 * kb, 32 * nb, RmGU{4}, scr, lane); continue; } r -= I_EU;
        { const int e = r / 128, q = r % 128, kb = q / 32, nb = q % 32; transpose_item(a->in[I_WED] + (size_t)e * 256 * 1024, 1024, Wdn + (size_t)e * 1024 * 256, 256, 0, 64 * kb, 32 * nb, RmId{0}, scr, lane); }
    }
    for (int i = F.gw * 64 + lane; i < 96 * 128; i += F.NGW * 64) *(u32x4*)(Win + (size_t)4256 * 1024 + (size_t)i * 8) = (u32x4){0u, 0u, 0u, 0u};
    for (int i = F.gw * 64 + lane; i < 1024 * 8; i += F.NGW * 64) { const int row = i >> 3, c8 = (i & 7) * 8; *(u32x4*)(Wblk + row * 128 + (row < 512 ? 64 : 0) + c8) = (u32x4){0u, 0u, 0u, 0u}; }
    { const int* pos = (const int*)a->in[I_POS]; float* cs = (float*)(F.ws + WS_CS);
      for (int i = F.gw * 64 + lane; i < NTOK * 16; i += F.NGW * 64) { const int t = i >> 4, j = i & 15;
          const float fr = exp2f(-(float)j * (13.287712379549449f / 16.0f));
          const float ang = (float)pos[t] * fr; cs[t * 32 + j] = cosf(ang); cs[t * 32 + 16 + j] = sinf(ang); } }
    { float* mod = (float*)(F.ws + WS_MOD); const float* c = a->in[I_C]; const float* wa = a->in[I_WADA]; const float* ba = a->in[I_BADA];
      LAS float* red = (LAS float*)(F.lds + 8 * 16384);
      LAS float* sc = (LAS float*)F.lds;
      if (F.vcu < 96) {
          __syncthreads();
          for (int i = tid_f; i < 8192; i += NTHR) sc[i] = siluf_(c[i]);
          __syncthreads();
      }
      for (int nb = F.vcu; nb < 96; nb += F.G) {
          float acc[8];
#pragma unroll
          for (int b = 0; b < 8; ++b) acc[b] = 0.f;
          const int n = nb * 64 + lane;
          for (int k0 = F.wave * 128; k0 < F.wave * 128 + 128; k0 += 16) { float w[16];
#pragma unroll
              for (int kk = 0; kk < 16; ++kk) w[kk] = wa[(size_t)(k0 + kk) * 6144 + n];
#pragma unroll
              for (int kk = 0; kk < 16; ++kk)
#pragma unroll
                  for (int b = 0; b < 8; ++b) acc[b] = fmaf(sc[b * 1024 + k0 + kk], w[kk], acc[b]); }
#pragma unroll
          for (int b = 0; b < 8; ++b) red[(F.wave * 8 + b) * 64 + lane] = acc[b];
          __syncthreads();
          { const int b = F.wave; float s = ba[n];
#pragma unroll
            for (int w = 0; w < 8; ++w) s += red[(w * 8 + b) * 64 + lane];
            mod[b * 6144 + n] = s; }
          __syncthreads();
      } }
}

__device__ __forceinline__ void p_normmod(const Frame& F, const float* x, const float* g, const float* mod, int sh_off, int sc_off, bf16* H) {
    const int lane_f = lane_id_fresh();
    f32x4 xa[4], xb[4];
    { const f32x4* xr = (const f32x4*)(x + (size_t)F.gw * 1024) + lane_f;
#pragma unroll
      for (int j = 0; j < 4; ++j) xa[j] = xr[64 * j]; }
    f32x4 gs[4], sh[4]; int bcur = -1;
#define NM_ROW(CUR, NXT, m_) do { const int mm = (m_); const int b = mm / SEQ; \
        if (b != bcur) { bcur = b; \
            _Pragma("unroll") for (int j = 0; j < 4; ++j) { const int col = 4 * lane_f + 256 * j; gs[j] = *(const f32x4*)(g + col) * (*(const f32x4*)(mod + b * 6144 + sc_off + col) + 1.0f); sh[j] = *(const f32x4*)(mod + b * 6144 + sh_off + col); } \
            asm volatile("s_waitcnt vmcnt(0)" : "+v"(gs[0]), "+v"(gs[1]), "+v"(gs[2]), "+v"(gs[3]), "+v"(sh[0]), "+v"(sh[1]), "+v"(sh[2]), "+v"(sh[3]), "+v"(CUR[0]), "+v"(CUR[1]), "+v"(CUR[2]), "+v"(CUR[3])); } \
        { const int mn = (mm + F.NGW < NTOK) ? mm + F.NGW : mm; const f32x4* xr = (const f32x4*)(x + (size_t)mn * 1024) + lane_f; \
          _Pragma("unroll") for (int j = 0; j < 4; ++j) NXT[j] = xr[64 * j]; } \
        float s = 0.f; \
        _Pragma("unroll") for (int j = 0; j < 4; ++j) s += (CUR[j].x * CUR[j].x + CUR[j].y * CUR[j].y) + (CUR[j].z * CUR[j].z + CUR[j].w * CUR[j].w); \
        const float rstd = 1.0f / sqrtf(wave_sum(s) * (1.f / 1024.f) + EPS); \
        u32x2* o = (u32x2*)(H + (size_t)mm * 1024) + lane_f; \
        _Pragma("unroll") for (int j = 0; j < 4; ++j) { const f32x4 y = CUR[j] * rstd * gs[j] + sh[j]; u32x2 w; w.x = pk2(y.x, y.y); w.y = pk2(y.z, y.w); o[64 * j] = w; } } while (0)
    for (int m = F.gw; m < NTOK; m += 2 * F.NGW) {
        NM_ROW(xa, xb, m);
        if (m + F.NGW < NTOK) NM_ROW(xb, xa, m + F.NGW);
    }
#undef NM_ROW
}

__device__ __forceinline__ void p_prep_a(const Frame& F, ArgsP a) {
    const int lane_f = lane_id_fresh();
    const bf16* ZR = (const bf16*)(F.ws + WS_ZR); const bf16* ZM = (const bf16*)(F.ws + WS_ZM);
    bf16* TWA = (bf16*)(F.ws + WS_TWA); bf16* SGL = (bf16*)(F.ws + WS_SGL); bf16* QA = (bf16*)(F.ws + WS_QA); bf16* KVA = (bf16*)(F.ws + WS_KVA);
    const float* mu = a->in[I_MU]; const float* gqa = a->in[I_GQA]; const float* gkva = a->in[I_GKVA];
    const int lane = lane_f;
    const f32x4 mm = *(const f32x4*)(mu + 1536 + 4 * lane), gq = *(const f32x4*)(gqa + 4 * lane), gk = *(const f32x4*)(gkva + 4 * (lane & 31));
    for (int m0 = F.gw; m0 < NTOK; m0 += 4 * F.NGW) {
        u32x2 cc[4], pp[4], qq[4], kk[4];
#pragma unroll
        for (int u = 0; u < 4; ++u) { const int m = (m0 + u * F.NGW < NTOK) ? m0 + u * F.NGW : m0; const bool first = (m % SEQ) == 0;
            cc[u] = *((const u32x2*)(ZR + (size_t)m * 1792 + 1536) + lane); pp[u] = *((const u32x2*)(ZR + (size_t)(first ? m : m - 1) * 1792 + 1536) + lane);
            qq[u] = *((const u32x2*)(ZM + (size_t)m * 512) + lane); kk[u] = *((const u32x2*)(ZM + (size_t)m * 512 + 256) + (lane & 31)); }
#pragma unroll
        for (int u = 0; u < 4; ++u) { const int m = m0 + u * F.NGW; if (m < NTOK) { const bool first = (m % SEQ) == 0;
            { const u32x2 c = cc[u]; u32x2 p = pp[u]; if (first) { p.x = 0u; p.y = 0u; }
              float z[4] = {lo2f(c.x), hi2f(c.x), lo2f(c.y), hi2f(c.y)}; const float q[4] = {lo2f(p.x), hi2f(p.x), lo2f(p.y), hi2f(p.y)};
              z[0] += (q[0] - z[0]) * mm.x; z[1] += (q[1] - z[1]) * mm.y; z[2] += (q[2] - z[2]) * mm.z; z[3] += (q[3] - z[3]) * mm.w;
              if (lane < 16) { u32x2 w; w.x = pk2(tanhf_(z[0]), tanhf_(z[1])); w.y = pk2(tanhf_(z[2]), tanhf_(z[3])); *((u32x2*)(TWA + (size_t)m * 128) + lane) = w; }
              else if (lane < 32) { u32x2 w; w.x = pk2(z[0], z[1]); w.y = pk2(z[2], z[3]); *((u32x2*)(TWA + (size_t)m * 128) + lane) = w; }
              else { u32x2 w; w.x = pk2(sigmoidf_(z[0]), sigmoidf_(z[1])); w.y = pk2(sigmoidf_(z[2]), sigmoidf_(z[3])); *((u32x2*)(SGL + (size_t)m * 128) + (lane - 32)) = w; } }
            { const u32x2 c = qq[u]; const float z[4] = {lo2f(c.x), hi2f(c.x), lo2f(c.y), hi2f(c.y)};
              u32x2 c2 = kk[u]; if (lane >= 32) { c2.x = 0u; c2.y = 0u; } const float y[4] = {lo2f(c2.x), hi2f(c2.x), lo2f(c2.y), hi2f(c2.y)};
              const float rstd = 1.0f / sqrtf(wave_sum((z[0] * z[0] + z[1] * z[1]) + (z[2] * z[2] + z[3] * z[3])) * (1.f / 256.f) + EPS);
              const float rstd2 = 1.0f / sqrtf(wave_sum((y[0] * y[0] + y[1] * y[1]) + (y[2] * y[2] + y[3] * y[3])) * (1.f / 128.f) + EPS);
              u32x2 w; w.x = pk2(z[0] * rstd * gq.x, z[1] * rstd * gq.y); w.y = pk2(z[2] * rstd * gq.z, z[3] * rstd * gq.w);
              *((u32x2*)(QA + (size_t)m * 256) + lane) = w;
              if (lane < 32) { u32x2 w2; w2.x = pk2(y[0] * rstd2 * gk.x, y[1] * rstd2 * gk.y); w2.y = pk2(y[2] * rstd2 * gk.z, y[3] * rstd2 * gk.w);
                  *((u32x2*)(KVA + (size_t)m * 128) + lane) = w2; } } } }
    }
}

__device__ __forceinline__ void p_prep_c(const Frame& F, ArgsP a) {
    const int lane_f = lane_id_fresh();
    const bf16* KN = (const bf16*)(F.dob + DO_KN); const bf16* ZM = (const bf16*)(F.ws + WS_ZM); bf16* KC = (bf16*)(F.ws + WS_KC);
    const float* cs = (const float*)(F.ws + WS_CS); const float* kn = a->in[I_KN];
    const int lane = lane_f, hd = lane >> 3, j = lane & 7;
    const f32x4 kg0 = *(const f32x4*)(kn + 8 * j), kg1 = *(const f32x4*)(kn + 8 * j + 4); const f32x2 kr1 = *(const f32x2*)(kn + 64 + 2 * j), kr2 = *(const f32x2*)(kn + 80 + 2 * j);
    for (int m0 = F.gw; m0 < NTOK; m0 += 4 * F.NGW) {
        u32x4 kv[4]; unsigned z1[4], z2[4]; f32x2 cc[4], sn[4];
#pragma unroll
        for (int u = 0; u < 4; ++u) { const size_t m = (size_t)((m0 + u * F.NGW < NTOK) ? m0 + u * F.NGW : m0);
            kv[u] = *(const u32x4*)(KN + m * 512 + hd * 64 + 8 * j); z1[u] = *(const unsigned*)(ZM + m * 512 + 384 + 2 * j); z2[u] = *(const unsigned*)(ZM + m * 512 + 400 + 2 * j);
            cc[u] = *(const f32x2*)(cs + m * 32 + 2 * j); sn[u] = *(const f32x2*)(cs + m * 32 + 16 + 2 * j); }
#pragma unroll
        for (int u = 0; u < 4; ++u) { const int m = m0 + u * F.NGW; if (m < NTOK) {
            float v[8]; unpack8(kv[u], v); float x1[2] = {lo2f(z1[u]), hi2f(z1[u])}, x2[2] = {lo2f(z2[u]), hi2f(z2[u])};
            float ss = (x1[0] * x1[0] + x1[1] * x1[1]) + (x2[0] * x2[0] + x2[1] * x2[1]);
#pragma unroll
            for (int i = 0; i < 8; ++i) ss += v[i] * v[i];
            const float rstd = 1.0f / sqrtf(sum8(ss) * (1.f / 96.f) + EPS);
            v[0] *= rstd * kg0.x; v[1] *= rstd * kg0.y; v[2] *= rstd * kg0.z; v[3] *= rstd * kg0.w; v[4] *= rstd * kg1.x; v[5] *= rstd * kg1.y; v[6] *= rstd * kg1.z; v[7] *= rstd * kg1.w;
            x1[0] *= rstd * kr1.x; x1[1] *= rstd * kr1.y; x2[0] *= rstd * kr2.x; x2[1] *= rstd * kr2.y;
            bf16* kp = KC + (size_t)m * 768 + hd * 96;
            *(u32x4*)(kp + 8 * j) = pack8(v); *(unsigned*)(kp + 64 + 2 * j) = pk2(x1[0] * cc[u].x - x2[0] * sn[u].x, x1[1] * cc[u].y - x2[1] * sn[u].y);
            *(unsigned*)(kp + 80 + 2 * j) = pk2(x2[0] * cc[u].x + x1[0] * sn[u].x, x2[1] * cc[u].y + x1[1] * sn[u].y); } }
    }
}

__device__ __forceinline__ void p_attn_naive(const Frame& F) {
    const int lane_f = lane_id_fresh(), tid_f = F.wave * 64 + lane_f;
    const bf16* Q = (const bf16*)(F.dob + DO_Q); const bf16* KC = (const bf16*)(F.ws + WS_KC); const bf16* VC = (const bf16*)(F.ws + WS_VC); bf16* YM = (bf16*)(F.ws + WS_YM);
    LAS float* Ks = (LAS float*)F.lds; LAS float* Vs = (LAS float*)(F.lds + 32 * 96 * 4);
    const int tid = tid_f;
    for (int unit = F.vcu; unit < 64 * 16; unit += F.G) {
        const int bh = unit >> 4, qb = 15 - (unit & 15), b = bh >> 3, h = bh & 7; const size_t row0 = (size_t)b * SEQ; const int t = qb * 512 + tid;
        unsigned qp[48];
        { const u32x4* qg = (const u32x4*)(Q + (row0 + t) * 768 + h * 96);
#pragma unroll
          for (int i = 0; i < 12; ++i) { const u32x4 w = qg[i]; qp[4 * i] = w.x; qp[4 * i + 1] = w.y; qp[4 * i + 2] = w.z; qp[4 * i + 3] = w.w; } }
        float o[64];
#pragma unroll
        for (int i = 0; i < 64; ++i) o[i] = 0.f;
        float mx = -INFINITY, l = 0.f;
        const int nkt = (qb + 1) * 16;
        for (int kt = 0; kt < nkt; ++kt) {
            __syncthreads();
            if (tid < 384) { const int r = tid / 12, c8 = (tid % 12) * 8; float v[8]; unpack8(*(const u32x4*)(KC + (row0 + kt * 32 + r) * 768 + h * 96 + c8), v);
#pragma unroll
                for (int i = 0; i < 8; ++i) Ks[r * 96 + c8 + i] = v[i]; }
            if (tid < 256) { const int r = tid >> 3, c8 = (tid & 7) * 8; float v[8]; unpack8(*(const u32x4*)(VC + (row0 + kt * 32 + r) * 512 + h * 64 + c8), v);
#pragma unroll
                for (int i = 0; i < 8; ++i) Vs[r * 64 + c8 + i] = v[i]; }
            __syncthreads();
            for (int kk = 0; kk < 32; ++kk) {
                const int kv = kt * 32 + kk;
                float s = 0.f; const LAS f32x4* kr = (const LAS f32x4*)(Ks + kk * 96);
#pragma unroll
                for (int i = 0; i < 24; ++i) { const f32x4 k4 = kr[i]; s += lo2f(qp[2 * i]) * k4.x + hi2f(qp[2 * i]) * k4.y + lo2f(qp[2 * i + 1]) * k4.z + hi2f(qp[2 * i + 1]) * k4.w; }
                if (kv <= t) {
                    const float mn = fmaxf(mx, s), f = exp2f(mx - mn), p = exp2f(s - mn); mx = mn; l = l * f + p;
                    const LAS f32x4* vr = (const LAS f32x4*)(Vs + kk * 64);
#pragma unroll
                    for (int i = 0; i < 16; ++i) { const f32x4 v4 = vr[i]; o[4 * i] = o[4 * i] * f + p * v4.x; o[4 * i + 1] = o[4 * i + 1] * f + p * v4.y; o[4 * i + 2] = o[4 * i + 2] * f + p * v4.z; o[4 * i + 3] = o[4 * i + 3] * f + p * v4.w; }
                }
            }
        }
        const float il = 1.f / l; u32x4* og = (u32x4*)(YM + (row0 + t) * 512 + h * 64);
#pragma unroll
        for (int i = 0; i < 8; ++i) { u32x4 w; w.x = pk2(o[8 * i] * il, o[8 * i + 1] * il); w.y = pk2(o[8 * i + 2] * il, o[8 * i + 3] * il); w.z = pk2(o[8 * i + 4] * il, o[8 * i + 5] * il); w.w = pk2(o[8 * i + 6] * il, o[8 * i + 7] * il); og[i] = w; }
    }
    __syncthreads();
}

typedef float f32x16 __attribute__((ext_vector_type(16)));
typedef short s16x4 __attribute__((ext_vector_type(4)));
__device__ __forceinline__ int crow(int r, int hi) { return (r & 3) + 8 * (r >> 2) + 4 * hi; }
__device__ __forceinline__ float max3f(float a, float b, float c) { float r; asm("v_max3_f32 %0, %1, %2, %3" : "=v"(r) : "v"(a), "v"(b), "v"(c)); return r; }
__device__ __forceinline__ float max2f(float a, float b) { float r; asm("v_max_f32_e32 %0, %1, %2" : "=v"(r) : "v"(a), "v"(b)); return r; }
__device__ __forceinline__ float xhalf_max(float x) { auto rr = __builtin_amdgcn_permlane32_swap(__float_as_uint(x), __float_as_uint(x), false, false); return max2f(__uint_as_float(rr[0]), __uint_as_float(rr[1])); }
__device__ __forceinline__ float xhalf_sum(float x) { auto rr = __builtin_amdgcn_permlane32_swap(__float_as_uint(x), __float_as_uint(x), false, false); return __uint_as_float(rr[0]) + __uint_as_float(rr[1]); }
__device__ __forceinline__ bf16x8 packp(const f32x16& p, int s2) {
    u32x4 w; w.x = pk2(p[8 * s2 + 0], p[8 * s2 + 1]); w.y = pk2(p[8 * s2 + 2], p[8 * s2 + 3]); w.z = pk2(p[8 * s2 + 4], p[8 * s2 + 5]); w.w = pk2(p[8 * s2 + 6], p[8 * s2 + 7]);
    return __builtin_bit_cast(bf16x8, w);
}
__device__ __forceinline__ void p_attn_mfma(const Frame& F, const float* qn) {
    const int lane_f = lane_id_fresh(), tid_f = F.wave * 64 + lane_f;
    const bf16* Q = (const bf16*)(F.dob + DO_Q); const bf16* KC = (const bf16*)(F.ws + WS_KC); const bf16* VC = (const bf16*)(F.ws + WS_VC); bf16* YM = (bf16*)(F.ws + WS_YM);
    const float* cs = (const float*)(F.ws + WS_CS);
    constexpr int KST = 208, VST = 192, KBYTES = 64 * KST, SUB = KBYTES + 64 * VST, BUF = 2 * SUB;
    const int tid = tid_f, lane = lane_f, wave = F.wave, r = lane & 31, hi = lane >> 5;
    int kg[3], kl[3], vg[2], vl[2];
#pragma unroll
    for (int i = 0; i < 3; ++i) { const int c = tid + 512 * i, row = c / 12, pc = c % 12; kg[i] = row * 768 + pc * 8; kl[i] = (row >> 6) * SUB + (row & 63) * KST + pc * 16; }
#pragma unroll
    for (int i = 0; i < 2; ++i) { const int c = tid + 512 * i, row = c >> 3, pc = c & 7; vg[i] = row * 512 + pc * 8; vl[i] = (row >> 6) * SUB + KBYTES + (row & 63) * VST + pc * 16; }
    const int g4 = lane >> 4, li = lane & 15;
    const int vtr = (4 * (g4 >> 1) + (li >> 2)) * VST + (16 * (g4 & 1) + 4 * (li & 3)) * 2;
    const int kfr = r * KST + hi * 16;
    LAS unsigned char* lds = F.lds;
    for (int item = F.vcu; item < 1024; item += F.G) {
        const int bh = item >> 4, sidx = item & 15, b = bh >> 3, h = bh & 7; const size_t row0 = (size_t)b * SEQ;
        const bf16* Kg = KC + row0 * 768 + h * 96; const bf16* Vg = VC + row0 * 512 + h * 64;
        for (int uu = 0; uu < 2; ++uu) {
            const int qb = uu == 0 ? 31 - sidx : sidx, q0 = qb * 256, NT = (q0 + 256) / 128;
            const int qw = q0 + wave * 32;
            bf16x8 qf[6];
            {
              const bf16* qp = Q + (row0 + qw + r) * 768 + h * 96 + hi * 8; const float* csr = cs + (row0 + qw + r) * 32 + 8 * hi;
              u32x4 raw[6];
#pragma unroll
              for (int s = 0; s < 6; ++s) raw[s] = *(const u32x4*)(qp + 16 * s);
              const f32x4 c0 = *(const f32x4*)csr, c1 = *(const f32x4*)(csr + 4), s0 = *(const f32x4*)(csr + 16), s1 = *(const f32x4*)(csr + 20);
              float ss = 0.f;
#pragma unroll
              for (int s = 0; s < 6; ++s) { float t[8]; unpack8(raw[s], t);
#pragma unroll
                  for (int e = 0; e < 8; ++e) ss += t[e] * t[e]; }
              const float rstd = QSCALE / sqrtf(xhalf_sum(ss) * (1.f / 96.f) + EPS);
#pragma unroll
              for (int s = 0; s < 4; ++s) { float t[8]; unpack8(raw[s], t); const f32x4 g0 = *(const f32x4*)(qn + 16 * s + 8 * hi), g1 = *(const f32x4*)(qn + 16 * s + 8 * hi + 4);
                  t[0] *= rstd * g0.x; t[1] *= rstd * g0.y; t[2] *= rstd * g0.z; t[3] *= rstd * g0.w; t[4] *= rstd * g1.x; t[5] *= rstd * g1.y; t[6] *= rstd * g1.z; t[7] *= rstd * g1.w;
                  qf[s] = __builtin_bit_cast(bf16x8, pack8(t)); }
              { float a4[8], a5[8]; unpack8(raw[4], a4); unpack8(raw[5], a5);
                const f32x4 g0 = *(const f32x4*)(qn + 64 + 8 * hi), g1 = *(const f32x4*)(qn + 64 + 8 * hi + 4), h0 = *(const f32x4*)(qn + 80 + 8 * hi), h1 = *(const f32x4*)(qn + 80 + 8 * hi + 4);
                const float ga[8] = {g0.x, g0.y, g0.z, g0.w, g1.x, g1.y, g1.z, g1.w}, gb[8] = {h0.x, h0.y, h0.z, h0.w, h1.x, h1.y, h1.z, h1.w};
                const float cc[8] = {c0.x, c0.y, c0.z, c0.w, c1.x, c1.y, c1.z, c1.w}, sn[8] = {s0.x, s0.y, s0.z, s0.w, s1.x, s1.y, s1.z, s1.w};
#pragma unroll
                for (int e = 0; e < 8; ++e) { const float x1 = a4[e] * rstd * ga[e], x2 = a5[e] * rstd * gb[e]; a4[e] = x1 * cc[e] - x2 * sn[e]; a5[e] = x2 * cc[e] + x1 * sn[e]; }
                qf[4] = __builtin_bit_cast(bf16x8, pack8(a4)); qf[5] = __builtin_bit_cast(bf16x8, pack8(a5)); } }
            f32x16 o0 = {}, o1 = {}, negm = {}; float m = 0.f, l = 0.f;
            u32x4 ak[3], av[2];
#pragma unroll
            for (int i = 0; i < 3; ++i) ak[i] = *(const u32x4*)(Kg + kg[i]);
#pragma unroll
            for (int i = 0; i < 2; ++i) av[i] = *(const u32x4*)(Vg + vg[i]);
            asm volatile("" : "+v"(qf[0]), "+v"(qf[1]), "+v"(qf[2]), "+v"(qf[3]), "+v"(qf[4]), "+v"(qf[5]));
            LDS_BAR();
#pragma unroll
            for (int i = 0; i < 3; ++i) *(LAS u32x4*)(lds + kl[i]) = ak[i];
#pragma unroll
            for (int i = 0; i < 2; ++i) *(LAS u32x4*)(lds + vl[i]) = av[i];
            LDS_BAR();
            for (int t = 0; t < NT; ++t) {
                LAS unsigned char* bb = lds + (t & 1) * BUF;
                { const int tn = (t + 1 < NT) ? t + 1 : t;
                  const bf16* kgp = Kg + (size_t)tn * 128 * 768; const bf16* vgp = Vg + (size_t)tn * 128 * 512;
#pragma unroll
                  for (int i = 0; i < 3; ++i) ak[i] = *(const u32x4*)(kgp + kg[i]);
#pragma unroll
                  for (int i = 0; i < 2; ++i) av[i] = *(const u32x4*)(vgp + vg[i]); }
#pragma unroll
                for (int sub = 0; sub < 2; ++sub) {
                    const int tt = 2 * t + sub;
                    if (64 * tt <= qw + 31) {
                        LAS unsigned char* kb = bb + sub * SUB; LAS unsigned char* vb = kb + KBYTES;
                        bf16x8 kf0[6], kf1[6];
#pragma unroll
                        for (int s = 0; s < 6; ++s) { kf0[s] = *(const LAS bf16x8*)(kb + kfr + s * 32); kf1[s] = *(const LAS bf16x8*)(kb + kfr + 32 * KST + s * 32); }
                        __builtin_amdgcn_sched_barrier(0);
                        f32x16 p0 = negm, p1 = negm;
#pragma unroll
                        for (int s = 0; s < 6; ++s) { p0 = __builtin_amdgcn_mfma_f32_32x32x16_bf16(kf0[s], qf[s], p0, 0, 0, 0); p1 = __builtin_amdgcn_mfma_f32_32x32x16_bf16(kf1[s], qf[s], p1, 0, 0, 0); }
                        if (64 * tt + 63 > qw) {
                            int hm = hi; asm volatile("" : "+v"(hm));
                            const int qrel = qw + r - 64 * tt - 4 * hm;
#pragma unroll
                            for (int rg = 0; rg < 16; ++rg) { const int kv = (rg & 3) + 8 * (rg >> 2); if (kv > qrel) p0[rg] = -INFINITY; if (kv + 32 > qrel) p1[rg] = -INFINITY; }
                        }
                        float mx;
                        { float a = max3f(p0[0], p0[1], p1[0]), b2 = max3f(p0[2], p0[3], p1[1]); a = max3f(a, p1[2], p1[3]);
#pragma unroll
                          for (int rg = 4; rg < 16; rg += 4) { a = max3f(a, p0[rg], p0[rg + 1]); b2 = max3f(b2, p0[rg + 2], p0[rg + 3]); a = max3f(a, p1[rg], p1[rg + 1]); b2 = max3f(b2, p1[rg + 2], p1[rg + 3]); }
                          mx = xhalf_max(max2f(a, b2)); }
                        if (!__all(mx <= 8.0f)) {
                            const float dl = max2f(mx, 0.f), f = __builtin_amdgcn_exp2f(-dl); m += dl; l *= f;
#pragma unroll
                            for (int rg = 0; rg < 16; ++rg) { p0[rg] -= dl; p1[rg] -= dl; o0[rg] *= f; o1[rg] *= f; negm[rg] = -m; }
                        }
                        float rs = 0.f;
#pragma unroll
                        for (int rg = 0; rg < 16; ++rg) { p0[rg] = __builtin_amdgcn_exp2f(p0[rg]); p1[rg] = __builtin_amdgcn_exp2f(p1[rg]); rs += p0[rg] + p1[rg]; }
                        l += rs;
#pragma unroll
                        for (int hh = 0; hh < 2; ++hh)
#pragma unroll
                            for (int s2 = 0; s2 < 2; ++s2) { const bf16x8 pf = packp(hh == 0 ? p0 : p1, s2);
#pragma unroll
                                for (int db = 0; db < 2; ++db) { LAS unsigned char* vp_ = vb + vtr + (32 * hh + 16 * s2) * VST + db * 64;
                                    const s16x4 lo = __builtin_bit_cast(s16x4, __builtin_amdgcn_ds_read_tr16_b64_v4i16((LAS s16x4*)vp_));
                                    const s16x4 hi4 = __builtin_bit_cast(s16x4, __builtin_amdgcn_ds_read_tr16_b64_v4i16((LAS s16x4*)(vp_ + 8 * VST)));
                                    const bf16x8 vf = (bf16x8){lo[0], lo[1], lo[2], lo[3], hi4[0], hi4[1], hi4[2], hi4[3]};
                                    if (db == 0) o0 = __builtin_amdgcn_mfma_f32_32x32x16_bf16(vf, pf, o0, 0, 0, 0); else o1 = __builtin_amdgcn_mfma_f32_32x32x16_bf16(vf, pf, o1, 0, 0, 0); } }
                    }
                }
                { LAS unsigned char* nb = lds + ((t + 1) & 1) * BUF;
#pragma unroll
                  for (int i = 0; i < 3; ++i) *(LAS u32x4*)(nb + kl[i]) = ak[i];
#pragma unroll
                  for (int i = 0; i < 2; ++i) *(LAS u32x4*)(nb + vl[i]) = av[i]; }
                LDS_BAR();
            }
            const float il = 1.0f / xhalf_sum(l);
            bf16* op = YM + (row0 + qw + r) * YYLD + h * 64 + 4 * hi;
#pragma unroll
            for (int gq = 0; gq < 4; ++gq) { u32x2 w0, w1;
                w0.x = pk2(o0[4 * gq] * il, o0[4 * gq + 1] * il); w0.y = pk2(o0[4 * gq + 2] * il, o0[4 * gq + 3] * il);
                w1.x = pk2(o1[4 * gq] * il, o1[4 * gq + 1] * il); w1.y = pk2(o1[4 * gq + 2] * il, o1[4 * gq + 3] * il);
                *(u32x2*)(op + 8 * gq) = w0; *(u32x2*)(op + 32 + 8 * gq) = w1; }
        }
    }
    __syncthreads();
}

constexpr int CS_CH = 256, CS_NCH = SEQ / CS_CH;
constexpr int CS_RS = 144;
constexpr int CS_IMG = 16 * CS_RS;
constexpr int CS_WAVE = 8 * CS_IMG + 512;
enum { IM_A = 0, IM_R = 1, IM_B = 2, IM_K = 3, IM_BH = 4, IM_KH = 5, IM_V = 6, IM_G = 7 };
constexpr size_t DO_CSP = 64 * MiB, DO_CSG = 128 * MiB, DO_CSZ = 192 * MiB;
__device__ __forceinline__ int crow8(int q, int hi) { return (q & 3) + 8 * ((q >> 2) & 1) + 4 * hi; }
template <int N> __device__ __forceinline__ float dpp_shr0(float x) { return __builtin_bit_cast(float, __builtin_amdgcn_update_dpp(0, __builtin_bit_cast(int, x), 0x110 + N, 0xf, 0xf, true)); }
__device__ __forceinline__ float rowscan16(float x) { x += dpp_shr0<1>(x); x += dpp_shr0<2>(x); x += dpp_shr0<4>(x); x += dpp_shr0<8>(x); return x; }
__device__ __forceinline__ float xsum_16_32(float v) {
    { auto r = __builtin_amdgcn_permlane16_swap(__float_as_uint(v), __float_as_uint(v), false, false); v = __uint_as_float(r[0]) + __uint_as_float(r[1]); }
    { auto r = __builtin_amdgcn_permlane32_swap(__float_as_uint(v), __float_as_uint(v), false, false); v = __uint_as_float(r[0]) + __uint_as_float(r[1]); }
    return v;
}
__device__ __forceinline__ bf16x8 cs_rowfrag(const LAS unsigned char* rowp, int hi, int ks) {
    const LAS unsigned char* p = rowp + (16 * ks + 4 * hi) * 2; const u32x2 a = *(const LAS u32x2*)p, b = *(const LAS u32x2*)(p + 16);
    return __builtin_bit_cast(bf16x8, (u32x4){a.x, a.y, b.x, b.y});
}
__device__ __forceinline__ bf16x8 cs_trfrag(LAS unsigned char* img, int cb, int lane) {
    const int g4 = lane >> 4, li = lane & 15; LAS unsigned char* p = img + (4 * (g4 >> 1) + (li >> 2)) * CS_RS + (32 * cb + 16 * (g4 & 1) + 4 * (li & 3)) * 2;
    const s16x4 lo = __builtin_bit_cast(s16x4, __builtin_amdgcn_ds_read_tr16_b64_v4i16((LAS s16x4*)p));
    const s16x4 h4 = __builtin_bit_cast(s16x4, __builtin_amdgcn_ds_read_tr16_b64_v4i16((LAS s16x4*)(p + 8 * CS_RS)));
    return (bf16x8){lo[0], lo[1], lo[2], lo[3], h4[0], h4[1], h4[2], h4[3]};
}
__device__ __forceinline__ bf16x8 cs_zero8() { return (bf16x8){0, 0, 0, 0, 0, 0, 0, 0}; }
struct CsIn { const bf16 *ZR, *A, *LW, *G; const float *mu, *k_k, *k_a, *r_k; };
template <bool USE_V, bool WITH_Y>
__device__ __forceinline__ void cs_prep(const CsIn& in, size_t row0, int tok0, int h, LAS unsigned char* wl, int lane) {
    const int t = lane & 15, jq = lane >> 4, tok = tok0 + t; const bool first = tok == 0;
    const size_t g = row0 + tok, gp = row0 + (first ? 0 : tok - 1); const int c0 = h * 64 + 16 * jq;
    LAS float* gct = (LAS float*)(wl + 8 * CS_IMG); LAS float* btt = gct + 64;
    u32x4 Lrc[2], Lrp[2], Lkc[2], Lkp[2], Lav[2], Llw[2], Lvc[2], Lvp[2];
#pragma unroll
    for (int hf = 0; hf < 2; ++hf) { const int cc = c0 + 8 * hf;
        Lkc[hf] = *(const u32x4*)(in.ZR + g * 1792 + 512 + cc); Lkp[hf] = *(const u32x4*)(in.ZR + gp * 1792 + 512 + cc);
        Lrc[hf] = *(const u32x4*)(in.ZR + g * 1792 + cc); Lrp[hf] = *(const u32x4*)(in.ZR + gp * 1792 + cc);
        Lav[hf] = *(const u32x4*)(in.A + g * 512 + cc); Llw[hf] = *(const u32x4*)(in.LW + g * 512 + cc);
        if (USE_V) { Lvc[hf] = *(const u32x4*)(in.ZR + g * 1792 + 1024 + cc); Lvp[hf] = *(const u32x4*)(in.ZR + gp * 1792 + 1024 + cc); }
    }
    float inv;
    { float ss = 0.f;
#pragma unroll
      for (int hf = 0; hf < 2; ++hf) { float kc[8], kp[8]; unpack8(Lkc[hf], kc); unpack8(Lkp[hf], kp);
          const f32x4 m0 = *(const f32x4*)(in.mu + 512 + c0 + 8 * hf), m1 = *(const f32x4*)(in.mu + 512 + c0 + 8 * hf + 4), q0 = *(const f32x4*)(in.k_k + c0 + 8 * hf), q1 = *(const f32x4*)(in.k_k + c0 + 8 * hf + 4);
          const float mm[8] = {m0.x, m0.y, m0.z, m0.w, m1.x, m1.y, m1.z, m1.w}, qq[8] = {q0.x, q0.y, q0.z, q0.w, q1.x, q1.y, q1.z, q1.w};
#pragma unroll
          for (int e = 0; e < 8; ++e) { const float zk = kc[e] + ((first ? 0.f : kp[e]) - kc[e]) * mm[e]; const float kr = zk * qq[e]; ss += kr * kr; } }
      inv = 1.0f / fmaxf(sqrtf(xsum_16_32(ss)), 1e-12f); }
    float btacc = 0.f;
#pragma unroll
    for (int hf = 0; hf < 2; ++hf) {
        const int cc = c0 + 8 * hf;
        u32x4 Lgg = {}; if (WITH_Y) Lgg = *(const u32x4*)(in.G + g * 512 + cc);
        float rc[8], rp[8], kc[8], kp[8], av[8], lw[8];
        unpack8(Lrc[hf], rc); unpack8(Lrp[hf], rp); unpack8(Lkc[hf], kc); unpack8(Lkp[hf], kp); unpack8(Lav[hf], av); unpack8(Llw[hf], lw);
        float mr[8], mk[8], qk[8], qa[8], qr[8];
        { const f32x4 a0 = *(const f32x4*)(in.mu + cc), a1 = *(const f32x4*)(in.mu + cc + 4), b0 = *(const f32x4*)(in.mu + 512 + cc), b1 = *(const f32x4*)(in.mu + 512 + cc + 4);
          const f32x4 c0_ = *(const f32x4*)(in.k_k + cc), c1_ = *(const f32x4*)(in.k_k + cc + 4), d0 = *(const f32x4*)(in.k_a + cc), d1 = *(const f32x4*)(in.k_a + cc + 4);
          mr[0] = a0.x; mr[1] = a0.y; mr[2] = a0.z; mr[3] = a0.w; mr[4] = a1.x; mr[5] = a1.y; mr[6] = a1.z; mr[7] = a1.w;
          mk[0] = b0.x; mk[1] = b0.y; mk[2] = b0.z; mk[3] = b0.w; mk[4] = b1.x; mk[5] = b1.y; mk[6] = b1.z; mk[7] = b1.w;
          qk[0] = c0_.x; qk[1] = c0_.y; qk[2] = c0_.z; qk[3] = c0_.w; qk[4] = c1_.x; qk[5] = c1_.y; qk[6] = c1_.z; qk[7] = c1_.w;
          qa[0] = d0.x; qa[1] = d0.y; qa[2] = d0.z; qa[3] = d0.w; qa[4] = d1.x; qa[5] = d1.y; qa[6] = d1.z; qa[7] = d1.w; }
        if (WITH_Y) { const f32x4 e0 = *(const f32x4*)(in.r_k + cc), e1 = *(const f32x4*)(in.r_k + cc + 4); qr[0] = e0.x; qr[1] = e0.y; qr[2] = e0.z; qr[3] = e0.w; qr[4] = e1.x; qr[5] = e1.y; qr[6] = e1.z; qr[7] = e1.w; }
        float oA[8], oR[8], oB[8], oK[8], oBH[8], oKH[8];
#pragma unroll
        for (int e = 0; e < 8; ++e) {
            const float r = rc[e] + ((first ? 0.f : rp[e]) - rc[e]) * mr[e]; const float zk = kc[e] + ((first ? 0.f : kp[e]) - kc[e]) * mk[e];
            const float kq = zk * (1.f + (av[e] - 1.f) * qa[e]); const float kk = zk * qk[e] * inv; const float b = kk * av[e];
            const float Lg = rowscan16(lw[e]); const float eLg = __builtin_amdgcn_exp2f(1.4426950408889634f * Lg); const float enLg = __builtin_amdgcn_rcpf(eLg);
            const float eLgm = __builtin_bit_cast(float, __builtin_amdgcn_update_dpp(0x3f800000, __builtin_bit_cast(int, eLg), 0x111, 0xf, 0xf, false));
            const float eC = __builtin_bit_cast(float, __builtin_amdgcn_ds_bpermute(((lane & 48) | 15) << 2, __builtin_bit_cast(int, eLg)));
            oA[e] = -kk * eLgm; oR[e] = r * eLg; oB[e] = b * enLg; oK[e] = kq * enLg; oBH[e] = oB[e] * eC; oKH[e] = oK[e] * eC;
            if (WITH_Y) btacc += r * kq * qr[e];
            if (t == 15) gct[16 * jq + 8 * hf + e] = eC;
        }
        const int wo = t * CS_RS + (16 * jq + 8 * hf) * 2;
        *(LAS u32x4*)(wl + IM_A * CS_IMG + wo) = pack8(oA); *(LAS u32x4*)(wl + IM_R * CS_IMG + wo) = pack8(oR); *(LAS u32x4*)(wl + IM_B * CS_IMG + wo) = pack8(oB);
        *(LAS u32x4*)(wl + IM_K * CS_IMG + wo) = pack8(oK); *(LAS u32x4*)(wl + IM_BH * CS_IMG + wo) = pack8(oBH); *(LAS u32x4*)(wl + IM_KH * CS_IMG + wo) = pack8(oKH);
        if (USE_V) { float vc[8], vp[8], o[8]; unpack8(Lvc[hf], vc); unpack8(Lvp[hf], vp);
            const f32x4 a0 = *(const f32x4*)(in.mu + 1024 + cc), a1 = *(const f32x4*)(in.mu + 1024 + cc + 4); const float mv[8] = {a0.x, a0.y, a0.z, a0.w, a1.x, a1.y, a1.z, a1.w};
#pragma unroll
            for (int e = 0; e < 8; ++e) o[e] = vc[e] + ((first ? 0.f : vp[e]) - vc[e]) * mv[e];
            *(LAS u32x4*)(wl + IM_V * CS_IMG + wo) = pack8(o); }
        if (WITH_Y) *(LAS u32x4*)(wl + IM_G * CS_IMG + wo) = Lgg;
    }
    if (WITH_Y) { btacc = xsum_16_32(btacc); if (lane < 16) btt[lane] = btacc; }
}
struct CsFr { bf16x8 fAR[4], aL1, aL2, aL4, aL8, aLkMk, aMb; };
__device__ __forceinline__ void cs_gram(CsFr& fr, LAS unsigned char* wl, int lane) {
    const int hi = lane >> 5, row = lane & 15; const bool up = (lane & 16) != 0;
    const LAS unsigned char* rpAR = wl + (up ? IM_R : IM_A) * CS_IMG + row * CS_RS; const LAS unsigned char* rpBK = wl + (up ? IM_K : IM_B) * CS_IMG + row * CS_RS;
#pragma unroll
    for (int ks = 0; ks < 4; ++ks) fr.fAR[ks] = cs_rowfrag(rpAR, hi, ks);
    f32x16 F1 = {}, F2 = {};
#pragma unroll
    for (int ks = 0; ks < 4; ++ks) { const bf16x8 fBK = cs_rowfrag(rpBK, hi, ks);
        F1 = __builtin_amdgcn_mfma_f32_32x32x16_bf16(fBK, fr.fAR[ks], F1, 0, 0, 0);
        F2 = __builtin_amdgcn_mfma_f32_32x32x16_bf16(fr.fAR[ks], fBK, F2, 0, 0, 0); }
#pragma unroll
    for (int q = 0; q < 8; ++q) { const int s = crow8(q, hi); const bool k1 = up ? (s <= row) : (s < row);
        F1[q] = k1 ? F1[q] : 0.f; F1[8 + q] = k1 ? F1[8 + q] : 0.f; F2[q] = (!up && row < s) ? F2[q] : 0.f; }
    const bf16x8 f1lo = packp(F1, 0);
    fr.aL1 = up ? cs_zero8() : f1lo;
    fr.aMb = up ? f1lo : cs_zero8();
    fr.aLkMk = packp(F1, 1);
    const bf16x8 p2 = packp(F2, 0);
    const f32x16 z16 = {};
    const f32x16 Q1 = __builtin_amdgcn_mfma_f32_32x32x16_bf16(p2, fr.aL1, z16, 0, 0, 0), Q2 = __builtin_amdgcn_mfma_f32_32x32x16_bf16(fr.aL1, p2, z16, 0, 0, 0);
    fr.aL2 = packp(Q1, 0); const bf16x8 p2b = packp(Q2, 0);
    const f32x16 R1 = __builtin_amdgcn_mfma_f32_32x32x16_bf16(p2b, fr.aL2, z16, 0, 0, 0), R2 = __builtin_amdgcn_mfma_f32_32x32x16_bf16(fr.aL2, p2b, z16, 0, 0, 0);
    fr.aL4 = packp(R1, 0); const bf16x8 p2c = packp(R2, 0);
    const f32x16 S1 = __builtin_amdgcn_mfma_f32_32x32x16_bf16(p2c, fr.aL4, z16, 0, 0, 0);
    fr.aL8 = packp(S1, 0);
}
template <bool USE_V, bool WITH_Y>
__device__ __forceinline__ void cs_apply(f32x16 (&Z)[2][2], f32x16 (&D)[2], const CsFr& fr, LAS unsigned char* wl, int lane) {
    const int hi = lane >> 5;
    bf16x8 vf[2];
    if (USE_V) { vf[0] = cs_trfrag(wl + IM_V * CS_IMG, 0, lane); vf[1] = cs_trfrag(wl + IM_V * CS_IMG, 1, lane); }
#pragma unroll
    for (int nb = 0; nb < 2; ++nb) { f32x16 d = {};
#pragma unroll
        for (int jb = 0; jb < 2; ++jb)
#pragma unroll
            for (int k2 = 0; k2 < 2; ++k2) d = __builtin_amdgcn_mfma_f32_32x32x16_bf16(fr.fAR[2 * jb + k2], packp(Z[jb][nb], k2), d, 0, 0, 0);
        if (USE_V) d = __builtin_amdgcn_mfma_f32_32x32x16_bf16(fr.aLkMk, vf[nb], d, 0, 0, 0);
        D[nb] = d; }
#pragma unroll
    for (int nb = 0; nb < 2; ++nb) {
        D[nb] = __builtin_amdgcn_mfma_f32_32x32x16_bf16(fr.aL8, packp(D[nb], 0), D[nb], 0, 0, 0);
        D[nb] = __builtin_amdgcn_mfma_f32_32x32x16_bf16(fr.aL4, packp(D[nb], 0), D[nb], 0, 0, 0);
        D[nb] = __builtin_amdgcn_mfma_f32_32x32x16_bf16(fr.aL2, packp(D[nb], 0), D[nb], 0, 0, 0);
        D[nb] = __builtin_amdgcn_mfma_f32_32x32x16_bf16(fr.aL1, packp(D[nb], 0), D[nb], 0, 0, 0);
    }
    const bf16x8 u0 = packp(D[0], 0), u1 = packp(D[1], 0);
    if (WITH_Y) { D[0] = __builtin_amdgcn_mfma_f32_32x32x16_bf16(fr.aMb, u0, D[0], 0, 0, 0); D[1] = __builtin_amdgcn_mfma_f32_32x32x16_bf16(fr.aMb, u1, D[1], 0, 0, 0); }
    const LAS float* gct = (const LAS float*)(wl + 8 * CS_IMG);
#pragma unroll
    for (int jb = 0; jb < 2; ++jb) {
        const bf16x8 fb = cs_trfrag(wl + IM_BH * CS_IMG, jb, lane); bf16x8 fk = cs_zero8(); if (USE_V) fk = cs_trfrag(wl + IM_KH * CS_IMG, jb, lane);
        float gc[16];
#pragma unroll
        for (int g4 = 0; g4 < 4; ++g4) { const f32x4 x = *(const LAS f32x4*)(gct + 32 * jb + 8 * g4 + 4 * hi); gc[4 * g4] = x.x; gc[4 * g4 + 1] = x.y; gc[4 * g4 + 2] = x.z; gc[4 * g4 + 3] = x.w; }
#pragma unroll
        for (int nb = 0; nb < 2; ++nb) { f32x16 z = Z[jb][nb];
#pragma unroll
            for (int q = 0; q < 16; ++q) z[q] *= gc[q];
            z = __builtin_amdgcn_mfma_f32_32x32x16_bf16(fb, nb == 0 ? u0 : u1, z, 0, 0, 0);
            if (USE_V) z = __builtin_amdgcn_mfma_f32_32x32x16_bf16(fk, vf[nb], z, 0, 0, 0);
            Z[jb][nb] = z; }
    }
}
__device__ __forceinline__ void cs_apply_pk(bf16x8 (&Zp)[2][2][2], f32x16 (&D)[2], const CsFr& fr, LAS unsigned char* wl, int lane) {
    const int hi = lane >> 5;
#pragma unroll
    for (int nb = 0; nb < 2; ++nb) { f32x16 d = {};
#pragma unroll
        for (int jb = 0; jb < 2; ++jb)
#pragma unroll
            for (int k2 = 0; k2 < 2; ++k2) d = __builtin_amdgcn_mfma_f32_32x32x16_bf16(fr.fAR[2 * jb + k2], Zp[jb][nb][k2], d, 0, 0, 0);
        D[nb] = d; }
#pragma unroll
    for (int nb = 0; nb < 2; ++nb) {
        D[nb] = __builtin_amdgcn_mfma_f32_32x32x16_bf16(fr.aL8, packp(D[nb], 0), D[nb], 0, 0, 0);
        D[nb] = __builtin_amdgcn_mfma_f32_32x32x16_bf16(fr.aL4, packp(D[nb], 0), D[nb], 0, 0, 0);
        D[nb] = __builtin_amdgcn_mfma_f32_32x32x16_bf16(fr.aL2, packp(D[nb], 0), D[nb], 0, 0, 0);
        D[nb] = __builtin_amdgcn_mfma_f32_32x32x16_bf16(fr.aL1, packp(D[nb], 0), D[nb], 0, 0, 0);
    }
    const bf16x8 u0 = packp(D[0], 0), u1 = packp(D[1], 0);
    const LAS float* gct = (const LAS float*)(wl + 8 * CS_IMG);
#pragma unroll
    for (int jb = 0; jb < 2; ++jb) {
        const bf16x8 fb = cs_trfrag(wl + IM_BH * CS_IMG, jb, lane);
        float gc[16];
#pragma unroll
        for (int g4 = 0; g4 < 4; ++g4) { const f32x4 x = *(const LAS f32x4*)(gct + 32 * jb + 8 * g4 + 4 * hi); gc[4 * g4] = x.x; gc[4 * g4 + 1] = x.y; gc[4 * g4 + 2] = x.z; gc[4 * g4 + 3] = x.w; }
#pragma unroll
        for (int nb = 0; nb < 2; ++nb) { f32x16 z;
#pragma unroll
            for (int k2 = 0; k2 < 2; ++k2) { float e[8]; unpack8(__builtin_bit_cast(u32x4, Zp[jb][nb][k2]), e);
#pragma unroll
                for (int q = 0; q < 8; ++q) z[8 * k2 + q] = e[q] * gc[8 * k2 + q]; }
            z = __builtin_amdgcn_mfma_f32_32x32x16_bf16(fb, nb == 0 ? u0 : u1, z, 0, 0, 0);
            Zp[jb][nb][0] = packp(z, 0); Zp[jb][nb][1] = packp(z, 1); }
    }
}
template <bool USE_V, bool WITH_Y>
__device__ __forceinline__ void cs_step(f32x16 (&Z)[2][2], f32x16 (&D)[2], LAS unsigned char* wl, int lane) { CsFr fr; cs_gram(fr, wl, lane); cs_apply<USE_V, WITH_Y>(Z, D, fr, wl, lane); }
__device__ __forceinline__ void p_cs_a(const Frame& F, ArgsP a) {
    const int lane = lane_id_fresh();
    LAS unsigned char* wl = F.lds + F.wave * CS_WAVE;
    CsIn in{(const bf16*)(F.ws + WS_ZR), (const bf16*)(F.ws + WS_A), (const bf16*)(F.ws + WS_LW), (const bf16*)(F.dob + DO_G), a->in[I_MU], a->in[I_KK], a->in[I_KA], a->in[I_RK]};
    bf16* Pm = (bf16*)(F.dob + DO_CSP); bf16* Gf = (bf16*)(F.dob + DO_CSG);
    const int hi = lane >> 5;
    for (int uc = F.gw; uc < 64 * CS_NCH; uc += F.NGW) {
        const int bh = uc / CS_NCH, c = uc % CS_NCH, b = bh >> 3, h = bh & 7; const size_t row0 = (size_t)b * SEQ;
        f32x16 ZG[2][2], D[2]; bf16x8 ZP[2][2][2];
#pragma unroll
        for (int jb = 0; jb < 2; ++jb)
#pragma unroll
            for (int nb = 0; nb < 2; ++nb) { f32x16 z = {}; ZG[jb][nb] = z;
                if (jb == nb) {
#pragma unroll
                    for (int q = 0; q < 16; ++q) z[q] = (crow(q, hi) == (lane & 31)) ? 1.f : 0.f; }
                ZP[jb][nb][0] = packp(z, 0); ZP[jb][nb][1] = packp(z, 1); }
        for (int sc = 0; sc < CS_CH / 16; ++sc) { int ln = lane; asm volatile("" : "+v"(ln));
            cs_prep<true, false>(in, row0, c * CS_CH + sc * 16, h, wl, ln); asm volatile("s_waitcnt lgkmcnt(0)" ::: "memory");
            CsFr fr; cs_gram(fr, wl, ln);
            cs_apply_pk(ZP, D, fr, wl, ln); cs_apply<true, false>(ZG, D, fr, wl, ln); asm volatile("s_waitcnt lgkmcnt(0)" ::: "memory"); }
        int lo_ = lane; asm volatile("" : "+v"(lo_)); const int hi_o = lo_ >> 5;
        {
            LAS unsigned short* tb = (LAS unsigned short*)(wl + 4 * hi_o * CS_RS + (lo_ & 31) * 2);
#pragma unroll
            for (int jb = 0; jb < 2; ++jb)
#pragma unroll
                for (int nb = 0; nb < 2; ++nb)
#pragma unroll
                    for (int q = 0; q < 16; ++q) tb[((32 * jb + (q & 3) + 8 * (q >> 2)) * CS_RS + 64 * nb) / 2] = (unsigned short)ZP[jb][nb][q >> 3][q & 7];
            bf16* dst = Pm + (size_t)uc * 4096;
#pragma unroll
            for (int i = 0; i < 8; ++i) { const int ch = lo_ + 64 * i, rr = ch >> 3, c8 = (ch & 7) * 8; *(u32x4*)(dst + rr * 64 + c8) = *(const LAS u32x4*)(wl + rr * CS_RS + c8 * 2); }
            asm volatile("s_waitcnt lgkmcnt(0)" ::: "memory");
        }
        {
            bf16* dst = Gf + (size_t)uc * 4096;
#pragma unroll
            for (int jb = 0; jb < 2; ++jb)
#pragma unroll
                for (int nb = 0; nb < 2; ++nb) { u32x4 w0, w1; const f32x16& z = ZG[jb][nb];
                    w0.x = pk2(z[0], z[1]); w0.y = pk2(z[2], z[3]); w0.z = pk2(z[4], z[5]); w0.w = pk2(z[6], z[7]); w1.x = pk2(z[8], z[9]); w1.y = pk2(z[10], z[11]); w1.z = pk2(z[12], z[13]); w1.w = pk2(z[14], z[15]);
                    u32x4* p = (u32x4*)(dst + ((jb * 2 + nb) * 64 + lo_) * 16); p[0] = w0; p[1] = w1; }
        }
    }
}
struct CsB { u32x2 p[2][2][2][2]; u32x4 g[2][2]; };
__device__ __forceinline__ void csb_load(CsB& X, const bf16* Pm, const bf16* Gf, size_t uc, int nb, int lane) {
    const int hi = lane >> 5, r = lane & 31; const bf16* Pc = Pm + uc * 4096;
#pragma unroll
    for (int mb = 0; mb < 2; ++mb) {
#pragma unroll
        for (int jb = 0; jb < 2; ++jb)
#pragma unroll
            for (int k2 = 0; k2 < 2; ++k2) { const bf16* pr = Pc + (32 * mb + r) * 64 + 32 * jb + 16 * k2 + 4 * hi; X.p[mb][jb][k2][0] = *(const u32x2*)pr; X.p[mb][jb][k2][1] = *(const u32x2*)(pr + 8); }
        const u32x4* gp = (const u32x4*)(Gf + uc * 4096 + ((mb * 2 + nb) * 64 + lane) * 16); X.g[mb][0] = gp[0]; X.g[mb][1] = gp[1]; }
}
__device__ __forceinline__ void csb_step(f32x16 (&Z)[2], const CsB& X, bf16* Zf, size_t uc, int nb, int lane) {
#pragma unroll
    for (int jb = 0; jb < 2; ++jb) { u32x4 w0, w1; const f32x16& z = Z[jb];
        w0.x = pk2(z[0], z[1]); w0.y = pk2(z[2], z[3]); w0.z = pk2(z[4], z[5]); w0.w = pk2(z[6], z[7]); w1.x = pk2(z[8], z[9]); w1.y = pk2(z[10], z[11]); w1.z = pk2(z[12], z[13]); w1.w = pk2(z[14], z[15]);
        u32x4* p = (u32x4*)(Zf + uc * 4096 + ((jb * 2 + nb) * 64 + lane) * 16); p[0] = w0; p[1] = w1; }
    f32x16 N[2];
#pragma unroll
    for (int mb = 0; mb < 2; ++mb) { float g0[8], g1[8]; unpack8(X.g[mb][0], g0); unpack8(X.g[mb][1], g1);
#pragma unroll
        for (int q = 0; q < 8; ++q) { N[mb][q] = g0[q]; N[mb][8 + q] = g1[q]; } }
#pragma unroll
    for (int jb = 0; jb < 2; ++jb)
#pragma unroll
        for (int k2 = 0; k2 < 2; ++k2) { const bf16x8 zb = packp(Z[jb], k2);
#pragma unroll
            for (int mb = 0; mb < 2; ++mb) { const u32x2 x0 = X.p[mb][jb][k2][0], x1 = X.p[mb][jb][k2][1];
                N[mb] = __builtin_amdgcn_mfma_f32_32x32x16_bf16(__builtin_bit_cast(bf16x8, (u32x4){x0.x, x0.y, x1.x, x1.y}), zb, N[mb], 0, 0, 0); } }
    Z[0] = N[0]; Z[1] = N[1];
}
__device__ __forceinline__ void p_cs_b(const Frame& F) {
    const int lane = lane_id_fresh();
    const bf16* Pm = (const bf16*)(F.dob + DO_CSP); const bf16* Gf = (const bf16*)(F.dob + DO_CSG); bf16* Zf = (bf16*)(F.dob + DO_CSZ);
    for (int u16 = F.gw; u16 < 128 * 16; u16 += F.NGW) {
        if (u16 & 15) continue;
        const int u = u16 >> 4, bh = u >> 1, nb = u & 1; const size_t uc0 = (size_t)bh * CS_NCH;
        f32x16 Z[2] = {};
        CsB X0, X1, X2;
        csb_load(X0, Pm, Gf, uc0, nb, lane); csb_load(X1, Pm, Gf, uc0 + 1, nb, lane);
#define CSB_CL(c_) (uc0 + ((c_) < CS_NCH ? (c_) : CS_NCH - 1))
        int c = 0;
        for (; c + 2 < CS_NCH; c += 3) {
            csb_load(X2, Pm, Gf, CSB_CL(c + 2), nb, lane); csb_step(Z, X0, Zf, uc0 + c, nb, lane);
            csb_load(X0, Pm, Gf, CSB_CL(c + 3), nb, lane); csb_step(Z, X1, Zf, uc0 + c + 1, nb, lane);
            csb_load(X1, Pm, Gf, CSB_CL(c + 4), nb, lane); csb_step(Z, X2, Zf, uc0 + c + 2, nb, lane);
        }
        if (c < CS_NCH) { csb_step(Z, X0, Zf, uc0 + c, nb, lane); ++c; }
        if (c < CS_NCH) { csb_step(Z, X1, Zf, uc0 + c, nb, lane); ++c; }
#undef CSB_CL
    }
}
__device__ __forceinline__ void p_cs_c(const Frame& F, ArgsP a) {
    const int lane = lane_id_fresh(), hi = lane >> 5;
    LAS unsigned char* wl = F.lds + F.wave * CS_WAVE;
    CsIn in{(const bf16*)(F.ws + WS_ZR), (const bf16*)(F.ws + WS_A), (const bf16*)(F.ws + WS_LW), (const bf16*)(F.dob + DO_G), a->in[I_MU], a->in[I_KK], a->in[I_KA], a->in[I_RK]};
    const bf16* Zf = (const bf16*)(F.dob + DO_CSZ); bf16* Y = (bf16*)(F.ws + WS_Y); const float* lnw = a->in[I_LNW]; const float* lnb = a->in[I_LNB];
    const LAS float* btt = (const LAS float*)(wl + 8 * CS_IMG) + 64;
    for (int uc = F.gw; uc < 64 * CS_NCH; uc += F.NGW) {
        const int bh = uc / CS_NCH, c = uc % CS_NCH, b = bh >> 3, h = bh & 7; const size_t row0 = (size_t)b * SEQ;
        f32x16 Z[2][2], D[2];
        int lu = lane; asm volatile("" : "+v"(lu));
#pragma unroll
        for (int jb = 0; jb < 2; ++jb)
#pragma unroll
            for (int nb = 0; nb < 2; ++nb) { const u32x4* p = (const u32x4*)(Zf + (size_t)uc * 4096 + ((jb * 2 + nb) * 64 + lu) * 16); float g0[8], g1[8]; unpack8(p[0], g0); unpack8(p[1], g1);
#pragma unroll
                for (int q = 0; q < 8; ++q) { Z[jb][nb][q] = g0[q]; Z[jb][nb][8 + q] = g1[q]; } }
        const float lw0 = lnw[h * 64 + (lu & 31)], lw1 = lnw[h * 64 + 32 + (lu & 31)], lb0 = lnb[h * 64 + (lu & 31)], lb1 = lnb[h * 64 + 32 + (lu & 31)];
        for (int sc = 0; sc < CS_CH / 16; ++sc) {
            const int tok0 = c * CS_CH + sc * 16;
            int ln = lane; asm volatile("" : "+v"(ln));
            cs_prep<true, true>(in, row0, tok0, h, wl, ln); asm volatile("s_waitcnt lgkmcnt(0)" ::: "memory");
            cs_step<true, true>(Z, D, wl, ln); asm volatile("s_waitcnt lgkmcnt(0)" ::: "memory");
            const int hl = ln >> 5;
            const bf16x8 v0 = cs_trfrag(wl + IM_V * CS_IMG, 0, ln), v1 = cs_trfrag(wl + IM_V * CS_IMG, 1, ln), g0 = cs_trfrag(wl + IM_G * CS_IMG, 0, ln), g1 = cs_trfrag(wl + IM_G * CS_IMG, 1, ln);
            const f32x4 bta = *(const LAS f32x4*)(btt + 4 * hl), btb = *(const LAS f32x4*)(btt + 8 + 4 * hl); const float bt[8] = {bta.x, bta.y, bta.z, bta.w, btb.x, btb.y, btb.z, btb.w};
#pragma unroll
            for (int q = 0; q < 8; ++q) {
                const float y0 = D[0][8 + q], y1 = D[1][8 + q];
                const float mean = allsum32(y0 + y1) * (1.f / 64.f); const float d0 = y0 - mean, d1 = y1 - mean;
                const float rstd = 1.0f / sqrtf(allsum32(d0 * d0 + d1 * d1) * (1.f / 64.f) + LN_X_EPS);
                const float o0 = (d0 * rstd * lw0 + lb0 + bt[q] * bf2f((unsigned short)v0[q])) * bf2f((unsigned short)g0[q]);
                const float o1 = (d1 * rstd * lw1 + lb1 + bt[q] * bf2f((unsigned short)v1[q])) * bf2f((unsigned short)g1[q]);
                bf16* yp = Y + (row0 + tok0 + crow8(q, hl)) * YYLD + h * 64 + (ln & 31);
                yp[0] = (unsigned short)f2bf(o0); yp[32] = (unsigned short)f2bf(o1);
            }
            asm volatile("s_waitcnt lgkmcnt(0)" ::: "memory");
        }
    }
}

__device__ __forceinline__ void p_ffn_route(const Frame& F, ArgsP a, unsigned* cnt, int* route) {
    const int lane_f = lane_id_fresh(), tid_f = F.wave * 64 + lane_f;
    const float* X = a->in[I_X]; const bf16* MO = (const bf16*)(F.ws + WS_MO); bf16* H2 = (bf16*)(F.ws + WS_H2); const float* mod = (const float*)(F.ws + WS_MOD); const float* g = a->in[I_GFFN];
    constexpr int RTS = 1028;
    LAS float* wr = (LAS float*)F.lds;
    __syncthreads();
    for (int i = tid_f; i < 1024 * 4; i += NTHR) { const int k = i >> 2, o = i & 3; wr[o * RTS + k] = a->in[I_WRG][i]; }
    for (int i = tid_f; i < 1024 * 32; i += NTHR) { const int k = i >> 5, o = i & 31; wr[(4 + o) * RTS + k] = a->in[I_WRE][i]; }
    __syncthreads();
    LAS float* brl = wr + 36 * RTS;
    if (tid_f < 4) brl[tid_f] = a->in[I_BRG][tid_f]; else if (tid_f < 36) brl[tid_f] = a->in[I_BRE][tid_f - 4];
    const int lane = lane_f;
    LAS unsigned* lcnt = (LAS unsigned*)(F.lds + LDS_MISC + 512);
    if (tid_f < 64) lcnt[tid_f] = 0u;
    __syncthreads();
    int my_e0 = 0, my_e1 = 0; float my_w0 = 0.f, my_w1 = 0.f; int kk_ = 0;
    f32x4 xa[4], xb[4]; u32x2 ma[4], mb[4]; f32x4 gmv[4], gsv[4], shv[4]; int bcur = -1;
    { const f32x4* xr = (const f32x4*)(X + (size_t)F.gw * 1024) + lane; const u32x2* mr = (const u32x2*)(MO + (size_t)F.gw * 1024) + lane;
#pragma unroll
      for (int j = 0; j < 4; ++j) { xa[j] = xr[64 * j]; ma[j] = mr[64 * j]; } }
#define RT_ROW(CX, CM, NX, NM, m_) do { const int mm = (m_); const int b = mm / SEQ; \
        if (b != bcur) { bcur = b; \
            _Pragma("unroll") for (int j = 0; j < 4; ++j) { const int col = 4 * lane + 256 * j; gmv[j] = *(const f32x4*)(mod + b * 6144 + 2048 + col); \
                gsv[j] = *(const f32x4*)(g + col) * (*(const f32x4*)(mod + b * 6144 + 4096 + col) + 1.0f); shv[j] = *(const f32x4*)(mod + b * 6144 + 3072 + col); } \
            asm volatile("s_waitcnt vmcnt(0)" : "+v"(gmv[0]), "+v"(gmv[1]), "+v"(gmv[2]), "+v"(gmv[3]), "+v"(gsv[0]), "+v"(gsv[1]), "+v"(gsv[2]), "+v"(gsv[3]), "+v"(shv[0]), "+v"(shv[1]), "+v"(shv[2]), "+v"(shv[3])); \
            asm volatile("" : "+v"(CX[0]), "+v"(CX[1]), "+v"(CX[2]), "+v"(CX[3]), "+v"(CM[0]), "+v"(CM[1]), "+v"(CM[2]), "+v"(CM[3])); } \
        { const int mn = (mm + F.NGW < NTOK) ? mm + F.NGW : mm; const f32x4* xr = (const f32x4*)(X + (size_t)mn * 1024) + lane; const u32x2* mr = (const u32x2*)(MO + (size_t)mn * 1024) + lane; \
          _Pragma("unroll") for (int j = 0; j < 4; ++j) { NX[j] = xr[64 * j]; NM[j] = mr[64 * j]; } } \
        f32x4 v[4]; float s = 0.f; \
        _Pragma("unroll") for (int j = 0; j < 4; ++j) { v[j] = CX[j] + gmv[j] * (f32x4){lo2f(CM[j].x), hi2f(CM[j].x), lo2f(CM[j].y), hi2f(CM[j].y)}; \
            s += (v[j].x * v[j].x + v[j].y * v[j].y) + (v[j].z * v[j].z + v[j].w * v[j].w); } \
        const float rstd = 1.0f / sqrtf(wave_sum(s) * (1.f / 1024.f) + EPS); \
        u32x2* o = (u32x2*)(H2 + (size_t)mm * 1024) + lane; \
        _Pragma("unroll") for (int j = 0; j < 4; ++j) { v[j] = v[j] * rstd * gsv[j] + shv[j]; u32x2 w; w.x = pk2(v[j].x, v[j].y); w.y = pk2(v[j].z, v[j].w); o[64 * j] = w; } \
        float lgq[4]; \
        _Pragma("unroll") for (int oo = 0; oo < 4; ++oo) { float p = 0.f; \
            _Pragma("unroll") for (int j = 0; j < 4; ++j) { const f32x4 w4 = *(const LAS f32x4*)(wr + oo * RTS + 4 * lane + 256 * j); p += (v[j].x * w4.x + v[j].y * w4.y) + (v[j].z * w4.z + v[j].w * w4.w); } \
            lgq[oo] = wave_sum(p) + brl[oo]; } \
        int gi = 0; float gmx = lgq[0]; \
        _Pragma("unroll") for (int i = 1; i < 4; ++i) { if (lgq[i] > gmx) { gmx = lgq[i]; gi = i; } } \
        float gsum = 0.f; \
        _Pragma("unroll") for (int i = 0; i < 4; ++i) gsum += __expf(lgq[i] - gmx); \
        const float pg = 1.f / gsum; \
        gi = __builtin_amdgcn_readfirstlane(gi); \
        float el[8]; \
        { const LAS float* wg = wr + (4 + gi * 8) * RTS + 4 * lane; \
          _Pragma("unroll") for (int i = 0; i < 8; ++i) { float p = 0.f; \
              _Pragma("unroll") for (int j = 0; j < 4; ++j) { const f32x4 w4 = *(const LAS f32x4*)(wg + i * RTS + 256 * j); p += (v[j].x * w4.x + v[j].y * w4.y) + (v[j].z * w4.z + v[j].w * w4.w); } \
              el[i] = wave_sum(p) + brl[4 + gi * 8 + i]; } } \
        int i0 = 0; float m0 = el[0]; \
        _Pragma("unroll") for (int i = 1; i < 8; ++i) if (el[i] > m0) { m0 = el[i]; i0 = i; } \
        int i1 = -1; float m1 = -INFINITY; \
        _Pragma("unroll") for (int i = 0; i < 8; ++i) if (i != i0 && el[i] > m1) { m1 = el[i]; i1 = i; } \
        const float e1 = __expf(m1 - m0), w0 = pg / (1.f + e1), w1 = pg * e1 / (1.f + e1); \
        if (lane == kk_) { my_e0 = gi * 8 + i0; my_e1 = gi * 8 + i1; my_w0 = w0; my_w1 = w1; } \
        ++kk_; } while (0)
    for (int m = F.gw; m < NTOK; m += 2 * F.NGW) {
        RT_ROW(xa, ma, xb, mb, m);
        if (m + F.NGW < NTOK) RT_ROW(xb, mb, xa, ma, m + F.NGW);
    }
#undef RT_ROW
    unsigned lp0 = 0u, lp1 = 0u;
    if (lane < kk_) { lp0 = __hip_atomic_fetch_add(lcnt + my_e0, 1u, __ATOMIC_RELAXED, __HIP_MEMORY_SCOPE_WORKGROUP); lp1 = __hip_atomic_fetch_add(lcnt + my_e1, 1u, __ATOMIC_RELAXED, __HIP_MEMORY_SCOPE_WORKGROUP); }
    __syncthreads();
    if (tid_f < 32) lcnt[32 + tid_f] = __hip_atomic_fetch_add(cnt + tid_f, lcnt[tid_f], __ATOMIC_RELAXED, __HIP_MEMORY_SCOPE_AGENT);
    __syncthreads();
    if (lane < kk_) { const int m = F.gw + lane * F.NGW; int* rt = route + (size_t)m * 8;
        rt[0] = my_e0; rt[1] = my_e1; rt[2] = (int)(lcnt[32 + my_e0] + lp0); rt[3] = (int)(lcnt[32 + my_e1] + lp1); rt[4] = __builtin_bit_cast(int, my_w0); rt[5] = __builtin_bit_cast(int, my_w1); }
    __syncthreads();
}
__device__ __forceinline__ int moe_tables(const Frame& F, LAS int* offs, LAS int* texp) {
    const int lane_f = lane_id_fresh(), tid_f = F.wave * 64 + lane_f;
    const unsigned* cnt = (const unsigned*)(F.ws + WS_CTL) + CW_CNT;
    __syncthreads();
    if (F.wave == 0) {
        const int e = lane_f & 31; const int c = (int)__hip_atomic_load(cnt + e, __ATOMIC_RELAXED, __HIP_MEMORY_SCOPE_AGENT); const int nt = (c + 255) >> 8;
        int incl = nt;
#pragma unroll
        for (int d = 1; d < 32; d <<= 1) { const int o = __shfl_up(incl, d, 32); if (e >= d) incl += o; }
        const int t0 = incl - nt;
        if (lane_f < 32) { offs[e] = t0 << 8; if (e == 31) offs[32] = incl << 8; for (int t = 0; t < nt; ++t) texp[t0 + t] = e; }
    }
    __syncthreads();
    return offs[32] >> 8;
}
__device__ __forceinline__ void p_gather(const Frame& F) {
    const int lane_f = lane_id_fresh(), tid_f = F.wave * 64 + lane_f;
    LAS int* offs = (LAS int*)(F.lds + 1024); LAS int* texp = (LAS int*)(F.lds + 2048);
    moe_tables(F, offs, texp);
    const int* route = (const int*)(F.ws + WS_ROUTE); int* ridx = (int*)(F.ws + WS_ENT);
    const unsigned* cnt = (const unsigned*)(F.ws + WS_CTL) + CW_CNT;
    for (int m = F.vcu * NTHR + tid_f; m < NTOK; m += F.G * NTHR) { const u32x4 rt = *(const u32x4*)(route + (size_t)m * 8); ridx[offs[rt.x] + (int)rt.z] = m; ridx[offs[rt.y] + (int)rt.w] = m; }
    for (int i = F.vcu * NTHR + tid_f; i < 32 * 256; i += F.G * NTHR) { const int e = i >> 8, r = i & 255; const int c = (int)cnt[e]; const int pad = ((c + 255) & ~255) - c; if (r < pad) ridx[offs[e] + c + r] = 0; }
    __syncthreads();
}
__device__ __forceinline__ void p_combine(const Frame& F, const float* xin, float* dst) {
    const int lane_f = lane_id_fresh(), tid_f = F.wave * 64 + lane_f;
    LAS int* offs = (LAS int*)(F.lds + 1024); LAS int* texp = (LAS int*)(F.lds + 2048);
    moe_tables(F, offs, texp);
    const bf16* MO = (const bf16*)(F.ws + WS_MO); const bf16* YS = (const bf16*)(F.ws + WS_YS); const int* route = (const int*)(F.ws + WS_ROUTE); const float* mod = (const float*)(F.ws + WS_MOD);
    const int lane = lane_f;
    for (int m = F.gw; m < NTOK; m += F.NGW) {
        const int b = m / SEQ; const int* rt = route + (size_t)m * 8; const int d0 = offs[rt[0]] + rt[2], d1 = offs[rt[1]] + rt[3];
        const float w0 = __builtin_bit_cast(float, rt[4]), w1 = __builtin_bit_cast(float, rt[5]);
#pragma unroll
        for (int j = 0; j < 2; ++j) { const int col = 8 * lane + 512 * j; float y0[8], y1[8];
            unpack8(*(const u32x4*)(YS + (size_t)d0 * 1024 + col), y0); unpack8(*(const u32x4*)(YS + (size_t)d1 * 1024 + col), y1);
            const float* o = xin + (size_t)m * 1024 + col; const float* gt = mod + b * 6144 + 5120 + col; const float* gm = mod + b * 6144 + 2048 + col; float mo[8]; unpack8(*(const u32x4*)(MO + (size_t)m * 1024 + col), mo);
            f32x4 x0 = *(const f32x4*)o, x1 = *(const f32x4*)(o + 4); const f32x4 g0 = *(const f32x4*)gt, g1 = *(const f32x4*)(gt + 4), h0 = *(const f32x4*)gm, h1 = *(const f32x4*)(gm + 4);
            x0.x += h0.x * mo[0]; x0.y += h0.y * mo[1]; x0.z += h0.z * mo[2]; x0.w += h0.w * mo[3]; x1.x += h1.x * mo[4]; x1.y += h1.y * mo[5]; x1.z += h1.z * mo[6]; x1.w += h1.w * mo[7];
            x0.x += g0.x * (w0 * y0[0] + w1 * y1[0]); x0.y += g0.y * (w0 * y0[1] + w1 * y1[1]); x0.z += g0.z * (w0 * y0[2] + w1 * y1[2]); x0.w += g0.w * (w0 * y0[3] + w1 * y1[3]);
            x1.x += g1.x * (w0 * y0[4] + w1 * y1[4]); x1.y += g1.y * (w0 * y0[5] + w1 * y1[5]); x1.z += g1.z * (w0 * y0[6] + w1 * y1[6]); x1.w += g1.w * (w0 * y0[7] + w1 * y1[7]);
            float* od = dst + (size_t)m * 1024 + col; *(f32x4*)od = x0; *(f32x4*)(od + 4) = x1; }
    }
}

constexpr int NPHASE = 17;
template <int LO, int HI>
__global__ void __launch_bounds__(NTHR, 2) fwd(Args args) {
    extern __shared__ __attribute__((aligned(16))) unsigned char lds_raw[];
    Frame F;
    F.lds = (LAS unsigned char*)lds_raw;
    F.wave = __builtin_amdgcn_readfirstlane((int)threadIdx.x >> 6);
    F.G = gridDim.x; { const int bx = blockIdx.x; F.vcu = (F.G % 8 == 0) ? (bx % 8) * (F.G / 8) + bx / 8 : bx; }
    F.gw = F.vcu * NWAVES + F.wave; F.NGW = F.G * NWAVES;
    F.ws = args.ws; F.dob = (unsigned char*)args.out;
    ArgsP AP = (ArgsP)__builtin_amdgcn_kernarg_segment_ptr();
    volatile LAS unsigned* MISC = (volatile LAS unsigned*)(F.lds + LDS_MISC);
    if (threadIdx.x < 64) MISC[threadIdx.x] = 0u;
    __syncthreads();
    XcdBarrier bar; bar.bar = (unsigned*)(F.ws + WS_CTL) + CW_BAR; bar.x = 0; bar.st = MISC + 8;
#if N_LAUNCH_MODE == 1
    bar = xcd_barrier_post((unsigned*)(F.ws + WS_CTL) + CW_BAR, MISC + 8);
#define GRID_BAR() xcd_barrier(bar)
#else
#define GRID_BAR() do { } while (0)
#endif
#ifndef PROBE_REPEAT
#define PROBE_REPEAT -1
#endif
#define IN(k) (LO <= (k) && (k) < HI)
#define SEAM(k) do { if constexpr (IN(k) && IN((k) + 1)) GRID_BAR(); } while (0)
    const float* mod = (const float*)(F.ws + WS_MOD);

#define PH(k, ...) do { if constexpr (IN(k)) { asm volatile("" : "+s"(AP)); { __VA_ARGS__ } if constexpr (PROBE_REPEAT == (k)) { GRID_BAR(); asm volatile("" : "+s"(AP)); { __VA_ARGS__ } } } } while (0)
    PH(0, p0_prologue(F, AP);); SEAM(0);
    PH(1, p_normmod(F, AP->in[I_X], AP->in[I_GMIX], mod, 0, 1024, (bf16*)(F.ws + WS_H));); SEAM(1);
    PH(2, Gemm g{(const bf16*)(F.ws + WS_H), (const bf16*)(F.ws + WS_WIN), NTOK, N_IN_PAD, 1024}; StaticOrder S; S.init(NTOK, N_IN_PAD, F.G, (int)blockIdx.x);
        EpiZ E{(bf16*)(F.ws + WS_ZR), (bf16*)(F.ws + WS_SG), (bf16*)(F.ws + WS_ZM)}; gemm_phase_any(F.lds, g, S, E, F.wave);); SEAM(2);
    PH(3, p_prep_a(F, AP);); SEAM(3);
    PH(4,
        { Gemm g{(const bf16*)(F.ws + WS_TWA), (const bf16*)(F.ws + WS_WBLK), NTOK, 1024, 128}; StaticOrder S; S.init(NTOK, 1024, F.G, (int)blockIdx.x);
          EpiLora E{(bf16*)(F.ws + WS_LW), (bf16*)(F.ws + WS_A), AP->in[I_W0], AP->in[I_A0]}; gemm_phase_any(F.lds, g, S, E, F.wave); }
        { Gemm g{(const bf16*)(F.ws + WS_SGL), (const bf16*)(F.ws + WS_WG), NTOK, 512, 128}; StaticOrder S; S.init(NTOK, 512, F.G, (int)blockIdx.x);
          EpiPlain E{(bf16*)(F.dob + DO_G), nullptr, 1 << 30, 512, 0}; gemm_phase_any(F.lds, g, S, E, F.wave); }
        { Gemm g{(const bf16*)(F.ws + WS_QA), (const bf16*)(F.ws + WS_WUQ), NTOK, 768, 256}; StaticOrder S; S.init(NTOK, 768, F.G, (int)blockIdx.x);
          EpiPlain E{(bf16*)(F.dob + DO_Q), nullptr, 1 << 30, 768, 0}; gemm_phase_any(F.lds, g, S, E, F.wave); }
        { Gemm g{(const bf16*)(F.ws + WS_KVA), (const bf16*)(F.ws + WS_WUKV), NTOK, 1024, 128}; StaticOrder S; S.init(NTOK, 1024, F.G, (int)blockIdx.x);
          EpiPlain E{(bf16*)(F.dob + DO_KN), (bf16*)(F.ws + WS_VC), 512, 512, 512}; gemm_phase_any(F.lds, g, S, E, F.wave); }
    ); SEAM(4);
    PH(5, p_prep_c(F, AP);); SEAM(5);
#if ENG_ATTN == 1
    PH(6, p_attn_mfma(F, AP->in[I_QN]);); SEAM(6);
#else
    PH(6, p_attn_naive(F);); SEAM(6);
#endif
    PH(7, p_cs_a(F, AP);); SEAM(7);
    PH(8, p_cs_b(F);); SEAM(8);
    PH(9, p_cs_c(F, AP);); SEAM(9);
    PH(10, Gemm g{(const bf16*)(F.ws + WS_Y), (const bf16*)(F.ws + WS_WB), NTOK, 1024, 1024}; StaticOrder S; S.init(NTOK, 1024, F.G, (int)blockIdx.x);
        EpiBranch2 E{(bf16*)(F.ws + WS_MG), (const bf16*)(F.ws + WS_SG)}; gemm_phase_mid(F.lds, g, S, E, F.wave);); SEAM(10);
    PH(11, Gemm g{(const bf16*)(F.ws + WS_MG), (const bf16*)(F.ws + WS_WO), NTOK, 1024, 1024}; StaticOrder S; S.init(NTOK, 1024, F.G, (int)blockIdx.x);
        EpiPlain E{(bf16*)(F.ws + WS_MO), nullptr, 1 << 30, 1024, 0}; gemm_phase_any(F.lds, g, S, E, F.wave);); SEAM(11);
    if constexpr (PROBE_REPEAT == 12) { p_ffn_route(F, AP, (unsigned*)(F.ws + WS_CTL) + CW_CNT + 64, (int*)(F.ws + WS_CS)); GRID_BAR(); }
    if constexpr (IN(12)) { asm volatile("" : "+s"(AP)); p_ffn_route(F, AP, (unsigned*)(F.ws + WS_CTL) + CW_CNT, (int*)(F.ws + WS_ROUTE)); } SEAM(12);
    PH(13, p_gather(F);); SEAM(13);
    PH(14, LAS int* offs = (LAS int*)(F.lds + LDS_MISC + 1024); LAS int* texp = (LAS int*)(F.lds + LDS_MISC + 1024 + 256); const int nt = moe_tables(F, offs, texp);
        Gemm g{(const bf16*)(F.ws + WS_H2), (const bf16*)(F.ws + WS_WGU), MPAD, 512, 1024, (const int*)(F.ws + WS_ENT)}; TableOrder S{texp, nt, 2, F.G, (int)blockIdx.x};
        EpiGateUp E{(bf16*)(F.ws + WS_HID)}; gemm_phase_gather(F.lds, g, S, E, F.wave);); SEAM(14);
    PH(15, LAS int* offs = (LAS int*)(F.lds + LDS_MISC + 1024); LAS int* texp = (LAS int*)(F.lds + LDS_MISC + 1024 + 256); const int nt = moe_tables(F, offs, texp);
        Gemm g{(const bf16*)(F.ws + WS_HID), (const bf16*)(F.ws + WS_WDN), MPAD, 1024, 256}; TableOrder S{texp, nt, 4, F.G, (int)blockIdx.x};
        EpiDown E{(bf16*)(F.ws + WS_YS)}; gemm_phase_any(F.lds, g, S, E, F.wave);); SEAM(15);
    if constexpr (PROBE_REPEAT == 16) { asm volatile("" : "+s"(AP)); p_combine(F, AP->in[I_X], (float*)(F.ws + WS_SG)); GRID_BAR(); }
    if constexpr (IN(16)) { asm volatile("" : "+s"(AP)); p_combine(F, AP->in[I_X], (float*)F.dob); }
}

#if N_LAUNCH_MODE == 1
static bool set_attrs() { return hipFuncSetAttribute((const void*)fwd<0, NPHASE>, hipFuncAttributeMaxDynamicSharedMemorySize, LDS_BYTES) == hipSuccess; }
#else
template <int P> static bool set_attr_all() { if constexpr (P < NPHASE) { return hipFuncSetAttribute((const void*)fwd<P, P + 1>, hipFuncAttributeMaxDynamicSharedMemorySize, LDS_BYTES) == hipSuccess && set_attr_all<P + 1>(); } else return true; }
static bool set_attrs() { return set_attr_all<0>(); }
template <int P> static void launch_all(int grid, hipStream_t stream, const Args& a) { if constexpr (P < NPHASE) { hipLaunchKernelGGL((fwd<P, P + 1>), dim3(grid), dim3(NTHR), LDS_BYTES, stream, a); launch_all<P + 1>(grid, stream, a); } }
#endif
extern "C" void kernel_launch(void* const* d_in, const int* in_sizes, int n_in, void* d_out, int out_size, void* d_ws, size_t ws_size, hipStream_t stream) {
    static int grid = 0;
    if (grid == 0) {
        if (n_in != 34 || out_size != NTOK * DM || ws_size < WS_END) { fprintf(stderr, "kernel_launch: unexpected shapes (n_in %d out %d ws %zu)\n", n_in, out_size, ws_size); grid = -1; return; }
        int dev = 0, cus = 0;
        if (hipGetDevice(&dev) != hipSuccess || hipDeviceGetAttribute(&cus, hipDeviceAttributeMultiprocessorCount, dev) != hipSuccess) { grid = -1; return; }
        if (!set_attrs()) { fprintf(stderr, "kernel_launch: hipFuncSetAttribute failed\n"); grid = -1; return; }
        grid = cus;
    }
    if (grid < 0) return;
    (void)hipMemsetAsync((char*)d_ws + WS_CTL, 0, CTL_ZERO_BYTES, stream);
    Args a{};
    for (int i = 0; i < 34; ++i) a.in[i] = (const float*)d_in[i];
    a.out = (float*)d_out; a.ws = (unsigned char*)d_ws;
    a.ph_lo = 0; a.ph_hi = NPHASE;
#if N_LAUNCH_MODE == 1
    hipLaunchKernelGGL((fwd<0, NPHASE>), dim3(grid), dim3(NTHR), LDS_BYTES, stream, a);
#else
    launch_all<0>(grid, stream, a);
#endif
}
```

```cpp
#include <hip/hip_runtime.h>
#include <cstdio>
#include <cstdint>

#ifndef N_LAUNCH_MODE
#define N_LAUNCH_MODE 1
#endif
#ifndef ENG_GEMM
#define ENG_GEMM 1
#endif
#ifndef ENG_ATTN
#define ENG_ATTN 1
#endif

#define GAS __attribute__((address_space(1)))
#define LAS __attribute__((address_space(3)))
typedef unsigned short bf16;
typedef float f32x4 __attribute__((ext_vector_type(4)));
typedef float f32x2 __attribute__((ext_vector_type(2)));
typedef unsigned u32x4 __attribute__((ext_vector_type(4)));
typedef unsigned u32x2 __attribute__((ext_vector_type(2)));
typedef short bf16x8 __attribute__((ext_vector_type(8)));

constexpr int BATCH = 8, SEQ = 8192, DM = 1024, NTOK = BATCH * SEQ;
constexpr int D_RWKV = 512, RWKV_COLS = 1792, MLA_COLS = 416, D_IN = 4256, N_IN_PAD = 4352;
constexpr int NH = 8, QKD = 96, NOPE = 64, ROPE = 32, VD = 64;
constexpr int NEXP = 32, DEXP = 256;
constexpr int NCLS = 112, MPAD2 = 94208;
constexpr int MPAD = 139264;
constexpr float EPS = 1e-6f, LN_X_EPS = 64e-5f;
constexpr float QSCALE = 0.10206207261596577f * 1.4426950408889634f;

constexpr size_t MiB = 1u << 20;
constexpr size_t WS_CTL = 0, CTL_ZERO_BYTES = 1 * MiB;
constexpr size_t WS_MOD = 1 * MiB;
constexpr size_t WS_ROUTE = 2 * MiB;
constexpr size_t WS_CS = 4 * MiB;
constexpr size_t WS_ENT = 12 * MiB;
constexpr size_t WS_WIN = 16 * MiB;
constexpr size_t WS_WBLK = 25 * MiB;
constexpr size_t WS_WG = WS_WBLK + 256 * 1024;
constexpr size_t WS_WUQ = WS_WG + 128 * 1024;
constexpr size_t WS_WUKV = WS_WUQ + 384 * 1024;
constexpr size_t WS_WB = 26 * MiB;
constexpr size_t WS_WO = 28 * MiB;
constexpr size_t WS_WGU = 30 * MiB;
constexpr size_t WS_WDN = 62 * MiB;
constexpr size_t WS_SG = 80 * MiB;
constexpr size_t WS_H2 = 80 * MiB;
constexpr size_t WS_ZR = 336 * MiB;
constexpr size_t WS_VC = 816 * MiB;
constexpr size_t WS_KC = 880 * MiB;
constexpr size_t WS_Y = 560 * MiB;
constexpr size_t WS_XG = 336 * MiB;
constexpr size_t WS_ZM = 560 * MiB;
constexpr size_t WS_YM = 560 * MiB + 1024;
constexpr size_t WS_H = 688 * MiB;
constexpr size_t WS_LW = 688 * MiB;
constexpr size_t WS_A = 752 * MiB;
constexpr size_t WS_MG = 688 * MiB;
constexpr size_t WS_HID2 = 208 * MiB;
constexpr size_t WS_RW = 13 * MiB;
constexpr size_t WS_HID = 208 * MiB;
constexpr size_t WS_R = 752 * MiB;
constexpr size_t WS_V = 816 * MiB;
constexpr size_t WS_ZK = 880 * MiB;
constexpr size_t WS_TWA = 944 * MiB;
constexpr size_t WS_SGL = 960 * MiB;
constexpr size_t WS_QA = 976 * MiB;
constexpr size_t WS_KVA = 1008 * MiB;
constexpr size_t WS_KK = 944 * MiB;
constexpr size_t WS_YS = 752 * MiB;
constexpr size_t WS_MO = 560 * MiB;
constexpr int YYLD = 1024;
constexpr size_t WS_END = 1024 * MiB;
constexpr size_t DO_G = 0;
constexpr size_t DO_Q = 64 * MiB;
constexpr size_t DO_KN = 160 * MiB;

constexpr int CW_CNT = 64;
constexpr int CW_BAR = 4096;

constexpr int NWAVES = 8, NTHR = 512;
constexpr int LDS_BYTES = 155648;
constexpr int LDS_MISC = 151552;

__device__ __forceinline__ int lane_id_fresh() { int l; asm volatile("v_mbcnt_lo_u32_b32 %0, -1, 0\n\tv_mbcnt_hi_u32_b32 %0, -1, %0" : "=v"(l)); return l; }
__device__ __forceinline__ float bf2f(unsigned short h) { return __builtin_bit_cast(float, (unsigned)h << 16); }
__device__ __forceinline__ unsigned f2bf(float f) { unsigned u = __builtin_bit_cast(unsigned, f); return (u + 0x7fffu + ((u >> 16) & 1u)) >> 16; }
typedef __bf16 bf16x2_t __attribute__((ext_vector_type(2)));
__device__ __forceinline__ unsigned pk2(float lo, float hi) { const f32x2 v = {lo, hi}; return __builtin_bit_cast(unsigned, __builtin_convertvector(v, bf16x2_t)); }
__device__ __forceinline__ float lo2f(unsigned w) { return __builtin_bit_cast(float, w << 16); }
__device__ __forceinline__ float hi2f(unsigned w) { return __builtin_bit_cast(float, w & 0xffff0000u); }
template <int CTRL> __device__ __forceinline__ float dpp_add(float x) { return x + __builtin_bit_cast(float, __builtin_amdgcn_update_dpp(0, __builtin_bit_cast(int, x), CTRL, 0xf, 0xf, false)); }
__device__ __forceinline__ float allsum16(float x) { x = dpp_add<0xB1>(x); x = dpp_add<0x4E>(x); x = dpp_add<0x141>(x); x = dpp_add<0x140>(x); return x; }
__device__ __forceinline__ float allsum32(float x) { x = allsum16(x); auto r = __builtin_amdgcn_permlane16_swap(__float_as_uint(x), __float_as_uint(x), false, false); return __uint_as_float(r[0]) + __uint_as_float(r[1]); }
__device__ __forceinline__ float sum8(float x) { x = dpp_add<0xB1>(x); x = dpp_add<0x4E>(x); x = dpp_add<0x141>(x); return x; }
__device__ __forceinline__ float wave_sum(float v) {
    v = allsum16(v);
    { auto r = __builtin_amdgcn_permlane16_swap(__float_as_uint(v), __float_as_uint(v), false, false); v = __uint_as_float(r[0]) + __uint_as_float(r[1]); }
    { auto r = __builtin_amdgcn_permlane32_swap(__float_as_uint(v), __float_as_uint(v), false, false); v = __uint_as_float(r[0]) + __uint_as_float(r[1]); }
    return v;
}
__device__ __forceinline__ float sigmoidf_(float x) { return __builtin_amdgcn_rcpf(1.f + __builtin_amdgcn_exp2f(-1.4426950408889634f * x)); }
__device__ __forceinline__ float tanhf_(float x) { return 1.0f - 2.0f * __builtin_amdgcn_rcpf(1.f + __builtin_amdgcn_exp2f(2.8853900817779268f * x)); }
__device__ __forceinline__ float siluf_(float x) { return x * __builtin_amdgcn_rcpf(1.f + __builtin_amdgcn_exp2f(-1.4426950408889634f * x)); }
__device__ __forceinline__ void unpack8(const u32x4 w, float (&v)[8]) {
    v[0] = lo2f(w.x); v[1] = hi2f(w.x); v[2] = lo2f(w.y); v[3] = hi2f(w.y); v[4] = lo2f(w.z); v[5] = hi2f(w.z); v[6] = lo2f(w.w); v[7] = hi2f(w.w);
}
__device__ __forceinline__ u32x4 pack8(const float (&v)[8]) { u32x4 w; w.x = pk2(v[0], v[1]); w.y = pk2(v[2], v[3]); w.z = pk2(v[4], v[5]); w.w = pk2(v[6], v[7]); return w; }

#define LDS_BAR() do { asm volatile("s_waitcnt lgkmcnt(0)" ::: "memory"); __builtin_amdgcn_s_barrier(); asm volatile("" ::: "memory"); } while (0)

#define XB_TMO      128
#define XB_XCNT(j)  (256  + 64 * (j))
#define XB_XSUB(j)  (1280 + 64 * (j))
#define XB_XGEN(j)  (2304 + 64 * (j))
#define XB_TOP      3328
#define XB_TOPGEN   3392
#define XCD_BAR_WORDS 3456
#define XB_SPIN_CAP (1u << 19)
__device__ __forceinline__ unsigned xb_ld(unsigned* p)              { return __hip_atomic_load(p, __ATOMIC_RELAXED, __HIP_MEMORY_SCOPE_AGENT); }
__device__ __forceinline__ unsigned xb_add(unsigned* p, unsigned v) { return __hip_atomic_fetch_add(p, v, __ATOMIC_RELAXED, __HIP_MEMORY_SCOPE_AGENT); }
__device__ __forceinline__ unsigned xb_xcc_id() { return (unsigned)__builtin_amdgcn_s_getreg((3 << 11) | 20) & 0xFu; }
#define XB_SPIN(cond, bar) do { unsigned _sp = 0; while (cond) { __builtin_amdgcn_s_sleep(1); \
    if ((++_sp & 255u) == 0u) { if (xb_ld(&(bar)[XB_TMO])) break; if (_sp > XB_SPIN_CAP) { atomicAdd(&(bar)[XB_TMO], 1u); break; } } } } while (0)
struct XcdBarrier { unsigned* bar; unsigned x; volatile LAS unsigned* st; };
__device__ __forceinline__ XcdBarrier xcd_barrier_post(unsigned* bar, volatile LAS unsigned* st) {
    XcdBarrier b; b.bar = bar; b.x = xb_xcc_id(); b.st = st;
    if (threadIdx.x == 0) (void)xb_add(&bar[XB_XCNT(b.x)], 1u);
    return b;
}
__device__ __forceinline__ void xcd_barrier_complete(unsigned* bar, unsigned x, unsigned& nloc, unsigned& nx) {
    const unsigned G = gridDim.x * gridDim.y * gridDim.z;
    unsigned sum, cnt, mine, sp = 0u;
    for (;;) {
        sum = 0u; cnt = 0u; mine = 0u;
#pragma unroll
        for (unsigned j = 0; j < 16; ++j) { const unsigned c = xb_ld(&bar[XB_XCNT(j)]); sum += c; cnt += (c > 0u) ? 1u : 0u; mine = (j == x) ? c : mine; }
        if (sum == G) break;
        __builtin_amdgcn_s_sleep(1);
        if ((++sp & 255u) == 0u) { if (xb_ld(&bar[XB_TMO])) break; if (sp > XB_SPIN_CAP) { atomicAdd(&bar[XB_TMO], 1u); break; } }
    }
    nloc = mine > 0u ? mine : 1u; nx = cnt > 0u ? cnt : 1u;
}
__device__ __forceinline__ void xcd_barrier(const XcdBarrier& b) {
    asm volatile("s_waitcnt vmcnt(0)" ::: "memory");
    __syncthreads();
    if (threadIdx.x == 0) {
        unsigned* bar = b.bar;
        __builtin_amdgcn_s_waitcnt(0);
        unsigned nloc = b.st[0], nx = b.st[1];
        if (nloc == 0u) { xcd_barrier_complete(bar, b.x, nloc, nx); b.st[0] = nloc; b.st[1] = nx; }
        const unsigned old = xb_add(&bar[XB_XSUB(b.x)], 1u);
        const unsigned gen = old / nloc;
        if (old + 1u == (gen + 1u) * nloc) {
            __builtin_amdgcn_fence(__ATOMIC_RELEASE, "agent");
            asm volatile("s_waitcnt vmcnt(0)" ::: "memory");
            const unsigned og = xb_add(&bar[XB_TOP], 1u);
            const unsigned tg = og / nx;
            if (og + 1u == (tg + 1u) * nx) xb_add(&bar[XB_TOPGEN], 1u);
            else XB_SPIN(xb_ld(&bar[XB_TOPGEN]) == tg, bar);
            __builtin_amdgcn_fence(__ATOMIC_ACQUIRE, "agent");
            xb_add(&bar[XB_XGEN(b.x)], 1u);
            asm volatile("s_waitcnt vmcnt(0)" ::: "memory");
        } else {
            XB_SPIN(xb_ld(&bar[XB_XGEN(b.x)]) == gen, bar);
            __builtin_amdgcn_fence(__ATOMIC_ACQUIRE, "agent");
            asm volatile("s_waitcnt vmcnt(0)" ::: "memory");
        }
    }
    __syncthreads();
}

struct Args {
    const float* in[34]; float* out; unsigned char* ws; int ph_lo, ph_hi;
};
typedef const __attribute__((address_space(4))) Args* ArgsP;
struct Frame {
    LAS unsigned char* lds;
    int wave, vcu, G, gw, NGW;
    unsigned char* ws; unsigned char* dob;
};
enum { I_X = 0, I_C, I_POS, I_WADA, I_BADA, I_GMIX, I_WIN, I_MU, I_W0, I_WDEC, I_A0, I_WAUP, I_WGUP, I_KK, I_KA, I_RK, I_LNW, I_LNB, I_GQA, I_WUQ, I_GKVA, I_WUKV,
       I_QN, I_KN, I_WBR, I_WOUT, I_GFFN, I_WRG, I_BRG, I_WRE, I_BRE, I_WEG, I_WEU, I_WED };

struct Unit { int pm, pn, aux; };
struct Gemm { const bf16* A; const bf16* Bt; int M, N, K; const int* ridx = nullptr; int ldb = 0; };
constexpr int NXCD = 8, WGM = 8;
struct StaticOrder {
    int nM, nN, nwg, G, c;
    __device__ void init(int M, int N, int G_, int c_) { nM = M / 256; nN = N / 256; nwg = nM * nN; G = G_; c = c_; }
    __device__ bool next(int i, Unit& u) const {
        const long L = (long)i * G + c; if (L >= nwg) return false;
        int wgid = (int)L; { const int q = nwg / NXCD, r = nwg % NXCD, xcd = wgid % NXCD, off = wgid / NXCD; wgid = (xcd < r ? xcd * (q + 1) : r * (q + 1) + (xcd - r) * q) + off; }
        const int nig = WGM * nN, gid = wgid / nig, fm = gid * WGM, gsz = (nM - fm) < WGM ? (nM - fm) : WGM;
        u.pm = fm + ((wgid % nig) % gsz); u.pn = (wgid % nig) / gsz; u.aux = 0; return true;
    }
    __device__ __forceinline__ void a_ready(const Unit&) const {}
    __device__ __forceinline__ void done(const Unit&) const {}
};
struct TableOrder {
    const LAS int* texp; int ntiles, nN, G, c;
    __device__ bool next(int i, Unit& u) const {
        const long L = (long)i * G + c; if (L >= (long)ntiles * nN) return false;
        const int t = (int)(L / nN), j = (int)(L % nN); u.pm = t; u.pn = texp[t] * nN + j; u.aux = 0; return true;
    }
    __device__ __forceinline__ void a_ready(const Unit&) const {}
    __device__ __forceinline__ void done(const Unit&) const {}
};

__device__ __forceinline__ void cls_decode(int cls, int& e_lo, int& e_hi) {
    const int gi = cls / 28, idx = cls % 28;
    const int lo = (idx >= 7) + (idx >= 13) + (idx >= 18) + (idx >= 22) + (idx >= 25) + (idx >= 27), base = (lo * (15 - lo)) / 2;
    e_lo = gi * 8 + lo; e_hi = gi * 8 + lo + 1 + (idx - base);
}
struct PairOrderGU {
    const LAS int* texp; int ntiles, G, c;
    __device__ bool next(int i, Unit& u) const {
        const int L = i * G + c; if (L >= ntiles * 4) return false;
        const int t = L >> 2, j = L & 3; int el, eh; cls_decode(__builtin_amdgcn_readfirstlane(texp[t]), el, eh);
        u.pm = t; u.pn = (j < 2 ? el : eh) * 2 + (j & 1); u.aux = j >> 1; return true;
    }
    __device__ __forceinline__ void a_ready(const Unit&) const {}
    __device__ __forceinline__ void done(const Unit&) const {}
};
struct PairOrderDown {
    const LAS int* texp; int ntiles, G, c;
    __device__ bool next(int i, Unit& u) const {
        const int L = i * G + c; if (L >= ntiles * 4) return false;
        const int t = L >> 2, j = L & 3; int el, eh; cls_decode(__builtin_amdgcn_readfirstlane(texp[t]), el, eh);
        u.pm = t; u.pn = el * 4 + j; u.aux = eh * 4 + j; return true;
    }
    __device__ __forceinline__ void a_ready(const Unit&) const {}
    __device__ __forceinline__ void done(const Unit&) const {}
};

template <class Epi, class Sched>
__device__ __forceinline__ void gemm_phase_naive(LAS unsigned char* lds, const Gemm g, const Sched& S, const Epi& E) {
    const int tid = (int)__builtin_amdgcn_readfirstlane((int)threadIdx.x >> 6) * 64 + lane_id_fresh(), ty = tid >> 5, tx = tid & 31;
    LAS bf16* As = (LAS bf16*)lds; LAS bf16* Bs = (LAS bf16*)(lds + 128 * 40 * 2);
    Unit u;
    for (int i = 0; S.next(i, u); ++i) {
        for (int half = 0; half < 2; ++half) {
            float acc[8][8];
#pragma unroll
            for (int r = 0; r < 8; ++r)
#pragma unroll
                for (int c = 0; c < 8; ++c) acc[r][c] = 0.f;
            const bf16* Ab = g.A + ((size_t)u.pm * 256 + half * 128) * g.K; const bf16* Bb = g.Bt + (size_t)u.pn * 256 * g.K;
            for (int k0 = 0; k0 < g.K; k0 += 32) {
                __syncthreads();
                { const int r = tid >> 2, c8 = (tid & 3) * 8; *(LAS u32x4*)(As + r * 40 + c8) = *(const u32x4*)(Ab + (size_t)r * g.K + k0 + c8); }
#pragma unroll
                for (int j = 0; j < 2; ++j) { const int ch = tid + j * 512, r = ch >> 2, c8 = (ch & 3) * 8; *(LAS u32x4*)(Bs + r * 40 + c8) = *(const u32x4*)(Bb + (size_t)r * g.K + k0 + c8); }
                __syncthreads();
#pragma unroll 2
                for (int k = 0; k < 32; k += 2) {
                    float b0[8], b1[8];
#pragma unroll
                    for (int c = 0; c < 8; ++c) { const unsigned w = *(const LAS unsigned*)(Bs + (tx * 8 + c) * 40 + k); b0[c] = lo2f(w); b1[c] = hi2f(w); }
#pragma unroll
                    for (int r = 0; r < 8; ++r) { const unsigned w = *(const LAS unsigned*)(As + (ty * 8 + r) * 40 + k); const float a0 = lo2f(w), a1 = hi2f(w);
#pragma unroll
                        for (int c = 0; c < 8; ++c) acc[r][c] = fmaf(a1, b1[c], fmaf(a0, b0[c], acc[r][c])); }
                }
            }
#pragma unroll
            for (int r = 0; r < 8; ++r) E.store8(u, half * 128 + ty * 8 + r, tx * 8, acc[r]);
        }
    }
    __syncthreads();
}

struct EpiZ { bf16 *ZR, *SG, *ZM;
    __device__ __forceinline__ void store8(const Unit& u, int r, int c, const float (&v)[8]) const {
        const size_t row = (size_t)u.pm * 256 + r;
        if (u.pn < 7) { *(u32x4*)(ZR + row * 1792 + u.pn * 256 + c) = pack8(v); }
        else if (u.pn < 15) { __builtin_nontemporal_store(pack8(v), (u32x4*)(SG + row * 2048 + (u.pn - 7) * 256 + c)); }
        else { *(u32x4*)(ZM + row * 512 + (u.pn - 15) * 256 + c) = pack8(v); }
    } };
struct EpiLora { bf16 *LW, *A; const float *w0, *a0;
    __device__ __forceinline__ void store8(const Unit& u, int r, int c, const float (&v)[8]) const {
        const size_t row = (size_t)u.pm * 256 + r; const int col = u.pn * 256 + c; float o[8];
        const bool isw = col < 512; const float* bp = isw ? (w0 + col) : (a0 + col - 512);
        const f32x4 b0 = *(const f32x4*)bp, b1 = *(const f32x4*)(bp + 4); const float bb[8] = {b0.x, b0.y, b0.z, b0.w, b1.x, b1.y, b1.z, b1.w};
#pragma unroll
        for (int i = 0; i < 8; ++i) { const float e = __builtin_amdgcn_exp2f(fminf(-1.4426950408889634f * (bb[i] + v[i]), 120.f)); const float s = __builtin_amdgcn_rcpf(1.0f + e); o[i] = isw ? -0.60653065971263342f * s : s; }
        bf16* dst = isw ? (LW + row * 512 + col) : (A + row * 512 + col - 512);
        *(u32x4*)dst = pack8(o);
    } };
struct EpiPlain { bf16* O0; bf16* O1; int split, ld0, ld1;
    __device__ __forceinline__ void store8(const Unit& u, int r, int c, const float (&v)[8]) const {
        const size_t row = (size_t)u.pm * 256 + r; int col = u.pn * 256 + c;
        if (col < split) *(u32x4*)(O0 + row * ld0 + col) = pack8(v); else *(u32x4*)(O1 + row * ld1 + col - split) = pack8(v);
    } };
struct EpiBranch2 { bf16* MG; const bf16* SG;
    __device__ __forceinline__ void mid8(const Unit& u, int r, int c, float (&v)[8]) const {
        const size_t row = (size_t)u.pm * 256 + r; const int col = u.pn * 256 + c; float gr[8], gm[8];
        unpack8(*(const u32x4*)(SG + row * 2048 + col), gr); unpack8(*(const u32x4*)(SG + row * 2048 + 1024 + col), gm);
#pragma unroll
        for (int i = 0; i < 8; ++i) v[i] *= (1.f + __builtin_amdgcn_exp2f(-1.4426950408889634f * fmaxf(gm[i], -30.f))) * __builtin_amdgcn_rcpf(1.f + __builtin_amdgcn_exp2f(-1.4426950408889634f * gr[i]));
    }
    __device__ __forceinline__ void store8(const Unit& u, int r, int c, const float (&v)[8]) const {
        const size_t row = (size_t)u.pm * 256 + r; const int col = u.pn * 256 + c; float gm[8], o[8];
        unpack8(*(const u32x4*)(SG + row * 2048 + 1024 + col), gm);
#pragma unroll
        for (int i = 0; i < 8; ++i) o[i] = sigmoidf_(fmaxf(gm[i], -30.f)) * v[i];
        *(u32x4*)(MG + row * 1024 + col) = pack8(o);
    } };
struct EpiGateUp { bf16* HID;
    __device__ __forceinline__ void store8(const Unit& u, int r, int c, const float (&v)[8]) const {
        const size_t row = (size_t)u.pm * 256 + r; const int col = ((u.pn & 1) * 256 + c) >> 1;
        u32x2 w; w.x = pk2(siluf_(v[0]) * v[4], siluf_(v[1]) * v[5]); w.y = pk2(siluf_(v[2]) * v[6], siluf_(v[3]) * v[7]);
        *(u32x2*)(HID + row * 256 + col) = w;
    } };
struct EpiGateUp2 { bf16* HID2; const float* rw;
    __device__ __forceinline__ void store8(const Unit& u, int r, int c, const float (&v)[8]) const {
        const size_t row = (size_t)u.pm * 256 + r; const float w = rw[row * 2 + u.aux]; const int col = u.aux * 256 + (((u.pn & 1) * 256 + c) >> 1);
        u32x2 o; o.x = pk2(w * siluf_(v[0]) * v[4], w * siluf_(v[1]) * v[5]); o.y = pk2(w * siluf_(v[2]) * v[6], w * siluf_(v[3]) * v[7]);
        *(u32x2*)(HID2 + row * 512 + col) = o;
    } };
struct EpiDown2 { float* out; const float* x; const bf16* MO; const float* mod; const int* ridx;
    __device__ __forceinline__ void store8(const Unit& u, int r, int c, const float (&v)[8]) const {
        const int tok = ridx[u.pm * 256 + r]; if (tok < 0) return;
        const int col = (u.pn & 3) * 256 + c, b = tok / SEQ; const size_t off = (size_t)tok * 1024 + col;
        const float* gt = mod + b * 6144 + 5120 + col; const float* gm = mod + b * 6144 + 2048 + col; const u32x4 mw = *(const u32x4*)(MO + off);
        { f32x4 x0 = *(const f32x4*)(x + off); const f32x4 g0 = *(const f32x4*)gt, h0 = *(const f32x4*)gm;
          x0.x += h0.x * lo2f(mw.x) + g0.x * v[0]; x0.y += h0.y * hi2f(mw.x) + g0.y * v[1]; x0.z += h0.z * lo2f(mw.y) + g0.z * v[2]; x0.w += h0.w * hi2f(mw.y) + g0.w * v[3];
          *(f32x4*)(out + off) = x0; }
        { f32x4 x1 = *(const f32x4*)(x + off + 4); const f32x4 g1 = *(const f32x4*)(gt + 4), h1 = *(const f32x4*)(gm + 4);
          x1.x += h1.x * lo2f(mw.z) + g1.x * v[4]; x1.y += h1.y * hi2f(mw.z) + g1.y * v[5]; x1.z += h1.z * lo2f(mw.w) + g1.z * v[6]; x1.w += h1.w * hi2f(mw.w) + g1.w * v[7];
          *(f32x4*)(out + off + 4) = x1; }
    } };
struct EpiDown { bf16* YS;
    __device__ __forceinline__ void store8(const Unit& u, int r, int c, const float (&v)[8]) const {
        const size_t row = (size_t)u.pm * 256 + r; *(u32x4*)(YS + row * 1024 + (u.pn & 3) * 256 + c) = pack8(v);
    } };


namespace pg8 {
#define PG8_LAS __attribute__((address_space(3)))
typedef ::bf16x8 bf16x8; typedef ::f32x4 f32x4;
using ::Unit; using ::Gemm;
constexpr int BM = 256, BK = 64, HALF = 128, HTB = HALF * BK * 2  , STAGE_BYTES = 8 * HTB;

__device__ __forceinline__ int lds_byte(int r, int c) { const int st = (r >> 4) * 2 + (c >> 5), rr = r & 15, cc = c & 31, ob = rr * 64 + cc * 2; return st * 1024 + (ob ^ (((ob >> 9) & 1) << 5)); }
__device__ __forceinline__ void stage_rc(int b, int& R, int& C) { const int st = b / 1024, sb = b % 1024, swz = sb ^ (((sb >> 9) & 1) << 5); R = (st >> 1) * 16 + swz / 64; C = (st & 1) * 32 + (swz % 64) / 2; }
__device__ __forceinline__ int perm32(int rho) { const int n = rho >> 4, i = rho & 15; return 8 * (i >> 2) + 4 * n + (i & 3); }
template <class Epi, class Sched, bool ALIGN_EPI = false, bool SP2 = false, bool GATHER = false, bool MIDHOOK = false, bool BSEG = false>
__device__ __forceinline__ void gemm_phase(PG8_LAS unsigned char* lds, const Gemm g, const Sched& S, const Epi& E, const int wave_in) {
    const int lane = lane_id_fresh(), wid = wave_in, tid = wid * 64 + lane,
              wr = wid >> 2, wc = wid & 3, fr = lane & 15, fq = lane >> 4;
    const int K = g.K, nt = K / BK;
    unsigned voffA[2], voffB[2];
#pragma unroll
    for (int i = 0; i < 2; ++i) { int R, C; stage_rc(tid * 16 + i * 8192, R, C); const int Rb = Epi::PERM ? ((R & ~31) + perm32(R & 31)) : R;
        voffA[i] = (unsigned)(R * K + C) * 2u; voffB[i] = (unsigned)(Rb * (BSEG ? g.ldb : K) + C) * 2u; }
    unsigned vAc[2][2] = {{0u, 0u}, {0u, 0u}}, vAn[2][2] = {{0u, 0u}, {0u, 0u}}; int gR[2] = {0, 0}; unsigned gC[2] = {0u, 0u};
    if constexpr (GATHER) {
#pragma unroll
        for (int i = 0; i < 2; ++i) { int R, C; stage_rc(tid * 16 + i * 8192, R, C); gR[i] = R; gC[i] = (unsigned)C * 2u; } }
#define PG8_GIDX(dst, pm_) do { _Pragma("unroll") for (int _h = 0; _h < 2; ++_h) _Pragma("unroll") for (int _i = 0; _i < 2; ++_i) \
        { const int ri_ = g.ridx[(pm_) * BM + _h * HALF + gR[_i]]; dst[_h][_i] = (unsigned)(ri_ < 0 ? 0 : ri_) * (unsigned)(K * 2) + gC[_i]; } } while (0)
    const size_t kstep = (size_t)(BK * 2);
    const size_t hstep = (size_t)HALF * K * 2;
    const size_t tstep = 2 * hstep;
    const size_t hstepB = BSEG ? (size_t)HALF * g.ldb * 2 : hstep, tstepB = 2 * hstepB; const int nh = nt / 2;
    const unsigned ldsw = (unsigned)wid * 1024u;
    const int aoff = lds_byte(wr * 64 + fr, fq * 8), boff = lds_byte(wc * 32 + fr, fq * 8);
#define PG8_SA(b, h) (((b) * 2 + (h)) * HTB)
#define PG8_SB(b, h) ((4 + (b) * 2 + (h)) * HTB)
#define PG8_STAGE(bufoff, gbase, voff) do { _Pragma("unroll") for (int _i = 0; _i < 2; ++_i) \
        __builtin_amdgcn_global_load_lds((const unsigned*)((const char*)(gbase) + (voff)[_i]), (PG8_LAS unsigned*)(lds + (bufoff) + ldsw + _i * 8192), 16, 0, 0); } while (0)
#define PG8_STAGE_A(bufoff, kptr, h, isnext) do { if constexpr (GATHER) { unsigned _v[2]; _v[0] = (isnext) ? vAn[h][0] : vAc[h][0]; _v[1] = (isnext) ? vAn[h][1] : vAc[h][1]; PG8_STAGE(bufoff, kptr, _v); } \
        else { PG8_STAGE(bufoff, (kptr) + (h) * hstep, voffA); } } while (0)
#define PG8_LDA(dst, b, h) do { _Pragma("unroll") for (int m = 0; m < 4; ++m) _Pragma("unroll") for (int k = 0; k < 2; ++k) dst[m][k] = *(const PG8_LAS bf16x8*)(lds + PG8_SA(b, h) + aoff + m * 2048 + k * 1024); } while (0)
#define PG8_LDB(dst, b, h) do { _Pragma("unroll") for (int n = 0; n < 2; ++n) _Pragma("unroll") for (int k = 0; k < 2; ++k) dst[n][k] = *(const PG8_LAS bf16x8*)(lds + PG8_SB(b, h) + boff + n * 2048 + k * 1024); } while (0)
#define PG8_MMA(ai, bj, At, Bt) do { __builtin_amdgcn_s_setprio(1); _Pragma("unroll") for (int m = 0; m < 4; ++m) _Pragma("unroll") for (int n = 0; n < 2; ++n) _Pragma("unroll") for (int k = 0; k < 2; ++k) \
        acc[ai][bj][m][n] = __builtin_amdgcn_mfma_f32_16x16x32_bf16(Bt[n][k], At[m][k], acc[ai][bj][m][n], 0, 0, 0); __builtin_amdgcn_s_setprio(0); } while (0)
#define PG8_WAIT_V(n) asm volatile("s_waitcnt vmcnt(" #n ")" ::: "memory")
#define PG8_WAIT_L(n) asm volatile("s_waitcnt lgkmcnt(" #n ")" ::: "memory")
#define PG8_BAR __builtin_amdgcn_s_barrier()
#define PG8_SCHED __builtin_amdgcn_sched_barrier(0)
    Unit cur, nxt; int ui = 0;
    if (!S.next(0, cur)) return;
    f32x4 acc[2][2][4][2];
#pragma unroll
    for (int a = 0; a < 2; ++a)
#pragma unroll
        for (int b = 0; b < 2; ++b)
#pragma unroll
            for (int m = 0; m < 4; ++m)
#pragma unroll
                for (int n = 0; n < 2; ++n) acc[a][b][m][n] = (f32x4){0.f, 0.f, 0.f, 0.f};
    bf16x8 At[4][2], B0[2][2], B1[2][2];
    const char* cA = (const char*)g.A + (GATHER ? (size_t)0 : (size_t)cur.pm * tstep); const char* cB = (const char*)g.Bt + (size_t)cur.pn * tstepB; const char* cB2 = (const char*)g.Bt + (size_t)(BSEG ? cur.aux : cur.pn) * tstepB;
    if constexpr (GATHER) PG8_GIDX(vAc, cur.pm);
    S.a_ready(cur);
    if constexpr (SP2) {
        PG8_STAGE(PG8_SB(0, 0), cB, voffB); PG8_STAGE(PG8_SB(0, 1), cB + hstepB, voffB); PG8_STAGE_A(PG8_SA(0, 0), cA, 0, false); PG8_STAGE_A(PG8_SA(0, 1), cA, 1, false);
        if (wr == 1) PG8_BAR;
        PG8_WAIT_V(2); PG8_BAR;
        PG8_STAGE(PG8_SB(1, 0), cB + kstep, voffB); PG8_STAGE_A(PG8_SA(1, 0), cA + kstep, 0, false); PG8_STAGE(PG8_SB(1, 1), cB + hstepB + kstep, voffB);
        PG8_WAIT_V(6); PG8_BAR;
    } else {
        PG8_STAGE(PG8_SB(0, 0), cB, voffB); PG8_STAGE(PG8_SA(0, 0), cA, voffA); PG8_STAGE(PG8_SB(0, 1), cB + hstep, voffB); PG8_STAGE(PG8_SA(0, 1), cA + hstep, voffA);
        if (wr == 1) PG8_BAR;
        PG8_WAIT_V(4); PG8_BAR;
        PG8_STAGE(PG8_SB(1, 0), cB + kstep, voffB); PG8_STAGE(PG8_SA(1, 0), cA + kstep, voffA); PG8_STAGE(PG8_SB(1, 1), cB + hstep + kstep, voffB);
        PG8_WAIT_V(6); PG8_BAR;
    }
    for (;;) {
        const bool has_next = S.next(ui + 1, nxt);
        const char* nA = (has_next && !GATHER) ? (const char*)g.A + (size_t)nxt.pm * tstep : cA; const char* nB = has_next ? (const char*)g.Bt + (size_t)nxt.pn * tstepB : cB; const char* nB2 = (has_next && BSEG) ? (const char*)g.Bt + (size_t)nxt.aux * tstepB : (BSEG ? cB2 : nB);
        if constexpr (GATHER) { if (has_next) PG8_GIDX(vAn, nxt.pm); else { _Pragma("unroll") for (int _h = 0; _h < 2; ++_h) { vAn[_h][0] = vAc[_h][0]; vAn[_h][1] = vAc[_h][1]; } } }
        for (int t = 0; t < nt; t += 2) {
            if constexpr (MIDHOOK) { if (t == nt / 2) { E.mid(acc, cur, wr, wc, fr, fq); PG8_WAIT_V(0); } }
            const bool last = (t == nt - 2);
            const char* a1 = cA + (size_t)(t + 1) * kstep;
            const char* a2 = last ? nA : cA + (size_t)(t + 2) * kstep; const char* b2 = last ? nB : ((BSEG && t + 2 >= nh) ? cB2 + (size_t)(t + 2 - nh) * kstep : cB + (size_t)(t + 2) * kstep);
            const char* a3 = a2 + kstep; const char* b3 = b2 + kstep;
            if (last && has_next) S.a_ready(nxt);
            if constexpr (SP2) {
            PG8_LDB(B0, 0, 0); PG8_LDB(B1, 0, 1); PG8_SCHED; PG8_LDA(At, 0, 0); PG8_STAGE_A(PG8_SA(1, 1), a1, 1, false);
            PG8_WAIT_V(8); PG8_WAIT_L(0); PG8_BAR; PG8_MMA(0, 0, At, B0); PG8_MMA(0, 1, At, B1); PG8_BAR; PG8_SCHED;
            PG8_LDA(At, 0, 1); PG8_STAGE(PG8_SB(0, 0), b2, voffB); PG8_STAGE(PG8_SB(0, 1), b2 + hstepB, voffB); PG8_STAGE_A(PG8_SA(0, 0), a2, 0, last);
            PG8_WAIT_V(8); PG8_WAIT_L(0); PG8_BAR; PG8_MMA(1, 0, At, B0); PG8_MMA(1, 1, At, B1); PG8_BAR; PG8_SCHED;
            PG8_LDB(B0, 1, 0); PG8_LDB(B1, 1, 1); PG8_SCHED; PG8_LDA(At, 1, 0); PG8_STAGE_A(PG8_SA(0, 1), a2, 1, last);
            PG8_WAIT_V(8); PG8_WAIT_L(0); PG8_BAR; PG8_MMA(0, 0, At, B0); PG8_MMA(0, 1, At, B1); PG8_BAR; PG8_SCHED;
            PG8_LDA(At, 1, 1); PG8_STAGE(PG8_SB(1, 0), b3, voffB); PG8_STAGE(PG8_SB(1, 1), b3 + hstepB, voffB); PG8_STAGE_A(PG8_SA(1, 0), a3, 0, last);
            PG8_WAIT_V(8); PG8_WAIT_L(0); PG8_BAR; PG8_MMA(1, 0, At, B0); PG8_MMA(1, 1, At, B1); PG8_BAR; PG8_SCHED;
            } else {
            PG8_LDB(B0, 0, 0); PG8_SCHED; PG8_LDA(At, 0, 0); PG8_STAGE(PG8_SA(1, 1), a1 + hstep, voffA);
            PG8_WAIT_L(8); PG8_BAR; PG8_WAIT_L(0); PG8_MMA(0, 0, At, B0); PG8_BAR; PG8_SCHED;
            PG8_LDB(B1, 0, 1); PG8_STAGE(PG8_SB(0, 0), b2, voffB);
            PG8_BAR; PG8_WAIT_L(0); PG8_MMA(0, 1, At, B1); PG8_BAR;
            PG8_LDA(At, 0, 1); PG8_STAGE(PG8_SA(0, 0), a2, voffA);
            PG8_BAR; PG8_WAIT_L(0); PG8_MMA(1, 0, At, B0); PG8_BAR; PG8_SCHED;
            PG8_STAGE(PG8_SB(0, 1), b2 + hstep, voffB);
            PG8_WAIT_V(6); PG8_BAR; PG8_MMA(1, 1, At, B1); PG8_BAR;
            PG8_LDB(B0, 1, 0); PG8_SCHED; PG8_LDA(At, 1, 0); PG8_STAGE(PG8_SA(0, 1), a2 + hstep, voffA);
            PG8_WAIT_L(8); PG8_BAR; PG8_WAIT_L(0); PG8_MMA(0, 0, At, B0); PG8_BAR; PG8_SCHED;
            PG8_LDB(B1, 1, 1); PG8_STAGE(PG8_SB(1, 0), b3, voffB);
            PG8_BAR; PG8_WAIT_L(0); PG8_MMA(0, 1, At, B1); PG8_BAR;
            PG8_LDA(At, 1, 1); PG8_STAGE(PG8_SA(1, 0), a3, voffA);
            PG8_BAR; PG8_WAIT_L(0); PG8_MMA(1, 0, At, B0); PG8_BAR; PG8_SCHED;
            PG8_STAGE(PG8_SB(1, 1), b3 + hstep, voffB);
            PG8_WAIT_V(6); PG8_BAR; PG8_MMA(1, 1, At, B1); PG8_BAR;
            }
        }
        if constexpr (ALIGN_EPI) { if (wr == 0) PG8_BAR; }
        if constexpr (!Epi::AFTER_DRAIN) { E(acc, cur, wr, wc, fr, fq); S.done(cur); }
        if (!has_next) break;
#pragma unroll
        for (int a = 0; a < 2; ++a)
#pragma unroll
            for (int b = 0; b < 2; ++b)
#pragma unroll
                for (int m = 0; m < 4; ++m)
#pragma unroll
                    for (int n = 0; n < 2; ++n) acc[a][b][m][n] = (f32x4){0.f, 0.f, 0.f, 0.f};
        cur = nxt; cA = nA; cB = nB; cB2 = nB2; ++ui;
        if constexpr (GATHER) { _Pragma("unroll") for (int _h = 0; _h < 2; ++_h) { vAc[_h][0] = vAn[_h][0]; vAc[_h][1] = vAn[_h][1]; } }
        if constexpr (ALIGN_EPI) { if (wr == 1) PG8_BAR; }
    }
    PG8_WAIT_V(0);
    if constexpr (!ALIGN_EPI) { if (wr == 0) PG8_BAR; }
    PG8_BAR;
    if constexpr (Epi::AFTER_DRAIN) { E.fused(acc, cur, wr, wc, fr, fq, lds, wid, lane); S.done(cur); }
#undef PG8_SA
#undef PG8_SB
#undef PG8_STAGE
#undef PG8_STAGE_A
#undef PG8_GIDX
#undef PG8_LDA
#undef PG8_LDB
#undef PG8_MMA
#undef PG8_WAIT_V
#undef PG8_WAIT_L
#undef PG8_BAR
#undef PG8_SCHED
}

template <class F> struct EpiAdapt {
    static constexpr bool PERM = true, AFTER_DRAIN = false; F f;
    __device__ __forceinline__ void mid(f32x4 (&acc)[2][2][4][2], const Unit& u, int wr, int wc, int fr, int fq) const {
        asm volatile("" : "+v"(fr), "+v"(fq));
#pragma unroll
        for (int ai = 0; ai < 2; ++ai)
#pragma unroll
            for (int m = 0; m < 4; ++m) { const int row = ai * HALF + wr * 64 + m * 16 + fr;
#pragma unroll
                for (int bj = 0; bj < 2; ++bj) { float v[8] = {acc[ai][bj][m][0][0], acc[ai][bj][m][0][1], acc[ai][bj][m][0][2], acc[ai][bj][m][0][3], acc[ai][bj][m][1][0], acc[ai][bj][m][1][1], acc[ai][bj][m][1][2], acc[ai][bj][m][1][3]};
                    f.mid8(u, row, bj * HALF + wc * 32 + 8 * fq, v);
                    acc[ai][bj][m][0] = (f32x4){v[0], v[1], v[2], v[3]}; acc[ai][bj][m][1] = (f32x4){v[4], v[5], v[6], v[7]}; } }
    }
    __device__ __forceinline__ void operator()(const f32x4 (&acc)[2][2][4][2], const Unit& u, int wr, int wc, int fr, int fq) const {
        asm volatile("" : "+v"(fr), "+v"(fq));
#pragma unroll
        for (int ai = 0; ai < 2; ++ai)
#pragma unroll
            for (int m = 0; m < 4; ++m) { const int row = ai * HALF + wr * 64 + m * 16 + fr;
#pragma unroll
                for (int bj = 0; bj < 2; ++bj) { const f32x4 v0 = acc[ai][bj][m][0], v1 = acc[ai][bj][m][1];
                    const float v[8] = {v0[0], v0[1], v0[2], v0[3], v1[0], v1[1], v1[2], v1[3]};
                    f.store8(u, row, bj * HALF + wc * 32 + 8 * fq, v); } }
    }
};
}

template <class Epi, class Sched>
__device__ __forceinline__ void gemm_phase_mid(LAS unsigned char* lds, const Gemm g, const Sched& S, const Epi& E, const int wave_in) {
    pg8::EpiAdapt<Epi> EA{E};
    pg8::gemm_phase<pg8::EpiAdapt<Epi>, Sched, true, true, false, true>(lds, g, S, EA, wave_in);
}
template <class Epi, class Sched>
__device__ __forceinline__ void gemm_phase_bseg(LAS unsigned char* lds, const Gemm g, const Sched& S, const Epi& E, const int wave_in) {
    pg8::EpiAdapt<Epi> EA{E};
    pg8::gemm_phase<pg8::EpiAdapt<Epi>, Sched, true, true, false, false, true>(lds, g, S, EA, wave_in);
}
template <class Epi, class Sched>
__device__ __forceinline__ void gemm_phase_gather(LAS unsigned char* lds, const Gemm g, const Sched& S, const Epi& E, const int wave_in) {
    pg8::EpiAdapt<Epi> EA{E};
    pg8::gemm_phase<pg8::EpiAdapt<Epi>, Sched, true, true, true>(lds, g, S, EA, wave_in);
}
template <class Epi, class Sched>
__device__ __forceinline__ void gemm_phase_any(LAS unsigned char* lds, const Gemm g, const Sched& S, const Epi& E, const int wave_in) {
#if ENG_GEMM == 1
    pg8::EpiAdapt<Epi> EA{E};
    pg8::gemm_phase<pg8::EpiAdapt<Epi>, Sched, true, true>(lds, g, S, EA, wave_in);
#else
    gemm_phase_naive<Epi, Sched>(lds, g, S, E);
#endif
}

template <class RowMap>
__device__ __forceinline__ void transpose_item(const float* W, int ldw, bf16* WT, int ldt, int koff, int k0, int n0, const RowMap& rm, LAS float* scr, int lane) {
#pragma unroll 8
    for (int i = 0; i < 32; ++i) { const int kk = 2 * i + (lane >> 5); scr[kk * 33 + (lane & 31)] = W[(size_t)(k0 + kk) * ldw + n0 + (lane & 31)]; }
    asm volatile("s_waitcnt lgkmcnt(0)" ::: "memory");
    const int c = lane & 7;
#pragma unroll
    for (int j = 0; j < 4; ++j) { const int n = (lane >> 3) + 8 * j; const LAS float* s = scr + (8 * c) * 33 + n;
        u32x4 o; o.x = pk2(s[0 * 33], s[1 * 33]); o.y = pk2(s[2 * 33], s[3 * 33]); o.z = pk2(s[4 * 33], s[5 * 33]); o.w = pk2(s[6 * 33], s[7 * 33]);
        *(u32x4*)(WT + (size_t)rm(n0 + n) * ldt + koff + k0 + 8 * c) = o; }
    asm volatile("s_waitcnt lgkmcnt(0)" ::: "memory");
}
struct RmId { int off; __device__ int operator()(int n) const { return off + n; } };
struct RmWin { __device__ int operator()(int n) const { return n < 1792 ? n : (n < 2208 ? 3840 + (n - 1792) : 1792 + (n - 2208)); } };
struct RmUkv { __device__ int operator()(int n) const { const int h = n >> 7, j = n & 127; return j < 64 ? h * 64 + j : 512 + h * 64 + (j - 64); } };
struct RmGU { int off; __device__ int operator()(int j) const { return off + 8 * (j >> 2) + (j & 3); } };

__device__ __forceinline__ void p0_prologue(const Frame& F, ArgsP a) {
    const int lane_f = lane_id_fresh(), tid_f = F.wave * 64 + lane_f;
    LAS float* scr = (LAS float*)(F.lds + F.wave * 16384);
    const int lane = lane_f;
    bf16* Win = (bf16*)(F.ws + WS_WIN); bf16* Wblk = (bf16*)(F.ws + WS_WBLK); bf16* Wg = (bf16*)(F.ws + WS_WG); bf16* Wuq = (bf16*)(F.ws + WS_WUQ);
    bf16* Wukv = (bf16*)(F.ws + WS_WUKV); bf16* Wb = (bf16*)(F.ws + WS_WB); bf16* Wo = (bf16*)(F.ws + WS_WO); bf16* Wgu = (bf16*)(F.ws + WS_WGU); bf16* Wdn = (bf16*)(F.ws + WS_WDN);
    constexpr int I_IN = 16 * 133, I_DEC = 1 * 16, I_AUP = 16, I_GUP = 2 * 16, I_UQ = 4 * 24, I_UKV = 2 * 32, I_BR = 2 * 8 * 32, I_O = 16 * 32;
    constexpr int I_EG = 32 * 16 * 8, I_EU = I_EG, I_ED = 32 * 4 * 32;
    constexpr int NITEMS = I_IN + I_DEC + I_AUP + I_GUP + I_UQ + I_UKV + I_BR + I_O + I_EG + I_EU + I_ED;
    for (int it = F.gw; it < NITEMS; it += F.NGW) {
        int r = it;
        if (r < I_IN) { const int kb = r / 133, nb = r % 133; transpose_item(a->in[I_WIN], D_IN, Win, 1024, 0, 64 * kb, 32 * nb, RmWin{}, scr, lane); continue; } r -= I_IN;
        if (r < I_DEC) { transpose_item(a->in[I_WDEC], 512, Wblk, 128, 0, 0, 32 * r, RmId{0}, scr, lane); continue; } r -= I_DEC;
        if (r < I_AUP) { transpose_item(a->in[I_WAUP], 512, Wblk, 128, 64, 0, 32 * r, RmId{512}, scr, lane); continue; } r -= I_AUP;
        if (r < I_GUP) { const int kb = r / 16, nb = r % 16; transpose_item(a->in[I_WGUP], 512, Wg, 128, 0, 64 * kb, 32 * nb, RmId{0}, scr, lane); continue; } r -= I_GUP;
        if (r < I_UQ) { const int kb = r / 24, nb = r % 24; transpose_item(a->in[I_WUQ], 768, Wuq, 256, 0, 64 * kb, 32 * nb, RmId{0}, scr, lane); continue; } r -= I_UQ;
        if (r < I_UKV) { const int kb = r / 32, nb = r % 32; transpose_item(a->in[I_WUKV], 1024, Wukv, 128, 0, 64 * kb, 32 * nb, RmUkv{}, scr, lane); continue; } r -= I_UKV;
        if (r < I_BR) { const int br = r / 256, q = r % 256, kb = q / 32, nb = q % 32; transpose_item(a->in[I_WBR] + (size_t)br * 512 * 1024, 1024, Wb, 1024, 512 * br, 64 * kb, 32 * nb, RmId{0}, scr, lane); continue; } r -= I_BR;
        if (r < I_O) { const int kb = r / 32, nb = r % 32; transpose_item(a->in[I_WOUT], 1024, Wo, 1024, 0, 64 * kb, 32 * nb, RmId{0}, scr, lane); continue; } r -= I_O;
        if (r < I_EG) { const int e = r / 128, q = r % 128, kb = q / 8, nb = q % 8; transpose_item(a->in[I_WEG] + (size_t)e * 1024 * 256, 256, Wgu + (size_t)e * 512 * 1024, 1024, 0, 64 * kb, 32 * nb, RmGU{0}, scr, lane); continue; } r -= I_EG;
        if (r < I_EU) { const int e = r / 128, q = r % 128, kb = q / 8, nb = q % 8; transpose_item(a->in[I_WEU] + (size_t)e * 1024 * 256, 256, Wgu + (size_t)e * 512 * 1024, 1024, 0, 64 * kb, 32 * nb, RmGU{4}, scr, lane); continue; } r -= I_EU;
        { const int e = r / 128, q = r % 128, kb = q / 32, nb = q % 32; transpose_item(a->in[I_WED] + (size_t)e * 256 * 1024, 1024, Wdn + (size_t)e * 1024 * 256, 256, 0, 64 * kb, 32 * nb, RmId{0}, scr, lane); }
    }
    for (int i = F.gw * 64 + lane; i < 96 * 128; i += F.NGW * 64) *(u32x4*)(Win + (size_t)4256 * 1024 + (size_t)i * 8) = (u32x4){0u, 0u, 0u, 0u};
    for (int i = F.gw * 64 + lane; i < 1024 * 8; i += F.NGW * 64) { const int row = i >> 3, c8 = (i & 7) * 8; *(u32x4*)(Wblk + row * 128 + (row < 512 ? 64 : 0) + c8) = (u32x4){0u, 0u, 0u, 0u}; }
    { const int* pos = (const int*)a->in[I_POS]; float* cs = (float*)(F.ws + WS_CS);
      for (int i = F.gw * 64 + lane; i < NTOK * 16; i += F.NGW * 64) { const int t = i >> 4, j = i & 15;
          const float fr = exp2f(-(float)j * (13.287712379549449f / 16.0f));
          const float ang = (float)pos[t] * fr; cs[t * 32 + j] = cosf(ang); cs[t * 32 + 16 + j] = sinf(ang); } }
    { float* mod = (float*)(F.ws + WS_MOD); const float* c = a->in[I_C]; const float* wa = a->in[I_WADA]; const float* ba = a->in[I_BADA];
      LAS float* red = (LAS float*)(F.lds + 8 * 16384);
      LAS float* sc = (LAS float*)F.lds;
      if (F.vcu < 96) {
          __syncthreads();
          for (int i = tid_f; i < 8192; i += NTHR) sc[i] = siluf_(c[i]);
          __syncthreads();
      }
      for (int nb = F.vcu; nb < 96; nb += F.G) {
          float acc[8];
#pragma unroll
          for (int b = 0; b < 8; ++b) acc[b] = 0.f;
          const int n = nb * 64 + lane;
          for (int k0 = F.wave * 128; k0 < F.wave * 128 + 128; k0 += 16) { float w[16];
#pragma unroll
              for (int kk = 0; kk < 16; ++kk) w[kk] = wa[(size_t)(k0 + kk) * 6144 + n];
#pragma unroll
              for (int kk = 0; kk < 16; ++kk)
#pragma unroll
                  for (int b = 0; b < 8; ++b) acc[b] = fmaf(sc[b * 1024 + k0 + kk], w[kk], acc[b]); }
#pragma unroll
          for (int b = 0; b < 8; ++b) red[(F.wave * 8 + b) * 64 + lane] = acc[b];
          __syncthreads();
          { const int b = F.wave; float s = ba[n];
#pragma unroll
            for (int w = 0; w < 8; ++w) s += red[(w * 8 + b) * 64 + lane];
            mod[b * 6144 + n] = s; }
          __syncthreads();
      } }
}

__device__ __forceinline__ void p_normmod(const Frame& F, const float* x, const float* g, const float* mod, int sh_off, int sc_off, bf16* H) {
    const int lane_f = lane_id_fresh();
    f32x4 xa[4], xb[4];
    { const f32x4* xr = (const f32x4*)(x + (size_t)F.gw * 1024) + lane_f;
#pragma unroll
      for (int j = 0; j < 4; ++j) xa[j] = xr[64 * j]; }
    f32x4 gs[4], sh[4]; int bcur = -1;
#define NM_ROW(CUR, NXT, m_) do { const int mm = (m_); const int b = mm / SEQ; \
        if (b != bcur) { bcur = b; \
            _Pragma("unroll") for (int j = 0; j < 4; ++j) { const int col = 4 * lane_f + 256 * j; gs[j] = *(const f32x4*)(g + col) * (*(const f32x4*)(mod + b * 6144 + sc_off + col) + 1.0f); sh[j] = *(const f32x4*)(mod + b * 6144 + sh_off + col); } \
            asm volatile("s_waitcnt vmcnt(0)" : "+v"(gs[0]), "+v"(gs[1]), "+v"(gs[2]), "+v"(gs[3]), "+v"(sh[0]), "+v"(sh[1]), "+v"(sh[2]), "+v"(sh[3]), "+v"(CUR[0]), "+v"(CUR[1]), "+v"(CUR[2]), "+v"(CUR[3])); } \
        { const int mn = (mm + F.NGW < NTOK) ? mm + F.NGW : mm; const f32x4* xr = (const f32x4*)(x + (size_t)mn * 1024) + lane_f; \
          _Pragma("unroll") for (int j = 0; j < 4; ++j) NXT[j] = xr[64 * j]; } \
        float s = 0.f; \
        _Pragma("unroll") for (int j = 0; j < 4; ++j) s += (CUR[j].x * CUR[j].x + CUR[j].y * CUR[j].y) + (CUR[j].z * CUR[j].z + CUR[j].w * CUR[j].w); \
        const float rstd = 1.0f / sqrtf(wave_sum(s) * (1.f / 1024.f) + EPS); \
        u32x2* o = (u32x2*)(H + (size_t)mm * 1024) + lane_f; \
        _Pragma("unroll") for (int j = 0; j < 4; ++j) { const f32x4 y = CUR[j] * rstd * gs[j] + sh[j]; u32x2 w; w.x = pk2(y.x, y.y); w.y = pk2(y.z, y.w); o[64 * j] = w; } } while (0)
    for (int m = F.gw; m < NTOK; m += 2 * F.NGW) {
        NM_ROW(xa, xb, m);
        if (m + F.NGW < NTOK) NM_ROW(xb, xa, m + F.NGW);
    }
#undef NM_ROW
}

__device__ __forceinline__ void p_prep_a(const Frame& F, ArgsP a) {
    const int lane_f = lane_id_fresh();
    const bf16* ZR = (const bf16*)(F.ws + WS_ZR); const bf16* ZM = (const bf16*)(F.ws + WS_ZM);
    bf16* TWA = (bf16*)(F.ws + WS_TWA); bf16* SGL = (bf16*)(F.ws + WS_SGL); bf16* QA = (bf16*)(F.ws + WS_QA); bf16* KVA = (bf16*)(F.ws + WS_KVA);
    const float* mu = a->in[I_MU]; const float* gqa = a->in[I_GQA]; const float* gkva = a->in[I_GKVA];
    const int lane = lane_f;
    const f32x4 mm = *(const f32x4*)(mu + 1536 + 4 * lane), gq = *(const f32x4*)(gqa + 4 * lane), gk = *(const f32x4*)(gkva + 4 * (lane & 31));
    for (int m0 = F.gw; m0 < NTOK; m0 += 4 * F.NGW) {
        u32x2 cc[4], pp[4], qq[4], kk[4];
#pragma unroll
        for (int u = 0; u < 4; ++u) { const int m = (m0 + u * F.NGW < NTOK) ? m0 + u * F.NGW : m0; const bool first = (m % SEQ) == 0;
            cc[u] = *((const u32x2*)(ZR + (size_t)m * 1792 + 1536) + lane); pp[u] = *((const u32x2*)(ZR + (size_t)(first ? m : m - 1) * 1792 + 1536) + lane);
            qq[u] = *((const u32x2*)(ZM + (size_t)m * 512) + lane); kk[u] = *((const u32x2*)(ZM + (size_t)m * 512 + 256) + (lane & 31)); }
#pragma unroll
        for (int u = 0; u < 4; ++u) { const int m = m0 + u * F.NGW; if (m < NTOK) { const bool first = (m % SEQ) == 0;
            { const u32x2 c = cc[u]; u32x2 p = pp[u]; if (first) { p.x = 0u; p.y = 0u; }
              float z[4] = {lo2f(c.x), hi2f(c.x), lo2f(c.y), hi2f(c.y)}; const float q[4] = {lo2f(p.x), hi2f(p.x), lo2f(p.y), hi2f(p.y)};
              z[0] += (q[0] - z[0]) * mm.x; z[1] += (q[1] - z[1]) * mm.y; z[2] += (q[2] - z[2]) * mm.z; z[3] += (q[3] - z[3]) * mm.w;
              if (lane < 16) { u32x2 w; w.x = pk2(tanhf_(z[0]), tanhf_(z[1])); w.y = pk2(tanhf_(z[2]), tanhf_(z[3])); *((u32x2*)(TWA + (size_t)m * 128) + lane) = w; }
              else if (lane < 32) { u32x2 w; w.x = pk2(z[0], z[1]); w.y = pk2(z[2], z[3]); *((u32x2*)(TWA + (size_t)m * 128) + lane) = w; }
              else { u32x2 w; w.x = pk2(sigmoidf_(z[0]), sigmoidf_(z[1])); w.y = pk2(sigmoidf_(z[2]), sigmoidf_(z[3])); *((u32x2*)(SGL + (size_t)m * 128) + (lane - 32)) = w; } }
            { const u32x2 c = qq[u]; const float z[4] = {lo2f(c.x), hi2f(c.x), lo2f(c.y), hi2f(c.y)};
              u32x2 c2 = kk[u]; if (lane >= 32) { c2.x = 0u; c2.y = 0u; } const float y[4] = {lo2f(c2.x), hi2f(c2.x), lo2f(c2.y), hi2f(c2.y)};
              const float rstd = 1.0f / sqrtf(wave_sum((z[0] * z[0] + z[1] * z[1]) + (z[2] * z[2] + z[3] * z[3])) * (1.f / 256.f) + EPS);
              const float rstd2 = 1.0f / sqrtf(wave_sum((y[0] * y[0] + y[1] * y[1]) + (y[2] * y[2] + y[3] * y[3])) * (1.f / 128.f) + EPS);
              u32x2 w; w.x = pk2(z[0] * rstd * gq.x, z[1] * rstd * gq.y); w.y = pk2(z[2] * rstd * gq.z, z[3] * rstd * gq.w);
              *((u32x2*)(QA + (size_t)m * 256) + lane) = w;
              if (lane < 32) { u32x2 w2; w2.x = pk2(y[0] * rstd2 * gk.x, y[1] * rstd2 * gk.y); w2.y = pk2(y[2] * rstd2 * gk.z, y[3] * rstd2 * gk.w);
                  *((u32x2*)(KVA + (size_t)m * 128) + lane) = w2; } } } }
    }
}

__device__ __forceinline__ void p_prep_c(const Frame& F, ArgsP a) {
    const int lane_f = lane_id_fresh();
    const bf16* KN = (const bf16*)(F.dob + DO_KN); const bf16* ZM = (const bf16*)(F.ws + WS_ZM); bf16* KC = (bf16*)(F.ws + WS_KC);
    const float* cs = (const float*)(F.ws + WS_CS); const float* kn = a->in[I_KN];
    const int lane = lane_f, hd = lane >> 3, j = lane & 7;
    const f32x4 kg0 = *(const f32x4*)(kn + 8 * j), kg1 = *(const f32x4*)(kn + 8 * j + 4); const f32x2 kr1 = *(const f32x2*)(kn + 64 + 2 * j), kr2 = *(const f32x2*)(kn + 80 + 2 * j);
    for (int m0 = F.gw; m0 < NTOK; m0 += 4 * F.NGW) {
        u32x4 kv[4]; unsigned z1[4], z2[4]; f32x2 cc[4], sn[4];
#pragma unroll
        for (int u = 0; u < 4; ++u) { const size_t m = (size_t)((m0 + u * F.NGW < NTOK) ? m0 + u * F.NGW : m0);
            kv[u] = *(const u32x4*)(KN + m * 512 + hd * 64 + 8 * j); z1[u] = *(const unsigned*)(ZM + m * 512 + 384 + 2 * j); z2[u] = *(const unsigned*)(ZM + m * 512 + 400 + 2 * j);
            cc[u] = *(const f32x2*)(cs + m * 32 + 2 * j); sn[u] = *(const f32x2*)(cs + m * 32 + 16 + 2 * j); }
#pragma unroll
        for (int u = 0; u < 4; ++u) { const int m = m0 + u * F.NGW; if (m < NTOK) {
            float v[8]; unpack8(kv[u], v); float x1[2] = {lo2f(z1[u]), hi2f(z1[u])}, x2[2] = {lo2f(z2[u]), hi2f(z2[u])};
            float ss = (x1[0] * x1[0] + x1[1] * x1[1]) + (x2[0] * x2[0] + x2[1] * x2[1]);
#pragma unroll
            for (int i = 0; i < 8; ++i) ss += v[i] * v[i];
            const float rstd = 1.0f / sqrtf(sum8(ss) * (1.f / 96.f) + EPS);
            v[0] *= rstd * kg0.x; v[1] *= rstd * kg0.y; v[2] *= rstd * kg0.z; v[3] *= rstd * kg0.w; v[4] *= rstd * kg1.x; v[5] *= rstd * kg1.y; v[6] *= rstd * kg1.z; v[7] *= rstd * kg1.w;
            x1[0] *= rstd * kr1.x; x1[1] *= rstd * kr1.y; x2[0] *= rstd * kr2.x; x2[1] *= rstd * kr2.y;
            bf16* kp = KC + (size_t)m * 768 + hd * 96;
            *(u32x4*)(kp + 8 * j) = pack8(v); *(unsigned*)(kp + 64 + 2 * j) = pk2(x1[0] * cc[u].x - x2[0] * sn[u].x, x1[1] * cc[u].y - x2[1] * sn[u].y);
            *(unsigned*)(kp + 80 + 2 * j) = pk2(x2[0] * cc[u].x + x1[0] * sn[u].x, x2[1] * cc[u].y + x1[1] * sn[u].y); } }
    }
}

__device__ __forceinline__ void p_attn_naive(const Frame& F) {
    const int lane_f = lane_id_fresh(), tid_f = F.wave * 64 + lane_f;
    const bf16* Q = (const bf16*)(F.dob + DO_Q); const bf16* KC = (const bf16*)(F.ws + WS_KC); const bf16* VC = (const bf16*)(F.ws + WS_VC); bf16* YM = (bf16*)(F.ws + WS_YM);
    LAS float* Ks = (LAS float*)F.lds; LAS float* Vs = (LAS float*)(F.lds + 32 * 96 * 4);
    const int tid = tid_f;
    for (int unit = F.vcu; unit < 64 * 16; unit += F.G) {
        const int bh = unit >> 4, qb = 15 - (unit & 15), b = bh >> 3, h = bh & 7; const size_t row0 = (size_t)b * SEQ; const int t = qb * 512 + tid;
        unsigned qp[48];
        { const u32x4* qg = (const u32x4*)(Q + (row0 + t) * 768 + h * 96);
#pragma unroll
          for (int i = 0; i < 12; ++i) { const u32x4 w = qg[i]; qp[4 * i] = w.x; qp[4 * i + 1] = w.y; qp[4 * i + 2] = w.z; qp[4 * i + 3] = w.w; } }
        float o[64];
#pragma unroll
        for (int i = 0; i < 64; ++i) o[i] = 0.f;
        float mx = -INFINITY, l = 0.f;
        const int nkt = (qb + 1) * 16;
        for (int kt = 0; kt < nkt; ++kt) {
            __syncthreads();
            if (tid < 384) { const int r = tid / 12, c8 = (tid % 12) * 8; float v[8]; unpack8(*(const u32x4*)(KC + (row0 + kt * 32 + r) * 768 + h * 96 + c8), v);
#pragma unroll
                for (int i = 0; i < 8; ++i) Ks[r * 96 + c8 + i] = v[i]; }
            if (tid < 256) { const int r = tid >> 3, c8 = (tid & 7) * 8; float v[8]; unpack8(*(const u32x4*)(VC + (row0 + kt * 32 + r) * 512 + h * 64 + c8), v);
#pragma unroll
                for (int i = 0; i < 8; ++i) Vs[r * 64 + c8 + i] = v[i]; }
            __syncthreads();
            for (int kk = 0; kk < 32; ++kk) {
                const int kv = kt * 32 + kk;
                float s = 0.f; const LAS f32x4* kr = (const LAS f32x4*)(Ks + kk * 96);
#pragma unroll
                for (int i = 0; i < 24; ++i) { const f32x4 k4 = kr[i]; s += lo2f(qp[2 * i]) * k4.x + hi2f(qp[2 * i]) * k4.y + lo2f(qp[2 * i + 1]) * k4.z + hi2f(qp[2 * i + 1]) * k4.w; }
                if (kv <= t) {
                    const float mn = fmaxf(mx, s), f = exp2f(mx - mn), p = exp2f(s - mn); mx = mn; l = l * f + p;
                    const LAS f32x4* vr = (const LAS f32x4*)(Vs + kk * 64);
#pragma unroll
                    for (int i = 0; i < 16; ++i) { const f32x4 v4 = vr[i]; o[4 * i] = o[4 * i] * f + p * v4.x; o[4 * i + 1] = o[4 * i + 1] * f + p * v4.y; o[4 * i + 2] = o[4 * i + 2] * f + p * v4.z; o[4 * i + 3] = o[4 * i + 3] * f + p * v4.w; }
                }
            }
        }
        const float il = 1.f / l; u32x4* og = (u32x4*)(YM + (row0 + t) * 512 + h * 64);
#pragma unroll
        for (int i = 0; i < 8; ++i) { u32x4 w; w.x = pk2(o[8 * i] * il, o[8 * i + 1] * il); w.y = pk2(o[8 * i + 2] * il, o[8 * i + 3] * il); w.z = pk2(o[8 * i + 4] * il, o[8 * i + 5] * il); w.w = pk2(o[8 * i + 6] * il, o[8 * i + 7] * il); og[i] = w; }
    }
    __syncthreads();
}

typedef float f32x16 __attribute__((ext_vector_type(16)));
typedef short s16x4 __attribute__((ext_vector_type(4)));
__device__ __forceinline__ int crow(int r, int hi) { return (r & 3) + 8 * (r >> 2) + 4 * hi; }
__device__ __forceinline__ float max3f(float a, float b, float c) { float r; asm("v_max3_f32 %0, %1, %2, %3" : "=v"(r) : "v"(a), "v"(b), "v"(c)); return r; }
__device__ __forceinline__ float max2f(float a, float b) { float r; asm("v_max_f32_e32 %0, %1, %2" : "=v"(r) : "v"(a), "v"(b)); return r; }
__device__ __forceinline__ float xhalf_max(float x) { auto rr = __builtin_amdgcn_permlane32_swap(__float_as_uint(x), __float_as_uint(x), false, false); return max2f(__uint_as_float(rr[0]), __uint_as_float(rr[1])); }
__device__ __forceinline__ float xhalf_sum(float x) { auto rr = __builtin_amdgcn_permlane32_swap(__float_as_uint(x), __float_as_uint(x), false, false); return __uint_as_float(rr[0]) + __uint_as_float(rr[1]); }
__device__ __forceinline__ bf16x8 packp(const f32x16& p, int s2) {
    u32x4 w; w.x = pk2(p[8 * s2 + 0], p[8 * s2 + 1]); w.y = pk2(p[8 * s2 + 2], p[8 * s2 + 3]); w.z = pk2(p[8 * s2 + 4], p[8 * s2 + 5]); w.w = pk2(p[8 * s2 + 6], p[8 * s2 + 7]);
    return __builtin_bit_cast(bf16x8, w);
}
__device__ __forceinline__ void p_attn_mfma(const Frame& F, const float* qn) {
    const int lane_f = lane_id_fresh(), tid_f = F.wave * 64 + lane_f;
    const bf16* Q = (const bf16*)(F.dob + DO_Q); const bf16* KC = (const bf16*)(F.ws + WS_KC); const bf16* VC = (const bf16*)(F.ws + WS_VC); bf16* YM = (bf16*)(F.ws + WS_YM);
    const float* cs = (const float*)(F.ws + WS_CS);
    constexpr int KST = 208, VST = 192, KBYTES = 64 * KST, SUB = KBYTES + 64 * VST, BUF = 2 * SUB;
    const int tid = tid_f, lane = lane_f, wave = F.wave, r = lane & 31, hi = lane >> 5;
    int kg[3], kl[3], vg[2], vl[2];
#pragma unroll
    for (int i = 0; i < 3; ++i) { const int c = tid + 512 * i, row = c / 12, pc = c % 12; kg[i] = row * 768 + pc * 8; kl[i] = (row >> 6) * SUB + (row & 63) * KST + pc * 16; }
#pragma unroll
    for (int i = 0; i < 2; ++i) { const int c = tid + 512 * i, row = c >> 3, pc = c & 7; vg[i] = row * 512 + pc * 8; vl[i] = (row >> 6) * SUB + KBYTES + (row & 63) * VST + pc * 16; }
    const int g4 = lane >> 4, li = lane & 15;
    const int vtr = (4 * (g4 >> 1) + (li >> 2)) * VST + (16 * (g4 & 1) + 4 * (li & 3)) * 2;
    const int kfr = r * KST + hi * 16;
    LAS unsigned char* lds = F.lds;
    for (int item = F.vcu; item < 1024; item += F.G) {
        const int bh = item >> 4, sidx = item & 15, b = bh >> 3, h = bh & 7; const size_t row0 = (size_t)b * SEQ;
        const bf16* Kg = KC + row0 * 768 + h * 96; const bf16* Vg = VC + row0 * 512 + h * 64;
        for (int uu = 0; uu < 2; ++uu) {
            const int qb = uu == 0 ? 31 - sidx : sidx, q0 = qb * 256, NT = (q0 + 256) / 128;
            const int qw = q0 + wave * 32;
            bf16x8 qf[6];
            {
              const bf16* qp = Q + (row0 + qw + r) * 768 + h * 96 + hi * 8; const float* csr = cs + (row0 + qw + r) * 32 + 8 * hi;
              u32x4 raw[6];
#pragma unroll
              for (int s = 0; s < 6; ++s) raw[s] = *(const u32x4*)(qp + 16 * s);
              const f32x4 c0 = *(const f32x4*)csr, c1 = *(const f32x4*)(csr + 4), s0 = *(const f32x4*)(csr + 16), s1 = *(const f32x4*)(csr + 20);
              float ss = 0.f;
#pragma unroll
              for (int s = 0; s < 6; ++s) { float t[8]; unpack8(raw[s], t);
#pragma unroll
                  for (int e = 0; e < 8; ++e) ss += t[e] * t[e]; }
              const float rstd = QSCALE / sqrtf(xhalf_sum(ss) * (1.f / 96.f) + EPS);
#pragma unroll
              for (int s = 0; s < 4; ++s) { float t[8]; unpack8(raw[s], t); const f32x4 g0 = *(const f32x4*)(qn + 16 * s + 8 * hi), g1 = *(const f32x4*)(qn + 16 * s + 8 * hi + 4);
                  t[0] *= rstd * g0.x; t[1] *= rstd * g0.y; t[2] *= rstd * g0.z; t[3] *= rstd * g0.w; t[4] *= rstd * g1.x; t[5] *= rstd * g1.y; t[6] *= rstd * g1.z; t[7] *= rstd * g1.w;
                  qf[s] = __builtin_bit_cast(bf16x8, pack8(t)); }
              { float a4[8], a5[8]; unpack8(raw[4], a4); unpack8(raw[5], a5);
                const f32x4 g0 = *(const f32x4*)(qn + 64 + 8 * hi), g1 = *(const f32x4*)(qn + 64 + 8 * hi + 4), h0 = *(const f32x4*)(qn + 80 + 8 * hi), h1 = *(const f32x4*)(qn + 80 + 8 * hi + 4);
                const float ga[8] = {g0.x, g0.y, g0.z, g0.w, g1.x, g1.y, g1.z, g1.w}, gb[8] = {h0.x, h0.y, h0.z, h0.w, h1.x, h1.y, h1.z, h1.w};
                const float cc[8] = {c0.x, c0.y, c0.z, c0.w, c1.x, c1.y, c1.z, c1.w}, sn[8] = {s0.x, s0.y, s0.z, s0.w, s1.x, s1.y, s1.z, s1.w};
#pragma unroll
                for (int e = 0; e < 8; ++e) { const float x1 = a4[e] * rstd * ga[e], x2 = a5[e] * rstd * gb[e]; a4[e] = x1 * cc[e] - x2 * sn[e]; a5[e] = x2 * cc[e] + x1 * sn[e]; }
                qf[4] = __builtin_bit_cast(bf16x8, pack8(a4)); qf[5] = __builtin_bit_cast(bf16x8, pack8(a5)); } }
            f32x16 o0 = {}, o1 = {}, negm = {}; float m = 0.f, l = 0.f;
            u32x4 ak[3], av[2];
#pragma unroll
            for (int i = 0; i < 3; ++i) ak[i] = *(const u32x4*)(Kg + kg[i]);
#pragma unroll
            for (int i = 0; i < 2; ++i) av[i] = *(const u32x4*)(Vg + vg[i]);
            asm volatile("" : "+v"(qf[0]), "+v"(qf[1]), "+v"(qf[2]), "+v"(qf[3]), "+v"(qf[4]), "+v"(qf[5]));
            LDS_BAR();
#pragma unroll
            for (int i = 0; i < 3; ++i) *(LAS u32x4*)(lds + kl[i]) = ak[i];
#pragma unroll
            for (int i = 0; i < 2; ++i) *(LAS u32x4*)(lds + vl[i]) = av[i];
            LDS_BAR();
            for (int t = 0; t < NT; ++t) {
                LAS unsigned char* bb = lds + (t & 1) * BUF;
                { const int tn = (t + 1 < NT) ? t + 1 : t;
                  const bf16* kgp = Kg + (size_t)tn * 128 * 768; const bf16* vgp = Vg + (size_t)tn * 128 * 512;
#pragma unroll
                  for (int i = 0; i < 3; ++i) ak[i] = *(const u32x4*)(kgp + kg[i]);
#pragma unroll
                  for (int i = 0; i < 2; ++i) av[i] = *(const u32x4*)(vgp + vg[i]); }
#pragma unroll
                for (int sub = 0; sub < 2; ++sub) {
                    const int tt = 2 * t + sub;
                    if (64 * tt <= qw + 31) {
                        LAS unsigned char* kb = bb + sub * SUB; LAS unsigned char* vb = kb + KBYTES;
                        bf16x8 kf0[6], kf1[6];
#pragma unroll
                        for (int s = 0; s < 6; ++s) { kf0[s] = *(const LAS bf16x8*)(kb + kfr + s * 32); kf1[s] = *(const LAS bf16x8*)(kb + kfr + 32 * KST + s * 32); }
                        __builtin_amdgcn_sched_barrier(0);
                        f32x16 p0 = negm, p1 = negm;
#pragma unroll
                        for (int s = 0; s < 6; ++s) { p0 = __builtin_amdgcn_mfma_f32_32x32x16_bf16(kf0[s], qf[s], p0, 0, 0, 0); p1 = __builtin_amdgcn_mfma_f32_32x32x16_bf16(kf1[s], qf[s], p1, 0, 0, 0); }
                        if (64 * tt + 63 > qw) {
                            int hm = hi; asm volatile("" : "+v"(hm));
                            const int qrel = qw + r - 64 * tt - 4 * hm;
#pragma unroll
                            for (int rg = 0; rg < 16; ++rg) { const int kv = (rg & 3) + 8 * (rg >> 2); if (kv > qrel) p0[rg] = -INFINITY; if (kv + 32 > qrel) p1[rg] = -INFINITY; }
                        }
                        float mx;
                        { float a = max3f(p0[0], p0[1], p1[0]), b2 = max3f(p0[2], p0[3], p1[1]); a = max3f(a, p1[2], p1[3]);
#pragma unroll
                          for (int rg = 4; rg < 16; rg += 4) { a = max3f(a, p0[rg], p0[rg + 1]); b2 = max3f(b2, p0[rg + 2], p0[rg + 3]); a = max3f(a, p1[rg], p1[rg + 1]); b2 = max3f(b2, p1[rg + 2], p1[rg + 3]); }
                          mx = xhalf_max(max2f(a, b2)); }
                        if (!__all(mx <= 8.0f)) {
                            const float dl = max2f(mx, 0.f), f = __builtin_amdgcn_exp2f(-dl); m += dl; l *= f;
#pragma unroll
                            for (int rg = 0; rg < 16; ++rg) { p0[rg] -= dl; p1[rg] -= dl; o0[rg] *= f; o1[rg] *= f; negm[rg] = -m; }
                        }
                        float rs = 0.f;
#pragma unroll
                        for (int rg = 0; rg < 16; ++rg) { p0[rg] = __builtin_amdgcn_exp2f(p0[rg]); p1[rg] = __builtin_amdgcn_exp2f(p1[rg]); rs += p0[rg] + p1[rg]; }
                        l += rs;
#pragma unroll
                        for (int hh = 0; hh < 2; ++hh)
#pragma unroll
                            for (int s2 = 0; s2 < 2; ++s2) { const bf16x8 pf = packp(hh == 0 ? p0 : p1, s2);
#pragma unroll
                                for (int db = 0; db < 2; ++db) { LAS unsigned char* vp_ = vb + vtr + (32 * hh + 16 * s2) * VST + db * 64;
                                    const s16x4 lo = __builtin_bit_cast(s16x4, __builtin_amdgcn_ds_read_tr16_b64_v4i16((LAS s16x4*)vp_));
                                    const s16x4 hi4 = __builtin_bit_cast(s16x4, __builtin_amdgcn_ds_read_tr16_b64_v4i16((LAS s16x4*)(vp_ + 8 * VST)));
                                    const bf16x8 vf = (bf16x8){lo[0], lo[1], lo[2], lo[3], hi4[0], hi4[1], hi4[2], hi4[3]};
                                    if (db == 0) o0 = __builtin_amdgcn_mfma_f32_32x32x16_bf16(vf, pf, o0, 0, 0, 0); else o1 = __builtin_amdgcn_mfma_f32_32x32x16_bf16(vf, pf, o1, 0, 0, 0); } }
                    }
                }
                { LAS unsigned char* nb = lds + ((t + 1) & 1) * BUF;
#pragma unroll
                  for (int i = 0; i < 3; ++i) *(LAS u32x4*)(nb + kl[i]) = ak[i];
#pragma unroll
                  for (int i = 0; i < 2; ++i) *(LAS u32x4*)(nb + vl[i]) = av[i]; }
                LDS_BAR();
            }
            const float il = 1.0f / xhalf_sum(l);
            bf16* op = YM + (row0 + qw + r) * YYLD + h * 64 + 4 * hi;
#pragma unroll
            for (int gq = 0; gq < 4; ++gq) { u32x2 w0, w1;
                w0.x = pk2(o0[4 * gq] * il, o0[4 * gq + 1] * il); w0.y = pk2(o0[4 * gq + 2] * il, o0[4 * gq + 3] * il);
                w1.x = pk2(o1[4 * gq] * il, o1[4 * gq + 1] * il); w1.y = pk2(o1[4 * gq + 2] * il, o1[4 * gq + 3] * il);
                *(u32x2*)(op + 8 * gq) = w0; *(u32x2*)(op + 32 + 8 * gq) = w1; }
        }
    }
    __syncthreads();
}

constexpr int CS_CH = 256, CS_NCH = SEQ / CS_CH;
constexpr int CS_RS = 144;
constexpr int CS_IMG = 16 * CS_RS;
constexpr int CS_WAVE = 8 * CS_IMG + 512;
enum { IM_A = 0, IM_R = 1, IM_B = 2, IM_K = 3, IM_BH = 4, IM_KH = 5, IM_V = 6, IM_G = 7 };
constexpr size_t DO_CSP = 64 * MiB, DO_CSG = 128 * MiB, DO_CSZ = 192 * MiB;
__device__ __forceinline__ int crow8(int q, int hi) { return (q & 3) + 8 * ((q >> 2) & 1) + 4 * hi; }
template <int N> __device__ __forceinline__ float dpp_shr0(float x) { return __builtin_bit_cast(float, __builtin_amdgcn_update_dpp(0, __builtin_bit_cast(int, x), 0x110 + N, 0xf, 0xf, true)); }
__device__ __forceinline__ float rowscan16(float x) { x += dpp_shr0<1>(x); x += dpp_shr0<2>(x); x += dpp_shr0<4>(x); x += dpp_shr0<8>(x); return x; }
__device__ __forceinline__ float xsum_16_32(float v) {
    { auto r = __builtin_amdgcn_permlane16_swap(__float_as_uint(v), __float_as_uint(v), false, false); v = __uint_as_float(r[0]) + __uint_as_float(r[1]); }
    { auto r = __builtin_amdgcn_permlane32_swap(__float_as_uint(v), __float_as_uint(v), false, false); v = __uint_as_float(r[0]) + __uint_as_float(r[1]); }
    return v;
}
__device__ __forceinline__ bf16x8 cs_rowfrag(const LAS unsigned char* rowp, int hi, int ks) {
    const LAS unsigned char* p = rowp + (16 * ks + 4 * hi) * 2; const u32x2 a = *(const LAS u32x2*)p, b = *(const LAS u32x2*)(p + 16);
    return __builtin_bit_cast(bf16x8, (u32x4){a.x, a.y, b.x, b.y});
}
__device__ __forceinline__ bf16x8 cs_trfrag(LAS unsigned char* img, int cb, int lane) {
    const int g4 = lane >> 4, li = lane & 15; LAS unsigned char* p = img + (4 * (g4 >> 1) + (li >> 2)) * CS_RS + (32 * cb + 16 * (g4 & 1) + 4 * (li & 3)) * 2;
    const s16x4 lo = __builtin_bit_cast(s16x4, __builtin_amdgcn_ds_read_tr16_b64_v4i16((LAS s16x4*)p));
    const s16x4 h4 = __builtin_bit_cast(s16x4, __builtin_amdgcn_ds_read_tr16_b64_v4i16((LAS s16x4*)(p + 8 * CS_RS)));
    return (bf16x8){lo[0], lo[1], lo[2], lo[3], h4[0], h4[1], h4[2], h4[3]};
}
__device__ __forceinline__ bf16x8 cs_zero8() { return (bf16x8){0, 0, 0, 0, 0, 0, 0, 0}; }
struct CsIn { const bf16 *ZR, *A, *LW, *G; const float *mu, *k_k, *k_a, *r_k; };
template <bool USE_V, bool WITH_Y>
__device__ __forceinline__ void cs_prep(const CsIn& in, size_t row0, int tok0, int h, LAS unsigned char* wl, int lane) {
    const int t = lane & 15, jq = lane >> 4, tok = tok0 + t; const bool first = tok == 0;
    const size_t g = row0 + tok, gp = row0 + (first ? 0 : tok - 1); const int c0 = h * 64 + 16 * jq;
    LAS float* gct = (LAS float*)(wl + 8 * CS_IMG); LAS float* btt = gct + 64;
    u32x4 Lrc[2], Lrp[2], Lkc[2], Lkp[2], Lav[2], Llw[2], Lvc[2], Lvp[2];
#pragma unroll
    for (int hf = 0; hf < 2; ++hf) { const int cc = c0 + 8 * hf;
        Lkc[hf] = *(const u32x4*)(in.ZR + g * 1792 + 512 + cc); Lkp[hf] = *(const u32x4*)(in.ZR + gp * 1792 + 512 + cc);
        Lrc[hf] = *(const u32x4*)(in.ZR + g * 1792 + cc); Lrp[hf] = *(const u32x4*)(in.ZR + gp * 1792 + cc);
        Lav[hf] = *(const u32x4*)(in.A + g * 512 + cc); Llw[hf] = *(const u32x4*)(in.LW + g * 512 + cc);
        if (USE_V) { Lvc[hf] = *(const u32x4*)(in.ZR + g * 1792 + 1024 + cc); Lvp[hf] = *(const u32x4*)(in.ZR + gp * 1792 + 1024 + cc); }
    }
    float inv;
    { float ss = 0.f;
#pragma unroll
      for (int hf = 0; hf < 2; ++hf) { float kc[8], kp[8]; unpack8(Lkc[hf], kc); unpack8(Lkp[hf], kp);
          const f32x4 m0 = *(const f32x4*)(in.mu + 512 + c0 + 8 * hf), m1 = *(const f32x4*)(in.mu + 512 + c0 + 8 * hf + 4), q0 = *(const f32x4*)(in.k_k + c0 + 8 * hf), q1 = *(const f32x4*)(in.k_k + c0 + 8 * hf + 4);
          const float mm[8] = {m0.x, m0.y, m0.z, m0.w, m1.x, m1.y, m1.z, m1.w}, qq[8] = {q0.x, q0.y, q0.z, q0.w, q1.x, q1.y, q1.z, q1.w};
#pragma unroll
          for (int e = 0; e < 8; ++e) { const float zk = kc[e] + ((first ? 0.f : kp[e]) - kc[e]) * mm[e]; const float kr = zk * qq[e]; ss += kr * kr; } }
      inv = 1.0f / fmaxf(sqrtf(xsum_16_32(ss)), 1e-12f); }
    float btacc = 0.f;
#pragma unroll
    for (int hf = 0; hf < 2; ++hf) {
        const int cc = c0 + 8 * hf;
        u32x4 Lgg = {}; if (WITH_Y) Lgg = *(const u32x4*)(in.G + g * 512 + cc);
        float rc[8], rp[8], kc[8], kp[8], av[8], lw[8];
        unpack8(Lrc[hf], rc); unpack8(Lrp[hf], rp); unpack8(Lkc[hf], kc); unpack8(Lkp[hf], kp); unpack8(Lav[hf], av); unpack8(Llw[hf], lw);
        float mr[8], mk[8], qk[8], qa[8], qr[8];
        { const f32x4 a0 = *(const f32x4*)(in.mu + cc), a1 = *(const f32x4*)(in.mu + cc + 4), b0 = *(const f32x4*)(in.mu + 512 + cc), b1 = *(const f32x4*)(in.mu + 512 + cc + 4);
          const f32x4 c0_ = *(const f32x4*)(in.k_k + cc), c1_ = *(const f32x4*)(in.k_k + cc + 4), d0 = *(const f32x4*)(in.k_a + cc), d1 = *(const f32x4*)(in.k_a + cc + 4);
          mr[0] = a0.x; mr[1] = a0.y; mr[2] = a0.z; mr[3] = a0.w; mr[4] = a1.x; mr[5] = a1.y; mr[6] = a1.z; mr[7] = a1.w;
          mk[0] = b0.x; mk[1] = b0.y; mk[2] = b0.z; mk[3] = b0.w; mk[4] = b1.x; mk[5] = b1.y; mk[6] = b1.z; mk[7] = b1.w;
          qk[0] = c0_.x; qk[1] = c0_.y; qk[2] = c0_.z; qk[3] = c0_.w; qk[4] = c1_.x; qk[5] = c1_.y; qk[6] = c1_.z; qk[7] = c1_.w;
          qa[0] = d0.x; qa[1] = d0.y; qa[2] = d0.z; qa[3] = d0.w; qa[4] = d1.x; qa[5] = d1.y; qa[6] = d1.z; qa[7] = d1.w; }
        if (WITH_Y) { const f32x4 e0 = *(const f32x4*)(in.r_k + cc), e1 = *(const f32x4*)(in.r_k + cc + 4); qr[0] = e0.x; qr[1] = e0.y; qr[2] = e0.z; qr[3] = e0.w; qr[4] = e1.x; qr[5] = e1.y; qr[6] = e1.z; qr[7] = e1.w; }
        float oA[8], oR[8], oB[8], oK[8], oBH[8], oKH[8];
#pragma unroll
        for (int e = 0; e < 8; ++e) {
            const float r = rc[e] + ((first ? 0.f : rp[e]) - rc[e]) * mr[e]; const float zk = kc[e] + ((first ? 0.f : kp[e]) - kc[e]) * mk[e];
            const float kq = zk * (1.f + (av[e] - 1.f) * qa[e]); const float kk = zk * qk[e] * inv; const float b = kk * av[e];
            const float Lg = rowscan16(lw[e]); const float eLg = __builtin_amdgcn_exp2f(1.4426950408889634f * Lg); const float enLg = __builtin_amdgcn_rcpf(eLg);
            const float eLgm = __builtin_bit_cast(float, __builtin_amdgcn_update_dpp(0x3f800000, __builtin_bit_cast(int, eLg), 0x111, 0xf, 0xf, false));
            const float eC = __builtin_bit_cast(float, __builtin_amdgcn_ds_bpermute(((lane & 48) | 15) << 2, __builtin_bit_cast(int, eLg)));
            oA[e] = -kk * eLgm; oR[e] = r * eLg; oB[e] = b * enLg; oK[e] = kq * enLg; oBH[e] = oB[e] * eC; oKH[e] = oK[e] * eC;
            if (WITH_Y) btacc += r * kq * qr[e];
            if (t == 15) gct[16 * jq + 8 * hf + e] = eC;
        }
        const int wo = t * CS_RS + (16 * jq + 8 * hf) * 2;
        *(LAS u32x4*)(wl + IM_A * CS_IMG + wo) = pack8(oA); *(LAS u32x4*)(wl + IM_R * CS_IMG + wo) = pack8(oR); *(LAS u32x4*)(wl + IM_B * CS_IMG + wo) = pack8(oB);
        *(LAS u32x4*)(wl + IM_K * CS_IMG + wo) = pack8(oK); *(LAS u32x4*)(wl + IM_BH * CS_IMG + wo) = pack8(oBH); *(LAS u32x4*)(wl + IM_KH * CS_IMG + wo) = pack8(oKH);
        if (USE_V) { float vc[8], vp[8], o[8]; unpack8(Lvc[hf], vc); unpack8(Lvp[hf], vp);
            const f32x4 a0 = *(const f32x4*)(in.mu + 1024 + cc), a1 = *(const f32x4*)(in.mu + 1024 + cc + 4); const float mv[8] = {a0.x, a0.y, a0.z, a0.w, a1.x, a1.y, a1.z, a1.w};
#pragma unroll
            for (int e = 0; e < 8; ++e) o[e] = vc[e] + ((first ? 0.f : vp[e]) - vc[e]) * mv[e];
            *(LAS u32x4*)(wl + IM_V * CS_IMG + wo) = pack8(o); }
        if (WITH_Y) *(LAS u32x4*)(wl + IM_G * CS_IMG + wo) = Lgg;
    }
    if (WITH_Y) { btacc = xsum_16_32(btacc); if (lane < 16) btt[lane] = btacc; }
}
struct CsFr { bf16x8 fAR[4], aL1, aL2, aL4, aL8, aLkMk, aMb; };
__device__ __forceinline__ void cs_gram(CsFr& fr, LAS unsigned char* wl, int lane) {
    const int hi = lane >> 5, row = lane & 15; const bool up = (lane & 16) != 0;
    const LAS unsigned char* rpAR = wl + (up ? IM_R : IM_A) * CS_IMG + row * CS_RS; const LAS unsigned char* rpBK = wl + (up ? IM_K : IM_B) * CS_IMG + row * CS_RS;
#pragma unroll
    for (int ks = 0; ks < 4; ++ks) fr.fAR[ks] = cs_rowfrag(rpAR, hi, ks);
    f32x16 F1 = {}, F2 = {};
#pragma unroll
    for (int ks = 0; ks < 4; ++ks) { const bf16x8 fBK = cs_rowfrag(rpBK, hi, ks);
        F1 = __builtin_amdgcn_mfma_f32_32x32x16_bf16(fBK, fr.fAR[ks], F1, 0, 0, 0);
        F2 = __builtin_amdgcn_mfma_f32_32x32x16_bf16(fr.fAR[ks], fBK, F2, 0, 0, 0); }
#pragma unroll
    for (int q = 0; q < 8; ++q) { const int s = crow8(q, hi); const bool k1 = up ? (s <= row) : (s < row);
        F1[q] = k1 ? F1[q] : 0.f; F1[8 + q] = k1 ? F1[8 + q] : 0.f; F2[q] = (!up && row < s) ? F2[q] : 0.f; }
    const bf16x8 f1lo = packp(F1, 0);
    fr.aL1 = up ? cs_zero8() : f1lo;
    fr.aMb = up ? f1lo : cs_zero8();
    fr.aLkMk = packp(F1, 1);
    const bf16x8 p2 = packp(F2, 0);
    const f32x16 z16 = {};
    const f32x16 Q1 = __builtin_amdgcn_mfma_f32_32x32x16_bf16(p2, fr.aL1, z16, 0, 0, 0), Q2 = __builtin_amdgcn_mfma_f32_32x32x16_bf16(fr.aL1, p2, z16, 0, 0, 0);
    fr.aL2 = packp(Q1, 0); const bf16x8 p2b = packp(Q2, 0);
    const f32x16 R1 = __builtin_amdgcn_mfma_f32_32x32x16_bf16(p2b, fr.aL2, z16, 0, 0, 0), R2 = __builtin_amdgcn_mfma_f32_32x32x16_bf16(fr.aL2, p2b, z16, 0, 0, 0);
    fr.aL4 = packp(R1, 0); const bf16x8 p2c = packp(R2, 0);
    const f32x16 S1 = __builtin_amdgcn_mfma_f32_32x32x16_bf16(p2c, fr.aL4, z16, 0, 0, 0);
    fr.aL8 = packp(S1, 0);
}
template <bool USE_V, bool WITH_Y>
__device__ __forceinline__ void cs_apply(f32x16 (&Z)[2][2], f32x16 (&D)[2], const CsFr& fr, LAS unsigned char* wl, int lane) {
    const int hi = lane >> 5;
    bf16x8 vf[2];
    if (USE_V) { vf[0] = cs_trfrag(wl + IM_V * CS_IMG, 0, lane); vf[1] = cs_trfrag(wl + IM_V * CS_IMG, 1, lane); }
#pragma unroll
    for (int nb = 0; nb < 2; ++nb) { f32x16 d = {};
#pragma unroll
        for (int jb = 0; jb < 2; ++jb)
#pragma unroll
            for (int k2 = 0; k2 < 2; ++k2) d = __builtin_amdgcn_mfma_f32_32x32x16_bf16(fr.fAR[2 * jb + k2], packp(Z[jb][nb], k2), d, 0, 0, 0);
        if (USE_V) d = __builtin_amdgcn_mfma_f32_32x32x16_bf16(fr.aLkMk, vf[nb], d, 0, 0, 0);
        D[nb] = d; }
#pragma unroll
    for (int nb = 0; nb < 2; ++nb) {
        D[nb] = __builtin_amdgcn_mfma_f32_32x32x16_bf16(fr.aL8, packp(D[nb], 0), D[nb], 0, 0, 0);
        D[nb] = __builtin_amdgcn_mfma_f32_32x32x16_bf16(fr.aL4, packp(D[nb], 0), D[nb], 0, 0, 0);
        D[nb] = __builtin_amdgcn_mfma_f32_32x32x16_bf16(fr.aL2, packp(D[nb], 0), D[nb], 0, 0, 0);
        D[nb] = __builtin_amdgcn_mfma_f32_32x32x16_bf16(fr.aL1, packp(D[nb], 0), D[nb], 0, 0, 0);
    }
    const bf16x8 u0 = packp(D[0], 0), u1 = packp(D[1], 0);
    if (WITH_Y) { D[0] = __builtin_amdgcn_mfma_f32_32x32x16_bf16(fr.aMb, u0, D[0], 0, 0, 0); D[1] = __builtin_amdgcn_mfma_f32_32x32x16_bf16(fr.aMb, u1, D[1], 0, 0, 0); }
    const LAS float* gct = (const LAS float*)(wl + 8 * CS_IMG);
#pragma unroll
    for (int jb = 0; jb < 2; ++jb) {
        const bf16x8 fb = cs_trfrag(wl + IM_BH * CS_IMG, jb, lane); bf16x8 fk = cs_zero8(); if (USE_V) fk = cs_trfrag(wl + IM_KH * CS_IMG, jb, lane);
        float gc[16];
#pragma unroll
        for (int g4 = 0; g4 < 4; ++g4) { const f32x4 x = *(const LAS f32x4*)(gct + 32 * jb + 8 * g4 + 4 * hi); gc[4 * g4] = x.x; gc[4 * g4 + 1] = x.y; gc[4 * g4 + 2] = x.z; gc[4 * g4 + 3] = x.w; }
#pragma unroll
        for (int nb = 0; nb < 2; ++nb) { f32x16 z = Z[jb][nb];
#pragma unroll
            for (int q = 0; q < 16; ++q) z[q] *= gc[q];
            z = __builtin_amdgcn_mfma_f32_32x32x16_bf16(fb, nb == 0 ? u0 : u1, z, 0, 0, 0);
            if (USE_V) z = __builtin_amdgcn_mfma_f32_32x32x16_bf16(fk, vf[nb], z, 0, 0, 0);
            Z[jb][nb] = z; }
    }
}
__device__ __forceinline__ void cs_apply_pk(bf16x8 (&Zp)[2][2][2], f32x16 (&D)[2], const CsFr& fr, LAS unsigned char* wl, int lane) {
    const int hi = lane >> 5;
#pragma unroll
    for (int nb = 0; nb < 2; ++nb) { f32x16 d = {};
#pragma unroll
        for (int jb = 0; jb < 2; ++jb)
#pragma unroll
            for (int k2 = 0; k2 < 2; ++k2) d = __builtin_amdgcn_mfma_f32_32x32x16_bf16(fr.fAR[2 * jb + k2], Zp[jb][nb][k2], d, 0, 0, 0);
        D[nb] = d; }
#pragma unroll
    for (int nb = 0; nb < 2; ++nb) {
        D[nb] = __builtin_amdgcn_mfma_f32_32x32x16_bf16(fr.aL8, packp(D[nb], 0), D[nb], 0, 0, 0);
        D[nb] = __builtin_amdgcn_mfma_f32_32x32x16_bf16(fr.aL4, packp(D[nb], 0), D[nb], 0, 0, 0);
        D[nb] = __builtin_amdgcn_mfma_f32_32x32x16_bf16(fr.aL2, packp(D[nb], 0), D[nb], 0, 0, 0);
        D[nb] = __builtin_amdgcn_mfma_f32_32x32x16_bf16(fr.aL1, packp(D[nb], 0), D[nb], 0, 0, 0);
    }
    const bf16x8 u0 = packp(D[0], 0), u1 = packp(D[1], 0);
    const LAS float* gct = (const LAS float*)(wl + 8 * CS_IMG);
#pragma unroll
    for (int jb = 0; jb < 2; ++jb) {
        const bf16x8 fb = cs_trfrag(wl + IM_BH * CS_IMG, jb, lane);
        float gc[16];
#pragma unroll
        for (int g4 = 0; g4 < 4; ++g4) { const f32x4 x = *(const LAS f32x4*)(gct + 32 * jb + 8 * g4 + 4 * hi); gc[4 * g4] = x.x; gc[4 * g4 + 1] = x.y; gc[4 * g4 + 2] = x.z; gc[4 * g4 + 3] = x.w; }
#pragma unroll
        for (int nb = 0; nb < 2; ++nb) { f32x16 z;
#pragma unroll
            for (int k2 = 0; k2 < 2; ++k2) { float e[8]; unpack8(__builtin_bit_cast(u32x4, Zp[jb][nb][k2]), e);
#pragma unroll
                for (int q = 0; q < 8; ++q) z[8 * k2 + q] = e[q] * gc[8 * k2 + q]; }
            z = __builtin_amdgcn_mfma_f32_32x32x16_bf16(fb, nb == 0 ? u0 : u1, z, 0, 0, 0);
            Zp[jb][nb][0] = packp(z, 0); Zp[jb][nb][1] = packp(z, 1); }
    }
}
template <bool USE_V, bool WITH_Y>
__device__ __forceinline__ void cs_step(f32x16 (&Z)[2][2], f32x16 (&D)[2], LAS unsigned char* wl, int lane) { CsFr fr; cs_gram(fr, wl, lane); cs_apply<USE_V, WITH_Y>(Z, D, fr, wl, lane); }
__device__ __forceinline__ void p_cs_a(const Frame& F, ArgsP a) {
    const int lane = lane_id_fresh();
    LAS unsigned char* wl = F.lds + F.wave * CS_WAVE;
    CsIn in{(const bf16*)(F.ws + WS_ZR), (const bf16*)(F.ws + WS_A), (const bf16*)(F.ws + WS_LW), (const bf16*)(F.dob + DO_G), a->in[I_MU], a->in[I_KK], a->in[I_KA], a->in[I_RK]};
    bf16* Pm = (bf16*)(F.dob + DO_CSP); bf16* Gf = (bf16*)(F.dob + DO_CSG);
    const int hi = lane >> 5;
    for (int uc = F.gw; uc < 64 * CS_NCH; uc += F.NGW) {
        const int bh = uc / CS_NCH, c = uc % CS_NCH, b = bh >> 3, h = bh & 7; const size_t row0 = (size_t)b * SEQ;
        f32x16 ZG[2][2], D[2]; bf16x8 ZP[2][2][2];
#pragma unroll
        for (int jb = 0; jb < 2; ++jb)
#pragma unroll
            for (int nb = 0; nb < 2; ++nb) { f32x16 z = {}; ZG[jb][nb] = z;
                if (jb == nb) {
#pragma unroll
                    for (int q = 0; q < 16; ++q) z[q] = (crow(q, hi) == (lane & 31)) ? 1.f : 0.f; }
                ZP[jb][nb][0] = packp(z, 0); ZP[jb][nb][1] = packp(z, 1); }
        for (int sc = 0; sc < CS_CH / 16; ++sc) { int ln = lane; asm volatile("" : "+v"(ln));
            cs_prep<true, false>(in, row0, c * CS_CH + sc * 16, h, wl, ln); asm volatile("s_waitcnt lgkmcnt(0)" ::: "memory");
            CsFr fr; cs_gram(fr, wl, ln);
            cs_apply_pk(ZP, D, fr, wl, ln); cs_apply<true, false>(ZG, D, fr, wl, ln); asm volatile("s_waitcnt lgkmcnt(0)" ::: "memory"); }
        int lo_ = lane; asm volatile("" : "+v"(lo_)); const int hi_o = lo_ >> 5;
        {
            LAS unsigned short* tb = (LAS unsigned short*)(wl + 4 * hi_o * CS_RS + (lo_ & 31) * 2);
#pragma unroll
            for (int jb = 0; jb < 2; ++jb)
#pragma unroll
                for (int nb = 0; nb < 2; ++nb)
#pragma unroll
                    for (int q = 0; q < 16; ++q) tb[((32 * jb + (q & 3) + 8 * (q >> 2)) * CS_RS + 64 * nb) / 2] = (unsigned short)ZP[jb][nb][q >> 3][q & 7];
            bf16* dst = Pm + (size_t)uc * 4096;
#pragma unroll
            for (int i = 0; i < 8; ++i) { const int ch = lo_ + 64 * i, rr = ch >> 3, c8 = (ch & 7) * 8; *(u32x4*)(dst + rr * 64 + c8) = *(const LAS u32x4*)(wl + rr * CS_RS + c8 * 2); }
            asm volatile("s_waitcnt lgkmcnt(0)" ::: "memory");
        }
        {
            bf16* dst = Gf + (size_t)uc * 4096;
#pragma unroll
            for (int jb = 0; jb < 2; ++jb)
#pragma unroll
                for (int nb = 0; nb < 2; ++nb) { u32x4 w0, w1; const f32x16& z = ZG[jb][nb];
                    w0.x = pk2(z[0], z[1]); w0.y = pk2(z[2], z[3]); w0.z = pk2(z[4], z[5]); w0.w = pk2(z[6], z[7]); w1.x = pk2(z[8], z[9]); w1.y = pk2(z[10], z[11]); w1.z = pk2(z[12], z[13]); w1.w = pk2(z[14], z[15]);
                    u32x4* p = (u32x4*)(dst + ((jb * 2 + nb) * 64 + lo_) * 16); p[0] = w0; p[1] = w1; }
        }
    }
}
struct CsB { u32x2 p[2][2][2][2]; u32x4 g[2][2]; };
__device__ __forceinline__ void csb_load(CsB& X, const bf16* Pm, const bf16* Gf, size_t uc, int nb, int lane) {
    const int hi = lane >> 5, r = lane & 31; const bf16* Pc = Pm + uc * 4096;
#pragma unroll
    for (int mb = 0; mb < 2; ++mb) {
#pragma unroll
        for (int jb = 0; jb < 2; ++jb)
#pragma unroll
            for (int k2 = 0; k2 < 2; ++k2) { const bf16* pr = Pc + (32 * mb + r) * 64 + 32 * jb + 16 * k2 + 4 * hi; X.p[mb][jb][k2][0] = *(const u32x2*)pr; X.p[mb][jb][k2][1] = *(const u32x2*)(pr + 8); }
        const u32x4* gp = (const u32x4*)(Gf + uc * 4096 + ((mb * 2 + nb) * 64 + lane) * 16); X.g[mb][0] = gp[0]; X.g[mb][1] = gp[1]; }
}
__device__ __forceinline__ void csb_step(f32x16 (&Z)[2], const CsB& X, bf16* Zf, size_t uc, int nb, int lane) {
#pragma unroll
    for (int jb = 0; jb < 2; ++jb) { u32x4 w0, w1; const f32x16& z = Z[jb];
        w0.x = pk2(z[0], z[1]); w0.y = pk2(z[2], z[3]); w0.z = pk2(z[4], z[5]); w0.w = pk2(z[6], z[7]); w1.x = pk2(z[8], z[9]); w1.y = pk2(z[10], z[11]); w1.z = pk2(z[12], z[13]); w1.w = pk2(z[14], z[15]);
        u32x4* p = (u32x4*)(Zf + uc * 4096 + ((jb * 2 + nb) * 64 + lane) * 16); p[0] = w0; p[1] = w1; }
    f32x16 N[2];
#pragma unroll
    for (int mb = 0; mb < 2; ++mb) { float g0[8], g1[8]; unpack8(X.g[mb][0], g0); unpack8(X.g[mb][1], g1);
#pragma unroll
        for (int q = 0; q < 8; ++q) { N[mb][q] = g0[q]; N[mb][8 + q] = g1[q]; } }
#pragma unroll
    for (int jb = 0; jb < 2; ++jb)
#pragma unroll
        for (int k2 = 0; k2 < 2; ++k2) { const bf16x8 zb = packp(Z[jb], k2);
#pragma unroll
            for (int mb = 0; mb < 2; ++mb) { const u32x2 x0 = X.p[mb][jb][k2][0], x1 = X.p[mb][jb][k2][1];
                N[mb] = __builtin_amdgcn_mfma_f32_32x32x16_bf16(__builtin_bit_cast(bf16x8, (u32x4){x0.x, x0.y, x1.x, x1.y}), zb, N[mb], 0, 0, 0); } }
    Z[0] = N[0]; Z[1] = N[1];
}
__device__ __forceinline__ void p_cs_b(const Frame& F) {
    const int lane = lane_id_fresh();
    const bf16* Pm = (const bf16*)(F.dob + DO_CSP); const bf16* Gf = (const bf16*)(F.dob + DO_CSG); bf16* Zf = (bf16*)(F.dob + DO_CSZ);
    for (int u16 = F.gw; u16 < 128 * 16; u16 += F.NGW) {
        if (u16 & 15) continue;
        const int u = u16 >> 4, bh = u >> 1, nb = u & 1; const size_t uc0 = (size_t)bh * CS_NCH;
        f32x16 Z[2] = {};
        CsB X0, X1, X2;
        csb_load(X0, Pm, Gf, uc0, nb, lane); csb_load(X1, Pm, Gf, uc0 + 1, nb, lane);
#define CSB_CL(c_) (uc0 + ((c_) < CS_NCH ? (c_) : CS_NCH - 1))
        int c = 0;
        for (; c + 2 < CS_NCH; c += 3) {
            csb_load(X2, Pm, Gf, CSB_CL(c + 2), nb, lane); csb_step(Z, X0, Zf, uc0 + c, nb, lane);
            csb_load(X0, Pm, Gf, CSB_CL(c + 3), nb, lane); csb_step(Z, X1, Zf, uc0 + c + 1, nb, lane);
            csb_load(X1, Pm, Gf, CSB_CL(c + 4), nb, lane); csb_step(Z, X2, Zf, uc0 + c + 2, nb, lane);
        }
        if (c < CS_NCH) { csb_step(Z, X0, Zf, uc0 + c, nb, lane); ++c; }
        if (c < CS_NCH) { csb_step(Z, X1, Zf, uc0 + c, nb, lane); ++c; }
#undef CSB_CL
    }
}
__device__ __forceinline__ void p_cs_c(const Frame& F, ArgsP a) {
    const int lane = lane_id_fresh(), hi = lane >> 5;
    LAS unsigned char* wl = F.lds + F.wave * CS_WAVE;
    CsIn in{(const bf16*)(F.ws + WS_ZR), (const bf16*)(F.ws + WS_A), (const bf16*)(F.ws + WS_LW), (const bf16*)(F.dob + DO_G), a->in[I_MU], a->in[I_KK], a->in[I_KA], a->in[I_RK]};
    const bf16* Zf = (const bf16*)(F.dob + DO_CSZ); bf16* Y = (bf16*)(F.ws + WS_Y); const float* lnw = a->in[I_LNW]; const float* lnb = a->in[I_LNB];
    const LAS float* btt = (const LAS float*)(wl + 8 * CS_IMG) + 64;
    for (int uc = F.gw; uc < 64 * CS_NCH; uc += F.NGW) {
        const int bh = uc / CS_NCH, c = uc % CS_NCH, b = bh >> 3, h = bh & 7; const size_t row0 = (size_t)b * SEQ;
        f32x16 Z[2][2], D[2];
        int lu = lane; asm volatile("" : "+v"(lu));
#pragma unroll
        for (int jb = 0; jb < 2; ++jb)
#pragma unroll
            for (int nb = 0; nb < 2; ++nb) { const u32x4* p = (const u32x4*)(Zf + (size_t)uc * 4096 + ((jb * 2 + nb) * 64 + lu) * 16); float g0[8], g1[8]; unpack8(p[0], g0); unpack8(p[1], g1);
#pragma unroll
                for (int q = 0; q < 8; ++q) { Z[jb][nb][q] = g0[q]; Z[jb][nb][8 + q] = g1[q]; } }
        const float lw0 = lnw[h * 64 + (lu & 31)], lw1 = lnw[h * 64 + 32 + (lu & 31)], lb0 = lnb[h * 64 + (lu & 31)], lb1 = lnb[h * 64 + 32 + (lu & 31)];
        for (int sc = 0; sc < CS_CH / 16; ++sc) {
            const int tok0 = c * CS_CH + sc * 16;
            int ln = lane; asm volatile("" : "+v"(ln));
            cs_prep<true, true>(in, row0, tok0, h, wl, ln); asm volatile("s_waitcnt lgkmcnt(0)" ::: "memory");
            cs_step<true, true>(Z, D, wl, ln); asm volatile("s_waitcnt lgkmcnt(0)" ::: "memory");
            const int hl = ln >> 5;
            const bf16x8 v0 = cs_trfrag(wl + IM_V * CS_IMG, 0, ln), v1 = cs_trfrag(wl + IM_V * CS_IMG, 1, ln), g0 = cs_trfrag(wl + IM_G * CS_IMG, 0, ln), g1 = cs_trfrag(wl + IM_G * CS_IMG, 1, ln);
            const f32x4 bta = *(const LAS f32x4*)(btt + 4 * hl), btb = *(const LAS f32x4*)(btt + 8 + 4 * hl); const float bt[8] = {bta.x, bta.y, bta.z, bta.w, btb.x, btb.y, btb.z, btb.w};
#pragma unroll
            for (int q = 0; q < 8; ++q) {
                const float y0 = D[0][8 + q], y1 = D[1][8 + q];
                const float mean = allsum32(y0 + y1) * (1.f / 64.f); const float d0 = y0 - mean, d1 = y1 - mean;
                const float rstd = 1.0f / sqrtf(allsum32(d0 * d0 + d1 * d1) * (1.f / 64.f) + LN_X_EPS);
                const float o0 = (d0 * rstd * lw0 + lb0 + bt[q] * bf2f((unsigned short)v0[q])) * bf2f((unsigned short)g0[q]);
                const float o1 = (d1 * rstd * lw1 + lb1 + bt[q] * bf2f((unsigned short)v1[q])) * bf2f((unsigned short)g1[q]);
                bf16* yp = Y + (row0 + tok0 + crow8(q, hl)) * YYLD + h * 64 + (ln & 31);
                yp[0] = (unsigned short)f2bf(o0); yp[32] = (unsigned short)f2bf(o1);
            }
            asm volatile("s_waitcnt lgkmcnt(0)" ::: "memory");
        }
    }
}

__device__ __forceinline__ void p_ffn_route(const Frame& F, ArgsP a, unsigned* cnt, int* route) {
    const int lane_f = lane_id_fresh(), tid_f = F.wave * 64 + lane_f;
    const float* X = a->in[I_X]; const bf16* MO = (const bf16*)(F.ws + WS_MO); bf16* H2 = (bf16*)(F.ws + WS_H2); const float* mod = (const float*)(F.ws + WS_MOD); const float* g = a->in[I_GFFN];
    constexpr int RTS = 1028;
    LAS float* wr = (LAS float*)F.lds;
    __syncthreads();
    for (int i = tid_f; i < 1024 * 4; i += NTHR) { const int k = i >> 2, o = i & 3; wr[o * RTS + k] = a->in[I_WRG][i]; }
    for (int i = tid_f; i < 1024 * 32; i += NTHR) { const int k = i >> 5, o = i & 31; wr[(4 + o) * RTS + k] = a->in[I_WRE][i]; }
    __syncthreads();
    LAS float* brl = wr + 36 * RTS;
    if (tid_f < 4) brl[tid_f] = a->in[I_BRG][tid_f]; else if (tid_f < 36) brl[tid_f] = a->in[I_BRE][tid_f - 4];
    const int lane = lane_f;
    LAS unsigned* lcnt = (LAS unsigned*)(F.lds + LDS_MISC + 512);
    if (tid_f < 256) lcnt[tid_f] = 0u;
    __syncthreads();
    int my_e0 = 0, my_e1 = 0; float my_w0 = 0.f, my_w1 = 0.f; int kk_ = 0;
    f32x4 xa[4], xb[4]; u32x2 ma[4], mb[4]; f32x4 gmv[4], gsv[4], shv[4]; int bcur = -1;
    { const f32x4* xr = (const f32x4*)(X + (size_t)F.gw * 1024) + lane; const u32x2* mr = (const u32x2*)(MO + (size_t)F.gw * 1024) + lane;
#pragma unroll
      for (int j = 0; j < 4; ++j) { xa[j] = xr[64 * j]; ma[j] = mr[64 * j]; } }
#define RT_ROW(CX, CM, NX, NM, m_) do { const int mm = (m_); const int b = mm / SEQ; \
        if (b != bcur) { bcur = b; \
            _Pragma("unroll") for (int j = 0; j < 4; ++j) { const int col = 4 * lane + 256 * j; gmv[j] = *(const f32x4*)(mod + b * 6144 + 2048 + col); \
                gsv[j] = *(const f32x4*)(g + col) * (*(const f32x4*)(mod + b * 6144 + 4096 + col) + 1.0f); shv[j] = *(const f32x4*)(mod + b * 6144 + 3072 + col); } \
            asm volatile("s_waitcnt vmcnt(0)" : "+v"(gmv[0]), "+v"(gmv[1]), "+v"(gmv[2]), "+v"(gmv[3]), "+v"(gsv[0]), "+v"(gsv[1]), "+v"(gsv[2]), "+v"(gsv[3]), "+v"(shv[0]), "+v"(shv[1]), "+v"(shv[2]), "+v"(shv[3])); \
            asm volatile("" : "+v"(CX[0]), "+v"(CX[1]), "+v"(CX[2]), "+v"(CX[3]), "+v"(CM[0]), "+v"(CM[1]), "+v"(CM[2]), "+v"(CM[3])); } \
        { const int mn = (mm + F.NGW < NTOK) ? mm + F.NGW : mm; const f32x4* xr = (const f32x4*)(X + (size_t)mn * 1024) + lane; const u32x2* mr = (const u32x2*)(MO + (size_t)mn * 1024) + lane; \
          _Pragma("unroll") for (int j = 0; j < 4; ++j) { NX[j] = xr[64 * j]; NM[j] = mr[64 * j]; } } \
        f32x4 v[4]; float s = 0.f; \
        _Pragma("unroll") for (int j = 0; j < 4; ++j) { v[j] = CX[j] + gmv[j] * (f32x4){lo2f(CM[j].x), hi2f(CM[j].x), lo2f(CM[j].y), hi2f(CM[j].y)}; \
            s += (v[j].x * v[j].x + v[j].y * v[j].y) + (v[j].z * v[j].z + v[j].w * v[j].w); } \
        const float rstd = 1.0f / sqrtf(wave_sum(s) * (1.f / 1024.f) + EPS); \
        u32x2* o = (u32x2*)(H2 + (size_t)mm * 1024) + lane; \
        _Pragma("unroll") for (int j = 0; j < 4; ++j) { v[j] = v[j] * rstd * gsv[j] + shv[j]; u32x2 w; w.x = pk2(v[j].x, v[j].y); w.y = pk2(v[j].z, v[j].w); o[64 * j] = w; } \
        float lgq[4]; \
        _Pragma("unroll") for (int oo = 0; oo < 4; ++oo) { float p = 0.f; \
            _Pragma("unroll") for (int j = 0; j < 4; ++j) { const f32x4 w4 = *(const LAS f32x4*)(wr + oo * RTS + 4 * lane + 256 * j); p += (v[j].x * w4.x + v[j].y * w4.y) + (v[j].z * w4.z + v[j].w * w4.w); } \
            lgq[oo] = wave_sum(p) + brl[oo]; } \
        int gi = 0; float gmx = lgq[0]; \
        _Pragma("unroll") for (int i = 1; i < 4; ++i) { if (lgq[i] > gmx) { gmx = lgq[i]; gi = i; } } \
        float gsum = 0.f; \
        _Pragma("unroll") for (int i = 0; i < 4; ++i) gsum += __expf(lgq[i] - gmx); \
        const float pg = 1.f / gsum; \
        gi = __builtin_amdgcn_readfirstlane(gi); \
        float el[8]; \
        { const LAS float* wg = wr + (4 + gi * 8) * RTS + 4 * lane; \
          _Pragma("unroll") for (int i = 0; i < 8; ++i) { float p = 0.f; \
              _Pragma("unroll") for (int j = 0; j < 4; ++j) { const f32x4 w4 = *(const LAS f32x4*)(wg + i * RTS + 256 * j); p += (v[j].x * w4.x + v[j].y * w4.y) + (v[j].z * w4.z + v[j].w * w4.w); } \
              el[i] = wave_sum(p) + brl[4 + gi * 8 + i]; } } \
        int i0 = 0; float m0 = el[0]; \
        _Pragma("unroll") for (int i = 1; i < 8; ++i) if (el[i] > m0) { m0 = el[i]; i0 = i; } \
        int i1 = -1; float m1 = -INFINITY; \
        _Pragma("unroll") for (int i = 0; i < 8; ++i) if (i != i0 && el[i] > m1) { m1 = el[i]; i1 = i; } \
        const float e1 = __expf(m1 - m0), w0 = pg / (1.f + e1), w1 = pg * e1 / (1.f + e1); \
        { const int lo_ = i0 < i1 ? i0 : i1, hi_ = i0 < i1 ? i1 : i0; \
          if (lane == kk_) { my_e0 = gi * 28 + (lo_ * (15 - lo_)) / 2 + (hi_ - lo_ - 1); my_w0 = i0 < i1 ? w0 : w1; my_w1 = i0 < i1 ? w1 : w0; } } \
        ++kk_; } while (0)
    for (int m = F.gw; m < NTOK; m += 2 * F.NGW) {
        RT_ROW(xa, ma, xb, mb, m);
        if (m + F.NGW < NTOK) RT_ROW(xb, mb, xa, ma, m + F.NGW);
    }
#undef RT_ROW
    unsigned lp0 = 0u;
    if (lane < kk_) lp0 = __hip_atomic_fetch_add(lcnt + my_e0, 1u, __ATOMIC_RELAXED, __HIP_MEMORY_SCOPE_WORKGROUP);
    __syncthreads();
    if (tid_f < NCLS) lcnt[128 + tid_f] = __hip_atomic_fetch_add(cnt + tid_f, lcnt[tid_f], __ATOMIC_RELAXED, __HIP_MEMORY_SCOPE_AGENT);
    __syncthreads();
    if (lane < kk_) { const int m = F.gw + lane * F.NGW; int* rt = route + (size_t)m * 8;
        rt[0] = my_e0; rt[1] = (int)(lcnt[128 + my_e0] + lp0); rt[2] = __builtin_bit_cast(int, my_w0); rt[3] = __builtin_bit_cast(int, my_w1); }
    __syncthreads();
    (void)my_e1;
}
__device__ __forceinline__ int moe_tables(const Frame& F, LAS int* offs, LAS int* texp) {
    const int lane_f = lane_id_fresh();
    const unsigned* cnt = (const unsigned*)(F.ws + WS_CTL) + CW_CNT;
    __syncthreads();
    if (F.wave == 0) {
        const int c0 = (int)__hip_atomic_load(cnt + lane_f, __ATOMIC_RELAXED, __HIP_MEMORY_SCOPE_AGENT);
        const int c1 = (lane_f < NCLS - 64) ? (int)__hip_atomic_load(cnt + 64 + lane_f, __ATOMIC_RELAXED, __HIP_MEMORY_SCOPE_AGENT) : 0;
        const int n0 = (c0 + 255) >> 8, n1 = (c1 + 255) >> 8; int i0 = n0, i1 = n1;
#pragma unroll
        for (int d = 1; d < 64; d <<= 1) { const int a = __shfl_up(i0, d, 64), b = __shfl_up(i1, d, 64); if (lane_f >= d) { i0 += a; i1 += b; } }
        const int tot0 = __shfl(i0, 63, 64); i1 += tot0;
        const int t0 = i0 - n0, t1 = i1 - n1;
        offs[lane_f] = t0 << 8; for (int t = 0; t < n0; ++t) texp[t0 + t] = lane_f;
        if (lane_f < NCLS - 64) { offs[64 + lane_f] = t1 << 8; for (int t = 0; t < n1; ++t) texp[t1 + t] = 64 + lane_f; if (lane_f == NCLS - 65) offs[NCLS] = i1 << 8; }
    }
    __syncthreads();
    return __builtin_amdgcn_readfirstlane(offs[NCLS] >> 8);
}
__device__ __forceinline__ void p_gather(const Frame& F) {
    const int lane_f = lane_id_fresh(), tid_f = F.wave * 64 + lane_f;
    LAS int* offs = (LAS int*)(F.lds + 1024); LAS int* texp = (LAS int*)(F.lds + 2048);
    moe_tables(F, offs, texp);
    const int* route = (const int*)(F.ws + WS_ROUTE); int* ridx = (int*)(F.ws + WS_ENT); u32x2* rw = (u32x2*)(F.ws + WS_RW);
    const unsigned* cnt = (const unsigned*)(F.ws + WS_CTL) + CW_CNT;
    for (int m = F.vcu * NTHR + tid_f; m < NTOK; m += F.G * NTHR) { const u32x4 rt = *(const u32x4*)(route + (size_t)m * 8); const int d = offs[rt.x] + (int)rt.y; ridx[d] = m; rw[d] = (u32x2){rt.z, rt.w}; }
    for (int i = F.vcu * NTHR + tid_f; i < NCLS * 256; i += F.G * NTHR) { const int e = i >> 8, r = i & 255; const int c = (int)cnt[e]; const int pad = ((c + 255) & ~255) - c;
        if (r < pad) { ridx[offs[e] + c + r] = -1; rw[offs[e] + c + r] = (u32x2){0u, 0u}; } }
    __syncthreads();
}
__device__ __forceinline__ void p_combine(const Frame& F, const float* xin, float* dst) {
    const int lane_f = lane_id_fresh(), tid_f = F.wave * 64 + lane_f;
    LAS int* offs = (LAS int*)(F.lds + 1024); LAS int* texp = (LAS int*)(F.lds + 2048);
    moe_tables(F, offs, texp);
    const bf16* MO = (const bf16*)(F.ws + WS_MO); const bf16* YS = (const bf16*)(F.ws + WS_YS); const int* route = (const int*)(F.ws + WS_ROUTE); const float* mod = (const float*)(F.ws + WS_MOD);
    const int lane = lane_f;
    for (int m = F.gw; m < NTOK; m += F.NGW) {
        const int b = m / SEQ; const int* rt = route + (size_t)m * 8; const int d0 = offs[rt[0]] + rt[2], d1 = offs[rt[1]] + rt[3];
        const float w0 = __builtin_bit_cast(float, rt[4]), w1 = __builtin_bit_cast(float, rt[5]);
#pragma unroll
        for (int j = 0; j < 2; ++j) { const int col = 8 * lane + 512 * j; float y0[8], y1[8];
            unpack8(*(const u32x4*)(YS + (size_t)d0 * 1024 + col), y0); unpack8(*(const u32x4*)(YS + (size_t)d1 * 1024 + col), y1);
            const float* o = xin + (size_t)m * 1024 + col; const float* gt = mod + b * 6144 + 5120 + col; const float* gm = mod + b * 6144 + 2048 + col; float mo[8]; unpack8(*(const u32x4*)(MO + (size_t)m * 1024 + col), mo);
            f32x4 x0 = *(const f32x4*)o, x1 = *(const f32x4*)(o + 4); const f32x4 g0 = *(const f32x4*)gt, g1 = *(const f32x4*)(gt + 4), h0 = *(const f32x4*)gm, h1 = *(const f32x4*)(gm + 4);
            x0.x += h0.x * mo[0]; x0.y += h0.y * mo[1]; x0.z += h0.z * mo[2]; x0.w += h0.w * mo[3]; x1.x += h1.x * mo[4]; x1.y += h1.y * mo[5]; x1.z += h1.z * mo[6]; x1.w += h1.w * mo[7];
            x0.x += g0.x * (w0 * y0[0] + w1 * y1[0]); x0.y += g0.y * (w0 * y0[1] + w1 * y1[1]); x0.z += g0.z * (w0 * y0[2] + w1 * y1[2]); x0.w += g0.w * (w0 * y0[3] + w1 * y1[3]);
            x1.x += g1.x * (w0 * y0[4] + w1 * y1[4]); x1.y += g1.y * (w0 * y0[5] + w1 * y1[5]); x1.z += g1.z * (w0 * y0[6] + w1 * y1[6]); x1.w += g1.w * (w0 * y0[7] + w1 * y1[7]);
            float* od = dst + (size_t)m * 1024 + col; *(f32x4*)od = x0; *(f32x4*)(od + 4) = x1; }
    }
}

constexpr int NPHASE = 16;
template <int LO, int HI>
__global__ void __launch_bounds__(NTHR, 2) fwd(Args args) {
    extern __shared__ __attribute__((aligned(16))) unsigned char lds_raw[];
    Frame F;
    F.lds = (LAS unsigned char*)lds_raw;
    F.wave = __builtin_amdgcn_readfirstlane((int)threadIdx.x >> 6);
    F.G = gridDim.x; { const int bx = blockIdx.x; F.vcu = (F.G % 8 == 0) ? (bx % 8) * (F.G / 8) + bx / 8 : bx; }
    F.gw = F.vcu * NWAVES + F.wave; F.NGW = F.G * NWAVES;
    F.ws = args.ws; F.dob = (unsigned char*)args.out;
    ArgsP AP = (ArgsP)__builtin_amdgcn_kernarg_segment_ptr();
    volatile LAS unsigned* MISC = (volatile LAS unsigned*)(F.lds + LDS_MISC);
    if (threadIdx.x < 64) MISC[threadIdx.x] = 0u;
    __syncthreads();
    XcdBarrier bar; bar.bar = (unsigned*)(F.ws + WS_CTL) + CW_BAR; bar.x = 0; bar.st = MISC + 8;
#if N_LAUNCH_MODE == 1
    bar = xcd_barrier_post((unsigned*)(F.ws + WS_CTL) + CW_BAR, MISC + 8);
#define GRID_BAR() xcd_barrier(bar)
#else
#define GRID_BAR() do { } while (0)
#endif
#ifndef PROBE_REPEAT
#define PROBE_REPEAT -1
#endif
#define IN(k) (LO <= (k) && (k) < HI)
#define SEAM(k) do { if constexpr (IN(k) && IN((k) + 1)) GRID_BAR(); } while (0)
    const float* mod = (const float*)(F.ws + WS_MOD);

#define PH(k, ...) do { if constexpr (IN(k)) { asm volatile("" : "+s"(AP)); { __VA_ARGS__ } if constexpr (PROBE_REPEAT == (k)) { GRID_BAR(); asm volatile("" : "+s"(AP)); { __VA_ARGS__ } } } } while (0)
    PH(0, p0_prologue(F, AP);); SEAM(0);
    PH(1, p_normmod(F, AP->in[I_X], AP->in[I_GMIX], mod, 0, 1024, (bf16*)(F.ws + WS_H));); SEAM(1);
    PH(2, Gemm g{(const bf16*)(F.ws + WS_H), (const bf16*)(F.ws + WS_WIN), NTOK, N_IN_PAD, 1024}; StaticOrder S; S.init(NTOK, N_IN_PAD, F.G, (int)blockIdx.x);
        EpiZ E{(bf16*)(F.ws + WS_ZR), (bf16*)(F.ws + WS_SG), (bf16*)(F.ws + WS_ZM)}; gemm_phase_any(F.lds, g, S, E, F.wave);); SEAM(2);
    PH(3, p_prep_a(F, AP);); SEAM(3);
    PH(4,
        { Gemm g{(const bf16*)(F.ws + WS_TWA), (const bf16*)(F.ws + WS_WBLK), NTOK, 1024, 128}; StaticOrder S; S.init(NTOK, 1024, F.G, (int)blockIdx.x);
          EpiLora E{(bf16*)(F.ws + WS_LW), (bf16*)(F.ws + WS_A), AP->in[I_W0], AP->in[I_A0]}; gemm_phase_any(F.lds, g, S, E, F.wave); }
        { Gemm g{(const bf16*)(F.ws + WS_SGL), (const bf16*)(F.ws + WS_WG), NTOK, 512, 128}; StaticOrder S; S.init(NTOK, 512, F.G, (int)blockIdx.x);
          EpiPlain E{(bf16*)(F.dob + DO_G), nullptr, 1 << 30, 512, 0}; gemm_phase_any(F.lds, g, S, E, F.wave); }
        { Gemm g{(const bf16*)(F.ws + WS_QA), (const bf16*)(F.ws + WS_WUQ), NTOK, 768, 256}; StaticOrder S; S.init(NTOK, 768, F.G, (int)blockIdx.x);
          EpiPlain E{(bf16*)(F.dob + DO_Q), nullptr, 1 << 30, 768, 0}; gemm_phase_any(F.lds, g, S, E, F.wave); }
        { Gemm g{(const bf16*)(F.ws + WS_KVA), (const bf16*)(F.ws + WS_WUKV), NTOK, 1024, 128}; StaticOrder S; S.init(NTOK, 1024, F.G, (int)blockIdx.x);
          EpiPlain E{(bf16*)(F.dob + DO_KN), (bf16*)(F.ws + WS_VC), 512, 512, 512}; gemm_phase_any(F.lds, g, S, E, F.wave); }
    ); SEAM(4);
    PH(5, p_prep_c(F, AP);); SEAM(5);
#if ENG_ATTN == 1
    PH(6, p_attn_mfma(F, AP->in[I_QN]);); SEAM(6);
#else
    PH(6, p_attn_naive(F);); SEAM(6);
#endif
    PH(7, p_cs_a(F, AP);); SEAM(7);
    PH(8, p_cs_b(F);); SEAM(8);
    PH(9, p_cs_c(F, AP);); SEAM(9);
    PH(10, Gemm g{(const bf16*)(F.ws + WS_Y), (const bf16*)(F.ws + WS_WB), NTOK, 1024, 1024}; StaticOrder S; S.init(NTOK, 1024, F.G, (int)blockIdx.x);
        EpiBranch2 E{(bf16*)(F.ws + WS_MG), (const bf16*)(F.ws + WS_SG)}; gemm_phase_mid(F.lds, g, S, E, F.wave);); SEAM(10);
    PH(11, Gemm g{(const bf16*)(F.ws + WS_MG), (const bf16*)(F.ws + WS_WO), NTOK, 1024, 1024}; StaticOrder S; S.init(NTOK, 1024, F.G, (int)blockIdx.x);
        EpiPlain E{(bf16*)(F.ws + WS_MO), nullptr, 1 << 30, 1024, 0}; gemm_phase_any(F.lds, g, S, E, F.wave);); SEAM(11);
    if constexpr (PROBE_REPEAT == 12) { p_ffn_route(F, AP, (unsigned*)(F.ws + WS_CTL) + CW_CNT + 256, (int*)(F.ws + WS_CS)); GRID_BAR(); }
    if constexpr (IN(12)) { asm volatile("" : "+s"(AP)); p_ffn_route(F, AP, (unsigned*)(F.ws + WS_CTL) + CW_CNT, (int*)(F.ws + WS_ROUTE)); } SEAM(12);
    PH(13, p_gather(F);); SEAM(13);
    PH(14, LAS int* offs = (LAS int*)(F.lds + LDS_MISC + 1024); LAS int* texp = (LAS int*)(F.lds + LDS_MISC + 1024 + 512); const int nt = moe_tables(F, offs, texp);
        Gemm g{(const bf16*)(F.ws + WS_H2), (const bf16*)(F.ws + WS_WGU), MPAD2, 1024, 1024, (const int*)(F.ws + WS_ENT)}; PairOrderGU S{texp, nt, F.G, (int)blockIdx.x};
        EpiGateUp2 E{(bf16*)(F.ws + WS_HID2), (const float*)(F.ws + WS_RW)}; gemm_phase_gather(F.lds, g, S, E, F.wave);); SEAM(14);
    PH(15, LAS int* offs = (LAS int*)(F.lds + LDS_MISC + 1024); LAS int* texp = (LAS int*)(F.lds + LDS_MISC + 1024 + 512); const int nt = moe_tables(F, offs, texp);
        Gemm g{(const bf16*)(F.ws + WS_HID2), (const bf16*)(F.ws + WS_WDN), MPAD2, 1024, 512, nullptr, 256}; PairOrderDown S{texp, nt, F.G, (int)blockIdx.x};
        EpiDown2 E{(float*)F.dob, AP->in[I_X], (const bf16*)(F.ws + WS_MO), mod, (const int*)(F.ws + WS_ENT)}; gemm_phase_bseg(F.lds, g, S, E, F.wave););
}

#if N_LAUNCH_MODE == 1
static bool set_attrs() { return hipFuncSetAttribute((const void*)fwd<0, NPHASE>, hipFuncAttributeMaxDynamicSharedMemorySize, LDS_BYTES) == hipSuccess; }
#else
template <int P> static bool set_attr_all() { if constexpr (P < NPHASE) { return hipFuncSetAttribute((const void*)fwd<P, P + 1>, hipFuncAttributeMaxDynamicSharedMemorySize, LDS_BYTES) == hipSuccess && set_attr_all<P + 1>(); } else return true; }
static bool set_attrs() { return set_attr_all<0>(); }
template <int P> static void launch_all(int grid, hipStream_t stream, const Args& a) { if constexpr (P < NPHASE) { hipLaunchKernelGGL((fwd<P, P + 1>), dim3(grid), dim3(NTHR), LDS_BYTES, stream, a); launch_all<P + 1>(grid, stream, a); } }
#endif
extern "C" void kernel_launch(void* const* d_in, const int* in_sizes, int n_in, void* d_out, int out_size, void* d_ws, size_t ws_size, hipStream_t stream) {
    static int grid = 0;
    if (grid == 0) {
        if (n_in != 34 || out_size != NTOK * DM || ws_size < WS_END) { fprintf(stderr, "kernel_launch: unexpected shapes (n_in %d out %d ws %zu)\n", n_in, out_size, ws_size); grid = -1; return; }
        int dev = 0, cus = 0;
        if (hipGetDevice(&dev) != hipSuccess || hipDeviceGetAttribute(&cus, hipDeviceAttributeMultiprocessorCount, dev) != hipSuccess) { grid = -1; return; }
        if (!set_attrs()) { fprintf(stderr, "kernel_launch: hipFuncSetAttribute failed\n"); grid = -1; return; }
        grid = cus;
    }
    if (grid < 0) return;
    (void)hipMemsetAsync((char*)d_ws + WS_CTL, 0, CTL_ZERO_BYTES, stream);
    Args a{};
    for (int i = 0; i < 34; ++i) a.in[i] = (const float*)d_in[i];
    a.out = (float*)d_out; a.ws = (unsigned char*)d_ws;
    a.ph_lo = 0; a.ph_hi = NPHASE;
#if N_LAUNCH_MODE == 1
    hipLaunchKernelGGL((fwd<0, NPHASE>), dim3(grid), dim3(NTHR), LDS_BYTES, stream, a);
#else
    launch_all<0>(grid, stream, a);
#endif
}
```

```cpp
#include <hip/hip_runtime.h>
#include <cstdio>
#include <cstdint>

#ifndef N_LAUNCH_MODE
#define N_LAUNCH_MODE 1
#endif
#ifndef ENG_GEMM
#define ENG_GEMM 1
#endif
#ifndef ENG_ATTN
#define ENG_ATTN 1
#endif

#define GAS __attribute__((address_space(1)))
#define LAS __attribute__((address_space(3)))
typedef unsigned short bf16;
typedef float f32x4 __attribute__((ext_vector_type(4)));
typedef float f32x2 __attribute__((ext_vector_type(2)));
typedef unsigned u32x4 __attribute__((ext_vector_type(4)));
typedef unsigned u32x2 __attribute__((ext_vector_type(2)));
typedef short bf16x8 __attribute__((ext_vector_type(8)));

constexpr int BATCH = 8, SEQ = 8192, DM = 1024, NTOK = BATCH * SEQ;
constexpr int D_RWKV = 512, RWKV_COLS = 1792, MLA_COLS = 416, D_IN = 4256, N_IN_PAD = 4352;
constexpr int NH = 8, QKD = 96, NOPE = 64, ROPE = 32, VD = 64;
constexpr int NEXP = 32, DEXP = 256;
constexpr int NCLS = 112, MPAD2 = 94208;
constexpr int MPAD = 139264;
constexpr float EPS = 1e-6f, LN_X_EPS = 64e-5f;
constexpr float QSCALE = 0.10206207261596577f * 1.4426950408889634f;

constexpr size_t MiB = 1u << 20;
constexpr size_t WS_CTL = 0, CTL_ZERO_BYTES = 1 * MiB;
constexpr size_t WS_MOD = 1 * MiB;
constexpr size_t WS_ROUTE = 2 * MiB;
constexpr size_t WS_CS = 4 * MiB;
constexpr size_t WS_ENT = 12 * MiB;
constexpr size_t WS_WIN = 16 * MiB;
constexpr size_t WS_WBLK = 25 * MiB;
constexpr size_t WS_WG = WS_WBLK + 256 * 1024;
constexpr size_t WS_WUQ = WS_WG + 128 * 1024;
constexpr size_t WS_WUKV = WS_WUQ + 384 * 1024;
constexpr size_t WS_WB = 26 * MiB;
constexpr size_t WS_WO = 28 * MiB;
constexpr size_t WS_WGU = 30 * MiB;
constexpr size_t WS_WDN = 62 * MiB;
constexpr size_t WS_SG = 80 * MiB;
constexpr size_t WS_H2 = 80 * MiB;
constexpr size_t WS_ZR = 336 * MiB;
constexpr size_t WS_VC = 816 * MiB;
constexpr size_t WS_KC = 880 * MiB;
constexpr size_t WS_Y = 560 * MiB;
constexpr size_t WS_XG = 336 * MiB;
constexpr size_t WS_ZM = 560 * MiB;
constexpr size_t WS_YM = 560 * MiB + 1024;
constexpr size_t WS_H = 688 * MiB;
constexpr size_t WS_LW = 688 * MiB;
constexpr size_t WS_A = 752 * MiB;
constexpr size_t WS_MG = 688 * MiB;
constexpr size_t WS_HID2 = 208 * MiB;
constexpr size_t WS_RW = 13 * MiB;
constexpr size_t WS_HID = 208 * MiB;
constexpr size_t WS_R = 752 * MiB;
constexpr size_t WS_V = 816 * MiB;
constexpr size_t WS_ZK = 880 * MiB;
constexpr size_t WS_TWA = 944 * MiB;
constexpr size_t WS_SGL = 960 * MiB;
constexpr size_t WS_QA = 976 * MiB;
constexpr size_t WS_KVA = 1008 * MiB;
constexpr size_t WS_KK = 944 * MiB;
constexpr size_t WS_YS = 752 * MiB;
constexpr size_t WS_MO = 560 * MiB;
constexpr int YYLD = 1024;
constexpr size_t WS_END = 1024 * MiB;
constexpr size_t DO_G = 0;
constexpr size_t DO_Q = 64 * MiB;
constexpr size_t DO_KN = 160 * MiB;

constexpr int CW_CNT = 64;
constexpr int CW_BAR = 4096;

constexpr int NWAVES = 8, NTHR = 512;
constexpr int LDS_BYTES = 155648;
constexpr int LDS_MISC = 151552;

__device__ __forceinline__ int lane_id_fresh() { int l; asm volatile("v_mbcnt_lo_u32_b32 %0, -1, 0\n\tv_mbcnt_hi_u32_b32 %0, -1, %0" : "=v"(l)); return l; }
__device__ __forceinline__ float bf2f(unsigned short h) { return __builtin_bit_cast(float, (unsigned)h << 16); }
__device__ __forceinline__ unsigned f2bf(float f) { unsigned u = __builtin_bit_cast(unsigned, f); return (u + 0x7fffu + ((u >> 16) & 1u)) >> 16; }
typedef __bf16 bf16x2_t __attribute__((ext_vector_type(2)));
__device__ __forceinline__ unsigned pk2(float lo, float hi) { const f32x2 v = {lo, hi}; return __builtin_bit_cast(unsigned, __builtin_convertvector(v, bf16x2_t)); }
__device__ __forceinline__ float lo2f(unsigned w) { return __builtin_bit_cast(float, w << 16); }
__device__ __forceinline__ float hi2f(unsigned w) { return __builtin_bit_cast(float, w & 0xffff0000u); }
template <int CTRL> __device__ __forceinline__ float dpp_add(float x) { return x + __builtin_bit_cast(float, __builtin_amdgcn_update_dpp(0, __builtin_bit_cast(int, x), CTRL, 0xf, 0xf, false)); }
__device__ __forceinline__ float allsum16(float x) { x = dpp_add<0xB1>(x); x = dpp_add<0x4E>(x); x = dpp_add<0x141>(x); x = dpp_add<0x140>(x); return x; }
__device__ __forceinline__ float allsum32(float x) { x = allsum16(x); auto r = __builtin_amdgcn_permlane16_swap(__float_as_uint(x), __float_as_uint(x), false, false); return __uint_as_float(r[0]) + __uint_as_float(r[1]); }
__device__ __forceinline__ float sum8(float x) { x = dpp_add<0xB1>(x); x = dpp_add<0x4E>(x); x = dpp_add<0x141>(x); return x; }
__device__ __forceinline__ float wave_sum(float v) {
    v = allsum16(v);
    { auto r = __builtin_amdgcn_permlane16_swap(__float_as_uint(v), __float_as_uint(v), false, false); v = __uint_as_float(r[0]) + __uint_as_float(r[1]); }
    { auto r = __builtin_amdgcn_permlane32_swap(__float_as_uint(v), __float_as_uint(v), false, false); v = __uint_as_float(r[0]) + __uint_as_float(r[1]); }
    return v;
}
__device__ __forceinline__ float sigmoidf_(float x) { return __builtin_amdgcn_rcpf(1.f + __builtin_amdgcn_exp2f(-1.4426950408889634f * x)); }
__device__ __forceinline__ float tanhf_(float x) { return 1.0f - 2.0f * __builtin_amdgcn_rcpf(1.f + __builtin_amdgcn_exp2f(2.8853900817779268f * x)); }
__device__ __forceinline__ float siluf_(float x) { return x * __builtin_amdgcn_rcpf(1.f + __builtin_amdgcn_exp2f(-1.4426950408889634f * x)); }
__device__ __forceinline__ void unpack8(const u32x4 w, float (&v)[8]) {
    v[0] = lo2f(w.x); v[1] = hi2f(w.x); v[2] = lo2f(w.y); v[3] = hi2f(w.y); v[4] = lo2f(w.z); v[5] = hi2f(w.z); v[6] = lo2f(w.w); v[7] = hi2f(w.w);
}
__device__ __forceinline__ u32x4 pack8(const float (&v)[8]) { u32x4 w; w.x = pk2(v[0], v[1]); w.y = pk2(v[2], v[3]); w.z = pk2(v[4], v[5]); w.w = pk2(v[6], v[7]); return w; }

#define LDS_BAR() do { asm volatile("s_waitcnt lgkmcnt(0)" ::: "memory"); __builtin_amdgcn_s_barrier(); asm volatile("" ::: "memory"); } while (0)

#define XB_TMO      128
#define XB_XCNT(j)  (256  + 64 * (j))
#define XB_XSUB(j)  (1280 + 64 * (j))
#define XB_XGEN(j)  (2304 + 64 * (j))
#define XB_TOP      3328
#define XB_TOPGEN   3392
#define XCD_BAR_WORDS 3456
#define XB_SPIN_CAP (1u << 19)
__device__ __forceinline__ unsigned xb_ld(unsigned* p)              { return __hip_atomic_load(p, __ATOMIC_RELAXED, __HIP_MEMORY_SCOPE_AGENT); }
__device__ __forceinline__ unsigned xb_add(unsigned* p, unsigned v) { return __hip_atomic_fetch_add(p, v, __ATOMIC_RELAXED, __HIP_MEMORY_SCOPE_AGENT); }
__device__ __forceinline__ unsigned xb_xcc_id() { return (unsigned)__builtin_amdgcn_s_getreg((3 << 11) | 20) & 0xFu; }
#define XB_SPIN(cond, bar) do { unsigned _sp = 0; while (cond) { __builtin_amdgcn_s_sleep(1); \
    if ((++_sp & 255u) == 0u) { if (xb_ld(&(bar)[XB_TMO])) break; if (_sp > XB_SPIN_CAP) { atomicAdd(&(bar)[XB_TMO], 1u); break; } } } } while (0)
struct XcdBarrier { unsigned* bar; unsigned x; volatile LAS unsigned* st; };
__device__ __forceinline__ XcdBarrier xcd_barrier_post(unsigned* bar, volatile LAS unsigned* st) {
    XcdBarrier b; b.bar = bar; b.x = xb_xcc_id(); b.st = st;
    if (threadIdx.x == 0) (void)xb_add(&bar[XB_XCNT(b.x)], 1u);
    return b;
}
__device__ __forceinline__ void xcd_barrier_complete(unsigned* bar, unsigned x, unsigned& nloc, unsigned& nx) {
    const unsigned G = gridDim.x * gridDim.y * gridDim.z;
    unsigned sum, cnt, mine, sp = 0u;
    for (;;) {
        sum = 0u; cnt = 0u; mine = 0u;
#pragma unroll
        for (unsigned j = 0; j < 16; ++j) { const unsigned c = xb_ld(&bar[XB_XCNT(j)]); sum += c; cnt += (c > 0u) ? 1u : 0u; mine = (j == x) ? c : mine; }
        if (sum == G) break;
        __builtin_amdgcn_s_sleep(1);
        if ((++sp & 255u) == 0u) { if (xb_ld(&bar[XB_TMO])) break; if (sp > XB_SPIN_CAP) { atomicAdd(&bar[XB_TMO], 1u); break; } }
    }
    nloc = mine > 0u ? mine : 1u; nx = cnt > 0u ? cnt : 1u;
}
__device__ __forceinline__ void xcd_barrier(const XcdBarrier& b) {
    asm volatile("s_waitcnt vmcnt(0)" ::: "memory");
    __syncthreads();
    if (threadIdx.x == 0) {
        unsigned* bar = b.bar;
        __builtin_amdgcn_s_waitcnt(0);
        unsigned nloc = b.st[0], nx = b.st[1];
        if (nloc == 0u) { xcd_barrier_complete(bar, b.x, nloc, nx); b.st[0] = nloc; b.st[1] = nx; }
        const unsigned old = xb_add(&bar[XB_XSUB(b.x)], 1u);
        const unsigned gen = old / nloc;
        if (old + 1u == (gen + 1u) * nloc) {
            __builtin_amdgcn_fence(__ATOMIC_RELEASE, "agent");
            asm volatile("s_waitcnt vmcnt(0)" ::: "memory");
            const unsigned og = xb_add(&bar[XB_TOP], 1u);
            const unsigned tg = og / nx;
            if (og + 1u == (tg + 1u) * nx) xb_add(&bar[XB_TOPGEN], 1u);
            else XB_SPIN(xb_ld(&bar[XB_TOPGEN]) == tg, bar);
            __builtin_amdgcn_fence(__ATOMIC_ACQUIRE, "agent");
            xb_add(&bar[XB_XGEN(b.x)], 1u);
            asm volatile("s_waitcnt vmcnt(0)" ::: "memory");
        } else {
            XB_SPIN(xb_ld(&bar[XB_XGEN(b.x)]) == gen, bar);
            __builtin_amdgcn_fence(__ATOMIC_ACQUIRE, "agent");
            asm volatile("s_waitcnt vmcnt(0)" ::: "memory");
        }
    }
    __syncthreads();
}

struct Args {
    const float* in[34]; float* out; unsigned char* ws; int ph_lo, ph_hi;
};
typedef const __attribute__((address_space(4))) Args* ArgsP;
struct Frame {
    LAS unsigned char* lds;
    int wave, vcu, G, gw, NGW;
    unsigned char* ws; unsigned char* dob;
};
enum { I_X = 0, I_C, I_POS, I_WADA, I_BADA, I_GMIX, I_WIN, I_MU, I_W0, I_WDEC, I_A0, I_WAUP, I_WGUP, I_KK, I_KA, I_RK, I_LNW, I_LNB, I_GQA, I_WUQ, I_GKVA, I_WUKV,
       I_QN, I_KN, I_WBR, I_WOUT, I_GFFN, I_WRG, I_BRG, I_WRE, I_BRE, I_WEG, I_WEU, I_WED };

struct Unit { int pm, pn, aux; };
struct Gemm { const bf16* A; const bf16* Bt; int M, N, K; const int* ridx = nullptr; int ldb = 0; };
constexpr int NXCD = 8, WGM = 8;
struct StaticOrder {
    int nM, nN, nwg, G, c;
    __device__ void init(int M, int N, int G_, int c_) { nM = M / 256; nN = N / 256; nwg = nM * nN; G = G_; c = c_; }
    __device__ bool next(int i, Unit& u) const {
        const long L = (long)i * G + c; if (L >= nwg) return false;
        int wgid = (int)L; { const int q = nwg / NXCD, r = nwg % NXCD, xcd = wgid % NXCD, off = wgid / NXCD; wgid = (xcd < r ? xcd * (q + 1) : r * (q + 1) + (xcd - r) * q) + off; }
        const int nig = WGM * nN, gid = wgid / nig, fm = gid * WGM, gsz = (nM - fm) < WGM ? (nM - fm) : WGM;
        u.pm = fm + ((wgid % nig) % gsz); u.pn = (wgid % nig) / gsz; u.aux = 0; return true;
    }
    __device__ __forceinline__ void a_ready(const Unit&) const {}
    __device__ __forceinline__ void done(const Unit&) const {}
};
struct TableOrder {
    const LAS int* texp; int ntiles, nN, G, c;
    __device__ bool next(int i, Unit& u) const {
        const long L = (long)i * G + c; if (L >= (long)ntiles * nN) return false;
        const int t = (int)(L / nN), j = (int)(L % nN); u.pm = t; u.pn = texp[t] * nN + j; u.aux = 0; return true;
    }
    __device__ __forceinline__ void a_ready(const Unit&) const {}
    __device__ __forceinline__ void done(const Unit&) const {}
};

__device__ __forceinline__ void cls_decode(int cls, int& e_lo, int& e_hi) {
    const int gi = cls / 28, idx = cls % 28;
    const int lo = (idx >= 7) + (idx >= 13) + (idx >= 18) + (idx >= 22) + (idx >= 25) + (idx >= 27), base = (lo * (15 - lo)) / 2;
    e_lo = gi * 8 + lo; e_hi = gi * 8 + lo + 1 + (idx - base);
}
struct PairOrderGU {
    const LAS int* texp; int ntiles, G, c;
    __device__ bool next(int i, Unit& u) const {
        const int L = i * G + c; if (L >= ntiles * 4) return false;
        const int t = L >> 2, j = L & 3; int el, eh; cls_decode(__builtin_amdgcn_readfirstlane(texp[t]), el, eh);
        u.pm = t; u.pn = (j < 2 ? el : eh) * 2 + (j & 1); u.aux = j >> 1; return true;
    }
    __device__ __forceinline__ void a_ready(const Unit&) const {}
    __device__ __forceinline__ void done(const Unit&) const {}
};
struct PairOrderDown {
    const LAS int* texp; int ntiles, G, c;
    __device__ bool next(int i, Unit& u) const {
        const int L = i * G + c; if (L >= ntiles * 4) return false;
        const int t = L >> 2, j = L & 3; int el, eh; cls_decode(__builtin_amdgcn_readfirstlane(texp[t]), el, eh);
        u.pm = t; u.pn = el * 4 + j; u.aux = eh * 4 + j; return true;
    }
    __device__ __forceinline__ void a_ready(const Unit&) const {}
    __device__ __forceinline__ void done(const Unit&) const {}
};

template <class Epi, class Sched>
__device__ __forceinline__ void gemm_phase_naive(LAS unsigned char* lds, const Gemm g, const Sched& S, const Epi& E) {
    const int tid = (int)__builtin_amdgcn_readfirstlane((int)threadIdx.x >> 6) * 64 + lane_id_fresh(), ty = tid >> 5, tx = tid & 31;
    LAS bf16* As = (LAS bf16*)lds; LAS bf16* Bs = (LAS bf16*)(lds + 128 * 40 * 2);
    Unit u;
    for (int i = 0; S.next(i, u); ++i) {
        for (int half = 0; half < 2; ++half) {
            float acc[8][8];
#pragma unroll
            for (int r = 0; r < 8; ++r)
#pragma unroll
                for (int c = 0; c < 8; ++c) acc[r][c] = 0.f;
            const bf16* Ab = g.A + ((size_t)u.pm * 256 + half * 128) * g.K; const bf16* Bb = g.Bt + (size_t)u.pn * 256 * g.K;
            for (int k0 = 0; k0 < g.K; k0 += 32) {
                __syncthreads();
                { const int r = tid >> 2, c8 = (tid & 3) * 8; *(LAS u32x4*)(As + r * 40 + c8) = *(const u32x4*)(Ab + (size_t)r * g.K + k0 + c8); }
#pragma unroll
                for (int j = 0; j < 2; ++j) { const int ch = tid + j * 512, r = ch >> 2, c8 = (ch & 3) * 8; *(LAS u32x4*)(Bs + r * 40 + c8) = *(const u32x4*)(Bb + (size_t)r * g.K + k0 + c8); }
                __syncthreads();
#pragma unroll 2
                for (int k = 0; k < 32; k += 2) {
                    float b0[8], b1[8];
#pragma unroll
                    for (int c = 0; c < 8; ++c) { const unsigned w = *(const LAS unsigned*)(Bs + (tx * 8 + c) * 40 + k); b0[c] = lo2f(w); b1[c] = hi2f(w); }
#pragma unroll
                    for (int r = 0; r < 8; ++r) { const unsigned w = *(const LAS unsigned*)(As + (ty * 8 + r) * 40 + k); const float a0 = lo2f(w), a1 = hi2f(w);
#pragma unroll
                        for (int c = 0; c < 8; ++c) acc[r][c] = fmaf(a1, b1[c], fmaf(a0, b0[c], acc[r][c])); }
                }
            }
#pragma unroll
            for (int r = 0; r < 8; ++r) E.store8(u, half * 128 + ty * 8 + r, tx * 8, acc[r]);
        }
    }
    __syncthreads();
}

struct EpiZ { bf16 *ZR, *SG, *ZM;
    __device__ __forceinline__ void store8(const Unit& u, int r, int c, const float (&v)[8]) const {
        const size_t row = (size_t)u.pm * 256 + r;
        if (u.pn < 7) { *(u32x4*)(ZR + row * 1792 + u.pn * 256 + c) = pack8(v); }
        else if (u.pn < 15) { __builtin_nontemporal_store(pack8(v), (u32x4*)(SG + row * 2048 + (u.pn - 7) * 256 + c)); }
        else { *(u32x4*)(ZM + row * 512 + (u.pn - 15) * 256 + c) = pack8(v); }
    } };
struct EpiLora { bf16 *LW, *A; const float *w0, *a0;
    __device__ __forceinline__ void store8(const Unit& u, int r, int c, const float (&v)[8]) const {
        const size_t row = (size_t)u.pm * 256 + r; const int col = u.pn * 256 + c; float o[8];
        const bool isw = col < 512; const float* bp = isw ? (w0 + col) : (a0 + col - 512);
        const f32x4 b0 = *(const f32x4*)bp, b1 = *(const f32x4*)(bp + 4); const float bb[8] = {b0.x, b0.y, b0.z, b0.w, b1.x, b1.y, b1.z, b1.w};
#pragma unroll
        for (int i = 0; i < 8; ++i) { const float e = __builtin_amdgcn_exp2f(fminf(-1.4426950408889634f * (bb[i] + v[i]), 120.f)); const float s = __builtin_amdgcn_rcpf(1.0f + e); o[i] = isw ? -0.60653065971263342f * s : s; }
        bf16* dst = isw ? (LW + row * 512 + col) : (A + row * 512 + col - 512);
        *(u32x4*)dst = pack8(o);
    } };
struct EpiPlain { bf16* O0; bf16* O1; int split, ld0, ld1;
    __device__ __forceinline__ void store8(const Unit& u, int r, int c, const float (&v)[8]) const {
        const size_t row = (size_t)u.pm * 256 + r; int col = u.pn * 256 + c;
        if (col < split) *(u32x4*)(O0 + row * ld0 + col) = pack8(v); else *(u32x4*)(O1 + row * ld1 + col - split) = pack8(v);
    } };
struct EpiX1 { bf16* X1; const float* x; const float* mod;
    __device__ __forceinline__ void store8(const Unit& u, int r, int c, const float (&v)[8]) const {
        const size_t row = (size_t)u.pm * 256 + r; const int col = u.pn * 256 + c, b = (int)(row / SEQ); const size_t off = row * 1024 + col;
        const float* gm = mod + b * 6144 + 2048 + col; const f32x4 x0 = *(const f32x4*)(x + off), x1 = *(const f32x4*)(x + off + 4), h0 = *(const f32x4*)gm, h1 = *(const f32x4*)(gm + 4);
        const float o[8] = {x0.x + h0.x * v[0], x0.y + h0.y * v[1], x0.z + h0.z * v[2], x0.w + h0.w * v[3], x1.x + h1.x * v[4], x1.y + h1.y * v[5], x1.z + h1.z * v[6], x1.w + h1.w * v[7]};
        *(u32x4*)(X1 + off) = pack8(o);
    } };
struct EpiBranch2 { bf16* MG; const bf16* SG;
    __device__ __forceinline__ void mid8(const Unit& u, int r, int c, float (&v)[8]) const {
        const size_t row = (size_t)u.pm * 256 + r; const int col = u.pn * 256 + c; float gr[8], gm[8];
        unpack8(*(const u32x4*)(SG + row * 2048 + col), gr); unpack8(*(const u32x4*)(SG + row * 2048 + 1024 + col), gm);
#pragma unroll
        for (int i = 0; i < 8; ++i) v[i] *= (1.f + __builtin_amdgcn_exp2f(-1.4426950408889634f * fmaxf(gm[i], -30.f))) * __builtin_amdgcn_rcpf(1.f + __builtin_amdgcn_exp2f(-1.4426950408889634f * gr[i]));
    }
    __device__ __forceinline__ void store8(const Unit& u, int r, int c, const float (&v)[8]) const {
        const size_t row = (size_t)u.pm * 256 + r; const int col = u.pn * 256 + c; float gm[8], o[8];
        unpack8(*(const u32x4*)(SG + row * 2048 + 1024 + col), gm);
#pragma unroll
        for (int i = 0; i < 8; ++i) o[i] = sigmoidf_(fmaxf(gm[i], -30.f)) * v[i];
        *(u32x4*)(MG + row * 1024 + col) = pack8(o);
    } };
struct EpiGateUp { bf16* HID;
    __device__ __forceinline__ void store8(const Unit& u, int r, int c, const float (&v)[8]) const {
        const size_t row = (size_t)u.pm * 256 + r; const int col = ((u.pn & 1) * 256 + c) >> 1;
        u32x2 w; w.x = pk2(siluf_(v[0]) * v[4], siluf_(v[1]) * v[5]); w.y = pk2(siluf_(v[2]) * v[6], siluf_(v[3]) * v[7]);
        *(u32x2*)(HID + row * 256 + col) = w;
    } };
struct EpiGateUp2 { bf16* HID2; const float* rw;
    __device__ __forceinline__ void store8(const Unit& u, int r, int c, const float (&v)[8]) const {
        const size_t row = (size_t)u.pm * 256 + r; const float w = rw[row * 2 + u.aux]; const int col = u.aux * 256 + (((u.pn & 1) * 256 + c) >> 1);
        u32x2 o; o.x = pk2(w * siluf_(v[0]) * v[4], w * siluf_(v[1]) * v[5]); o.y = pk2(w * siluf_(v[2]) * v[6], w * siluf_(v[3]) * v[7]);
        *(u32x2*)(HID2 + row * 512 + col) = o;
    } };
struct EpiDown2 { float* out; const bf16* X1; const float* mod; const int* ridx;
    __device__ __forceinline__ void store8(const Unit& u, int r, int c, const float (&v)[8]) const {
        const int tok = ridx[u.pm * 256 + r]; if (tok < 0) return;
        const int col = (u.pn & 3) * 256 + c, b = tok / SEQ; const size_t off = (size_t)tok * 1024 + col;
        const float* gt = mod + b * 6144 + 5120 + col; const u32x4 xw = *(const u32x4*)(X1 + off); const f32x4 g0 = *(const f32x4*)gt, g1 = *(const f32x4*)(gt + 4);
        f32x4 o0, o1;
        o0.x = lo2f(xw.x) + g0.x * v[0]; o0.y = hi2f(xw.x) + g0.y * v[1]; o0.z = lo2f(xw.y) + g0.z * v[2]; o0.w = hi2f(xw.y) + g0.w * v[3];
        o1.x = lo2f(xw.z) + g1.x * v[4]; o1.y = hi2f(xw.z) + g1.y * v[5]; o1.z = lo2f(xw.w) + g1.z * v[6]; o1.w = hi2f(xw.w) + g1.w * v[7];
        *(f32x4*)(out + off) = o0; *(f32x4*)(out + off + 4) = o1;
    } };
struct EpiDown { bf16* YS;
    __device__ __forceinline__ void store8(const Unit& u, int r, int c, const float (&v)[8]) const {
        const size_t row = (size_t)u.pm * 256 + r; *(u32x4*)(YS + row * 1024 + (u.pn & 3) * 256 + c) = pack8(v);
    } };


namespace pg8 {
#define PG8_LAS __attribute__((address_space(3)))
typedef ::bf16x8 bf16x8; typedef ::f32x4 f32x4;
using ::Unit; using ::Gemm;
constexpr int BM = 256, BK = 64, HALF = 128, HTB = HALF * BK * 2  , STAGE_BYTES = 8 * HTB;

__device__ __forceinline__ int lds_byte(int r, int c) { const int st = (r >> 4) * 2 + (c >> 5), rr = r & 15, cc = c & 31, ob = rr * 64 + cc * 2; return st * 1024 + (ob ^ (((ob >> 9) & 1) << 5)); }
__device__ __forceinline__ void stage_rc(int b, int& R, int& C) { const int st = b / 1024, sb = b % 1024, swz = sb ^ (((sb >> 9) & 1) << 5); R = (st >> 1) * 16 + swz / 64; C = (st & 1) * 32 + (swz % 64) / 2; }
__device__ __forceinline__ int perm32(int rho) { const int n = rho >> 4, i = rho & 15; return 8 * (i >> 2) + 4 * n + (i & 3); }
template <class Epi, class Sched, bool ALIGN_EPI = false, bool SP2 = false, bool GATHER = false, bool MIDHOOK = false, bool BSEG = false>
__device__ __forceinline__ void gemm_phase(PG8_LAS unsigned char* lds, const Gemm g, const Sched& S, const Epi& E, const int wave_in) {
    const int lane = lane_id_fresh(), wid = wave_in, tid = wid * 64 + lane,
              wr = wid >> 2, wc = wid & 3, fr = lane & 15, fq = lane >> 4;
    const int K = g.K, nt = K / BK;
    unsigned voffA[2], voffB[2];
#pragma unroll
    for (int i = 0; i < 2; ++i) { int R, C; stage_rc(tid * 16 + i * 8192, R, C); const int Rb = Epi::PERM ? ((R & ~31) + perm32(R & 31)) : R;
        voffA[i] = (unsigned)(R * K + C) * 2u; voffB[i] = (unsigned)(Rb * (BSEG ? g.ldb : K) + C) * 2u; }
    unsigned vAc[2][2] = {{0u, 0u}, {0u, 0u}}, vAn[2][2] = {{0u, 0u}, {0u, 0u}}; int gR[2] = {0, 0}; unsigned gC[2] = {0u, 0u};
    if constexpr (GATHER) {
#pragma unroll
        for (int i = 0; i < 2; ++i) { int R, C; stage_rc(tid * 16 + i * 8192, R, C); gR[i] = R; gC[i] = (unsigned)C * 2u; } }
#define PG8_GIDX(dst, pm_) do { _Pragma("unroll") for (int _h = 0; _h < 2; ++_h) _Pragma("unroll") for (int _i = 0; _i < 2; ++_i) \
        { const int ri_ = g.ridx[(pm_) * BM + _h * HALF + gR[_i]]; dst[_h][_i] = (unsigned)(ri_ < 0 ? 0 : ri_) * (unsigned)(K * 2) + gC[_i]; } } while (0)
    const size_t kstep = (size_t)(BK * 2);
    const size_t hstep = (size_t)HALF * K * 2;
    const size_t tstep = 2 * hstep;
    const size_t hstepB = BSEG ? (size_t)HALF * g.ldb * 2 : hstep, tstepB = 2 * hstepB; const int nh = nt / 2;
    const unsigned ldsw = (unsigned)wid * 1024u;
    const int aoff = lds_byte(wr * 64 + fr, fq * 8), boff = lds_byte(wc * 32 + fr, fq * 8);
#define PG8_SA(b, h) (((b) * 2 + (h)) * HTB)
#define PG8_SB(b, h) ((4 + (b) * 2 + (h)) * HTB)
#define PG8_STAGE(bufoff, gbase, voff) do { _Pragma("unroll") for (int _i = 0; _i < 2; ++_i) \
        __builtin_amdgcn_global_load_lds((const unsigned*)((const char*)(gbase) + (voff)[_i]), (PG8_LAS unsigned*)(lds + (bufoff) + ldsw + _i * 8192), 16, 0, 0); } while (0)
#define PG8_STAGE_A(bufoff, kptr, h, isnext) do { if constexpr (GATHER) { unsigned _v[2]; _v[0] = (isnext) ? vAn[h][0] : vAc[h][0]; _v[1] = (isnext) ? vAn[h][1] : vAc[h][1]; PG8_STAGE(bufoff, kptr, _v); } \
        else { PG8_STAGE(bufoff, (kptr) + (h) * hstep, voffA); } } while (0)
#define PG8_LDA(dst, b, h) do { _Pragma("unroll") for (int m = 0; m < 4; ++m) _Pragma("unroll") for (int k = 0; k < 2; ++k) dst[m][k] = *(const PG8_LAS bf16x8*)(lds + PG8_SA(b, h) + aoff + m * 2048 + k * 1024); } while (0)
#define PG8_LDB(dst, b, h) do { _Pragma("unroll") for (int n = 0; n < 2; ++n) _Pragma("unroll") for (int k = 0; k < 2; ++k) dst[n][k] = *(const PG8_LAS bf16x8*)(lds + PG8_SB(b, h) + boff + n * 2048 + k * 1024); } while (0)
#define PG8_MMA(ai, bj, At, Bt) do { __builtin_amdgcn_s_setprio(1); _Pragma("unroll") for (int m = 0; m < 4; ++m) _Pragma("unroll") for (int n = 0; n < 2; ++n) _Pragma("unroll") for (int k = 0; k < 2; ++k) \
        acc[ai][bj][m][n] = __builtin_amdgcn_mfma_f32_16x16x32_bf16(Bt[n][k], At[m][k], acc[ai][bj][m][n], 0, 0, 0); __builtin_amdgcn_s_setprio(0); } while (0)
#define PG8_WAIT_V(n) asm volatile("s_waitcnt vmcnt(" #n ")" ::: "memory")
#define PG8_WAIT_L(n) asm volatile("s_waitcnt lgkmcnt(" #n ")" ::: "memory")
#define PG8_BAR __builtin_amdgcn_s_barrier()
#define PG8_SCHED __builtin_amdgcn_sched_barrier(0)
    Unit cur, nxt; int ui = 0;
    if (!S.next(0, cur)) return;
    f32x4 acc[2][2][4][2];
#pragma unroll
    for (int a = 0; a < 2; ++a)
#pragma unroll
        for (int b = 0; b < 2; ++b)
#pragma unroll
            for (int m = 0; m < 4; ++m)
#pragma unroll
                for (int n = 0; n < 2; ++n) acc[a][b][m][n] = (f32x4){0.f, 0.f, 0.f, 0.f};
    bf16x8 At[4][2], B0[2][2], B1[2][2];
    const char* cA = (const char*)g.A + (GATHER ? (size_t)0 : (size_t)cur.pm * tstep); const char* cB = (const char*)g.Bt + (size_t)cur.pn * tstepB; const char* cB2 = (const char*)g.Bt + (size_t)(BSEG ? cur.aux : cur.pn) * tstepB;
    if constexpr (GATHER) PG8_GIDX(vAc, cur.pm);
    S.a_ready(cur);
    if constexpr (SP2) {
        PG8_STAGE(PG8_SB(0, 0), cB, voffB); PG8_STAGE(PG8_SB(0, 1), cB + hstepB, voffB); PG8_STAGE_A(PG8_SA(0, 0), cA, 0, false); PG8_STAGE_A(PG8_SA(0, 1), cA, 1, false);
        if (wr == 1) PG8_BAR;
        PG8_WAIT_V(2); PG8_BAR;
        PG8_STAGE(PG8_SB(1, 0), cB + kstep, voffB); PG8_STAGE_A(PG8_SA(1, 0), cA + kstep, 0, false); PG8_STAGE(PG8_SB(1, 1), cB + hstepB + kstep, voffB);
        PG8_WAIT_V(6); PG8_BAR;
    } else {
        PG8_STAGE(PG8_SB(0, 0), cB, voffB); PG8_STAGE(PG8_SA(0, 0), cA, voffA); PG8_STAGE(PG8_SB(0, 1), cB + hstep, voffB); PG8_STAGE(PG8_SA(0, 1), cA + hstep, voffA);
        if (wr == 1) PG8_BAR;
        PG8_WAIT_V(4); PG8_BAR;
        PG8_STAGE(PG8_SB(1, 0), cB + kstep, voffB); PG8_STAGE(PG8_SA(1, 0), cA + kstep, voffA); PG8_STAGE(PG8_SB(1, 1), cB + hstep + kstep, voffB);
        PG8_WAIT_V(6); PG8_BAR;
    }
    for (;;) {
        const bool has_next = S.next(ui + 1, nxt);
        const char* nA = (has_next && !GATHER) ? (const char*)g.A + (size_t)nxt.pm * tstep : cA; const char* nB = has_next ? (const char*)g.Bt + (size_t)nxt.pn * tstepB : cB; const char* nB2 = (has_next && BSEG) ? (const char*)g.Bt + (size_t)nxt.aux * tstepB : (BSEG ? cB2 : nB);
        if constexpr (GATHER) { if (has_next) PG8_GIDX(vAn, nxt.pm); else { _Pragma("unroll") for (int _h = 0; _h < 2; ++_h) { vAn[_h][0] = vAc[_h][0]; vAn[_h][1] = vAc[_h][1]; } } }
        for (int t = 0; t < nt; t += 2) {
            if constexpr (MIDHOOK) { if (t == nt / 2) { E.mid(acc, cur, wr, wc, fr, fq); PG8_WAIT_V(0); } }
            const bool last = (t == nt - 2);
            const char* a1 = cA + (size_t)(t + 1) * kstep;
            const char* a2 = last ? nA : cA + (size_t)(t + 2) * kstep; const char* b2 = last ? nB : ((BSEG && t + 2 >= nh) ? cB2 + (size_t)(t + 2 - nh) * kstep : cB + (size_t)(t + 2) * kstep);
            const char* a3 = a2 + kstep; const char* b3 = b2 + kstep;
            if (last && has_next) S.a_ready(nxt);
            if constexpr (SP2) {
            PG8_LDB(B0, 0, 0); PG8_LDB(B1, 0, 1); PG8_SCHED; PG8_LDA(At, 0, 0); PG8_STAGE_A(PG8_SA(1, 1), a1, 1, false);
            PG8_WAIT_V(8); PG8_WAIT_L(0); PG8_BAR; PG8_MMA(0, 0, At, B0); PG8_MMA(0, 1, At, B1); PG8_BAR; PG8_SCHED;
            PG8_LDA(At, 0, 1); PG8_STAGE(PG8_SB(0, 0), b2, voffB); PG8_STAGE(PG8_SB(0, 1), b2 + hstepB, voffB); PG8_STAGE_A(PG8_SA(0, 0), a2, 0, last);
            PG8_WAIT_V(8); PG8_WAIT_L(0); PG8_BAR; PG8_MMA(1, 0, At, B0); PG8_MMA(1, 1, At, B1); PG8_BAR; PG8_SCHED;
            PG8_LDB(B0, 1, 0); PG8_LDB(B1, 1, 1); PG8_SCHED; PG8_LDA(At, 1, 0); PG8_STAGE_A(PG8_SA(0, 1), a2, 1, last);
            PG8_WAIT_V(8); PG8_WAIT_L(0); PG8_BAR; PG8_MMA(0, 0, At, B0); PG8_MMA(0, 1, At, B1); PG8_BAR; PG8_SCHED;
            PG8_LDA(At, 1, 1); PG8_STAGE(PG8_SB(1, 0), b3, voffB); PG8_STAGE(PG8_SB(1, 1), b3 + hstepB, voffB); PG8_STAGE_A(PG8_SA(1, 0), a3, 0, last);
            PG8_WAIT_V(8); PG8_WAIT_L(0); PG8_BAR; PG8_MMA(1, 0, At, B0); PG8_MMA(1, 1, At, B1); PG8_BAR; PG8_SCHED;
            } else {
            PG8_LDB(B0, 0, 0); PG8_SCHED; PG8_LDA(At, 0, 0); PG8_STAGE(PG8_SA(1, 1), a1 + hstep, voffA);
            PG8_WAIT_L(8); PG8_BAR; PG8_WAIT_L(0); PG8_MMA(0, 0, At, B0); PG8_BAR; PG8_SCHED;
            PG8_LDB(B1, 0, 1); PG8_STAGE(PG8_SB(0, 0), b2, voffB);
            PG8_BAR; PG8_WAIT_L(0); PG8_MMA(0, 1, At, B1); PG8_BAR;
            PG8_LDA(At, 0, 1); PG8_STAGE(PG8_SA(0, 0), a2, voffA);
            PG8_BAR; PG8_WAIT_L(0); PG8_MMA(1, 0, At, B0); PG8_BAR; PG8_SCHED;
            PG8_STAGE(PG8_SB(0, 1), b2 + hstep, voffB);
            PG8_WAIT_V(6); PG8_BAR; PG8_MMA(1, 1, At, B1); PG8_BAR;
            PG8_LDB(B0, 1, 0); PG8_SCHED; PG8_LDA(At, 1, 0); PG8_STAGE(PG8_SA(0, 1), a2 + hstep, voffA);
            PG8_WAIT_L(8); PG8_BAR; PG8_WAIT_L(0); PG8_MMA(0, 0, At, B0); PG8_BAR; PG8_SCHED;
            PG8_LDB(B1, 1, 1); PG8_STAGE(PG8_SB(1, 0), b3, voffB);
            PG8_BAR; PG8_WAIT_L(0); PG8_MMA(0, 1, At, B1); PG8_BAR;
            PG8_LDA(At, 1, 1); PG8_STAGE(PG8_SA(1, 0), a3, voffA);
            PG8_BAR; PG8_WAIT_L(0); PG8_MMA(1, 0, At, B0); PG8_BAR; PG8_SCHED;
            PG8_STAGE(PG8_SB(1, 1), b3 + hstep, voffB);
            PG8_WAIT_V(6); PG8_BAR; PG8_MMA(1, 1, At, B1); PG8_BAR;
            }
        }
        if constexpr (ALIGN_EPI) { if (wr == 0) PG8_BAR; }
        if constexpr (!Epi::AFTER_DRAIN) { E(acc, cur, wr, wc, fr, fq); S.done(cur); }
        if (!has_next) break;
#pragma unroll
        for (int a = 0; a < 2; ++a)
#pragma unroll
            for (int b = 0; b < 2; ++b)
#pragma unroll
                for (int m = 0; m < 4; ++m)
#pragma unroll
                    for (int n = 0; n < 2; ++n) acc[a][b][m][n] = (f32x4){0.f, 0.f, 0.f, 0.f};
        cur = nxt; cA = nA; cB = nB; cB2 = nB2; ++ui;
        if constexpr (GATHER) { _Pragma("unroll") for (int _h = 0; _h < 2; ++_h) { vAc[_h][0] = vAn[_h][0]; vAc[_h][1] = vAn[_h][1]; } }
        if constexpr (ALIGN_EPI) { if (wr == 1) PG8_BAR; }
    }
    PG8_WAIT_V(0);
    if constexpr (!ALIGN_EPI) { if (wr == 0) PG8_BAR; }
    PG8_BAR;
    if constexpr (Epi::AFTER_DRAIN) { E.fused(acc, cur, wr, wc, fr, fq, lds, wid, lane); S.done(cur); }
#undef PG8_SA
#undef PG8_SB
#undef PG8_STAGE
#undef PG8_STAGE_A
#undef PG8_GIDX
#undef PG8_LDA
#undef PG8_LDB
#undef PG8_MMA
#undef PG8_WAIT_V
#undef PG8_WAIT_L
#undef PG8_BAR
#undef PG8_SCHED
}

template <class F> struct EpiAdapt {
    static constexpr bool PERM = true, AFTER_DRAIN = false; F f;
    __device__ __forceinline__ void mid(f32x4 (&acc)[2][2][4][2], const Unit& u, int wr, int wc, int fr, int fq) const {
        asm volatile("" : "+v"(fr), "+v"(fq));
#pragma unroll
        for (int ai = 0; ai < 2; ++ai)
#pragma unroll
            for (int m = 0; m < 4; ++m) { const int row = ai * HALF + wr * 64 + m * 16 + fr;
#pragma unroll
                for (int bj = 0; bj < 2; ++bj) { float v[8] = {acc[ai][bj][m][0][0], acc[ai][bj][m][0][1], acc[ai][bj][m][0][2], acc[ai][bj][m][0][3], acc[ai][bj][m][1][0], acc[ai][bj][m][1][1], acc[ai][bj][m][1][2], acc[ai][bj][m][1][3]};
                    f.mid8(u, row, bj * HALF + wc * 32 + 8 * fq, v);
                    acc[ai][bj][m][0] = (f32x4){v[0], v[1], v[2], v[3]}; acc[ai][bj][m][1] = (f32x4){v[4], v[5], v[6], v[7]}; } }
    }
    __device__ __forceinline__ void operator()(const f32x4 (&acc)[2][2][4][2], const Unit& u, int wr, int wc, int fr, int fq) const {
        asm volatile("" : "+v"(fr), "+v"(fq));
#pragma unroll
        for (int ai = 0; ai < 2; ++ai)
#pragma unroll
            for (int m = 0; m < 4; ++m) { const int row = ai * HALF + wr * 64 + m * 16 + fr;
#pragma unroll
                for (int bj = 0; bj < 2; ++bj) { const f32x4 v0 = acc[ai][bj][m][0], v1 = acc[ai][bj][m][1];
                    const float v[8] = {v0[0], v0[1], v0[2], v0[3], v1[0], v1[1], v1[2], v1[3]};
                    f.store8(u, row, bj * HALF + wc * 32 + 8 * fq, v); } }
    }
};
}

template <class Epi, class Sched>
__device__ __forceinline__ void gemm_phase_mid(LAS unsigned char* lds, const Gemm g, const Sched& S, const Epi& E, const int wave_in) {
    pg8::EpiAdapt<Epi> EA{E};
    pg8::gemm_phase<pg8::EpiAdapt<Epi>, Sched, true, true, false, true>(lds, g, S, EA, wave_in);
}
template <class Epi, class Sched>
__device__ __forceinline__ void gemm_phase_bseg(LAS unsigned char* lds, const Gemm g, const Sched& S, const Epi& E, const int wave_in) {
    pg8::EpiAdapt<Epi> EA{E};
    pg8::gemm_phase<pg8::EpiAdapt<Epi>, Sched, true, true, false, false, true>(lds, g, S, EA, wave_in);
}
template <class Epi, class Sched>
__device__ __forceinline__ void gemm_phase_gather(LAS unsigned char* lds, const Gemm g, const Sched& S, const Epi& E, const int wave_in) {
    pg8::EpiAdapt<Epi> EA{E};
    pg8::gemm_phase<pg8::EpiAdapt<Epi>, Sched, true, true, true>(lds, g, S, EA, wave_in);
}
template <class Epi, class Sched>
__device__ __forceinline__ void gemm_phase_any(LAS unsigned char* lds, const Gemm g, const Sched& S, const Epi& E, const int wave_in) {
#if ENG_GEMM == 1
    pg8::EpiAdapt<Epi> EA{E};
    pg8::gemm_phase<pg8::EpiAdapt<Epi>, Sched, true, true>(lds, g, S, EA, wave_in);
#else
    gemm_phase_naive<Epi, Sched>(lds, g, S, E);
#endif
}

template <class RowMap>
__device__ __forceinline__ void transpose_item(const float* W, int ldw, bf16* WT, int ldt, int koff, int k0, int n0, const RowMap& rm, LAS float* scr, int lane) {
#pragma unroll 8
    for (int i = 0; i < 32; ++i) { const int kk = 2 * i + (lane >> 5); scr[kk * 33 + (lane & 31)] = W[(size_t)(k0 + kk) * ldw + n0 + (lane & 31)]; }
    asm volatile("s_waitcnt lgkmcnt(0)" ::: "memory");
    const int c = lane & 7;
#pragma unroll
    for (int j = 0; j < 4; ++j) { const int n = (lane >> 3) + 8 * j; const LAS float* s = scr + (8 * c) * 33 + n;
        u32x4 o; o.x = pk2(s[0 * 33], s[1 * 33]); o.y = pk2(s[2 * 33], s[3 * 33]); o.z = pk2(s[4 * 33], s[5 * 33]); o.w = pk2(s[6 * 33], s[7 * 33]);
        *(u32x4*)(WT + (size_t)rm(n0 + n) * ldt + koff + k0 + 8 * c) = o; }
    asm volatile("s_waitcnt lgkmcnt(0)" ::: "memory");
}
struct RmId { int off; __device__ int operator()(int n) const { return off + n; } };
struct RmWin { __device__ int operator()(int n) const { return n < 1792 ? n : (n < 2208 ? 3840 + (n - 1792) : 1792 + (n - 2208)); } };
struct RmUkv { __device__ int operator()(int n) const { const int h = n >> 7, j = n & 127; return j < 64 ? h * 64 + j : 512 + h * 64 + (j - 64); } };
struct RmGU { int off; __device__ int operator()(int j) const { return off + 8 * (j >> 2) + (j & 3); } };

__device__ __forceinline__ void p0_prologue(const Frame& F, ArgsP a) {
    const int lane_f = lane_id_fresh(), tid_f = F.wave * 64 + lane_f;
    LAS float* scr = (LAS float*)(F.lds + F.wave * 16384);
    const int lane = lane_f;
    bf16* Win = (bf16*)(F.ws + WS_WIN); bf16* Wblk = (bf16*)(F.ws + WS_WBLK); bf16* Wg = (bf16*)(F.ws + WS_WG); bf16* Wuq = (bf16*)(F.ws + WS_WUQ);
    bf16* Wukv = (bf16*)(F.ws + WS_WUKV); bf16* Wb = (bf16*)(F.ws + WS_WB); bf16* Wo = (bf16*)(F.ws + WS_WO); bf16* Wgu = (bf16*)(F.ws + WS_WGU); bf16* Wdn = (bf16*)(F.ws + WS_WDN);
    constexpr int I_IN = 16 * 133, I_DEC = 1 * 16, I_AUP = 16, I_GUP = 2 * 16, I_UQ = 4 * 24, I_UKV = 2 * 32, I_BR = 2 * 8 * 32, I_O = 16 * 32;
    constexpr int I_EG = 32 * 16 * 8, I_EU = I_EG, I_ED = 32 * 4 * 32;
    constexpr int NITEMS = I_IN + I_DEC + I_AUP + I_GUP + I_UQ + I_UKV + I_BR + I_O + I_EG + I_EU + I_ED;
    for (int it = F.gw; it < NITEMS; it += F.NGW) {
        int r = it;
        if (r < I_IN) { const int kb = r / 133, nb = r % 133; transpose_item(a->in[I_WIN], D_IN, Win, 1024, 0, 64 * kb, 32 * nb, RmWin{}, scr, lane); continue; } r -= I_IN;
        if (r < I_DEC) { transpose_item(a->in[I_WDEC], 512, Wblk, 128, 0, 0, 32 * r, RmId{0}, scr, lane); continue; } r -= I_DEC;
        if (r < I_AUP) { transpose_item(a->in[I_WAUP], 512, Wblk, 128, 64, 0, 32 * r, RmId{512}, scr, lane); continue; } r -= I_AUP;
        if (r < I_GUP) { const int kb = r / 16, nb = r % 16; transpose_item(a->in[I_WGUP], 512, Wg, 128, 0, 64 * kb, 32 * nb, RmId{0}, scr, lane); continue; } r -= I_GUP;
        if (r < I_UQ) { const int kb = r / 24, nb = r % 24; transpose_item(a->in[I_WUQ], 768, Wuq, 256, 0, 64 * kb, 32 * nb, RmId{0}, scr, lane); continue; } r -= I_UQ;
        if (r < I_UKV) { const int kb = r / 32, nb = r % 32; transpose_item(a->in[I_WUKV], 1024, Wukv, 128, 0, 64 * kb, 32 * nb, RmUkv{}, scr, lane); continue; } r -= I_UKV;
        if (r < I_BR) { const int br = r / 256, q = r % 256, kb = q / 32, nb = q % 32; transpose_item(a->in[I_WBR] + (size_t)br * 512 * 1024, 1024, Wb, 1024, 512 * br, 64 * kb, 32 * nb, RmId{0}, scr, lane); continue; } r -= I_BR;
        if (r < I_O) { const int kb = r / 32, nb = r % 32; transpose_item(a->in[I_WOUT], 1024, Wo, 1024, 0, 64 * kb, 32 * nb, RmId{0}, scr, lane); continue; } r -= I_O;
        if (r < I_EG) { const int e = r / 128, q = r % 128, kb = q / 8, nb = q % 8; transpose_item(a->in[I_WEG] + (size_t)e * 1024 * 256, 256, Wgu + (size_t)e * 512 * 1024, 1024, 0, 64 * kb, 32 * nb, RmGU{0}, scr, lane); continue; } r -= I_EG;
        if (r < I_EU) { const int e = r / 128, q = r % 128, kb = q / 8, nb = q % 8; transpose_item(a->in[I_WEU] + (size_t)e * 1024 * 256, 256, Wgu + (size_t)e * 512 * 1024, 1024, 0, 64 * kb, 32 * nb, RmGU{4}, scr, lane); continue; } r -= I_EU;
        { const int e = r / 128, q = r % 128, kb = q / 32, nb = q % 32; transpose_item(a->in[I_WED] + (size_t)e * 256 * 1024, 1024, Wdn + (size_t)e * 1024 * 256, 256, 0, 64 * kb, 32 * nb, RmId{0}, scr, lane); }
    }
    for (int i = F.gw * 64 + lane; i < 96 * 128; i += F.NGW * 64) *(u32x4*)(Win + (size_t)4256 * 1024 + (size_t)i * 8) = (u32x4){0u, 0u, 0u, 0u};
    for (int i = F.gw * 64 + lane; i < 1024 * 8; i += F.NGW * 64) { const int row = i >> 3, c8 = (i & 7) * 8; *(u32x4*)(Wblk + row * 128 + (row < 512 ? 64 : 0) + c8) = (u32x4){0u, 0u, 0u, 0u}; }
    { const int* pos = (const int*)a->in[I_POS]; float* cs = (float*)(F.ws + WS_CS);
      for (int i = F.gw * 64 + lane; i < NTOK * 16; i += F.NGW * 64) { const int t = i >> 4, j = i & 15;
          const float fr = exp2f(-(float)j * (13.287712379549449f / 16.0f));
          const float ang = (float)pos[t] * fr; cs[t * 32 + j] = cosf(ang); cs[t * 32 + 16 + j] = sinf(ang); } }
    { float* mod = (float*)(F.ws + WS_MOD); const float* c = a->in[I_C]; const float* wa = a->in[I_WADA]; const float* ba = a->in[I_BADA];
      LAS float* red = (LAS float*)(F.lds + 8 * 16384);
      LAS float* sc = (LAS float*)F.lds;
      if (F.vcu < 96) {
          __syncthreads();
          for (int i = tid_f; i < 8192; i += NTHR) sc[i] = siluf_(c[i]);
          __syncthreads();
      }
      for (int nb = F.vcu; nb < 96; nb += F.G) {
          float acc[8];
#pragma unroll
          for (int b = 0; b < 8; ++b) acc[b] = 0.f;
          const int n = nb * 64 + lane;
          for (int k0 = F.wave * 128; k0 < F.wave * 128 + 128; k0 += 16) { float w[16];
#pragma unroll
              for (int kk = 0; kk < 16; ++kk) w[kk] = wa[(size_t)(k0 + kk) * 6144 + n];
#pragma unroll
              for (int kk = 0; kk < 16; ++kk)
#pragma unroll
                  for (int b = 0; b < 8; ++b) acc[b] = fmaf(sc[b * 1024 + k0 + kk], w[kk], acc[b]); }
#pragma unroll
          for (int b = 0; b < 8; ++b) red[(F.wave * 8 + b) * 64 + lane] = acc[b];
          __syncthreads();
          { const int b = F.wave; float s = ba[n];
#pragma unroll
            for (int w = 0; w < 8; ++w) s += red[(w * 8 + b) * 64 + lane];
            mod[b * 6144 + n] = s; }
          __syncthreads();
      } }
}

__device__ __forceinline__ void p_normmod(const Frame& F, const float* x, const float* g, const float* mod, int sh_off, int sc_off, bf16* H) {
    const int lane_f = lane_id_fresh();
    f32x4 xa[4], xb[4];
    { const f32x4* xr = (const f32x4*)(x + (size_t)F.gw * 1024) + lane_f;
#pragma unroll
      for (int j = 0; j < 4; ++j) xa[j] = xr[64 * j]; }
    f32x4 gs[4], sh[4]; int bcur = -1;
#define NM_ROW(CUR, NXT, m_) do { const int mm = (m_); const int b = mm / SEQ; \
        if (b != bcur) { bcur = b; \
            _Pragma("unroll") for (int j = 0; j < 4; ++j) { const int col = 4 * lane_f + 256 * j; gs[j] = *(const f32x4*)(g + col) * (*(const f32x4*)(mod + b * 6144 + sc_off + col) + 1.0f); sh[j] = *(const f32x4*)(mod + b * 6144 + sh_off + col); } \
            asm volatile("s_waitcnt vmcnt(0)" : "+v"(gs[0]), "+v"(gs[1]), "+v"(gs[2]), "+v"(gs[3]), "+v"(sh[0]), "+v"(sh[1]), "+v"(sh[2]), "+v"(sh[3]), "+v"(CUR[0]), "+v"(CUR[1]), "+v"(CUR[2]), "+v"(CUR[3])); } \
        { const int mn = (mm + F.NGW < NTOK) ? mm + F.NGW : mm; const f32x4* xr = (const f32x4*)(x + (size_t)mn * 1024) + lane_f; \
          _Pragma("unroll") for (int j = 0; j < 4; ++j) NXT[j] = xr[64 * j]; } \
        float s = 0.f; \
        _Pragma("unroll") for (int j = 0; j < 4; ++j) s += (CUR[j].x * CUR[j].x + CUR[j].y * CUR[j].y) + (CUR[j].z * CUR[j].z + CUR[j].w * CUR[j].w); \
        const float rstd = 1.0f / sqrtf(wave_sum(s) * (1.f / 1024.f) + EPS); \
        u32x2* o = (u32x2*)(H + (size_t)mm * 1024) + lane_f; \
        _Pragma("unroll") for (int j = 0; j < 4; ++j) { const f32x4 y = CUR[j] * rstd * gs[j] + sh[j]; u32x2 w; w.x = pk2(y.x, y.y); w.y = pk2(y.z, y.w); o[64 * j] = w; } } while (0)
    for (int m = F.gw; m < NTOK; m += 2 * F.NGW) {
        NM_ROW(xa, xb, m);
        if (m + F.NGW < NTOK) NM_ROW(xb, xa, m + F.NGW);
    }
#undef NM_ROW
}

__device__ __forceinline__ void p_prep_a(const Frame& F, ArgsP a) {
    const int lane_f = lane_id_fresh();
    const bf16* ZR = (const bf16*)(F.ws + WS_ZR); const bf16* ZM = (const bf16*)(F.ws + WS_ZM);
    bf16* TWA = (bf16*)(F.ws + WS_TWA); bf16* SGL = (bf16*)(F.ws + WS_SGL); bf16* QA = (bf16*)(F.ws + WS_QA); bf16* KVA = (bf16*)(F.ws + WS_KVA);
    const float* mu = a->in[I_MU]; const float* gqa = a->in[I_GQA]; const float* gkva = a->in[I_GKVA];
    const int lane = lane_f;
    const f32x4 mm = *(const f32x4*)(mu + 1536 + 4 * lane), gq = *(const f32x4*)(gqa + 4 * lane), gk = *(const f32x4*)(gkva + 4 * (lane & 31));
    for (int m0 = F.gw; m0 < NTOK; m0 += 4 * F.NGW) {
        u32x2 cc[4], pp[4], qq[4], kk[4];
#pragma unroll
        for (int u = 0; u < 4; ++u) { const int m = (m0 + u * F.NGW < NTOK) ? m0 + u * F.NGW : m0; const bool first = (m % SEQ) == 0;
            cc[u] = *((const u32x2*)(ZR + (size_t)m * 1792 + 1536) + lane); pp[u] = *((const u32x2*)(ZR + (size_t)(first ? m : m - 1) * 1792 + 1536) + lane);
            qq[u] = *((const u32x2*)(ZM + (size_t)m * 512) + lane); kk[u] = *((const u32x2*)(ZM + (size_t)m * 512 + 256) + (lane & 31)); }
#pragma unroll
        for (int u = 0; u < 4; ++u) { const int m = m0 + u * F.NGW; if (m < NTOK) { const bool first = (m % SEQ) == 0;
            { const u32x2 c = cc[u]; u32x2 p = pp[u]; if (first) { p.x = 0u; p.y = 0u; }
              float z[4] = {lo2f(c.x), hi2f(c.x), lo2f(c.y), hi2f(c.y)}; const float q[4] = {lo2f(p.x), hi2f(p.x), lo2f(p.y), hi2f(p.y)};
              z[0] += (q[0] - z[0]) * mm.x; z[1] += (q[1] - z[1]) * mm.y; z[2] += (q[2] - z[2]) * mm.z; z[3] += (q[3] - z[3]) * mm.w;
              if (lane < 16) { u32x2 w; w.x = pk2(tanhf_(z[0]), tanhf_(z[1])); w.y = pk2(tanhf_(z[2]), tanhf_(z[3])); *((u32x2*)(TWA + (size_t)m * 128) + lane) = w; }
              else if (lane < 32) { u32x2 w; w.x = pk2(z[0], z[1]); w.y = pk2(z[2], z[3]); *((u32x2*)(TWA + (size_t)m * 128) + lane) = w; }
              else { u32x2 w; w.x = pk2(sigmoidf_(z[0]), sigmoidf_(z[1])); w.y = pk2(sigmoidf_(z[2]), sigmoidf_(z[3])); *((u32x2*)(SGL + (size_t)m * 128) + (lane - 32)) = w; } }
            { const u32x2 c = qq[u]; const float z[4] = {lo2f(c.x), hi2f(c.x), lo2f(c.y), hi2f(c.y)};
              u32x2 c2 = kk[u]; if (lane >= 32) { c2.x = 0u; c2.y = 0u; } const float y[4] = {lo2f(c2.x), hi2f(c2.x), lo2f(c2.y), hi2f(c2.y)};
              const float rstd = 1.0f / sqrtf(wave_sum((z[0] * z[0] + z[1] * z[1]) + (z[2] * z[2] + z[3] * z[3])) * (1.f / 256.f) + EPS);
              const float rstd2 = 1.0f / sqrtf(wave_sum((y[0] * y[0] + y[1] * y[1]) + (y[2] * y[2] + y[3] * y[3])) * (1.f / 128.f) + EPS);
              u32x2 w; w.x = pk2(z[0] * rstd * gq.x, z[1] * rstd * gq.y); w.y = pk2(z[2] * rstd * gq.z, z[3] * rstd * gq.w);
              *((u32x2*)(QA + (size_t)m * 256) + lane) = w;
              if (lane < 32) { u32x2 w2; w2.x = pk2(y[0] * rstd2 * gk.x, y[1] * rstd2 * gk.y); w2.y = pk2(y[2] * rstd2 * gk.z, y[3] * rstd2 * gk.w);
                  *((u32x2*)(KVA + (size_t)m * 128) + lane) = w2; } } } }
    }
}

__device__ __forceinline__ void p_prep_c(const Frame& F, ArgsP a) {
    const int lane_f = lane_id_fresh();
    const bf16* KN = (const bf16*)(F.dob + DO_KN); const bf16* ZM = (const bf16*)(F.ws + WS_ZM); bf16* KC = (bf16*)(F.ws + WS_KC);
    const float* cs = (const float*)(F.ws + WS_CS); const float* kn = a->in[I_KN];
    const int lane = lane_f, hd = lane >> 3, j = lane & 7;
    const f32x4 kg0 = *(const f32x4*)(kn + 8 * j), kg1 = *(const f32x4*)(kn + 8 * j + 4); const f32x2 kr1 = *(const f32x2*)(kn + 64 + 2 * j), kr2 = *(const f32x2*)(kn + 80 + 2 * j);
    for (int m0 = F.gw; m0 < NTOK; m0 += 4 * F.NGW) {
        u32x4 kv[4]; unsigned z1[4], z2[4]; f32x2 cc[4], sn[4];
#pragma unroll
        for (int u = 0; u < 4; ++u) { const size_t m = (size_t)((m0 + u * F.NGW < NTOK) ? m0 + u * F.NGW : m0);
            kv[u] = *(const u32x4*)(KN + m * 512 + hd * 64 + 8 * j); z1[u] = *(const unsigned*)(ZM + m * 512 + 384 + 2 * j); z2[u] = *(const unsigned*)(ZM + m * 512 + 400 + 2 * j);
            cc[u] = *(const f32x2*)(cs + m * 32 + 2 * j); sn[u] = *(const f32x2*)(cs + m * 32 + 16 + 2 * j); }
#pragma unroll
        for (int u = 0; u < 4; ++u) { const int m = m0 + u * F.NGW; if (m < NTOK) {
            float v[8]; unpack8(kv[u], v); float x1[2] = {lo2f(z1[u]), hi2f(z1[u])}, x2[2] = {lo2f(z2[u]), hi2f(z2[u])};
            float ss = (x1[0] * x1[0] + x1[1] * x1[1]) + (x2[0] * x2[0] + x2[1] * x2[1]);
#pragma unroll
            for (int i = 0; i < 8; ++i) ss += v[i] * v[i];
            const float rstd = 1.0f / sqrtf(sum8(ss) * (1.f / 96.f) + EPS);
            v[0] *= rstd * kg0.x; v[1] *= rstd * kg0.y; v[2] *= rstd * kg0.z; v[3] *= rstd * kg0.w; v[4] *= rstd * kg1.x; v[5] *= rstd * kg1.y; v[6] *= rstd * kg1.z; v[7] *= rstd * kg1.w;
            x1[0] *= rstd * kr1.x; x1[1] *= rstd * kr1.y; x2[0] *= rstd * kr2.x; x2[1] *= rstd * kr2.y;
            bf16* kp = KC + (size_t)m * 768 + hd * 96;
            *(u32x4*)(kp + 8 * j) = pack8(v); *(unsigned*)(kp + 64 + 2 * j) = pk2(x1[0] * cc[u].x - x2[0] * sn[u].x, x1[1] * cc[u].y - x2[1] * sn[u].y);
            *(unsigned*)(kp + 80 + 2 * j) = pk2(x2[0] * cc[u].x + x1[0] * sn[u].x, x2[1] * cc[u].y + x1[1] * sn[u].y); } }
    }
}

__device__ __forceinline__ void p_attn_naive(const Frame& F) {
    const int lane_f = lane_id_fresh(), tid_f = F.wave * 64 + lane_f;
    const bf16* Q = (const bf16*)(F.dob + DO_Q); const bf16* KC = (const bf16*)(F.ws + WS_KC); const bf16* VC = (const bf16*)(F.ws + WS_VC); bf16* YM = (bf16*)(F.ws + WS_YM);
    LAS float* Ks = (LAS float*)F.lds; LAS float* Vs = (LAS float*)(F.lds + 32 * 96 * 4);
    const int tid = tid_f;
    for (int unit = F.vcu; unit < 64 * 16; unit += F.G) {
        const int bh = unit >> 4, qb = 15 - (unit & 15), b = bh >> 3, h = bh & 7; const size_t row0 = (size_t)b * SEQ; const int t = qb * 512 + tid;
        unsigned qp[48];
        { const u32x4* qg = (const u32x4*)(Q + (row0 + t) * 768 + h * 96);
#pragma unroll
          for (int i = 0; i < 12; ++i) { const u32x4 w = qg[i]; qp[4 * i] = w.x; qp[4 * i + 1] = w.y; qp[4 * i + 2] = w.z; qp[4 * i + 3] = w.w; } }
        float o[64];
#pragma unroll
        for (int i = 0; i < 64; ++i) o[i] = 0.f;
        float mx = -INFINITY, l = 0.f;
        const int nkt = (qb + 1) * 16;
        for (int kt = 0; kt < nkt; ++kt) {
            __syncthreads();
            if (tid < 384) { const int r = tid / 12, c8 = (tid % 12) * 8; float v[8]; unpack8(*(const u32x4*)(KC + (row0 + kt * 32 + r) * 768 + h * 96 + c8), v);
#pragma unroll
                for (int i = 0; i < 8; ++i) Ks[r * 96 + c8 + i] = v[i]; }
            if (tid < 256) { const int r = tid >> 3, c8 = (tid & 7) * 8; float v[8]; unpack8(*(const u32x4*)(VC + (row0 + kt * 32 + r) * 512 + h * 64 + c8), v);
#pragma unroll
                for (int i = 0; i < 8; ++i) Vs[r * 64 + c8 + i] = v[i]; }
            __syncthreads();
            for (int kk = 0; kk < 32; ++kk) {
                const int kv = kt * 32 + kk;
                float s = 0.f; const LAS f32x4* kr = (const LAS f32x4*)(Ks + kk * 96);
#pragma unroll
                for (int i = 0; i < 24; ++i) { const f32x4 k4 = kr[i]; s += lo2f(qp[2 * i]) * k4.x + hi2f(qp[2 * i]) * k4.y + lo2f(qp[2 * i + 1]) * k4.z + hi2f(qp[2 * i + 1]) * k4.w; }
                if (kv <= t) {
                    const float mn = fmaxf(mx, s), f = exp2f(mx - mn), p = exp2f(s - mn); mx = mn; l = l * f + p;
                    const LAS f32x4* vr = (const LAS f32x4*)(Vs + kk * 64);
#pragma unroll
                    for (int i = 0; i < 16; ++i) { const f32x4 v4 = vr[i]; o[4 * i] = o[4 * i] * f + p * v4.x; o[4 * i + 1] = o[4 * i + 1] * f + p * v4.y; o[4 * i + 2] = o[4 * i + 2] * f + p * v4.z; o[4 * i + 3] = o[4 * i + 3] * f + p * v4.w; }
                }
            }
        }
        const float il = 1.f / l; u32x4* og = (u32x4*)(YM + (row0 + t) * 512 + h * 64);
#pragma unroll
        for (int i = 0; i < 8; ++i) { u32x4 w; w.x = pk2(o[8 * i] * il, o[8 * i + 1] * il); w.y = pk2(o[8 * i + 2] * il, o[8 * i + 3] * il); w.z = pk2(o[8 * i + 4] * il, o[8 * i + 5] * il); w.w = pk2(o[8 * i + 6] * il, o[8 * i + 7] * il); og[i] = w; }
    }
    __syncthreads();
}

typedef float f32x16 __attribute__((ext_vector_type(16)));
typedef short s16x4 __attribute__((ext_vector_type(4)));
__device__ __forceinline__ int crow(int r, int hi) { return (r & 3) + 8 * (r >> 2) + 4 * hi; }
__device__ __forceinline__ float max3f(float a, float b, float c) { float r; asm("v_max3_f32 %0, %1, %2, %3" : "=v"(r) : "v"(a), "v"(b), "v"(c)); return r; }
__device__ __forceinline__ float max2f(float a, float b) { float r; asm("v_max_f32_e32 %0, %1, %2" : "=v"(r) : "v"(a), "v"(b)); return r; }
__device__ __forceinline__ float xhalf_max(float x) { auto rr = __builtin_amdgcn_permlane32_swap(__float_as_uint(x), __float_as_uint(x), false, false); return max2f(__uint_as_float(rr[0]), __uint_as_float(rr[1])); }
__device__ __forceinline__ float xhalf_sum(float x) { auto rr = __builtin_amdgcn_permlane32_swap(__float_as_uint(x), __float_as_uint(x), false, false); return __uint_as_float(rr[0]) + __uint_as_float(rr[1]); }
__device__ __forceinline__ bf16x8 packp(const f32x16& p, int s2) {
    u32x4 w; w.x = pk2(p[8 * s2 + 0], p[8 * s2 + 1]); w.y = pk2(p[8 * s2 + 2], p[8 * s2 + 3]); w.z = pk2(p[8 * s2 + 4], p[8 * s2 + 5]); w.w = pk2(p[8 * s2 + 6], p[8 * s2 + 7]);
    return __builtin_bit_cast(bf16x8, w);
}
__device__ __forceinline__ void p_attn_mfma(const Frame& F, const float* qn) {
    const int lane_f = lane_id_fresh(), tid_f = F.wave * 64 + lane_f;
    const bf16* Q = (const bf16*)(F.dob + DO_Q); const bf16* KC = (const bf16*)(F.ws + WS_KC); const bf16* VC = (const bf16*)(F.ws + WS_VC); bf16* YM = (bf16*)(F.ws + WS_YM);
    const float* cs = (const float*)(F.ws + WS_CS);
    constexpr int KST = 208, VST = 192, KBYTES = 64 * KST, SUB = KBYTES + 64 * VST, BUF = 2 * SUB;
    const int tid = tid_f, lane = lane_f, wave = F.wave, r = lane & 31, hi = lane >> 5;
    int kg[3], kl[3], vg[2], vl[2];
#pragma unroll
    for (int i = 0; i < 3; ++i) { const int c = tid + 512 * i, row = c / 12, pc = c % 12; kg[i] = row * 768 + pc * 8; kl[i] = (row >> 6) * SUB + (row & 63) * KST + pc * 16; }
#pragma unroll
    for (int i = 0; i < 2; ++i) { const int c = tid + 512 * i, row = c >> 3, pc = c & 7; vg[i] = row * 512 + pc * 8; vl[i] = (row >> 6) * SUB + KBYTES + (row & 63) * VST + pc * 16; }
    const int g4 = lane >> 4, li = lane & 15;
    const int vtr = (4 * (g4 >> 1) + (li >> 2)) * VST + (16 * (g4 & 1) + 4 * (li & 3)) * 2;
    const int kfr = r * KST + hi * 16;
    LAS unsigned char* lds = F.lds;
    for (int item = F.vcu; item < 1024; item += F.G) {
        const int bh = item >> 4, sidx = item & 15, b = bh >> 3, h = bh & 7; const size_t row0 = (size_t)b * SEQ;
        const bf16* Kg = KC + row0 * 768 + h * 96; const bf16* Vg = VC + row0 * 512 + h * 64;
        for (int uu = 0; uu < 2; ++uu) {
            const int qb = uu == 0 ? 31 - sidx : sidx, q0 = qb * 256, NT = (q0 + 256) / 128;
            const int qw = q0 + wave * 32;
            bf16x8 qf[6];
            {
              const bf16* qp = Q + (row0 + qw + r) * 768 + h * 96 + hi * 8; const float* csr = cs + (row0 + qw + r) * 32 + 8 * hi;
              u32x4 raw[6];
#pragma unroll
              for (int s = 0; s < 6; ++s) raw[s] = *(const u32x4*)(qp + 16 * s);
              const f32x4 c0 = *(const f32x4*)csr, c1 = *(const f32x4*)(csr + 4), s0 = *(const f32x4*)(csr + 16), s1 = *(const f32x4*)(csr + 20);
              float ss = 0.f;
#pragma unroll
              for (int s = 0; s < 6; ++s) { float t[8]; unpack8(raw[s], t);
#pragma unroll
                  for (int e = 0; e < 8; ++e) ss += t[e] * t[e]; }
              const float rstd = QSCALE / sqrtf(xhalf_sum(ss) * (1.f / 96.f) + EPS);
#pragma unroll
              for (int s = 0; s < 4; ++s) { float t[8]; unpack8(raw[s], t); const f32x4 g0 = *(const f32x4*)(qn + 16 * s + 8 * hi), g1 = *(const f32x4*)(qn + 16 * s + 8 * hi + 4);
                  t[0] *= rstd * g0.x; t[1] *= rstd * g0.y; t[2] *= rstd * g0.z; t[3] *= rstd * g0.w; t[4] *= rstd * g1.x; t[5] *= rstd * g1.y; t[6] *= rstd * g1.z; t[7] *= rstd * g1.w;
                  qf[s] = __builtin_bit_cast(bf16x8, pack8(t)); }
              { float a4[8], a5[8]; unpack8(raw[4], a4); unpack8(raw[5], a5);
                const f32x4 g0 = *(const f32x4*)(qn + 64 + 8 * hi), g1 = *(const f32x4*)(qn + 64 + 8 * hi + 4), h0 = *(const f32x4*)(qn + 80 + 8 * hi), h1 = *(const f32x4*)(qn + 80 + 8 * hi + 4);
                const float ga[8] = {g0.x, g0.y, g0.z, g0.w, g1.x, g1.y, g1.z, g1.w}, gb[8] = {h0.x, h0.y, h0.z, h0.w, h1.x, h1.y, h1.z, h1.w};
                const float cc[8] = {c0.x, c0.y, c0.z, c0.w, c1.x, c1.y, c1.z, c1.w}, sn[8] = {s0.x, s0.y, s0.z, s0.w, s1.x, s1.y, s1.z, s1.w};
#pragma unroll
                for (int e = 0; e < 8; ++e) { const float x1 = a4[e] * rstd * ga[e], x2 = a5[e] * rstd * gb[e]; a4[e] = x1 * cc[e] - x2 * sn[e]; a5[e] = x2 * cc[e] + x1 * sn[e]; }
                qf[4] = __builtin_bit_cast(bf16x8, pack8(a4)); qf[5] = __builtin_bit_cast(bf16x8, pack8(a5)); } }
            f32x16 o0 = {}, o1 = {}, negm = {}; float m = 0.f, l = 0.f;
            u32x4 ak[3], av[2];
#pragma unroll
            for (int i = 0; i < 3; ++i) ak[i] = *(const u32x4*)(Kg + kg[i]);
#pragma unroll
            for (int i = 0; i < 2; ++i) av[i] = *(const u32x4*)(Vg + vg[i]);
            asm volatile("" : "+v"(qf[0]), "+v"(qf[1]), "+v"(qf[2]), "+v"(qf[3]), "+v"(qf[4]), "+v"(qf[5]));
            LDS_BAR();
#pragma unroll
            for (int i = 0; i < 3; ++i) *(LAS u32x4*)(lds + kl[i]) = ak[i];
#pragma unroll
            for (int i = 0; i < 2; ++i) *(LAS u32x4*)(lds + vl[i]) = av[i];
            LDS_BAR();
            for (int t = 0; t < NT; ++t) {
                LAS unsigned char* bb = lds + (t & 1) * BUF;
                { const int tn = (t + 1 < NT) ? t + 1 : t;
                  const bf16* kgp = Kg + (size_t)tn * 128 * 768; const bf16* vgp = Vg + (size_t)tn * 128 * 512;
#pragma unroll
                  for (int i = 0; i < 3; ++i) ak[i] = *(const u32x4*)(kgp + kg[i]);
#pragma unroll
                  for (int i = 0; i < 2; ++i) av[i] = *(const u32x4*)(vgp + vg[i]); }
#pragma unroll
                for (int sub = 0; sub < 2; ++sub) {
                    const int tt = 2 * t + sub;
                    if (64 * tt <= qw + 31) {
                        LAS unsigned char* kb = bb + sub * SUB; LAS unsigned char* vb = kb + KBYTES;
                        bf16x8 kf0[6], kf1[6];
#pragma unroll
                        for (int s = 0; s < 6; ++s) { kf0[s] = *(const LAS bf16x8*)(kb + kfr + s * 32); kf1[s] = *(const LAS bf16x8*)(kb + kfr + 32 * KST + s * 32); }
                        __builtin_amdgcn_sched_barrier(0);
                        f32x16 p0 = negm, p1 = negm;
#pragma unroll
                        for (int s = 0; s < 6; ++s) { p0 = __builtin_amdgcn_mfma_f32_32x32x16_bf16(kf0[s], qf[s], p0, 0, 0, 0); p1 = __builtin_amdgcn_mfma_f32_32x32x16_bf16(kf1[s], qf[s], p1, 0, 0, 0); }
                        if (64 * tt + 63 > qw) {
                            int hm = hi; asm volatile("" : "+v"(hm));
                            const int qrel = qw + r - 64 * tt - 4 * hm;
#pragma unroll
                            for (int rg = 0; rg < 16; ++rg) { const int kv = (rg & 3) + 8 * (rg >> 2); if (kv > qrel) p0[rg] = -INFINITY; if (kv + 32 > qrel) p1[rg] = -INFINITY; }
                        }
                        float mx;
                        { float a = max3f(p0[0], p0[1], p1[0]), b2 = max3f(p0[2], p0[3], p1[1]); a = max3f(a, p1[2], p1[3]);
#pragma unroll
                          for (int rg = 4; rg < 16; rg += 4) { a = max3f(a, p0[rg], p0[rg + 1]); b2 = max3f(b2, p0[rg + 2], p0[rg + 3]); a = max3f(a, p1[rg], p1[rg + 1]); b2 = max3f(b2, p1[rg + 2], p1[rg + 3]); }
                          mx = xhalf_max(max2f(a, b2)); }
                        if (!__all(mx <= 8.0f)) {
                            const float dl = max2f(mx, 0.f), f = __builtin_amdgcn_exp2f(-dl); m += dl; l *= f;
#pragma unroll
                            for (int rg = 0; rg < 16; ++rg) { p0[rg] -= dl; p1[rg] -= dl; o0[rg] *= f; o1[rg] *= f; negm[rg] = -m; }
                        }
                        float rs = 0.f;
#pragma unroll
                        for (int rg = 0; rg < 16; ++rg) { p0[rg] = __builtin_amdgcn_exp2f(p0[rg]); p1[rg] = __builtin_amdgcn_exp2f(p1[rg]); rs += p0[rg] + p1[rg]; }
                        l += rs;
#pragma unroll
                        for (int hh = 0; hh < 2; ++hh)
#pragma unroll
                            for (int s2 = 0; s2 < 2; ++s2) { const bf16x8 pf = packp(hh == 0 ? p0 : p1, s2);
#pragma unroll
                                for (int db = 0; db < 2; ++db) { LAS unsigned char* vp_ = vb + vtr + (32 * hh + 16 * s2) * VST + db * 64;
                                    const s16x4 lo = __builtin_bit_cast(s16x4, __builtin_amdgcn_ds_read_tr16_b64_v4i16((LAS s16x4*)vp_));
                                    const s16x4 hi4 = __builtin_bit_cast(s16x4, __builtin_amdgcn_ds_read_tr16_b64_v4i16((LAS s16x4*)(vp_ + 8 * VST)));
                                    const bf16x8 vf = (bf16x8){lo[0], lo[1], lo[2], lo[3], hi4[0], hi4[1], hi4[2], hi4[3]};
                                    if (db == 0) o0 = __builtin_amdgcn_mfma_f32_32x32x16_bf16(vf, pf, o0, 0, 0, 0); else o1 = __builtin_amdgcn_mfma_f32_32x32x16_bf16(vf, pf, o1, 0, 0, 0); } }
                    }
                }
                { LAS unsigned char* nb = lds + ((t + 1) & 1) * BUF;
#pragma unroll
                  for (int i = 0; i < 3; ++i) *(LAS u32x4*)(nb + kl[i]) = ak[i];
#pragma unroll
                  for (int i = 0; i < 2; ++i) *(LAS u32x4*)(nb + vl[i]) = av[i]; }
                LDS_BAR();
            }
            const float il = 1.0f / xhalf_sum(l);
            bf16* op = YM + (row0 + qw + r) * YYLD + h * 64 + 4 * hi;
#pragma unroll
            for (int gq = 0; gq < 4; ++gq) { u32x2 w0, w1;
                w0.x = pk2(o0[4 * gq] * il, o0[4 * gq + 1] * il); w0.y = pk2(o0[4 * gq + 2] * il, o0[4 * gq + 3] * il);
                w1.x = pk2(o1[4 * gq] * il, o1[4 * gq + 1] * il); w1.y = pk2(o1[4 * gq + 2] * il, o1[4 * gq + 3] * il);
                *(u32x2*)(op + 8 * gq) = w0; *(u32x2*)(op + 32 + 8 * gq) = w1; }
        }
    }
    __syncthreads();
}

constexpr int CS_CH = 256, CS_NCH = SEQ / CS_CH;
constexpr int CS_RS = 144;
constexpr int CS_IMG = 16 * CS_RS;
constexpr int CS_WAVE = 8 * CS_IMG + 512;
enum { IM_A = 0, IM_R = 1, IM_B = 2, IM_K = 3, IM_BH = 4, IM_KH = 5, IM_V = 6, IM_G = 7 };
constexpr size_t DO_CSP = 64 * MiB, DO_CSG = 128 * MiB, DO_CSZ = 192 * MiB;
__device__ __forceinline__ int crow8(int q, int hi) { return (q & 3) + 8 * ((q >> 2) & 1) + 4 * hi; }
template <int N> __device__ __forceinline__ float dpp_shr0(float x) { return __builtin_bit_cast(float, __builtin_amdgcn_update_dpp(0, __builtin_bit_cast(int, x), 0x110 + N, 0xf, 0xf, true)); }
__device__ __forceinline__ float rowscan16(float x) { x += dpp_shr0<1>(x); x += dpp_shr0<2>(x); x += dpp_shr0<4>(x); x += dpp_shr0<8>(x); return x; }
__device__ __forceinline__ float xsum_16_32(float v) {
    { auto r = __builtin_amdgcn_permlane16_swap(__float_as_uint(v), __float_as_uint(v), false, false); v = __uint_as_float(r[0]) + __uint_as_float(r[1]); }
    { auto r = __builtin_amdgcn_permlane32_swap(__float_as_uint(v), __float_as_uint(v), false, false); v = __uint_as_float(r[0]) + __uint_as_float(r[1]); }
    return v;
}
__device__ __forceinline__ bf16x8 cs_rowfrag(const LAS unsigned char* rowp, int hi, int ks) {
    const LAS unsigned char* p = rowp + (16 * ks + 4 * hi) * 2; const u32x2 a = *(const LAS u32x2*)p, b = *(const LAS u32x2*)(p + 16);
    return __builtin_bit_cast(bf16x8, (u32x4){a.x, a.y, b.x, b.y});
}
__device__ __forceinline__ bf16x8 cs_trfrag(LAS unsigned char* img, int cb, int lane) {
    const int g4 = lane >> 4, li = lane & 15; LAS unsigned char* p = img + (4 * (g4 >> 1) + (li >> 2)) * CS_RS + (32 * cb + 16 * (g4 & 1) + 4 * (li & 3)) * 2;
    const s16x4 lo = __builtin_bit_cast(s16x4, __builtin_amdgcn_ds_read_tr16_b64_v4i16((LAS s16x4*)p));
    const s16x4 h4 = __builtin_bit_cast(s16x4, __builtin_amdgcn_ds_read_tr16_b64_v4i16((LAS s16x4*)(p + 8 * CS_RS)));
    return (bf16x8){lo[0], lo[1], lo[2], lo[3], h4[0], h4[1], h4[2], h4[3]};
}
__device__ __forceinline__ bf16x8 cs_zero8() { return (bf16x8){0, 0, 0, 0, 0, 0, 0, 0}; }
struct CsIn { const bf16 *ZR, *A, *LW, *G; const float *mu, *k_k, *k_a, *r_k; };
template <bool USE_V, bool WITH_Y>
__device__ __forceinline__ void cs_prep(const CsIn& in, size_t row0, int tok0, int h, LAS unsigned char* wl, int lane) {
    const int t = lane & 15, jq = lane >> 4, tok = tok0 + t; const bool first = tok == 0;
    const size_t g = row0 + tok, gp = row0 + (first ? 0 : tok - 1); const int c0 = h * 64 + 16 * jq;
    LAS float* gct = (LAS float*)(wl + 8 * CS_IMG); LAS float* btt = gct + 64;
    u32x4 Lrc[2], Lrp[2], Lkc[2], Lkp[2], Lav[2], Llw[2], Lvc[2], Lvp[2];
#pragma unroll
    for (int hf = 0; hf < 2; ++hf) { const int cc = c0 + 8 * hf;
        Lkc[hf] = *(const u32x4*)(in.ZR + g * 1792 + 512 + cc); Lkp[hf] = *(const u32x4*)(in.ZR + gp * 1792 + 512 + cc);
        Lrc[hf] = *(const u32x4*)(in.ZR + g * 1792 + cc); Lrp[hf] = *(const u32x4*)(in.ZR + gp * 1792 + cc);
        Lav[hf] = *(const u32x4*)(in.A + g * 512 + cc); Llw[hf] = *(const u32x4*)(in.LW + g * 512 + cc);
        if (USE_V) { Lvc[hf] = *(const u32x4*)(in.ZR + g * 1792 + 1024 + cc); Lvp[hf] = *(const u32x4*)(in.ZR + gp * 1792 + 1024 + cc); }
    }
    float inv;
    { float ss = 0.f;
#pragma unroll
      for (int hf = 0; hf < 2; ++hf) { float kc[8], kp[8]; unpack8(Lkc[hf], kc); unpack8(Lkp[hf], kp);
          const f32x4 m0 = *(const f32x4*)(in.mu + 512 + c0 + 8 * hf), m1 = *(const f32x4*)(in.mu + 512 + c0 + 8 * hf + 4), q0 = *(const f32x4*)(in.k_k + c0 + 8 * hf), q1 = *(const f32x4*)(in.k_k + c0 + 8 * hf + 4);
          const float mm[8] = {m0.x, m0.y, m0.z, m0.w, m1.x, m1.y, m1.z, m1.w}, qq[8] = {q0.x, q0.y, q0.z, q0.w, q1.x, q1.y, q1.z, q1.w};
#pragma unroll
          for (int e = 0; e < 8; ++e) { const float zk = kc[e] + ((first ? 0.f : kp[e]) - kc[e]) * mm[e]; const float kr = zk * qq[e]; ss += kr * kr; } }
      inv = 1.0f / fmaxf(sqrtf(xsum_16_32(ss)), 1e-12f); }
    float btacc = 0.f;
#pragma unroll
    for (int hf = 0; hf < 2; ++hf) {
        const int cc = c0 + 8 * hf;
        u32x4 Lgg = {}; if (WITH_Y) Lgg = *(const u32x4*)(in.G + g * 512 + cc);
        float rc[8], rp[8], kc[8], kp[8], av[8], lw[8];
        unpack8(Lrc[hf], rc); unpack8(Lrp[hf], rp); unpack8(Lkc[hf], kc); unpack8(Lkp[hf], kp); unpack8(Lav[hf], av); unpack8(Llw[hf], lw);
        float mr[8], mk[8], qk[8], qa[8], qr[8];
        { const f32x4 a0 = *(const f32x4*)(in.mu + cc), a1 = *(const f32x4*)(in.mu + cc + 4), b0 = *(const f32x4*)(in.mu + 512 + cc), b1 = *(const f32x4*)(in.mu + 512 + cc + 4);
          const f32x4 c0_ = *(const f32x4*)(in.k_k + cc), c1_ = *(const f32x4*)(in.k_k + cc + 4), d0 = *(const f32x4*)(in.k_a + cc), d1 = *(const f32x4*)(in.k_a + cc + 4);
          mr[0] = a0.x; mr[1] = a0.y; mr[2] = a0.z; mr[3] = a0.w; mr[4] = a1.x; mr[5] = a1.y; mr[6] = a1.z; mr[7] = a1.w;
          mk[0] = b0.x; mk[1] = b0.y; mk[2] = b0.z; mk[3] = b0.w; mk[4] = b1.x; mk[5] = b1.y; mk[6] = b1.z; mk[7] = b1.w;
          qk[0] = c0_.x; qk[1] = c0_.y; qk[2] = c0_.z; qk[3] = c0_.w; qk[4] = c1_.x; qk[5] = c1_.y; qk[6] = c1_.z; qk[7] = c1_.w;
          qa[0] = d0.x; qa[1] = d0.y; qa[2] = d0.z; qa[3] = d0.w; qa[4] = d1.x; qa[5] = d1.y; qa[6] = d1.z; qa[7] = d1.w; }
        if (WITH_Y) { const f32x4 e0 = *(const f32x4*)(in.r_k + cc), e1 = *(const f32x4*)(in.r_k + cc + 4); qr[0] = e0.x; qr[1] = e0.y; qr[2] = e0.z; qr[3] = e0.w; qr[4] = e1.x; qr[5] = e1.y; qr[6] = e1.z; qr[7] = e1.w; }
        float oA[8], oR[8], oB[8], oK[8], oBH[8], oKH[8];
#pragma unroll
        for (int e = 0; e < 8; ++e) {
            const float r = rc[e] + ((first ? 0.f : rp[e]) - rc[e]) * mr[e]; const float zk = kc[e] + ((first ? 0.f : kp[e]) - kc[e]) * mk[e];
            const float kq = zk * (1.f + (av[e] - 1.f) * qa[e]); const float kk = zk * qk[e] * inv; const float b = kk * av[e];
            const float Lg = rowscan16(lw[e]); const float eLg = __builtin_amdgcn_exp2f(1.4426950408889634f * Lg); const float enLg = __builtin_amdgcn_rcpf(eLg);
            const float eLgm = __builtin_bit_cast(float, __builtin_amdgcn_update_dpp(0x3f800000, __builtin_bit_cast(int, eLg), 0x111, 0xf, 0xf, false));
            const float eC = __builtin_bit_cast(float, __builtin_amdgcn_ds_bpermute(((lane & 48) | 15) << 2, __builtin_bit_cast(int, eLg)));
            oA[e] = -kk * eLgm; oR[e] = r * eLg; oB[e] = b * enLg; oK[e] = kq * enLg; oBH[e] = oB[e] * eC; oKH[e] = oK[e] * eC;
            if (WITH_Y) btacc += r * kq * qr[e];
            if (t == 15) gct[16 * jq + 8 * hf + e] = eC;
        }
        const int wo = t * CS_RS + (16 * jq + 8 * hf) * 2;
        *(LAS u32x4*)(wl + IM_A * CS_IMG + wo) = pack8(oA); *(LAS u32x4*)(wl + IM_R * CS_IMG + wo) = pack8(oR); *(LAS u32x4*)(wl + IM_B * CS_IMG + wo) = pack8(oB);
        *(LAS u32x4*)(wl + IM_K * CS_IMG + wo) = pack8(oK); *(LAS u32x4*)(wl + IM_BH * CS_IMG + wo) = pack8(oBH); *(LAS u32x4*)(wl + IM_KH * CS_IMG + wo) = pack8(oKH);
        if (USE_V) { float vc[8], vp[8], o[8]; unpack8(Lvc[hf], vc); unpack8(Lvp[hf], vp);
            const f32x4 a0 = *(const f32x4*)(in.mu + 1024 + cc), a1 = *(const f32x4*)(in.mu + 1024 + cc + 4); const float mv[8] = {a0.x, a0.y, a0.z, a0.w, a1.x, a1.y, a1.z, a1.w};
#pragma unroll
            for (int e = 0; e < 8; ++e) o[e] = vc[e] + ((first ? 0.f : vp[e]) - vc[e]) * mv[e];
            *(LAS u32x4*)(wl + IM_V * CS_IMG + wo) = pack8(o); }
        if (WITH_Y) *(LAS u32x4*)(wl + IM_G * CS_IMG + wo) = Lgg;
    }
    if (WITH_Y) { btacc = xsum_16_32(btacc); if (lane < 16) btt[lane] = btacc; }
}
struct CsFr { bf16x8 fAR[4], aL1, aL2, aL4, aL8, aLkMk, aMb; };
__device__ __forceinline__ void cs_gram(CsFr& fr, LAS unsigned char* wl, int lane) {
    const int hi = lane >> 5, row = lane & 15; const bool up = (lane & 16) != 0;
    const LAS unsigned char* rpAR = wl + (up ? IM_R : IM_A) * CS_IMG + row * CS_RS; const LAS unsigned char* rpBK = wl + (up ? IM_K : IM_B) * CS_IMG + row * CS_RS;
#pragma unroll
    for (int ks = 0; ks < 4; ++ks) fr.fAR[ks] = cs_rowfrag(rpAR, hi, ks);
    f32x16 F1 = {}, F2 = {};
#pragma unroll
    for (int ks = 0; ks < 4; ++ks) { const bf16x8 fBK = cs_rowfrag(rpBK, hi, ks);
        F1 = __builtin_amdgcn_mfma_f32_32x32x16_bf16(fBK, fr.fAR[ks], F1, 0, 0, 0);
        F2 = __builtin_amdgcn_mfma_f32_32x32x16_bf16(fr.fAR[ks], fBK, F2, 0, 0, 0); }
#pragma unroll
    for (int q = 0; q < 8; ++q) { const int s = crow8(q, hi); const bool k1 = up ? (s <= row) : (s < row);
        F1[q] = k1 ? F1[q] : 0.f; F1[8 + q] = k1 ? F1[8 + q] : 0.f; F2[q] = (!up && row < s) ? F2[q] : 0.f; }
    const bf16x8 f1lo = packp(F1, 0);
    fr.aL1 = up ? cs_zero8() : f1lo;
    fr.aMb = up ? f1lo : cs_zero8();
    fr.aLkMk = packp(F1, 1);
    const bf16x8 p2 = packp(F2, 0);
    const f32x16 z16 = {};
    const f32x16 Q1 = __builtin_amdgcn_mfma_f32_32x32x16_bf16(p2, fr.aL1, z16, 0, 0, 0), Q2 = __builtin_amdgcn_mfma_f32_32x32x16_bf16(fr.aL1, p2, z16, 0, 0, 0);
    fr.aL2 = packp(Q1, 0); const bf16x8 p2b = packp(Q2, 0);
    const f32x16 R1 = __builtin_amdgcn_mfma_f32_32x32x16_bf16(p2b, fr.aL2, z16, 0, 0, 0), R2 = __builtin_amdgcn_mfma_f32_32x32x16_bf16(fr.aL2, p2b, z16, 0, 0, 0);
    fr.aL4 = packp(R1, 0); const bf16x8 p2c = packp(R2, 0);
    const f32x16 S1 = __builtin_amdgcn_mfma_f32_32x32x16_bf16(p2c, fr.aL4, z16, 0, 0, 0);
    fr.aL8 = packp(S1, 0);
}
template <bool USE_V, bool WITH_Y>
__device__ __forceinline__ void cs_apply(f32x16 (&Z)[2][2], f32x16 (&D)[2], const CsFr& fr, LAS unsigned char* wl, int lane) {
    const int hi = lane >> 5;
    bf16x8 vf[2];
    if (USE_V) { vf[0] = cs_trfrag(wl + IM_V * CS_IMG, 0, lane); vf[1] = cs_trfrag(wl + IM_V * CS_IMG, 1, lane); }
#pragma unroll
    for (int nb = 0; nb < 2; ++nb) { f32x16 d = {};
#pragma unroll
        for (int jb = 0; jb < 2; ++jb)
#pragma unroll
            for (int k2 = 0; k2 < 2; ++k2) d = __builtin_amdgcn_mfma_f32_32x32x16_bf16(fr.fAR[2 * jb + k2], packp(Z[jb][nb], k2), d, 0, 0, 0);
        if (USE_V) d = __builtin_amdgcn_mfma_f32_32x32x16_bf16(fr.aLkMk, vf[nb], d, 0, 0, 0);
        D[nb] = d; }
#pragma unroll
    for (int nb = 0; nb < 2; ++nb) {
        D[nb] = __builtin_amdgcn_mfma_f32_32x32x16_bf16(fr.aL8, packp(D[nb], 0), D[nb], 0, 0, 0);
        D[nb] = __builtin_amdgcn_mfma_f32_32x32x16_bf16(fr.aL4, packp(D[nb], 0), D[nb], 0, 0, 0);
        D[nb] = __builtin_amdgcn_mfma_f32_32x32x16_bf16(fr.aL2, packp(D[nb], 0), D[nb], 0, 0, 0);
        D[nb] = __builtin_amdgcn_mfma_f32_32x32x16_bf16(fr.aL1, packp(D[nb], 0), D[nb], 0, 0, 0);
    }
    const bf16x8 u0 = packp(D[0], 0), u1 = packp(D[1], 0);
    if (WITH_Y) { D[0] = __builtin_amdgcn_mfma_f32_32x32x16_bf16(fr.aMb, u0, D[0], 0, 0, 0); D[1] = __builtin_amdgcn_mfma_f32_32x32x16_bf16(fr.aMb, u1, D[1], 0, 0, 0); }
    const LAS float* gct = (const LAS float*)(wl + 8 * CS_IMG);
#pragma unroll
    for (int jb = 0; jb < 2; ++jb) {
        const bf16x8 fb = cs_trfrag(wl + IM_BH * CS_IMG, jb, lane); bf16x8 fk = cs_zero8(); if (USE_V) fk = cs_trfrag(wl + IM_KH * CS_IMG, jb, lane);
        float gc[16];
#pragma unroll
        for (int g4 = 0; g4 < 4; ++g4) { const f32x4 x = *(const LAS f32x4*)(gct + 32 * jb + 8 * g4 + 4 * hi); gc[4 * g4] = x.x; gc[4 * g4 + 1] = x.y; gc[4 * g4 + 2] = x.z; gc[4 * g4 + 3] = x.w; }
#pragma unroll
        for (int nb = 0; nb < 2; ++nb) { f32x16 z = Z[jb][nb];
#pragma unroll
            for (int q = 0; q < 16; ++q) z[q] *= gc[q];
            z = __builtin_amdgcn_mfma_f32_32x32x16_bf16(fb, nb == 0 ? u0 : u1, z, 0, 0, 0);
            if (USE_V) z = __builtin_amdgcn_mfma_f32_32x32x16_bf16(fk, vf[nb], z, 0, 0, 0);
            Z[jb][nb] = z; }
    }
}
__device__ __forceinline__ void cs_apply_pk(bf16x8 (&Zp)[2][2][2], f32x16 (&D)[2], const CsFr& fr, LAS unsigned char* wl, int lane) {
    const int hi = lane >> 5;
#pragma unroll
    for (int nb = 0; nb < 2; ++nb) { f32x16 d = {};
#pragma unroll
        for (int jb = 0; jb < 2; ++jb)
#pragma unroll
            for (int k2 = 0; k2 < 2; ++k2) d = __builtin_amdgcn_mfma_f32_32x32x16_bf16(fr.fAR[2 * jb + k2], Zp[jb][nb][k2], d, 0, 0, 0);
        D[nb] = d; }
#pragma unroll
    for (int nb = 0; nb < 2; ++nb) {
        D[nb] = __builtin_amdgcn_mfma_f32_32x32x16_bf16(fr.aL8, packp(D[nb], 0), D[nb], 0, 0, 0);
        D[nb] = __builtin_amdgcn_mfma_f32_32x32x16_bf16(fr.aL4, packp(D[nb], 0), D[nb], 0, 0, 0);
        D[nb] = __builtin_amdgcn_mfma_f32_32x32x16_bf16(fr.aL2, packp(D[nb], 0), D[nb], 0, 0, 0);
        D[nb] = __builtin_amdgcn_mfma_f32_32x32x16_bf16(fr.aL1, packp(D[nb], 0), D[nb], 0, 0, 0);
    }
    const bf16x8 u0 = packp(D[0], 0), u1 = packp(D[1], 0);
    const LAS float* gct = (const LAS float*)(wl + 8 * CS_IMG);
#pragma unroll
    for (int jb = 0; jb < 2; ++jb) {
        const bf16x8 fb = cs_trfrag(wl + IM_BH * CS_IMG, jb, lane);
        float gc[16];
#pragma unroll
        for (int g4 = 0; g4 < 4; ++g4) { const f32x4 x = *(const LAS f32x4*)(gct + 32 * jb + 8 * g4 + 4 * hi); gc[4 * g4] = x.x; gc[4 * g4 + 1] = x.y; gc[4 * g4 + 2] = x.z; gc[4 * g4 + 3] = x.w; }
#pragma unroll
        for (int nb = 0; nb < 2; ++nb) { f32x16 z;
#pragma unroll
            for (int k2 = 0; k2 < 2; ++k2) { float e[8]; unpack8(__builtin_bit_cast(u32x4, Zp[jb][nb][k2]), e);
#pragma unroll
                for (int q = 0; q < 8; ++q) z[8 * k2 + q] = e[q] * gc[8 * k2 + q]; }
            z = __builtin_amdgcn_mfma_f32_32x32x16_bf16(fb, nb == 0 ? u0 : u1, z, 0, 0, 0);
            Zp[jb][nb][0] = packp(z, 0); Zp[jb][nb][1] = packp(z, 1); }
    }
}
template <bool USE_V, bool WITH_Y>
__device__ __forceinline__ void cs_step(f32x16 (&Z)[2][2], f32x16 (&D)[2], LAS unsigned char* wl, int lane) { CsFr fr; cs_gram(fr, wl, lane); cs_apply<USE_V, WITH_Y>(Z, D, fr, wl, lane); }
__device__ __forceinline__ void p_cs_a(const Frame& F, ArgsP a) {
    const int lane = lane_id_fresh();
    LAS unsigned char* wl = F.lds + F.wave * CS_WAVE;
    CsIn in{(const bf16*)(F.ws + WS_ZR), (const bf16*)(F.ws + WS_A), (const bf16*)(F.ws + WS_LW), (const bf16*)(F.dob + DO_G), a->in[I_MU], a->in[I_KK], a->in[I_KA], a->in[I_RK]};
    bf16* Pm = (bf16*)(F.dob + DO_CSP); bf16* Gf = (bf16*)(F.dob + DO_CSG);
    const int hi = lane >> 5;
    for (int uc = F.gw; uc < 64 * CS_NCH; uc += F.NGW) {
        const int bh = uc / CS_NCH, c = uc % CS_NCH, b = bh >> 3, h = bh & 7; const size_t row0 = (size_t)b * SEQ;
        f32x16 ZG[2][2], D[2]; bf16x8 ZP[2][2][2];
#pragma unroll
        for (int jb = 0; jb < 2; ++jb)
#pragma unroll
            for (int nb = 0; nb < 2; ++nb) { f32x16 z = {}; ZG[jb][nb] = z;
                if (jb == nb) {
#pragma unroll
                    for (int q = 0; q < 16; ++q) z[q] = (crow(q, hi) == (lane & 31)) ? 1.f : 0.f; }
                ZP[jb][nb][0] = packp(z, 0); ZP[jb][nb][1] = packp(z, 1); }
        for (int sc = 0; sc < CS_CH / 16; ++sc) { int ln = lane; asm volatile("" : "+v"(ln));
            cs_prep<true, false>(in, row0, c * CS_CH + sc * 16, h, wl, ln); asm volatile("s_waitcnt lgkmcnt(0)" ::: "memory");
            CsFr fr; cs_gram(fr, wl, ln);
            cs_apply_pk(ZP, D, fr, wl, ln); cs_apply<true, false>(ZG, D, fr, wl, ln); asm volatile("s_waitcnt lgkmcnt(0)" ::: "memory"); }
        int lo_ = lane; asm volatile("" : "+v"(lo_)); const int hi_o = lo_ >> 5;
        {
            LAS unsigned short* tb = (LAS unsigned short*)(wl + 4 * hi_o * CS_RS + (lo_ & 31) * 2);
#pragma unroll
            for (int jb = 0; jb < 2; ++jb)
#pragma unroll
                for (int nb = 0; nb < 2; ++nb)
#pragma unroll
                    for (int q = 0; q < 16; ++q) tb[((32 * jb + (q & 3) + 8 * (q >> 2)) * CS_RS + 64 * nb) / 2] = (unsigned short)ZP[jb][nb][q >> 3][q & 7];
            bf16* dst = Pm + (size_t)uc * 4096;
#pragma unroll
            for (int i = 0; i < 8; ++i) { const int ch = lo_ + 64 * i, rr = ch >> 3, c8 = (ch & 7) * 8; *(u32x4*)(dst + rr * 64 + c8) = *(const LAS u32x4*)(wl + rr * CS_RS + c8 * 2); }
            asm volatile("s_waitcnt lgkmcnt(0)" ::: "memory");
        }
        {
            bf16* dst = Gf + (size_t)uc * 4096;
#pragma unroll
            for (int jb = 0; jb < 2; ++jb)
#pragma unroll
                for (int nb = 0; nb < 2; ++nb) { u32x4 w0, w1; const f32x16& z = ZG[jb][nb];
                    w0.x = pk2(z[0], z[1]); w0.y = pk2(z[2], z[3]); w0.z = pk2(z[4], z[5]); w0.w = pk2(z[6], z[7]); w1.x = pk2(z[8], z[9]); w1.y = pk2(z[10], z[11]); w1.z = pk2(z[12], z[13]); w1.w = pk2(z[14], z[15]);
                    u32x4* p = (u32x4*)(dst + ((jb * 2 + nb) * 64 + lo_) * 16); p[0] = w0; p[1] = w1; }
        }
    }
}
struct CsB { u32x2 p[2][2][2][2]; u32x4 g[2][2]; };
__device__ __forceinline__ void csb_load(CsB& X, const bf16* Pm, const bf16* Gf, size_t uc, int nb, int lane) {
    const int hi = lane >> 5, r = lane & 31; const bf16* Pc = Pm + uc * 4096;
#pragma unroll
    for (int mb = 0; mb < 2; ++mb) {
#pragma unroll
        for (int jb = 0; jb < 2; ++jb)
#pragma unroll
            for (int k2 = 0; k2 < 2; ++k2) { const bf16* pr = Pc + (32 * mb + r) * 64 + 32 * jb + 16 * k2 + 4 * hi; X.p[mb][jb][k2][0] = *(const u32x2*)pr; X.p[mb][jb][k2][1] = *(const u32x2*)(pr + 8); }
        const u32x4* gp = (const u32x4*)(Gf + uc * 4096 + ((mb * 2 + nb) * 64 + lane) * 16); X.g[mb][0] = gp[0]; X.g[mb][1] = gp[1]; }
}
__device__ __forceinline__ void csb_step(f32x16 (&Z)[2], const CsB& X, bf16* Zf, size_t uc, int nb, int lane) {
#pragma unroll
    for (int jb = 0; jb < 2; ++jb) { u32x4 w0, w1; const f32x16& z = Z[jb];
        w0.x = pk2(z[0], z[1]); w0.y = pk2(z[2], z[3]); w0.z = pk2(z[4], z[5]); w0.w = pk2(z[6], z[7]); w1.x = pk2(z[8], z[9]); w1.y = pk2(z[10], z[11]); w1.z = pk2(z[12], z[13]); w1.w = pk2(z[14], z[15]);
        u32x4* p = (u32x4*)(Zf + uc * 4096 + ((jb * 2 + nb) * 64 + lane) * 16); p[0] = w0; p[1] = w1; }
    f32x16 N[2];
#pragma unroll
    for (int mb = 0; mb < 2; ++mb) { float g0[8], g1[8]; unpack8(X.g[mb][0], g0); unpack8(X.g[mb][1], g1);
#pragma unroll
        for (int q = 0; q < 8; ++q) { N[mb][q] = g0[q]; N[mb][8 + q] = g1[q]; } }
#pragma unroll
    for (int jb = 0; jb < 2; ++jb)
#pragma unroll
        for (int k2 = 0; k2 < 2; ++k2) { const bf16x8 zb = packp(Z[jb], k2);
#pragma unroll
            for (int mb = 0; mb < 2; ++mb) { const u32x2 x0 = X.p[mb][jb][k2][0], x1 = X.p[mb][jb][k2][1];
                N[mb] = __builtin_amdgcn_mfma_f32_32x32x16_bf16(__builtin_bit_cast(bf16x8, (u32x4){x0.x, x0.y, x1.x, x1.y}), zb, N[mb], 0, 0, 0); } }
    Z[0] = N[0]; Z[1] = N[1];
}
__device__ __forceinline__ void p_cs_b(const Frame& F) {
    const int lane = lane_id_fresh();
    const bf16* Pm = (const bf16*)(F.dob + DO_CSP); const bf16* Gf = (const bf16*)(F.dob + DO_CSG); bf16* Zf = (bf16*)(F.dob + DO_CSZ);
    for (int u16 = F.gw; u16 < 128 * 16; u16 += F.NGW) {
        if (u16 & 15) continue;
        const int u = u16 >> 4, bh = u >> 1, nb = u & 1; const size_t uc0 = (size_t)bh * CS_NCH;
        f32x16 Z[2] = {};
        CsB X0, X1, X2;
        csb_load(X0, Pm, Gf, uc0, nb, lane); csb_load(X1, Pm, Gf, uc0 + 1, nb, lane);
#define CSB_CL(c_) (uc0 + ((c_) < CS_NCH ? (c_) : CS_NCH - 1))
        int c = 0;
        for (; c + 2 < CS_NCH; c += 3) {
            csb_load(X2, Pm, Gf, CSB_CL(c + 2), nb, lane); csb_step(Z, X0, Zf, uc0 + c, nb, lane);
            csb_load(X0, Pm, Gf, CSB_CL(c + 3), nb, lane); csb_step(Z, X1, Zf, uc0 + c + 1, nb, lane);
            csb_load(X1, Pm, Gf, CSB_CL(c + 4), nb, lane); csb_step(Z, X2, Zf, uc0 + c + 2, nb, lane);
        }
        if (c < CS_NCH) { csb_step(Z, X0, Zf, uc0 + c, nb, lane); ++c; }
        if (c < CS_NCH) { csb_step(Z, X1, Zf, uc0 + c, nb, lane); ++c; }
#undef CSB_CL
    }
}
__device__ __forceinline__ void p_cs_c(const Frame& F, ArgsP a) {
    const int lane = lane_id_fresh(), hi = lane >> 5;
    LAS unsigned char* wl = F.lds + F.wave * CS_WAVE;
    CsIn in{(const bf16*)(F.ws + WS_ZR), (const bf16*)(F.ws + WS_A), (const bf16*)(F.ws + WS_LW), (const bf16*)(F.dob + DO_G), a->in[I_MU], a->in[I_KK], a->in[I_KA], a->in[I_RK]};
    const bf16* Zf = (const bf16*)(F.dob + DO_CSZ); bf16* Y = (bf16*)(F.ws + WS_Y); const float* lnw = a->in[I_LNW]; const float* lnb = a->in[I_LNB];
    const LAS float* btt = (const LAS float*)(wl + 8 * CS_IMG) + 64;
    for (int uc = F.gw; uc < 64 * CS_NCH; uc += F.NGW) {
        const int bh = uc / CS_NCH, c = uc % CS_NCH, b = bh >> 3, h = bh & 7; const size_t row0 = (size_t)b * SEQ;
        f32x16 Z[2][2], D[2];
        int lu = lane; asm volatile("" : "+v"(lu));
#pragma unroll
        for (int jb = 0; jb < 2; ++jb)
#pragma unroll
            for (int nb = 0; nb < 2; ++nb) { const u32x4* p = (const u32x4*)(Zf + (size_t)uc * 4096 + ((jb * 2 + nb) * 64 + lu) * 16); float g0[8], g1[8]; unpack8(p[0], g0); unpack8(p[1], g1);
#pragma unroll
                for (int q = 0; q < 8; ++q) { Z[jb][nb][q] = g0[q]; Z[jb][nb][8 + q] = g1[q]; } }
        const float lw0 = lnw[h * 64 + (lu & 31)], lw1 = lnw[h * 64 + 32 + (lu & 31)], lb0 = lnb[h * 64 + (lu & 31)], lb1 = lnb[h * 64 + 32 + (lu & 31)];
        for (int sc = 0; sc < CS_CH / 16; ++sc) {
            const int tok0 = c * CS_CH + sc * 16;
            int ln = lane; asm volatile("" : "+v"(ln));
            cs_prep<true, true>(in, row0, tok0, h, wl, ln); asm volatile("s_waitcnt lgkmcnt(0)" ::: "memory");
            cs_step<true, true>(Z, D, wl, ln); asm volatile("s_waitcnt lgkmcnt(0)" ::: "memory");
            const int hl = ln >> 5;
            const bf16x8 v0 = cs_trfrag(wl + IM_V * CS_IMG, 0, ln), v1 = cs_trfrag(wl + IM_V * CS_IMG, 1, ln), g0 = cs_trfrag(wl + IM_G * CS_IMG, 0, ln), g1 = cs_trfrag(wl + IM_G * CS_IMG, 1, ln);
            const f32x4 bta = *(const LAS f32x4*)(btt + 4 * hl), btb = *(const LAS f32x4*)(btt + 8 + 4 * hl); const float bt[8] = {bta.x, bta.y, bta.z, bta.w, btb.x, btb.y, btb.z, btb.w};
#pragma unroll
            for (int q = 0; q < 8; ++q) {
                const float y0 = D[0][8 + q], y1 = D[1][8 + q];
                const float mean = allsum32(y0 + y1) * (1.f / 64.f); const float d0 = y0 - mean, d1 = y1 - mean;
                const float rstd = 1.0f / sqrtf(allsum32(d0 * d0 + d1 * d1) * (1.f / 64.f) + LN_X_EPS);
                const float o0 = (d0 * rstd * lw0 + lb0 + bt[q] * bf2f((unsigned short)v0[q])) * bf2f((unsigned short)g0[q]);
                const float o1 = (d1 * rstd * lw1 + lb1 + bt[q] * bf2f((unsigned short)v1[q])) * bf2f((unsigned short)g1[q]);
                bf16* yp = Y + (row0 + tok0 + crow8(q, hl)) * YYLD + h * 64 + (ln & 31);
                yp[0] = (unsigned short)f2bf(o0); yp[32] = (unsigned short)f2bf(o1);
            }
            asm volatile("s_waitcnt lgkmcnt(0)" ::: "memory");
        }
    }
}

__device__ __forceinline__ void p_ffn_route(const Frame& F, ArgsP a, unsigned* cnt, int* route) {
    const int lane_f = lane_id_fresh(), tid_f = F.wave * 64 + lane_f;
    const bf16* MO = (const bf16*)(F.ws + WS_MO); bf16* H2 = (bf16*)(F.ws + WS_H2); const float* mod = (const float*)(F.ws + WS_MOD); const float* g = a->in[I_GFFN];
    constexpr int RTS = 1028;
    LAS float* wr = (LAS float*)F.lds;
    __syncthreads();
    for (int i = tid_f; i < 1024 * 4; i += NTHR) { const int k = i >> 2, o = i & 3; wr[o * RTS + k] = a->in[I_WRG][i]; }
    for (int i = tid_f; i < 1024 * 32; i += NTHR) { const int k = i >> 5, o = i & 31; wr[(4 + o) * RTS + k] = a->in[I_WRE][i]; }
    __syncthreads();
    LAS float* brl = wr + 36 * RTS;
    if (tid_f < 4) brl[tid_f] = a->in[I_BRG][tid_f]; else if (tid_f < 36) brl[tid_f] = a->in[I_BRE][tid_f - 4];
    const int lane = lane_f;
    LAS unsigned* lcnt = (LAS unsigned*)(F.lds + LDS_MISC + 512);
    if (tid_f < 256) lcnt[tid_f] = 0u;
    __syncthreads();
    int my_e0 = 0, my_e1 = 0; float my_w0 = 0.f, my_w1 = 0.f; int kk_ = 0;
    u32x2 ma[4], mb[4]; f32x4 gsv[4], shv[4]; int bcur = -1;
    { const u32x2* mr = (const u32x2*)(MO + (size_t)F.gw * 1024) + lane;
#pragma unroll
      for (int j = 0; j < 4; ++j) ma[j] = mr[64 * j]; }
#define RT_ROW(CM, NM, m_) do { const int mm = (m_); const int b = mm / SEQ; \
        if (b != bcur) { bcur = b; \
            _Pragma("unroll") for (int j = 0; j < 4; ++j) { const int col = 4 * lane + 256 * j; \
                gsv[j] = *(const f32x4*)(g + col) * (*(const f32x4*)(mod + b * 6144 + 4096 + col) + 1.0f); shv[j] = *(const f32x4*)(mod + b * 6144 + 3072 + col); } \
            asm volatile("s_waitcnt vmcnt(0)" : "+v"(gsv[0]), "+v"(gsv[1]), "+v"(gsv[2]), "+v"(gsv[3]), "+v"(shv[0]), "+v"(shv[1]), "+v"(shv[2]), "+v"(shv[3])); \
            asm volatile("" : "+v"(CM[0]), "+v"(CM[1]), "+v"(CM[2]), "+v"(CM[3])); } \
        { const int mn = (mm + F.NGW < NTOK) ? mm + F.NGW : mm; const u32x2* mr = (const u32x2*)(MO + (size_t)mn * 1024) + lane; \
          _Pragma("unroll") for (int j = 0; j < 4; ++j) NM[j] = mr[64 * j]; } \
        f32x4 v[4]; float s = 0.f; \
        _Pragma("unroll") for (int j = 0; j < 4; ++j) { v[j] = (f32x4){lo2f(CM[j].x), hi2f(CM[j].x), lo2f(CM[j].y), hi2f(CM[j].y)}; \
            s += (v[j].x * v[j].x + v[j].y * v[j].y) + (v[j].z * v[j].z + v[j].w * v[j].w); } \
        const float rstd = 1.0f / sqrtf(wave_sum(s) * (1.f / 1024.f) + EPS); \
        u32x2* o = (u32x2*)(H2 + (size_t)mm * 1024) + lane; \
        _Pragma("unroll") for (int j = 0; j < 4; ++j) { v[j] = v[j] * rstd * gsv[j] + shv[j]; u32x2 w; w.x = pk2(v[j].x, v[j].y); w.y = pk2(v[j].z, v[j].w); o[64 * j] = w; } \
        float lgq[4]; \
        _Pragma("unroll") for (int oo = 0; oo < 4; ++oo) { float p = 0.f; \
            _Pragma("unroll") for (int j = 0; j < 4; ++j) { const f32x4 w4 = *(const LAS f32x4*)(wr + oo * RTS + 4 * lane + 256 * j); p += (v[j].x * w4.x + v[j].y * w4.y) + (v[j].z * w4.z + v[j].w * w4.w); } \
            lgq[oo] = wave_sum(p) + brl[oo]; } \
        int gi = 0; float gmx = lgq[0]; \
        _Pragma("unroll") for (int i = 1; i < 4; ++i) { if (lgq[i] > gmx) { gmx = lgq[i]; gi = i; } } \
        float gsum = 0.f; \
        _Pragma("unroll") for (int i = 0; i < 4; ++i) gsum += __expf(lgq[i] - gmx); \
        const float pg = 1.f / gsum; \
        gi = __builtin_amdgcn_readfirstlane(gi); \
        float el[8]; \
        { const LAS float* wg = wr + (4 + gi * 8) * RTS + 4 * lane; \
          _Pragma("unroll") for (int i = 0; i < 8; ++i) { float p = 0.f; \
              _Pragma("unroll") for (int j = 0; j < 4; ++j) { const f32x4 w4 = *(const LAS f32x4*)(wg + i * RTS + 256 * j); p += (v[j].x * w4.x + v[j].y * w4.y) + (v[j].z * w4.z + v[j].w * w4.w); } \
              el[i] = wave_sum(p) + brl[4 + gi * 8 + i]; } } \
        int i0 = 0; float m0 = el[0]; \
        _Pragma("unroll") for (int i = 1; i < 8; ++i) if (el[i] > m0) { m0 = el[i]; i0 = i; } \
        int i1 = -1; float m1 = -INFINITY; \
        _Pragma("unroll") for (int i = 0; i < 8; ++i) if (i != i0 && el[i] > m1) { m1 = el[i]; i1 = i; } \
        const float e1 = __expf(m1 - m0), w0 = pg / (1.f + e1), w1 = pg * e1 / (1.f + e1); \
        { const int lo_ = i0 < i1 ? i0 : i1, hi_ = i0 < i1 ? i1 : i0; \
          if (lane == kk_) { my_e0 = gi * 28 + (lo_ * (15 - lo_)) / 2 + (hi_ - lo_ - 1); my_w0 = i0 < i1 ? w0 : w1; my_w1 = i0 < i1 ? w1 : w0; } } \
        ++kk_; } while (0)
    for (int m = F.gw; m < NTOK; m += 2 * F.NGW) {
        RT_ROW(ma, mb, m);
        if (m + F.NGW < NTOK) RT_ROW(mb, ma, m + F.NGW);
    }
#undef RT_ROW
    unsigned lp0 = 0u;
    if (lane < kk_) lp0 = __hip_atomic_fetch_add(lcnt + my_e0, 1u, __ATOMIC_RELAXED, __HIP_MEMORY_SCOPE_WORKGROUP);
    __syncthreads();
    if (tid_f < NCLS) lcnt[128 + tid_f] = __hip_atomic_fetch_add(cnt + tid_f, lcnt[tid_f], __ATOMIC_RELAXED, __HIP_MEMORY_SCOPE_AGENT);
    __syncthreads();
    if (lane < kk_) { const int m = F.gw + lane * F.NGW; int* rt = route + (size_t)m * 8;
        rt[0] = my_e0; rt[1] = (int)(lcnt[128 + my_e0] + lp0); rt[2] = __builtin_bit_cast(int, my_w0); rt[3] = __builtin_bit_cast(int, my_w1); }
    __syncthreads();
    (void)my_e1;
}
__device__ __forceinline__ int moe_tables(const Frame& F, LAS int* offs, LAS int* texp) {
    const int lane_f = lane_id_fresh();
    const unsigned* cnt = (const unsigned*)(F.ws + WS_CTL) + CW_CNT;
    __syncthreads();
    if (F.wave == 0) {
        const int c0 = (int)__hip_atomic_load(cnt + lane_f, __ATOMIC_RELAXED, __HIP_MEMORY_SCOPE_AGENT);
        const int c1 = (lane_f < NCLS - 64) ? (int)__hip_atomic_load(cnt + 64 + lane_f, __ATOMIC_RELAXED, __HIP_MEMORY_SCOPE_AGENT) : 0;
        const int n0 = (c0 + 255) >> 8, n1 = (c1 + 255) >> 8; int i0 = n0, i1 = n1;
#pragma unroll
        for (int d = 1; d < 64; d <<= 1) { const int a = __shfl_up(i0, d, 64), b = __shfl_up(i1, d, 64); if (lane_f >= d) { i0 += a; i1 += b; } }
        const int tot0 = __shfl(i0, 63, 64); i1 += tot0;
        const int t0 = i0 - n0, t1 = i1 - n1;
        offs[lane_f] = t0 << 8; for (int t = 0; t < n0; ++t) texp[t0 + t] = lane_f;
        if (lane_f < NCLS - 64) { offs[64 + lane_f] = t1 << 8; for (int t = 0; t < n1; ++t) texp[t1 + t] = 64 + lane_f; if (lane_f == NCLS - 65) offs[NCLS] = i1 << 8; }
    }
    __syncthreads();
    return __builtin_amdgcn_readfirstlane(offs[NCLS] >> 8);
}
__device__ __forceinline__ void p_gather(const Frame& F) {
    const int lane_f = lane_id_fresh(), tid_f = F.wave * 64 + lane_f;
    LAS int* offs = (LAS int*)(F.lds + 1024); LAS int* texp = (LAS int*)(F.lds + 2048);
    moe_tables(F, offs, texp);
    const int* route = (const int*)(F.ws + WS_ROUTE); int* ridx = (int*)(F.ws + WS_ENT); u32x2* rw = (u32x2*)(F.ws + WS_RW);
    const unsigned* cnt = (const unsigned*)(F.ws + WS_CTL) + CW_CNT;
    for (int m = F.vcu * NTHR + tid_f; m < NTOK; m += F.G * NTHR) { const u32x4 rt = *(const u32x4*)(route + (size_t)m * 8); const int d = offs[rt.x] + (int)rt.y; ridx[d] = m; rw[d] = (u32x2){rt.z, rt.w}; }
    for (int i = F.vcu * NTHR + tid_f; i < NCLS * 256; i += F.G * NTHR) { const int e = i >> 8, r = i & 255; const int c = (int)cnt[e]; const int pad = ((c + 255) & ~255) - c;
        if (r < pad) { ridx[offs[e] + c + r] = -1; rw[offs[e] + c + r] = (u32x2){0u, 0u}; } }
    __syncthreads();
}
__device__ __forceinline__ void p_combine(const Frame& F, const float* xin, float* dst) {
    const int lane_f = lane_id_fresh(), tid_f = F.wave * 64 + lane_f;
    LAS int* offs = (LAS int*)(F.lds + 1024); LAS int* texp = (LAS int*)(F.lds + 2048);
    moe_tables(F, offs, texp);
    const bf16* MO = (const bf16*)(F.ws + WS_MO); const bf16* YS = (const bf16*)(F.ws + WS_YS); const int* route = (const int*)(F.ws + WS_ROUTE); const float* mod = (const float*)(F.ws + WS_MOD);
    const int lane = lane_f;
    for (int m = F.gw; m < NTOK; m += F.NGW) {
        const int b = m / SEQ; const int* rt = route + (size_t)m * 8; const int d0 = offs[rt[0]] + rt[2], d1 = offs[rt[1]] + rt[3];
        const float w0 = __builtin_bit_cast(float, rt[4]), w1 = __builtin_bit_cast(float, rt[5]);
#pragma unroll
        for (int j = 0; j < 2; ++j) { const int col = 8 * lane + 512 * j; float y0[8], y1[8];
            unpack8(*(const u32x4*)(YS + (size_t)d0 * 1024 + col), y0); unpack8(*(const u32x4*)(YS + (size_t)d1 * 1024 + col), y1);
            const float* o = xin + (size_t)m * 1024 + col; const float* gt = mod + b * 6144 + 5120 + col; const float* gm = mod + b * 6144 + 2048 + col; float mo[8]; unpack8(*(const u32x4*)(MO + (size_t)m * 1024 + col), mo);
            f32x4 x0 = *(const f32x4*)o, x1 = *(const f32x4*)(o + 4); const f32x4 g0 = *(const f32x4*)gt, g1 = *(const f32x4*)(gt + 4), h0 = *(const f32x4*)gm, h1 = *(const f32x4*)(gm + 4);
            x0.x += h0.x * mo[0]; x0.y += h0.y * mo[1]; x0.z += h0.z * mo[2]; x0.w += h0.w * mo[3]; x1.x += h1.x * mo[4]; x1.y += h1.y * mo[5]; x1.z += h1.z * mo[6]; x1.w += h1.w * mo[7];
            x0.x += g0.x * (w0 * y0[0] + w1 * y1[0]); x0.y += g0.y * (w0 * y0[1] + w1 * y1[1]); x0.z += g0.z * (w0 * y0[2] + w1 * y1[2]); x0.w += g0.w * (w0 * y0[3] + w1 * y1[3]);
            x1.x += g1.x * (w0 * y0[4] + w1 * y1[4]); x1.y += g1.y * (w0 * y0[5] + w1 * y1[5]); x1.z += g1.z * (w0 * y0[6] + w1 * y1[6]); x1.w += g1.w * (w0 * y0[7] + w1 * y1[7]);
            float* od = dst + (size_t)m * 1024 + col; *(f32x4*)od = x0; *(f32x4*)(od + 4) = x1; }
    }
}

constexpr int NPHASE = 16;
template <int LO, int HI>
__global__ void __launch_bounds__(NTHR, 2) fwd(Args args) {
    extern __shared__ __attribute__((aligned(16))) unsigned char lds_raw[];
    Frame F;
    F.lds = (LAS unsigned char*)lds_raw;
    F.wave = __builtin_amdgcn_readfirstlane((int)threadIdx.x >> 6);
    F.G = gridDim.x; { const int bx = blockIdx.x; F.vcu = (F.G % 8 == 0) ? (bx % 8) * (F.G / 8) + bx / 8 : bx; }
    F.gw = F.vcu * NWAVES + F.wave; F.NGW = F.G * NWAVES;
    F.ws = args.ws; F.dob = (unsigned char*)args.out;
    ArgsP AP = (ArgsP)__builtin_amdgcn_kernarg_segment_ptr();
    volatile LAS unsigned* MISC = (volatile LAS unsigned*)(F.lds + LDS_MISC);
    if (threadIdx.x < 64) MISC[threadIdx.x] = 0u;
    __syncthreads();
    XcdBarrier bar; bar.bar = (unsigned*)(F.ws + WS_CTL) + CW_BAR; bar.x = 0; bar.st = MISC + 8;
#if N_LAUNCH_MODE == 1
    bar = xcd_barrier_post((unsigned*)(F.ws + WS_CTL) + CW_BAR, MISC + 8);
#define GRID_BAR() xcd_barrier(bar)
#else
#define GRID_BAR() do { } while (0)
#endif
#ifndef PROBE_REPEAT
#define PROBE_REPEAT -1
#endif
#define IN(k) (LO <= (k) && (k) < HI)
#define SEAM(k) do { if constexpr (IN(k) && IN((k) + 1)) GRID_BAR(); } while (0)
    const float* mod = (const float*)(F.ws + WS_MOD);

#define PH(k, ...) do { if constexpr (IN(k)) { asm volatile("" : "+s"(AP)); { __VA_ARGS__ } if constexpr (PROBE_REPEAT == (k)) { GRID_BAR(); asm volatile("" : "+s"(AP)); { __VA_ARGS__ } } } } while (0)
    PH(0, p0_prologue(F, AP);); SEAM(0);
    PH(1, p_normmod(F, AP->in[I_X], AP->in[I_GMIX], mod, 0, 1024, (bf16*)(F.ws + WS_H));); SEAM(1);
    PH(2, Gemm g{(const bf16*)(F.ws + WS_H), (const bf16*)(F.ws + WS_WIN), NTOK, N_IN_PAD, 1024}; StaticOrder S; S.init(NTOK, N_IN_PAD, F.G, (int)blockIdx.x);
        EpiZ E{(bf16*)(F.ws + WS_ZR), (bf16*)(F.ws + WS_SG), (bf16*)(F.ws + WS_ZM)}; gemm_phase_any(F.lds, g, S, E, F.wave);); SEAM(2);
    PH(3, p_prep_a(F, AP);); SEAM(3);
    PH(4,
        { Gemm g{(const bf16*)(F.ws + WS_TWA), (const bf16*)(F.ws + WS_WBLK), NTOK, 1024, 128}; StaticOrder S; S.init(NTOK, 1024, F.G, (int)blockIdx.x);
          EpiLora E{(bf16*)(F.ws + WS_LW), (bf16*)(F.ws + WS_A), AP->in[I_W0], AP->in[I_A0]}; gemm_phase_any(F.lds, g, S, E, F.wave); }
        { Gemm g{(const bf16*)(F.ws + WS_SGL), (const bf16*)(F.ws + WS_WG), NTOK, 512, 128}; StaticOrder S; S.init(NTOK, 512, F.G, (int)blockIdx.x);
          EpiPlain E{(bf16*)(F.dob + DO_G), nullptr, 1 << 30, 512, 0}; gemm_phase_any(F.lds, g, S, E, F.wave); }
        { Gemm g{(const bf16*)(F.ws + WS_QA), (const bf16*)(F.ws + WS_WUQ), NTOK, 768, 256}; StaticOrder S; S.init(NTOK, 768, F.G, (int)blockIdx.x);
          EpiPlain E{(bf16*)(F.dob + DO_Q), nullptr, 1 << 30, 768, 0}; gemm_phase_any(F.lds, g, S, E, F.wave); }
        { Gemm g{(const bf16*)(F.ws + WS_KVA), (const bf16*)(F.ws + WS_WUKV), NTOK, 1024, 128}; StaticOrder S; S.init(NTOK, 1024, F.G, (int)blockIdx.x);
          EpiPlain E{(bf16*)(F.dob + DO_KN), (bf16*)(F.ws + WS_VC), 512, 512, 512}; gemm_phase_any(F.lds, g, S, E, F.wave); }
    ); SEAM(4);
    PH(5, p_prep_c(F, AP);); SEAM(5);
#if ENG_ATTN == 1
    PH(6, p_attn_mfma(F, AP->in[I_QN]);); SEAM(6);
#else
    PH(6, p_attn_naive(F);); SEAM(6);
#endif
    PH(7, p_cs_a(F, AP);); SEAM(7);
    PH(8, p_cs_b(F);); SEAM(8);
    PH(9, p_cs_c(F, AP);); SEAM(9);
    PH(10, Gemm g{(const bf16*)(F.ws + WS_Y), (const bf16*)(F.ws + WS_WB), NTOK, 1024, 1024}; StaticOrder S; S.init(NTOK, 1024, F.G, (int)blockIdx.x);
        EpiBranch2 E{(bf16*)(F.ws + WS_MG), (const bf16*)(F.ws + WS_SG)}; gemm_phase_mid(F.lds, g, S, E, F.wave);); SEAM(10);
    PH(11, Gemm g{(const bf16*)(F.ws + WS_MG), (const bf16*)(F.ws + WS_WO), NTOK, 1024, 1024}; StaticOrder S; S.init(NTOK, 1024, F.G, (int)blockIdx.x);
        EpiX1 E{(bf16*)(F.ws + WS_MO), AP->in[I_X], mod}; gemm_phase_any(F.lds, g, S, E, F.wave);); SEAM(11);
    if constexpr (PROBE_REPEAT == 12) { p_ffn_route(F, AP, (unsigned*)(F.ws + WS_CTL) + CW_CNT + 256, (int*)(F.ws + WS_CS)); GRID_BAR(); }
    if constexpr (IN(12)) { asm volatile("" : "+s"(AP)); p_ffn_route(F, AP, (unsigned*)(F.ws + WS_CTL) + CW_CNT, (int*)(F.ws + WS_ROUTE)); } SEAM(12);
    PH(13, p_gather(F);); SEAM(13);
    PH(14, LAS int* offs = (LAS int*)(F.lds + LDS_MISC + 1024); LAS int* texp = (LAS int*)(F.lds + LDS_MISC + 1024 + 512); const int nt = moe_tables(F, offs, texp);
        Gemm g{(const bf16*)(F.ws + WS_H2), (const bf16*)(F.ws + WS_WGU), MPAD2, 1024, 1024, (const int*)(F.ws + WS_ENT)}; PairOrderGU S{texp, nt, F.G, (int)blockIdx.x};
        EpiGateUp2 E{(bf16*)(F.ws + WS_HID2), (const float*)(F.ws + WS_RW)}; gemm_phase_gather(F.lds, g, S, E, F.wave);); SEAM(14);
    PH(15, LAS int* offs = (LAS int*)(F.lds + LDS_MISC + 1024); LAS int* texp = (LAS int*)(F.lds + LDS_MISC + 1024 + 512); const int nt = moe_tables(F, offs, texp);
        Gemm g{(const bf16*)(F.ws + WS_HID2), (const bf16*)(F.ws + WS_WDN), MPAD2, 1024, 512, nullptr, 256}; PairOrderDown S{texp, nt, F.G, (int)blockIdx.x};
        EpiDown2 E{(float*)F.dob, (const bf16*)(F.ws + WS_MO), mod, (const int*)(F.ws + WS_ENT)}; gemm_phase_bseg(F.lds, g, S, E, F.wave););
}

#if N_LAUNCH_MODE == 1
static bool set_attrs() { return hipFuncSetAttribute((const void*)fwd<0, NPHASE>, hipFuncAttributeMaxDynamicSharedMemorySize, LDS_BYTES) == hipSuccess; }
#else
template <int P> static bool set_attr_all() { if constexpr (P < NPHASE) { return hipFuncSetAttribute((const void*)fwd<P, P + 1>, hipFuncAttributeMaxDynamicSharedMemorySize, LDS_BYTES) == hipSuccess && set_attr_all<P + 1>(); } else return true; }
static bool set_attrs() { return set_attr_all<0>(); }
template <int P> static void launch_all(int grid, hipStream_t stream, const Args& a) { if constexpr (P < NPHASE) { hipLaunchKernelGGL((fwd<P, P + 1>), dim3(grid), dim3(NTHR), LDS_BYTES, stream, a); launch_all<P + 1>(grid, stream, a); } }
#endif
extern "C" void kernel_launch(void* const* d_in, const int* in_sizes, int n_in, void* d_out, int out_size, void* d_ws, size_t ws_size, hipStream_t stream) {
    static int grid = 0;
    if (grid == 0) {
        if (n_in != 34 || out_size != NTOK * DM || ws_size < WS_END) { fprintf(stderr, "kernel_launch: unexpected shapes (n_in %d out %d ws %zu)\n", n_in, out_size, ws_size); grid = -1; return; }
        int dev = 0, cus = 0;
        if (hipGetDevice(&dev) != hipSuccess || hipDeviceGetAttribute(&cus, hipDeviceAttributeMultiprocessorCount, dev) != hipSuccess) { grid = -1; return; }
        if (!set_attrs()) { fprintf(stderr, "kernel_launch: hipFuncSetAttribute failed\n"); grid = -1; return; }
        grid = cus;
    }
    if (grid < 0) return;
    (void)hipMemsetAsync((char*)d_ws + WS_CTL, 0, CTL_ZERO_BYTES, stream);
    Args a{};
    for (int i = 0; i < 34; ++i) a.in[i] = (const float*)d_in[i];
    a.out = (float*)d_out; a.ws = (unsigned char*)d_ws;
    a.ph_lo = 0; a.ph_hi = NPHASE;
#if N_LAUNCH_MODE == 1
    hipLaunchKernelGGL((fwd<0, NPHASE>), dim3(grid), dim3(NTHR), LDS_BYTES, stream, a);
#else
    launch_all<0>(grid, stream, a);
#endif
}
```

```cpp
#include <hip/hip_runtime.h>
#include <cstdio>
#include <cstdint>

#ifndef N_LAUNCH_MODE
#define N_LAUNCH_MODE 1
#endif
#ifndef ENG_GEMM
#define ENG_GEMM 1
#endif
#ifndef ENG_ATTN
#define ENG_ATTN 1
#endif

#define GAS __attribute__((address_space(1)))
#define LAS __attribute__((address_space(3)))
typedef unsigned short bf16;
typedef float f32x4 __attribute__((ext_vector_type(4)));
typedef float f32x2 __attribute__((ext_vector_type(2)));
typedef unsigned u32x4 __attribute__((ext_vector_type(4)));
typedef unsigned u32x2 __attribute__((ext_vector_type(2)));
typedef short bf16x8 __attribute__((ext_vector_type(8)));

constexpr int BATCH = 8, SEQ = 8192, DM = 1024, NTOK = BATCH * SEQ;
constexpr int D_RWKV = 512, RWKV_COLS = 1792, MLA_COLS = 416, D_IN = 4256, N_IN_PAD = 4352;
constexpr int NH = 8, QKD = 96, NOPE = 64, ROPE = 32, VD = 64;
constexpr int NEXP = 32, DEXP = 256;
constexpr int NCLS = 112, MPAD2 = 94208;
constexpr int MPAD = 139264;
constexpr float EPS = 1e-6f, LN_X_EPS = 64e-5f;
constexpr float QSCALE = 0.10206207261596577f * 1.4426950408889634f;

constexpr size_t MiB = 1u << 20;
constexpr size_t WS_CTL = 0, CTL_ZERO_BYTES = 1 * MiB;
constexpr size_t WS_MOD = 1 * MiB;
constexpr size_t WS_ROUTE = 2 * MiB;
constexpr size_t WS_CS = 4 * MiB;
constexpr size_t WS_ENT = 12 * MiB;
constexpr size_t WS_WIN = 16 * MiB;
constexpr size_t WS_WBLK = 25 * MiB;
constexpr size_t WS_WG = WS_WBLK + 256 * 1024;
constexpr size_t WS_WUQ = WS_WG + 128 * 1024;
constexpr size_t WS_WUKV = WS_WUQ + 384 * 1024;
constexpr size_t WS_WB = 26 * MiB;
constexpr size_t WS_WO = 28 * MiB;
constexpr size_t WS_WGU = 30 * MiB;
constexpr size_t WS_WDN = 62 * MiB;
constexpr size_t WS_SG = 80 * MiB;
constexpr size_t WS_H2 = 80 * MiB;
constexpr size_t WS_ZR = 336 * MiB;
constexpr size_t WS_VC = 816 * MiB;
constexpr size_t WS_KC = 880 * MiB;
constexpr size_t WS_Y = 560 * MiB;
constexpr size_t WS_XG = 336 * MiB;
constexpr size_t WS_ZM = 560 * MiB;
constexpr size_t WS_YM = 560 * MiB + 1024;
constexpr size_t WS_H = 688 * MiB;
constexpr size_t WS_LW = 688 * MiB;
constexpr size_t WS_A = 752 * MiB;
constexpr size_t WS_MG = 688 * MiB;
constexpr size_t WS_HID2 = 208 * MiB;
constexpr int CLS_CAP = 65536;
constexpr size_t WS_RIDXV = 336 * MiB;
constexpr size_t WS_RWV = 368 * MiB;
constexpr size_t WS_RW = 13 * MiB;
constexpr size_t WS_HID = 208 * MiB;
constexpr size_t WS_R = 752 * MiB;
constexpr size_t WS_V = 816 * MiB;
constexpr size_t WS_ZK = 880 * MiB;
constexpr size_t WS_TWA = 944 * MiB;
constexpr size_t WS_SGL = 960 * MiB;
constexpr size_t WS_QA = 976 * MiB;
constexpr size_t WS_KVA = 1008 * MiB;
constexpr size_t WS_KK = 944 * MiB;
constexpr size_t WS_YS = 752 * MiB;
constexpr size_t WS_MO = 560 * MiB;
constexpr int YYLD = 1024;
constexpr size_t WS_END = 1024 * MiB;
constexpr size_t DO_G = 0;
constexpr size_t DO_Q = 64 * MiB;
constexpr size_t DO_KN = 160 * MiB;

constexpr int CW_CNT = 64;
constexpr int CW_BAR = 4096;

constexpr int NWAVES = 8, NTHR = 512;
constexpr int LDS_BYTES = 155648;
constexpr int LDS_MISC = 151552;

__device__ __forceinline__ int lane_id_fresh() { int l; asm volatile("v_mbcnt_lo_u32_b32 %0, -1, 0\n\tv_mbcnt_hi_u32_b32 %0, -1, %0" : "=v"(l)); return l; }
__device__ __forceinline__ float bf2f(unsigned short h) { return __builtin_bit_cast(float, (unsigned)h << 16); }
__device__ __forceinline__ unsigned f2bf(float f) { unsigned u = __builtin_bit_cast(unsigned, f); return (u + 0x7fffu + ((u >> 16) & 1u)) >> 16; }
typedef __bf16 bf16x2_t __attribute__((ext_vector_type(2)));
__device__ __forceinline__ unsigned pk2(float lo, float hi) { const f32x2 v = {lo, hi}; return __builtin_bit_cast(unsigned, __builtin_convertvector(v, bf16x2_t)); }
__device__ __forceinline__ float lo2f(unsigned w) { return __builtin_bit_cast(float, w << 16); }
__device__ __forceinline__ float hi2f(unsigned w) { return __builtin_bit_cast(float, w & 0xffff0000u); }
template <int CTRL> __device__ __forceinline__ float dpp_add(float x) { return x + __builtin_bit_cast(float, __builtin_amdgcn_update_dpp(0, __builtin_bit_cast(int, x), CTRL, 0xf, 0xf, false)); }
__device__ __forceinline__ float allsum16(float x) { x = dpp_add<0xB1>(x); x = dpp_add<0x4E>(x); x = dpp_add<0x141>(x); x = dpp_add<0x140>(x); return x; }
__device__ __forceinline__ float allsum32(float x) { x = allsum16(x); auto r = __builtin_amdgcn_permlane16_swap(__float_as_uint(x), __float_as_uint(x), false, false); return __uint_as_float(r[0]) + __uint_as_float(r[1]); }
__device__ __forceinline__ float sum8(float x) { x = dpp_add<0xB1>(x); x = dpp_add<0x4E>(x); x = dpp_add<0x141>(x); return x; }
__device__ __forceinline__ float wave_sum(float v) {
    v = allsum16(v);
    { auto r = __builtin_amdgcn_permlane16_swap(__float_as_uint(v), __float_as_uint(v), false, false); v = __uint_as_float(r[0]) + __uint_as_float(r[1]); }
    { auto r = __builtin_amdgcn_permlane32_swap(__float_as_uint(v), __float_as_uint(v), false, false); v = __uint_as_float(r[0]) + __uint_as_float(r[1]); }
    return v;
}
__device__ __forceinline__ float sigmoidf_(float x) { return __builtin_amdgcn_rcpf(1.f + __builtin_amdgcn_exp2f(-1.4426950408889634f * x)); }
__device__ __forceinline__ float tanhf_(float x) { return 1.0f - 2.0f * __builtin_amdgcn_rcpf(1.f + __builtin_amdgcn_exp2f(2.8853900817779268f * x)); }
__device__ __forceinline__ float siluf_(float x) { return x * __builtin_amdgcn_rcpf(1.f + __builtin_amdgcn_exp2f(-1.4426950408889634f * x)); }
__device__ __forceinline__ void unpack8(const u32x4 w, float (&v)[8]) {
    v[0] = lo2f(w.x); v[1] = hi2f(w.x); v[2] = lo2f(w.y); v[3] = hi2f(w.y); v[4] = lo2f(w.z); v[5] = hi2f(w.z); v[6] = lo2f(w.w); v[7] = hi2f(w.w);
}
__device__ __forceinline__ u32x4 pack8(const float (&v)[8]) { u32x4 w; w.x = pk2(v[0], v[1]); w.y = pk2(v[2], v[3]); w.z = pk2(v[4], v[5]); w.w = pk2(v[6], v[7]); return w; }

#define LDS_BAR() do { asm volatile("s_waitcnt lgkmcnt(0)" ::: "memory"); __builtin_amdgcn_s_barrier(); asm volatile("" ::: "memory"); } while (0)

#define XB_TMO      128
#define XB_XCNT(j)  (256  + 64 * (j))
#define XB_XSUB(j)  (1280 + 64 * (j))
#define XB_XGEN(j)  (2304 + 64 * (j))
#define XB_TOP      3328
#define XB_TOPGEN   3392
#define XCD_BAR_WORDS 3456
#define XB_SPIN_CAP (1u << 19)
__device__ __forceinline__ unsigned xb_ld(unsigned* p)              { return __hip_atomic_load(p, __ATOMIC_RELAXED, __HIP_MEMORY_SCOPE_AGENT); }
__device__ __forceinline__ unsigned xb_add(unsigned* p, unsigned v) { return __hip_atomic_fetch_add(p, v, __ATOMIC_RELAXED, __HIP_MEMORY_SCOPE_AGENT); }
__device__ __forceinline__ unsigned xb_xcc_id() { return (unsigned)__builtin_amdgcn_s_getreg((3 << 11) | 20) & 0xFu; }
#define XB_SPIN(cond, bar) do { unsigned _sp = 0; while (cond) { __builtin_amdgcn_s_sleep(1); \
    if ((++_sp & 255u) == 0u) { if (xb_ld(&(bar)[XB_TMO])) break; if (_sp > XB_SPIN_CAP) { atomicAdd(&(bar)[XB_TMO], 1u); break; } } } } while (0)
struct XcdBarrier { unsigned* bar; unsigned x; volatile LAS unsigned* st; };
__device__ __forceinline__ XcdBarrier xcd_barrier_post(unsigned* bar, volatile LAS unsigned* st) {
    XcdBarrier b; b.bar = bar; b.x = xb_xcc_id(); b.st = st;
    if (threadIdx.x == 0) (void)xb_add(&bar[XB_XCNT(b.x)], 1u);
    return b;
}
__device__ __forceinline__ void xcd_barrier_complete(unsigned* bar, unsigned x, unsigned& nloc, unsigned& nx) {
    const unsigned G = gridDim.x * gridDim.y * gridDim.z;
    unsigned sum, cnt, mine, sp = 0u;
    for (;;) {
        sum = 0u; cnt = 0u; mine = 0u;
#pragma unroll
        for (unsigned j = 0; j < 16; ++j) { const unsigned c = xb_ld(&bar[XB_XCNT(j)]); sum += c; cnt += (c > 0u) ? 1u : 0u; mine = (j == x) ? c : mine; }
        if (sum == G) break;
        __builtin_amdgcn_s_sleep(1);
        if ((++sp & 255u) == 0u) { if (xb_ld(&bar[XB_TMO])) break; if (sp > XB_SPIN_CAP) { atomicAdd(&bar[XB_TMO], 1u); break; } }
    }
    nloc = mine > 0u ? mine : 1u; nx = cnt > 0u ? cnt : 1u;
}
__device__ __forceinline__ void xcd_barrier(const XcdBarrier& b) {
    asm volatile("s_waitcnt vmcnt(0)" ::: "memory");
    __syncthreads();
    if (threadIdx.x == 0) {
        unsigned* bar = b.bar;
        __builtin_amdgcn_s_waitcnt(0);
        unsigned nloc = b.st[0], nx = b.st[1];
        if (nloc == 0u) { xcd_barrier_complete(bar, b.x, nloc, nx); b.st[0] = nloc; b.st[1] = nx; }
        const unsigned old = xb_add(&bar[XB_XSUB(b.x)], 1u);
        const unsigned gen = old / nloc;
        if (old + 1u == (gen + 1u) * nloc) {
            __builtin_amdgcn_fence(__ATOMIC_RELEASE, "agent");
            asm volatile("s_waitcnt vmcnt(0)" ::: "memory");
            const unsigned og = xb_add(&bar[XB_TOP], 1u);
            const unsigned tg = og / nx;
            if (og + 1u == (tg + 1u) * nx) xb_add(&bar[XB_TOPGEN], 1u);
            else XB_SPIN(xb_ld(&bar[XB_TOPGEN]) == tg, bar);
            __builtin_amdgcn_fence(__ATOMIC_ACQUIRE, "agent");
            xb_add(&bar[XB_XGEN(b.x)], 1u);
            asm volatile("s_waitcnt vmcnt(0)" ::: "memory");
        } else {
            XB_SPIN(xb_ld(&bar[XB_XGEN(b.x)]) == gen, bar);
            __builtin_amdgcn_fence(__ATOMIC_ACQUIRE, "agent");
            asm volatile("s_waitcnt vmcnt(0)" ::: "memory");
        }
    }
    __syncthreads();
}

struct Args {
    const float* in[34]; float* out; unsigned char* ws; int ph_lo, ph_hi;
};
typedef const __attribute__((address_space(4))) Args* ArgsP;
struct Frame {
    LAS unsigned char* lds;
    int wave, vcu, G, gw, NGW;
    unsigned char* ws; unsigned char* dob;
};
enum { I_X = 0, I_C, I_POS, I_WADA, I_BADA, I_GMIX, I_WIN, I_MU, I_W0, I_WDEC, I_A0, I_WAUP, I_WGUP, I_KK, I_KA, I_RK, I_LNW, I_LNB, I_GQA, I_WUQ, I_GKVA, I_WUKV,
       I_QN, I_KN, I_WBR, I_WOUT, I_GFFN, I_WRG, I_BRG, I_WRE, I_BRE, I_WEG, I_WEU, I_WED };

struct Unit { int pm, pn, aux, vr, nv; };
struct Gemm { const bf16* A; const bf16* Bt; int M, N, K; const int* ridx = nullptr; int ldb = 0; };
constexpr int NXCD = 8, WGM = 8;
struct StaticOrder {
    int nM, nN, nwg, G, c;
    __device__ void init(int M, int N, int G_, int c_) { nM = M / 256; nN = N / 256; nwg = nM * nN; G = G_; c = c_; }
    __device__ bool next(int i, Unit& u) const {
        const long L = (long)i * G + c; if (L >= nwg) return false;
        int wgid = (int)L; { const int q = nwg / NXCD, r = nwg % NXCD, xcd = wgid % NXCD, off = wgid / NXCD; wgid = (xcd < r ? xcd * (q + 1) : r * (q + 1) + (xcd - r) * q) + off; }
        const int nig = WGM * nN, gid = wgid / nig, fm = gid * WGM, gsz = (nM - fm) < WGM ? (nM - fm) : WGM;
        u.pm = fm + ((wgid % nig) % gsz); u.pn = (wgid % nig) / gsz; u.aux = 0; u.vr = 0; u.nv = 256; return true;
    }
    __device__ __forceinline__ void a_ready(const Unit&) const {}
    __device__ __forceinline__ void done(const Unit&) const {}
};
struct TableOrder {
    const LAS int* texp; int ntiles, nN, G, c;
    __device__ bool next(int i, Unit& u) const {
        const long L = (long)i * G + c; if (L >= (long)ntiles * nN) return false;
        const int t = (int)(L / nN), j = (int)(L % nN); u.pm = t; u.pn = texp[t] * nN + j; u.aux = 0; u.vr = 0; u.nv = 256; return true;
    }
    __device__ __forceinline__ void a_ready(const Unit&) const {}
    __device__ __forceinline__ void done(const Unit&) const {}
};

__device__ __forceinline__ void cls_decode(int cls, int& e_lo, int& e_hi) {
    const int gi = cls / 28, idx = cls % 28;
    const int lo = (idx >= 7) + (idx >= 13) + (idx >= 18) + (idx >= 22) + (idx >= 25) + (idx >= 27), base = (lo * (15 - lo)) / 2;
    e_lo = gi * 8 + lo; e_hi = gi * 8 + lo + 1 + (idx - base);
}
struct PairOrderGU {
    const LAS int* texp; const LAS int* offs; const LAS int* ccnt; int ntiles, G, c;
    __device__ bool next(int i, Unit& u) const {
        const int L = i * G + c; if (L >= ntiles * 4) return false;
        const int t = L >> 2, j = L & 3; int el, eh; const int cls = __builtin_amdgcn_readfirstlane(texp[t]); cls_decode(cls, el, eh);
        const int r0 = t * 256 - __builtin_amdgcn_readfirstlane(offs[cls]), left = __builtin_amdgcn_readfirstlane(ccnt[cls]) - r0;
        u.pm = t; u.pn = (j < 2 ? el : eh) * 2 + (j & 1); u.aux = j >> 1; u.vr = cls * CLS_CAP + r0; u.nv = left < 256 ? left : 256; return true;
    }
    __device__ __forceinline__ void a_ready(const Unit&) const {}
    __device__ __forceinline__ void done(const Unit&) const {}
};
struct PairOrderDown {
    const LAS int* texp; const LAS int* offs; const LAS int* ccnt; int ntiles, G, c;
    __device__ bool next(int i, Unit& u) const {
        const int L = i * G + c; if (L >= ntiles * 4) return false;
        const int t = L >> 2, j = L & 3; int el, eh; const int cls = __builtin_amdgcn_readfirstlane(texp[t]); cls_decode(cls, el, eh);
        const int r0 = t * 256 - __builtin_amdgcn_readfirstlane(offs[cls]), left = __builtin_amdgcn_readfirstlane(ccnt[cls]) - r0;
        u.pm = t; u.pn = el * 4 + j; u.aux = eh * 4 + j; u.vr = cls * CLS_CAP + r0; u.nv = left < 256 ? left : 256; return true;
    }
    __device__ __forceinline__ void a_ready(const Unit&) const {}
    __device__ __forceinline__ void done(const Unit&) const {}
};

template <class Epi, class Sched>
__device__ __forceinline__ void gemm_phase_naive(LAS unsigned char* lds, const Gemm g, const Sched& S, const Epi& E) {
    const int tid = (int)__builtin_amdgcn_readfirstlane((int)threadIdx.x >> 6) * 64 + lane_id_fresh(), ty = tid >> 5, tx = tid & 31;
    LAS bf16* As = (LAS bf16*)lds; LAS bf16* Bs = (LAS bf16*)(lds + 128 * 40 * 2);
    Unit u;
    for (int i = 0; S.next(i, u); ++i) {
        for (int half = 0; half < 2; ++half) {
            float acc[8][8];
#pragma unroll
            for (int r = 0; r < 8; ++r)
#pragma unroll
                for (int c = 0; c < 8; ++c) acc[r][c] = 0.f;
            const bf16* Ab = g.A + ((size_t)u.pm * 256 + half * 128) * g.K; const bf16* Bb = g.Bt + (size_t)u.pn * 256 * g.K;
            for (int k0 = 0; k0 < g.K; k0 += 32) {
                __syncthreads();
                { const int r = tid >> 2, c8 = (tid & 3) * 8; *(LAS u32x4*)(As + r * 40 + c8) = *(const u32x4*)(Ab + (size_t)r * g.K + k0 + c8); }
#pragma unroll
                for (int j = 0; j < 2; ++j) { const int ch = tid + j * 512, r = ch >> 2, c8 = (ch & 3) * 8; *(LAS u32x4*)(Bs + r * 40 + c8) = *(const u32x4*)(Bb + (size_t)r * g.K + k0 + c8); }
                __syncthreads();
#pragma unroll 2
                for (int k = 0; k < 32; k += 2) {
                    float b0[8], b1[8];
#pragma unroll
                    for (int c = 0; c < 8; ++c) { const unsigned w = *(const LAS unsigned*)(Bs + (tx * 8 + c) * 40 + k); b0[c] = lo2f(w); b1[c] = hi2f(w); }
#pragma unroll
                    for (int r = 0; r < 8; ++r) { const unsigned w = *(const LAS unsigned*)(As + (ty * 8 + r) * 40 + k); const float a0 = lo2f(w), a1 = hi2f(w);
#pragma unroll
                        for (int c = 0; c < 8; ++c) acc[r][c] = fmaf(a1, b1[c], fmaf(a0, b0[c], acc[r][c])); }
                }
            }
#pragma unroll
            for (int r = 0; r < 8; ++r) E.store8(u, half * 128 + ty * 8 + r, tx * 8, acc[r]);
        }
    }
    __syncthreads();
}

struct EpiZ { bf16 *ZR, *SG, *ZM;
    __device__ __forceinline__ void store8(const Unit& u, int r, int c, const float (&v)[8]) const {
        const size_t row = (size_t)u.pm * 256 + r;
        if (u.pn < 7) { *(u32x4*)(ZR + row * 1792 + u.pn * 256 + c) = pack8(v); }
        else if (u.pn < 15) { __builtin_nontemporal_store(pack8(v), (u32x4*)(SG + row * 2048 + (u.pn - 7) * 256 + c)); }
        else { *(u32x4*)(ZM + row * 512 + (u.pn - 15) * 256 + c) = pack8(v); }
    } };
struct EpiLora { bf16 *LW, *A; const float *w0, *a0;
    __device__ __forceinline__ void store8(const Unit& u, int r, int c, const float (&v)[8]) const {
        const size_t row = (size_t)u.pm * 256 + r; const int col = u.pn * 256 + c; float o[8];
        const bool isw = col < 512; const float* bp = isw ? (w0 + col) : (a0 + col - 512);
        const f32x4 b0 = *(const f32x4*)bp, b1 = *(const f32x4*)(bp + 4); const float bb[8] = {b0.x, b0.y, b0.z, b0.w, b1.x, b1.y, b1.z, b1.w};
#pragma unroll
        for (int i = 0; i < 8; ++i) { const float e = __builtin_amdgcn_exp2f(fminf(-1.4426950408889634f * (bb[i] + v[i]), 120.f)); const float s = __builtin_amdgcn_rcpf(1.0f + e); o[i] = isw ? -0.60653065971263342f * s : s; }
        bf16* dst = isw ? (LW + row * 512 + col) : (A + row * 512 + col - 512);
        *(u32x4*)dst = pack8(o);
    } };
struct EpiPlain { bf16* O0; bf16* O1; int split, ld0, ld1;
    __device__ __forceinline__ void store8(const Unit& u, int r, int c, const float (&v)[8]) const {
        const size_t row = (size_t)u.pm * 256 + r; int col = u.pn * 256 + c;
        if (col < split) *(u32x4*)(O0 + row * ld0 + col) = pack8(v); else *(u32x4*)(O1 + row * ld1 + col - split) = pack8(v);
    } };
struct EpiX1 { bf16* X1; const float* x; const float* mod;
    __device__ __forceinline__ void store8(const Unit& u, int r, int c, const float (&v)[8]) const {
        const size_t row = (size_t)u.pm * 256 + r; const int col = u.pn * 256 + c, b = (int)(row / SEQ); const size_t off = row * 1024 + col;
        const float* gm = mod + b * 6144 + 2048 + col; const f32x4 x0 = *(const f32x4*)(x + off), x1 = *(const f32x4*)(x + off + 4), h0 = *(const f32x4*)gm, h1 = *(const f32x4*)(gm + 4);
        const float o[8] = {x0.x + h0.x * v[0], x0.y + h0.y * v[1], x0.z + h0.z * v[2], x0.w + h0.w * v[3], x1.x + h1.x * v[4], x1.y + h1.y * v[5], x1.z + h1.z * v[6], x1.w + h1.w * v[7]};
        *(u32x4*)(X1 + off) = pack8(o);
    } };
struct EpiBranch2 { bf16* MG; const bf16* SG;
    __device__ __forceinline__ void mid8(const Unit& u, int r, int c, float (&v)[8]) const {
        const size_t row = (size_t)u.pm * 256 + r; const int col = u.pn * 256 + c; float gr[8], gm[8];
        unpack8(*(const u32x4*)(SG + row * 2048 + col), gr); unpack8(*(const u32x4*)(SG + row * 2048 + 1024 + col), gm);
#pragma unroll
        for (int i = 0; i < 8; ++i) v[i] *= (1.f + __builtin_amdgcn_exp2f(-1.4426950408889634f * fmaxf(gm[i], -30.f))) * __builtin_amdgcn_rcpf(1.f + __builtin_amdgcn_exp2f(-1.4426950408889634f * gr[i]));
    }
    __device__ __forceinline__ void store8(const Unit& u, int r, int c, const float (&v)[8]) const {
        const size_t row = (size_t)u.pm * 256 + r; const int col = u.pn * 256 + c; float gm[8], o[8];
        unpack8(*(const u32x4*)(SG + row * 2048 + 1024 + col), gm);
#pragma unroll
        for (int i = 0; i < 8; ++i) o[i] = sigmoidf_(fmaxf(gm[i], -30.f)) * v[i];
        *(u32x4*)(MG + row * 1024 + col) = pack8(o);
    } };
struct EpiGateUp { bf16* HID;
    __device__ __forceinline__ void store8(const Unit& u, int r, int c, const float (&v)[8]) const {
        const size_t row = (size_t)u.pm * 256 + r; const int col = ((u.pn & 1) * 256 + c) >> 1;
        u32x2 w; w.x = pk2(siluf_(v[0]) * v[4], siluf_(v[1]) * v[5]); w.y = pk2(siluf_(v[2]) * v[6], siluf_(v[3]) * v[7]);
        *(u32x2*)(HID + row * 256 + col) = w;
    } };
struct EpiGateUp2 { bf16* HID2; const float* rw;
    __device__ __forceinline__ void store8(const Unit& u, int r, int c, const float (&v)[8]) const {
        const size_t row = (size_t)u.pm * 256 + r; const float w = r < u.nv ? rw[((size_t)u.vr + r) * 2 + u.aux] : 0.f; const int col = u.aux * 256 + (((u.pn & 1) * 256 + c) >> 1);
        u32x2 o; o.x = pk2(w * siluf_(v[0]) * v[4], w * siluf_(v[1]) * v[5]); o.y = pk2(w * siluf_(v[2]) * v[6], w * siluf_(v[3]) * v[7]);
        *(u32x2*)(HID2 + row * 512 + col) = o;
    } };
struct EpiDown2 { float* out; const bf16* X1; const float* mod; const int* ridx;
    __device__ __forceinline__ void store8(const Unit& u, int r, int c, const float (&v)[8]) const {
        if (r >= u.nv) return;
        const int tok = ridx[u.vr + r];
        const int col = (u.pn & 3) * 256 + c, b = tok / SEQ; const size_t off = (size_t)tok * 1024 + col;
        const float* gt = mod + b * 6144 + 5120 + col; const u32x4 xw = *(const u32x4*)(X1 + off); const f32x4 g0 = *(const f32x4*)gt, g1 = *(const f32x4*)(gt + 4);
        f32x4 o0, o1;
        o0.x = lo2f(xw.x) + g0.x * v[0]; o0.y = hi2f(xw.x) + g0.y * v[1]; o0.z = lo2f(xw.y) + g0.z * v[2]; o0.w = hi2f(xw.y) + g0.w * v[3];
        o1.x = lo2f(xw.z) + g1.x * v[4]; o1.y = hi2f(xw.z) + g1.y * v[5]; o1.z = lo2f(xw.w) + g1.z * v[6]; o1.w = hi2f(xw.w) + g1.w * v[7];
        *(f32x4*)(out + off) = o0; *(f32x4*)(out + off + 4) = o1;
    } };
struct EpiDown { bf16* YS;
    __device__ __forceinline__ void store8(const Unit& u, int r, int c, const float (&v)[8]) const {
        const size_t row = (size_t)u.pm * 256 + r; *(u32x4*)(YS + row * 1024 + (u.pn & 3) * 256 + c) = pack8(v);
    } };


namespace pg8 {
#define PG8_LAS __attribute__((address_space(3)))
typedef ::bf16x8 bf16x8; typedef ::f32x4 f32x4;
using ::Unit; using ::Gemm;
constexpr int BM = 256, BK = 64, HALF = 128, HTB = HALF * BK * 2  , STAGE_BYTES = 8 * HTB;

__device__ __forceinline__ int lds_byte(int r, int c) { const int st = (r >> 4) * 2 + (c >> 5), rr = r & 15, cc = c & 31, ob = rr * 64 + cc * 2; return st * 1024 + (ob ^ (((ob >> 9) & 1) << 5)); }
__device__ __forceinline__ void stage_rc(int b, int& R, int& C) { const int st = b / 1024, sb = b % 1024, swz = sb ^ (((sb >> 9) & 1) << 5); R = (st >> 1) * 16 + swz / 64; C = (st & 1) * 32 + (swz % 64) / 2; }
__device__ __forceinline__ int perm32(int rho) { const int n = rho >> 4, i = rho & 15; return 8 * (i >> 2) + 4 * n + (i & 3); }
template <class Epi, class Sched, bool ALIGN_EPI = false, bool SP2 = false, bool GATHER = false, bool MIDHOOK = false, bool BSEG = false>
__device__ __forceinline__ void gemm_phase(PG8_LAS unsigned char* lds, const Gemm g, const Sched& S, const Epi& E, const int wave_in) {
    const int lane = lane_id_fresh(), wid = wave_in, tid = wid * 64 + lane,
              wr = wid >> 2, wc = wid & 3, fr = lane & 15, fq = lane >> 4;
    const int K = g.K, nt = K / BK;
    unsigned voffA[2], voffB[2];
#pragma unroll
    for (int i = 0; i < 2; ++i) { int R, C; stage_rc(tid * 16 + i * 8192, R, C); const int Rb = Epi::PERM ? ((R & ~31) + perm32(R & 31)) : R;
        voffA[i] = (unsigned)(R * K + C) * 2u; voffB[i] = (unsigned)(Rb * (BSEG ? g.ldb : K) + C) * 2u; }
    unsigned vAc[2][2] = {{0u, 0u}, {0u, 0u}}, vAn[2][2] = {{0u, 0u}, {0u, 0u}}; int gR[2] = {0, 0}; unsigned gC[2] = {0u, 0u};
    if constexpr (GATHER) {
#pragma unroll
        for (int i = 0; i < 2; ++i) { int R, C; stage_rc(tid * 16 + i * 8192, R, C); gR[i] = R; gC[i] = (unsigned)C * 2u; } }
#define PG8_GIDX(dst, U_) do { _Pragma("unroll") for (int _h = 0; _h < 2; ++_h) _Pragma("unroll") for (int _i = 0; _i < 2; ++_i) \
        { const int rr_ = _h * HALF + gR[_i]; const int ri_ = rr_ < (U_).nv ? g.ridx[(U_).vr + rr_] : 0; dst[_h][_i] = (unsigned)ri_ * (unsigned)(K * 2) + gC[_i]; } } while (0)
    const size_t kstep = (size_t)(BK * 2);
    const size_t hstep = (size_t)HALF * K * 2;
    const size_t tstep = 2 * hstep;
    const size_t hstepB = BSEG ? (size_t)HALF * g.ldb * 2 : hstep, tstepB = 2 * hstepB; const int nh = nt / 2;
    const unsigned ldsw = (unsigned)wid * 1024u;
    const int aoff = lds_byte(wr * 64 + fr, fq * 8), boff = lds_byte(wc * 32 + fr, fq * 8);
#define PG8_SA(b, h) (((b) * 2 + (h)) * HTB)
#define PG8_SB(b, h) ((4 + (b) * 2 + (h)) * HTB)
#define PG8_STAGE(bufoff, gbase, voff) do { _Pragma("unroll") for (int _i = 0; _i < 2; ++_i) \
        __builtin_amdgcn_global_load_lds((const unsigned*)((const char*)(gbase) + (voff)[_i]), (PG8_LAS unsigned*)(lds + (bufoff) + ldsw + _i * 8192), 16, 0, 0); } while (0)
#define PG8_STAGE_A(bufoff, kptr, h, isnext) do { if constexpr (GATHER) { unsigned _v[2]; _v[0] = (isnext) ? vAn[h][0] : vAc[h][0]; _v[1] = (isnext) ? vAn[h][1] : vAc[h][1]; PG8_STAGE(bufoff, kptr, _v); } \
        else { PG8_STAGE(bufoff, (kptr) + (h) * hstep, voffA); } } while (0)
#define PG8_LDA(dst, b, h) do { _Pragma("unroll") for (int m = 0; m < 4; ++m) _Pragma("unroll") for (int k = 0; k < 2; ++k) dst[m][k] = *(const PG8_LAS bf16x8*)(lds + PG8_SA(b, h) + aoff + m * 2048 + k * 1024); } while (0)
#define PG8_LDB(dst, b, h) do { _Pragma("unroll") for (int n = 0; n < 2; ++n) _Pragma("unroll") for (int k = 0; k < 2; ++k) dst[n][k] = *(const PG8_LAS bf16x8*)(lds + PG8_SB(b, h) + boff + n * 2048 + k * 1024); } while (0)
#define PG8_MMA(ai, bj, At, Bt) do { __builtin_amdgcn_s_setprio(1); _Pragma("unroll") for (int m = 0; m < 4; ++m) _Pragma("unroll") for (int n = 0; n < 2; ++n) _Pragma("unroll") for (int k = 0; k < 2; ++k) \
        acc[ai][bj][m][n] = __builtin_amdgcn_mfma_f32_16x16x32_bf16(Bt[n][k], At[m][k], acc[ai][bj][m][n], 0, 0, 0); __builtin_amdgcn_s_setprio(0); } while (0)
#define PG8_WAIT_V(n) asm volatile("s_waitcnt vmcnt(" #n ")" ::: "memory")
#define PG8_WAIT_L(n) asm volatile("s_waitcnt lgkmcnt(" #n ")" ::: "memory")
#define PG8_BAR __builtin_amdgcn_s_barrier()
#define PG8_SCHED __builtin_amdgcn_sched_barrier(0)
    Unit cur, nxt; int ui = 0;
    if (!S.next(0, cur)) return;
    f32x4 acc[2][2][4][2];
#pragma unroll
    for (int a = 0; a < 2; ++a)
#pragma unroll
        for (int b = 0; b < 2; ++b)
#pragma unroll
            for (int m = 0; m < 4; ++m)
#pragma unroll
                for (int n = 0; n < 2; ++n) acc[a][b][m][n] = (f32x4){0.f, 0.f, 0.f, 0.f};
    bf16x8 At[4][2], B0[2][2], B1[2][2];
    const char* cA = (const char*)g.A + (GATHER ? (size_t)0 : (size_t)cur.pm * tstep); const char* cB = (const char*)g.Bt + (size_t)cur.pn * tstepB; const char* cB2 = (const char*)g.Bt + (size_t)(BSEG ? cur.aux : cur.pn) * tstepB;
    if constexpr (GATHER) PG8_GIDX(vAc, cur);
    S.a_ready(cur);
    if constexpr (SP2) {
        PG8_STAGE(PG8_SB(0, 0), cB, voffB); PG8_STAGE(PG8_SB(0, 1), cB + hstepB, voffB); PG8_STAGE_A(PG8_SA(0, 0), cA, 0, false); PG8_STAGE_A(PG8_SA(0, 1), cA, 1, false);
        if (wr == 1) PG8_BAR;
        PG8_WAIT_V(2); PG8_BAR;
        PG8_STAGE(PG8_SB(1, 0), cB + kstep, voffB); PG8_STAGE_A(PG8_SA(1, 0), cA + kstep, 0, false); PG8_STAGE(PG8_SB(1, 1), cB + hstepB + kstep, voffB);
        PG8_WAIT_V(6); PG8_BAR;
    } else {
        PG8_STAGE(PG8_SB(0, 0), cB, voffB); PG8_STAGE(PG8_SA(0, 0), cA, voffA); PG8_STAGE(PG8_SB(0, 1), cB + hstep, voffB); PG8_STAGE(PG8_SA(0, 1), cA + hstep, voffA);
        if (wr == 1) PG8_BAR;
        PG8_WAIT_V(4); PG8_BAR;
        PG8_STAGE(PG8_SB(1, 0), cB + kstep, voffB); PG8_STAGE(PG8_SA(1, 0), cA + kstep, voffA); PG8_STAGE(PG8_SB(1, 1), cB + hstep + kstep, voffB);
        PG8_WAIT_V(6); PG8_BAR;
    }
    for (;;) {
        const bool has_next = S.next(ui + 1, nxt);
        const char* nA = (has_next && !GATHER) ? (const char*)g.A + (size_t)nxt.pm * tstep : cA; const char* nB = has_next ? (const char*)g.Bt + (size_t)nxt.pn * tstepB : cB; const char* nB2 = (has_next && BSEG) ? (const char*)g.Bt + (size_t)nxt.aux * tstepB : (BSEG ? cB2 : nB);
        if constexpr (GATHER) { if (has_next) PG8_GIDX(vAn, nxt); else { _Pragma("unroll") for (int _h = 0; _h < 2; ++_h) { vAn[_h][0] = vAc[_h][0]; vAn[_h][1] = vAc[_h][1]; } } }
        for (int t = 0; t < nt; t += 2) {
            if constexpr (MIDHOOK) { if (t == nt / 2) { E.mid(acc, cur, wr, wc, fr, fq); PG8_WAIT_V(0); } }
            const bool last = (t == nt - 2);
            const char* a1 = cA + (size_t)(t + 1) * kstep;
            const char* a2 = last ? nA : cA + (size_t)(t + 2) * kstep; const char* b2 = last ? nB : ((BSEG && t + 2 >= nh) ? cB2 + (size_t)(t + 2 - nh) * kstep : cB + (size_t)(t + 2) * kstep);
            const char* a3 = a2 + kstep; const char* b3 = b2 + kstep;
            if (last && has_next) S.a_ready(nxt);
            if constexpr (SP2) {
            PG8_LDB(B0, 0, 0); PG8_LDB(B1, 0, 1); PG8_SCHED; PG8_LDA(At, 0, 0); PG8_STAGE_A(PG8_SA(1, 1), a1, 1, false);
            PG8_WAIT_V(8); PG8_WAIT_L(0); PG8_BAR; PG8_MMA(0, 0, At, B0); PG8_MMA(0, 1, At, B1); PG8_BAR; PG8_SCHED;
            PG8_LDA(At, 0, 1); PG8_STAGE(PG8_SB(0, 0), b2, voffB); PG8_STAGE(PG8_SB(0, 1), b2 + hstepB, voffB); PG8_STAGE_A(PG8_SA(0, 0), a2, 0, last);
            PG8_WAIT_V(8); PG8_WAIT_L(0); PG8_BAR; PG8_MMA(1, 0, At, B0); PG8_MMA(1, 1, At, B1); PG8_BAR; PG8_SCHED;
            PG8_LDB(B0, 1, 0); PG8_LDB(B1, 1, 1); PG8_SCHED; PG8_LDA(At, 1, 0); PG8_STAGE_A(PG8_SA(0, 1), a2, 1, last);
            PG8_WAIT_V(8); PG8_WAIT_L(0); PG8_BAR; PG8_MMA(0, 0, At, B0); PG8_MMA(0, 1, At, B1); PG8_BAR; PG8_SCHED;
            PG8_LDA(At, 1, 1); PG8_STAGE(PG8_SB(1, 0), b3, voffB); PG8_STAGE(PG8_SB(1, 1), b3 + hstepB, voffB); PG8_STAGE_A(PG8_SA(1, 0), a3, 0, last);
            PG8_WAIT_V(8); PG8_WAIT_L(0); PG8_BAR; PG8_MMA(1, 0, At, B0); PG8_MMA(1, 1, At, B1); PG8_BAR; PG8_SCHED;
            } else {
            PG8_LDB(B0, 0, 0); PG8_SCHED; PG8_LDA(At, 0, 0); PG8_STAGE(PG8_SA(1, 1), a1 + hstep, voffA);
            PG8_WAIT_L(8); PG8_BAR; PG8_WAIT_L(0); PG8_MMA(0, 0, At, B0); PG8_BAR; PG8_SCHED;
            PG8_LDB(B1, 0, 1); PG8_STAGE(PG8_SB(0, 0), b2, voffB);
            PG8_BAR; PG8_WAIT_L(0); PG8_MMA(0, 1, At, B1); PG8_BAR;
            PG8_LDA(At, 0, 1); PG8_STAGE(PG8_SA(0, 0), a2, voffA);
            PG8_BAR; PG8_WAIT_L(0); PG8_MMA(1, 0, At, B0); PG8_BAR; PG8_SCHED;
            PG8_STAGE(PG8_SB(0, 1), b2 + hstep, voffB);
            PG8_WAIT_V(6); PG8_BAR; PG8_MMA(1, 1, At, B1); PG8_BAR;
            PG8_LDB(B0, 1, 0); PG8_SCHED; PG8_LDA(At, 1, 0); PG8_STAGE(PG8_SA(0, 1), a2 + hstep, voffA);
            PG8_WAIT_L(8); PG8_BAR; PG8_WAIT_L(0); PG8_MMA(0, 0, At, B0); PG8_BAR; PG8_SCHED;
            PG8_LDB(B1, 1, 1); PG8_STAGE(PG8_SB(1, 0), b3, voffB);
            PG8_BAR; PG8_WAIT_L(0); PG8_MMA(0, 1, At, B1); PG8_BAR;
            PG8_LDA(At, 1, 1); PG8_STAGE(PG8_SA(1, 0), a3, voffA);
            PG8_BAR; PG8_WAIT_L(0); PG8_MMA(1, 0, At, B0); PG8_BAR; PG8_SCHED;
            PG8_STAGE(PG8_SB(1, 1), b3 + hstep, voffB);
            PG8_WAIT_V(6); PG8_BAR; PG8_MMA(1, 1, At, B1); PG8_BAR;
            }
        }
        if constexpr (ALIGN_EPI) { if (wr == 0) PG8_BAR; }
        if constexpr (!Epi::AFTER_DRAIN) { E(acc, cur, wr, wc, fr, fq); S.done(cur); }
        if (!has_next) break;
#pragma unroll
        for (int a = 0; a < 2; ++a)
#pragma unroll
            for (int b = 0; b < 2; ++b)
#pragma unroll
                for (int m = 0; m < 4; ++m)
#pragma unroll
                    for (int n = 0; n < 2; ++n) acc[a][b][m][n] = (f32x4){0.f, 0.f, 0.f, 0.f};
        cur = nxt; cA = nA; cB = nB; cB2 = nB2; ++ui;
        if constexpr (GATHER) { _Pragma("unroll") for (int _h = 0; _h < 2; ++_h) { vAc[_h][0] = vAn[_h][0]; vAc[_h][1] = vAn[_h][1]; } }
        if constexpr (ALIGN_EPI) { if (wr == 1) PG8_BAR; }
    }
    PG8_WAIT_V(0);
    if constexpr (!ALIGN_EPI) { if (wr == 0) PG8_BAR; }
    PG8_BAR;
    if constexpr (Epi::AFTER_DRAIN) { E.fused(acc, cur, wr, wc, fr, fq, lds, wid, lane); S.done(cur); }
#undef PG8_SA
#undef PG8_SB
#undef PG8_STAGE
#undef PG8_STAGE_A
#undef PG8_GIDX
#undef PG8_LDA
#undef PG8_LDB
#undef PG8_MMA
#undef PG8_WAIT_V
#undef PG8_WAIT_L
#undef PG8_BAR
#undef PG8_SCHED
}

template <class F> struct EpiAdapt {
    static constexpr bool PERM = true, AFTER_DRAIN = false; F f;
    __device__ __forceinline__ void mid(f32x4 (&acc)[2][2][4][2], const Unit& u, int wr, int wc, int fr, int fq) const {
        asm volatile("" : "+v"(fr), "+v"(fq));
#pragma unroll
        for (int ai = 0; ai < 2; ++ai)
#pragma unroll
            for (int m = 0; m < 4; ++m) { const int row = ai * HALF + wr * 64 + m * 16 + fr;
#pragma unroll
                for (int bj = 0; bj < 2; ++bj) { float v[8] = {acc[ai][bj][m][0][0], acc[ai][bj][m][0][1], acc[ai][bj][m][0][2], acc[ai][bj][m][0][3], acc[ai][bj][m][1][0], acc[ai][bj][m][1][1], acc[ai][bj][m][1][2], acc[ai][bj][m][1][3]};
                    f.mid8(u, row, bj * HALF + wc * 32 + 8 * fq, v);
                    acc[ai][bj][m][0] = (f32x4){v[0], v[1], v[2], v[3]}; acc[ai][bj][m][1] = (f32x4){v[4], v[5], v[6], v[7]}; } }
    }
    __device__ __forceinline__ void operator()(const f32x4 (&acc)[2][2][4][2], const Unit& u, int wr, int wc, int fr, int fq) const {
        asm volatile("" : "+v"(fr), "+v"(fq));
#pragma unroll
        for (int ai = 0; ai < 2; ++ai)
#pragma unroll
            for (int m = 0; m < 4; ++m) { const int row = ai * HALF + wr * 64 + m * 16 + fr;
#pragma unroll
                for (int bj = 0; bj < 2; ++bj) { const f32x4 v0 = acc[ai][bj][m][0], v1 = acc[ai][bj][m][1];
                    const float v[8] = {v0[0], v0[1], v0[2], v0[3], v1[0], v1[1], v1[2], v1[3]};
                    f.store8(u, row, bj * HALF + wc * 32 + 8 * fq, v); } }
    }
};
}

template <class Epi, class Sched>
__device__ __forceinline__ void gemm_phase_mid(LAS unsigned char* lds, const Gemm g, const Sched& S, const Epi& E, const int wave_in) {
    pg8::EpiAdapt<Epi> EA{E};
    pg8::gemm_phase<pg8::EpiAdapt<Epi>, Sched, true, true, false, true>(lds, g, S, EA, wave_in);
}
template <class Epi, class Sched>
__device__ __forceinline__ void gemm_phase_bseg(LAS unsigned char* lds, const Gemm g, const Sched& S, const Epi& E, const int wave_in) {
    pg8::EpiAdapt<Epi> EA{E};
    pg8::gemm_phase<pg8::EpiAdapt<Epi>, Sched, true, true, false, false, true>(lds, g, S, EA, wave_in);
}
template <class Epi, class Sched>
__device__ __forceinline__ void gemm_phase_gather(LAS unsigned char* lds, const Gemm g, const Sched& S, const Epi& E, const int wave_in) {
    pg8::EpiAdapt<Epi> EA{E};
    pg8::gemm_phase<pg8::EpiAdapt<Epi>, Sched, true, true, true>(lds, g, S, EA, wave_in);
}
template <class Epi, class Sched>
__device__ __forceinline__ void gemm_phase_any(LAS unsigned char* lds, const Gemm g, const Sched& S, const Epi& E, const int wave_in) {
#if ENG_GEMM == 1
    pg8::EpiAdapt<Epi> EA{E};
    pg8::gemm_phase<pg8::EpiAdapt<Epi>, Sched, true, true>(lds, g, S, EA, wave_in);
#else
    gemm_phase_naive<Epi, Sched>(lds, g, S, E);
#endif
}

template <class RowMap>
__device__ __forceinline__ void transpose_item(const float* W, int ldw, bf16* WT, int ldt, int koff, int k0, int n0, const RowMap& rm, LAS float* scr, int lane) {
#pragma unroll 8
    for (int i = 0; i < 32; ++i) { const int kk = 2 * i + (lane >> 5); scr[kk * 33 + (lane & 31)] = W[(size_t)(k0 + kk) * ldw + n0 + (lane & 31)]; }
    asm volatile("s_waitcnt lgkmcnt(0)" ::: "memory");
    const int c = lane & 7;
#pragma unroll
    for (int j = 0; j < 4; ++j) { const int n = (lane >> 3) + 8 * j; const LAS float* s = scr + (8 * c) * 33 + n;
        u32x4 o; o.x = pk2(s[0 * 33], s[1 * 33]); o.y = pk2(s[2 * 33], s[3 * 33]); o.z = pk2(s[4 * 33], s[5 * 33]); o.w = pk2(s[6 * 33], s[7 * 33]);
        *(u32x4*)(WT + (size_t)rm(n0 + n) * ldt + koff + k0 + 8 * c) = o; }
    asm volatile("s_waitcnt lgkmcnt(0)" ::: "memory");
}
struct RmId { int off; __device__ int operator()(int n) const { return off + n; } };
struct RmWin { __device__ int operator()(int n) const { return n < 1792 ? n : (n < 2208 ? 3840 + (n - 1792) : 1792 + (n - 2208)); } };
struct RmUkv { __device__ int operator()(int n) const { const int h = n >> 7, j = n & 127; return j < 64 ? h * 64 + j : 512 + h * 64 + (j - 64); } };
struct RmGU { int off; __device__ int operator()(int j) const { return off + 8 * (j >> 2) + (j & 3); } };

__device__ __forceinline__ void p0_prologue(const Frame& F, ArgsP a) {
    const int lane_f = lane_id_fresh(), tid_f = F.wave * 64 + lane_f;
    LAS float* scr = (LAS float*)(F.lds + F.wave * 16384);
    const int lane = lane_f;
    bf16* Win = (bf16*)(F.ws + WS_WIN); bf16* Wblk = (bf16*)(F.ws + WS_WBLK); bf16* Wg = (bf16*)(F.ws + WS_WG); bf16* Wuq = (bf16*)(F.ws + WS_WUQ);
    bf16* Wukv = (bf16*)(F.ws + WS_WUKV); bf16* Wb = (bf16*)(F.ws + WS_WB); bf16* Wo = (bf16*)(F.ws + WS_WO); bf16* Wgu = (bf16*)(F.ws + WS_WGU); bf16* Wdn = (bf16*)(F.ws + WS_WDN);
    constexpr int I_IN = 16 * 133, I_DEC = 1 * 16, I_AUP = 16, I_GUP = 2 * 16, I_UQ = 4 * 24, I_UKV = 2 * 32, I_BR = 2 * 8 * 32, I_O = 16 * 32;
    constexpr int I_EG = 32 * 16 * 8, I_EU = I_EG, I_ED = 32 * 4 * 32;
    constexpr int NITEMS = I_IN + I_DEC + I_AUP + I_GUP + I_UQ + I_UKV + I_BR + I_O + I_EG + I_EU + I_ED;
    for (int it = F.gw; it < NITEMS; it += F.NGW) {
        int r = it;
        if (r < I_IN) { const int kb = r / 133, nb = r % 133; transpose_item(a->in[I_WIN], D_IN, Win, 1024, 0, 64 * kb, 32 * nb, RmWin{}, scr, lane); continue; } r -= I_IN;
        if (r < I_DEC) { transpose_item(a->in[I_WDEC], 512, Wblk, 128, 0, 0, 32 * r, RmId{0}, scr, lane); continue; } r -= I_DEC;
        if (r < I_AUP) { transpose_item(a->in[I_WAUP], 512, Wblk, 128, 64, 0, 32 * r, RmId{512}, scr, lane); continue; } r -= I_AUP;
        if (r < I_GUP) { const int kb = r / 16, nb = r % 16; transpose_item(a->in[I_WGUP], 512, Wg, 128, 0, 64 * kb, 32 * nb, RmId{0}, scr, lane); continue; } r -= I_GUP;
        if (r < I_UQ) { const int kb = r / 24, nb = r % 24; transpose_item(a->in[I_WUQ], 768, Wuq, 256, 0, 64 * kb, 32 * nb, RmId{0}, scr, lane); continue; } r -= I_UQ;
        if (r < I_UKV) { const int kb = r / 32, nb = r % 32; transpose_item(a->in[I_WUKV], 1024, Wukv, 128, 0, 64 * kb, 32 * nb, RmUkv{}, scr, lane); continue; } r -= I_UKV;
        if (r < I_BR) { const int br = r / 256, q = r % 256, kb = q / 32, nb = q % 32; transpose_item(a->in[I_WBR] + (size_t)br * 512 * 1024, 1024, Wb, 1024, 512 * br, 64 * kb, 32 * nb, RmId{0}, scr, lane); continue; } r -= I_BR;
        if (r < I_O) { const int kb = r / 32, nb = r % 32; transpose_item(a->in[I_WOUT], 1024, Wo, 1024, 0, 64 * kb, 32 * nb, RmId{0}, scr, lane); continue; } r -= I_O;
        if (r < I_EG) { const int e = r / 128, q = r % 128, kb = q / 8, nb = q % 8; transpose_item(a->in[I_WEG] + (size_t)e * 1024 * 256, 256, Wgu + (size_t)e * 512 * 1024, 1024, 0, 64 * kb, 32 * nb, RmGU{0}, scr, lane); continue; } r -= I_EG;
        if (r < I_EU) { const int e = r / 128, q = r % 128, kb = q / 8, nb = q % 8; transpose_item(a->in[I_WEU] + (size_t)e * 1024 * 256, 256, Wgu + (size_t)e * 512 * 1024, 1024, 0, 64 * kb, 32 * nb, RmGU{4}, scr, lane); continue; } r -= I_EU;
        { const int e = r / 128, q = r % 128, kb = q / 32, nb = q % 32; transpose_item(a->in[I_WED] + (size_t)e * 256 * 1024, 1024, Wdn + (size_t)e * 1024 * 256, 256, 0, 64 * kb, 32 * nb, RmId{0}, scr, lane); }
    }
    for (int i = F.gw * 64 + lane; i < 96 * 128; i += F.NGW * 64) *(u32x4*)(Win + (size_t)4256 * 1024 + (size_t)i * 8) = (u32x4){0u, 0u, 0u, 0u};
    for (int i = F.gw * 64 + lane; i < 1024 * 8; i += F.NGW * 64) { const int row = i >> 3, c8 = (i & 7) * 8; *(u32x4*)(Wblk + row * 128 + (row < 512 ? 64 : 0) + c8) = (u32x4){0u, 0u, 0u, 0u}; }
    { const int* pos = (const int*)a->in[I_POS]; float* cs = (float*)(F.ws + WS_CS);
      for (int i = F.gw * 64 + lane; i < NTOK * 16; i += F.NGW * 64) { const int t = i >> 4, j = i & 15;
          const float fr = exp2f(-(float)j * (13.287712379549449f / 16.0f));
          const float ang = (float)pos[t] * fr; cs[t * 32 + j] = cosf(ang); cs[t * 32 + 16 + j] = sinf(ang); } }
    { float* mod = (float*)(F.ws + WS_MOD); const float* c = a->in[I_C]; const float* wa = a->in[I_WADA]; const float* ba = a->in[I_BADA];
      LAS float* red = (LAS float*)(F.lds + 8 * 16384);
      LAS float* sc = (LAS float*)F.lds;
      if (F.vcu < 96) {
          __syncthreads();
          for (int i = tid_f; i < 8192; i += NTHR) sc[i] = siluf_(c[i]);
          __syncthreads();
      }
      for (int nb = F.vcu; nb < 96; nb += F.G) {
          float acc[8];
#pragma unroll
          for (int b = 0; b < 8; ++b) acc[b] = 0.f;
          const int n = nb * 64 + lane;
          for (int k0 = F.wave * 128; k0 < F.wave * 128 + 128; k0 += 16) { float w[16];
#pragma unroll
              for (int kk = 0; kk < 16; ++kk) w[kk] = wa[(size_t)(k0 + kk) * 6144 + n];
#pragma unroll
              for (int kk = 0; kk < 16; ++kk)
#pragma unroll
                  for (int b = 0; b < 8; ++b) acc[b] = fmaf(sc[b * 1024 + k0 + kk], w[kk], acc[b]); }
#pragma unroll
          for (int b = 0; b < 8; ++b) red[(F.wave * 8 + b) * 64 + lane] = acc[b];
          __syncthreads();
          { const int b = F.wave; float s = ba[n];
#pragma unroll
            for (int w = 0; w < 8; ++w) s += red[(w * 8 + b) * 64 + lane];
            mod[b * 6144 + n] = s; }
          __syncthreads();
      } }
}

__device__ __forceinline__ void p_normmod(const Frame& F, const float* x, const float* g, const float* mod, int sh_off, int sc_off, bf16* H) {
    const int lane_f = lane_id_fresh();
    f32x4 xa[4], xb[4];
    { const f32x4* xr = (const f32x4*)(x + (size_t)F.gw * 1024) + lane_f;
#pragma unroll
      for (int j = 0; j < 4; ++j) xa[j] = xr[64 * j]; }
    f32x4 gs[4], sh[4]; int bcur = -1;
#define NM_ROW(CUR, NXT, m_) do { const int mm = (m_); const int b = mm / SEQ; \
        if (b != bcur) { bcur = b; \
            _Pragma("unroll") for (int j = 0; j < 4; ++j) { const int col = 4 * lane_f + 256 * j; gs[j] = *(const f32x4*)(g + col) * (*(const f32x4*)(mod + b * 6144 + sc_off + col) + 1.0f); sh[j] = *(const f32x4*)(mod + b * 6144 + sh_off + col); } \
            asm volatile("s_waitcnt vmcnt(0)" : "+v"(gs[0]), "+v"(gs[1]), "+v"(gs[2]), "+v"(gs[3]), "+v"(sh[0]), "+v"(sh[1]), "+v"(sh[2]), "+v"(sh[3]), "+v"(CUR[0]), "+v"(CUR[1]), "+v"(CUR[2]), "+v"(CUR[3])); } \
        { const int mn = (mm + F.NGW < NTOK) ? mm + F.NGW : mm; const f32x4* xr = (const f32x4*)(x + (size_t)mn * 1024) + lane_f; \
          _Pragma("unroll") for (int j = 0; j < 4; ++j) NXT[j] = xr[64 * j]; } \
        float s = 0.f; \
        _Pragma("unroll") for (int j = 0; j < 4; ++j) s += (CUR[j].x * CUR[j].x + CUR[j].y * CUR[j].y) + (CUR[j].z * CUR[j].z + CUR[j].w * CUR[j].w); \
        const float rstd = 1.0f / sqrtf(wave_sum(s) * (1.f / 1024.f) + EPS); \
        u32x2* o = (u32x2*)(H + (size_t)mm * 1024) + lane_f; \
        _Pragma("unroll") for (int j = 0; j < 4; ++j) { const f32x4 y = CUR[j] * rstd * gs[j] + sh[j]; u32x2 w; w.x = pk2(y.x, y.y); w.y = pk2(y.z, y.w); o[64 * j] = w; } } while (0)
    for (int m = F.gw; m < NTOK; m += 2 * F.NGW) {
        NM_ROW(xa, xb, m);
        if (m + F.NGW < NTOK) NM_ROW(xb, xa, m + F.NGW);
    }
#undef NM_ROW
}

__device__ __forceinline__ void p_prep_a(const Frame& F, ArgsP a) {
    const int lane_f = lane_id_fresh();
    const bf16* ZR = (const bf16*)(F.ws + WS_ZR); const bf16* ZM = (const bf16*)(F.ws + WS_ZM);
    bf16* TWA = (bf16*)(F.ws + WS_TWA); bf16* SGL = (bf16*)(F.ws + WS_SGL); bf16* QA = (bf16*)(F.ws + WS_QA); bf16* KVA = (bf16*)(F.ws + WS_KVA);
    const float* mu = a->in[I_MU]; const float* gqa = a->in[I_GQA]; const float* gkva = a->in[I_GKVA];
    const int lane = lane_f;
    const f32x4 mm = *(const f32x4*)(mu + 1536 + 4 * lane), gq = *(const f32x4*)(gqa + 4 * lane), gk = *(const f32x4*)(gkva + 4 * (lane & 31));
    for (int m0 = F.gw; m0 < NTOK; m0 += 4 * F.NGW) {
        u32x2 cc[4], pp[4], qq[4], kk[4];
#pragma unroll
        for (int u = 0; u < 4; ++u) { const int m = (m0 + u * F.NGW < NTOK) ? m0 + u * F.NGW : m0; const bool first = (m % SEQ) == 0;
            cc[u] = *((const u32x2*)(ZR + (size_t)m * 1792 + 1536) + lane); pp[u] = *((const u32x2*)(ZR + (size_t)(first ? m : m - 1) * 1792 + 1536) + lane);
            qq[u] = *((const u32x2*)(ZM + (size_t)m * 512) + lane); kk[u] = *((const u32x2*)(ZM + (size_t)m * 512 + 256) + (lane & 31)); }
#pragma unroll
        for (int u = 0; u < 4; ++u) { const int m = m0 + u * F.NGW; if (m < NTOK) { const bool first = (m % SEQ) == 0;
            { const u32x2 c = cc[u]; u32x2 p = pp[u]; if (first) { p.x = 0u; p.y = 0u; }
              float z[4] = {lo2f(c.x), hi2f(c.x), lo2f(c.y), hi2f(c.y)}; const float q[4] = {lo2f(p.x), hi2f(p.x), lo2f(p.y), hi2f(p.y)};
              z[0] += (q[0] - z[0]) * mm.x; z[1] += (q[1] - z[1]) * mm.y; z[2] += (q[2] - z[2]) * mm.z; z[3] += (q[3] - z[3]) * mm.w;
              if (lane < 16) { u32x2 w; w.x = pk2(tanhf_(z[0]), tanhf_(z[1])); w.y = pk2(tanhf_(z[2]), tanhf_(z[3])); *((u32x2*)(TWA + (size_t)m * 128) + lane) = w; }
              else if (lane < 32) { u32x2 w; w.x = pk2(z[0], z[1]); w.y = pk2(z[2], z[3]); *((u32x2*)(TWA + (size_t)m * 128) + lane) = w; }
              else { u32x2 w; w.x = pk2(sigmoidf_(z[0]), sigmoidf_(z[1])); w.y = pk2(sigmoidf_(z[2]), sigmoidf_(z[3])); *((u32x2*)(SGL + (size_t)m * 128) + (lane - 32)) = w; } }
            { const u32x2 c = qq[u]; const float z[4] = {lo2f(c.x), hi2f(c.x), lo2f(c.y), hi2f(c.y)};
              u32x2 c2 = kk[u]; if (lane >= 32) { c2.x = 0u; c2.y = 0u; } const float y[4] = {lo2f(c2.x), hi2f(c2.x), lo2f(c2.y), hi2f(c2.y)};
              const float rstd = 1.0f / sqrtf(wave_sum((z[0] * z[0] + z[1] * z[1]) + (z[2] * z[2] + z[3] * z[3])) * (1.f / 256.f) + EPS);
              const float rstd2 = 1.0f / sqrtf(wave_sum((y[0] * y[0] + y[1] * y[1]) + (y[2] * y[2] + y[3] * y[3])) * (1.f / 128.f) + EPS);
              u32x2 w; w.x = pk2(z[0] * rstd * gq.x, z[1] * rstd * gq.y); w.y = pk2(z[2] * rstd * gq.z, z[3] * rstd * gq.w);
              *((u32x2*)(QA + (size_t)m * 256) + lane) = w;
              if (lane < 32) { u32x2 w2; w2.x = pk2(y[0] * rstd2 * gk.x, y[1] * rstd2 * gk.y); w2.y = pk2(y[2] * rstd2 * gk.z, y[3] * rstd2 * gk.w);
                  *((u32x2*)(KVA + (size_t)m * 128) + lane) = w2; } } } }
    }
}

__device__ __forceinline__ void p_prep_c(const Frame& F, ArgsP a) {
    const int lane_f = lane_id_fresh();
    const bf16* KN = (const bf16*)(F.dob + DO_KN); const bf16* ZM = (const bf16*)(F.ws + WS_ZM); bf16* KC = (bf16*)(F.ws + WS_KC);
    const float* cs = (const float*)(F.ws + WS_CS); const float* kn = a->in[I_KN];
    const int lane = lane_f, hd = lane >> 3, j = lane & 7;
    const f32x4 kg0 = *(const f32x4*)(kn + 8 * j), kg1 = *(const f32x4*)(kn + 8 * j + 4); const f32x2 kr1 = *(const f32x2*)(kn + 64 + 2 * j), kr2 = *(const f32x2*)(kn + 80 + 2 * j);
    for (int m0 = F.gw; m0 < NTOK; m0 += 4 * F.NGW) {
        u32x4 kv[4]; unsigned z1[4], z2[4]; f32x2 cc[4], sn[4];
#pragma unroll
        for (int u = 0; u < 4; ++u) { const size_t m = (size_t)((m0 + u * F.NGW < NTOK) ? m0 + u * F.NGW : m0);
            kv[u] = *(const u32x4*)(KN + m * 512 + hd * 64 + 8 * j); z1[u] = *(const unsigned*)(ZM + m * 512 + 384 + 2 * j); z2[u] = *(const unsigned*)(ZM + m * 512 + 400 + 2 * j);
            cc[u] = *(const f32x2*)(cs + m * 32 + 2 * j); sn[u] = *(const f32x2*)(cs + m * 32 + 16 + 2 * j); }
#pragma unroll
        for (int u = 0; u < 4; ++u) { const int m = m0 + u * F.NGW; if (m < NTOK) {
            float v[8]; unpack8(kv[u], v); float x1[2] = {lo2f(z1[u]), hi2f(z1[u])}, x2[2] = {lo2f(z2[u]), hi2f(z2[u])};
            float ss = (x1[0] * x1[0] + x1[1] * x1[1]) + (x2[0] * x2[0] + x2[1] * x2[1]);
#pragma unroll
            for (int i = 0; i < 8; ++i) ss += v[i] * v[i];
            const float rstd = 1.0f / sqrtf(sum8(ss) * (1.f / 96.f) + EPS);
            v[0] *= rstd * kg0.x; v[1] *= rstd * kg0.y; v[2] *= rstd * kg0.z; v[3] *= rstd * kg0.w; v[4] *= rstd * kg1.x; v[5] *= rstd * kg1.y; v[6] *= rstd * kg1.z; v[7] *= rstd * kg1.w;
            x1[0] *= rstd * kr1.x; x1[1] *= rstd * kr1.y; x2[0] *= rstd * kr2.x; x2[1] *= rstd * kr2.y;
            bf16* kp = KC + (size_t)m * 768 + hd * 96;
            *(u32x4*)(kp + 8 * j) = pack8(v); *(unsigned*)(kp + 64 + 2 * j) = pk2(x1[0] * cc[u].x - x2[0] * sn[u].x, x1[1] * cc[u].y - x2[1] * sn[u].y);
            *(unsigned*)(kp + 80 + 2 * j) = pk2(x2[0] * cc[u].x + x1[0] * sn[u].x, x2[1] * cc[u].y + x1[1] * sn[u].y); } }
    }
}

__device__ __forceinline__ void p_attn_naive(const Frame& F) {
    const int lane_f = lane_id_fresh(), tid_f = F.wave * 64 + lane_f;
    const bf16* Q = (const bf16*)(F.dob + DO_Q); const bf16* KC = (const bf16*)(F.ws + WS_KC); const bf16* VC = (const bf16*)(F.ws + WS_VC); bf16* YM = (bf16*)(F.ws + WS_YM);
    LAS float* Ks = (LAS float*)F.lds; LAS float* Vs = (LAS float*)(F.lds + 32 * 96 * 4);
    const int tid = tid_f;
    for (int unit = F.vcu; unit < 64 * 16; unit += F.G) {
        const int bh = unit >> 4, qb = 15 - (unit & 15), b = bh >> 3, h = bh & 7; const size_t row0 = (size_t)b * SEQ; const int t = qb * 512 + tid;
        unsigned qp[48];
        { const u32x4* qg = (const u32x4*)(Q + (row0 + t) * 768 + h * 96);
#pragma unroll
          for (int i = 0; i < 12; ++i) { const u32x4 w = qg[i]; qp[4 * i] = w.x; qp[4 * i + 1] = w.y; qp[4 * i + 2] = w.z; qp[4 * i + 3] = w.w; } }
        float o[64];
#pragma unroll
        for (int i = 0; i < 64; ++i) o[i] = 0.f;
        float mx = -INFINITY, l = 0.f;
        const int nkt = (qb + 1) * 16;
        for (int kt = 0; kt < nkt; ++kt) {
            __syncthreads();
            if (tid < 384) { const int r = tid / 12, c8 = (tid % 12) * 8; float v[8]; unpack8(*(const u32x4*)(KC + (row0 + kt * 32 + r) * 768 + h * 96 + c8), v);
#pragma unroll
                for (int i = 0; i < 8; ++i) Ks[r * 96 + c8 + i] = v[i]; }
            if (tid < 256) { const int r = tid >> 3, c8 = (tid & 7) * 8; float v[8]; unpack8(*(const u32x4*)(VC + (row0 + kt * 32 + r) * 512 + h * 64 + c8), v);
#pragma unroll
                for (int i = 0; i < 8; ++i) Vs[r * 64 + c8 + i] = v[i]; }
            __syncthreads();
            for (int kk = 0; kk < 32; ++kk) {
                const int kv = kt * 32 + kk;
                float s = 0.f; const LAS f32x4* kr = (const LAS f32x4*)(Ks + kk * 96);
#pragma unroll
                for (int i = 0; i < 24; ++i) { const f32x4 k4 = kr[i]; s += lo2f(qp[2 * i]) * k4.x + hi2f(qp[2 * i]) * k4.y + lo2f(qp[2 * i + 1]) * k4.z + hi2f(qp[2 * i + 1]) * k4.w; }
                if (kv <= t) {
                    const float mn = fmaxf(mx, s), f = exp2f(mx - mn), p = exp2f(s - mn); mx = mn; l = l * f + p;
                    const LAS f32x4* vr = (const LAS f32x4*)(Vs + kk * 64);
#pragma unroll
                    for (int i = 0; i < 16; ++i) { const f32x4 v4 = vr[i]; o[4 * i] = o[4 * i] * f + p * v4.x; o[4 * i + 1] = o[4 * i + 1] * f + p * v4.y; o[4 * i + 2] = o[4 * i + 2] * f + p * v4.z; o[4 * i + 3] = o[4 * i + 3] * f + p * v4.w; }
                }
            }
        }
        const float il = 1.f / l; u32x4* og = (u32x4*)(YM + (row0 + t) * 512 + h * 64);
#pragma unroll
        for (int i = 0; i < 8; ++i) { u32x4 w; w.x = pk2(o[8 * i] * il, o[8 * i + 1] * il); w.y = pk2(o[8 * i + 2] * il, o[8 * i + 3] * il); w.z = pk2(o[8 * i + 4] * il, o[8 * i + 5] * il); w.w = pk2(o[8 * i + 6] * il, o[8 * i + 7] * il); og[i] = w; }
    }
    __syncthreads();
}

typedef float f32x16 __attribute__((ext_vector_type(16)));
typedef short s16x4 __attribute__((ext_vector_type(4)));
__device__ __forceinline__ int crow(int r, int hi) { return (r & 3) + 8 * (r >> 2) + 4 * hi; }
__device__ __forceinline__ float max3f(float a, float b, float c) { float r; asm("v_max3_f32 %0, %1, %2, %3" : "=v"(r) : "v"(a), "v"(b), "v"(c)); return r; }
__device__ __forceinline__ float max2f(float a, float b) { float r; asm("v_max_f32_e32 %0, %1, %2" : "=v"(r) : "v"(a), "v"(b)); return r; }
__device__ __forceinline__ float xhalf_max(float x) { auto rr = __builtin_amdgcn_permlane32_swap(__float_as_uint(x), __float_as_uint(x), false, false); return max2f(__uint_as_float(rr[0]), __uint_as_float(rr[1])); }
__device__ __forceinline__ float xhalf_sum(float x) { auto rr = __builtin_amdgcn_permlane32_swap(__float_as_uint(x), __float_as_uint(x), false, false); return __uint_as_float(rr[0]) + __uint_as_float(rr[1]); }
__device__ __forceinline__ bf16x8 packp(const f32x16& p, int s2) {
    u32x4 w; w.x = pk2(p[8 * s2 + 0], p[8 * s2 + 1]); w.y = pk2(p[8 * s2 + 2], p[8 * s2 + 3]); w.z = pk2(p[8 * s2 + 4], p[8 * s2 + 5]); w.w = pk2(p[8 * s2 + 6], p[8 * s2 + 7]);
    return __builtin_bit_cast(bf16x8, w);
}
__device__ __forceinline__ void p_attn_mfma(const Frame& F, const float* qn) {
    const int lane_f = lane_id_fresh(), tid_f = F.wave * 64 + lane_f;
    const bf16* Q = (const bf16*)(F.dob + DO_Q); const bf16* KC = (const bf16*)(F.ws + WS_KC); const bf16* VC = (const bf16*)(F.ws + WS_VC); bf16* YM = (bf16*)(F.ws + WS_YM);
    const float* cs = (const float*)(F.ws + WS_CS);
    constexpr int KST = 208, VST = 192, KBYTES = 64 * KST, SUB = KBYTES + 64 * VST, BUF = 2 * SUB;
    const int tid = tid_f, lane = lane_f, wave = F.wave, r = lane & 31, hi = lane >> 5;
    int kg[3], kl[3], vg[2], vl[2];
#pragma unroll
    for (int i = 0; i < 3; ++i) { const int c = tid + 512 * i, row = c / 12, pc = c % 12; kg[i] = row * 768 + pc * 8; kl[i] = (row >> 6) * SUB + (row & 63) * KST + pc * 16; }
#pragma unroll
    for (int i = 0; i < 2; ++i) { const int c = tid + 512 * i, row = c >> 3, pc = c & 7; vg[i] = row * 512 + pc * 8; vl[i] = (row >> 6) * SUB + KBYTES + (row & 63) * VST + pc * 16; }
    const int g4 = lane >> 4, li = lane & 15;
    const int vtr = (4 * (g4 >> 1) + (li >> 2)) * VST + (16 * (g4 & 1) + 4 * (li & 3)) * 2;
    const int kfr = r * KST + hi * 16;
    LAS unsigned char* lds = F.lds;
    for (int item = F.vcu; item < 1024; item += F.G) {
        const int bh = item >> 4, sidx = item & 15, b = bh >> 3, h = bh & 7; const size_t row0 = (size_t)b * SEQ;
        const bf16* Kg = KC + row0 * 768 + h * 96; const bf16* Vg = VC + row0 * 512 + h * 64;
        for (int uu = 0; uu < 2; ++uu) {
            const int qb = uu == 0 ? 31 - sidx : sidx, q0 = qb * 256, NT = (q0 + 256) / 128;
            const int qw = q0 + wave * 32;
            bf16x8 qf[6];
            {
              const bf16* qp = Q + (row0 + qw + r) * 768 + h * 96 + hi * 8; const float* csr = cs + (row0 + qw + r) * 32 + 8 * hi;
              u32x4 raw[6];
#pragma unroll
              for (int s = 0; s < 6; ++s) raw[s] = *(const u32x4*)(qp + 16 * s);
              const f32x4 c0 = *(const f32x4*)csr, c1 = *(const f32x4*)(csr + 4), s0 = *(const f32x4*)(csr + 16), s1 = *(const f32x4*)(csr + 20);
              float ss = 0.f;
#pragma unroll
              for (int s = 0; s < 6; ++s) { float t[8]; unpack8(raw[s], t);
#pragma unroll
                  for (int e = 0; e < 8; ++e) ss += t[e] * t[e]; }
              const float rstd = QSCALE / sqrtf(xhalf_sum(ss) * (1.f / 96.f) + EPS);
#pragma unroll
              for (int s = 0; s < 4; ++s) { float t[8]; unpack8(raw[s], t); const f32x4 g0 = *(const f32x4*)(qn + 16 * s + 8 * hi), g1 = *(const f32x4*)(qn + 16 * s + 8 * hi + 4);
                  t[0] *= rstd * g0.x; t[1] *= rstd * g0.y; t[2] *= rstd * g0.z; t[3] *= rstd * g0.w; t[4] *= rstd * g1.x; t[5] *= rstd * g1.y; t[6] *= rstd * g1.z; t[7] *= rstd * g1.w;
                  qf[s] = __builtin_bit_cast(bf16x8, pack8(t)); }
              { float a4[8], a5[8]; unpack8(raw[4], a4); unpack8(raw[5], a5);
                const f32x4 g0 = *(const f32x4*)(qn + 64 + 8 * hi), g1 = *(const f32x4*)(qn + 64 + 8 * hi + 4), h0 = *(const f32x4*)(qn + 80 + 8 * hi), h1 = *(const f32x4*)(qn + 80 + 8 * hi + 4);
                const float ga[8] = {g0.x, g0.y, g0.z, g0.w, g1.x, g1.y, g1.z, g1.w}, gb[8] = {h0.x, h0.y, h0.z, h0.w, h1.x, h1.y, h1.z, h1.w};
                const float cc[8] = {c0.x, c0.y, c0.z, c0.w, c1.x, c1.y, c1.z, c1.w}, sn[8] = {s0.x, s0.y, s0.z, s0.w, s1.x, s1.y, s1.z, s1.w};
#pragma unroll
                for (int e = 0; e < 8; ++e) { const float x1 = a4[e] * rstd * ga[e], x2 = a5[e] * rstd * gb[e]; a4[e] = x1 * cc[e] - x2 * sn[e]; a5[e] = x2 * cc[e] + x1 * sn[e]; }
                qf[4] = __builtin_bit_cast(bf16x8, pack8(a4)); qf[5] = __builtin_bit_cast(bf16x8, pack8(a5)); } }
            f32x16 o0 = {}, o1 = {}, negm = {}; float m = 0.f, l = 0.f;
            u32x4 ak[3], av[2];
#pragma unroll
            for (int i = 0; i < 3; ++i) ak[i] = *(const u32x4*)(Kg + kg[i]);
#pragma unroll
            for (int i = 0; i < 2; ++i) av[i] = *(const u32x4*)(Vg + vg[i]);
            asm volatile("" : "+v"(qf[0]), "+v"(qf[1]), "+v"(qf[2]), "+v"(qf[3]), "+v"(qf[4]), "+v"(qf[5]));
            LDS_BAR();
#pragma unroll
            for (int i = 0; i < 3; ++i) *(LAS u32x4*)(lds + kl[i]) = ak[i];
#pragma unroll
            for (int i = 0; i < 2; ++i) *(LAS u32x4*)(lds + vl[i]) = av[i];
            LDS_BAR();
            for (int t = 0; t < NT; ++t) {
                LAS unsigned char* bb = lds + (t & 1) * BUF;
                { const int tn = (t + 1 < NT) ? t + 1 : t;
                  const bf16* kgp = Kg + (size_t)tn * 128 * 768; const bf16* vgp = Vg + (size_t)tn * 128 * 512;
#pragma unroll
                  for (int i = 0; i < 3; ++i) ak[i] = *(const u32x4*)(kgp + kg[i]);
#pragma unroll
                  for (int i = 0; i < 2; ++i) av[i] = *(const u32x4*)(vgp + vg[i]); }
#pragma unroll
                for (int sub = 0; sub < 2; ++sub) {
                    const int tt = 2 * t + sub;
                    if (64 * tt <= qw + 31) {
                        LAS unsigned char* kb = bb + sub * SUB; LAS unsigned char* vb = kb + KBYTES;
                        bf16x8 kf0[6], kf1[6];
#pragma unroll
                        for (int s = 0; s < 6; ++s) { kf0[s] = *(const LAS bf16x8*)(kb + kfr + s * 32); kf1[s] = *(const LAS bf16x8*)(kb + kfr + 32 * KST + s * 32); }
                        __builtin_amdgcn_sched_barrier(0);
                        f32x16 p0 = negm, p1 = negm;
#pragma unroll
                        for (int s = 0; s < 6; ++s) { p0 = __builtin_amdgcn_mfma_f32_32x32x16_bf16(kf0[s], qf[s], p0, 0, 0, 0); p1 = __builtin_amdgcn_mfma_f32_32x32x16_bf16(kf1[s], qf[s], p1, 0, 0, 0); }
                        if (64 * tt + 63 > qw) {
                            int hm = hi; asm volatile("" : "+v"(hm));
                            const int qrel = qw + r - 64 * tt - 4 * hm;
#pragma unroll
                            for (int rg = 0; rg < 16; ++rg) { const int kv = (rg & 3) + 8 * (rg >> 2); if (kv > qrel) p0[rg] = -INFINITY; if (kv + 32 > qrel) p1[rg] = -INFINITY; }
                        }
                        float mx;
                        { float a = max3f(p0[0], p0[1], p1[0]), b2 = max3f(p0[2], p0[3], p1[1]); a = max3f(a, p1[2], p1[3]);
#pragma unroll
                          for (int rg = 4; rg < 16; rg += 4) { a = max3f(a, p0[rg], p0[rg + 1]); b2 = max3f(b2, p0[rg + 2], p0[rg + 3]); a = max3f(a, p1[rg], p1[rg + 1]); b2 = max3f(b2, p1[rg + 2], p1[rg + 3]); }
                          mx = xhalf_max(max2f(a, b2)); }
                        if (!__all(mx <= 8.0f)) {
                            const float dl = max2f(mx, 0.f), f = __builtin_amdgcn_exp2f(-dl); m += dl; l *= f;
#pragma unroll
                            for (int rg = 0; rg < 16; ++rg) { p0[rg] -= dl; p1[rg] -= dl; o0[rg] *= f; o1[rg] *= f; negm[rg] = -m; }
                        }
                        float rs = 0.f;
#pragma unroll
                        for (int rg = 0; rg < 16; ++rg) { p0[rg] = __builtin_amdgcn_exp2f(p0[rg]); p1[rg] = __builtin_amdgcn_exp2f(p1[rg]); rs += p0[rg] + p1[rg]; }
                        l += rs;
#pragma unroll
                        for (int hh = 0; hh < 2; ++hh)
#pragma unroll
                            for (int s2 = 0; s2 < 2; ++s2) { const bf16x8 pf = packp(hh == 0 ? p0 : p1, s2);
#pragma unroll
                                for (int db = 0; db < 2; ++db) { LAS unsigned char* vp_ = vb + vtr + (32 * hh + 16 * s2) * VST + db * 64;
                                    const s16x4 lo = __builtin_bit_cast(s16x4, __builtin_amdgcn_ds_read_tr16_b64_v4i16((LAS s16x4*)vp_));
                                    const s16x4 hi4 = __builtin_bit_cast(s16x4, __builtin_amdgcn_ds_read_tr16_b64_v4i16((LAS s16x4*)(vp_ + 8 * VST)));
                                    const bf16x8 vf = (bf16x8){lo[0], lo[1], lo[2], lo[3], hi4[0], hi4[1], hi4[2], hi4[3]};
                                    if (db == 0) o0 = __builtin_amdgcn_mfma_f32_32x32x16_bf16(vf, pf, o0, 0, 0, 0); else o1 = __builtin_amdgcn_mfma_f32_32x32x16_bf16(vf, pf, o1, 0, 0, 0); } }
                    }
                }
                { LAS unsigned char* nb = lds + ((t + 1) & 1) * BUF;
#pragma unroll
                  for (int i = 0; i < 3; ++i) *(LAS u32x4*)(nb + kl[i]) = ak[i];
#pragma unroll
                  for (int i = 0; i < 2; ++i) *(LAS u32x4*)(nb + vl[i]) = av[i]; }
                LDS_BAR();
            }
            const float il = 1.0f / xhalf_sum(l);
            bf16* op = YM + (row0 + qw + r) * YYLD + h * 64 + 4 * hi;
#pragma unroll
            for (int gq = 0; gq < 4; ++gq) { u32x2 w0, w1;
                w0.x = pk2(o0[4 * gq] * il, o0[4 * gq + 1] * il); w0.y = pk2(o0[4 * gq + 2] * il, o0[4 * gq + 3] * il);
                w1.x = pk2(o1[4 * gq] * il, o1[4 * gq + 1] * il); w1.y = pk2(o1[4 * gq + 2] * il, o1[4 * gq + 3] * il);
                *(u32x2*)(op + 8 * gq) = w0; *(u32x2*)(op + 32 + 8 * gq) = w1; }
        }
    }
    __syncthreads();
}

constexpr int CS_CH = 256, CS_NCH = SEQ / CS_CH;
constexpr int CS_RS = 144;
constexpr int CS_IMG = 16 * CS_RS;
constexpr int CS_WAVE = 8 * CS_IMG + 512;
enum { IM_A = 0, IM_R = 1, IM_B = 2, IM_K = 3, IM_BH = 4, IM_KH = 5, IM_V = 6, IM_G = 7 };
constexpr size_t DO_CSP = 64 * MiB, DO_CSG = 128 * MiB, DO_CSZ = 192 * MiB;
__device__ __forceinline__ int crow8(int q, int hi) { return (q & 3) + 8 * ((q >> 2) & 1) + 4 * hi; }
template <int N> __device__ __forceinline__ float dpp_shr0(float x) { return __builtin_bit_cast(float, __builtin_amdgcn_update_dpp(0, __builtin_bit_cast(int, x), 0x110 + N, 0xf, 0xf, true)); }
__device__ __forceinline__ float rowscan16(float x) { x += dpp_shr0<1>(x); x += dpp_shr0<2>(x); x += dpp_shr0<4>(x); x += dpp_shr0<8>(x); return x; }
__device__ __forceinline__ float xsum_16_32(float v) {
    { auto r = __builtin_amdgcn_permlane16_swap(__float_as_uint(v), __float_as_uint(v), false, false); v = __uint_as_float(r[0]) + __uint_as_float(r[1]); }
    { auto r = __builtin_amdgcn_permlane32_swap(__float_as_uint(v), __float_as_uint(v), false, false); v = __uint_as_float(r[0]) + __uint_as_float(r[1]); }
    return v;
}
__device__ __forceinline__ bf16x8 cs_rowfrag(const LAS unsigned char* rowp, int hi, int ks) {
    const LAS unsigned char* p = rowp + (16 * ks + 4 * hi) * 2; const u32x2 a = *(const LAS u32x2*)p, b = *(const LAS u32x2*)(p + 16);
    return __builtin_bit_cast(bf16x8, (u32x4){a.x, a.y, b.x, b.y});
}
__device__ __forceinline__ bf16x8 cs_trfrag(LAS unsigned char* img, int cb, int lane) {
    const int g4 = lane >> 4, li = lane & 15; LAS unsigned char* p = img + (4 * (g4 >> 1) + (li >> 2)) * CS_RS + (32 * cb + 16 * (g4 & 1) + 4 * (li & 3)) * 2;
    const s16x4 lo = __builtin_bit_cast(s16x4, __builtin_amdgcn_ds_read_tr16_b64_v4i16((LAS s16x4*)p));
    const s16x4 h4 = __builtin_bit_cast(s16x4, __builtin_amdgcn_ds_read_tr16_b64_v4i16((LAS s16x4*)(p + 8 * CS_RS)));
    return (bf16x8){lo[0], lo[1], lo[2], lo[3], h4[0], h4[1], h4[2], h4[3]};
}
__device__ __forceinline__ bf16x8 cs_zero8() { return (bf16x8){0, 0, 0, 0, 0, 0, 0, 0}; }
struct CsIn { const bf16 *ZR, *A, *LW, *G; const float *mu, *k_k, *k_a, *r_k; };
template <bool USE_V, bool WITH_Y>
__device__ __forceinline__ void cs_prep(const CsIn& in, size_t row0, int tok0, int h, LAS unsigned char* wl, int lane) {
    const int t = lane & 15, jq = lane >> 4, tok = tok0 + t; const bool first = tok == 0;
    const size_t g = row0 + tok, gp = row0 + (first ? 0 : tok - 1); const int c0 = h * 64 + 16 * jq;
    LAS float* gct = (LAS float*)(wl + 8 * CS_IMG); LAS float* btt = gct + 64;
    u32x4 Lrc[2], Lrp[2], Lkc[2], Lkp[2], Lav[2], Llw[2], Lvc[2], Lvp[2];
#pragma unroll
    for (int hf = 0; hf < 2; ++hf) { const int cc = c0 + 8 * hf;
        Lkc[hf] = *(const u32x4*)(in.ZR + g * 1792 + 512 + cc); Lkp[hf] = *(const u32x4*)(in.ZR + gp * 1792 + 512 + cc);
        Lrc[hf] = *(const u32x4*)(in.ZR + g * 1792 + cc); Lrp[hf] = *(const u32x4*)(in.ZR + gp * 1792 + cc);
        Lav[hf] = *(const u32x4*)(in.A + g * 512 + cc); Llw[hf] = *(const u32x4*)(in.LW + g * 512 + cc);
        if (USE_V) { Lvc[hf] = *(const u32x4*)(in.ZR + g * 1792 + 1024 + cc); Lvp[hf] = *(const u32x4*)(in.ZR + gp * 1792 + 1024 + cc); }
    }
    float inv;
    { float ss = 0.f;
#pragma unroll
      for (int hf = 0; hf < 2; ++hf) { float kc[8], kp[8]; unpack8(Lkc[hf], kc); unpack8(Lkp[hf], kp);
          const f32x4 m0 = *(const f32x4*)(in.mu + 512 + c0 + 8 * hf), m1 = *(const f32x4*)(in.mu + 512 + c0 + 8 * hf + 4), q0 = *(const f32x4*)(in.k_k + c0 + 8 * hf), q1 = *(const f32x4*)(in.k_k + c0 + 8 * hf + 4);
          const float mm[8] = {m0.x, m0.y, m0.z, m0.w, m1.x, m1.y, m1.z, m1.w}, qq[8] = {q0.x, q0.y, q0.z, q0.w, q1.x, q1.y, q1.z, q1.w};
#pragma unroll
          for (int e = 0; e < 8; ++e) { const float zk = kc[e] + ((first ? 0.f : kp[e]) - kc[e]) * mm[e]; const float kr = zk * qq[e]; ss += kr * kr; } }
      inv = 1.0f / fmaxf(sqrtf(xsum_16_32(ss)), 1e-12f); }
    float btacc = 0.f;
#pragma unroll
    for (int hf = 0; hf < 2; ++hf) {
        const int cc = c0 + 8 * hf;
        u32x4 Lgg = {}; if (WITH_Y) Lgg = *(const u32x4*)(in.G + g * 512 + cc);
        float rc[8], rp[8], kc[8], kp[8], av[8], lw[8];
        unpack8(Lrc[hf], rc); unpack8(Lrp[hf], rp); unpack8(Lkc[hf], kc); unpack8(Lkp[hf], kp); unpack8(Lav[hf], av); unpack8(Llw[hf], lw);
        float mr[8], mk[8], qk[8], qa[8], qr[8];
        { const f32x4 a0 = *(const f32x4*)(in.mu + cc), a1 = *(const f32x4*)(in.mu + cc + 4), b0 = *(const f32x4*)(in.mu + 512 + cc), b1 = *(const f32x4*)(in.mu + 512 + cc + 4);
          const f32x4 c0_ = *(const f32x4*)(in.k_k + cc), c1_ = *(const f32x4*)(in.k_k + cc + 4), d0 = *(const f32x4*)(in.k_a + cc), d1 = *(const f32x4*)(in.k_a + cc + 4);
          mr[0] = a0.x; mr[1] = a0.y; mr[2] = a0.z; mr[3] = a0.w; mr[4] = a1.x; mr[5] = a1.y; mr[6] = a1.z; mr[7] = a1.w;
          mk[0] = b0.x; mk[1] = b0.y; mk[2] = b0.z; mk[3] = b0.w; mk[4] = b1.x; mk[5] = b1.y; mk[6] = b1.z; mk[7] = b1.w;
          qk[0] = c0_.x; qk[1] = c0_.y; qk[2] = c0_.z; qk[3] = c0_.w; qk[4] = c1_.x; qk[5] = c1_.y; qk[6] = c1_.z; qk[7] = c1_.w;
          qa[0] = d0.x; qa[1] = d0.y; qa[2] = d0.z; qa[3] = d0.w; qa[4] = d1.x; qa[5] = d1.y; qa[6] = d1.z; qa[7] = d1.w; }
        if (WITH_Y) { const f32x4 e0 = *(const f32x4*)(in.r_k + cc), e1 = *(const f32x4*)(in.r_k + cc + 4); qr[0] = e0.x; qr[1] = e0.y; qr[2] = e0.z; qr[3] = e0.w; qr[4] = e1.x; qr[5] = e1.y; qr[6] = e1.z; qr[7] = e1.w; }
        float oA[8], oR[8], oB[8], oK[8], oBH[8], oKH[8];
#pragma unroll
        for (int e = 0; e < 8; ++e) {
            const float r = rc[e] + ((first ? 0.f : rp[e]) - rc[e]) * mr[e]; const float zk = kc[e] + ((first ? 0.f : kp[e]) - kc[e]) * mk[e];
            const float kq = zk * (1.f + (av[e] - 1.f) * qa[e]); const float kk = zk * qk[e] * inv; const float b = kk * av[e];
            const float Lg = rowscan16(lw[e]); const float eLg = __builtin_amdgcn_exp2f(1.4426950408889634f * Lg); const float enLg = __builtin_amdgcn_rcpf(eLg);
            const float eLgm = __builtin_bit_cast(float, __builtin_amdgcn_update_dpp(0x3f800000, __builtin_bit_cast(int, eLg), 0x111, 0xf, 0xf, false));
            const float eC = __builtin_bit_cast(float, __builtin_amdgcn_ds_bpermute(((lane & 48) | 15) << 2, __builtin_bit_cast(int, eLg)));
            oA[e] = -kk * eLgm; oR[e] = r * eLg; oB[e] = b * enLg; oK[e] = kq * enLg; oBH[e] = oB[e] * eC; oKH[e] = oK[e] * eC;
            if (WITH_Y) btacc += r * kq * qr[e];
            if (t == 15) gct[16 * jq + 8 * hf + e] = eC;
        }
        const int wo = t * CS_RS + (16 * jq + 8 * hf) * 2;
        *(LAS u32x4*)(wl + IM_A * CS_IMG + wo) = pack8(oA); *(LAS u32x4*)(wl + IM_R * CS_IMG + wo) = pack8(oR); *(LAS u32x4*)(wl + IM_B * CS_IMG + wo) = pack8(oB);
        *(LAS u32x4*)(wl + IM_K * CS_IMG + wo) = pack8(oK); *(LAS u32x4*)(wl + IM_BH * CS_IMG + wo) = pack8(oBH); *(LAS u32x4*)(wl + IM_KH * CS_IMG + wo) = pack8(oKH);
        if (USE_V) { float vc[8], vp[8], o[8]; unpack8(Lvc[hf], vc); unpack8(Lvp[hf], vp);
            const f32x4 a0 = *(const f32x4*)(in.mu + 1024 + cc), a1 = *(const f32x4*)(in.mu + 1024 + cc + 4); const float mv[8] = {a0.x, a0.y, a0.z, a0.w, a1.x, a1.y, a1.z, a1.w};
#pragma unroll
            for (int e = 0; e < 8; ++e) o[e] = vc[e] + ((first ? 0.f : vp[e]) - vc[e]) * mv[e];
            *(LAS u32x4*)(wl + IM_V * CS_IMG + wo) = pack8(o); }
        if (WITH_Y) *(LAS u32x4*)(wl + IM_G * CS_IMG + wo) = Lgg;
    }
    if (WITH_Y) { btacc = xsum_16_32(btacc); if (lane < 16) btt[lane] = btacc; }
}
struct CsFr { bf16x8 fAR[4], aL1, aL2, aL4, aL8, aLkMk, aMb; };
__device__ __forceinline__ void cs_gram(CsFr& fr, LAS unsigned char* wl, int lane) {
    const int hi = lane >> 5, row = lane & 15; const bool up = (lane & 16) != 0;
    const LAS unsigned char* rpAR = wl + (up ? IM_R : IM_A) * CS_IMG + row * CS_RS; const LAS unsigned char* rpBK = wl + (up ? IM_K : IM_B) * CS_IMG + row * CS_RS;
#pragma unroll
    for (int ks = 0; ks < 4; ++ks) fr.fAR[ks] = cs_rowfrag(rpAR, hi, ks);
    f32x16 F1 = {}, F2 = {};
#pragma unroll
    for (int ks = 0; ks < 4; ++ks) { const bf16x8 fBK = cs_rowfrag(rpBK, hi, ks);
        F1 = __builtin_amdgcn_mfma_f32_32x32x16_bf16(fBK, fr.fAR[ks], F1, 0, 0, 0);
        F2 = __builtin_amdgcn_mfma_f32_32x32x16_bf16(fr.fAR[ks], fBK, F2, 0, 0, 0); }
#pragma unroll
    for (int q = 0; q < 8; ++q) { const int s = crow8(q, hi); const bool k1 = up ? (s <= row) : (s < row);
        F1[q] = k1 ? F1[q] : 0.f; F1[8 + q] = k1 ? F1[8 + q] : 0.f; F2[q] = (!up && row < s) ? F2[q] : 0.f; }
    const bf16x8 f1lo = packp(F1, 0);
    fr.aL1 = up ? cs_zero8() : f1lo;
    fr.aMb = up ? f1lo : cs_zero8();
    fr.aLkMk = packp(F1, 1);
    const bf16x8 p2 = packp(F2, 0);
    const f32x16 z16 = {};
    const f32x16 Q1 = __builtin_amdgcn_mfma_f32_32x32x16_bf16(p2, fr.aL1, z16, 0, 0, 0), Q2 = __builtin_amdgcn_mfma_f32_32x32x16_bf16(fr.aL1, p2, z16, 0, 0, 0);
    fr.aL2 = packp(Q1, 0); const bf16x8 p2b = packp(Q2, 0);
    const f32x16 R1 = __builtin_amdgcn_mfma_f32_32x32x16_bf16(p2b, fr.aL2, z16, 0, 0, 0), R2 = __builtin_amdgcn_mfma_f32_32x32x16_bf16(fr.aL2, p2b, z16, 0, 0, 0);
    fr.aL4 = packp(R1, 0); const bf16x8 p2c = packp(R2, 0);
    const f32x16 S1 = __builtin_amdgcn_mfma_f32_32x32x16_bf16(p2c, fr.aL4, z16, 0, 0, 0);
    fr.aL8 = packp(S1, 0);
}
template <bool USE_V, bool WITH_Y>
__device__ __forceinline__ void cs_apply(f32x16 (&Z)[2][2], f32x16 (&D)[2], const CsFr& fr, LAS unsigned char* wl, int lane) {
    const int hi = lane >> 5;
    bf16x8 vf[2];
    if (USE_V) { vf[0] = cs_trfrag(wl + IM_V * CS_IMG, 0, lane); vf[1] = cs_trfrag(wl + IM_V * CS_IMG, 1, lane); }
#pragma unroll
    for (int nb = 0; nb < 2; ++nb) { f32x16 d = {};
#pragma unroll
        for (int jb = 0; jb < 2; ++jb)
#pragma unroll
            for (int k2 = 0; k2 < 2; ++k2) d = __builtin_amdgcn_mfma_f32_32x32x16_bf16(fr.fAR[2 * jb + k2], packp(Z[jb][nb], k2), d, 0, 0, 0);
        if (USE_V) d = __builtin_amdgcn_mfma_f32_32x32x16_bf16(fr.aLkMk, vf[nb], d, 0, 0, 0);
        D[nb] = d; }
#pragma unroll
    for (int nb = 0; nb < 2; ++nb) {
        D[nb] = __builtin_amdgcn_mfma_f32_32x32x16_bf16(fr.aL8, packp(D[nb], 0), D[nb], 0, 0, 0);
        D[nb] = __builtin_amdgcn_mfma_f32_32x32x16_bf16(fr.aL4, packp(D[nb], 0), D[nb], 0, 0, 0);
        D[nb] = __builtin_amdgcn_mfma_f32_32x32x16_bf16(fr.aL2, packp(D[nb], 0), D[nb], 0, 0, 0);
        D[nb] = __builtin_amdgcn_mfma_f32_32x32x16_bf16(fr.aL1, packp(D[nb], 0), D[nb], 0, 0, 0);
    }
    const bf16x8 u0 = packp(D[0], 0), u1 = packp(D[1], 0);
    if (WITH_Y) { D[0] = __builtin_amdgcn_mfma_f32_32x32x16_bf16(fr.aMb, u0, D[0], 0, 0, 0); D[1] = __builtin_amdgcn_mfma_f32_32x32x16_bf16(fr.aMb, u1, D[1], 0, 0, 0); }
    const LAS float* gct = (const LAS float*)(wl + 8 * CS_IMG);
#pragma unroll
    for (int jb = 0; jb < 2; ++jb) {
        const bf16x8 fb = cs_trfrag(wl + IM_BH * CS_IMG, jb, lane); bf16x8 fk = cs_zero8(); if (USE_V) fk = cs_trfrag(wl + IM_KH * CS_IMG, jb, lane);
        float gc[16];
#pragma unroll
        for (int g4 = 0; g4 < 4; ++g4) { const f32x4 x = *(const LAS f32x4*)(gct + 32 * jb + 8 * g4 + 4 * hi); gc[4 * g4] = x.x; gc[4 * g4 + 1] = x.y; gc[4 * g4 + 2] = x.z; gc[4 * g4 + 3] = x.w; }
#pragma unroll
        for (int nb = 0; nb < 2; ++nb) { f32x16 z = Z[jb][nb];
#pragma unroll
            for (int q = 0; q < 16; ++q) z[q] *= gc[q];
            z = __builtin_amdgcn_mfma_f32_32x32x16_bf16(fb, nb == 0 ? u0 : u1, z, 0, 0, 0);
            if (USE_V) z = __builtin_amdgcn_mfma_f32_32x32x16_bf16(fk, vf[nb], z, 0, 0, 0);
            Z[jb][nb] = z; }
    }
}
__device__ __forceinline__ void cs_apply_pk(bf16x8 (&Zp)[2][2][2], f32x16 (&D)[2], const CsFr& fr, LAS unsigned char* wl, int lane) {
    const int hi = lane >> 5;
#pragma unroll
    for (int nb = 0; nb < 2; ++nb) { f32x16 d = {};
#pragma unroll
        for (int jb = 0; jb < 2; ++jb)
#pragma unroll
            for (int k2 = 0; k2 < 2; ++k2) d = __builtin_amdgcn_mfma_f32_32x32x16_bf16(fr.fAR[2 * jb + k2], Zp[jb][nb][k2], d, 0, 0, 0);
        D[nb] = d; }
#pragma unroll
    for (int nb = 0; nb < 2; ++nb) {
        D[nb] = __builtin_amdgcn_mfma_f32_32x32x16_bf16(fr.aL8, packp(D[nb], 0), D[nb], 0, 0, 0);
        D[nb] = __builtin_amdgcn_mfma_f32_32x32x16_bf16(fr.aL4, packp(D[nb], 0), D[nb], 0, 0, 0);
        D[nb] = __builtin_amdgcn_mfma_f32_32x32x16_bf16(fr.aL2, packp(D[nb], 0), D[nb], 0, 0, 0);
        D[nb] = __builtin_amdgcn_mfma_f32_32x32x16_bf16(fr.aL1, packp(D[nb], 0), D[nb], 0, 0, 0);
    }
    const bf16x8 u0 = packp(D[0], 0), u1 = packp(D[1], 0);
    const LAS float* gct = (const LAS float*)(wl + 8 * CS_IMG);
#pragma unroll
    for (int jb = 0; jb < 2; ++jb) {
        const bf16x8 fb = cs_trfrag(wl + IM_BH * CS_IMG, jb, lane);
        float gc[16];
#pragma unroll
        for (int g4 = 0; g4 < 4; ++g4) { const f32x4 x = *(const LAS f32x4*)(gct + 32 * jb + 8 * g4 + 4 * hi); gc[4 * g4] = x.x; gc[4 * g4 + 1] = x.y; gc[4 * g4 + 2] = x.z; gc[4 * g4 + 3] = x.w; }
#pragma unroll
        for (int nb = 0; nb < 2; ++nb) { f32x16 z;
#pragma unroll
            for (int k2 = 0; k2 < 2; ++k2) { float e[8]; unpack8(__builtin_bit_cast(u32x4, Zp[jb][nb][k2]), e);
#pragma unroll
                for (int q = 0; q < 8; ++q) z[8 * k2 + q] = e[q] * gc[8 * k2 + q]; }
            z = __builtin_amdgcn_mfma_f32_32x32x16_bf16(fb, nb == 0 ? u0 : u1, z, 0, 0, 0);
            Zp[jb][nb][0] = packp(z, 0); Zp[jb][nb][1] = packp(z, 1); }
    }
}
template <bool USE_V, bool WITH_Y>
__device__ __forceinline__ void cs_step(f32x16 (&Z)[2][2], f32x16 (&D)[2], LAS unsigned char* wl, int lane) { CsFr fr; cs_gram(fr, wl, lane); cs_apply<USE_V, WITH_Y>(Z, D, fr, wl, lane); }
__device__ __forceinline__ void p_cs_a(const Frame& F, ArgsP a) {
    const int lane = lane_id_fresh();
    LAS unsigned char* wl = F.lds + F.wave * CS_WAVE;
    CsIn in{(const bf16*)(F.ws + WS_ZR), (const bf16*)(F.ws + WS_A), (const bf16*)(F.ws + WS_LW), (const bf16*)(F.dob + DO_G), a->in[I_MU], a->in[I_KK], a->in[I_KA], a->in[I_RK]};
    bf16* Pm = (bf16*)(F.dob + DO_CSP); bf16* Gf = (bf16*)(F.dob + DO_CSG);
    const int hi = lane >> 5;
    for (int uc = F.gw; uc < 64 * CS_NCH; uc += F.NGW) {
        const int bh = uc / CS_NCH, c = uc % CS_NCH, b = bh >> 3, h = bh & 7; const size_t row0 = (size_t)b * SEQ;
        f32x16 ZG[2][2], D[2]; bf16x8 ZP[2][2][2];
#pragma unroll
        for (int jb = 0; jb < 2; ++jb)
#pragma unroll
            for (int nb = 0; nb < 2; ++nb) { f32x16 z = {}; ZG[jb][nb] = z;
                if (jb == nb) {
#pragma unroll
                    for (int q = 0; q < 16; ++q) z[q] = (crow(q, hi) == (lane & 31)) ? 1.f : 0.f; }
                ZP[jb][nb][0] = packp(z, 0); ZP[jb][nb][1] = packp(z, 1); }
        for (int sc = 0; sc < CS_CH / 16; ++sc) { int ln = lane; asm volatile("" : "+v"(ln));
            cs_prep<true, false>(in, row0, c * CS_CH + sc * 16, h, wl, ln); asm volatile("s_waitcnt lgkmcnt(0)" ::: "memory");
            CsFr fr; cs_gram(fr, wl, ln);
            cs_apply_pk(ZP, D, fr, wl, ln); cs_apply<true, false>(ZG, D, fr, wl, ln); asm volatile("s_waitcnt lgkmcnt(0)" ::: "memory"); }
        int lo_ = lane; asm volatile("" : "+v"(lo_)); const int hi_o = lo_ >> 5;
        {
            LAS unsigned short* tb = (LAS unsigned short*)(wl + 4 * hi_o * CS_RS + (lo_ & 31) * 2);
#pragma unroll
            for (int jb = 0; jb < 2; ++jb)
#pragma unroll
                for (int nb = 0; nb < 2; ++nb)
#pragma unroll
                    for (int q = 0; q < 16; ++q) tb[((32 * jb + (q & 3) + 8 * (q >> 2)) * CS_RS + 64 * nb) / 2] = (unsigned short)ZP[jb][nb][q >> 3][q & 7];
            bf16* dst = Pm + (size_t)uc * 4096;
#pragma unroll
            for (int i = 0; i < 8; ++i) { const int ch = lo_ + 64 * i, rr = ch >> 3, c8 = (ch & 7) * 8; *(u32x4*)(dst + rr * 64 + c8) = *(const LAS u32x4*)(wl + rr * CS_RS + c8 * 2); }
            asm volatile("s_waitcnt lgkmcnt(0)" ::: "memory");
        }
        {
            bf16* dst = Gf + (size_t)uc * 4096;
#pragma unroll
            for (int jb = 0; jb < 2; ++jb)
#pragma unroll
                for (int nb = 0; nb < 2; ++nb) { u32x4 w0, w1; const f32x16& z = ZG[jb][nb];
                    w0.x = pk2(z[0], z[1]); w0.y = pk2(z[2], z[3]); w0.z = pk2(z[4], z[5]); w0.w = pk2(z[6], z[7]); w1.x = pk2(z[8], z[9]); w1.y = pk2(z[10], z[11]); w1.z = pk2(z[12], z[13]); w1.w = pk2(z[14], z[15]);
                    u32x4* p = (u32x4*)(dst + ((jb * 2 + nb) * 64 + lo_) * 16); p[0] = w0; p[1] = w1; }
        }
    }
}
struct CsB { u32x2 p[2][2][2][2]; u32x4 g[2][2]; };
__device__ __forceinline__ void csb_load(CsB& X, const bf16* Pm, const bf16* Gf, size_t uc, int nb, int lane) {
    const int hi = lane >> 5, r = lane & 31; const bf16* Pc = Pm + uc * 4096;
#pragma unroll
    for (int mb = 0; mb < 2; ++mb) {
#pragma unroll
        for (int jb = 0; jb < 2; ++jb)
#pragma unroll
            for (int k2 = 0; k2 < 2; ++k2) { const bf16* pr = Pc + (32 * mb + r) * 64 + 32 * jb + 16 * k2 + 4 * hi; X.p[mb][jb][k2][0] = *(const u32x2*)pr; X.p[mb][jb][k2][1] = *(const u32x2*)(pr + 8); }
        const u32x4* gp = (const u32x4*)(Gf + uc * 4096 + ((mb * 2 + nb) * 64 + lane) * 16); X.g[mb][0] = gp[0]; X.g[mb][1] = gp[1]; }
}
__device__ __forceinline__ void csb_step(f32x16 (&Z)[2], const CsB& X, bf16* Zf, size_t uc, int nb, int lane) {
#pragma unroll
    for (int jb = 0; jb < 2; ++jb) { u32x4 w0, w1; const f32x16& z = Z[jb];
        w0.x = pk2(z[0], z[1]); w0.y = pk2(z[2], z[3]); w0.z = pk2(z[4], z[5]); w0.w = pk2(z[6], z[7]); w1.x = pk2(z[8], z[9]); w1.y = pk2(z[10], z[11]); w1.z = pk2(z[12], z[13]); w1.w = pk2(z[14], z[15]);
        u32x4* p = (u32x4*)(Zf + uc * 4096 + ((jb * 2 + nb) * 64 + lane) * 16); p[0] = w0; p[1] = w1; }
    f32x16 N[2];
#pragma unroll
    for (int mb = 0; mb < 2; ++mb) { float g0[8], g1[8]; unpack8(X.g[mb][0], g0); unpack8(X.g[mb][1], g1);
#pragma unroll
        for (int q = 0; q < 8; ++q) { N[mb][q] = g0[q]; N[mb][8 + q] = g1[q]; } }
#pragma unroll
    for (int jb = 0; jb < 2; ++jb)
#pragma unroll
        for (int k2 = 0; k2 < 2; ++k2) { const bf16x8 zb = packp(Z[jb], k2);
#pragma unroll
            for (int mb = 0; mb < 2; ++mb) { const u32x2 x0 = X.p[mb][jb][k2][0], x1 = X.p[mb][jb][k2][1];
                N[mb] = __builtin_amdgcn_mfma_f32_32x32x16_bf16(__builtin_bit_cast(bf16x8, (u32x4){x0.x, x0.y, x1.x, x1.y}), zb, N[mb], 0, 0, 0); } }
    Z[0] = N[0]; Z[1] = N[1];
}
__device__ __forceinline__ void p_cs_b(const Frame& F) {
    const int lane = lane_id_fresh();
    const bf16* Pm = (const bf16*)(F.dob + DO_CSP); const bf16* Gf = (const bf16*)(F.dob + DO_CSG); bf16* Zf = (bf16*)(F.dob + DO_CSZ);
    for (int u16 = F.gw; u16 < 128 * 16; u16 += F.NGW) {
        if (u16 & 15) continue;
        const int u = u16 >> 4, bh = u >> 1, nb = u & 1; const size_t uc0 = (size_t)bh * CS_NCH;
        f32x16 Z[2] = {};
        CsB X0, X1, X2;
        csb_load(X0, Pm, Gf, uc0, nb, lane); csb_load(X1, Pm, Gf, uc0 + 1, nb, lane);
#define CSB_CL(c_) (uc0 + ((c_) < CS_NCH ? (c_) : CS_NCH - 1))
        int c = 0;
        for (; c + 2 < CS_NCH; c += 3) {
            csb_load(X2, Pm, Gf, CSB_CL(c + 2), nb, lane); csb_step(Z, X0, Zf, uc0 + c, nb, lane);
            csb_load(X0, Pm, Gf, CSB_CL(c + 3), nb, lane); csb_step(Z, X1, Zf, uc0 + c + 1, nb, lane);
            csb_load(X1, Pm, Gf, CSB_CL(c + 4), nb, lane); csb_step(Z, X2, Zf, uc0 + c + 2, nb, lane);
        }
        if (c < CS_NCH) { csb_step(Z, X0, Zf, uc0 + c, nb, lane); ++c; }
        if (c < CS_NCH) { csb_step(Z, X1, Zf, uc0 + c, nb, lane); ++c; }
#undef CSB_CL
    }
}
__device__ __forceinline__ void p_cs_c(const Frame& F, ArgsP a) {
    const int lane = lane_id_fresh(), hi = lane >> 5;
    LAS unsigned char* wl = F.lds + F.wave * CS_WAVE;
    CsIn in{(const bf16*)(F.ws + WS_ZR), (const bf16*)(F.ws + WS_A), (const bf16*)(F.ws + WS_LW), (const bf16*)(F.dob + DO_G), a->in[I_MU], a->in[I_KK], a->in[I_KA], a->in[I_RK]};
    const bf16* Zf = (const bf16*)(F.dob + DO_CSZ); bf16* Y = (bf16*)(F.ws + WS_Y); const float* lnw = a->in[I_LNW]; const float* lnb = a->in[I_LNB];
    const LAS float* btt = (const LAS float*)(wl + 8 * CS_IMG) + 64;
    for (int uc = F.gw; uc < 64 * CS_NCH; uc += F.NGW) {
        const int bh = uc / CS_NCH, c = uc % CS_NCH, b = bh >> 3, h = bh & 7; const size_t row0 = (size_t)b * SEQ;
        f32x16 Z[2][2], D[2];
        int lu = lane; asm volatile("" : "+v"(lu));
#pragma unroll
        for (int jb = 0; jb < 2; ++jb)
#pragma unroll
            for (int nb = 0; nb < 2; ++nb) { const u32x4* p = (const u32x4*)(Zf + (size_t)uc * 4096 + ((jb * 2 + nb) * 64 + lu) * 16); float g0[8], g1[8]; unpack8(p[0], g0); unpack8(p[1], g1);
#pragma unroll
                for (int q = 0; q < 8; ++q) { Z[jb][nb][q] = g0[q]; Z[jb][nb][8 + q] = g1[q]; } }
        const float lw0 = lnw[h * 64 + (lu & 31)], lw1 = lnw[h * 64 + 32 + (lu & 31)], lb0 = lnb[h * 64 + (lu & 31)], lb1 = lnb[h * 64 + 32 + (lu & 31)];
        for (int sc = 0; sc < CS_CH / 16; ++sc) {
            const int tok0 = c * CS_CH + sc * 16;
            int ln = lane; asm volatile("" : "+v"(ln));
            cs_prep<true, true>(in, row0, tok0, h, wl, ln); asm volatile("s_waitcnt lgkmcnt(0)" ::: "memory");
            cs_step<true, true>(Z, D, wl, ln); asm volatile("s_waitcnt lgkmcnt(0)" ::: "memory");
            const int hl = ln >> 5;
            const bf16x8 v0 = cs_trfrag(wl + IM_V * CS_IMG, 0, ln), v1 = cs_trfrag(wl + IM_V * CS_IMG, 1, ln), g0 = cs_trfrag(wl + IM_G * CS_IMG, 0, ln), g1 = cs_trfrag(wl + IM_G * CS_IMG, 1, ln);
            const f32x4 bta = *(const LAS f32x4*)(btt + 4 * hl), btb = *(const LAS f32x4*)(btt + 8 + 4 * hl); const float bt[8] = {bta.x, bta.y, bta.z, bta.w, btb.x, btb.y, btb.z, btb.w};
#pragma unroll
            for (int q = 0; q < 8; ++q) {
                const float y0 = D[0][8 + q], y1 = D[1][8 + q];
                const float mean = allsum32(y0 + y1) * (1.f / 64.f); const float d0 = y0 - mean, d1 = y1 - mean;
                const float rstd = 1.0f / sqrtf(allsum32(d0 * d0 + d1 * d1) * (1.f / 64.f) + LN_X_EPS);
                const float o0 = (d0 * rstd * lw0 + lb0 + bt[q] * bf2f((unsigned short)v0[q])) * bf2f((unsigned short)g0[q]);
                const float o1 = (d1 * rstd * lw1 + lb1 + bt[q] * bf2f((unsigned short)v1[q])) * bf2f((unsigned short)g1[q]);
                bf16* yp = Y + (row0 + tok0 + crow8(q, hl)) * YYLD + h * 64 + (ln & 31);
                yp[0] = (unsigned short)f2bf(o0); yp[32] = (unsigned short)f2bf(o1);
            }
            asm volatile("s_waitcnt lgkmcnt(0)" ::: "memory");
        }
    }
}

__device__ __forceinline__ void p_ffn_route(const Frame& F, ArgsP a, unsigned* cnt, int* ridxv, f32x2* rwv) {
    const int lane_f = lane_id_fresh(), tid_f = F.wave * 64 + lane_f;
    const bf16* MO = (const bf16*)(F.ws + WS_MO); bf16* H2 = (bf16*)(F.ws + WS_H2); const float* mod = (const float*)(F.ws + WS_MOD); const float* g = a->in[I_GFFN];
    constexpr int RTS = 1028;
    LAS float* wr = (LAS float*)F.lds;
    __syncthreads();
    for (int i = tid_f; i < 1024 * 4; i += NTHR) { const int k = i >> 2, o = i & 3; wr[o * RTS + k] = a->in[I_WRG][i]; }
    for (int i = tid_f; i < 1024 * 32; i += NTHR) { const int k = i >> 5, o = i & 31; wr[(4 + o) * RTS + k] = a->in[I_WRE][i]; }
    __syncthreads();
    LAS float* brl = wr + 36 * RTS;
    if (tid_f < 4) brl[tid_f] = a->in[I_BRG][tid_f]; else if (tid_f < 36) brl[tid_f] = a->in[I_BRE][tid_f - 4];
    const int lane = lane_f;
    LAS unsigned* lcnt = (LAS unsigned*)(F.lds + LDS_MISC + 512);
    if (tid_f < 256) lcnt[tid_f] = 0u;
    __syncthreads();
    int my_e0 = 0, my_e1 = 0; float my_w0 = 0.f, my_w1 = 0.f; int kk_ = 0;
    u32x2 ma[4], mb[4]; f32x4 gsv[4], shv[4]; int bcur = -1;
    { const u32x2* mr = (const u32x2*)(MO + (size_t)F.gw * 1024) + lane;
#pragma unroll
      for (int j = 0; j < 4; ++j) ma[j] = mr[64 * j]; }
#define RT_ROW(CM, NM, m_) do { const int mm = (m_); const int b = mm / SEQ; \
        if (b != bcur) { bcur = b; \
            _Pragma("unroll") for (int j = 0; j < 4; ++j) { const int col = 4 * lane + 256 * j; \
                gsv[j] = *(const f32x4*)(g + col) * (*(const f32x4*)(mod + b * 6144 + 4096 + col) + 1.0f); shv[j] = *(const f32x4*)(mod + b * 6144 + 3072 + col); } \
            asm volatile("s_waitcnt vmcnt(0)" : "+v"(gsv[0]), "+v"(gsv[1]), "+v"(gsv[2]), "+v"(gsv[3]), "+v"(shv[0]), "+v"(shv[1]), "+v"(shv[2]), "+v"(shv[3])); \
            asm volatile("" : "+v"(CM[0]), "+v"(CM[1]), "+v"(CM[2]), "+v"(CM[3])); } \
        { const int mn = (mm + F.NGW < NTOK) ? mm + F.NGW : mm; const u32x2* mr = (const u32x2*)(MO + (size_t)mn * 1024) + lane; \
          _Pragma("unroll") for (int j = 0; j < 4; ++j) NM[j] = mr[64 * j]; } \
        f32x4 v[4]; float s = 0.f; \
        _Pragma("unroll") for (int j = 0; j < 4; ++j) { v[j] = (f32x4){lo2f(CM[j].x), hi2f(CM[j].x), lo2f(CM[j].y), hi2f(CM[j].y)}; \
            s += (v[j].x * v[j].x + v[j].y * v[j].y) + (v[j].z * v[j].z + v[j].w * v[j].w); } \
        const float rstd = 1.0f / sqrtf(wave_sum(s) * (1.f / 1024.f) + EPS); \
        u32x2* o = (u32x2*)(H2 + (size_t)mm * 1024) + lane; \
        _Pragma("unroll") for (int j = 0; j < 4; ++j) { v[j] = v[j] * rstd * gsv[j] + shv[j]; u32x2 w; w.x = pk2(v[j].x, v[j].y); w.y = pk2(v[j].z, v[j].w); o[64 * j] = w; } \
        float lgq[4]; \
        _Pragma("unroll") for (int oo = 0; oo < 4; ++oo) { float p = 0.f; \
            _Pragma("unroll") for (int j = 0; j < 4; ++j) { const f32x4 w4 = *(const LAS f32x4*)(wr + oo * RTS + 4 * lane + 256 * j); p += (v[j].x * w4.x + v[j].y * w4.y) + (v[j].z * w4.z + v[j].w * w4.w); } \
            lgq[oo] = wave_sum(p) + brl[oo]; } \
        int gi = 0; float gmx = lgq[0]; \
        _Pragma("unroll") for (int i = 1; i < 4; ++i) { if (lgq[i] > gmx) { gmx = lgq[i]; gi = i; } } \
        float gsum = 0.f; \
        _Pragma("unroll") for (int i = 0; i < 4; ++i) gsum += __expf(lgq[i] - gmx); \
        const float pg = 1.f / gsum; \
        gi = __builtin_amdgcn_readfirstlane(gi); \
        float el[8]; \
        { const LAS float* wg = wr + (4 + gi * 8) * RTS + 4 * lane; \
          _Pragma("unroll") for (int i = 0; i < 8; ++i) { float p = 0.f; \
              _Pragma("unroll") for (int j = 0; j < 4; ++j) { const f32x4 w4 = *(const LAS f32x4*)(wg + i * RTS + 256 * j); p += (v[j].x * w4.x + v[j].y * w4.y) + (v[j].z * w4.z + v[j].w * w4.w); } \
              el[i] = wave_sum(p) + brl[4 + gi * 8 + i]; } } \
        int i0 = 0; float m0 = el[0]; \
        _Pragma("unroll") for (int i = 1; i < 8; ++i) if (el[i] > m0) { m0 = el[i]; i0 = i; } \
        int i1 = -1; float m1 = -INFINITY; \
        _Pragma("unroll") for (int i = 0; i < 8; ++i) if (i != i0 && el[i] > m1) { m1 = el[i]; i1 = i; } \
        const float e1 = __expf(m1 - m0), w0 = pg / (1.f + e1), w1 = pg * e1 / (1.f + e1); \
        { const int lo_ = i0 < i1 ? i0 : i1, hi_ = i0 < i1 ? i1 : i0; \
          if (lane == kk_) { my_e0 = gi * 28 + (lo_ * (15 - lo_)) / 2 + (hi_ - lo_ - 1); my_w0 = i0 < i1 ? w0 : w1; my_w1 = i0 < i1 ? w1 : w0; } } \
        ++kk_; } while (0)
    for (int m = F.gw; m < NTOK; m += 2 * F.NGW) {
        RT_ROW(ma, mb, m);
        if (m + F.NGW < NTOK) RT_ROW(mb, ma, m + F.NGW);
    }
#undef RT_ROW
    unsigned lp0 = 0u;
    if (lane < kk_) lp0 = __hip_atomic_fetch_add(lcnt + my_e0, 1u, __ATOMIC_RELAXED, __HIP_MEMORY_SCOPE_WORKGROUP);
    __syncthreads();
    if (tid_f < NCLS) lcnt[128 + tid_f] = __hip_atomic_fetch_add(cnt + tid_f, lcnt[tid_f], __ATOMIC_RELAXED, __HIP_MEMORY_SCOPE_AGENT);
    __syncthreads();
    if (lane < kk_) { const int m = F.gw + lane * F.NGW; const size_t v = (size_t)my_e0 * CLS_CAP + (lcnt[128 + my_e0] + lp0);
        ridxv[v] = m; rwv[v] = (f32x2){my_w0, my_w1}; }
    __syncthreads();
    (void)my_e1;
}
__device__ __forceinline__ int moe_tables(const Frame& F, LAS int* offs, LAS int* texp, LAS int* ccnt) {
    const int lane_f = lane_id_fresh();
    const unsigned* cnt = (const unsigned*)(F.ws + WS_CTL) + CW_CNT;
    __syncthreads();
    if (F.wave == 0) {
        const int c0 = (int)__hip_atomic_load(cnt + lane_f, __ATOMIC_RELAXED, __HIP_MEMORY_SCOPE_AGENT);
        const int c1 = (lane_f < NCLS - 64) ? (int)__hip_atomic_load(cnt + 64 + lane_f, __ATOMIC_RELAXED, __HIP_MEMORY_SCOPE_AGENT) : 0;
        const int n0 = (c0 + 255) >> 8, n1 = (c1 + 255) >> 8; int i0 = n0, i1 = n1;
#pragma unroll
        for (int d = 1; d < 64; d <<= 1) { const int a = __shfl_up(i0, d, 64), b = __shfl_up(i1, d, 64); if (lane_f >= d) { i0 += a; i1 += b; } }
        const int tot0 = __shfl(i0, 63, 64); i1 += tot0;
        const int t0 = i0 - n0, t1 = i1 - n1;
        offs[lane_f] = t0 << 8; ccnt[lane_f] = c0; for (int t = 0; t < n0; ++t) texp[t0 + t] = lane_f;
        if (lane_f < NCLS - 64) { offs[64 + lane_f] = t1 << 8; ccnt[64 + lane_f] = c1; for (int t = 0; t < n1; ++t) texp[t1 + t] = 64 + lane_f; if (lane_f == NCLS - 65) offs[NCLS] = i1 << 8; }
    }
    __syncthreads();
    return __builtin_amdgcn_readfirstlane(offs[NCLS] >> 8);
}
constexpr int NPHASE = 15;
template <int LO, int HI>
__global__ void __launch_bounds__(NTHR, 2) fwd(Args args) {
    extern __shared__ __attribute__((aligned(16))) unsigned char lds_raw[];
    Frame F;
    F.lds = (LAS unsigned char*)lds_raw;
    F.wave = __builtin_amdgcn_readfirstlane((int)threadIdx.x >> 6);
    F.G = gridDim.x; { const int bx = blockIdx.x; F.vcu = (F.G % 8 == 0) ? (bx % 8) * (F.G / 8) + bx / 8 : bx; }
    F.gw = F.vcu * NWAVES + F.wave; F.NGW = F.G * NWAVES;
    F.ws = args.ws; F.dob = (unsigned char*)args.out;
    ArgsP AP = (ArgsP)__builtin_amdgcn_kernarg_segment_ptr();
    volatile LAS unsigned* MISC = (volatile LAS unsigned*)(F.lds + LDS_MISC);
    if (threadIdx.x < 64) MISC[threadIdx.x] = 0u;
    __syncthreads();
    XcdBarrier bar; bar.bar = (unsigned*)(F.ws + WS_CTL) + CW_BAR; bar.x = 0; bar.st = MISC + 8;
#if N_LAUNCH_MODE == 1
    bar = xcd_barrier_post((unsigned*)(F.ws + WS_CTL) + CW_BAR, MISC + 8);
#define GRID_BAR() xcd_barrier(bar)
#else
#define GRID_BAR() do { } while (0)
#endif
#ifndef PROBE_REPEAT
#define PROBE_REPEAT -1
#endif
#define IN(k) (LO <= (k) && (k) < HI)
#define SEAM(k) do { if constexpr (IN(k) && IN((k) + 1)) GRID_BAR(); } while (0)
    const float* mod = (const float*)(F.ws + WS_MOD);

#define PH(k, ...) do { if constexpr (IN(k)) { asm volatile("" : "+s"(AP)); { __VA_ARGS__ } if constexpr (PROBE_REPEAT == (k)) { GRID_BAR(); asm volatile("" : "+s"(AP)); { __VA_ARGS__ } } } } while (0)
    PH(0, p0_prologue(F, AP);); SEAM(0);
    PH(1, p_normmod(F, AP->in[I_X], AP->in[I_GMIX], mod, 0, 1024, (bf16*)(F.ws + WS_H));); SEAM(1);
    PH(2, Gemm g{(const bf16*)(F.ws + WS_H), (const bf16*)(F.ws + WS_WIN), NTOK, N_IN_PAD, 1024}; StaticOrder S; S.init(NTOK, N_IN_PAD, F.G, (int)blockIdx.x);
        EpiZ E{(bf16*)(F.ws + WS_ZR), (bf16*)(F.ws + WS_SG), (bf16*)(F.ws + WS_ZM)}; gemm_phase_any(F.lds, g, S, E, F.wave);); SEAM(2);
    PH(3, p_prep_a(F, AP);); SEAM(3);
    PH(4,
        { Gemm g{(const bf16*)(F.ws + WS_TWA), (const bf16*)(F.ws + WS_WBLK), NTOK, 1024, 128}; StaticOrder S; S.init(NTOK, 1024, F.G, (int)blockIdx.x);
          EpiLora E{(bf16*)(F.ws + WS_LW), (bf16*)(F.ws + WS_A), AP->in[I_W0], AP->in[I_A0]}; gemm_phase_any(F.lds, g, S, E, F.wave); }
        { Gemm g{(const bf16*)(F.ws + WS_SGL), (const bf16*)(F.ws + WS_WG), NTOK, 512, 128}; StaticOrder S; S.init(NTOK, 512, F.G, (int)blockIdx.x);
          EpiPlain E{(bf16*)(F.dob + DO_G), nullptr, 1 << 30, 512, 0}; gemm_phase_any(F.lds, g, S, E, F.wave); }
        { Gemm g{(const bf16*)(F.ws + WS_QA), (const bf16*)(F.ws + WS_WUQ), NTOK, 768, 256}; StaticOrder S; S.init(NTOK, 768, F.G, (int)blockIdx.x);
          EpiPlain E{(bf16*)(F.dob + DO_Q), nullptr, 1 << 30, 768, 0}; gemm_phase_any(F.lds, g, S, E, F.wave); }
        { Gemm g{(const bf16*)(F.ws + WS_KVA), (const bf16*)(F.ws + WS_WUKV), NTOK, 1024, 128}; StaticOrder S; S.init(NTOK, 1024, F.G, (int)blockIdx.x);
          EpiPlain E{(bf16*)(F.dob + DO_KN), (bf16*)(F.ws + WS_VC), 512, 512, 512}; gemm_phase_any(F.lds, g, S, E, F.wave); }
    ); SEAM(4);
    PH(5, p_prep_c(F, AP);); SEAM(5);
#if ENG_ATTN == 1
    PH(6, p_attn_mfma(F, AP->in[I_QN]);); SEAM(6);
#else
    PH(6, p_attn_naive(F);); SEAM(6);
#endif
    PH(7, p_cs_a(F, AP);); SEAM(7);
    PH(8, p_cs_b(F);); SEAM(8);
    PH(9, p_cs_c(F, AP);); SEAM(9);
    PH(10, Gemm g{(const bf16*)(F.ws + WS_Y), (const bf16*)(F.ws + WS_WB), NTOK, 1024, 1024}; StaticOrder S; S.init(NTOK, 1024, F.G, (int)blockIdx.x);
        EpiBranch2 E{(bf16*)(F.ws + WS_MG), (const bf16*)(F.ws + WS_SG)}; gemm_phase_mid(F.lds, g, S, E, F.wave);); SEAM(10);
    PH(11, Gemm g{(const bf16*)(F.ws + WS_MG), (const bf16*)(F.ws + WS_WO), NTOK, 1024, 1024}; StaticOrder S; S.init(NTOK, 1024, F.G, (int)blockIdx.x);
        EpiX1 E{(bf16*)(F.ws + WS_MO), AP->in[I_X], mod}; gemm_phase_any(F.lds, g, S, E, F.wave);); SEAM(11);
    if constexpr (IN(12)) { asm volatile("" : "+s"(AP)); p_ffn_route(F, AP, (unsigned*)(F.ws + WS_CTL) + CW_CNT, (int*)(F.ws + WS_RIDXV), (f32x2*)(F.ws + WS_RWV)); } SEAM(12);
#define MOE_TABLES() LAS int* offs = (LAS int*)(F.lds + LDS_MISC + 1024); LAS int* ccnt = (LAS int*)(F.lds + LDS_MISC + 1536); LAS int* texp = (LAS int*)(F.lds + LDS_MISC + 2048); const int nt = moe_tables(F, offs, texp, ccnt)
    PH(13, MOE_TABLES();
        Gemm g{(const bf16*)(F.ws + WS_H2), (const bf16*)(F.ws + WS_WGU), MPAD2, 1024, 1024, (const int*)(F.ws + WS_RIDXV)}; PairOrderGU S{texp, offs, ccnt, nt, F.G, (int)blockIdx.x};
        EpiGateUp2 E{(bf16*)(F.ws + WS_HID2), (const float*)(F.ws + WS_RWV)}; gemm_phase_gather(F.lds, g, S, E, F.wave);); SEAM(13);
    PH(14, MOE_TABLES();
        Gemm g{(const bf16*)(F.ws + WS_HID2), (const bf16*)(F.ws + WS_WDN), MPAD2, 1024, 512, nullptr, 256}; PairOrderDown S{texp, offs, ccnt, nt, F.G, (int)blockIdx.x};
        EpiDown2 E{(float*)F.dob, (const bf16*)(F.ws + WS_MO), mod, (const int*)(F.ws + WS_RIDXV)}; gemm_phase_bseg(F.lds, g, S, E, F.wave););
#undef MOE_TABLES
}

#if N_LAUNCH_MODE == 1
static bool set_attrs() { return hipFuncSetAttribute((const void*)fwd<0, NPHASE>, hipFuncAttributeMaxDynamicSharedMemorySize, LDS_BYTES) == hipSuccess; }
#else
template <int P> static bool set_attr_all() { if constexpr (P < NPHASE) { return hipFuncSetAttribute((const void*)fwd<P, P + 1>, hipFuncAttributeMaxDynamicSharedMemorySize, LDS_BYTES) == hipSuccess && set_attr_all<P + 1>(); } else return true; }
static bool set_attrs() { return set_attr_all<0>(); }
template <int P> static void launch_all(int grid, hipStream_t stream, const Args& a) { if constexpr (P < NPHASE) { hipLaunchKernelGGL((fwd<P, P + 1>), dim3(grid), dim3(NTHR), LDS_BYTES, stream, a); launch_all<P + 1>(grid, stream, a); } }
#endif
extern "C" void kernel_launch(void* const* d_in, const int* in_sizes, int n_in, void* d_out, int out_size, void* d_ws, size_t ws_size, hipStream_t stream) {
    static int grid = 0;
    if (grid == 0) {
        if (n_in != 34 || out_size != NTOK * DM || ws_size < WS_END) { fprintf(stderr, "kernel_launch: unexpected shapes (n_in %d out %d ws %zu)\n", n_in, out_size, ws_size); grid = -1; return; }
        int dev = 0, cus = 0;
        if (hipGetDevice(&dev) != hipSuccess || hipDeviceGetAttribute(&cus, hipDeviceAttributeMultiprocessorCount, dev) != hipSuccess) { grid = -1; return; }
        if (!set_attrs()) { fprintf(stderr, "kernel_launch: hipFuncSetAttribute failed\n"); grid = -1; return; }
        grid = cus;
    }
    if (grid < 0) return;
    (void)hipMemsetAsync((char*)d_ws + WS_CTL, 0, CTL_ZERO_BYTES, stream);
    Args a{};
    for (int i = 0; i < 34; ++i) a.in[i] = (const float*)d_in[i];
    a.out = (float*)d_out; a.ws = (unsigned char*)d_ws;
    a.ph_lo = 0; a.ph_hi = NPHASE;
#if N_LAUNCH_MODE == 1
    hipLaunchKernelGGL((fwd<0, NPHASE>), dim3(grid), dim3(NTHR), LDS_BYTES, stream, a);
#else
    launch_all<0>(grid, stream, a);
#endif
}
```

```cpp
#include <hip/hip_runtime.h>
#include <cstdio>
#include <cstdint>

#ifndef N_LAUNCH_MODE
#define N_LAUNCH_MODE 1
#endif
#ifndef ENG_GEMM
#define ENG_GEMM 1
#endif
#ifndef ENG_ATTN
#define ENG_ATTN 1
#endif

#define GAS __attribute__((address_space(1)))
#define LAS __attribute__((address_space(3)))
typedef unsigned short bf16;
typedef float f32x4 __attribute__((ext_vector_type(4)));
typedef float f32x2 __attribute__((ext_vector_type(2)));
typedef unsigned u32x4 __attribute__((ext_vector_type(4)));
typedef unsigned u32x2 __attribute__((ext_vector_type(2)));
typedef short bf16x8 __attribute__((ext_vector_type(8)));

constexpr int BATCH = 8, SEQ = 8192, DM = 1024, NTOK = BATCH * SEQ;
constexpr int D_RWKV = 512, RWKV_COLS = 1792, MLA_COLS = 416, D_IN = 4256, N_IN_PAD = 4352;
constexpr int NH = 8, QKD = 96, NOPE = 64, ROPE = 32, VD = 64;
constexpr int NEXP = 32, DEXP = 256;
constexpr int NCLS = 112, MPAD2 = 94208;
constexpr int MPAD = 139264;
constexpr float EPS = 1e-6f, LN_X_EPS = 64e-5f;
constexpr float QSCALE = 0.10206207261596577f * 1.4426950408889634f;

constexpr size_t MiB = 1u << 20;
constexpr size_t WS_CTL = 0, CTL_ZERO_BYTES = 1 * MiB;
constexpr size_t WS_MOD = 1 * MiB;
constexpr size_t WS_ROUTE = 2 * MiB;
constexpr size_t WS_CS = 4 * MiB;
constexpr size_t WS_ENT = 12 * MiB;
constexpr size_t WS_WIN = 16 * MiB;
constexpr size_t WS_WBLK = 25 * MiB;
constexpr size_t WS_WG = WS_WBLK + 256 * 1024;
constexpr size_t WS_WUQ = WS_WG + 128 * 1024;
constexpr size_t WS_WUKV = WS_WUQ + 384 * 1024;
constexpr size_t WS_WB = 26 * MiB;
constexpr size_t WS_WO = 28 * MiB;
constexpr size_t WS_WGU = 30 * MiB;
constexpr size_t WS_WDN = 62 * MiB;
constexpr size_t WS_SG = 80 * MiB;
constexpr size_t WS_H2 = 80 * MiB;
constexpr size_t WS_ZR = 336 * MiB;
constexpr size_t WS_VC = 816 * MiB;
constexpr size_t WS_KC = 880 * MiB;
constexpr size_t WS_Y = 560 * MiB;
constexpr size_t WS_XG = 336 * MiB;
constexpr size_t WS_ZM = 560 * MiB;
constexpr size_t WS_YM = 560 * MiB + 1024;
constexpr size_t WS_H = 688 * MiB;
constexpr size_t WS_LW = 688 * MiB;
constexpr size_t WS_A = 752 * MiB;
constexpr size_t WS_MG = 688 * MiB;
constexpr size_t WS_HID2 = 208 * MiB;
constexpr int CLS_CAP = 65536;
constexpr size_t WS_RIDXV = 336 * MiB;
constexpr size_t WS_RWV = 368 * MiB;
constexpr size_t WS_RW = 13 * MiB;
constexpr size_t WS_HID = 208 * MiB;
constexpr size_t WS_R = 752 * MiB;
constexpr size_t WS_V = 816 * MiB;
constexpr size_t WS_ZK = 880 * MiB;
constexpr size_t WS_TWA = 944 * MiB;
constexpr size_t WS_SGL = 960 * MiB;
constexpr size_t WS_QA = 976 * MiB;
constexpr size_t WS_KVA = 1008 * MiB;
constexpr size_t WS_KK = 944 * MiB;
constexpr size_t WS_YS = 752 * MiB;
constexpr size_t WS_MO = 560 * MiB;
constexpr int YYLD = 1024;
constexpr size_t WS_END = 1024 * MiB;
constexpr size_t DO_G = 0;
constexpr size_t DO_Q = 64 * MiB;
constexpr size_t DO_KN = 160 * MiB;

constexpr int CW_CNT = 64;
constexpr int CW_BAR = 4096;

constexpr int NWAVES = 8, NTHR = 512;
constexpr int LDS_BYTES = 155648;
constexpr int LDS_MISC = 151552;

__device__ __forceinline__ int lane_id_fresh() { int l; asm volatile("v_mbcnt_lo_u32_b32 %0, -1, 0\n\tv_mbcnt_hi_u32_b32 %0, -1, %0" : "=v"(l)); return l; }
__device__ __forceinline__ float bf2f(unsigned short h) { return __builtin_bit_cast(float, (unsigned)h << 16); }
__device__ __forceinline__ unsigned f2bf(float f) { unsigned u = __builtin_bit_cast(unsigned, f); return (u + 0x7fffu + ((u >> 16) & 1u)) >> 16; }
typedef __bf16 bf16x2_t __attribute__((ext_vector_type(2)));
__device__ __forceinline__ unsigned pk2(float lo, float hi) { const f32x2 v = {lo, hi}; return __builtin_bit_cast(unsigned, __builtin_convertvector(v, bf16x2_t)); }
__device__ __forceinline__ float lo2f(unsigned w) { return __builtin_bit_cast(float, w << 16); }
__device__ __forceinline__ float hi2f(unsigned w) { return __builtin_bit_cast(float, w & 0xffff0000u); }
template <int CTRL> __device__ __forceinline__ float dpp_add(float x) { return x + __builtin_bit_cast(float, __builtin_amdgcn_update_dpp(0, __builtin_bit_cast(int, x), CTRL, 0xf, 0xf, false)); }
__device__ __forceinline__ float allsum16(float x) { x = dpp_add<0xB1>(x); x = dpp_add<0x4E>(x); x = dpp_add<0x141>(x); x = dpp_add<0x140>(x); return x; }
__device__ __forceinline__ float allsum32(float x) { x = allsum16(x); auto r = __builtin_amdgcn_permlane16_swap(__float_as_uint(x), __float_as_uint(x), false, false); return __uint_as_float(r[0]) + __uint_as_float(r[1]); }
__device__ __forceinline__ float sum8(float x) { x = dpp_add<0xB1>(x); x = dpp_add<0x4E>(x); x = dpp_add<0x141>(x); return x; }
__device__ __forceinline__ float wave_sum(float v) {
    v = allsum16(v);
    { auto r = __builtin_amdgcn_permlane16_swap(__float_as_uint(v), __float_as_uint(v), false, false); v = __uint_as_float(r[0]) + __uint_as_float(r[1]); }
    { auto r = __builtin_amdgcn_permlane32_swap(__float_as_uint(v), __float_as_uint(v), false, false); v = __uint_as_float(r[0]) + __uint_as_float(r[1]); }
    return v;
}
__device__ __forceinline__ float sigmoidf_(float x) { return __builtin_amdgcn_rcpf(1.f + __builtin_amdgcn_exp2f(-1.4426950408889634f * x)); }
__device__ __forceinline__ float tanhf_(float x) { return 1.0f - 2.0f * __builtin_amdgcn_rcpf(1.f + __builtin_amdgcn_exp2f(2.8853900817779268f * x)); }
__device__ __forceinline__ float siluf_(float x) { return x * __builtin_amdgcn_rcpf(1.f + __builtin_amdgcn_exp2f(-1.4426950408889634f * x)); }
__device__ __forceinline__ void unpack8(const u32x4 w, float (&v)[8]) {
    v[0] = lo2f(w.x); v[1] = hi2f(w.x); v[2] = lo2f(w.y); v[3] = hi2f(w.y); v[4] = lo2f(w.z); v[5] = hi2f(w.z); v[6] = lo2f(w.w); v[7] = hi2f(w.w);
}
__device__ __forceinline__ u32x4 pack8(const float (&v)[8]) { u32x4 w; w.x = pk2(v[0], v[1]); w.y = pk2(v[2], v[3]); w.z = pk2(v[4], v[5]); w.w = pk2(v[6], v[7]); return w; }

#define LDS_BAR() do { asm volatile("s_waitcnt lgkmcnt(0)" ::: "memory"); __builtin_amdgcn_s_barrier(); asm volatile("" ::: "memory"); } while (0)

#define XB_TMO      128
#define XB_XCNT(j)  (256  + 64 * (j))
#define XB_XSUB(j)  (1280 + 64 * (j))
#define XB_XGEN(j)  (2304 + 64 * (j))
#define XB_TOP      3328
#define XB_TOPGEN   3392
#define XCD_BAR_WORDS 3456
#define XB_SPIN_CAP (1u << 19)
__device__ __forceinline__ unsigned xb_ld(unsigned* p)              { return __hip_atomic_load(p, __ATOMIC_RELAXED, __HIP_MEMORY_SCOPE_AGENT); }
__device__ __forceinline__ unsigned xb_add(unsigned* p, unsigned v) { return __hip_atomic_fetch_add(p, v, __ATOMIC_RELAXED, __HIP_MEMORY_SCOPE_AGENT); }
__device__ __forceinline__ unsigned xb_xcc_id() { return (unsigned)__builtin_amdgcn_s_getreg((3 << 11) | 20) & 0xFu; }
#define XB_SPIN(cond, bar) do { unsigned _sp = 0; while (cond) { __builtin_amdgcn_s_sleep(1); \
    if ((++_sp & 255u) == 0u) { if (xb_ld(&(bar)[XB_TMO])) break; if (_sp > XB_SPIN_CAP) { atomicAdd(&(bar)[XB_TMO], 1u); break; } } } } while (0)
struct XcdBarrier { unsigned* bar; unsigned x; volatile LAS unsigned* st; };
__device__ __forceinline__ XcdBarrier xcd_barrier_post(unsigned* bar, volatile LAS unsigned* st) {
    XcdBarrier b; b.bar = bar; b.x = xb_xcc_id(); b.st = st;
    if (threadIdx.x == 0) (void)xb_add(&bar[XB_XCNT(b.x)], 1u);
    return b;
}
__device__ __forceinline__ void xcd_barrier_complete(unsigned* bar, unsigned x, unsigned& nloc, unsigned& nx) {
    const unsigned G = gridDim.x * gridDim.y * gridDim.z;
    unsigned sum, cnt, mine, sp = 0u;
    for (;;) {
        sum = 0u; cnt = 0u; mine = 0u;
#pragma unroll
        for (unsigned j = 0; j < 16; ++j) { const unsigned c = xb_ld(&bar[XB_XCNT(j)]); sum += c; cnt += (c > 0u) ? 1u : 0u; mine = (j == x) ? c : mine; }
        if (sum == G) break;
        __builtin_amdgcn_s_sleep(1);
        if ((++sp & 255u) == 0u) { if (xb_ld(&bar[XB_TMO])) break; if (sp > XB_SPIN_CAP) { atomicAdd(&bar[XB_TMO], 1u); break; } }
    }
    nloc = mine > 0u ? mine : 1u; nx = cnt > 0u ? cnt : 1u;
}
__device__ __forceinline__ void xcd_barrier(const XcdBarrier& b) {
    asm volatile("s_waitcnt vmcnt(0)" ::: "memory");
    __syncthreads();
    if (threadIdx.x == 0) {
        unsigned* bar = b.bar;
        __builtin_amdgcn_s_waitcnt(0);
        unsigned nloc = b.st[0], nx = b.st[1];
        if (nloc == 0u) { xcd_barrier_complete(bar, b.x, nloc, nx); b.st[0] = nloc; b.st[1] = nx; }
        const unsigned old = xb_add(&bar[XB_XSUB(b.x)], 1u);
        const unsigned gen = old / nloc;
        if (old + 1u == (gen + 1u) * nloc) {
            __builtin_amdgcn_fence(__ATOMIC_RELEASE, "agent");
            asm volatile("s_waitcnt vmcnt(0)" ::: "memory");
            const unsigned og = xb_add(&bar[XB_TOP], 1u);
            const unsigned tg = og / nx;
            if (og + 1u == (tg + 1u) * nx) xb_add(&bar[XB_TOPGEN], 1u);
            else XB_SPIN(xb_ld(&bar[XB_TOPGEN]) == tg, bar);
            __builtin_amdgcn_fence(__ATOMIC_ACQUIRE, "agent");
            xb_add(&bar[XB_XGEN(b.x)], 1u);
            asm volatile("s_waitcnt vmcnt(0)" ::: "memory");
        } else {
            XB_SPIN(xb_ld(&bar[XB_XGEN(b.x)]) == gen, bar);
            __builtin_amdgcn_fence(__ATOMIC_ACQUIRE, "agent");
            asm volatile("s_waitcnt vmcnt(0)" ::: "memory");
        }
    }
    __syncthreads();
}

struct Args {
    const float* in[34]; float* out; unsigned char* ws; int ph_lo, ph_hi;
};
typedef const __attribute__((address_space(4))) Args* ArgsP;
struct Frame {
    LAS unsigned char* lds;
    int wave, vcu, G, gw, NGW;
    unsigned char* ws; unsigned char* dob;
};
enum { I_X = 0, I_C, I_POS, I_WADA, I_BADA, I_GMIX, I_WIN, I_MU, I_W0, I_WDEC, I_A0, I_WAUP, I_WGUP, I_KK, I_KA, I_RK, I_LNW, I_LNB, I_GQA, I_WUQ, I_GKVA, I_WUKV,
       I_QN, I_KN, I_WBR, I_WOUT, I_GFFN, I_WRG, I_BRG, I_WRE, I_BRE, I_WEG, I_WEU, I_WED };

struct Unit { int pm, pn, aux, vr, nv; };
struct Gemm { const bf16* A; const bf16* Bt; int M, N, K; const int* ridx = nullptr; int ldb = 0; };
constexpr int NXCD = 8, WGM = 8;
struct StaticOrder {
    int nM, nN, nwg, G, c;
    __device__ void init(int M, int N, int G_, int c_) { nM = M / 256; nN = N / 256; nwg = nM * nN; G = G_; c = c_; }
    __device__ bool next(int i, Unit& u) const {
        const long L = (long)i * G + c; if (L >= nwg) return false;
        int wgid = (int)L; { const int q = nwg / NXCD, r = nwg % NXCD, xcd = wgid % NXCD, off = wgid / NXCD; wgid = (xcd < r ? xcd * (q + 1) : r * (q + 1) + (xcd - r) * q) + off; }
        const int nig = WGM * nN, gid = wgid / nig, fm = gid * WGM, gsz = (nM - fm) < WGM ? (nM - fm) : WGM;
        u.pm = fm + ((wgid % nig) % gsz); u.pn = (wgid % nig) / gsz; u.aux = 0; u.vr = 0; u.nv = 256; return true;
    }
    __device__ __forceinline__ void a_ready(const Unit&) const {}
    __device__ __forceinline__ void done(const Unit&) const {}
};
struct TableOrder {
    const LAS int* texp; int ntiles, nN, G, c;
    __device__ bool next(int i, Unit& u) const {
        const long L = (long)i * G + c; if (L >= (long)ntiles * nN) return false;
        const int t = (int)(L / nN), j = (int)(L % nN); u.pm = t; u.pn = texp[t] * nN + j; u.aux = 0; u.vr = 0; u.nv = 256; return true;
    }
    __device__ __forceinline__ void a_ready(const Unit&) const {}
    __device__ __forceinline__ void done(const Unit&) const {}
};

__device__ __forceinline__ void cls_decode(int cls, int& e_lo, int& e_hi) {
    const int gi = cls / 28, idx = cls % 28;
    const int lo = (idx >= 7) + (idx >= 13) + (idx >= 18) + (idx >= 22) + (idx >= 25) + (idx >= 27), base = (lo * (15 - lo)) / 2;
    e_lo = gi * 8 + lo; e_hi = gi * 8 + lo + 1 + (idx - base);
}
struct PairOrderGU {
    const LAS int* texp; const LAS int* offs; const LAS int* ccnt; int ntiles, G, c;
    __device__ bool next(int i, Unit& u) const {
        const int L = i * G + c; if (L >= ntiles * 4) return false;
        const int t = L >> 2, j = L & 3; int el, eh; const int cls = __builtin_amdgcn_readfirstlane(texp[t]); cls_decode(cls, el, eh);
        const int r0 = t * 256 - __builtin_amdgcn_readfirstlane(offs[cls]), left = __builtin_amdgcn_readfirstlane(ccnt[cls]) - r0;
        u.pm = t; u.pn = (j < 2 ? el : eh) * 2 + (j & 1); u.aux = j >> 1; u.vr = cls * CLS_CAP + r0; u.nv = left < 256 ? left : 256; return true;
    }
    __device__ __forceinline__ void a_ready(const Unit&) const {}
    __device__ __forceinline__ void done(const Unit&) const {}
};
struct PairOrderDown {
    const LAS int* texp; const LAS int* offs; const LAS int* ccnt; int ntiles, G, c;
    __device__ bool next(int i, Unit& u) const {
        const int L = i * G + c; if (L >= ntiles * 4) return false;
        const int t = L >> 2, j = L & 3; int el, eh; const int cls = __builtin_amdgcn_readfirstlane(texp[t]); cls_decode(cls, el, eh);
        const int r0 = t * 256 - __builtin_amdgcn_readfirstlane(offs[cls]), left = __builtin_amdgcn_readfirstlane(ccnt[cls]) - r0;
        u.pm = t; u.pn = el * 4 + j; u.aux = eh * 4 + j; u.vr = cls * CLS_CAP + r0; u.nv = left < 256 ? left : 256; return true;
    }
    __device__ __forceinline__ void a_ready(const Unit&) const {}
    __device__ __forceinline__ void done(const Unit&) const {}
};

template <class Epi, class Sched>
__device__ __forceinline__ void gemm_phase_naive(LAS unsigned char* lds, const Gemm g, const Sched& S, const Epi& E) {
    const int tid = (int)__builtin_amdgcn_readfirstlane((int)threadIdx.x >> 6) * 64 + lane_id_fresh(), ty = tid >> 5, tx = tid & 31;
    LAS bf16* As = (LAS bf16*)lds; LAS bf16* Bs = (LAS bf16*)(lds + 128 * 40 * 2);
    Unit u;
    for (int i = 0; S.next(i, u); ++i) {
        for (int half = 0; half < 2; ++half) {
            float acc[8][8];
#pragma unroll
            for (int r = 0; r < 8; ++r)
#pragma unroll
                for (int c = 0; c < 8; ++c) acc[r][c] = 0.f;
            const bf16* Ab = g.A + ((size_t)u.pm * 256 + half * 128) * g.K; const bf16* Bb = g.Bt + (size_t)u.pn * 256 * g.K;
            for (int k0 = 0; k0 < g.K; k0 += 32) {
                __syncthreads();
                { const int r = tid >> 2, c8 = (tid & 3) * 8; *(LAS u32x4*)(As + r * 40 + c8) = *(const u32x4*)(Ab + (size_t)r * g.K + k0 + c8); }
#pragma unroll
                for (int j = 0; j < 2; ++j) { const int ch = tid + j * 512, r = ch >> 2, c8 = (ch & 3) * 8; *(LAS u32x4*)(Bs + r * 40 + c8) = *(const u32x4*)(Bb + (size_t)r * g.K + k0 + c8); }
                __syncthreads();
#pragma unroll 2
                for (int k = 0; k < 32; k += 2) {
                    float b0[8], b1[8];
#pragma unroll
                    for (int c = 0; c < 8; ++c) { const unsigned w = *(const LAS unsigned*)(Bs + (tx * 8 + c) * 40 + k); b0[c] = lo2f(w); b1[c] = hi2f(w); }
#pragma unroll
                    for (int r = 0; r < 8; ++r) { const unsigned w = *(const LAS unsigned*)(As + (ty * 8 + r) * 40 + k); const float a0 = lo2f(w), a1 = hi2f(w);
#pragma unroll
                        for (int c = 0; c < 8; ++c) acc[r][c] = fmaf(a1, b1[c], fmaf(a0, b0[c], acc[r][c])); }
                }
            }
#pragma unroll
            for (int r = 0; r < 8; ++r) E.store8(u, half * 128 + ty * 8 + r, tx * 8, acc[r]);
        }
    }
    __syncthreads();
}

struct EpiZ { bf16 *ZR, *SG, *ZM;
    __device__ __forceinline__ void store8(const Unit& u, int r, int c, const float (&v)[8]) const {
        const size_t row = (size_t)u.pm * 256 + r;
        if (u.pn < 7) { *(u32x4*)(ZR + row * 1792 + u.pn * 256 + c) = pack8(v); }
        else if (u.pn < 15) { __builtin_nontemporal_store(pack8(v), (u32x4*)(SG + row * 2048 + (u.pn - 7) * 256 + c)); }
        else { *(u32x4*)(ZM + row * 512 + (u.pn - 15) * 256 + c) = pack8(v); }
    } };
struct EpiLora { bf16 *LW, *A; const float *w0, *a0;
    __device__ __forceinline__ void store8(const Unit& u, int r, int c, const float (&v)[8]) const {
        const size_t row = (size_t)u.pm * 256 + r; const int col = u.pn * 256 + c; float o[8];
        const bool isw = col < 512; const float* bp = isw ? (w0 + col) : (a0 + col - 512);
        const f32x4 b0 = *(const f32x4*)bp, b1 = *(const f32x4*)(bp + 4); const float bb[8] = {b0.x, b0.y, b0.z, b0.w, b1.x, b1.y, b1.z, b1.w};
#pragma unroll
        for (int i = 0; i < 8; ++i) { const float e = __builtin_amdgcn_exp2f(fminf(-1.4426950408889634f * (bb[i] + v[i]), 120.f)); const float s = __builtin_amdgcn_rcpf(1.0f + e); o[i] = isw ? -0.60653065971263342f * s : s; }
        bf16* dst = isw ? (LW + row * 512 + col) : (A + row * 512 + col - 512);
        *(u32x4*)dst = pack8(o);
    } };
struct EpiPlain { bf16* O0; bf16* O1; int split, ld0, ld1;
    __device__ __forceinline__ void store8(const Unit& u, int r, int c, const float (&v)[8]) const {
        const size_t row = (size_t)u.pm * 256 + r; int col = u.pn * 256 + c;
        if (col < split) *(u32x4*)(O0 + row * ld0 + col) = pack8(v); else *(u32x4*)(O1 + row * ld1 + col - split) = pack8(v);
    } };
struct EpiX1 { bf16* X1; const float* x; const float* mod;
    __device__ __forceinline__ void store8(const Unit& u, int r, int c, const float (&v)[8]) const {
        const size_t row = (size_t)u.pm * 256 + r; const int col = u.pn * 256 + c, b = (int)(row / SEQ); const size_t off = row * 1024 + col;
        const float* gm = mod + b * 6144 + 2048 + col; const f32x4 x0 = *(const f32x4*)(x + off), x1 = *(const f32x4*)(x + off + 4), h0 = *(const f32x4*)gm, h1 = *(const f32x4*)(gm + 4);
        const float o[8] = {x0.x + h0.x * v[0], x0.y + h0.y * v[1], x0.z + h0.z * v[2], x0.w + h0.w * v[3], x1.x + h1.x * v[4], x1.y + h1.y * v[5], x1.z + h1.z * v[6], x1.w + h1.w * v[7]};
        *(u32x4*)(X1 + off) = pack8(o);
    } };
struct EpiBranch2 { bf16* MG; const bf16* SG;
    __device__ __forceinline__ void mid8(const Unit& u, int r, int c, float (&v)[8]) const {
        const size_t row = (size_t)u.pm * 256 + r; const int col = u.pn * 256 + c; float gr[8], gm[8];
        unpack8(*(const u32x4*)(SG + row * 2048 + col), gr); unpack8(*(const u32x4*)(SG + row * 2048 + 1024 + col), gm);
#pragma unroll
        for (int i = 0; i < 8; ++i) v[i] *= (1.f + __builtin_amdgcn_exp2f(-1.4426950408889634f * fmaxf(gm[i], -30.f))) * __builtin_amdgcn_rcpf(1.f + __builtin_amdgcn_exp2f(-1.4426950408889634f * gr[i]));
    }
    __device__ __forceinline__ void store8(const Unit& u, int r, int c, const float (&v)[8]) const {
        const size_t row = (size_t)u.pm * 256 + r; const int col = u.pn * 256 + c; float gm[8], o[8];
        unpack8(*(const u32x4*)(SG + row * 2048 + 1024 + col), gm);
#pragma unroll
        for (int i = 0; i < 8; ++i) o[i] = sigmoidf_(fmaxf(gm[i], -30.f)) * v[i];
        *(u32x4*)(MG + row * 1024 + col) = pack8(o);
    } };
struct EpiGateUp { bf16* HID;
    __device__ __forceinline__ void store8(const Unit& u, int r, int c, const float (&v)[8]) const {
        const size_t row = (size_t)u.pm * 256 + r; const int col = ((u.pn & 1) * 256 + c) >> 1;
        u32x2 w; w.x = pk2(siluf_(v[0]) * v[4], siluf_(v[1]) * v[5]); w.y = pk2(siluf_(v[2]) * v[6], siluf_(v[3]) * v[7]);
        *(u32x2*)(HID + row * 256 + col) = w;
    } };
struct EpiGateUp2 { bf16* HID2; const float* rw;
    __device__ __forceinline__ void store8(const Unit& u, int r, int c, const float (&v)[8]) const {
        const size_t row = (size_t)u.pm * 256 + r; const float w = r < u.nv ? rw[((size_t)u.vr + r) * 2 + u.aux] : 0.f; const int col = u.aux * 256 + (((u.pn & 1) * 256 + c) >> 1);
        u32x2 o; o.x = pk2(w * siluf_(v[0]) * v[4], w * siluf_(v[1]) * v[5]); o.y = pk2(w * siluf_(v[2]) * v[6], w * siluf_(v[3]) * v[7]);
        *(u32x2*)(HID2 + row * 512 + col) = o;
    } };
struct EpiDown2 { float* out; const bf16* X1; const float* mod; const int* ridx;
    __device__ __forceinline__ void store8(const Unit& u, int r, int c, const float (&v)[8]) const {
        if (r >= u.nv) return;
        const int tok = ridx[u.vr + r];
        const int col = (u.pn & 3) * 256 + c, b = tok / SEQ; const size_t off = (size_t)tok * 1024 + col;
        const float* gt = mod + b * 6144 + 5120 + col; const u32x4 xw = *(const u32x4*)(X1 + off); const f32x4 g0 = *(const f32x4*)gt, g1 = *(const f32x4*)(gt + 4);
        f32x4 o0, o1;
        o0.x = lo2f(xw.x) + g0.x * v[0]; o0.y = hi2f(xw.x) + g0.y * v[1]; o0.z = lo2f(xw.y) + g0.z * v[2]; o0.w = hi2f(xw.y) + g0.w * v[3];
        o1.x = lo2f(xw.z) + g1.x * v[4]; o1.y = hi2f(xw.z) + g1.y * v[5]; o1.z = lo2f(xw.w) + g1.z * v[6]; o1.w = hi2f(xw.w) + g1.w * v[7];
        *(f32x4*)(out + off) = o0; *(f32x4*)(out + off + 4) = o1;
    } };
struct EpiDown { bf16* YS;
    __device__ __forceinline__ void store8(const Unit& u, int r, int c, const float (&v)[8]) const {
        const size_t row = (size_t)u.pm * 256 + r; *(u32x4*)(YS + row * 1024 + (u.pn & 3) * 256 + c) = pack8(v);
    } };


namespace pg8 {
#define PG8_LAS __attribute__((address_space(3)))
typedef ::bf16x8 bf16x8; typedef ::f32x4 f32x4;
using ::Unit; using ::Gemm;
constexpr int BM = 256, BK = 64, HALF = 128, HTB = HALF * BK * 2  , STAGE_BYTES = 8 * HTB;

__device__ __forceinline__ int lds_byte(int r, int c) { const int st = (r >> 4) * 2 + (c >> 5), rr = r & 15, cc = c & 31, ob = rr * 64 + cc * 2; return st * 1024 + (ob ^ (((ob >> 9) & 1) << 5)); }
__device__ __forceinline__ void stage_rc(int b, int& R, int& C) { const int st = b / 1024, sb = b % 1024, swz = sb ^ (((sb >> 9) & 1) << 5); R = (st >> 1) * 16 + swz / 64; C = (st & 1) * 32 + (swz % 64) / 2; }
__device__ __forceinline__ int perm32(int rho) { const int n = rho >> 4, i = rho & 15; return 8 * (i >> 2) + 4 * n + (i & 3); }
template <class Epi, class Sched, bool ALIGN_EPI = false, bool SP2 = false, bool GATHER = false, bool MIDHOOK = false, bool BSEG = false>
__device__ __forceinline__ void gemm_phase(PG8_LAS unsigned char* lds, const Gemm g, const Sched& S, const Epi& E, const int wave_in) {
    const int lane = lane_id_fresh(), wid = wave_in, tid = wid * 64 + lane,
              wr = wid >> 2, wc = wid & 3, fr = lane & 15, fq = lane >> 4;
    const int K = g.K, nt = K / BK;
    unsigned voffA[2], voffB[2];
#pragma unroll
    for (int i = 0; i < 2; ++i) { int R, C; stage_rc(tid * 16 + i * 8192, R, C); const int Rb = Epi::PERM ? ((R & ~31) + perm32(R & 31)) : R;
        voffA[i] = (unsigned)(R * K + C) * 2u; voffB[i] = (unsigned)(Rb * (BSEG ? g.ldb : K) + C) * 2u; }
    unsigned vAc[2][2] = {{0u, 0u}, {0u, 0u}}, vAn[2][2] = {{0u, 0u}, {0u, 0u}}; int gR[2] = {0, 0}; unsigned gC[2] = {0u, 0u};
    if constexpr (GATHER) {
#pragma unroll
        for (int i = 0; i < 2; ++i) { int R, C; stage_rc(tid * 16 + i * 8192, R, C); gR[i] = R; gC[i] = (unsigned)C * 2u; } }
#define PG8_GIDX(dst, U_) do { _Pragma("unroll") for (int _h = 0; _h < 2; ++_h) _Pragma("unroll") for (int _i = 0; _i < 2; ++_i) \
        { const int rr_ = _h * HALF + gR[_i]; const int ri_ = rr_ < (U_).nv ? g.ridx[(U_).vr + rr_] : 0; dst[_h][_i] = (unsigned)ri_ * (unsigned)(K * 2) + gC[_i]; } } while (0)
    const size_t kstep = (size_t)(BK * 2);
    const size_t hstep = (size_t)HALF * K * 2;
    const size_t tstep = 2 * hstep;
    const size_t hstepB = BSEG ? (size_t)HALF * g.ldb * 2 : hstep, tstepB = 2 * hstepB; const int nh = nt / 2;
    const unsigned ldsw = (unsigned)wid * 1024u;
    const int aoff = lds_byte(wr * 64 + fr, fq * 8), boff = lds_byte(wc * 32 + fr, fq * 8);
#define PG8_SA(b, h) (((b) * 2 + (h)) * HTB)
#define PG8_SB(b, h) ((4 + (b) * 2 + (h)) * HTB)
#define PG8_STAGE(bufoff, gbase, voff) do { _Pragma("unroll") for (int _i = 0; _i < 2; ++_i) \
        __builtin_amdgcn_global_load_lds((const unsigned*)((const char*)(gbase) + (voff)[_i]), (PG8_LAS unsigned*)(lds + (bufoff) + ldsw + _i * 8192), 16, 0, 0); } while (0)
#define PG8_STAGE_A(bufoff, kptr, h, isnext) do { if constexpr (GATHER) { unsigned _v[2]; _v[0] = (isnext) ? vAn[h][0] : vAc[h][0]; _v[1] = (isnext) ? vAn[h][1] : vAc[h][1]; PG8_STAGE(bufoff, kptr, _v); } \
        else { PG8_STAGE(bufoff, (kptr) + (h) * hstep, voffA); } } while (0)
#define PG8_LDA(dst, b, h) do { _Pragma("unroll") for (int m = 0; m < 4; ++m) _Pragma("unroll") for (int k = 0; k < 2; ++k) dst[m][k] = *(const PG8_LAS bf16x8*)(lds + PG8_SA(b, h) + aoff + m * 2048 + k * 1024); } while (0)
#define PG8_LDB(dst, b, h) do { _Pragma("unroll") for (int n = 0; n < 2; ++n) _Pragma("unroll") for (int k = 0; k < 2; ++k) dst[n][k] = *(const PG8_LAS bf16x8*)(lds + PG8_SB(b, h) + boff + n * 2048 + k * 1024); } while (0)
#define PG8_MMA(ai, bj, At, Bt) do { __builtin_amdgcn_s_setprio(1); _Pragma("unroll") for (int m = 0; m < 4; ++m) _Pragma("unroll") for (int n = 0; n < 2; ++n) _Pragma("unroll") for (int k = 0; k < 2; ++k) \
        acc[ai][bj][m][n] = __builtin_amdgcn_mfma_f32_16x16x32_bf16(Bt[n][k], At[m][k], acc[ai][bj][m][n], 0, 0, 0); __builtin_amdgcn_s_setprio(0); } while (0)
#define PG8_WAIT_V(n) asm volatile("s_waitcnt vmcnt(" #n ")" ::: "memory")
#define PG8_WAIT_L(n) asm volatile("s_waitcnt lgkmcnt(" #n ")" ::: "memory")
#define PG8_BAR __builtin_amdgcn_s_barrier()
#define PG8_SCHED __builtin_amdgcn_sched_barrier(0)
    Unit cur, nxt; int ui = 0;
    if (!S.next(0, cur)) return;
    f32x4 acc[2][2][4][2];
#pragma unroll
    for (int a = 0; a < 2; ++a)
#pragma unroll
        for (int b = 0; b < 2; ++b)
#pragma unroll
            for (int m = 0; m < 4; ++m)
#pragma unroll
                for (int n = 0; n < 2; ++n) acc[a][b][m][n] = (f32x4){0.f, 0.f, 0.f, 0.f};
    bf16x8 At[4][2], B0[2][2], B1[2][2];
    const char* cA = (const char*)g.A + (GATHER ? (size_t)0 : (size_t)cur.pm * tstep); const char* cB = (const char*)g.Bt + (size_t)cur.pn * tstepB; const char* cB2 = (const char*)g.Bt + (size_t)(BSEG ? cur.aux : cur.pn) * tstepB;
    if constexpr (GATHER) PG8_GIDX(vAc, cur);
    S.a_ready(cur);
    if constexpr (SP2) {
        PG8_STAGE(PG8_SB(0, 0), cB, voffB); PG8_STAGE(PG8_SB(0, 1), cB + hstepB, voffB); PG8_STAGE_A(PG8_SA(0, 0), cA, 0, false); PG8_STAGE_A(PG8_SA(0, 1), cA, 1, false);
        if (wr == 1) PG8_BAR;
        PG8_WAIT_V(2); PG8_BAR;
        PG8_STAGE(PG8_SB(1, 0), cB + kstep, voffB); PG8_STAGE_A(PG8_SA(1, 0), cA + kstep, 0, false); PG8_STAGE(PG8_SB(1, 1), cB + hstepB + kstep, voffB);
        PG8_WAIT_V(6); PG8_BAR;
    } else {
        PG8_STAGE(PG8_SB(0, 0), cB, voffB); PG8_STAGE(PG8_SA(0, 0), cA, voffA); PG8_STAGE(PG8_SB(0, 1), cB + hstep, voffB); PG8_STAGE(PG8_SA(0, 1), cA + hstep, voffA);
        if (wr == 1) PG8_BAR;
        PG8_WAIT_V(4); PG8_BAR;
        PG8_STAGE(PG8_SB(1, 0), cB + kstep, voffB); PG8_STAGE(PG8_SA(1, 0), cA + kstep, voffA); PG8_STAGE(PG8_SB(1, 1), cB + hstep + kstep, voffB);
        PG8_WAIT_V(6); PG8_BAR;
    }
    for (;;) {
        const bool has_next = S.next(ui + 1, nxt);
        const char* nA = (has_next && !GATHER) ? (const char*)g.A + (size_t)nxt.pm * tstep : cA; const char* nB = has_next ? (const char*)g.Bt + (size_t)nxt.pn * tstepB : cB; const char* nB2 = (has_next && BSEG) ? (const char*)g.Bt + (size_t)nxt.aux * tstepB : (BSEG ? cB2 : nB);
        if constexpr (GATHER) { if (has_next) PG8_GIDX(vAn, nxt); else { _Pragma("unroll") for (int _h = 0; _h < 2; ++_h) { vAn[_h][0] = vAc[_h][0]; vAn[_h][1] = vAc[_h][1]; } } }
        for (int t = 0; t < nt; t += 2) {
            if constexpr (MIDHOOK) { if (t == nt / 2) { E.mid(acc, cur, wr, wc, fr, fq); PG8_WAIT_V(0); } }
            const bool last = (t == nt - 2);
            const char* a1 = cA + (size_t)(t + 1) * kstep;
            const char* a2 = last ? nA : cA + (size_t)(t + 2) * kstep; const char* b2 = last ? nB : ((BSEG && t + 2 >= nh) ? cB2 + (size_t)(t + 2 - nh) * kstep : cB + (size_t)(t + 2) * kstep);
            const char* a3 = a2 + kstep; const char* b3 = b2 + kstep;
            if (last && has_next) S.a_ready(nxt);
            if constexpr (SP2) {
            PG8_LDB(B0, 0, 0); PG8_LDB(B1, 0, 1); PG8_SCHED; PG8_LDA(At, 0, 0); PG8_STAGE_A(PG8_SA(1, 1), a1, 1, false);
            PG8_WAIT_V(8); PG8_WAIT_L(0); PG8_BAR; PG8_MMA(0, 0, At, B0); PG8_MMA(0, 1, At, B1); PG8_BAR; PG8_SCHED;
            PG8_LDA(At, 0, 1); PG8_STAGE(PG8_SB(0, 0), b2, voffB); PG8_STAGE(PG8_SB(0, 1), b2 + hstepB, voffB); PG8_STAGE_A(PG8_SA(0, 0), a2, 0, last);
            PG8_WAIT_V(8); PG8_WAIT_L(0); PG8_BAR; PG8_MMA(1, 0, At, B0); PG8_MMA(1, 1, At, B1); PG8_BAR; PG8_SCHED;
            PG8_LDB(B0, 1, 0); PG8_LDB(B1, 1, 1); PG8_SCHED; PG8_LDA(At, 1, 0); PG8_STAGE_A(PG8_SA(0, 1), a2, 1, last);
            PG8_WAIT_V(8); PG8_WAIT_L(0); PG8_BAR; PG8_MMA(0, 0, At, B0); PG8_MMA(0, 1, At, B1); PG8_BAR; PG8_SCHED;
            PG8_LDA(At, 1, 1); PG8_STAGE(PG8_SB(1, 0), b3, voffB); PG8_STAGE(PG8_SB(1, 1), b3 + hstepB, voffB); PG8_STAGE_A(PG8_SA(1, 0), a3, 0, last);
            PG8_WAIT_V(8); PG8_WAIT_L(0); PG8_BAR; PG8_MMA(1, 0, At, B0); PG8_MMA(1, 1, At, B1); PG8_BAR; PG8_SCHED;
            } else {
            PG8_LDB(B0, 0, 0); PG8_SCHED; PG8_LDA(At, 0, 0); PG8_STAGE(PG8_SA(1, 1), a1 + hstep, voffA);
            PG8_WAIT_L(8); PG8_BAR; PG8_WAIT_L(0); PG8_MMA(0, 0, At, B0); PG8_BAR; PG8_SCHED;
            PG8_LDB(B1, 0, 1); PG8_STAGE(PG8_SB(0, 0), b2, voffB);
            PG8_BAR; PG8_WAIT_L(0); PG8_MMA(0, 1, At, B1); PG8_BAR;
            PG8_LDA(At, 0, 1); PG8_STAGE(PG8_SA(0, 0), a2, voffA);
            PG8_BAR; PG8_WAIT_L(0); PG8_MMA(1, 0, At, B0); PG8_BAR; PG8_SCHED;
            PG8_STAGE(PG8_SB(0, 1), b2 + hstep, voffB);
            PG8_WAIT_V(6); PG8_BAR; PG8_MMA(1, 1, At, B1); PG8_BAR;
            PG8_LDB(B0, 1, 0); PG8_SCHED; PG8_LDA(At, 1, 0); PG8_STAGE(PG8_SA(0, 1), a2 + hstep, voffA);
            PG8_WAIT_L(8); PG8_BAR; PG8_WAIT_L(0); PG8_MMA(0, 0, At, B0); PG8_BAR; PG8_SCHED;
            PG8_LDB(B1, 1, 1); PG8_STAGE(PG8_SB(1, 0), b3, voffB);
            PG8_BAR; PG8_WAIT_L(0); PG8_MMA(0, 1, At, B1); PG8_BAR;
            PG8_LDA(At, 1, 1); PG8_STAGE(PG8_SA(1, 0), a3, voffA);
            PG8_BAR; PG8_WAIT_L(0); PG8_MMA(1, 0, At, B0); PG8_BAR; PG8_SCHED;
            PG8_STAGE(PG8_SB(1, 1), b3 + hstep, voffB);
            PG8_WAIT_V(6); PG8_BAR; PG8_MMA(1, 1, At, B1); PG8_BAR;
            }
        }
        if constexpr (ALIGN_EPI) { if (wr == 0) PG8_BAR; }
        if constexpr (!Epi::AFTER_DRAIN) { E(acc, cur, wr, wc, fr, fq); S.done(cur); }
        if (!has_next) break;
#pragma unroll
        for (int a = 0; a < 2; ++a)
#pragma unroll
            for (int b = 0; b < 2; ++b)
#pragma unroll
                for (int m = 0; m < 4; ++m)
#pragma unroll
                    for (int n = 0; n < 2; ++n) acc[a][b][m][n] = (f32x4){0.f, 0.f, 0.f, 0.f};
        cur = nxt; cA = nA; cB = nB; cB2 = nB2; ++ui;
        if constexpr (GATHER) { _Pragma("unroll") for (int _h = 0; _h < 2; ++_h) { vAc[_h][0] = vAn[_h][0]; vAc[_h][1] = vAn[_h][1]; } }
        if constexpr (ALIGN_EPI) { if (wr == 1) PG8_BAR; }
    }
    PG8_WAIT_V(0);
    if constexpr (!ALIGN_EPI) { if (wr == 0) PG8_BAR; }
    PG8_BAR;
    if constexpr (Epi::AFTER_DRAIN) { E.fused(acc, cur, wr, wc, fr, fq, lds, wid, lane); S.done(cur); }
#undef PG8_SA
#undef PG8_SB
#undef PG8_STAGE
#undef PG8_STAGE_A
#undef PG8_GIDX
#undef PG8_LDA
#undef PG8_LDB
#undef PG8_MMA
#undef PG8_WAIT_V
#undef PG8_WAIT_L
#undef PG8_BAR
#undef PG8_SCHED
}

template <class F> struct EpiAdapt {
    static constexpr bool PERM = true, AFTER_DRAIN = false; F f;
    __device__ __forceinline__ void mid(f32x4 (&acc)[2][2][4][2], const Unit& u, int wr, int wc, int fr, int fq) const {
        asm volatile("" : "+v"(fr), "+v"(fq));
#pragma unroll
        for (int ai = 0; ai < 2; ++ai)
#pragma unroll
            for (int m = 0; m < 4; ++m) { const int row = ai * HALF + wr * 64 + m * 16 + fr;
#pragma unroll
                for (int bj = 0; bj < 2; ++bj) { float v[8] = {acc[ai][bj][m][0][0], acc[ai][bj][m][0][1], acc[ai][bj][m][0][2], acc[ai][bj][m][0][3], acc[ai][bj][m][1][0], acc[ai][bj][m][1][1], acc[ai][bj][m][1][2], acc[ai][bj][m][1][3]};
                    f.mid8(u, row, bj * HALF + wc * 32 + 8 * fq, v);
                    acc[ai][bj][m][0] = (f32x4){v[0], v[1], v[2], v[3]}; acc[ai][bj][m][1] = (f32x4){v[4], v[5], v[6], v[7]}; } }
    }
    __device__ __forceinline__ void operator()(const f32x4 (&acc)[2][2][4][2], const Unit& u, int wr, int wc, int fr, int fq) const {
        asm volatile("" : "+v"(fr), "+v"(fq));
#pragma unroll
        for (int ai = 0; ai < 2; ++ai)
#pragma unroll
            for (int m = 0; m < 4; ++m) { const int row = ai * HALF + wr * 64 + m * 16 + fr;
#pragma unroll
                for (int bj = 0; bj < 2; ++bj) { const f32x4 v0 = acc[ai][bj][m][0], v1 = acc[ai][bj][m][1];
                    const float v[8] = {v0[0], v0[1], v0[2], v0[3], v1[0], v1[1], v1[2], v1[3]};
                    f.store8(u, row, bj * HALF + wc * 32 + 8 * fq, v); } }
    }
};
}

template <class Epi, class Sched>
__device__ __forceinline__ void gemm_phase_mid(LAS unsigned char* lds, const Gemm g, const Sched& S, const Epi& E, const int wave_in) {
    pg8::EpiAdapt<Epi> EA{E};
    pg8::gemm_phase<pg8::EpiAdapt<Epi>, Sched, true, true, false, true>(lds, g, S, EA, wave_in);
}
template <class Epi, class Sched>
__device__ __forceinline__ void gemm_phase_bseg(LAS unsigned char* lds, const Gemm g, const Sched& S, const Epi& E, const int wave_in) {
    pg8::EpiAdapt<Epi> EA{E};
    pg8::gemm_phase<pg8::EpiAdapt<Epi>, Sched, true, true, false, false, true>(lds, g, S, EA, wave_in);
}
template <class Epi, class Sched>
__device__ __forceinline__ void gemm_phase_gather(LAS unsigned char* lds, const Gemm g, const Sched& S, const Epi& E, const int wave_in) {
    pg8::EpiAdapt<Epi> EA{E};
    pg8::gemm_phase<pg8::EpiAdapt<Epi>, Sched, true, true, true>(lds, g, S, EA, wave_in);
}
template <class Epi, class Sched>
__device__ __forceinline__ void gemm_phase_any(LAS unsigned char* lds, const Gemm g, const Sched& S, const Epi& E, const int wave_in) {
#if ENG_GEMM == 1
    pg8::EpiAdapt<Epi> EA{E};
    pg8::gemm_phase<pg8::EpiAdapt<Epi>, Sched, true, true>(lds, g, S, EA, wave_in);
#else
    gemm_phase_naive<Epi, Sched>(lds, g, S, E);
#endif
}

template <class RowMap>
__device__ __forceinline__ void transpose_item(const float* W, int ldw, bf16* WT, int ldt, int koff, int k0, int n0, const RowMap& rm, LAS float* scr, int lane) {
#pragma unroll 8
    for (int i = 0; i < 32; ++i) { const int kk = 2 * i + (lane >> 5); scr[kk * 33 + (lane & 31)] = W[(size_t)(k0 + kk) * ldw + n0 + (lane & 31)]; }
    asm volatile("s_waitcnt lgkmcnt(0)" ::: "memory");
    const int c = lane & 7;
#pragma unroll
    for (int j = 0; j < 4; ++j) { const int n = (lane >> 3) + 8 * j; const LAS float* s = scr + (8 * c) * 33 + n;
        u32x4 o; o.x = pk2(s[0 * 33], s[1 * 33]); o.y = pk2(s[2 * 33], s[3 * 33]); o.z = pk2(s[4 * 33], s[5 * 33]); o.w = pk2(s[6 * 33], s[7 * 33]);
        *(u32x4*)(WT + (size_t)rm(n0 + n) * ldt + koff + k0 + 8 * c) = o; }
    asm volatile("s_waitcnt lgkmcnt(0)" ::: "memory");
}
struct RmId { int off; __device__ int operator()(int n) const { return off + n; } };
struct RmWin { __device__ int operator()(int n) const { return n < 1792 ? n : (n < 2208 ? 3840 + (n - 1792) : 1792 + (n - 2208)); } };
struct RmUkv { __device__ int operator()(int n) const { const int h = n >> 7, j = n & 127; return j < 64 ? h * 64 + j : 512 + h * 64 + (j - 64); } };
struct RmGU { int off; __device__ int operator()(int j) const { return off + 8 * (j >> 2) + (j & 3); } };

__device__ __forceinline__ void p0_prologue(const Frame& F, ArgsP a) {
    const int lane_f = lane_id_fresh(), tid_f = F.wave * 64 + lane_f;
    LAS float* scr = (LAS float*)(F.lds + F.wave * 16384);
    const int lane = lane_f;
    bf16* Win = (bf16*)(F.ws + WS_WIN); bf16* Wblk = (bf16*)(F.ws + WS_WBLK); bf16* Wg = (bf16*)(F.ws + WS_WG); bf16* Wuq = (bf16*)(F.ws + WS_WUQ);
    bf16* Wukv = (bf16*)(F.ws + WS_WUKV); bf16* Wb = (bf16*)(F.ws + WS_WB); bf16* Wo = (bf16*)(F.ws + WS_WO); bf16* Wgu = (bf16*)(F.ws + WS_WGU); bf16* Wdn = (bf16*)(F.ws + WS_WDN);
    constexpr int I_IN = 16 * 133, I_DEC = 1 * 16, I_AUP = 16, I_GUP = 2 * 16, I_UQ = 4 * 24, I_UKV = 2 * 32, I_BR = 2 * 8 * 32, I_O = 16 * 32;
    constexpr int I_EG = 32 * 16 * 8, I_EU = I_EG, I_ED = 32 * 4 * 32;
    constexpr int NITEMS = I_IN + I_DEC + I_AUP + I_GUP + I_UQ + I_UKV + I_BR + I_O + I_EG + I_EU + I_ED;
    for (int it = F.gw; it < NITEMS; it += F.NGW) {
        int r = it;
        if (r < I_IN) { const int kb = r / 133, nb = r % 133; transpose_item(a->in[I_WIN], D_IN, Win, 1024, 0, 64 * kb, 32 * nb, RmWin{}, scr, lane); continue; } r -= I_IN;
        if (r < I_DEC) { transpose_item(a->in[I_WDEC], 512, Wblk, 128, 0, 0, 32 * r, RmId{0}, scr, lane); continue; } r -= I_DEC;
        if (r < I_AUP) { transpose_item(a->in[I_WAUP], 512, Wblk, 128, 64, 0, 32 * r, RmId{512}, scr, lane); continue; } r -= I_AUP;
        if (r < I_GUP) { const int kb = r / 16, nb = r % 16; transpose_item(a->in[I_WGUP], 512, Wg, 128, 0, 64 * kb, 32 * nb, RmId{0}, scr, lane); continue; } r -= I_GUP;
        if (r < I_UQ) { const int kb = r / 24, nb = r % 24; transpose_item(a->in[I_WUQ], 768, Wuq, 256, 0, 64 * kb, 32 * nb, RmId{0}, scr, lane); continue; } r -= I_UQ;
        if (r < I_UKV) { const int kb = r / 32, nb = r % 32; transpose_item(a->in[I_WUKV], 1024, Wukv, 128, 0, 64 * kb, 32 * nb, RmUkv{}, scr, lane); continue; } r -= I_UKV;
        if (r < I_BR) { const int br = r / 256, q = r % 256, kb = q / 32, nb = q % 32; transpose_item(a->in[I_WBR] + (size_t)br * 512 * 1024, 1024, Wb, 1024, 512 * br, 64 * kb, 32 * nb, RmId{0}, scr, lane); continue; } r -= I_BR;
        if (r < I_O) { const int kb = r / 32, nb = r % 32; transpose_item(a->in[I_WOUT], 1024, Wo, 1024, 0, 64 * kb, 32 * nb, RmId{0}, scr, lane); continue; } r -= I_O;
        if (r < I_EG) { const int e = r / 128, q = r % 128, kb = q / 8, nb = q % 8; transpose_item(a->in[I_WEG] + (size_t)e * 1024 * 256, 256, Wgu + (size_t)e * 512 * 1024, 1024, 0, 64 * kb, 32 * nb, RmGU{0}, scr, lane); continue; } r -= I_EG;
        if (r < I_EU) { const int e = r / 128, q = r % 128, kb = q / 8, nb = q % 8; transpose_item(a->in[I_WEU] + (size_t)e * 1024 * 256, 256, Wgu + (size_t)e * 512 * 1024, 1024, 0, 64 * kb, 32 * nb, RmGU{4}, scr, lane); continue; } r -= I_EU;
        { const int e = r / 128, q = r % 128, kb = q / 32, nb = q % 32; transpose_item(a->in[I_WED] + (size_t)e * 256 * 1024, 1024, Wdn + (size_t)e * 1024 * 256, 256, 0, 64 * kb, 32 * nb, RmId{0}, scr, lane); }
    }
    for (int i = F.gw * 64 + lane; i < 96 * 128; i += F.NGW * 64) *(u32x4*)(Win + (size_t)4256 * 1024 + (size_t)i * 8) = (u32x4){0u, 0u, 0u, 0u};
    for (int i = F.gw * 64 + lane; i < 1024 * 8; i += F.NGW * 64) { const int row = i >> 3, c8 = (i & 7) * 8; *(u32x4*)(Wblk + row * 128 + (row < 512 ? 64 : 0) + c8) = (u32x4){0u, 0u, 0u, 0u}; }
    { const int* pos = (const int*)a->in[I_POS]; float* cs = (float*)(F.ws + WS_CS);
      for (int i = F.gw * 64 + lane; i < NTOK * 16; i += F.NGW * 64) { const int t = i >> 4, j = i & 15;
          const float fr = exp2f(-(float)j * (13.287712379549449f / 16.0f));
          const float ang = (float)pos[t] * fr; cs[t * 32 + j] = cosf(ang); cs[t * 32 + 16 + j] = sinf(ang); } }
    { float* mod = (float*)(F.ws + WS_MOD); const float* c = a->in[I_C]; const float* wa = a->in[I_WADA]; const float* ba = a->in[I_BADA];
      LAS float* red = (LAS float*)(F.lds + 8 * 16384);
      LAS float* sc = (LAS float*)F.lds;
      if (F.vcu < 96) {
          __syncthreads();
          for (int i = tid_f; i < 8192; i += NTHR) sc[i] = siluf_(c[i]);
          __syncthreads();
      }
      for (int nb = F.vcu; nb < 96; nb += F.G) {
          float acc[8];
#pragma unroll
          for (int b = 0; b < 8; ++b) acc[b] = 0.f;
          const int n = nb * 64 + lane;
          for (int k0 = F.wave * 128; k0 < F.wave * 128 + 128; k0 += 16) { float w[16];
#pragma unroll
              for (int kk = 0; kk < 16; ++kk) w[kk] = wa[(size_t)(k0 + kk) * 6144 + n];
#pragma unroll
              for (int kk = 0; kk < 16; ++kk)
#pragma unroll
                  for (int b = 0; b < 8; ++b) acc[b] = fmaf(sc[b * 1024 + k0 + kk], w[kk], acc[b]); }
#pragma unroll
          for (int b = 0; b < 8; ++b) red[(F.wave * 8 + b) * 64 + lane] = acc[b];
          __syncthreads();
          { const int b = F.wave; float s = ba[n];
#pragma unroll
            for (int w = 0; w < 8; ++w) s += red[(w * 8 + b) * 64 + lane];
            mod[b * 6144 + n] = s; }
          __syncthreads();
      } }
}

__device__ __forceinline__ void p_normmod(const Frame& F, const float* x, const float* g, const float* mod, int sh_off, int sc_off, bf16* H) {
    const int lane_f = lane_id_fresh();
    f32x4 xa[4], xb[4];
    { const f32x4* xr = (const f32x4*)(x + (size_t)F.gw * 1024) + lane_f;
#pragma unroll
      for (int j = 0; j < 4; ++j) xa[j] = xr[64 * j]; }
    f32x4 gs[4], sh[4]; int bcur = -1;
#define NM_ROW(CUR, NXT, m_) do { const int mm = (m_); const int b = mm / SEQ; \
        if (b != bcur) { bcur = b; \
            _Pragma("unroll") for (int j = 0; j < 4; ++j) { const int col = 4 * lane_f + 256 * j; gs[j] = *(const f32x4*)(g + col) * (*(const f32x4*)(mod + b * 6144 + sc_off + col) + 1.0f); sh[j] = *(const f32x4*)(mod + b * 6144 + sh_off + col); } \
            asm volatile("s_waitcnt vmcnt(0)" : "+v"(gs[0]), "+v"(gs[1]), "+v"(gs[2]), "+v"(gs[3]), "+v"(sh[0]), "+v"(sh[1]), "+v"(sh[2]), "+v"(sh[3]), "+v"(CUR[0]), "+v"(CUR[1]), "+v"(CUR[2]), "+v"(CUR[3])); } \
        { const int mn = (mm + F.NGW < NTOK) ? mm + F.NGW : mm; const f32x4* xr = (const f32x4*)(x + (size_t)mn * 1024) + lane_f; \
          _Pragma("unroll") for (int j = 0; j < 4; ++j) NXT[j] = xr[64 * j]; } \
        float s = 0.f; \
        _Pragma("unroll") for (int j = 0; j < 4; ++j) s += (CUR[j].x * CUR[j].x + CUR[j].y * CUR[j].y) + (CUR[j].z * CUR[j].z + CUR[j].w * CUR[j].w); \
        const float rstd = 1.0f / sqrtf(wave_sum(s) * (1.f / 1024.f) + EPS); \
        u32x2* o = (u32x2*)(H + (size_t)mm * 1024) + lane_f; \
        _Pragma("unroll") for (int j = 0; j < 4; ++j) { const f32x4 y = CUR[j] * rstd * gs[j] + sh[j]; u32x2 w; w.x = pk2(y.x, y.y); w.y = pk2(y.z, y.w); o[64 * j] = w; } } while (0)
    for (int m = F.gw; m < NTOK; m += 2 * F.NGW) {
        NM_ROW(xa, xb, m);
        if (m + F.NGW < NTOK) NM_ROW(xb, xa, m + F.NGW);
    }
#undef NM_ROW
}

__device__ __forceinline__ void p_prep_a(const Frame& F, ArgsP a) {
    const int lane_f = lane_id_fresh();
    const bf16* ZR = (const bf16*)(F.ws + WS_ZR); const bf16* ZM = (const bf16*)(F.ws + WS_ZM);
    bf16* TWA = (bf16*)(F.ws + WS_TWA); bf16* SGL = (bf16*)(F.ws + WS_SGL); bf16* QA = (bf16*)(F.ws + WS_QA); bf16* KVA = (bf16*)(F.ws + WS_KVA);
    const float* mu = a->in[I_MU]; const float* gqa = a->in[I_GQA]; const float* gkva = a->in[I_GKVA];
    const int lane = lane_f;
    const f32x4 mm = *(const f32x4*)(mu + 1536 + 4 * lane), gq = *(const f32x4*)(gqa + 4 * lane), gk = *(const f32x4*)(gkva + 4 * (lane & 31));
    for (int m0 = F.gw; m0 < NTOK; m0 += 4 * F.NGW) {
        u32x2 cc[4], pp[4], qq[4], kk[4];
#pragma unroll
        for (int u = 0; u < 4; ++u) { const int m = (m0 + u * F.NGW < NTOK) ? m0 + u * F.NGW : m0; const bool first = (m % SEQ) == 0;
            cc[u] = *((const u32x2*)(ZR + (size_t)m * 1792 + 1536) + lane); pp[u] = *((const u32x2*)(ZR + (size_t)(first ? m : m - 1) * 1792 + 1536) + lane);
            qq[u] = *((const u32x2*)(ZM + (size_t)m * 512) + lane); kk[u] = *((const u32x2*)(ZM + (size_t)m * 512 + 256) + (lane & 31)); }
#pragma unroll
        for (int u = 0; u < 4; ++u) { const int m = m0 + u * F.NGW; if (m < NTOK) { const bool first = (m % SEQ) == 0;
            { const u32x2 c = cc[u]; u32x2 p = pp[u]; if (first) { p.x = 0u; p.y = 0u; }
              float z[4] = {lo2f(c.x), hi2f(c.x), lo2f(c.y), hi2f(c.y)}; const float q[4] = {lo2f(p.x), hi2f(p.x), lo2f(p.y), hi2f(p.y)};
              z[0] += (q[0] - z[0]) * mm.x; z[1] += (q[1] - z[1]) * mm.y; z[2] += (q[2] - z[2]) * mm.z; z[3] += (q[3] - z[3]) * mm.w;
              if (lane < 16) { u32x2 w; w.x = pk2(tanhf_(z[0]), tanhf_(z[1])); w.y = pk2(tanhf_(z[2]), tanhf_(z[3])); *((u32x2*)(TWA + (size_t)m * 128) + lane) = w; }
              else if (lane < 32) { u32x2 w; w.x = pk2(z[0], z[1]); w.y = pk2(z[2], z[3]); *((u32x2*)(TWA + (size_t)m * 128) + lane) = w; }
              else { u32x2 w; w.x = pk2(sigmoidf_(z[0]), sigmoidf_(z[1])); w.y = pk2(sigmoidf_(z[2]), sigmoidf_(z[3])); *((u32x2*)(SGL + (size_t)m * 128) + (lane - 32)) = w; } }
            { const u32x2 c = qq[u]; const float z[4] = {lo2f(c.x), hi2f(c.x), lo2f(c.y), hi2f(c.y)};
              u32x2 c2 = kk[u]; if (lane >= 32) { c2.x = 0u; c2.y = 0u; } const float y[4] = {lo2f(c2.x), hi2f(c2.x), lo2f(c2.y), hi2f(c2.y)};
              const float rstd = 1.0f / sqrtf(wave_sum((z[0] * z[0] + z[1] * z[1]) + (z[2] * z[2] + z[3] * z[3])) * (1.f / 256.f) + EPS);
              const float rstd2 = 1.0f / sqrtf(wave_sum((y[0] * y[0] + y[1] * y[1]) + (y[2] * y[2] + y[3] * y[3])) * (1.f / 128.f) + EPS);
              u32x2 w; w.x = pk2(z[0] * rstd * gq.x, z[1] * rstd * gq.y); w.y = pk2(z[2] * rstd * gq.z, z[3] * rstd * gq.w);
              *((u32x2*)(QA + (size_t)m * 256) + lane) = w;
              if (lane < 32) { u32x2 w2; w2.x = pk2(y[0] * rstd2 * gk.x, y[1] * rstd2 * gk.y); w2.y = pk2(y[2] * rstd2 * gk.z, y[3] * rstd2 * gk.w);
                  *((u32x2*)(KVA + (size_t)m * 128) + lane) = w2; } } } }
    }
}

__device__ __forceinline__ void p_prep_c(const Frame& F, ArgsP a) {
    const int lane_f = lane_id_fresh();
    const bf16* KN = (const bf16*)(F.dob + DO_KN); const bf16* ZM = (const bf16*)(F.ws + WS_ZM); bf16* KC = (bf16*)(F.ws + WS_KC);
    const float* cs = (const float*)(F.ws + WS_CS); const float* kn = a->in[I_KN];
    const int lane = lane_f, hd = lane >> 3, j = lane & 7;
    const f32x4 kg0 = *(const f32x4*)(kn + 8 * j), kg1 = *(const f32x4*)(kn + 8 * j + 4); const f32x2 kr1 = *(const f32x2*)(kn + 64 + 2 * j), kr2 = *(const f32x2*)(kn + 80 + 2 * j);
    for (int m0 = F.gw; m0 < NTOK; m0 += 4 * F.NGW) {
        u32x4 kv[4]; unsigned z1[4], z2[4]; f32x2 cc[4], sn[4];
#pragma unroll
        for (int u = 0; u < 4; ++u) { const size_t m = (size_t)((m0 + u * F.NGW < NTOK) ? m0 + u * F.NGW : m0);
            kv[u] = *(const u32x4*)(KN + m * 512 + hd * 64 + 8 * j); z1[u] = *(const unsigned*)(ZM + m * 512 + 384 + 2 * j); z2[u] = *(const unsigned*)(ZM + m * 512 + 400 + 2 * j);
            cc[u] = *(const f32x2*)(cs + m * 32 + 2 * j); sn[u] = *(const f32x2*)(cs + m * 32 + 16 + 2 * j); }
#pragma unroll
        for (int u = 0; u < 4; ++u) { const int m = m0 + u * F.NGW; if (m < NTOK) {
            float v[8]; unpack8(kv[u], v); float x1[2] = {lo2f(z1[u]), hi2f(z1[u])}, x2[2] = {lo2f(z2[u]), hi2f(z2[u])};
            float ss = (x1[0] * x1[0] + x1[1] * x1[1]) + (x2[0] * x2[0] + x2[1] * x2[1]);
#pragma unroll
            for (int i = 0; i < 8; ++i) ss += v[i] * v[i];
            const float rstd = 1.0f / sqrtf(sum8(ss) * (1.f / 96.f) + EPS);
            v[0] *= rstd * kg0.x; v[1] *= rstd * kg0.y; v[2] *= rstd * kg0.z; v[3] *= rstd * kg0.w; v[4] *= rstd * kg1.x; v[5] *= rstd * kg1.y; v[6] *= rstd * kg1.z; v[7] *= rstd * kg1.w;
            x1[0] *= rstd * kr1.x; x1[1] *= rstd * kr1.y; x2[0] *= rstd * kr2.x; x2[1] *= rstd * kr2.y;
            bf16* kp = KC + (size_t)m * 768 + hd * 96;
            *(u32x4*)(kp + 8 * j) = pack8(v); *(unsigned*)(kp + 64 + 2 * j) = pk2(x1[0] * cc[u].x - x2[0] * sn[u].x, x1[1] * cc[u].y - x2[1] * sn[u].y);
            *(unsigned*)(kp + 80 + 2 * j) = pk2(x2[0] * cc[u].x + x1[0] * sn[u].x, x2[1] * cc[u].y + x1[1] * sn[u].y); } }
    }
}

__device__ __forceinline__ void p_attn_naive(const Frame& F) {
    const int lane_f = lane_id_fresh(), tid_f = F.wave * 64 + lane_f;
    const bf16* Q = (const bf16*)(F.dob + DO_Q); const bf16* KC = (const bf16*)(F.ws + WS_KC); const bf16* VC = (const bf16*)(F.ws + WS_VC); bf16* YM = (bf16*)(F.ws + WS_YM);
    LAS float* Ks = (LAS float*)F.lds; LAS float* Vs = (LAS float*)(F.lds + 32 * 96 * 4);
    const int tid = tid_f;
    for (int unit = F.vcu; unit < 64 * 16; unit += F.G) {
        const int bh = unit >> 4, qb = 15 - (unit & 15), b = bh >> 3, h = bh & 7; const size_t row0 = (size_t)b * SEQ; const int t = qb * 512 + tid;
        unsigned qp[48];
        { const u32x4* qg = (const u32x4*)(Q + (row0 + t) * 768 + h * 96);
#pragma unroll
          for (int i = 0; i < 12; ++i) { const u32x4 w = qg[i]; qp[4 * i] = w.x; qp[4 * i + 1] = w.y; qp[4 * i + 2] = w.z; qp[4 * i + 3] = w.w; } }
        float o[64];
#pragma unroll
        for (int i = 0; i < 64; ++i) o[i] = 0.f;
        float mx = -INFINITY, l = 0.f;
        const int nkt = (qb + 1) * 16;
        for (int kt = 0; kt < nkt; ++kt) {
            __syncthreads();
            if (tid < 384) { const int r = tid / 12, c8 = (tid % 12) * 8; float v[8]; unpack8(*(const u32x4*)(KC + (row0 + kt * 32 + r) * 768 + h * 96 + c8), v);
#pragma unroll
                for (int i = 0; i < 8; ++i) Ks[r * 96 + c8 + i] = v[i]; }
            if (tid < 256) { const int r = tid >> 3, c8 = (tid & 7) * 8; float v[8]; unpack8(*(const u32x4*)(VC + (row0 + kt * 32 + r) * 512 + h * 64 + c8), v);
#pragma unroll
                for (int i = 0; i < 8; ++i) Vs[r * 64 + c8 + i] = v[i]; }
            __syncthreads();
            for (int kk = 0; kk < 32; ++kk) {
                const int kv = kt * 32 + kk;
                float s = 0.f; const LAS f32x4* kr = (const LAS f32x4*)(Ks + kk * 96);
#pragma unroll
                for (int i = 0; i < 24; ++i) { const f32x4 k4 = kr[i]; s += lo2f(qp[2 * i]) * k4.x + hi2f(qp[2 * i]) * k4.y + lo2f(qp[2 * i + 1]) * k4.z + hi2f(qp[2 * i + 1]) * k4.w; }
                if (kv <= t) {
                    const float mn = fmaxf(mx, s), f = exp2f(mx - mn), p = exp2f(s - mn); mx = mn; l = l * f + p;
                    const LAS f32x4* vr = (const LAS f32x4*)(Vs + kk * 64);
#pragma unroll
                    for (int i = 0; i < 16; ++i) { const f32x4 v4 = vr[i]; o[4 * i] = o[4 * i] * f + p * v4.x; o[4 * i + 1] = o[4 * i + 1] * f + p * v4.y; o[4 * i + 2] = o[4 * i + 2] * f + p * v4.z; o[4 * i + 3] = o[4 * i + 3] * f + p * v4.w; }
                }
            }
        }
        const float il = 1.f / l; u32x4* og = (u32x4*)(YM + (row0 + t) * 512 + h * 64);
#pragma unroll
        for (int i = 0; i < 8; ++i) { u32x4 w; w.x = pk2(o[8 * i] * il, o[8 * i + 1] * il); w.y = pk2(o[8 * i + 2] * il, o[8 * i + 3] * il); w.z = pk2(o[8 * i + 4] * il, o[8 * i + 5] * il); w.w = pk2(o[8 * i + 6] * il, o[8 * i + 7] * il); og[i] = w; }
    }
    __syncthreads();
}

typedef float f32x16 __attribute__((ext_vector_type(16)));
typedef short s16x4 __attribute__((ext_vector_type(4)));
__device__ __forceinline__ int crow(int r, int hi) { return (r & 3) + 8 * (r >> 2) + 4 * hi; }
__device__ __forceinline__ float max3f(float a, float b, float c) { float r; asm("v_max3_f32 %0, %1, %2, %3" : "=v"(r) : "v"(a), "v"(b), "v"(c)); return r; }
__device__ __forceinline__ float max2f(float a, float b) { float r; asm("v_max_f32_e32 %0, %1, %2" : "=v"(r) : "v"(a), "v"(b)); return r; }
__device__ __forceinline__ float xhalf_max(float x) { auto rr = __builtin_amdgcn_permlane32_swap(__float_as_uint(x), __float_as_uint(x), false, false); return max2f(__uint_as_float(rr[0]), __uint_as_float(rr[1])); }
__device__ __forceinline__ float xhalf_sum(float x) { auto rr = __builtin_amdgcn_permlane32_swap(__float_as_uint(x), __float_as_uint(x), false, false); return __uint_as_float(rr[0]) + __uint_as_float(rr[1]); }
__device__ __forceinline__ bf16x8 packp(const f32x16& p, int s2) {
    u32x4 w; w.x = pk2(p[8 * s2 + 0], p[8 * s2 + 1]); w.y = pk2(p[8 * s2 + 2], p[8 * s2 + 3]); w.z = pk2(p[8 * s2 + 4], p[8 * s2 + 5]); w.w = pk2(p[8 * s2 + 6], p[8 * s2 + 7]);
    return __builtin_bit_cast(bf16x8, w);
}
__device__ __forceinline__ void p_attn_mfma(const Frame& F, const float* qn) {
    const int lane_f = lane_id_fresh(), tid_f = F.wave * 64 + lane_f;
    const bf16* Q = (const bf16*)(F.dob + DO_Q); const bf16* KC = (const bf16*)(F.ws + WS_KC); const bf16* VC = (const bf16*)(F.ws + WS_VC); bf16* YM = (bf16*)(F.ws + WS_YM);
    const float* cs = (const float*)(F.ws + WS_CS);
    constexpr int KST = 208, VST = 192, KBYTES = 64 * KST, SUB = KBYTES + 64 * VST, BUF = 2 * SUB;
    const int tid = tid_f, lane = lane_f, wave = F.wave, r = lane & 31, hi = lane >> 5;
    int kg[3], kl[3], vg[2], vl[2];
#pragma unroll
    for (int i = 0; i < 3; ++i) { const int c = tid + 512 * i, row = c / 12, pc = c % 12; kg[i] = row * 768 + pc * 8; kl[i] = (row >> 6) * SUB + (row & 63) * KST + pc * 16; }
#pragma unroll
    for (int i = 0; i < 2; ++i) { const int c = tid + 512 * i, row = c >> 3, pc = c & 7; vg[i] = row * 512 + pc * 8; vl[i] = (row >> 6) * SUB + KBYTES + (row & 63) * VST + pc * 16; }
    const int g4 = lane >> 4, li = lane & 15;
    const int vtr = (4 * (g4 >> 1) + (li >> 2)) * VST + (16 * (g4 & 1) + 4 * (li & 3)) * 2;
    const int kfr = r * KST + hi * 16;
    LAS unsigned char* lds = F.lds;
    for (int item = F.vcu; item < 1024; item += F.G) {
        const int bh = item >> 4, sidx = item & 15, b = bh >> 3, h = bh & 7; const size_t row0 = (size_t)b * SEQ;
        const bf16* Kg = KC + row0 * 768 + h * 96; const bf16* Vg = VC + row0 * 512 + h * 64;
        for (int uu = 0; uu < 2; ++uu) {
            const int qb = uu == 0 ? 31 - sidx : sidx, q0 = qb * 256, NT = (q0 + 256) / 128;
            const int qw = q0 + wave * 32;
            bf16x8 qf[6];
            {
              const bf16* qp = Q + (row0 + qw + r) * 768 + h * 96 + hi * 8; const float* csr = cs + (row0 + qw + r) * 32 + 8 * hi;
              u32x4 raw[6];
#pragma unroll
              for (int s = 0; s < 6; ++s) raw[s] = *(const u32x4*)(qp + 16 * s);
              const f32x4 c0 = *(const f32x4*)csr, c1 = *(const f32x4*)(csr + 4), s0 = *(const f32x4*)(csr + 16), s1 = *(const f32x4*)(csr + 20);
              float ss = 0.f;
#pragma unroll
              for (int s = 0; s < 6; ++s) { float t[8]; unpack8(raw[s], t);
#pragma unroll
                  for (int e = 0; e < 8; ++e) ss += t[e] * t[e]; }
              const float rstd = QSCALE / sqrtf(xhalf_sum(ss) * (1.f / 96.f) + EPS);
#pragma unroll
              for (int s = 0; s < 4; ++s) { float t[8]; unpack8(raw[s], t); const f32x4 g0 = *(const f32x4*)(qn + 16 * s + 8 * hi), g1 = *(const f32x4*)(qn + 16 * s + 8 * hi + 4);
                  t[0] *= rstd * g0.x; t[1] *= rstd * g0.y; t[2] *= rstd * g0.z; t[3] *= rstd * g0.w; t[4] *= rstd * g1.x; t[5] *= rstd * g1.y; t[6] *= rstd * g1.z; t[7] *= rstd * g1.w;
                  qf[s] = __builtin_bit_cast(bf16x8, pack8(t)); }
              { float a4[8], a5[8]; unpack8(raw[4], a4); unpack8(raw[5], a5);
                const f32x4 g0 = *(const f32x4*)(qn + 64 + 8 * hi), g1 = *(const f32x4*)(qn + 64 + 8 * hi + 4), h0 = *(const f32x4*)(qn + 80 + 8 * hi), h1 = *(const f32x4*)(qn + 80 + 8 * hi + 4);
                const float ga[8] = {g0.x, g0.y, g0.z, g0.w, g1.x, g1.y, g1.z, g1.w}, gb[8] = {h0.x, h0.y, h0.z, h0.w, h1.x, h1.y, h1.z, h1.w};
                const float cc[8] = {c0.x, c0.y, c0.z, c0.w, c1.x, c1.y, c1.z, c1.w}, sn[8] = {s0.x, s0.y, s0.z, s0.w, s1.x, s1.y, s1.z, s1.w};
#pragma unroll
                for (int e = 0; e < 8; ++e) { const float x1 = a4[e] * rstd * ga[e], x2 = a5[e] * rstd * gb[e]; a4[e] = x1 * cc[e] - x2 * sn[e]; a5[e] = x2 * cc[e] + x1 * sn[e]; }
                qf[4] = __builtin_bit_cast(bf16x8, pack8(a4)); qf[5] = __builtin_bit_cast(bf16x8, pack8(a5)); } }
            f32x16 o0 = {}, o1 = {}, negm = {}; float m = 0.f, l = 0.f;
            u32x4 ak[3], av[2];
#pragma unroll
            for (int i = 0; i < 3; ++i) ak[i] = *(const u32x4*)(Kg + kg[i]);
#pragma unroll
            for (int i = 0; i < 2; ++i) av[i] = *(const u32x4*)(Vg + vg[i]);
            asm volatile("" : "+v"(qf[0]), "+v"(qf[1]), "+v"(qf[2]), "+v"(qf[3]), "+v"(qf[4]), "+v"(qf[5]));
            LDS_BAR();
#pragma unroll
            for (int i = 0; i < 3; ++i) *(LAS u32x4*)(lds + kl[i]) = ak[i];
#pragma unroll
            for (int i = 0; i < 2; ++i) *(LAS u32x4*)(lds + vl[i]) = av[i];
            LDS_BAR();
            for (int t = 0; t < NT; ++t) {
                LAS unsigned char* bb = lds + (t & 1) * BUF;
                { const int tn = (t + 1 < NT) ? t + 1 : t;
                  const bf16* kgp = Kg + (size_t)tn * 128 * 768; const bf16* vgp = Vg + (size_t)tn * 128 * 512;
#pragma unroll
                  for (int i = 0; i < 3; ++i) ak[i] = *(const u32x4*)(kgp + kg[i]);
#pragma unroll
                  for (int i = 0; i < 2; ++i) av[i] = *(const u32x4*)(vgp + vg[i]); }
#pragma unroll
                for (int sub = 0; sub < 2; ++sub) {
                    const int tt = 2 * t + sub;
                    if (64 * tt <= qw + 31) {
                        LAS unsigned char* kb = bb + sub * SUB; LAS unsigned char* vb = kb + KBYTES;
                        bf16x8 kf0[6], kf1[6];
#pragma unroll
                        for (int s = 0; s < 6; ++s) { kf0[s] = *(const LAS bf16x8*)(kb + kfr + s * 32); kf1[s] = *(const LAS bf16x8*)(kb + kfr + 32 * KST + s * 32); }
                        __builtin_amdgcn_sched_barrier(0);
                        f32x16 p0 = negm, p1 = negm;
#pragma unroll
                        for (int s = 0; s < 6; ++s) { p0 = __builtin_amdgcn_mfma_f32_32x32x16_bf16(kf0[s], qf[s], p0, 0, 0, 0); p1 = __builtin_amdgcn_mfma_f32_32x32x16_bf16(kf1[s], qf[s], p1, 0, 0, 0); }
                        if (64 * tt + 63 > qw) {
                            int hm = hi; asm volatile("" : "+v"(hm));
                            const int qrel = qw + r - 64 * tt - 4 * hm;
#pragma unroll
                            for (int rg = 0; rg < 16; ++rg) { const int kv = (rg & 3) + 8 * (rg >> 2); if (kv > qrel) p0[rg] = -INFINITY; if (kv + 32 > qrel) p1[rg] = -INFINITY; }
                        }
                        float mx;
                        { float a = max3f(p0[0], p0[1], p1[0]), b2 = max3f(p0[2], p0[3], p1[1]); a = max3f(a, p1[2], p1[3]);
#pragma unroll
                          for (int rg = 4; rg < 16; rg += 4) { a = max3f(a, p0[rg], p0[rg + 1]); b2 = max3f(b2, p0[rg + 2], p0[rg + 3]); a = max3f(a, p1[rg], p1[rg + 1]); b2 = max3f(b2, p1[rg + 2], p1[rg + 3]); }
                          mx = xhalf_max(max2f(a, b2)); }
                        if (!__all(mx <= 8.0f)) {
                            const float dl = max2f(mx, 0.f), f = __builtin_amdgcn_exp2f(-dl); m += dl; l *= f;
#pragma unroll
                            for (int rg = 0; rg < 16; ++rg) { p0[rg] -= dl; p1[rg] -= dl; o0[rg] *= f; o1[rg] *= f; negm[rg] = -m; }
                        }
                        float rs = 0.f;
#pragma unroll
                        for (int rg = 0; rg < 16; ++rg) { p0[rg] = __builtin_amdgcn_exp2f(p0[rg]); p1[rg] = __builtin_amdgcn_exp2f(p1[rg]); rs += p0[rg] + p1[rg]; }
                        l += rs;
#pragma unroll
                        for (int hh = 0; hh < 2; ++hh)
#pragma unroll
                            for (int s2 = 0; s2 < 2; ++s2) { const bf16x8 pf = packp(hh == 0 ? p0 : p1, s2);
#pragma unroll
                                for (int db = 0; db < 2; ++db) { LAS unsigned char* vp_ = vb + vtr + (32 * hh + 16 * s2) * VST + db * 64;
                                    const s16x4 lo = __builtin_bit_cast(s16x4, __builtin_amdgcn_ds_read_tr16_b64_v4i16((LAS s16x4*)vp_));
                                    const s16x4 hi4 = __builtin_bit_cast(s16x4, __builtin_amdgcn_ds_read_tr16_b64_v4i16((LAS s16x4*)(vp_ + 8 * VST)));
                                    const bf16x8 vf = (bf16x8){lo[0], lo[1], lo[2], lo[3], hi4[0], hi4[1], hi4[2], hi4[3]};
                                    if (db == 0) o0 = __builtin_amdgcn_mfma_f32_32x32x16_bf16(vf, pf, o0, 0, 0, 0); else o1 = __builtin_amdgcn_mfma_f32_32x32x16_bf16(vf, pf, o1, 0, 0, 0); } }
                    }
                }
                { LAS unsigned char* nb = lds + ((t + 1) & 1) * BUF;
#pragma unroll
                  for (int i = 0; i < 3; ++i) *(LAS u32x4*)(nb + kl[i]) = ak[i];
#pragma unroll
                  for (int i = 0; i < 2; ++i) *(LAS u32x4*)(nb + vl[i]) = av[i]; }
                LDS_BAR();
            }
            const float il = 1.0f / xhalf_sum(l);
            bf16* op = YM + (row0 + qw + r) * YYLD + h * 64 + 4 * hi;
#pragma unroll
            for (int gq = 0; gq < 4; ++gq) { u32x2 w0, w1;
                w0.x = pk2(o0[4 * gq] * il, o0[4 * gq + 1] * il); w0.y = pk2(o0[4 * gq + 2] * il, o0[4 * gq + 3] * il);
                w1.x = pk2(o1[4 * gq] * il, o1[4 * gq + 1] * il); w1.y = pk2(o1[4 * gq + 2] * il, o1[4 * gq + 3] * il);
                *(u32x2*)(op + 8 * gq) = w0; *(u32x2*)(op + 32 + 8 * gq) = w1; }
        }
    }
    __syncthreads();
}

constexpr int CS_CH = 256, CS_NCH = SEQ / CS_CH;
constexpr int CS_RS = 144;
constexpr int CS_IMG = 16 * CS_RS;
constexpr int CS_WAVE = 8 * CS_IMG + 512;
enum { IM_A = 0, IM_R = 1, IM_B = 2, IM_K = 3, IM_BH = 4, IM_KH = 5, IM_V = 6, IM_G = 7 };
constexpr size_t DO_CSP = 64 * MiB, DO_CSG = 128 * MiB, DO_CSZ = 192 * MiB;
__device__ __forceinline__ int crow8(int q, int hi) { return (q & 3) + 8 * ((q >> 2) & 1) + 4 * hi; }
template <int N> __device__ __forceinline__ float dpp_shr0(float x) { return __builtin_bit_cast(float, __builtin_amdgcn_update_dpp(0, __builtin_bit_cast(int, x), 0x110 + N, 0xf, 0xf, true)); }
__device__ __forceinline__ float rowscan16(float x) { x += dpp_shr0<1>(x); x += dpp_shr0<2>(x); x += dpp_shr0<4>(x); x += dpp_shr0<8>(x); return x; }
__device__ __forceinline__ float xsum_16_32(float v) {
    { auto r = __builtin_amdgcn_permlane16_swap(__float_as_uint(v), __float_as_uint(v), false, false); v = __uint_as_float(r[0]) + __uint_as_float(r[1]); }
    { auto r = __builtin_amdgcn_permlane32_swap(__float_as_uint(v), __float_as_uint(v), false, false); v = __uint_as_float(r[0]) + __uint_as_float(r[1]); }
    return v;
}
__device__ __forceinline__ bf16x8 cs_rowfrag(const LAS unsigned char* rowp, int hi, int ks) {
    const LAS unsigned char* p = rowp + (16 * ks + 4 * hi) * 2; const u32x2 a = *(const LAS u32x2*)p, b = *(const LAS u32x2*)(p + 16);
    return __builtin_bit_cast(bf16x8, (u32x4){a.x, a.y, b.x, b.y});
}
__device__ __forceinline__ bf16x8 cs_trfrag(LAS unsigned char* img, int cb, int lane) {
    const int g4 = lane >> 4, li = lane & 15; LAS unsigned char* p = img + (4 * (g4 >> 1) + (li >> 2)) * CS_RS + (32 * cb + 16 * (g4 & 1) + 4 * (li & 3)) * 2;
    const s16x4 lo = __builtin_bit_cast(s16x4, __builtin_amdgcn_ds_read_tr16_b64_v4i16((LAS s16x4*)p));
    const s16x4 h4 = __builtin_bit_cast(s16x4, __builtin_amdgcn_ds_read_tr16_b64_v4i16((LAS s16x4*)(p + 8 * CS_RS)));
    return (bf16x8){lo[0], lo[1], lo[2], lo[3], h4[0], h4[1], h4[2], h4[3]};
}
__device__ __forceinline__ bf16x8 cs_zero8() { return (bf16x8){0, 0, 0, 0, 0, 0, 0, 0}; }
struct CsIn { const bf16 *ZR, *A, *LW, *G; const float *mu, *k_k, *k_a, *r_k; };
template <bool USE_V, bool WITH_Y>
__device__ __forceinline__ void cs_prep(const CsIn& in, size_t row0, int tok0, int h, LAS unsigned char* wl, int lane) {
    const int t = lane & 15, jq = lane >> 4, tok = tok0 + t; const bool first = tok == 0;
    const size_t g = row0 + tok, gp = row0 + (first ? 0 : tok - 1); const int c0 = h * 64 + 16 * jq;
    LAS float* gct = (LAS float*)(wl + 8 * CS_IMG); LAS float* btt = gct + 64;
    u32x4 Lrc[2], Lrp[2], Lkc[2], Lkp[2], Lav[2], Llw[2], Lvc[2], Lvp[2];
#pragma unroll
    for (int hf = 0; hf < 2; ++hf) { const int cc = c0 + 8 * hf;
        Lkc[hf] = *(const u32x4*)(in.ZR + g * 1792 + 512 + cc); Lkp[hf] = *(const u32x4*)(in.ZR + gp * 1792 + 512 + cc);
        Lrc[hf] = *(const u32x4*)(in.ZR + g * 1792 + cc); Lrp[hf] = *(const u32x4*)(in.ZR + gp * 1792 + cc);
        Lav[hf] = *(const u32x4*)(in.A + g * 512 + cc); Llw[hf] = *(const u32x4*)(in.LW + g * 512 + cc);
        if (USE_V) { Lvc[hf] = *(const u32x4*)(in.ZR + g * 1792 + 1024 + cc); Lvp[hf] = *(const u32x4*)(in.ZR + gp * 1792 + 1024 + cc); }
    }
    float inv;
    { float ss = 0.f;
#pragma unroll
      for (int hf = 0; hf < 2; ++hf) { float kc[8], kp[8]; unpack8(Lkc[hf], kc); unpack8(Lkp[hf], kp);
          const f32x4 m0 = *(const f32x4*)(in.mu + 512 + c0 + 8 * hf), m1 = *(const f32x4*)(in.mu + 512 + c0 + 8 * hf + 4), q0 = *(const f32x4*)(in.k_k + c0 + 8 * hf), q1 = *(const f32x4*)(in.k_k + c0 + 8 * hf + 4);
          const float mm[8] = {m0.x, m0.y, m0.z, m0.w, m1.x, m1.y, m1.z, m1.w}, qq[8] = {q0.x, q0.y, q0.z, q0.w, q1.x, q1.y, q1.z, q1.w};
#pragma unroll
          for (int e = 0; e < 8; ++e) { const float zk = kc[e] + ((first ? 0.f : kp[e]) - kc[e]) * mm[e]; const float kr = zk * qq[e]; ss += kr * kr; } }
      inv = 1.0f / fmaxf(sqrtf(xsum_16_32(ss)), 1e-12f); }
    float btacc = 0.f;
#pragma unroll
    for (int hf = 0; hf < 2; ++hf) {
        const int cc = c0 + 8 * hf;
        u32x4 Lgg = {}; if (WITH_Y) Lgg = *(const u32x4*)(in.G + g * 512 + cc);
        float rc[8], rp[8], kc[8], kp[8], av[8], lw[8];
        unpack8(Lrc[hf], rc); unpack8(Lrp[hf], rp); unpack8(Lkc[hf], kc); unpack8(Lkp[hf], kp); unpack8(Lav[hf], av); unpack8(Llw[hf], lw);
        float mr[8], mk[8], qk[8], qa[8], qr[8];
        { const f32x4 a0 = *(const f32x4*)(in.mu + cc), a1 = *(const f32x4*)(in.mu + cc + 4), b0 = *(const f32x4*)(in.mu + 512 + cc), b1 = *(const f32x4*)(in.mu + 512 + cc + 4);
          const f32x4 c0_ = *(const f32x4*)(in.k_k + cc), c1_ = *(const f32x4*)(in.k_k + cc + 4), d0 = *(const f32x4*)(in.k_a + cc), d1 = *(const f32x4*)(in.k_a + cc + 4);
          mr[0] = a0.x; mr[1] = a0.y; mr[2] = a0.z; mr[3] = a0.w; mr[4] = a1.x; mr[5] = a1.y; mr[6] = a1.z; mr[7] = a1.w;
          mk[0] = b0.x; mk[1] = b0.y; mk[2] = b0.z; mk[3] = b0.w; mk[4] = b1.x; mk[5] = b1.y; mk[6] = b1.z; mk[7] = b1.w;
          qk[0] = c0_.x; qk[1] = c0_.y; qk[2] = c0_.z; qk[3] = c0_.w; qk[4] = c1_.x; qk[5] = c1_.y; qk[6] = c1_.z; qk[7] = c1_.w;
          qa[0] = d0.x; qa[1] = d0.y; qa[2] = d0.z; qa[3] = d0.w; qa[4] = d1.x; qa[5] = d1.y; qa[6] = d1.z; qa[7] = d1.w; }
        if (WITH_Y) { const f32x4 e0 = *(const f32x4*)(in.r_k + cc), e1 = *(const f32x4*)(in.r_k + cc + 4); qr[0] = e0.x; qr[1] = e0.y; qr[2] = e0.z; qr[3] = e0.w; qr[4] = e1.x; qr[5] = e1.y; qr[6] = e1.z; qr[7] = e1.w; }
        float oA[8], oR[8], oB[8], oK[8], oBH[8], oKH[8];
#pragma unroll
        for (int e = 0; e < 8; ++e) {
            const float r = rc[e] + ((first ? 0.f : rp[e]) - rc[e]) * mr[e]; const float zk = kc[e] + ((first ? 0.f : kp[e]) - kc[e]) * mk[e];
            const float kq = zk * (1.f + (av[e] - 1.f) * qa[e]); const float kk = zk * qk[e] * inv; const float b = kk * av[e];
            const float Lg = rowscan16(lw[e]); const float eLg = __builtin_amdgcn_exp2f(1.4426950408889634f * Lg); const float enLg = __builtin_amdgcn_rcpf(eLg);
            const float eLgm = __builtin_bit_cast(float, __builtin_amdgcn_update_dpp(0x3f800000, __builtin_bit_cast(int, eLg), 0x111, 0xf, 0xf, false));
            const float eC = __builtin_bit_cast(float, __builtin_amdgcn_ds_bpermute(((lane & 48) | 15) << 2, __builtin_bit_cast(int, eLg)));
            oA[e] = -kk * eLgm; oR[e] = r * eLg; oB[e] = b * enLg; oK[e] = kq * enLg; oBH[e] = oB[e] * eC; oKH[e] = oK[e] * eC;
            if (WITH_Y) btacc += r * kq * qr[e];
            if (t == 15) gct[16 * jq + 8 * hf + e] = eC;
        }
        const int wo = t * CS_RS + (16 * jq + 8 * hf) * 2;
        *(LAS u32x4*)(wl + IM_A * CS_IMG + wo) = pack8(oA); *(LAS u32x4*)(wl + IM_R * CS_IMG + wo) = pack8(oR); *(LAS u32x4*)(wl + IM_B * CS_IMG + wo) = pack8(oB);
        *(LAS u32x4*)(wl + IM_K * CS_IMG + wo) = pack8(oK); *(LAS u32x4*)(wl + IM_BH * CS_IMG + wo) = pack8(oBH); *(LAS u32x4*)(wl + IM_KH * CS_IMG + wo) = pack8(oKH);
        if (USE_V) { float vc[8], vp[8], o[8]; unpack8(Lvc[hf], vc); unpack8(Lvp[hf], vp);
            const f32x4 a0 = *(const f32x4*)(in.mu + 1024 + cc), a1 = *(const f32x4*)(in.mu + 1024 + cc + 4); const float mv[8] = {a0.x, a0.y, a0.z, a0.w, a1.x, a1.y, a1.z, a1.w};
#pragma unroll
            for (int e = 0; e < 8; ++e) o[e] = vc[e] + ((first ? 0.f : vp[e]) - vc[e]) * mv[e];
            *(LAS u32x4*)(wl + IM_V * CS_IMG + wo) = pack8(o); }
        if (WITH_Y) *(LAS u32x4*)(wl + IM_G * CS_IMG + wo) = Lgg;
    }
    if (WITH_Y) { btacc = xsum_16_32(btacc); if (lane < 16) btt[lane] = btacc; }
}
struct CsFr { bf16x8 fAR[4], aL1, aL2, aL4, aL8, aLkMk, aMb; };
__device__ __forceinline__ void cs_gram(CsFr& fr, LAS unsigned char* wl, int lane) {
    const int hi = lane >> 5, row = lane & 15; const bool up = (lane & 16) != 0;
    const LAS unsigned char* rpAR = wl + (up ? IM_R : IM_A) * CS_IMG + row * CS_RS; const LAS unsigned char* rpBK = wl + (up ? IM_K : IM_B) * CS_IMG + row * CS_RS;
#pragma unroll
    for (int ks = 0; ks < 4; ++ks) fr.fAR[ks] = cs_rowfrag(rpAR, hi, ks);
    f32x16 F1 = {}, F2 = {};
#pragma unroll
    for (int ks = 0; ks < 4; ++ks) { const bf16x8 fBK = cs_rowfrag(rpBK, hi, ks);
        F1 = __builtin_amdgcn_mfma_f32_32x32x16_bf16(fBK, fr.fAR[ks], F1, 0, 0, 0);
        F2 = __builtin_amdgcn_mfma_f32_32x32x16_bf16(fr.fAR[ks], fBK, F2, 0, 0, 0); }
#pragma unroll
    for (int q = 0; q < 8; ++q) { const int s = crow8(q, hi); const bool k1 = up ? (s <= row) : (s < row);
        F1[q] = k1 ? F1[q] : 0.f; F1[8 + q] = k1 ? F1[8 + q] : 0.f; F2[q] = (!up && row < s) ? F2[q] : 0.f; }
    const bf16x8 f1lo = packp(F1, 0);
    fr.aL1 = up ? cs_zero8() : f1lo;
    fr.aMb = up ? f1lo : cs_zero8();
    fr.aLkMk = packp(F1, 1);
    const bf16x8 p2 = packp(F2, 0);
    const f32x16 z16 = {};
    const f32x16 Q1 = __builtin_amdgcn_mfma_f32_32x32x16_bf16(p2, fr.aL1, z16, 0, 0, 0), Q2 = __builtin_amdgcn_mfma_f32_32x32x16_bf16(fr.aL1, p2, z16, 0, 0, 0);
    fr.aL2 = packp(Q1, 0); const bf16x8 p2b = packp(Q2, 0);
    const f32x16 R1 = __builtin_amdgcn_mfma_f32_32x32x16_bf16(p2b, fr.aL2, z16, 0, 0, 0), R2 = __builtin_amdgcn_mfma_f32_32x32x16_bf16(fr.aL2, p2b, z16, 0, 0, 0);
    fr.aL4 = packp(R1, 0); const bf16x8 p2c = packp(R2, 0);
    const f32x16 S1 = __builtin_amdgcn_mfma_f32_32x32x16_bf16(p2c, fr.aL4, z16, 0, 0, 0);
    fr.aL8 = packp(S1, 0);
}
template <bool USE_V, bool WITH_Y>
__device__ __forceinline__ void cs_apply(f32x16 (&Z)[2][2], f32x16 (&D)[2], const CsFr& fr, LAS unsigned char* wl, int lane) {
    const int hi = lane >> 5;
    bf16x8 vf[2];
    if (USE_V) { vf[0] = cs_trfrag(wl + IM_V * CS_IMG, 0, lane); vf[1] = cs_trfrag(wl + IM_V * CS_IMG, 1, lane); }
#pragma unroll
    for (int nb = 0; nb < 2; ++nb) { f32x16 d = {};
#pragma unroll
        for (int jb = 0; jb < 2; ++jb)
#pragma unroll
            for (int k2 = 0; k2 < 2; ++k2) d = __builtin_amdgcn_mfma_f32_32x32x16_bf16(fr.fAR[2 * jb + k2], packp(Z[jb][nb], k2), d, 0, 0, 0);
        if (USE_V) d = __builtin_amdgcn_mfma_f32_32x32x16_bf16(fr.aLkMk, vf[nb], d, 0, 0, 0);
        D[nb] = d; }
#pragma unroll
    for (int nb = 0; nb < 2; ++nb) {
        D[nb] = __builtin_amdgcn_mfma_f32_32x32x16_bf16(fr.aL8, packp(D[nb], 0), D[nb], 0, 0, 0);
        D[nb] = __builtin_amdgcn_mfma_f32_32x32x16_bf16(fr.aL4, packp(D[nb], 0), D[nb], 0, 0, 0);
        D[nb] = __builtin_amdgcn_mfma_f32_32x32x16_bf16(fr.aL2, packp(D[nb], 0), D[nb], 0, 0, 0);
        D[nb] = __builtin_amdgcn_mfma_f32_32x32x16_bf16(fr.aL1, packp(D[nb], 0), D[nb], 0, 0, 0);
    }
    const bf16x8 u0 = packp(D[0], 0), u1 = packp(D[1], 0);
    if (WITH_Y) { D[0] = __builtin_amdgcn_mfma_f32_32x32x16_bf16(fr.aMb, u0, D[0], 0, 0, 0); D[1] = __builtin_amdgcn_mfma_f32_32x32x16_bf16(fr.aMb, u1, D[1], 0, 0, 0); }
    const LAS float* gct = (const LAS float*)(wl + 8 * CS_IMG);
#pragma unroll
    for (int jb = 0; jb < 2; ++jb) {
        const bf16x8 fb = cs_trfrag(wl + IM_BH * CS_IMG, jb, lane); bf16x8 fk = cs_zero8(); if (USE_V) fk = cs_trfrag(wl + IM_KH * CS_IMG, jb, lane);
        float gc[16];
#pragma unroll
        for (int g4 = 0; g4 < 4; ++g4) { const f32x4 x = *(const LAS f32x4*)(gct + 32 * jb + 8 * g4 + 4 * hi); gc[4 * g4] = x.x; gc[4 * g4 + 1] = x.y; gc[4 * g4 + 2] = x.z; gc[4 * g4 + 3] = x.w; }
#pragma unroll
        for (int nb = 0; nb < 2; ++nb) { f32x16 z = Z[jb][nb];
#pragma unroll
            for (int q = 0; q < 16; ++q) z[q] *= gc[q];
            z = __builtin_amdgcn_mfma_f32_32x32x16_bf16(fb, nb == 0 ? u0 : u1, z, 0, 0, 0);
            if (USE_V) z = __builtin_amdgcn_mfma_f32_32x32x16_bf16(fk, vf[nb], z, 0, 0, 0);
            Z[jb][nb] = z; }
    }
}
__device__ __forceinline__ void cs_apply_pk(bf16x8 (&Zp)[2][2][2], f32x16 (&D)[2], const CsFr& fr, LAS unsigned char* wl, int lane) {
    const int hi = lane >> 5;
#pragma unroll
    for (int nb = 0; nb < 2; ++nb) { f32x16 d = {};
#pragma unroll
        for (int jb = 0; jb < 2; ++jb)
#pragma unroll
            for (int k2 = 0; k2 < 2; ++k2) d = __builtin_amdgcn_mfma_f32_32x32x16_bf16(fr.fAR[2 * jb + k2], Zp[jb][nb][k2], d, 0, 0, 0);
        D[nb] = d; }
#pragma unroll
    for (int nb = 0; nb < 2; ++nb) {
        D[nb] = __builtin_amdgcn_mfma_f32_32x32x16_bf16(fr.aL8, packp(D[nb], 0), D[nb], 0, 0, 0);
        D[nb] = __builtin_amdgcn_mfma_f32_32x32x16_bf16(fr.aL4, packp(D[nb], 0), D[nb], 0, 0, 0);
        D[nb] = __builtin_amdgcn_mfma_f32_32x32x16_bf16(fr.aL2, packp(D[nb], 0), D[nb], 0, 0, 0);
        D[nb] = __builtin_amdgcn_mfma_f32_32x32x16_bf16(fr.aL1, packp(D[nb], 0), D[nb], 0, 0, 0);
    }
    const bf16x8 u0 = packp(D[0], 0), u1 = packp(D[1], 0);
    const LAS float* gct = (const LAS float*)(wl + 8 * CS_IMG);
#pragma unroll
    for (int jb = 0; jb < 2; ++jb) {
        const bf16x8 fb = cs_trfrag(wl + IM_BH * CS_IMG, jb, lane);
        float gc[16];
#pragma unroll
        for (int g4 = 0; g4 < 4; ++g4) { const f32x4 x = *(const LAS f32x4*)(gct + 32 * jb + 8 * g4 + 4 * hi); gc[4 * g4] = x.x; gc[4 * g4 + 1] = x.y; gc[4 * g4 + 2] = x.z; gc[4 * g4 + 3] = x.w; }
#pragma unroll
        for (int nb = 0; nb < 2; ++nb) { f32x16 z;
#pragma unroll
            for (int k2 = 0; k2 < 2; ++k2) { float e[8]; unpack8(__builtin_bit_cast(u32x4, Zp[jb][nb][k2]), e);
#pragma unroll
                for (int q = 0; q < 8; ++q) z[8 * k2 + q] = e[q] * gc[8 * k2 + q]; }
            z = __builtin_amdgcn_mfma_f32_32x32x16_bf16(fb, nb == 0 ? u0 : u1, z, 0, 0, 0);
            Zp[jb][nb][0] = packp(z, 0); Zp[jb][nb][1] = packp(z, 1); }
    }
}
template <bool USE_V, bool WITH_Y>
__device__ __forceinline__ void cs_step(f32x16 (&Z)[2][2], f32x16 (&D)[2], LAS unsigned char* wl, int lane) { CsFr fr; cs_gram(fr, wl, lane); cs_apply<USE_V, WITH_Y>(Z, D, fr, wl, lane); }
__device__ __forceinline__ void p_cs_a(const Frame& F, ArgsP a) {
    const int lane = lane_id_fresh();
    LAS unsigned char* wl = F.lds + F.wave * CS_WAVE;
    CsIn in{(const bf16*)(F.ws + WS_ZR), (const bf16*)(F.ws + WS_A), (const bf16*)(F.ws + WS_LW), (const bf16*)(F.dob + DO_G), a->in[I_MU], a->in[I_KK], a->in[I_KA], a->in[I_RK]};
    bf16* Pm = (bf16*)(F.dob + DO_CSP); bf16* Gf = (bf16*)(F.dob + DO_CSG);
    const int hi = lane >> 5;
    for (int uc = F.gw; uc < 64 * CS_NCH; uc += F.NGW) {
        const int bh = uc / CS_NCH, c = uc % CS_NCH, b = bh >> 3, h = bh & 7; const size_t row0 = (size_t)b * SEQ;
        f32x16 ZG[2][2], D[2]; bf16x8 ZP[2][2][2];
#pragma unroll
        for (int jb = 0; jb < 2; ++jb)
#pragma unroll
            for (int nb = 0; nb < 2; ++nb) { f32x16 z = {}; ZG[jb][nb] = z;
                if (jb == nb) {
#pragma unroll
                    for (int q = 0; q < 16; ++q) z[q] = (crow(q, hi) == (lane & 31)) ? 1.f : 0.f; }
                ZP[jb][nb][0] = packp(z, 0); ZP[jb][nb][1] = packp(z, 1); }
        for (int sc = 0; sc < CS_CH / 16; ++sc) { int ln = lane; asm volatile("" : "+v"(ln));
            cs_prep<true, false>(in, row0, c * CS_CH + sc * 16, h, wl, ln); asm volatile("s_waitcnt lgkmcnt(0)" ::: "memory");
            CsFr fr; cs_gram(fr, wl, ln);
            cs_apply_pk(ZP, D, fr, wl, ln); cs_apply<true, false>(ZG, D, fr, wl, ln); asm volatile("s_waitcnt lgkmcnt(0)" ::: "memory"); }
        int lo_ = lane; asm volatile("" : "+v"(lo_)); const int hi_o = lo_ >> 5;
        {
            LAS unsigned short* tb = (LAS unsigned short*)(wl + 4 * hi_o * CS_RS + (lo_ & 31) * 2);
#pragma unroll
            for (int jb = 0; jb < 2; ++jb)
#pragma unroll
                for (int nb = 0; nb < 2; ++nb)
#pragma unroll
                    for (int q = 0; q < 16; ++q) tb[((32 * jb + (q & 3) + 8 * (q >> 2)) * CS_RS + 64 * nb) / 2] = (unsigned short)ZP[jb][nb][q >> 3][q & 7];
            bf16* dst = Pm + (size_t)uc * 4096;
            asm volatile("s_waitcnt lgkmcnt(0)" ::: "memory");
#pragma unroll
            for (int mb = 0; mb < 2; ++mb)
#pragma unroll
                for (int f = 0; f < 4; ++f) { const LAS unsigned char* src = wl + (32 * mb + (lo_ & 31)) * CS_RS + (16 * f + 4 * hi_o) * 2;
                    const u32x2 x0 = *(const LAS u32x2*)src, x1 = *(const LAS u32x2*)(src + 16);
                    *(u32x4*)(dst + ((mb * 64 + lo_) * 4 + f) * 8) = (u32x4){x0.x, x0.y, x1.x, x1.y}; }
            asm volatile("s_waitcnt lgkmcnt(0)" ::: "memory");
        }
        {
            bf16* dst = Gf + (size_t)uc * 4096;
#pragma unroll
            for (int jb = 0; jb < 2; ++jb)
#pragma unroll
                for (int nb = 0; nb < 2; ++nb) { u32x4 w0, w1; const f32x16& z = ZG[jb][nb];
                    w0.x = pk2(z[0], z[1]); w0.y = pk2(z[2], z[3]); w0.z = pk2(z[4], z[5]); w0.w = pk2(z[6], z[7]); w1.x = pk2(z[8], z[9]); w1.y = pk2(z[10], z[11]); w1.z = pk2(z[12], z[13]); w1.w = pk2(z[14], z[15]);
                    u32x4* p = (u32x4*)(dst + ((jb * 2 + nb) * 64 + lo_) * 16); p[0] = w0; p[1] = w1; }
        }
    }
}
struct CsB { u32x4 p[2][2][2]; u32x4 g[2][2]; };
__device__ __forceinline__ void csb_load(CsB& X, const bf16* Pm, const bf16* Gf, size_t uc, int nb, int lane) {
    const bf16* Pc = Pm + uc * 4096;
#pragma unroll
    for (int mb = 0; mb < 2; ++mb) { const u32x4* pp = (const u32x4*)(Pc + (mb * 64 + lane) * 32);
#pragma unroll
        for (int jb = 0; jb < 2; ++jb)
#pragma unroll
            for (int k2 = 0; k2 < 2; ++k2) X.p[mb][jb][k2] = pp[jb * 2 + k2];
        const u32x4* gp = (const u32x4*)(Gf + uc * 4096 + ((mb * 2 + nb) * 64 + lane) * 16); X.g[mb][0] = gp[0]; X.g[mb][1] = gp[1]; }
}
__device__ __forceinline__ void csb_step(f32x16 (&Z)[2], const CsB& X, bf16* Zf, size_t uc, int nb, int lane) {
#pragma unroll
    for (int jb = 0; jb < 2; ++jb) { u32x4 w0, w1; const f32x16& z = Z[jb];
        w0.x = pk2(z[0], z[1]); w0.y = pk2(z[2], z[3]); w0.z = pk2(z[4], z[5]); w0.w = pk2(z[6], z[7]); w1.x = pk2(z[8], z[9]); w1.y = pk2(z[10], z[11]); w1.z = pk2(z[12], z[13]); w1.w = pk2(z[14], z[15]);
        u32x4* p = (u32x4*)(Zf + uc * 4096 + ((jb * 2 + nb) * 64 + lane) * 16); p[0] = w0; p[1] = w1; }
    f32x16 N[2];
#pragma unroll
    for (int mb = 0; mb < 2; ++mb) { float g0[8], g1[8]; unpack8(X.g[mb][0], g0); unpack8(X.g[mb][1], g1);
#pragma unroll
        for (int q = 0; q < 8; ++q) { N[mb][q] = g0[q]; N[mb][8 + q] = g1[q]; } }
#pragma unroll
    for (int jb = 0; jb < 2; ++jb)
#pragma unroll
        for (int k2 = 0; k2 < 2; ++k2) { const bf16x8 zb = packp(Z[jb], k2);
#pragma unroll
            for (int mb = 0; mb < 2; ++mb) N[mb] = __builtin_amdgcn_mfma_f32_32x32x16_bf16(__builtin_bit_cast(bf16x8, X.p[mb][jb][k2]), zb, N[mb], 0, 0, 0); }
    Z[0] = N[0]; Z[1] = N[1];
}
__device__ __forceinline__ void p_cs_b(const Frame& F) {
    const int lane = lane_id_fresh();
    const bf16* Pm = (const bf16*)(F.dob + DO_CSP); const bf16* Gf = (const bf16*)(F.dob + DO_CSG); bf16* Zf = (bf16*)(F.dob + DO_CSZ);
    for (int u16 = F.gw; u16 < 128 * 16; u16 += F.NGW) {
        if (u16 & 15) continue;
        const int u = u16 >> 4, bh = u >> 1, nb = u & 1; const size_t uc0 = (size_t)bh * CS_NCH;
        f32x16 Z[2] = {};
        CsB X0, X1, X2;
        csb_load(X0, Pm, Gf, uc0, nb, lane); csb_load(X1, Pm, Gf, uc0 + 1, nb, lane);
#define CSB_CL(c_) (uc0 + ((c_) < CS_NCH ? (c_) : CS_NCH - 1))
        int c = 0;
        for (; c + 2 < CS_NCH; c += 3) {
            csb_load(X2, Pm, Gf, CSB_CL(c + 2), nb, lane); csb_step(Z, X0, Zf, uc0 + c, nb, lane);
            csb_load(X0, Pm, Gf, CSB_CL(c + 3), nb, lane); csb_step(Z, X1, Zf, uc0 + c + 1, nb, lane);
            csb_load(X1, Pm, Gf, CSB_CL(c + 4), nb, lane); csb_step(Z, X2, Zf, uc0 + c + 2, nb, lane);
        }
        if (c < CS_NCH) { csb_step(Z, X0, Zf, uc0 + c, nb, lane); ++c; }
        if (c < CS_NCH) { csb_step(Z, X1, Zf, uc0 + c, nb, lane); ++c; }
#undef CSB_CL
    }
}
__device__ __forceinline__ void p_cs_c(const Frame& F, ArgsP a) {
    const int lane = lane_id_fresh(), hi = lane >> 5;
    LAS unsigned char* wl = F.lds + F.wave * CS_WAVE;
    CsIn in{(const bf16*)(F.ws + WS_ZR), (const bf16*)(F.ws + WS_A), (const bf16*)(F.ws + WS_LW), (const bf16*)(F.dob + DO_G), a->in[I_MU], a->in[I_KK], a->in[I_KA], a->in[I_RK]};
    const bf16* Zf = (const bf16*)(F.dob + DO_CSZ); bf16* Y = (bf16*)(F.ws + WS_Y); const float* lnw = a->in[I_LNW]; const float* lnb = a->in[I_LNB];
    const LAS float* btt = (const LAS float*)(wl + 8 * CS_IMG) + 64;
    for (int uc = F.gw; uc < 64 * CS_NCH; uc += F.NGW) {
        const int bh = uc / CS_NCH, c = uc % CS_NCH, b = bh >> 3, h = bh & 7; const size_t row0 = (size_t)b * SEQ;
        f32x16 Z[2][2], D[2];
        int lu = lane; asm volatile("" : "+v"(lu));
#pragma unroll
        for (int jb = 0; jb < 2; ++jb)
#pragma unroll
            for (int nb = 0; nb < 2; ++nb) { const u32x4* p = (const u32x4*)(Zf + (size_t)uc * 4096 + ((jb * 2 + nb) * 64 + lu) * 16); float g0[8], g1[8]; unpack8(p[0], g0); unpack8(p[1], g1);
#pragma unroll
                for (int q = 0; q < 8; ++q) { Z[jb][nb][q] = g0[q]; Z[jb][nb][8 + q] = g1[q]; } }
        const float lw0 = lnw[h * 64 + (lu & 31)], lw1 = lnw[h * 64 + 32 + (lu & 31)], lb0 = lnb[h * 64 + (lu & 31)], lb1 = lnb[h * 64 + 32 + (lu & 31)];
        for (int sc = 0; sc < CS_CH / 16; ++sc) {
            const int tok0 = c * CS_CH + sc * 16;
            int ln = lane; asm volatile("" : "+v"(ln));
            cs_prep<true, true>(in, row0, tok0, h, wl, ln); asm volatile("s_waitcnt lgkmcnt(0)" ::: "memory");
            cs_step<true, true>(Z, D, wl, ln); asm volatile("s_waitcnt lgkmcnt(0)" ::: "memory");
            const int hl = ln >> 5;
            const bf16x8 v0 = cs_trfrag(wl + IM_V * CS_IMG, 0, ln), v1 = cs_trfrag(wl + IM_V * CS_IMG, 1, ln), g0 = cs_trfrag(wl + IM_G * CS_IMG, 0, ln), g1 = cs_trfrag(wl + IM_G * CS_IMG, 1, ln);
            const f32x4 bta = *(const LAS f32x4*)(btt + 4 * hl), btb = *(const LAS f32x4*)(btt + 8 + 4 * hl); const float bt[8] = {bta.x, bta.y, bta.z, bta.w, btb.x, btb.y, btb.z, btb.w};
#pragma unroll
            for (int q = 0; q < 8; ++q) {
                const float y0 = D[0][8 + q], y1 = D[1][8 + q];
                const float mean = allsum32(y0 + y1) * (1.f / 64.f); const float d0 = y0 - mean, d1 = y1 - mean;
                const float rstd = 1.0f / sqrtf(allsum32(d0 * d0 + d1 * d1) * (1.f / 64.f) + LN_X_EPS);
                const float o0 = (d0 * rstd * lw0 + lb0 + bt[q] * bf2f((unsigned short)v0[q])) * bf2f((unsigned short)g0[q]);
                const float o1 = (d1 * rstd * lw1 + lb1 + bt[q] * bf2f((unsigned short)v1[q])) * bf2f((unsigned short)g1[q]);
                bf16* yp = Y + (row0 + tok0 + crow8(q, hl)) * YYLD + h * 64 + (ln & 31);
                yp[0] = (unsigned short)f2bf(o0); yp[32] = (unsigned short)f2bf(o1);
            }
            asm volatile("s_waitcnt lgkmcnt(0)" ::: "memory");
        }
    }
}

__device__ __forceinline__ void p_ffn_route(const Frame& F, ArgsP a, unsigned* cnt, int* ridxv, f32x2* rwv) {
    const int lane_f = lane_id_fresh(), tid_f = F.wave * 64 + lane_f;
    const bf16* MO = (const bf16*)(F.ws + WS_MO); bf16* H2 = (bf16*)(F.ws + WS_H2); const float* mod = (const float*)(F.ws + WS_MOD); const float* g = a->in[I_GFFN];
    constexpr int RTS = 1028;
    LAS float* wr = (LAS float*)F.lds;
    __syncthreads();
    for (int i = tid_f; i < 1024 * 4; i += NTHR) { const int k = i >> 2, o = i & 3; wr[o * RTS + k] = a->in[I_WRG][i]; }
    for (int i = tid_f; i < 1024 * 32; i += NTHR) { const int k = i >> 5, o = i & 31; wr[(4 + o) * RTS + k] = a->in[I_WRE][i]; }
    __syncthreads();
    LAS float* brl = wr + 36 * RTS;
    if (tid_f < 4) brl[tid_f] = a->in[I_BRG][tid_f]; else if (tid_f < 36) brl[tid_f] = a->in[I_BRE][tid_f - 4];
    const int lane = lane_f;
    LAS unsigned* lcnt = (LAS unsigned*)(F.lds + LDS_MISC + 512);
    if (tid_f < 256) lcnt[tid_f] = 0u;
    __syncthreads();
    int my_e0 = 0, my_e1 = 0; float my_w0 = 0.f, my_w1 = 0.f; int kk_ = 0;
    u32x2 ma[4], mb[4]; f32x4 gsv[4], shv[4]; int bcur = -1;
    { const u32x2* mr = (const u32x2*)(MO + (size_t)F.gw * 1024) + lane;
#pragma unroll
      for (int j = 0; j < 4; ++j) ma[j] = mr[64 * j]; }
#define RT_ROW(CM, NM, m_) do { const int mm = (m_); const int b = mm / SEQ; \
        if (b != bcur) { bcur = b; \
            _Pragma("unroll") for (int j = 0; j < 4; ++j) { const int col = 4 * lane + 256 * j; \
                gsv[j] = *(const f32x4*)(g + col) * (*(const f32x4*)(mod + b * 6144 + 4096 + col) + 1.0f); shv[j] = *(const f32x4*)(mod + b * 6144 + 3072 + col); } \
            asm volatile("s_waitcnt vmcnt(0)" : "+v"(gsv[0]), "+v"(gsv[1]), "+v"(gsv[2]), "+v"(gsv[3]), "+v"(shv[0]), "+v"(shv[1]), "+v"(shv[2]), "+v"(shv[3])); \
            asm volatile("" : "+v"(CM[0]), "+v"(CM[1]), "+v"(CM[2]), "+v"(CM[3])); } \
        { const int mn = (mm + F.NGW < NTOK) ? mm + F.NGW : mm; const u32x2* mr = (const u32x2*)(MO + (size_t)mn * 1024) + lane; \
          _Pragma("unroll") for (int j = 0; j < 4; ++j) NM[j] = mr[64 * j]; } \
        f32x4 v[4]; float s = 0.f; \
        _Pragma("unroll") for (int j = 0; j < 4; ++j) { v[j] = (f32x4){lo2f(CM[j].x), hi2f(CM[j].x), lo2f(CM[j].y), hi2f(CM[j].y)}; \
            s += (v[j].x * v[j].x + v[j].y * v[j].y) + (v[j].z * v[j].z + v[j].w * v[j].w); } \
        const float rstd = 1.0f / sqrtf(wave_sum(s) * (1.f / 1024.f) + EPS); \
        u32x2* o = (u32x2*)(H2 + (size_t)mm * 1024) + lane; \
        _Pragma("unroll") for (int j = 0; j < 4; ++j) { v[j] = v[j] * rstd * gsv[j] + shv[j]; u32x2 w; w.x = pk2(v[j].x, v[j].y); w.y = pk2(v[j].z, v[j].w); o[64 * j] = w; } \
        float lgq[4]; \
        _Pragma("unroll") for (int oo = 0; oo < 4; ++oo) { float p = 0.f; \
            _Pragma("unroll") for (int j = 0; j < 4; ++j) { const f32x4 w4 = *(const LAS f32x4*)(wr + oo * RTS + 4 * lane + 256 * j); p += (v[j].x * w4.x + v[j].y * w4.y) + (v[j].z * w4.z + v[j].w * w4.w); } \
            lgq[oo] = wave_sum(p) + brl[oo]; } \
        int gi = 0; float gmx = lgq[0]; \
        _Pragma("unroll") for (int i = 1; i < 4; ++i) { if (lgq[i] > gmx) { gmx = lgq[i]; gi = i; } } \
        float gsum = 0.f; \
        _Pragma("unroll") for (int i = 0; i < 4; ++i) gsum += __expf(lgq[i] - gmx); \
        const float pg = 1.f / gsum; \
        gi = __builtin_amdgcn_readfirstlane(gi); \
        float el[8]; \
        { const LAS float* wg = wr + (4 + gi * 8) * RTS + 4 * lane; \
          _Pragma("unroll") for (int i = 0; i < 8; ++i) { float p = 0.f; \
              _Pragma("unroll") for (int j = 0; j < 4; ++j) { const f32x4 w4 = *(const LAS f32x4*)(wg + i * RTS + 256 * j); p += (v[j].x * w4.x + v[j].y * w4.y) + (v[j].z * w4.z + v[j].w * w4.w); } \
              el[i] = wave_sum(p) + brl[4 + gi * 8 + i]; } } \
        int i0 = 0; float m0 = el[0]; \
        _Pragma("unroll") for (int i = 1; i < 8; ++i) if (el[i] > m0) { m0 = el[i]; i0 = i; } \
        int i1 = -1; float m1 = -INFINITY; \
        _Pragma("unroll") for (int i = 0; i < 8; ++i) if (i != i0 && el[i] > m1) { m1 = el[i]; i1 = i; } \
        const float e1 = __expf(m1 - m0), w0 = pg / (1.f + e1), w1 = pg * e1 / (1.f + e1); \
        { const int lo_ = i0 < i1 ? i0 : i1, hi_ = i0 < i1 ? i1 : i0; \
          if (lane == kk_) { my_e0 = gi * 28 + (lo_ * (15 - lo_)) / 2 + (hi_ - lo_ - 1); my_w0 = i0 < i1 ? w0 : w1; my_w1 = i0 < i1 ? w1 : w0; } } \
        ++kk_; } while (0)
    for (int m = F.gw; m < NTOK; m += 2 * F.NGW) {
        RT_ROW(ma, mb, m);
        if (m + F.NGW < NTOK) RT_ROW(mb, ma, m + F.NGW);
    }
#undef RT_ROW
    unsigned lp0 = 0u;
    if (lane < kk_) lp0 = __hip_atomic_fetch_add(lcnt + my_e0, 1u, __ATOMIC_RELAXED, __HIP_MEMORY_SCOPE_WORKGROUP);
    __syncthreads();
    if (tid_f < NCLS) lcnt[128 + tid_f] = __hip_atomic_fetch_add(cnt + tid_f, lcnt[tid_f], __ATOMIC_RELAXED, __HIP_MEMORY_SCOPE_AGENT);
    __syncthreads();
    if (lane < kk_) { const int m = F.gw + lane * F.NGW; const size_t v = (size_t)my_e0 * CLS_CAP + (lcnt[128 + my_e0] + lp0);
        ridxv[v] = m; rwv[v] = (f32x2){my_w0, my_w1}; }
    __syncthreads();
    (void)my_e1;
}
__device__ __forceinline__ int moe_tables(const Frame& F, LAS int* offs, LAS int* texp, LAS int* ccnt) {
    const int lane_f = lane_id_fresh();
    const unsigned* cnt = (const unsigned*)(F.ws + WS_CTL) + CW_CNT;
    __syncthreads();
    if (F.wave == 0) {
        const int c0 = (int)__hip_atomic_load(cnt + lane_f, __ATOMIC_RELAXED, __HIP_MEMORY_SCOPE_AGENT);
        const int c1 = (lane_f < NCLS - 64) ? (int)__hip_atomic_load(cnt + 64 + lane_f, __ATOMIC_RELAXED, __HIP_MEMORY_SCOPE_AGENT) : 0;
        const int n0 = (c0 + 255) >> 8, n1 = (c1 + 255) >> 8; int i0 = n0, i1 = n1;
#pragma unroll
        for (int d = 1; d < 64; d <<= 1) { const int a = __shfl_up(i0, d, 64), b = __shfl_up(i1, d, 64); if (lane_f >= d) { i0 += a; i1 += b; } }
        const int tot0 = __shfl(i0, 63, 64); i1 += tot0;
        const int t0 = i0 - n0, t1 = i1 - n1;
        offs[lane_f] = t0 << 8; ccnt[lane_f] = c0; for (int t = 0; t < n0; ++t) texp[t0 + t] = lane_f;
        if (lane_f < NCLS - 64) { offs[64 + lane_f] = t1 << 8; ccnt[64 + lane_f] = c1; for (int t = 0; t < n1; ++t) texp[t1 + t] = 64 + lane_f; if (lane_f == NCLS - 65) offs[NCLS] = i1 << 8; }
    }
    __syncthreads();
    return __builtin_amdgcn_readfirstlane(offs[NCLS] >> 8);
}
constexpr int NPHASE = 15;
template <int LO, int HI>
__global__ void __launch_bounds__(NTHR, 2) fwd(Args args) {
    extern __shared__ __attribute__((aligned(16))) unsigned char lds_raw[];
    Frame F;
    F.lds = (LAS unsigned char*)lds_raw;
    F.wave = __builtin_amdgcn_readfirstlane((int)threadIdx.x >> 6);
    F.G = gridDim.x; { const int bx = blockIdx.x; F.vcu = (F.G % 8 == 0) ? (bx % 8) * (F.G / 8) + bx / 8 : bx; }
    F.gw = F.vcu * NWAVES + F.wave; F.NGW = F.G * NWAVES;
    F.ws = args.ws; F.dob = (unsigned char*)args.out;
    ArgsP AP = (ArgsP)__builtin_amdgcn_kernarg_segment_ptr();
    volatile LAS unsigned* MISC = (volatile LAS unsigned*)(F.lds + LDS_MISC);
    if (threadIdx.x < 64) MISC[threadIdx.x] = 0u;
    __syncthreads();
    XcdBarrier bar; bar.bar = (unsigned*)(F.ws + WS_CTL) + CW_BAR; bar.x = 0; bar.st = MISC + 8;
#if N_LAUNCH_MODE == 1
    bar = xcd_barrier_post((unsigned*)(F.ws + WS_CTL) + CW_BAR, MISC + 8);
#define GRID_BAR() xcd_barrier(bar)
#else
#define GRID_BAR() do { } while (0)
#endif
#ifndef PROBE_REPEAT
#define PROBE_REPEAT -1
#endif
#define IN(k) (LO <= (k) && (k) < HI)
#define SEAM(k) do { if constexpr (IN(k) && IN((k) + 1)) GRID_BAR(); } while (0)
    const float* mod = (const float*)(F.ws + WS_MOD);

#define PH(k, ...) do { if constexpr (IN(k)) { asm volatile("" : "+s"(AP)); { __VA_ARGS__ } if constexpr (PROBE_REPEAT == (k)) { GRID_BAR(); asm volatile("" : "+s"(AP)); { __VA_ARGS__ } } } } while (0)
    PH(0, p0_prologue(F, AP);); SEAM(0);
    PH(1, p_normmod(F, AP->in[I_X], AP->in[I_GMIX], mod, 0, 1024, (bf16*)(F.ws + WS_H));); SEAM(1);
    PH(2, Gemm g{(const bf16*)(F.ws + WS_H), (const bf16*)(F.ws + WS_WIN), NTOK, N_IN_PAD, 1024}; StaticOrder S; S.init(NTOK, N_IN_PAD, F.G, (int)blockIdx.x);
        EpiZ E{(bf16*)(F.ws + WS_ZR), (bf16*)(F.ws + WS_SG), (bf16*)(F.ws + WS_ZM)}; gemm_phase_any(F.lds, g, S, E, F.wave);); SEAM(2);
    PH(3, p_prep_a(F, AP);); SEAM(3);
    PH(4,
        { Gemm g{(const bf16*)(F.ws + WS_TWA), (const bf16*)(F.ws + WS_WBLK), NTOK, 1024, 128}; StaticOrder S; S.init(NTOK, 1024, F.G, (int)blockIdx.x);
          EpiLora E{(bf16*)(F.ws + WS_LW), (bf16*)(F.ws + WS_A), AP->in[I_W0], AP->in[I_A0]}; gemm_phase_any(F.lds, g, S, E, F.wave); }
        { Gemm g{(const bf16*)(F.ws + WS_SGL), (const bf16*)(F.ws + WS_WG), NTOK, 512, 128}; StaticOrder S; S.init(NTOK, 512, F.G, (int)blockIdx.x);
          EpiPlain E{(bf16*)(F.dob + DO_G), nullptr, 1 << 30, 512, 0}; gemm_phase_any(F.lds, g, S, E, F.wave); }
        { Gemm g{(const bf16*)(F.ws + WS_QA), (const bf16*)(F.ws + WS_WUQ), NTOK, 768, 256}; StaticOrder S; S.init(NTOK, 768, F.G, (int)blockIdx.x);
          EpiPlain E{(bf16*)(F.dob + DO_Q), nullptr, 1 << 30, 768, 0}; gemm_phase_any(F.lds, g, S, E, F.wave); }
        { Gemm g{(const bf16*)(F.ws + WS_KVA), (const bf16*)(F.ws + WS_WUKV), NTOK, 1024, 128}; StaticOrder S; S.init(NTOK, 1024, F.G, (int)blockIdx.x);
          EpiPlain E{(bf16*)(F.dob + DO_KN), (bf16*)(F.ws + WS_VC), 512, 512, 512}; gemm_phase_any(F.lds, g, S, E, F.wave); }
    ); SEAM(4);
    PH(5, p_prep_c(F, AP);); SEAM(5);
#if ENG_ATTN == 1
    PH(6, p_attn_mfma(F, AP->in[I_QN]);); SEAM(6);
#else
    PH(6, p_attn_naive(F);); SEAM(6);
#endif
    PH(7, p_cs_a(F, AP);); SEAM(7);
    PH(8, p_cs_b(F);); SEAM(8);
    PH(9, p_cs_c(F, AP);); SEAM(9);
    PH(10, Gemm g{(const bf16*)(F.ws + WS_Y), (const bf16*)(F.ws + WS_WB), NTOK, 1024, 1024}; StaticOrder S; S.init(NTOK, 1024, F.G, (int)blockIdx.x);
        EpiBranch2 E{(bf16*)(F.ws + WS_MG), (const bf16*)(F.ws + WS_SG)}; gemm_phase_mid(F.lds, g, S, E, F.wave);); SEAM(10);
    PH(11, Gemm g{(const bf16*)(F.ws + WS_MG), (const bf16*)(F.ws + WS_WO), NTOK, 1024, 1024}; StaticOrder S; S.init(NTOK, 1024, F.G, (int)blockIdx.x);
        EpiX1 E{(bf16*)(F.ws + WS_MO), AP->in[I_X], mod}; gemm_phase_any(F.lds, g, S, E, F.wave);); SEAM(11);
    if constexpr (IN(12)) { asm volatile("" : "+s"(AP)); p_ffn_route(F, AP, (unsigned*)(F.ws + WS_CTL) + CW_CNT, (int*)(F.ws + WS_RIDXV), (f32x2*)(F.ws + WS_RWV)); } SEAM(12);
#define MOE_TABLES() LAS int* offs = (LAS int*)(F.lds + LDS_MISC + 1024); LAS int* ccnt = (LAS int*)(F.lds + LDS_MISC + 1536); LAS int* texp = (LAS int*)(F.lds + LDS_MISC + 2048); const int nt = moe_tables(F, offs, texp, ccnt)
    PH(13, MOE_TABLES();
        Gemm g{(const bf16*)(F.ws + WS_H2), (const bf16*)(F.ws + WS_WGU), MPAD2, 1024, 1024, (const int*)(F.ws + WS_RIDXV)}; PairOrderGU S{texp, offs, ccnt, nt, F.G, (int)blockIdx.x};
        EpiGateUp2 E{(bf16*)(F.ws + WS_HID2), (const float*)(F.ws + WS_RWV)}; gemm_phase_gather(F.lds, g, S, E, F.wave);); SEAM(13);
    PH(14, MOE_TABLES();
        Gemm g{(const bf16*)(F.ws + WS_HID2), (const bf16*)(F.ws + WS_WDN), MPAD2, 1024, 512, nullptr, 256}; PairOrderDown S{texp, offs, ccnt, nt, F.G, (int)blockIdx.x};
        EpiDown2 E{(float*)F.dob, (const bf16*)(F.ws + WS_MO), mod, (const int*)(F.ws + WS_RIDXV)}; gemm_phase_bseg(F.lds, g, S, E, F.wave););
#undef MOE_TABLES
}

#if N_LAUNCH_MODE == 1
static bool set_attrs() { return hipFuncSetAttribute((const void*)fwd<0, NPHASE>, hipFuncAttributeMaxDynamicSharedMemorySize, LDS_BYTES) == hipSuccess; }
#else
template <int P> static bool set_attr_all() { if constexpr (P < NPHASE) { return hipFuncSetAttribute((const void*)fwd<P, P + 1>, hipFuncAttributeMaxDynamicSharedMemorySize, LDS_BYTES) == hipSuccess && set_attr_all<P + 1>(); } else return true; }
static bool set_attrs() { return set_attr_all<0>(); }
template <int P> static void launch_all(int grid, hipStream_t stream, const Args& a) { if constexpr (P < NPHASE) { hipLaunchKernelGGL((fwd<P, P + 1>), dim3(grid), dim3(NTHR), LDS_BYTES, stream, a); launch_all<P + 1>(grid, stream, a); } }
#endif
extern "C" void kernel_launch(void* const* d_in, const int* in_sizes, int n_in, void* d_out, int out_size, void* d_ws, size_t ws_size, hipStream_t stream) {
    static int grid = 0;
    if (grid == 0) {
        if (n_in != 34 || out_size != NTOK * DM || ws_size < WS_END) { fprintf(stderr, "kernel_launch: unexpected shapes (n_in %d out %d ws %zu)\n", n_in, out_size, ws_size); grid = -1; return; }
        int dev = 0, cus = 0;
        if (hipGetDevice(&dev) != hipSuccess || hipDeviceGetAttribute(&cus, hipDeviceAttributeMultiprocessorCount, dev) != hipSuccess) { grid = -1; return; }
        if (!set_attrs()) { fprintf(stderr, "kernel_launch: hipFuncSetAttribute failed\n"); grid = -1; return; }
        grid = cus;
    }
    if (grid < 0) return;
    (void)hipMemsetAsync((char*)d_ws + WS_CTL, 0, CTL_ZERO_BYTES, stream);
    Args a{};
    for (int i = 0; i < 34; ++i) a.in[i] = (const float*)d_in[i];
    a.out = (float*)d_out; a.ws = (unsigned char*)d_ws;
    a.ph_lo = 0; a.ph_hi = NPHASE;
#if N_LAUNCH_MODE == 1
    hipLaunchKernelGGL((fwd<0, NPHASE>), dim3(grid), dim3(NTHR), LDS_BYTES, stream, a);
#else
    launch_all<0>(grid, stream, a);
#endif
}
```

```cpp
#include <hip/hip_runtime.h>
#include <cstdio>
#include <cstdint>

#ifndef N_LAUNCH_MODE
#define N_LAUNCH_MODE 1
#endif
#ifndef ENG_GEMM
#define ENG_GEMM 1
#endif
#ifndef ENG_ATTN
#define ENG_ATTN 1
#endif

#define GAS __attribute__((address_space(1)))
#define LAS __attribute__((address_space(3)))
typedef unsigned short bf16;
typedef float f32x4 __attribute__((ext_vector_type(4)));
typedef float f32x2 __attribute__((ext_vector_type(2)));
typedef unsigned u32x4 __attribute__((ext_vector_type(4)));
typedef unsigned u32x2 __attribute__((ext_vector_type(2)));
typedef short bf16x8 __attribute__((ext_vector_type(8)));

constexpr int BATCH = 8, SEQ = 8192, DM = 1024, NTOK = BATCH * SEQ;
constexpr int D_RWKV = 512, RWKV_COLS = 1792, MLA_COLS = 416, D_IN = 4256, N_IN_PAD = 4352;
constexpr int NH = 8, QKD = 96, NOPE = 64, ROPE = 32, VD = 64;
constexpr int NEXP = 32, DEXP = 256;
constexpr int NCLS = 112, MPAD2 = 94208;
constexpr int MPAD = 139264;
constexpr float EPS = 1e-6f, LN_X_EPS = 64e-5f;
constexpr float QSCALE = 0.10206207261596577f * 1.4426950408889634f;

constexpr size_t MiB = 1u << 20;
constexpr size_t WS_CTL = 0, CTL_ZERO_BYTES = 1 * MiB;
constexpr size_t WS_MOD = 1 * MiB;
constexpr size_t WS_ROUTE = 2 * MiB;
constexpr size_t WS_CS = 4 * MiB;
constexpr size_t WS_ENT = 12 * MiB;
constexpr size_t WS_WIN = 16 * MiB;
constexpr size_t WS_WBLK = 25 * MiB;
constexpr size_t WS_WG = WS_WBLK + 256 * 1024;
constexpr size_t WS_WUQ = WS_WG + 128 * 1024;
constexpr size_t WS_WUKV = WS_WUQ + 384 * 1024;
constexpr size_t WS_WB = 26 * MiB;
constexpr size_t WS_WO = 28 * MiB;
constexpr size_t WS_WGU = 30 * MiB;
constexpr size_t WS_WDN = 62 * MiB;
constexpr size_t WS_SG = 80 * MiB;
constexpr size_t WS_H2 = 80 * MiB;
constexpr size_t WS_ZR = 336 * MiB;
constexpr size_t WS_VC = 816 * MiB;
constexpr size_t WS_KC = 880 * MiB;
constexpr size_t WS_Y = 560 * MiB;
constexpr size_t WS_XG = 336 * MiB;
constexpr size_t WS_ZM = 560 * MiB;
constexpr size_t WS_YM = 560 * MiB + 1024;
constexpr size_t WS_H = 688 * MiB;
constexpr size_t WS_LW = 688 * MiB;
constexpr size_t WS_A = 752 * MiB;
constexpr size_t WS_MG = 688 * MiB;
constexpr size_t WS_HID2 = 208 * MiB;
constexpr int CLS_CAP = 65536;
constexpr size_t WS_RIDXV = 336 * MiB;
constexpr size_t WS_RWV = 368 * MiB;
constexpr size_t WS_RW = 13 * MiB;
constexpr size_t WS_HID = 208 * MiB;
constexpr size_t WS_R = 752 * MiB;
constexpr size_t WS_V = 816 * MiB;
constexpr size_t WS_ZK = 880 * MiB;
constexpr size_t WS_TWA = 944 * MiB;
constexpr size_t WS_SGL = 960 * MiB;
constexpr size_t WS_QA = 976 * MiB;
constexpr size_t WS_KVA = 1008 * MiB;
constexpr size_t WS_KK = 944 * MiB;
constexpr size_t WS_YS = 752 * MiB;
constexpr size_t WS_MO = 560 * MiB;
constexpr int YYLD = 1024;
constexpr size_t WS_END = 1024 * MiB;
constexpr size_t DO_G = 0;
constexpr size_t DO_Q = 64 * MiB;
constexpr size_t DO_KN = 160 * MiB;

constexpr int CW_CNT = 64;
constexpr int CW_BAR = 4096;

constexpr int NWAVES = 8, NTHR = 512;
constexpr int LDS_BYTES = 155648;
constexpr int LDS_MISC = 151552;

__device__ __forceinline__ int lane_id_fresh() { int l; asm volatile("v_mbcnt_lo_u32_b32 %0, -1, 0\n\tv_mbcnt_hi_u32_b32 %0, -1, %0" : "=v"(l)); return l; }
__device__ __forceinline__ float bf2f(unsigned short h) { return __builtin_bit_cast(float, (unsigned)h << 16); }
__device__ __forceinline__ unsigned f2bf(float f) { unsigned u = __builtin_bit_cast(unsigned, f); return (u + 0x7fffu + ((u >> 16) & 1u)) >> 16; }
typedef __bf16 bf16x2_t __attribute__((ext_vector_type(2)));
__device__ __forceinline__ unsigned pk2(float lo, float hi) { const f32x2 v = {lo, hi}; return __builtin_bit_cast(unsigned, __builtin_convertvector(v, bf16x2_t)); }
__device__ __forceinline__ float lo2f(unsigned w) { return __builtin_bit_cast(float, w << 16); }
__device__ __forceinline__ float hi2f(unsigned w) { return __builtin_bit_cast(float, w & 0xffff0000u); }
template <int CTRL> __device__ __forceinline__ float dpp_add(float x) { return x + __builtin_bit_cast(float, __builtin_amdgcn_update_dpp(0, __builtin_bit_cast(int, x), CTRL, 0xf, 0xf, false)); }
__device__ __forceinline__ float allsum16(float x) { x = dpp_add<0xB1>(x); x = dpp_add<0x4E>(x); x = dpp_add<0x141>(x); x = dpp_add<0x140>(x); return x; }
__device__ __forceinline__ float allsum32(float x) { x = allsum16(x); auto r = __builtin_amdgcn_permlane16_swap(__float_as_uint(x), __float_as_uint(x), false, false); return __uint_as_float(r[0]) + __uint_as_float(r[1]); }
__device__ __forceinline__ float sum8(float x) { x = dpp_add<0xB1>(x); x = dpp_add<0x4E>(x); x = dpp_add<0x141>(x); return x; }
__device__ __forceinline__ float wave_sum(float v) {
    v = allsum16(v);
    { auto r = __builtin_amdgcn_permlane16_swap(__float_as_uint(v), __float_as_uint(v), false, false); v = __uint_as_float(r[0]) + __uint_as_float(r[1]); }
    { auto r = __builtin_amdgcn_permlane32_swap(__float_as_uint(v), __float_as_uint(v), false, false); v = __uint_as_float(r[0]) + __uint_as_float(r[1]); }
    return v;
}
__device__ __forceinline__ float sigmoidf_(float x) { return __builtin_amdgcn_rcpf(1.f + __builtin_amdgcn_exp2f(-1.4426950408889634f * x)); }
__device__ __forceinline__ float tanhf_(float x) { return 1.0f - 2.0f * __builtin_amdgcn_rcpf(1.f + __builtin_amdgcn_exp2f(2.8853900817779268f * x)); }
__device__ __forceinline__ float siluf_(float x) { return x * __builtin_amdgcn_rcpf(1.f + __builtin_amdgcn_exp2f(-1.4426950408889634f * x)); }
__device__ __forceinline__ void unpack8(const u32x4 w, float (&v)[8]) {
    v[0] = lo2f(w.x); v[1] = hi2f(w.x); v[2] = lo2f(w.y); v[3] = hi2f(w.y); v[4] = lo2f(w.z); v[5] = hi2f(w.z); v[6] = lo2f(w.w); v[7] = hi2f(w.w);
}
__device__ __forceinline__ u32x4 pack8(const float (&v)[8]) { u32x4 w; w.x = pk2(v[0], v[1]); w.y = pk2(v[2], v[3]); w.z = pk2(v[4], v[5]); w.w = pk2(v[6], v[7]); return w; }

#define LDS_BAR() do { asm volatile("s_waitcnt lgkmcnt(0)" ::: "memory"); __builtin_amdgcn_s_barrier(); asm volatile("" ::: "memory"); } while (0)

#define XB_TMO      128
#define XB_XCNT(j)  (256  + 64 * (j))
#define XB_XSUB(j)  (1280 + 64 * (j))
#define XB_XGEN(j)  (2304 + 64 * (j))
#define XB_TOP      3328
#define XB_TOPGEN   3392
#define XCD_BAR_WORDS 3456
#define XB_SPIN_CAP (1u << 19)
__device__ __forceinline__ unsigned xb_ld(unsigned* p)              { return __hip_atomic_load(p, __ATOMIC_RELAXED, __HIP_MEMORY_SCOPE_AGENT); }
__device__ __forceinline__ unsigned xb_add(unsigned* p, unsigned v) { return __hip_atomic_fetch_add(p, v, __ATOMIC_RELAXED, __HIP_MEMORY_SCOPE_AGENT); }
__device__ __forceinline__ unsigned xb_xcc_id() { return (unsigned)__builtin_amdgcn_s_getreg((3 << 11) | 20) & 0xFu; }
#define XB_SPIN(cond, bar) do { unsigned _sp = 0; while (cond) { __builtin_amdgcn_s_sleep(1); \
    if ((++_sp & 255u) == 0u) { if (xb_ld(&(bar)[XB_TMO])) break; if (_sp > XB_SPIN_CAP) { atomicAdd(&(bar)[XB_TMO], 1u); break; } } } } while (0)
struct XcdBarrier { unsigned* bar; unsigned x; volatile LAS unsigned* st; };
__device__ __forceinline__ XcdBarrier xcd_barrier_post(unsigned* bar, volatile LAS unsigned* st) {
    XcdBarrier b; b.bar = bar; b.x = xb_xcc_id(); b.st = st;
    if (threadIdx.x == 0) (void)xb_add(&bar[XB_XCNT(b.x)], 1u);
    return b;
}
__device__ __forceinline__ void xcd_barrier_complete(unsigned* bar, unsigned x, unsigned& nloc, unsigned& nx) {
    const unsigned G = gridDim.x * gridDim.y * gridDim.z;
    unsigned sum, cnt, mine, sp = 0u;
    for (;;) {
        sum = 0u; cnt = 0u; mine = 0u;
#pragma unroll
        for (unsigned j = 0; j < 16; ++j) { const unsigned c = xb_ld(&bar[XB_XCNT(j)]); sum += c; cnt += (c > 0u) ? 1u : 0u; mine = (j == x) ? c : mine; }
        if (sum == G) break;
        __builtin_amdgcn_s_sleep(1);
        if ((++sp & 255u) == 0u) { if (xb_ld(&bar[XB_TMO])) break; if (sp > XB_SPIN_CAP) { atomicAdd(&bar[XB_TMO], 1u); break; } }
    }
    nloc = mine > 0u ? mine : 1u; nx = cnt > 0u ? cnt : 1u;
}
__device__ __forceinline__ void xcd_barrier(const XcdBarrier& b) {
    asm volatile("s_waitcnt vmcnt(0)" ::: "memory");
    __syncthreads();
    if (threadIdx.x == 0) {
        unsigned* bar = b.bar;
        __builtin_amdgcn_s_waitcnt(0);
        unsigned nloc = b.st[0], nx = b.st[1];
        if (nloc == 0u) { xcd_barrier_complete(bar, b.x, nloc, nx); b.st[0] = nloc; b.st[1] = nx; }
        const unsigned old = xb_add(&bar[XB_XSUB(b.x)], 1u);
        const unsigned gen = old / nloc;
        if (old + 1u == (gen + 1u) * nloc) {
            __builtin_amdgcn_fence(__ATOMIC_RELEASE, "agent");
            asm volatile("s_waitcnt vmcnt(0)" ::: "memory");
            const unsigned og = xb_add(&bar[XB_TOP], 1u);
            const unsigned tg = og / nx;
            if (og + 1u == (tg + 1u) * nx) xb_add(&bar[XB_TOPGEN], 1u);
            else XB_SPIN(xb_ld(&bar[XB_TOPGEN]) == tg, bar);
            __builtin_amdgcn_fence(__ATOMIC_ACQUIRE, "agent");
            xb_add(&bar[XB_XGEN(b.x)], 1u);
            asm volatile("s_waitcnt vmcnt(0)" ::: "memory");
        } else {
            XB_SPIN(xb_ld(&bar[XB_XGEN(b.x)]) == gen, bar);
            __builtin_amdgcn_fence(__ATOMIC_ACQUIRE, "agent");
            asm volatile("s_waitcnt vmcnt(0)" ::: "memory");
        }
    }
    __syncthreads();
}

struct Args {
    const float* in[34]; float* out; unsigned char* ws; int ph_lo, ph_hi;
};
typedef const __attribute__((address_space(4))) Args* ArgsP;
struct Frame {
    LAS unsigned char* lds;
    int wave, vcu, G, gw, NGW;
    unsigned char* ws; unsigned char* dob;
};
enum { I_X = 0, I_C, I_POS, I_WADA, I_BADA, I_GMIX, I_WIN, I_MU, I_W0, I_WDEC, I_A0, I_WAUP, I_WGUP, I_KK, I_KA, I_RK, I_LNW, I_LNB, I_GQA, I_WUQ, I_GKVA, I_WUKV,
       I_QN, I_KN, I_WBR, I_WOUT, I_GFFN, I_WRG, I_BRG, I_WRE, I_BRE, I_WEG, I_WEU, I_WED };

struct Unit { int pm, pn, aux, vr, nv; };
struct Gemm { const bf16* A; const bf16* Bt; int M, N, K; const int* ridx = nullptr; int ldb = 0; };
constexpr int NXCD = 8, WGM = 8;
struct StaticOrder {
    int nM, nN, nwg, G, c;
    __device__ void init(int M, int N, int G_, int c_) { nM = M / 256; nN = N / 256; nwg = nM * nN; G = G_; c = c_; }
    __device__ bool next(int i, Unit& u) const {
        const long L = (long)i * G + c; if (L >= nwg) return false;
        int wgid = (int)L; { const int q = nwg / NXCD, r = nwg % NXCD, xcd = wgid % NXCD, off = wgid / NXCD; wgid = (xcd < r ? xcd * (q + 1) : r * (q + 1) + (xcd - r) * q) + off; }
        const int nig = WGM * nN, gid = wgid / nig, fm = gid * WGM, gsz = (nM - fm) < WGM ? (nM - fm) : WGM;
        u.pm = fm + ((wgid % nig) % gsz); u.pn = (wgid % nig) / gsz; u.aux = 0; u.vr = 0; u.nv = 256; return true;
    }
    __device__ __forceinline__ void a_ready(const Unit&) const {}
    __device__ __forceinline__ void done(const Unit&) const {}
};
struct TableOrder {
    const LAS int* texp; int ntiles, nN, G, c;
    __device__ bool next(int i, Unit& u) const {
        const long L = (long)i * G + c; if (L >= (long)ntiles * nN) return false;
        const int t = (int)(L / nN), j = (int)(L % nN); u.pm = t; u.pn = texp[t] * nN + j; u.aux = 0; u.vr = 0; u.nv = 256; return true;
    }
    __device__ __forceinline__ void a_ready(const Unit&) const {}
    __device__ __forceinline__ void done(const Unit&) const {}
};

__device__ __forceinline__ void cls_decode(int cls, int& e_lo, int& e_hi) {
    const int gi = cls / 28, idx = cls % 28;
    const int lo = (idx >= 7) + (idx >= 13) + (idx >= 18) + (idx >= 22) + (idx >= 25) + (idx >= 27), base = (lo * (15 - lo)) / 2;
    e_lo = gi * 8 + lo; e_hi = gi * 8 + lo + 1 + (idx - base);
}
struct PairOrderGU {
    const LAS int* texp; const LAS int* offs; const LAS int* ccnt; int ntiles, G, c;
    __device__ bool next(int i, Unit& u) const {
        const int L = i * G + c; if (L >= ntiles * 4) return false;
        const int t = L >> 2, j = L & 3; int el, eh; const int cls = __builtin_amdgcn_readfirstlane(texp[t]); cls_decode(cls, el, eh);
        const int r0 = t * 256 - __builtin_amdgcn_readfirstlane(offs[cls]), left = __builtin_amdgcn_readfirstlane(ccnt[cls]) - r0;
        u.pm = t; u.pn = (j < 2 ? el : eh) * 2 + (j & 1); u.aux = j >> 1; u.vr = cls * CLS_CAP + r0; u.nv = left < 256 ? left : 256; return true;
    }
    __device__ __forceinline__ void a_ready(const Unit&) const {}
    __device__ __forceinline__ void done(const Unit&) const {}
};
struct PairOrderDown {
    const LAS int* texp; const LAS int* offs; const LAS int* ccnt; int ntiles, G, c;
    __device__ bool next(int i, Unit& u) const {
        const int L = i * G + c; if (L >= ntiles * 4) return false;
        const int t = L >> 2, j = L & 3; int el, eh; const int cls = __builtin_amdgcn_readfirstlane(texp[t]); cls_decode(cls, el, eh);
        const int r0 = t * 256 - __builtin_amdgcn_readfirstlane(offs[cls]), left = __builtin_amdgcn_readfirstlane(ccnt[cls]) - r0;
        u.pm = t; u.pn = el * 4 + j; u.aux = eh * 4 + j; u.vr = cls * CLS_CAP + r0; u.nv = left < 256 ? left : 256; return true;
    }
    __device__ __forceinline__ void a_ready(const Unit&) const {}
    __device__ __forceinline__ void done(const Unit&) const {}
};

template <class Epi, class Sched>
__device__ __forceinline__ void gemm_phase_naive(LAS unsigned char* lds, const Gemm g, const Sched& S, const Epi& E) {
    const int tid = (int)__builtin_amdgcn_readfirstlane((int)threadIdx.x >> 6) * 64 + lane_id_fresh(), ty = tid >> 5, tx = tid & 31;
    LAS bf16* As = (LAS bf16*)lds; LAS bf16* Bs = (LAS bf16*)(lds + 128 * 40 * 2);
    Unit u;
    for (int i = 0; S.next(i, u); ++i) {
        for (int half = 0; half < 2; ++half) {
            float acc[8][8];
#pragma unroll
            for (int r = 0; r < 8; ++r)
#pragma unroll
                for (int c = 0; c < 8; ++c) acc[r][c] = 0.f;
            const bf16* Ab = g.A + ((size_t)u.pm * 256 + half * 128) * g.K; const bf16* Bb = g.Bt + (size_t)u.pn * 256 * g.K;
            for (int k0 = 0; k0 < g.K; k0 += 32) {
                __syncthreads();
                { const int r = tid >> 2, c8 = (tid & 3) * 8; *(LAS u32x4*)(As + r * 40 + c8) = *(const u32x4*)(Ab + (size_t)r * g.K + k0 + c8); }
#pragma unroll
                for (int j = 0; j < 2; ++j) { const int ch = tid + j * 512, r = ch >> 2, c8 = (ch & 3) * 8; *(LAS u32x4*)(Bs + r * 40 + c8) = *(const u32x4*)(Bb + (size_t)r * g.K + k0 + c8); }
                __syncthreads();
#pragma unroll 2
                for (int k = 0; k < 32; k += 2) {
                    float b0[8], b1[8];
#pragma unroll
                    for (int c = 0; c < 8; ++c) { const unsigned w = *(const LAS unsigned*)(Bs + (tx * 8 + c) * 40 + k); b0[c] = lo2f(w); b1[c] = hi2f(w); }
#pragma unroll
                    for (int r = 0; r < 8; ++r) { const unsigned w = *(const LAS unsigned*)(As + (ty * 8 + r) * 40 + k); const float a0 = lo2f(w), a1 = hi2f(w);
#pragma unroll
                        for (int c = 0; c < 8; ++c) acc[r][c] = fmaf(a1, b1[c], fmaf(a0, b0[c], acc[r][c])); }
                }
            }
#pragma unroll
            for (int r = 0; r < 8; ++r) E.store8(u, half * 128 + ty * 8 + r, tx * 8, acc[r]);
        }
    }
    __syncthreads();
}

struct EpiZ { bf16 *ZR, *SG, *ZM;
    __device__ __forceinline__ void store8(const Unit& u, int r, int c, const float (&v)[8]) const {
        const size_t row = (size_t)u.pm * 256 + r;
        if (u.pn < 7) { *(u32x4*)(ZR + row * 1792 + u.pn * 256 + c) = pack8(v); }
        else if (u.pn < 15) { __builtin_nontemporal_store(pack8(v), (u32x4*)(SG + row * 2048 + (u.pn - 7) * 256 + c)); }
        else { *(u32x4*)(ZM + row * 512 + (u.pn - 15) * 256 + c) = pack8(v); }
    } };
struct EpiLora { bf16 *LW, *A; const float *w0, *a0;
    __device__ __forceinline__ void store8(const Unit& u, int r, int c, const float (&v)[8]) const {
        const size_t row = (size_t)u.pm * 256 + r; const int col = u.pn * 256 + c; float o[8];
        const bool isw = col < 512; const float* bp = isw ? (w0 + col) : (a0 + col - 512);
        const f32x4 b0 = *(const f32x4*)bp, b1 = *(const f32x4*)(bp + 4); const float bb[8] = {b0.x, b0.y, b0.z, b0.w, b1.x, b1.y, b1.z, b1.w};
#pragma unroll
        for (int i = 0; i < 8; ++i) { const float e = __builtin_amdgcn_exp2f(fminf(-1.4426950408889634f * (bb[i] + v[i]), 120.f)); const float s = __builtin_amdgcn_rcpf(1.0f + e); o[i] = isw ? -0.60653065971263342f * s : s; }
        bf16* dst = isw ? (LW + row * 512 + col) : (A + row * 512 + col - 512);
        *(u32x4*)dst = pack8(o);
    } };
struct EpiPlain { bf16* O0; bf16* O1; int split, ld0, ld1;
    __device__ __forceinline__ void store8(const Unit& u, int r, int c, const float (&v)[8]) const {
        const size_t row = (size_t)u.pm * 256 + r; int col = u.pn * 256 + c;
        if (col < split) *(u32x4*)(O0 + row * ld0 + col) = pack8(v); else *(u32x4*)(O1 + row * ld1 + col - split) = pack8(v);
    } };
struct EpiX1 { bf16* X1; const float* x; const float* mod;
    __device__ __forceinline__ void store8(const Unit& u, int r, int c, const float (&v)[8]) const {
        const size_t row = (size_t)u.pm * 256 + r; const int col = u.pn * 256 + c, b = (int)(row / SEQ); const size_t off = row * 1024 + col;
        const float* gm = mod + b * 6144 + 2048 + col; const f32x4 x0 = *(const f32x4*)(x + off), x1 = *(const f32x4*)(x + off + 4), h0 = *(const f32x4*)gm, h1 = *(const f32x4*)(gm + 4);
        const float o[8] = {x0.x + h0.x * v[0], x0.y + h0.y * v[1], x0.z + h0.z * v[2], x0.w + h0.w * v[3], x1.x + h1.x * v[4], x1.y + h1.y * v[5], x1.z + h1.z * v[6], x1.w + h1.w * v[7]};
        *(u32x4*)(X1 + off) = pack8(o);
    } };
struct EpiBranch2 { bf16* MG; const bf16* SG;
    __device__ __forceinline__ void mid8(const Unit& u, int r, int c, float (&v)[8]) const {
        const size_t row = (size_t)u.pm * 256 + r; const int col = u.pn * 256 + c; float gr[8], gm[8];
        unpack8(*(const u32x4*)(SG + row * 2048 + col), gr); unpack8(*(const u32x4*)(SG + row * 2048 + 1024 + col), gm);
#pragma unroll
        for (int i = 0; i < 8; ++i) v[i] *= (1.f + __builtin_amdgcn_exp2f(-1.4426950408889634f * fmaxf(gm[i], -30.f))) * __builtin_amdgcn_rcpf(1.f + __builtin_amdgcn_exp2f(-1.4426950408889634f * gr[i]));
    }
    __device__ __forceinline__ void store8(const Unit& u, int r, int c, const float (&v)[8]) const {
        const size_t row = (size_t)u.pm * 256 + r; const int col = u.pn * 256 + c; float gm[8], o[8];
        unpack8(*(const u32x4*)(SG + row * 2048 + 1024 + col), gm);
#pragma unroll
        for (int i = 0; i < 8; ++i) o[i] = sigmoidf_(fmaxf(gm[i], -30.f)) * v[i];
        *(u32x4*)(MG + row * 1024 + col) = pack8(o);
    } };
struct EpiGateUp { bf16* HID;
    __device__ __forceinline__ void store8(const Unit& u, int r, int c, const float (&v)[8]) const {
        const size_t row = (size_t)u.pm * 256 + r; const int col = ((u.pn & 1) * 256 + c) >> 1;
        u32x2 w; w.x = pk2(siluf_(v[0]) * v[4], siluf_(v[1]) * v[5]); w.y = pk2(siluf_(v[2]) * v[6], siluf_(v[3]) * v[7]);
        *(u32x2*)(HID + row * 256 + col) = w;
    } };
struct EpiGateUp2 { bf16* HID2; const float* rw;
    __device__ __forceinline__ void store8(const Unit& u, int r, int c, const float (&v)[8]) const {
        const size_t row = (size_t)u.pm * 256 + r; const float w = r < u.nv ? rw[((size_t)u.vr + r) * 2 + u.aux] : 0.f; const int col = u.aux * 256 + (((u.pn & 1) * 256 + c) >> 1);
        u32x2 o; o.x = pk2(w * siluf_(v[0]) * v[4], w * siluf_(v[1]) * v[5]); o.y = pk2(w * siluf_(v[2]) * v[6], w * siluf_(v[3]) * v[7]);
        *(u32x2*)(HID2 + row * 512 + col) = o;
    } };
struct EpiDown2 { float* out; const bf16* X1; const float* mod; const int* ridx;
    __device__ __forceinline__ void store8(const Unit& u, int r, int c, const float (&v)[8]) const {
        if (r >= u.nv) return;
        const int tok = ridx[u.vr + r];
        const int col = (u.pn & 3) * 256 + c, b = tok / SEQ; const size_t off = (size_t)tok * 1024 + col;
        const float* gt = mod + b * 6144 + 5120 + col; const u32x4 xw = *(const u32x4*)(X1 + off); const f32x4 g0 = *(const f32x4*)gt, g1 = *(const f32x4*)(gt + 4);
        f32x4 o0, o1;
        o0.x = lo2f(xw.x) + g0.x * v[0]; o0.y = hi2f(xw.x) + g0.y * v[1]; o0.z = lo2f(xw.y) + g0.z * v[2]; o0.w = hi2f(xw.y) + g0.w * v[3];
        o1.x = lo2f(xw.z) + g1.x * v[4]; o1.y = hi2f(xw.z) + g1.y * v[5]; o1.z = lo2f(xw.w) + g1.z * v[6]; o1.w = hi2f(xw.w) + g1.w * v[7];
        *(f32x4*)(out + off) = o0; *(f32x4*)(out + off + 4) = o1;
    } };
struct EpiDown { bf16* YS;
    __device__ __forceinline__ void store8(const Unit& u, int r, int c, const float (&v)[8]) const {
        const size_t row = (size_t)u.pm * 256 + r; *(u32x4*)(YS + row * 1024 + (u.pn & 3) * 256 + c) = pack8(v);
    } };


namespace pg8 {
#define PG8_LAS __attribute__((address_space(3)))
typedef ::bf16x8 bf16x8; typedef ::f32x4 f32x4;
using ::Unit; using ::Gemm;
constexpr int BM = 256, BK = 64, HALF = 128, HTB = HALF * BK * 2  , STAGE_BYTES = 8 * HTB;

__device__ __forceinline__ int lds_byte(int r, int c) { const int st = (r >> 4) * 2 + (c >> 5), rr = r & 15, cc = c & 31, ob = rr * 64 + cc * 2; return st * 1024 + (ob ^ (((ob >> 9) & 1) << 5)); }
__device__ __forceinline__ void stage_rc(int b, int& R, int& C) { const int st = b / 1024, sb = b % 1024, swz = sb ^ (((sb >> 9) & 1) << 5); R = (st >> 1) * 16 + swz / 64; C = (st & 1) * 32 + (swz % 64) / 2; }
__device__ __forceinline__ int perm32(int rho) { const int n = rho >> 4, i = rho & 15; return 8 * (i >> 2) + 4 * n + (i & 3); }
template <class Epi, class Sched, bool ALIGN_EPI = false, bool SP2 = false, bool GATHER = false, bool MIDHOOK = false, bool BSEG = false>
__device__ __forceinline__ void gemm_phase(PG8_LAS unsigned char* lds, const Gemm g, const Sched& S, const Epi& E, const int wave_in) {
    const int lane = lane_id_fresh(), wid = wave_in, tid = wid * 64 + lane,
              wr = wid >> 2, wc = wid & 3, fr = lane & 15, fq = lane >> 4;
    const int K = g.K, nt = K / BK;
    unsigned voffA[2], voffB[2];
#pragma unroll
    for (int i = 0; i < 2; ++i) { int R, C; stage_rc(tid * 16 + i * 8192, R, C); const int Rb = Epi::PERM ? ((R & ~31) + perm32(R & 31)) : R;
        voffA[i] = (unsigned)(R * K + C) * 2u; voffB[i] = (unsigned)(Rb * (BSEG ? g.ldb : K) + C) * 2u; }
    unsigned vAc[2][2] = {{0u, 0u}, {0u, 0u}}, vAn[2][2] = {{0u, 0u}, {0u, 0u}}; int gR[2] = {0, 0}; unsigned gC[2] = {0u, 0u};
    if constexpr (GATHER) {
#pragma unroll
        for (int i = 0; i < 2; ++i) { int R, C; stage_rc(tid * 16 + i * 8192, R, C); gR[i] = R; gC[i] = (unsigned)C * 2u; } }
#define PG8_GIDX(dst, U_) do { _Pragma("unroll") for (int _h = 0; _h < 2; ++_h) _Pragma("unroll") for (int _i = 0; _i < 2; ++_i) \
        { const int rr_ = _h * HALF + gR[_i]; const int ri_ = rr_ < (U_).nv ? g.ridx[(U_).vr + rr_] : 0; dst[_h][_i] = (unsigned)ri_ * (unsigned)(K * 2) + gC[_i]; } } while (0)
    const size_t kstep = (size_t)(BK * 2);
    const size_t hstep = (size_t)HALF * K * 2;
    const size_t tstep = 2 * hstep;
    const size_t hstepB = BSEG ? (size_t)HALF * g.ldb * 2 : hstep, tstepB = 2 * hstepB; const int nh = nt / 2;
    const unsigned ldsw = (unsigned)wid * 1024u;
    const int aoff = lds_byte(wr * 64 + fr, fq * 8), boff = lds_byte(wc * 32 + fr, fq * 8);
#define PG8_SA(b, h) (((b) * 2 + (h)) * HTB)
#define PG8_SB(b, h) ((4 + (b) * 2 + (h)) * HTB)
#define PG8_STAGE(bufoff, gbase, voff) do { _Pragma("unroll") for (int _i = 0; _i < 2; ++_i) \
        __builtin_amdgcn_global_load_lds((const unsigned*)((const char*)(gbase) + (voff)[_i]), (PG8_LAS unsigned*)(lds + (bufoff) + ldsw + _i * 8192), 16, 0, 0); } while (0)
#define PG8_STAGE_A(bufoff, kptr, h, isnext) do { if constexpr (GATHER) { unsigned _v[2]; _v[0] = (isnext) ? vAn[h][0] : vAc[h][0]; _v[1] = (isnext) ? vAn[h][1] : vAc[h][1]; PG8_STAGE(bufoff, kptr, _v); } \
        else { PG8_STAGE(bufoff, (kptr) + (h) * hstep, voffA); } } while (0)
#define PG8_LDA(dst, b, h) do { _Pragma("unroll") for (int m = 0; m < 4; ++m) _Pragma("unroll") for (int k = 0; k < 2; ++k) dst[m][k] = *(const PG8_LAS bf16x8*)(lds + PG8_SA(b, h) + aoff + m * 2048 + k * 1024); } while (0)
#define PG8_LDB(dst, b, h) do { _Pragma("unroll") for (int n = 0; n < 2; ++n) _Pragma("unroll") for (int k = 0; k < 2; ++k) dst[n][k] = *(const PG8_LAS bf16x8*)(lds + PG8_SB(b, h) + boff + n * 2048 + k * 1024); } while (0)
#define PG8_MMA(ai, bj, At, Bt) do { __builtin_amdgcn_s_setprio(1); _Pragma("unroll") for (int m = 0; m < 4; ++m) _Pragma("unroll") for (int n = 0; n < 2; ++n) _Pragma("unroll") for (int k = 0; k < 2; ++k) \
        acc[ai][bj][m][n] = __builtin_amdgcn_mfma_f32_16x16x32_bf16(Bt[n][k], At[m][k], acc[ai][bj][m][n], 0, 0, 0); __builtin_amdgcn_s_setprio(0); } while (0)
#define PG8_WAIT_V(n) asm volatile("s_waitcnt vmcnt(" #n ")" ::: "memory")
#define PG8_WAIT_L(n) asm volatile("s_waitcnt lgkmcnt(" #n ")" ::: "memory")
#define PG8_BAR __builtin_amdgcn_s_barrier()
#define PG8_SCHED __builtin_amdgcn_sched_barrier(0)
    Unit cur, nxt; int ui = 0;
    if (!S.next(0, cur)) return;
    f32x4 acc[2][2][4][2];
#pragma unroll
    for (int a = 0; a < 2; ++a)
#pragma unroll
        for (int b = 0; b < 2; ++b)
#pragma unroll
            for (int m = 0; m < 4; ++m)
#pragma unroll
                for (int n = 0; n < 2; ++n) acc[a][b][m][n] = (f32x4){0.f, 0.f, 0.f, 0.f};
    bf16x8 At[4][2], B0[2][2], B1[2][2];
    const char* cA = (const char*)g.A + (GATHER ? (size_t)0 : (size_t)cur.pm * tstep); const char* cB = (const char*)g.Bt + (size_t)cur.pn * tstepB; const char* cB2 = (const char*)g.Bt + (size_t)(BSEG ? cur.aux : cur.pn) * tstepB;
    if constexpr (GATHER) PG8_GIDX(vAc, cur);
    S.a_ready(cur);
    if constexpr (SP2) {
        PG8_STAGE(PG8_SB(0, 0), cB, voffB); PG8_STAGE(PG8_SB(0, 1), cB + hstepB, voffB); PG8_STAGE_A(PG8_SA(0, 0), cA, 0, false); PG8_STAGE_A(PG8_SA(0, 1), cA, 1, false);
        if (wr == 1) PG8_BAR;
        PG8_WAIT_V(2); PG8_BAR;
        PG8_STAGE(PG8_SB(1, 0), cB + kstep, voffB); PG8_STAGE_A(PG8_SA(1, 0), cA + kstep, 0, false); PG8_STAGE(PG8_SB(1, 1), cB + hstepB + kstep, voffB);
        PG8_WAIT_V(6); PG8_BAR;
    } else {
        PG8_STAGE(PG8_SB(0, 0), cB, voffB); PG8_STAGE(PG8_SA(0, 0), cA, voffA); PG8_STAGE(PG8_SB(0, 1), cB + hstep, voffB); PG8_STAGE(PG8_SA(0, 1), cA + hstep, voffA);
        if (wr == 1) PG8_BAR;
        PG8_WAIT_V(4); PG8_BAR;
        PG8_STAGE(PG8_SB(1, 0), cB + kstep, voffB); PG8_STAGE(PG8_SA(1, 0), cA + kstep, voffA); PG8_STAGE(PG8_SB(1, 1), cB + hstep + kstep, voffB);
        PG8_WAIT_V(6); PG8_BAR;
    }
    for (;;) {
        const bool has_next = S.next(ui + 1, nxt);
        const char* nA = (has_next && !GATHER) ? (const char*)g.A + (size_t)nxt.pm * tstep : cA; const char* nB = has_next ? (const char*)g.Bt + (size_t)nxt.pn * tstepB : cB; const char* nB2 = (has_next && BSEG) ? (const char*)g.Bt + (size_t)nxt.aux * tstepB : (BSEG ? cB2 : nB);
        if constexpr (GATHER) { if (has_next) PG8_GIDX(vAn, nxt); else { _Pragma("unroll") for (int _h = 0; _h < 2; ++_h) { vAn[_h][0] = vAc[_h][0]; vAn[_h][1] = vAc[_h][1]; } } }
        for (int t = 0; t < nt; t += 2) {
            if constexpr (MIDHOOK) { if (t == nt / 2) { E.mid(acc, cur, wr, wc, fr, fq); PG8_WAIT_V(0); } }
            const bool last = (t == nt - 2);
            const char* a1 = cA + (size_t)(t + 1) * kstep;
            const char* a2 = last ? nA : cA + (size_t)(t + 2) * kstep; const char* b2 = last ? nB : ((BSEG && t + 2 >= nh) ? cB2 + (size_t)(t + 2 - nh) * kstep : cB + (size_t)(t + 2) * kstep);
            const char* a3 = a2 + kstep; const char* b3 = b2 + kstep;
            if (last && has_next) S.a_ready(nxt);
            if constexpr (SP2) {
            PG8_LDB(B0, 0, 0); PG8_LDB(B1, 0, 1); PG8_SCHED; PG8_LDA(At, 0, 0); PG8_STAGE_A(PG8_SA(1, 1), a1, 1, false);
            PG8_WAIT_V(8); PG8_WAIT_L(0); PG8_BAR; PG8_MMA(0, 0, At, B0); PG8_MMA(0, 1, At, B1); PG8_BAR; PG8_SCHED;
            PG8_LDA(At, 0, 1); PG8_STAGE(PG8_SB(0, 0), b2, voffB); PG8_STAGE(PG8_SB(0, 1), b2 + hstepB, voffB); PG8_STAGE_A(PG8_SA(0, 0), a2, 0, last);
            PG8_WAIT_V(8); PG8_WAIT_L(0); PG8_BAR; PG8_MMA(1, 0, At, B0); PG8_MMA(1, 1, At, B1); PG8_BAR; PG8_SCHED;
            PG8_LDB(B0, 1, 0); PG8_LDB(B1, 1, 1); PG8_SCHED; PG8_LDA(At, 1, 0); PG8_STAGE_A(PG8_SA(0, 1), a2, 1, last);
            PG8_WAIT_V(8); PG8_WAIT_L(0); PG8_BAR; PG8_MMA(0, 0, At, B0); PG8_MMA(0, 1, At, B1); PG8_BAR; PG8_SCHED;
            PG8_LDA(At, 1, 1); PG8_STAGE(PG8_SB(1, 0), b3, voffB); PG8_STAGE(PG8_SB(1, 1), b3 + hstepB, voffB); PG8_STAGE_A(PG8_SA(1, 0), a3, 0, last);
            PG8_WAIT_V(8); PG8_WAIT_L(0); PG8_BAR; PG8_MMA(1, 0, At, B0); PG8_MMA(1, 1, At, B1); PG8_BAR; PG8_SCHED;
            } else {
            PG8_LDB(B0, 0, 0); PG8_SCHED; PG8_LDA(At, 0, 0); PG8_STAGE(PG8_SA(1, 1), a1 + hstep, voffA);
            PG8_WAIT_L(8); PG8_BAR; PG8_WAIT_L(0); PG8_MMA(0, 0, At, B0); PG8_BAR; PG8_SCHED;
            PG8_LDB(B1, 0, 1); PG8_STAGE(PG8_SB(0, 0), b2, voffB);
            PG8_BAR; PG8_WAIT_L(0); PG8_MMA(0, 1, At, B1); PG8_BAR;
            PG8_LDA(At, 0, 1); PG8_STAGE(PG8_SA(0, 0), a2, voffA);
            PG8_BAR; PG8_WAIT_L(0); PG8_MMA(1, 0, At, B0); PG8_BAR; PG8_SCHED;
            PG8_STAGE(PG8_SB(0, 1), b2 + hstep, voffB);
            PG8_WAIT_V(6); PG8_BAR; PG8_MMA(1, 1, At, B1); PG8_BAR;
            PG8_LDB(B0, 1, 0); PG8_SCHED; PG8_LDA(At, 1, 0); PG8_STAGE(PG8_SA(0, 1), a2 + hstep, voffA);
            PG8_WAIT_L(8); PG8_BAR; PG8_WAIT_L(0); PG8_MMA(0, 0, At, B0); PG8_BAR; PG8_SCHED;
            PG8_LDB(B1, 1, 1); PG8_STAGE(PG8_SB(1, 0), b3, voffB);
            PG8_BAR; PG8_WAIT_L(0); PG8_MMA(0, 1, At, B1); PG8_BAR;
            PG8_LDA(At, 1, 1); PG8_STAGE(PG8_SA(1, 0), a3, voffA);
            PG8_BAR; PG8_WAIT_L(0); PG8_MMA(1, 0, At, B0); PG8_BAR; PG8_SCHED;
            PG8_STAGE(PG8_SB(1, 1), b3 + hstep, voffB);
            PG8_WAIT_V(6); PG8_BAR; PG8_MMA(1, 1, At, B1); PG8_BAR;
            }
        }
        if constexpr (ALIGN_EPI) { if (wr == 0) PG8_BAR; }
        if constexpr (!Epi::AFTER_DRAIN) { E(acc, cur, wr, wc, fr, fq); S.done(cur); }
        if (!has_next) break;
#pragma unroll
        for (int a = 0; a < 2; ++a)
#pragma unroll
            for (int b = 0; b < 2; ++b)
#pragma unroll
                for (int m = 0; m < 4; ++m)
#pragma unroll
                    for (int n = 0; n < 2; ++n) acc[a][b][m][n] = (f32x4){0.f, 0.f, 0.f, 0.f};
        cur = nxt; cA = nA; cB = nB; cB2 = nB2; ++ui;
        if constexpr (GATHER) { _Pragma("unroll") for (int _h = 0; _h < 2; ++_h) { vAc[_h][0] = vAn[_h][0]; vAc[_h][1] = vAn[_h][1]; } }
        if constexpr (ALIGN_EPI) { if (wr == 1) PG8_BAR; }
    }
    PG8_WAIT_V(0);
    if constexpr (!ALIGN_EPI) { if (wr == 0) PG8_BAR; }
    PG8_BAR;
    if constexpr (Epi::AFTER_DRAIN) { E.fused(acc, cur, wr, wc, fr, fq, lds, wid, lane); S.done(cur); }
#undef PG8_SA
#undef PG8_SB
#undef PG8_STAGE
#undef PG8_STAGE_A
#undef PG8_GIDX
#undef PG8_LDA
#undef PG8_LDB
#undef PG8_MMA
#undef PG8_WAIT_V
#undef PG8_WAIT_L
#undef PG8_BAR
#undef PG8_SCHED
}

template <class F> struct EpiAdapt {
    static constexpr bool PERM = true, AFTER_DRAIN = false; F f;
    __device__ __forceinline__ void mid(f32x4 (&acc)[2][2][4][2], const Unit& u, int wr, int wc, int fr, int fq) const {
        asm volatile("" : "+v"(fr), "+v"(fq));
#pragma unroll
        for (int ai = 0; ai < 2; ++ai)
#pragma unroll
            for (int m = 0; m < 4; ++m) { const int row = ai * HALF + wr * 64 + m * 16 + fr;
#pragma unroll
                for (int bj = 0; bj < 2; ++bj) { float v[8] = {acc[ai][bj][m][0][0], acc[ai][bj][m][0][1], acc[ai][bj][m][0][2], acc[ai][bj][m][0][3], acc[ai][bj][m][1][0], acc[ai][bj][m][1][1], acc[ai][bj][m][1][2], acc[ai][bj][m][1][3]};
                    f.mid8(u, row, bj * HALF + wc * 32 + 8 * fq, v);
                    acc[ai][bj][m][0] = (f32x4){v[0], v[1], v[2], v[3]}; acc[ai][bj][m][1] = (f32x4){v[4], v[5], v[6], v[7]}; } }
    }
    __device__ __forceinline__ void operator()(const f32x4 (&acc)[2][2][4][2], const Unit& u, int wr, int wc, int fr, int fq) const {
        asm volatile("" : "+v"(fr), "+v"(fq));
#pragma unroll
        for (int ai = 0; ai < 2; ++ai)
#pragma unroll
            for (int m = 0; m < 4; ++m) { const int row = ai * HALF + wr * 64 + m * 16 + fr;
#pragma unroll
                for (int bj = 0; bj < 2; ++bj) { const f32x4 v0 = acc[ai][bj][m][0], v1 = acc[ai][bj][m][1];
                    const float v[8] = {v0[0], v0[1], v0[2], v0[3], v1[0], v1[1], v1[2], v1[3]};
                    f.store8(u, row, bj * HALF + wc * 32 + 8 * fq, v); } }
    }
};
}

template <class Epi, class Sched>
__device__ __forceinline__ void gemm_phase_mid(LAS unsigned char* lds, const Gemm g, const Sched& S, const Epi& E, const int wave_in) {
    pg8::EpiAdapt<Epi> EA{E};
    pg8::gemm_phase<pg8::EpiAdapt<Epi>, Sched, true, true, false, true>(lds, g, S, EA, wave_in);
}
template <class Epi, class Sched>
__device__ __forceinline__ void gemm_phase_bseg(LAS unsigned char* lds, const Gemm g, const Sched& S, const Epi& E, const int wave_in) {
    pg8::EpiAdapt<Epi> EA{E};
    pg8::gemm_phase<pg8::EpiAdapt<Epi>, Sched, true, true, false, false, true>(lds, g, S, EA, wave_in);
}
template <class Epi, class Sched>
__device__ __forceinline__ void gemm_phase_gather(LAS unsigned char* lds, const Gemm g, const Sched& S, const Epi& E, const int wave_in) {
    pg8::EpiAdapt<Epi> EA{E};
    pg8::gemm_phase<pg8::EpiAdapt<Epi>, Sched, true, true, true>(lds, g, S, EA, wave_in);
}
template <class Epi, class Sched>
__device__ __forceinline__ void gemm_phase_any(LAS unsigned char* lds, const Gemm g, const Sched& S, const Epi& E, const int wave_in) {
#if ENG_GEMM == 1
    pg8::EpiAdapt<Epi> EA{E};
    pg8::gemm_phase<pg8::EpiAdapt<Epi>, Sched, true, true>(lds, g, S, EA, wave_in);
#else
    gemm_phase_naive<Epi, Sched>(lds, g, S, E);
#endif
}

template <class RowMap>
__device__ __forceinline__ void transpose_item(const float* W, int ldw, bf16* WT, int ldt, int koff, int k0, int n0, const RowMap& rm, LAS float* scr, int lane) {
#pragma unroll 8
    for (int i = 0; i < 32; ++i) { const int kk = 2 * i + (lane >> 5); scr[kk * 33 + (lane & 31)] = W[(size_t)(k0 + kk) * ldw + n0 + (lane & 31)]; }
    asm volatile("s_waitcnt lgkmcnt(0)" ::: "memory");
    const int c = lane & 7;
#pragma unroll
    for (int j = 0; j < 4; ++j) { const int n = (lane >> 3) + 8 * j; const LAS float* s = scr + (8 * c) * 33 + n;
        u32x4 o; o.x = pk2(s[0 * 33], s[1 * 33]); o.y = pk2(s[2 * 33], s[3 * 33]); o.z = pk2(s[4 * 33], s[5 * 33]); o.w = pk2(s[6 * 33], s[7 * 33]);
        *(u32x4*)(WT + (size_t)rm(n0 + n) * ldt + koff + k0 + 8 * c) = o; }
    asm volatile("s_waitcnt lgkmcnt(0)" ::: "memory");
}
struct RmId { int off; __device__ int operator()(int n) const { return off + n; } };
struct RmWin { __device__ int operator()(int n) const { return n < 1792 ? n : (n < 2208 ? 3840 + (n - 1792) : 1792 + (n - 2208)); } };
struct RmUkv { __device__ int operator()(int n) const { const int h = n >> 7, j = n & 127; return j < 64 ? h * 64 + j : 512 + h * 64 + (j - 64); } };
struct RmGU { int off; __device__ int operator()(int j) const { return off + 8 * (j >> 2) + (j & 3); } };

__device__ __forceinline__ void p0_prologue(const Frame& F, ArgsP a) {
    const int lane_f = lane_id_fresh(), tid_f = F.wave * 64 + lane_f;
    LAS float* scr = (LAS float*)(F.lds + F.wave * 16384);
    const int lane = lane_f;
    bf16* Win = (bf16*)(F.ws + WS_WIN); bf16* Wblk = (bf16*)(F.ws + WS_WBLK); bf16* Wg = (bf16*)(F.ws + WS_WG); bf16* Wuq = (bf16*)(F.ws + WS_WUQ);
    bf16* Wukv = (bf16*)(F.ws + WS_WUKV); bf16* Wb = (bf16*)(F.ws + WS_WB); bf16* Wo = (bf16*)(F.ws + WS_WO); bf16* Wgu = (bf16*)(F.ws + WS_WGU); bf16* Wdn = (bf16*)(F.ws + WS_WDN);
    constexpr int I_IN = 16 * 133, I_DEC = 1 * 16, I_AUP = 16, I_GUP = 2 * 16, I_UQ = 4 * 24, I_UKV = 2 * 32, I_BR = 2 * 8 * 32, I_O = 16 * 32;
    constexpr int I_EG = 32 * 16 * 8, I_EU = I_EG, I_ED = 32 * 4 * 32;
    constexpr int NITEMS = I_IN + I_DEC + I_AUP + I_GUP + I_UQ + I_UKV + I_BR + I_O + I_EG + I_EU + I_ED;
    for (int it = F.gw; it < NITEMS; it += F.NGW) {
        int r = it;
        if (r < I_IN) { const int kb = r / 133, nb = r % 133; transpose_item(a->in[I_WIN], D_IN, Win, 1024, 0, 64 * kb, 32 * nb, RmWin{}, scr, lane); continue; } r -= I_IN;
        if (r < I_DEC) { transpose_item(a->in[I_WDEC], 512, Wblk, 128, 0, 0, 32 * r, RmId{0}, scr, lane); continue; } r -= I_DEC;
        if (r < I_AUP) { transpose_item(a->in[I_WAUP], 512, Wblk, 128, 64, 0, 32 * r, RmId{512}, scr, lane); continue; } r -= I_AUP;
        if (r < I_GUP) { const int kb = r / 16, nb = r % 16; transpose_item(a->in[I_WGUP], 512, Wg, 128, 0, 64 * kb, 32 * nb, RmId{0}, scr, lane); continue; } r -= I_GUP;
        if (r < I_UQ) { const int kb = r / 24, nb = r % 24; transpose_item(a->in[I_WUQ], 768, Wuq, 256, 0, 64 * kb, 32 * nb, RmId{0}, scr, lane); continue; } r -= I_UQ;
        if (r < I_UKV) { const int kb = r / 32, nb = r % 32; transpose_item(a->in[I_WUKV], 1024, Wukv, 128, 0, 64 * kb, 32 * nb, RmUkv{}, scr, lane); continue; } r -= I_UKV;
        if (r < I_BR) { const int br = r / 256, q = r % 256, kb = q / 32, nb = q % 32; transpose_item(a->in[I_WBR] + (size_t)br * 512 * 1024, 1024, Wb, 1024, 512 * br, 64 * kb, 32 * nb, RmId{0}, scr, lane); continue; } r -= I_BR;
        if (r < I_O) { const int kb = r / 32, nb = r % 32; transpose_item(a->in[I_WOUT], 1024, Wo, 1024, 0, 64 * kb, 32 * nb, RmId{0}, scr, lane); continue; } r -= I_O;
        if (r < I_EG) { const int e = r / 128, q = r % 128, kb = q / 8, nb = q % 8; transpose_item(a->in[I_WEG] + (size_t)e * 1024 * 256, 256, Wgu + (size_t)e * 512 * 1024, 1024, 0, 64 * kb, 32 * nb, RmGU{0}, scr, lane); continue; } r -= I_EG;
        if (r < I_EU) { const int e = r / 128, q = r % 128, kb = q / 8, nb = q % 8; transpose_item(a->in[I_WEU] + (size_t)e * 1024 * 256, 256, Wgu + (size_t)e * 512 * 1024, 1024, 0, 64 * kb, 32 * nb, RmGU{4}, scr, lane); continue; } r -= I_EU;
        { const int e = r / 128, q = r % 128, kb = q / 32, nb = q % 32; transpose_item(a->in[I_WED] + (size_t)e * 256 * 1024, 1024, Wdn + (size_t)e * 1024 * 256, 256, 0, 64 * kb, 32 * nb, RmId{0}, scr, lane); }
    }
    for (int i = F.gw * 64 + lane; i < 96 * 128; i += F.NGW * 64) *(u32x4*)(Win + (size_t)4256 * 1024 + (size_t)i * 8) = (u32x4){0u, 0u, 0u, 0u};
    for (int i = F.gw * 64 + lane; i < 1024 * 8; i += F.NGW * 64) { const int row = i >> 3, c8 = (i & 7) * 8; *(u32x4*)(Wblk + row * 128 + (row < 512 ? 64 : 0) + c8) = (u32x4){0u, 0u, 0u, 0u}; }
    { const int* pos = (const int*)a->in[I_POS]; float* cs = (float*)(F.ws + WS_CS);
      for (int i = F.gw * 64 + lane; i < NTOK * 16; i += F.NGW * 64) { const int t = i >> 4, j = i & 15;
          const float fr = exp2f(-(float)j * (13.287712379549449f / 16.0f));
          const float ang = (float)pos[t] * fr; cs[t * 32 + j] = cosf(ang); cs[t * 32 + 16 + j] = sinf(ang); } }
    { float* mod = (float*)(F.ws + WS_MOD); const float* c = a->in[I_C]; const float* wa = a->in[I_WADA]; const float* ba = a->in[I_BADA];
      LAS float* red = (LAS float*)(F.lds + 8 * 16384);
      LAS float* sc = (LAS float*)F.lds;
      if (F.vcu < 96) {
          __syncthreads();
          for (int i = tid_f; i < 8192; i += NTHR) sc[i] = siluf_(c[i]);
          __syncthreads();
      }
      for (int nb = F.vcu; nb < 96; nb += F.G) {
          float acc[8];
#pragma unroll
          for (int b = 0; b < 8; ++b) acc[b] = 0.f;
          const int n = nb * 64 + lane;
          for (int k0 = F.wave * 128; k0 < F.wave * 128 + 128; k0 += 16) { float w[16];
#pragma unroll
              for (int kk = 0; kk < 16; ++kk) w[kk] = wa[(size_t)(k0 + kk) * 6144 + n];
#pragma unroll
              for (int kk = 0; kk < 16; ++kk)
#pragma unroll
                  for (int b = 0; b < 8; ++b) acc[b] = fmaf(sc[b * 1024 + k0 + kk], w[kk], acc[b]); }
#pragma unroll
          for (int b = 0; b < 8; ++b) red[(F.wave * 8 + b) * 64 + lane] = acc[b];
          __syncthreads();
          { const int b = F.wave; float s = ba[n];
#pragma unroll
            for (int w = 0; w < 8; ++w) s += red[(w * 8 + b) * 64 + lane];
            mod[b * 6144 + n] = s; }
          __syncthreads();
      } }
}

__device__ __forceinline__ void p_normmod(const Frame& F, const float* x, const float* g, const float* mod, int sh_off, int sc_off, bf16* H) {
    const int lane_f = lane_id_fresh();
    f32x4 xa[4], xb[4];
    { const f32x4* xr = (const f32x4*)(x + (size_t)F.gw * 1024) + lane_f;
#pragma unroll
      for (int j = 0; j < 4; ++j) xa[j] = xr[64 * j]; }
    f32x4 gs[4], sh[4]; int bcur = -1;
#define NM_ROW(CUR, NXT, m_) do { const int mm = (m_); const int b = mm / SEQ; \
        if (b != bcur) { bcur = b; \
            _Pragma("unroll") for (int j = 0; j < 4; ++j) { const int col = 4 * lane_f + 256 * j; gs[j] = *(const f32x4*)(g + col) * (*(const f32x4*)(mod + b * 6144 + sc_off + col) + 1.0f); sh[j] = *(const f32x4*)(mod + b * 6144 + sh_off + col); } \
            asm volatile("s_waitcnt vmcnt(0)" : "+v"(gs[0]), "+v"(gs[1]), "+v"(gs[2]), "+v"(gs[3]), "+v"(sh[0]), "+v"(sh[1]), "+v"(sh[2]), "+v"(sh[3]), "+v"(CUR[0]), "+v"(CUR[1]), "+v"(CUR[2]), "+v"(CUR[3])); } \
        { const int mn = (mm + F.NGW < NTOK) ? mm + F.NGW : mm; const f32x4* xr = (const f32x4*)(x + (size_t)mn * 1024) + lane_f; \
          _Pragma("unroll") for (int j = 0; j < 4; ++j) NXT[j] = xr[64 * j]; } \
        float s = 0.f; \
        _Pragma("unroll") for (int j = 0; j < 4; ++j) s += (CUR[j].x * CUR[j].x + CUR[j].y * CUR[j].y) + (CUR[j].z * CUR[j].z + CUR[j].w * CUR[j].w); \
        const float rstd = 1.0f / sqrtf(wave_sum(s) * (1.f / 1024.f) + EPS); \
        u32x2* o = (u32x2*)(H + (size_t)mm * 1024) + lane_f; \
        _Pragma("unroll") for (int j = 0; j < 4; ++j) { const f32x4 y = CUR[j] * rstd * gs[j] + sh[j]; u32x2 w; w.x = pk2(y.x, y.y); w.y = pk2(y.z, y.w); o[64 * j] = w; } } while (0)
    for (int m = F.gw; m < NTOK; m += 2 * F.NGW) {
        NM_ROW(xa, xb, m);
        if (m + F.NGW < NTOK) NM_ROW(xb, xa, m + F.NGW);
    }
#undef NM_ROW
}

__device__ __forceinline__ void p_prep_a(const Frame& F, ArgsP a) {
    const int lane_f = lane_id_fresh();
    const bf16* ZR = (const bf16*)(F.ws + WS_ZR); const bf16* ZM = (const bf16*)(F.ws + WS_ZM);
    bf16* TWA = (bf16*)(F.ws + WS_TWA); bf16* SGL = (bf16*)(F.ws + WS_SGL); bf16* QA = (bf16*)(F.ws + WS_QA); bf16* KVA = (bf16*)(F.ws + WS_KVA);
    const float* mu = a->in[I_MU]; const float* gqa = a->in[I_GQA]; const float* gkva = a->in[I_GKVA];
    const int lane = lane_f;
    const f32x4 mm = *(const f32x4*)(mu + 1536 + 4 * lane), gq = *(const f32x4*)(gqa + 4 * lane), gk = *(const f32x4*)(gkva + 4 * (lane & 31));
    for (int m0 = F.gw; m0 < NTOK; m0 += 4 * F.NGW) {
        u32x2 cc[4], pp[4], qq[4], kk[4];
#pragma unroll
        for (int u = 0; u < 4; ++u) { const int m = (m0 + u * F.NGW < NTOK) ? m0 + u * F.NGW : m0; const bool first = (m % SEQ) == 0;
            cc[u] = *((const u32x2*)(ZR + (size_t)m * 1792 + 1536) + lane); pp[u] = *((const u32x2*)(ZR + (size_t)(first ? m : m - 1) * 1792 + 1536) + lane);
            qq[u] = *((const u32x2*)(ZM + (size_t)m * 512) + lane); kk[u] = *((const u32x2*)(ZM + (size_t)m * 512 + 256) + (lane & 31)); }
#pragma unroll
        for (int u = 0; u < 4; ++u) { const int m = m0 + u * F.NGW; if (m < NTOK) { const bool first = (m % SEQ) == 0;
            { const u32x2 c = cc[u]; u32x2 p = pp[u]; if (first) { p.x = 0u; p.y = 0u; }
              float z[4] = {lo2f(c.x), hi2f(c.x), lo2f(c.y), hi2f(c.y)}; const float q[4] = {lo2f(p.x), hi2f(p.x), lo2f(p.y), hi2f(p.y)};
              z[0] += (q[0] - z[0]) * mm.x; z[1] += (q[1] - z[1]) * mm.y; z[2] += (q[2] - z[2]) * mm.z; z[3] += (q[3] - z[3]) * mm.w;
              if (lane < 16) { u32x2 w; w.x = pk2(tanhf_(z[0]), tanhf_(z[1])); w.y = pk2(tanhf_(z[2]), tanhf_(z[3])); *((u32x2*)(TWA + (size_t)m * 128) + lane) = w; }
              else if (lane < 32) { u32x2 w; w.x = pk2(z[0], z[1]); w.y = pk2(z[2], z[3]); *((u32x2*)(TWA + (size_t)m * 128) + lane) = w; }
              else { u32x2 w; w.x = pk2(sigmoidf_(z[0]), sigmoidf_(z[1])); w.y = pk2(sigmoidf_(z[2]), sigmoidf_(z[3])); *((u32x2*)(SGL + (size_t)m * 128) + (lane - 32)) = w; } }
            { const u32x2 c = qq[u]; const float z[4] = {lo2f(c.x), hi2f(c.x), lo2f(c.y), hi2f(c.y)};
              u32x2 c2 = kk[u]; if (lane >= 32) { c2.x = 0u; c2.y = 0u; } const float y[4] = {lo2f(c2.x), hi2f(c2.x), lo2f(c2.y), hi2f(c2.y)};
              const float rstd = 1.0f / sqrtf(wave_sum((z[0] * z[0] + z[1] * z[1]) + (z[2] * z[2] + z[3] * z[3])) * (1.f / 256.f) + EPS);
              const float rstd2 = 1.0f / sqrtf(wave_sum((y[0] * y[0] + y[1] * y[1]) + (y[2] * y[2] + y[3] * y[3])) * (1.f / 128.f) + EPS);
              u32x2 w; w.x = pk2(z[0] * rstd * gq.x, z[1] * rstd * gq.y); w.y = pk2(z[2] * rstd * gq.z, z[3] * rstd * gq.w);
              *((u32x2*)(QA + (size_t)m * 256) + lane) = w;
              if (lane < 32) { u32x2 w2; w2.x = pk2(y[0] * rstd2 * gk.x, y[1] * rstd2 * gk.y); w2.y = pk2(y[2] * rstd2 * gk.z, y[3] * rstd2 * gk.w);
                  *((u32x2*)(KVA + (size_t)m * 128) + lane) = w2; } } } }
    }
}

__device__ __forceinline__ void p_prep_c(const Frame& F, ArgsP a) {
    const int lane_f = lane_id_fresh();
    const bf16* KN = (const bf16*)(F.dob + DO_KN); const bf16* ZM = (const bf16*)(F.ws + WS_ZM); bf16* KC = (bf16*)(F.ws + WS_KC);
    const float* cs = (const float*)(F.ws + WS_CS); const float* kn = a->in[I_KN];
    const int lane = lane_f, hd = lane >> 3, j = lane & 7;
    const f32x4 kg0 = *(const f32x4*)(kn + 8 * j), kg1 = *(const f32x4*)(kn + 8 * j + 4); const f32x2 kr1 = *(const f32x2*)(kn + 64 + 2 * j), kr2 = *(const f32x2*)(kn + 80 + 2 * j);
    for (int m0 = F.gw; m0 < NTOK; m0 += 4 * F.NGW) {
        u32x4 kv[4]; unsigned z1[4], z2[4]; f32x2 cc[4], sn[4];
#pragma unroll
        for (int u = 0; u < 4; ++u) { const size_t m = (size_t)((m0 + u * F.NGW < NTOK) ? m0 + u * F.NGW : m0);
            kv[u] = *(const u32x4*)(KN + m * 512 + hd * 64 + 8 * j); z1[u] = *(const unsigned*)(ZM + m * 512 + 384 + 2 * j); z2[u] = *(const unsigned*)(ZM + m * 512 + 400 + 2 * j);
            cc[u] = *(const f32x2*)(cs + m * 32 + 2 * j); sn[u] = *(const f32x2*)(cs + m * 32 + 16 + 2 * j); }
#pragma unroll
        for (int u = 0; u < 4; ++u) { const int m = m0 + u * F.NGW; if (m < NTOK) {
            float v[8]; unpack8(kv[u], v); float x1[2] = {lo2f(z1[u]), hi2f(z1[u])}, x2[2] = {lo2f(z2[u]), hi2f(z2[u])};
            float ss = (x1[0] * x1[0] + x1[1] * x1[1]) + (x2[0] * x2[0] + x2[1] * x2[1]);
#pragma unroll
            for (int i = 0; i < 8; ++i) ss += v[i] * v[i];
            const float rstd = 1.0f / sqrtf(sum8(ss) * (1.f / 96.f) + EPS);
            v[0] *= rstd * kg0.x; v[1] *= rstd * kg0.y; v[2] *= rstd * kg0.z; v[3] *= rstd * kg0.w; v[4] *= rstd * kg1.x; v[5] *= rstd * kg1.y; v[6] *= rstd * kg1.z; v[7] *= rstd * kg1.w;
            x1[0] *= rstd * kr1.x; x1[1] *= rstd * kr1.y; x2[0] *= rstd * kr2.x; x2[1] *= rstd * kr2.y;
            bf16* kp = KC + (size_t)m * 768 + hd * 96;
            *(u32x4*)(kp + 8 * j) = pack8(v); *(unsigned*)(kp + 64 + 2 * j) = pk2(x1[0] * cc[u].x - x2[0] * sn[u].x, x1[1] * cc[u].y - x2[1] * sn[u].y);
            *(unsigned*)(kp + 80 + 2 * j) = pk2(x2[0] * cc[u].x + x1[0] * sn[u].x, x2[1] * cc[u].y + x1[1] * sn[u].y); } }
    }
}

__device__ __forceinline__ void p_attn_naive(const Frame& F) {
    const int lane_f = lane_id_fresh(), tid_f = F.wave * 64 + lane_f;
    const bf16* Q = (const bf16*)(F.dob + DO_Q); const bf16* KC = (const bf16*)(F.ws + WS_KC); const bf16* VC = (const bf16*)(F.ws + WS_VC); bf16* YM = (bf16*)(F.ws + WS_YM);
    LAS float* Ks = (LAS float*)F.lds; LAS float* Vs = (LAS float*)(F.lds + 32 * 96 * 4);
    const int tid = tid_f;
    for (int unit = F.vcu; unit < 64 * 16; unit += F.G) {
        const int bh = unit >> 4, qb = 15 - (unit & 15), b = bh >> 3, h = bh & 7; const size_t row0 = (size_t)b * SEQ; const int t = qb * 512 + tid;
        unsigned qp[48];
        { const u32x4* qg = (const u32x4*)(Q + (row0 + t) * 768 + h * 96);
#pragma unroll
          for (int i = 0; i < 12; ++i) { const u32x4 w = qg[i]; qp[4 * i] = w.x; qp[4 * i + 1] = w.y; qp[4 * i + 2] = w.z; qp[4 * i + 3] = w.w; } }
        float o[64];
#pragma unroll
        for (int i = 0; i < 64; ++i) o[i] = 0.f;
        float mx = -INFINITY, l = 0.f;
        const int nkt = (qb + 1) * 16;
        for (int kt = 0; kt < nkt; ++kt) {
            __syncthreads();
            if (tid < 384) { const int r = tid / 12, c8 = (tid % 12) * 8; float v[8]; unpack8(*(const u32x4*)(KC + (row0 + kt * 32 + r) * 768 + h * 96 + c8), v);
#pragma unroll
                for (int i = 0; i < 8; ++i) Ks[r * 96 + c8 + i] = v[i]; }
            if (tid < 256) { const int r = tid >> 3, c8 = (tid & 7) * 8; float v[8]; unpack8(*(const u32x4*)(VC + (row0 + kt * 32 + r) * 512 + h * 64 + c8), v);
#pragma unroll
                for (int i = 0; i < 8; ++i) Vs[r * 64 + c8 + i] = v[i]; }
            __syncthreads();
            for (int kk = 0; kk < 32; ++kk) {
                const int kv = kt * 32 + kk;
                float s = 0.f; const LAS f32x4* kr = (const LAS f32x4*)(Ks + kk * 96);
#pragma unroll
                for (int i = 0; i < 24; ++i) { const f32x4 k4 = kr[i]; s += lo2f(qp[2 * i]) * k4.x + hi2f(qp[2 * i]) * k4.y + lo2f(qp[2 * i + 1]) * k4.z + hi2f(qp[2 * i + 1]) * k4.w; }
                if (kv <= t) {
                    const float mn = fmaxf(mx, s), f = exp2f(mx - mn), p = exp2f(s - mn); mx = mn; l = l * f + p;
                    const LAS f32x4* vr = (const LAS f32x4*)(Vs + kk * 64);
#pragma unroll
                    for (int i = 0; i < 16; ++i) { const f32x4 v4 = vr[i]; o[4 * i] = o[4 * i] * f + p * v4.x; o[4 * i + 1] = o[4 * i + 1] * f + p * v4.y; o[4 * i + 2] = o[4 * i + 2] * f + p * v4.z; o[4 * i + 3] = o[4 * i + 3] * f + p * v4.w; }
                }
            }
        }
        const float il = 1.f / l; u32x4* og = (u32x4*)(YM + (row0 + t) * 512 + h * 64);
#pragma unroll
        for (int i = 0; i < 8; ++i) { u32x4 w; w.x = pk2(o[8 * i] * il, o[8 * i + 1] * il); w.y = pk2(o[8 * i + 2] * il, o[8 * i + 3] * il); w.z = pk2(o[8 * i + 4] * il, o[8 * i + 5] * il); w.w = pk2(o[8 * i + 6] * il, o[8 * i + 7] * il); og[i] = w; }
    }
    __syncthreads();
}

typedef float f32x16 __attribute__((ext_vector_type(16)));
typedef short s16x4 __attribute__((ext_vector_type(4)));
__device__ __forceinline__ int crow(int r, int hi) { return (r & 3) + 8 * (r >> 2) + 4 * hi; }
__device__ __forceinline__ float max3f(float a, float b, float c) { float r; asm("v_max3_f32 %0, %1, %2, %3" : "=v"(r) : "v"(a), "v"(b), "v"(c)); return r; }
__device__ __forceinline__ float max2f(float a, float b) { float r; asm("v_max_f32_e32 %0, %1, %2" : "=v"(r) : "v"(a), "v"(b)); return r; }
__device__ __forceinline__ float xhalf_max(float x) { auto rr = __builtin_amdgcn_permlane32_swap(__float_as_uint(x), __float_as_uint(x), false, false); return max2f(__uint_as_float(rr[0]), __uint_as_float(rr[1])); }
__device__ __forceinline__ float xhalf_sum(float x) { auto rr = __builtin_amdgcn_permlane32_swap(__float_as_uint(x), __float_as_uint(x), false, false); return __uint_as_float(rr[0]) + __uint_as_float(rr[1]); }
__device__ __forceinline__ bf16x8 packp(const f32x16& p, int s2) {
    u32x4 w; w.x = pk2(p[8 * s2 + 0], p[8 * s2 + 1]); w.y = pk2(p[8 * s2 + 2], p[8 * s2 + 3]); w.z = pk2(p[8 * s2 + 4], p[8 * s2 + 5]); w.w = pk2(p[8 * s2 + 6], p[8 * s2 + 7]);
    return __builtin_bit_cast(bf16x8, w);
}
template <bool BOUNDED>
__device__ __forceinline__ void p_attn_body(const Frame& F, const float* qn) {
    const int lane_f = lane_id_fresh(), tid_f = F.wave * 64 + lane_f;
    const bf16* Q = (const bf16*)(F.dob + DO_Q); const bf16* KC = (const bf16*)(F.ws + WS_KC); const bf16* VC = (const bf16*)(F.ws + WS_VC); bf16* YM = (bf16*)(F.ws + WS_YM);
    const float* cs = (const float*)(F.ws + WS_CS);
    constexpr int KST = 208, VST = 192, KBYTES = 64 * KST, SUB = KBYTES + 64 * VST, BUF = 2 * SUB;
    const int tid = tid_f, lane = lane_f, wave = F.wave, r = lane & 31, hi = lane >> 5;
    int kg[3], kl[3], vg[2], vl[2];
#pragma unroll
    for (int i = 0; i < 3; ++i) { const int c = tid + 512 * i, row = c / 12, pc = c % 12; kg[i] = row * 768 + pc * 8; kl[i] = (row >> 6) * SUB + (row & 63) * KST + pc * 16; }
#pragma unroll
    for (int i = 0; i < 2; ++i) { const int c = tid + 512 * i, row = c >> 3, pc = c & 7; vg[i] = row * 512 + pc * 8; vl[i] = (row >> 6) * SUB + KBYTES + (row & 63) * VST + pc * 16; }
    const int g4 = lane >> 4, li = lane & 15;
    const int vtr = (4 * (g4 >> 1) + (li >> 2)) * VST + (16 * (g4 & 1) + 4 * (li & 3)) * 2;
    const int kfr = r * KST + hi * 16;
    LAS unsigned char* lds = F.lds;
    for (int item = F.vcu; item < 1024; item += F.G) {
        const int bh = item >> 4, sidx = item & 15, b = bh >> 3, h = bh & 7; const size_t row0 = (size_t)b * SEQ;
        const bf16* Kg = KC + row0 * 768 + h * 96; const bf16* Vg = VC + row0 * 512 + h * 64;
        for (int uu = 0; uu < 2; ++uu) {
            const int qb = uu == 0 ? 31 - sidx : sidx, q0 = qb * 256, NT = (q0 + 256) / 128;
            const int qw = q0 + wave * 32;
            bf16x8 qf[6];
            {
              const bf16* qp = Q + (row0 + qw + r) * 768 + h * 96 + hi * 8; const float* csr = cs + (row0 + qw + r) * 32 + 8 * hi;
              u32x4 raw[6];
#pragma unroll
              for (int s = 0; s < 6; ++s) raw[s] = *(const u32x4*)(qp + 16 * s);
              const f32x4 c0 = *(const f32x4*)csr, c1 = *(const f32x4*)(csr + 4), s0 = *(const f32x4*)(csr + 16), s1 = *(const f32x4*)(csr + 20);
              float ss = 0.f;
#pragma unroll
              for (int s = 0; s < 6; ++s) { float t[8]; unpack8(raw[s], t);
#pragma unroll
                  for (int e = 0; e < 8; ++e) ss += t[e] * t[e]; }
              const float rstd = QSCALE / sqrtf(xhalf_sum(ss) * (1.f / 96.f) + EPS);
#pragma unroll
              for (int s = 0; s < 4; ++s) { float t[8]; unpack8(raw[s], t); const f32x4 g0 = *(const f32x4*)(qn + 16 * s + 8 * hi), g1 = *(const f32x4*)(qn + 16 * s + 8 * hi + 4);
                  t[0] *= rstd * g0.x; t[1] *= rstd * g0.y; t[2] *= rstd * g0.z; t[3] *= rstd * g0.w; t[4] *= rstd * g1.x; t[5] *= rstd * g1.y; t[6] *= rstd * g1.z; t[7] *= rstd * g1.w;
                  qf[s] = __builtin_bit_cast(bf16x8, pack8(t)); }
              { float a4[8], a5[8]; unpack8(raw[4], a4); unpack8(raw[5], a5);
                const f32x4 g0 = *(const f32x4*)(qn + 64 + 8 * hi), g1 = *(const f32x4*)(qn + 64 + 8 * hi + 4), h0 = *(const f32x4*)(qn + 80 + 8 * hi), h1 = *(const f32x4*)(qn + 80 + 8 * hi + 4);
                const float ga[8] = {g0.x, g0.y, g0.z, g0.w, g1.x, g1.y, g1.z, g1.w}, gb[8] = {h0.x, h0.y, h0.z, h0.w, h1.x, h1.y, h1.z, h1.w};
                const float cc[8] = {c0.x, c0.y, c0.z, c0.w, c1.x, c1.y, c1.z, c1.w}, sn[8] = {s0.x, s0.y, s0.z, s0.w, s1.x, s1.y, s1.z, s1.w};
#pragma unroll
                for (int e = 0; e < 8; ++e) { const float x1 = a4[e] * rstd * ga[e], x2 = a5[e] * rstd * gb[e]; a4[e] = x1 * cc[e] - x2 * sn[e]; a5[e] = x2 * cc[e] + x1 * sn[e]; }
                qf[4] = __builtin_bit_cast(bf16x8, pack8(a4)); qf[5] = __builtin_bit_cast(bf16x8, pack8(a5)); } }
            f32x16 o0 = {}, o1 = {}, negm = {}; float m = 0.f, l = 0.f;
            u32x4 ak[3], av[2];
#pragma unroll
            for (int i = 0; i < 3; ++i) ak[i] = *(const u32x4*)(Kg + kg[i]);
#pragma unroll
            for (int i = 0; i < 2; ++i) av[i] = *(const u32x4*)(Vg + vg[i]);
            asm volatile("" : "+v"(qf[0]), "+v"(qf[1]), "+v"(qf[2]), "+v"(qf[3]), "+v"(qf[4]), "+v"(qf[5]));
            LDS_BAR();
#pragma unroll
            for (int i = 0; i < 3; ++i) *(LAS u32x4*)(lds + kl[i]) = ak[i];
#pragma unroll
            for (int i = 0; i < 2; ++i) *(LAS u32x4*)(lds + vl[i]) = av[i];
            LDS_BAR();
            for (int t = 0; t < NT; ++t) {
                LAS unsigned char* bb = lds + (t & 1) * BUF;
                { const int tn = (t + 1 < NT) ? t + 1 : t;
                  const bf16* kgp = Kg + (size_t)tn * 128 * 768; const bf16* vgp = Vg + (size_t)tn * 128 * 512;
#pragma unroll
                  for (int i = 0; i < 3; ++i) ak[i] = *(const u32x4*)(kgp + kg[i]);
#pragma unroll
                  for (int i = 0; i < 2; ++i) av[i] = *(const u32x4*)(vgp + vg[i]); }
#pragma unroll
                for (int sub = 0; sub < 2; ++sub) {
                    const int tt = 2 * t + sub;
                    if (64 * tt <= qw + 31) {
                        LAS unsigned char* kb = bb + sub * SUB; LAS unsigned char* vb = kb + KBYTES;
                        bf16x8 kf0[6], kf1[6];
#pragma unroll
                        for (int s = 0; s < 6; ++s) { kf0[s] = *(const LAS bf16x8*)(kb + kfr + s * 32); kf1[s] = *(const LAS bf16x8*)(kb + kfr + 32 * KST + s * 32); }
                        __builtin_amdgcn_sched_barrier(0);
                        f32x16 p0 = negm, p1 = negm;
#pragma unroll
                        for (int s = 0; s < 6; ++s) { p0 = __builtin_amdgcn_mfma_f32_32x32x16_bf16(kf0[s], qf[s], p0, 0, 0, 0); p1 = __builtin_amdgcn_mfma_f32_32x32x16_bf16(kf1[s], qf[s], p1, 0, 0, 0); }
                        if (64 * tt + 63 > qw) {
                            int hm = hi; asm volatile("" : "+v"(hm));
                            const int qrel = qw + r - 64 * tt - 4 * hm;
#pragma unroll
                            for (int rg = 0; rg < 16; ++rg) { const int kv = (rg & 3) + 8 * (rg >> 2); if (kv > qrel) p0[rg] = -INFINITY; if (kv + 32 > qrel) p1[rg] = -INFINITY; }
                        }
                        if constexpr (!BOUNDED) {
                        float mx;
                        { float a = max3f(p0[0], p0[1], p1[0]), b2 = max3f(p0[2], p0[3], p1[1]); a = max3f(a, p1[2], p1[3]);
#pragma unroll
                          for (int rg = 4; rg < 16; rg += 4) { a = max3f(a, p0[rg], p0[rg + 1]); b2 = max3f(b2, p0[rg + 2], p0[rg + 3]); a = max3f(a, p1[rg], p1[rg + 1]); b2 = max3f(b2, p1[rg + 2], p1[rg + 3]); }
                          mx = xhalf_max(max2f(a, b2)); }
                        if (!__all(mx <= 8.0f)) {
                            const float dl = max2f(mx, 0.f), f = __builtin_amdgcn_exp2f(-dl); m += dl; l *= f;
#pragma unroll
                            for (int rg = 0; rg < 16; ++rg) { p0[rg] -= dl; p1[rg] -= dl; o0[rg] *= f; o1[rg] *= f; negm[rg] = -m; }
                        }
                        }
                        float rs = 0.f;
#pragma unroll
                        for (int rg = 0; rg < 16; ++rg) { p0[rg] = __builtin_amdgcn_exp2f(p0[rg]); p1[rg] = __builtin_amdgcn_exp2f(p1[rg]); rs += p0[rg] + p1[rg]; }
                        l += rs;
#pragma unroll
                        for (int hh = 0; hh < 2; ++hh)
#pragma unroll
                            for (int s2 = 0; s2 < 2; ++s2) { const bf16x8 pf = packp(hh == 0 ? p0 : p1, s2);
#pragma unroll
                                for (int db = 0; db < 2; ++db) { LAS unsigned char* vp_ = vb + vtr + (32 * hh + 16 * s2) * VST + db * 64;
                                    const s16x4 lo = __builtin_bit_cast(s16x4, __builtin_amdgcn_ds_read_tr16_b64_v4i16((LAS s16x4*)vp_));
                                    const s16x4 hi4 = __builtin_bit_cast(s16x4, __builtin_amdgcn_ds_read_tr16_b64_v4i16((LAS s16x4*)(vp_ + 8 * VST)));
                                    const bf16x8 vf = (bf16x8){lo[0], lo[1], lo[2], lo[3], hi4[0], hi4[1], hi4[2], hi4[3]};
                                    if (db == 0) o0 = __builtin_amdgcn_mfma_f32_32x32x16_bf16(vf, pf, o0, 0, 0, 0); else o1 = __builtin_amdgcn_mfma_f32_32x32x16_bf16(vf, pf, o1, 0, 0, 0); } }
                    }
                }
                { LAS unsigned char* nb = lds + ((t + 1) & 1) * BUF;
#pragma unroll
                  for (int i = 0; i < 3; ++i) *(LAS u32x4*)(nb + kl[i]) = ak[i];
#pragma unroll
                  for (int i = 0; i < 2; ++i) *(LAS u32x4*)(nb + vl[i]) = av[i]; }
                LDS_BAR();
            }
            const float il = 1.0f / xhalf_sum(l);
            bf16* op = YM + (row0 + qw + r) * YYLD + h * 64 + 4 * hi;
#pragma unroll
            for (int gq = 0; gq < 4; ++gq) { u32x2 w0, w1;
                w0.x = pk2(o0[4 * gq] * il, o0[4 * gq + 1] * il); w0.y = pk2(o0[4 * gq + 2] * il, o0[4 * gq + 3] * il);
                w1.x = pk2(o1[4 * gq] * il, o1[4 * gq + 1] * il); w1.y = pk2(o1[4 * gq + 2] * il, o1[4 * gq + 3] * il);
                *(u32x2*)(op + 8 * gq) = w0; *(u32x2*)(op + 32 + 8 * gq) = w1; }
        }
    }
    __syncthreads();
}

__device__ __forceinline__ void p_attn_mfma(const Frame& F, const float* qn, const float* kn) {
    const int lane = lane_id_fresh();
    float gq = fmaxf(fabsf(qn[lane]), lane < 32 ? fabsf(qn[64 + lane]) : 0.f), gk = fmaxf(fabsf(kn[lane]), lane < 32 ? fabsf(kn[64 + lane]) : 0.f);
#pragma unroll
    for (int d = 32; d >= 1; d >>= 1) { gq = fmaxf(gq, __shfl_xor(gq, d, 64)); gk = fmaxf(gk, __shfl_xor(gk, d, 64)); }
    const float bound = __builtin_bit_cast(float, __builtin_amdgcn_readfirstlane(__builtin_bit_cast(int, 96.f * QSCALE * 1.02f * gq * gk)));
    if (bound <= 60.f) p_attn_body<true>(F, qn); else p_attn_body<false>(F, qn);
}

constexpr int CS_CH = 256, CS_NCH = SEQ / CS_CH;
constexpr int CS_RS = 144;
constexpr int CS_IMG = 16 * CS_RS;
constexpr int CS_WAVE = 8 * CS_IMG + 512;
enum { IM_A = 0, IM_R = 1, IM_B = 2, IM_K = 3, IM_BH = 4, IM_KH = 5, IM_V = 6, IM_G = 7 };
constexpr size_t DO_CSP = 64 * MiB, DO_CSG = 128 * MiB, DO_CSZ = 192 * MiB;
__device__ __forceinline__ int crow8(int q, int hi) { return (q & 3) + 8 * ((q >> 2) & 1) + 4 * hi; }
template <int N> __device__ __forceinline__ float dpp_shr0(float x) { return __builtin_bit_cast(float, __builtin_amdgcn_update_dpp(0, __builtin_bit_cast(int, x), 0x110 + N, 0xf, 0xf, true)); }
__device__ __forceinline__ float rowscan16(float x) { x += dpp_shr0<1>(x); x += dpp_shr0<2>(x); x += dpp_shr0<4>(x); x += dpp_shr0<8>(x); return x; }
__device__ __forceinline__ float xsum_16_32(float v) {
    { auto r = __builtin_amdgcn_permlane16_swap(__float_as_uint(v), __float_as_uint(v), false, false); v = __uint_as_float(r[0]) + __uint_as_float(r[1]); }
    { auto r = __builtin_amdgcn_permlane32_swap(__float_as_uint(v), __float_as_uint(v), false, false); v = __uint_as_float(r[0]) + __uint_as_float(r[1]); }
    return v;
}
__device__ __forceinline__ bf16x8 cs_rowfrag(const LAS unsigned char* rowp, int hi, int ks) {
    const LAS unsigned char* p = rowp + (16 * ks + 4 * hi) * 2; const u32x2 a = *(const LAS u32x2*)p, b = *(const LAS u32x2*)(p + 16);
    return __builtin_bit_cast(bf16x8, (u32x4){a.x, a.y, b.x, b.y});
}
__device__ __forceinline__ bf16x8 cs_trfrag(LAS unsigned char* img, int cb, int lane) {
    const int g4 = lane >> 4, li = lane & 15; LAS unsigned char* p = img + (4 * (g4 >> 1) + (li >> 2)) * CS_RS + (32 * cb + 16 * (g4 & 1) + 4 * (li & 3)) * 2;
    const s16x4 lo = __builtin_bit_cast(s16x4, __builtin_amdgcn_ds_read_tr16_b64_v4i16((LAS s16x4*)p));
    const s16x4 h4 = __builtin_bit_cast(s16x4, __builtin_amdgcn_ds_read_tr16_b64_v4i16((LAS s16x4*)(p + 8 * CS_RS)));
    return (bf16x8){lo[0], lo[1], lo[2], lo[3], h4[0], h4[1], h4[2], h4[3]};
}
__device__ __forceinline__ bf16x8 cs_zero8() { return (bf16x8){0, 0, 0, 0, 0, 0, 0, 0}; }
struct CsIn { const bf16 *ZR, *A, *LW, *G; const float *mu, *k_k, *k_a, *r_k; };
template <bool USE_V, bool WITH_Y>
__device__ __forceinline__ void cs_prep(const CsIn& in, size_t row0, int tok0, int h, LAS unsigned char* wl, int lane) {
    const int t = lane & 15, jq = lane >> 4, tok = tok0 + t; const bool first = tok == 0;
    const size_t g = row0 + tok, gp = row0 + (first ? 0 : tok - 1); const int c0 = h * 64 + 16 * jq;
    LAS float* gct = (LAS float*)(wl + 8 * CS_IMG); LAS float* btt = gct + 64;
    u32x4 Lrc[2], Lrp[2], Lkc[2], Lkp[2], Lav[2], Llw[2], Lvc[2], Lvp[2];
#pragma unroll
    for (int hf = 0; hf < 2; ++hf) { const int cc = c0 + 8 * hf;
        Lkc[hf] = *(const u32x4*)(in.ZR + g * 1792 + 512 + cc); Lkp[hf] = *(const u32x4*)(in.ZR + gp * 1792 + 512 + cc);
        Lrc[hf] = *(const u32x4*)(in.ZR + g * 1792 + cc); Lrp[hf] = *(const u32x4*)(in.ZR + gp * 1792 + cc);
        Lav[hf] = *(const u32x4*)(in.A + g * 512 + cc); Llw[hf] = *(const u32x4*)(in.LW + g * 512 + cc);
        if (USE_V) { Lvc[hf] = *(const u32x4*)(in.ZR + g * 1792 + 1024 + cc); Lvp[hf] = *(const u32x4*)(in.ZR + gp * 1792 + 1024 + cc); }
    }
    float inv;
    { float ss = 0.f;
#pragma unroll
      for (int hf = 0; hf < 2; ++hf) { float kc[8], kp[8]; unpack8(Lkc[hf], kc); unpack8(Lkp[hf], kp);
          const f32x4 m0 = *(const f32x4*)(in.mu + 512 + c0 + 8 * hf), m1 = *(const f32x4*)(in.mu + 512 + c0 + 8 * hf + 4), q0 = *(const f32x4*)(in.k_k + c0 + 8 * hf), q1 = *(const f32x4*)(in.k_k + c0 + 8 * hf + 4);
          const float mm[8] = {m0.x, m0.y, m0.z, m0.w, m1.x, m1.y, m1.z, m1.w}, qq[8] = {q0.x, q0.y, q0.z, q0.w, q1.x, q1.y, q1.z, q1.w};
#pragma unroll
          for (int e = 0; e < 8; ++e) { const float zk = kc[e] + ((first ? 0.f : kp[e]) - kc[e]) * mm[e]; const float kr = zk * qq[e]; ss += kr * kr; } }
      inv = 1.0f / fmaxf(sqrtf(xsum_16_32(ss)), 1e-12f); }
    float btacc = 0.f;
#pragma unroll
    for (int hf = 0; hf < 2; ++hf) {
        const int cc = c0 + 8 * hf;
        u32x4 Lgg = {}; if (WITH_Y) Lgg = *(const u32x4*)(in.G + g * 512 + cc);
        float rc[8], rp[8], kc[8], kp[8], av[8], lw[8];
        unpack8(Lrc[hf], rc); unpack8(Lrp[hf], rp); unpack8(Lkc[hf], kc); unpack8(Lkp[hf], kp); unpack8(Lav[hf], av); unpack8(Llw[hf], lw);
        float mr[8], mk[8], qk[8], qa[8], qr[8];
        { const f32x4 a0 = *(const f32x4*)(in.mu + cc), a1 = *(const f32x4*)(in.mu + cc + 4), b0 = *(const f32x4*)(in.mu + 512 + cc), b1 = *(const f32x4*)(in.mu + 512 + cc + 4);
          const f32x4 c0_ = *(const f32x4*)(in.k_k + cc), c1_ = *(const f32x4*)(in.k_k + cc + 4), d0 = *(const f32x4*)(in.k_a + cc), d1 = *(const f32x4*)(in.k_a + cc + 4);
          mr[0] = a0.x; mr[1] = a0.y; mr[2] = a0.z; mr[3] = a0.w; mr[4] = a1.x; mr[5] = a1.y; mr[6] = a1.z; mr[7] = a1.w;
          mk[0] = b0.x; mk[1] = b0.y; mk[2] = b0.z; mk[3] = b0.w; mk[4] = b1.x; mk[5] = b1.y; mk[6] = b1.z; mk[7] = b1.w;
          qk[0] = c0_.x; qk[1] = c0_.y; qk[2] = c0_.z; qk[3] = c0_.w; qk[4] = c1_.x; qk[5] = c1_.y; qk[6] = c1_.z; qk[7] = c1_.w;
          qa[0] = d0.x; qa[1] = d0.y; qa[2] = d0.z; qa[3] = d0.w; qa[4] = d1.x; qa[5] = d1.y; qa[6] = d1.z; qa[7] = d1.w; }
        if (WITH_Y) { const f32x4 e0 = *(const f32x4*)(in.r_k + cc), e1 = *(const f32x4*)(in.r_k + cc + 4); qr[0] = e0.x; qr[1] = e0.y; qr[2] = e0.z; qr[3] = e0.w; qr[4] = e1.x; qr[5] = e1.y; qr[6] = e1.z; qr[7] = e1.w; }
        float oA[8], oR[8], oB[8], oK[8], oBH[8], oKH[8];
#pragma unroll
        for (int e = 0; e < 8; ++e) {
            const float r = rc[e] + ((first ? 0.f : rp[e]) - rc[e]) * mr[e]; const float zk = kc[e] + ((first ? 0.f : kp[e]) - kc[e]) * mk[e];
            const float kq = zk * (1.f + (av[e] - 1.f) * qa[e]); const float kk = zk * qk[e] * inv; const float b = kk * av[e];
            const float Lg = rowscan16(lw[e]); const float eLg = __builtin_amdgcn_exp2f(1.4426950408889634f * Lg); const float enLg = __builtin_amdgcn_rcpf(eLg);
            const float eLgm = __builtin_bit_cast(float, __builtin_amdgcn_update_dpp(0x3f800000, __builtin_bit_cast(int, eLg), 0x111, 0xf, 0xf, false));
            const float eC = __builtin_bit_cast(float, __builtin_amdgcn_ds_bpermute(((lane & 48) | 15) << 2, __builtin_bit_cast(int, eLg)));
            oA[e] = -kk * eLgm; oR[e] = r * eLg; oB[e] = b * enLg; oK[e] = kq * enLg; oBH[e] = oB[e] * eC; oKH[e] = oK[e] * eC;
            if (WITH_Y) btacc += r * kq * qr[e];
            if (t == 15) gct[16 * jq + 8 * hf + e] = eC;
        }
        const int wo = t * CS_RS + (16 * jq + 8 * hf) * 2;
        *(LAS u32x4*)(wl + IM_A * CS_IMG + wo) = pack8(oA); *(LAS u32x4*)(wl + IM_R * CS_IMG + wo) = pack8(oR); *(LAS u32x4*)(wl + IM_B * CS_IMG + wo) = pack8(oB);
        *(LAS u32x4*)(wl + IM_K * CS_IMG + wo) = pack8(oK); *(LAS u32x4*)(wl + IM_BH * CS_IMG + wo) = pack8(oBH); *(LAS u32x4*)(wl + IM_KH * CS_IMG + wo) = pack8(oKH);
        if (USE_V) { float vc[8], vp[8], o[8]; unpack8(Lvc[hf], vc); unpack8(Lvp[hf], vp);
            const f32x4 a0 = *(const f32x4*)(in.mu + 1024 + cc), a1 = *(const f32x4*)(in.mu + 1024 + cc + 4); const float mv[8] = {a0.x, a0.y, a0.z, a0.w, a1.x, a1.y, a1.z, a1.w};
#pragma unroll
            for (int e = 0; e < 8; ++e) o[e] = vc[e] + ((first ? 0.f : vp[e]) - vc[e]) * mv[e];
            *(LAS u32x4*)(wl + IM_V * CS_IMG + wo) = pack8(o); }
        if (WITH_Y) *(LAS u32x4*)(wl + IM_G * CS_IMG + wo) = Lgg;
    }
    if (WITH_Y) { btacc = xsum_16_32(btacc); if (lane < 16) btt[lane] = btacc; }
}
struct CsFr { bf16x8 fAR[4], aL1, aL2, aL4, aL8, aLkMk, aMb; };
__device__ __forceinline__ void cs_gram(CsFr& fr, LAS unsigned char* wl, int lane) {
    const int hi = lane >> 5, row = lane & 15; const bool up = (lane & 16) != 0;
    const LAS unsigned char* rpAR = wl + (up ? IM_R : IM_A) * CS_IMG + row * CS_RS; const LAS unsigned char* rpBK = wl + (up ? IM_K : IM_B) * CS_IMG + row * CS_RS;
#pragma unroll
    for (int ks = 0; ks < 4; ++ks) fr.fAR[ks] = cs_rowfrag(rpAR, hi, ks);
    f32x16 F1 = {}, F2 = {};
#pragma unroll
    for (int ks = 0; ks < 4; ++ks) { const bf16x8 fBK = cs_rowfrag(rpBK, hi, ks);
        F1 = __builtin_amdgcn_mfma_f32_32x32x16_bf16(fBK, fr.fAR[ks], F1, 0, 0, 0);
        F2 = __builtin_amdgcn_mfma_f32_32x32x16_bf16(fr.fAR[ks], fBK, F2, 0, 0, 0); }
#pragma unroll
    for (int q = 0; q < 8; ++q) { const int s = crow8(q, hi); const bool k1 = up ? (s <= row) : (s < row);
        F1[q] = k1 ? F1[q] : 0.f; F1[8 + q] = k1 ? F1[8 + q] : 0.f; F2[q] = (!up && row < s) ? F2[q] : 0.f; }
    const bf16x8 f1lo = packp(F1, 0);
    fr.aL1 = up ? cs_zero8() : f1lo;
    fr.aMb = up ? f1lo : cs_zero8();
    fr.aLkMk = packp(F1, 1);
    const bf16x8 p2 = packp(F2, 0);
    const f32x16 z16 = {};
    const f32x16 Q1 = __builtin_amdgcn_mfma_f32_32x32x16_bf16(p2, fr.aL1, z16, 0, 0, 0), Q2 = __builtin_amdgcn_mfma_f32_32x32x16_bf16(fr.aL1, p2, z16, 0, 0, 0);
    fr.aL2 = packp(Q1, 0); const bf16x8 p2b = packp(Q2, 0);
    const f32x16 R1 = __builtin_amdgcn_mfma_f32_32x32x16_bf16(p2b, fr.aL2, z16, 0, 0, 0), R2 = __builtin_amdgcn_mfma_f32_32x32x16_bf16(fr.aL2, p2b, z16, 0, 0, 0);
    fr.aL4 = packp(R1, 0); const bf16x8 p2c = packp(R2, 0);
    const f32x16 S1 = __builtin_amdgcn_mfma_f32_32x32x16_bf16(p2c, fr.aL4, z16, 0, 0, 0);
    fr.aL8 = packp(S1, 0);
}
template <bool USE_V, bool WITH_Y>
__device__ __forceinline__ void cs_apply(f32x16 (&Z)[2][2], f32x16 (&D)[2], const CsFr& fr, LAS unsigned char* wl, int lane) {
    const int hi = lane >> 5;
    bf16x8 vf[2];
    if (USE_V) { vf[0] = cs_trfrag(wl + IM_V * CS_IMG, 0, lane); vf[1] = cs_trfrag(wl + IM_V * CS_IMG, 1, lane); }
#pragma unroll
    for (int nb = 0; nb < 2; ++nb) { f32x16 d = {};
#pragma unroll
        for (int jb = 0; jb < 2; ++jb)
#pragma unroll
            for (int k2 = 0; k2 < 2; ++k2) d = __builtin_amdgcn_mfma_f32_32x32x16_bf16(fr.fAR[2 * jb + k2], packp(Z[jb][nb], k2), d, 0, 0, 0);
        if (USE_V) d = __builtin_amdgcn_mfma_f32_32x32x16_bf16(fr.aLkMk, vf[nb], d, 0, 0, 0);
        D[nb] = d; }
#pragma unroll
    for (int nb = 0; nb < 2; ++nb) {
        D[nb] = __builtin_amdgcn_mfma_f32_32x32x16_bf16(fr.aL8, packp(D[nb], 0), D[nb], 0, 0, 0);
        D[nb] = __builtin_amdgcn_mfma_f32_32x32x16_bf16(fr.aL4, packp(D[nb], 0), D[nb], 0, 0, 0);
        D[nb] = __builtin_amdgcn_mfma_f32_32x32x16_bf16(fr.aL2, packp(D[nb], 0), D[nb], 0, 0, 0);
        D[nb] = __builtin_amdgcn_mfma_f32_32x32x16_bf16(fr.aL1, packp(D[nb], 0), D[nb], 0, 0, 0);
    }
    const bf16x8 u0 = packp(D[0], 0), u1 = packp(D[1], 0);
    if (WITH_Y) { D[0] = __builtin_amdgcn_mfma_f32_32x32x16_bf16(fr.aMb, u0, D[0], 0, 0, 0); D[1] = __builtin_amdgcn_mfma_f32_32x32x16_bf16(fr.aMb, u1, D[1], 0, 0, 0); }
    const LAS float* gct = (const LAS float*)(wl + 8 * CS_IMG);
#pragma unroll
    for (int jb = 0; jb < 2; ++jb) {
        const bf16x8 fb = cs_trfrag(wl + IM_BH * CS_IMG, jb, lane); bf16x8 fk = cs_zero8(); if (USE_V) fk = cs_trfrag(wl + IM_KH * CS_IMG, jb, lane);
        float gc[16];
#pragma unroll
        for (int g4 = 0; g4 < 4; ++g4) { const f32x4 x = *(const LAS f32x4*)(gct + 32 * jb + 8 * g4 + 4 * hi); gc[4 * g4] = x.x; gc[4 * g4 + 1] = x.y; gc[4 * g4 + 2] = x.z; gc[4 * g4 + 3] = x.w; }
#pragma unroll
        for (int nb = 0; nb < 2; ++nb) { f32x16 z = Z[jb][nb];
#pragma unroll
            for (int q = 0; q < 16; ++q) z[q] *= gc[q];
            z = __builtin_amdgcn_mfma_f32_32x32x16_bf16(fb, nb == 0 ? u0 : u1, z, 0, 0, 0);
            if (USE_V) z = __builtin_amdgcn_mfma_f32_32x32x16_bf16(fk, vf[nb], z, 0, 0, 0);
            Z[jb][nb] = z; }
    }
}
__device__ __forceinline__ void cs_apply_pk(bf16x8 (&Zp)[2][2][2], f32x16 (&D)[2], const CsFr& fr, LAS unsigned char* wl, int lane) {
    const int hi = lane >> 5;
#pragma unroll
    for (int nb = 0; nb < 2; ++nb) { f32x16 d = {};
#pragma unroll
        for (int jb = 0; jb < 2; ++jb)
#pragma unroll
            for (int k2 = 0; k2 < 2; ++k2) d = __builtin_amdgcn_mfma_f32_32x32x16_bf16(fr.fAR[2 * jb + k2], Zp[jb][nb][k2], d, 0, 0, 0);
        D[nb] = d; }
#pragma unroll
    for (int nb = 0; nb < 2; ++nb) {
        D[nb] = __builtin_amdgcn_mfma_f32_32x32x16_bf16(fr.aL8, packp(D[nb], 0), D[nb], 0, 0, 0);
        D[nb] = __builtin_amdgcn_mfma_f32_32x32x16_bf16(fr.aL4, packp(D[nb], 0), D[nb], 0, 0, 0);
        D[nb] = __builtin_amdgcn_mfma_f32_32x32x16_bf16(fr.aL2, packp(D[nb], 0), D[nb], 0, 0, 0);
        D[nb] = __builtin_amdgcn_mfma_f32_32x32x16_bf16(fr.aL1, packp(D[nb], 0), D[nb], 0, 0, 0);
    }
    const bf16x8 u0 = packp(D[0], 0), u1 = packp(D[1], 0);
    const LAS float* gct = (const LAS float*)(wl + 8 * CS_IMG);
#pragma unroll
    for (int jb = 0; jb < 2; ++jb) {
        const bf16x8 fb = cs_trfrag(wl + IM_BH * CS_IMG, jb, lane);
        float gc[16];
#pragma unroll
        for (int g4 = 0; g4 < 4; ++g4) { const f32x4 x = *(const LAS f32x4*)(gct + 32 * jb + 8 * g4 + 4 * hi); gc[4 * g4] = x.x; gc[4 * g4 + 1] = x.y; gc[4 * g4 + 2] = x.z; gc[4 * g4 + 3] = x.w; }
#pragma unroll
        for (int nb = 0; nb < 2; ++nb) { f32x16 z;
#pragma unroll
            for (int k2 = 0; k2 < 2; ++k2) { float e[8]; unpack8(__builtin_bit_cast(u32x4, Zp[jb][nb][k2]), e);
#pragma unroll
                for (int q = 0; q < 8; ++q) z[8 * k2 + q] = e[q] * gc[8 * k2 + q]; }
            z = __builtin_amdgcn_mfma_f32_32x32x16_bf16(fb, nb == 0 ? u0 : u1, z, 0, 0, 0);
            Zp[jb][nb][0] = packp(z, 0); Zp[jb][nb][1] = packp(z, 1); }
    }
}
template <bool USE_V, bool WITH_Y>
__device__ __forceinline__ void cs_step(f32x16 (&Z)[2][2], f32x16 (&D)[2], LAS unsigned char* wl, int lane) { CsFr fr; cs_gram(fr, wl, lane); cs_apply<USE_V, WITH_Y>(Z, D, fr, wl, lane); }
__device__ __forceinline__ void p_cs_a(const Frame& F, ArgsP a) {
    const int lane = lane_id_fresh();
    LAS unsigned char* wl = F.lds + F.wave * CS_WAVE;
    CsIn in{(const bf16*)(F.ws + WS_ZR), (const bf16*)(F.ws + WS_A), (const bf16*)(F.ws + WS_LW), (const bf16*)(F.dob + DO_G), a->in[I_MU], a->in[I_KK], a->in[I_KA], a->in[I_RK]};
    bf16* Pm = (bf16*)(F.dob + DO_CSP); bf16* Gf = (bf16*)(F.dob + DO_CSG);
    const int hi = lane >> 5;
    for (int uc = F.gw; uc < 64 * CS_NCH; uc += F.NGW) {
        const int bh = uc / CS_NCH, c = uc % CS_NCH, b = bh >> 3, h = bh & 7; const size_t row0 = (size_t)b * SEQ;
        f32x16 ZG[2][2], D[2]; bf16x8 ZP[2][2][2];
#pragma unroll
        for (int jb = 0; jb < 2; ++jb)
#pragma unroll
            for (int nb = 0; nb < 2; ++nb) { f32x16 z = {}; ZG[jb][nb] = z;
                if (jb == nb) {
#pragma unroll
                    for (int q = 0; q < 16; ++q) z[q] = (crow(q, hi) == (lane & 31)) ? 1.f : 0.f; }
                ZP[jb][nb][0] = packp(z, 0); ZP[jb][nb][1] = packp(z, 1); }
        for (int sc = 0; sc < CS_CH / 16; ++sc) { int ln = lane; asm volatile("" : "+v"(ln));
            cs_prep<true, false>(in, row0, c * CS_CH + sc * 16, h, wl, ln); asm volatile("s_waitcnt lgkmcnt(0)" ::: "memory");
            CsFr fr; cs_gram(fr, wl, ln);
            cs_apply_pk(ZP, D, fr, wl, ln); cs_apply<true, false>(ZG, D, fr, wl, ln); asm volatile("s_waitcnt lgkmcnt(0)" ::: "memory"); }
        int lo_ = lane; asm volatile("" : "+v"(lo_)); const int hi_o = lo_ >> 5;
        {
            LAS unsigned short* tb = (LAS unsigned short*)(wl + 4 * hi_o * CS_RS + (lo_ & 31) * 2);
#pragma unroll
            for (int jb = 0; jb < 2; ++jb)
#pragma unroll
                for (int nb = 0; nb < 2; ++nb)
#pragma unroll
                    for (int q = 0; q < 16; ++q) tb[((32 * jb + (q & 3) + 8 * (q >> 2)) * CS_RS + 64 * nb) / 2] = (unsigned short)ZP[jb][nb][q >> 3][q & 7];
            bf16* dst = Pm + (size_t)uc * 4096;
            asm volatile("s_waitcnt lgkmcnt(0)" ::: "memory");
#pragma unroll
            for (int mb = 0; mb < 2; ++mb)
#pragma unroll
                for (int f = 0; f < 4; ++f) { const LAS unsigned char* src = wl + (32 * mb + (lo_ & 31)) * CS_RS + (16 * f + 4 * hi_o) * 2;
                    const u32x2 x0 = *(const LAS u32x2*)src, x1 = *(const LAS u32x2*)(src + 16);
                    *(u32x4*)(dst + ((mb * 64 + lo_) * 4 + f) * 8) = (u32x4){x0.x, x0.y, x1.x, x1.y}; }
            asm volatile("s_waitcnt lgkmcnt(0)" ::: "memory");
        }
        {
            bf16* dst = Gf + (size_t)uc * 4096;
#pragma unroll
            for (int jb = 0; jb < 2; ++jb)
#pragma unroll
                for (int nb = 0; nb < 2; ++nb) { u32x4 w0, w1; const f32x16& z = ZG[jb][nb];
                    w0.x = pk2(z[0], z[1]); w0.y = pk2(z[2], z[3]); w0.z = pk2(z[4], z[5]); w0.w = pk2(z[6], z[7]); w1.x = pk2(z[8], z[9]); w1.y = pk2(z[10], z[11]); w1.z = pk2(z[12], z[13]); w1.w = pk2(z[14], z[15]);
                    u32x4* p = (u32x4*)(dst + ((jb * 2 + nb) * 64 + lo_) * 16); p[0] = w0; p[1] = w1; }
        }
    }
}
struct CsB { u32x4 p[2][2][2]; u32x4 g[2][2]; };
__device__ __forceinline__ void csb_load(CsB& X, const bf16* Pm, const bf16* Gf, size_t uc, int nb, int lane) {
    const bf16* Pc = Pm + uc * 4096;
#pragma unroll
    for (int mb = 0; mb < 2; ++mb) { const u32x4* pp = (const u32x4*)(Pc + (mb * 64 + lane) * 32);
#pragma unroll
        for (int jb = 0; jb < 2; ++jb)
#pragma unroll
            for (int k2 = 0; k2 < 2; ++k2) X.p[mb][jb][k2] = pp[jb * 2 + k2];
        const u32x4* gp = (const u32x4*)(Gf + uc * 4096 + ((mb * 2 + nb) * 64 + lane) * 16); X.g[mb][0] = gp[0]; X.g[mb][1] = gp[1]; }
}
__device__ __forceinline__ void csb_step(f32x16 (&Z)[2], const CsB& X, bf16* Zf, size_t uc, int nb, int lane) {
#pragma unroll
    for (int jb = 0; jb < 2; ++jb) { u32x4 w0, w1; const f32x16& z = Z[jb];
        w0.x = pk2(z[0], z[1]); w0.y = pk2(z[2], z[3]); w0.z = pk2(z[4], z[5]); w0.w = pk2(z[6], z[7]); w1.x = pk2(z[8], z[9]); w1.y = pk2(z[10], z[11]); w1.z = pk2(z[12], z[13]); w1.w = pk2(z[14], z[15]);
        u32x4* p = (u32x4*)(Zf + uc * 4096 + ((jb * 2 + nb) * 64 + lane) * 16); p[0] = w0; p[1] = w1; }
    f32x16 N[2];
#pragma unroll
    for (int mb = 0; mb < 2; ++mb) { float g0[8], g1[8]; unpack8(X.g[mb][0], g0); unpack8(X.g[mb][1], g1);
#pragma unroll
        for (int q = 0; q < 8; ++q) { N[mb][q] = g0[q]; N[mb][8 + q] = g1[q]; } }
#pragma unroll
    for (int jb = 0; jb < 2; ++jb)
#pragma unroll
        for (int k2 = 0; k2 < 2; ++k2) { const bf16x8 zb = packp(Z[jb], k2);
#pragma unroll
            for (int mb = 0; mb < 2; ++mb) N[mb] = __builtin_amdgcn_mfma_f32_32x32x16_bf16(__builtin_bit_cast(bf16x8, X.p[mb][jb][k2]), zb, N[mb], 0, 0, 0); }
    Z[0] = N[0]; Z[1] = N[1];
}
__device__ __forceinline__ void p_cs_b(const Frame& F) {
    const int lane = lane_id_fresh();
    const bf16* Pm = (const bf16*)(F.dob + DO_CSP); const bf16* Gf = (const bf16*)(F.dob + DO_CSG); bf16* Zf = (bf16*)(F.dob + DO_CSZ);
    for (int u16 = F.gw; u16 < 128 * 16; u16 += F.NGW) {
        if (u16 & 15) continue;
        const int u = u16 >> 4, bh = u >> 1, nb = u & 1; const size_t uc0 = (size_t)bh * CS_NCH;
        f32x16 Z[2] = {};
        CsB X0, X1, X2;
        csb_load(X0, Pm, Gf, uc0, nb, lane); csb_load(X1, Pm, Gf, uc0 + 1, nb, lane);
#define CSB_CL(c_) (uc0 + ((c_) < CS_NCH ? (c_) : CS_NCH - 1))
        int c = 0;
        for (; c + 2 < CS_NCH; c += 3) {
            csb_load(X2, Pm, Gf, CSB_CL(c + 2), nb, lane); csb_step(Z, X0, Zf, uc0 + c, nb, lane);
            csb_load(X0, Pm, Gf, CSB_CL(c + 3), nb, lane); csb_step(Z, X1, Zf, uc0 + c + 1, nb, lane);
            csb_load(X1, Pm, Gf, CSB_CL(c + 4), nb, lane); csb_step(Z, X2, Zf, uc0 + c + 2, nb, lane);
        }
        if (c < CS_NCH) { csb_step(Z, X0, Zf, uc0 + c, nb, lane); ++c; }
        if (c < CS_NCH) { csb_step(Z, X1, Zf, uc0 + c, nb, lane); ++c; }
#undef CSB_CL
    }
}
__device__ __forceinline__ void p_cs_c(const Frame& F, ArgsP a) {
    const int lane = lane_id_fresh(), hi = lane >> 5;
    LAS unsigned char* wl = F.lds + F.wave * CS_WAVE;
    CsIn in{(const bf16*)(F.ws + WS_ZR), (const bf16*)(F.ws + WS_A), (const bf16*)(F.ws + WS_LW), (const bf16*)(F.dob + DO_G), a->in[I_MU], a->in[I_KK], a->in[I_KA], a->in[I_RK]};
    const bf16* Zf = (const bf16*)(F.dob + DO_CSZ); bf16* Y = (bf16*)(F.ws + WS_Y); const float* lnw = a->in[I_LNW]; const float* lnb = a->in[I_LNB];
    const LAS float* btt = (const LAS float*)(wl + 8 * CS_IMG) + 64;
    for (int uc = F.gw; uc < 64 * CS_NCH; uc += F.NGW) {
        const int bh = uc / CS_NCH, c = uc % CS_NCH, b = bh >> 3, h = bh & 7; const size_t row0 = (size_t)b * SEQ;
        f32x16 Z[2][2], D[2];
        int lu = lane; asm volatile("" : "+v"(lu));
#pragma unroll
        for (int jb = 0; jb < 2; ++jb)
#pragma unroll
            for (int nb = 0; nb < 2; ++nb) { const u32x4* p = (const u32x4*)(Zf + (size_t)uc * 4096 + ((jb * 2 + nb) * 64 + lu) * 16); float g0[8], g1[8]; unpack8(p[0], g0); unpack8(p[1], g1);
#pragma unroll
                for (int q = 0; q < 8; ++q) { Z[jb][nb][q] = g0[q]; Z[jb][nb][8 + q] = g1[q]; } }
        const float lw0 = lnw[h * 64 + (lu & 31)], lw1 = lnw[h * 64 + 32 + (lu & 31)], lb0 = lnb[h * 64 + (lu & 31)], lb1 = lnb[h * 64 + 32 + (lu & 31)];
        for (int sc = 0; sc < CS_CH / 16; ++sc) {
            const int tok0 = c * CS_CH + sc * 16;
            int ln = lane; asm volatile("" : "+v"(ln));
            cs_prep<true, true>(in, row0, tok0, h, wl, ln); asm volatile("s_waitcnt lgkmcnt(0)" ::: "memory");
            cs_step<true, true>(Z, D, wl, ln); asm volatile("s_waitcnt lgkmcnt(0)" ::: "memory");
            const int hl = ln >> 5;
            const bf16x8 v0 = cs_trfrag(wl + IM_V * CS_IMG, 0, ln), v1 = cs_trfrag(wl + IM_V * CS_IMG, 1, ln), g0 = cs_trfrag(wl + IM_G * CS_IMG, 0, ln), g1 = cs_trfrag(wl + IM_G * CS_IMG, 1, ln);
            const f32x4 bta = *(const LAS f32x4*)(btt + 4 * hl), btb = *(const LAS f32x4*)(btt + 8 + 4 * hl); const float bt[8] = {bta.x, bta.y, bta.z, bta.w, btb.x, btb.y, btb.z, btb.w};
#pragma unroll
            for (int q = 0; q < 8; ++q) {
                const float y0 = D[0][8 + q], y1 = D[1][8 + q];
                const float mean = allsum32(y0 + y1) * (1.f / 64.f); const float d0 = y0 - mean, d1 = y1 - mean;
                const float rstd = 1.0f / sqrtf(allsum32(d0 * d0 + d1 * d1) * (1.f / 64.f) + LN_X_EPS);
                const float o0 = (d0 * rstd * lw0 + lb0 + bt[q] * bf2f((unsigned short)v0[q])) * bf2f((unsigned short)g0[q]);
                const float o1 = (d1 * rstd * lw1 + lb1 + bt[q] * bf2f((unsigned short)v1[q])) * bf2f((unsigned short)g1[q]);
                bf16* yp = Y + (row0 + tok0 + crow8(q, hl)) * YYLD + h * 64 + (ln & 31);
                yp[0] = (unsigned short)f2bf(o0); yp[32] = (unsigned short)f2bf(o1);
            }
            asm volatile("s_waitcnt lgkmcnt(0)" ::: "memory");
        }
    }
}

__device__ __forceinline__ void p_ffn_route(const Frame& F, ArgsP a, unsigned* cnt, int* ridxv, f32x2* rwv) {
    const int lane_f = lane_id_fresh(), tid_f = F.wave * 64 + lane_f;
    const bf16* MO = (const bf16*)(F.ws + WS_MO); bf16* H2 = (bf16*)(F.ws + WS_H2); const float* mod = (const float*)(F.ws + WS_MOD); const float* g = a->in[I_GFFN];
    constexpr int RTS = 1028;
    LAS float* wr = (LAS float*)F.lds;
    __syncthreads();
    for (int i = tid_f; i < 1024 * 4; i += NTHR) { const int k = i >> 2, o = i & 3; wr[o * RTS + k] = a->in[I_WRG][i]; }
    for (int i = tid_f; i < 1024 * 32; i += NTHR) { const int k = i >> 5, o = i & 31; wr[(4 + o) * RTS + k] = a->in[I_WRE][i]; }
    __syncthreads();
    LAS float* brl = wr + 36 * RTS;
    if (tid_f < 4) brl[tid_f] = a->in[I_BRG][tid_f]; else if (tid_f < 36) brl[tid_f] = a->in[I_BRE][tid_f - 4];
    const int lane = lane_f;
    LAS unsigned* lcnt = (LAS unsigned*)(F.lds + LDS_MISC + 512);
    if (tid_f < 256) lcnt[tid_f] = 0u;
    __syncthreads();
    int my_e0 = 0, my_e1 = 0; float my_w0 = 0.f, my_w1 = 0.f; int kk_ = 0;
    u32x2 ma[4], mb[4]; f32x4 gsv[4], shv[4]; int bcur = -1;
    { const u32x2* mr = (const u32x2*)(MO + (size_t)F.gw * 1024) + lane;
#pragma unroll
      for (int j = 0; j < 4; ++j) ma[j] = mr[64 * j]; }
#define RT_ROW(CM, NM, m_) do { const int mm = (m_); const int b = mm / SEQ; \
        if (b != bcur) { bcur = b; \
            _Pragma("unroll") for (int j = 0; j < 4; ++j) { const int col = 4 * lane + 256 * j; \
                gsv[j] = *(const f32x4*)(g + col) * (*(const f32x4*)(mod + b * 6144 + 4096 + col) + 1.0f); shv[j] = *(const f32x4*)(mod + b * 6144 + 3072 + col); } \
            asm volatile("s_waitcnt vmcnt(0)" : "+v"(gsv[0]), "+v"(gsv[1]), "+v"(gsv[2]), "+v"(gsv[3]), "+v"(shv[0]), "+v"(shv[1]), "+v"(shv[2]), "+v"(shv[3])); \
            asm volatile("" : "+v"(CM[0]), "+v"(CM[1]), "+v"(CM[2]), "+v"(CM[3])); } \
        { const int mn = (mm + F.NGW < NTOK) ? mm + F.NGW : mm; const u32x2* mr = (const u32x2*)(MO + (size_t)mn * 1024) + lane; \
          _Pragma("unroll") for (int j = 0; j < 4; ++j) NM[j] = mr[64 * j]; } \
        f32x4 v[4]; float s = 0.f; \
        _Pragma("unroll") for (int j = 0; j < 4; ++j) { v[j] = (f32x4){lo2f(CM[j].x), hi2f(CM[j].x), lo2f(CM[j].y), hi2f(CM[j].y)}; \
            s += (v[j].x * v[j].x + v[j].y * v[j].y) + (v[j].z * v[j].z + v[j].w * v[j].w); } \
        const float rstd = 1.0f / sqrtf(wave_sum(s) * (1.f / 1024.f) + EPS); \
        u32x2* o = (u32x2*)(H2 + (size_t)mm * 1024) + lane; \
        _Pragma("unroll") for (int j = 0; j < 4; ++j) { v[j] = v[j] * rstd * gsv[j] + shv[j]; u32x2 w; w.x = pk2(v[j].x, v[j].y); w.y = pk2(v[j].z, v[j].w); o[64 * j] = w; } \
        float lgq[4]; \
        _Pragma("unroll") for (int oo = 0; oo < 4; ++oo) { float p = 0.f; \
            _Pragma("unroll") for (int j = 0; j < 4; ++j) { const f32x4 w4 = *(const LAS f32x4*)(wr + oo * RTS + 4 * lane + 256 * j); p += (v[j].x * w4.x + v[j].y * w4.y) + (v[j].z * w4.z + v[j].w * w4.w); } \
            lgq[oo] = wave_sum(p) + brl[oo]; } \
        int gi = 0; float gmx = lgq[0]; \
        _Pragma("unroll") for (int i = 1; i < 4; ++i) { if (lgq[i] > gmx) { gmx = lgq[i]; gi = i; } } \
        float gsum = 0.f; \
        _Pragma("unroll") for (int i = 0; i < 4; ++i) gsum += __expf(lgq[i] - gmx); \
        const float pg = 1.f / gsum; \
        gi = __builtin_amdgcn_readfirstlane(gi); \
        float el[8]; \
        { const LAS float* wg = wr + (4 + gi * 8) * RTS + 4 * lane; \
          _Pragma("unroll") for (int i = 0; i < 8; ++i) { float p = 0.f; \
              _Pragma("unroll") for (int j = 0; j < 4; ++j) { const f32x4 w4 = *(const LAS f32x4*)(wg + i * RTS + 256 * j); p += (v[j].x * w4.x + v[j].y * w4.y) + (v[j].z * w4.z + v[j].w * w4.w); } \
              el[i] = wave_sum(p) + brl[4 + gi * 8 + i]; } } \
        int i0 = 0; float m0 = el[0]; \
        _Pragma("unroll") for (int i = 1; i < 8; ++i) if (el[i] > m0) { m0 = el[i]; i0 = i; } \
        int i1 = -1; float m1 = -INFINITY; \
        _Pragma("unroll") for (int i = 0; i < 8; ++i) if (i != i0 && el[i] > m1) { m1 = el[i]; i1 = i; } \
        const float e1 = __expf(m1 - m0), w0 = pg / (1.f + e1), w1 = pg * e1 / (1.f + e1); \
        { const int lo_ = i0 < i1 ? i0 : i1, hi_ = i0 < i1 ? i1 : i0; \
          if (lane == kk_) { my_e0 = gi * 28 + (lo_ * (15 - lo_)) / 2 + (hi_ - lo_ - 1); my_w0 = i0 < i1 ? w0 : w1; my_w1 = i0 < i1 ? w1 : w0; } } \
        ++kk_; } while (0)
    for (int m = F.gw; m < NTOK; m += 2 * F.NGW) {
        RT_ROW(ma, mb, m);
        if (m + F.NGW < NTOK) RT_ROW(mb, ma, m + F.NGW);
    }
#undef RT_ROW
    unsigned lp0 = 0u;
    if (lane < kk_) lp0 = __hip_atomic_fetch_add(lcnt + my_e0, 1u, __ATOMIC_RELAXED, __HIP_MEMORY_SCOPE_WORKGROUP);
    __syncthreads();
    if (tid_f < NCLS) lcnt[128 + tid_f] = __hip_atomic_fetch_add(cnt + tid_f, lcnt[tid_f], __ATOMIC_RELAXED, __HIP_MEMORY_SCOPE_AGENT);
    __syncthreads();
    if (lane < kk_) { const int m = F.gw + lane * F.NGW; const size_t v = (size_t)my_e0 * CLS_CAP + (lcnt[128 + my_e0] + lp0);
        ridxv[v] = m; rwv[v] = (f32x2){my_w0, my_w1}; }
    __syncthreads();
    (void)my_e1;
}
__device__ __forceinline__ int moe_tables(const Frame& F, LAS int* offs, LAS int* texp, LAS int* ccnt) {
    const int lane_f = lane_id_fresh();
    const unsigned* cnt = (const unsigned*)(F.ws + WS_CTL) + CW_CNT;
    __syncthreads();
    if (F.wave == 0) {
        const int c0 = (int)__hip_atomic_load(cnt + lane_f, __ATOMIC_RELAXED, __HIP_MEMORY_SCOPE_AGENT);
        const int c1 = (lane_f < NCLS - 64) ? (int)__hip_atomic_load(cnt + 64 + lane_f, __ATOMIC_RELAXED, __HIP_MEMORY_SCOPE_AGENT) : 0;
        const int n0 = (c0 + 255) >> 8, n1 = (c1 + 255) >> 8; int i0 = n0, i1 = n1;
#pragma unroll
        for (int d = 1; d < 64; d <<= 1) { const int a = __shfl_up(i0, d, 64), b = __shfl_up(i1, d, 64); if (lane_f >= d) { i0 += a; i1 += b; } }
        const int tot0 = __shfl(i0, 63, 64); i1 += tot0;
        const int t0 = i0 - n0, t1 = i1 - n1;
        offs[lane_f] = t0 << 8; ccnt[lane_f] = c0; for (int t = 0; t < n0; ++t) texp[t0 + t] = lane_f;
        if (lane_f < NCLS - 64) { offs[64 + lane_f] = t1 << 8; ccnt[64 + lane_f] = c1; for (int t = 0; t < n1; ++t) texp[t1 + t] = 64 + lane_f; if (lane_f == NCLS - 65) offs[NCLS] = i1 << 8; }
    }
    __syncthreads();
    return __builtin_amdgcn_readfirstlane(offs[NCLS] >> 8);
}
constexpr int NPHASE = 15;
template <int LO, int HI>
__global__ void __launch_bounds__(NTHR, 2) fwd(Args args) {
    extern __shared__ __attribute__((aligned(16))) unsigned char lds_raw[];
    Frame F;
    F.lds = (LAS unsigned char*)lds_raw;
    F.wave = __builtin_amdgcn_readfirstlane((int)threadIdx.x >> 6);
    F.G = gridDim.x; { const int bx = blockIdx.x; F.vcu = (F.G % 8 == 0) ? (bx % 8) * (F.G / 8) + bx / 8 : bx; }
    F.gw = F.vcu * NWAVES + F.wave; F.NGW = F.G * NWAVES;
    F.ws = args.ws; F.dob = (unsigned char*)args.out;
    ArgsP AP = (ArgsP)__builtin_amdgcn_kernarg_segment_ptr();
    volatile LAS unsigned* MISC = (volatile LAS unsigned*)(F.lds + LDS_MISC);
    if (threadIdx.x < 64) MISC[threadIdx.x] = 0u;
    __syncthreads();
    XcdBarrier bar; bar.bar = (unsigned*)(F.ws + WS_CTL) + CW_BAR; bar.x = 0; bar.st = MISC + 8;
#if N_LAUNCH_MODE == 1
    bar = xcd_barrier_post((unsigned*)(F.ws + WS_CTL) + CW_BAR, MISC + 8);
#define GRID_BAR() xcd_barrier(bar)
#else
#define GRID_BAR() do { } while (0)
#endif
#ifndef PROBE_REPEAT
#define PROBE_REPEAT -1
#endif
#define IN(k) (LO <= (k) && (k) < HI)
#define SEAM(k) do { if constexpr (IN(k) && IN((k) + 1)) GRID_BAR(); } while (0)
    const float* mod = (const float*)(F.ws + WS_MOD);

#define PH(k, ...) do { if constexpr (IN(k)) { asm volatile("" : "+s"(AP)); { __VA_ARGS__ } if constexpr (PROBE_REPEAT == (k)) { GRID_BAR(); asm volatile("" : "+s"(AP)); { __VA_ARGS__ } } } } while (0)
    PH(0, p0_prologue(F, AP);); SEAM(0);
    PH(1, p_normmod(F, AP->in[I_X], AP->in[I_GMIX], mod, 0, 1024, (bf16*)(F.ws + WS_H));); SEAM(1);
    PH(2, Gemm g{(const bf16*)(F.ws + WS_H), (const bf16*)(F.ws + WS_WIN), NTOK, N_IN_PAD, 1024}; StaticOrder S; S.init(NTOK, N_IN_PAD, F.G, (int)blockIdx.x);
        EpiZ E{(bf16*)(F.ws + WS_ZR), (bf16*)(F.ws + WS_SG), (bf16*)(F.ws + WS_ZM)}; gemm_phase_any(F.lds, g, S, E, F.wave);); SEAM(2);
    PH(3, p_prep_a(F, AP);); SEAM(3);
    PH(4,
        { Gemm g{(const bf16*)(F.ws + WS_TWA), (const bf16*)(F.ws + WS_WBLK), NTOK, 1024, 128}; StaticOrder S; S.init(NTOK, 1024, F.G, (int)blockIdx.x);
          EpiLora E{(bf16*)(F.ws + WS_LW), (bf16*)(F.ws + WS_A), AP->in[I_W0], AP->in[I_A0]}; gemm_phase_any(F.lds, g, S, E, F.wave); }
        { Gemm g{(const bf16*)(F.ws + WS_SGL), (const bf16*)(F.ws + WS_WG), NTOK, 512, 128}; StaticOrder S; S.init(NTOK, 512, F.G, (int)blockIdx.x);
          EpiPlain E{(bf16*)(F.dob + DO_G), nullptr, 1 << 30, 512, 0}; gemm_phase_any(F.lds, g, S, E, F.wave); }
        { Gemm g{(const bf16*)(F.ws + WS_QA), (const bf16*)(F.ws + WS_WUQ), NTOK, 768, 256}; StaticOrder S; S.init(NTOK, 768, F.G, (int)blockIdx.x);
          EpiPlain E{(bf16*)(F.dob + DO_Q), nullptr, 1 << 30, 768, 0}; gemm_phase_any(F.lds, g, S, E, F.wave); }
        { Gemm g{(const bf16*)(F.ws + WS_KVA), (const bf16*)(F.ws + WS_WUKV), NTOK, 1024, 128}; StaticOrder S; S.init(NTOK, 1024, F.G, (int)blockIdx.x);
          EpiPlain E{(bf16*)(F.dob + DO_KN), (bf16*)(F.ws + WS_VC), 512, 512, 512}; gemm_phase_any(F.lds, g, S, E, F.wave); }
    ); SEAM(4);
    PH(5, p_prep_c(F, AP);); SEAM(5);
#if ENG_ATTN == 1
    PH(6, p_attn_mfma(F, AP->in[I_QN], AP->in[I_KN]);); SEAM(6);
#else
    PH(6, p_attn_naive(F);); SEAM(6);
#endif
    PH(7, p_cs_a(F, AP);); SEAM(7);
    PH(8, p_cs_b(F);); SEAM(8);
    PH(9, p_cs_c(F, AP);); SEAM(9);
    PH(10, Gemm g{(const bf16*)(F.ws + WS_Y), (const bf16*)(F.ws + WS_WB), NTOK, 1024, 1024}; StaticOrder S; S.init(NTOK, 1024, F.G, (int)blockIdx.x);
        EpiBranch2 E{(bf16*)(F.ws + WS_MG), (const bf16*)(F.ws + WS_SG)}; gemm_phase_mid(F.lds, g, S, E, F.wave);); SEAM(10);
    PH(11, Gemm g{(const bf16*)(F.ws + WS_MG), (const bf16*)(F.ws + WS_WO), NTOK, 1024, 1024}; StaticOrder S; S.init(NTOK, 1024, F.G, (int)blockIdx.x);
        EpiX1 E{(bf16*)(F.ws + WS_MO), AP->in[I_X], mod}; gemm_phase_any(F.lds, g, S, E, F.wave);); SEAM(11);
    if constexpr (IN(12)) { asm volatile("" : "+s"(AP)); p_ffn_route(F, AP, (unsigned*)(F.ws + WS_CTL) + CW_CNT, (int*)(F.ws + WS_RIDXV), (f32x2*)(F.ws + WS_RWV)); } SEAM(12);
#define MOE_TABLES() LAS int* offs = (LAS int*)(F.lds + LDS_MISC + 1024); LAS int* ccnt = (LAS int*)(F.lds + LDS_MISC + 1536); LAS int* texp = (LAS int*)(F.lds + LDS_MISC + 2048); const int nt = moe_tables(F, offs, texp, ccnt)
    PH(13, MOE_TABLES();
        Gemm g{(const bf16*)(F.ws + WS_H2), (const bf16*)(F.ws + WS_WGU), MPAD2, 1024, 1024, (const int*)(F.ws + WS_RIDXV)}; PairOrderGU S{texp, offs, ccnt, nt, F.G, (int)blockIdx.x};
        EpiGateUp2 E{(bf16*)(F.ws + WS_HID2), (const float*)(F.ws + WS_RWV)}; gemm_phase_gather(F.lds, g, S, E, F.wave);); SEAM(13);
    PH(14, MOE_TABLES();
        Gemm g{(const bf16*)(F.ws + WS_HID2), (const bf16*)(F.ws + WS_WDN), MPAD2, 1024, 512, nullptr, 256}; PairOrderDown S{texp, offs, ccnt, nt, F.G, (int)blockIdx.x};
        EpiDown2 E{(float*)F.dob, (const bf16*)(F.ws + WS_MO), mod, (const int*)(F.ws + WS_RIDXV)}; gemm_phase_bseg(F.lds, g, S, E, F.wave););
#undef MOE_TABLES
}

#if N_LAUNCH_MODE == 1
static bool set_attrs() { return hipFuncSetAttribute((const void*)fwd<0, NPHASE>, hipFuncAttributeMaxDynamicSharedMemorySize, LDS_BYTES) == hipSuccess; }
#else
template <int P> static bool set_attr_all() { if constexpr (P < NPHASE) { return hipFuncSetAttribute((const void*)fwd<P, P + 1>, hipFuncAttributeMaxDynamicSharedMemorySize, LDS_BYTES) == hipSuccess && set_attr_all<P + 1>(); } else return true; }
static bool set_attrs() { return set_attr_all<0>(); }
template <int P> static void launch_all(int grid, hipStream_t stream, const Args& a) { if constexpr (P < NPHASE) { hipLaunchKernelGGL((fwd<P, P + 1>), dim3(grid), dim3(NTHR), LDS_BYTES, stream, a); launch_all<P + 1>(grid, stream, a); } }
#endif
extern "C" void kernel_launch(void* const* d_in, const int* in_sizes, int n_in, void* d_out, int out_size, void* d_ws, size_t ws_size, hipStream_t stream) {
    static int grid = 0;
    if (grid == 0) {
        if (n_in != 34 || out_size != NTOK * DM || ws_size < WS_END) { fprintf(stderr, "kernel_launch: unexpected shapes (n_in %d out %d ws %zu)\n", n_in, out_size, ws_size); grid = -1; return; }
        int dev = 0, cus = 0;
        if (hipGetDevice(&dev) != hipSuccess || hipDeviceGetAttribute(&cus, hipDeviceAttributeMultiprocessorCount, dev) != hipSuccess) { grid = -1; return; }
        if (!set_attrs()) { fprintf(stderr, "kernel_launch: hipFuncSetAttribute failed\n"); grid = -1; return; }
        grid = cus;
    }
    if (grid < 0) return;
    (void)hipMemsetAsync((char*)d_ws + WS_CTL, 0, CTL_ZERO_BYTES, stream);
    Args a{};
    for (int i = 0; i < 34; ++i) a.in[i] = (const float*)d_in[i];
    a.out = (float*)d_out; a.ws = (unsigned char*)d_ws;
    a.ph_lo = 0; a.ph_hi = NPHASE;
#if N_LAUNCH_MODE == 1
    hipLaunchKernelGGL((fwd<0, NPHASE>), dim3(grid), dim3(NTHR), LDS_BYTES, stream, a);
#else
    launch_all<0>(grid, stream, a);
#endif
}
```

```cpp
#include <hip/hip_runtime.h>
#include <cstdio>
#include <cstdint>

#ifndef N_LAUNCH_MODE
#define N_LAUNCH_MODE 1
#endif
#ifndef ENG_GEMM
#define ENG_GEMM 1
#endif
#ifndef ENG_ATTN
#define ENG_ATTN 1
#endif

#define GAS __attribute__((address_space(1)))
#define LAS __attribute__((address_space(3)))
typedef unsigned short bf16;
typedef float f32x4 __attribute__((ext_vector_type(4)));
typedef float f32x2 __attribute__((ext_vector_type(2)));
typedef unsigned u32x4 __attribute__((ext_vector_type(4)));
typedef unsigned u32x2 __attribute__((ext_vector_type(2)));
typedef short bf16x8 __attribute__((ext_vector_type(8)));

constexpr int BATCH = 8, SEQ = 8192, DM = 1024, NTOK = BATCH * SEQ;
constexpr int D_RWKV = 512, RWKV_COLS = 1792, MLA_COLS = 416, D_IN = 4256, N_IN_PAD = 4352;
constexpr int NH = 8, QKD = 96, NOPE = 64, ROPE = 32, VD = 64;
constexpr int NEXP = 32, DEXP = 256;
constexpr int NCLS = 112, MPAD2 = 94208;
constexpr int MPAD = 139264;
constexpr float EPS = 1e-6f, LN_X_EPS = 64e-5f;
constexpr float QSCALE = 0.10206207261596577f * 1.4426950408889634f;

constexpr size_t MiB = 1u << 20;
constexpr size_t WS_CTL = 0, CTL_ZERO_BYTES = 1 * MiB;
constexpr size_t WS_MOD = 1 * MiB;
constexpr size_t WS_ROUTE = 2 * MiB;
constexpr size_t WS_CS = 4 * MiB;
constexpr size_t WS_ENT = 12 * MiB;
constexpr size_t WS_WIN = 16 * MiB;
constexpr size_t WS_WBLK = 25 * MiB;
constexpr size_t WS_WG = WS_WBLK + 256 * 1024;
constexpr size_t WS_WUQ = WS_WG + 128 * 1024;
constexpr size_t WS_WUKV = WS_WUQ + 384 * 1024;
constexpr size_t WS_WB = 26 * MiB;
constexpr size_t WS_WO = 28 * MiB;
constexpr size_t WS_WGU = 30 * MiB;
constexpr size_t WS_WDN = 62 * MiB;
constexpr size_t WS_SG = 80 * MiB;
constexpr size_t WS_H2 = 80 * MiB;
constexpr size_t WS_ZR = 336 * MiB;
constexpr size_t WS_VC = 816 * MiB;
constexpr size_t WS_KC = 880 * MiB;
constexpr size_t WS_Y = 560 * MiB;
constexpr size_t WS_XG = 336 * MiB;
constexpr size_t WS_ZM = 560 * MiB;
constexpr size_t WS_YM = 560 * MiB + 1024;
constexpr size_t WS_H = 688 * MiB;
constexpr size_t WS_LW = 688 * MiB;
constexpr size_t WS_A = 752 * MiB;
constexpr size_t WS_MG = 688 * MiB;
constexpr size_t WS_HID2 = 208 * MiB;
constexpr int CLS_CAP = 65536;
constexpr size_t WS_RIDXV = 336 * MiB;
constexpr size_t WS_RWV = 368 * MiB;
constexpr size_t WS_RW = 13 * MiB;
constexpr size_t WS_HID = 208 * MiB;
constexpr size_t WS_R = 752 * MiB;
constexpr size_t WS_V = 816 * MiB;
constexpr size_t WS_ZK = 880 * MiB;
constexpr size_t WS_TWA = 944 * MiB;
constexpr size_t WS_SGL = 960 * MiB;
constexpr size_t WS_QA = 976 * MiB;
constexpr size_t WS_KVA = 1008 * MiB;
constexpr size_t WS_KK = 944 * MiB;
constexpr size_t WS_YS = 752 * MiB;
constexpr size_t WS_MO = 560 * MiB;
constexpr int YYLD = 1024;
constexpr size_t WS_H8 = 880 * MiB;
constexpr size_t WS_WG8 = 21 * MiB;
constexpr size_t WS_END = 1024 * MiB;
constexpr size_t DO_G = 0;
constexpr size_t DO_Q = 64 * MiB;
constexpr size_t DO_KN = 160 * MiB;

constexpr int CW_CNT = 64;
constexpr int CW_BAR = 4096;

constexpr int NWAVES = 8, NTHR = 512;
constexpr int LDS_BYTES = 155648;
constexpr int LDS_MISC = 151552;

__device__ __forceinline__ int lane_id_fresh() { int l; asm volatile("v_mbcnt_lo_u32_b32 %0, -1, 0\n\tv_mbcnt_hi_u32_b32 %0, -1, %0" : "=v"(l)); return l; }
__device__ __forceinline__ float bf2f(unsigned short h) { return __builtin_bit_cast(float, (unsigned)h << 16); }
__device__ __forceinline__ unsigned f2bf(float f) { unsigned u = __builtin_bit_cast(unsigned, f); return (u + 0x7fffu + ((u >> 16) & 1u)) >> 16; }
typedef __bf16 bf16x2_t __attribute__((ext_vector_type(2)));
__device__ __forceinline__ unsigned pk2(float lo, float hi) { const f32x2 v = {lo, hi}; return __builtin_bit_cast(unsigned, __builtin_convertvector(v, bf16x2_t)); }
__device__ __forceinline__ float lo2f(unsigned w) { return __builtin_bit_cast(float, w << 16); }
__device__ __forceinline__ float hi2f(unsigned w) { return __builtin_bit_cast(float, w & 0xffff0000u); }
template <int CTRL> __device__ __forceinline__ float dpp_add(float x) { return x + __builtin_bit_cast(float, __builtin_amdgcn_update_dpp(0, __builtin_bit_cast(int, x), CTRL, 0xf, 0xf, false)); }
__device__ __forceinline__ float allsum16(float x) { x = dpp_add<0xB1>(x); x = dpp_add<0x4E>(x); x = dpp_add<0x141>(x); x = dpp_add<0x140>(x); return x; }
__device__ __forceinline__ float allsum32(float x) { x = allsum16(x); auto r = __builtin_amdgcn_permlane16_swap(__float_as_uint(x), __float_as_uint(x), false, false); return __uint_as_float(r[0]) + __uint_as_float(r[1]); }
__device__ __forceinline__ float sum8(float x) { x = dpp_add<0xB1>(x); x = dpp_add<0x4E>(x); x = dpp_add<0x141>(x); return x; }
__device__ __forceinline__ float wave_sum(float v) {
    v = allsum16(v);
    { auto r = __builtin_amdgcn_permlane16_swap(__float_as_uint(v), __float_as_uint(v), false, false); v = __uint_as_float(r[0]) + __uint_as_float(r[1]); }
    { auto r = __builtin_amdgcn_permlane32_swap(__float_as_uint(v), __float_as_uint(v), false, false); v = __uint_as_float(r[0]) + __uint_as_float(r[1]); }
    return v;
}
template <int CTRL> __device__ __forceinline__ float dpp_max(float x) { return fmaxf(x, __builtin_bit_cast(float, __builtin_amdgcn_update_dpp(0, __builtin_bit_cast(int, x), CTRL, 0xf, 0xf, false))); }
__device__ __forceinline__ float wave_max_nonneg(float v) {
    v = dpp_max<0xB1>(v); v = dpp_max<0x4E>(v); v = dpp_max<0x141>(v); v = dpp_max<0x140>(v);
    { auto r = __builtin_amdgcn_permlane16_swap(__float_as_uint(v), __float_as_uint(v), false, false); v = fmaxf(__uint_as_float(r[0]), __uint_as_float(r[1])); }
    { auto r = __builtin_amdgcn_permlane32_swap(__float_as_uint(v), __float_as_uint(v), false, false); v = fmaxf(__uint_as_float(r[0]), __uint_as_float(r[1])); }
    return v;
}
__device__ __forceinline__ float sigmoidf_(float x) { return __builtin_amdgcn_rcpf(1.f + __builtin_amdgcn_exp2f(-1.4426950408889634f * x)); }
__device__ __forceinline__ float tanhf_(float x) { return 1.0f - 2.0f * __builtin_amdgcn_rcpf(1.f + __builtin_amdgcn_exp2f(2.8853900817779268f * x)); }
__device__ __forceinline__ float siluf_(float x) { return x * __builtin_amdgcn_rcpf(1.f + __builtin_amdgcn_exp2f(-1.4426950408889634f * x)); }
__device__ __forceinline__ void unpack8(const u32x4 w, float (&v)[8]) {
    v[0] = lo2f(w.x); v[1] = hi2f(w.x); v[2] = lo2f(w.y); v[3] = hi2f(w.y); v[4] = lo2f(w.z); v[5] = hi2f(w.z); v[6] = lo2f(w.w); v[7] = hi2f(w.w);
}
__device__ __forceinline__ u32x4 pack8(const float (&v)[8]) { u32x4 w; w.x = pk2(v[0], v[1]); w.y = pk2(v[2], v[3]); w.z = pk2(v[4], v[5]); w.w = pk2(v[6], v[7]); return w; }

#define LDS_BAR() do { asm volatile("s_waitcnt lgkmcnt(0)" ::: "memory"); __builtin_amdgcn_s_barrier(); asm volatile("" ::: "memory"); } while (0)

#define XB_TMO      128
#define XB_XCNT(j)  (256  + 64 * (j))
#define XB_XSUB(j)  (1280 + 64 * (j))
#define XB_XGEN(j)  (2304 + 64 * (j))
#define XB_TOP      3328
#define XB_TOPGEN   3392
#define XCD_BAR_WORDS 3456
#define XB_SPIN_CAP (1u << 19)
__device__ __forceinline__ unsigned xb_ld(unsigned* p)              { return __hip_atomic_load(p, __ATOMIC_RELAXED, __HIP_MEMORY_SCOPE_AGENT); }
__device__ __forceinline__ unsigned xb_add(unsigned* p, unsigned v) { return __hip_atomic_fetch_add(p, v, __ATOMIC_RELAXED, __HIP_MEMORY_SCOPE_AGENT); }
__device__ __forceinline__ unsigned xb_xcc_id() { return (unsigned)__builtin_amdgcn_s_getreg((3 << 11) | 20) & 0xFu; }
#define XB_SPIN(cond, bar) do { unsigned _sp = 0; while (cond) { __builtin_amdgcn_s_sleep(1); \
    if ((++_sp & 255u) == 0u) { if (xb_ld(&(bar)[XB_TMO])) break; if (_sp > XB_SPIN_CAP) { atomicAdd(&(bar)[XB_TMO], 1u); break; } } } } while (0)
struct XcdBarrier { unsigned* bar; unsigned x; volatile LAS unsigned* st; };
__device__ __forceinline__ XcdBarrier xcd_barrier_post(unsigned* bar, volatile LAS unsigned* st) {
    XcdBarrier b; b.bar = bar; b.x = xb_xcc_id(); b.st = st;
    if (threadIdx.x == 0) (void)xb_add(&bar[XB_XCNT(b.x)], 1u);
    return b;
}
__device__ __forceinline__ void xcd_barrier_complete(unsigned* bar, unsigned x, unsigned& nloc, unsigned& nx) {
    const unsigned G = gridDim.x * gridDim.y * gridDim.z;
    unsigned sum, cnt, mine, sp = 0u;
    for (;;) {
        sum = 0u; cnt = 0u; mine = 0u;
#pragma unroll
        for (unsigned j = 0; j < 16; ++j) { const unsigned c = xb_ld(&bar[XB_XCNT(j)]); sum += c; cnt += (c > 0u) ? 1u : 0u; mine = (j == x) ? c : mine; }
        if (sum == G) break;
        __builtin_amdgcn_s_sleep(1);
        if ((++sp & 255u) == 0u) { if (xb_ld(&bar[XB_TMO])) break; if (sp > XB_SPIN_CAP) { atomicAdd(&bar[XB_TMO], 1u); break; } }
    }
    nloc = mine > 0u ? mine : 1u; nx = cnt > 0u ? cnt : 1u;
}
__device__ __forceinline__ void xcd_barrier(const XcdBarrier& b) {
    asm volatile("s_waitcnt vmcnt(0)" ::: "memory");
    __syncthreads();
    if (threadIdx.x == 0) {
        unsigned* bar = b.bar;
        __builtin_amdgcn_s_waitcnt(0);
        unsigned nloc = b.st[0], nx = b.st[1];
        if (nloc == 0u) { xcd_barrier_complete(bar, b.x, nloc, nx); b.st[0] = nloc; b.st[1] = nx; }
        const unsigned old = xb_add(&bar[XB_XSUB(b.x)], 1u);
        const unsigned gen = old / nloc;
        if (old + 1u == (gen + 1u) * nloc) {
            __builtin_amdgcn_fence(__ATOMIC_RELEASE, "agent");
            asm volatile("s_waitcnt vmcnt(0)" ::: "memory");
            const unsigned og = xb_add(&bar[XB_TOP], 1u);
            const unsigned tg = og / nx;
            if (og + 1u == (tg + 1u) * nx) xb_add(&bar[XB_TOPGEN], 1u);
            else XB_SPIN(xb_ld(&bar[XB_TOPGEN]) == tg, bar);
            __builtin_amdgcn_fence(__ATOMIC_ACQUIRE, "agent");
            xb_add(&bar[XB_XGEN(b.x)], 1u);
            asm volatile("s_waitcnt vmcnt(0)" ::: "memory");
        } else {
            XB_SPIN(xb_ld(&bar[XB_XGEN(b.x)]) == gen, bar);
            __builtin_amdgcn_fence(__ATOMIC_ACQUIRE, "agent");
            asm volatile("s_waitcnt vmcnt(0)" ::: "memory");
        }
    }
    __syncthreads();
}

struct Args {
    const float* in[34]; float* out; unsigned char* ws; int ph_lo, ph_hi;
};
typedef const __attribute__((address_space(4))) Args* ArgsP;
struct Frame {
    LAS unsigned char* lds;
    int wave, vcu, G, gw, NGW;
    unsigned char* ws; unsigned char* dob;
};
enum { I_X = 0, I_C, I_POS, I_WADA, I_BADA, I_GMIX, I_WIN, I_MU, I_W0, I_WDEC, I_A0, I_WAUP, I_WGUP, I_KK, I_KA, I_RK, I_LNW, I_LNB, I_GQA, I_WUQ, I_GKVA, I_WUKV,
       I_QN, I_KN, I_WBR, I_WOUT, I_GFFN, I_WRG, I_BRG, I_WRE, I_BRE, I_WEG, I_WEU, I_WED };

struct Unit { int pm, pn, aux, vr, nv; };
struct Gemm { const bf16* A; const bf16* Bt; int M, N, K; const int* ridx = nullptr; int ldb = 0; };
constexpr int NXCD = 8, WGM = 8;
struct StaticOrder {
    int nM, nN, nwg, G, c;
    __device__ void init(int M, int N, int G_, int c_) { nM = M / 256; nN = N / 256; nwg = nM * nN; G = G_; c = c_; }
    __device__ bool next(int i, Unit& u) const {
        const long L = (long)i * G + c; if (L >= nwg) return false;
        int wgid = (int)L; { const int q = nwg / NXCD, r = nwg % NXCD, xcd = wgid % NXCD, off = wgid / NXCD; wgid = (xcd < r ? xcd * (q + 1) : r * (q + 1) + (xcd - r) * q) + off; }
        const int nig = WGM * nN, gid = wgid / nig, fm = gid * WGM, gsz = (nM - fm) < WGM ? (nM - fm) : WGM;
        u.pm = fm + ((wgid % nig) % gsz); u.pn = (wgid % nig) / gsz; u.aux = 0; u.vr = 0; u.nv = 256; return true;
    }
    __device__ __forceinline__ void a_ready(const Unit&) const {}
    __device__ __forceinline__ void done(const Unit&) const {}
};
struct TableOrder {
    const LAS int* texp; int ntiles, nN, G, c;
    __device__ bool next(int i, Unit& u) const {
        const long L = (long)i * G + c; if (L >= (long)ntiles * nN) return false;
        const int t = (int)(L / nN), j = (int)(L % nN); u.pm = t; u.pn = texp[t] * nN + j; u.aux = 0; u.vr = 0; u.nv = 256; return true;
    }
    __device__ __forceinline__ void a_ready(const Unit&) const {}
    __device__ __forceinline__ void done(const Unit&) const {}
};

__device__ __forceinline__ void cls_decode(int cls, int& e_lo, int& e_hi) {
    const int gi = cls / 28, idx = cls % 28;
    const int lo = (idx >= 7) + (idx >= 13) + (idx >= 18) + (idx >= 22) + (idx >= 25) + (idx >= 27), base = (lo * (15 - lo)) / 2;
    e_lo = gi * 8 + lo; e_hi = gi * 8 + lo + 1 + (idx - base);
}
struct PairOrderGU {
    const LAS int* texp; const LAS int* offs; const LAS int* ccnt; int ntiles, G, c;
    __device__ bool next(int i, Unit& u) const {
        const int L = i * G + c; if (L >= ntiles * 4) return false;
        const int t = L >> 2, j = L & 3; int el, eh; const int cls = __builtin_amdgcn_readfirstlane(texp[t]); cls_decode(cls, el, eh);
        const int r0 = t * 256 - __builtin_amdgcn_readfirstlane(offs[cls]), left = __builtin_amdgcn_readfirstlane(ccnt[cls]) - r0;
        u.pm = t; u.pn = (j < 2 ? el : eh) * 2 + (j & 1); u.aux = j >> 1; u.vr = cls * CLS_CAP + r0; u.nv = left < 256 ? left : 256; return true;
    }
    __device__ __forceinline__ void a_ready(const Unit&) const {}
    __device__ __forceinline__ void done(const Unit&) const {}
};
struct PairOrderDown {
    const LAS int* texp; const LAS int* offs; const LAS int* ccnt; int ntiles, G, c;
    __device__ bool next(int i, Unit& u) const {
        const int L = i * G + c; if (L >= ntiles * 4) return false;
        const int t = L >> 2, j = L & 3; int el, eh; const int cls = __builtin_amdgcn_readfirstlane(texp[t]); cls_decode(cls, el, eh);
        const int r0 = t * 256 - __builtin_amdgcn_readfirstlane(offs[cls]), left = __builtin_amdgcn_readfirstlane(ccnt[cls]) - r0;
        u.pm = t; u.pn = el * 4 + j; u.aux = eh * 4 + j; u.vr = cls * CLS_CAP + r0; u.nv = left < 256 ? left : 256; return true;
    }
    __device__ __forceinline__ void a_ready(const Unit&) const {}
    __device__ __forceinline__ void done(const Unit&) const {}
};

template <class Epi, class Sched>
__device__ __forceinline__ void gemm_phase_naive(LAS unsigned char* lds, const Gemm g, const Sched& S, const Epi& E) {
    const int tid = (int)__builtin_amdgcn_readfirstlane((int)threadIdx.x >> 6) * 64 + lane_id_fresh(), ty = tid >> 5, tx = tid & 31;
    LAS bf16* As = (LAS bf16*)lds; LAS bf16* Bs = (LAS bf16*)(lds + 128 * 40 * 2);
    Unit u;
    for (int i = 0; S.next(i, u); ++i) {
        for (int half = 0; half < 2; ++half) {
            float acc[8][8];
#pragma unroll
            for (int r = 0; r < 8; ++r)
#pragma unroll
                for (int c = 0; c < 8; ++c) acc[r][c] = 0.f;
            const bf16* Ab = g.A + ((size_t)u.pm * 256 + half * 128) * g.K; const bf16* Bb = g.Bt + (size_t)u.pn * 256 * g.K;
            for (int k0 = 0; k0 < g.K; k0 += 32) {
                __syncthreads();
                { const int r = tid >> 2, c8 = (tid & 3) * 8; *(LAS u32x4*)(As + r * 40 + c8) = *(const u32x4*)(Ab + (size_t)r * g.K + k0 + c8); }
#pragma unroll
                for (int j = 0; j < 2; ++j) { const int ch = tid + j * 512, r = ch >> 2, c8 = (ch & 3) * 8; *(LAS u32x4*)(Bs + r * 40 + c8) = *(const u32x4*)(Bb + (size_t)r * g.K + k0 + c8); }
                __syncthreads();
#pragma unroll 2
                for (int k = 0; k < 32; k += 2) {
                    float b0[8], b1[8];
#pragma unroll
                    for (int c = 0; c < 8; ++c) { const unsigned w = *(const LAS unsigned*)(Bs + (tx * 8 + c) * 40 + k); b0[c] = lo2f(w); b1[c] = hi2f(w); }
#pragma unroll
                    for (int r = 0; r < 8; ++r) { const unsigned w = *(const LAS unsigned*)(As + (ty * 8 + r) * 40 + k); const float a0 = lo2f(w), a1 = hi2f(w);
#pragma unroll
                        for (int c = 0; c < 8; ++c) acc[r][c] = fmaf(a1, b1[c], fmaf(a0, b0[c], acc[r][c])); }
                }
            }
#pragma unroll
            for (int r = 0; r < 8; ++r) E.store8(u, half * 128 + ty * 8 + r, tx * 8, acc[r]);
        }
    }
    __syncthreads();
}

__device__ __forceinline__ u32x2 pack8_fp8(const float (&v)[8]) {
    float c[8];
#pragma unroll
    for (int i = 0; i < 8; ++i) c[i] = __builtin_amdgcn_fmed3f(v[i], -400.f, 400.f);
    int w0 = 0, w1 = 0;
    w0 = __builtin_amdgcn_cvt_pk_fp8_f32(c[0], c[1], w0, false); w0 = __builtin_amdgcn_cvt_pk_fp8_f32(c[2], c[3], w0, true);
    w1 = __builtin_amdgcn_cvt_pk_fp8_f32(c[4], c[5], w1, false); w1 = __builtin_amdgcn_cvt_pk_fp8_f32(c[6], c[7], w1, true);
    return (u32x2){(unsigned)w0, (unsigned)w1};
}
__device__ __forceinline__ void unpack8_fp8(u32x2 w, float (&v)[8]) {
    const f32x2 a = __builtin_amdgcn_cvt_pk_f32_fp8((int)w.x, false), b = __builtin_amdgcn_cvt_pk_f32_fp8((int)w.x, true), c = __builtin_amdgcn_cvt_pk_f32_fp8((int)w.y, false), d = __builtin_amdgcn_cvt_pk_f32_fp8((int)w.y, true);
    v[0] = a.x; v[1] = a.y; v[2] = b.x; v[3] = b.y; v[4] = c.x; v[5] = c.y; v[6] = d.x; v[7] = d.y;
}
struct EpiZ { bf16 *ZR, *ZM;
    __device__ __forceinline__ void store8(const Unit& u, int r, int c, const float (&v)[8]) const {
        const size_t row = (size_t)u.pm * 256 + r;
        if (u.pn < 7) { __builtin_nontemporal_store(pack8(v), (u32x4*)(ZR + row * 1792 + u.pn * 256 + c)); }
        else { __builtin_nontemporal_store(pack8(v), (u32x4*)(ZM + row * 512 + (u.pn - 7) * 256 + c)); }
    } };
struct EpiZG { bf16* SG;
    __device__ __forceinline__ void store8(const Unit& u, int r, int c, const float (&v)[8]) const {
        const size_t row = (size_t)u.pm * 256 + r; float w[8];
#pragma unroll
        for (int i = 0; i < 8; ++i) w[i] = v[i] * (1.f / 64.f);
        __builtin_nontemporal_store(pack8_fp8(w), (u32x2*)((unsigned char*)SG + row * 2048 + u.pn * 256 + c));
    } };
struct EpiLora { bf16 *LW, *A; const float *w0, *a0;
    static constexpr bool HAS_PRE = true;
    struct ColPre { f32x4 b0, b1; }; struct RowPre {}; struct Pre {};
    __device__ __forceinline__ ColPre colpre(const Unit& u, int c) const { const int col = u.pn * 256 + c; const float* bp = col < 512 ? (w0 + col) : (a0 + col - 512); return ColPre{*(const f32x4*)bp, *(const f32x4*)(bp + 4)}; }
    __device__ __forceinline__ RowPre rowpre(const Unit&, int) const { return RowPre{}; }
    __device__ __forceinline__ Pre pre(const Unit&, int, int, const RowPre&) const { return Pre{}; }
    __device__ __forceinline__ void post(const Unit& u, int r, int c, const float (&v)[8], const Pre&, const RowPre&, const ColPre& cp) const {
        const size_t row = (size_t)u.pm * 256 + r; const int col = u.pn * 256 + c; float o[8];
        const bool isw = col < 512;
        const f32x4 b0 = cp.b0, b1 = cp.b1; const float bb[8] = {b0.x, b0.y, b0.z, b0.w, b1.x, b1.y, b1.z, b1.w};
#pragma unroll
        for (int i = 0; i < 8; ++i) { const float e = __builtin_amdgcn_exp2f(fminf(-1.4426950408889634f * (bb[i] + v[i]), 120.f)); const float s = __builtin_amdgcn_rcpf(1.0f + e); o[i] = isw ? -0.60653065971263342f * s : s; }
        bf16* dst = isw ? (LW + row * 512 + col) : (A + row * 512 + col - 512);
        __builtin_nontemporal_store(pack8(o), (u32x4*)dst);
    } };
struct EpiPlain { bf16* O0; bf16* O1; int split, ld0, ld1;
    __device__ __forceinline__ void store8(const Unit& u, int r, int c, const float (&v)[8]) const {
        const size_t row = (size_t)u.pm * 256 + r; int col = u.pn * 256 + c;
        if (col < split) __builtin_nontemporal_store(pack8(v), (u32x4*)(O0 + row * ld0 + col)); else __builtin_nontemporal_store(pack8(v), (u32x4*)(O1 + row * ld1 + col - split));
    } };
struct EpiX1 { bf16* X1; const float* x; const float* mod;
    static constexpr bool HAS_PRE = true;
    struct ColPre { f32x4 h0, h1; }; struct RowPre {}; struct Pre { f32x4 x0, x1; };
    __device__ __forceinline__ ColPre colpre(const Unit& u, int c) const { const int b = (u.pm * 256) / SEQ; const float* gm = mod + b * 6144 + 2048 + u.pn * 256 + c; return ColPre{*(const f32x4*)gm * (1.f / 1024.f), *(const f32x4*)(gm + 4) * (1.f / 1024.f)}; }
    __device__ __forceinline__ RowPre rowpre(const Unit&, int) const { return RowPre{}; }
    __device__ __forceinline__ Pre pre(const Unit& u, int r, int c, const RowPre&) const { const size_t off = ((size_t)u.pm * 256 + r) * 1024 + u.pn * 256 + c; return Pre{*(const f32x4*)(x + off), *(const f32x4*)(x + off + 4)}; }
    __device__ __forceinline__ void post(const Unit& u, int r, int c, const float (&v)[8], const Pre& p, const RowPre&, const ColPre& cp) const {
        const size_t off = ((size_t)u.pm * 256 + r) * 1024 + u.pn * 256 + c;
        const float o[8] = {p.x0.x + cp.h0.x * v[0], p.x0.y + cp.h0.y * v[1], p.x0.z + cp.h0.z * v[2], p.x0.w + cp.h0.w * v[3], p.x1.x + cp.h1.x * v[4], p.x1.y + cp.h1.y * v[5], p.x1.z + cp.h1.z * v[6], p.x1.w + cp.h1.w * v[7]};
        *(u32x4*)(X1 + off) = pack8(o);
    } };
struct EpiBranch2 { bf16* MG; const bf16* SG;
    static constexpr bool HAS_PRE = true, HAS_MIDPRE = true;
    struct ColPre {}; struct RowPre {}; struct Pre { u32x2 gm; }; struct MidPre { u32x2 gr, gm; };
    __device__ __forceinline__ MidPre midpre(const Unit& u, int r, int c) const { const unsigned char* g = (const unsigned char*)SG + ((size_t)u.pm * 256 + r) * 2048 + u.pn * 256 + c; return MidPre{*(const u32x2*)g, *(const u32x2*)(g + 1024)}; }
    __device__ __forceinline__ void midpost(const Unit&, int, int, float (&v)[8], const MidPre& p) const {
        float gr[8], gm[8]; unpack8_fp8(p.gr, gr); unpack8_fp8(p.gm, gm);
#pragma unroll
        for (int i = 0; i < 8; ++i) v[i] *= (1.f + __builtin_amdgcn_exp2f(-1.4426950408889634f * fmaxf(gm[i], -30.f))) * __builtin_amdgcn_rcpf(1.f + __builtin_amdgcn_exp2f(-1.4426950408889634f * gr[i]));
    }
    __device__ __forceinline__ ColPre colpre(const Unit&, int) const { return ColPre{}; }
    __device__ __forceinline__ RowPre rowpre(const Unit&, int) const { return RowPre{}; }
    __device__ __forceinline__ Pre pre(const Unit& u, int r, int c, const RowPre&) const { return Pre{*(const u32x2*)((const unsigned char*)SG + ((size_t)u.pm * 256 + r) * 2048 + 1024 + u.pn * 256 + c)}; }
    __device__ __forceinline__ void post(const Unit& u, int r, int c, const float (&v)[8], const Pre& p, const RowPre&, const ColPre&) const {
        const size_t row = (size_t)u.pm * 256 + r; const int col = u.pn * 256 + c; float gm[8], o[8]; unpack8_fp8(p.gm, gm);
#pragma unroll
        for (int i = 0; i < 8; ++i) o[i] = (1.f / 64.f) * sigmoidf_(fmaxf(gm[i], -30.f)) * v[i];
        *(u32x2*)((unsigned char*)MG + row * 1024 + col) = pack8_fp8(o);
    } };
struct EpiGateUp { bf16* HID;
    __device__ __forceinline__ void store8(const Unit& u, int r, int c, const float (&v)[8]) const {
        const size_t row = (size_t)u.pm * 256 + r; const int col = ((u.pn & 1) * 256 + c) >> 1;
        u32x2 w; w.x = pk2(siluf_(v[0]) * v[4], siluf_(v[1]) * v[5]); w.y = pk2(siluf_(v[2]) * v[6], siluf_(v[3]) * v[7]);
        *(u32x2*)(HID + row * 256 + col) = w;
    } };
struct EpiGateUp2 { static constexpr int NSTORE = 0;
    bf16* HID2; const float* rw;
    static constexpr bool HAS_PRE = true; static constexpr int PRE_ROWS = 1;
    struct ColPre {}; struct RowPre { float w; }; struct Pre {};
    __device__ __forceinline__ ColPre colpre(const Unit&, int) const { return ColPre{}; }
    __device__ __forceinline__ RowPre rowpre(const Unit& u, int r) const { return RowPre{r < u.nv ? rw[((size_t)u.vr + r) * 2 + u.aux] : 0.f}; }
    __device__ __forceinline__ Pre pre(const Unit&, int, int, const RowPre&) const { return Pre{}; }
    __device__ __forceinline__ void post(const Unit& u, int r, int c, const float (&v)[8], const Pre&, const RowPre& rp, const ColPre&) const {
        const size_t row = (size_t)u.pm * 256 + r; const float w = rp.w * (16.f / 64.f); const int col = u.aux * 256 + (((u.pn & 1) * 256 + c) >> 1);
        float h_[4];
#pragma unroll
        for (int i = 0; i < 4; ++i) h_[i] = __builtin_amdgcn_fmed3f(w * siluf_(v[i] * (1.f / 64.f)) * v[4 + i], -440.f, 440.f);
        int o = __builtin_amdgcn_cvt_pk_fp8_f32(h_[0], h_[1], 0, false); o = __builtin_amdgcn_cvt_pk_fp8_f32(h_[2], h_[3], o, true);
        *(unsigned*)((unsigned char*)HID2 + row * 512 + col) = (unsigned)o;
    } };
struct EpiDown2 { static constexpr int NSTORE = 0;
    float* out; const bf16* X1; const LAS unsigned char* gtl; const int* ridx;
    static constexpr bool HAS_PRE = true; static constexpr int PRE_ROWS = 2;
    struct ColPre {}; struct RowPre { int tok; }; struct Pre { u32x4 xw; };
    __device__ __forceinline__ ColPre colpre(const Unit&, int) const { return ColPre{}; }
    __device__ __forceinline__ RowPre rowpre(const Unit& u, int r) const { return RowPre{r < u.nv ? ridx[u.vr + r] : -1}; }
    __device__ __forceinline__ Pre pre(const Unit& u, int, int c, const RowPre& rp) const { const int tk = rp.tok < 0 ? 0 : rp.tok; return Pre{*(const u32x4*)(X1 + (size_t)tk * 1024 + (u.pn & 3) * 256 + c)}; }
    __device__ __forceinline__ void post(const Unit& u, int, int c, const float (&v)[8], const Pre& p, const RowPre& rp, const ColPre&) const {
        const int tok = rp.tok; if (tok < 0) return;
        const int col = (u.pn & 3) * 256 + c, b = tok / SEQ; const size_t off = (size_t)tok * 1024 + col;
        const u32x4 xw = p.xw; const u32x4 gw = *(const LAS u32x4*)(gtl + (b * 1024 + col) * 2);
        f32x4 o0, o1;
        o0.x = lo2f(xw.x) + lo2f(gw.x) * v[0]; o0.y = hi2f(xw.x) + hi2f(gw.x) * v[1]; o0.z = lo2f(xw.y) + lo2f(gw.y) * v[2]; o0.w = hi2f(xw.y) + hi2f(gw.y) * v[3];
        o1.x = lo2f(xw.z) + lo2f(gw.z) * v[4]; o1.y = hi2f(xw.z) + hi2f(gw.z) * v[5]; o1.z = lo2f(xw.w) + lo2f(gw.w) * v[6]; o1.w = hi2f(xw.w) + hi2f(gw.w) * v[7];
        *(f32x4*)(out + off) = o0; *(f32x4*)(out + off + 4) = o1;
    } };
struct EpiDown { bf16* YS;
    __device__ __forceinline__ void store8(const Unit& u, int r, int c, const float (&v)[8]) const {
        const size_t row = (size_t)u.pm * 256 + r; *(u32x4*)(YS + row * 1024 + (u.pn & 3) * 256 + c) = pack8(v);
    } };


namespace pg8 {
#define PG8_LAS __attribute__((address_space(3)))
typedef ::bf16x8 bf16x8; typedef ::f32x4 f32x4; typedef int i32x4 __attribute__((ext_vector_type(4))); typedef int i32x8 __attribute__((ext_vector_type(8)));
using ::Unit; using ::Gemm;
constexpr int BM = 256, BK = 64, HALF = 128, HTB = HALF * BK * 2  , STAGE_BYTES = 8 * HTB;

__device__ __forceinline__ int lds_byte(int r, int c) { const int st = (r >> 4) * 2 + (c >> 5), rr = r & 15, cc = c & 31, ob = rr * 64 + cc * 2; return st * 1024 + (ob ^ (((ob >> 9) & 1) << 5)); }
__device__ __forceinline__ void stage_rc(int b, int& R, int& C) { const int st = b / 1024, sb = b % 1024, swz = sb ^ (((sb >> 9) & 1) << 5); R = (st >> 1) * 16 + swz / 64; C = (st & 1) * 32 + (swz % 64) / 2; }
__device__ __forceinline__ int perm32(int rho) { const int n = rho >> 4, i = rho & 15; return 8 * (i >> 2) + 4 * n + (i & 3); }
template <class Epi, class Sched, bool ALIGN_EPI = false, bool SP2 = false, bool GATHER = false, bool MIDHOOK = false, bool BSEG = false, bool FP8 = false>
__device__ __forceinline__ void gemm_phase(PG8_LAS unsigned char* lds, const Gemm g, const Sched& S, const Epi& E, const int wave_in) {
    const int lane = lane_id_fresh(), wid = wave_in, tid = wid * 64 + lane,
              wr = wid >> 2, wc = wid & 3, fr = lane & 15, fq = lane >> 4;
    constexpr int ES = FP8 ? 1 : 2;
    const int K = g.K, nt = K * ES / (BK * 2);
    unsigned voffA[2], voffB[2];
#pragma unroll
    for (int i = 0; i < 2; ++i) { int R, C; stage_rc(tid * 16 + i * 8192, R, C); const int Rb = Epi::PERM ? ((R & ~31) + perm32(R & 31)) : R;
        voffA[i] = (unsigned)(R * K) * (unsigned)ES + (unsigned)C * 2u; voffB[i] = (unsigned)(Rb * (BSEG ? g.ldb : K)) * (unsigned)ES + (unsigned)C * 2u; }
    unsigned vAc[2][2] = {{0u, 0u}, {0u, 0u}}, vAn[2][2] = {{0u, 0u}, {0u, 0u}}; int gR[2] = {0, 0}; unsigned gC[2] = {0u, 0u};
    if constexpr (GATHER) {
#pragma unroll
        for (int i = 0; i < 2; ++i) { int R, C; stage_rc(tid * 16 + i * 8192, R, C); gR[i] = R; gC[i] = (unsigned)C * 2u; } }
#define PG8_GIDX(dst, U_) do { _Pragma("unroll") for (int _h = 0; _h < 2; ++_h) _Pragma("unroll") for (int _i = 0; _i < 2; ++_i) \
        { const int rr_ = _h * HALF + gR[_i]; const int ri_ = rr_ < (U_).nv ? g.ridx[(U_).vr + rr_] : 0; dst[_h][_i] = (unsigned)ri_ * (unsigned)(K * ES) + gC[_i]; } } while (0)
    const size_t kstep = (size_t)(BK * 2);
    const size_t hstep = (size_t)HALF * K * ES;
    const size_t tstep = 2 * hstep;
    const size_t hstepB = BSEG ? (size_t)HALF * g.ldb * ES : hstep, tstepB = 2 * hstepB; const int nh = nt / 2;
    const unsigned ldsw = (unsigned)wid * 1024u;
    const int aoff = lds_byte(wr * 64 + fr, fq * 8), boff = lds_byte(wc * 32 + fr, fq * 8);
#define PG8_SA(b, h) (((b) * 2 + (h)) * HTB)
#define PG8_SB(b, h) ((4 + (b) * 2 + (h)) * HTB)
#define PG8_STAGE(bufoff, gbase, voff) do { _Pragma("unroll") for (int _i = 0; _i < 2; ++_i) \
        __builtin_amdgcn_global_load_lds((const unsigned*)((const char*)(gbase) + (voff)[_i]), (PG8_LAS unsigned*)(lds + (bufoff) + ldsw + _i * 8192), 16, 0, 0); } while (0)
#define PG8_STAGE_A(bufoff, kptr, h, isnext) do { if constexpr (GATHER) { unsigned _v[2]; _v[0] = (isnext) ? vAn[h][0] : vAc[h][0]; _v[1] = (isnext) ? vAn[h][1] : vAc[h][1]; PG8_STAGE(bufoff, kptr, _v); } \
        else { PG8_STAGE(bufoff, (kptr) + (h) * hstep, voffA); } } while (0)
#define PG8_LDA(dst, b, h) do { if constexpr (FP8) { _Pragma("unroll") for (int m = 0; m < 4; ++m) { dst##8[m].lo = *(const PG8_LAS i32x4*)(lds + PG8_SA(b, h) + aoff + m * 2048); dst##8[m].hi = *(const PG8_LAS i32x4*)(lds + PG8_SA(b, h) + aoff + m * 2048 + 1024); } } \
        else { _Pragma("unroll") for (int m = 0; m < 4; ++m) _Pragma("unroll") for (int k = 0; k < 2; ++k) dst[m][k] = *(const PG8_LAS bf16x8*)(lds + PG8_SA(b, h) + aoff + m * 2048 + k * 1024); } } while (0)
#define PG8_LDB(dst, b, h) do { if constexpr (FP8) { _Pragma("unroll") for (int n = 0; n < 2; ++n) { dst##8[n].lo = *(const PG8_LAS i32x4*)(lds + PG8_SB(b, h) + boff + n * 2048); dst##8[n].hi = *(const PG8_LAS i32x4*)(lds + PG8_SB(b, h) + boff + n * 2048 + 1024); } } \
        else { _Pragma("unroll") for (int n = 0; n < 2; ++n) _Pragma("unroll") for (int k = 0; k < 2; ++k) dst[n][k] = *(const PG8_LAS bf16x8*)(lds + PG8_SB(b, h) + boff + n * 2048 + k * 1024); } } while (0)
#define PG8_MMA(ai, bj, At, Bt) do { __builtin_amdgcn_s_setprio(1); \
        if constexpr (FP8) { _Pragma("unroll") for (int m = 0; m < 4; ++m) _Pragma("unroll") for (int n = 0; n < 2; ++n) \
              asm volatile("v_mfma_f32_16x16x128_f8f6f4 %0, %1, %2, %0" : "+v"(acc[ai][bj][m][n]) : "v"(Bt##8[n]), "v"(At##8[m])); }     \
        else { _Pragma("unroll") for (int m = 0; m < 4; ++m) _Pragma("unroll") for (int n = 0; n < 2; ++n) _Pragma("unroll") for (int k = 0; k < 2; ++k) \
              acc[ai][bj][m][n] = __builtin_amdgcn_mfma_f32_16x16x32_bf16(Bt[n][k], At[m][k], acc[ai][bj][m][n], 0, 0, 0); } \
        __builtin_amdgcn_s_setprio(0); } while (0)
#define PG8_WAIT_V(n) asm volatile("s_waitcnt vmcnt(" #n ")" ::: "memory")
#define PG8_WAIT_L(n) asm volatile("s_waitcnt lgkmcnt(" #n ")" ::: "memory")
#define PG8_BAR __builtin_amdgcn_s_barrier()
#define PG8_SCHED __builtin_amdgcn_sched_barrier(0)
    Unit cur, nxt; int ui = 0;
    if (!S.next(0, cur)) return;
    f32x4 acc[2][2][4][2];
#pragma unroll
    for (int a = 0; a < 2; ++a)
#pragma unroll
        for (int b = 0; b < 2; ++b)
#pragma unroll
            for (int m = 0; m < 4; ++m)
#pragma unroll
                for (int n = 0; n < 2; ++n) acc[a][b][m][n] = (f32x4){0.f, 0.f, 0.f, 0.f};
    bf16x8 At[4][2], B0[2][2], B1[2][2]; i32x8 At8[4], B08[2], B18[2];
    const char* cA = (const char*)g.A + (GATHER ? (size_t)0 : (size_t)cur.pm * tstep); const char* cB = (const char*)g.Bt + (size_t)cur.pn * tstepB; const char* cB2 = (const char*)g.Bt + (size_t)(BSEG ? cur.aux : cur.pn) * tstepB;
    if constexpr (GATHER) PG8_GIDX(vAc, cur);
    S.a_ready(cur);
    if constexpr (SP2) {
        PG8_STAGE(PG8_SB(0, 0), cB, voffB); PG8_STAGE(PG8_SB(0, 1), cB + hstepB, voffB); PG8_STAGE_A(PG8_SA(0, 0), cA, 0, false); PG8_STAGE_A(PG8_SA(0, 1), cA, 1, false);
        if (wr == 1) PG8_BAR;
        PG8_WAIT_V(2); PG8_BAR;
        PG8_STAGE(PG8_SB(1, 0), cB + kstep, voffB); PG8_STAGE_A(PG8_SA(1, 0), cA + kstep, 0, false); PG8_STAGE(PG8_SB(1, 1), cB + hstepB + kstep, voffB);
        if constexpr (Epi::NSTORE == 16) PG8_WAIT_V(0); else PG8_WAIT_V(6);
        PG8_BAR;
    } else {
        PG8_STAGE(PG8_SB(0, 0), cB, voffB); PG8_STAGE(PG8_SA(0, 0), cA, voffA); PG8_STAGE(PG8_SB(0, 1), cB + hstep, voffB); PG8_STAGE(PG8_SA(0, 1), cA + hstep, voffA);
        if (wr == 1) PG8_BAR;
        PG8_WAIT_V(4); PG8_BAR;
        PG8_STAGE(PG8_SB(1, 0), cB + kstep, voffB); PG8_STAGE(PG8_SA(1, 0), cA + kstep, voffA); PG8_STAGE(PG8_SB(1, 1), cB + hstep + kstep, voffB);
        PG8_WAIT_V(6); PG8_BAR;
    }
    for (;;) {
        const bool has_next = S.next(ui + 1, nxt);
        const char* nA = (has_next && !GATHER) ? (const char*)g.A + (size_t)nxt.pm * tstep : cA; const char* nB = has_next ? (const char*)g.Bt + (size_t)nxt.pn * tstepB : cB; const char* nB2 = (has_next && BSEG) ? (const char*)g.Bt + (size_t)nxt.aux * tstepB : (BSEG ? cB2 : nB);
        if constexpr (GATHER) { if (has_next) PG8_GIDX(vAn, nxt); else { _Pragma("unroll") for (int _h = 0; _h < 2; ++_h) { vAn[_h][0] = vAc[_h][0]; vAn[_h][1] = vAc[_h][1]; } } }
#define PG8_PAIR(W1, W2, W3) do { \
            if constexpr (MIDHOOK) { if (t == nt / 2) { if constexpr (FP8) asm volatile("s_nop 15\n\ts_nop 15" ::: "memory"); E.mid(acc, cur, wr, wc, fr, fq); PG8_WAIT_V(0); } } \
            const bool last = (t == nt - 2); \
            const char* a1 = cA + (size_t)(t + 1) * kstep; \
            const char* a2 = last ? nA : cA + (size_t)(t + 2) * kstep; const char* b2 = last ? nB : ((BSEG && t + 2 >= nh) ? cB2 + (size_t)(t + 2 - nh) * kstep : cB + (size_t)(t + 2) * kstep); \
            const char* a3 = a2 + kstep; const char* b3 = b2 + kstep; \
            if (last && has_next) S.a_ready(nxt); \
              \
            PG8_LDB(B0, 0, 0); PG8_LDB(B1, 0, 1); PG8_SCHED; PG8_LDA(At, 0, 0); PG8_STAGE_A(PG8_SA(1, 1), a1, 1, false); \
            PG8_WAIT_V(W1); PG8_WAIT_L(0); PG8_BAR; PG8_MMA(0, 0, At, B0); PG8_MMA(0, 1, At, B1); PG8_BAR; PG8_SCHED; \
              \
            PG8_LDA(At, 0, 1); PG8_STAGE(PG8_SB(0, 0), b2, voffB); PG8_STAGE(PG8_SB(0, 1), b2 + hstepB, voffB); PG8_STAGE_A(PG8_SA(0, 0), a2, 0, last); \
            PG8_WAIT_V(W2); PG8_WAIT_L(0); PG8_BAR; PG8_MMA(1, 0, At, B0); PG8_MMA(1, 1, At, B1); PG8_BAR; PG8_SCHED; \
              \
            PG8_LDB(B0, 1, 0); PG8_LDB(B1, 1, 1); PG8_SCHED; PG8_LDA(At, 1, 0); PG8_STAGE_A(PG8_SA(0, 1), a2, 1, last); \
            PG8_WAIT_V(W3); PG8_WAIT_L(0); PG8_BAR; PG8_MMA(0, 0, At, B0); PG8_MMA(0, 1, At, B1); PG8_BAR; PG8_SCHED; \
              \
            PG8_LDA(At, 1, 1); PG8_STAGE(PG8_SB(1, 0), b3, voffB); PG8_STAGE(PG8_SB(1, 1), b3 + hstepB, voffB); PG8_STAGE_A(PG8_SA(1, 0), a3, 0, last); \
            PG8_WAIT_V(8); PG8_WAIT_L(0); PG8_BAR; PG8_MMA(1, 0, At, B0); PG8_MMA(1, 1, At, B1); PG8_BAR; PG8_SCHED; } while (0)
        if constexpr (SP2) {
            int t = 0;
            if constexpr (Epi::NSTORE == 16) { PG8_PAIR(24, 24, 24); t = 2; }
            for (; t < nt; t += 2) PG8_PAIR(8, 8, 8);
        } else {
        for (int t = 0; t < nt; t += 2) {
            if constexpr (MIDHOOK) { if (t == nt / 2) { E.mid(acc, cur, wr, wc, fr, fq); PG8_WAIT_V(0); } }
            const bool last = (t == nt - 2);
            const char* a1 = cA + (size_t)(t + 1) * kstep;
            const char* a2 = last ? nA : cA + (size_t)(t + 2) * kstep; const char* b2 = last ? nB : cB + (size_t)(t + 2) * kstep;
            const char* a3 = a2 + kstep; const char* b3 = b2 + kstep;
            if (last && has_next) S.a_ready(nxt);
            PG8_LDB(B0, 0, 0); PG8_SCHED; PG8_LDA(At, 0, 0); PG8_STAGE(PG8_SA(1, 1), a1 + hstep, voffA);
            PG8_WAIT_L(8); PG8_BAR; PG8_WAIT_L(0); PG8_MMA(0, 0, At, B0); PG8_BAR; PG8_SCHED;
            PG8_LDB(B1, 0, 1); PG8_STAGE(PG8_SB(0, 0), b2, voffB);
            PG8_BAR; PG8_WAIT_L(0); PG8_MMA(0, 1, At, B1); PG8_BAR;
            PG8_LDA(At, 0, 1); PG8_STAGE(PG8_SA(0, 0), a2, voffA);
            PG8_BAR; PG8_WAIT_L(0); PG8_MMA(1, 0, At, B0); PG8_BAR; PG8_SCHED;
            PG8_STAGE(PG8_SB(0, 1), b2 + hstep, voffB);
            PG8_WAIT_V(6); PG8_BAR; PG8_MMA(1, 1, At, B1); PG8_BAR;
            PG8_LDB(B0, 1, 0); PG8_SCHED; PG8_LDA(At, 1, 0); PG8_STAGE(PG8_SA(0, 1), a2 + hstep, voffA);
            PG8_WAIT_L(8); PG8_BAR; PG8_WAIT_L(0); PG8_MMA(0, 0, At, B0); PG8_BAR; PG8_SCHED;
            PG8_LDB(B1, 1, 1); PG8_STAGE(PG8_SB(1, 0), b3, voffB);
            PG8_BAR; PG8_WAIT_L(0); PG8_MMA(0, 1, At, B1); PG8_BAR;
            PG8_LDA(At, 1, 1); PG8_STAGE(PG8_SA(1, 0), a3, voffA);
            PG8_BAR; PG8_WAIT_L(0); PG8_MMA(1, 0, At, B0); PG8_BAR; PG8_SCHED;
            PG8_STAGE(PG8_SB(1, 1), b3 + hstep, voffB);
            PG8_WAIT_V(6); PG8_BAR; PG8_MMA(1, 1, At, B1); PG8_BAR;
        }
        }
#undef PG8_PAIR
        if constexpr (FP8) asm volatile("s_nop 15\n\ts_nop 15" ::: "memory");
        if constexpr (ALIGN_EPI) { if (wr == 0) PG8_BAR; }
        if constexpr (!Epi::AFTER_DRAIN) { E(acc, cur, wr, wc, fr, fq); S.done(cur); }
        if (!has_next) break;
#pragma unroll
        for (int a = 0; a < 2; ++a)
#pragma unroll
            for (int b = 0; b < 2; ++b)
#pragma unroll
                for (int m = 0; m < 4; ++m)
#pragma unroll
                    for (int n = 0; n < 2; ++n) acc[a][b][m][n] = (f32x4){0.f, 0.f, 0.f, 0.f};
        cur = nxt; cA = nA; cB = nB; cB2 = nB2; ++ui;
        if constexpr (GATHER) { _Pragma("unroll") for (int _h = 0; _h < 2; ++_h) { vAc[_h][0] = vAn[_h][0]; vAc[_h][1] = vAn[_h][1]; } }
        if constexpr (ALIGN_EPI) { if (wr == 1) PG8_BAR; }
    }
    PG8_WAIT_V(0);
    if constexpr (!ALIGN_EPI) { if (wr == 0) PG8_BAR; }
    PG8_BAR;
    if constexpr (Epi::AFTER_DRAIN) { E.fused(acc, cur, wr, wc, fr, fq, lds, wid, lane); S.done(cur); }
#undef PG8_SA
#undef PG8_SB
#undef PG8_STAGE
#undef PG8_STAGE_A
#undef PG8_GIDX
#undef PG8_LDA
#undef PG8_LDB
#undef PG8_MMA
#undef PG8_WAIT_V
#undef PG8_WAIT_L
#undef PG8_BAR
#undef PG8_SCHED
}

template <class F, class = void> struct NStoreOf { static constexpr int v = 16; };
template <class F> struct NStoreOf<F, decltype((void)F::NSTORE)> { static constexpr int v = F::NSTORE; };
template <class F, class = void> struct HasPre { static constexpr bool v = false; };
template <class F> struct HasPre<F, decltype((void)F::HAS_PRE)> { static constexpr bool v = F::HAS_PRE; };
template <class F, class = void> struct PreRowsOf { static constexpr int v = 4; };
template <class F> struct PreRowsOf<F, decltype((void)F::PRE_ROWS)> { static constexpr int v = F::PRE_ROWS; };
template <class F, class = void> struct HasMidPre { static constexpr bool v = false; };
template <class F> struct HasMidPre<F, decltype((void)F::HAS_MIDPRE)> { static constexpr bool v = F::HAS_MIDPRE; };
template <class F> struct EpiAdapt {
    static constexpr bool PERM = true, AFTER_DRAIN = false; static constexpr int NSTORE = NStoreOf<F>::v; F f;
    __device__ __forceinline__ void mid(f32x4 (&acc)[2][2][4][2], const Unit& u, int wr, int wc, int fr, int fq) const {
        { const int l_ = lane_id_fresh(); fr = l_ & 15; fq = l_ >> 4; }
        if constexpr (HasMidPre<F>::v) {
#pragma unroll
            for (int ai = 0; ai < 2; ++ai) { typename F::MidPre mp[4][2];
#pragma unroll
                for (int m = 0; m < 4; ++m)
#pragma unroll
                    for (int bj = 0; bj < 2; ++bj) mp[m][bj] = f.midpre(u, ai * HALF + wr * 64 + m * 16 + fr, bj * HALF + wc * 32 + 8 * fq);
#pragma unroll
                for (int m = 0; m < 4; ++m)
#pragma unroll
                    for (int bj = 0; bj < 2; ++bj) { float v[8] = {acc[ai][bj][m][0][0], acc[ai][bj][m][0][1], acc[ai][bj][m][0][2], acc[ai][bj][m][0][3], acc[ai][bj][m][1][0], acc[ai][bj][m][1][1], acc[ai][bj][m][1][2], acc[ai][bj][m][1][3]};
                        f.midpost(u, ai * HALF + wr * 64 + m * 16 + fr, bj * HALF + wc * 32 + 8 * fq, v, mp[m][bj]);
                        acc[ai][bj][m][0] = (f32x4){v[0], v[1], v[2], v[3]}; acc[ai][bj][m][1] = (f32x4){v[4], v[5], v[6], v[7]}; } }
            return;
        } else {
#pragma unroll
        for (int ai = 0; ai < 2; ++ai)
#pragma unroll
            for (int m = 0; m < 4; ++m) { const int row = ai * HALF + wr * 64 + m * 16 + fr;
#pragma unroll
                for (int bj = 0; bj < 2; ++bj) { float v[8] = {acc[ai][bj][m][0][0], acc[ai][bj][m][0][1], acc[ai][bj][m][0][2], acc[ai][bj][m][0][3], acc[ai][bj][m][1][0], acc[ai][bj][m][1][1], acc[ai][bj][m][1][2], acc[ai][bj][m][1][3]};
                    f.mid8(u, row, bj * HALF + wc * 32 + 8 * fq, v);
                    acc[ai][bj][m][0] = (f32x4){v[0], v[1], v[2], v[3]}; acc[ai][bj][m][1] = (f32x4){v[4], v[5], v[6], v[7]}; } }
        }
    }
    __device__ __forceinline__ void operator()(const f32x4 (&acc)[2][2][4][2], const Unit& u, int wr, int wc, int fr, int fq) const {
        { const int l_ = lane_id_fresh(); fr = l_ & 15; fq = l_ >> 4; }
        if constexpr (HasPre<F>::v) {
            typename F::ColPre cp[2];
#pragma unroll
            for (int bj = 0; bj < 2; ++bj) cp[bj] = f.colpre(u, bj * HALF + wc * 32 + 8 * fq);
#pragma unroll
            for (int ai = 0; ai < 2; ++ai)
#pragma unroll
            for (int mg = 0; mg < 4; mg += PreRowsOf<F>::v) { typename F::RowPre rp[4]; typename F::Pre pr[4][2];
#pragma unroll
                for (int m = mg; m < mg + PreRowsOf<F>::v; ++m) rp[m] = f.rowpre(u, ai * HALF + wr * 64 + m * 16 + fr);
#pragma unroll
                for (int m = mg; m < mg + PreRowsOf<F>::v; ++m)
#pragma unroll
                    for (int bj = 0; bj < 2; ++bj) pr[m][bj] = f.pre(u, ai * HALF + wr * 64 + m * 16 + fr, bj * HALF + wc * 32 + 8 * fq, rp[m]);
#pragma unroll
                for (int m = mg; m < mg + PreRowsOf<F>::v; ++m)
#pragma unroll
                    for (int bj = 0; bj < 2; ++bj) { const f32x4 v0 = acc[ai][bj][m][0], v1 = acc[ai][bj][m][1];
                        const float v[8] = {v0[0], v0[1], v0[2], v0[3], v1[0], v1[1], v1[2], v1[3]};
                        f.post(u, ai * HALF + wr * 64 + m * 16 + fr, bj * HALF + wc * 32 + 8 * fq, v, pr[m][bj], rp[m], cp[bj]); } }
        } else {
#pragma unroll
        for (int ai = 0; ai < 2; ++ai)
#pragma unroll
            for (int m = 0; m < 4; ++m) { const int row = ai * HALF + wr * 64 + m * 16 + fr;
#pragma unroll
                for (int bj = 0; bj < 2; ++bj) { const f32x4 v0 = acc[ai][bj][m][0], v1 = acc[ai][bj][m][1];
                    const float v[8] = {v0[0], v0[1], v0[2], v0[3], v1[0], v1[1], v1[2], v1[3]};
                    f.store8(u, row, bj * HALF + wc * 32 + 8 * fq, v); } }
        }
    }
};
}

template <class Epi, class Sched>
__device__ __forceinline__ void gemm_phase_mid(LAS unsigned char* lds, const Gemm g, const Sched& S, const Epi& E, const int wave_in) {
    pg8::EpiAdapt<Epi> EA{E};
    pg8::gemm_phase<pg8::EpiAdapt<Epi>, Sched, true, true, false, true>(lds, g, S, EA, wave_in);
}
template <class Epi, class Sched>
__device__ __forceinline__ void gemm_phase_bseg(LAS unsigned char* lds, const Gemm g, const Sched& S, const Epi& E, const int wave_in) {
    pg8::EpiAdapt<Epi> EA{E};
    pg8::gemm_phase<pg8::EpiAdapt<Epi>, Sched, true, true, false, false, true, true>(lds, g, S, EA, wave_in);
}
template <class Epi, class Sched>
__device__ __forceinline__ void gemm_phase_gather(LAS unsigned char* lds, const Gemm g, const Sched& S, const Epi& E, const int wave_in) {
    pg8::EpiAdapt<Epi> EA{E};
    pg8::gemm_phase<pg8::EpiAdapt<Epi>, Sched, true, true, true, false, false, true>(lds, g, S, EA, wave_in);
}
template <class Epi, class Sched>
__device__ __forceinline__ void gemm_phase_mid_fp8(LAS unsigned char* lds, const Gemm g, const Sched& S, const Epi& E, const int wave_in) {
    pg8::EpiAdapt<Epi> EA{E};
    pg8::gemm_phase<pg8::EpiAdapt<Epi>, Sched, true, true, false, true, false, true>(lds, g, S, EA, wave_in);
}
template <class Epi, class Sched>
__device__ __forceinline__ void gemm_phase_fp8(LAS unsigned char* lds, const Gemm g, const Sched& S, const Epi& E, const int wave_in) {
    pg8::EpiAdapt<Epi> EA{E};
    pg8::gemm_phase<pg8::EpiAdapt<Epi>, Sched, true, true, false, false, false, true>(lds, g, S, EA, wave_in);
}
template <class Epi, class Sched>
__device__ __forceinline__ void gemm_phase_any(LAS unsigned char* lds, const Gemm g, const Sched& S, const Epi& E, const int wave_in) {
#if ENG_GEMM == 1
    pg8::EpiAdapt<Epi> EA{E};
    pg8::gemm_phase<pg8::EpiAdapt<Epi>, Sched, true, true>(lds, g, S, EA, wave_in);
#else
    gemm_phase_naive<Epi, Sched>(lds, g, S, E);
#endif
}

template <class RowMap>
__device__ __forceinline__ void transpose_item(const float* W, int ldw, bf16* WT, int ldt, int koff, int k0, int n0, const RowMap& rm, LAS float* scr, int lane) {
#pragma unroll 8
    for (int i = 0; i < 32; ++i) { const int kk = 2 * i + (lane >> 5); scr[kk * 33 + (lane & 31)] = W[(size_t)(k0 + kk) * ldw + n0 + (lane & 31)]; }
    asm volatile("s_waitcnt lgkmcnt(0)" ::: "memory");
    const int c = lane & 7;
#pragma unroll
    for (int j = 0; j < 4; ++j) { const int n = (lane >> 3) + 8 * j; const LAS float* s = scr + (8 * c) * 33 + n;
        u32x4 o; o.x = pk2(s[0 * 33], s[1 * 33]); o.y = pk2(s[2 * 33], s[3 * 33]); o.z = pk2(s[4 * 33], s[5 * 33]); o.w = pk2(s[6 * 33], s[7 * 33]);
        *(u32x4*)(WT + (size_t)rm(n0 + n) * ldt + koff + k0 + 8 * c) = o; }
    asm volatile("s_waitcnt lgkmcnt(0)" ::: "memory");
}
struct RmId { int off; __device__ int operator()(int n) const { return off + n; } };
struct RmWin { __device__ int operator()(int n) const { return n; } };
struct RmUkv { __device__ int operator()(int n) const { const int h = n >> 7, j = n & 127; return j < 64 ? h * 64 + j : 512 + h * 64 + (j - 64); } };
struct RmGU { int off; __device__ int operator()(int j) const { return off + 8 * (j >> 2) + (j & 3); } };

__device__ __forceinline__ void p0_prologue(const Frame& F, ArgsP a) {
    const int lane_f = lane_id_fresh(), tid_f = F.wave * 64 + lane_f;
    LAS float* scr = (LAS float*)(F.lds + F.wave * 16384);
    const int lane = lane_f;
    bf16* Win = (bf16*)(F.ws + WS_WIN); bf16* Wblk = (bf16*)(F.ws + WS_WBLK); bf16* Wg = (bf16*)(F.ws + WS_WG); bf16* Wuq = (bf16*)(F.ws + WS_WUQ);
    bf16* Wukv = (bf16*)(F.ws + WS_WUKV); bf16* Wb = (bf16*)(F.ws + WS_WB); bf16* Wo = (bf16*)(F.ws + WS_WO); bf16* Wgu = (bf16*)(F.ws + WS_WGU); bf16* Wdn = (bf16*)(F.ws + WS_WDN);
    constexpr int I_IN = 16 * 133, I_DEC = 1 * 16, I_AUP = 16, I_GUP = 2 * 16, I_UQ = 4 * 24, I_UKV = 2 * 32, I_BR = 2 * 8 * 32, I_O = 16 * 32;
    constexpr int I_EG = 32 * 16 * 8, I_EU = I_EG, I_ED = 32 * 4 * 32;
    constexpr int NITEMS = I_IN + I_DEC + I_AUP + I_GUP + I_UQ + I_UKV + I_BR + I_O + I_EG + I_EU + I_ED;
    struct TItem { const float* W; bf16* WT; int ldw, ldt, koff, k0, n0, kind, off; };
    auto decode = [&](int it) -> TItem {
        int r = it;
        if (r < I_IN) { const int kb = r / 133, nb = r % 133; if (nb < 69) return TItem{a->in[I_WIN], Win, D_IN, 1024, 0, 64 * kb, 32 * nb, 1, 0};
                        return TItem{a->in[I_WIN], (bf16*)(F.ws + WS_WG8), D_IN, 1024, 0, 64 * kb, 32 * nb, 5, -2208}; } r -= I_IN;
        if (r < I_DEC) { return TItem{a->in[I_WDEC], Wblk, 512, 128, 0, 0, 32 * r, 0, 0}; } r -= I_DEC;
        if (r < I_AUP) { return TItem{a->in[I_WAUP], Wblk, 512, 128, 64, 0, 32 * r, 0, 512}; } r -= I_AUP;
        if (r < I_GUP) { const int kb = r / 16, nb = r % 16; return TItem{a->in[I_WGUP], Wg, 512, 128, 0, 64 * kb, 32 * nb, 0, 0}; } r -= I_GUP;
        if (r < I_UQ) { const int kb = r / 24, nb = r % 24; return TItem{a->in[I_WUQ], Wuq, 768, 256, 0, 64 * kb, 32 * nb, 0, 0}; } r -= I_UQ;
        if (r < I_UKV) { const int kb = r / 32, nb = r % 32; return TItem{a->in[I_WUKV], Wukv, 1024, 128, 0, 64 * kb, 32 * nb, 2, 0}; } r -= I_UKV;
        if (r < I_BR) { const int br = r / 256, q = r % 256, kb = q / 32, nb = q % 32; return TItem{a->in[I_WBR] + (size_t)br * 512 * 1024, Wb, 1024, 1024, 512 * br, 64 * kb, 32 * nb, 5, 0}; } r -= I_BR;
        if (r < I_O) { const int kb = r / 32, nb = r % 32; return TItem{a->in[I_WOUT], Wo, 1024, 1024, 0, 64 * kb, 32 * nb, 5, 0}; } r -= I_O;
        if (r < I_EG) { const int e = r / 128, q = r % 128, kb = q / 8, nb = q % 8; return TItem{a->in[I_WEG] + (size_t)e * 1024 * 256, (bf16*)((unsigned char*)Wgu + (size_t)e * 512 * 1024), 256, 1024, 0, 64 * kb, 32 * nb, 4, 0}; } r -= I_EG;
        if (r < I_EU) { const int e = r / 128, q = r % 128, kb = q / 8, nb = q % 8; return TItem{a->in[I_WEU] + (size_t)e * 1024 * 256, (bf16*)((unsigned char*)Wgu + (size_t)e * 512 * 1024), 256, 1024, 0, 64 * kb, 32 * nb, 4, 4}; } r -= I_EU;
        { const int e = r / 128, q = r % 128, kb = q / 32, nb = q % 32; return TItem{a->in[I_WED] + (size_t)e * 256 * 1024, (bf16*)((unsigned char*)Wdn + (size_t)e * 1024 * 256), 1024, 256, 0, 64 * kb, 32 * nb, 5, 0}; }
    };
#define TI_LOAD(T, WV) do { const float* wp_ = (T).W + (size_t)((T).k0 + (lane >> 5)) * (T).ldw + (T).n0 + (lane & 31); \
        _Pragma("unroll") for (int i = 0; i < 32; ++i) WV[i] = wp_[(size_t)(2 * i) * (T).ldw]; } while (0)
#define TI_FINISH(T, WV) do { \
        _Pragma("unroll") for (int i = 0; i < 32; ++i) scr[(2 * i + (lane >> 5)) * 33 + (lane & 31)] = WV[i]; \
        asm volatile("s_waitcnt lgkmcnt(0)" ::: "memory"); \
        const int c_ = lane & 7; \
        _Pragma("unroll") for (int j = 0; j < 4; ++j) { const int nl_ = (lane >> 3) + 8 * j; const LAS float* s_ = scr + (8 * c_) * 33 + nl_; const int n_ = (T).n0 + nl_; int row_; \
            if ((T).kind == 0) row_ = (T).off + n_; else if ((T).kind == 1) row_ = RmWin{}(n_); else if ((T).kind == 2) row_ = RmUkv{}(n_); else if ((T).kind == 4) row_ = RmGU{(T).off}(n_); else row_ = (T).off + n_; \
            if ((T).kind >= 4) { const float f_[8] = {64.f * s_[0 * 33], 64.f * s_[1 * 33], 64.f * s_[2 * 33], 64.f * s_[3 * 33], 64.f * s_[4 * 33], 64.f * s_[5 * 33], 64.f * s_[6 * 33], 64.f * s_[7 * 33]}; \
                *(u32x2*)((unsigned char*)(T).WT + (size_t)row_ * (T).ldt + (T).koff + (T).k0 + 8 * c_) = pack8_fp8(f_); } \
            else { u32x4 o_; o_.x = pk2(s_[0 * 33], s_[1 * 33]); o_.y = pk2(s_[2 * 33], s_[3 * 33]); o_.z = pk2(s_[4 * 33], s_[5 * 33]); o_.w = pk2(s_[6 * 33], s_[7 * 33]); \
                *(u32x4*)((T).WT + (size_t)row_ * (T).ldt + (T).koff + (T).k0 + 8 * c_) = o_; } } \
        asm volatile("s_waitcnt lgkmcnt(0)" ::: "memory"); } while (0)
    if (F.gw < NITEMS) {
        float wa[32], wb[32];
        TItem ta = decode(F.gw), tb = ta; TI_LOAD(ta, wa);
        for (int it = F.gw; it < NITEMS; it += 2 * F.NGW) {
            { const int i1 = it + F.NGW; tb = decode(i1 < NITEMS ? i1 : it); TI_LOAD(tb, wb); }
            TI_FINISH(ta, wa);
            { const int i2 = it + 2 * F.NGW; ta = decode(i2 < NITEMS ? i2 : it); TI_LOAD(ta, wa); }
            if (it + F.NGW < NITEMS) TI_FINISH(tb, wb);
        }
    }
#undef TI_LOAD
#undef TI_FINISH
    for (int i = F.gw * 64 + lane; i < 96 * 128; i += F.NGW * 64) *(u32x4*)(Win + (size_t)2208 * 1024 + (size_t)i * 8) = (u32x4){0u, 0u, 0u, 0u};
    for (int i = F.gw * 64 + lane; i < 1024 * 8; i += F.NGW * 64) { const int row = i >> 3, c8 = (i & 7) * 8; *(u32x4*)(Wblk + row * 128 + (row < 512 ? 64 : 0) + c8) = (u32x4){0u, 0u, 0u, 0u}; }
    { const int* pos = (const int*)a->in[I_POS]; float* cs = (float*)(F.ws + WS_CS);
      for (int i0 = F.gw * 64 + lane; i0 < NTOK * 16; i0 += 8 * F.NGW * 64) { int pv[8];
#pragma unroll
          for (int k = 0; k < 8; ++k) { const int i = i0 + k * F.NGW * 64; pv[k] = pos[(i < NTOK * 16 ? i : i0) >> 4]; }
#pragma unroll
          for (int k = 0; k < 8; ++k) { const int i = i0 + k * F.NGW * 64; if (i < NTOK * 16) { const int t = i >> 4, j = i & 15;
              const float fr = exp2f(-(float)j * (13.287712379549449f / 16.0f));
              const float ang = (float)pv[k] * fr; cs[t * 32 + j] = cosf(ang); cs[t * 32 + 16 + j] = sinf(ang); } } } }
    { float* mod = (float*)(F.ws + WS_MOD); const float* c = a->in[I_C]; const float* wa = a->in[I_WADA]; const float* ba = a->in[I_BADA];
      LAS float* red = (LAS float*)(F.lds + 8 * 16384);
      LAS float* sc = (LAS float*)F.lds;
      if (F.vcu < 96) {
          __syncthreads();
          { float cv[16];
#pragma unroll
            for (int k = 0; k < 16; ++k) cv[k] = c[tid_f + k * NTHR];
#pragma unroll
            for (int k = 0; k < 16; ++k) sc[tid_f + k * NTHR] = siluf_(cv[k]); }
          __syncthreads();
      }
      for (int nb = F.vcu; nb < 96; nb += F.G) {
          float acc[8];
#pragma unroll
          for (int b = 0; b < 8; ++b) acc[b] = 0.f;
          const int n = nb * 64 + lane;
          for (int k0 = F.wave * 128; k0 < F.wave * 128 + 128; k0 += 16) { float w[16];
#pragma unroll
              for (int kk = 0; kk < 16; ++kk) w[kk] = wa[(size_t)(k0 + kk) * 6144 + n];
#pragma unroll
              for (int kk = 0; kk < 16; ++kk)
#pragma unroll
                  for (int b = 0; b < 8; ++b) acc[b] = fmaf(sc[b * 1024 + k0 + kk], w[kk], acc[b]); }
#pragma unroll
          for (int b = 0; b < 8; ++b) red[(F.wave * 8 + b) * 64 + lane] = acc[b];
          __syncthreads();
          { const int b = F.wave; float s = ba[n];
#pragma unroll
            for (int w = 0; w < 8; ++w) s += red[(w * 8 + b) * 64 + lane];
            mod[b * 6144 + n] = s; }
          __syncthreads();
      } }
}

__device__ __forceinline__ void p_normmod(const Frame& F, const float* x, const float* g, const float* mod, int sh_off, int sc_off, bf16* H, unsigned char* H8) {
    const int lane_f = lane_id_fresh();
    f32x4 xa[4], xb[4];
    { const f32x4* xr = (const f32x4*)(x + (size_t)F.gw * 1024) + lane_f;
#pragma unroll
      for (int j = 0; j < 4; ++j) xa[j] = xr[64 * j]; }
    f32x4 gs[4], sh[4]; int bcur = -1;
#define NM_ROW(CUR, NXT, m_) do { const int mm = (m_); const int b = mm / SEQ; \
        if (b != bcur) { bcur = b; \
            _Pragma("unroll") for (int j = 0; j < 4; ++j) { const int col = 4 * lane_f + 256 * j; gs[j] = *(const f32x4*)(g + col) * (*(const f32x4*)(mod + b * 6144 + sc_off + col) + 1.0f); sh[j] = *(const f32x4*)(mod + b * 6144 + sh_off + col); } \
            asm volatile("s_waitcnt vmcnt(0)" : "+v"(gs[0]), "+v"(gs[1]), "+v"(gs[2]), "+v"(gs[3]), "+v"(sh[0]), "+v"(sh[1]), "+v"(sh[2]), "+v"(sh[3]), "+v"(CUR[0]), "+v"(CUR[1]), "+v"(CUR[2]), "+v"(CUR[3])); } \
        { const int mn = (mm + F.NGW < NTOK) ? mm + F.NGW : mm; const f32x4* xr = (const f32x4*)(x + (size_t)mn * 1024) + lane_f; \
          _Pragma("unroll") for (int j = 0; j < 4; ++j) NXT[j] = xr[64 * j]; } \
        float s = 0.f; \
        _Pragma("unroll") for (int j = 0; j < 4; ++j) s += (CUR[j].x * CUR[j].x + CUR[j].y * CUR[j].y) + (CUR[j].z * CUR[j].z + CUR[j].w * CUR[j].w); \
        const float rstd = __builtin_amdgcn_rsqf(wave_sum(s) * (1.f / 1024.f) + EPS); \
        u32x2* o = (u32x2*)(H + (size_t)mm * 1024) + lane_f; unsigned* o8 = (unsigned*)(H8 + (size_t)mm * 1024) + lane_f; \
        _Pragma("unroll") for (int j = 0; j < 4; ++j) { const f32x4 y = CUR[j] * rstd * gs[j] + sh[j]; u32x2 w; w.x = pk2(y.x, y.y); w.y = pk2(y.z, y.w); o[64 * j] = w; \
            int w8 = __builtin_amdgcn_cvt_pk_fp8_f32(__builtin_amdgcn_fmed3f(y.x, -440.f, 440.f), __builtin_amdgcn_fmed3f(y.y, -440.f, 440.f), 0, false); \
            w8 = __builtin_amdgcn_cvt_pk_fp8_f32(__builtin_amdgcn_fmed3f(y.z, -440.f, 440.f), __builtin_amdgcn_fmed3f(y.w, -440.f, 440.f), w8, true); o8[64 * j] = (unsigned)w8; } } while (0)
    for (int m = F.gw; m < NTOK; m += 2 * F.NGW) {
        NM_ROW(xa, xb, m);
        if (m + F.NGW < NTOK) NM_ROW(xb, xa, m + F.NGW);
    }
#undef NM_ROW
}

__device__ __forceinline__ void p_prep_a(const Frame& F, ArgsP a) {
    const int lane_f = lane_id_fresh();
    const bf16* ZR = (const bf16*)(F.ws + WS_ZR); const bf16* ZM = (const bf16*)(F.ws + WS_ZM);
    bf16* TWA = (bf16*)(F.ws + WS_TWA); bf16* SGL = (bf16*)(F.ws + WS_SGL); bf16* QA = (bf16*)(F.ws + WS_QA); bf16* KVA = (bf16*)(F.ws + WS_KVA);
    const float* mu = a->in[I_MU]; const float* gqa = a->in[I_GQA]; const float* gkva = a->in[I_GKVA];
    const int lane = lane_f;
    const f32x4 mm = *(const f32x4*)(mu + 1536 + 4 * lane), gq = *(const f32x4*)(gqa + 4 * lane), gk = *(const f32x4*)(gkva + 4 * (lane & 31));
#define PA_LOAD(CC, PP, QQ, KK, m0_) do { _Pragma("unroll") for (int u = 0; u < 4; ++u) { const int mq = (m0_) + u * F.NGW; const int m = mq < NTOK ? mq : F.gw; const bool first = (m % SEQ) == 0; \
            CC[u] = *((const u32x2*)(ZR + (size_t)m * 1792 + 1536) + lane); PP[u] = *((const u32x2*)(ZR + (size_t)(first ? m : m - 1) * 1792 + 1536) + lane); \
            QQ[u] = *((const u32x2*)(ZM + (size_t)m * 512) + lane); KK[u] = *((const u32x2*)(ZM + (size_t)m * 512 + 256) + (lane & 31)); } } while (0)
#define PA_COMP(CC, PP, QQ, KK, m0_) do { _Pragma("unroll") for (int u = 0; u < 4; ++u) { const int m = (m0_) + u * F.NGW; if (m < NTOK) { const bool first = (m % SEQ) == 0; \
            { const u32x2 c = CC[u]; u32x2 p = PP[u]; if (first) { p.x = 0u; p.y = 0u; } \
              float z[4] = {lo2f(c.x), hi2f(c.x), lo2f(c.y), hi2f(c.y)}; const float q[4] = {lo2f(p.x), hi2f(p.x), lo2f(p.y), hi2f(p.y)}; \
              z[0] += (q[0] - z[0]) * mm.x; z[1] += (q[1] - z[1]) * mm.y; z[2] += (q[2] - z[2]) * mm.z; z[3] += (q[3] - z[3]) * mm.w; \
              if (lane < 16) { u32x2 w; w.x = pk2(tanhf_(z[0]), tanhf_(z[1])); w.y = pk2(tanhf_(z[2]), tanhf_(z[3])); *((u32x2*)(TWA + (size_t)m * 128) + lane) = w; } \
              else if (lane < 32) { u32x2 w; w.x = pk2(z[0], z[1]); w.y = pk2(z[2], z[3]); *((u32x2*)(TWA + (size_t)m * 128) + lane) = w; } \
              else { u32x2 w; w.x = pk2(sigmoidf_(z[0]), sigmoidf_(z[1])); w.y = pk2(sigmoidf_(z[2]), sigmoidf_(z[3])); *((u32x2*)(SGL + (size_t)m * 128) + (lane - 32)) = w; } } \
            { const u32x2 c = QQ[u]; const float z[4] = {lo2f(c.x), hi2f(c.x), lo2f(c.y), hi2f(c.y)}; \
              u32x2 c2 = KK[u]; if (lane >= 32) { c2.x = 0u; c2.y = 0u; } const float y[4] = {lo2f(c2.x), hi2f(c2.x), lo2f(c2.y), hi2f(c2.y)}; \
              const float rstd = 1.0f / sqrtf(wave_sum((z[0] * z[0] + z[1] * z[1]) + (z[2] * z[2] + z[3] * z[3])) * (1.f / 256.f) + EPS); \
              const float rstd2 = 1.0f / sqrtf(wave_sum((y[0] * y[0] + y[1] * y[1]) + (y[2] * y[2] + y[3] * y[3])) * (1.f / 128.f) + EPS); \
              u32x2 w; w.x = pk2(z[0] * rstd * gq.x, z[1] * rstd * gq.y); w.y = pk2(z[2] * rstd * gq.z, z[3] * rstd * gq.w); \
              *((u32x2*)(QA + (size_t)m * 256) + lane) = w; \
              if (lane < 32) { u32x2 w2; w2.x = pk2(y[0] * rstd2 * gk.x, y[1] * rstd2 * gk.y); w2.y = pk2(y[2] * rstd2 * gk.z, y[3] * rstd2 * gk.w); \
                  *((u32x2*)(KVA + (size_t)m * 128) + lane) = w2; } } } } } while (0)
    u32x2 ca[4], pa[4], qa[4], ka[4], cb[4], pb[4], qb[4], kb[4];
    PA_LOAD(ca, pa, qa, ka, F.gw);
    for (int m0 = F.gw; m0 < NTOK; m0 += 8 * F.NGW) {
        PA_LOAD(cb, pb, qb, kb, m0 + 4 * F.NGW); PA_COMP(ca, pa, qa, ka, m0);
        PA_LOAD(ca, pa, qa, ka, m0 + 8 * F.NGW); PA_COMP(cb, pb, qb, kb, m0 + 4 * F.NGW);
    }
#undef PA_LOAD
#undef PA_COMP
}

__device__ __forceinline__ void p_prep_c(const Frame& F_, ArgsP a, int gwi, int ngw) {
    struct { int gw, NGW; unsigned char* ws; unsigned char* dob; } F{gwi, ngw, F_.ws, F_.dob};
    const int lane_f = lane_id_fresh();
    const bf16* KN = (const bf16*)(F.dob + DO_KN); const bf16* ZM = (const bf16*)(F.ws + WS_ZM); bf16* KC = (bf16*)(F.ws + WS_KC);
    const float* cs = (const float*)(F.ws + WS_CS); const float* kn = a->in[I_KN];
    const int lane = lane_f, hd = lane >> 3, j = lane & 7;
    const f32x4 kg0 = *(const f32x4*)(kn + 8 * j), kg1 = *(const f32x4*)(kn + 8 * j + 4); const f32x2 kr1 = *(const f32x2*)(kn + 64 + 2 * j), kr2 = *(const f32x2*)(kn + 80 + 2 * j);
#define PC_LOAD(KV, Z1, Z2, CC, SN, m0_) do { _Pragma("unroll") for (int u = 0; u < 4; ++u) { const int mq = (m0_) + u * F.NGW; const size_t m = (size_t)(mq < NTOK ? mq : F.gw); \
            KV[u] = *(const u32x4*)(KN + m * 512 + hd * 64 + 8 * j); Z1[u] = *(const unsigned*)(ZM + m * 512 + 384 + 2 * j); Z2[u] = *(const unsigned*)(ZM + m * 512 + 400 + 2 * j); \
            CC[u] = *(const f32x2*)(cs + m * 32 + 2 * j); SN[u] = *(const f32x2*)(cs + m * 32 + 16 + 2 * j); } } while (0)
#define PC_COMP(KV, Z1, Z2, CC, SN, m0_) do { _Pragma("unroll") for (int u = 0; u < 4; ++u) { const int m = (m0_) + u * F.NGW; if (m < NTOK) { \
            float v[8]; unpack8(KV[u], v); float x1[2] = {lo2f(Z1[u]), hi2f(Z1[u])}, x2[2] = {lo2f(Z2[u]), hi2f(Z2[u])}; \
            float ss = (x1[0] * x1[0] + x1[1] * x1[1]) + (x2[0] * x2[0] + x2[1] * x2[1]); \
            _Pragma("unroll") for (int i = 0; i < 8; ++i) ss += v[i] * v[i]; \
            const float rstd = 1.0f / sqrtf(sum8(ss) * (1.f / 96.f) + EPS); \
            v[0] *= rstd * kg0.x; v[1] *= rstd * kg0.y; v[2] *= rstd * kg0.z; v[3] *= rstd * kg0.w; v[4] *= rstd * kg1.x; v[5] *= rstd * kg1.y; v[6] *= rstd * kg1.z; v[7] *= rstd * kg1.w; \
            x1[0] *= rstd * kr1.x; x1[1] *= rstd * kr1.y; x2[0] *= rstd * kr2.x; x2[1] *= rstd * kr2.y; \
            bf16* kp = KC + (size_t)m * 768 + hd * 96; \
            *(u32x4*)(kp + 8 * j) = pack8(v); *(unsigned*)(kp + 64 + 2 * j) = pk2(x1[0] * CC[u].x - x2[0] * SN[u].x, x1[1] * CC[u].y - x2[1] * SN[u].y); \
            *(unsigned*)(kp + 80 + 2 * j) = pk2(x2[0] * CC[u].x + x1[0] * SN[u].x, x2[1] * CC[u].y + x1[1] * SN[u].y); } } } while (0)
    u32x4 kva[4], kvb[4]; unsigned z1a[4], z2a[4], z1b[4], z2b[4]; f32x2 cca[4], sna[4], ccb[4], snb[4];
    PC_LOAD(kva, z1a, z2a, cca, sna, F.gw);
    for (int m0 = F.gw; m0 < NTOK; m0 += 8 * F.NGW) {
        PC_LOAD(kvb, z1b, z2b, ccb, snb, m0 + 4 * F.NGW); PC_COMP(kva, z1a, z2a, cca, sna, m0);
        PC_LOAD(kva, z1a, z2a, cca, sna, m0 + 8 * F.NGW); PC_COMP(kvb, z1b, z2b, ccb, snb, m0 + 4 * F.NGW);
    }
#undef PC_LOAD
#undef PC_COMP
}

__device__ __forceinline__ void p_attn_naive(const Frame& F) {
    const int lane_f = lane_id_fresh(), tid_f = F.wave * 64 + lane_f;
    const bf16* Q = (const bf16*)(F.dob + DO_Q); const bf16* KC = (const bf16*)(F.ws + WS_KC); const bf16* VC = (const bf16*)(F.ws + WS_VC); bf16* YM = (bf16*)(F.ws + WS_YM);
    LAS float* Ks = (LAS float*)F.lds; LAS float* Vs = (LAS float*)(F.lds + 32 * 96 * 4);
    const int tid = tid_f;
    for (int unit = F.vcu; unit < 64 * 16; unit += F.G) {
        const int bh = unit >> 4, qb = 15 - (unit & 15), b = bh >> 3, h = bh & 7; const size_t row0 = (size_t)b * SEQ; const int t = qb * 512 + tid;
        unsigned qp[48];
        { const u32x4* qg = (const u32x4*)(Q + (row0 + t) * 768 + h * 96);
#pragma unroll
          for (int i = 0; i < 12; ++i) { const u32x4 w = qg[i]; qp[4 * i] = w.x; qp[4 * i + 1] = w.y; qp[4 * i + 2] = w.z; qp[4 * i + 3] = w.w; } }
        float o[64];
#pragma unroll
        for (int i = 0; i < 64; ++i) o[i] = 0.f;
        float mx = -INFINITY, l = 0.f;
        const int nkt = (qb + 1) * 16;
        for (int kt = 0; kt < nkt; ++kt) {
            __syncthreads();
            if (tid < 384) { const int r = tid / 12, c8 = (tid % 12) * 8; float v[8]; unpack8(*(const u32x4*)(KC + (row0 + kt * 32 + r) * 768 + h * 96 + c8), v);
#pragma unroll
                for (int i = 0; i < 8; ++i) Ks[r * 96 + c8 + i] = v[i]; }
            if (tid < 256) { const int r = tid >> 3, c8 = (tid & 7) * 8; float v[8]; unpack8(*(const u32x4*)(VC + (row0 + kt * 32 + r) * 512 + h * 64 + c8), v);
#pragma unroll
                for (int i = 0; i < 8; ++i) Vs[r * 64 + c8 + i] = v[i]; }
            __syncthreads();
            for (int kk = 0; kk < 32; ++kk) {
                const int kv = kt * 32 + kk;
                float s = 0.f; const LAS f32x4* kr = (const LAS f32x4*)(Ks + kk * 96);
#pragma unroll
                for (int i = 0; i < 24; ++i) { const f32x4 k4 = kr[i]; s += lo2f(qp[2 * i]) * k4.x + hi2f(qp[2 * i]) * k4.y + lo2f(qp[2 * i + 1]) * k4.z + hi2f(qp[2 * i + 1]) * k4.w; }
                if (kv <= t) {
                    const float mn = fmaxf(mx, s), f = exp2f(mx - mn), p = exp2f(s - mn); mx = mn; l = l * f + p;
                    const LAS f32x4* vr = (const LAS f32x4*)(Vs + kk * 64);
#pragma unroll
                    for (int i = 0; i < 16; ++i) { const f32x4 v4 = vr[i]; o[4 * i] = o[4 * i] * f + p * v4.x; o[4 * i + 1] = o[4 * i + 1] * f + p * v4.y; o[4 * i + 2] = o[4 * i + 2] * f + p * v4.z; o[4 * i + 3] = o[4 * i + 3] * f + p * v4.w; }
                }
            }
        }
        const float il = 1.f / l; u32x4* og = (u32x4*)(YM + (row0 + t) * 512 + h * 64);
#pragma unroll
        for (int i = 0; i < 8; ++i) { u32x4 w; w.x = pk2(o[8 * i] * il, o[8 * i + 1] * il); w.y = pk2(o[8 * i + 2] * il, o[8 * i + 3] * il); w.z = pk2(o[8 * i + 4] * il, o[8 * i + 5] * il); w.w = pk2(o[8 * i + 6] * il, o[8 * i + 7] * il); og[i] = w; }
    }
    __syncthreads();
}

typedef float f32x16 __attribute__((ext_vector_type(16)));
typedef short s16x4 __attribute__((ext_vector_type(4)));
__device__ __forceinline__ int crow(int r, int hi) { return (r & 3) + 8 * (r >> 2) + 4 * hi; }
__device__ __forceinline__ float max3f(float a, float b, float c) { float r; asm("v_max3_f32 %0, %1, %2, %3" : "=v"(r) : "v"(a), "v"(b), "v"(c)); return r; }
__device__ __forceinline__ float max2f(float a, float b) { float r; asm("v_max_f32_e32 %0, %1, %2" : "=v"(r) : "v"(a), "v"(b)); return r; }
__device__ __forceinline__ float xhalf_max(float x) { auto rr = __builtin_amdgcn_permlane32_swap(__float_as_uint(x), __float_as_uint(x), false, false); return max2f(__uint_as_float(rr[0]), __uint_as_float(rr[1])); }
__device__ __forceinline__ float xhalf_sum(float x) { auto rr = __builtin_amdgcn_permlane32_swap(__float_as_uint(x), __float_as_uint(x), false, false); return __uint_as_float(rr[0]) + __uint_as_float(rr[1]); }
__device__ __forceinline__ bf16x8 packp(const f32x16& p, int s2) {
    u32x4 w; w.x = pk2(p[8 * s2 + 0], p[8 * s2 + 1]); w.y = pk2(p[8 * s2 + 2], p[8 * s2 + 3]); w.z = pk2(p[8 * s2 + 4], p[8 * s2 + 5]); w.w = pk2(p[8 * s2 + 6], p[8 * s2 + 7]);
    return __builtin_bit_cast(bf16x8, w);
}
template <bool BOUNDED>
__device__ __forceinline__ void p_attn_body(const Frame& F, const float* qn) {
    const int lane_f = lane_id_fresh(), tid_f = F.wave * 64 + lane_f;
    const bf16* Q = (const bf16*)(F.dob + DO_Q); const bf16* KC = (const bf16*)(F.ws + WS_KC); const bf16* VC = (const bf16*)(F.ws + WS_VC); bf16* YM = (bf16*)(F.ws + WS_YM);
    const float* cs = (const float*)(F.ws + WS_CS);
    constexpr int KST = 208, VST = 192, KBYTES = 64 * KST, SUB = KBYTES + 64 * VST, BUF = 2 * SUB;
    const int tid = tid_f, lane = lane_f, wave = F.wave, r = lane & 31, hi = lane >> 5;
    int kg[3], kl[3], vg[2], vl[2];
#pragma unroll
    for (int i = 0; i < 3; ++i) { const int c = tid + 512 * i, row = c / 12, pc = c % 12; kg[i] = row * 768 + pc * 8; kl[i] = (row >> 6) * SUB + (row & 63) * KST + pc * 16; }
#pragma unroll
    for (int i = 0; i < 2; ++i) { const int c = tid + 512 * i, row = c >> 3, pc = c & 7; vg[i] = row * 512 + pc * 8; vl[i] = (row >> 6) * SUB + KBYTES + (row & 63) * VST + pc * 16; }
    const int g4 = lane >> 4, li = lane & 15;
    const int vtr = (4 * (g4 >> 1) + (li >> 2)) * VST + (16 * (g4 & 1) + 4 * (li & 3)) * 2;
    const int kfr = r * KST + hi * 16;
    LAS unsigned char* lds = F.lds;
    bool carried = false;
    for (int item = F.vcu; item < 1024; item += F.G) {
        const int bh = item >> 4, sidx = item & 15, b = bh >> 3, h = bh & 7; const size_t row0 = (size_t)b * SEQ;
        const bf16* Kg = KC + row0 * 768 + h * 96; const bf16* Vg = VC + row0 * 512 + h * 64;
        for (int uu = 0; uu < 2; ++uu) {
            const int qb = uu == 0 ? 31 - sidx : sidx, q0 = qb * 256, NT = (q0 + 256) / 128;
            const int qw = q0 + wave * 32;
            bf16x8 qf[6];
            {
              const bf16* qp = Q + (row0 + qw + r) * 768 + h * 96 + hi * 8; const float* csr = cs + (row0 + qw + r) * 32 + 8 * hi;
              u32x4 raw[6];
#pragma unroll
              for (int s = 0; s < 6; ++s) raw[s] = *(const u32x4*)(qp + 16 * s);
              const f32x4 c0 = *(const f32x4*)csr, c1 = *(const f32x4*)(csr + 4), s0 = *(const f32x4*)(csr + 16), s1 = *(const f32x4*)(csr + 20);
              float ss = 0.f;
#pragma unroll
              for (int s = 0; s < 6; ++s) { float t[8]; unpack8(raw[s], t);
#pragma unroll
                  for (int e = 0; e < 8; ++e) ss += t[e] * t[e]; }
              const float rstd = QSCALE / sqrtf(xhalf_sum(ss) * (1.f / 96.f) + EPS);
#pragma unroll
              for (int s = 0; s < 4; ++s) { float t[8]; unpack8(raw[s], t); const f32x4 g0 = *(const f32x4*)(qn + 16 * s + 8 * hi), g1 = *(const f32x4*)(qn + 16 * s + 8 * hi + 4);
                  t[0] *= rstd * g0.x; t[1] *= rstd * g0.y; t[2] *= rstd * g0.z; t[3] *= rstd * g0.w; t[4] *= rstd * g1.x; t[5] *= rstd * g1.y; t[6] *= rstd * g1.z; t[7] *= rstd * g1.w;
                  qf[s] = __builtin_bit_cast(bf16x8, pack8(t)); }
              { float a4[8], a5[8]; unpack8(raw[4], a4); unpack8(raw[5], a5);
                const f32x4 g0 = *(const f32x4*)(qn + 64 + 8 * hi), g1 = *(const f32x4*)(qn + 64 + 8 * hi + 4), h0 = *(const f32x4*)(qn + 80 + 8 * hi), h1 = *(const f32x4*)(qn + 80 + 8 * hi + 4);
                const float ga[8] = {g0.x, g0.y, g0.z, g0.w, g1.x, g1.y, g1.z, g1.w}, gb[8] = {h0.x, h0.y, h0.z, h0.w, h1.x, h1.y, h1.z, h1.w};
                const float cc[8] = {c0.x, c0.y, c0.z, c0.w, c1.x, c1.y, c1.z, c1.w}, sn[8] = {s0.x, s0.y, s0.z, s0.w, s1.x, s1.y, s1.z, s1.w};
#pragma unroll
                for (int e = 0; e < 8; ++e) { const float x1 = a4[e] * rstd * ga[e], x2 = a5[e] * rstd * gb[e]; a4[e] = x1 * cc[e] - x2 * sn[e]; a5[e] = x2 * cc[e] + x1 * sn[e]; }
                qf[4] = __builtin_bit_cast(bf16x8, pack8(a4)); qf[5] = __builtin_bit_cast(bf16x8, pack8(a5)); } }
            f32x16 o0 = {}, o1 = {}, negm = {}; float m = 0.f, l = 0.f;
            u32x4 ak[3], av[2];
            if (!carried) {
#pragma unroll
                for (int i = 0; i < 3; ++i) ak[i] = *(const u32x4*)(Kg + kg[i]);
#pragma unroll
                for (int i = 0; i < 2; ++i) av[i] = *(const u32x4*)(Vg + vg[i]);
                asm volatile("" : "+v"(qf[0]), "+v"(qf[1]), "+v"(qf[2]), "+v"(qf[3]), "+v"(qf[4]), "+v"(qf[5]));
                LDS_BAR();
#pragma unroll
                for (int i = 0; i < 3; ++i) *(LAS u32x4*)(lds + kl[i]) = ak[i];
#pragma unroll
                for (int i = 0; i < 2; ++i) *(LAS u32x4*)(lds + vl[i]) = av[i];
                LDS_BAR();
            } else asm volatile("" : "+v"(qf[0]), "+v"(qf[1]), "+v"(qf[2]), "+v"(qf[3]), "+v"(qf[4]), "+v"(qf[5]));
            for (int t = 0; t < NT; ++t) {
                LAS unsigned char* bb = lds + (t & 1) * BUF;
                { const bool lst = t + 1 >= NT;
                  const int bhx = (lst && uu == 1) ? (((item + F.G < 1024) ? item + F.G : item) >> 4) : bh;
                  const size_t rx = (size_t)(bhx >> 3) * SEQ + (lst ? 0 : (t + 1) * 128);
                  const bf16* kgp = KC + rx * 768 + (bhx & 7) * 96; const bf16* vgp = VC + rx * 512 + (bhx & 7) * 64;
#pragma unroll
                  for (int i = 0; i < 3; ++i) ak[i] = *(const u32x4*)(kgp + kg[i]);
#pragma unroll
                  for (int i = 0; i < 2; ++i) av[i] = *(const u32x4*)(vgp + vg[i]); }
                bool fused = false;
                if constexpr (BOUNDED) fused = 128 * t + 127 <= qw;
                if (fused) {
                    LAS unsigned char* kb0 = bb; LAS unsigned char* vb0 = bb + KBYTES; LAS unsigned char* kb1 = bb + SUB; LAS unsigned char* vb1 = kb1 + KBYTES;
                    bf16x8 ka0[6], ka1[6], kc0[6], kc1[6];
#pragma unroll
                    for (int s = 0; s < 6; ++s) { ka0[s] = *(const LAS bf16x8*)(kb0 + kfr + s * 32); ka1[s] = *(const LAS bf16x8*)(kb0 + kfr + 32 * KST + s * 32); }
                    __builtin_amdgcn_sched_barrier(0);
                    f32x16 p0 = {}, p1 = {}, p2 = {}, p3 = {};
#pragma unroll
                    for (int s = 0; s < 6; ++s) { p0 = __builtin_amdgcn_mfma_f32_32x32x16_bf16(ka0[s], qf[s], p0, 0, 0, 0); p1 = __builtin_amdgcn_mfma_f32_32x32x16_bf16(ka1[s], qf[s], p1, 0, 0, 0); }
#pragma unroll
                    for (int s = 0; s < 6; ++s) { kc0[s] = *(const LAS bf16x8*)(kb1 + kfr + s * 32); kc1[s] = *(const LAS bf16x8*)(kb1 + kfr + 32 * KST + s * 32); }
#pragma unroll
                    for (int rg = 0; rg < 16; ++rg) { p0[rg] = __builtin_amdgcn_exp2f(p0[rg]); p1[rg] = __builtin_amdgcn_exp2f(p1[rg]); l += p0[rg]; l += p1[rg]; }
#pragma unroll
                    for (int s = 0; s < 6; ++s) { p2 = __builtin_amdgcn_mfma_f32_32x32x16_bf16(kc0[s], qf[s], p2, 0, 0, 0); p3 = __builtin_amdgcn_mfma_f32_32x32x16_bf16(kc1[s], qf[s], p3, 0, 0, 0); }
#define ATT_PV(PA, PB, VB) _Pragma("unroll") for (int hh = 0; hh < 2; ++hh) _Pragma("unroll") for (int s2 = 0; s2 < 2; ++s2) { const bf16x8 pf = packp(hh == 0 ? PA : PB, s2); \
                        _Pragma("unroll") for (int db = 0; db < 2; ++db) { LAS unsigned char* vp_ = (VB) + vtr + (32 * hh + 16 * s2) * VST + db * 64; \
                            const s16x4 lo = __builtin_bit_cast(s16x4, __builtin_amdgcn_ds_read_tr16_b64_v4i16((LAS s16x4*)vp_)); \
                            const s16x4 hi4 = __builtin_bit_cast(s16x4, __builtin_amdgcn_ds_read_tr16_b64_v4i16((LAS s16x4*)(vp_ + 8 * VST))); \
                            const bf16x8 vf = (bf16x8){lo[0], lo[1], lo[2], lo[3], hi4[0], hi4[1], hi4[2], hi4[3]}; \
                            if (db == 0) o0 = __builtin_amdgcn_mfma_f32_32x32x16_bf16(vf, pf, o0, 0, 0, 0); else o1 = __builtin_amdgcn_mfma_f32_32x32x16_bf16(vf, pf, o1, 0, 0, 0); } }
                    ATT_PV(p0, p1, vb0);
#pragma unroll
                    for (int rg = 0; rg < 16; ++rg) { p2[rg] = __builtin_amdgcn_exp2f(p2[rg]); p3[rg] = __builtin_amdgcn_exp2f(p3[rg]); l += p2[rg]; l += p3[rg]; }
                    ATT_PV(p2, p3, vb1);
#undef ATT_PV
#define SGB(mask, n) __builtin_amdgcn_sched_group_barrier(mask, n, 0)
                    SGB(0x008, 6); SGB(0x100, 12); SGB(0x008, 6);
#pragma unroll
                    for (int i = 0; i < 12; ++i) { SGB(0x008, 1); SGB(0x400, 3); SGB(0x002, 4); }
                    SGB(0x100, 4);
#pragma unroll
                    for (int i = 0; i < 8; ++i) { SGB(0x008, 1); SGB(0x100, 2); SGB(0x400, 4); SGB(0x002, 6); }
#pragma unroll
                    for (int i = 0; i < 8; ++i) { SGB(0x008, 1); SGB(0x100, 2); }
#undef SGB
                } else
#pragma unroll
                for (int sub = 0; sub < 2; ++sub) {
                    const int tt = 2 * t + sub;
                    if (64 * tt <= qw + 31) {
                        LAS unsigned char* kb = bb + sub * SUB; LAS unsigned char* vb = kb + KBYTES;
                        bf16x8 kf0[6], kf1[6];
#pragma unroll
                        for (int s = 0; s < 6; ++s) { kf0[s] = *(const LAS bf16x8*)(kb + kfr + s * 32); kf1[s] = *(const LAS bf16x8*)(kb + kfr + 32 * KST + s * 32); }
                        __builtin_amdgcn_sched_barrier(0);
                        f32x16 p0 = negm, p1 = negm;
#pragma unroll
                        for (int s = 0; s < 6; ++s) { p0 = __builtin_amdgcn_mfma_f32_32x32x16_bf16(kf0[s], qf[s], p0, 0, 0, 0); p1 = __builtin_amdgcn_mfma_f32_32x32x16_bf16(kf1[s], qf[s], p1, 0, 0, 0); }
                        if (64 * tt + 63 > qw) {
                            int hm = hi; asm volatile("" : "+v"(hm));
                            const int qrel = qw + r - 64 * tt - 4 * hm;
#pragma unroll
                            for (int rg = 0; rg < 16; ++rg) { const int kv = (rg & 3) + 8 * (rg >> 2); if (kv > qrel) p0[rg] = -INFINITY; if (kv + 32 > qrel) p1[rg] = -INFINITY; }
                        }
                        if constexpr (!BOUNDED) {
                        float mx;
                        { float a = max3f(p0[0], p0[1], p1[0]), b2 = max3f(p0[2], p0[3], p1[1]); a = max3f(a, p1[2], p1[3]);
#pragma unroll
                          for (int rg = 4; rg < 16; rg += 4) { a = max3f(a, p0[rg], p0[rg + 1]); b2 = max3f(b2, p0[rg + 2], p0[rg + 3]); a = max3f(a, p1[rg], p1[rg + 1]); b2 = max3f(b2, p1[rg + 2], p1[rg + 3]); }
                          mx = xhalf_max(max2f(a, b2)); }
                        if (!__all(mx <= 8.0f)) {
                            const float dl = max2f(mx, 0.f), f = __builtin_amdgcn_exp2f(-dl); m += dl; l *= f;
#pragma unroll
                            for (int rg = 0; rg < 16; ++rg) { p0[rg] -= dl; p1[rg] -= dl; o0[rg] *= f; o1[rg] *= f; negm[rg] = -m; }
                        }
                        }
                        float rs = 0.f;
#pragma unroll
                        for (int rg = 0; rg < 16; ++rg) { p0[rg] = __builtin_amdgcn_exp2f(p0[rg]); p1[rg] = __builtin_amdgcn_exp2f(p1[rg]); rs += p0[rg] + p1[rg]; }
                        l += rs;
#pragma unroll
                        for (int hh = 0; hh < 2; ++hh)
#pragma unroll
                            for (int s2 = 0; s2 < 2; ++s2) { const bf16x8 pf = packp(hh == 0 ? p0 : p1, s2);
#pragma unroll
                                for (int db = 0; db < 2; ++db) { LAS unsigned char* vp_ = vb + vtr + (32 * hh + 16 * s2) * VST + db * 64;
                                    const s16x4 lo = __builtin_bit_cast(s16x4, __builtin_amdgcn_ds_read_tr16_b64_v4i16((LAS s16x4*)vp_));
                                    const s16x4 hi4 = __builtin_bit_cast(s16x4, __builtin_amdgcn_ds_read_tr16_b64_v4i16((LAS s16x4*)(vp_ + 8 * VST)));
                                    const bf16x8 vf = (bf16x8){lo[0], lo[1], lo[2], lo[3], hi4[0], hi4[1], hi4[2], hi4[3]};
                                    if (db == 0) o0 = __builtin_amdgcn_mfma_f32_32x32x16_bf16(vf, pf, o0, 0, 0, 0); else o1 = __builtin_amdgcn_mfma_f32_32x32x16_bf16(vf, pf, o1, 0, 0, 0); } }
                    }
                }
                { LAS unsigned char* nb = lds + ((t + 1) & 1) * BUF;
#pragma unroll
                  for (int i = 0; i < 3; ++i) *(LAS u32x4*)(nb + kl[i]) = ak[i];
#pragma unroll
                  for (int i = 0; i < 2; ++i) *(LAS u32x4*)(nb + vl[i]) = av[i]; }
                LDS_BAR();
            }
            carried = true;
            const float il = 1.0f / xhalf_sum(l);
            unsigned char* op = F.ws + WS_Y + (row0 + qw + r) * 1024 + 512 + h * 64 + 4 * hi;
            const float il16 = 16.f * il;
#pragma unroll
            for (int gq = 0; gq < 4; ++gq) {
                int w0 = __builtin_amdgcn_cvt_pk_fp8_f32(__builtin_amdgcn_fmed3f(o0[4 * gq] * il16, -440.f, 440.f), __builtin_amdgcn_fmed3f(o0[4 * gq + 1] * il16, -440.f, 440.f), 0, false);
                w0 = __builtin_amdgcn_cvt_pk_fp8_f32(__builtin_amdgcn_fmed3f(o0[4 * gq + 2] * il16, -440.f, 440.f), __builtin_amdgcn_fmed3f(o0[4 * gq + 3] * il16, -440.f, 440.f), w0, true);
                int w1 = __builtin_amdgcn_cvt_pk_fp8_f32(__builtin_amdgcn_fmed3f(o1[4 * gq] * il16, -440.f, 440.f), __builtin_amdgcn_fmed3f(o1[4 * gq + 1] * il16, -440.f, 440.f), 0, false);
                w1 = __builtin_amdgcn_cvt_pk_fp8_f32(__builtin_amdgcn_fmed3f(o1[4 * gq + 2] * il16, -440.f, 440.f), __builtin_amdgcn_fmed3f(o1[4 * gq + 3] * il16, -440.f, 440.f), w1, true);
                *(unsigned*)(op + 8 * gq) = (unsigned)w0; *(unsigned*)(op + 32 + 8 * gq) = (unsigned)w1; }
        }
    }
    __syncthreads();
}

__device__ __forceinline__ void p_attn_mfma(const Frame& F, const float* qn, const float* kn) {
    const int lane = lane_id_fresh();
    float gq = fmaxf(fabsf(qn[lane]), lane < 32 ? fabsf(qn[64 + lane]) : 0.f), gk = fmaxf(fabsf(kn[lane]), lane < 32 ? fabsf(kn[64 + lane]) : 0.f);
    gq = wave_max_nonneg(gq); gk = wave_max_nonneg(gk);
    const float bound = __builtin_bit_cast(float, __builtin_amdgcn_readfirstlane(__builtin_bit_cast(int, 96.f * QSCALE * 1.02f * gq * gk)));
    if (bound <= 60.f) p_attn_body<true>(F, qn); else p_attn_body<false>(F, qn);
}

constexpr int CS_CH = 256, CS_NCH = SEQ / CS_CH;
constexpr int CS_RS = 144;
constexpr int CS_IMG = 16 * CS_RS;
constexpr int CS_WAVE = 8 * CS_IMG + 512;
enum { IM_A = 0, IM_R = 1, IM_B = 2, IM_K = 3, IM_BH = 4, IM_KH = 5, IM_V = 6, IM_G = 7 };
constexpr size_t DO_CSP = 208 * MiB, DO_CSG = 224 * MiB, DO_CSZ = 240 * MiB;     constexpr size_t DO_UNUSED_ = 0;
__device__ __forceinline__ int crow8(int q, int hi) { return (q & 3) + 8 * ((q >> 2) & 1) + 4 * hi; }
template <int N> __device__ __forceinline__ float dpp_shr0(float x) { return __builtin_bit_cast(float, __builtin_amdgcn_update_dpp(0, __builtin_bit_cast(int, x), 0x110 + N, 0xf, 0xf, true)); }
__device__ __forceinline__ float rowscan16(float x) { x += dpp_shr0<1>(x); x += dpp_shr0<2>(x); x += dpp_shr0<4>(x); x += dpp_shr0<8>(x); return x; }
__device__ __forceinline__ float xsum_16_32(float v) {
    { auto r = __builtin_amdgcn_permlane16_swap(__float_as_uint(v), __float_as_uint(v), false, false); v = __uint_as_float(r[0]) + __uint_as_float(r[1]); }
    { auto r = __builtin_amdgcn_permlane32_swap(__float_as_uint(v), __float_as_uint(v), false, false); v = __uint_as_float(r[0]) + __uint_as_float(r[1]); }
    return v;
}
__device__ __forceinline__ bf16x8 cs_rowfrag(const LAS unsigned char* rowp, int hi, int ks) {
    const LAS unsigned char* p = rowp + (16 * ks + 4 * hi) * 2; const u32x2 a = *(const LAS u32x2*)p, b = *(const LAS u32x2*)(p + 16);
    return __builtin_bit_cast(bf16x8, (u32x4){a.x, a.y, b.x, b.y});
}
__device__ __forceinline__ bf16x8 cs_trfrag(LAS unsigned char* img, int cb, int lane) {
    const int g4 = lane >> 4, li = lane & 15; LAS unsigned char* p = img + (4 * (g4 >> 1) + (li >> 2)) * CS_RS + (32 * cb + 16 * (g4 & 1) + 4 * (li & 3)) * 2;
    const s16x4 lo = __builtin_bit_cast(s16x4, __builtin_amdgcn_ds_read_tr16_b64_v4i16((LAS s16x4*)p));
    const s16x4 h4 = __builtin_bit_cast(s16x4, __builtin_amdgcn_ds_read_tr16_b64_v4i16((LAS s16x4*)(p + 8 * CS_RS)));
    return (bf16x8){lo[0], lo[1], lo[2], lo[3], h4[0], h4[1], h4[2], h4[3]};
}
__device__ __forceinline__ bf16x8 cs_zero8() { return (bf16x8){0, 0, 0, 0, 0, 0, 0, 0}; }
struct CsIn { const bf16 *ZR, *A, *LW, *G; const float *mu, *k_k, *k_a, *r_k; };
template <bool USE_V, bool WITH_Y>
__device__ __forceinline__ void cs_prep(const CsIn& in, size_t row0, int tok0, int h, LAS unsigned char* wl, int lane) {
    const int t = lane & 15, jq = lane >> 4, tok = tok0 + t; const bool first = tok == 0;
    const size_t g = row0 + tok, gp = row0 + (first ? 0 : tok - 1); const int c0 = h * 64 + 16 * jq;
    LAS float* gct = (LAS float*)(wl + 8 * CS_IMG); LAS float* btt = gct + 64;
    u32x4 Lrc[2], Lrp[2], Lkc[2], Lkp[2], Lav[2], Llw[2], Lvc[2], Lvp[2];
#pragma unroll
    for (int hf = 0; hf < 2; ++hf) { const int cc = c0 + 8 * hf;
        Lkc[hf] = *(const u32x4*)(in.ZR + g * 1792 + 512 + cc); Lkp[hf] = *(const u32x4*)(in.ZR + gp * 1792 + 512 + cc);
        Lrc[hf] = *(const u32x4*)(in.ZR + g * 1792 + cc); Lrp[hf] = *(const u32x4*)(in.ZR + gp * 1792 + cc);
        Lav[hf] = *(const u32x4*)(in.A + g * 512 + cc); Llw[hf] = *(const u32x4*)(in.LW + g * 512 + cc);
        if (USE_V) { Lvc[hf] = *(const u32x4*)(in.ZR + g * 1792 + 1024 + cc); Lvp[hf] = *(const u32x4*)(in.ZR + gp * 1792 + 1024 + cc); }
    }
    float inv;
    { float ss = 0.f;
#pragma unroll
      for (int hf = 0; hf < 2; ++hf) { float kc[8], kp[8]; unpack8(Lkc[hf], kc); unpack8(Lkp[hf], kp);
          const f32x4 m0 = *(const f32x4*)(in.mu + 512 + c0 + 8 * hf), m1 = *(const f32x4*)(in.mu + 512 + c0 + 8 * hf + 4), q0 = *(const f32x4*)(in.k_k + c0 + 8 * hf), q1 = *(const f32x4*)(in.k_k + c0 + 8 * hf + 4);
          const float mm[8] = {m0.x, m0.y, m0.z, m0.w, m1.x, m1.y, m1.z, m1.w}, qq[8] = {q0.x, q0.y, q0.z, q0.w, q1.x, q1.y, q1.z, q1.w};
#pragma unroll
          for (int e = 0; e < 8; ++e) { const float zk = kc[e] + ((first ? 0.f : kp[e]) - kc[e]) * mm[e]; const float kr = zk * qq[e]; ss += kr * kr; } }
      inv = __builtin_amdgcn_rsqf(fmaxf(xsum_16_32(ss), 1e-24f)); }
    float btacc = 0.f;
#pragma unroll
    for (int hf = 0; hf < 2; ++hf) {
        const int cc = c0 + 8 * hf;
        u32x4 Lgg = {}; if (WITH_Y) Lgg = *(const u32x4*)(in.G + g * 512 + cc);
        float rc[8], rp[8], kc[8], kp[8], av[8], lw[8];
        unpack8(Lrc[hf], rc); unpack8(Lrp[hf], rp); unpack8(Lkc[hf], kc); unpack8(Lkp[hf], kp); unpack8(Lav[hf], av); unpack8(Llw[hf], lw);
        float mr[8], mk[8], qk[8], qa[8], qr[8];
        { const f32x4 a0 = *(const f32x4*)(in.mu + cc), a1 = *(const f32x4*)(in.mu + cc + 4), b0 = *(const f32x4*)(in.mu + 512 + cc), b1 = *(const f32x4*)(in.mu + 512 + cc + 4);
          const f32x4 c0_ = *(const f32x4*)(in.k_k + cc), c1_ = *(const f32x4*)(in.k_k + cc + 4), d0 = *(const f32x4*)(in.k_a + cc), d1 = *(const f32x4*)(in.k_a + cc + 4);
          mr[0] = a0.x; mr[1] = a0.y; mr[2] = a0.z; mr[3] = a0.w; mr[4] = a1.x; mr[5] = a1.y; mr[6] = a1.z; mr[7] = a1.w;
          mk[0] = b0.x; mk[1] = b0.y; mk[2] = b0.z; mk[3] = b0.w; mk[4] = b1.x; mk[5] = b1.y; mk[6] = b1.z; mk[7] = b1.w;
          qk[0] = c0_.x; qk[1] = c0_.y; qk[2] = c0_.z; qk[3] = c0_.w; qk[4] = c1_.x; qk[5] = c1_.y; qk[6] = c1_.z; qk[7] = c1_.w;
          qa[0] = d0.x; qa[1] = d0.y; qa[2] = d0.z; qa[3] = d0.w; qa[4] = d1.x; qa[5] = d1.y; qa[6] = d1.z; qa[7] = d1.w; }
        if (WITH_Y) { const f32x4 e0 = *(const f32x4*)(in.r_k + cc), e1 = *(const f32x4*)(in.r_k + cc + 4); qr[0] = e0.x; qr[1] = e0.y; qr[2] = e0.z; qr[3] = e0.w; qr[4] = e1.x; qr[5] = e1.y; qr[6] = e1.z; qr[7] = e1.w; }
        float oA[8], oR[8], oB[8], oK[8], oBH[8], oKH[8], eCs[8];
#pragma unroll
        for (int e = 0; e < 8; ++e) {
            const float r = rc[e] + ((first ? 0.f : rp[e]) - rc[e]) * mr[e]; const float zk = kc[e] + ((first ? 0.f : kp[e]) - kc[e]) * mk[e];
            const float kq = zk * (1.f + (av[e] - 1.f) * qa[e]); const float kk = zk * qk[e] * inv; const float b = kk * av[e];
            const float Lg = rowscan16(lw[e]); const float eLg = __builtin_amdgcn_exp2f(1.4426950408889634f * Lg); const float enLg = __builtin_amdgcn_rcpf(eLg);
            const float eLgm = __builtin_bit_cast(float, __builtin_amdgcn_update_dpp(0x3f800000, __builtin_bit_cast(int, eLg), 0x111, 0xf, 0xf, false));
            const float eC = __builtin_bit_cast(float, __builtin_amdgcn_ds_bpermute(((lane & 48) | 15) << 2, __builtin_bit_cast(int, eLg)));
            oA[e] = -kk * eLgm; oR[e] = r * eLg; oB[e] = b * enLg; oK[e] = kq * enLg; oBH[e] = oB[e] * eC; oKH[e] = oK[e] * eC;
            if (WITH_Y) btacc += r * kq * qr[e];
            eCs[e] = eC;
        }
        if (t == 15) { *(LAS f32x4*)(gct + 16 * jq + 8 * hf) = (f32x4){eCs[0], eCs[1], eCs[2], eCs[3]}; *(LAS f32x4*)(gct + 16 * jq + 8 * hf + 4) = (f32x4){eCs[4], eCs[5], eCs[6], eCs[7]}; }
        const int wo = t * CS_RS + (16 * jq + 8 * hf) * 2;
        *(LAS u32x4*)(wl + IM_A * CS_IMG + wo) = pack8(oA); *(LAS u32x4*)(wl + IM_R * CS_IMG + wo) = pack8(oR); *(LAS u32x4*)(wl + IM_B * CS_IMG + wo) = pack8(oB);
        *(LAS u32x4*)(wl + IM_K * CS_IMG + wo) = pack8(oK); *(LAS u32x4*)(wl + IM_BH * CS_IMG + wo) = pack8(oBH); *(LAS u32x4*)(wl + IM_KH * CS_IMG + wo) = pack8(oKH);
        if (USE_V) { float vc[8], vp[8], o[8]; unpack8(Lvc[hf], vc); unpack8(Lvp[hf], vp);
            const f32x4 a0 = *(const f32x4*)(in.mu + 1024 + cc), a1 = *(const f32x4*)(in.mu + 1024 + cc + 4); const float mv[8] = {a0.x, a0.y, a0.z, a0.w, a1.x, a1.y, a1.z, a1.w};
#pragma unroll
            for (int e = 0; e < 8; ++e) o[e] = vc[e] + ((first ? 0.f : vp[e]) - vc[e]) * mv[e];
            *(LAS u32x4*)(wl + IM_V * CS_IMG + wo) = pack8(o); }
        if (WITH_Y) *(LAS u32x4*)(wl + IM_G * CS_IMG + wo) = Lgg;
    }
    if (WITH_Y) { btacc = xsum_16_32(btacc); if (lane < 16) btt[lane] = btacc; }
}
struct CsFr { bf16x8 fAR[4], aL1, aL2, aL4, aL8, aLkMk, aMb; };
__device__ __forceinline__ void cs_gram(CsFr& fr, LAS unsigned char* wl, int lane) {
    const int hi = lane >> 5, row = lane & 15; const bool up = (lane & 16) != 0;
    const LAS unsigned char* rpAR = wl + (up ? IM_R : IM_A) * CS_IMG + row * CS_RS; const LAS unsigned char* rpBK = wl + (up ? IM_K : IM_B) * CS_IMG + row * CS_RS;
#pragma unroll
    for (int ks = 0; ks < 4; ++ks) fr.fAR[ks] = cs_rowfrag(rpAR, hi, ks);
    f32x16 F1 = {}, F2 = {};
#pragma unroll
    for (int ks = 0; ks < 4; ++ks) { const bf16x8 fBK = cs_rowfrag(rpBK, hi, ks);
        F1 = __builtin_amdgcn_mfma_f32_32x32x16_bf16(fBK, fr.fAR[ks], F1, 0, 0, 0);
        F2 = __builtin_amdgcn_mfma_f32_32x32x16_bf16(fr.fAR[ks], fBK, F2, 0, 0, 0); }
#pragma unroll
    for (int q = 0; q < 8; ++q) { const int s = crow8(q, hi); const bool k1 = up ? (s <= row) : (s < row);
        F1[q] = k1 ? F1[q] : 0.f; F1[8 + q] = k1 ? F1[8 + q] : 0.f; F2[q] = (!up && row < s) ? F2[q] : 0.f; }
    const bf16x8 f1lo = packp(F1, 0);
    fr.aL1 = up ? cs_zero8() : f1lo;
    fr.aMb = up ? f1lo : cs_zero8();
    fr.aLkMk = packp(F1, 1);
    const bf16x8 p2 = packp(F2, 0);
    const f32x16 z16 = {};
    const f32x16 Q1 = __builtin_amdgcn_mfma_f32_32x32x16_bf16(p2, fr.aL1, z16, 0, 0, 0), Q2 = __builtin_amdgcn_mfma_f32_32x32x16_bf16(fr.aL1, p2, z16, 0, 0, 0);
    fr.aL2 = packp(Q1, 0); const bf16x8 p2b = packp(Q2, 0);
    const f32x16 R1 = __builtin_amdgcn_mfma_f32_32x32x16_bf16(p2b, fr.aL2, z16, 0, 0, 0), R2 = __builtin_amdgcn_mfma_f32_32x32x16_bf16(fr.aL2, p2b, z16, 0, 0, 0);
    fr.aL4 = packp(R1, 0); const bf16x8 p2c = packp(R2, 0);
    const f32x16 S1 = __builtin_amdgcn_mfma_f32_32x32x16_bf16(p2c, fr.aL4, z16, 0, 0, 0);
    fr.aL8 = packp(S1, 0);
}
template <bool USE_V, bool WITH_Y>
__device__ __forceinline__ void cs_apply(f32x16 (&Z)[2][2], f32x16 (&D)[2], const CsFr& fr, LAS unsigned char* wl, int lane) {
    const int hi = lane >> 5;
    bf16x8 vf[2];
    if (USE_V) { vf[0] = cs_trfrag(wl + IM_V * CS_IMG, 0, lane); vf[1] = cs_trfrag(wl + IM_V * CS_IMG, 1, lane); }
#pragma unroll
    for (int nb = 0; nb < 2; ++nb) { f32x16 d = {};
#pragma unroll
        for (int jb = 0; jb < 2; ++jb)
#pragma unroll
            for (int k2 = 0; k2 < 2; ++k2) d = __builtin_amdgcn_mfma_f32_32x32x16_bf16(fr.fAR[2 * jb + k2], packp(Z[jb][nb], k2), d, 0, 0, 0);
        if (USE_V) d = __builtin_amdgcn_mfma_f32_32x32x16_bf16(fr.aLkMk, vf[nb], d, 0, 0, 0);
        D[nb] = d; }
#pragma unroll
    for (int nb = 0; nb < 2; ++nb) {
        D[nb] = __builtin_amdgcn_mfma_f32_32x32x16_bf16(fr.aL8, packp(D[nb], 0), D[nb], 0, 0, 0);
        D[nb] = __builtin_amdgcn_mfma_f32_32x32x16_bf16(fr.aL4, packp(D[nb], 0), D[nb], 0, 0, 0);
        D[nb] = __builtin_amdgcn_mfma_f32_32x32x16_bf16(fr.aL2, packp(D[nb], 0), D[nb], 0, 0, 0);
        D[nb] = __builtin_amdgcn_mfma_f32_32x32x16_bf16(fr.aL1, packp(D[nb], 0), D[nb], 0, 0, 0);
    }
    const bf16x8 u0 = packp(D[0], 0), u1 = packp(D[1], 0);
    if (WITH_Y) { D[0] = __builtin_amdgcn_mfma_f32_32x32x16_bf16(fr.aMb, u0, D[0], 0, 0, 0); D[1] = __builtin_amdgcn_mfma_f32_32x32x16_bf16(fr.aMb, u1, D[1], 0, 0, 0); }
    const LAS float* gct = (const LAS float*)(wl + 8 * CS_IMG);
#pragma unroll
    for (int jb = 0; jb < 2; ++jb) {
        const bf16x8 fb = cs_trfrag(wl + IM_BH * CS_IMG, jb, lane); bf16x8 fk = cs_zero8(); if (USE_V) fk = cs_trfrag(wl + IM_KH * CS_IMG, jb, lane);
        float gc[16];
#pragma unroll
        for (int g4 = 0; g4 < 4; ++g4) { const f32x4 x = *(const LAS f32x4*)(gct + 32 * jb + 8 * g4 + 4 * hi); gc[4 * g4] = x.x; gc[4 * g4 + 1] = x.y; gc[4 * g4 + 2] = x.z; gc[4 * g4 + 3] = x.w; }
#pragma unroll
        for (int nb = 0; nb < 2; ++nb) { f32x16 z = Z[jb][nb];
#pragma unroll
            for (int q = 0; q < 16; ++q) z[q] *= gc[q];
            z = __builtin_amdgcn_mfma_f32_32x32x16_bf16(fb, nb == 0 ? u0 : u1, z, 0, 0, 0);
            if (USE_V) z = __builtin_amdgcn_mfma_f32_32x32x16_bf16(fk, vf[nb], z, 0, 0, 0);
            Z[jb][nb] = z; }
    }
}
__device__ __forceinline__ void cs_apply_pk(bf16x8 (&Zp)[2][2][2], f32x16 (&D)[2], const CsFr& fr, LAS unsigned char* wl, int lane) {
    const int hi = lane >> 5;
#pragma unroll
    for (int nb = 0; nb < 2; ++nb) { f32x16 d = {};
#pragma unroll
        for (int jb = 0; jb < 2; ++jb)
#pragma unroll
            for (int k2 = 0; k2 < 2; ++k2) d = __builtin_amdgcn_mfma_f32_32x32x16_bf16(fr.fAR[2 * jb + k2], Zp[jb][nb][k2], d, 0, 0, 0);
        D[nb] = d; }
#pragma unroll
    for (int nb = 0; nb < 2; ++nb) {
        D[nb] = __builtin_amdgcn_mfma_f32_32x32x16_bf16(fr.aL8, packp(D[nb], 0), D[nb], 0, 0, 0);
        D[nb] = __builtin_amdgcn_mfma_f32_32x32x16_bf16(fr.aL4, packp(D[nb], 0), D[nb], 0, 0, 0);
        D[nb] = __builtin_amdgcn_mfma_f32_32x32x16_bf16(fr.aL2, packp(D[nb], 0), D[nb], 0, 0, 0);
        D[nb] = __builtin_amdgcn_mfma_f32_32x32x16_bf16(fr.aL1, packp(D[nb], 0), D[nb], 0, 0, 0);
    }
    const bf16x8 u0 = packp(D[0], 0), u1 = packp(D[1], 0);
    const LAS float* gct = (const LAS float*)(wl + 8 * CS_IMG);
#pragma unroll
    for (int jb = 0; jb < 2; ++jb) {
        const bf16x8 fb = cs_trfrag(wl + IM_BH * CS_IMG, jb, lane);
        float gc[16];
#pragma unroll
        for (int g4 = 0; g4 < 4; ++g4) { const f32x4 x = *(const LAS f32x4*)(gct + 32 * jb + 8 * g4 + 4 * hi); gc[4 * g4] = x.x; gc[4 * g4 + 1] = x.y; gc[4 * g4 + 2] = x.z; gc[4 * g4 + 3] = x.w; }
#pragma unroll
        for (int nb = 0; nb < 2; ++nb) { f32x16 z;
#pragma unroll
            for (int k2 = 0; k2 < 2; ++k2) { float e[8]; unpack8(__builtin_bit_cast(u32x4, Zp[jb][nb][k2]), e);
#pragma unroll
                for (int q = 0; q < 8; ++q) z[8 * k2 + q] = e[q] * gc[8 * k2 + q]; }
            z = __builtin_amdgcn_mfma_f32_32x32x16_bf16(fb, nb == 0 ? u0 : u1, z, 0, 0, 0);
            Zp[jb][nb][0] = packp(z, 0); Zp[jb][nb][1] = packp(z, 1); }
    }
}
template <bool USE_V, bool WITH_Y>
__device__ __forceinline__ void cs_step(f32x16 (&Z)[2][2], f32x16 (&D)[2], LAS unsigned char* wl, int lane) { CsFr fr; cs_gram(fr, wl, lane); cs_apply<USE_V, WITH_Y>(Z, D, fr, wl, lane); }
__device__ __forceinline__ void p_cs_a(const Frame& F, ArgsP a) {
    const int lane = lane_id_fresh();
    LAS unsigned char* wl = F.lds + F.wave * CS_WAVE;
    CsIn in{(const bf16*)(F.ws + WS_ZR), (const bf16*)(F.ws + WS_A), (const bf16*)(F.ws + WS_LW), (const bf16*)(F.dob + DO_G), a->in[I_MU], a->in[I_KK], a->in[I_KA], a->in[I_RK]};
    bf16* Pm = (bf16*)(F.ws + DO_CSP); bf16* Gf = (bf16*)(F.ws + DO_CSG);
    const int hi = lane >> 5;
    for (int uc = F.gw; uc < 64 * CS_NCH; uc += F.NGW) {
        const int bh = uc / CS_NCH, c = uc % CS_NCH, b = bh >> 3, h = bh & 7; const size_t row0 = (size_t)b * SEQ;
        f32x16 ZG[2][2], D[2]; bf16x8 ZP[2][2][2];
#pragma unroll
        for (int jb = 0; jb < 2; ++jb)
#pragma unroll
            for (int nb = 0; nb < 2; ++nb) { f32x16 z = {}; ZG[jb][nb] = z;
                if (jb == nb) {
#pragma unroll
                    for (int q = 0; q < 16; ++q) z[q] = (crow(q, hi) == (lane & 31)) ? 1.f : 0.f; }
                ZP[jb][nb][0] = packp(z, 0); ZP[jb][nb][1] = packp(z, 1); }
        for (int sc = 0; sc < CS_CH / 16; ++sc) { int ln = lane; asm volatile("" : "+v"(ln));
            cs_prep<true, false>(in, row0, c * CS_CH + sc * 16, h, wl, ln); asm volatile("" ::: "memory");
            CsFr fr; cs_gram(fr, wl, ln);
            cs_apply_pk(ZP, D, fr, wl, ln); cs_apply<true, false>(ZG, D, fr, wl, ln); asm volatile("" ::: "memory"); }
        int lo_ = lane; asm volatile("" : "+v"(lo_)); const int hi_o = lo_ >> 5;
        {
            LAS unsigned short* tb = (LAS unsigned short*)(wl + 4 * hi_o * CS_RS + (lo_ & 31) * 2);
#pragma unroll
            for (int jb = 0; jb < 2; ++jb)
#pragma unroll
                for (int nb = 0; nb < 2; ++nb)
#pragma unroll
                    for (int q = 0; q < 16; ++q) tb[((32 * jb + (q & 3) + 8 * (q >> 2)) * CS_RS + 64 * nb) / 2] = (unsigned short)ZP[jb][nb][q >> 3][q & 7];
            bf16* dst = Pm + (size_t)uc * 4096;
            asm volatile("s_waitcnt lgkmcnt(0)" ::: "memory");
#pragma unroll
            for (int mb = 0; mb < 2; ++mb)
#pragma unroll
                for (int f = 0; f < 4; ++f) { const LAS unsigned char* src = wl + (32 * mb + (lo_ & 31)) * CS_RS + (16 * f + 4 * hi_o) * 2;
                    const u32x2 x0 = *(const LAS u32x2*)src, x1 = *(const LAS u32x2*)(src + 16);
                    *(u32x4*)(dst + ((mb * 64 + lo_) * 4 + f) * 8) = (u32x4){x0.x, x0.y, x1.x, x1.y}; }
            asm volatile("s_waitcnt lgkmcnt(0)" ::: "memory");
        }
        {
            bf16* dst = Gf + (size_t)uc * 4096;
#pragma unroll
            for (int jb = 0; jb < 2; ++jb)
#pragma unroll
                for (int nb = 0; nb < 2; ++nb) { u32x4 w0, w1; const f32x16& z = ZG[jb][nb];
                    w0.x = pk2(z[0], z[1]); w0.y = pk2(z[2], z[3]); w0.z = pk2(z[4], z[5]); w0.w = pk2(z[6], z[7]); w1.x = pk2(z[8], z[9]); w1.y = pk2(z[10], z[11]); w1.z = pk2(z[12], z[13]); w1.w = pk2(z[14], z[15]);
                    u32x4* p = (u32x4*)(dst + ((jb * 2 + nb) * 64 + lo_) * 16); p[0] = w0; p[1] = w1; }
        }
    }
}
struct CsB { u32x4 p[2][2][2]; u32x4 g[2][2]; };
__device__ __forceinline__ void csb_load(CsB& X, const bf16* Pm, const bf16* Gf, size_t uc, int nb, int lane) {
    const bf16* Pc = Pm + uc * 4096;
#pragma unroll
    for (int mb = 0; mb < 2; ++mb) { const u32x4* pp = (const u32x4*)(Pc + (mb * 64 + lane) * 32);
#pragma unroll
        for (int jb = 0; jb < 2; ++jb)
#pragma unroll
            for (int k2 = 0; k2 < 2; ++k2) X.p[mb][jb][k2] = pp[jb * 2 + k2];
        const u32x4* gp = (const u32x4*)(Gf + uc * 4096 + ((mb * 2 + nb) * 64 + lane) * 16); X.g[mb][0] = gp[0]; X.g[mb][1] = gp[1]; }
}
__device__ __forceinline__ void csb_step(f32x16 (&Z)[2], const CsB& X, bf16* Zf, size_t uc, int nb, int lane) {
#pragma unroll
    for (int jb = 0; jb < 2; ++jb) { u32x4 w0, w1; const f32x16& z = Z[jb];
        w0.x = pk2(z[0], z[1]); w0.y = pk2(z[2], z[3]); w0.z = pk2(z[4], z[5]); w0.w = pk2(z[6], z[7]); w1.x = pk2(z[8], z[9]); w1.y = pk2(z[10], z[11]); w1.z = pk2(z[12], z[13]); w1.w = pk2(z[14], z[15]);
        u32x4* p = (u32x4*)(Zf + uc * 4096 + ((jb * 2 + nb) * 64 + lane) * 16); p[0] = w0; p[1] = w1; }
    f32x16 N[2];
#pragma unroll
    for (int mb = 0; mb < 2; ++mb) { float g0[8], g1[8]; unpack8(X.g[mb][0], g0); unpack8(X.g[mb][1], g1);
#pragma unroll
        for (int q = 0; q < 8; ++q) { N[mb][q] = g0[q]; N[mb][8 + q] = g1[q]; } }
#pragma unroll
    for (int jb = 0; jb < 2; ++jb)
#pragma unroll
        for (int k2 = 0; k2 < 2; ++k2) { const bf16x8 zb = packp(Z[jb], k2);
#pragma unroll
            for (int mb = 0; mb < 2; ++mb) N[mb] = __builtin_amdgcn_mfma_f32_32x32x16_bf16(__builtin_bit_cast(bf16x8, X.p[mb][jb][k2]), zb, N[mb], 0, 0, 0); }
    Z[0] = N[0]; Z[1] = N[1];
}
__device__ __forceinline__ void p_cs_b(const Frame& F) {
    const int lane = lane_id_fresh();
    const bf16* Pm = (const bf16*)(F.ws + DO_CSP); const bf16* Gf = (const bf16*)(F.ws + DO_CSG); bf16* Zf = (bf16*)(F.ws + DO_CSZ);
    for (int u16 = F.gw; u16 < 128 * 16; u16 += F.NGW) {
        if (u16 & 15) continue;
        const int u = u16 >> 4, bh = u >> 1, nb = u & 1; const size_t uc0 = (size_t)bh * CS_NCH;
        f32x16 Z[2] = {};
        CsB X0, X1, X2;
        csb_load(X0, Pm, Gf, uc0, nb, lane); csb_load(X1, Pm, Gf, uc0 + 1, nb, lane);
#define CSB_CL(c_) (uc0 + ((c_) < CS_NCH ? (c_) : CS_NCH - 1))
        int c = 0;
        for (; c + 2 < CS_NCH; c += 3) {
            csb_load(X2, Pm, Gf, CSB_CL(c + 2), nb, lane); csb_step(Z, X0, Zf, uc0 + c, nb, lane);
            csb_load(X0, Pm, Gf, CSB_CL(c + 3), nb, lane); csb_step(Z, X1, Zf, uc0 + c + 1, nb, lane);
            csb_load(X1, Pm, Gf, CSB_CL(c + 4), nb, lane); csb_step(Z, X2, Zf, uc0 + c + 2, nb, lane);
        }
        if (c < CS_NCH) { csb_step(Z, X0, Zf, uc0 + c, nb, lane); ++c; }
        if (c < CS_NCH) { csb_step(Z, X1, Zf, uc0 + c, nb, lane); ++c; }
#undef CSB_CL
    }
}
__device__ __forceinline__ void p_cs_c(const Frame& F, ArgsP a) {
    const int lane = lane_id_fresh(), hi = lane >> 5;
    LAS unsigned char* wl = F.lds + F.wave * CS_WAVE;
    CsIn in{(const bf16*)(F.ws + WS_ZR), (const bf16*)(F.ws + WS_A), (const bf16*)(F.ws + WS_LW), (const bf16*)(F.dob + DO_G), a->in[I_MU], a->in[I_KK], a->in[I_KA], a->in[I_RK]};
    const bf16* Zf = (const bf16*)(F.ws + DO_CSZ); bf16* Y = (bf16*)(F.ws + WS_Y); const float* lnw = a->in[I_LNW]; const float* lnb = a->in[I_LNB];
    const LAS float* btt = (const LAS float*)(wl + 8 * CS_IMG) + 64;
    for (int uc = F.gw; uc < 64 * CS_NCH; uc += F.NGW) {
        const int bh = uc / CS_NCH, c = uc % CS_NCH, b = bh >> 3, h = bh & 7; const size_t row0 = (size_t)b * SEQ;
        f32x16 Z[2][2], D[2];
        int lu = lane; asm volatile("" : "+v"(lu));
#pragma unroll
        for (int jb = 0; jb < 2; ++jb)
#pragma unroll
            for (int nb = 0; nb < 2; ++nb) { const u32x4* p = (const u32x4*)(Zf + (size_t)uc * 4096 + ((jb * 2 + nb) * 64 + lu) * 16); float g0[8], g1[8]; unpack8(p[0], g0); unpack8(p[1], g1);
#pragma unroll
                for (int q = 0; q < 8; ++q) { Z[jb][nb][q] = g0[q]; Z[jb][nb][8 + q] = g1[q]; } }
        const float lw0 = lnw[h * 64 + (lu & 31)], lw1 = lnw[h * 64 + 32 + (lu & 31)], lb0 = lnb[h * 64 + (lu & 31)], lb1 = lnb[h * 64 + 32 + (lu & 31)];
        for (int sc = 0; sc < CS_CH / 16; ++sc) {
            const int tok0 = c * CS_CH + sc * 16;
            int ln = lane; asm volatile("" : "+v"(ln));
            cs_prep<true, true>(in, row0, tok0, h, wl, ln); asm volatile("" ::: "memory");
            cs_step<true, true>(Z, D, wl, ln); asm volatile("" ::: "memory");
            const int hl = ln >> 5;
            const bf16x8 v0 = cs_trfrag(wl + IM_V * CS_IMG, 0, ln), v1 = cs_trfrag(wl + IM_V * CS_IMG, 1, ln), g0 = cs_trfrag(wl + IM_G * CS_IMG, 0, ln), g1 = cs_trfrag(wl + IM_G * CS_IMG, 1, ln);
            const f32x4 bta = *(const LAS f32x4*)(btt + 4 * hl), btb = *(const LAS f32x4*)(btt + 8 + 4 * hl); const float bt[8] = {bta.x, bta.y, bta.z, bta.w, btb.x, btb.y, btb.z, btb.w};
#pragma unroll
            for (int q = 0; q < 8; ++q) {
                const float y0 = D[0][8 + q], y1 = D[1][8 + q];
                const float mean = allsum32(y0 + y1) * (1.f / 64.f); const float d0 = y0 - mean, d1 = y1 - mean;
                const float rstd = __builtin_amdgcn_rsqf(allsum32(d0 * d0 + d1 * d1) * (1.f / 64.f) + LN_X_EPS);
                const float o0 = (d0 * rstd * lw0 + lb0 + bt[q] * bf2f((unsigned short)v0[q])) * bf2f((unsigned short)g0[q]);
                const float o1 = (d1 * rstd * lw1 + lb1 + bt[q] * bf2f((unsigned short)v1[q])) * bf2f((unsigned short)g1[q]);
                unsigned char* yp = (unsigned char*)Y + (row0 + tok0 + crow8(q, hl)) * 1024 + h * 64 + (ln & 31);
                const int w8 = __builtin_amdgcn_cvt_pk_fp8_f32(__builtin_amdgcn_fmed3f(16.f * o0, -440.f, 440.f), __builtin_amdgcn_fmed3f(16.f * o1, -440.f, 440.f), 0, false);
                yp[0] = (unsigned char)(w8 & 0xff); yp[32] = (unsigned char)((w8 >> 8) & 0xff);
            }
            asm volatile("" ::: "memory");
        }
    }
}

__device__ __forceinline__ void p_ffn_route(const Frame& F, ArgsP a, unsigned* cnt, int* ridxv, f32x2* rwv) {
    const int lane_f = lane_id_fresh(), tid_f = F.wave * 64 + lane_f;
    const bf16* MO = (const bf16*)(F.ws + WS_MO); bf16* H2 = (bf16*)(F.ws + WS_H2); const float* mod = (const float*)(F.ws + WS_MOD); const float* g = a->in[I_GFFN];
    constexpr int RTS = 1028;
    LAS float* wr = (LAS float*)F.lds;
    __syncthreads();
    for (int i = tid_f; i < 1024 * 4; i += NTHR) { const int k = i >> 2, o = i & 3; wr[o * RTS + k] = a->in[I_WRG][i]; }
    for (int i = tid_f; i < 1024 * 32; i += NTHR) { const int k = i >> 5, o = i & 31; wr[(4 + o) * RTS + k] = a->in[I_WRE][i]; }
    __syncthreads();
    LAS float* brl = wr + 36 * RTS;
    if (tid_f < 4) brl[tid_f] = a->in[I_BRG][tid_f]; else if (tid_f < 36) brl[tid_f] = a->in[I_BRE][tid_f - 4];
    const int lane = lane_f;
    LAS unsigned* lcnt = (LAS unsigned*)(F.lds + LDS_MISC + 512);
    if (tid_f < 256) lcnt[tid_f] = 0u;
    __syncthreads();
    int my_e0 = 0, my_e1 = 0; float my_w0 = 0.f, my_w1 = 0.f; int kk_ = 0;
    u32x2 ma[4], mb[4]; f32x4 gsv[4], shv[4]; int bcur = -1;
    { const u32x2* mr = (const u32x2*)(MO + (size_t)F.gw * 1024) + lane;
#pragma unroll
      for (int j = 0; j < 4; ++j) ma[j] = mr[64 * j]; }
#define RT_ROW(CM, NM, m_) do { const int mm = (m_); const int b = mm / SEQ; \
        if (b != bcur) { bcur = b; \
            _Pragma("unroll") for (int j = 0; j < 4; ++j) { const int col = 4 * lane + 256 * j; \
                gsv[j] = *(const f32x4*)(g + col) * (*(const f32x4*)(mod + b * 6144 + 4096 + col) + 1.0f); shv[j] = *(const f32x4*)(mod + b * 6144 + 3072 + col); } \
            asm volatile("s_waitcnt vmcnt(0)" : "+v"(gsv[0]), "+v"(gsv[1]), "+v"(gsv[2]), "+v"(gsv[3]), "+v"(shv[0]), "+v"(shv[1]), "+v"(shv[2]), "+v"(shv[3])); \
            asm volatile("" : "+v"(CM[0]), "+v"(CM[1]), "+v"(CM[2]), "+v"(CM[3])); } \
        { const int mn = (mm + F.NGW < NTOK) ? mm + F.NGW : mm; const u32x2* mr = (const u32x2*)(MO + (size_t)mn * 1024) + lane; \
          _Pragma("unroll") for (int j = 0; j < 4; ++j) NM[j] = mr[64 * j]; } \
        f32x4 v[4]; float s = 0.f; \
        _Pragma("unroll") for (int j = 0; j < 4; ++j) { v[j] = (f32x4){lo2f(CM[j].x), hi2f(CM[j].x), lo2f(CM[j].y), hi2f(CM[j].y)}; \
            s += (v[j].x * v[j].x + v[j].y * v[j].y) + (v[j].z * v[j].z + v[j].w * v[j].w); } \
        const float rstd = __builtin_amdgcn_rsqf(wave_sum(s) * (1.f / 1024.f) + EPS); \
        unsigned* o = (unsigned*)((unsigned char*)H2 + (size_t)mm * 1024) + lane;        \
        _Pragma("unroll") for (int j = 0; j < 4; ++j) { v[j] = v[j] * rstd * gsv[j] + shv[j]; \
            int w = __builtin_amdgcn_cvt_pk_fp8_f32(__builtin_amdgcn_fmed3f(v[j].x, -440.f, 440.f), __builtin_amdgcn_fmed3f(v[j].y, -440.f, 440.f), 0, false); \
            w = __builtin_amdgcn_cvt_pk_fp8_f32(__builtin_amdgcn_fmed3f(v[j].z, -440.f, 440.f), __builtin_amdgcn_fmed3f(v[j].w, -440.f, 440.f), w, true); o[64 * j] = (unsigned)w; } \
        float lgq[4];                            \
        _Pragma("unroll") for (int oo = 0; oo < 4; ++oo) { float p = 0.f; \
            _Pragma("unroll") for (int j = 0; j < 4; ++j) { const f32x4 w4 = *(const LAS f32x4*)(wr + oo * RTS + 4 * lane + 256 * j); p = fmaf(v[j].x, w4.x, p); p = fmaf(v[j].y, w4.y, p); p = fmaf(v[j].z, w4.z, p); p = fmaf(v[j].w, w4.w, p); } \
            lgq[oo] = p; } \
        _Pragma("unroll") for (int oo = 0; oo < 4; ++oo) lgq[oo] = wave_sum(lgq[oo]) + brl[oo]; \
        int gi = 0; float gmx = lgq[0]; \
        _Pragma("unroll") for (int i = 1; i < 4; ++i) { if (lgq[i] > gmx) { gmx = lgq[i]; gi = i; } } \
        float gsum = 0.f; \
        _Pragma("unroll") for (int i = 0; i < 4; ++i) gsum += __expf(lgq[i] - gmx); \
        const float pg = __builtin_amdgcn_rcpf(gsum); \
        gi = __builtin_amdgcn_readfirstlane(gi); \
        float el[8]; \
        { const LAS float* wg = wr + (4 + gi * 8) * RTS + 4 * lane; \
          _Pragma("unroll") for (int i = 0; i < 8; ++i) { float p = 0.f; \
              _Pragma("unroll") for (int j = 0; j < 4; ++j) { const f32x4 w4 = *(const LAS f32x4*)(wg + i * RTS + 256 * j); p = fmaf(v[j].x, w4.x, p); p = fmaf(v[j].y, w4.y, p); p = fmaf(v[j].z, w4.z, p); p = fmaf(v[j].w, w4.w, p); } \
              el[i] = p; } \
          _Pragma("unroll") for (int i = 0; i < 8; ++i) el[i] = wave_sum(el[i]) + brl[4 + gi * 8 + i]; } \
        int i0 = 0; float m0 = el[0]; \
        _Pragma("unroll") for (int i = 1; i < 8; ++i) if (el[i] > m0) { m0 = el[i]; i0 = i; } \
        int i1 = -1; float m1 = -INFINITY; \
        _Pragma("unroll") for (int i = 0; i < 8; ++i) if (i != i0 && el[i] > m1) { m1 = el[i]; i1 = i; } \
        const float e1 = __expf(m1 - m0), w0 = pg * __builtin_amdgcn_rcpf(1.f + e1), w1 = w0 * e1; \
        { const int lo_ = i0 < i1 ? i0 : i1, hi_ = i0 < i1 ? i1 : i0; \
          if (lane == kk_) { my_e0 = gi * 28 + (lo_ * (15 - lo_)) / 2 + (hi_ - lo_ - 1); my_w0 = i0 < i1 ? w0 : w1; my_w1 = i0 < i1 ? w1 : w0; } } \
        ++kk_; } while (0)
    for (int m = F.gw; m < NTOK; m += 2 * F.NGW) {
        RT_ROW(ma, mb, m);
        if (m + F.NGW < NTOK) RT_ROW(mb, ma, m + F.NGW);
    }
#undef RT_ROW
    unsigned lp0 = 0u;
    if (lane < kk_) lp0 = __hip_atomic_fetch_add(lcnt + my_e0, 1u, __ATOMIC_RELAXED, __HIP_MEMORY_SCOPE_WORKGROUP);
    __syncthreads();
    if (tid_f < NCLS) lcnt[128 + tid_f] = __hip_atomic_fetch_add(cnt + tid_f, lcnt[tid_f], __ATOMIC_RELAXED, __HIP_MEMORY_SCOPE_AGENT);
    __syncthreads();
    if (lane < kk_) { const int m = F.gw + lane * F.NGW; const size_t v = (size_t)my_e0 * CLS_CAP + (lcnt[128 + my_e0] + lp0);
        ridxv[v] = m; rwv[v] = (f32x2){my_w0, my_w1}; }
    __syncthreads();
    (void)my_e1;
}
__device__ __forceinline__ int moe_tables(const Frame& F, LAS int* offs, LAS int* texp, LAS int* ccnt) {
    const int lane_f = lane_id_fresh();
    const unsigned* cnt = (const unsigned*)(F.ws + WS_CTL) + CW_CNT;
    __syncthreads();
    if (F.wave == 0) {
        const int c0 = (int)__hip_atomic_load(cnt + lane_f, __ATOMIC_RELAXED, __HIP_MEMORY_SCOPE_AGENT);
        const int c1 = (lane_f < NCLS - 64) ? (int)__hip_atomic_load(cnt + 64 + lane_f, __ATOMIC_RELAXED, __HIP_MEMORY_SCOPE_AGENT) : 0;
        const int n0 = (c0 + 255) >> 8, n1 = (c1 + 255) >> 8; int i0 = n0, i1 = n1;
#pragma unroll
        for (int d = 1; d < 64; d <<= 1) { const int a = __shfl_up(i0, d, 64), b = __shfl_up(i1, d, 64); if (lane_f >= d) { i0 += a; i1 += b; } }
        const int tot0 = __shfl(i0, 63, 64); i1 += tot0;
        const int t0 = i0 - n0, t1 = i1 - n1;
        offs[lane_f] = t0 << 8; ccnt[lane_f] = c0; for (int t = 0; t < n0; ++t) texp[t0 + t] = lane_f;
        if (lane_f < NCLS - 64) { offs[64 + lane_f] = t1 << 8; ccnt[64 + lane_f] = c1; for (int t = 0; t < n1; ++t) texp[t1 + t] = 64 + lane_f; if (lane_f == NCLS - 65) offs[NCLS] = i1 << 8; }
    }
    __syncthreads();
    return __builtin_amdgcn_readfirstlane(offs[NCLS] >> 8);
}
constexpr int NPHASE = 14;
template <int LO, int HI>
__global__ void __launch_bounds__(NTHR, 2) fwd(Args args) {
    extern __shared__ __attribute__((aligned(16))) unsigned char lds_raw[];
    Frame F;
    F.lds = (LAS unsigned char*)lds_raw;
    F.wave = __builtin_amdgcn_readfirstlane((int)threadIdx.x >> 6);
    F.G = gridDim.x; { const int bx = blockIdx.x; F.vcu = (F.G % 8 == 0) ? (bx % 8) * (F.G / 8) + bx / 8 : bx; }
    F.gw = F.vcu * NWAVES + F.wave; F.NGW = F.G * NWAVES;
    F.ws = args.ws; F.dob = (unsigned char*)args.out;
    ArgsP AP = (ArgsP)__builtin_amdgcn_kernarg_segment_ptr();
    volatile LAS unsigned* MISC = (volatile LAS unsigned*)(F.lds + LDS_MISC);
    if (threadIdx.x < 64) MISC[threadIdx.x] = 0u;
    __syncthreads();
    XcdBarrier bar; bar.bar = (unsigned*)(F.ws + WS_CTL) + CW_BAR; bar.x = 0; bar.st = MISC + 8;
#if N_LAUNCH_MODE == 1
    bar = xcd_barrier_post((unsigned*)(F.ws + WS_CTL) + CW_BAR, MISC + 8);
#define GRID_BAR() xcd_barrier(bar)
#else
#define GRID_BAR() do { } while (0)
#endif
#ifndef PROBE_REPEAT
#define PROBE_REPEAT -1
#endif
#define IN(k) (LO <= (k) && (k) < HI)
#define SEAM(k) do { if constexpr (IN(k) && IN((k) + 1)) GRID_BAR(); } while (0)
    const float* mod = (const float*)(F.ws + WS_MOD);

#define PH(k, ...) do { if constexpr (IN(k)) { asm volatile("" : "+s"(AP)); { __VA_ARGS__ } if constexpr (PROBE_REPEAT == (k)) { GRID_BAR(); asm volatile("" : "+s"(AP)); { __VA_ARGS__ } } } } while (0)
    PH(0, p0_prologue(F, AP);); SEAM(0);
    PH(1, p_normmod(F, AP->in[I_X], AP->in[I_GMIX], mod, 0, 1024, (bf16*)(F.ws + WS_H), F.ws + WS_H8);); SEAM(1);
    PH(2, { Gemm g{(const bf16*)(F.ws + WS_H), (const bf16*)(F.ws + WS_WIN), NTOK, 2304, 1024}; StaticOrder S; S.init(NTOK, 2304, F.G, (int)blockIdx.x);
            EpiZ E{(bf16*)(F.ws + WS_ZR), (bf16*)(F.ws + WS_ZM)}; gemm_phase_any(F.lds, g, S, E, F.wave); }
          { Gemm g{(const bf16*)(F.ws + WS_H8), (const bf16*)(F.ws + WS_WG8), NTOK, 2048, 1024}; StaticOrder S; S.init(NTOK, 2048, F.G, (int)blockIdx.x);
            EpiZG E{(bf16*)(F.ws + WS_SG)}; gemm_phase_fp8(F.lds, g, S, E, F.wave); }); SEAM(2);
    PH(3, p_prep_a(F, AP);); SEAM(3);
    PH(4,
        { Gemm g{(const bf16*)(F.ws + WS_TWA), (const bf16*)(F.ws + WS_WBLK), NTOK, 1024, 128}; StaticOrder S; S.init(NTOK, 1024, F.G, (int)blockIdx.x);
          EpiLora E{(bf16*)(F.ws + WS_LW), (bf16*)(F.ws + WS_A), AP->in[I_W0], AP->in[I_A0]}; gemm_phase_any(F.lds, g, S, E, F.wave); }
        { Gemm g{(const bf16*)(F.ws + WS_SGL), (const bf16*)(F.ws + WS_WG), NTOK, 512, 128}; StaticOrder S; S.init(NTOK, 512, F.G, (int)blockIdx.x);
          EpiPlain E{(bf16*)(F.dob + DO_G), nullptr, 1 << 30, 512, 0}; gemm_phase_any(F.lds, g, S, E, F.wave); }
        { Gemm g{(const bf16*)(F.ws + WS_QA), (const bf16*)(F.ws + WS_WUQ), NTOK, 768, 256}; StaticOrder S; S.init(NTOK, 768, F.G, (int)blockIdx.x);
          EpiPlain E{(bf16*)(F.dob + DO_Q), nullptr, 1 << 30, 768, 0}; gemm_phase_any(F.lds, g, S, E, F.wave); }
        { Gemm g{(const bf16*)(F.ws + WS_KVA), (const bf16*)(F.ws + WS_WUKV), NTOK, 1024, 128}; StaticOrder S; S.init(NTOK, 1024, F.G, (int)blockIdx.x);
          EpiPlain E{(bf16*)(F.dob + DO_KN), (bf16*)(F.ws + WS_VC), 512, 512, 512}; gemm_phase_any(F.lds, g, S, E, F.wave); }
    ); SEAM(4);
    PH(5, p_cs_a(F, AP);); SEAM(5);
    PH(6, { if ((F.vcu & 1) == 0) { if (F.wave == 0) p_cs_b(F); }
            else p_prep_c(F, AP, (F.vcu >> 1) * NWAVES + F.wave, (F.G >> 1) * NWAVES); }); SEAM(6);
#if ENG_ATTN == 1
    PH(7, p_attn_mfma(F, AP->in[I_QN], AP->in[I_KN]);); SEAM(7);
#else
    PH(7, p_attn_naive(F);); SEAM(7);
#endif
    PH(8, p_cs_c(F, AP);); SEAM(8);
    PH(9, Gemm g{(const bf16*)(F.ws + WS_Y), (const bf16*)(F.ws + WS_WB), NTOK, 1024, 1024}; StaticOrder S; S.init(NTOK, 1024, F.G, (int)blockIdx.x);
        EpiBranch2 E{(bf16*)(F.ws + WS_MG), (const bf16*)(F.ws + WS_SG)}; gemm_phase_mid_fp8(F.lds, g, S, E, F.wave);); SEAM(9);
    PH(10, Gemm g{(const bf16*)(F.ws + WS_MG), (const bf16*)(F.ws + WS_WO), NTOK, 1024, 1024}; StaticOrder S; S.init(NTOK, 1024, F.G, (int)blockIdx.x);
        EpiX1 E{(bf16*)(F.ws + WS_MO), AP->in[I_X], mod}; gemm_phase_fp8(F.lds, g, S, E, F.wave);); SEAM(10);
    if constexpr (IN(11)) { asm volatile("" : "+s"(AP)); p_ffn_route(F, AP, (unsigned*)(F.ws + WS_CTL) + CW_CNT, (int*)(F.ws + WS_RIDXV), (f32x2*)(F.ws + WS_RWV)); } SEAM(11);
#define MOE_TABLES() LAS int* offs = (LAS int*)(F.lds + LDS_MISC + 1024); LAS int* ccnt = (LAS int*)(F.lds + LDS_MISC + 1536); LAS int* texp = (LAS int*)(F.lds + LDS_MISC + 2048); const int nt = moe_tables(F, offs, texp, ccnt)
    PH(12, MOE_TABLES();
        Gemm g{(const bf16*)(F.ws + WS_H2), (const bf16*)(F.ws + WS_WGU), MPAD2, 1024, 1024, (const int*)(F.ws + WS_RIDXV)}; PairOrderGU S{texp, offs, ccnt, nt, F.G, (int)blockIdx.x};
        EpiGateUp2 E{(bf16*)(F.ws + WS_HID2), (const float*)(F.ws + WS_RWV)}; gemm_phase_gather(F.lds, g, S, E, F.wave);); SEAM(12);
    PH(13, MOE_TABLES();
        Gemm g{(const bf16*)(F.ws + WS_HID2), (const bf16*)(F.ws + WS_WDN), MPAD2, 1024, 512, nullptr, 256}; PairOrderDown S{texp, offs, ccnt, nt, F.G, (int)blockIdx.x};
        { const int tq = F.wave * 64 + lane_id_fresh();
          const int bq = tq >> 6, c16 = (tq & 63) * 16; const float* gp = mod + bq * 6144 + 5120 + c16; float ga[8], gb[8];
          { const f32x4 a0 = *(const f32x4*)gp, a1 = *(const f32x4*)(gp + 4), a2 = *(const f32x4*)(gp + 8), a3 = *(const f32x4*)(gp + 12);
            ga[0] = a0.x; ga[1] = a0.y; ga[2] = a0.z; ga[3] = a0.w; ga[4] = a1.x; ga[5] = a1.y; ga[6] = a1.z; ga[7] = a1.w; gb[0] = a2.x; gb[1] = a2.y; gb[2] = a2.z; gb[3] = a2.w; gb[4] = a3.x; gb[5] = a3.y; gb[6] = a3.z; gb[7] = a3.w; }
          _Pragma("unroll") for (int i = 0; i < 8; ++i) { ga[i] *= (1.f / 1024.f); gb[i] *= (1.f / 1024.f); }
          LAS u32x4* gd = (LAS u32x4*)(F.lds + 131072 + (bq * 1024 + c16) * 2); gd[0] = pack8(ga); gd[1] = pack8(gb); __syncthreads(); }
        EpiDown2 E{(float*)F.dob, (const bf16*)(F.ws + WS_MO), (const LAS unsigned char*)(F.lds + 131072), (const int*)(F.ws + WS_RIDXV)}; gemm_phase_bseg(F.lds, g, S, E, F.wave););
#undef MOE_TABLES
}

#if N_LAUNCH_MODE == 1
static bool set_attrs() { return hipFuncSetAttribute((const void*)fwd<0, NPHASE>, hipFuncAttributeMaxDynamicSharedMemorySize, LDS_BYTES) == hipSuccess; }
#else
template <int P> static bool set_attr_all() { if constexpr (P < NPHASE) { return hipFuncSetAttribute((const void*)fwd<P, P + 1>, hipFuncAttributeMaxDynamicSharedMemorySize, LDS_BYTES) == hipSuccess && set_attr_all<P + 1>(); } else return true; }
static bool set_attrs() { return set_attr_all<0>(); }
template <int P> static void launch_all(int grid, hipStream_t stream, const Args& a) { if constexpr (P < NPHASE) { hipLaunchKernelGGL((fwd<P, P + 1>), dim3(grid), dim3(NTHR), LDS_BYTES, stream, a); launch_all<P + 1>(grid, stream, a); } }
#endif
extern "C" void kernel_launch(void* const* d_in, const int* in_sizes, int n_in, void* d_out, int out_size, void* d_ws, size_t ws_size, hipStream_t stream) {
    static int grid = 0;
    if (grid == 0) {
        if (n_in != 34 || out_size != NTOK * DM || ws_size < WS_END) { fprintf(stderr, "kernel_launch: unexpected shapes (n_in %d out %d ws %zu)\n", n_in, out_size, ws_size); grid = -1; return; }
        int dev = 0, cus = 0;
        if (hipGetDevice(&dev) != hipSuccess || hipDeviceGetAttribute(&cus, hipDeviceAttributeMultiprocessorCount, dev) != hipSuccess) { grid = -1; return; }
        if (!set_attrs()) { fprintf(stderr, "kernel_launch: hipFuncSetAttribute failed\n"); grid = -1; return; }
        grid = cus;
    }
    if (grid < 0) return;
    (void)hipMemsetAsync((char*)d_ws + WS_CTL, 0, CTL_ZERO_BYTES, stream);
    Args a{};
    for (int i = 0; i < 34; ++i) a.in[i] = (const float*)d_in[i];
    a.out = (float*)d_out; a.ws = (unsigned char*)d_ws;
    a.ph_lo = 0; a.ph_hi = NPHASE;
#if N_LAUNCH_MODE == 1
    hipLaunchKernelGGL((fwd<0, NPHASE>), dim3(grid), dim3(NTHR), LDS_BYTES, stream, a);
#else
    launch_all<0>(grid, stream, a);
#endif
}
```
